# Optimizing an MI355X kernel written in HIP

```python
import jax, jax.numpy as jnp
from jax import lax
import numpy as np

D_MODEL = 1024
BATCH = 2
SEQ = 16384
DEPTH = 4

GRID_W = 64
CTX_LEN = 256
N_MIXERS = 2
N_A_LAYERS = (DEPTH + 1) // 2
N_B_LAYERS = DEPTH // 2
EPS = 1e-6
MLSTM_HEADS = 4
MLSTM_DQK = D_MODEL // (2 * MLSTM_HEADS)
MLSTM_DV = D_MODEL // MLSTM_HEADS
MLSTM_CHUNK = 64
IGATE_SOFTCAP = 15.0
FGATE_BIAS_INIT = 3.0
MLSTM_NQ = MLSTM_HEADS * MLSTM_DQK
MLSTM_NV = MLSTM_HEADS * MLSTM_DV
MLSTM_PROJ = 2 * MLSTM_NQ + MLSTM_NV + D_MODEL + 4 * MLSTM_HEADS
CONV_W = 3
N_GROUPS = 4
EXPERTS_PER_GROUP = 8
N_EXPERTS = N_GROUPS * EXPERTS_PER_GROUP
TOP_K = 2
D_EXPERT = D_MODEL // 2
MOE_BLOCK = 256

kernel_name = 'hybrid_mlstm_shortconv_hmoe_dit'


def rmsnorm(x, g):
    xf = x.astype(jnp.float32)
    y = xf * lax.rsqrt(jnp.mean(xf * xf, axis=-1, keepdims=True) + EPS)
    return (y * g.astype(jnp.float32)).astype(x.dtype)


def modulate(x, shift, scale):
    return x * (1 + scale) + shift


def centred_conv3(z, w, axis):
    n = z.shape[axis]
    pad = [(0, 0)] * z.ndim
    pad[axis] = (1, 1)
    zp = jnp.pad(z, pad)
    left = lax.slice_in_dim(zp, 0, n, axis=axis)
    mid = lax.slice_in_dim(zp, 1, n + 1, axis=axis)
    right = lax.slice_in_dim(zp, 2, n + 2, axis=axis)
    return w[0] * left + w[1] * mid + w[2] * right


def short_conv_mixer(h, w_in, conv_w, w_out, grid):
    bg, cg, u = jnp.split(h @ w_in, 3, axis=-1)
    z = cg * u
    if grid:
        b_, t, ch = z.shape
        rows = t // GRID_W
        y = centred_conv3(z.reshape(b_, rows, GRID_W, ch), conv_w, axis=2).reshape(b_, t, ch)
    else:
        y = centred_conv3(z, conv_w, axis=1)
    return (bg * y) @ w_out


def mlstm_scan(q, k, v, li, lf, state, return_h):
    b_, nh, t, _ = q.shape
    dv = v.shape[-1]
    nc = t // MLSTM_CHUNK

    def chunks(a):
        a = a.reshape(a.shape[:2] + (nc, MLSTM_CHUNK) + a.shape[3:])
        return jnp.moveaxis(a, 2, 0)

    causal = jnp.tril(jnp.ones((MLSTM_CHUNK, MLSTM_CHUNK), dtype=bool))

    def step(carry, inp):
        c_st, n_st, m_st = carry
        qc, kc, vc, ic, fc = inp
        b = jnp.cumsum(fc, axis=-1)
        b_last = b[..., -1]
        w_end = b_last[..., None] - b + ic
        m_new = jnp.maximum(b_last + m_st, w_end.max(-1))
        a_end = jnp.exp(w_end - m_new[..., None])
        decay = jnp.exp(b_last + m_st - m_new)
        c_new = decay[..., None, None] * c_st + jnp.einsum('bhsk,bhsv->bhkv', kc * a_end[..., None], vc)
        n_new = decay[..., None] * n_st + jnp.einsum('bhsk,bhs->bhk', kc, a_end)
        if not return_h:
            return (c_new, n_new, m_new), None
        logw = jnp.where(causal, b[..., :, None] - b[..., None, :] + ic[..., None, :], -jnp.inf)
        inter = b + m_st[..., None]
        m_row = jnp.maximum(inter, logw.max(-1))
        s = jnp.einsum('bhjk,bhsk->bhjs', qc, kc) * jnp.exp(logw - m_row[..., None])
        a_inter = jnp.exp(inter - m_row)
        num = jnp.einsum('bhjs,bhsv->bhjv', s, vc) + a_inter[..., None] * jnp.einsum('bhjk,bhkv->bhjv', qc, c_st)
        den = s.sum(-1) + a_inter * jnp.einsum('bhjk,bhk->bhj', qc, n_st)
        h = num / jnp.maximum(jnp.abs(den), jnp.exp(-m_row))[..., None]
        return (c_new, n_new, m_new), h

    state, hs = lax.scan(step, state, (chunks(q), chunks(k), chunks(v), chunks(li), chunks(lf)))
    if return_h:
        hs = jnp.moveaxis(hs, 0, 2).reshape(b_, nh, t, dv)
    return hs, state


def mlstm_project(h, w_in, b_gate):
    p = (h @ w_in).astype(jnp.float32)
    b_, t, _ = p.shape
    q, k, v, o, g = jnp.split(p, [MLSTM_NQ, 2 * MLSTM_NQ, 2 * MLSTM_NQ + MLSTM_NV,
                                  2 * MLSTM_NQ + MLSTM_NV + D_MODEL], axis=-1)

    def heads(a, d):
        return a.reshape(b_, t, MLSTM_HEADS, d).transpose(0, 2, 1, 3)

    q = heads(q, MLSTM_DQK) * (MLSTM_DQK ** -0.5)
    k = heads(k, MLSTM_DQK)
    v = heads(v, MLSTM_DV)
    g = (g + b_gate.astype(jnp.float32)).reshape(b_, t, 4, MLSTM_HEADS).transpose(2, 0, 3, 1)
    li = IGATE_SOFTCAP * jnp.tanh(g[0::2] / IGATE_SOFTCAP)
    lf = jax.nn.log_sigmoid(g[1::2])
    return q, k, v, jax.nn.sigmoid(o), li, lf


def mlstm_bidir(q, k, v, li, lf, st_f0, st_b0, return_h):
    def flip(a):
        return jnp.flip(a, axis=2)
    h_f, st_f = mlstm_scan(q, k, v, li[0], lf[0], st_f0, return_h)
    h_b, st_b = mlstm_scan(flip(q), flip(k), flip(v), flip(li[1]), flip(lf[1]), st_b0, return_h)
    h = h_f + flip(h_b) if return_h else None
    return h, st_f, st_b


def mlstm_output(h, o, head_g, w_out, dtype):
    h = h * lax.rsqrt(jnp.mean(h * h, axis=-1, keepdims=True) + EPS)
    b_, nh, t, dv = h.shape
    h = h.transpose(0, 2, 1, 3).reshape(b_, t, nh * dv) * head_g.astype(jnp.float32) * o
    return h.astype(dtype) @ w_out


def mlstm_mixer(h_lat, h_ctx, w_in, b_gate, head_g, w_out, ctx_out):
    b_ = h_lat.shape[0]
    zero = (jnp.zeros((b_, MLSTM_HEADS, MLSTM_DQK, MLSTM_DV), jnp.float32),
            jnp.zeros((b_, MLSTM_HEADS, MLSTM_DQK), jnp.float32),
            jnp.zeros((b_, MLSTM_HEADS), jnp.float32))
    qc, kc, vc, oc, lic, lfc = mlstm_project(h_ctx, w_in, b_gate)
    hc, st_f, st_b = mlstm_bidir(qc, kc, vc, lic, lfc, zero, zero, ctx_out)
    ql, kl, vl, ol, lil, lfl = mlstm_project(h_lat, w_in, b_gate)
    hl, _, _ = mlstm_bidir(ql, kl, vl, lil, lfl, st_f, st_b, True)
    y_lat = mlstm_output(hl, ol, head_g, w_out, h_lat.dtype)
    y_ctx = mlstm_output(hc, oc, head_g, w_out, h_ctx.dtype) if ctx_out else None
    return y_lat, y_ctx


def hier_moe(h, w_group, b_group, w_router, b_router, w_gate, w_up, w_down):
    t, d = h.shape
    p_group = jax.nn.softmax((h @ w_group).astype(jnp.float32) + b_group.astype(jnp.float32), axis=-1)
    grp = jnp.argmax(p_group, axis=-1)
    p_grp = jnp.take_along_axis(p_group, grp[:, None], axis=1)
    logits = ((h @ w_router).astype(jnp.float32) + b_router.astype(jnp.float32)).reshape(t, N_GROUPS, EXPERTS_PER_GROUP)
    logits = jnp.take_along_axis(logits, grp[:, None, None], axis=1)[:, 0]
    top_p, top_i = lax.top_k(jax.nn.softmax(logits, axis=-1), TOP_K)
    gate = p_grp * top_p / top_p.sum(-1, keepdims=True)
    eid = grp[:, None] * EXPERTS_PER_GROUP + top_i
    n_assign = t * TOP_K
    e_flat = eid.reshape(-1)
    tok_flat = jnp.repeat(jnp.arange(t, dtype=jnp.int32), TOP_K)
    order = jnp.argsort(e_flat)
    e_s, tok_s, w_s = e_flat[order], tok_flat[order], gate.reshape(-1)[order]
    counts = jnp.bincount(e_flat, length=N_EXPERTS)
    starts = jnp.cumsum(counts) - counts
    padded = (counts + MOE_BLOCK - 1) // MOE_BLOCK * MOE_BLOCK
    pends = jnp.cumsum(padded)
    pstarts = pends - padded
    dest = pstarts[e_s] + jnp.arange(n_assign) - starts[e_s]
    n_blocks = -(-n_assign // MOE_BLOCK) + N_EXPERTS
    slot_tok = jnp.full((n_blocks * MOE_BLOCK,), t, jnp.int32).at[dest].set(tok_s)
    slot_w = jnp.zeros((n_blocks * MOE_BLOCK,), h.dtype).at[dest].set(w_s.astype(h.dtype))
    blk_e = jnp.minimum(jnp.searchsorted(pends, jnp.arange(n_blocks) * MOE_BLOCK, side='right'), N_EXPERTS - 1)
    xb = jnp.concatenate([h, jnp.zeros((1, d), h.dtype)], axis=0)[slot_tok].reshape(n_blocks, MOE_BLOCK, d)

    def expert_block(args):
        xblk, e = args
        return (jax.nn.silu(xblk @ w_gate[e]) * (xblk @ w_up[e])) @ w_down[e]

    yb = lax.map(expert_block, (xb, blk_e)).reshape(-1, d) * slot_w[:, None]
    return jax.ops.segment_sum(yb, slot_tok, num_segments=t + 1)[:t]


def setup_inputs(seed: int = 0) -> dict:
    key = jax.random.key(seed)
    ks = jax.random.split(key, 22)
    f32 = jnp.float32

    def nrm(k, shape, scale):
        return scale * jax.random.normal(k, shape, f32)

    d = D_MODEL
    gate_idx = jnp.arange(4 * MLSTM_HEADS) // MLSTM_HEADS
    fgate_offset = jnp.where(gate_idx % 2 == 1, FGATE_BIAS_INIT, 0.0).astype(f32)
    return {
        'x': nrm(ks[0], (BATCH, SEQ, d), 1.0),
        'c': nrm(ks[1], (BATCH, d), 1.0),
        'ctx': nrm(ks[2], (BATCH, CTX_LEN, d), 1.0),
        'c_ctx': nrm(ks[3], (d,), 1.0),
        'mod_w': nrm(ks[4], (DEPTH, d, 6 * d), 0.5 * d ** -0.5),
        'mod_b': nrm(ks[5], (DEPTH, 6 * d), 0.01),
        'norm_g': 1.0 + nrm(ks[6], (DEPTH, 2, d), 0.02),
        'final_g': 1.0 + nrm(ks[7], (d,), 0.02),
        'a_w_in': nrm(ks[8], (N_A_LAYERS, d, MLSTM_PROJ), d ** -0.5),
        'a_b_gate': nrm(ks[9], (N_A_LAYERS, 4 * MLSTM_HEADS), 0.1) + fgate_offset,
        'a_head_g': 1.0 + nrm(ks[10], (N_A_LAYERS, MLSTM_NV), 0.02),
        'a_w_out': nrm(ks[11], (N_A_LAYERS, MLSTM_NV, d), MLSTM_NV ** -0.5),
        'b_w_in': nrm(ks[12], (N_B_LAYERS, d, 3 * d), d ** -0.5),
        'b_conv_w': nrm(ks[13], (N_B_LAYERS, CONV_W, d), CONV_W ** -0.5),
        'b_w_out': nrm(ks[14], (N_B_LAYERS, d, d), d ** -0.5),
        'moe_w_group': nrm(ks[15], (DEPTH, d, N_GROUPS), d ** -0.5),
        'moe_b_group': nrm(ks[16], (DEPTH, N_GROUPS), 0.01),
        'moe_w_router': nrm(ks[17], (DEPTH, d, N_EXPERTS), d ** -0.5),
        'moe_b_router': nrm(ks[18], (DEPTH, N_EXPERTS), 0.01),
        'moe_w_gate': nrm(ks[19], (DEPTH, N_EXPERTS, d, D_EXPERT), d ** -0.5),
        'moe_w_up': nrm(ks[20], (DEPTH, N_EXPERTS, d, D_EXPERT), d ** -0.5),
        'moe_w_down': nrm(ks[21], (DEPTH, N_EXPERTS, D_EXPERT, d), D_EXPERT ** -0.5),
    }


def reference(x, c, ctx, c_ctx, mod_w, mod_b, norm_g, final_g, a_w_in, a_b_gate, a_head_g, a_w_out,
              b_w_in, b_conv_w, b_w_out, moe_w_group, moe_b_group, moe_w_router, moe_b_router,
              moe_w_gate, moe_w_up, moe_w_down):
    silu_c = jax.nn.silu(c)
    silu_cc = jax.nn.silu(c_ctx)
    lat, cx = x, ctx
    b_, s_, d = x.shape
    for l in range(DEPTH):
        kind, j = l % N_MIXERS, l // N_MIXERS
        ctx_after = any(i % N_MIXERS == 0 for i in range(l + 1, DEPTH))
        ctx_here = kind == 0 or ctx_after
        mod = (silu_c @ mod_w[l] + mod_b[l])[:, None, :]
        sh1, sc1, g1, sh2, sc2, g2 = jnp.split(mod, 6, axis=-1)
        hl = modulate(rmsnorm(lat, norm_g[l, 0]), sh1, sc1)
        if ctx_here:
            mc = silu_cc @ mod_w[l] + mod_b[l]
            csh1, csc1, cg1, csh2, csc2, cg2 = jnp.split(mc, 6, axis=-1)
            hc = modulate(rmsnorm(cx, norm_g[l, 0]), csh1, csc1)
        if kind == 0:
            yl, yc = mlstm_mixer(hl, hc, a_w_in[j], a_b_gate[j], a_head_g[j], a_w_out[j], ctx_after)
        else:
            yl = short_conv_mixer(hl, b_w_in[j], b_conv_w[j], b_w_out[j], grid=True)
            yc = short_conv_mixer(hc, b_w_in[j], b_conv_w[j], b_w_out[j], grid=False) if ctx_after else None
        lat = lat + g1 * yl
        hl2 = modulate(rmsnorm(lat, norm_g[l, 1]), sh2, sc2)
        moe_args = (moe_w_group[l], moe_b_group[l], moe_w_router[l], moe_b_router[l],
                    moe_w_gate[l], moe_w_up[l], moe_w_down[l])
        if ctx_after:
            cx = cx + cg1 * yc
            hc2 = modulate(rmsnorm(cx, norm_g[l, 1]), csh2, csc2)
            n_ctx = hc2.shape[1]
            y = hier_moe(jnp.concatenate([hl2.reshape(-1, d), hc2.reshape(-1, d)], axis=0), *moe_args)
            lat = lat + g2 * y[:b_ * s_].reshape(b_, s_, d)
            cx = cx + cg2 * y[b_ * s_:].reshape(b_, n_ctx, d)
        else:
            lat = lat + g2 * hier_moe(hl2.reshape(-1, d), *moe_args).reshape(b_, s_, d)
    return rmsnorm(lat, final_g)
```

```cpp
#include <hip/hip_runtime.h>
#include <cstdio>
#include <cstdint>

#define LAS __attribute__((address_space(3)))
typedef unsigned short bf16;
typedef float f32x4 __attribute__((ext_vector_type(4)));
typedef unsigned u32x4 __attribute__((ext_vector_type(4)));
typedef unsigned u32x2 __attribute__((ext_vector_type(2)));

constexpr int D = 1024, BATCH = 2, SEQ = 16384, DEPTH = 4, CTXL = 256;
constexpr int NL = BATCH * SEQ, NCX = BATCH * CTXL, NR = NL + NCX;
constexpr int NH = 4, DQK = 128, DV = 256, NQ = 512, NV = 1024, PROJ = 3088, PW = 3072;
constexpr int NGRP = 4, EPG = 8, NE = 32, DE = 512;
constexpr int NBLK = 65;
constexpr int NUNIT = BATCH * NH * NBLK;
constexpr int CAP = NR;
constexpr int YROWS = 74752;
constexpr float EPS = 1e-6f;
constexpr int NT = 512, NW = 8;

constexpr size_t MiB = 1u << 20;
constexpr size_t WS_CTL = 0, CTL_BYTES = 1 * MiB;
constexpr size_t WS_MOD = 1 * MiB;
constexpr size_t WS_GATE = 2 * MiB;
constexpr size_t WS_TOKSLOT = 5 * MiB;
constexpr size_t WS_TOKW = 6 * MiB;
constexpr size_t WS_SLOTTOK = 7 * MiB;
constexpr size_t WS_DN = 12 * MiB;
constexpr size_t WS_NST = 13 * MiB;
constexpr size_t WS_BTOT = 14 * MiB;
constexpr size_t WS_LAT = 16 * MiB;
constexpr size_t WS_HB = 146 * MiB;
constexpr size_t WS_PB = 211 * MiB;
constexpr size_t WS_HM = 406 * MiB;
constexpr size_t WS_DC = 471 * MiB;
constexpr size_t WS_CST = 601 * MiB;
constexpr size_t WS_END = 731 * MiB;
constexpr int CW_CNT = 1024;

struct Args { const float* in[22]; float* out; unsigned char* ws; int lo, hi; };

__device__ __forceinline__ float bf2f(bf16 v) { return __uint_as_float(((unsigned)v) << 16); }
__device__ __forceinline__ unsigned f2bf(float f) { unsigned u = __float_as_uint(f); return (u + 0x7fffu + ((u >> 16) & 1u)) >> 16; }
__device__ __forceinline__ unsigned pk2(float lo, float hi) { return f2bf(lo) | (f2bf(hi) << 16); }
__device__ __forceinline__ float wave_sum(float v) {
#pragma unroll
    for (int o = 1; o < 64; o <<= 1) v += __shfl_xor(v, o);
    return v;
}
__device__ __forceinline__ float sigmoidf_(float x) { return 1.f / (1.f + __expf(-x)); }
__device__ __forceinline__ float siluf_(float x) { return x / (1.f + __expf(-x)); }
__device__ __forceinline__ float logsigmoidf_(float x) { return fminf(x, 0.f) - log1pf(__expf(-fabsf(x))); }
__device__ __forceinline__ int blk_row0(int b, int blk) { return blk == 0 ? NL + b * CTXL : b * SEQ + (blk - 1) * 256; }
__device__ __forceinline__ int mod_vec_of_row(int row) { return row < NL ? row / SEQ : 2; }

struct Ctx {
    LAS unsigned char* lds; int tid, lane, wave, G, bid;
    const Args* a;
};

__device__ __forceinline__ void slot_bases(const Args& A, int l, LAS int* sb, int tid) {
    if (tid == 0) {
        const unsigned* cnt = (const unsigned*)(A.ws + WS_CTL) + CW_CNT + l * 32;
        int acc = 0;
        for (int e = 0; e < NE; ++e) { sb[e] = acc; acc += (((int)cnt[e] + 255) / 256) * 256; }
        sb[NE] = acc;
    }
    __syncthreads();
}

__device__ __forceinline__ void phase_mod(const Args& A, const Ctx& C) {
    LAS float* sc = (LAS float*)C.lds;
    LAS float* red = sc + 3072;
    const float* c = A.in[1]; const float* cc = A.in[3];
    for (int i = C.tid; i < 3072; i += NT) { const float v = i < 2048 ? c[i] : cc[i - 2048]; sc[i] = siluf_(v); }
    __syncthreads();
    float* MOD = (float*)(A.ws + WS_MOD);
    for (int u = C.bid; u < DEPTH * 96; u += C.G) {
        const int l = u / 96, cg = u % 96, col = cg * 64 + C.lane;
        const float* w = A.in[4] + (size_t)l * D * 6 * D + col;
        float a0 = 0.f, a1 = 0.f, a2 = 0.f;
        for (int k = C.wave * 128; k < C.wave * 128 + 128; ++k) { const float wv = w[(size_t)k * 6 * D]; a0 += sc[k] * wv; a1 += sc[1024 + k] * wv; a2 += sc[2048 + k] * wv; }
        red[(C.wave * 3 + 0) * 64 + C.lane] = a0; red[(C.wave * 3 + 1) * 64 + C.lane] = a1; red[(C.wave * 3 + 2) * 64 + C.lane] = a2;
        __syncthreads();
        if (C.tid < 192) { const int v = C.tid / 64, ln = C.tid % 64; float s = 0.f;
            for (int w8 = 0; w8 < 8; ++w8) s += red[(w8 * 3 + v) * 64 + ln];
            MOD[(size_t)(l * 3 + v) * 6 * D + cg * 64 + ln] = s + A.in[5][(size_t)l * 6 * D + cg * 64 + ln]; }
        __syncthreads();
    }
}

__device__ __forceinline__ void load_row_f32(const float* p, int lane, f32x4 (&v)[4]) {
#pragma unroll
    for (int j = 0; j < 4; ++j) v[j] = *(const f32x4*)(p + 4 * lane + 256 * j);
}
__device__ __forceinline__ void load_row_bf16(const bf16* p, int lane, f32x4 (&v)[4]) {
#pragma unroll
    for (int j = 0; j < 4; ++j) { const u32x2 w = *(const u32x2*)(p + 4 * lane + 256 * j);
        v[j] = (f32x4){__uint_as_float(w.x << 16), __uint_as_float(w.x & 0xffff0000u), __uint_as_float(w.y << 16), __uint_as_float(w.y & 0xffff0000u)}; }
}
__device__ __forceinline__ void store_row_bf16(bf16* p, int lane, const f32x4 (&v)[4]) {
#pragma unroll
    for (int j = 0; j < 4; ++j) { u32x2 w; w.x = pk2(v[j].x, v[j].y); w.y = pk2(v[j].z, v[j].w); *(u32x2*)(p + 4 * lane + 256 * j) = w; }
}
__device__ __forceinline__ void moe_combine(const Args& A, int lp, int row, int lane, LAS const int* sb, f32x4 (&v)[4]) {
    const int* ts = (const int*)(A.ws + WS_TOKSLOT) + row * 2; const float* tw = (const float*)(A.ws + WS_TOKW) + row * 2;
    const bf16* Y = (const bf16*)(A.ws + WS_PB);
    const int t0 = ts[0], t1 = ts[1]; const float w0 = tw[0], w1 = tw[1];
    const size_t s0 = (size_t)(sb[t0 >> 20] + (t0 & 0xfffff)), s1 = (size_t)(sb[t1 >> 20] + (t1 & 0xfffff));
    f32x4 y0[4], y1[4], g2[4];
    load_row_bf16(Y + s0 * D, lane, y0); load_row_bf16(Y + s1 * D, lane, y1);
    load_row_f32((const float*)(A.ws + WS_MOD) + (size_t)(lp * 3 + mod_vec_of_row(row)) * 6 * D + 5 * D, lane, g2);
#pragma unroll
    for (int j = 0; j < 4; ++j) v[j] += g2[j] * (y0[j] * w0 + y1[j] * w1);
}
__device__ __forceinline__ void norm_mod(const f32x4 (&v)[4], const float* g, const float* sh, const float* sc, int lane, f32x4 (&h)[4]) {
    float s = 0.f;
#pragma unroll
    for (int j = 0; j < 4; ++j) s += (v[j].x * v[j].x + v[j].y * v[j].y) + (v[j].z * v[j].z + v[j].w * v[j].w);
    const float r = 1.0f / sqrtf(wave_sum(s) * (1.f / D) + EPS);
    f32x4 gg[4], ss[4], cc[4];
    load_row_f32(g, lane, gg); load_row_f32(sh, lane, ss); load_row_f32(sc, lane, cc);
#pragma unroll
    for (int j = 0; j < 4; ++j) h[j] = (v[j] * r) * gg[j] * (1.f + cc[j]) + ss[j];
}

__device__ __forceinline__ void phase_r1(const Args& A, const Ctx& C, int l) {
    LAS int* sb = (LAS int*)C.lds;
    LAS float* GW = (LAS float*)(C.lds + 256);
    const bool mls = (l & 1) == 0; const int j = l >> 1;
    if (l > 0) slot_bases(A, l - 1, sb, C.tid);
    if (mls) { const float* w = A.in[8] + (size_t)j * D * PROJ + PW;
        for (int i = C.tid; i < 16 * D; i += NT) { const int k = i >> 4, c = i & 15; GW[c * D + k] = w[(size_t)k * PROJ + c]; }
        __syncthreads(); }
    const int nrows = (l <= 2) ? NR : NL;
    float* LAT = (float*)(A.ws + WS_LAT); bf16* H = (bf16*)(A.ws + WS_HB); float* GATE = (float*)(A.ws + WS_GATE);
    const float* MOD = (const float*)(A.ws + WS_MOD);
    for (int row = C.bid * NW + C.wave; row < nrows; row += C.G * NW) {
        f32x4 v[4], h[4];
        if (l == 0) load_row_f32(row < NL ? A.in[0] + (size_t)row * D : A.in[2] + (size_t)(row - NL) * D, C.lane, v);
        else { load_row_f32(LAT + (size_t)row * D, C.lane, v); moe_combine(A, l - 1, row, C.lane, sb, v); }
#pragma unroll
        for (int q = 0; q < 4; ++q) *(f32x4*)(LAT + (size_t)row * D + 4 * C.lane + 256 * q) = v[q];
        const float* mv = MOD + (size_t)(l * 3 + mod_vec_of_row(row)) * 6 * D;
        norm_mod(v, A.in[6] + (size_t)(l * 2 + 0) * D, mv + 0 * D, mv + 1 * D, C.lane, h);
        store_row_bf16(H + (size_t)row * D, C.lane, h);
        if (mls) {
            float gt[16];
#pragma unroll
            for (int c = 0; c < 16; ++c) { float s = 0.f;
#pragma unroll
                for (int q = 0; q < 4; ++q) { const f32x4 w = *(const LAS f32x4*)(GW + c * D + 4 * C.lane + 256 * q); s += (h[q].x * w.x + h[q].y * w.y) + (h[q].z * w.z + h[q].w * w.w); }
                gt[c] = wave_sum(s); }
            if (C.lane < 16) { float g = 0.f;
#pragma unroll
                for (int c = 0; c < 16; ++c) g = (C.lane == c) ? gt[c] : g;
                g += A.in[9][j * 16 + C.lane];
                const int gtype = C.lane >> 2;
                const float o = (gtype & 1) ? logsigmoidf_(g) : 15.0f * tanhf(g * (1.0f / 15.0f));
                GATE[(size_t)row * 16 + C.lane] = o; }
        }
    }
}

__device__ __forceinline__ void phase_r2(const Args& A, const Ctx& C, int l) {
    LAS float* RW = (LAS float*)C.lds;
    { const float* wg = A.in[15] + (size_t)l * D * NGRP; const float* wr = A.in[17] + (size_t)l * D * NE;
      for (int i = C.tid; i < 4 * D; i += NT) { const int k = i >> 2, c = i & 3; RW[c * D + k] = wg[(size_t)k * NGRP + c]; }
      for (int i = C.tid; i < 32 * D; i += NT) { const int k = i >> 5, c = i & 31; RW[(4 + c) * D + k] = wr[(size_t)k * NE + c]; }
      __syncthreads(); }
    const int nrows = (l <= 1) ? NR : NL;
    float* LAT = (float*)(A.ws + WS_LAT); bf16* H = (bf16*)(A.ws + WS_HB);
    const float* MOD = (const float*)(A.ws + WS_MOD);
    unsigned* cnt = (unsigned*)(A.ws + WS_CTL) + CW_CNT + l * 32;
    int* TS = (int*)(A.ws + WS_TOKSLOT); float* TW = (float*)(A.ws + WS_TOKW); int* ST = (int*)(A.ws + WS_SLOTTOK);
    for (int row = C.bid * NW + C.wave; row < nrows; row += C.G * NW) {
        f32x4 v[4], y[4], g1[4], h[4];
        const float* mv = MOD + (size_t)(l * 3 + mod_vec_of_row(row)) * 6 * D;
        load_row_f32(LAT + (size_t)row * D, C.lane, v); load_row_bf16(H + (size_t)row * D, C.lane, y); load_row_f32(mv + 2 * D, C.lane, g1);
#pragma unroll
        for (int q = 0; q < 4; ++q) { v[q] += g1[q] * y[q]; *(f32x4*)(LAT + (size_t)row * D + 4 * C.lane + 256 * q) = v[q]; }
        norm_mod(v, A.in[6] + (size_t)(l * 2 + 1) * D, mv + 3 * D, mv + 4 * D, C.lane, h);
        store_row_bf16(H + (size_t)row * D, C.lane, h);
        float mine = 0.f;
#pragma unroll 2
        for (int c = 0; c < 36; ++c) { float s = 0.f;
#pragma unroll
            for (int q = 0; q < 4; ++q) { const f32x4 w = *(const LAS f32x4*)(RW + c * D + 4 * C.lane + 256 * q); s += (h[q].x * w.x + h[q].y * w.y) + (h[q].z * w.z + h[q].w * w.w); }
            s = wave_sum(s); mine = (C.lane == c) ? s : mine; }
        LAS float* wl = (LAS float*)(C.lds + 36 * D * 4) + C.wave * 64;
        if (C.lane < 36) wl[C.lane] = mine;
        asm volatile("s_waitcnt lgkmcnt(0)" ::: "memory");
        if (C.lane == 0) {
            float lg[36];
#pragma unroll
            for (int c = 0; c < 36; ++c) lg[c] = wl[c];
            const float* bg = A.in[16] + l * NGRP; const float* br = A.in[18] + l * NE;
            float gl[4]; int grp = 0; float gm = -3.0e38f;
#pragma unroll
            for (int c = 0; c < 4; ++c) { gl[c] = lg[c] + bg[c]; if (gl[c] > gm) { gm = gl[c]; grp = c; } }
            float gs = 0.f;
#pragma unroll
            for (int c = 0; c < 4; ++c) gs += __expf(gl[c] - gm);
            const float pgrp = 1.0f / gs;
            float rl[8];
#pragma unroll
            for (int i = 0; i < 8; ++i) { float t = 0.f;
#pragma unroll
                for (int g = 0; g < 4; ++g) t = (g == grp) ? lg[4 + g * 8 + i] : t;
                rl[i] = t + br[grp * 8 + i]; }
            int i0 = 0; float m0 = rl[0];
#pragma unroll
            for (int i = 1; i < 8; ++i) if (rl[i] > m0) { m0 = rl[i]; i0 = i; }
            int i1 = -1; float m1 = -3.0e38f;
#pragma unroll
            for (int i = 0; i < 8; ++i) if (i != i0 && rl[i] > m1) { m1 = rl[i]; i1 = i; }
            const float p0 = 1.0f, p1 = __expf(m1 - m0);
            const float w0 = pgrp * p0 / (p0 + p1), w1 = pgrp * p1 / (p0 + p1);
            const int e0 = grp * 8 + i0, e1 = grp * 8 + i1;
            const unsigned q0 = atomicAdd(cnt + e0, 1u), q1 = atomicAdd(cnt + e1, 1u);
            ST[(size_t)e0 * CAP + q0] = row; ST[(size_t)e1 * CAP + q1] = row;
            TS[row * 2 + 0] = (e0 << 20) | (int)q0; TS[row * 2 + 1] = (e1 << 20) | (int)q1;
            TW[row * 2 + 0] = w0; TW[row * 2 + 1] = w1;
        }
    }
}

__device__ __forceinline__ void phase_final(const Args& A, const Ctx& C) {
    LAS int* sb = (LAS int*)C.lds;
    slot_bases(A, 3, sb, C.tid);
    const float* LAT = (const float*)(A.ws + WS_LAT);
    for (int row = C.bid * NW + C.wave; row < NL; row += C.G * NW) {
        f32x4 v[4], g[4];
        load_row_f32(LAT + (size_t)row * D, C.lane, v); moe_combine(A, 3, row, C.lane, sb, v);
        float s = 0.f;
#pragma unroll
        for (int j = 0; j < 4; ++j) s += (v[j].x * v[j].x + v[j].y * v[j].y) + (v[j].z * v[j].z + v[j].w * v[j].w);
        const float r = 1.0f / sqrtf(wave_sum(s) * (1.f / D) + EPS);
        load_row_f32(A.in[7], C.lane, g);
#pragma unroll
        for (int j = 0; j < 4; ++j) *(f32x4*)(A.out + (size_t)row * D + 4 * C.lane + 256 * j) = (v[j] * r) * g[j];
    }
}

__device__ __forceinline__ void phase_conv(const Args& A, const Ctx& C, int l) {
    const int j = l >> 1; const int nrows = (l <= 1) ? NR : NL;
    const bf16* P = (const bf16*)(A.ws + WS_PB); bf16* HM = (bf16*)(A.ws + WS_HM);
    const float* cw = A.in[13] + (size_t)j * 3 * D;
    for (int row = C.bid * NW + C.wave; row < nrows; row += C.G * NW) {
        bool hasl, hasr;
        if (row < NL) { const int t = row & 63; hasl = t != 0; hasr = t != 63; } else { const int t = (row - NL) & 255; hasl = t != 0; hasr = t != 255; }
        f32x4 bg[4], cg[4], u[4], w0[4], w1[4], w2[4], acc[4];
        const bf16* pr = P + (size_t)row * PW;
        load_row_bf16(pr, C.lane, bg); load_row_bf16(pr + D, C.lane, cg); load_row_bf16(pr + 2 * D, C.lane, u);
        load_row_f32(cw, C.lane, w0); load_row_f32(cw + D, C.lane, w1); load_row_f32(cw + 2 * D, C.lane, w2);
#pragma unroll
        for (int q = 0; q < 4; ++q) acc[q] = w1[q] * (cg[q] * u[q]);
        if (hasl) { load_row_bf16(pr - PW + D, C.lane, cg); load_row_bf16(pr - PW + 2 * D, C.lane, u);
#pragma unroll
            for (int q = 0; q < 4; ++q) acc[q] += w0[q] * (cg[q] * u[q]); }
        if (hasr) { load_row_bf16(pr + PW + D, C.lane, cg); load_row_bf16(pr + PW + 2 * D, C.lane, u);
#pragma unroll
            for (int q = 0; q < 4; ++q) acc[q] += w2[q] * (cg[q] * u[q]); }
#pragma unroll
        for (int q = 0; q < 4; ++q) acc[q] *= bg[q];
        store_row_bf16(HM + (size_t)row * D, C.lane, acc);
    }
}

template <bool DUAL, class RowPtr, class Epi>
__device__ __forceinline__ void ngemm_tile(LAS float* lds, int tid, RowPtr rowptr, const float* B0, const float* B1, int ldb, int n0, int K, Epi epi) {
    LAS float* As = lds;
    LAS float* Bs0 = lds + 16 * 132;
    LAS float* Bs1 = Bs0 + 16 * 68;
    const int tr = tid >> 4, tc = tid & 15;
    float acc0[4][4], acc1[4][4];
#pragma unroll
    for (int i = 0; i < 4; ++i)
#pragma unroll
        for (int j = 0; j < 4; ++j) { acc0[i][j] = 0.f; acc1[i][j] = 0.f; }
    const int ar = tid >> 2, akq = (tid & 3) * 4;
    const bf16* ap = rowptr(ar);
    const int bk = tid >> 5, bn = (tid & 31) * 2;
    for (int k0 = 0; k0 < K; k0 += 16) {
        u32x2 av = (u32x2){0u, 0u};
        if (ap) av = *(const u32x2*)(ap + k0 + akq);
        As[(akq + 0) * 132 + ar] = __uint_as_float(av.x << 16); As[(akq + 1) * 132 + ar] = __uint_as_float(av.x & 0xffff0000u);
        As[(akq + 2) * 132 + ar] = __uint_as_float(av.y << 16); As[(akq + 3) * 132 + ar] = __uint_as_float(av.y & 0xffff0000u);
        { const float* bp = B0 + (size_t)(k0 + bk) * ldb + n0 + bn; Bs0[bk * 68 + bn] = bp[0]; Bs0[bk * 68 + bn + 1] = bp[1]; }
        if (DUAL) { const float* bp = B1 + (size_t)(k0 + bk) * ldb + n0 + bn; Bs1[bk * 68 + bn] = bp[0]; Bs1[bk * 68 + bn + 1] = bp[1]; }
        __syncthreads();
#pragma unroll
        for (int kk = 0; kk < 16; ++kk) {
            const f32x4 a = *(const LAS f32x4*)(As + kk * 132 + tr * 4);
            const f32x4 b = *(const LAS f32x4*)(Bs0 + kk * 68 + tc * 4);
#pragma unroll
            for (int i = 0; i < 4; ++i)
#pragma unroll
                for (int j = 0; j < 4; ++j) acc0[i][j] += a[i] * b[j];
            if (DUAL) { const f32x4 b1 = *(const LAS f32x4*)(Bs1 + kk * 68 + tc * 4);
#pragma unroll
                for (int i = 0; i < 4; ++i)
#pragma unroll
                    for (int j = 0; j < 4; ++j) acc1[i][j] += a[i] * b1[j]; }
        }
        __syncthreads();
    }
#pragma unroll
    for (int i = 0; i < 4; ++i) epi(tr * 4 + i, n0 + tc * 4, acc0[i], acc1[i]);
}

__device__ __forceinline__ void phase_g1(const Args& A, const Ctx& C, int l) {
    const bool mls = (l & 1) == 0; const int j = l >> 1;
    const int nrows = (l <= 2) ? NR : NL;
    const bf16* H = (const bf16*)(A.ws + WS_HB); bf16* P = (bf16*)(A.ws + WS_PB);
    const float* W = mls ? A.in[8] + (size_t)j * D * PROJ : A.in[12] + (size_t)j * D * PW; const int ldb = mls ? PROJ : PW;
    const int tm = nrows / 128, tn = PW / 64;
    for (int t = C.bid; t < tm * tn; t += C.G) {
        const int m0 = (t / tn) * 128, n0 = (t % tn) * 64;
        ngemm_tile<false>((LAS float*)C.lds, C.tid, [&](int r) { return H + (size_t)(m0 + r) * D; }, W, W, ldb, n0, D,
            [&](int r, int c, const float (&a0)[4], const float (&)[4]) {
                float o[4];
#pragma unroll
                for (int q = 0; q < 4; ++q) { float x = a0[q]; if (mls) { if (c < NQ) x *= 0.08838834764831845f; else if (c >= 2 * NQ + NV) x = sigmoidf_(x); } o[q] = x; }
                u32x2 w; w.x = pk2(o[0], o[1]); w.y = pk2(o[2], o[3]); *(u32x2*)(P + (size_t)(m0 + r) * PW + c) = w; });
    }
}
__device__ __forceinline__ void phase_g2(const Args& A, const Ctx& C, int l) {
    const bool mls = (l & 1) == 0; const int j = l >> 1;
    const int nrows = (l <= 1) ? NR : NL;
    const bf16* HM = (const bf16*)(A.ws + WS_HM); bf16* YL = (bf16*)(A.ws + WS_HB);
    const float* W = (mls ? A.in[11] : A.in[14]) + (size_t)j * D * D;
    const int tm = nrows / 128, tn = D / 64;
    for (int t = C.bid; t < tm * tn; t += C.G) {
        const int m0 = (t / tn) * 128, n0 = (t % tn) * 64;
        ngemm_tile<false>((LAS float*)C.lds, C.tid, [&](int r) { return HM + (size_t)(m0 + r) * D; }, W, W, D, n0, D,
            [&](int r, int c, const float (&a0)[4], const float (&)[4]) {
                u32x2 w; w.x = pk2(a0[0], a0[1]); w.y = pk2(a0[2], a0[3]); *(u32x2*)(YL + (size_t)(m0 + r) * D + c) = w; });
    }
}
__device__ __forceinline__ void phase_m1(const Args& A, const Ctx& C, int l) {
    LAS int* sb = (LAS int*)(C.lds + 32768); LAS int* ts = sb + 40;
    slot_bases(A, l, sb, C.tid);
    const unsigned* cnt = (const unsigned*)(A.ws + WS_CTL) + CW_CNT + l * 32;
    if (C.tid == 0) { int acc = 0; for (int e = 0; e < NE; ++e) { ts[e] = acc; acc += (((int)cnt[e] + 127) / 128) * (DE / 64); } ts[NE] = acc; }
    __syncthreads();
    const bf16* H = (const bf16*)(A.ws + WS_HB); bf16* ACT = (bf16*)(A.ws + WS_DC); const int* ST = (const int*)(A.ws + WS_SLOTTOK);
    const int ntile = ts[NE];
    for (int t = C.bid; t < ntile; t += C.G) {
        int e = 0; while (t >= ts[e + 1]) ++e;
        const int tl = t - ts[e], m0 = (tl / (DE / 64)) * 128, n0 = (tl % (DE / 64)) * 64, ce = (int)cnt[e];
        const float* Wg = A.in[19] + ((size_t)l * NE + e) * D * DE; const float* Wu = A.in[20] + ((size_t)l * NE + e) * D * DE;
        const int* st = ST + (size_t)e * CAP; const size_t base = (size_t)sb[e];
        ngemm_tile<true>((LAS float*)C.lds, C.tid, [&](int r) -> const bf16* { return (m0 + r < ce) ? H + (size_t)st[m0 + r] * D : nullptr; }, Wg, Wu, DE, n0, D,
            [&](int r, int c, const float (&a0)[4], const float (&a1)[4]) {
                if (m0 + r < ce) { u32x2 w; w.x = pk2(siluf_(a0[0]) * a1[0], siluf_(a0[1]) * a1[1]); w.y = pk2(siluf_(a0[2]) * a1[2], siluf_(a0[3]) * a1[3]);
                    *(u32x2*)(ACT + (base + m0 + r) * DE + c) = w; } });
    }
}
__device__ __forceinline__ void phase_m2(const Args& A, const Ctx& C, int l) {
    LAS int* sb = (LAS int*)(C.lds + 32768); LAS int* ts = sb + 40;
    slot_bases(A, l, sb, C.tid);
    const unsigned* cnt = (const unsigned*)(A.ws + WS_CTL) + CW_CNT + l * 32;
    if (C.tid == 0) { int acc = 0; for (int e = 0; e < NE; ++e) { ts[e] = acc; acc += (((int)cnt[e] + 127) / 128) * (D / 64); } ts[NE] = acc; }
    __syncthreads();
    const bf16* ACT = (const bf16*)(A.ws + WS_DC); bf16* Y = (bf16*)(A.ws + WS_PB);
    const int ntile = ts[NE];
    for (int t = C.bid; t < ntile; t += C.G) {
        int e = 0; while (t >= ts[e + 1]) ++e;
        const int tl = t - ts[e], m0 = (tl / (D / 64)) * 128, n0 = (tl % (D / 64)) * 64, ce = (int)cnt[e];
        const float* Wd = A.in[21] + ((size_t)l * NE + e) * DE * D; const size_t base = (size_t)sb[e];
        ngemm_tile<false>((LAS float*)C.lds, C.tid, [&](int r) -> const bf16* { return (m0 + r < ce) ? ACT + (base + m0 + r) * DE : nullptr; }, Wd, Wd, D, n0, DE,
            [&](int r, int c, const float (&a0)[4], const float (&)[4]) {
                if (m0 + r < ce) { u32x2 w; w.x = pk2(a0[0], a0[1]); w.y = pk2(a0[2], a0[3]); *(u32x2*)(Y + (base + m0 + r) * D + c) = w; } });
    }
}

__device__ __forceinline__ void block_gates(const Args& A, int row0, int h, LAS float* bf, LAS float* bb, LAS float* lif, LAS float* lib, int tid) {
    const float* GATE = (const float*)(A.ws + WS_GATE);
    if (tid < 256) { const float* g = GATE + (size_t)(row0 + tid) * 16; lif[tid] = g[0 + h]; bf[tid] = g[4 + h]; lib[tid] = g[8 + h]; bb[tid] = g[12 + h]; }
    __syncthreads();
    if (tid == 0) { float s = 0.f; for (int i = 0; i < 256; ++i) { s += bf[i]; bf[i] = s; } }
    if (tid == 64) { float s = 0.f; for (int i = 255; i >= 0; --i) { s += bb[i]; bb[i] = s; } }
    __syncthreads();
}
__device__ __forceinline__ void phase_s1(const Args& A, const Ctx& C, int l) {
    LAS float* bf = (LAS float*)C.lds; LAS float* bb = bf + 256; LAS float* lif = bb + 256; LAS float* lib = lif + 256; LAS float* af = lib + 256; LAS float* ab = af + 256;
    const bf16* P = (const bf16*)(A.ws + WS_PB);
    float* DC = (float*)(A.ws + WS_DC); float* DN = (float*)(A.ws + WS_DN); float* BT = (float*)(A.ws + WS_BTOT);
    for (int u = C.bid; u < NUNIT; u += C.G) {
        const int blk = u % NBLK, bh = u / NBLK, h = bh % NH, b = bh / NH; const int row0 = blk_row0(b, blk);
        block_gates(A, row0, h, bf, bb, lif, lib, C.tid);
        if (C.tid < 256) { af[C.tid] = __expf(bf[255] - bf[C.tid] + lif[C.tid]); ab[C.tid] = __expf(bb[0] - bb[C.tid] + lib[C.tid]); }
        if (C.tid == 0) { BT[u * 2 + 0] = bf[255]; BT[u * 2 + 1] = bb[0]; }
        __syncthreads();
        const int dg = C.tid >> 5, eg = C.tid & 31;
        float cf[8][8], cb[8][8], nf[8], nb[8];
#pragma unroll
        for (int i = 0; i < 8; ++i) { nf[i] = 0.f; nb[i] = 0.f;
#pragma unroll
            for (int q = 0; q < 8; ++q) { cf[i][q] = 0.f; cb[i][q] = 0.f; } }
        for (int s = 0; s < 256; ++s) {
            const bf16* pr = P + (size_t)(row0 + s) * PW;
            const u32x4 kv = *(const u32x4*)(pr + NQ + h * DQK + dg * 8); const u32x4 vv = *(const u32x4*)(pr + 2 * NQ + h * DV + eg * 8);
            float kk[8], ve[8];
#pragma unroll
            for (int i = 0; i < 4; ++i) { kk[2 * i] = __uint_as_float(kv[i] << 16); kk[2 * i + 1] = __uint_as_float(kv[i] & 0xffff0000u); ve[2 * i] = __uint_as_float(vv[i] << 16); ve[2 * i + 1] = __uint_as_float(vv[i] & 0xffff0000u); }
            const float wf = af[s], wb = ab[s];
#pragma unroll
            for (int i = 0; i < 8; ++i) { const float kf = kk[i] * wf, kb = kk[i] * wb; nf[i] += kf; nb[i] += kb;
#pragma unroll
                for (int q = 0; q < 8; ++q) { cf[i][q] += kf * ve[q]; cb[i][q] += kb * ve[q]; } }
        }
        float* dcf = DC + (size_t)(u * 2 + 0) * DQK * DV; float* dcb = DC + (size_t)(u * 2 + 1) * DQK * DV;
#pragma unroll
        for (int i = 0; i < 8; ++i) {
            *(f32x4*)(dcf + (dg * 8 + i) * DV + eg * 8) = (f32x4){cf[i][0], cf[i][1], cf[i][2], cf[i][3]}; *(f32x4*)(dcf + (dg * 8 + i) * DV + eg * 8 + 4) = (f32x4){cf[i][4], cf[i][5], cf[i][6], cf[i][7]};
            *(f32x4*)(dcb + (dg * 8 + i) * DV + eg * 8) = (f32x4){cb[i][0], cb[i][1], cb[i][2], cb[i][3]}; *(f32x4*)(dcb + (dg * 8 + i) * DV + eg * 8 + 4) = (f32x4){cb[i][4], cb[i][5], cb[i][6], cb[i][7]};
            if (eg == 0) { DN[(size_t)(u * 2 + 0) * DQK + dg * 8 + i] = nf[i]; DN[(size_t)(u * 2 + 1) * DQK + dg * 8 + i] = nb[i]; }
        }
        __syncthreads();
    }
}
__device__ __forceinline__ void phase_s2(const Args& A, const Ctx& C) {
    const float* DC = (const float*)(A.ws + WS_DC); const float* DN = (const float*)(A.ws + WS_DN); const float* BT = (const float*)(A.ws + WS_BTOT);
    float* CST = (float*)(A.ws + WS_CST); float* NST = (float*)(A.ws + WS_NST);
    const int EL = DQK * DV + DQK;
    for (long i = (long)C.bid * NT + C.tid; i < (long)BATCH * NH * 2 * EL; i += (long)C.G * NT) {
        const int el = (int)(i % EL), ch = (int)(i / EL), dir = ch & 1, bh = ch >> 1;
        float st = 0.f;
        for (int idx = 0; idx < NBLK; ++idx) {
            const int blk = dir == 0 ? idx : (idx == 0 ? 0 : NBLK - idx);
            const int u = bh * NBLK + blk;
            const float dec = __expf(BT[u * 2 + dir]);
            if (el < DQK * DV) { CST[(size_t)(u * 2 + dir) * DQK * DV + el] = st; st = dec * st + DC[(size_t)(u * 2 + dir) * DQK * DV + el]; }
            else { NST[(size_t)(u * 2 + dir) * DQK + (el - DQK * DV)] = st; st = dec * st + DN[(size_t)(u * 2 + dir) * DQK + (el - DQK * DV)]; }
        }
    }
}
__device__ __forceinline__ void phase_s3(const Args& A, const Ctx& C, int l) {
    const int j = l >> 1;
    LAS float* bf = (LAS float*)C.lds; LAS float* bb = bf + 256; LAS float* lif = bb + 256; LAS float* lib = lif + 256;
    LAS float* den = lib + 256;
    LAS float* qs = den + 64;
    LAS float* Pf = qs + 32 * 128;
    LAS float* Pb = Pf + 32 * 256;
    LAS float* hr = Pb + 32 * 256;
    const bf16* P = (const bf16*)(A.ws + WS_PB); bf16* HM = (bf16*)(A.ws + WS_HM);
    const float* CST = (const float*)(A.ws + WS_CST); const float* NST = (const float*)(A.ws + WS_NST);
    const float* hg = A.in[10] + (size_t)j * NV;
    const bool ctx_out = (l == 0);
    for (int u = C.bid; u < NUNIT; u += C.G) {
        const int blk = u % NBLK, bh = u / NBLK, h = bh % NH, b = bh / NH; const int row0 = blk_row0(b, blk);
        if (blk == 0 && !ctx_out) continue;
        block_gates(A, row0, h, bf, bb, lif, lib, C.tid);
        const float* Cf = CST + (size_t)(u * 2 + 0) * DQK * DV; const float* Cb = CST + (size_t)(u * 2 + 1) * DQK * DV;
        const float* Nf = NST + (size_t)(u * 2 + 0) * DQK; const float* Nb = NST + (size_t)(u * 2 + 1) * DQK;
        for (int jt = 0; jt < 8; ++jt) {
            const int j0 = jt * 32;
            for (int i = C.tid; i < 32 * 128; i += NT) { const int r = i >> 7, d = i & 127; qs[i] = bf2f(P[(size_t)(row0 + j0 + r) * PW + h * DQK + d]); }
            __syncthreads();
            { const int r = C.tid >> 4, sg = C.tid & 15, jj = j0 + r;
              for (int i = 0; i < 16; ++i) { const int s = sg + 16 * i; const bf16* kr = P + (size_t)(row0 + s) * PW + NQ + h * DQK; float dot = 0.f;
#pragma unroll
                  for (int d8 = 0; d8 < 16; ++d8) { const u32x4 kv = *(const u32x4*)(kr + d8 * 8);
#pragma unroll
                      for (int q = 0; q < 4; ++q) dot += qs[r * 128 + d8 * 8 + 2 * q] * __uint_as_float(kv[q] << 16) + qs[r * 128 + d8 * 8 + 2 * q + 1] * __uint_as_float(kv[q] & 0xffff0000u); }
                  const float wf = (s <= jj) ? __expf(bf[jj] - bf[s] + lif[s]) : 0.f; const float wb = (s >= jj) ? __expf(bb[jj] - bb[s] + lib[s]) : 0.f;
                  Pf[r * 256 + s] = dot * wf; Pb[r * 256 + s] = dot * wb; } }
            __syncthreads();
            if (C.tid < 64) { const int r = C.tid >> 1, dir = C.tid & 1, jj = j0 + r; LAS const float* pp = (dir ? Pb : Pf) + r * 256; float s = 0.f;
                for (int i = 0; i < 256; ++i) s += pp[i];
                const float* nn = dir ? Nb : Nf; float qn = 0.f;
                for (int d = 0; d < 128; ++d) qn += qs[r * 128 + d] * nn[d];
                den[dir * 32 + r] = s + __expf(dir ? bb[jj] : bf[jj]) * qn; }
            __syncthreads();
            { const int r = C.tid >> 4, eg = C.tid & 15, jj = j0 + r;
              float af[16], ab[16], cf[16], cb[16];
#pragma unroll
              for (int q = 0; q < 16; ++q) { af[q] = 0.f; ab[q] = 0.f; cf[q] = 0.f; cb[q] = 0.f; }
              for (int s = 0; s < 256; ++s) { const float pf = Pf[r * 256 + s], pb = Pb[r * 256 + s]; const bf16* vr = P + (size_t)(row0 + s) * PW + 2 * NQ + h * DV + eg * 16;
                  const u32x4 v0 = *(const u32x4*)vr, v1 = *(const u32x4*)(vr + 8);
#pragma unroll
                  for (int q = 0; q < 4; ++q) { const float a = __uint_as_float(v0[q] << 16), c = __uint_as_float(v0[q] & 0xffff0000u), e = __uint_as_float(v1[q] << 16), g = __uint_as_float(v1[q] & 0xffff0000u);
                      af[2 * q] += pf * a; af[2 * q + 1] += pf * c; af[8 + 2 * q] += pf * e; af[8 + 2 * q + 1] += pf * g;
                      ab[2 * q] += pb * a; ab[2 * q + 1] += pb * c; ab[8 + 2 * q] += pb * e; ab[8 + 2 * q + 1] += pb * g; } }
              for (int d = 0; d < 128; ++d) { const float qd = qs[r * 128 + d];
#pragma unroll
                  for (int q4 = 0; q4 < 4; ++q4) { const f32x4 x = *(const f32x4*)(Cf + d * DV + eg * 16 + q4 * 4), y = *(const f32x4*)(Cb + d * DV + eg * 16 + q4 * 4);
#pragma unroll
                      for (int q = 0; q < 4; ++q) { cf[q4 * 4 + q] += qd * x[q]; cb[q4 * 4 + q] += qd * y[q]; } } }
              const float ef = __expf(bf[jj]), eb = __expf(bb[jj]);
              const float rf = 1.0f / fmaxf(fabsf(den[r]), 1.0f), rb = 1.0f / fmaxf(fabsf(den[32 + r]), 1.0f);
#pragma unroll
              for (int q = 0; q < 16; ++q) hr[r * 256 + eg * 16 + q] = (af[q] + ef * cf[q]) * rf + (ab[q] + eb * cb[q]) * rb; }
            __syncthreads();
            for (int rr = 0; rr < 4; ++rr) { const int r = C.wave * 4 + rr; const size_t row = (size_t)(row0 + j0 + r);
                const f32x4 x = *(const LAS f32x4*)(hr + r * 256 + C.lane * 4);
                const float ss = wave_sum((x.x * x.x + x.y * x.y) + (x.z * x.z + x.w * x.w));
                const float rs = 1.0f / sqrtf(ss * (1.0f / DV) + EPS);
                const f32x4 g = *(const f32x4*)(hg + h * DV + C.lane * 4);
                const u32x2 ow = *(const u32x2*)(P + row * PW + 2 * NQ + NV + h * DV + C.lane * 4);
                const f32x4 o = (f32x4){__uint_as_float(ow.x << 16), __uint_as_float(ow.x & 0xffff0000u), __uint_as_float(ow.y << 16), __uint_as_float(ow.y & 0xffff0000u)};
                const f32x4 y = x * rs * g * o;
                u32x2 w; w.x = pk2(y.x, y.y); w.y = pk2(y.z, y.w); *(u32x2*)(HM + row * D + h * DV + C.lane * 4) = w; }
            __syncthreads();
        }
    }
}

constexpr int LDS_BYTES = 152 * 1024;
enum { K_MOD, K_R1, K_G1, K_S1, K_S2, K_S3, K_CONV, K_G2, K_R2, K_M1, K_M2, K_FINAL, K_N };
template <int KIND> __global__ void __launch_bounds__(NT, 2) k_phase(Args args) {
    extern __shared__ __attribute__((aligned(16))) unsigned char lds_raw[];
    Ctx C; C.lds = (LAS unsigned char*)lds_raw; C.tid = threadIdx.x; C.lane = C.tid & 63; C.wave = __builtin_amdgcn_readfirstlane(C.tid >> 6); C.G = gridDim.x; C.bid = blockIdx.x; C.a = &args;
    const int l = args.lo;
    if constexpr (KIND == K_MOD) phase_mod(args, C);
    if constexpr (KIND == K_R1) phase_r1(args, C, l);
    if constexpr (KIND == K_G1) phase_g1(args, C, l);
    if constexpr (KIND == K_S1) phase_s1(args, C, l);
    if constexpr (KIND == K_S2) phase_s2(args, C);
    if constexpr (KIND == K_S3) phase_s3(args, C, l);
    if constexpr (KIND == K_CONV) phase_conv(args, C, l);
    if constexpr (KIND == K_G2) phase_g2(args, C, l);
    if constexpr (KIND == K_R2) phase_r2(args, C, l);
    if constexpr (KIND == K_M1) phase_m1(args, C, l);
    if constexpr (KIND == K_M2) phase_m2(args, C, l);
    if constexpr (KIND == K_FINAL) phase_final(args, C);
}
template <int KIND> static void launch(int grid, hipStream_t stream, Args a, int l) {
    static bool attr = false;
    if (!attr) { (void)hipFuncSetAttribute((const void*)k_phase<KIND>, hipFuncAttributeMaxDynamicSharedMemorySize, LDS_BYTES); attr = true; }
    a.lo = l; a.hi = 0;
    hipLaunchKernelGGL(k_phase<KIND>, dim3(grid), dim3(NT), LDS_BYTES, stream, a);
}

extern "C" void kernel_launch(void* const* d_in, const int* in_sizes, int n_in, void* d_out, int out_size, void* d_ws, size_t ws_size, hipStream_t stream) {
    static int grid = 0;
    if (grid == 0) {
        if (n_in != 22 || out_size != NL * D || ws_size < WS_END) { fprintf(stderr, "kernel_launch: unexpected shapes (n_in %d out %d ws %zu)\n", n_in, out_size, ws_size); grid = -1; return; }
        int dev = 0, cus = 0;
        if (hipGetDevice(&dev) != hipSuccess || hipDeviceGetAttribute(&cus, hipDeviceAttributeMultiprocessorCount, dev) != hipSuccess) { grid = -1; return; }
        grid = cus;
    }
    if (grid < 0) return;
    (void)hipMemsetAsync((char*)d_ws + WS_CTL, 0, CTL_BYTES, stream);
    Args a{};
    for (int i = 0; i < 22; ++i) a.in[i] = (const float*)d_in[i];
    a.out = (float*)d_out; a.ws = (unsigned char*)d_ws;
    launch<K_MOD>(grid, stream, a, 0);
    for (int l = 0; l < DEPTH; ++l) {
        launch<K_R1>(grid, stream, a, l); launch<K_G1>(grid, stream, a, l);
        if ((l & 1) == 0) { launch<K_S1>(grid, stream, a, l); launch<K_S2>(grid, stream, a, l); launch<K_S3>(grid, stream, a, l); }
        else launch<K_CONV>(grid, stream, a, l);
        launch<K_G2>(grid, stream, a, l); launch<K_R2>(grid, stream, a, l); launch<K_M1>(grid, stream, a, l); launch<K_M2>(grid, stream, a, l);
    }
    launch<K_FINAL>(grid, stream, a, 0);
}
```

```cpp
#include <hip/hip_runtime.h>
#include <cstdio>
#include <cstdint>

#define LAS __attribute__((address_space(3)))
typedef unsigned short bf16;
typedef float f32x4 __attribute__((ext_vector_type(4)));
typedef unsigned u32x4 __attribute__((ext_vector_type(4)));
typedef unsigned u32x2 __attribute__((ext_vector_type(2)));

constexpr int D = 1024, BATCH = 2, SEQ = 16384, DEPTH = 4, CTXL = 256;
constexpr int NL = BATCH * SEQ, NCX = BATCH * CTXL, NR = NL + NCX;
constexpr int NH = 4, DQK = 128, DV = 256, NQ = 512, NV = 1024, PROJ = 3088, PW = 3072;
constexpr int NGRP = 4, EPG = 8, NE = 32, DE = 512;
constexpr int NBLK = 65;
constexpr int NUNIT = BATCH * NH * NBLK;
constexpr int CAP = NR;
constexpr int YROWS = 74752;
constexpr float EPS = 1e-6f;
constexpr int NT = 512, NW = 8;

constexpr size_t MiB = 1u << 20;
constexpr size_t WS_CTL = 0, CTL_BYTES = 1 * MiB;
constexpr size_t WS_MOD = 1 * MiB;
constexpr size_t WS_GATE = 2 * MiB;
constexpr size_t WS_TOKSLOT = 5 * MiB;
constexpr size_t WS_TOKW = 6 * MiB;
constexpr size_t WS_SLOTTOK = 7 * MiB;
constexpr size_t WS_DN = 12 * MiB;
constexpr size_t WS_NST = 13 * MiB;
constexpr size_t WS_BTOT = 14 * MiB;
constexpr size_t WS_LAT = 16 * MiB;
constexpr size_t WS_HB = 146 * MiB;
constexpr size_t WS_PB = 211 * MiB;
constexpr size_t WS_HM = 406 * MiB;
constexpr size_t WS_DC = 471 * MiB;
constexpr size_t WS_CST = 601 * MiB;
constexpr size_t WS_END = 731 * MiB;
constexpr int CW_CNT = 1024;

struct Args { const float* in[22]; float* out; unsigned char* ws; int lo, hi; };

__device__ __forceinline__ float bf2f(bf16 v) { return __uint_as_float(((unsigned)v) << 16); }
__device__ __forceinline__ unsigned f2bf(float f) { unsigned u = __float_as_uint(f); return (u + 0x7fffu + ((u >> 16) & 1u)) >> 16; }
__device__ __forceinline__ unsigned pk2(float lo, float hi) { return f2bf(lo) | (f2bf(hi) << 16); }
__device__ __forceinline__ float wave_sum(float v) {
#pragma unroll
    for (int o = 1; o < 64; o <<= 1) v += __shfl_xor(v, o);
    return v;
}
__device__ __forceinline__ float sigmoidf_(float x) { return 1.f / (1.f + __expf(-x)); }
__device__ __forceinline__ float siluf_(float x) { return x / (1.f + __expf(-x)); }
__device__ __forceinline__ float logsigmoidf_(float x) { return fminf(x, 0.f) - log1pf(__expf(-fabsf(x))); }
__device__ __forceinline__ int blk_row0(int b, int blk) { return blk == 0 ? NL + b * CTXL : b * SEQ + (blk - 1) * 256; }
__device__ __forceinline__ int mod_vec_of_row(int row) { return row < NL ? row / SEQ : 2; }

struct Ctx {
    LAS unsigned char* lds; int tid, lane, wave, G, bid;
    const Args* a;
};

__device__ __forceinline__ void slot_bases(const Args& A, int l, LAS int* sb, int tid) {
    if (tid == 0) {
        const unsigned* cnt = (const unsigned*)(A.ws + WS_CTL) + CW_CNT + l * 32;
        int acc = 0;
        for (int e = 0; e < NE; ++e) { sb[e] = acc; acc += (((int)cnt[e] + 255) / 256) * 256; }
        sb[NE] = acc;
    }
    __syncthreads();
}

__device__ __forceinline__ void phase_mod(const Args& A, const Ctx& C) {
    LAS float* sc = (LAS float*)C.lds;
    LAS float* red = sc + 3072;
    const float* c = A.in[1]; const float* cc = A.in[3];
    for (int i = C.tid; i < 3072; i += NT) { const float v = i < 2048 ? c[i] : cc[i - 2048]; sc[i] = siluf_(v); }
    __syncthreads();
    float* MOD = (float*)(A.ws + WS_MOD);
    for (int u = C.bid; u < DEPTH * 96; u += C.G) {
        const int l = u / 96, cg = u % 96, col = cg * 64 + C.lane;
        const float* w = A.in[4] + (size_t)l * D * 6 * D + col;
        float a0 = 0.f, a1 = 0.f, a2 = 0.f;
        for (int k = C.wave * 128; k < C.wave * 128 + 128; ++k) { const float wv = w[(size_t)k * 6 * D]; a0 += sc[k] * wv; a1 += sc[1024 + k] * wv; a2 += sc[2048 + k] * wv; }
        red[(C.wave * 3 + 0) * 64 + C.lane] = a0; red[(C.wave * 3 + 1) * 64 + C.lane] = a1; red[(C.wave * 3 + 2) * 64 + C.lane] = a2;
        __syncthreads();
        if (C.tid < 192) { const int v = C.tid / 64, ln = C.tid % 64; float s = 0.f;
            for (int w8 = 0; w8 < 8; ++w8) s += red[(w8 * 3 + v) * 64 + ln];
            MOD[(size_t)(l * 3 + v) * 6 * D + cg * 64 + ln] = s + A.in[5][(size_t)l * 6 * D + cg * 64 + ln]; }
        __syncthreads();
    }
}

__device__ __forceinline__ void load_row_f32(const float* p, int lane, f32x4 (&v)[4]) {
#pragma unroll
    for (int j = 0; j < 4; ++j) v[j] = *(const f32x4*)(p + 4 * lane + 256 * j);
}
__device__ __forceinline__ void load_row_bf16(const bf16* p, int lane, f32x4 (&v)[4]) {
#pragma unroll
    for (int j = 0; j < 4; ++j) { const u32x2 w = *(const u32x2*)(p + 4 * lane + 256 * j);
        v[j] = (f32x4){__uint_as_float(w.x << 16), __uint_as_float(w.x & 0xffff0000u), __uint_as_float(w.y << 16), __uint_as_float(w.y & 0xffff0000u)}; }
}
__device__ __forceinline__ void store_row_bf16(bf16* p, int lane, const f32x4 (&v)[4]) {
#pragma unroll
    for (int j = 0; j < 4; ++j) { u32x2 w; w.x = pk2(v[j].x, v[j].y); w.y = pk2(v[j].z, v[j].w); *(u32x2*)(p + 4 * lane + 256 * j) = w; }
}
__device__ __forceinline__ void moe_combine(const Args& A, int lp, int row, int lane, LAS const int* sb, f32x4 (&v)[4]) {
    const int* ts = (const int*)(A.ws + WS_TOKSLOT) + row * 2; const float* tw = (const float*)(A.ws + WS_TOKW) + row * 2;
    const bf16* Y = (const bf16*)(A.ws + WS_PB);
    const int t0 = ts[0], t1 = ts[1]; const float w0 = tw[0], w1 = tw[1];
    const size_t s0 = (size_t)(sb[t0 >> 20] + (t0 & 0xfffff)), s1 = (size_t)(sb[t1 >> 20] + (t1 & 0xfffff));
    f32x4 y0[4], y1[4], g2[4];
    load_row_bf16(Y + s0 * D, lane, y0); load_row_bf16(Y + s1 * D, lane, y1);
    load_row_f32((const float*)(A.ws + WS_MOD) + (size_t)(lp * 3 + mod_vec_of_row(row)) * 6 * D + 5 * D, lane, g2);
#pragma unroll
    for (int j = 0; j < 4; ++j) v[j] += g2[j] * (y0[j] * w0 + y1[j] * w1);
}
__device__ __forceinline__ void norm_mod(const f32x4 (&v)[4], const float* g, const float* sh, const float* sc, int lane, f32x4 (&h)[4]) {
    float s = 0.f;
#pragma unroll
    for (int j = 0; j < 4; ++j) s += (v[j].x * v[j].x + v[j].y * v[j].y) + (v[j].z * v[j].z + v[j].w * v[j].w);
    const float r = 1.0f / sqrtf(wave_sum(s) * (1.f / D) + EPS);
    f32x4 gg[4], ss[4], cc[4];
    load_row_f32(g, lane, gg); load_row_f32(sh, lane, ss); load_row_f32(sc, lane, cc);
#pragma unroll
    for (int j = 0; j < 4; ++j) h[j] = (v[j] * r) * gg[j] * (1.f + cc[j]) + ss[j];
}

__device__ __forceinline__ void phase_r1(const Args& A, const Ctx& C, int l) {
    LAS int* sb = (LAS int*)C.lds;
    LAS float* GW = (LAS float*)(C.lds + 256);
    const bool mls = (l & 1) == 0; const int j = l >> 1;
    if (l > 0) slot_bases(A, l - 1, sb, C.tid);
    if (mls) { const float* w = A.in[8] + (size_t)j * D * PROJ + PW;
        for (int i = C.tid; i < 16 * D; i += NT) { const int k = i >> 4, c = i & 15; GW[c * D + k] = w[(size_t)k * PROJ + c]; }
        __syncthreads(); }
    const int nrows = (l <= 2) ? NR : NL;
    float* LAT = (float*)(A.ws + WS_LAT); bf16* H = (bf16*)(A.ws + WS_HB); float* GATE = (float*)(A.ws + WS_GATE);
    const float* MOD = (const float*)(A.ws + WS_MOD);
    for (int row = C.bid * NW + C.wave; row < nrows; row += C.G * NW) {
        f32x4 v[4], h[4];
        if (l == 0) load_row_f32(row < NL ? A.in[0] + (size_t)row * D : A.in[2] + (size_t)(row - NL) * D, C.lane, v);
        else { load_row_f32(LAT + (size_t)row * D, C.lane, v); moe_combine(A, l - 1, row, C.lane, sb, v); }
#pragma unroll
        for (int q = 0; q < 4; ++q) *(f32x4*)(LAT + (size_t)row * D + 4 * C.lane + 256 * q) = v[q];
        const float* mv = MOD + (size_t)(l * 3 + mod_vec_of_row(row)) * 6 * D;
        norm_mod(v, A.in[6] + (size_t)(l * 2 + 0) * D, mv + 0 * D, mv + 1 * D, C.lane, h);
        store_row_bf16(H + (size_t)row * D, C.lane, h);
        if (mls) {
            float g = 0.f;
#pragma unroll 2
            for (int c = 0; c < 16; ++c) { float s = 0.f;
#pragma unroll
                for (int q = 0; q < 4; ++q) { const f32x4 w = *(const LAS f32x4*)(GW + c * D + 4 * C.lane + 256 * q); s += (h[q].x * w.x + h[q].y * w.y) + (h[q].z * w.z + h[q].w * w.w); }
                s = wave_sum(s); g = (C.lane == c) ? s : g; }
            if (C.lane < 16) {
                g += A.in[9][j * 16 + C.lane];
                const int gtype = C.lane >> 2;
                const float o = (gtype & 1) ? logsigmoidf_(g) : 15.0f * tanhf(g * (1.0f / 15.0f));
                GATE[(size_t)row * 16 + C.lane] = o; }
        }
    }
}

__device__ __forceinline__ void phase_r2(const Args& A, const Ctx& C, int l) {
    LAS float* RW = (LAS float*)C.lds;
    { const float* wg = A.in[15] + (size_t)l * D * NGRP; const float* wr = A.in[17] + (size_t)l * D * NE;
      for (int i = C.tid; i < 4 * D; i += NT) { const int k = i >> 2, c = i & 3; RW[c * D + k] = wg[(size_t)k * NGRP + c]; }
      for (int i = C.tid; i < 32 * D; i += NT) { const int k = i >> 5, c = i & 31; RW[(4 + c) * D + k] = wr[(size_t)k * NE + c]; }
      __syncthreads(); }
    const int nrows = (l <= 1) ? NR : NL;
    float* LAT = (float*)(A.ws + WS_LAT); bf16* H = (bf16*)(A.ws + WS_HB);
    const float* MOD = (const float*)(A.ws + WS_MOD);
    unsigned* cnt = (unsigned*)(A.ws + WS_CTL) + CW_CNT + l * 32;
    int* TS = (int*)(A.ws + WS_TOKSLOT); float* TW = (float*)(A.ws + WS_TOKW); int* ST = (int*)(A.ws + WS_SLOTTOK);
    for (int row = C.bid * NW + C.wave; row < nrows; row += C.G * NW) {
        f32x4 v[4], y[4], g1[4], h[4];
        const float* mv = MOD + (size_t)(l * 3 + mod_vec_of_row(row)) * 6 * D;
        load_row_f32(LAT + (size_t)row * D, C.lane, v); load_row_bf16(H + (size_t)row * D, C.lane, y); load_row_f32(mv + 2 * D, C.lane, g1);
#pragma unroll
        for (int q = 0; q < 4; ++q) { v[q] += g1[q] * y[q]; *(f32x4*)(LAT + (size_t)row * D + 4 * C.lane + 256 * q) = v[q]; }
        norm_mod(v, A.in[6] + (size_t)(l * 2 + 1) * D, mv + 3 * D, mv + 4 * D, C.lane, h);
        store_row_bf16(H + (size_t)row * D, C.lane, h);
        float mine = 0.f;
#pragma unroll 2
        for (int c = 0; c < 36; ++c) { float s = 0.f;
#pragma unroll
            for (int q = 0; q < 4; ++q) { const f32x4 w = *(const LAS f32x4*)(RW + c * D + 4 * C.lane + 256 * q); s += (h[q].x * w.x + h[q].y * w.y) + (h[q].z * w.z + h[q].w * w.w); }
            s = wave_sum(s); mine = (C.lane == c) ? s : mine; }
        LAS float* wl = (LAS float*)(C.lds + 36 * D * 4) + C.wave * 64;
        if (C.lane < 36) wl[C.lane] = mine;
        asm volatile("s_waitcnt lgkmcnt(0)" ::: "memory");
        if (C.lane == 0) {
            float lg[36];
#pragma unroll
            for (int c = 0; c < 36; ++c) lg[c] = wl[c];
            const float* bg = A.in[16] + l * NGRP; const float* br = A.in[18] + l * NE;
            float gl[4]; int grp = 0; float gm = -3.0e38f;
#pragma unroll
            for (int c = 0; c < 4; ++c) { gl[c] = lg[c] + bg[c]; if (gl[c] > gm) { gm = gl[c]; grp = c; } }
            float gs = 0.f;
#pragma unroll
            for (int c = 0; c < 4; ++c) gs += __expf(gl[c] - gm);
            const float pgrp = 1.0f / gs;
            float rl[8];
#pragma unroll
            for (int i = 0; i < 8; ++i) { float t = 0.f;
#pragma unroll
                for (int g = 0; g < 4; ++g) t = (g == grp) ? lg[4 + g * 8 + i] : t;
                rl[i] = t + br[grp * 8 + i]; }
            int i0 = 0; float m0 = rl[0];
#pragma unroll
            for (int i = 1; i < 8; ++i) if (rl[i] > m0) { m0 = rl[i]; i0 = i; }
            int i1 = -1; float m1 = -3.0e38f;
#pragma unroll
            for (int i = 0; i < 8; ++i) if (i != i0 && rl[i] > m1) { m1 = rl[i]; i1 = i; }
            const float p0 = 1.0f, p1 = __expf(m1 - m0);
            const float w0 = pgrp * p0 / (p0 + p1), w1 = pgrp * p1 / (p0 + p1);
            const int e0 = grp * 8 + i0, e1 = grp * 8 + i1;
            const unsigned q0 = atomicAdd(cnt + e0, 1u), q1 = atomicAdd(cnt + e1, 1u);
            ST[(size_t)e0 * CAP + q0] = row; ST[(size_t)e1 * CAP + q1] = row;
            TS[row * 2 + 0] = (e0 << 20) | (int)q0; TS[row * 2 + 1] = (e1 << 20) | (int)q1;
            TW[row * 2 + 0] = w0; TW[row * 2 + 1] = w1;
        }
    }
}

__device__ __forceinline__ void phase_final(const Args& A, const Ctx& C) {
    LAS int* sb = (LAS int*)C.lds;
    slot_bases(A, 3, sb, C.tid);
    const float* LAT = (const float*)(A.ws + WS_LAT);
    for (int row = C.bid * NW + C.wave; row < NL; row += C.G * NW) {
        f32x4 v[4], g[4];
        load_row_f32(LAT + (size_t)row * D, C.lane, v); moe_combine(A, 3, row, C.lane, sb, v);
        float s = 0.f;
#pragma unroll
        for (int j = 0; j < 4; ++j) s += (v[j].x * v[j].x + v[j].y * v[j].y) + (v[j].z * v[j].z + v[j].w * v[j].w);
        const float r = 1.0f / sqrtf(wave_sum(s) * (1.f / D) + EPS);
        load_row_f32(A.in[7], C.lane, g);
#pragma unroll
        for (int j = 0; j < 4; ++j) *(f32x4*)(A.out + (size_t)row * D + 4 * C.lane + 256 * j) = (v[j] * r) * g[j];
    }
}

__device__ __forceinline__ void phase_conv(const Args& A, const Ctx& C, int l) {
    const int j = l >> 1; const int nrows = (l <= 1) ? NR : NL;
    const bf16* P = (const bf16*)(A.ws + WS_PB); bf16* HM = (bf16*)(A.ws + WS_HM);
    const float* cw = A.in[13] + (size_t)j * 3 * D;
    for (int row = C.bid * NW + C.wave; row < nrows; row += C.G * NW) {
        bool hasl, hasr;
        if (row < NL) { const int t = row & 63; hasl = t != 0; hasr = t != 63; } else { const int t = (row - NL) & 255; hasl = t != 0; hasr = t != 255; }
        f32x4 bg[4], cg[4], u[4], w0[4], w1[4], w2[4], acc[4];
        const bf16* pr = P + (size_t)row * PW;
        load_row_bf16(pr, C.lane, bg); load_row_bf16(pr + D, C.lane, cg); load_row_bf16(pr + 2 * D, C.lane, u);
        load_row_f32(cw, C.lane, w0); load_row_f32(cw + D, C.lane, w1); load_row_f32(cw + 2 * D, C.lane, w2);
#pragma unroll
        for (int q = 0; q < 4; ++q) acc[q] = w1[q] * (cg[q] * u[q]);
        if (hasl) { load_row_bf16(pr - PW + D, C.lane, cg); load_row_bf16(pr - PW + 2 * D, C.lane, u);
#pragma unroll
            for (int q = 0; q < 4; ++q) acc[q] += w0[q] * (cg[q] * u[q]); }
        if (hasr) { load_row_bf16(pr + PW + D, C.lane, cg); load_row_bf16(pr + PW + 2 * D, C.lane, u);
#pragma unroll
            for (int q = 0; q < 4; ++q) acc[q] += w2[q] * (cg[q] * u[q]); }
#pragma unroll
        for (int q = 0; q < 4; ++q) acc[q] *= bg[q];
        store_row_bf16(HM + (size_t)row * D, C.lane, acc);
    }
}

template <bool DUAL, class RowPtr, class Epi>
__device__ __forceinline__ void ngemm_tile(LAS float* lds, int tid, RowPtr rowptr, const float* B0, const float* B1, int ldb, int n0, int K, Epi epi) {
    LAS float* As = lds;
    LAS float* Bs0 = lds + 16 * 132;
    LAS float* Bs1 = Bs0 + 16 * 68;
    const int tr = tid >> 4, tc = tid & 15;
    float acc0[4][4], acc1[4][4];
#pragma unroll
    for (int i = 0; i < 4; ++i)
#pragma unroll
        for (int j = 0; j < 4; ++j) { acc0[i][j] = 0.f; acc1[i][j] = 0.f; }
    const int ar = tid >> 2, akq = (tid & 3) * 4;
    const bf16* ap = rowptr(ar);
    const int bk = tid >> 5, bn = (tid & 31) * 2;
    for (int k0 = 0; k0 < K; k0 += 16) {
        u32x2 av = (u32x2){0u, 0u};
        if (ap) av = *(const u32x2*)(ap + k0 + akq);
        As[(akq + 0) * 132 + ar] = __uint_as_float(av.x << 16); As[(akq + 1) * 132 + ar] = __uint_as_float(av.x & 0xffff0000u);
        As[(akq + 2) * 132 + ar] = __uint_as_float(av.y << 16); As[(akq + 3) * 132 + ar] = __uint_as_float(av.y & 0xffff0000u);
        { const float* bp = B0 + (size_t)(k0 + bk) * ldb + n0 + bn; Bs0[bk * 68 + bn] = bp[0]; Bs0[bk * 68 + bn + 1] = bp[1]; }
        if (DUAL) { const float* bp = B1 + (size_t)(k0 + bk) * ldb + n0 + bn; Bs1[bk * 68 + bn] = bp[0]; Bs1[bk * 68 + bn + 1] = bp[1]; }
        __syncthreads();
#pragma unroll
        for (int kk = 0; kk < 16; ++kk) {
            const f32x4 a = *(const LAS f32x4*)(As + kk * 132 + tr * 4);
            const f32x4 b = *(const LAS f32x4*)(Bs0 + kk * 68 + tc * 4);
#pragma unroll
            for (int i = 0; i < 4; ++i)
#pragma unroll
                for (int j = 0; j < 4; ++j) acc0[i][j] += a[i] * b[j];
            if (DUAL) { const f32x4 b1 = *(const LAS f32x4*)(Bs1 + kk * 68 + tc * 4);
#pragma unroll
                for (int i = 0; i < 4; ++i)
#pragma unroll
                    for (int j = 0; j < 4; ++j) acc1[i][j] += a[i] * b1[j]; }
        }
        __syncthreads();
    }
#pragma unroll
    for (int i = 0; i < 4; ++i) epi(tr * 4 + i, n0 + tc * 4, acc0[i], acc1[i]);
}

__device__ __forceinline__ void phase_g1(const Args& A, const Ctx& C, int l) {
    const bool mls = (l & 1) == 0; const int j = l >> 1;
    const int nrows = (l <= 2) ? NR : NL;
    const bf16* H = (const bf16*)(A.ws + WS_HB); bf16* P = (bf16*)(A.ws + WS_PB);
    const float* W = mls ? A.in[8] + (size_t)j * D * PROJ : A.in[12] + (size_t)j * D * PW; const int ldb = mls ? PROJ : PW;
    const int tm = nrows / 128, tn = PW / 64;
    for (int t = C.bid; t < tm * tn; t += C.G) {
        const int m0 = (t / tn) * 128, n0 = (t % tn) * 64;
        ngemm_tile<false>((LAS float*)C.lds, C.tid, [&](int r) { return H + (size_t)(m0 + r) * D; }, W, W, ldb, n0, D,
            [&](int r, int c, const float (&a0)[4], const float (&)[4]) {
                float o[4];
#pragma unroll
                for (int q = 0; q < 4; ++q) { float x = a0[q]; if (mls) { if (c < NQ) x *= 0.08838834764831845f; else if (c >= 2 * NQ + NV) x = sigmoidf_(x); } o[q] = x; }
                u32x2 w; w.x = pk2(o[0], o[1]); w.y = pk2(o[2], o[3]); *(u32x2*)(P + (size_t)(m0 + r) * PW + c) = w; });
    }
}
__device__ __forceinline__ void phase_g2(const Args& A, const Ctx& C, int l) {
    const bool mls = (l & 1) == 0; const int j = l >> 1;
    const int nrows = (l <= 1) ? NR : NL;
    const bf16* HM = (const bf16*)(A.ws + WS_HM); bf16* YL = (bf16*)(A.ws + WS_HB);
    const float* W = (mls ? A.in[11] : A.in[14]) + (size_t)j * D * D;
    const int tm = nrows / 128, tn = D / 64;
    for (int t = C.bid; t < tm * tn; t += C.G) {
        const int m0 = (t / tn) * 128, n0 = (t % tn) * 64;
        ngemm_tile<false>((LAS float*)C.lds, C.tid, [&](int r) { return HM + (size_t)(m0 + r) * D; }, W, W, D, n0, D,
            [&](int r, int c, const float (&a0)[4], const float (&)[4]) {
                u32x2 w; w.x = pk2(a0[0], a0[1]); w.y = pk2(a0[2], a0[3]); *(u32x2*)(YL + (size_t)(m0 + r) * D + c) = w; });
    }
}
__device__ __forceinline__ void phase_m1(const Args& A, const Ctx& C, int l) {
    LAS int* sb = (LAS int*)(C.lds + 32768); LAS int* ts = sb + 40;
    slot_bases(A, l, sb, C.tid);
    const unsigned* cnt = (const unsigned*)(A.ws + WS_CTL) + CW_CNT + l * 32;
    if (C.tid == 0) { int acc = 0; for (int e = 0; e < NE; ++e) { ts[e] = acc; acc += (((int)cnt[e] + 127) / 128) * (DE / 64); } ts[NE] = acc; }
    __syncthreads();
    const bf16* H = (const bf16*)(A.ws + WS_HB); bf16* ACT = (bf16*)(A.ws + WS_DC); const int* ST = (const int*)(A.ws + WS_SLOTTOK);
    const int ntile = ts[NE];
    for (int t = C.bid; t < ntile; t += C.G) {
        int e = 0; while (t >= ts[e + 1]) ++e;
        const int tl = t - ts[e], m0 = (tl / (DE / 64)) * 128, n0 = (tl % (DE / 64)) * 64, ce = (int)cnt[e];
        const float* Wg = A.in[19] + ((size_t)l * NE + e) * D * DE; const float* Wu = A.in[20] + ((size_t)l * NE + e) * D * DE;
        const int* st = ST + (size_t)e * CAP; const size_t base = (size_t)sb[e];
        ngemm_tile<true>((LAS float*)C.lds, C.tid, [&](int r) -> const bf16* { return (m0 + r < ce) ? H + (size_t)st[m0 + r] * D : nullptr; }, Wg, Wu, DE, n0, D,
            [&](int r, int c, const float (&a0)[4], const float (&a1)[4]) {
                if (m0 + r < ce) { u32x2 w; w.x = pk2(siluf_(a0[0]) * a1[0], siluf_(a0[1]) * a1[1]); w.y = pk2(siluf_(a0[2]) * a1[2], siluf_(a0[3]) * a1[3]);
                    *(u32x2*)(ACT + (base + m0 + r) * DE + c) = w; } });
    }
}
__device__ __forceinline__ void phase_m2(const Args& A, const Ctx& C, int l) {
    LAS int* sb = (LAS int*)(C.lds + 32768); LAS int* ts = sb + 40;
    slot_bases(A, l, sb, C.tid);
    const unsigned* cnt = (const unsigned*)(A.ws + WS_CTL) + CW_CNT + l * 32;
    if (C.tid == 0) { int acc = 0; for (int e = 0; e < NE; ++e) { ts[e] = acc; acc += (((int)cnt[e] + 127) / 128) * (D / 64); } ts[NE] = acc; }
    __syncthreads();
    const bf16* ACT = (const bf16*)(A.ws + WS_DC); bf16* Y = (bf16*)(A.ws + WS_PB);
    const int ntile = ts[NE];
    for (int t = C.bid; t < ntile; t += C.G) {
        int e = 0; while (t >= ts[e + 1]) ++e;
        const int tl = t - ts[e], m0 = (tl / (D / 64)) * 128, n0 = (tl % (D / 64)) * 64, ce = (int)cnt[e];
        const float* Wd = A.in[21] + ((size_t)l * NE + e) * DE * D; const size_t base = (size_t)sb[e];
        ngemm_tile<false>((LAS float*)C.lds, C.tid, [&](int r) -> const bf16* { return (m0 + r < ce) ? ACT + (base + m0 + r) * DE : nullptr; }, Wd, Wd, D, n0, DE,
            [&](int r, int c, const float (&a0)[4], const float (&)[4]) {
                if (m0 + r < ce) { u32x2 w; w.x = pk2(a0[0], a0[1]); w.y = pk2(a0[2], a0[3]); *(u32x2*)(Y + (base + m0 + r) * D + c) = w; } });
    }
}

__device__ __forceinline__ void block_gates(const Args& A, int row0, int h, LAS float* bf, LAS float* bb, LAS float* lif, LAS float* lib, int tid) {
    const float* GATE = (const float*)(A.ws + WS_GATE);
    if (tid < 256) { const float* g = GATE + (size_t)(row0 + tid) * 16; lif[tid] = g[0 + h]; bf[tid] = g[4 + h]; lib[tid] = g[8 + h]; bb[tid] = g[12 + h]; }
    __syncthreads();
    if (tid == 0) { float s = 0.f; for (int i = 0; i < 256; ++i) { s += bf[i]; bf[i] = s; } }
    if (tid == 64) { float s = 0.f; for (int i = 255; i >= 0; --i) { s += bb[i]; bb[i] = s; } }
    __syncthreads();
}
__device__ __forceinline__ void phase_s1(const Args& A, const Ctx& C, int l) {
    LAS float* bf = (LAS float*)C.lds; LAS float* bb = bf + 256; LAS float* lif = bb + 256; LAS float* lib = lif + 256; LAS float* af = lib + 256; LAS float* ab = af + 256;
    const bf16* P = (const bf16*)(A.ws + WS_PB);
    float* DC = (float*)(A.ws + WS_DC); float* DN = (float*)(A.ws + WS_DN); float* BT = (float*)(A.ws + WS_BTOT);
    for (int u = C.bid; u < NUNIT; u += C.G) {
        const int blk = u % NBLK, bh = u / NBLK, h = bh % NH, b = bh / NH; const int row0 = blk_row0(b, blk);
        block_gates(A, row0, h, bf, bb, lif, lib, C.tid);
        if (C.tid < 256) { af[C.tid] = __expf(bf[255] - bf[C.tid] + lif[C.tid]); ab[C.tid] = __expf(bb[0] - bb[C.tid] + lib[C.tid]); }
        if (C.tid == 0) { BT[u * 2 + 0] = bf[255]; BT[u * 2 + 1] = bb[0]; }
        __syncthreads();
        const int dg = C.tid >> 5, eg = C.tid & 31;
        float cf[8][8], cb[8][8], nf[8], nb[8];
#pragma unroll
        for (int i = 0; i < 8; ++i) { nf[i] = 0.f; nb[i] = 0.f;
#pragma unroll
            for (int q = 0; q < 8; ++q) { cf[i][q] = 0.f; cb[i][q] = 0.f; } }
#pragma unroll 2
        for (int s = 0; s < 256; ++s) {
            const bf16* pr = P + (size_t)(row0 + s) * PW;
            const u32x4 kv = *(const u32x4*)(pr + NQ + h * DQK + dg * 8); const u32x4 vv = *(const u32x4*)(pr + 2 * NQ + h * DV + eg * 8);
            float kk[8], ve[8];
#pragma unroll
            for (int i = 0; i < 4; ++i) { kk[2 * i] = __uint_as_float(kv[i] << 16); kk[2 * i + 1] = __uint_as_float(kv[i] & 0xffff0000u); ve[2 * i] = __uint_as_float(vv[i] << 16); ve[2 * i + 1] = __uint_as_float(vv[i] & 0xffff0000u); }
            const float wf = af[s], wb = ab[s];
#pragma unroll
            for (int i = 0; i < 8; ++i) { const float kf = kk[i] * wf, kb = kk[i] * wb; nf[i] += kf; nb[i] += kb;
#pragma unroll
                for (int q = 0; q < 8; ++q) { cf[i][q] += kf * ve[q]; cb[i][q] += kb * ve[q]; } }
        }
        float* dcf = DC + (size_t)(u * 2 + 0) * DQK * DV; float* dcb = DC + (size_t)(u * 2 + 1) * DQK * DV;
#pragma unroll
        for (int i = 0; i < 8; ++i) {
            *(f32x4*)(dcf + (dg * 8 + i) * DV + eg * 8) = (f32x4){cf[i][0], cf[i][1], cf[i][2], cf[i][3]}; *(f32x4*)(dcf + (dg * 8 + i) * DV + eg * 8 + 4) = (f32x4){cf[i][4], cf[i][5], cf[i][6], cf[i][7]};
            *(f32x4*)(dcb + (dg * 8 + i) * DV + eg * 8) = (f32x4){cb[i][0], cb[i][1], cb[i][2], cb[i][3]}; *(f32x4*)(dcb + (dg * 8 + i) * DV + eg * 8 + 4) = (f32x4){cb[i][4], cb[i][5], cb[i][6], cb[i][7]};
            if (eg == 0) { DN[(size_t)(u * 2 + 0) * DQK + dg * 8 + i] = nf[i]; DN[(size_t)(u * 2 + 1) * DQK + dg * 8 + i] = nb[i]; }
        }
        __syncthreads();
    }
}
__device__ __forceinline__ void phase_s2(const Args& A, const Ctx& C) {
    const float* DC = (const float*)(A.ws + WS_DC); const float* DN = (const float*)(A.ws + WS_DN); const float* BT = (const float*)(A.ws + WS_BTOT);
    float* CST = (float*)(A.ws + WS_CST); float* NST = (float*)(A.ws + WS_NST);
    const int EL = DQK * DV + DQK;
    for (long i = (long)C.bid * NT + C.tid; i < (long)BATCH * NH * 2 * EL; i += (long)C.G * NT) {
        const int el = (int)(i % EL), ch = (int)(i / EL), dir = ch & 1, bh = ch >> 1;
        float st = 0.f;
        for (int idx = 0; idx < NBLK; ++idx) {
            const int blk = dir == 0 ? idx : (idx == 0 ? 0 : NBLK - idx);
            const int u = bh * NBLK + blk;
            const float dec = __expf(BT[u * 2 + dir]);
            if (el < DQK * DV) { CST[(size_t)(u * 2 + dir) * DQK * DV + el] = st; st = dec * st + DC[(size_t)(u * 2 + dir) * DQK * DV + el]; }
            else { NST[(size_t)(u * 2 + dir) * DQK + (el - DQK * DV)] = st; st = dec * st + DN[(size_t)(u * 2 + dir) * DQK + (el - DQK * DV)]; }
        }
    }
}
__device__ __forceinline__ void phase_s3(const Args& A, const Ctx& C, int l) {
    const int j = l >> 1;
    LAS float* bf = (LAS float*)C.lds; LAS float* bb = bf + 256; LAS float* lif = bb + 256; LAS float* lib = lif + 256;
    LAS float* den = lib + 256;
    LAS float* qs = den + 64;
    LAS float* Pf = qs + 32 * 128;
    LAS float* Pb = Pf + 32 * 256;
    LAS float* hr = Pb + 32 * 256;
    const bf16* P = (const bf16*)(A.ws + WS_PB); bf16* HM = (bf16*)(A.ws + WS_HM);
    const float* CST = (const float*)(A.ws + WS_CST); const float* NST = (const float*)(A.ws + WS_NST);
    const float* hg = A.in[10] + (size_t)j * NV;
    const bool ctx_out = (l == 0);
    for (int u = C.bid; u < NUNIT; u += C.G) {
        const int blk = u % NBLK, bh = u / NBLK, h = bh % NH, b = bh / NH; const int row0 = blk_row0(b, blk);
        if (blk == 0 && !ctx_out) continue;
        block_gates(A, row0, h, bf, bb, lif, lib, C.tid);
        const float* Cf = CST + (size_t)(u * 2 + 0) * DQK * DV; const float* Cb = CST + (size_t)(u * 2 + 1) * DQK * DV;
        const float* Nf = NST + (size_t)(u * 2 + 0) * DQK; const float* Nb = NST + (size_t)(u * 2 + 1) * DQK;
        for (int jt = 0; jt < 8; ++jt) {
            const int j0 = jt * 32;
            for (int i = C.tid; i < 32 * 128; i += NT) { const int r = i >> 7, d = i & 127; qs[i] = bf2f(P[(size_t)(row0 + j0 + r) * PW + h * DQK + d]); }
            __syncthreads();
            { const int r = C.tid >> 4, sg = C.tid & 15, jj = j0 + r;
#pragma unroll 1
              for (int i = 0; i < 16; ++i) { const int s = sg + 16 * i; const bf16* kr = P + (size_t)(row0 + s) * PW + NQ + h * DQK; float dot = 0.f;
#pragma unroll
                  for (int d8 = 0; d8 < 16; ++d8) { const u32x4 kv = *(const u32x4*)(kr + d8 * 8);
#pragma unroll
                      for (int q = 0; q < 4; ++q) dot += qs[r * 128 + d8 * 8 + 2 * q] * __uint_as_float(kv[q] << 16) + qs[r * 128 + d8 * 8 + 2 * q + 1] * __uint_as_float(kv[q] & 0xffff0000u); }
                  const float wf = (s <= jj) ? __expf(bf[jj] - bf[s] + lif[s]) : 0.f; const float wb = (s >= jj) ? __expf(bb[jj] - bb[s] + lib[s]) : 0.f;
                  Pf[r * 256 + s] = dot * wf; Pb[r * 256 + s] = dot * wb; } }
            __syncthreads();
            if (C.tid < 64) { const int r = C.tid >> 1, dir = C.tid & 1, jj = j0 + r; LAS const float* pp = (dir ? Pb : Pf) + r * 256; float s = 0.f;
                for (int i = 0; i < 256; ++i) s += pp[i];
                const float* nn = dir ? Nb : Nf; float qn = 0.f;
                for (int d = 0; d < 128; ++d) qn += qs[r * 128 + d] * nn[d];
                den[dir * 32 + r] = s + __expf(dir ? bb[jj] : bf[jj]) * qn; }
            __syncthreads();
            { const int r = C.tid >> 4, eg = C.tid & 15, jj = j0 + r;
              float af[16], ab[16], cf[16], cb[16];
#pragma unroll
              for (int q = 0; q < 16; ++q) { af[q] = 0.f; ab[q] = 0.f; cf[q] = 0.f; cb[q] = 0.f; }
#pragma unroll 2
              for (int s = 0; s < 256; ++s) { const float pf = Pf[r * 256 + s], pb = Pb[r * 256 + s]; const bf16* vr = P + (size_t)(row0 + s) * PW + 2 * NQ + h * DV + eg * 16;
                  const u32x4 v0 = *(const u32x4*)vr, v1 = *(const u32x4*)(vr + 8);
#pragma unroll
                  for (int q = 0; q < 4; ++q) { const float a = __uint_as_float(v0[q] << 16), c = __uint_as_float(v0[q] & 0xffff0000u), e = __uint_as_float(v1[q] << 16), g = __uint_as_float(v1[q] & 0xffff0000u);
                      af[2 * q] += pf * a; af[2 * q + 1] += pf * c; af[8 + 2 * q] += pf * e; af[8 + 2 * q + 1] += pf * g;
                      ab[2 * q] += pb * a; ab[2 * q + 1] += pb * c; ab[8 + 2 * q] += pb * e; ab[8 + 2 * q + 1] += pb * g; } }
#pragma unroll 2
              for (int d = 0; d < 128; ++d) { const float qd = qs[r * 128 + d];
#pragma unroll
                  for (int q4 = 0; q4 < 4; ++q4) { const f32x4 x = *(const f32x4*)(Cf + d * DV + eg * 16 + q4 * 4), y = *(const f32x4*)(Cb + d * DV + eg * 16 + q4 * 4);
#pragma unroll
                      for (int q = 0; q < 4; ++q) { cf[q4 * 4 + q] += qd * x[q]; cb[q4 * 4 + q] += qd * y[q]; } } }
              const float ef = __expf(bf[jj]), eb = __expf(bb[jj]);
              const float rf = 1.0f / fmaxf(fabsf(den[r]), 1.0f), rb = 1.0f / fmaxf(fabsf(den[32 + r]), 1.0f);
#pragma unroll
              for (int q = 0; q < 16; ++q) hr[r * 256 + eg * 16 + q] = (af[q] + ef * cf[q]) * rf + (ab[q] + eb * cb[q]) * rb; }
            __syncthreads();
            for (int rr = 0; rr < 4; ++rr) { const int r = C.wave * 4 + rr; const size_t row = (size_t)(row0 + j0 + r);
                const f32x4 x = *(const LAS f32x4*)(hr + r * 256 + C.lane * 4);
                const float ss = wave_sum((x.x * x.x + x.y * x.y) + (x.z * x.z + x.w * x.w));
                const float rs = 1.0f / sqrtf(ss * (1.0f / DV) + EPS);
                const f32x4 g = *(const f32x4*)(hg + h * DV + C.lane * 4);
                const u32x2 ow = *(const u32x2*)(P + row * PW + 2 * NQ + NV + h * DV + C.lane * 4);
                const f32x4 o = (f32x4){__uint_as_float(ow.x << 16), __uint_as_float(ow.x & 0xffff0000u), __uint_as_float(ow.y << 16), __uint_as_float(ow.y & 0xffff0000u)};
                const f32x4 y = x * rs * g * o;
                u32x2 w; w.x = pk2(y.x, y.y); w.y = pk2(y.z, y.w); *(u32x2*)(HM + row * D + h * DV + C.lane * 4) = w; }
            __syncthreads();
        }
    }
}

#define XB_TMO      128
#define XB_XCNT(j)  (256  + 64 * (j))
#define XB_XSUB(j)  (1280 + 64 * (j))
#define XB_XGEN(j)  (2304 + 64 * (j))
#define XB_TOP      3328
#define XB_TOPGEN   3392
#define XCD_BAR_WORDS 3456
#define XB_SPIN_CAP (1u << 18)

__device__ __forceinline__ unsigned xb_ld(unsigned* p)              { return __hip_atomic_load(p, __ATOMIC_RELAXED, __HIP_MEMORY_SCOPE_AGENT); }
__device__ __forceinline__ unsigned xb_add(unsigned* p, unsigned v) { return __hip_atomic_fetch_add(p, v, __ATOMIC_RELAXED, __HIP_MEMORY_SCOPE_AGENT); }
__device__ __forceinline__ unsigned xb_xcc_id() { return (unsigned)__builtin_amdgcn_s_getreg((3 << 11) | 20) & 0xFu; }
#define XB_SPIN(cond, bar) do { unsigned _sp = 0; while (cond) { __builtin_amdgcn_s_sleep(1); \
    if ((++_sp & 255u) == 0u) { if (xb_ld(&(bar)[XB_TMO])) break; if (_sp > XB_SPIN_CAP) { atomicAdd(&(bar)[XB_TMO], 1u); break; } } } } while (0)

struct XcdBarrier {
    unsigned* bar; unsigned x;
    volatile LAS unsigned* st;
};

__device__ __forceinline__ XcdBarrier xcd_barrier_post(unsigned* bar, volatile LAS unsigned* st) {
    XcdBarrier b; b.bar = bar; b.x = xb_xcc_id(); b.st = st;
    if (threadIdx.x == 0) (void)xb_add(&bar[XB_XCNT(b.x)], 1u);
    return b;
}
__device__ __forceinline__ void xcd_barrier_complete(unsigned* bar, unsigned x, unsigned& nloc, unsigned& nx) {
    const unsigned G = gridDim.x * gridDim.y * gridDim.z;
    unsigned sum, cnt, mine, sp = 0u;
    for (;;) {
        sum = 0u; cnt = 0u; mine = 0u;
#pragma unroll
        for (unsigned j = 0; j < 16; ++j) { const unsigned c = xb_ld(&bar[XB_XCNT(j)]); sum += c; cnt += (c > 0u) ? 1u : 0u; mine = (j == x) ? c : mine; }
        if (sum == G) break;
        __builtin_amdgcn_s_sleep(1);
        if ((++sp & 255u) == 0u) { if (xb_ld(&bar[XB_TMO])) break; if (sp > XB_SPIN_CAP) { atomicAdd(&bar[XB_TMO], 1u); break; } }
    }
    nloc = mine > 0u ? mine : 1u; nx = cnt > 0u ? cnt : 1u;
}

__device__ __forceinline__ void xcd_barrier(const XcdBarrier& b) {
    asm volatile("s_waitcnt vmcnt(0)" ::: "memory");
    __syncthreads();
    if (threadIdx.x == 0) {
        unsigned* bar = b.bar;
        __builtin_amdgcn_s_waitcnt(0);
        unsigned nloc = b.st[0], nx = b.st[1];
        if (nloc == 0u) { xcd_barrier_complete(bar, b.x, nloc, nx); b.st[0] = nloc; b.st[1] = nx; }
        const unsigned old = xb_add(&bar[XB_XSUB(b.x)], 1u);
        const unsigned gen = old / nloc;
        if (old + 1u == (gen + 1u) * nloc) {
            __builtin_amdgcn_fence(__ATOMIC_RELEASE, "agent");
            asm volatile("s_waitcnt vmcnt(0)" ::: "memory");
            const unsigned og = xb_add(&bar[XB_TOP], 1u);
            const unsigned tg = og / nx;
            if (og + 1u == (tg + 1u) * nx) xb_add(&bar[XB_TOPGEN], 1u);
            else XB_SPIN(xb_ld(&bar[XB_TOPGEN]) == tg, bar);
            __builtin_amdgcn_fence(__ATOMIC_ACQUIRE, "agent");
            xb_add(&bar[XB_XGEN(b.x)], 1u);
            asm volatile("s_waitcnt vmcnt(0)" ::: "memory");
        } else {
            XB_SPIN(xb_ld(&bar[XB_XGEN(b.x)]) == gen, bar);
            __builtin_amdgcn_fence(__ATOMIC_ACQUIRE, "agent");
            asm volatile("s_waitcnt vmcnt(0)" ::: "memory");
        }
    }
    __syncthreads();
}


constexpr int LDS_BYTES = 152 * 1024;
constexpr int CW_BAR = 8192;
static_assert((CW_BAR + XCD_BAR_WORDS) * 4 <= (int)CTL_BYTES, "ctl");
#ifndef MK_MULTI
#define MK_MULTI 0
#endif
#define IN(p) (lo <= (p) && (p) < hi)
#define SEAM(p) do { if ((p) + 1 < hi) xcd_barrier(bar); } while (0)
template <int L> __device__ __forceinline__ void layer_phases(const Args& args, const Ctx& C, const XcdBarrier& bar, int lo, int hi) {
    constexpr int pb = 16 * L;
    if (IN(pb + 1)) { phase_r1(args, C, L); SEAM(pb + 1); }
    if (IN(pb + 2)) { phase_g1(args, C, L); SEAM(pb + 2); }
    if constexpr ((L & 1) == 0) {
        if (IN(pb + 3)) { phase_s1(args, C, L); SEAM(pb + 3); }
        if (IN(pb + 4)) { phase_s2(args, C); SEAM(pb + 4); }
        if (IN(pb + 5)) { phase_s3(args, C, L); SEAM(pb + 5); }
    } else {
        if (IN(pb + 3)) { phase_conv(args, C, L); SEAM(pb + 3); }
    }
    if (IN(pb + 6)) { phase_g2(args, C, L); SEAM(pb + 6); }
    if (IN(pb + 7)) { phase_r2(args, C, L); SEAM(pb + 7); }
    if (IN(pb + 8)) { phase_m1(args, C, L); SEAM(pb + 8); }
    if (IN(pb + 9)) { phase_m2(args, C, L); SEAM(pb + 9); }
}
__global__ void __launch_bounds__(NT, 2) fwd_kernel(Args args) {
    extern __shared__ __attribute__((aligned(16))) unsigned char lds_raw[];
    Ctx C; C.lds = (LAS unsigned char*)lds_raw; C.tid = threadIdx.x; C.lane = C.tid & 63; C.wave = __builtin_amdgcn_readfirstlane(C.tid >> 6); C.G = gridDim.x; C.bid = blockIdx.x; C.a = &args;
    const int lo = args.lo, hi = args.hi;
    volatile LAS unsigned* xbw = (volatile LAS unsigned*)(C.lds + LDS_BYTES - 16);
    if (C.tid < 4) xbw[C.tid] = 0u;
    __syncthreads();
    XcdBarrier bar; bar.bar = (unsigned*)(args.ws + WS_CTL) + CW_BAR; bar.x = 0; bar.st = xbw;
    if (hi - lo > 1) bar = xcd_barrier_post((unsigned*)(args.ws + WS_CTL) + CW_BAR, xbw);
    if (IN(0)) { phase_mod(args, C); SEAM(0); }
    layer_phases<0>(args, C, bar, lo, hi);
    layer_phases<1>(args, C, bar, lo, hi);
    layer_phases<2>(args, C, bar, lo, hi);
    layer_phases<3>(args, C, bar, lo, hi);
    if (IN(64)) phase_final(args, C);
}
#undef IN
#undef SEAM

extern "C" void kernel_launch(void* const* d_in, const int* in_sizes, int n_in, void* d_out, int out_size, void* d_ws, size_t ws_size, hipStream_t stream) {
    static int grid = 0;
    if (grid == 0) {
        if (n_in != 22 || out_size != NL * D || ws_size < WS_END) { fprintf(stderr, "kernel_launch: unexpected shapes (n_in %d out %d ws %zu)\n", n_in, out_size, ws_size); grid = -1; return; }
        int dev = 0, cus = 0, per_cu = 0;
        if (hipGetDevice(&dev) != hipSuccess || hipDeviceGetAttribute(&cus, hipDeviceAttributeMultiprocessorCount, dev) != hipSuccess) { grid = -1; return; }
        if (hipFuncSetAttribute((const void*)fwd_kernel, hipFuncAttributeMaxDynamicSharedMemorySize, LDS_BYTES) != hipSuccess) { grid = -1; return; }
        if (hipOccupancyMaxActiveBlocksPerMultiprocessor(&per_cu, (const void*)fwd_kernel, NT, LDS_BYTES) != hipSuccess || per_cu < 1) { fprintf(stderr, "kernel_launch: occupancy query says %d\n", per_cu); }
        (void)hipGetLastError();
        grid = cus;
    }
    if (grid < 0) return;
    (void)hipMemsetAsync((char*)d_ws + WS_CTL, 0, CTL_BYTES, stream);
    Args a{};
    for (int i = 0; i < 22; ++i) a.in[i] = (const float*)d_in[i];
    a.out = (float*)d_out; a.ws = (unsigned char*)d_ws;
#if MK_MULTI
    int phases[64]; int np = 0;
    phases[np++] = 0;
    for (int l = 0; l < DEPTH; ++l) { const int pb = 16 * l; phases[np++] = pb + 1; phases[np++] = pb + 2; phases[np++] = pb + 3;
        if ((l & 1) == 0) { phases[np++] = pb + 4; phases[np++] = pb + 5; }
        phases[np++] = pb + 6; phases[np++] = pb + 7; phases[np++] = pb + 8; phases[np++] = pb + 9; }
    phases[np++] = 64;
    for (int i = 0; i < np; ++i) { a.lo = phases[i]; a.hi = phases[i] + 1; hipLaunchKernelGGL(fwd_kernel, dim3(grid), dim3(NT), LDS_BYTES, stream, a); }
#else
    a.lo = 0; a.hi = 65;
    hipLaunchKernelGGL(fwd_kernel, dim3(grid), dim3(NT), LDS_BYTES, stream, a);
#endif
}
```

```cpp
#include <hip/hip_runtime.h>
#include <cstdio>
#include <cstdint>

#define LAS __attribute__((address_space(3)))
typedef unsigned short bf16;
typedef float f32x4 __attribute__((ext_vector_type(4)));
typedef unsigned u32x4 __attribute__((ext_vector_type(4)));
typedef unsigned u32x2 __attribute__((ext_vector_type(2)));

constexpr int D = 1024, BATCH = 2, SEQ = 16384, DEPTH = 4, CTXL = 256;
constexpr int NL = BATCH * SEQ, NCX = BATCH * CTXL, NR = NL + NCX;
constexpr int NH = 4, DQK = 128, DV = 256, NQ = 512, NV = 1024, PROJ = 3088, PW = 3072;
constexpr int NGRP = 4, EPG = 8, NE = 32, DE = 512;
constexpr int NBLK = 65;
constexpr int NUNIT = BATCH * NH * NBLK;
constexpr int CAP = NR;
constexpr int YROWS = 74752;
constexpr float EPS = 1e-6f;
constexpr int NT = 512, NW = 8;

constexpr size_t MiB = 1u << 20;
constexpr size_t WS_CTL = 0, CTL_BYTES = 1 * MiB;
constexpr size_t WS_MOD = 1 * MiB;
constexpr size_t WS_GATE = 2 * MiB;
constexpr size_t WS_TOKSLOT = 5 * MiB;
constexpr size_t WS_TOKW = 6 * MiB;
constexpr size_t WS_SLOTTOK = 7 * MiB;
constexpr size_t WS_DN = 12 * MiB;
constexpr size_t WS_NST = 13 * MiB;
constexpr size_t WS_BTOT = 14 * MiB;
constexpr size_t WS_LAT = 16 * MiB;
constexpr size_t WS_HB = 146 * MiB;
constexpr size_t WS_PB = 211 * MiB;
constexpr size_t WS_HM = 406 * MiB;
constexpr size_t WS_DC = 471 * MiB;
constexpr size_t WS_CST = 601 * MiB;
constexpr size_t WS_WAIN = 731 * MiB;
constexpr size_t WS_WBIN = 743 * MiB;
constexpr size_t WS_WAOUT = 755 * MiB;
constexpr size_t WS_WBOUT = 759 * MiB;
constexpr size_t WS_WGU = 763 * MiB;
constexpr size_t WS_WDN = 827 * MiB;
constexpr size_t WS_END = 859 * MiB;
constexpr int CW_CNT = 1024;

struct Args { const float* in[22]; float* out; unsigned char* ws; int lo, hi; };

__device__ __forceinline__ float bf2f(bf16 v) { return __uint_as_float(((unsigned)v) << 16); }
__device__ __forceinline__ unsigned f2bf(float f) { unsigned u = __float_as_uint(f); return (u + 0x7fffu + ((u >> 16) & 1u)) >> 16; }
__device__ __forceinline__ unsigned pk2(float lo, float hi) { return f2bf(lo) | (f2bf(hi) << 16); }
__device__ __forceinline__ float wave_sum(float v) {
#pragma unroll
    for (int o = 1; o < 64; o <<= 1) v += __shfl_xor(v, o);
    return v;
}
__device__ __forceinline__ float sigmoidf_(float x) { return 1.f / (1.f + __expf(-x)); }
__device__ __forceinline__ float siluf_(float x) { return x / (1.f + __expf(-x)); }
__device__ __forceinline__ float logsigmoidf_(float x) { return fminf(x, 0.f) - log1pf(__expf(-fabsf(x))); }
__device__ __forceinline__ int blk_row0(int b, int blk) { return blk == 0 ? NL + b * CTXL : b * SEQ + (blk - 1) * 256; }
__device__ __forceinline__ int mod_vec_of_row(int row) { return row < NL ? row / SEQ : 2; }

struct Ctx {
    LAS unsigned char* lds; int tid, lane, wave, G, bid;
    const Args* a;
};

__device__ __forceinline__ void slot_bases(const Args& A, int l, LAS int* sb, int tid) {
    if (tid == 0) {
        const unsigned* cnt = (const unsigned*)(A.ws + WS_CTL) + CW_CNT + l * 32;
        int acc = 0;
        for (int e = 0; e < NE; ++e) { sb[e] = acc; acc += (((int)cnt[e] + 255) / 256) * 256; }
        sb[NE] = acc;
    }
    __syncthreads();
}

__device__ __forceinline__ void phase_mod(const Args& A, const Ctx& C) {
    LAS float* sc = (LAS float*)C.lds;
    LAS float* red = sc + 3072;
    const float* c = A.in[1]; const float* cc = A.in[3];
    for (int i = C.tid; i < 3072; i += NT) { const float v = i < 2048 ? c[i] : cc[i - 2048]; sc[i] = siluf_(v); }
    __syncthreads();
    float* MOD = (float*)(A.ws + WS_MOD);
    for (int u = C.bid; u < DEPTH * 96; u += C.G) {
        const int l = u / 96, cg = u % 96, col = cg * 64 + C.lane;
        const float* w = A.in[4] + (size_t)l * D * 6 * D + col;
        float a0 = 0.f, a1 = 0.f, a2 = 0.f;
        for (int k = C.wave * 128; k < C.wave * 128 + 128; ++k) { const float wv = w[(size_t)k * 6 * D]; a0 += sc[k] * wv; a1 += sc[1024 + k] * wv; a2 += sc[2048 + k] * wv; }
        red[(C.wave * 3 + 0) * 64 + C.lane] = a0; red[(C.wave * 3 + 1) * 64 + C.lane] = a1; red[(C.wave * 3 + 2) * 64 + C.lane] = a2;
        __syncthreads();
        if (C.tid < 192) { const int v = C.tid / 64, ln = C.tid % 64; float s = 0.f;
            for (int w8 = 0; w8 < 8; ++w8) s += red[(w8 * 3 + v) * 64 + ln];
            MOD[(size_t)(l * 3 + v) * 6 * D + cg * 64 + ln] = s + A.in[5][(size_t)l * 6 * D + cg * 64 + ln]; }
        __syncthreads();
    }
}

__device__ __forceinline__ void load_row_f32(const float* p, int lane, f32x4 (&v)[4]) {
#pragma unroll
    for (int j = 0; j < 4; ++j) v[j] = *(const f32x4*)(p + 4 * lane + 256 * j);
}
__device__ __forceinline__ void load_row_bf16(const bf16* p, int lane, f32x4 (&v)[4]) {
#pragma unroll
    for (int j = 0; j < 4; ++j) { const u32x2 w = *(const u32x2*)(p + 4 * lane + 256 * j);
        v[j] = (f32x4){__uint_as_float(w.x << 16), __uint_as_float(w.x & 0xffff0000u), __uint_as_float(w.y << 16), __uint_as_float(w.y & 0xffff0000u)}; }
}
__device__ __forceinline__ void store_row_bf16(bf16* p, int lane, const f32x4 (&v)[4]) {
#pragma unroll
    for (int j = 0; j < 4; ++j) { u32x2 w; w.x = pk2(v[j].x, v[j].y); w.y = pk2(v[j].z, v[j].w); *(u32x2*)(p + 4 * lane + 256 * j) = w; }
}
__device__ __forceinline__ void moe_combine(const Args& A, int lp, int row, int lane, LAS const int* sb, f32x4 (&v)[4]) {
    const int* ts = (const int*)(A.ws + WS_TOKSLOT) + row * 2; const float* tw = (const float*)(A.ws + WS_TOKW) + row * 2;
    const bf16* Y = (const bf16*)(A.ws + WS_PB);
    const int t0 = ts[0], t1 = ts[1]; const float w0 = tw[0], w1 = tw[1];
    const size_t s0 = (size_t)(sb[t0 >> 20] + (t0 & 0xfffff)), s1 = (size_t)(sb[t1 >> 20] + (t1 & 0xfffff));
    f32x4 y0[4], y1[4], g2[4];
    load_row_bf16(Y + s0 * D, lane, y0); load_row_bf16(Y + s1 * D, lane, y1);
    load_row_f32((const float*)(A.ws + WS_MOD) + (size_t)(lp * 3 + mod_vec_of_row(row)) * 6 * D + 5 * D, lane, g2);
#pragma unroll
    for (int j = 0; j < 4; ++j) v[j] += g2[j] * (y0[j] * w0 + y1[j] * w1);
}
__device__ __forceinline__ void norm_mod(const f32x4 (&v)[4], const float* g, const float* sh, const float* sc, int lane, f32x4 (&h)[4]) {
    float s = 0.f;
#pragma unroll
    for (int j = 0; j < 4; ++j) s += (v[j].x * v[j].x + v[j].y * v[j].y) + (v[j].z * v[j].z + v[j].w * v[j].w);
    const float r = 1.0f / sqrtf(wave_sum(s) * (1.f / D) + EPS);
    f32x4 gg[4], ss[4], cc[4];
    load_row_f32(g, lane, gg); load_row_f32(sh, lane, ss); load_row_f32(sc, lane, cc);
#pragma unroll
    for (int j = 0; j < 4; ++j) h[j] = (v[j] * r) * gg[j] * (1.f + cc[j]) + ss[j];
}

__device__ __forceinline__ void phase_r1(const Args& A, const Ctx& C, int l) {
    LAS int* sb = (LAS int*)C.lds;
    LAS float* GW = (LAS float*)(C.lds + 256);
    const bool mls = (l & 1) == 0; const int j = l >> 1;
    if (l > 0) slot_bases(A, l - 1, sb, C.tid);
    if (mls) { const float* w = A.in[8] + (size_t)j * D * PROJ + PW;
        for (int i = C.tid; i < 16 * D; i += NT) { const int k = i >> 4, c = i & 15; GW[c * D + k] = w[(size_t)k * PROJ + c]; }
        __syncthreads(); }
    const int nrows = (l <= 2) ? NR : NL;
    float* LAT = (float*)(A.ws + WS_LAT); bf16* H = (bf16*)(A.ws + WS_HB); float* GATE = (float*)(A.ws + WS_GATE);
    const float* MOD = (const float*)(A.ws + WS_MOD);
    for (int row = C.bid * NW + C.wave; row < nrows; row += C.G * NW) {
        f32x4 v[4], h[4];
        if (l == 0) load_row_f32(row < NL ? A.in[0] + (size_t)row * D : A.in[2] + (size_t)(row - NL) * D, C.lane, v);
        else { load_row_f32(LAT + (size_t)row * D, C.lane, v); moe_combine(A, l - 1, row, C.lane, sb, v); }
#pragma unroll
        for (int q = 0; q < 4; ++q) *(f32x4*)(LAT + (size_t)row * D + 4 * C.lane + 256 * q) = v[q];
        const float* mv = MOD + (size_t)(l * 3 + mod_vec_of_row(row)) * 6 * D;
        norm_mod(v, A.in[6] + (size_t)(l * 2 + 0) * D, mv + 0 * D, mv + 1 * D, C.lane, h);
        store_row_bf16(H + (size_t)row * D, C.lane, h);
        if (mls) {
            float g = 0.f;
#pragma unroll 2
            for (int c = 0; c < 16; ++c) { float s = 0.f;
#pragma unroll
                for (int q = 0; q < 4; ++q) { const f32x4 w = *(const LAS f32x4*)(GW + c * D + 4 * C.lane + 256 * q); s += (h[q].x * w.x + h[q].y * w.y) + (h[q].z * w.z + h[q].w * w.w); }
                s = wave_sum(s); g = (C.lane == c) ? s : g; }
            if (C.lane < 16) {
                g += A.in[9][j * 16 + C.lane];
                const int gtype = C.lane >> 2;
                const float o = (gtype & 1) ? logsigmoidf_(g) : 15.0f * tanhf(g * (1.0f / 15.0f));
                GATE[(size_t)row * 16 + C.lane] = o; }
        }
    }
}

__device__ __forceinline__ void phase_r2(const Args& A, const Ctx& C, int l) {
    LAS float* RW = (LAS float*)C.lds;
    { const float* wg = A.in[15] + (size_t)l * D * NGRP; const float* wr = A.in[17] + (size_t)l * D * NE;
      for (int i = C.tid; i < 4 * D; i += NT) { const int k = i >> 2, c = i & 3; RW[c * D + k] = wg[(size_t)k * NGRP + c]; }
      for (int i = C.tid; i < 32 * D; i += NT) { const int k = i >> 5, c = i & 31; RW[(4 + c) * D + k] = wr[(size_t)k * NE + c]; }
      __syncthreads(); }
    const int nrows = (l <= 1) ? NR : NL;
    float* LAT = (float*)(A.ws + WS_LAT); bf16* H = (bf16*)(A.ws + WS_HB);
    const float* MOD = (const float*)(A.ws + WS_MOD);
    unsigned* cnt = (unsigned*)(A.ws + WS_CTL) + CW_CNT + l * 32;
    int* TS = (int*)(A.ws + WS_TOKSLOT); float* TW = (float*)(A.ws + WS_TOKW); int* ST = (int*)(A.ws + WS_SLOTTOK);
    for (int row = C.bid * NW + C.wave; row < nrows; row += C.G * NW) {
        f32x4 v[4], y[4], g1[4], h[4];
        const float* mv = MOD + (size_t)(l * 3 + mod_vec_of_row(row)) * 6 * D;
        load_row_f32(LAT + (size_t)row * D, C.lane, v); load_row_bf16(H + (size_t)row * D, C.lane, y); load_row_f32(mv + 2 * D, C.lane, g1);
#pragma unroll
        for (int q = 0; q < 4; ++q) { v[q] += g1[q] * y[q]; *(f32x4*)(LAT + (size_t)row * D + 4 * C.lane + 256 * q) = v[q]; }
        norm_mod(v, A.in[6] + (size_t)(l * 2 + 1) * D, mv + 3 * D, mv + 4 * D, C.lane, h);
        store_row_bf16(H + (size_t)row * D, C.lane, h);
        float mine = 0.f;
#pragma unroll 2
        for (int c = 0; c < 36; ++c) { float s = 0.f;
#pragma unroll
            for (int q = 0; q < 4; ++q) { const f32x4 w = *(const LAS f32x4*)(RW + c * D + 4 * C.lane + 256 * q); s += (h[q].x * w.x + h[q].y * w.y) + (h[q].z * w.z + h[q].w * w.w); }
            s = wave_sum(s); mine = (C.lane == c) ? s : mine; }
        LAS float* wl = (LAS float*)(C.lds + 36 * D * 4) + C.wave * 64;
        if (C.lane < 36) wl[C.lane] = mine;
        asm volatile("s_waitcnt lgkmcnt(0)" ::: "memory");
        if (C.lane == 0) {
            float lg[36];
#pragma unroll
            for (int c = 0; c < 36; ++c) lg[c] = wl[c];
            const float* bg = A.in[16] + l * NGRP; const float* br = A.in[18] + l * NE;
            float gl[4]; int grp = 0; float gm = -3.0e38f;
#pragma unroll
            for (int c = 0; c < 4; ++c) { gl[c] = lg[c] + bg[c]; if (gl[c] > gm) { gm = gl[c]; grp = c; } }
            float gs = 0.f;
#pragma unroll
            for (int c = 0; c < 4; ++c) gs += __expf(gl[c] - gm);
            const float pgrp = 1.0f / gs;
            float rl[8];
#pragma unroll
            for (int i = 0; i < 8; ++i) { float t = 0.f;
#pragma unroll
                for (int g = 0; g < 4; ++g) t = (g == grp) ? lg[4 + g * 8 + i] : t;
                rl[i] = t + br[grp * 8 + i]; }
            int i0 = 0; float m0 = rl[0];
#pragma unroll
            for (int i = 1; i < 8; ++i) if (rl[i] > m0) { m0 = rl[i]; i0 = i; }
            int i1 = -1; float m1 = -3.0e38f;
#pragma unroll
            for (int i = 0; i < 8; ++i) if (i != i0 && rl[i] > m1) { m1 = rl[i]; i1 = i; }
            const float p0 = 1.0f, p1 = __expf(m1 - m0);
            const float w0 = pgrp * p0 / (p0 + p1), w1 = pgrp * p1 / (p0 + p1);
            const int e0 = grp * 8 + i0, e1 = grp * 8 + i1;
            const unsigned q0 = atomicAdd(cnt + e0, 1u), q1 = atomicAdd(cnt + e1, 1u);
            ST[(size_t)e0 * CAP + q0] = row; ST[(size_t)e1 * CAP + q1] = row;
            TS[row * 2 + 0] = (e0 << 20) | (int)q0; TS[row * 2 + 1] = (e1 << 20) | (int)q1;
            TW[row * 2 + 0] = w0; TW[row * 2 + 1] = w1;
        }
    }
}

__device__ __forceinline__ void phase_final(const Args& A, const Ctx& C) {
    LAS int* sb = (LAS int*)C.lds;
    slot_bases(A, 3, sb, C.tid);
    const float* LAT = (const float*)(A.ws + WS_LAT);
    for (int row = C.bid * NW + C.wave; row < NL; row += C.G * NW) {
        f32x4 v[4], g[4];
        load_row_f32(LAT + (size_t)row * D, C.lane, v); moe_combine(A, 3, row, C.lane, sb, v);
        float s = 0.f;
#pragma unroll
        for (int j = 0; j < 4; ++j) s += (v[j].x * v[j].x + v[j].y * v[j].y) + (v[j].z * v[j].z + v[j].w * v[j].w);
        const float r = 1.0f / sqrtf(wave_sum(s) * (1.f / D) + EPS);
        load_row_f32(A.in[7], C.lane, g);
#pragma unroll
        for (int j = 0; j < 4; ++j) *(f32x4*)(A.out + (size_t)row * D + 4 * C.lane + 256 * j) = (v[j] * r) * g[j];
    }
}

__device__ __forceinline__ void phase_conv(const Args& A, const Ctx& C, int l) {
    const int j = l >> 1; const int nrows = (l <= 1) ? NR : NL;
    const bf16* P = (const bf16*)(A.ws + WS_PB); bf16* HM = (bf16*)(A.ws + WS_HM);
    const float* cw = A.in[13] + (size_t)j * 3 * D;
    for (int row = C.bid * NW + C.wave; row < nrows; row += C.G * NW) {
        bool hasl, hasr;
        if (row < NL) { const int t = row & 63; hasl = t != 0; hasr = t != 63; } else { const int t = (row - NL) & 255; hasl = t != 0; hasr = t != 255; }
        f32x4 bg[4], z[4], w0[4], w1[4], w2[4], acc[4];
        const bf16* pr = P + (size_t)row * PW;
        load_row_bf16(pr, C.lane, bg); load_row_bf16(pr + D, C.lane, z);
        load_row_f32(cw, C.lane, w0); load_row_f32(cw + D, C.lane, w1); load_row_f32(cw + 2 * D, C.lane, w2);
#pragma unroll
        for (int q = 0; q < 4; ++q) acc[q] = w1[q] * z[q];
        if (hasl) { load_row_bf16(pr - PW + D, C.lane, z);
#pragma unroll
            for (int q = 0; q < 4; ++q) acc[q] += w0[q] * z[q]; }
        if (hasr) { load_row_bf16(pr + PW + D, C.lane, z);
#pragma unroll
            for (int q = 0; q < 4; ++q) acc[q] += w2[q] * z[q]; }
#pragma unroll
        for (int q = 0; q < 4; ++q) acc[q] *= bg[q];
        store_row_bf16(HM + (size_t)row * D, C.lane, acc);
    }
}

typedef short bf16x8 __attribute__((ext_vector_type(8)));
constexpr int BM = 256, BK = 64, HALF = 128, HTB = HALF * BK * 2, STAGE_BYTES = 8 * HTB, NXCD = 8, WGM = 8;
constexpr int LDS_TAB = STAGE_BYTES;
__device__ __forceinline__ int lds_byte(int r, int c) { const int st = (r >> 4) * 2 + (c >> 5), rr = r & 15, cc = c & 31, ob = rr * 64 + cc * 2; return st * 1024 + (ob ^ (((ob >> 9) & 1) << 5)); }
__device__ __forceinline__ void stage_rc(int b, int& R, int& C) { const int st = b / 1024, sb = b % 1024, swz = sb ^ (((sb >> 9) & 1) << 5); R = (st >> 1) * 16 + swz / 64; C = (st & 1) * 32 + (swz % 64) / 2; }
__device__ __forceinline__ int perm32(int rho) { const int n = rho >> 4, i = rho & 15; return 8 * (i >> 2) + 4 * n + (i & 3); }
__device__ __forceinline__ unsigned cvt_pk_bf16(float lo, float hi) { unsigned r; asm volatile("v_cvt_pk_bf16_f32 %0, %1, %2" : "=v"(r) : "v"(lo), "v"(hi)); return r; }

struct GUnit { const char* a; const char* b; int orow, ocol, aux; };

template <class Epi, class Sched, bool GATHER>
__device__ __forceinline__ void gemm_phase(LAS unsigned char* lds, const int K, const Sched& S, const Epi& E) {
    const int tid = threadIdx.x, wid = __builtin_amdgcn_readfirstlane(tid >> 6), lane = tid & 63, wr = wid >> 2, wc = wid & 3, fr = lane & 15, fq = lane >> 4;
    const int nt = K / BK;
    unsigned voffB[2], voA[2][2], noA[2][2]; int Rr[2], Cc[2];
#pragma unroll
    for (int i = 0; i < 2; ++i) { int R, C; stage_rc(tid * 16 + i * 8192, R, C); const int Rb = (R & ~31) + perm32(R & 31); Rr[i] = R; Cc[i] = C;
        voffB[i] = (unsigned)(Rb * K + C) * 2u;
        voA[0][i] = (unsigned)(R * K + C) * 2u; voA[1][i] = (unsigned)((R + HALF) * K + C) * 2u; }
    const size_t kstep = (size_t)(BK * 2);
    const size_t hstep = (size_t)HALF * K * 2;
    const unsigned ldsw = (unsigned)wid * 1024u;
    const int aoff = lds_byte(wr * 64 + fr, fq * 8), boff = lds_byte(wc * 32 + fr, fq * 8);
#define PG8_SA(b, h) (((b) * 2 + (h)) * HTB)
#define PG8_SB(b, h) ((4 + (b) * 2 + (h)) * HTB)
#define PG8_STAGE(bufoff, gbase, voff) do { _Pragma("unroll") for (int _i = 0; _i < 2; ++_i) \
        __builtin_amdgcn_global_load_lds((const unsigned*)((const char*)(gbase) + (voff)[_i]), (LAS unsigned*)(lds + (bufoff) + ldsw + _i * 8192), 16, 0, 0); } while (0)
#define PG8_LDA(dst, b, h) do { _Pragma("unroll") for (int m = 0; m < 4; ++m) _Pragma("unroll") for (int k = 0; k < 2; ++k) dst[m][k] = *(const LAS bf16x8*)(lds + PG8_SA(b, h) + aoff + m * 2048 + k * 1024); } while (0)
#define PG8_LDB(dst, b, h) do { _Pragma("unroll") for (int n = 0; n < 2; ++n) _Pragma("unroll") for (int k = 0; k < 2; ++k) dst[n][k] = *(const LAS bf16x8*)(lds + PG8_SB(b, h) + boff + n * 2048 + k * 1024); } while (0)
#define PG8_MMA(ai, bj, At, Bt) do { __builtin_amdgcn_s_setprio(1); _Pragma("unroll") for (int m = 0; m < 4; ++m) _Pragma("unroll") for (int n = 0; n < 2; ++n) _Pragma("unroll") for (int k = 0; k < 2; ++k) \
        acc[ai][bj][m][n] = __builtin_amdgcn_mfma_f32_16x16x32_bf16(Bt[n][k], At[m][k], acc[ai][bj][m][n], 0, 0, 0); __builtin_amdgcn_s_setprio(0); } while (0)
#define PG8_WAIT_V(n) asm volatile("s_waitcnt vmcnt(" #n ")" ::: "memory")
#define PG8_WAIT_L(n) asm volatile("s_waitcnt lgkmcnt(" #n ")" ::: "memory")
#define PG8_BAR __builtin_amdgcn_s_barrier()
#define PG8_SCHED __builtin_amdgcn_sched_barrier(0)
    GUnit cur, nxt; int ui = 0;
    if (!S.next(0, cur)) return;
    if constexpr (GATHER) {
#pragma unroll
        for (int h = 0; h < 2; ++h)
#pragma unroll
            for (int i = 0; i < 2; ++i) voA[h][i] = S.arow_off(0, h * HALF + Rr[i]) + (unsigned)Cc[i] * 2u;
    }
    f32x4 acc[2][2][4][2];
#pragma unroll
    for (int a = 0; a < 2; ++a)
#pragma unroll
        for (int b = 0; b < 2; ++b)
#pragma unroll
            for (int m = 0; m < 4; ++m)
#pragma unroll
                for (int n = 0; n < 2; ++n) acc[a][b][m][n] = (f32x4){0.f, 0.f, 0.f, 0.f};
    bf16x8 At[4][2], B0[2][2], B1[2][2];
    const char* cA = cur.a; const char* cB = cur.b;
    PG8_STAGE(PG8_SB(0, 0), cB, voffB); PG8_STAGE(PG8_SB(0, 1), cB + hstep, voffB); PG8_STAGE(PG8_SA(0, 0), cA, voA[0]); PG8_STAGE(PG8_SA(0, 1), cA, voA[1]);
    if (wr == 1) PG8_BAR;
    PG8_WAIT_V(2); PG8_BAR;
    PG8_STAGE(PG8_SB(1, 0), cB + kstep, voffB); PG8_STAGE(PG8_SA(1, 0), cA + kstep, voA[0]); PG8_STAGE(PG8_SB(1, 1), cB + hstep + kstep, voffB);
    PG8_WAIT_V(6); PG8_BAR;
    for (;;) {
        const bool has_next = S.next(ui + 1, nxt);
        const char* nA = has_next ? nxt.a : cA; const char* nB = has_next ? nxt.b : cB;
        for (int t = 0; t < nt; t += 2) {
            const bool last = (t == nt - 2);
            const char* a1 = cA + (size_t)(t + 1) * kstep;
            const char* a2 = last ? nA : cA + (size_t)(t + 2) * kstep; const char* b2 = last ? nB : cB + (size_t)(t + 2) * kstep;
            const char* a3 = a2 + kstep; const char* b3 = b2 + kstep;
            unsigned sA[2][2];
            if constexpr (GATHER) {
                if (last) {
#pragma unroll
                    for (int h = 0; h < 2; ++h)
#pragma unroll
                        for (int i = 0; i < 2; ++i) noA[h][i] = has_next ? S.arow_off(ui + 1, h * HALF + Rr[i]) + (unsigned)Cc[i] * 2u : voA[h][i];
                }
#pragma unroll
                for (int h = 0; h < 2; ++h)
#pragma unroll
                    for (int i = 0; i < 2; ++i) sA[h][i] = last ? noA[h][i] : voA[h][i];
            } else {
#pragma unroll
                for (int h = 0; h < 2; ++h)
#pragma unroll
                    for (int i = 0; i < 2; ++i) sA[h][i] = voA[h][i];
            }
            PG8_LDB(B0, 0, 0); PG8_LDB(B1, 0, 1); PG8_SCHED; PG8_LDA(At, 0, 0); PG8_STAGE(PG8_SA(1, 1), a1, voA[1]);
            PG8_WAIT_V(8); PG8_WAIT_L(0); PG8_BAR; PG8_MMA(0, 0, At, B0); PG8_MMA(0, 1, At, B1); PG8_BAR; PG8_SCHED;
            PG8_LDA(At, 0, 1); PG8_STAGE(PG8_SB(0, 0), b2, voffB); PG8_STAGE(PG8_SB(0, 1), b2 + hstep, voffB); PG8_STAGE(PG8_SA(0, 0), a2, sA[0]);
            PG8_WAIT_V(8); PG8_WAIT_L(0); PG8_BAR; PG8_MMA(1, 0, At, B0); PG8_MMA(1, 1, At, B1); PG8_BAR; PG8_SCHED;
            PG8_LDB(B0, 1, 0); PG8_LDB(B1, 1, 1); PG8_SCHED; PG8_LDA(At, 1, 0); PG8_STAGE(PG8_SA(0, 1), a2, sA[1]);
            PG8_WAIT_V(8); PG8_WAIT_L(0); PG8_BAR; PG8_MMA(0, 0, At, B0); PG8_MMA(0, 1, At, B1); PG8_BAR; PG8_SCHED;
            PG8_LDA(At, 1, 1); PG8_STAGE(PG8_SB(1, 0), b3, voffB); PG8_STAGE(PG8_SB(1, 1), b3 + hstep, voffB); PG8_STAGE(PG8_SA(1, 0), a3, sA[0]);
            PG8_WAIT_V(8); PG8_WAIT_L(0); PG8_BAR; PG8_MMA(1, 0, At, B0); PG8_MMA(1, 1, At, B1); PG8_BAR; PG8_SCHED;
        }
        if (wr == 0) PG8_BAR;
        E(acc, cur, wr, wc, fr, fq);
        if (!has_next) break;
#pragma unroll
        for (int a = 0; a < 2; ++a)
#pragma unroll
            for (int b = 0; b < 2; ++b)
#pragma unroll
                for (int m = 0; m < 4; ++m)
#pragma unroll
                    for (int n = 0; n < 2; ++n) acc[a][b][m][n] = (f32x4){0.f, 0.f, 0.f, 0.f};
        cur = nxt; cA = nA; cB = nB; ++ui;
        if constexpr (GATHER) {
#pragma unroll
            for (int h = 0; h < 2; ++h)
#pragma unroll
                for (int i = 0; i < 2; ++i) voA[h][i] = noA[h][i];
        }
        if (wr == 1) PG8_BAR;
    }
    PG8_WAIT_V(0);
    PG8_BAR;
#undef PG8_SA
#undef PG8_SB
#undef PG8_STAGE
#undef PG8_LDA
#undef PG8_LDB
#undef PG8_MMA
#undef PG8_WAIT_V
#undef PG8_WAIT_L
#undef PG8_BAR
#undef PG8_SCHED
}

__device__ __forceinline__ int xcd_remap(int L, int nwg) { const int q = nwg / NXCD, r = nwg % NXCD, xcd = L % NXCD, off = L / NXCD; return (xcd < r ? xcd * (q + 1) : r * (q + 1) + (xcd - r) * q) + off; }

struct DenseSched {
    const char* A; const char* Bt; int nM, nN, nwg, G, c; size_t tstep;
    __device__ __forceinline__ void init(const void* A_, const void* Bt_, int M, int N, int K, int G_, int c_) { A = (const char*)A_; Bt = (const char*)Bt_; nM = M / BM; nN = N / BM; nwg = nM * nN; G = G_; c = c_; tstep = (size_t)BM * K * 2; }
    __device__ __forceinline__ bool next(int i, GUnit& u) const {
        const long L = (long)i * G + c; if (L >= nwg) return false;
        const int wgid = xcd_remap((int)L, nwg);
        const int nig = WGM * nN, gid = wgid / nig, fm = gid * WGM, gsz = (nM - fm) < WGM ? (nM - fm) : WGM;
        const int pm = fm + ((wgid % nig) % gsz), pn = (wgid % nig) / gsz;
        u.a = A + (size_t)pm * tstep; u.b = Bt + (size_t)pn * tstep; u.orow = pm * BM; u.ocol = pn * BM; u.aux = pn; return true;
    }
    __device__ __forceinline__ unsigned arow_off(int, int) const { return 0u; }
};

constexpr int MAXU = 12;
struct MoeTab { int n; int e[MAXU], mb[MAXU], nt[MAXU]; int sb[NE + 1]; };
struct MoeSched {
    LAS const MoeTab* T; LAS const unsigned* ridx;
    const char* A; const char* W; size_t wstride_e, tstepB; int K; int arow_bytes;
    __device__ __forceinline__ bool next(int i, GUnit& u) const {
        const int n = __builtin_amdgcn_readfirstlane(T->n); if (i >= n) return false;
        const int e = __builtin_amdgcn_readfirstlane(T->e[i]), mb = __builtin_amdgcn_readfirstlane(T->mb[i]), nt = __builtin_amdgcn_readfirstlane(T->nt[i]);
        const int base = __builtin_amdgcn_readfirstlane(T->sb[e]);
        u.orow = base + mb * BM; u.ocol = nt; u.aux = e;
        u.a = A + (size_t)u.orow * arow_bytes;
        u.b = W + (size_t)e * wstride_e + (size_t)nt * tstepB; return true;
    }
    __device__ __forceinline__ unsigned arow_off(int i, int r) const { return ridx[i * 256 + r]; }
};
template <bool GATHER>
__device__ __forceinline__ void moe_tables(const Args& A, const Ctx& C, int l, int ntile_n, LAS MoeTab* T, LAS unsigned* ridx, int arow_bytes) {
    const unsigned* cnt = (const unsigned*)(A.ws + WS_CTL) + CW_CNT + l * 32;
    LAS int* ust = (LAS int*)(T + 1);
    if (C.tid == 0) { int acc = 0, ua = 0; for (int e = 0; e < NE; ++e) { T->sb[e] = acc; ust[e] = ua; const int nb = ((int)cnt[e] + 255) / 256; acc += nb * 256; ua += nb * ntile_n; } T->sb[NE] = acc; ust[NE] = ua;
        const int nwg = ua; int n = 0;
        for (int i = 0; i < MAXU; ++i) { const long L = (long)i * C.G + C.bid; if (L >= nwg) break; const int w = xcd_remap((int)L, nwg); int e = 0; while (w >= ust[e + 1]) ++e;
            const int lu = w - ust[e]; T->e[i] = e; T->mb[i] = lu / ntile_n; T->nt[i] = lu % ntile_n; ++n; }
        T->n = n; }
    __syncthreads();
    if constexpr (GATHER) {
        const int* ST = (const int*)(A.ws + WS_SLOTTOK); const int n = T->n;
        for (int i = C.tid; i < n * 256; i += NT) { const int ui = i >> 8, r = i & 255, e = T->e[ui], m0 = T->mb[ui] * 256, ce = (int)cnt[e];
            const int rr = (m0 + r < ce) ? m0 + r : ce - 1;
            ridx[i] = (unsigned)ST[(size_t)e * CAP + rr] * (unsigned)arow_bytes; }
        __syncthreads();
    }
}

struct EpiStore { bf16* O; int ldc; float scale_lo; int sig_from;
    __device__ __forceinline__ void operator()(const f32x4 (&acc)[2][2][4][2], const GUnit& u, int wr, int wc, int fr, int fq) const {
        const float sc = (u.ocol < NQ) ? scale_lo : 1.0f; const bool sg = u.ocol >= sig_from;
#pragma unroll
        for (int ai = 0; ai < 2; ++ai)
#pragma unroll
            for (int m = 0; m < 4; ++m) { bf16* rowp = O + (size_t)(u.orow + ai * HALF + wr * 64 + m * 16 + fr) * ldc + u.ocol + wc * 32 + 8 * fq;
#pragma unroll
                for (int bj = 0; bj < 2; ++bj) { f32x4 v0 = acc[ai][bj][m][0] * sc, v1 = acc[ai][bj][m][1] * sc;
                    if (sg) {
#pragma unroll
                        for (int q = 0; q < 4; ++q) { v0[q] = __builtin_amdgcn_rcpf(1.0f + __expf(-v0[q])); v1[q] = __builtin_amdgcn_rcpf(1.0f + __expf(-v1[q])); } }
                    u32x4 w; w.x = cvt_pk_bf16(v0[0], v0[1]); w.y = cvt_pk_bf16(v0[2], v0[3]); w.z = cvt_pk_bf16(v1[0], v1[1]); w.w = cvt_pk_bf16(v1[2], v1[3]);
                    *(u32x4*)(rowp + bj * HALF) = w; } }
    }
};
template <int MODE> struct EpiPair { bf16* O; int ldc; int plain_below;
    __device__ __forceinline__ void operator()(const f32x4 (&acc)[2][2][4][2], const GUnit& u, int wr, int wc, int fr, int fq) const {
        if (MODE == 0 && u.ocol < plain_below) {
#pragma unroll
            for (int ai = 0; ai < 2; ++ai)
#pragma unroll
                for (int m = 0; m < 4; ++m) { bf16* rowp = O + (size_t)(u.orow + ai * HALF + wr * 64 + m * 16 + fr) * ldc + u.ocol + wc * 32 + 8 * fq;
#pragma unroll
                    for (int bj = 0; bj < 2; ++bj) { const f32x4 v0 = acc[ai][bj][m][0], v1 = acc[ai][bj][m][1];
                        u32x4 w; w.x = cvt_pk_bf16(v0[0], v0[1]); w.y = cvt_pk_bf16(v0[2], v0[3]); w.z = cvt_pk_bf16(v1[0], v1[1]); w.w = cvt_pk_bf16(v1[2], v1[3]);
                        *(u32x4*)(rowp + bj * HALF) = w; } }
            return;
        }
        const int ocol = (MODE == 0) ? plain_below + (u.ocol - plain_below) / 2 : u.ocol * HALF;
#pragma unroll
        for (int ai = 0; ai < 2; ++ai)
#pragma unroll
            for (int m = 0; m < 4; ++m) { bf16* rowp = O + (size_t)(u.orow + ai * HALF + wr * 64 + m * 16 + fr) * ldc + ocol + wc * 32 + 8 * fq;
                f32x4 v0, v1;
#pragma unroll
                for (int q = 0; q < 4; ++q) {
                    const float x0 = acc[ai][0][m][0][q], x1 = acc[ai][0][m][1][q];
                    const float g0 = (MODE == 1) ? x0 * __builtin_amdgcn_rcpf(1.0f + __expf(-x0)) : x0, g1 = (MODE == 1) ? x1 * __builtin_amdgcn_rcpf(1.0f + __expf(-x1)) : x1;
                    v0[q] = g0 * acc[ai][1][m][0][q]; v1[q] = g1 * acc[ai][1][m][1][q]; }
                u32x4 w; w.x = cvt_pk_bf16(v0[0], v0[1]); w.y = cvt_pk_bf16(v0[2], v0[3]); w.z = cvt_pk_bf16(v1[0], v1[1]); w.w = cvt_pk_bf16(v1[2], v1[3]);
                *(u32x4*)rowp = w; }
    }
};
struct EpiStoreTile { bf16* O; int ldc;
    __device__ __forceinline__ void operator()(const f32x4 (&acc)[2][2][4][2], const GUnit& u, int wr, int wc, int fr, int fq) const {
#pragma unroll
        for (int ai = 0; ai < 2; ++ai)
#pragma unroll
            for (int m = 0; m < 4; ++m) { bf16* rowp = O + (size_t)(u.orow + ai * HALF + wr * 64 + m * 16 + fr) * ldc + u.ocol * BM + wc * 32 + 8 * fq;
#pragma unroll
                for (int bj = 0; bj < 2; ++bj) { const f32x4 v0 = acc[ai][bj][m][0], v1 = acc[ai][bj][m][1];
                    u32x4 w; w.x = cvt_pk_bf16(v0[0], v0[1]); w.y = cvt_pk_bf16(v0[2], v0[3]); w.z = cvt_pk_bf16(v1[0], v1[1]); w.w = cvt_pk_bf16(v1[2], v1[3]);
                    *(u32x4*)(rowp + bj * HALF) = w; } }
    }
};

__device__ __forceinline__ void transpose_item(const float* W, int ldw, int K, bf16* WT, int drow0, int k0, int n0, LAS float* scr, int lane) {
#pragma unroll 8
    for (int i = 0; i < 32; ++i) { const int kk = 2 * i + (lane >> 5); scr[kk * 33 + (lane & 31)] = W[(size_t)(k0 + kk) * ldw + n0 + (lane & 31)]; }
    asm volatile("s_waitcnt lgkmcnt(0)" ::: "memory");
    const int c = lane & 7;
#pragma unroll
    for (int j = 0; j < 4; ++j) { const int n = (lane >> 3) + 8 * j; const LAS float* s = scr + (8 * c) * 33 + n;
        u32x4 o; o.x = pk2(s[0 * 33], s[1 * 33]); o.y = pk2(s[2 * 33], s[3 * 33]); o.z = pk2(s[4 * 33], s[5 * 33]); o.w = pk2(s[6 * 33], s[7 * 33]);
        *(u32x4*)(WT + (size_t)(drow0 + n) * K + k0 + 8 * c) = o; }
    asm volatile("s_waitcnt lgkmcnt(0)" ::: "memory");
}
__device__ __forceinline__ int pair_row(int n, int which) { return (n >> 7) * 256 + (n & 127) + which * 128; }
__device__ __forceinline__ void phase_cvt_mixer(const Args& A, const Ctx& C) {
    LAS float* scr = (LAS float*)(C.lds + 16384 + C.wave * 16384);
    const int gw = C.bid * NW + C.wave, NGW = C.G * NW;
    constexpr int I_IN = (D / 64) * (PW / 32), I_OUT = (D / 64) * (D / 32), PER = 2 * (I_IN + I_OUT);
    for (int it = gw; it < 2 * PER; it += NGW) {
        const int kind = it / PER; int r = it % PER; const int j = r / (I_IN + I_OUT); r %= (I_IN + I_OUT);
        if (r < I_IN) { const int kb = r / (PW / 32), nb = r % (PW / 32), n0 = nb * 32;
            bf16* WT = (bf16*)(A.ws + (kind == 0 ? WS_WAIN : WS_WBIN)) + (size_t)j * PW * D;
            if (kind == 0) transpose_item(A.in[8] + (size_t)j * D * PROJ, PROJ, D, WT, n0, kb * 64, n0, scr, C.lane);
            else { const int drow = n0 < D ? n0 : (n0 < 2 * D ? D + pair_row(n0 - D, 0) : D + pair_row(n0 - 2 * D, 1));
                transpose_item(A.in[12] + (size_t)j * D * PW, PW, D, WT, drow, kb * 64, n0, scr, C.lane); } }
        else { r -= I_IN; const int kb = r / (D / 32), nb = r % (D / 32), n0 = nb * 32;
            bf16* WT = (bf16*)(A.ws + (kind == 0 ? WS_WAOUT : WS_WBOUT)) + (size_t)j * D * D;
            transpose_item((kind == 0 ? A.in[11] : A.in[14]) + (size_t)j * D * D, D, D, WT, n0, kb * 64, n0, scr, C.lane); }
    }
}
__device__ __forceinline__ void phase_cvt_moe(const Args& A, const Ctx& C, int l) {
    LAS float* scr = (LAS float*)(C.lds + 16384 + C.wave * 16384);
    const int gw = C.bid * NW + C.wave, NGW = C.G * NW;
    constexpr int I_G = (D / 64) * (DE / 32), I_D = (DE / 64) * (D / 32), PER = 2 * I_G + I_D;
    bf16* WGU = (bf16*)(A.ws + WS_WGU); bf16* WDN = (bf16*)(A.ws + WS_WDN);
    for (int it = gw; it < NE * PER; it += NGW) {
        const int e = it / PER; int r = it % PER;
        if (r < 2 * I_G) { const int which = r / I_G; r %= I_G; const int kb = r / (DE / 32), nb = r % (DE / 32), n0 = nb * 32;
            transpose_item((which == 0 ? A.in[19] : A.in[20]) + ((size_t)l * NE + e) * D * DE, DE, D, WGU + (size_t)e * 2 * DE * D, pair_row(n0, which), kb * 64, n0, scr, C.lane); }
        else { r -= 2 * I_G; const int kb = r / (D / 32), nb = r % (D / 32), n0 = nb * 32;
            transpose_item(A.in[21] + ((size_t)l * NE + e) * DE * D, D, DE, WDN + (size_t)e * D * DE, n0, kb * 64, n0, scr, C.lane); }
    }
}

__device__ __forceinline__ void phase_g1(const Args& A, const Ctx& C, int l) {
    const bool mls = (l & 1) == 0; const int j = l >> 1; const int nrows = (l <= 2) ? NR : NL;
    DenseSched S; S.init(A.ws + WS_HB, A.ws + (mls ? WS_WAIN : WS_WBIN) + (size_t)j * PW * D * 2, nrows, PW, D, C.G, C.bid);
    if (mls) { EpiStore E{(bf16*)(A.ws + WS_PB), PW, 0.08838834764831845f, 2 * NQ + NV}; gemm_phase<EpiStore, DenseSched, false>(C.lds, D, S, E); }
    else { EpiPair<0> E{(bf16*)(A.ws + WS_PB), PW, D}; gemm_phase<EpiPair<0>, DenseSched, false>(C.lds, D, S, E); }
}
__device__ __forceinline__ void phase_g2(const Args& A, const Ctx& C, int l) {
    const bool mls = (l & 1) == 0; const int j = l >> 1; const int nrows = (l <= 1) ? NR : NL;
    DenseSched S; S.init(A.ws + WS_HM, A.ws + (mls ? WS_WAOUT : WS_WBOUT) + (size_t)j * D * D * 2, nrows, D, D, C.G, C.bid);
    EpiStore E{(bf16*)(A.ws + WS_HB), D, 1.0f, 1 << 30}; gemm_phase<EpiStore, DenseSched, false>(C.lds, D, S, E);
}
__device__ __forceinline__ void phase_m1(const Args& A, const Ctx& C, int l) {
    LAS MoeTab* T = (LAS MoeTab*)(C.lds + LDS_TAB); LAS unsigned* ridx = (LAS unsigned*)(C.lds + LDS_TAB + 1024);
    moe_tables<true>(A, C, l, 4, T, ridx, D * 2);
    MoeSched S; S.T = T; S.ridx = ridx; S.A = (const char*)(A.ws + WS_HB); S.W = (const char*)(A.ws + WS_WGU); S.wstride_e = (size_t)2 * DE * D * 2; S.tstepB = (size_t)BM * D * 2; S.K = D; S.arow_bytes = 0;
    EpiPair<1> E{(bf16*)(A.ws + WS_DC), DE, 0}; gemm_phase<EpiPair<1>, MoeSched, true>(C.lds, D, S, E);
}
__device__ __forceinline__ void phase_m2(const Args& A, const Ctx& C, int l) {
    LAS MoeTab* T = (LAS MoeTab*)(C.lds + LDS_TAB); LAS unsigned* ridx = (LAS unsigned*)(C.lds + LDS_TAB + 1024);
    moe_tables<false>(A, C, l, 4, T, ridx, DE * 2);
    MoeSched S; S.T = T; S.ridx = ridx; S.A = (const char*)(A.ws + WS_DC); S.W = (const char*)(A.ws + WS_WDN); S.wstride_e = (size_t)D * DE * 2; S.tstepB = (size_t)BM * DE * 2; S.K = DE; S.arow_bytes = DE * 2;
    EpiStoreTile E{(bf16*)(A.ws + WS_PB), D}; gemm_phase<EpiStoreTile, MoeSched, false>(C.lds, DE, S, E);
}

__device__ __forceinline__ void block_gates(const Args& A, int row0, int h, LAS float* bf, LAS float* bb, LAS float* lif, LAS float* lib, int tid) {
    const float* GATE = (const float*)(A.ws + WS_GATE);
    if (tid < 256) { const float* g = GATE + (size_t)(row0 + tid) * 16; lif[tid] = g[0 + h]; bf[tid] = g[4 + h]; lib[tid] = g[8 + h]; bb[tid] = g[12 + h]; }
    __syncthreads();
    if (tid == 0) { float s = 0.f; for (int i = 0; i < 256; ++i) { s += bf[i]; bf[i] = s; } }
    if (tid == 64) { float s = 0.f; for (int i = 255; i >= 0; --i) { s += bb[i]; bb[i] = s; } }
    __syncthreads();
}
__device__ __forceinline__ void phase_s1(const Args& A, const Ctx& C, int l) {
    LAS float* bf = (LAS float*)C.lds; LAS float* bb = bf + 256; LAS float* lif = bb + 256; LAS float* lib = lif + 256; LAS float* af = lib + 256; LAS float* ab = af + 256;
    const bf16* P = (const bf16*)(A.ws + WS_PB);
    float* DC = (float*)(A.ws + WS_DC); float* DN = (float*)(A.ws + WS_DN); float* BT = (float*)(A.ws + WS_BTOT);
    for (int u = C.bid; u < NUNIT; u += C.G) {
        const int blk = u % NBLK, bh = u / NBLK, h = bh % NH, b = bh / NH; const int row0 = blk_row0(b, blk);
        block_gates(A, row0, h, bf, bb, lif, lib, C.tid);
        if (C.tid < 256) { af[C.tid] = __expf(bf[255] - bf[C.tid] + lif[C.tid]); ab[C.tid] = __expf(bb[0] - bb[C.tid] + lib[C.tid]); }
        if (C.tid == 0) { BT[u * 2 + 0] = bf[255]; BT[u * 2 + 1] = bb[0]; }
        __syncthreads();
        const int dg = C.tid >> 5, eg = C.tid & 31;
        float cf[8][8], cb[8][8], nf[8], nb[8];
#pragma unroll
        for (int i = 0; i < 8; ++i) { nf[i] = 0.f; nb[i] = 0.f;
#pragma unroll
            for (int q = 0; q < 8; ++q) { cf[i][q] = 0.f; cb[i][q] = 0.f; } }
#pragma unroll 2
        for (int s = 0; s < 256; ++s) {
            const bf16* pr = P + (size_t)(row0 + s) * PW;
            const u32x4 kv = *(const u32x4*)(pr + NQ + h * DQK + dg * 8); const u32x4 vv = *(const u32x4*)(pr + 2 * NQ + h * DV + eg * 8);
            float kk[8], ve[8];
#pragma unroll
            for (int i = 0; i < 4; ++i) { kk[2 * i] = __uint_as_float(kv[i] << 16); kk[2 * i + 1] = __uint_as_float(kv[i] & 0xffff0000u); ve[2 * i] = __uint_as_float(vv[i] << 16); ve[2 * i + 1] = __uint_as_float(vv[i] & 0xffff0000u); }
            const float wf = af[s], wb = ab[s];
#pragma unroll
            for (int i = 0; i < 8; ++i) { const float kf = kk[i] * wf, kb = kk[i] * wb; nf[i] += kf; nb[i] += kb;
#pragma unroll
                for (int q = 0; q < 8; ++q) { cf[i][q] += kf * ve[q]; cb[i][q] += kb * ve[q]; } }
        }
        float* dcf = DC + (size_t)(u * 2 + 0) * DQK * DV; float* dcb = DC + (size_t)(u * 2 + 1) * DQK * DV;
#pragma unroll
        for (int i = 0; i < 8; ++i) {
            *(f32x4*)(dcf + (dg * 8 + i) * DV + eg * 8) = (f32x4){cf[i][0], cf[i][1], cf[i][2], cf[i][3]}; *(f32x4*)(dcf + (dg * 8 + i) * DV + eg * 8 + 4) = (f32x4){cf[i][4], cf[i][5], cf[i][6], cf[i][7]};
            *(f32x4*)(dcb + (dg * 8 + i) * DV + eg * 8) = (f32x4){cb[i][0], cb[i][1], cb[i][2], cb[i][3]}; *(f32x4*)(dcb + (dg * 8 + i) * DV + eg * 8 + 4) = (f32x4){cb[i][4], cb[i][5], cb[i][6], cb[i][7]};
            if (eg == 0) { DN[(size_t)(u * 2 + 0) * DQK + dg * 8 + i] = nf[i]; DN[(size_t)(u * 2 + 1) * DQK + dg * 8 + i] = nb[i]; }
        }
        __syncthreads();
    }
}
__device__ __forceinline__ void phase_s2(const Args& A, const Ctx& C) {
    const float* DC = (const float*)(A.ws + WS_DC); const float* DN = (const float*)(A.ws + WS_DN); const float* BT = (const float*)(A.ws + WS_BTOT);
    float* CST = (float*)(A.ws + WS_CST); float* NST = (float*)(A.ws + WS_NST);
    const int EL = DQK * DV + DQK;
    for (long i = (long)C.bid * NT + C.tid; i < (long)BATCH * NH * 2 * EL; i += (long)C.G * NT) {
        const int el = (int)(i % EL), ch = (int)(i / EL), dir = ch & 1, bh = ch >> 1;
        float st = 0.f;
        for (int idx = 0; idx < NBLK; ++idx) {
            const int blk = dir == 0 ? idx : (idx == 0 ? 0 : NBLK - idx);
            const int u = bh * NBLK + blk;
            const float dec = __expf(BT[u * 2 + dir]);
            if (el < DQK * DV) { CST[(size_t)(u * 2 + dir) * DQK * DV + el] = st; st = dec * st + DC[(size_t)(u * 2 + dir) * DQK * DV + el]; }
            else { NST[(size_t)(u * 2 + dir) * DQK + (el - DQK * DV)] = st; st = dec * st + DN[(size_t)(u * 2 + dir) * DQK + (el - DQK * DV)]; }
        }
    }
}
__device__ __forceinline__ void phase_s3(const Args& A, const Ctx& C, int l) {
    const int j = l >> 1;
    LAS float* bf = (LAS float*)C.lds; LAS float* bb = bf + 256; LAS float* lif = bb + 256; LAS float* lib = lif + 256;
    LAS float* den = lib + 256;
    LAS float* qs = den + 64;
    LAS float* Pf = qs + 32 * 128;
    LAS float* Pb = Pf + 32 * 256;
    LAS float* hr = Pb + 32 * 256;
    const bf16* P = (const bf16*)(A.ws + WS_PB); bf16* HM = (bf16*)(A.ws + WS_HM);
    const float* CST = (const float*)(A.ws + WS_CST); const float* NST = (const float*)(A.ws + WS_NST);
    const float* hg = A.in[10] + (size_t)j * NV;
    const bool ctx_out = (l == 0);
    for (int u = C.bid; u < NUNIT; u += C.G) {
        const int blk = u % NBLK, bh = u / NBLK, h = bh % NH, b = bh / NH; const int row0 = blk_row0(b, blk);
        if (blk == 0 && !ctx_out) continue;
        block_gates(A, row0, h, bf, bb, lif, lib, C.tid);
        const float* Cf = CST + (size_t)(u * 2 + 0) * DQK * DV; const float* Cb = CST + (size_t)(u * 2 + 1) * DQK * DV;
        const float* Nf = NST + (size_t)(u * 2 + 0) * DQK; const float* Nb = NST + (size_t)(u * 2 + 1) * DQK;
        for (int jt = 0; jt < 8; ++jt) {
            const int j0 = jt * 32;
            for (int i = C.tid; i < 32 * 128; i += NT) { const int r = i >> 7, d = i & 127; qs[i] = bf2f(P[(size_t)(row0 + j0 + r) * PW + h * DQK + d]); }
            __syncthreads();
            { const int r = C.tid >> 4, sg = C.tid & 15, jj = j0 + r;
#pragma unroll 1
              for (int i = 0; i < 16; ++i) { const int s = sg + 16 * i; const bf16* kr = P + (size_t)(row0 + s) * PW + NQ + h * DQK; float dot = 0.f;
#pragma unroll
                  for (int d8 = 0; d8 < 16; ++d8) { const u32x4 kv = *(const u32x4*)(kr + d8 * 8);
#pragma unroll
                      for (int q = 0; q < 4; ++q) dot += qs[r * 128 + d8 * 8 + 2 * q] * __uint_as_float(kv[q] << 16) + qs[r * 128 + d8 * 8 + 2 * q + 1] * __uint_as_float(kv[q] & 0xffff0000u); }
                  const float wf = (s <= jj) ? __expf(bf[jj] - bf[s] + lif[s]) : 0.f; const float wb = (s >= jj) ? __expf(bb[jj] - bb[s] + lib[s]) : 0.f;
                  Pf[r * 256 + s] = dot * wf; Pb[r * 256 + s] = dot * wb; } }
            __syncthreads();
            if (C.tid < 64) { const int r = C.tid >> 1, dir = C.tid & 1, jj = j0 + r; LAS const float* pp = (dir ? Pb : Pf) + r * 256; float s = 0.f;
                for (int i = 0; i < 256; ++i) s += pp[i];
                const float* nn = dir ? Nb : Nf; float qn = 0.f;
                for (int d = 0; d < 128; ++d) qn += qs[r * 128 + d] * nn[d];
                den[dir * 32 + r] = s + __expf(dir ? bb[jj] : bf[jj]) * qn; }
            __syncthreads();
            { const int r = C.tid >> 4, eg = C.tid & 15, jj = j0 + r;
              float af[16], ab[16], cf[16], cb[16];
#pragma unroll
              for (int q = 0; q < 16; ++q) { af[q] = 0.f; ab[q] = 0.f; cf[q] = 0.f; cb[q] = 0.f; }
#pragma unroll 2
              for (int s = 0; s < 256; ++s) { const float pf = Pf[r * 256 + s], pb = Pb[r * 256 + s]; const bf16* vr = P + (size_t)(row0 + s) * PW + 2 * NQ + h * DV + eg * 16;
                  const u32x4 v0 = *(const u32x4*)vr, v1 = *(const u32x4*)(vr + 8);
#pragma unroll
                  for (int q = 0; q < 4; ++q) { const float a = __uint_as_float(v0[q] << 16), c = __uint_as_float(v0[q] & 0xffff0000u), e = __uint_as_float(v1[q] << 16), g = __uint_as_float(v1[q] & 0xffff0000u);
                      af[2 * q] += pf * a; af[2 * q + 1] += pf * c; af[8 + 2 * q] += pf * e; af[8 + 2 * q + 1] += pf * g;
                      ab[2 * q] += pb * a; ab[2 * q + 1] += pb * c; ab[8 + 2 * q] += pb * e; ab[8 + 2 * q + 1] += pb * g; } }
#pragma unroll 2
              for (int d = 0; d < 128; ++d) { const float qd = qs[r * 128 + d];
#pragma unroll
                  for (int q4 = 0; q4 < 4; ++q4) { const f32x4 x = *(const f32x4*)(Cf + d * DV + eg * 16 + q4 * 4), y = *(const f32x4*)(Cb + d * DV + eg * 16 + q4 * 4);
#pragma unroll
                      for (int q = 0; q < 4; ++q) { cf[q4 * 4 + q] += qd * x[q]; cb[q4 * 4 + q] += qd * y[q]; } } }
              const float ef = __expf(bf[jj]), eb = __expf(bb[jj]);
              const float rf = 1.0f / fmaxf(fabsf(den[r]), 1.0f), rb = 1.0f / fmaxf(fabsf(den[32 + r]), 1.0f);
#pragma unroll
              for (int q = 0; q < 16; ++q) hr[r * 256 + eg * 16 + q] = (af[q] + ef * cf[q]) * rf + (ab[q] + eb * cb[q]) * rb; }
            __syncthreads();
            for (int rr = 0; rr < 4; ++rr) { const int r = C.wave * 4 + rr; const size_t row = (size_t)(row0 + j0 + r);
                const f32x4 x = *(const LAS f32x4*)(hr + r * 256 + C.lane * 4);
                const float ss = wave_sum((x.x * x.x + x.y * x.y) + (x.z * x.z + x.w * x.w));
                const float rs = 1.0f / sqrtf(ss * (1.0f / DV) + EPS);
                const f32x4 g = *(const f32x4*)(hg + h * DV + C.lane * 4);
                const u32x2 ow = *(const u32x2*)(P + row * PW + 2 * NQ + NV + h * DV + C.lane * 4);
                const f32x4 o = (f32x4){__uint_as_float(ow.x << 16), __uint_as_float(ow.x & 0xffff0000u), __uint_as_float(ow.y << 16), __uint_as_float(ow.y & 0xffff0000u)};
                const f32x4 y = x * rs * g * o;
                u32x2 w; w.x = pk2(y.x, y.y); w.y = pk2(y.z, y.w); *(u32x2*)(HM + row * D + h * DV + C.lane * 4) = w; }
            __syncthreads();
        }
    }
}

#define XB_TMO      128
#define XB_XCNT(j)  (256  + 64 * (j))
#define XB_XSUB(j)  (1280 + 64 * (j))
#define XB_XGEN(j)  (2304 + 64 * (j))
#define XB_TOP      3328
#define XB_TOPGEN   3392
#define XCD_BAR_WORDS 3456
#define XB_SPIN_CAP (1u << 18)

__device__ __forceinline__ unsigned xb_ld(unsigned* p)              { return __hip_atomic_load(p, __ATOMIC_RELAXED, __HIP_MEMORY_SCOPE_AGENT); }
__device__ __forceinline__ unsigned xb_add(unsigned* p, unsigned v) { return __hip_atomic_fetch_add(p, v, __ATOMIC_RELAXED, __HIP_MEMORY_SCOPE_AGENT); }
__device__ __forceinline__ unsigned xb_xcc_id() { return (unsigned)__builtin_amdgcn_s_getreg((3 << 11) | 20) & 0xFu; }
#define XB_SPIN(cond, bar) do { unsigned _sp = 0; while (cond) { __builtin_amdgcn_s_sleep(1); \
    if ((++_sp & 255u) == 0u) { if (xb_ld(&(bar)[XB_TMO])) break; if (_sp > XB_SPIN_CAP) { atomicAdd(&(bar)[XB_TMO], 1u); break; } } } } while (0)

struct XcdBarrier {
    unsigned* bar; unsigned x;
    volatile LAS unsigned* st;
};

__device__ __forceinline__ XcdBarrier xcd_barrier_post(unsigned* bar, volatile LAS unsigned* st) {
    XcdBarrier b; b.bar = bar; b.x = xb_xcc_id(); b.st = st;
    if (threadIdx.x == 0) (void)xb_add(&bar[XB_XCNT(b.x)], 1u);
    return b;
}
__device__ __forceinline__ void xcd_barrier_complete(unsigned* bar, unsigned x, unsigned& nloc, unsigned& nx) {
    const unsigned G = gridDim.x * gridDim.y * gridDim.z;
    unsigned sum, cnt, mine, sp = 0u;
    for (;;) {
        sum = 0u; cnt = 0u; mine = 0u;
#pragma unroll
        for (unsigned j = 0; j < 16; ++j) { const unsigned c = xb_ld(&bar[XB_XCNT(j)]); sum += c; cnt += (c > 0u) ? 1u : 0u; mine = (j == x) ? c : mine; }
        if (sum == G) break;
        __builtin_amdgcn_s_sleep(1);
        if ((++sp & 255u) == 0u) { if (xb_ld(&bar[XB_TMO])) break; if (sp > XB_SPIN_CAP) { atomicAdd(&bar[XB_TMO], 1u); break; } }
    }
    nloc = mine > 0u ? mine : 1u; nx = cnt > 0u ? cnt : 1u;
}

__device__ __forceinline__ void xcd_barrier(const XcdBarrier& b) {
    asm volatile("s_waitcnt vmcnt(0)" ::: "memory");
    __syncthreads();
    if (threadIdx.x == 0) {
        unsigned* bar = b.bar;
        __builtin_amdgcn_s_waitcnt(0);
        unsigned nloc = b.st[0], nx = b.st[1];
        if (nloc == 0u) { xcd_barrier_complete(bar, b.x, nloc, nx); b.st[0] = nloc; b.st[1] = nx; }
        const unsigned old = xb_add(&bar[XB_XSUB(b.x)], 1u);
        const unsigned gen = old / nloc;
        if (old + 1u == (gen + 1u) * nloc) {
            __builtin_amdgcn_fence(__ATOMIC_RELEASE, "agent");
            asm volatile("s_waitcnt vmcnt(0)" ::: "memory");
            const unsigned og = xb_add(&bar[XB_TOP], 1u);
            const unsigned tg = og / nx;
            if (og + 1u == (tg + 1u) * nx) xb_add(&bar[XB_TOPGEN], 1u);
            else XB_SPIN(xb_ld(&bar[XB_TOPGEN]) == tg, bar);
            __builtin_amdgcn_fence(__ATOMIC_ACQUIRE, "agent");
            xb_add(&bar[XB_XGEN(b.x)], 1u);
            asm volatile("s_waitcnt vmcnt(0)" ::: "memory");
        } else {
            XB_SPIN(xb_ld(&bar[XB_XGEN(b.x)]) == gen, bar);
            __builtin_amdgcn_fence(__ATOMIC_ACQUIRE, "agent");
            asm volatile("s_waitcnt vmcnt(0)" ::: "memory");
        }
    }
    __syncthreads();
}


constexpr int LDS_BYTES = 152 * 1024;
constexpr int CW_BAR = 8192;
static_assert((CW_BAR + XCD_BAR_WORDS) * 4 <= (int)CTL_BYTES, "ctl");
#ifndef MK_MULTI
#define MK_MULTI 0
#endif
#define IN(p) (lo <= (p) && (p) < hi)
#define SEAM(p) do { if ((p) + 1 < hi) xcd_barrier(bar); } while (0)
template <int L> __device__ __forceinline__ void layer_phases(const Args& args, const Ctx& C, const XcdBarrier& bar, int lo, int hi) {
    constexpr int pb = 16 * L;
    if (IN(pb + 1)) { phase_cvt_moe(args, C, L); __syncthreads(); phase_r1(args, C, L); SEAM(pb + 1); }
    if (IN(pb + 2)) { phase_g1(args, C, L); SEAM(pb + 2); }
    if constexpr ((L & 1) == 0) {
        if (IN(pb + 3)) { phase_s1(args, C, L); SEAM(pb + 3); }
        if (IN(pb + 4)) { phase_s2(args, C); SEAM(pb + 4); }
        if (IN(pb + 5)) { phase_s3(args, C, L); SEAM(pb + 5); }
    } else {
        if (IN(pb + 3)) { phase_conv(args, C, L); SEAM(pb + 3); }
    }
    if (IN(pb + 6)) { phase_g2(args, C, L); SEAM(pb + 6); }
    if (IN(pb + 7)) { phase_r2(args, C, L); SEAM(pb + 7); }
    if (IN(pb + 8)) { phase_m1(args, C, L); SEAM(pb + 8); }
    if (IN(pb + 9)) { phase_m2(args, C, L); SEAM(pb + 9); }
}
__global__ void __launch_bounds__(NT, 2) fwd_kernel(Args args) {
    extern __shared__ __attribute__((aligned(16))) unsigned char lds_raw[];
    Ctx C; C.lds = (LAS unsigned char*)lds_raw; C.tid = threadIdx.x; C.lane = C.tid & 63; C.wave = __builtin_amdgcn_readfirstlane(C.tid >> 6); C.G = gridDim.x; C.bid = blockIdx.x; C.a = &args;
    const int lo = args.lo, hi = args.hi;
    volatile LAS unsigned* xbw = (volatile LAS unsigned*)(C.lds + LDS_BYTES - 16);
    if (C.tid < 4) xbw[C.tid] = 0u;
    __syncthreads();
    XcdBarrier bar; bar.bar = (unsigned*)(args.ws + WS_CTL) + CW_BAR; bar.x = 0; bar.st = xbw;
    if (hi - lo > 1) bar = xcd_barrier_post((unsigned*)(args.ws + WS_CTL) + CW_BAR, xbw);
    if (IN(0)) { phase_mod(args, C); __syncthreads(); phase_cvt_mixer(args, C); SEAM(0); }
    layer_phases<0>(args, C, bar, lo, hi);
    layer_phases<1>(args, C, bar, lo, hi);
    layer_phases<2>(args, C, bar, lo, hi);
    layer_phases<3>(args, C, bar, lo, hi);
    if (IN(64)) phase_final(args, C);
}
#undef IN
#undef SEAM

extern "C" void kernel_launch(void* const* d_in, const int* in_sizes, int n_in, void* d_out, int out_size, void* d_ws, size_t ws_size, hipStream_t stream) {
    static int grid = 0;
    if (grid == 0) {
        if (n_in != 22 || out_size != NL * D || ws_size < WS_END) { fprintf(stderr, "kernel_launch: unexpected shapes (n_in %d out %d ws %zu)\n", n_in, out_size, ws_size); grid = -1; return; }
        int dev = 0, cus = 0, per_cu = 0;
        if (hipGetDevice(&dev) != hipSuccess || hipDeviceGetAttribute(&cus, hipDeviceAttributeMultiprocessorCount, dev) != hipSuccess) { grid = -1; return; }
        if (hipFuncSetAttribute((const void*)fwd_kernel, hipFuncAttributeMaxDynamicSharedMemorySize, LDS_BYTES) != hipSuccess) { grid = -1; return; }
        if (hipOccupancyMaxActiveBlocksPerMultiprocessor(&per_cu, (const void*)fwd_kernel, NT, LDS_BYTES) != hipSuccess || per_cu < 1) { fprintf(stderr, "kernel_launch: occupancy query says %d\n", per_cu); }
        (void)hipGetLastError();
        grid = cus;
    }
    if (grid < 0) return;
    (void)hipMemsetAsync((char*)d_ws + WS_CTL, 0, CTL_BYTES, stream);
    Args a{};
    for (int i = 0; i < 22; ++i) a.in[i] = (const float*)d_in[i];
    a.out = (float*)d_out; a.ws = (unsigned char*)d_ws;
#if MK_MULTI
    int phases[64]; int np = 0;
    phases[np++] = 0;
    for (int l = 0; l < DEPTH; ++l) { const int pb = 16 * l; phases[np++] = pb + 1; phases[np++] = pb + 2; phases[np++] = pb + 3;
        if ((l & 1) == 0) { phases[np++] = pb + 4; phases[np++] = pb + 5; }
        phases[np++] = pb + 6; phases[np++] = pb + 7; phases[np++] = pb + 8; phases[np++] = pb + 9; }
    phases[np++] = 64;
    for (int i = 0; i < np; ++i) { a.lo = phases[i]; a.hi = phases[i] + 1; hipLaunchKernelGGL(fwd_kernel, dim3(grid), dim3(NT), LDS_BYTES, stream, a); }
#else
    a.lo = 0; a.hi = 65;
    hipLaunchKernelGGL(fwd_kernel, dim3(grid), dim3(NT), LDS_BYTES, stream, a);
#endif
}
```

```cpp
#include <hip/hip_runtime.h>
#include <cstdio>
#include <cstdint>

#define LAS __attribute__((address_space(3)))
typedef unsigned short bf16;
typedef float f32x4 __attribute__((ext_vector_type(4)));
typedef unsigned u32x4 __attribute__((ext_vector_type(4)));
typedef unsigned u32x2 __attribute__((ext_vector_type(2)));

constexpr int D = 1024, BATCH = 2, SEQ = 16384, DEPTH = 4, CTXL = 256;
constexpr int NL = BATCH * SEQ, NCX = BATCH * CTXL, NR = NL + NCX;
constexpr int NH = 4, DQK = 128, DV = 256, NQ = 512, NV = 1024, PROJ = 3088, PW = 3072;
constexpr int NGRP = 4, EPG = 8, NE = 32, DE = 512;
constexpr int NBLK = 65;
constexpr int NUNIT = BATCH * NH * NBLK;
constexpr int CAP = NR;
constexpr int YROWS = 74752;
constexpr float EPS = 1e-6f;
constexpr int NT = 512, NW = 8;

constexpr size_t MiB = 1u << 20;
constexpr size_t WS_CTL = 0, CTL_BYTES = 1 * MiB;
constexpr size_t WS_MOD = 1 * MiB;
constexpr size_t WS_GATE = 2 * MiB;
constexpr size_t WS_TOKSLOT = 5 * MiB;
constexpr size_t WS_TOKW = 6 * MiB;
constexpr size_t WS_SLOTTOK = 7 * MiB;
constexpr size_t WS_DN = 12 * MiB;
constexpr size_t WS_NST = 13 * MiB;
constexpr size_t WS_BTOT = 14 * MiB;
constexpr size_t WS_LAT = 16 * MiB;
constexpr size_t WS_HB = 146 * MiB;
constexpr size_t WS_PB = 211 * MiB;
constexpr size_t WS_HM = 406 * MiB;
constexpr size_t WS_DC = 471 * MiB;
constexpr size_t WS_CST = 601 * MiB;
constexpr size_t WS_VT = 666 * MiB;
constexpr size_t WS_WAIN = 731 * MiB;
constexpr size_t WS_WBIN = 743 * MiB;
constexpr size_t WS_WAOUT = 755 * MiB;
constexpr size_t WS_WBOUT = 759 * MiB;
constexpr size_t WS_WGU = 763 * MiB;
constexpr size_t WS_WDN = 827 * MiB;
constexpr size_t WS_END = 859 * MiB;
constexpr int CW_CNT = 1024;

struct Args { const float* in[22]; float* out; unsigned char* ws; int lo, hi; };

__device__ __forceinline__ float bf2f(bf16 v) { return __uint_as_float(((unsigned)v) << 16); }
__device__ __forceinline__ unsigned f2bf(float f) { unsigned u = __float_as_uint(f); return (u + 0x7fffu + ((u >> 16) & 1u)) >> 16; }
__device__ __forceinline__ unsigned pk2(float lo, float hi) { return f2bf(lo) | (f2bf(hi) << 16); }
__device__ __forceinline__ float wave_sum(float v) {
#pragma unroll
    for (int o = 1; o < 64; o <<= 1) v += __shfl_xor(v, o);
    return v;
}
__device__ __forceinline__ float sigmoidf_(float x) { return 1.f / (1.f + __expf(-x)); }
__device__ __forceinline__ float siluf_(float x) { return x / (1.f + __expf(-x)); }
__device__ __forceinline__ float logsigmoidf_(float x) { return fminf(x, 0.f) - log1pf(__expf(-fabsf(x))); }
__device__ __forceinline__ int blk_row0(int b, int blk) { return blk == 0 ? NL + b * CTXL : b * SEQ + (blk - 1) * 256; }
__device__ __forceinline__ int mod_vec_of_row(int row) { return row < NL ? row / SEQ : 2; }

struct Ctx {
    LAS unsigned char* lds; int tid, lane, wave, G, bid;
    const Args* a;
};

__device__ __forceinline__ void slot_bases(const Args& A, int l, LAS int* sb, int tid) {
    if (tid == 0) {
        const unsigned* cnt = (const unsigned*)(A.ws + WS_CTL) + CW_CNT + l * 32;
        int acc = 0;
        for (int e = 0; e < NE; ++e) { sb[e] = acc; acc += (((int)cnt[e] + 255) / 256) * 256; }
        sb[NE] = acc;
    }
    __syncthreads();
}

__device__ __forceinline__ void phase_mod(const Args& A, const Ctx& C) {
    LAS float* sc = (LAS float*)C.lds;
    LAS float* red = sc + 3072;
    const float* c = A.in[1]; const float* cc = A.in[3];
    for (int i = C.tid; i < 3072; i += NT) { const float v = i < 2048 ? c[i] : cc[i - 2048]; sc[i] = siluf_(v); }
    __syncthreads();
    float* MOD = (float*)(A.ws + WS_MOD);
    for (int u = C.bid; u < DEPTH * 96; u += C.G) {
        const int l = u / 96, cg = u % 96, col = cg * 64 + C.lane;
        const float* w = A.in[4] + (size_t)l * D * 6 * D + col;
        float a0 = 0.f, a1 = 0.f, a2 = 0.f;
        for (int k = C.wave * 128; k < C.wave * 128 + 128; ++k) { const float wv = w[(size_t)k * 6 * D]; a0 += sc[k] * wv; a1 += sc[1024 + k] * wv; a2 += sc[2048 + k] * wv; }
        red[(C.wave * 3 + 0) * 64 + C.lane] = a0; red[(C.wave * 3 + 1) * 64 + C.lane] = a1; red[(C.wave * 3 + 2) * 64 + C.lane] = a2;
        __syncthreads();
        if (C.tid < 192) { const int v = C.tid / 64, ln = C.tid % 64; float s = 0.f;
            for (int w8 = 0; w8 < 8; ++w8) s += red[(w8 * 3 + v) * 64 + ln];
            MOD[(size_t)(l * 3 + v) * 6 * D + cg * 64 + ln] = s + A.in[5][(size_t)l * 6 * D + cg * 64 + ln]; }
        __syncthreads();
    }
}

__device__ __forceinline__ void load_row_f32(const float* p, int lane, f32x4 (&v)[4]) {
#pragma unroll
    for (int j = 0; j < 4; ++j) v[j] = *(const f32x4*)(p + 4 * lane + 256 * j);
}
__device__ __forceinline__ void load_row_bf16(const bf16* p, int lane, f32x4 (&v)[4]) {
#pragma unroll
    for (int j = 0; j < 4; ++j) { const u32x2 w = *(const u32x2*)(p + 4 * lane + 256 * j);
        v[j] = (f32x4){__uint_as_float(w.x << 16), __uint_as_float(w.x & 0xffff0000u), __uint_as_float(w.y << 16), __uint_as_float(w.y & 0xffff0000u)}; }
}
__device__ __forceinline__ void store_row_bf16(bf16* p, int lane, const f32x4 (&v)[4]) {
#pragma unroll
    for (int j = 0; j < 4; ++j) { u32x2 w; w.x = pk2(v[j].x, v[j].y); w.y = pk2(v[j].z, v[j].w); *(u32x2*)(p + 4 * lane + 256 * j) = w; }
}
__device__ __forceinline__ void moe_combine(const Args& A, int lp, int row, int lane, LAS const int* sb, f32x4 (&v)[4]) {
    const int* ts = (const int*)(A.ws + WS_TOKSLOT) + row * 2; const float* tw = (const float*)(A.ws + WS_TOKW) + row * 2;
    const bf16* Y = (const bf16*)(A.ws + WS_PB);
    const int t0 = ts[0], t1 = ts[1]; const float w0 = tw[0], w1 = tw[1];
    const size_t s0 = (size_t)(sb[t0 >> 20] + (t0 & 0xfffff)), s1 = (size_t)(sb[t1 >> 20] + (t1 & 0xfffff));
    f32x4 y0[4], y1[4], g2[4];
    load_row_bf16(Y + s0 * D, lane, y0); load_row_bf16(Y + s1 * D, lane, y1);
    load_row_f32((const float*)(A.ws + WS_MOD) + (size_t)(lp * 3 + mod_vec_of_row(row)) * 6 * D + 5 * D, lane, g2);
#pragma unroll
    for (int j = 0; j < 4; ++j) v[j] += g2[j] * (y0[j] * w0 + y1[j] * w1);
}
__device__ __forceinline__ void norm_mod(const f32x4 (&v)[4], const float* g, const float* sh, const float* sc, int lane, f32x4 (&h)[4]) {
    float s = 0.f;
#pragma unroll
    for (int j = 0; j < 4; ++j) s += (v[j].x * v[j].x + v[j].y * v[j].y) + (v[j].z * v[j].z + v[j].w * v[j].w);
    const float r = 1.0f / sqrtf(wave_sum(s) * (1.f / D) + EPS);
    f32x4 gg[4], ss[4], cc[4];
    load_row_f32(g, lane, gg); load_row_f32(sh, lane, ss); load_row_f32(sc, lane, cc);
#pragma unroll
    for (int j = 0; j < 4; ++j) h[j] = (v[j] * r) * gg[j] * (1.f + cc[j]) + ss[j];
}

__device__ __forceinline__ void phase_r1(const Args& A, const Ctx& C, int l) {
    LAS int* sb = (LAS int*)C.lds;
    LAS float* GW = (LAS float*)(C.lds + 256);
    const bool mls = (l & 1) == 0; const int j = l >> 1;
    if (l > 0) slot_bases(A, l - 1, sb, C.tid);
    if (mls) { const float* w = A.in[8] + (size_t)j * D * PROJ + PW;
        for (int i = C.tid; i < 16 * D; i += NT) { const int k = i >> 4, c = i & 15; GW[c * D + k] = w[(size_t)k * PROJ + c]; }
        __syncthreads(); }
    const int nrows = (l <= 2) ? NR : NL;
    float* LAT = (float*)(A.ws + WS_LAT); bf16* H = (bf16*)(A.ws + WS_HB); float* GATE = (float*)(A.ws + WS_GATE);
    const float* MOD = (const float*)(A.ws + WS_MOD);
    for (int row = C.bid * NW + C.wave; row < nrows; row += C.G * NW) {
        f32x4 v[4], h[4];
        if (l == 0) load_row_f32(row < NL ? A.in[0] + (size_t)row * D : A.in[2] + (size_t)(row - NL) * D, C.lane, v);
        else { load_row_f32(LAT + (size_t)row * D, C.lane, v); moe_combine(A, l - 1, row, C.lane, sb, v); }
#pragma unroll
        for (int q = 0; q < 4; ++q) *(f32x4*)(LAT + (size_t)row * D + 4 * C.lane + 256 * q) = v[q];
        const float* mv = MOD + (size_t)(l * 3 + mod_vec_of_row(row)) * 6 * D;
        norm_mod(v, A.in[6] + (size_t)(l * 2 + 0) * D, mv + 0 * D, mv + 1 * D, C.lane, h);
        store_row_bf16(H + (size_t)row * D, C.lane, h);
        if (mls) {
            float g = 0.f;
#pragma unroll 2
            for (int c = 0; c < 16; ++c) { float s = 0.f;
#pragma unroll
                for (int q = 0; q < 4; ++q) { const f32x4 w = *(const LAS f32x4*)(GW + c * D + 4 * C.lane + 256 * q); s += (h[q].x * w.x + h[q].y * w.y) + (h[q].z * w.z + h[q].w * w.w); }
                s = wave_sum(s); g = (C.lane == c) ? s : g; }
            if (C.lane < 16) {
                g += A.in[9][j * 16 + C.lane];
                const int gtype = C.lane >> 2;
                const float o = (gtype & 1) ? logsigmoidf_(g) : 15.0f * tanhf(g * (1.0f / 15.0f));
                GATE[(size_t)row * 16 + C.lane] = o; }
        }
    }
}

__device__ __forceinline__ void phase_r2(const Args& A, const Ctx& C, int l) {
    LAS float* RW = (LAS float*)C.lds;
    { const float* wg = A.in[15] + (size_t)l * D * NGRP; const float* wr = A.in[17] + (size_t)l * D * NE;
      for (int i = C.tid; i < 4 * D; i += NT) { const int k = i >> 2, c = i & 3; RW[c * D + k] = wg[(size_t)k * NGRP + c]; }
      for (int i = C.tid; i < 32 * D; i += NT) { const int k = i >> 5, c = i & 31; RW[(4 + c) * D + k] = wr[(size_t)k * NE + c]; }
      __syncthreads(); }
    const int nrows = (l <= 1) ? NR : NL;
    float* LAT = (float*)(A.ws + WS_LAT); bf16* H = (bf16*)(A.ws + WS_HB);
    const float* MOD = (const float*)(A.ws + WS_MOD);
    unsigned* cnt = (unsigned*)(A.ws + WS_CTL) + CW_CNT + l * 32;
    int* TS = (int*)(A.ws + WS_TOKSLOT); float* TW = (float*)(A.ws + WS_TOKW); int* ST = (int*)(A.ws + WS_SLOTTOK);
    for (int row = C.bid * NW + C.wave; row < nrows; row += C.G * NW) {
        f32x4 v[4], y[4], g1[4], h[4];
        const float* mv = MOD + (size_t)(l * 3 + mod_vec_of_row(row)) * 6 * D;
        load_row_f32(LAT + (size_t)row * D, C.lane, v); load_row_bf16(H + (size_t)row * D, C.lane, y); load_row_f32(mv + 2 * D, C.lane, g1);
#pragma unroll
        for (int q = 0; q < 4; ++q) { v[q] += g1[q] * y[q]; *(f32x4*)(LAT + (size_t)row * D + 4 * C.lane + 256 * q) = v[q]; }
        norm_mod(v, A.in[6] + (size_t)(l * 2 + 1) * D, mv + 3 * D, mv + 4 * D, C.lane, h);
        store_row_bf16(H + (size_t)row * D, C.lane, h);
        float mine = 0.f;
#pragma unroll 2
        for (int c = 0; c < 36; ++c) { float s = 0.f;
#pragma unroll
            for (int q = 0; q < 4; ++q) { const f32x4 w = *(const LAS f32x4*)(RW + c * D + 4 * C.lane + 256 * q); s += (h[q].x * w.x + h[q].y * w.y) + (h[q].z * w.z + h[q].w * w.w); }
            s = wave_sum(s); mine = (C.lane == c) ? s : mine; }
        LAS float* wl = (LAS float*)(C.lds + 36 * D * 4) + C.wave * 64;
        if (C.lane < 36) wl[C.lane] = mine;
        asm volatile("s_waitcnt lgkmcnt(0)" ::: "memory");
        if (C.lane == 0) {
            float lg[36];
#pragma unroll
            for (int c = 0; c < 36; ++c) lg[c] = wl[c];
            const float* bg = A.in[16] + l * NGRP; const float* br = A.in[18] + l * NE;
            float gl[4]; int grp = 0; float gm = -3.0e38f;
#pragma unroll
            for (int c = 0; c < 4; ++c) { gl[c] = lg[c] + bg[c]; if (gl[c] > gm) { gm = gl[c]; grp = c; } }
            float gs = 0.f;
#pragma unroll
            for (int c = 0; c < 4; ++c) gs += __expf(gl[c] - gm);
            const float pgrp = 1.0f / gs;
            float rl[8];
#pragma unroll
            for (int i = 0; i < 8; ++i) { float t = 0.f;
#pragma unroll
                for (int g = 0; g < 4; ++g) t = (g == grp) ? lg[4 + g * 8 + i] : t;
                rl[i] = t + br[grp * 8 + i]; }
            int i0 = 0; float m0 = rl[0];
#pragma unroll
            for (int i = 1; i < 8; ++i) if (rl[i] > m0) { m0 = rl[i]; i0 = i; }
            int i1 = -1; float m1 = -3.0e38f;
#pragma unroll
            for (int i = 0; i < 8; ++i) if (i != i0 && rl[i] > m1) { m1 = rl[i]; i1 = i; }
            const float p0 = 1.0f, p1 = __expf(m1 - m0);
            const float w0 = pgrp * p0 / (p0 + p1), w1 = pgrp * p1 / (p0 + p1);
            const int e0 = grp * 8 + i0, e1 = grp * 8 + i1;
            const unsigned q0 = atomicAdd(cnt + e0, 1u), q1 = atomicAdd(cnt + e1, 1u);
            ST[(size_t)e0 * CAP + q0] = row; ST[(size_t)e1 * CAP + q1] = row;
            TS[row * 2 + 0] = (e0 << 20) | (int)q0; TS[row * 2 + 1] = (e1 << 20) | (int)q1;
            TW[row * 2 + 0] = w0; TW[row * 2 + 1] = w1;
        }
    }
}

__device__ __forceinline__ void phase_final(const Args& A, const Ctx& C) {
    LAS int* sb = (LAS int*)C.lds;
    slot_bases(A, 3, sb, C.tid);
    const float* LAT = (const float*)(A.ws + WS_LAT);
    for (int row = C.bid * NW + C.wave; row < NL; row += C.G * NW) {
        f32x4 v[4], g[4];
        load_row_f32(LAT + (size_t)row * D, C.lane, v); moe_combine(A, 3, row, C.lane, sb, v);
        float s = 0.f;
#pragma unroll
        for (int j = 0; j < 4; ++j) s += (v[j].x * v[j].x + v[j].y * v[j].y) + (v[j].z * v[j].z + v[j].w * v[j].w);
        const float r = 1.0f / sqrtf(wave_sum(s) * (1.f / D) + EPS);
        load_row_f32(A.in[7], C.lane, g);
#pragma unroll
        for (int j = 0; j < 4; ++j) *(f32x4*)(A.out + (size_t)row * D + 4 * C.lane + 256 * j) = (v[j] * r) * g[j];
    }
}

__device__ __forceinline__ void phase_conv(const Args& A, const Ctx& C, int l) {
    const int j = l >> 1; const int nrows = (l <= 1) ? NR : NL;
    const bf16* P = (const bf16*)(A.ws + WS_PB); bf16* HM = (bf16*)(A.ws + WS_HM);
    const float* cw = A.in[13] + (size_t)j * 3 * D;
    for (int row = C.bid * NW + C.wave; row < nrows; row += C.G * NW) {
        bool hasl, hasr;
        if (row < NL) { const int t = row & 63; hasl = t != 0; hasr = t != 63; } else { const int t = (row - NL) & 255; hasl = t != 0; hasr = t != 255; }
        f32x4 bg[4], z[4], w0[4], w1[4], w2[4], acc[4];
        const bf16* pr = P + (size_t)row * PW;
        load_row_bf16(pr, C.lane, bg); load_row_bf16(pr + D, C.lane, z);
        load_row_f32(cw, C.lane, w0); load_row_f32(cw + D, C.lane, w1); load_row_f32(cw + 2 * D, C.lane, w2);
#pragma unroll
        for (int q = 0; q < 4; ++q) acc[q] = w1[q] * z[q];
        if (hasl) { load_row_bf16(pr - PW + D, C.lane, z);
#pragma unroll
            for (int q = 0; q < 4; ++q) acc[q] += w0[q] * z[q]; }
        if (hasr) { load_row_bf16(pr + PW + D, C.lane, z);
#pragma unroll
            for (int q = 0; q < 4; ++q) acc[q] += w2[q] * z[q]; }
#pragma unroll
        for (int q = 0; q < 4; ++q) acc[q] *= bg[q];
        store_row_bf16(HM + (size_t)row * D, C.lane, acc);
    }
}

typedef short bf16x8 __attribute__((ext_vector_type(8)));
constexpr int BM = 256, BK = 64, HALF = 128, HTB = HALF * BK * 2, STAGE_BYTES = 8 * HTB, NXCD = 8, WGM = 8;
constexpr int LDS_TAB = STAGE_BYTES;
__device__ __forceinline__ int lds_byte(int r, int c) { const int st = (r >> 4) * 2 + (c >> 5), rr = r & 15, cc = c & 31, ob = rr * 64 + cc * 2; return st * 1024 + (ob ^ (((ob >> 9) & 1) << 5)); }
__device__ __forceinline__ void stage_rc(int b, int& R, int& C) { const int st = b / 1024, sb = b % 1024, swz = sb ^ (((sb >> 9) & 1) << 5); R = (st >> 1) * 16 + swz / 64; C = (st & 1) * 32 + (swz % 64) / 2; }
__device__ __forceinline__ int perm32(int rho) { const int n = rho >> 4, i = rho & 15; return 8 * (i >> 2) + 4 * n + (i & 3); }
__device__ __forceinline__ unsigned cvt_pk_bf16(float lo, float hi) { unsigned r; asm volatile("v_cvt_pk_bf16_f32 %0, %1, %2" : "=v"(r) : "v"(lo), "v"(hi)); return r; }

struct GUnit { const char* a; const char* b; int orow, ocol, aux; };

template <class Epi, class Sched, bool GATHER>
__device__ __forceinline__ void gemm_phase(LAS unsigned char* lds, const int K, const Sched& S, const Epi& E) {
    const int tid = threadIdx.x, wid = __builtin_amdgcn_readfirstlane(tid >> 6), lane = tid & 63, wr = wid >> 2, wc = wid & 3, fr = lane & 15, fq = lane >> 4;
    const int nt = K / BK;
    unsigned voffB[2], voA[2][2], noA[2][2]; int Rr[2], Cc[2];
#pragma unroll
    for (int i = 0; i < 2; ++i) { int R, C; stage_rc(tid * 16 + i * 8192, R, C); const int Rb = (R & ~31) + perm32(R & 31); Rr[i] = R; Cc[i] = C;
        voffB[i] = (unsigned)(Rb * K + C) * 2u;
        voA[0][i] = (unsigned)(R * K + C) * 2u; voA[1][i] = (unsigned)((R + HALF) * K + C) * 2u; }
    const size_t kstep = (size_t)(BK * 2);
    const size_t hstep = (size_t)HALF * K * 2;
    const unsigned ldsw = (unsigned)wid * 1024u;
    const int aoff = lds_byte(wr * 64 + fr, fq * 8), boff = lds_byte(wc * 32 + fr, fq * 8);
#define PG8_SA(b, h) (((b) * 2 + (h)) * HTB)
#define PG8_SB(b, h) ((4 + (b) * 2 + (h)) * HTB)
#define PG8_STAGE(bufoff, gbase, voff) do { _Pragma("unroll") for (int _i = 0; _i < 2; ++_i) \
        __builtin_amdgcn_global_load_lds((const unsigned*)((const char*)(gbase) + (voff)[_i]), (LAS unsigned*)(lds + (bufoff) + ldsw + _i * 8192), 16, 0, 0); } while (0)
#define PG8_LDA(dst, b, h) do { _Pragma("unroll") for (int m = 0; m < 4; ++m) _Pragma("unroll") for (int k = 0; k < 2; ++k) dst[m][k] = *(const LAS bf16x8*)(lds + PG8_SA(b, h) + aoff + m * 2048 + k * 1024); } while (0)
#define PG8_LDB(dst, b, h) do { _Pragma("unroll") for (int n = 0; n < 2; ++n) _Pragma("unroll") for (int k = 0; k < 2; ++k) dst[n][k] = *(const LAS bf16x8*)(lds + PG8_SB(b, h) + boff + n * 2048 + k * 1024); } while (0)
#define PG8_MMA(ai, bj, At, Bt) do { __builtin_amdgcn_s_setprio(1); _Pragma("unroll") for (int m = 0; m < 4; ++m) _Pragma("unroll") for (int n = 0; n < 2; ++n) _Pragma("unroll") for (int k = 0; k < 2; ++k) \
        acc[ai][bj][m][n] = __builtin_amdgcn_mfma_f32_16x16x32_bf16(Bt[n][k], At[m][k], acc[ai][bj][m][n], 0, 0, 0); __builtin_amdgcn_s_setprio(0); } while (0)
#define PG8_WAIT_V(n) asm volatile("s_waitcnt vmcnt(" #n ")" ::: "memory")
#define PG8_WAIT_L(n) asm volatile("s_waitcnt lgkmcnt(" #n ")" ::: "memory")
#define PG8_BAR __builtin_amdgcn_s_barrier()
#define PG8_SCHED __builtin_amdgcn_sched_barrier(0)
    GUnit cur, nxt; int ui = 0;
    if (!S.next(0, cur)) return;
    if constexpr (GATHER) {
#pragma unroll
        for (int h = 0; h < 2; ++h)
#pragma unroll
            for (int i = 0; i < 2; ++i) voA[h][i] = S.arow_off(0, h * HALF + Rr[i]) + (unsigned)Cc[i] * 2u;
    }
    f32x4 acc[2][2][4][2];
#pragma unroll
    for (int a = 0; a < 2; ++a)
#pragma unroll
        for (int b = 0; b < 2; ++b)
#pragma unroll
            for (int m = 0; m < 4; ++m)
#pragma unroll
                for (int n = 0; n < 2; ++n) acc[a][b][m][n] = (f32x4){0.f, 0.f, 0.f, 0.f};
    bf16x8 At[4][2], B0[2][2], B1[2][2];
    const char* cA = cur.a; const char* cB = cur.b;
    PG8_STAGE(PG8_SB(0, 0), cB, voffB); PG8_STAGE(PG8_SB(0, 1), cB + hstep, voffB); PG8_STAGE(PG8_SA(0, 0), cA, voA[0]); PG8_STAGE(PG8_SA(0, 1), cA, voA[1]);
    if (wr == 1) PG8_BAR;
    PG8_WAIT_V(2); PG8_BAR;
    PG8_STAGE(PG8_SB(1, 0), cB + kstep, voffB); PG8_STAGE(PG8_SA(1, 0), cA + kstep, voA[0]); PG8_STAGE(PG8_SB(1, 1), cB + hstep + kstep, voffB);
    PG8_WAIT_V(6); PG8_BAR;
    for (;;) {
        const bool has_next = S.next(ui + 1, nxt);
        const char* nA = has_next ? nxt.a : cA; const char* nB = has_next ? nxt.b : cB;
        for (int t = 0; t < nt; t += 2) {
            const bool last = (t == nt - 2);
            const char* a1 = cA + (size_t)(t + 1) * kstep;
            const char* a2 = last ? nA : cA + (size_t)(t + 2) * kstep; const char* b2 = last ? nB : cB + (size_t)(t + 2) * kstep;
            const char* a3 = a2 + kstep; const char* b3 = b2 + kstep;
            unsigned sA[2][2];
            if constexpr (GATHER) {
                if (last) {
#pragma unroll
                    for (int h = 0; h < 2; ++h)
#pragma unroll
                        for (int i = 0; i < 2; ++i) noA[h][i] = has_next ? S.arow_off(ui + 1, h * HALF + Rr[i]) + (unsigned)Cc[i] * 2u : voA[h][i];
                }
#pragma unroll
                for (int h = 0; h < 2; ++h)
#pragma unroll
                    for (int i = 0; i < 2; ++i) sA[h][i] = last ? noA[h][i] : voA[h][i];
            } else {
#pragma unroll
                for (int h = 0; h < 2; ++h)
#pragma unroll
                    for (int i = 0; i < 2; ++i) sA[h][i] = voA[h][i];
            }
            PG8_LDB(B0, 0, 0); PG8_LDB(B1, 0, 1); PG8_SCHED; PG8_LDA(At, 0, 0); PG8_STAGE(PG8_SA(1, 1), a1, voA[1]);
            PG8_WAIT_V(8); PG8_WAIT_L(0); PG8_BAR; PG8_MMA(0, 0, At, B0); PG8_MMA(0, 1, At, B1); PG8_BAR; PG8_SCHED;
            PG8_LDA(At, 0, 1); PG8_STAGE(PG8_SB(0, 0), b2, voffB); PG8_STAGE(PG8_SB(0, 1), b2 + hstep, voffB); PG8_STAGE(PG8_SA(0, 0), a2, sA[0]);
            PG8_WAIT_V(8); PG8_WAIT_L(0); PG8_BAR; PG8_MMA(1, 0, At, B0); PG8_MMA(1, 1, At, B1); PG8_BAR; PG8_SCHED;
            PG8_LDB(B0, 1, 0); PG8_LDB(B1, 1, 1); PG8_SCHED; PG8_LDA(At, 1, 0); PG8_STAGE(PG8_SA(0, 1), a2, sA[1]);
            PG8_WAIT_V(8); PG8_WAIT_L(0); PG8_BAR; PG8_MMA(0, 0, At, B0); PG8_MMA(0, 1, At, B1); PG8_BAR; PG8_SCHED;
            PG8_LDA(At, 1, 1); PG8_STAGE(PG8_SB(1, 0), b3, voffB); PG8_STAGE(PG8_SB(1, 1), b3 + hstep, voffB); PG8_STAGE(PG8_SA(1, 0), a3, sA[0]);
            PG8_WAIT_V(8); PG8_WAIT_L(0); PG8_BAR; PG8_MMA(1, 0, At, B0); PG8_MMA(1, 1, At, B1); PG8_BAR; PG8_SCHED;
        }
        if (wr == 0) PG8_BAR;
        E(acc, cur, wr, wc, fr, fq);
        if (!has_next) break;
#pragma unroll
        for (int a = 0; a < 2; ++a)
#pragma unroll
            for (int b = 0; b < 2; ++b)
#pragma unroll
                for (int m = 0; m < 4; ++m)
#pragma unroll
                    for (int n = 0; n < 2; ++n) acc[a][b][m][n] = (f32x4){0.f, 0.f, 0.f, 0.f};
        cur = nxt; cA = nA; cB = nB; ++ui;
        if constexpr (GATHER) {
#pragma unroll
            for (int h = 0; h < 2; ++h)
#pragma unroll
                for (int i = 0; i < 2; ++i) voA[h][i] = noA[h][i];
        }
        if (wr == 1) PG8_BAR;
    }
    PG8_WAIT_V(0);
    PG8_BAR;
#undef PG8_SA
#undef PG8_SB
#undef PG8_STAGE
#undef PG8_LDA
#undef PG8_LDB
#undef PG8_MMA
#undef PG8_WAIT_V
#undef PG8_WAIT_L
#undef PG8_BAR
#undef PG8_SCHED
}

__device__ __forceinline__ int xcd_remap(int L, int nwg) { const int q = nwg / NXCD, r = nwg % NXCD, xcd = L % NXCD, off = L / NXCD; return (xcd < r ? xcd * (q + 1) : r * (q + 1) + (xcd - r) * q) + off; }

struct DenseSched {
    const char* A; const char* Bt; int nM, nN, nwg, G, c; size_t tstep; int sw_lo, sw_hi;
    __device__ __forceinline__ void init(const void* A_, const void* Bt_, int M, int N, int K, int G_, int c_) { A = (const char*)A_; Bt = (const char*)Bt_; nM = M / BM; nN = N / BM; nwg = nM * nN; G = G_; c = c_; tstep = (size_t)BM * K * 2; sw_lo = 0; sw_hi = 0; }
    __device__ __forceinline__ bool next(int i, GUnit& u) const {
        const long L = (long)i * G + c; if (L >= nwg) return false;
        const int wgid = xcd_remap((int)L, nwg);
        const int nig = WGM * nN, gid = wgid / nig, fm = gid * WGM, gsz = (nM - fm) < WGM ? (nM - fm) : WGM;
        const int pm = fm + ((wgid % nig) % gsz), pn = (wgid % nig) / gsz;
        if (pn >= sw_lo && pn < sw_hi) { u.a = Bt + (size_t)pn * tstep; u.b = A + (size_t)pm * tstep; u.orow = pm; u.ocol = pn - sw_lo; u.aux = 1; }
        else { u.a = A + (size_t)pm * tstep; u.b = Bt + (size_t)pn * tstep; u.orow = pm * BM; u.ocol = pn * BM; u.aux = 0; }
        return true;
    }
    __device__ __forceinline__ unsigned arow_off(int, int) const { return 0u; }
};

constexpr int MAXU = 12;
struct MoeTab { int n; int e[MAXU], mb[MAXU], nt[MAXU]; int sb[NE + 1]; };
struct MoeSched {
    LAS const MoeTab* T; LAS const unsigned* ridx;
    const char* A; const char* W; size_t wstride_e, tstepB; int K; int arow_bytes;
    __device__ __forceinline__ bool next(int i, GUnit& u) const {
        const int n = __builtin_amdgcn_readfirstlane(T->n); if (i >= n) return false;
        const int e = __builtin_amdgcn_readfirstlane(T->e[i]), mb = __builtin_amdgcn_readfirstlane(T->mb[i]), nt = __builtin_amdgcn_readfirstlane(T->nt[i]);
        const int base = __builtin_amdgcn_readfirstlane(T->sb[e]);
        u.orow = base + mb * BM; u.ocol = nt; u.aux = e;
        u.a = A + (size_t)u.orow * arow_bytes;
        u.b = W + (size_t)e * wstride_e + (size_t)nt * tstepB; return true;
    }
    __device__ __forceinline__ unsigned arow_off(int i, int r) const { return ridx[i * 256 + r]; }
};
template <bool GATHER>
__device__ __forceinline__ void moe_tables(const Args& A, const Ctx& C, int l, int ntile_n, LAS MoeTab* T, LAS unsigned* ridx, int arow_bytes) {
    const unsigned* cnt = (const unsigned*)(A.ws + WS_CTL) + CW_CNT + l * 32;
    LAS int* ust = (LAS int*)(T + 1);
    if (C.tid == 0) { int acc = 0, ua = 0; for (int e = 0; e < NE; ++e) { T->sb[e] = acc; ust[e] = ua; const int nb = ((int)cnt[e] + 255) / 256; acc += nb * 256; ua += nb * ntile_n; } T->sb[NE] = acc; ust[NE] = ua;
        const int nwg = ua; int n = 0;
        for (int i = 0; i < MAXU; ++i) { const long L = (long)i * C.G + C.bid; if (L >= nwg) break; const int w = xcd_remap((int)L, nwg); int e = 0; while (w >= ust[e + 1]) ++e;
            const int lu = w - ust[e]; T->e[i] = e; T->mb[i] = lu / ntile_n; T->nt[i] = lu % ntile_n; ++n; }
        T->n = n; }
    __syncthreads();
    if constexpr (GATHER) {
        const int* ST = (const int*)(A.ws + WS_SLOTTOK); const int n = T->n;
        for (int i = C.tid; i < n * 256; i += NT) { const int ui = i >> 8, r = i & 255, e = T->e[ui], m0 = T->mb[ui] * 256, ce = (int)cnt[e];
            const int rr = (m0 + r < ce) ? m0 + r : ce - 1;
            ridx[i] = (unsigned)ST[(size_t)e * CAP + rr] * (unsigned)arow_bytes; }
        __syncthreads();
    }
}

struct EpiStore { bf16* O; int ldc; float scale_lo; int sig_from; bf16* VT;
    __device__ __forceinline__ void operator()(const f32x4 (&acc)[2][2][4][2], const GUnit& u, int wr, int wc, int fr, int fq) const {
        const bool tr = u.aux != 0;
        const float sc = (!tr && u.ocol < NQ) ? scale_lo : 1.0f; const bool sg = !tr && u.ocol >= sig_from;
        bf16* Ob = tr ? VT + (size_t)(u.orow * NH + u.ocol) * 65536 : O + (size_t)u.orow * ldc + u.ocol; const int ld = tr ? 256 : ldc;
#pragma unroll
        for (int ai = 0; ai < 2; ++ai)
#pragma unroll
            for (int m = 0; m < 4; ++m) { bf16* rowp = Ob + (size_t)(ai * HALF + wr * 64 + m * 16 + fr) * ld + wc * 32 + 8 * fq;
#pragma unroll
                for (int bj = 0; bj < 2; ++bj) { f32x4 v0 = acc[ai][bj][m][0] * sc, v1 = acc[ai][bj][m][1] * sc;
                    if (sg) {
#pragma unroll
                        for (int q = 0; q < 4; ++q) { v0[q] = __builtin_amdgcn_rcpf(1.0f + __expf(-v0[q])); v1[q] = __builtin_amdgcn_rcpf(1.0f + __expf(-v1[q])); } }
                    u32x4 w; w.x = cvt_pk_bf16(v0[0], v0[1]); w.y = cvt_pk_bf16(v0[2], v0[3]); w.z = cvt_pk_bf16(v1[0], v1[1]); w.w = cvt_pk_bf16(v1[2], v1[3]);
                    *(u32x4*)(rowp + bj * HALF) = w; } }
    }
};
template <int MODE> struct EpiPair { bf16* O; int ldc; int plain_below;
    __device__ __forceinline__ void operator()(const f32x4 (&acc)[2][2][4][2], const GUnit& u, int wr, int wc, int fr, int fq) const {
        if (MODE == 0 && u.ocol < plain_below) {
#pragma unroll
            for (int ai = 0; ai < 2; ++ai)
#pragma unroll
                for (int m = 0; m < 4; ++m) { bf16* rowp = O + (size_t)(u.orow + ai * HALF + wr * 64 + m * 16 + fr) * ldc + u.ocol + wc * 32 + 8 * fq;
#pragma unroll
                    for (int bj = 0; bj < 2; ++bj) { const f32x4 v0 = acc[ai][bj][m][0], v1 = acc[ai][bj][m][1];
                        u32x4 w; w.x = cvt_pk_bf16(v0[0], v0[1]); w.y = cvt_pk_bf16(v0[2], v0[3]); w.z = cvt_pk_bf16(v1[0], v1[1]); w.w = cvt_pk_bf16(v1[2], v1[3]);
                        *(u32x4*)(rowp + bj * HALF) = w; } }
            return;
        }
        const int ocol = (MODE == 0) ? plain_below + (u.ocol - plain_below) / 2 : u.ocol * HALF;
#pragma unroll
        for (int ai = 0; ai < 2; ++ai)
#pragma unroll
            for (int m = 0; m < 4; ++m) { bf16* rowp = O + (size_t)(u.orow + ai * HALF + wr * 64 + m * 16 + fr) * ldc + ocol + wc * 32 + 8 * fq;
                f32x4 v0, v1;
#pragma unroll
                for (int q = 0; q < 4; ++q) {
                    const float x0 = acc[ai][0][m][0][q], x1 = acc[ai][0][m][1][q];
                    const float g0 = (MODE == 1) ? x0 * __builtin_amdgcn_rcpf(1.0f + __expf(-x0)) : x0, g1 = (MODE == 1) ? x1 * __builtin_amdgcn_rcpf(1.0f + __expf(-x1)) : x1;
                    v0[q] = g0 * acc[ai][1][m][0][q]; v1[q] = g1 * acc[ai][1][m][1][q]; }
                u32x4 w; w.x = cvt_pk_bf16(v0[0], v0[1]); w.y = cvt_pk_bf16(v0[2], v0[3]); w.z = cvt_pk_bf16(v1[0], v1[1]); w.w = cvt_pk_bf16(v1[2], v1[3]);
                *(u32x4*)rowp = w; }
    }
};
struct EpiStoreTile { bf16* O; int ldc;
    __device__ __forceinline__ void operator()(const f32x4 (&acc)[2][2][4][2], const GUnit& u, int wr, int wc, int fr, int fq) const {
#pragma unroll
        for (int ai = 0; ai < 2; ++ai)
#pragma unroll
            for (int m = 0; m < 4; ++m) { bf16* rowp = O + (size_t)(u.orow + ai * HALF + wr * 64 + m * 16 + fr) * ldc + u.ocol * BM + wc * 32 + 8 * fq;
#pragma unroll
                for (int bj = 0; bj < 2; ++bj) { const f32x4 v0 = acc[ai][bj][m][0], v1 = acc[ai][bj][m][1];
                    u32x4 w; w.x = cvt_pk_bf16(v0[0], v0[1]); w.y = cvt_pk_bf16(v0[2], v0[3]); w.z = cvt_pk_bf16(v1[0], v1[1]); w.w = cvt_pk_bf16(v1[2], v1[3]);
                    *(u32x4*)(rowp + bj * HALF) = w; } }
    }
};

__device__ __forceinline__ void transpose_item(const float* W, int ldw, int K, bf16* WT, int drow0, int k0, int n0, LAS float* scr, int lane) {
#pragma unroll 8
    for (int i = 0; i < 32; ++i) { const int kk = 2 * i + (lane >> 5); scr[kk * 33 + (lane & 31)] = W[(size_t)(k0 + kk) * ldw + n0 + (lane & 31)]; }
    asm volatile("s_waitcnt lgkmcnt(0)" ::: "memory");
    const int c = lane & 7;
#pragma unroll
    for (int j = 0; j < 4; ++j) { const int n = (lane >> 3) + 8 * j; const LAS float* s = scr + (8 * c) * 33 + n;
        u32x4 o; o.x = pk2(s[0 * 33], s[1 * 33]); o.y = pk2(s[2 * 33], s[3 * 33]); o.z = pk2(s[4 * 33], s[5 * 33]); o.w = pk2(s[6 * 33], s[7 * 33]);
        *(u32x4*)(WT + (size_t)(drow0 + n) * K + k0 + 8 * c) = o; }
    asm volatile("s_waitcnt lgkmcnt(0)" ::: "memory");
}
__device__ __forceinline__ int pair_row(int n, int which) { return (n >> 7) * 256 + (n & 127) + which * 128; }
__device__ __forceinline__ void phase_cvt_mixer(const Args& A, const Ctx& C) {
    LAS float* scr = (LAS float*)(C.lds + 16384 + C.wave * 16384);
    const int gw = C.bid * NW + C.wave, NGW = C.G * NW;
    constexpr int I_IN = (D / 64) * (PW / 32), I_OUT = (D / 64) * (D / 32), PER = 2 * (I_IN + I_OUT);
    for (int it = gw; it < 2 * PER; it += NGW) {
        const int kind = it / PER; int r = it % PER; const int j = r / (I_IN + I_OUT); r %= (I_IN + I_OUT);
        if (r < I_IN) { const int kb = r / (PW / 32), nb = r % (PW / 32), n0 = nb * 32;
            bf16* WT = (bf16*)(A.ws + (kind == 0 ? WS_WAIN : WS_WBIN)) + (size_t)j * PW * D;
            if (kind == 0) transpose_item(A.in[8] + (size_t)j * D * PROJ, PROJ, D, WT, n0, kb * 64, n0, scr, C.lane);
            else { const int drow = n0 < D ? n0 : (n0 < 2 * D ? D + pair_row(n0 - D, 0) : D + pair_row(n0 - 2 * D, 1));
                transpose_item(A.in[12] + (size_t)j * D * PW, PW, D, WT, drow, kb * 64, n0, scr, C.lane); } }
        else { r -= I_IN; const int kb = r / (D / 32), nb = r % (D / 32), n0 = nb * 32;
            bf16* WT = (bf16*)(A.ws + (kind == 0 ? WS_WAOUT : WS_WBOUT)) + (size_t)j * D * D;
            transpose_item((kind == 0 ? A.in[11] : A.in[14]) + (size_t)j * D * D, D, D, WT, n0, kb * 64, n0, scr, C.lane); }
    }
}
__device__ __forceinline__ void phase_cvt_moe(const Args& A, const Ctx& C, int l) {
    LAS float* scr = (LAS float*)(C.lds + 16384 + C.wave * 16384);
    const int gw = C.bid * NW + C.wave, NGW = C.G * NW;
    constexpr int I_G = (D / 64) * (DE / 32), I_D = (DE / 64) * (D / 32), PER = 2 * I_G + I_D;
    bf16* WGU = (bf16*)(A.ws + WS_WGU); bf16* WDN = (bf16*)(A.ws + WS_WDN);
    for (int it = gw; it < NE * PER; it += NGW) {
        const int e = it / PER; int r = it % PER;
        if (r < 2 * I_G) { const int which = r / I_G; r %= I_G; const int kb = r / (DE / 32), nb = r % (DE / 32), n0 = nb * 32;
            transpose_item((which == 0 ? A.in[19] : A.in[20]) + ((size_t)l * NE + e) * D * DE, DE, D, WGU + (size_t)e * 2 * DE * D, pair_row(n0, which), kb * 64, n0, scr, C.lane); }
        else { r -= 2 * I_G; const int kb = r / (D / 32), nb = r % (D / 32), n0 = nb * 32;
            transpose_item(A.in[21] + ((size_t)l * NE + e) * DE * D, D, DE, WDN + (size_t)e * D * DE, n0, kb * 64, n0, scr, C.lane); }
    }
}

__device__ __forceinline__ void phase_g1(const Args& A, const Ctx& C, int l) {
    const bool mls = (l & 1) == 0; const int j = l >> 1; const int nrows = (l <= 2) ? NR : NL;
    DenseSched S; S.init(A.ws + WS_HB, A.ws + (mls ? WS_WAIN : WS_WBIN) + (size_t)j * PW * D * 2, nrows, PW, D, C.G, C.bid);
    if (mls) { S.sw_lo = 4; S.sw_hi = 8; EpiStore E{(bf16*)(A.ws + WS_PB), PW, 0.08838834764831845f, 2 * NQ + NV, (bf16*)(A.ws + WS_VT)}; gemm_phase<EpiStore, DenseSched, false>(C.lds, D, S, E); }
    else { EpiPair<0> E{(bf16*)(A.ws + WS_PB), PW, D}; gemm_phase<EpiPair<0>, DenseSched, false>(C.lds, D, S, E); }
}
__device__ __forceinline__ void phase_g2(const Args& A, const Ctx& C, int l) {
    const bool mls = (l & 1) == 0; const int j = l >> 1; const int nrows = (l <= 1) ? NR : NL;
    DenseSched S; S.init(A.ws + WS_HM, A.ws + (mls ? WS_WAOUT : WS_WBOUT) + (size_t)j * D * D * 2, nrows, D, D, C.G, C.bid);
    EpiStore E{(bf16*)(A.ws + WS_HB), D, 1.0f, 1 << 30, nullptr}; gemm_phase<EpiStore, DenseSched, false>(C.lds, D, S, E);
}
__device__ __forceinline__ void phase_m1(const Args& A, const Ctx& C, int l) {
    LAS MoeTab* T = (LAS MoeTab*)(C.lds + LDS_TAB); LAS unsigned* ridx = (LAS unsigned*)(C.lds + LDS_TAB + 1024);
    moe_tables<true>(A, C, l, 4, T, ridx, D * 2);
    MoeSched S; S.T = T; S.ridx = ridx; S.A = (const char*)(A.ws + WS_HB); S.W = (const char*)(A.ws + WS_WGU); S.wstride_e = (size_t)2 * DE * D * 2; S.tstepB = (size_t)BM * D * 2; S.K = D; S.arow_bytes = 0;
    EpiPair<1> E{(bf16*)(A.ws + WS_DC), DE, 0}; gemm_phase<EpiPair<1>, MoeSched, true>(C.lds, D, S, E);
}
__device__ __forceinline__ void phase_m2(const Args& A, const Ctx& C, int l) {
    LAS MoeTab* T = (LAS MoeTab*)(C.lds + LDS_TAB); LAS unsigned* ridx = (LAS unsigned*)(C.lds + LDS_TAB + 1024);
    moe_tables<false>(A, C, l, 4, T, ridx, DE * 2);
    MoeSched S; S.T = T; S.ridx = ridx; S.A = (const char*)(A.ws + WS_DC); S.W = (const char*)(A.ws + WS_WDN); S.wstride_e = (size_t)D * DE * 2; S.tstepB = (size_t)BM * DE * 2; S.K = DE; S.arow_bytes = DE * 2;
    EpiStoreTile E{(bf16*)(A.ws + WS_PB), D}; gemm_phase<EpiStoreTile, MoeSched, false>(C.lds, DE, S, E);
}

typedef float f32x16 __attribute__((ext_vector_type(16)));
typedef float f32x2 __attribute__((ext_vector_type(2)));
typedef __bf16 bf16x2_t __attribute__((ext_vector_type(2)));
#define MFMA32(a, b, c) __builtin_amdgcn_mfma_f32_32x32x16_bf16((a), (b), (c), 0, 0, 0)
__device__ __forceinline__ unsigned cvt2(float lo, float hi) { const f32x2 v = {lo, hi}; return __builtin_bit_cast(unsigned, __builtin_convertvector(v, bf16x2_t)); }
__device__ __forceinline__ bf16x8 pack8(float a0, float a1, float a2, float a3, float a4, float a5, float a6, float a7) {
    u32x4 p; p.x = cvt2(a0, a1); p.y = cvt2(a2, a3); p.z = cvt2(a4, a5); p.w = cvt2(a6, a7); return __builtin_bit_cast(bf16x8, p); }
__device__ __forceinline__ float bflo(unsigned w) { return __uint_as_float(w << 16); }
__device__ __forceinline__ float bfhi(unsigned w) { return __uint_as_float(w & 0xffff0000u); }
__device__ __forceinline__ int vt_tile(int b, int h, int blk) { return (blk == 0 ? 128 + b : b * 64 + blk - 1) * NH + h; }

__device__ __forceinline__ float wave_incl_scan(float v, int lane) {
#pragma unroll
    for (int o = 1; o < 64; o <<= 1) { const float t = __shfl_up(v, o); v += (lane >= o) ? t : 0.f; }
    return v;
}
__device__ __forceinline__ void block_gates(const Args& A, int row0, int h, LAS float* bf, LAS float* bb, LAS float* lif, LAS float* lib, int tid) {
    const float* GATE = (const float*)(A.ws + WS_GATE);
    if (tid < 256) { const float* g = GATE + (size_t)(row0 + tid) * 16; lif[tid] = g[0 + h]; bf[tid] = g[4 + h]; lib[tid] = g[8 + h]; bb[tid] = g[12 + h]; }
    __syncthreads();
    const int lane = tid & 63, wv = tid >> 6;
    if (wv == 0) { f32x4 x = *(LAS f32x4*)(bf + 4 * lane); x.y += x.x; x.z += x.y; x.w += x.z; const float tot = wave_incl_scan(x.w, lane); const float ex = tot - x.w;
        x.x += ex; x.y += ex; x.z += ex; x.w += ex; *(LAS f32x4*)(bf + 4 * lane) = x; }
    if (wv == 1) { f32x4 y = *(LAS f32x4*)(bb + 4 * (63 - lane)); y.z += y.w; y.y += y.z; y.x += y.y; const float tot = wave_incl_scan(y.x, lane); const float ex = tot - y.x;
        y.x += ex; y.y += ex; y.z += ex; y.w += ex; *(LAS f32x4*)(bb + 4 * (63 - lane)) = y; }
    __syncthreads();
}
__device__ __forceinline__ void phase_s1(const Args& A, const Ctx& C, int l) {
    LAS float* bf = (LAS float*)C.lds; LAS float* bb = bf + 256; LAS float* lif = bb + 256; LAS float* lib = lif + 256; LAS float* af = lib + 256; LAS float* ab = af + 256;
    constexpr int KP = 528;
    LAS unsigned char* KTf = C.lds + 8192; LAS unsigned char* KTb = KTf + 128 * KP;
    const bf16* P = (const bf16*)(A.ws + WS_PB); const bf16* VT = (const bf16*)(A.ws + WS_VT);
    float* DC = (float*)(A.ws + WS_DC); float* DN = (float*)(A.ws + WS_DN); float* BT = (float*)(A.ws + WS_BTOT);
    const int r = C.lane & 31, hh = C.lane >> 5, w = C.wave;
    for (int u = C.bid; u < NUNIT; u += C.G) {
        const int blk = u % NBLK, bh = u / NBLK, h = bh % NH, b = bh / NH; const int row0 = blk_row0(b, blk);
        block_gates(A, row0, h, bf, bb, lif, lib, C.tid);
        if (C.tid < 256) { af[C.tid] = __expf(bf[255] - bf[C.tid] + lif[C.tid]); ab[C.tid] = __expf(bb[0] - bb[C.tid] + lib[C.tid]); }
        if (C.tid == 0) { BT[u * 2 + 0] = bf[255]; BT[u * 2 + 1] = bb[0]; }
        __syncthreads();
        { const int sp = C.tid >> 2, dq = C.tid & 3, s0 = 2 * sp;
          const bf16* k0 = P + (size_t)(row0 + s0) * PW + NQ + h * DQK + 32 * dq;
          const float f0 = af[s0], f1 = af[s0 + 1], g0 = ab[s0], g1 = ab[s0 + 1];
#pragma unroll
          for (int c = 0; c < 4; ++c) { const u32x4 x0 = *(const u32x4*)(k0 + 8 * c), x1 = *(const u32x4*)(k0 + PW + 8 * c);
#pragma unroll
              for (int q = 0; q < 4; ++q) { const int d = 32 * dq + 8 * c + 2 * q;
                  const float a0 = bflo(x0[q]), a1 = bfhi(x0[q]), c0 = bflo(x1[q]), c1 = bfhi(x1[q]);
                  *(LAS unsigned*)(KTf + d * KP + s0 * 2) = cvt2(a0 * f0, c0 * f1); *(LAS unsigned*)(KTf + (d + 1) * KP + s0 * 2) = cvt2(a1 * f0, c1 * f1);
                  *(LAS unsigned*)(KTb + d * KP + s0 * 2) = cvt2(a0 * g0, c0 * g1); *(LAS unsigned*)(KTb + (d + 1) * KP + s0 * 2) = cvt2(a1 * g0, c1 * g1); } } }
        __syncthreads();
        if (C.tid < 256) { const int dir = C.tid >> 7, d = C.tid & 127; LAS const unsigned* kr = (LAS const unsigned*)((dir ? KTb : KTf) + d * KP); float s = 0.f;
            for (int i = 0; i < 128; ++i) { const unsigned x = kr[i]; s += bflo(x) + bfhi(x); }
            DN[(size_t)(u * 2 + dir) * DQK + d] = s; }
        const bf16* vt = VT + (size_t)vt_tile(b, h, blk) * 65536 + (size_t)(32 * w + r) * 256 + 8 * hh;
        f32x16 accf[4], accb[4];
#pragma unroll
        for (int dt = 0; dt < 4; ++dt)
#pragma unroll
            for (int i = 0; i < 16; ++i) { accf[dt][i] = 0.f; accb[dt][i] = 0.f; }
#pragma unroll 2
        for (int ks = 0; ks < 16; ++ks) { const bf16x8 a = *(const bf16x8*)(vt + 16 * ks);
#pragma unroll
            for (int dt = 0; dt < 4; ++dt) { const int off = (dt * 32 + r) * KP + (16 * ks + 8 * hh) * 2;
                const bf16x8 b0 = *(const LAS bf16x8*)(KTf + off), b1 = *(const LAS bf16x8*)(KTb + off);
                accf[dt] = MFMA32(a, b0, accf[dt]); accb[dt] = MFMA32(a, b1, accb[dt]); } }
        float* dcf = DC + (size_t)(u * 2 + 0) * DQK * DV + (size_t)(32 * w + 4 * hh) * DQK + r; float* dcb = dcf + DQK * DV;
#pragma unroll
        for (int g = 0; g < 4; ++g) { float* pf = dcf + g * 8 * DQK; float* pb = dcb + g * 8 * DQK; asm volatile("" : "+v"(pf), "+v"(pb));
#pragma unroll
            for (int q = 0; q < 4; ++q)
#pragma unroll
                for (int dt = 0; dt < 4; ++dt) { pf[q * DQK + dt * 32] = accf[dt][4 * g + q]; pb[q * DQK + dt * 32] = accb[dt][4 * g + q]; } }
        __syncthreads();
    }
}
__device__ __forceinline__ void phase_s2(const Args& A, const Ctx& C) {
    const float* DC = (const float*)(A.ws + WS_DC); const float* DN = (const float*)(A.ws + WS_DN); const float* BT = (const float*)(A.ws + WS_BTOT);
    bf16* CST = (bf16*)(A.ws + WS_CST); float* NST = (float*)(A.ws + WS_NST);
    constexpr int EL4 = DQK * DV / 4;
    for (int g = C.bid * NT + C.tid; g < BATCH * NH * 2 * EL4; g += C.G * NT) {
        const int e4 = (g % EL4) * 4, ch = g / EL4, dir = ch & 1, bh = ch >> 1;
        f32x4 st = (f32x4){0.f, 0.f, 0.f, 0.f};
        for (int idx = 0; idx < NBLK; ++idx) {
            const int blk = dir == 0 ? idx : (idx == 0 ? 0 : NBLK - idx); const int u = bh * NBLK + blk;
            const float dec = __expf(BT[u * 2 + dir]);
            const f32x4 dc = *(const f32x4*)(DC + (size_t)(u * 2 + dir) * DQK * DV + e4);
            u32x2 o; o.x = cvt2(st.x, st.y); o.y = cvt2(st.z, st.w);
            *(u32x2*)(CST + (size_t)(u * 2 + dir) * DQK * DV + e4) = o;
            st = st * dec + dc;
        }
    }
    for (int g = C.bid * NT + C.tid; g < BATCH * NH * 2 * DQK; g += C.G * NT) {
        const int d = g % DQK, ch = g / DQK, dir = ch & 1, bh = ch >> 1; float st = 0.f;
        for (int idx = 0; idx < NBLK; ++idx) {
            const int blk = dir == 0 ? idx : (idx == 0 ? 0 : NBLK - idx); const int u = bh * NBLK + blk;
            NST[(size_t)(u * 2 + dir) * DQK + d] = st; st = __expf(BT[u * 2 + dir]) * st + DN[(size_t)(u * 2 + dir) * DQK + d];
        }
    }
}
__device__ __forceinline__ void phase_s3(const Args& A, const Ctx& C, int l) {
    const int jl = l >> 1; const bool ctx_out = (l == 0);
    LAS float* bf = (LAS float*)C.lds; LAS float* bb = bf + 256; LAS float* gf = bb + 256; LAS float* gb = gf + 256;
    LAS float* nf = gb + 256; LAS float* nb = nf + 128; LAS float* hgl = nb + 128;
    constexpr int KP = 272, VP = 136, CP = 144;
    LAS unsigned char* Kimg = C.lds + 6144;
    LAS unsigned char* CH = Kimg + 256 * KP;
    LAS float* ssx = (LAS float*)(CH + 256 * CP);
    const bf16* P = (const bf16*)(A.ws + WS_PB); const bf16* VT = (const bf16*)(A.ws + WS_VT); bf16* HM = (bf16*)(A.ws + WS_HM);
    const bf16* CST = (const bf16*)(A.ws + WS_CST); const float* NST = (const float*)(A.ws + WS_NST);
    const float* hg = A.in[10] + (size_t)jl * NV;
    const int w = C.wave, eh = w >> 2;
    for (int u = C.bid; u < NUNIT; u += C.G) {
        const int blk = u % NBLK, bh = u / NBLK, h = bh % NH, b = bh / NH; const int row0 = blk_row0(b, blk);
        if (blk == 0 && !ctx_out) continue;
        block_gates(A, row0, h, bf, bb, gf, gb, C.tid);
        if (C.tid < 256) { gf[C.tid] -= bf[C.tid]; gb[C.tid] -= bb[C.tid]; hgl[C.tid] = hg[h * DV + C.tid]; }
        else { const int t = C.tid - 256; nf[t] = NST[(size_t)(u * 2 + (t >> 7)) * DQK + (t & 127)]; }
        { const int s = C.tid >> 1, half = C.tid & 1; const bf16* kr = P + (size_t)(row0 + s) * PW + NQ + h * DQK + 64 * half;
#pragma unroll
          for (int c = 0; c < 8; ++c) *(LAS u32x4*)(Kimg + s * KP + half * 128 + c * 16) = *(const u32x4*)(kr + 8 * c); }
        __syncthreads();
        const bf16* vtile = VT + (size_t)vt_tile(b, h, blk) * 65536;
#pragma unroll 1
        for (int ps = 0; ps < 2; ++ps) {
            int lz = threadIdx.x & 63; asm volatile("" : "+v"(lz));
            const int r = lz & 31, hh = lz >> 5;
            const int jt = 2 * (w & 3) + ps; const int jrow = row0 + 32 * jt + r;
            bf16x8 qf[8];
            { const bf16* qr = P + (size_t)jrow * PW + h * DQK + 8 * hh;
#pragma unroll
              for (int kk = 0; kk < 8; ++kk) qf[kk] = *(const bf16x8*)(qr + 16 * kk); }
            const float bfj = bf[32 * jt + r], bbj = bb[32 * jt + r];
            float qnf = 0.f, qnb = 0.f;
#pragma unroll
            for (int kk = 0; kk < 8; ++kk) { const u32x4 qq = __builtin_bit_cast(u32x4, qf[kk]); const int d = 16 * kk + 8 * hh;
                const f32x4 n0 = *(const LAS f32x4*)(nf + d), n1 = *(const LAS f32x4*)(nf + d + 4), m0 = *(const LAS f32x4*)(nb + d), m1 = *(const LAS f32x4*)(nb + d + 4);
                qnf += (bflo(qq.x) * n0.x + bfhi(qq.x) * n0.y) + (bflo(qq.y) * n0.z + bfhi(qq.y) * n0.w) + (bflo(qq.z) * n1.x + bfhi(qq.z) * n1.y) + (bflo(qq.w) * n1.z + bfhi(qq.w) * n1.w);
                qnb += (bflo(qq.x) * m0.x + bfhi(qq.x) * m0.y) + (bflo(qq.y) * m0.z + bfhi(qq.y) * m0.w) + (bflo(qq.z) * m1.x + bfhi(qq.z) * m1.y) + (bflo(qq.w) * m1.z + bfhi(qq.w) * m1.w);
                if (kk & 1) asm volatile("" ::: "memory"); }
            qnf += __shfl_xor(qnf, 32); qnb += __shfl_xor(qnb, 32);
            float denf = 0.f, denb = 0.f;
#pragma unroll 1
            for (int kt = 0; kt < 8; ++kt) {
                f32x16 c;
#pragma unroll
                for (int i = 0; i < 16; ++i) c[i] = 0.f;
#pragma unroll
                for (int kk = 0; kk < 8; ++kk) { const bf16x8 a = *(const LAS bf16x8*)(Kimg + (kt * 32 + r) * KP + (16 * kk + 8 * hh) * 2); c = MFMA32(a, qf[kk], c); if ((kk & 3) == 3) asm volatile("" ::: "memory"); }
#pragma unroll
                for (int g = 0; g < 4; ++g) { const int sl0 = 8 * g + 4 * hh;
                    const f32x4 g4f = *(const LAS f32x4*)(gf + kt * 32 + sl0), g4b = *(const LAS f32x4*)(gb + kt * 32 + sl0);
#pragma unroll
                    for (int q = 0; q < 4; ++q) { const int sl = sl0 + q; const float cv = c[4 * g + q];
                        if (kt <= jt) { const bool act = (kt < jt) || (sl <= r); denf += cv * __expf(act ? bfj + g4f[q] : -1.0e30f); }
                        if (kt >= jt) { const bool act = (kt > jt) || (sl >= r); denb += cv * __expf(act ? bbj + g4b[q] : -1.0e30f); } } }
            }
            denf += __shfl_xor(denf, 32); denb += __shfl_xor(denb, 32);
            const float ebf = __expf(bfj), ebb = __expf(bbj);
            denf += ebf * qnf; denb += ebb * qnb;
            const float rf = 1.0f / fmaxf(fabsf(denf), 1.0f), rb = 1.0f / fmaxf(fabsf(denb), 1.0f);
            f32x16 acc[4];
#pragma unroll
            for (int et = 0; et < 4; ++et)
#pragma unroll
                for (int i = 0; i < 16; ++i) acc[et][i] = 0.f;
#pragma unroll 1
            for (int ch = 0; ch < 4; ++ch) {
                __syncthreads();
                { int tz = threadIdx.x; asm volatile("" : "+v"(tz)); const int e = tz >> 1, half = tz & 1; const bf16* vr = vtile + (size_t)e * 256 + 64 * ch + 32 * half;
#pragma unroll
                  for (int c4 = 0; c4 < 4; ++c4) { const u32x4 x = *(const u32x4*)(vr + 8 * c4);
                      *(LAS u32x2*)(CH + e * VP + half * 64 + c4 * 16) = (u32x2){x.x, x.y}; *(LAS u32x2*)(CH + e * VP + half * 64 + c4 * 16 + 8) = (u32x2){x.z, x.w}; } }
                __syncthreads();
#pragma unroll 1
                for (int kt2 = 0; kt2 < 2; ++kt2) { const int kt = 2 * ch + kt2;
                    f32x16 c;
#pragma unroll
                    for (int i = 0; i < 16; ++i) c[i] = 0.f;
#pragma unroll
                    for (int kk = 0; kk < 8; ++kk) { const bf16x8 a = *(const LAS bf16x8*)(Kimg + (kt * 32 + r) * KP + (16 * kk + 8 * hh) * 2); c = MFMA32(a, qf[kk], c); if ((kk & 3) == 3) asm volatile("" ::: "memory"); }
                    float p[16];
#pragma unroll
                    for (int g = 0; g < 4; ++g) { const int sl0 = 8 * g + 4 * hh;
                        const f32x4 g4f = *(const LAS f32x4*)(gf + kt * 32 + sl0), g4b = *(const LAS f32x4*)(gb + kt * 32 + sl0);
#pragma unroll
                        for (int q = 0; q < 4; ++q) { const int sl = sl0 + q; float wt = 0.f;
                            if (kt <= jt) { const bool act = (kt < jt) || (sl <= r); wt += rf * __expf(act ? bfj + g4f[q] : -1.0e30f); }
                            if (kt >= jt) { const bool act = (kt > jt) || (sl >= r); wt += rb * __expf(act ? bbj + g4b[q] : -1.0e30f); }
                            p[4 * g + q] = c[4 * g + q] * wt; } }
                    const bf16x8 pa0 = pack8(p[0], p[1], p[2], p[3], p[4], p[5], p[6], p[7]), pa1 = pack8(p[8], p[9], p[10], p[11], p[12], p[13], p[14], p[15]);
#pragma unroll
                    for (int et = 0; et < 4; ++et) { LAS const unsigned char* vb = CH + ((4 * eh + et) * 32 + r) * VP + (kt2 * 32 + 4 * hh) * 2;
                        const u32x2 l0 = *(LAS const u32x2*)(vb), h0 = *(LAS const u32x2*)(vb + 16), l1 = *(LAS const u32x2*)(vb + 32), h1 = *(LAS const u32x2*)(vb + 48);
                        const bf16x8 a0 = __builtin_bit_cast(bf16x8, (u32x4){l0.x, l0.y, h0.x, h0.y}), a1 = __builtin_bit_cast(bf16x8, (u32x4){l1.x, l1.y, h1.x, h1.y});
                        acc[et] = MFMA32(a0, pa0, acc[et]); acc[et] = MFMA32(a1, pa1, acc[et]); asm volatile("" ::: "memory"); }
                }
            }
#pragma unroll 1
            for (int dir = 0; dir < 2; ++dir) {
                const float sc = dir ? ebb * rb : ebf * rf;
#pragma unroll
                for (int dh = 0; dh < 2; ++dh) {
                    __syncthreads();
                    { int tz = threadIdx.x; asm volatile("" : "+v"(tz)); const int e = tz >> 1, half = tz & 1; const bf16* cr = CST + (size_t)(u * 2 + dir) * DQK * DV + (size_t)e * DQK + 64 * dh + 32 * half;
#pragma unroll
                      for (int c4 = 0; c4 < 4; ++c4) *(LAS u32x4*)(CH + e * CP + half * 64 + c4 * 16) = *(const u32x4*)(cr + 8 * c4); }
                    __syncthreads();
#pragma unroll
                    for (int k4 = 0; k4 < 4; ++k4) { const u32x4 qq = __builtin_bit_cast(u32x4, qf[4 * dh + k4]);
                        const bf16x8 qs = pack8(bflo(qq.x) * sc, bfhi(qq.x) * sc, bflo(qq.y) * sc, bfhi(qq.y) * sc, bflo(qq.z) * sc, bfhi(qq.z) * sc, bflo(qq.w) * sc, bfhi(qq.w) * sc);
#pragma unroll
                        for (int et = 0; et < 4; ++et) { const bf16x8 a = *(const LAS bf16x8*)(CH + ((4 * eh + et) * 32 + r) * CP + (16 * k4 + 8 * hh) * 2); acc[et] = MFMA32(a, qs, acc[et]); } asm volatile("" ::: "memory"); }
                }
            }
            float ss = 0.f;
#pragma unroll
            for (int et = 0; et < 4; ++et)
#pragma unroll
                for (int i = 0; i < 16; ++i) ss += acc[et][i] * acc[et][i];
            ss += __shfl_xor(ss, 32);
            __syncthreads();
            if (hh == 0) ssx[w * 32 + r] = ss;
            __syncthreads();
            ss += ssx[(w ^ 4) * 32 + r];
            const float rs = 1.0f / sqrtf(ss * (1.0f / DV) + EPS);
            int lz2 = threadIdx.x & 63; asm volatile("" : "+v"(lz2)); const int jrow2 = row0 + 32 * jt + (lz2 & 31), hh2 = lz2 >> 5;
            const bf16* orow = P + (size_t)jrow2 * PW + 2 * NQ + NV + h * DV + 4 * hh2; bf16* hrow = HM + (size_t)jrow2 * D + h * DV + 4 * hh2; LAS const float* hgl2 = hgl + 4 * hh2;
#pragma unroll
            for (int et = 0; et < 4; ++et)
#pragma unroll
                for (int g = 0; g < 4; ++g) { const int e0 = (4 * eh + et) * 32 + 8 * g;
                    const u32x2 ow = *(const u32x2*)(orow + e0); const f32x4 gn = *(const LAS f32x4*)(hgl2 + e0);
                    u32x2 o; o.x = cvt2(acc[et][4 * g + 0] * rs * gn.x * bflo(ow.x), acc[et][4 * g + 1] * rs * gn.y * bfhi(ow.x));
                    o.y = cvt2(acc[et][4 * g + 2] * rs * gn.z * bflo(ow.y), acc[et][4 * g + 3] * rs * gn.w * bfhi(ow.y));
                    *(u32x2*)(hrow + e0) = o; asm volatile("" ::: "memory"); }
        }
        __syncthreads();
    }
}

#define XB_TMO      128
#define XB_XCNT(j)  (256  + 64 * (j))
#define XB_XSUB(j)  (1280 + 64 * (j))
#define XB_XGEN(j)  (2304 + 64 * (j))
#define XB_TOP      3328
#define XB_TOPGEN   3392
#define XCD_BAR_WORDS 3456
#define XB_SPIN_CAP (1u << 18)

__device__ __forceinline__ unsigned xb_ld(unsigned* p)              { return __hip_atomic_load(p, __ATOMIC_RELAXED, __HIP_MEMORY_SCOPE_AGENT); }
__device__ __forceinline__ unsigned xb_add(unsigned* p, unsigned v) { return __hip_atomic_fetch_add(p, v, __ATOMIC_RELAXED, __HIP_MEMORY_SCOPE_AGENT); }
__device__ __forceinline__ unsigned xb_xcc_id() { return (unsigned)__builtin_amdgcn_s_getreg((3 << 11) | 20) & 0xFu; }
#define XB_SPIN(cond, bar) do { unsigned _sp = 0; while (cond) { __builtin_amdgcn_s_sleep(1); \
    if ((++_sp & 255u) == 0u) { if (xb_ld(&(bar)[XB_TMO])) break; if (_sp > XB_SPIN_CAP) { atomicAdd(&(bar)[XB_TMO], 1u); break; } } } } while (0)

struct XcdBarrier {
    unsigned* bar; unsigned x;
    volatile LAS unsigned* st;
};

__device__ __forceinline__ XcdBarrier xcd_barrier_post(unsigned* bar, volatile LAS unsigned* st) {
    XcdBarrier b; b.bar = bar; b.x = xb_xcc_id(); b.st = st;
    if (threadIdx.x == 0) (void)xb_add(&bar[XB_XCNT(b.x)], 1u);
    return b;
}
__device__ __forceinline__ void xcd_barrier_complete(unsigned* bar, unsigned x, unsigned& nloc, unsigned& nx) {
    const unsigned G = gridDim.x * gridDim.y * gridDim.z;
    unsigned sum, cnt, mine, sp = 0u;
    for (;;) {
        sum = 0u; cnt = 0u; mine = 0u;
#pragma unroll
        for (unsigned j = 0; j < 16; ++j) { const unsigned c = xb_ld(&bar[XB_XCNT(j)]); sum += c; cnt += (c > 0u) ? 1u : 0u; mine = (j == x) ? c : mine; }
        if (sum == G) break;
        __builtin_amdgcn_s_sleep(1);
        if ((++sp & 255u) == 0u) { if (xb_ld(&bar[XB_TMO])) break; if (sp > XB_SPIN_CAP) { atomicAdd(&bar[XB_TMO], 1u); break; } }
    }
    nloc = mine > 0u ? mine : 1u; nx = cnt > 0u ? cnt : 1u;
}

__device__ __forceinline__ void xcd_barrier(const XcdBarrier& b) {
    asm volatile("s_waitcnt vmcnt(0)" ::: "memory");
    __syncthreads();
    if (threadIdx.x == 0) {
        unsigned* bar = b.bar;
        __builtin_amdgcn_s_waitcnt(0);
        unsigned nloc = b.st[0], nx = b.st[1];
        if (nloc == 0u) { xcd_barrier_complete(bar, b.x, nloc, nx); b.st[0] = nloc; b.st[1] = nx; }
        const unsigned old = xb_add(&bar[XB_XSUB(b.x)], 1u);
        const unsigned gen = old / nloc;
        if (old + 1u == (gen + 1u) * nloc) {
            __builtin_amdgcn_fence(__ATOMIC_RELEASE, "agent");
            asm volatile("s_waitcnt vmcnt(0)" ::: "memory");
            const unsigned og = xb_add(&bar[XB_TOP], 1u);
            const unsigned tg = og / nx;
            if (og + 1u == (tg + 1u) * nx) xb_add(&bar[XB_TOPGEN], 1u);
            else XB_SPIN(xb_ld(&bar[XB_TOPGEN]) == tg, bar);
            __builtin_amdgcn_fence(__ATOMIC_ACQUIRE, "agent");
            xb_add(&bar[XB_XGEN(b.x)], 1u);
            asm volatile("s_waitcnt vmcnt(0)" ::: "memory");
        } else {
            XB_SPIN(xb_ld(&bar[XB_XGEN(b.x)]) == gen, bar);
            __builtin_amdgcn_fence(__ATOMIC_ACQUIRE, "agent");
            asm volatile("s_waitcnt vmcnt(0)" ::: "memory");
        }
    }
    __syncthreads();
}


constexpr int LDS_BYTES = 152 * 1024;
constexpr int CW_BAR = 8192;
static_assert((CW_BAR + XCD_BAR_WORDS) * 4 <= (int)CTL_BYTES, "ctl");
#ifndef MK_MULTI
#define MK_MULTI 0
#endif
#define IN(p) (lo <= (p) && (p) < hi)
#define SEAM(p) do { if ((p) + 1 < hi) xcd_barrier(bar); } while (0)
template <int L> __device__ __forceinline__ void layer_phases(const Args& args, const Ctx& C, const XcdBarrier& bar, int lo, int hi) {
    constexpr int pb = 16 * L;
    if (IN(pb + 1)) { phase_cvt_moe(args, C, L); __syncthreads(); phase_r1(args, C, L); SEAM(pb + 1); }
    if (IN(pb + 2)) { phase_g1(args, C, L); SEAM(pb + 2); }
    if constexpr ((L & 1) == 0) {
        if (IN(pb + 3)) { phase_s1(args, C, L); SEAM(pb + 3); }
        if (IN(pb + 4)) { phase_s2(args, C); SEAM(pb + 4); }
        if (IN(pb + 5)) { phase_s3(args, C, L); SEAM(pb + 5); }
    } else {
        if (IN(pb + 3)) { phase_conv(args, C, L); SEAM(pb + 3); }
    }
    if (IN(pb + 6)) { phase_g2(args, C, L); SEAM(pb + 6); }
    if (IN(pb + 7)) { phase_r2(args, C, L); SEAM(pb + 7); }
    if (IN(pb + 8)) { phase_m1(args, C, L); SEAM(pb + 8); }
    if (IN(pb + 9)) { phase_m2(args, C, L); SEAM(pb + 9); }
}
__global__ void __launch_bounds__(NT, 2) fwd_kernel(Args args) {
    extern __shared__ __attribute__((aligned(16))) unsigned char lds_raw[];
    Ctx C; C.lds = (LAS unsigned char*)lds_raw; C.tid = threadIdx.x; C.lane = C.tid & 63; C.wave = __builtin_amdgcn_readfirstlane(C.tid >> 6); C.G = gridDim.x; C.bid = blockIdx.x; C.a = &args;
    const int lo = args.lo, hi = args.hi;
    volatile LAS unsigned* xbw = (volatile LAS unsigned*)(C.lds + LDS_BYTES - 16);
    if (C.tid < 4) xbw[C.tid] = 0u;
    __syncthreads();
    XcdBarrier bar; bar.bar = (unsigned*)(args.ws + WS_CTL) + CW_BAR; bar.x = 0; bar.st = xbw;
    if (hi - lo > 1) bar = xcd_barrier_post((unsigned*)(args.ws + WS_CTL) + CW_BAR, xbw);
    if (IN(0)) { phase_mod(args, C); __syncthreads(); phase_cvt_mixer(args, C); SEAM(0); }
    layer_phases<0>(args, C, bar, lo, hi);
    layer_phases<1>(args, C, bar, lo, hi);
    layer_phases<2>(args, C, bar, lo, hi);
    layer_phases<3>(args, C, bar, lo, hi);
    if (IN(64)) phase_final(args, C);
}
#undef IN
#undef SEAM

extern "C" void kernel_launch(void* const* d_in, const int* in_sizes, int n_in, void* d_out, int out_size, void* d_ws, size_t ws_size, hipStream_t stream) {
    static int grid = 0;
    if (grid == 0) {
        if (n_in != 22 || out_size != NL * D || ws_size < WS_END) { fprintf(stderr, "kernel_launch: unexpected shapes (n_in %d out %d ws %zu)\n", n_in, out_size, ws_size); grid = -1; return; }
        int dev = 0, cus = 0, per_cu = 0;
        if (hipGetDevice(&dev) != hipSuccess || hipDeviceGetAttribute(&cus, hipDeviceAttributeMultiprocessorCount, dev) != hipSuccess) { grid = -1; return; }
        if (hipFuncSetAttribute((const void*)fwd_kernel, hipFuncAttributeMaxDynamicSharedMemorySize, LDS_BYTES) != hipSuccess) { grid = -1; return; }
        if (hipOccupancyMaxActiveBlocksPerMultiprocessor(&per_cu, (const void*)fwd_kernel, NT, LDS_BYTES) != hipSuccess || per_cu < 1) { fprintf(stderr, "kernel_launch: occupancy query says %d\n", per_cu); }
        (void)hipGetLastError();
        grid = cus;
    }
    if (grid < 0) return;
    (void)hipMemsetAsync((char*)d_ws + WS_CTL, 0, CTL_BYTES, stream);
    Args a{};
    for (int i = 0; i < 22; ++i) a.in[i] = (const float*)d_in[i];
    a.out = (float*)d_out; a.ws = (unsigned char*)d_ws;
#if MK_MULTI
    int phases[64]; int np = 0;
    phases[np++] = 0;
    for (int l = 0; l < DEPTH; ++l) { const int pb = 16 * l; phases[np++] = pb + 1; phases[np++] = pb + 2; phases[np++] = pb + 3;
        if ((l & 1) == 0) { phases[np++] = pb + 4; phases[np++] = pb + 5; }
        phases[np++] = pb + 6; phases[np++] = pb + 7; phases[np++] = pb + 8; phases[np++] = pb + 9; }
    phases[np++] = 64;
    for (int i = 0; i < np; ++i) { a.lo = phases[i]; a.hi = phases[i] + 1; hipLaunchKernelGGL(fwd_kernel, dim3(grid), dim3(NT), LDS_BYTES, stream, a); }
#else
    a.lo = 0; a.hi = 65;
    hipLaunchKernelGGL(fwd_kernel, dim3(grid), dim3(NT), LDS_BYTES, stream, a);
#endif
}
```

```cpp
#include <hip/hip_runtime.h>
#include <cstdio>
#include <cstdint>

#define LAS __attribute__((address_space(3)))
typedef unsigned short bf16;
typedef float f32x4 __attribute__((ext_vector_type(4)));
typedef unsigned u32x4 __attribute__((ext_vector_type(4)));
typedef unsigned u32x2 __attribute__((ext_vector_type(2)));

constexpr int D = 1024, BATCH = 2, SEQ = 16384, DEPTH = 4, CTXL = 256;
constexpr int NL = BATCH * SEQ, NCX = BATCH * CTXL, NR = NL + NCX;
constexpr int NH = 4, DQK = 128, DV = 256, NQ = 512, NV = 1024, PROJ = 3088, PW = 3072;
constexpr int NGRP = 4, EPG = 8, NE = 32, DE = 512;
constexpr int NBLK = 65;
constexpr int NUNIT = BATCH * NH * NBLK;
constexpr int CAP = NR;
constexpr int YROWS = 74752;
constexpr float EPS = 1e-6f;
constexpr int NT = 512, NW = 8;
constexpr int LDS_TAB_END = 152 * 1024 - 16;

constexpr size_t MiB = 1u << 20;
constexpr size_t WS_CTL = 0, CTL_BYTES = 1 * MiB;
constexpr size_t WS_MOD = 1 * MiB;
constexpr size_t WS_GATE = 2 * MiB;
constexpr size_t WS_TOKSLOT = 5 * MiB;
constexpr size_t WS_TOKW = 6 * MiB;
constexpr size_t WS_SLOTTOK = 7 * MiB;
constexpr size_t WS_DN = 12 * MiB;
constexpr size_t WS_NST = 13 * MiB;
constexpr size_t WS_BTOT = 14 * MiB;
constexpr size_t WS_LAT = 16 * MiB;
constexpr size_t WS_HB = 146 * MiB;
constexpr size_t WS_PB = 211 * MiB;
constexpr size_t WS_HM = 406 * MiB;
constexpr size_t WS_DC = 471 * MiB;
constexpr size_t WS_CST = 601 * MiB;
constexpr size_t WS_VT = 666 * MiB;
constexpr size_t WS_WAIN = 731 * MiB;
constexpr size_t WS_WBIN = 743 * MiB;
constexpr size_t WS_WAOUT = 755 * MiB;
constexpr size_t WS_WBOUT = 759 * MiB;
constexpr size_t WS_WGU = 763 * MiB;
constexpr size_t WS_WDN = 827 * MiB;
constexpr size_t WS_END = 859 * MiB;
constexpr int CW_CNT = 1024, CNT_STRIDE = 64;

struct Args { const float* in[22]; float* out; unsigned char* ws; int lo, hi; };

__device__ __forceinline__ float bf2f(bf16 v) { return __uint_as_float(((unsigned)v) << 16); }
__device__ __forceinline__ unsigned f2bf(float f) { unsigned u = __float_as_uint(f); return (u + 0x7fffu + ((u >> 16) & 1u)) >> 16; }
__device__ __forceinline__ unsigned pk2(float lo, float hi) { return f2bf(lo) | (f2bf(hi) << 16); }
template <int CTRL, int ROWMASK> __device__ __forceinline__ float dpp_mov(float x) { return __int_as_float(__builtin_amdgcn_update_dpp(0, __float_as_int(x), CTRL, ROWMASK, 0xf, false)); }
__device__ __forceinline__ float wave_sum(float v) {
    v += dpp_mov<0xB1, 0xf>(v); v += dpp_mov<0x4E, 0xf>(v); v += dpp_mov<0x141, 0xf>(v); v += dpp_mov<0x140, 0xf>(v);
    v += dpp_mov<0x142, 0xA>(v); v += dpp_mov<0x143, 0xC>(v);
    return __int_as_float(__builtin_amdgcn_readlane(__float_as_int(v), 63));
}
__device__ __forceinline__ float sigmoidf_(float x) { return 1.f / (1.f + __expf(-x)); }
__device__ __forceinline__ float siluf_(float x) { return x / (1.f + __expf(-x)); }
__device__ __forceinline__ float logsigmoidf_(float x) { return fminf(x, 0.f) - log1pf(__expf(-fabsf(x))); }
__device__ __forceinline__ int blk_row0(int b, int blk) { return blk == 0 ? NL + b * CTXL : b * SEQ + (blk - 1) * 256; }
__device__ __forceinline__ int mod_vec_of_row(int row) { return row < NL ? row / SEQ : 2; }

struct Ctx {
    LAS unsigned char* lds; int tid, lane, wave, G, bid;
    const Args* a;
};

__device__ __forceinline__ void slot_bases(const Args& A, int l, LAS int* sb, int tid) {
    if (tid == 0) {
        const unsigned* cnt = (const unsigned*)(A.ws + WS_CTL) + CW_CNT + l * 32 * CNT_STRIDE;
        int acc = 0;
        for (int e = 0; e < NE; ++e) { sb[e] = acc; acc += (((int)cnt[e * CNT_STRIDE] + 255) / 256) * 256; }
        sb[NE] = acc;
    }
    __syncthreads();
}

__device__ __forceinline__ void phase_mod(const Args& A, const Ctx& C) {
    LAS float* sc = (LAS float*)C.lds;
    LAS float* red = sc + 3072;
    const float* c = A.in[1]; const float* cc = A.in[3];
    for (int i = C.tid; i < 3072; i += NT) { const float v = i < 2048 ? c[i] : cc[i - 2048]; sc[i] = siluf_(v); }
    __syncthreads();
    float* MOD = (float*)(A.ws + WS_MOD);
    for (int u = C.bid; u < DEPTH * 96; u += C.G) {
        const int l = u / 96, cg = u % 96, col = cg * 64 + C.lane;
        const float* w = A.in[4] + (size_t)l * D * 6 * D + col;
        float a0 = 0.f, a1 = 0.f, a2 = 0.f;
        for (int k = C.wave * 128; k < C.wave * 128 + 128; ++k) { const float wv = w[(size_t)k * 6 * D]; a0 += sc[k] * wv; a1 += sc[1024 + k] * wv; a2 += sc[2048 + k] * wv; }
        red[(C.wave * 3 + 0) * 64 + C.lane] = a0; red[(C.wave * 3 + 1) * 64 + C.lane] = a1; red[(C.wave * 3 + 2) * 64 + C.lane] = a2;
        __syncthreads();
        if (C.tid < 192) { const int v = C.tid / 64, ln = C.tid % 64; float s = 0.f;
            for (int w8 = 0; w8 < 8; ++w8) s += red[(w8 * 3 + v) * 64 + ln];
            MOD[(size_t)(l * 3 + v) * 6 * D + cg * 64 + ln] = s + A.in[5][(size_t)l * 6 * D + cg * 64 + ln]; }
        __syncthreads();
    }
}

__device__ __forceinline__ void load_row_f32(const float* p, int lane, f32x4 (&v)[4]) {
#pragma unroll
    for (int j = 0; j < 4; ++j) v[j] = *(const f32x4*)(p + 4 * lane + 256 * j);
}
__device__ __forceinline__ void load_row_bf16(const bf16* p, int lane, f32x4 (&v)[4]) {
#pragma unroll
    for (int j = 0; j < 4; ++j) { const u32x2 w = *(const u32x2*)(p + 4 * lane + 256 * j);
        v[j] = (f32x4){__uint_as_float(w.x << 16), __uint_as_float(w.x & 0xffff0000u), __uint_as_float(w.y << 16), __uint_as_float(w.y & 0xffff0000u)}; }
}
__device__ __forceinline__ void store_row_bf16(bf16* p, int lane, const f32x4 (&v)[4]) {
#pragma unroll
    for (int j = 0; j < 4; ++j) { u32x2 w; w.x = pk2(v[j].x, v[j].y); w.y = pk2(v[j].z, v[j].w); *(u32x2*)(p + 4 * lane + 256 * j) = w; }
}
__device__ __forceinline__ void moe_combine(const Args& A, int lp, int row, int lane, LAS const int* sb, f32x4 (&v)[4]) {
    const int* ts = (const int*)(A.ws + WS_TOKSLOT) + row * 2; const float* tw = (const float*)(A.ws + WS_TOKW) + row * 2;
    const bf16* Y = (const bf16*)(A.ws + WS_PB);
    const int t0 = ts[0], t1 = ts[1]; const float w0 = tw[0], w1 = tw[1];
    const size_t s0 = (size_t)(sb[t0 >> 20] + (t0 & 0xfffff)), s1 = (size_t)(sb[t1 >> 20] + (t1 & 0xfffff));
    f32x4 y0[4], y1[4], g2[4];
    load_row_bf16(Y + s0 * D, lane, y0); load_row_bf16(Y + s1 * D, lane, y1);
    load_row_f32((const float*)(A.ws + WS_MOD) + (size_t)(lp * 3 + mod_vec_of_row(row)) * 6 * D + 5 * D, lane, g2);
#pragma unroll
    for (int j = 0; j < 4; ++j) v[j] += g2[j] * (y0[j] * w0 + y1[j] * w1);
}
__device__ __forceinline__ void norm_mod(const f32x4 (&v)[4], const float* g, const float* sh, const float* sc, int lane, f32x4 (&h)[4]) {
    float s = 0.f;
#pragma unroll
    for (int j = 0; j < 4; ++j) s += (v[j].x * v[j].x + v[j].y * v[j].y) + (v[j].z * v[j].z + v[j].w * v[j].w);
    const float r = 1.0f / sqrtf(wave_sum(s) * (1.f / D) + EPS);
    f32x4 gg[4], ss[4], cc[4];
    load_row_f32(g, lane, gg); load_row_f32(sh, lane, ss); load_row_f32(sc, lane, cc);
#pragma unroll
    for (int j = 0; j < 4; ++j) h[j] = (v[j] * r) * gg[j] * (1.f + cc[j]) + ss[j];
}

struct RowVec { f32x4 a[4], s[4], g[4]; };
__device__ __forceinline__ void load_rowvec(RowVec& R, const float* ng, const float* sh, const float* sc, const float* gt, int lane) {
    f32x4 n[4], c[4]; load_row_f32(ng, lane, n); load_row_f32(sc, lane, c); load_row_f32(sh, lane, R.s); if (gt) load_row_f32(gt, lane, R.g);
#pragma unroll
    for (int q = 0; q < 4; ++q) R.a[q] = n[q] * (1.f + c[q]);
}
__device__ __forceinline__ void load_row_bf16raw(const bf16* p, int lane, u32x2 (&v)[4]) {
#pragma unroll
    for (int j = 0; j < 4; ++j) v[j] = *(const u32x2*)(p + 4 * lane + 256 * j);
}
__device__ __forceinline__ f32x4 bf4(u32x2 w) { return (f32x4){__uint_as_float(w.x << 16), __uint_as_float(w.x & 0xffff0000u), __uint_as_float(w.y << 16), __uint_as_float(w.y & 0xffff0000u)}; }
__device__ __forceinline__ float row_rstd(const f32x4 (&v)[4]) {
    float s = 0.f;
#pragma unroll
    for (int j = 0; j < 4; ++j) s += (v[j].x * v[j].x + v[j].y * v[j].y) + (v[j].z * v[j].z + v[j].w * v[j].w);
    return 1.0f / sqrtf(wave_sum(s) * (1.f / D) + EPS);
}

__device__ __forceinline__ void phase_r1(const Args& A, const Ctx& C, int l) {
    LAS int* sb = (LAS int*)C.lds;
    LAS float* GW = (LAS float*)(C.lds + 256);
    const bool mls = (l & 1) == 0; const int j = l >> 1;
    if (l > 0) slot_bases(A, l - 1, sb, C.tid);
    if (mls) { const float* w = A.in[8] + (size_t)j * D * PROJ + PW;
        f32x4 t[2][4];
#pragma unroll
        for (int jj = 0; jj < 2; ++jj)
#pragma unroll
            for (int q = 0; q < 4; ++q) t[jj][q] = *(const f32x4*)(w + (size_t)(C.tid + NT * jj) * PROJ + 4 * q);
#pragma unroll
        for (int jj = 0; jj < 2; ++jj)
#pragma unroll
            for (int q = 0; q < 4; ++q) { const int k = C.tid + NT * jj; GW[(4 * q + 0) * D + k] = t[jj][q].x; GW[(4 * q + 1) * D + k] = t[jj][q].y; GW[(4 * q + 2) * D + k] = t[jj][q].z; GW[(4 * q + 3) * D + k] = t[jj][q].w; }
        __syncthreads(); }
    const int nrows = (l <= 2) ? NR : NL;
    bf16* LAT = (bf16*)(A.ws + WS_LAT); bf16* H = (bf16*)(A.ws + WS_HB); float* GATE = (float*)(A.ws + WS_GATE);
    const float* MOD = (const float*)(A.ws + WS_MOD); const bf16* Y = (const bf16*)(A.ws + WS_PB);
    const int* TS = (const int*)(A.ws + WS_TOKSLOT); const float* TW = (const float*)(A.ws + WS_TOKW);
    const int rpw = (((nrows + C.G - 1) / C.G) + 1) & ~1; const int wrow0 = C.bid * rpw; const int wend = min(wrow0 + rpw, nrows);
    for (int sa = wrow0; sa < wend;) {
        const int mvi = mod_vec_of_row(sa); const int bnd = mvi == 0 ? SEQ : (mvi == 1 ? NL : NR); const int sbnd = min(wend, bnd);
        RowVec RV; { const float* mv = MOD + (size_t)(l * 3 + mvi) * 6 * D;
            load_rowvec(RV, A.in[6] + (size_t)(l * 2 + 0) * D, mv + 0 * D, mv + 1 * D, l > 0 ? MOD + (size_t)((l - 1) * 3 + mvi) * 6 * D + 5 * D : nullptr, C.lane); }
        for (int ra = sa + 2 * C.wave; ra < sbnd; ra += 2 * NW) {
            const bool hasb = ra + 1 < sbnd; const int rb = hasb ? ra + 1 : ra;
            f32x4 va[4], vb[4]; float wa0 = 0.f, wa1 = 0.f, wb0 = 0.f, wb1 = 0.f;
            if (l == 0) { load_row_f32(ra < NL ? A.in[0] + (size_t)ra * D : A.in[2] + (size_t)(ra - NL) * D, C.lane, va); load_row_f32(rb < NL ? A.in[0] + (size_t)rb * D : A.in[2] + (size_t)(rb - NL) * D, C.lane, vb); }
            else {
                const int ta0 = TS[ra * 2], ta1 = TS[ra * 2 + 1], tb0 = TS[rb * 2], tb1 = TS[rb * 2 + 1]; wa0 = TW[ra * 2]; wa1 = TW[ra * 2 + 1]; wb0 = TW[rb * 2]; wb1 = TW[rb * 2 + 1];
                load_row_bf16(LAT + (size_t)ra * D, C.lane, va); load_row_bf16(LAT + (size_t)rb * D, C.lane, vb);
                u32x2 ya0[4], ya1[4], yb0[4], yb1[4];
                load_row_bf16raw(Y + (size_t)(sb[ta0 >> 20] + (ta0 & 0xfffff)) * D, C.lane, ya0); load_row_bf16raw(Y + (size_t)(sb[ta1 >> 20] + (ta1 & 0xfffff)) * D, C.lane, ya1);
                load_row_bf16raw(Y + (size_t)(sb[tb0 >> 20] + (tb0 & 0xfffff)) * D, C.lane, yb0); load_row_bf16raw(Y + (size_t)(sb[tb1 >> 20] + (tb1 & 0xfffff)) * D, C.lane, yb1);
#pragma unroll
                for (int q = 0; q < 4; ++q) { va[q] += RV.g[q] * (bf4(ya0[q]) * wa0 + bf4(ya1[q]) * wa1); vb[q] += RV.g[q] * (bf4(yb0[q]) * wb0 + bf4(yb1[q]) * wb1); }
            }
            store_row_bf16(LAT + (size_t)ra * D, C.lane, va); if (hasb) store_row_bf16(LAT + (size_t)rb * D, C.lane, vb);
            const float rra = row_rstd(va), rrb = row_rstd(vb);
            f32x4 ha[4], hb[4];
#pragma unroll
            for (int q = 0; q < 4; ++q) { ha[q] = (va[q] * rra) * RV.a[q] + RV.s[q]; hb[q] = (vb[q] * rrb) * RV.a[q] + RV.s[q]; }
            store_row_bf16(H + (size_t)ra * D, C.lane, ha); if (hasb) store_row_bf16(H + (size_t)rb * D, C.lane, hb);
            if (mls) {
                float ga = 0.f, gb = 0.f;
#pragma unroll 2
                for (int c = 0; c < 16; ++c) { float s0 = 0.f, s1 = 0.f;
#pragma unroll
                    for (int q = 0; q < 4; ++q) { const f32x4 w = *(const LAS f32x4*)(GW + c * D + 4 * C.lane + 256 * q);
                        s0 += (ha[q].x * w.x + ha[q].y * w.y) + (ha[q].z * w.z + ha[q].w * w.w); s1 += (hb[q].x * w.x + hb[q].y * w.y) + (hb[q].z * w.z + hb[q].w * w.w); }
                    s0 = wave_sum(s0); s1 = wave_sum(s1); ga = (C.lane == c) ? s0 : ga; gb = (C.lane == c) ? s1 : gb; }
                if (C.lane < 16) {
                    const float bgt = A.in[9][j * 16 + C.lane]; const int gtype = C.lane >> 2;
                    ga += bgt; gb += bgt;
                    GATE[(size_t)ra * 16 + C.lane] = (gtype & 1) ? logsigmoidf_(ga) : 15.0f * tanhf(ga * (1.0f / 15.0f));
                    if (hasb) GATE[(size_t)rb * 16 + C.lane] = (gtype & 1) ? logsigmoidf_(gb) : 15.0f * tanhf(gb * (1.0f / 15.0f)); }
            }
        }
        sa = sbnd;
    }
}

__device__ __forceinline__ void phase_r2(const Args& A, const Ctx& C, int l) {
    LAS float* RW = (LAS float*)C.lds;
    LAS float* wlb = (LAS float*)(C.lds + 36 * D * 4);
    LAS unsigned* hist = (LAS unsigned*)(wlb + 1024);
    LAS unsigned* gbase = hist + 32;
    constexpr int RCAP = 144;
    LAS int* rec = (LAS int*)(gbase + 32);
    static_assert(36 * D * 4 + 4096 + 256 + RCAP * 16 <= LDS_TAB_END, "R2 LDS map");
    { const float* wg = A.in[15] + (size_t)l * D * NGRP; const float* wr = A.in[17] + (size_t)l * D * NE;
      f32x4 tg[2], tr[16];
#pragma unroll
      for (int jj = 0; jj < 2; ++jj) tg[jj] = *(const f32x4*)(wg + (size_t)(C.tid + NT * jj) * 4);
#pragma unroll
      for (int jj = 0; jj < 16; ++jj) tr[jj] = *(const f32x4*)(wr + (size_t)(C.tid + NT * jj) * 4);
#pragma unroll
      for (int jj = 0; jj < 2; ++jj) { const int k = C.tid + NT * jj; RW[0 * D + k] = tg[jj].x; RW[1 * D + k] = tg[jj].y; RW[2 * D + k] = tg[jj].z; RW[3 * D + k] = tg[jj].w; }
#pragma unroll
      for (int jj = 0; jj < 16; ++jj) { const int i4 = C.tid + NT * jj, k = i4 >> 3, c0 = 4 + (i4 & 7) * 4; RW[(c0 + 0) * D + k] = tr[jj].x; RW[(c0 + 1) * D + k] = tr[jj].y; RW[(c0 + 2) * D + k] = tr[jj].z; RW[(c0 + 3) * D + k] = tr[jj].w; } }
    const int nrows = (l <= 1) ? NR : NL;
    bf16* LAT = (bf16*)(A.ws + WS_LAT); bf16* H = (bf16*)(A.ws + WS_HB);
    const float* MOD = (const float*)(A.ws + WS_MOD);
    unsigned* cnt = (unsigned*)(A.ws + WS_CTL) + CW_CNT + l * 32 * CNT_STRIDE;
    int* TS = (int*)(A.ws + WS_TOKSLOT); float* TW = (float*)(A.ws + WS_TOKW); int* ST = (int*)(A.ws + WS_SLOTTOK);
    const int rpw = (((nrows + C.G - 1) / C.G) + 1) & ~1; const int wrow0 = C.bid * rpw; const int wend0 = min(wrow0 + rpw, nrows);
    const float* bg = A.in[16] + l * NGRP; const float* br = A.in[18] + l * NE;
    for (int cb = wrow0; cb < wend0; cb += RCAP) {
        const int wend = min(cb + RCAP, wend0);
        if (C.tid < 32) hist[C.tid] = 0u;
        __syncthreads();
        for (int sa = cb; sa < wend;) {
            const int mvi = mod_vec_of_row(sa); const int bnd = mvi == 0 ? SEQ : (mvi == 1 ? NL : NR); const int sbnd = min(wend, bnd);
            RowVec RV; { const float* mv = MOD + (size_t)(l * 3 + mvi) * 6 * D; load_rowvec(RV, A.in[6] + (size_t)(l * 2 + 1) * D, mv + 3 * D, mv + 4 * D, mv + 2 * D, C.lane); }
            const int rlast = sbnd - 2;
            u32x2 la[4], lb[4], ya[4], yb[4];
            { const int r0 = min(sa + 2 * C.wave, rlast); load_row_bf16raw(LAT + (size_t)r0 * D, C.lane, la); load_row_bf16raw(LAT + (size_t)(r0 + 1) * D, C.lane, lb);
              load_row_bf16raw(H + (size_t)r0 * D, C.lane, ya); load_row_bf16raw(H + (size_t)(r0 + 1) * D, C.lane, yb); }
            for (int ra = sa + 2 * C.wave; ra < sbnd; ra += 2 * NW) {
                const int rb = ra + 1; const bool hasb = true;
                u32x2 lan[4], lbn[4], yan[4], ybn[4];
                { const int r1 = min(ra + 2 * NW, rlast); load_row_bf16raw(LAT + (size_t)r1 * D, C.lane, lan); load_row_bf16raw(LAT + (size_t)(r1 + 1) * D, C.lane, lbn);
                  load_row_bf16raw(H + (size_t)r1 * D, C.lane, yan); load_row_bf16raw(H + (size_t)(r1 + 1) * D, C.lane, ybn); }
                f32x4 va[4], vb[4];
#pragma unroll
                for (int q = 0; q < 4; ++q) { va[q] = bf4(la[q]) + RV.g[q] * bf4(ya[q]); vb[q] = bf4(lb[q]) + RV.g[q] * bf4(yb[q]); }
                store_row_bf16(LAT + (size_t)ra * D, C.lane, va); if (hasb) store_row_bf16(LAT + (size_t)rb * D, C.lane, vb);
                const float rra = row_rstd(va), rrb = row_rstd(vb);
                f32x4 ha[4], hb[4];
#pragma unroll
                for (int q = 0; q < 4; ++q) { ha[q] = (va[q] * rra) * RV.a[q] + RV.s[q]; hb[q] = (vb[q] * rrb) * RV.a[q] + RV.s[q]; }
                store_row_bf16(H + (size_t)ra * D, C.lane, ha); if (hasb) store_row_bf16(H + (size_t)rb * D, C.lane, hb);
#pragma unroll
                for (int q = 0; q < 4; ++q) { la[q] = lan[q]; lb[q] = lbn[q]; ya[q] = yan[q]; yb[q] = ybn[q]; }
                float ma = 0.f, mb = 0.f;
#pragma unroll 2
                for (int c = 0; c < 36; ++c) { float s0 = 0.f, s1 = 0.f;
#pragma unroll
                    for (int q = 0; q < 4; ++q) { const f32x4 w = *(const LAS f32x4*)(RW + c * D + 4 * C.lane + 256 * q);
                        s0 += (ha[q].x * w.x + ha[q].y * w.y) + (ha[q].z * w.z + ha[q].w * w.w); s1 += (hb[q].x * w.x + hb[q].y * w.y) + (hb[q].z * w.z + hb[q].w * w.w); }
                    s0 = wave_sum(s0); s1 = wave_sum(s1); ma = (C.lane == c) ? s0 : ma; mb = (C.lane == c) ? s1 : mb; }
                LAS float* wl = wlb + C.wave * 128;
                if (C.lane < 36) { wl[C.lane] = ma; wl[64 + C.lane] = mb; }
                asm volatile("s_waitcnt lgkmcnt(0)" ::: "memory");
                if (C.lane < 2 && (C.lane == 0 || hasb)) {
                    LAS const float* wm = wl + 64 * C.lane; const int row = C.lane ? rb : ra;
                    float lg[36];
#pragma unroll
                    for (int c = 0; c < 36; ++c) lg[c] = wm[c];
                    float gl[4]; int grp = 0; float gm = -3.0e38f;
#pragma unroll
                    for (int c = 0; c < 4; ++c) { gl[c] = lg[c] + bg[c]; if (gl[c] > gm) { gm = gl[c]; grp = c; } }
                    float gs = 0.f;
#pragma unroll
                    for (int c = 0; c < 4; ++c) gs += __expf(gl[c] - gm);
                    const float pgrp = 1.0f / gs;
                    float rl[8];
#pragma unroll
                    for (int i = 0; i < 8; ++i) { float t = 0.f;
#pragma unroll
                        for (int g = 0; g < 4; ++g) t = (g == grp) ? lg[4 + g * 8 + i] : t;
                        rl[i] = t + br[grp * 8 + i]; }
                    int i0 = 0; float m0 = rl[0];
#pragma unroll
                    for (int i = 1; i < 8; ++i) if (rl[i] > m0) { m0 = rl[i]; i0 = i; }
                    int i1 = -1; float m1 = -3.0e38f;
#pragma unroll
                    for (int i = 0; i < 8; ++i) if (i != i0 && rl[i] > m1) { m1 = rl[i]; i1 = i; }
                    const float p0 = 1.0f, p1 = __expf(m1 - m0);
                    const float w0 = pgrp * p0 / (p0 + p1), w1 = pgrp * p1 / (p0 + p1);
                    const int e0 = grp * 8 + i0, e1 = grp * 8 + i1;
                    const unsigned q0 = __hip_atomic_fetch_add(hist + e0, 1u, __ATOMIC_RELAXED, __HIP_MEMORY_SCOPE_WORKGROUP), q1 = __hip_atomic_fetch_add(hist + e1, 1u, __ATOMIC_RELAXED, __HIP_MEMORY_SCOPE_WORKGROUP);
                    const int li = row - cb;
                    rec[li * 4 + 0] = e0 | (e1 << 8); rec[li * 4 + 1] = (int)q0; rec[li * 4 + 2] = (int)q1;
                    TW[row * 2 + 0] = w0; TW[row * 2 + 1] = w1;
                }
            }
            sa = sbnd;
        }
        __syncthreads();
        if (C.tid < 32) gbase[C.tid] = hist[C.tid] ? atomicAdd(cnt + C.tid * CNT_STRIDE, hist[C.tid]) : 0u;
        __syncthreads();
        for (int i = C.tid; i < wend - cb; i += NT) { const int row = cb + i; const int ee = rec[i * 4], e0 = ee & 255, e1 = ee >> 8;
            const unsigned q0 = gbase[e0] + (unsigned)rec[i * 4 + 1], q1 = gbase[e1] + (unsigned)rec[i * 4 + 2];
            ST[(size_t)e0 * CAP + q0] = row; ST[(size_t)e1 * CAP + q1] = row;
            TS[row * 2 + 0] = (e0 << 20) | (int)q0; TS[row * 2 + 1] = (e1 << 20) | (int)q1; }
        __syncthreads();
    }
}

__device__ __forceinline__ void phase_final(const Args& A, const Ctx& C) {
    LAS int* sb = (LAS int*)C.lds;
    slot_bases(A, 3, sb, C.tid);
    const bf16* LAT = (const bf16*)(A.ws + WS_LAT);
    for (int row = C.bid * NW + C.wave; row < NL; row += C.G * NW) {
        f32x4 v[4], g[4];
        load_row_bf16(LAT + (size_t)row * D, C.lane, v); moe_combine(A, 3, row, C.lane, sb, v);
        float s = 0.f;
#pragma unroll
        for (int j = 0; j < 4; ++j) s += (v[j].x * v[j].x + v[j].y * v[j].y) + (v[j].z * v[j].z + v[j].w * v[j].w);
        const float r = 1.0f / sqrtf(wave_sum(s) * (1.f / D) + EPS);
        load_row_f32(A.in[7], C.lane, g);
#pragma unroll
        for (int j = 0; j < 4; ++j) *(f32x4*)(A.out + (size_t)row * D + 4 * C.lane + 256 * j) = (v[j] * r) * g[j];
    }
}

__device__ __forceinline__ void phase_conv(const Args& A, const Ctx& C, int l) {
    const int j = l >> 1; const int nrows = (l <= 1) ? NR : NL;
    const bf16* P = (const bf16*)(A.ws + WS_PB); bf16* HM = (bf16*)(A.ws + WS_HM);
    const float* cw = A.in[13] + (size_t)j * 3 * D;
    for (int row = C.bid * NW + C.wave; row < nrows; row += C.G * NW) {
        bool hasl, hasr;
        if (row < NL) { const int t = row & 63; hasl = t != 0; hasr = t != 63; } else { const int t = (row - NL) & 255; hasl = t != 0; hasr = t != 255; }
        f32x4 bg[4], z[4], w0[4], w1[4], w2[4], acc[4];
        const bf16* pr = P + (size_t)row * PW;
        load_row_bf16(pr, C.lane, bg); load_row_bf16(pr + D, C.lane, z);
        load_row_f32(cw, C.lane, w0); load_row_f32(cw + D, C.lane, w1); load_row_f32(cw + 2 * D, C.lane, w2);
#pragma unroll
        for (int q = 0; q < 4; ++q) acc[q] = w1[q] * z[q];
        if (hasl) { load_row_bf16(pr - PW + D, C.lane, z);
#pragma unroll
            for (int q = 0; q < 4; ++q) acc[q] += w0[q] * z[q]; }
        if (hasr) { load_row_bf16(pr + PW + D, C.lane, z);
#pragma unroll
            for (int q = 0; q < 4; ++q) acc[q] += w2[q] * z[q]; }
#pragma unroll
        for (int q = 0; q < 4; ++q) acc[q] *= bg[q];
        store_row_bf16(HM + (size_t)row * D, C.lane, acc);
    }
}

typedef short bf16x8 __attribute__((ext_vector_type(8)));
constexpr int BM = 256, BK = 64, HALF = 128, HTB = HALF * BK * 2, STAGE_BYTES = 8 * HTB, NXCD = 8, WGM = 8;
constexpr int LDS_TAB = STAGE_BYTES;
__device__ __forceinline__ int lds_byte(int r, int c) { const int st = (r >> 4) * 2 + (c >> 5), rr = r & 15, cc = c & 31, ob = rr * 64 + cc * 2; return st * 1024 + (ob ^ (((ob >> 9) & 1) << 5)); }
__device__ __forceinline__ void stage_rc(int b, int& R, int& C) { const int st = b / 1024, sb = b % 1024, swz = sb ^ (((sb >> 9) & 1) << 5); R = (st >> 1) * 16 + swz / 64; C = (st & 1) * 32 + (swz % 64) / 2; }
__device__ __forceinline__ int perm32(int rho) { const int n = rho >> 4, i = rho & 15; return 8 * (i >> 2) + 4 * n + (i & 3); }
__device__ __forceinline__ unsigned cvt_pk_bf16(float lo, float hi) { unsigned r; asm volatile("v_cvt_pk_bf16_f32 %0, %1, %2" : "=v"(r) : "v"(lo), "v"(hi)); return r; }

struct GUnit { const char* a; const char* b; int orow, ocol, aux; };

template <class Epi, class Sched, bool GATHER>
__device__ __forceinline__ void gemm_phase(LAS unsigned char* lds, const int K, const Sched& S, const Epi& E) {
    const int tid = threadIdx.x, wid = __builtin_amdgcn_readfirstlane(tid >> 6), lane = tid & 63, wr = wid >> 2, wc = wid & 3, fr = lane & 15, fq = lane >> 4;
    const int nt = K / BK;
    unsigned voffB[2], voA[2][2]; int Rr[2], Cc[2];
#pragma unroll
    for (int i = 0; i < 2; ++i) { int R, C; stage_rc(tid * 16 + i * 8192, R, C); const int Rb = (R & ~31) + perm32(R & 31); Rr[i] = R; Cc[i] = C;
        voffB[i] = (unsigned)(Rb * K + C) * 2u;
        voA[0][i] = (unsigned)(R * K + C) * 2u; voA[1][i] = (unsigned)((R + HALF) * K + C) * 2u; }
    const size_t kstep = (size_t)(BK * 2);
    const size_t hstep = (size_t)HALF * K * 2;
    const unsigned ldsw = (unsigned)wid * 1024u;
    const int aoff = lds_byte(wr * 64 + fr, fq * 8), boff = lds_byte(wc * 32 + fr, fq * 8);
#define PG8_SA(b, h) (((b) * 2 + (h)) * HTB)
#define PG8_SB(b, h) ((4 + (b) * 2 + (h)) * HTB)
#define PG8_STAGE(bufoff, gbase, voff) do { _Pragma("unroll") for (int _i = 0; _i < 2; ++_i) \
        __builtin_amdgcn_global_load_lds((const unsigned*)((const char*)(gbase) + (voff)[_i]), (LAS unsigned*)(lds + (bufoff) + ldsw + _i * 8192), 16, 0, 0); } while (0)
#define PG8_LDA(dst, b, h) do { _Pragma("unroll") for (int m = 0; m < 4; ++m) _Pragma("unroll") for (int k = 0; k < 2; ++k) dst[m][k] = *(const LAS bf16x8*)(lds + PG8_SA(b, h) + aoff + m * 2048 + k * 1024); } while (0)
#define PG8_LDB(dst, b, h) do { _Pragma("unroll") for (int n = 0; n < 2; ++n) _Pragma("unroll") for (int k = 0; k < 2; ++k) dst[n][k] = *(const LAS bf16x8*)(lds + PG8_SB(b, h) + boff + n * 2048 + k * 1024); } while (0)
#define PG8_MMA(ai, bj, At, Bt) do { __builtin_amdgcn_s_setprio(1); _Pragma("unroll") for (int m = 0; m < 4; ++m) _Pragma("unroll") for (int n = 0; n < 2; ++n) _Pragma("unroll") for (int k = 0; k < 2; ++k) \
        acc[ai][bj][m][n] = __builtin_amdgcn_mfma_f32_16x16x32_bf16(Bt[n][k], At[m][k], acc[ai][bj][m][n], 0, 0, 0); __builtin_amdgcn_s_setprio(0); } while (0)
#define PG8_WAIT_V(n) asm volatile("s_waitcnt vmcnt(" #n ")" ::: "memory")
#define PG8_WAIT_L(n) asm volatile("s_waitcnt lgkmcnt(" #n ")" ::: "memory")
#define PG8_BAR __builtin_amdgcn_s_barrier()
#define PG8_SCHED __builtin_amdgcn_sched_barrier(0)
    GUnit cur, nxt; int ui = 0;
    if (!S.next(0, cur)) return;
    if constexpr (GATHER) {
#pragma unroll
        for (int h = 0; h < 2; ++h)
#pragma unroll
            for (int i = 0; i < 2; ++i) voA[h][i] = S.arow_off(0, h * HALF + Rr[i]) + (unsigned)Cc[i] * 2u;
    }
    f32x4 acc[2][2][4][2];
#pragma unroll
    for (int a = 0; a < 2; ++a)
#pragma unroll
        for (int b = 0; b < 2; ++b)
#pragma unroll
            for (int m = 0; m < 4; ++m)
#pragma unroll
                for (int n = 0; n < 2; ++n) acc[a][b][m][n] = (f32x4){0.f, 0.f, 0.f, 0.f};
    bf16x8 At[4][2], B0[2][2], B1[2][2];
    const char* cA = cur.a; const char* cB = cur.b;
    PG8_STAGE(PG8_SB(0, 0), cB, voffB); PG8_STAGE(PG8_SB(0, 1), cB + hstep, voffB); PG8_STAGE(PG8_SA(0, 0), cA, voA[0]); PG8_STAGE(PG8_SA(0, 1), cA, voA[1]);
    if (wr == 1) PG8_BAR;
    PG8_WAIT_V(2); PG8_BAR;
    PG8_STAGE(PG8_SB(1, 0), cB + kstep, voffB); PG8_STAGE(PG8_SA(1, 0), cA + kstep, voA[0]); PG8_STAGE(PG8_SB(1, 1), cB + hstep + kstep, voffB);
    PG8_WAIT_V(6); PG8_BAR;
    for (;;) {
        const bool has_next = S.next(ui + 1, nxt);
        const char* nA = has_next ? nxt.a : cA; const char* nB = has_next ? nxt.b : cB;
        for (int t = 0; t < nt; t += 2) {
            const bool last = (t == nt - 2);
            const char* a1 = cA + (size_t)(t + 1) * kstep;
            const char* a2 = last ? nA : cA + (size_t)(t + 2) * kstep; const char* b2 = last ? nB : cB + (size_t)(t + 2) * kstep;
            const char* a3 = a2 + kstep; const char* b3 = b2 + kstep;
            unsigned sA[2][2];
#pragma unroll
            for (int h = 0; h < 2; ++h)
#pragma unroll
                for (int i = 0; i < 2; ++i) sA[h][i] = voA[h][i];
            if constexpr (GATHER) {
                if (last && has_next) {
#pragma unroll
                    for (int h = 0; h < 2; ++h)
#pragma unroll
                        for (int i = 0; i < 2; ++i) sA[h][i] = S.arow_off(ui + 1, h * HALF + Rr[i]) + (unsigned)Cc[i] * 2u;
                }
            }
            PG8_LDB(B0, 0, 0); PG8_LDB(B1, 0, 1); PG8_SCHED; PG8_LDA(At, 0, 0); PG8_STAGE(PG8_SA(1, 1), a1, voA[1]);
            PG8_WAIT_V(8); PG8_WAIT_L(0); PG8_BAR; PG8_MMA(0, 0, At, B0); PG8_MMA(0, 1, At, B1); PG8_BAR; PG8_SCHED;
            PG8_LDA(At, 0, 1); PG8_STAGE(PG8_SB(0, 0), b2, voffB); PG8_STAGE(PG8_SB(0, 1), b2 + hstep, voffB); PG8_STAGE(PG8_SA(0, 0), a2, sA[0]);
            PG8_WAIT_V(8); PG8_WAIT_L(0); PG8_BAR; PG8_MMA(1, 0, At, B0); PG8_MMA(1, 1, At, B1); PG8_BAR; PG8_SCHED;
            PG8_LDB(B0, 1, 0); PG8_LDB(B1, 1, 1); PG8_SCHED; PG8_LDA(At, 1, 0); PG8_STAGE(PG8_SA(0, 1), a2, sA[1]);
            PG8_WAIT_V(8); PG8_WAIT_L(0); PG8_BAR; PG8_MMA(0, 0, At, B0); PG8_MMA(0, 1, At, B1); PG8_BAR; PG8_SCHED;
            PG8_LDA(At, 1, 1); PG8_STAGE(PG8_SB(1, 0), b3, voffB); PG8_STAGE(PG8_SB(1, 1), b3 + hstep, voffB); PG8_STAGE(PG8_SA(1, 0), a3, sA[0]);
            PG8_WAIT_V(8); PG8_WAIT_L(0); PG8_BAR; PG8_MMA(1, 0, At, B0); PG8_MMA(1, 1, At, B1); PG8_BAR; PG8_SCHED;
        }
        if (wr == 0) PG8_BAR;
        E(acc, cur, wr, wc, fr, fq);
        if (!has_next) break;
#pragma unroll
        for (int a = 0; a < 2; ++a)
#pragma unroll
            for (int b = 0; b < 2; ++b)
#pragma unroll
                for (int m = 0; m < 4; ++m)
#pragma unroll
                    for (int n = 0; n < 2; ++n) acc[a][b][m][n] = (f32x4){0.f, 0.f, 0.f, 0.f};
        cur = nxt; cA = nA; cB = nB; ++ui;
        if constexpr (GATHER) {
#pragma unroll
            for (int h = 0; h < 2; ++h)
#pragma unroll
                for (int i = 0; i < 2; ++i) voA[h][i] = S.arow_off(ui, h * HALF + Rr[i]) + (unsigned)Cc[i] * 2u;
        }
        if (wr == 1) PG8_BAR;
    }
    PG8_WAIT_V(0);
    PG8_BAR;
#undef PG8_SA
#undef PG8_SB
#undef PG8_STAGE
#undef PG8_LDA
#undef PG8_LDB
#undef PG8_MMA
#undef PG8_WAIT_V
#undef PG8_WAIT_L
#undef PG8_BAR
#undef PG8_SCHED
}

__device__ __forceinline__ int xcd_remap(int L, int nwg) { const int q = nwg / NXCD, r = nwg % NXCD, xcd = L % NXCD, off = L / NXCD; return (xcd < r ? xcd * (q + 1) : r * (q + 1) + (xcd - r) * q) + off; }

struct DenseSched {
    const char* A; const char* Bt; int nM, nN, nwg, G, c; size_t tstep; int sw_lo, sw_hi;
    __device__ __forceinline__ void init(const void* A_, const void* Bt_, int M, int N, int K, int G_, int c_) { A = (const char*)A_; Bt = (const char*)Bt_; nM = M / BM; nN = N / BM; nwg = nM * nN; G = G_; c = c_; tstep = (size_t)BM * K * 2; sw_lo = 0; sw_hi = 0; }
    __device__ __forceinline__ bool next(int i, GUnit& u) const {
        const long L = (long)i * G + c; if (L >= nwg) return false;
        const int wgid = xcd_remap((int)L, nwg);
        const int nig = WGM * nN, gid = wgid / nig, fm = gid * WGM, gsz = (nM - fm) < WGM ? (nM - fm) : WGM;
        const int pm = fm + ((wgid % nig) % gsz), pn = (wgid % nig) / gsz;
        if (pn >= sw_lo && pn < sw_hi) { u.a = Bt + (size_t)pn * tstep; u.b = A + (size_t)pm * tstep; u.orow = pm; u.ocol = pn - sw_lo; u.aux = 1; }
        else { u.a = A + (size_t)pm * tstep; u.b = Bt + (size_t)pn * tstep; u.orow = pm * BM; u.ocol = pn * BM; u.aux = 0; }
        return true;
    }
    __device__ __forceinline__ unsigned arow_off(int, int) const { return 0u; }
};

constexpr int MAXU = 12;
struct MoeTab { int n; int e[MAXU], mb[MAXU], nt[MAXU]; int sb[NE + 1]; };
struct MoeSched {
    LAS const MoeTab* T; LAS const unsigned* ridx;
    const char* A; const char* W; size_t wstride_e, tstepB; int K; int arow_bytes;
    __device__ __forceinline__ bool next(int i, GUnit& u) const {
        const int n = __builtin_amdgcn_readfirstlane(T->n); if (i >= n) return false;
        const int e = __builtin_amdgcn_readfirstlane(T->e[i]), mb = __builtin_amdgcn_readfirstlane(T->mb[i]), nt = __builtin_amdgcn_readfirstlane(T->nt[i]);
        const int base = __builtin_amdgcn_readfirstlane(T->sb[e]);
        u.orow = base + mb * BM; u.ocol = nt; u.aux = e;
        u.a = A + (size_t)u.orow * arow_bytes;
        u.b = W + (size_t)e * wstride_e + (size_t)nt * tstepB; return true;
    }
    __device__ __forceinline__ unsigned arow_off(int i, int r) const { return ridx[i * 256 + r]; }
};
template <bool GATHER>
__device__ __forceinline__ void moe_tables(const Args& A, const Ctx& C, int l, int ntile_n, LAS MoeTab* T, LAS unsigned* ridx, int arow_bytes) {
    const unsigned* cnt = (const unsigned*)(A.ws + WS_CTL) + CW_CNT + l * 32 * CNT_STRIDE;
    LAS int* ust = (LAS int*)(T + 1);
    if (C.tid == 0) { int acc = 0, ua = 0; for (int e = 0; e < NE; ++e) { T->sb[e] = acc; ust[e] = ua; const int nb = ((int)cnt[e * CNT_STRIDE] + 255) / 256; acc += nb * 256; ua += nb * ntile_n; } T->sb[NE] = acc; ust[NE] = ua;
        const int nwg = ua; int n = 0;
        for (int i = 0; i < MAXU; ++i) { const long L = (long)i * C.G + C.bid; if (L >= nwg) break; const int w = xcd_remap((int)L, nwg); int e = 0; while (w >= ust[e + 1]) ++e;
            const int lu = w - ust[e]; T->e[i] = e; T->mb[i] = lu / ntile_n; T->nt[i] = lu % ntile_n; ++n; }
        T->n = n; }
    __syncthreads();
    if constexpr (GATHER) {
        const int* ST = (const int*)(A.ws + WS_SLOTTOK); const int n = T->n;
        for (int i = C.tid; i < n * 256; i += NT) { const int ui = i >> 8, r = i & 255, e = T->e[ui], m0 = T->mb[ui] * 256, ce = (int)cnt[e * CNT_STRIDE];
            const int rr = (m0 + r < ce) ? m0 + r : ce - 1;
            ridx[i] = (unsigned)ST[(size_t)e * CAP + rr] * (unsigned)arow_bytes; }
        __syncthreads();
    }
}

struct EpiStore { bf16* O; int ldc; float scale_lo; int sig_from; bf16* VT;
    __device__ __forceinline__ void operator()(const f32x4 (&acc)[2][2][4][2], const GUnit& u, int wr, int wc, int fr, int fq) const {
        const bool tr = u.aux != 0;
        const float sc = (!tr && u.ocol < NQ) ? scale_lo : 1.0f; const bool sg = !tr && u.ocol >= sig_from;
        bf16* Ob = tr ? VT + (size_t)(u.orow * NH + u.ocol) * 65536 : O + (size_t)u.orow * ldc + u.ocol; const int ld = tr ? 256 : ldc;
#pragma unroll
        for (int ai = 0; ai < 2; ++ai)
#pragma unroll
            for (int m = 0; m < 4; ++m) { bf16* rowp = Ob + (size_t)(ai * HALF + wr * 64 + m * 16 + fr) * ld + wc * 32 + 8 * fq;
#pragma unroll
                for (int bj = 0; bj < 2; ++bj) { f32x4 v0 = acc[ai][bj][m][0] * sc, v1 = acc[ai][bj][m][1] * sc;
                    if (sg) {
#pragma unroll
                        for (int q = 0; q < 4; ++q) { v0[q] = __builtin_amdgcn_rcpf(1.0f + __expf(-v0[q])); v1[q] = __builtin_amdgcn_rcpf(1.0f + __expf(-v1[q])); } }
                    u32x4 w; w.x = cvt_pk_bf16(v0[0], v0[1]); w.y = cvt_pk_bf16(v0[2], v0[3]); w.z = cvt_pk_bf16(v1[0], v1[1]); w.w = cvt_pk_bf16(v1[2], v1[3]);
                    *(u32x4*)(rowp + bj * HALF) = w; } }
    }
};
template <int MODE> struct EpiPair { bf16* O; int ldc; int plain_below;
    __device__ __forceinline__ void operator()(const f32x4 (&acc)[2][2][4][2], const GUnit& u, int wr, int wc, int fr, int fq) const {
        if (MODE == 0 && u.ocol < plain_below) {
#pragma unroll
            for (int ai = 0; ai < 2; ++ai)
#pragma unroll
                for (int m = 0; m < 4; ++m) { bf16* rowp = O + (size_t)(u.orow + ai * HALF + wr * 64 + m * 16 + fr) * ldc + u.ocol + wc * 32 + 8 * fq;
#pragma unroll
                    for (int bj = 0; bj < 2; ++bj) { const f32x4 v0 = acc[ai][bj][m][0], v1 = acc[ai][bj][m][1];
                        u32x4 w; w.x = cvt_pk_bf16(v0[0], v0[1]); w.y = cvt_pk_bf16(v0[2], v0[3]); w.z = cvt_pk_bf16(v1[0], v1[1]); w.w = cvt_pk_bf16(v1[2], v1[3]);
                        *(u32x4*)(rowp + bj * HALF) = w; } }
            return;
        }
        const int ocol = (MODE == 0) ? plain_below + (u.ocol - plain_below) / 2 : u.ocol * HALF;
#pragma unroll
        for (int ai = 0; ai < 2; ++ai)
#pragma unroll
            for (int m = 0; m < 4; ++m) { bf16* rowp = O + (size_t)(u.orow + ai * HALF + wr * 64 + m * 16 + fr) * ldc + ocol + wc * 32 + 8 * fq;
                f32x4 v0, v1;
#pragma unroll
                for (int q = 0; q < 4; ++q) {
                    const float x0 = acc[ai][0][m][0][q], x1 = acc[ai][0][m][1][q];
                    const float g0 = (MODE == 1) ? x0 * __builtin_amdgcn_rcpf(1.0f + __expf(-x0)) : x0, g1 = (MODE == 1) ? x1 * __builtin_amdgcn_rcpf(1.0f + __expf(-x1)) : x1;
                    v0[q] = g0 * acc[ai][1][m][0][q]; v1[q] = g1 * acc[ai][1][m][1][q]; }
                u32x4 w; w.x = cvt_pk_bf16(v0[0], v0[1]); w.y = cvt_pk_bf16(v0[2], v0[3]); w.z = cvt_pk_bf16(v1[0], v1[1]); w.w = cvt_pk_bf16(v1[2], v1[3]);
                *(u32x4*)rowp = w; }
    }
};
struct EpiStoreTile { bf16* O; int ldc;
    __device__ __forceinline__ void operator()(const f32x4 (&acc)[2][2][4][2], const GUnit& u, int wr, int wc, int fr, int fq) const {
#pragma unroll
        for (int ai = 0; ai < 2; ++ai)
#pragma unroll
            for (int m = 0; m < 4; ++m) { bf16* rowp = O + (size_t)(u.orow + ai * HALF + wr * 64 + m * 16 + fr) * ldc + u.ocol * BM + wc * 32 + 8 * fq;
#pragma unroll
                for (int bj = 0; bj < 2; ++bj) { const f32x4 v0 = acc[ai][bj][m][0], v1 = acc[ai][bj][m][1];
                    u32x4 w; w.x = cvt_pk_bf16(v0[0], v0[1]); w.y = cvt_pk_bf16(v0[2], v0[3]); w.z = cvt_pk_bf16(v1[0], v1[1]); w.w = cvt_pk_bf16(v1[2], v1[3]);
                    *(u32x4*)(rowp + bj * HALF) = w; } }
    }
};

__device__ __forceinline__ void transpose_item(const float* W, int ldw, int K, bf16* WT, int drow0, int k0, int n0, LAS float* scr, int lane) {
#pragma unroll
    for (int i = 0; i < 32; ++i) { const int kk = 2 * i + (lane >> 5); scr[kk * 33 + (lane & 31)] = W[(size_t)(k0 + kk) * ldw + n0 + (lane & 31)]; }
    asm volatile("s_waitcnt lgkmcnt(0)" ::: "memory");
    const int c = lane & 7;
#pragma unroll
    for (int j = 0; j < 4; ++j) { const int n = (lane >> 3) + 8 * j; const LAS float* s = scr + (8 * c) * 33 + n;
        u32x4 o; o.x = pk2(s[0 * 33], s[1 * 33]); o.y = pk2(s[2 * 33], s[3 * 33]); o.z = pk2(s[4 * 33], s[5 * 33]); o.w = pk2(s[6 * 33], s[7 * 33]);
        *(u32x4*)(WT + (size_t)(drow0 + n) * K + k0 + 8 * c) = o; }
    asm volatile("s_waitcnt lgkmcnt(0)" ::: "memory");
}
__device__ __forceinline__ int pair_row(int n, int which) { return (n >> 7) * 256 + (n & 127) + which * 128; }
__device__ __forceinline__ void phase_cvt_mixer(const Args& A, const Ctx& C) {
    LAS float* scr = (LAS float*)(C.lds + 16384 + C.wave * 16384);
    const int gw = C.bid * NW + C.wave, NGW = C.G * NW;
    constexpr int I_IN = (D / 64) * (PW / 32), I_OUT = (D / 64) * (D / 32), PER = 2 * (I_IN + I_OUT);
    for (int it = gw; it < 2 * PER; it += NGW) {
        const int kind = it / PER; int r = it % PER; const int j = r / (I_IN + I_OUT); r %= (I_IN + I_OUT);
        if (r < I_IN) { const int kb = r / (PW / 32), nb = r % (PW / 32), n0 = nb * 32;
            bf16* WT = (bf16*)(A.ws + (kind == 0 ? WS_WAIN : WS_WBIN)) + (size_t)j * PW * D;
            if (kind == 0) transpose_item(A.in[8] + (size_t)j * D * PROJ, PROJ, D, WT, n0, kb * 64, n0, scr, C.lane);
            else { const int drow = n0 < D ? n0 : (n0 < 2 * D ? D + pair_row(n0 - D, 0) : D + pair_row(n0 - 2 * D, 1));
                transpose_item(A.in[12] + (size_t)j * D * PW, PW, D, WT, drow, kb * 64, n0, scr, C.lane); } }
        else { r -= I_IN; const int kb = r / (D / 32), nb = r % (D / 32), n0 = nb * 32;
            bf16* WT = (bf16*)(A.ws + (kind == 0 ? WS_WAOUT : WS_WBOUT)) + (size_t)j * D * D;
            transpose_item((kind == 0 ? A.in[11] : A.in[14]) + (size_t)j * D * D, D, D, WT, n0, kb * 64, n0, scr, C.lane); }
    }
}
__device__ __forceinline__ void phase_cvt_moe(const Args& A, const Ctx& C, int l) {
    LAS float* scr = (LAS float*)(C.lds + 16384 + C.wave * 16384);
    const int gw = C.bid * NW + C.wave, NGW = C.G * NW;
    constexpr int I_G = (D / 64) * (DE / 32), I_D = (DE / 64) * (D / 32), PER = 2 * I_G + I_D;
    bf16* WGU = (bf16*)(A.ws + WS_WGU); bf16* WDN = (bf16*)(A.ws + WS_WDN);
    for (int it = gw; it < NE * PER; it += NGW) {
        const int e = it / PER; int r = it % PER;
        if (r < 2 * I_G) { const int which = r / I_G; r %= I_G; const int kb = r / (DE / 32), nb = r % (DE / 32), n0 = nb * 32;
            transpose_item((which == 0 ? A.in[19] : A.in[20]) + ((size_t)l * NE + e) * D * DE, DE, D, WGU + (size_t)e * 2 * DE * D, pair_row(n0, which), kb * 64, n0, scr, C.lane); }
        else { r -= 2 * I_G; const int kb = r / (D / 32), nb = r % (D / 32), n0 = nb * 32;
            transpose_item(A.in[21] + ((size_t)l * NE + e) * DE * D, D, DE, WDN + (size_t)e * D * DE, n0, kb * 64, n0, scr, C.lane); }
    }
}

__device__ __forceinline__ void phase_g1(const Args& A, const Ctx& C, int l) {
    const bool mls = (l & 1) == 0; const int j = l >> 1; const int nrows = (l <= 2) ? NR : NL;
    DenseSched S; S.init(A.ws + WS_HB, A.ws + (mls ? WS_WAIN : WS_WBIN) + (size_t)j * PW * D * 2, nrows, PW, D, C.G, C.bid);
    if (mls) { S.sw_lo = 4; S.sw_hi = 8; EpiStore E{(bf16*)(A.ws + WS_PB), PW, 0.08838834764831845f, 2 * NQ + NV, (bf16*)(A.ws + WS_VT)}; gemm_phase<EpiStore, DenseSched, false>(C.lds, D, S, E); }
    else { EpiPair<0> E{(bf16*)(A.ws + WS_PB), PW, D}; gemm_phase<EpiPair<0>, DenseSched, false>(C.lds, D, S, E); }
}
__device__ __forceinline__ void phase_g2(const Args& A, const Ctx& C, int l) {
    const bool mls = (l & 1) == 0; const int j = l >> 1; const int nrows = (l <= 1) ? NR : NL;
    DenseSched S; S.init(A.ws + WS_HM, A.ws + (mls ? WS_WAOUT : WS_WBOUT) + (size_t)j * D * D * 2, nrows, D, D, C.G, C.bid);
    EpiStore E{(bf16*)(A.ws + WS_HB), D, 1.0f, 1 << 30, nullptr}; gemm_phase<EpiStore, DenseSched, false>(C.lds, D, S, E);
}
__device__ __forceinline__ void phase_m1(const Args& A, const Ctx& C, int l) {
    LAS MoeTab* T = (LAS MoeTab*)(C.lds + LDS_TAB); LAS unsigned* ridx = (LAS unsigned*)(C.lds + LDS_TAB + 1024);
    moe_tables<true>(A, C, l, 4, T, ridx, D * 2);
    MoeSched S; S.T = T; S.ridx = ridx; S.A = (const char*)(A.ws + WS_HB); S.W = (const char*)(A.ws + WS_WGU); S.wstride_e = (size_t)2 * DE * D * 2; S.tstepB = (size_t)BM * D * 2; S.K = D; S.arow_bytes = 0;
    EpiPair<1> E{(bf16*)(A.ws + WS_DC), DE, 0}; gemm_phase<EpiPair<1>, MoeSched, true>(C.lds, D, S, E);
}
__device__ __forceinline__ void phase_m2(const Args& A, const Ctx& C, int l) {
    LAS MoeTab* T = (LAS MoeTab*)(C.lds + LDS_TAB); LAS unsigned* ridx = (LAS unsigned*)(C.lds + LDS_TAB + 1024);
    moe_tables<false>(A, C, l, 4, T, ridx, DE * 2);
    MoeSched S; S.T = T; S.ridx = ridx; S.A = (const char*)(A.ws + WS_DC); S.W = (const char*)(A.ws + WS_WDN); S.wstride_e = (size_t)D * DE * 2; S.tstepB = (size_t)BM * DE * 2; S.K = DE; S.arow_bytes = DE * 2;
    EpiStoreTile E{(bf16*)(A.ws + WS_PB), D}; gemm_phase<EpiStoreTile, MoeSched, false>(C.lds, DE, S, E);
}

typedef float f32x16 __attribute__((ext_vector_type(16)));
typedef float f32x2 __attribute__((ext_vector_type(2)));
typedef __bf16 bf16x2_t __attribute__((ext_vector_type(2)));
#define MFMA32(a, b, c) __builtin_amdgcn_mfma_f32_32x32x16_bf16((a), (b), (c), 0, 0, 0)
__device__ __forceinline__ unsigned cvt2(float lo, float hi) { const f32x2 v = {lo, hi}; return __builtin_bit_cast(unsigned, __builtin_convertvector(v, bf16x2_t)); }
__device__ __forceinline__ bf16x8 pack8(float a0, float a1, float a2, float a3, float a4, float a5, float a6, float a7) {
    u32x4 p; p.x = cvt2(a0, a1); p.y = cvt2(a2, a3); p.z = cvt2(a4, a5); p.w = cvt2(a6, a7); return __builtin_bit_cast(bf16x8, p); }
__device__ __forceinline__ float bflo(unsigned w) { return __uint_as_float(w << 16); }
__device__ __forceinline__ float bfhi(unsigned w) { return __uint_as_float(w & 0xffff0000u); }
__device__ __forceinline__ int vt_tile(int b, int h, int blk) { return (blk == 0 ? 128 + b : b * 64 + blk - 1) * NH + h; }

__device__ __forceinline__ float wave_incl_scan(float v, int lane) {
#pragma unroll
    for (int o = 1; o < 64; o <<= 1) { const float t = __shfl_up(v, o); v += (lane >= o) ? t : 0.f; }
    return v;
}
__device__ __forceinline__ void block_gates(const Args& A, int row0, int h, LAS float* bf, LAS float* bb, LAS float* lif, LAS float* lib, int tid) {
    const float* GATE = (const float*)(A.ws + WS_GATE);
    if (tid < 256) { const float* g = GATE + (size_t)(row0 + tid) * 16; lif[tid] = g[0 + h]; bf[tid] = g[4 + h]; lib[tid] = g[8 + h]; bb[tid] = g[12 + h]; }
    __syncthreads();
    const int lane = tid & 63, wv = tid >> 6;
    if (wv == 0) { f32x4 x = *(LAS f32x4*)(bf + 4 * lane); x.y += x.x; x.z += x.y; x.w += x.z; const float tot = wave_incl_scan(x.w, lane); const float ex = tot - x.w;
        x.x += ex; x.y += ex; x.z += ex; x.w += ex; *(LAS f32x4*)(bf + 4 * lane) = x; }
    if (wv == 1) { f32x4 y = *(LAS f32x4*)(bb + 4 * (63 - lane)); y.z += y.w; y.y += y.z; y.x += y.y; const float tot = wave_incl_scan(y.x, lane); const float ex = tot - y.x;
        y.x += ex; y.y += ex; y.z += ex; y.w += ex; *(LAS f32x4*)(bb + 4 * (63 - lane)) = y; }
    __syncthreads();
}
__device__ __forceinline__ void phase_s1(const Args& A, const Ctx& C, int l) {
    LAS float* bf = (LAS float*)C.lds; LAS float* bb = bf + 256; LAS float* lif = bb + 256; LAS float* lib = lif + 256; LAS float* af = lib + 256; LAS float* ab = af + 256;
    constexpr int KP = 528;
    LAS unsigned char* KTf = C.lds + 8192; LAS unsigned char* KTb = KTf + 128 * KP;
    const bf16* P = (const bf16*)(A.ws + WS_PB); const bf16* VT = (const bf16*)(A.ws + WS_VT);
    float* DC = (float*)(A.ws + WS_DC); float* DN = (float*)(A.ws + WS_DN); float* BT = (float*)(A.ws + WS_BTOT);
    const int r = C.lane & 31, hh = C.lane >> 5, w = C.wave;
    for (int u = C.bid; u < NUNIT; u += C.G) {
        const int blk = u % NBLK, bh = u / NBLK, h = bh % NH, b = bh / NH; const int row0 = blk_row0(b, blk);
        block_gates(A, row0, h, bf, bb, lif, lib, C.tid);
        if (C.tid < 256) { af[C.tid] = __expf(bf[255] - bf[C.tid] + lif[C.tid]); ab[C.tid] = __expf(bb[0] - bb[C.tid] + lib[C.tid]); }
        if (C.tid == 0) { BT[u * 2 + 0] = bf[255]; BT[u * 2 + 1] = bb[0]; }
        __syncthreads();
        { const int sp = C.tid >> 2, dq = C.tid & 3, s0 = 2 * sp;
          const bf16* k0 = P + (size_t)(row0 + s0) * PW + NQ + h * DQK + 32 * dq;
          const float f0 = af[s0], f1 = af[s0 + 1], g0 = ab[s0], g1 = ab[s0 + 1];
#pragma unroll
          for (int c = 0; c < 4; ++c) { const u32x4 x0 = *(const u32x4*)(k0 + 8 * c), x1 = *(const u32x4*)(k0 + PW + 8 * c);
#pragma unroll
              for (int q = 0; q < 4; ++q) { const int d = 32 * dq + 8 * c + 2 * q;
                  const float a0 = bflo(x0[q]), a1 = bfhi(x0[q]), c0 = bflo(x1[q]), c1 = bfhi(x1[q]);
                  *(LAS unsigned*)(KTf + d * KP + s0 * 2) = cvt2(a0 * f0, c0 * f1); *(LAS unsigned*)(KTf + (d + 1) * KP + s0 * 2) = cvt2(a1 * f0, c1 * f1);
                  *(LAS unsigned*)(KTb + d * KP + s0 * 2) = cvt2(a0 * g0, c0 * g1); *(LAS unsigned*)(KTb + (d + 1) * KP + s0 * 2) = cvt2(a1 * g0, c1 * g1); } } }
        __syncthreads();
        if (C.tid < 256) { const int dir = C.tid >> 7, d = C.tid & 127; LAS const unsigned* kr = (LAS const unsigned*)((dir ? KTb : KTf) + d * KP); float s = 0.f;
            for (int i = 0; i < 128; ++i) { const unsigned x = kr[i]; s += bflo(x) + bfhi(x); }
            DN[(size_t)(u * 2 + dir) * DQK + d] = s; }
        const bf16* vt = VT + (size_t)vt_tile(b, h, blk) * 65536 + (size_t)(32 * w + r) * 256 + 8 * hh;
        f32x16 accf[4], accb[4];
#pragma unroll
        for (int dt = 0; dt < 4; ++dt)
#pragma unroll
            for (int i = 0; i < 16; ++i) { accf[dt][i] = 0.f; accb[dt][i] = 0.f; }
#pragma unroll 2
        for (int ks = 0; ks < 16; ++ks) { const bf16x8 a = *(const bf16x8*)(vt + 16 * ks);
#pragma unroll
            for (int dt = 0; dt < 4; ++dt) { const int off = (dt * 32 + r) * KP + (16 * ks + 8 * hh) * 2;
                const bf16x8 b0 = *(const LAS bf16x8*)(KTf + off), b1 = *(const LAS bf16x8*)(KTb + off);
                accf[dt] = MFMA32(a, b0, accf[dt]); accb[dt] = MFMA32(a, b1, accb[dt]); } }
        float* dcf = DC + (size_t)(u * 2 + 0) * DQK * DV + (size_t)(32 * w + 4 * hh) * DQK + r; float* dcb = dcf + DQK * DV;
#pragma unroll
        for (int g = 0; g < 4; ++g) { float* pf = dcf + g * 8 * DQK; float* pb = dcb + g * 8 * DQK; asm volatile("" : "+v"(pf), "+v"(pb));
#pragma unroll
            for (int q = 0; q < 4; ++q)
#pragma unroll
                for (int dt = 0; dt < 4; ++dt) { pf[q * DQK + dt * 32] = accf[dt][4 * g + q]; pb[q * DQK + dt * 32] = accb[dt][4 * g + q]; } }
        __syncthreads();
    }
}
__device__ __forceinline__ void phase_s2(const Args& A, const Ctx& C) {
    const float* __restrict__ DC = (const float*)(A.ws + WS_DC); const float* __restrict__ DN = (const float*)(A.ws + WS_DN); const float* __restrict__ BT = (const float*)(A.ws + WS_BTOT);
    bf16* __restrict__ CST = (bf16*)(A.ws + WS_CST); float* __restrict__ NST = (float*)(A.ws + WS_NST);
    constexpr int EL4 = DQK * DV / 4;
    for (int g = C.bid * NT + C.tid; g < BATCH * NH * 2 * EL4; g += C.G * NT) {
        const int e4 = (g % EL4) * 4, ch = g / EL4, dir = ch & 1, bh = ch >> 1;
        f32x4 st = (f32x4){0.f, 0.f, 0.f, 0.f};
#pragma unroll 5
        for (int idx = 0; idx < NBLK; ++idx) {
            const int blk = dir == 0 ? idx : (idx == 0 ? 0 : NBLK - idx); const int u = bh * NBLK + blk;
            const float dec = __expf(BT[u * 2 + dir]);
            const f32x4 dc = *(const f32x4*)(DC + (size_t)(u * 2 + dir) * DQK * DV + e4);
            u32x2 o; o.x = cvt2(st.x, st.y); o.y = cvt2(st.z, st.w);
            *(u32x2*)(CST + (size_t)(u * 2 + dir) * DQK * DV + e4) = o;
            st = st * dec + dc;
        }
    }
    for (int g = C.bid * NT + C.tid; g < BATCH * NH * 2 * DQK; g += C.G * NT) {
        const int d = g % DQK, ch = g / DQK, dir = ch & 1, bh = ch >> 1; float st = 0.f;
        for (int idx = 0; idx < NBLK; ++idx) {
            const int blk = dir == 0 ? idx : (idx == 0 ? 0 : NBLK - idx); const int u = bh * NBLK + blk;
            NST[(size_t)(u * 2 + dir) * DQK + d] = st; st = __expf(BT[u * 2 + dir]) * st + DN[(size_t)(u * 2 + dir) * DQK + d];
        }
    }
}
__device__ __forceinline__ void lds_barrier() { asm volatile("s_waitcnt lgkmcnt(0)" ::: "memory"); __builtin_amdgcn_s_barrier(); asm volatile("" ::: "memory"); }
__device__ __forceinline__ void phase_s3(const Args& A, const Ctx& C, int l) {
    const int jl = l >> 1; const bool ctx_out = (l == 0);
    LAS float* bf = (LAS float*)C.lds; LAS float* bb = bf + 256; LAS float* gf = bb + 256; LAS float* gb = gf + 256;
    LAS float* nf = gb + 256; LAS float* nb = nf + 128; LAS float* ssx = nb + 128;
    constexpr int KP = 272, VP = 136, CP = 144, OP = 528;
    LAS unsigned char* Kimg = C.lds + 6144;
    LAS unsigned char* CH = Kimg + 256 * KP;
    static_assert(6144 + 256 * KP + 128 * OP <= LDS_TAB_END, "S3 LDS map");
    const bf16* P = (const bf16*)(A.ws + WS_PB); const bf16* VT = (const bf16*)(A.ws + WS_VT); bf16* HM = (bf16*)(A.ws + WS_HM);
    const bf16* CST = (const bf16*)(A.ws + WS_CST); const float* NST = (const float*)(A.ws + WS_NST);
    const float* hg = A.in[10] + (size_t)jl * NV;
    const int w = C.wave, eh = w >> 2;
    for (int u = C.bid; u < NUNIT; u += C.G) {
        const int blk = u % NBLK, bh = u / NBLK, h = bh % NH, b = bh / NH; const int row0 = blk_row0(b, blk);
        if (blk == 0 && !ctx_out) continue;
        block_gates(A, row0, h, bf, bb, gf, gb, C.tid);
        if (C.tid < 256) { gf[C.tid] -= bf[C.tid]; gb[C.tid] -= bb[C.tid]; }
        else { const int t = C.tid - 256; nf[t] = NST[(size_t)(u * 2 + (t >> 7)) * DQK + (t & 127)]; }
        { const int pc = C.tid & 15, s0 = C.tid >> 4; const bf16* kr = P + (size_t)(row0 + s0) * PW + NQ + h * DQK + 8 * pc;
#pragma unroll
          for (int i = 0; i < 8; ++i) *(LAS u32x4*)(Kimg + (s0 + 32 * i) * KP + pc * 16) = *(const u32x4*)(kr + (size_t)(32 * i) * PW); }
        __syncthreads();
        const bf16* vtile = VT + (size_t)vt_tile(b, h, blk) * 65536;
        const bf16* ctile = CST + (size_t)(u * 2) * DQK * DV;
#pragma unroll 1
        for (int ps = 0; ps < 2; ++ps) {
            int lz = threadIdx.x & 63; asm volatile("" : "+v"(lz));
            const int r = lz & 31, hh = lz >> 5;
            const int jt = 2 * (w & 3) + ps; const int jrow = row0 + 32 * jt + r;
            u32x4 pre[4];
            { int tz = threadIdx.x; asm volatile("" : "+v"(tz)); const int pc = tz & 7, e0 = tz >> 3; const bf16* vr = vtile + (size_t)e0 * 256 + 8 * pc;
#pragma unroll
              for (int c4 = 0; c4 < 4; ++c4) pre[c4] = *(const u32x4*)(vr + (size_t)(64 * c4) * 256); }
            bf16x8 qf[8];
            { const bf16* qr = P + (size_t)jrow * PW + h * DQK + 8 * hh;
#pragma unroll
              for (int kk = 0; kk < 8; ++kk) qf[kk] = *(const bf16x8*)(qr + 16 * kk); }
            const float bfj = bf[32 * jt + r], bbj = bb[32 * jt + r];
            float qnf = 0.f, qnb = 0.f;
#pragma unroll
            for (int kk = 0; kk < 8; ++kk) { const u32x4 qq = __builtin_bit_cast(u32x4, qf[kk]); const int d = 16 * kk + 8 * hh;
                const f32x4 n0 = *(const LAS f32x4*)(nf + d), n1 = *(const LAS f32x4*)(nf + d + 4), m0 = *(const LAS f32x4*)(nb + d), m1 = *(const LAS f32x4*)(nb + d + 4);
                qnf += (bflo(qq.x) * n0.x + bfhi(qq.x) * n0.y) + (bflo(qq.y) * n0.z + bfhi(qq.y) * n0.w) + (bflo(qq.z) * n1.x + bfhi(qq.z) * n1.y) + (bflo(qq.w) * n1.z + bfhi(qq.w) * n1.w);
                qnb += (bflo(qq.x) * m0.x + bfhi(qq.x) * m0.y) + (bflo(qq.y) * m0.z + bfhi(qq.y) * m0.w) + (bflo(qq.z) * m1.x + bfhi(qq.z) * m1.y) + (bflo(qq.w) * m1.z + bfhi(qq.w) * m1.w);
                if (kk & 1) asm volatile("" ::: "memory"); }
            qnf += __shfl_xor(qnf, 32); qnb += __shfl_xor(qnb, 32);
            float denf = 0.f, denb = 0.f;
#pragma unroll 1
            for (int kt = 0; kt < 8; ++kt) {
                f32x16 c;
#pragma unroll
                for (int i = 0; i < 16; ++i) c[i] = 0.f;
#pragma unroll
                for (int kk = 0; kk < 8; ++kk) { const bf16x8 a = *(const LAS bf16x8*)(Kimg + (kt * 32 + r) * KP + (16 * kk + 8 * hh) * 2); c = MFMA32(a, qf[kk], c); }
#pragma unroll
                for (int g = 0; g < 4; ++g) { const int sl0 = 8 * g + 4 * hh;
                    const f32x4 g4f = *(const LAS f32x4*)(gf + kt * 32 + sl0), g4b = *(const LAS f32x4*)(gb + kt * 32 + sl0);
#pragma unroll
                    for (int q = 0; q < 4; ++q) { const int sl = sl0 + q; const float cv = c[4 * g + q];
                        if (kt <= jt) { const bool act = (kt < jt) || (sl <= r); denf += cv * __expf(act ? bfj + g4f[q] : -1.0e30f); }
                        if (kt >= jt) { const bool act = (kt > jt) || (sl >= r); denb += cv * __expf(act ? bbj + g4b[q] : -1.0e30f); } } }
            }
            denf += __shfl_xor(denf, 32); denb += __shfl_xor(denb, 32);
            const float ebf = __expf(bfj), ebb = __expf(bbj);
            denf += ebf * qnf; denb += ebb * qnb;
            const float rf = 1.0f / fmaxf(fabsf(denf), 1.0f), rb = 1.0f / fmaxf(fabsf(denb), 1.0f);
            const float scf = ebf * rf, scb = ebb * rb;
            f32x16 acc[4];
#pragma unroll
            for (int et = 0; et < 4; ++et)
#pragma unroll
                for (int i = 0; i < 16; ++i) acc[et][i] = 0.f;
#pragma unroll
            for (int ci = 0; ci < 8; ++ci) {
                lds_barrier();
                { int tz = threadIdx.x; asm volatile("" : "+v"(tz)); const int pc = tz & 7, e0 = tz >> 3;
                  if (ci < 4) {
#pragma unroll
                      for (int c4 = 0; c4 < 4; ++c4) { *(LAS u32x2*)(CH + (e0 + 64 * c4) * VP + pc * 16) = (u32x2){pre[c4].x, pre[c4].y}; *(LAS u32x2*)(CH + (e0 + 64 * c4) * VP + pc * 16 + 8) = (u32x2){pre[c4].z, pre[c4].w}; }
                  } else {
#pragma unroll
                      for (int c4 = 0; c4 < 4; ++c4) *(LAS u32x4*)(CH + (e0 + 64 * c4) * CP + pc * 16) = pre[c4];
                  }
                  if (ci < 7) { const int cn = ci + 1;
                      const bf16* src = (cn < 4) ? vtile + (size_t)e0 * 256 + 64 * cn + 8 * pc : ctile + (size_t)(cn >= 6 ? DQK * DV : 0) + (size_t)e0 * DQK + 64 * (cn & 1) + 8 * pc;
                      const size_t rstep = (cn < 4) ? (size_t)64 * 256 : (size_t)64 * DQK;
#pragma unroll
                      for (int c4 = 0; c4 < 4; ++c4) pre[c4] = *(const u32x4*)(src + c4 * rstep); } }
                lds_barrier();
                if (ci < 4) {
#pragma unroll 1
                    for (int kt2 = 0; kt2 < 2; ++kt2) { const int kt = 2 * ci + kt2;
                        f32x16 c;
#pragma unroll
                        for (int i = 0; i < 16; ++i) c[i] = 0.f;
#pragma unroll
                        for (int kk = 0; kk < 8; ++kk) { const bf16x8 a = *(const LAS bf16x8*)(Kimg + (kt * 32 + r) * KP + (16 * kk + 8 * hh) * 2); c = MFMA32(a, qf[kk], c); }
                        float p[16]; const float bfj2 = bf[32 * jt + r], bbj2 = bb[32 * jt + r];
#pragma unroll
                        for (int g = 0; g < 4; ++g) { const int sl0 = 8 * g + 4 * hh;
                            const f32x4 g4f = *(const LAS f32x4*)(gf + kt * 32 + sl0), g4b = *(const LAS f32x4*)(gb + kt * 32 + sl0);
#pragma unroll
                            for (int q = 0; q < 4; ++q) { const int sl = sl0 + q; float wt = 0.f;
                                if (kt <= jt) { const bool act = (kt < jt) || (sl <= r); wt += rf * __expf(act ? bfj2 + g4f[q] : -1.0e30f); }
                                if (kt >= jt) { const bool act = (kt > jt) || (sl >= r); wt += rb * __expf(act ? bbj2 + g4b[q] : -1.0e30f); }
                                p[4 * g + q] = c[4 * g + q] * wt; } }
                        const bf16x8 pa0 = pack8(p[0], p[1], p[2], p[3], p[4], p[5], p[6], p[7]), pa1 = pack8(p[8], p[9], p[10], p[11], p[12], p[13], p[14], p[15]);
#pragma unroll
                        for (int et = 0; et < 4; ++et) { LAS const unsigned char* vb = CH + ((4 * eh + et) * 32 + r) * VP + (kt2 * 32 + 4 * hh) * 2;
                            const u32x2 l0 = *(LAS const u32x2*)(vb), h0 = *(LAS const u32x2*)(vb + 16), l1 = *(LAS const u32x2*)(vb + 32), h1 = *(LAS const u32x2*)(vb + 48);
                            const bf16x8 a0 = __builtin_bit_cast(bf16x8, (u32x4){l0.x, l0.y, h0.x, h0.y}), a1 = __builtin_bit_cast(bf16x8, (u32x4){l1.x, l1.y, h1.x, h1.y});
                            acc[et] = MFMA32(a0, pa0, acc[et]); acc[et] = MFMA32(a1, pa1, acc[et]); }
                    }
                } else {
                    const int dir = (ci - 4) >> 1, dh = ci & 1;
                    const float sc = dir ? scb : scf;
#pragma unroll
                    for (int k4 = 0; k4 < 4; ++k4) { const u32x4 qq = __builtin_bit_cast(u32x4, qf[4 * dh + k4]);
                        const bf16x8 qs = pack8(bflo(qq.x) * sc, bfhi(qq.x) * sc, bflo(qq.y) * sc, bfhi(qq.y) * sc, bflo(qq.z) * sc, bfhi(qq.z) * sc, bflo(qq.w) * sc, bfhi(qq.w) * sc);
#pragma unroll
                        for (int et = 0; et < 4; ++et) { const bf16x8 a = *(const LAS bf16x8*)(CH + ((4 * eh + et) * 32 + r) * CP + (16 * k4 + 8 * hh) * 2); acc[et] = MFMA32(a, qs, acc[et]); } }
                }
            }
            float ss = 0.f;
#pragma unroll
            for (int et = 0; et < 4; ++et)
#pragma unroll
                for (int i = 0; i < 16; ++i) ss += acc[et][i] * acc[et][i];
            ss += __shfl_xor(ss, 32);
            if (hh == 0) ssx[w * 32 + r] = ss;
            lds_barrier();
            ss += ssx[(w ^ 4) * 32 + r];
            const float rs = 1.0f / sqrtf(ss * (1.0f / DV) + EPS);
            { LAS unsigned char* ob = CH + ((w & 3) * 32 + r) * OP + (eh * 128 + 4 * hh) * 2;
#pragma unroll
              for (int et = 0; et < 4; ++et)
#pragma unroll
                  for (int g = 0; g < 4; ++g) { u32x2 o; o.x = cvt2(acc[et][4 * g + 0] * rs, acc[et][4 * g + 1] * rs); o.y = cvt2(acc[et][4 * g + 2] * rs, acc[et][4 * g + 3] * rs);
                      *(LAS u32x2*)(ob + (et * 32 + 8 * g) * 2) = o; } }
            lds_barrier();
            { int tz = threadIdx.x; asm volatile("" : "+v"(tz)); const int pc = tz & 31, lr0 = tz >> 5;
              const f32x4 g0 = *(const f32x4*)(hg + h * DV + 8 * pc), g1 = *(const f32x4*)(hg + h * DV + 8 * pc + 4);
#pragma unroll
              for (int hf = 0; hf < 2; ++hf) {
              u32x4 ov[4];
#pragma unroll
              for (int i = 0; i < 4; ++i) { const int lr = lr0 + 16 * (4 * hf + i); const int grow = row0 + 64 * (lr >> 5) + 32 * ps + (lr & 31); ov[i] = *(const u32x4*)(P + (size_t)grow * PW + 2 * NQ + NV + h * DV + 8 * pc); }
#pragma unroll
              for (int i = 0; i < 4; ++i) { const int lr = lr0 + 16 * (4 * hf + i); const int grow = row0 + 64 * (lr >> 5) + 32 * ps + (lr & 31);
                  const u32x4 hv = *(const LAS u32x4*)(CH + lr * OP + pc * 16);
                  u32x4 o; o.x = cvt2(bflo(hv.x) * g0.x * bflo(ov[i].x), bfhi(hv.x) * g0.y * bfhi(ov[i].x)); o.y = cvt2(bflo(hv.y) * g0.z * bflo(ov[i].y), bfhi(hv.y) * g0.w * bfhi(ov[i].y));
                  o.z = cvt2(bflo(hv.z) * g1.x * bflo(ov[i].z), bfhi(hv.z) * g1.y * bfhi(ov[i].z)); o.w = cvt2(bflo(hv.w) * g1.z * bflo(ov[i].w), bfhi(hv.w) * g1.w * bfhi(ov[i].w));
                  *(u32x4*)(HM + (size_t)grow * D + h * DV + 8 * pc) = o; }
              asm volatile("" ::: "memory"); } }
        }
        __syncthreads();
    }
}

#define XB_TMO      128
#define XB_XCNT(j)  (256  + 64 * (j))
#define XB_XSUB(j)  (1280 + 64 * (j))
#define XB_XGEN(j)  (2304 + 64 * (j))
#define XB_TOP      3328
#define XB_TOPGEN   3392
#define XCD_BAR_WORDS 3456
#define XB_SPIN_CAP (1u << 18)

__device__ __forceinline__ unsigned xb_ld(unsigned* p)              { return __hip_atomic_load(p, __ATOMIC_RELAXED, __HIP_MEMORY_SCOPE_AGENT); }
__device__ __forceinline__ unsigned xb_add(unsigned* p, unsigned v) { return __hip_atomic_fetch_add(p, v, __ATOMIC_RELAXED, __HIP_MEMORY_SCOPE_AGENT); }
__device__ __forceinline__ unsigned xb_xcc_id() { return (unsigned)__builtin_amdgcn_s_getreg((3 << 11) | 20) & 0xFu; }
#define XB_SPIN(cond, bar) do { unsigned _sp = 0; while (cond) { __builtin_amdgcn_s_sleep(1); \
    if ((++_sp & 255u) == 0u) { if (xb_ld(&(bar)[XB_TMO])) break; if (_sp > XB_SPIN_CAP) { atomicAdd(&(bar)[XB_TMO], 1u); break; } } } } while (0)

struct XcdBarrier {
    unsigned* bar; unsigned x;
    volatile LAS unsigned* st;
};

__device__ __forceinline__ XcdBarrier xcd_barrier_post(unsigned* bar, volatile LAS unsigned* st) {
    XcdBarrier b; b.bar = bar; b.x = xb_xcc_id(); b.st = st;
    if (threadIdx.x == 0) (void)xb_add(&bar[XB_XCNT(b.x)], 1u);
    return b;
}
__device__ __forceinline__ void xcd_barrier_complete(unsigned* bar, unsigned x, unsigned& nloc, unsigned& nx) {
    const unsigned G = gridDim.x * gridDim.y * gridDim.z;
    unsigned sum, cnt, mine, sp = 0u;
    for (;;) {
        sum = 0u; cnt = 0u; mine = 0u;
#pragma unroll
        for (unsigned j = 0; j < 16; ++j) { const unsigned c = xb_ld(&bar[XB_XCNT(j)]); sum += c; cnt += (c > 0u) ? 1u : 0u; mine = (j == x) ? c : mine; }
        if (sum == G) break;
        __builtin_amdgcn_s_sleep(1);
        if ((++sp & 255u) == 0u) { if (xb_ld(&bar[XB_TMO])) break; if (sp > XB_SPIN_CAP) { atomicAdd(&bar[XB_TMO], 1u); break; } }
    }
    nloc = mine > 0u ? mine : 1u; nx = cnt > 0u ? cnt : 1u;
}

__device__ __forceinline__ void xcd_barrier(const XcdBarrier& b) {
    asm volatile("s_waitcnt vmcnt(0)" ::: "memory");
    __syncthreads();
    if (threadIdx.x == 0) {
        unsigned* bar = b.bar;
        __builtin_amdgcn_s_waitcnt(0);
        unsigned nloc = b.st[0], nx = b.st[1];
        if (nloc == 0u) { xcd_barrier_complete(bar, b.x, nloc, nx); b.st[0] = nloc; b.st[1] = nx; }
        const unsigned old = xb_add(&bar[XB_XSUB(b.x)], 1u);
        const unsigned gen = old / nloc;
        if (old + 1u == (gen + 1u) * nloc) {
            __builtin_amdgcn_fence(__ATOMIC_RELEASE, "agent");
            asm volatile("s_waitcnt vmcnt(0)" ::: "memory");
            const unsigned og = xb_add(&bar[XB_TOP], 1u);
            const unsigned tg = og / nx;
            if (og + 1u == (tg + 1u) * nx) xb_add(&bar[XB_TOPGEN], 1u);
            else XB_SPIN(xb_ld(&bar[XB_TOPGEN]) == tg, bar);
            __builtin_amdgcn_fence(__ATOMIC_ACQUIRE, "agent");
            xb_add(&bar[XB_XGEN(b.x)], 1u);
            asm volatile("s_waitcnt vmcnt(0)" ::: "memory");
        } else {
            XB_SPIN(xb_ld(&bar[XB_XGEN(b.x)]) == gen, bar);
            __builtin_amdgcn_fence(__ATOMIC_ACQUIRE, "agent");
            asm volatile("s_waitcnt vmcnt(0)" ::: "memory");
        }
    }
    __syncthreads();
}


constexpr int LDS_BYTES = 152 * 1024;
constexpr int CW_BAR = 16384;
static_assert((CW_BAR + XCD_BAR_WORDS) * 4 <= (int)CTL_BYTES, "ctl");
#ifndef MK_MULTI
#define MK_MULTI 0
#endif
#define IN(p) (lo <= (p) && (p) < hi)
#ifndef PROBE_MASK
#define PROBE_MASK 0
#endif
#define DUP(bit, call) do { call; if (PROBE_MASK & (bit)) { xcd_barrier(bar); call; } } while (0)
#define SEAM(p) do { if ((p) + 1 < hi) xcd_barrier(bar); } while (0)
__device__ __forceinline__ Ctx fresh(const Ctx& C) { Ctx R = C; int tz = threadIdx.x; asm volatile("" : "+v"(tz)); R.tid = tz; R.lane = tz & 63; return R; }
template <int L> __device__ __forceinline__ void layer_phases(const Args& args, const Ctx& C, const XcdBarrier& bar, int lo, int hi) {
    constexpr int pb = 16 * L;
    if (IN(pb + 1)) { DUP(4, phase_cvt_moe(args, fresh(C), L)); __syncthreads(); phase_r1(args, fresh(C), L); SEAM(pb + 1); }
    if (IN(pb + 2)) { DUP(1, phase_g1(args, fresh(C), L)); SEAM(pb + 2); }
    if constexpr ((L & 1) == 0) {
        if (IN(pb + 3)) { DUP(2, phase_s1(args, fresh(C), L)); SEAM(pb + 3); }
        if (IN(pb + 4)) { DUP(2, phase_s2(args, fresh(C))); SEAM(pb + 4); }
        if (IN(pb + 5)) { DUP(2, phase_s3(args, fresh(C), L)); SEAM(pb + 5); }
    } else {
        if (IN(pb + 3)) { DUP(8, phase_conv(args, fresh(C), L)); SEAM(pb + 3); }
    }
    if (IN(pb + 6)) { DUP(1, phase_g2(args, fresh(C), L)); SEAM(pb + 6); }
    if (IN(pb + 7)) { phase_r2(args, fresh(C), L); SEAM(pb + 7); }
    if (IN(pb + 8)) { DUP(1, phase_m1(args, fresh(C), L)); SEAM(pb + 8); }
    if (IN(pb + 9)) { DUP(1, phase_m2(args, fresh(C), L)); SEAM(pb + 9); }
}
__global__ void __launch_bounds__(NT, 2) fwd_kernel(Args args) {
    extern __shared__ __attribute__((aligned(16))) unsigned char lds_raw[];
    Ctx C; C.lds = (LAS unsigned char*)lds_raw; C.tid = threadIdx.x; C.lane = C.tid & 63; C.wave = __builtin_amdgcn_readfirstlane(C.tid >> 6); C.G = gridDim.x; C.bid = blockIdx.x; C.a = &args;
    const int lo = args.lo, hi = args.hi;
    volatile LAS unsigned* xbw = (volatile LAS unsigned*)(C.lds + LDS_BYTES - 16);
    if (C.tid < 4) xbw[C.tid] = 0u;
    __syncthreads();
    XcdBarrier bar; bar.bar = (unsigned*)(args.ws + WS_CTL) + CW_BAR; bar.x = 0; bar.st = xbw;
    if (hi - lo > 1) bar = xcd_barrier_post((unsigned*)(args.ws + WS_CTL) + CW_BAR, xbw);
    if (IN(0)) { DUP(4, phase_mod(args, fresh(C))); __syncthreads(); DUP(4, phase_cvt_mixer(args, fresh(C))); SEAM(0); }
    layer_phases<0>(args, C, bar, lo, hi);
    layer_phases<1>(args, C, bar, lo, hi);
    layer_phases<2>(args, C, bar, lo, hi);
    layer_phases<3>(args, C, bar, lo, hi);
    if (IN(64)) phase_final(args, fresh(C));
}
#undef IN
#undef SEAM

extern "C" void kernel_launch(void* const* d_in, const int* in_sizes, int n_in, void* d_out, int out_size, void* d_ws, size_t ws_size, hipStream_t stream) {
    static int grid = 0;
    if (grid == 0) {
        if (n_in != 22 || out_size != NL * D || ws_size < WS_END) { fprintf(stderr, "kernel_launch: unexpected shapes (n_in %d out %d ws %zu)\n", n_in, out_size, ws_size); grid = -1; return; }
        int dev = 0, cus = 0, per_cu = 0;
        if (hipGetDevice(&dev) != hipSuccess || hipDeviceGetAttribute(&cus, hipDeviceAttributeMultiprocessorCount, dev) != hipSuccess) { grid = -1; return; }
        if (hipFuncSetAttribute((const void*)fwd_kernel, hipFuncAttributeMaxDynamicSharedMemorySize, LDS_BYTES) != hipSuccess) { grid = -1; return; }
        if (hipOccupancyMaxActiveBlocksPerMultiprocessor(&per_cu, (const void*)fwd_kernel, NT, LDS_BYTES) != hipSuccess || per_cu < 1) { fprintf(stderr, "kernel_launch: occupancy query says %d\n", per_cu); }
        (void)hipGetLastError();
        grid = cus;
    }
    if (grid < 0) return;
    (void)hipMemsetAsync((char*)d_ws + WS_CTL, 0, CTL_BYTES, stream);
    Args a{};
    for (int i = 0; i < 22; ++i) a.in[i] = (const float*)d_in[i];
    a.out = (float*)d_out; a.ws = (unsigned char*)d_ws;
#if MK_MULTI
    int phases[64]; int np = 0;
    phases[np++] = 0;
    for (int l = 0; l < DEPTH; ++l) { const int pb = 16 * l; phases[np++] = pb + 1; phases[np++] = pb + 2; phases[np++] = pb + 3;
        if ((l & 1) == 0) { phases[np++] = pb + 4; phases[np++] = pb + 5; }
        phases[np++] = pb + 6; phases[np++] = pb + 7; phases[np++] = pb + 8; phases[np++] = pb + 9; }
    phases[np++] = 64;
    for (int i = 0; i < np; ++i) { a.lo = phases[i]; a.hi = phases[i] + 1; hipLaunchKernelGGL(fwd_kernel, dim3(grid), dim3(NT), LDS_BYTES, stream, a); }
#else
    a.lo = 0; a.hi = 65;
    hipLaunchKernelGGL(fwd_kernel, dim3(grid), dim3(NT), LDS_BYTES, stream, a);
#ifdef PROBE_PHASES
    { const int pp[] = {PROBE_PHASES};
      for (int rep = 0; rep < PROBE_REPS; ++rep) for (unsigned i = 0; i < sizeof(pp) / sizeof(pp[0]); ++i) { a.lo = pp[i]; a.hi = pp[i] + 1; hipLaunchKernelGGL(fwd_kernel, dim3(grid), dim3(NT), LDS_BYTES, stream, a); } }
#endif
#endif
}
```

```cpp
#include <hip/hip_runtime.h>
#include <cstdio>
#include <cstdint>

#define LAS __attribute__((address_space(3)))
typedef unsigned short bf16;
typedef float f32x4 __attribute__((ext_vector_type(4)));
typedef unsigned u32x4 __attribute__((ext_vector_type(4)));
typedef unsigned u32x2 __attribute__((ext_vector_type(2)));

constexpr int D = 1024, BATCH = 2, SEQ = 16384, DEPTH = 4, CTXL = 256;
constexpr int NL = BATCH * SEQ, NCX = BATCH * CTXL, NR = NL + NCX;
constexpr int NH = 4, DQK = 128, DV = 256, NQ = 512, NV = 1024, PROJ = 3088, PW = 3072;
constexpr int NGRP = 4, EPG = 8, NE = 32, DE = 512;
constexpr int NBLK = 65;
constexpr int NUNIT = BATCH * NH * NBLK;
constexpr int CAP = NR;
constexpr int YROWS = 74752;
constexpr float EPS = 1e-6f;
constexpr int NT = 512, NW = 8;
constexpr int LDS_TAB_END = 152 * 1024 - 16;

constexpr size_t MiB = 1u << 20;
constexpr size_t WS_CTL = 0, CTL_BYTES = 1 * MiB;
constexpr size_t WS_MOD = 1 * MiB;
constexpr size_t WS_GATE = 2 * MiB;
constexpr size_t WS_TOKSLOT = 5 * MiB;
constexpr size_t WS_TOKW = 6 * MiB;
constexpr size_t WS_SLOTTOK = 7 * MiB;
constexpr size_t WS_DN = 12 * MiB;
constexpr size_t WS_NST = 13 * MiB;
constexpr size_t WS_BTOT = 14 * MiB;
constexpr size_t WS_LAT = 16 * MiB;
constexpr size_t WS_HB = 146 * MiB;
constexpr size_t WS_PB = 211 * MiB;
constexpr size_t WS_HM = 406 * MiB;
constexpr size_t WS_DC = 471 * MiB;
constexpr size_t WS_CST = 601 * MiB;
constexpr size_t WS_VT = 666 * MiB;
constexpr size_t WS_WAIN = 731 * MiB;
constexpr size_t WS_WBIN = 743 * MiB;
constexpr size_t WS_WAOUT = 755 * MiB;
constexpr size_t WS_WBOUT = 759 * MiB;
constexpr size_t WS_WGU = 763 * MiB;
constexpr size_t WS_WDN = 827 * MiB;
constexpr size_t WS_H8 = 843 * MiB;
constexpr size_t WS_END = 880 * MiB;
constexpr int CW_CNT = 1024, CNT_STRIDE = 64;

struct Args { const float* in[22]; float* out; unsigned char* ws; int lo, hi; };

typedef short bf16x8 __attribute__((ext_vector_type(8)));
typedef float f32x2 __attribute__((ext_vector_type(2)));
typedef __bf16 bf16x2_t __attribute__((ext_vector_type(2)));
__device__ __forceinline__ unsigned cvt2(float lo, float hi) { const f32x2 v = {lo, hi}; return __builtin_bit_cast(unsigned, __builtin_convertvector(v, bf16x2_t)); }
__device__ __forceinline__ float bf2f(bf16 v) { return __uint_as_float(((unsigned)v) << 16); }
__device__ __forceinline__ unsigned f2bf(float f) { unsigned u = __float_as_uint(f); return (u + 0x7fffu + ((u >> 16) & 1u)) >> 16; }
__device__ __forceinline__ unsigned pk2(float lo, float hi) { return f2bf(lo) | (f2bf(hi) << 16); }
template <int CTRL, int ROWMASK> __device__ __forceinline__ float dpp_mov(float x) { return __int_as_float(__builtin_amdgcn_update_dpp(0, __float_as_int(x), CTRL, ROWMASK, 0xf, false)); }
__device__ __forceinline__ float wave_sum(float v) {
    v += dpp_mov<0xB1, 0xf>(v); v += dpp_mov<0x4E, 0xf>(v); v += dpp_mov<0x141, 0xf>(v); v += dpp_mov<0x140, 0xf>(v);
    v += dpp_mov<0x142, 0xA>(v); v += dpp_mov<0x143, 0xC>(v);
    return __int_as_float(__builtin_amdgcn_readlane(__float_as_int(v), 63));
}
__device__ __forceinline__ float sigmoidf_(float x) { return 1.f / (1.f + __expf(-x)); }
__device__ __forceinline__ float siluf_(float x) { return x / (1.f + __expf(-x)); }
__device__ __forceinline__ float logsigmoidf_(float x) { return fminf(x, 0.f) - log1pf(__expf(-fabsf(x))); }
__device__ __forceinline__ int blk_row0(int b, int blk) { return blk == 0 ? NL + b * CTXL : b * SEQ + (blk - 1) * 256; }
__device__ __forceinline__ int mod_vec_of_row(int row) { return row < NL ? row / SEQ : 2; }

struct Ctx {
    LAS unsigned char* lds; int tid, lane, wave, G, bid;
    const Args* a;
};

__device__ __forceinline__ void slot_bases(const Args& A, int l, LAS int* sb, int tid) {
    if (tid == 0) {
        const unsigned* cnt = (const unsigned*)(A.ws + WS_CTL) + CW_CNT + l * 32 * CNT_STRIDE;
        int acc = 0;
        for (int e = 0; e < NE; ++e) { sb[e] = acc; acc += (((int)cnt[e * CNT_STRIDE] + 255) / 256) * 256; }
        sb[NE] = acc;
    }
    __syncthreads();
}

__device__ __forceinline__ void phase_mod(const Args& A, const Ctx& C) {
    LAS float* sc = (LAS float*)C.lds;
    LAS float* red = sc + 3072;
    const float* c = A.in[1]; const float* cc = A.in[3];
    for (int i = C.tid; i < 3072; i += NT) { const float v = i < 2048 ? c[i] : cc[i - 2048]; sc[i] = siluf_(v); }
    __syncthreads();
    float* MOD = (float*)(A.ws + WS_MOD);
    for (int u = C.bid; u < DEPTH * 96; u += C.G) {
        const int l = u / 96, cg = u % 96, col = cg * 64 + C.lane;
        const float* w = A.in[4] + (size_t)l * D * 6 * D + col;
        float a0 = 0.f, a1 = 0.f, a2 = 0.f;
        for (int k = C.wave * 128; k < C.wave * 128 + 128; ++k) { const float wv = w[(size_t)k * 6 * D]; a0 += sc[k] * wv; a1 += sc[1024 + k] * wv; a2 += sc[2048 + k] * wv; }
        red[(C.wave * 3 + 0) * 64 + C.lane] = a0; red[(C.wave * 3 + 1) * 64 + C.lane] = a1; red[(C.wave * 3 + 2) * 64 + C.lane] = a2;
        __syncthreads();
        if (C.tid < 192) { const int v = C.tid / 64, ln = C.tid % 64; float s = 0.f;
            for (int w8 = 0; w8 < 8; ++w8) s += red[(w8 * 3 + v) * 64 + ln];
            MOD[(size_t)(l * 3 + v) * 6 * D + cg * 64 + ln] = s + A.in[5][(size_t)l * 6 * D + cg * 64 + ln]; }
        __syncthreads();
    }
}

__device__ __forceinline__ void load_row_f32(const float* p, int lane, f32x4 (&v)[4]) {
#pragma unroll
    for (int j = 0; j < 4; ++j) v[j] = *(const f32x4*)(p + 4 * lane + 256 * j);
}
__device__ __forceinline__ void load_row_bf16(const bf16* p, int lane, f32x4 (&v)[4]) {
#pragma unroll
    for (int j = 0; j < 4; ++j) { const u32x2 w = *(const u32x2*)(p + 4 * lane + 256 * j);
        v[j] = (f32x4){__uint_as_float(w.x << 16), __uint_as_float(w.x & 0xffff0000u), __uint_as_float(w.y << 16), __uint_as_float(w.y & 0xffff0000u)}; }
}
__device__ __forceinline__ void store_row_bf16(bf16* p, int lane, const f32x4 (&v)[4]) {
#pragma unroll
    for (int j = 0; j < 4; ++j) { u32x2 w; w.x = pk2(v[j].x, v[j].y); w.y = pk2(v[j].z, v[j].w); *(u32x2*)(p + 4 * lane + 256 * j) = w; }
}
__device__ __forceinline__ void moe_combine(const Args& A, int lp, int row, int lane, LAS const int* sb, f32x4 (&v)[4]) {
    const int* ts = (const int*)(A.ws + WS_TOKSLOT) + row * 2; const float* tw = (const float*)(A.ws + WS_TOKW) + row * 2;
    const bf16* Y = (const bf16*)(A.ws + WS_PB);
    const int t0 = ts[0], t1 = ts[1]; const float w0 = tw[0], w1 = tw[1];
    const size_t s0 = (size_t)(sb[t0 >> 20] + (t0 & 0xfffff)), s1 = (size_t)(sb[t1 >> 20] + (t1 & 0xfffff));
    f32x4 y0[4], y1[4], g2[4];
    load_row_bf16(Y + s0 * D, lane, y0); load_row_bf16(Y + s1 * D, lane, y1);
    load_row_f32((const float*)(A.ws + WS_MOD) + (size_t)(lp * 3 + mod_vec_of_row(row)) * 6 * D + 5 * D, lane, g2);
#pragma unroll
    for (int j = 0; j < 4; ++j) v[j] += g2[j] * (y0[j] * w0 + y1[j] * w1);
}
__device__ __forceinline__ void norm_mod(const f32x4 (&v)[4], const float* g, const float* sh, const float* sc, int lane, f32x4 (&h)[4]) {
    float s = 0.f;
#pragma unroll
    for (int j = 0; j < 4; ++j) s += (v[j].x * v[j].x + v[j].y * v[j].y) + (v[j].z * v[j].z + v[j].w * v[j].w);
    const float r = 1.0f / sqrtf(wave_sum(s) * (1.f / D) + EPS);
    f32x4 gg[4], ss[4], cc[4];
    load_row_f32(g, lane, gg); load_row_f32(sh, lane, ss); load_row_f32(sc, lane, cc);
#pragma unroll
    for (int j = 0; j < 4; ++j) h[j] = (v[j] * r) * gg[j] * (1.f + cc[j]) + ss[j];
}

struct RowVec { f32x4 a[4], s[4], g[4]; };
__device__ __forceinline__ void load_rowvec(RowVec& R, const float* ng, const float* sh, const float* sc, const float* gt, int lane) {
    f32x4 n[4], c[4]; load_row_f32(ng, lane, n); load_row_f32(sc, lane, c); load_row_f32(sh, lane, R.s); if (gt) load_row_f32(gt, lane, R.g);
#pragma unroll
    for (int q = 0; q < 4; ++q) R.a[q] = n[q] * (1.f + c[q]);
}
__device__ __forceinline__ void load_row_bf16raw(const bf16* p, int lane, u32x2 (&v)[4]) {
#pragma unroll
    for (int j = 0; j < 4; ++j) v[j] = *(const u32x2*)(p + 4 * lane + 256 * j);
}
__device__ __forceinline__ void store_row_fp8(unsigned char* p, int lane, const f32x4 (&v)[4]) {
#pragma unroll
    for (int j = 0; j < 4; ++j) { int w = 0; w = __builtin_amdgcn_cvt_pk_fp8_f32(v[j].x, v[j].y, w, false); w = __builtin_amdgcn_cvt_pk_fp8_f32(v[j].z, v[j].w, w, true); *(unsigned*)(p + 4 * lane + 256 * j) = (unsigned)w; }
}
__device__ __forceinline__ f32x4 bf4(u32x2 w) { return (f32x4){__uint_as_float(w.x << 16), __uint_as_float(w.x & 0xffff0000u), __uint_as_float(w.y << 16), __uint_as_float(w.y & 0xffff0000u)}; }
__device__ __forceinline__ float row_rstd(const f32x4 (&v)[4]) {
    float s = 0.f;
#pragma unroll
    for (int j = 0; j < 4; ++j) s += (v[j].x * v[j].x + v[j].y * v[j].y) + (v[j].z * v[j].z + v[j].w * v[j].w);
    return 1.0f / sqrtf(wave_sum(s) * (1.f / D) + EPS);
}

__device__ __forceinline__ void phase_r1(const Args& A, const Ctx& C, int l) {
    LAS int* sb = (LAS int*)C.lds;
    LAS float* GW = (LAS float*)(C.lds + 256);
    const bool mls = (l & 1) == 0; const int j = l >> 1;
    if (l > 0) slot_bases(A, l - 1, sb, C.tid);
    if (mls) { const float* w = A.in[8] + (size_t)j * D * PROJ + PW;
        f32x4 t[2][4];
#pragma unroll
        for (int jj = 0; jj < 2; ++jj)
#pragma unroll
            for (int q = 0; q < 4; ++q) t[jj][q] = *(const f32x4*)(w + (size_t)(C.tid + NT * jj) * PROJ + 4 * q);
#pragma unroll
        for (int jj = 0; jj < 2; ++jj)
#pragma unroll
            for (int q = 0; q < 4; ++q) { const int k = C.tid + NT * jj; GW[(4 * q + 0) * D + k] = t[jj][q].x; GW[(4 * q + 1) * D + k] = t[jj][q].y; GW[(4 * q + 2) * D + k] = t[jj][q].z; GW[(4 * q + 3) * D + k] = t[jj][q].w; }
        __syncthreads(); }
    const int nrows = (l <= 2) ? NR : NL;
    bf16* LAT = (bf16*)(A.ws + WS_LAT); bf16* H = (bf16*)(A.ws + WS_HB); float* GATE = (float*)(A.ws + WS_GATE);
    const float* MOD = (const float*)(A.ws + WS_MOD); const bf16* Y = (const bf16*)(A.ws + WS_PB);
    const int* TS = (const int*)(A.ws + WS_TOKSLOT); const float* TW = (const float*)(A.ws + WS_TOKW);
    const int rpw = (((nrows + C.G - 1) / C.G) + 1) & ~1; const int wrow0 = C.bid * rpw; const int wend = min(wrow0 + rpw, nrows);
    for (int sa = wrow0; sa < wend;) {
        const int mvi = mod_vec_of_row(sa); const int bnd = mvi == 0 ? SEQ : (mvi == 1 ? NL : NR); const int sbnd = min(wend, bnd);
        RowVec RV; { const float* mv = MOD + (size_t)(l * 3 + mvi) * 6 * D;
            load_rowvec(RV, A.in[6] + (size_t)(l * 2 + 0) * D, mv + 0 * D, mv + 1 * D, l > 0 ? MOD + (size_t)((l - 1) * 3 + mvi) * 6 * D + 5 * D : nullptr, C.lane); }
        for (int ra = sa + 2 * C.wave; ra < sbnd; ra += 2 * NW) {
            const bool hasb = ra + 1 < sbnd; const int rb = hasb ? ra + 1 : ra;
            f32x4 va[4], vb[4]; float wa0 = 0.f, wa1 = 0.f, wb0 = 0.f, wb1 = 0.f;
            if (l == 0) { load_row_f32(ra < NL ? A.in[0] + (size_t)ra * D : A.in[2] + (size_t)(ra - NL) * D, C.lane, va); load_row_f32(rb < NL ? A.in[0] + (size_t)rb * D : A.in[2] + (size_t)(rb - NL) * D, C.lane, vb); }
            else {
                const int ta0 = TS[ra * 2], ta1 = TS[ra * 2 + 1], tb0 = TS[rb * 2], tb1 = TS[rb * 2 + 1]; wa0 = TW[ra * 2]; wa1 = TW[ra * 2 + 1]; wb0 = TW[rb * 2]; wb1 = TW[rb * 2 + 1];
                load_row_bf16(LAT + (size_t)ra * D, C.lane, va); load_row_bf16(LAT + (size_t)rb * D, C.lane, vb);
                u32x2 ya0[4], ya1[4], yb0[4], yb1[4];
                load_row_bf16raw(Y + (size_t)(sb[ta0 >> 20] + (ta0 & 0xfffff)) * D, C.lane, ya0); load_row_bf16raw(Y + (size_t)(sb[ta1 >> 20] + (ta1 & 0xfffff)) * D, C.lane, ya1);
                load_row_bf16raw(Y + (size_t)(sb[tb0 >> 20] + (tb0 & 0xfffff)) * D, C.lane, yb0); load_row_bf16raw(Y + (size_t)(sb[tb1 >> 20] + (tb1 & 0xfffff)) * D, C.lane, yb1);
#pragma unroll
                for (int q = 0; q < 4; ++q) { va[q] += RV.g[q] * (bf4(ya0[q]) * wa0 + bf4(ya1[q]) * wa1); vb[q] += RV.g[q] * (bf4(yb0[q]) * wb0 + bf4(yb1[q]) * wb1); }
            }
            store_row_bf16(LAT + (size_t)ra * D, C.lane, va); if (hasb) store_row_bf16(LAT + (size_t)rb * D, C.lane, vb);
            const float rra = row_rstd(va), rrb = row_rstd(vb);
            f32x4 ha[4], hb[4];
#pragma unroll
            for (int q = 0; q < 4; ++q) { ha[q] = (va[q] * rra) * RV.a[q] + RV.s[q]; hb[q] = (vb[q] * rrb) * RV.a[q] + RV.s[q]; }
            store_row_bf16(H + (size_t)ra * D, C.lane, ha); if (hasb) store_row_bf16(H + (size_t)rb * D, C.lane, hb);
            if (mls) {
                float ga = 0.f, gb = 0.f;
#pragma unroll 2
                for (int c = 0; c < 16; ++c) { float s0 = 0.f, s1 = 0.f;
#pragma unroll
                    for (int q = 0; q < 4; ++q) { const f32x4 w = *(const LAS f32x4*)(GW + c * D + 4 * C.lane + 256 * q);
                        s0 += (ha[q].x * w.x + ha[q].y * w.y) + (ha[q].z * w.z + ha[q].w * w.w); s1 += (hb[q].x * w.x + hb[q].y * w.y) + (hb[q].z * w.z + hb[q].w * w.w); }
                    s0 = wave_sum(s0); s1 = wave_sum(s1); ga = (C.lane == c) ? s0 : ga; gb = (C.lane == c) ? s1 : gb; }
                if (C.lane < 16) {
                    const float bgt = A.in[9][j * 16 + C.lane]; const int gtype = C.lane >> 2;
                    ga += bgt; gb += bgt;
                    GATE[(size_t)ra * 16 + C.lane] = (gtype & 1) ? logsigmoidf_(ga) : 15.0f * tanhf(ga * (1.0f / 15.0f));
                    if (hasb) GATE[(size_t)rb * 16 + C.lane] = (gtype & 1) ? logsigmoidf_(gb) : 15.0f * tanhf(gb * (1.0f / 15.0f)); }
            }
        }
        sa = sbnd;
    }
}

__device__ __forceinline__ void phase_r2(const Args& A, const Ctx& C, int l) {
    constexpr int WP = 2064;
    LAS unsigned char* RWB = C.lds;
    LAS float* WL = (LAS float*)(C.lds + 48 * WP);
    LAS unsigned* hist = (LAS unsigned*)(WL + 8 * 16 * 48);
    LAS unsigned* gbase = hist + 32;
    constexpr int RCAP = 144;
    LAS int* rec = (LAS int*)(gbase + 32);
    static_assert(48 * WP + 8 * 16 * 48 * 4 + 256 + RCAP * 16 <= LDS_TAB_END, "R2 LDS map");
    { const float* wg = A.in[15] + (size_t)l * D * NGRP; const float* wr = A.in[17] + (size_t)l * D * NE;
      { const int kp = C.tid; const f32x4 x0 = *(const f32x4*)(wg + (size_t)(2 * kp) * 4), x1 = *(const f32x4*)(wg + (size_t)(2 * kp + 1) * 4);
        *(LAS unsigned*)(RWB + 0 * WP + kp * 4) = cvt2(x0.x, x1.x); *(LAS unsigned*)(RWB + 1 * WP + kp * 4) = cvt2(x0.y, x1.y);
        *(LAS unsigned*)(RWB + 2 * WP + kp * 4) = cvt2(x0.z, x1.z); *(LAS unsigned*)(RWB + 3 * WP + kp * 4) = cvt2(x0.w, x1.w); }
      f32x4 t0[8], t1[8];
#pragma unroll
      for (int jj = 0; jj < 8; ++jj) { const int it = C.tid + NT * jj, kp = it >> 3, cg = it & 7; t0[jj] = *(const f32x4*)(wr + (size_t)(2 * kp) * NE + 4 * cg); t1[jj] = *(const f32x4*)(wr + (size_t)(2 * kp + 1) * NE + 4 * cg); }
#pragma unroll
      for (int jj = 0; jj < 8; ++jj) { const int it = C.tid + NT * jj, kp = it >> 3, c0 = 4 + 4 * (it & 7);
          *(LAS unsigned*)(RWB + (c0 + 0) * WP + kp * 4) = cvt2(t0[jj].x, t1[jj].x); *(LAS unsigned*)(RWB + (c0 + 1) * WP + kp * 4) = cvt2(t0[jj].y, t1[jj].y);
          *(LAS unsigned*)(RWB + (c0 + 2) * WP + kp * 4) = cvt2(t0[jj].z, t1[jj].z); *(LAS unsigned*)(RWB + (c0 + 3) * WP + kp * 4) = cvt2(t0[jj].w, t1[jj].w); }
      for (int i = C.tid; i < 12 * 512; i += NT) *(LAS unsigned*)(RWB + (36 + i / 512) * WP + (i % 512) * 4) = 0u; }
    const int nrows = (l <= 1) ? NR : NL;
    bf16* LAT = (bf16*)(A.ws + WS_LAT); bf16* H = (bf16*)(A.ws + WS_HB); unsigned char* H8 = A.ws + WS_H8;
    const float* MOD = (const float*)(A.ws + WS_MOD);
    unsigned* cnt = (unsigned*)(A.ws + WS_CTL) + CW_CNT + l * 32 * CNT_STRIDE;
    int* TS = (int*)(A.ws + WS_TOKSLOT); float* TW = (float*)(A.ws + WS_TOKW); int* ST = (int*)(A.ws + WS_SLOTTOK);
    const int rpw = (((nrows + C.G - 1) / C.G) + 1) & ~1; const int wrow0 = C.bid * rpw; const int wend0 = min(wrow0 + rpw, nrows);
    const float* bg = A.in[16] + l * NGRP; const float* br = A.in[18] + l * NE;
    for (int cb = wrow0; cb < wend0; cb += RCAP) {
        const int wend = min(cb + RCAP, wend0);
        if (C.tid < 32) hist[C.tid] = 0u;
        for (int sa = cb; sa < wend;) {
            const int mvi = mod_vec_of_row(sa); const int bnd = mvi == 0 ? SEQ : (mvi == 1 ? NL : NR); const int sbnd = min(wend, bnd);
            RowVec RV; { const float* mv = MOD + (size_t)(l * 3 + mvi) * 6 * D; load_rowvec(RV, A.in[6] + (size_t)(l * 2 + 1) * D, mv + 3 * D, mv + 4 * D, mv + 2 * D, C.lane); }
            const int rlast = sbnd - 2;
            u32x2 la[4], lb[4], ya[4], yb[4];
            { const int r0 = min(sa + 2 * C.wave, rlast); load_row_bf16raw(LAT + (size_t)r0 * D, C.lane, la); load_row_bf16raw(LAT + (size_t)(r0 + 1) * D, C.lane, lb);
              load_row_bf16raw(H + (size_t)r0 * D, C.lane, ya); load_row_bf16raw(H + (size_t)(r0 + 1) * D, C.lane, yb); }
            for (int ra = sa + 2 * C.wave; ra < sbnd; ra += 2 * NW) {
                const int rb = ra + 1;
                u32x2 lan[4], lbn[4], yan[4], ybn[4];
                { const int r1 = min(ra + 2 * NW, rlast); load_row_bf16raw(LAT + (size_t)r1 * D, C.lane, lan); load_row_bf16raw(LAT + (size_t)(r1 + 1) * D, C.lane, lbn);
                  load_row_bf16raw(H + (size_t)r1 * D, C.lane, yan); load_row_bf16raw(H + (size_t)(r1 + 1) * D, C.lane, ybn); }
                f32x4 va[4], vb[4];
#pragma unroll
                for (int q = 0; q < 4; ++q) { va[q] = bf4(la[q]) + RV.g[q] * bf4(ya[q]); vb[q] = bf4(lb[q]) + RV.g[q] * bf4(yb[q]); }
                store_row_bf16(LAT + (size_t)ra * D, C.lane, va); store_row_bf16(LAT + (size_t)rb * D, C.lane, vb);
                const float rra = row_rstd(va), rrb = row_rstd(vb);
                f32x4 ha[4], hb[4];
#pragma unroll
                for (int q = 0; q < 4; ++q) { ha[q] = (va[q] * rra) * RV.a[q] + RV.s[q]; hb[q] = (vb[q] * rrb) * RV.a[q] + RV.s[q]; }
                store_row_bf16(H + (size_t)ra * D, C.lane, ha); store_row_bf16(H + (size_t)rb * D, C.lane, hb);
                store_row_fp8(H8 + (size_t)ra * D, C.lane, ha); store_row_fp8(H8 + (size_t)rb * D, C.lane, hb);
#pragma unroll
                for (int q = 0; q < 4; ++q) { la[q] = lan[q]; lb[q] = lbn[q]; ya[q] = yan[q]; yb[q] = ybn[q]; }
            }
            sa = sbnd;
        }
        __syncthreads();
        const int fr = C.lane & 15, fq = C.lane >> 4;
        for (int t = C.wave; t * 16 < wend - cb; t += NW) {
            const int trow = min(cb + 16 * t + fr, wend - 1);
            const bf16* hp = H + (size_t)trow * D + 8 * fq;
            f32x4 acc[3];
#pragma unroll
            for (int ct = 0; ct < 3; ++ct) acc[ct] = (f32x4){0.f, 0.f, 0.f, 0.f};
#pragma unroll 1
            for (int kb = 0; kb < 4; ++kb) {
                bf16x8 av[8];
#pragma unroll
                for (int k8 = 0; k8 < 8; ++k8) av[k8] = *(const bf16x8*)(hp + 32 * (8 * kb + k8));
#pragma unroll
                for (int k8 = 0; k8 < 8; ++k8)
#pragma unroll
                    for (int ct = 0; ct < 3; ++ct) { const bf16x8 bv = *(const LAS bf16x8*)(RWB + (ct * 16 + fr) * WP + (32 * (8 * kb + k8) + 8 * fq) * 2);
                        acc[ct] = __builtin_amdgcn_mfma_f32_16x16x32_bf16(av[k8], bv, acc[ct], 0, 0, 0); }
            }
            LAS float* wl = WL + C.wave * 16 * 48;
#pragma unroll
            for (int ct = 0; ct < 3; ++ct)
#pragma unroll
                for (int jq = 0; jq < 4; ++jq) wl[(4 * fq + jq) * 48 + ct * 16 + fr] = acc[ct][jq];
            asm volatile("s_waitcnt lgkmcnt(0)" ::: "memory");
            const int row = cb + 16 * t + C.lane;
            if (C.lane < 16 && row < wend) {
                LAS const float* wm = wl + C.lane * 48;
                float lg[36];
#pragma unroll
                for (int c = 0; c < 36; ++c) lg[c] = wm[c];
                float gl[4]; int grp = 0; float gm = -3.0e38f;
#pragma unroll
                for (int c = 0; c < 4; ++c) { gl[c] = lg[c] + bg[c]; if (gl[c] > gm) { gm = gl[c]; grp = c; } }
                float gs = 0.f;
#pragma unroll
                for (int c = 0; c < 4; ++c) gs += __expf(gl[c] - gm);
                const float pgrp = 1.0f / gs;
                float rl[8];
#pragma unroll
                for (int i = 0; i < 8; ++i) { float tt = 0.f;
#pragma unroll
                    for (int g = 0; g < 4; ++g) tt = (g == grp) ? lg[4 + g * 8 + i] : tt;
                    rl[i] = tt + br[grp * 8 + i]; }
                int i0 = 0; float m0 = rl[0];
#pragma unroll
                for (int i = 1; i < 8; ++i) if (rl[i] > m0) { m0 = rl[i]; i0 = i; }
                int i1 = -1; float m1 = -3.0e38f;
#pragma unroll
                for (int i = 0; i < 8; ++i) if (i != i0 && rl[i] > m1) { m1 = rl[i]; i1 = i; }
                const float p0 = 1.0f, p1 = __expf(m1 - m0);
                const float w0 = pgrp * p0 / (p0 + p1), w1 = pgrp * p1 / (p0 + p1);
                const int e0 = grp * 8 + i0, e1 = grp * 8 + i1;
                const unsigned q0 = __hip_atomic_fetch_add(hist + e0, 1u, __ATOMIC_RELAXED, __HIP_MEMORY_SCOPE_WORKGROUP), q1 = __hip_atomic_fetch_add(hist + e1, 1u, __ATOMIC_RELAXED, __HIP_MEMORY_SCOPE_WORKGROUP);
                const int li = row - cb;
                rec[li * 4 + 0] = e0 | (e1 << 8); rec[li * 4 + 1] = (int)q0; rec[li * 4 + 2] = (int)q1;
                TW[row * 2 + 0] = w0; TW[row * 2 + 1] = w1;
            }
        }
        __syncthreads();
        if (C.tid < 32) gbase[C.tid] = hist[C.tid] ? atomicAdd(cnt + C.tid * CNT_STRIDE, hist[C.tid]) : 0u;
        __syncthreads();
        for (int i = C.tid; i < wend - cb; i += NT) { const int row = cb + i; const int ee = rec[i * 4], e0 = ee & 255, e1 = ee >> 8;
            const unsigned q0 = gbase[e0] + (unsigned)rec[i * 4 + 1], q1 = gbase[e1] + (unsigned)rec[i * 4 + 2];
            ST[(size_t)e0 * CAP + q0] = row; ST[(size_t)e1 * CAP + q1] = row;
            TS[row * 2 + 0] = (e0 << 20) | (int)q0; TS[row * 2 + 1] = (e1 << 20) | (int)q1; }
        __syncthreads();
    }
}

__device__ __forceinline__ void phase_final(const Args& A, const Ctx& C) {
    LAS int* sb = (LAS int*)C.lds;
    slot_bases(A, 3, sb, C.tid);
    const bf16* LAT = (const bf16*)(A.ws + WS_LAT);
    for (int row = C.bid * NW + C.wave; row < NL; row += C.G * NW) {
        f32x4 v[4], g[4];
        load_row_bf16(LAT + (size_t)row * D, C.lane, v); moe_combine(A, 3, row, C.lane, sb, v);
        float s = 0.f;
#pragma unroll
        for (int j = 0; j < 4; ++j) s += (v[j].x * v[j].x + v[j].y * v[j].y) + (v[j].z * v[j].z + v[j].w * v[j].w);
        const float r = 1.0f / sqrtf(wave_sum(s) * (1.f / D) + EPS);
        load_row_f32(A.in[7], C.lane, g);
#pragma unroll
        for (int j = 0; j < 4; ++j) *(f32x4*)(A.out + (size_t)row * D + 4 * C.lane + 256 * j) = (v[j] * r) * g[j];
    }
}

__device__ __forceinline__ void phase_conv(const Args& A, const Ctx& C, int l) {
    const int j = l >> 1; const int nrows = (l <= 1) ? NR : NL;
    const bf16* P = (const bf16*)(A.ws + WS_PB); bf16* HM = (bf16*)(A.ws + WS_HM);
    const float* cw = A.in[13] + (size_t)j * 3 * D;
    for (int row = C.bid * NW + C.wave; row < nrows; row += C.G * NW) {
        bool hasl, hasr;
        if (row < NL) { const int t = row & 63; hasl = t != 0; hasr = t != 63; } else { const int t = (row - NL) & 255; hasl = t != 0; hasr = t != 255; }
        f32x4 bg[4], z[4], w0[4], w1[4], w2[4], acc[4];
        const bf16* pr = P + (size_t)row * PW;
        load_row_bf16(pr, C.lane, bg); load_row_bf16(pr + D, C.lane, z);
        load_row_f32(cw, C.lane, w0); load_row_f32(cw + D, C.lane, w1); load_row_f32(cw + 2 * D, C.lane, w2);
#pragma unroll
        for (int q = 0; q < 4; ++q) acc[q] = w1[q] * z[q];
        if (hasl) { load_row_bf16(pr - PW + D, C.lane, z);
#pragma unroll
            for (int q = 0; q < 4; ++q) acc[q] += w0[q] * z[q]; }
        if (hasr) { load_row_bf16(pr + PW + D, C.lane, z);
#pragma unroll
            for (int q = 0; q < 4; ++q) acc[q] += w2[q] * z[q]; }
#pragma unroll
        for (int q = 0; q < 4; ++q) acc[q] *= bg[q];
        store_row_bf16(HM + (size_t)row * D, C.lane, acc);
    }
}

constexpr int BM = 256, BK = 64, HALF = 128, HTB = HALF * BK * 2, STAGE_BYTES = 8 * HTB, NXCD = 8, WGM = 8;
constexpr int LDS_TAB = STAGE_BYTES;
__device__ __forceinline__ int lds_byte(int r, int c) { const int st = (r >> 4) * 2 + (c >> 5), rr = r & 15, cc = c & 31, ob = rr * 64 + cc * 2; return st * 1024 + (ob ^ (((ob >> 9) & 1) << 5)); }
__device__ __forceinline__ void stage_rc(int b, int& R, int& C) { const int st = b / 1024, sb = b % 1024, swz = sb ^ (((sb >> 9) & 1) << 5); R = (st >> 1) * 16 + swz / 64; C = (st & 1) * 32 + (swz % 64) / 2; }
__device__ __forceinline__ int perm32(int rho) { const int n = rho >> 4, i = rho & 15; return 8 * (i >> 2) + 4 * n + (i & 3); }
__device__ __forceinline__ unsigned cvt_pk_bf16(float lo, float hi) { unsigned r; asm volatile("v_cvt_pk_bf16_f32 %0, %1, %2" : "=v"(r) : "v"(lo), "v"(hi)); return r; }

struct GUnit { const char* a; const char* b; int orow, ocol, aux; };

typedef int i32x8 __attribute__((ext_vector_type(8)));
typedef int i32x4 __attribute__((ext_vector_type(4)));
template <class Epi, class Sched, bool GATHER, bool FP8 = false>
__device__ __forceinline__ void gemm_phase(LAS unsigned char* lds, const int K, const Sched& S, const Epi& E) {
    const int tid = threadIdx.x, wid = __builtin_amdgcn_readfirstlane(tid >> 6), lane = tid & 63, wr = wid >> 2, wc = wid & 3, fr = lane & 15, fq = lane >> 4;
    const int RB = FP8 ? K : 2 * K;
    const int nt = RB / (BK * 2);
    unsigned voffB[2], voA[2][2]; int Rr[2], Cc[2];
#pragma unroll
    for (int i = 0; i < 2; ++i) { int R, C; stage_rc(tid * 16 + i * 8192, R, C); const int Rb = (R & ~31) + perm32(R & 31); Rr[i] = R; Cc[i] = C;
        voffB[i] = (unsigned)(Rb * RB + C * 2);
        voA[0][i] = (unsigned)(R * RB + C * 2); voA[1][i] = (unsigned)((R + HALF) * RB + C * 2); }
    const size_t kstep = (size_t)(BK * 2);
    const size_t hstep = (size_t)HALF * RB;
    const unsigned ldsw = (unsigned)wid * 1024u;
    const unsigned ldsbase = (unsigned)(size_t)lds;
    const int aoff = lds_byte(wr * 64 + fr, fq * 8), boff = lds_byte(wc * 32 + fr, fq * 8);
#define PG8_SA(b, h) (((b) * 2 + (h)) * HTB)
#define PG8_SB(b, h) ((4 + (b) * 2 + (h)) * HTB)
#define PG8_STAGE(bufoff, gbase, voff) do { _Pragma("unroll") for (int _i = 0; _i < 2; ++_i) \
        asm volatile("s_mov_b32 m0, %2\n\ts_nop 0\n\tglobal_load_lds_dwordx4 %0, %1" :: "v"((voff)[_i]), "s"((const char*)(gbase)), "s"(ldsbase + (unsigned)(bufoff) + ldsw + (unsigned)(_i * 8192)) : "memory"); } while (0)
#define PG8_STAGE_A1(bufoff, gbase) do { if constexpr (GATHER) PG8_STAGE(bufoff, gbase, voA[1]); else PG8_STAGE(bufoff, (const char*)(gbase) + hstep, voA[0]); } while (0)
#define PG8_LDA(dst, b, h) do { if constexpr (FP8) { _Pragma("unroll") for (int m = 0; m < 4; ++m) { \
        const i32x4 _lo = *(const LAS i32x4*)(lds + PG8_SA(b, h) + aoff + m * 2048), _hi = *(const LAS i32x4*)(lds + PG8_SA(b, h) + aoff + m * 2048 + 1024); \
        dst##8[m] = __builtin_shufflevector(_lo, _hi, 0, 1, 2, 3, 4, 5, 6, 7); } } \
      else { _Pragma("unroll") for (int m = 0; m < 4; ++m) _Pragma("unroll") for (int k = 0; k < 2; ++k) dst[m][k] = *(const LAS bf16x8*)(lds + PG8_SA(b, h) + aoff + m * 2048 + k * 1024); } } while (0)
#define PG8_LDB(dst, b, h) do { if constexpr (FP8) { _Pragma("unroll") for (int n = 0; n < 2; ++n) { \
        const i32x4 _lo = *(const LAS i32x4*)(lds + PG8_SB(b, h) + boff + n * 2048), _hi = *(const LAS i32x4*)(lds + PG8_SB(b, h) + boff + n * 2048 + 1024); \
        dst##8[n] = __builtin_shufflevector(_lo, _hi, 0, 1, 2, 3, 4, 5, 6, 7); } } \
      else { _Pragma("unroll") for (int n = 0; n < 2; ++n) _Pragma("unroll") for (int k = 0; k < 2; ++k) dst[n][k] = *(const LAS bf16x8*)(lds + PG8_SB(b, h) + boff + n * 2048 + k * 1024); } } while (0)
#define PG8_MMA(ai, bj, At, Bt) do { __builtin_amdgcn_s_setprio(1); \
        if constexpr (FP8) { _Pragma("unroll") for (int m = 0; m < 4; ++m) _Pragma("unroll") for (int n = 0; n < 2; ++n) \
            acc[ai][bj][m][n] = __builtin_amdgcn_mfma_scale_f32_16x16x128_f8f6f4(Bt##8[n], At##8[m], acc[ai][bj][m][n], 0, 0, 0, 0x7f7f7f7f, 0, 0x7f7f7f7f); } \
        else { _Pragma("unroll") for (int m = 0; m < 4; ++m) _Pragma("unroll") for (int n = 0; n < 2; ++n) _Pragma("unroll") for (int k = 0; k < 2; ++k) \
            acc[ai][bj][m][n] = __builtin_amdgcn_mfma_f32_16x16x32_bf16(Bt[n][k], At[m][k], acc[ai][bj][m][n], 0, 0, 0); } \
        __builtin_amdgcn_s_setprio(0); } while (0)
#define PG8_WAIT_V(n) asm volatile("s_waitcnt vmcnt(" #n ")" ::: "memory")
#define PG8_WAIT_L(n) asm volatile("s_waitcnt lgkmcnt(" #n ")" ::: "memory")
#define PG8_BAR __builtin_amdgcn_s_barrier()
#define PG8_SCHED __builtin_amdgcn_sched_barrier(0)
    GUnit cur, nxt; int ui = 0;
    if (!S.next(0, cur)) return;
    if constexpr (GATHER) {
#pragma unroll
        for (int h = 0; h < 2; ++h)
#pragma unroll
            for (int i = 0; i < 2; ++i) voA[h][i] = S.arow_off(0, h * HALF + Rr[i]) + (unsigned)Cc[i] * 2u;
    }
    f32x4 acc[2][2][4][2];
#pragma unroll
    for (int a = 0; a < 2; ++a)
#pragma unroll
        for (int b = 0; b < 2; ++b)
#pragma unroll
            for (int m = 0; m < 4; ++m)
#pragma unroll
                for (int n = 0; n < 2; ++n) acc[a][b][m][n] = (f32x4){0.f, 0.f, 0.f, 0.f};
    bf16x8 At[4][2], B0[2][2], B1[2][2]; i32x8 At8[4], B08[2], B18[2];
    const char* cA = cur.a; const char* cB = cur.b;
    PG8_STAGE(PG8_SB(0, 0), cB, voffB); PG8_STAGE(PG8_SB(0, 1), cB + hstep, voffB); PG8_STAGE(PG8_SA(0, 0), cA, voA[0]); PG8_STAGE_A1(PG8_SA(0, 1), cA);
    if (wr == 1) PG8_BAR;
    PG8_WAIT_V(2); PG8_BAR;
    PG8_STAGE(PG8_SB(1, 0), cB + kstep, voffB); PG8_STAGE(PG8_SA(1, 0), cA + kstep, voA[0]); PG8_STAGE(PG8_SB(1, 1), cB + hstep + kstep, voffB);
    PG8_WAIT_V(6); PG8_BAR;
    for (;;) {
        const bool has_next = S.next(ui + 1, nxt);
        const char* nA = has_next ? nxt.a : cA; const char* nB = has_next ? nxt.b : cB;
#pragma unroll 1
        for (int t = 0; t < nt; t += 2) {
            const bool last = (t == nt - 2);
            const char* a1 = cA + (size_t)(t + 1) * kstep;
            const char* a2 = last ? nA : cA + (size_t)(t + 2) * kstep; const char* b2 = last ? nB : cB + (size_t)(t + 2) * kstep;
            const char* a3 = a2 + kstep; const char* b3 = b2 + kstep;
            PG8_LDB(B0, 0, 0); PG8_LDB(B1, 0, 1); PG8_SCHED; PG8_LDA(At, 0, 0); PG8_STAGE_A1(PG8_SA(1, 1), a1);
            if constexpr (GATHER) { if (last && has_next) {
#pragma unroll
                for (int h = 0; h < 2; ++h)
#pragma unroll
                    for (int i = 0; i < 2; ++i) { int R2, C2; stage_rc(tid * 16 + i * 8192, R2, C2); voA[h][i] = S.arow_off(ui + 1, h * HALF + R2) + (unsigned)C2 * 2u; } } }
            PG8_WAIT_V(8); PG8_WAIT_L(0); PG8_BAR; PG8_MMA(0, 0, At, B0); PG8_MMA(0, 1, At, B1); PG8_BAR; PG8_SCHED;
            PG8_LDA(At, 0, 1); PG8_STAGE(PG8_SB(0, 0), b2, voffB); PG8_STAGE(PG8_SB(0, 1), b2 + hstep, voffB); PG8_STAGE(PG8_SA(0, 0), a2, voA[0]);
            PG8_WAIT_V(8); PG8_WAIT_L(0); PG8_BAR; PG8_MMA(1, 0, At, B0); PG8_MMA(1, 1, At, B1); PG8_BAR; PG8_SCHED;
            PG8_LDB(B0, 1, 0); PG8_LDB(B1, 1, 1); PG8_SCHED; PG8_LDA(At, 1, 0); PG8_STAGE_A1(PG8_SA(0, 1), a2);
            PG8_WAIT_V(8); PG8_WAIT_L(0); PG8_BAR; PG8_MMA(0, 0, At, B0); PG8_MMA(0, 1, At, B1); PG8_BAR; PG8_SCHED;
            PG8_LDA(At, 1, 1); PG8_STAGE(PG8_SB(1, 0), b3, voffB); PG8_STAGE(PG8_SB(1, 1), b3 + hstep, voffB); PG8_STAGE(PG8_SA(1, 0), a3, voA[0]);
            PG8_WAIT_V(8); PG8_WAIT_L(0); PG8_BAR; PG8_MMA(1, 0, At, B0); PG8_MMA(1, 1, At, B1); PG8_BAR; PG8_SCHED;
        }
        if (wr == 0) PG8_BAR;
        { int tz = threadIdx.x; asm volatile("" : "+v"(tz));
          const int wz = tz >> 6, lz = tz & 63; E(acc, cur, wz >> 2, wz & 3, lz & 15, lz >> 4); }
        if (!has_next) break;
#pragma unroll
        for (int a = 0; a < 2; ++a)
#pragma unroll
            for (int b = 0; b < 2; ++b)
#pragma unroll
                for (int m = 0; m < 4; ++m)
#pragma unroll
                    for (int n = 0; n < 2; ++n) acc[a][b][m][n] = (f32x4){0.f, 0.f, 0.f, 0.f};
        cur = nxt; cA = nA; cB = nB; ++ui;
        if (wr == 1) PG8_BAR;
    }
    PG8_WAIT_V(0);
    PG8_BAR;
#undef PG8_SA
#undef PG8_SB
#undef PG8_STAGE
#undef PG8_STAGE_A1
#undef PG8_LDA
#undef PG8_LDB
#undef PG8_MMA
#undef PG8_WAIT_V
#undef PG8_WAIT_L
#undef PG8_BAR
#undef PG8_SCHED
}

__device__ __forceinline__ int xcd_remap(int L, int nwg) { const int q = nwg / NXCD, r = nwg % NXCD, xcd = L % NXCD, off = L / NXCD; return (xcd < r ? xcd * (q + 1) : r * (q + 1) + (xcd - r) * q) + off; }

struct DenseSched {
    const char* A; const char* Bt; int nM, nN, nwg, G, c; size_t tstep; int sw_lo, sw_hi;
    __device__ __forceinline__ void init(const void* A_, const void* Bt_, int M, int N, int K, int G_, int c_) { A = (const char*)A_; Bt = (const char*)Bt_; nM = M / BM; nN = N / BM; nwg = nM * nN; G = G_; c = c_; tstep = (size_t)BM * K * 2; sw_lo = 0; sw_hi = 0; }
    __device__ __forceinline__ bool next(int i, GUnit& u) const {
        const long L = (long)i * G + c; if (L >= nwg) return false;
        const int wgid = xcd_remap((int)L, nwg);
        const int nig = WGM * nN, gid = wgid / nig, fm = gid * WGM, gsz = (nM - fm) < WGM ? (nM - fm) : WGM;
        const int pm = fm + ((wgid % nig) % gsz), pn = (wgid % nig) / gsz;
        if (pn >= sw_lo && pn < sw_hi) { u.a = Bt + (size_t)pn * tstep; u.b = A + (size_t)pm * tstep; u.orow = pm; u.ocol = pn - sw_lo; u.aux = 1; }
        else { u.a = A + (size_t)pm * tstep; u.b = Bt + (size_t)pn * tstep; u.orow = pm * BM; u.ocol = pn * BM; u.aux = 0; }
        return true;
    }
    __device__ __forceinline__ unsigned arow_off(int, int) const { return 0u; }
};

constexpr int MAXU = 12;
struct MoeTab { int n; int e[MAXU], mb[MAXU], nt[MAXU]; int sb[NE + 1]; };
struct MoeSched {
    LAS const MoeTab* T; LAS const unsigned* ridx;
    const char* A; const char* W; size_t wstride_e, tstepB; int K; int arow_bytes;
    __device__ __forceinline__ bool next(int i, GUnit& u) const {
        const int n = __builtin_amdgcn_readfirstlane(T->n); if (i >= n) return false;
        const int e = __builtin_amdgcn_readfirstlane(T->e[i]), mb = __builtin_amdgcn_readfirstlane(T->mb[i]), nt = __builtin_amdgcn_readfirstlane(T->nt[i]);
        const int base = __builtin_amdgcn_readfirstlane(T->sb[e]);
        u.orow = base + mb * BM; u.ocol = nt; u.aux = e;
        u.a = A + (size_t)u.orow * arow_bytes;
        u.b = W + (size_t)e * wstride_e + (size_t)nt * tstepB; return true;
    }
    __device__ __forceinline__ unsigned arow_off(int i, int r) const { return ridx[i * 256 + r]; }
};
template <bool GATHER>
__device__ __forceinline__ void moe_tables(const Args& A, const Ctx& C, int l, int ntile_n, LAS MoeTab* T, LAS unsigned* ridx, int arow_bytes) {
    const unsigned* cnt = (const unsigned*)(A.ws + WS_CTL) + CW_CNT + l * 32 * CNT_STRIDE;
    LAS int* ust = (LAS int*)(T + 1);
    if (C.tid == 0) { int acc = 0, ua = 0; for (int e = 0; e < NE; ++e) { T->sb[e] = acc; ust[e] = ua; const int nb = ((int)cnt[e * CNT_STRIDE] + 255) / 256; acc += nb * 256; ua += nb * ntile_n; } T->sb[NE] = acc; ust[NE] = ua;
        const int nwg = ua; int n = 0;
        for (int i = 0; i < MAXU; ++i) { const long L = (long)i * C.G + C.bid; if (L >= nwg) break; const int w = xcd_remap((int)L, nwg); int e = 0; while (w >= ust[e + 1]) ++e;
            const int lu = w - ust[e]; T->e[i] = e; T->mb[i] = lu / ntile_n; T->nt[i] = lu % ntile_n; ++n; }
        T->n = n; }
    __syncthreads();
    if constexpr (GATHER) {
        const int* ST = (const int*)(A.ws + WS_SLOTTOK); const int n = T->n;
        for (int i = C.tid; i < n * 256; i += NT) { const int ui = i >> 8, r = i & 255, e = T->e[ui], m0 = T->mb[ui] * 256, ce = (int)cnt[e * CNT_STRIDE];
            const int rr = (m0 + r < ce) ? m0 + r : ce - 1;
            ridx[i] = (unsigned)ST[(size_t)e * CAP + rr] * (unsigned)arow_bytes; }
        __syncthreads();
    }
}

struct EpiStore { bf16* O; int ldc; float scale_lo; int sig_from; bf16* VT;
    __device__ __forceinline__ void operator()(const f32x4 (&acc)[2][2][4][2], const GUnit& u, int wr, int wc, int fr, int fq) const {
        const bool tr = u.aux != 0;
        const float sc = (!tr && u.ocol < NQ) ? scale_lo : 1.0f; const bool sg = !tr && u.ocol >= sig_from;
        bf16* Ob = tr ? VT + (size_t)(u.orow * NH + u.ocol) * 65536 : O + (size_t)u.orow * ldc + u.ocol; const int ld = tr ? 256 : ldc;
#pragma unroll
        for (int ai = 0; ai < 2; ++ai)
#pragma unroll
            for (int m = 0; m < 4; ++m) { bf16* rowp = Ob + (size_t)(ai * HALF + wr * 64 + m * 16 + fr) * ld + wc * 32 + 8 * fq;
#pragma unroll
                for (int bj = 0; bj < 2; ++bj) { f32x4 v0 = acc[ai][bj][m][0] * sc, v1 = acc[ai][bj][m][1] * sc;
                    if (sg) {
#pragma unroll
                        for (int q = 0; q < 4; ++q) { v0[q] = __builtin_amdgcn_rcpf(1.0f + __expf(-v0[q])); v1[q] = __builtin_amdgcn_rcpf(1.0f + __expf(-v1[q])); } }
                    u32x4 w; w.x = cvt_pk_bf16(v0[0], v0[1]); w.y = cvt_pk_bf16(v0[2], v0[3]); w.z = cvt_pk_bf16(v1[0], v1[1]); w.w = cvt_pk_bf16(v1[2], v1[3]);
                    *(u32x4*)(rowp + bj * HALF) = w; } }
    }
};
__device__ __forceinline__ u32x2 cvt8_fp8(f32x4 a, f32x4 b) { int lo = 0, hi = 0;
    lo = __builtin_amdgcn_cvt_pk_fp8_f32(a[0], a[1], lo, false); lo = __builtin_amdgcn_cvt_pk_fp8_f32(a[2], a[3], lo, true);
    hi = __builtin_amdgcn_cvt_pk_fp8_f32(b[0], b[1], hi, false); hi = __builtin_amdgcn_cvt_pk_fp8_f32(b[2], b[3], hi, true); return (u32x2){(unsigned)lo, (unsigned)hi}; }
struct EpiSwigluF8 { unsigned char* O; int ldc; float s;
    __device__ __forceinline__ void operator()(const f32x4 (&acc)[2][2][4][2], const GUnit& u, int wr, int wc, int fr, int fq) const {
        const int ocol = u.ocol * HALF;
#pragma unroll
        for (int ai = 0; ai < 2; ++ai)
#pragma unroll
            for (int m = 0; m < 4; ++m) { unsigned char* rowp = O + (size_t)(u.orow + ai * HALF + wr * 64 + m * 16 + fr) * ldc + ocol + wc * 32 + 8 * fq;
                f32x4 v0, v1;
#pragma unroll
                for (int q = 0; q < 4; ++q) { const float x0 = acc[ai][0][m][0][q] * s, x1 = acc[ai][0][m][1][q] * s;
                    v0[q] = x0 * __builtin_amdgcn_rcpf(1.0f + __expf(-x0)) * (acc[ai][1][m][0][q] * s); v1[q] = x1 * __builtin_amdgcn_rcpf(1.0f + __expf(-x1)) * (acc[ai][1][m][1][q] * s); }
                *(u32x2*)rowp = cvt8_fp8(v0, v1); }
    }
};
template <int MODE> struct EpiPair { bf16* O; int ldc; int plain_below;
    __device__ __forceinline__ void operator()(const f32x4 (&acc)[2][2][4][2], const GUnit& u, int wr, int wc, int fr, int fq) const {
        if (MODE == 0 && u.ocol < plain_below) {
#pragma unroll
            for (int ai = 0; ai < 2; ++ai)
#pragma unroll
                for (int m = 0; m < 4; ++m) { bf16* rowp = O + (size_t)(u.orow + ai * HALF + wr * 64 + m * 16 + fr) * ldc + u.ocol + wc * 32 + 8 * fq;
#pragma unroll
                    for (int bj = 0; bj < 2; ++bj) { const f32x4 v0 = acc[ai][bj][m][0], v1 = acc[ai][bj][m][1];
                        u32x4 w; w.x = cvt_pk_bf16(v0[0], v0[1]); w.y = cvt_pk_bf16(v0[2], v0[3]); w.z = cvt_pk_bf16(v1[0], v1[1]); w.w = cvt_pk_bf16(v1[2], v1[3]);
                        *(u32x4*)(rowp + bj * HALF) = w; } }
            return;
        }
        const int ocol = (MODE == 0) ? plain_below + (u.ocol - plain_below) / 2 : u.ocol * HALF;
#pragma unroll
        for (int ai = 0; ai < 2; ++ai)
#pragma unroll
            for (int m = 0; m < 4; ++m) { bf16* rowp = O + (size_t)(u.orow + ai * HALF + wr * 64 + m * 16 + fr) * ldc + ocol + wc * 32 + 8 * fq;
                f32x4 v0, v1;
#pragma unroll
                for (int q = 0; q < 4; ++q) {
                    const float x0 = acc[ai][0][m][0][q], x1 = acc[ai][0][m][1][q];
                    const float g0 = (MODE == 1) ? x0 * __builtin_amdgcn_rcpf(1.0f + __expf(-x0)) : x0, g1 = (MODE == 1) ? x1 * __builtin_amdgcn_rcpf(1.0f + __expf(-x1)) : x1;
                    v0[q] = g0 * acc[ai][1][m][0][q]; v1[q] = g1 * acc[ai][1][m][1][q]; }
                u32x4 w; w.x = cvt_pk_bf16(v0[0], v0[1]); w.y = cvt_pk_bf16(v0[2], v0[3]); w.z = cvt_pk_bf16(v1[0], v1[1]); w.w = cvt_pk_bf16(v1[2], v1[3]);
                *(u32x4*)rowp = w; }
    }
};
struct EpiStoreTile { bf16* O; int ldc; float s;
    __device__ __forceinline__ void operator()(const f32x4 (&acc)[2][2][4][2], const GUnit& u, int wr, int wc, int fr, int fq) const {
#pragma unroll
        for (int ai = 0; ai < 2; ++ai)
#pragma unroll
            for (int m = 0; m < 4; ++m) { bf16* rowp = O + (size_t)(u.orow + ai * HALF + wr * 64 + m * 16 + fr) * ldc + u.ocol * BM + wc * 32 + 8 * fq;
#pragma unroll
                for (int bj = 0; bj < 2; ++bj) { const f32x4 v0 = acc[ai][bj][m][0] * s, v1 = acc[ai][bj][m][1] * s;
                    u32x4 w; w.x = cvt_pk_bf16(v0[0], v0[1]); w.y = cvt_pk_bf16(v0[2], v0[3]); w.z = cvt_pk_bf16(v1[0], v1[1]); w.w = cvt_pk_bf16(v1[2], v1[3]);
                    *(u32x4*)(rowp + bj * HALF) = w; } }
    }
};

__device__ __forceinline__ void transpose_item(const float* W, int ldw, int K, bf16* WT, int drow0, int k0, int n0, LAS float* scr, int lane) {
#pragma unroll
    for (int i = 0; i < 32; ++i) { const int kk = 2 * i + (lane >> 5); scr[kk * 33 + (lane & 31)] = W[(size_t)(k0 + kk) * ldw + n0 + (lane & 31)]; }
    asm volatile("s_waitcnt lgkmcnt(0)" ::: "memory");
    const int c = lane & 7;
#pragma unroll
    for (int j = 0; j < 4; ++j) { const int n = (lane >> 3) + 8 * j; const LAS float* s = scr + (8 * c) * 33 + n;
        u32x4 o; o.x = pk2(s[0 * 33], s[1 * 33]); o.y = pk2(s[2 * 33], s[3 * 33]); o.z = pk2(s[4 * 33], s[5 * 33]); o.w = pk2(s[6 * 33], s[7 * 33]);
        *(u32x4*)(WT + (size_t)(drow0 + n) * K + k0 + 8 * c) = o; }
    asm volatile("s_waitcnt lgkmcnt(0)" ::: "memory");
}
__device__ __forceinline__ void transpose_item_fp8(const float* W, int ldw, int K, unsigned char* WT8, int drow0, int k0, int n0, LAS float* scr, int lane, float sc) {
#pragma unroll
    for (int i = 0; i < 32; ++i) { const int kk = 2 * i + (lane >> 5); scr[kk * 33 + (lane & 31)] = W[(size_t)(k0 + kk) * ldw + n0 + (lane & 31)]; }
    asm volatile("s_waitcnt lgkmcnt(0)" ::: "memory");
    const int n = lane >> 1, half = lane & 1; const LAS float* sp = scr + (32 * half) * 33 + n;
    unsigned char* dst = WT8 + (size_t)(drow0 + n) * K + k0 + 32 * half;
#pragma unroll
    for (int c = 0; c < 2; ++c) { u32x4 o;
#pragma unroll
        for (int q = 0; q < 4; ++q) { int p = 0; const LAS float* s4 = sp + (16 * c + 4 * q) * 33;
            p = __builtin_amdgcn_cvt_pk_fp8_f32(s4[0] * sc, s4[33] * sc, p, false); p = __builtin_amdgcn_cvt_pk_fp8_f32(s4[66] * sc, s4[99] * sc, p, true); o[q] = (unsigned)p; }
        *(u32x4*)(dst + 16 * c) = o; }
    asm volatile("s_waitcnt lgkmcnt(0)" ::: "memory");
}
__device__ __forceinline__ int pair_row(int n, int which) { return (n >> 7) * 256 + (n & 127) + which * 128; }
__device__ __forceinline__ void phase_cvt_mixer(const Args& A, const Ctx& C) {
    LAS float* scr = (LAS float*)(C.lds + 16384 + C.wave * 16384);
    const int gw = C.bid * NW + C.wave, NGW = C.G * NW;
    constexpr int I_IN = (D / 64) * (PW / 32), I_OUT = (D / 64) * (D / 32), PER = 2 * (I_IN + I_OUT);
    for (int it = gw; it < 2 * PER; it += NGW) {
        const int kind = it / PER; int r = it % PER; const int j = r / (I_IN + I_OUT); r %= (I_IN + I_OUT);
        if (r < I_IN) { const int kb = r / (PW / 32), nb = r % (PW / 32), n0 = nb * 32;
            bf16* WT = (bf16*)(A.ws + (kind == 0 ? WS_WAIN : WS_WBIN)) + (size_t)j * PW * D;
            if (kind == 0) transpose_item(A.in[8] + (size_t)j * D * PROJ, PROJ, D, WT, n0, kb * 64, n0, scr, C.lane);
            else { const int drow = n0 < D ? n0 : (n0 < 2 * D ? D + pair_row(n0 - D, 0) : D + pair_row(n0 - 2 * D, 1));
                transpose_item(A.in[12] + (size_t)j * D * PW, PW, D, WT, drow, kb * 64, n0, scr, C.lane); } }
        else { r -= I_IN; const int kb = r / (D / 32), nb = r % (D / 32), n0 = nb * 32;
            bf16* WT = (bf16*)(A.ws + (kind == 0 ? WS_WAOUT : WS_WBOUT)) + (size_t)j * D * D;
            transpose_item((kind == 0 ? A.in[11] : A.in[14]) + (size_t)j * D * D, D, D, WT, n0, kb * 64, n0, scr, C.lane); }
    }
}
constexpr float WSCALE = 32.0f;
__device__ __forceinline__ void phase_cvt_moe(const Args& A, const Ctx& C, int l) {
    LAS float* scr = (LAS float*)(C.lds + 16384 + C.wave * 16384);
    const int gw = C.bid * NW + C.wave, NGW = C.G * NW;
    constexpr int I_G = (D / 64) * (DE / 32), I_D = (DE / 64) * (D / 32), PER = 2 * I_G + I_D;
    unsigned char* WGU = A.ws + WS_WGU; unsigned char* WDN = A.ws + WS_WDN;
    for (int it = gw; it < NE * PER; it += NGW) {
        const int e = it / PER; int r = it % PER;
        if (r < 2 * I_G) { const int which = r / I_G; r %= I_G; const int kb = r / (DE / 32), nb = r % (DE / 32), n0 = nb * 32;
            transpose_item_fp8((which == 0 ? A.in[19] : A.in[20]) + ((size_t)l * NE + e) * D * DE, DE, D, WGU + (size_t)e * 2 * DE * D, pair_row(n0, which), kb * 64, n0, scr, C.lane, WSCALE); }
        else { r -= 2 * I_G; const int kb = r / (D / 32), nb = r % (D / 32), n0 = nb * 32;
            transpose_item_fp8(A.in[21] + ((size_t)l * NE + e) * DE * D, D, DE, WDN + (size_t)e * D * DE, n0, kb * 64, n0, scr, C.lane, WSCALE); }
    }
}

__device__ __forceinline__ void phase_g1(const Args& A, const Ctx& C, int l) {
    const bool mls = (l & 1) == 0; const int j = l >> 1; const int nrows = (l <= 2) ? NR : NL;
    DenseSched S; S.init(A.ws + WS_HB, A.ws + (mls ? WS_WAIN : WS_WBIN) + (size_t)j * PW * D * 2, nrows, PW, D, C.G, C.bid);
    if (mls) { S.sw_lo = 4; S.sw_hi = 8; EpiStore E{(bf16*)(A.ws + WS_PB), PW, 0.08838834764831845f, 2 * NQ + NV, (bf16*)(A.ws + WS_VT)}; gemm_phase<EpiStore, DenseSched, false>(C.lds, D, S, E); }
    else { EpiPair<0> E{(bf16*)(A.ws + WS_PB), PW, D}; gemm_phase<EpiPair<0>, DenseSched, false>(C.lds, D, S, E); }
}
__device__ __forceinline__ void phase_g2(const Args& A, const Ctx& C, int l) {
    const bool mls = (l & 1) == 0; const int j = l >> 1; const int nrows = (l <= 1) ? NR : NL;
    DenseSched S; S.init(A.ws + WS_HM, A.ws + (mls ? WS_WAOUT : WS_WBOUT) + (size_t)j * D * D * 2, nrows, D, D, C.G, C.bid);
    EpiStore E{(bf16*)(A.ws + WS_HB), D, 1.0f, 1 << 30, nullptr}; gemm_phase<EpiStore, DenseSched, false>(C.lds, D, S, E);
}
__device__ __forceinline__ void phase_m1(const Args& A, const Ctx& C, int l) {
    LAS MoeTab* T = (LAS MoeTab*)(C.lds + LDS_TAB); LAS unsigned* ridx = (LAS unsigned*)(C.lds + LDS_TAB + 1024);
    moe_tables<true>(A, C, l, 4, T, ridx, D);
    MoeSched S; S.T = T; S.ridx = ridx; S.A = (const char*)(A.ws + WS_H8); S.W = (const char*)(A.ws + WS_WGU); S.wstride_e = (size_t)2 * DE * D; S.tstepB = (size_t)BM * D; S.K = D; S.arow_bytes = 0;
    EpiSwigluF8 E{A.ws + WS_DC, DE, 1.0f / WSCALE}; gemm_phase<EpiSwigluF8, MoeSched, true, true>(C.lds, D, S, E);
}
__device__ __forceinline__ void phase_m2(const Args& A, const Ctx& C, int l) {
    LAS MoeTab* T = (LAS MoeTab*)(C.lds + LDS_TAB); LAS unsigned* ridx = (LAS unsigned*)(C.lds + LDS_TAB + 1024);
    moe_tables<false>(A, C, l, 4, T, ridx, DE);
    MoeSched S; S.T = T; S.ridx = ridx; S.A = (const char*)(A.ws + WS_DC); S.W = (const char*)(A.ws + WS_WDN); S.wstride_e = (size_t)D * DE; S.tstepB = (size_t)BM * DE; S.K = DE; S.arow_bytes = DE;
    EpiStoreTile E{(bf16*)(A.ws + WS_PB), D, 1.0f / WSCALE}; gemm_phase<EpiStoreTile, MoeSched, false, true>(C.lds, DE, S, E);
}

typedef float f32x16 __attribute__((ext_vector_type(16)));
#define MFMA32(a, b, c) __builtin_amdgcn_mfma_f32_32x32x16_bf16((a), (b), (c), 0, 0, 0)
__device__ __forceinline__ bf16x8 pack8(float a0, float a1, float a2, float a3, float a4, float a5, float a6, float a7) {
    u32x4 p; p.x = cvt2(a0, a1); p.y = cvt2(a2, a3); p.z = cvt2(a4, a5); p.w = cvt2(a6, a7); return __builtin_bit_cast(bf16x8, p); }
__device__ __forceinline__ float bflo(unsigned w) { return __uint_as_float(w << 16); }
__device__ __forceinline__ float bfhi(unsigned w) { return __uint_as_float(w & 0xffff0000u); }
__device__ __forceinline__ int vt_tile(int b, int h, int blk) { return (blk == 0 ? 128 + b : b * 64 + blk - 1) * NH + h; }

__device__ __forceinline__ float wave_incl_scan(float v, int lane) {
#pragma unroll
    for (int o = 1; o < 64; o <<= 1) { const float t = __shfl_up(v, o); v += (lane >= o) ? t : 0.f; }
    return v;
}
__device__ __forceinline__ void block_gates(const Args& A, int row0, int h, LAS float* bf, LAS float* bb, LAS float* lif, LAS float* lib, int tid) {
    const float* GATE = (const float*)(A.ws + WS_GATE);
    if (tid < 256) { const float* g = GATE + (size_t)(row0 + tid) * 16; lif[tid] = g[0 + h]; bf[tid] = g[4 + h]; lib[tid] = g[8 + h]; bb[tid] = g[12 + h]; }
    __syncthreads();
    const int lane = tid & 63, wv = tid >> 6;
    if (wv == 0) { f32x4 x = *(LAS f32x4*)(bf + 4 * lane); x.y += x.x; x.z += x.y; x.w += x.z; const float tot = wave_incl_scan(x.w, lane); const float ex = tot - x.w;
        x.x += ex; x.y += ex; x.z += ex; x.w += ex; *(LAS f32x4*)(bf + 4 * lane) = x; }
    if (wv == 1) { f32x4 y = *(LAS f32x4*)(bb + 4 * (63 - lane)); y.z += y.w; y.y += y.z; y.x += y.y; const float tot = wave_incl_scan(y.x, lane); const float ex = tot - y.x;
        y.x += ex; y.y += ex; y.z += ex; y.w += ex; *(LAS f32x4*)(bb + 4 * (63 - lane)) = y; }
    __syncthreads();
}
__device__ __forceinline__ void phase_s1(const Args& A, const Ctx& C, int l) {
    LAS float* bf = (LAS float*)C.lds; LAS float* bb = bf + 256; LAS float* lif = bb + 256; LAS float* lib = lif + 256; LAS float* af = lib + 256; LAS float* ab = af + 256;
    constexpr int KP = 528;
    LAS unsigned char* KTf = C.lds + 8192; LAS unsigned char* KTb = KTf + 128 * KP;
    const bf16* P = (const bf16*)(A.ws + WS_PB); const bf16* VT = (const bf16*)(A.ws + WS_VT);
    float* DC = (float*)(A.ws + WS_DC); float* DN = (float*)(A.ws + WS_DN); float* BT = (float*)(A.ws + WS_BTOT);
    const int r = C.lane & 31, hh = C.lane >> 5, w = C.wave;
    for (int u = C.bid; u < NUNIT; u += C.G) {
        const int blk = u % NBLK, bh = u / NBLK, h = bh % NH, b = bh / NH; const int row0 = blk_row0(b, blk);
        block_gates(A, row0, h, bf, bb, lif, lib, C.tid);
        if (C.tid < 256) { af[C.tid] = __expf(bf[255] - bf[C.tid] + lif[C.tid]); ab[C.tid] = __expf(bb[0] - bb[C.tid] + lib[C.tid]); }
        if (C.tid == 0) { BT[u * 2 + 0] = bf[255]; BT[u * 2 + 1] = bb[0]; }
        __syncthreads();
        { const int sp = C.tid >> 2, dq = C.tid & 3, s0 = 2 * sp;
          const bf16* k0 = P + (size_t)(row0 + s0) * PW + NQ + h * DQK + 32 * dq;
          const float f0 = af[s0], f1 = af[s0 + 1], g0 = ab[s0], g1 = ab[s0 + 1];
#pragma unroll
          for (int c = 0; c < 4; ++c) { const u32x4 x0 = *(const u32x4*)(k0 + 8 * c), x1 = *(const u32x4*)(k0 + PW + 8 * c);
#pragma unroll
              for (int q = 0; q < 4; ++q) { const int d = 32 * dq + 8 * c + 2 * q;
                  const float a0 = bflo(x0[q]), a1 = bfhi(x0[q]), c0 = bflo(x1[q]), c1 = bfhi(x1[q]);
                  *(LAS unsigned*)(KTf + d * KP + s0 * 2) = cvt2(a0 * f0, c0 * f1); *(LAS unsigned*)(KTf + (d + 1) * KP + s0 * 2) = cvt2(a1 * f0, c1 * f1);
                  *(LAS unsigned*)(KTb + d * KP + s0 * 2) = cvt2(a0 * g0, c0 * g1); *(LAS unsigned*)(KTb + (d + 1) * KP + s0 * 2) = cvt2(a1 * g0, c1 * g1); } } }
        __syncthreads();
        if (C.tid < 256) { const int dir = C.tid >> 7, d = C.tid & 127; LAS const unsigned* kr = (LAS const unsigned*)((dir ? KTb : KTf) + d * KP); float s = 0.f;
            for (int i = 0; i < 128; ++i) { const unsigned x = kr[i]; s += bflo(x) + bfhi(x); }
            DN[(size_t)(u * 2 + dir) * DQK + d] = s; }
        const bf16* vt = VT + (size_t)vt_tile(b, h, blk) * 65536 + (size_t)(32 * w + r) * 256 + 8 * hh;
        f32x16 accf[4], accb[4];
#pragma unroll
        for (int dt = 0; dt < 4; ++dt)
#pragma unroll
            for (int i = 0; i < 16; ++i) { accf[dt][i] = 0.f; accb[dt][i] = 0.f; }
#pragma unroll 2
        for (int ks = 0; ks < 16; ++ks) { const bf16x8 a = *(const bf16x8*)(vt + 16 * ks);
#pragma unroll
            for (int dt = 0; dt < 4; ++dt) { const int off = (dt * 32 + r) * KP + (16 * ks + 8 * hh) * 2;
                const bf16x8 b0 = *(const LAS bf16x8*)(KTf + off), b1 = *(const LAS bf16x8*)(KTb + off);
                accf[dt] = MFMA32(a, b0, accf[dt]); accb[dt] = MFMA32(a, b1, accb[dt]); } }
        float* dcf = DC + (size_t)(u * 2 + 0) * DQK * DV + (size_t)(32 * w + 4 * hh) * DQK + r; float* dcb = dcf + DQK * DV;
#pragma unroll
        for (int g = 0; g < 4; ++g) { float* pf = dcf + g * 8 * DQK; float* pb = dcb + g * 8 * DQK; asm volatile("" : "+v"(pf), "+v"(pb));
#pragma unroll
            for (int q = 0; q < 4; ++q)
#pragma unroll
                for (int dt = 0; dt < 4; ++dt) { pf[q * DQK + dt * 32] = accf[dt][4 * g + q]; pb[q * DQK + dt * 32] = accb[dt][4 * g + q]; } }
        __syncthreads();
    }
}
__device__ __forceinline__ void phase_s2(const Args& A, const Ctx& C) {
    const float* __restrict__ DC = (const float*)(A.ws + WS_DC); const float* __restrict__ DN = (const float*)(A.ws + WS_DN); const float* __restrict__ BT = (const float*)(A.ws + WS_BTOT);
    bf16* __restrict__ CST = (bf16*)(A.ws + WS_CST); float* __restrict__ NST = (float*)(A.ws + WS_NST);
    constexpr int EL4 = DQK * DV / 4;
    for (int g = C.bid * NT + C.tid; g < BATCH * NH * 2 * EL4; g += C.G * NT) {
        const int e4 = (g % EL4) * 4, ch = g / EL4, dir = ch & 1, bh = ch >> 1;
        f32x4 st = (f32x4){0.f, 0.f, 0.f, 0.f};
#pragma unroll 5
        for (int idx = 0; idx < NBLK; ++idx) {
            const int blk = dir == 0 ? idx : (idx == 0 ? 0 : NBLK - idx); const int u = bh * NBLK + blk;
            const float dec = __expf(BT[u * 2 + dir]);
            const f32x4 dc = *(const f32x4*)(DC + (size_t)(u * 2 + dir) * DQK * DV + e4);
            u32x2 o; o.x = cvt2(st.x, st.y); o.y = cvt2(st.z, st.w);
            *(u32x2*)(CST + (size_t)(u * 2 + dir) * DQK * DV + e4) = o;
            st = st * dec + dc;
        }
    }
    for (int g = C.bid * NT + C.tid; g < BATCH * NH * 2 * DQK; g += C.G * NT) {
        const int d = g % DQK, ch = g / DQK, dir = ch & 1, bh = ch >> 1; float st = 0.f;
        for (int idx = 0; idx < NBLK; ++idx) {
            const int blk = dir == 0 ? idx : (idx == 0 ? 0 : NBLK - idx); const int u = bh * NBLK + blk;
            NST[(size_t)(u * 2 + dir) * DQK + d] = st; st = __expf(BT[u * 2 + dir]) * st + DN[(size_t)(u * 2 + dir) * DQK + d];
        }
    }
}
__device__ __forceinline__ void lds_barrier() { asm volatile("s_waitcnt lgkmcnt(0)" ::: "memory"); __builtin_amdgcn_s_barrier(); asm volatile("" ::: "memory"); }
__device__ __forceinline__ void phase_s3(const Args& A, const Ctx& C, int l) {
    const int jl = l >> 1; const bool ctx_out = (l == 0);
    LAS float* bf = (LAS float*)C.lds; LAS float* bb = bf + 256; LAS float* gf = bb + 256; LAS float* gb = gf + 256;
    LAS float* nf = gb + 256; LAS float* nb = nf + 128; LAS float* ssx = nb + 128;
    constexpr int KP = 272, VP = 136, CP = 144, OP = 528;
    LAS unsigned char* Kimg = C.lds + 6144;
    LAS unsigned char* CH = Kimg + 256 * KP;
    static_assert(6144 + 256 * KP + 128 * OP <= LDS_TAB_END, "S3 LDS map");
    const bf16* P = (const bf16*)(A.ws + WS_PB); const bf16* VT = (const bf16*)(A.ws + WS_VT); bf16* HM = (bf16*)(A.ws + WS_HM);
    const bf16* CST = (const bf16*)(A.ws + WS_CST); const float* NST = (const float*)(A.ws + WS_NST);
    const float* hg = A.in[10] + (size_t)jl * NV;
    const int w = C.wave, eh = w >> 2;
    for (int u = C.bid; u < NUNIT; u += C.G) {
        const int blk = u % NBLK, bh = u / NBLK, h = bh % NH, b = bh / NH; const int row0 = blk_row0(b, blk);
        if (blk == 0 && !ctx_out) continue;
        block_gates(A, row0, h, bf, bb, gf, gb, C.tid);
        if (C.tid < 256) { gf[C.tid] -= bf[C.tid]; gb[C.tid] -= bb[C.tid]; }
        else { const int t = C.tid - 256; nf[t] = NST[(size_t)(u * 2 + (t >> 7)) * DQK + (t & 127)]; }
        { const int pc = C.tid & 15, s0 = C.tid >> 4; const bf16* kr = P + (size_t)(row0 + s0) * PW + NQ + h * DQK + 8 * pc;
#pragma unroll
          for (int i = 0; i < 8; ++i) *(LAS u32x4*)(Kimg + (s0 + 32 * i) * KP + pc * 16) = *(const u32x4*)(kr + (size_t)(32 * i) * PW); }
        __syncthreads();
        const bf16* vtile = VT + (size_t)vt_tile(b, h, blk) * 65536;
        const bf16* ctile = CST + (size_t)(u * 2) * DQK * DV;
#pragma unroll 1
        for (int ps = 0; ps < 2; ++ps) {
            int lz = threadIdx.x & 63; asm volatile("" : "+v"(lz));
            const int r = lz & 31, hh = lz >> 5;
            const int jt = 2 * (w & 3) + ps; const int jrow = row0 + 32 * jt + r;
            u32x4 pre[4];
            { int tz = threadIdx.x; asm volatile("" : "+v"(tz)); const int pc = tz & 7, e0 = tz >> 3; const bf16* vr = vtile + (size_t)e0 * 256 + 8 * pc;
#pragma unroll
              for (int c4 = 0; c4 < 4; ++c4) pre[c4] = *(const u32x4*)(vr + (size_t)(64 * c4) * 256); }
            bf16x8 qf[8];
            { const bf16* qr = P + (size_t)jrow * PW + h * DQK + 8 * hh;
#pragma unroll
              for (int kk = 0; kk < 8; ++kk) qf[kk] = *(const bf16x8*)(qr + 16 * kk); }
            const float bfj = bf[32 * jt + r], bbj = bb[32 * jt + r];
            float qnf = 0.f, qnb = 0.f;
#pragma unroll
            for (int kk = 0; kk < 8; ++kk) { const u32x4 qq = __builtin_bit_cast(u32x4, qf[kk]); const int d = 16 * kk + 8 * hh;
                const f32x4 n0 = *(const LAS f32x4*)(nf + d), n1 = *(const LAS f32x4*)(nf + d + 4), m0 = *(const LAS f32x4*)(nb + d), m1 = *(const LAS f32x4*)(nb + d + 4);
                qnf += (bflo(qq.x) * n0.x + bfhi(qq.x) * n0.y) + (bflo(qq.y) * n0.z + bfhi(qq.y) * n0.w) + (bflo(qq.z) * n1.x + bfhi(qq.z) * n1.y) + (bflo(qq.w) * n1.z + bfhi(qq.w) * n1.w);
                qnb += (bflo(qq.x) * m0.x + bfhi(qq.x) * m0.y) + (bflo(qq.y) * m0.z + bfhi(qq.y) * m0.w) + (bflo(qq.z) * m1.x + bfhi(qq.z) * m1.y) + (bflo(qq.w) * m1.z + bfhi(qq.w) * m1.w);
                if (kk & 1) asm volatile("" ::: "memory"); }
            qnf += __shfl_xor(qnf, 32); qnb += __shfl_xor(qnb, 32);
            float denf = 0.f, denb = 0.f;
#pragma unroll 1
            for (int kt = 0; kt < 8; ++kt) {
                f32x16 c;
#pragma unroll
                for (int i = 0; i < 16; ++i) c[i] = 0.f;
#pragma unroll
                for (int kk = 0; kk < 8; ++kk) { const bf16x8 a = *(const LAS bf16x8*)(Kimg + (kt * 32 + r) * KP + (16 * kk + 8 * hh) * 2); c = MFMA32(a, qf[kk], c); }
#pragma unroll
                for (int g = 0; g < 4; ++g) { const int sl0 = 8 * g + 4 * hh;
                    const f32x4 g4f = *(const LAS f32x4*)(gf + kt * 32 + sl0), g4b = *(const LAS f32x4*)(gb + kt * 32 + sl0);
#pragma unroll
                    for (int q = 0; q < 4; ++q) { const int sl = sl0 + q; const float cv = c[4 * g + q];
                        if (kt <= jt) { const bool act = (kt < jt) || (sl <= r); denf += cv * __expf(act ? bfj + g4f[q] : -1.0e30f); }
                        if (kt >= jt) { const bool act = (kt > jt) || (sl >= r); denb += cv * __expf(act ? bbj + g4b[q] : -1.0e30f); } } }
            }
            denf += __shfl_xor(denf, 32); denb += __shfl_xor(denb, 32);
            const float ebf = __expf(bfj), ebb = __expf(bbj);
            denf += ebf * qnf; denb += ebb * qnb;
            const float rf = 1.0f / fmaxf(fabsf(denf), 1.0f), rb = 1.0f / fmaxf(fabsf(denb), 1.0f);
            const float scf = ebf * rf, scb = ebb * rb;
            f32x16 acc[4];
#pragma unroll
            for (int et = 0; et < 4; ++et)
#pragma unroll
                for (int i = 0; i < 16; ++i) acc[et][i] = 0.f;
#pragma unroll
            for (int ci = 0; ci < 8; ++ci) {
                lds_barrier();
                { int tz = threadIdx.x; asm volatile("" : "+v"(tz)); const int pc = tz & 7, e0 = tz >> 3;
                  if (ci < 4) {
#pragma unroll
                      for (int c4 = 0; c4 < 4; ++c4) { *(LAS u32x2*)(CH + (e0 + 64 * c4) * VP + pc * 16) = (u32x2){pre[c4].x, pre[c4].y}; *(LAS u32x2*)(CH + (e0 + 64 * c4) * VP + pc * 16 + 8) = (u32x2){pre[c4].z, pre[c4].w}; }
                  } else {
#pragma unroll
                      for (int c4 = 0; c4 < 4; ++c4) *(LAS u32x4*)(CH + (e0 + 64 * c4) * CP + pc * 16) = pre[c4];
                  }
                  if (ci < 7) { const int cn = ci + 1;
                      const bf16* src = (cn < 4) ? vtile + (size_t)e0 * 256 + 64 * cn + 8 * pc : ctile + (size_t)(cn >= 6 ? DQK * DV : 0) + (size_t)e0 * DQK + 64 * (cn & 1) + 8 * pc;
                      const size_t rstep = (cn < 4) ? (size_t)64 * 256 : (size_t)64 * DQK;
#pragma unroll
                      for (int c4 = 0; c4 < 4; ++c4) pre[c4] = *(const u32x4*)(src + c4 * rstep); } }
                lds_barrier();
                if (ci < 4) {
#pragma unroll 1
                    for (int kt2 = 0; kt2 < 2; ++kt2) { const int kt = 2 * ci + kt2;
                        f32x16 c;
#pragma unroll
                        for (int i = 0; i < 16; ++i) c[i] = 0.f;
#pragma unroll
                        for (int kk = 0; kk < 8; ++kk) { const bf16x8 a = *(const LAS bf16x8*)(Kimg + (kt * 32 + r) * KP + (16 * kk + 8 * hh) * 2); c = MFMA32(a, qf[kk], c); }
                        float p[16]; const float bfj2 = bf[32 * jt + r], bbj2 = bb[32 * jt + r];
#pragma unroll
                        for (int g = 0; g < 4; ++g) { const int sl0 = 8 * g + 4 * hh;
                            const f32x4 g4f = *(const LAS f32x4*)(gf + kt * 32 + sl0), g4b = *(const LAS f32x4*)(gb + kt * 32 + sl0);
#pragma unroll
                            for (int q = 0; q < 4; ++q) { const int sl = sl0 + q; float wt = 0.f;
                                if (kt <= jt) { const bool act = (kt < jt) || (sl <= r); wt += rf * __expf(act ? bfj2 + g4f[q] : -1.0e30f); }
                                if (kt >= jt) { const bool act = (kt > jt) || (sl >= r); wt += rb * __expf(act ? bbj2 + g4b[q] : -1.0e30f); }
                                p[4 * g + q] = c[4 * g + q] * wt; } }
                        const bf16x8 pa0 = pack8(p[0], p[1], p[2], p[3], p[4], p[5], p[6], p[7]), pa1 = pack8(p[8], p[9], p[10], p[11], p[12], p[13], p[14], p[15]);
#pragma unroll
                        for (int et = 0; et < 4; ++et) { LAS const unsigned char* vb = CH + ((4 * eh + et) * 32 + r) * VP + (kt2 * 32 + 4 * hh) * 2;
                            const u32x2 l0 = *(LAS const u32x2*)(vb), h0 = *(LAS const u32x2*)(vb + 16), l1 = *(LAS const u32x2*)(vb + 32), h1 = *(LAS const u32x2*)(vb + 48);
                            const bf16x8 a0 = __builtin_bit_cast(bf16x8, (u32x4){l0.x, l0.y, h0.x, h0.y}), a1 = __builtin_bit_cast(bf16x8, (u32x4){l1.x, l1.y, h1.x, h1.y});
                            acc[et] = MFMA32(a0, pa0, acc[et]); acc[et] = MFMA32(a1, pa1, acc[et]); }
                    }
                } else {
                    const int dir = (ci - 4) >> 1, dh = ci & 1;
                    const float sc = dir ? scb : scf;
#pragma unroll
                    for (int k4 = 0; k4 < 4; ++k4) { const u32x4 qq = __builtin_bit_cast(u32x4, qf[4 * dh + k4]);
                        const bf16x8 qs = pack8(bflo(qq.x) * sc, bfhi(qq.x) * sc, bflo(qq.y) * sc, bfhi(qq.y) * sc, bflo(qq.z) * sc, bfhi(qq.z) * sc, bflo(qq.w) * sc, bfhi(qq.w) * sc);
#pragma unroll
                        for (int et = 0; et < 4; ++et) { const bf16x8 a = *(const LAS bf16x8*)(CH + ((4 * eh + et) * 32 + r) * CP + (16 * k4 + 8 * hh) * 2); acc[et] = MFMA32(a, qs, acc[et]); } }
                }
            }
            float ss = 0.f;
#pragma unroll
            for (int et = 0; et < 4; ++et)
#pragma unroll
                for (int i = 0; i < 16; ++i) ss += acc[et][i] * acc[et][i];
            ss += __shfl_xor(ss, 32);
            if (hh == 0) ssx[w * 32 + r] = ss;
            lds_barrier();
            ss += ssx[(w ^ 4) * 32 + r];
            const float rs = 1.0f / sqrtf(ss * (1.0f / DV) + EPS);
            { LAS unsigned char* ob = CH + ((w & 3) * 32 + r) * OP + (eh * 128 + 4 * hh) * 2;
#pragma unroll
              for (int et = 0; et < 4; ++et)
#pragma unroll
                  for (int g = 0; g < 4; ++g) { u32x2 o; o.x = cvt2(acc[et][4 * g + 0] * rs, acc[et][4 * g + 1] * rs); o.y = cvt2(acc[et][4 * g + 2] * rs, acc[et][4 * g + 3] * rs);
                      *(LAS u32x2*)(ob + (et * 32 + 8 * g) * 2) = o; } }
            lds_barrier();
            { int tz = threadIdx.x; asm volatile("" : "+v"(tz)); const int pc = tz & 31, lr0 = tz >> 5;
              const f32x4 g0 = *(const f32x4*)(hg + h * DV + 8 * pc), g1 = *(const f32x4*)(hg + h * DV + 8 * pc + 4);
#pragma unroll
              for (int hf = 0; hf < 2; ++hf) {
              u32x4 ov[4];
#pragma unroll
              for (int i = 0; i < 4; ++i) { const int lr = lr0 + 16 * (4 * hf + i); const int grow = row0 + 64 * (lr >> 5) + 32 * ps + (lr & 31); ov[i] = *(const u32x4*)(P + (size_t)grow * PW + 2 * NQ + NV + h * DV + 8 * pc); }
#pragma unroll
              for (int i = 0; i < 4; ++i) { const int lr = lr0 + 16 * (4 * hf + i); const int grow = row0 + 64 * (lr >> 5) + 32 * ps + (lr & 31);
                  const u32x4 hv = *(const LAS u32x4*)(CH + lr * OP + pc * 16);
                  u32x4 o; o.x = cvt2(bflo(hv.x) * g0.x * bflo(ov[i].x), bfhi(hv.x) * g0.y * bfhi(ov[i].x)); o.y = cvt2(bflo(hv.y) * g0.z * bflo(ov[i].y), bfhi(hv.y) * g0.w * bfhi(ov[i].y));
                  o.z = cvt2(bflo(hv.z) * g1.x * bflo(ov[i].z), bfhi(hv.z) * g1.y * bfhi(ov[i].z)); o.w = cvt2(bflo(hv.w) * g1.z * bflo(ov[i].w), bfhi(hv.w) * g1.w * bfhi(ov[i].w));
                  *(u32x4*)(HM + (size_t)grow * D + h * DV + 8 * pc) = o; }
              asm volatile("" ::: "memory"); } }
        }
        __syncthreads();
    }
}

#define XB_TMO      128
#define XB_XCNT(j)  (256  + 64 * (j))
#define XB_XSUB(j)  (1280 + 64 * (j))
#define XB_XGEN(j)  (2304 + 64 * (j))
#define XB_TOP      3328
#define XB_TOPGEN   3392
#define XCD_BAR_WORDS 3456
#define XB_SPIN_CAP (1u << 18)

__device__ __forceinline__ unsigned xb_ld(unsigned* p)              { return __hip_atomic_load(p, __ATOMIC_RELAXED, __HIP_MEMORY_SCOPE_AGENT); }
__device__ __forceinline__ unsigned xb_add(unsigned* p, unsigned v) { return __hip_atomic_fetch_add(p, v, __ATOMIC_RELAXED, __HIP_MEMORY_SCOPE_AGENT); }
__device__ __forceinline__ unsigned xb_xcc_id() { return (unsigned)__builtin_amdgcn_s_getreg((3 << 11) | 20) & 0xFu; }
#define XB_SPIN(cond, bar) do { unsigned _sp = 0; while (cond) { __builtin_amdgcn_s_sleep(1); \
    if ((++_sp & 255u) == 0u) { if (xb_ld(&(bar)[XB_TMO])) break; if (_sp > XB_SPIN_CAP) { atomicAdd(&(bar)[XB_TMO], 1u); break; } } } } while (0)

struct XcdBarrier {
    unsigned* bar; unsigned x;
    volatile LAS unsigned* st;
};

__device__ __forceinline__ XcdBarrier xcd_barrier_post(unsigned* bar, volatile LAS unsigned* st) {
    XcdBarrier b; b.bar = bar; b.x = xb_xcc_id(); b.st = st;
    if (threadIdx.x == 0) (void)xb_add(&bar[XB_XCNT(b.x)], 1u);
    return b;
}
__device__ __forceinline__ void xcd_barrier_complete(unsigned* bar, unsigned x, unsigned& nloc, unsigned& nx) {
    const unsigned G = gridDim.x * gridDim.y * gridDim.z;
    unsigned sum, cnt, mine, sp = 0u;
    for (;;) {
        sum = 0u; cnt = 0u; mine = 0u;
#pragma unroll
        for (unsigned j = 0; j < 16; ++j) { const unsigned c = xb_ld(&bar[XB_XCNT(j)]); sum += c; cnt += (c > 0u) ? 1u : 0u; mine = (j == x) ? c : mine; }
        if (sum == G) break;
        __builtin_amdgcn_s_sleep(1);
        if ((++sp & 255u) == 0u) { if (xb_ld(&bar[XB_TMO])) break; if (sp > XB_SPIN_CAP) { atomicAdd(&bar[XB_TMO], 1u); break; } }
    }
    nloc = mine > 0u ? mine : 1u; nx = cnt > 0u ? cnt : 1u;
}

__device__ __forceinline__ void xcd_barrier(const XcdBarrier& b) {
    asm volatile("s_waitcnt vmcnt(0)" ::: "memory");
    __syncthreads();
    if (threadIdx.x == 0) {
        unsigned* bar = b.bar;
        __builtin_amdgcn_s_waitcnt(0);
        unsigned nloc = b.st[0], nx = b.st[1];
        if (nloc == 0u) { xcd_barrier_complete(bar, b.x, nloc, nx); b.st[0] = nloc; b.st[1] = nx; }
        const unsigned old = xb_add(&bar[XB_XSUB(b.x)], 1u);
        const unsigned gen = old / nloc;
        if (old + 1u == (gen + 1u) * nloc) {
            __builtin_amdgcn_fence(__ATOMIC_RELEASE, "agent");
            asm volatile("s_waitcnt vmcnt(0)" ::: "memory");
            const unsigned og = xb_add(&bar[XB_TOP], 1u);
            const unsigned tg = og / nx;
            if (og + 1u == (tg + 1u) * nx) xb_add(&bar[XB_TOPGEN], 1u);
            else XB_SPIN(xb_ld(&bar[XB_TOPGEN]) == tg, bar);
            __builtin_amdgcn_fence(__ATOMIC_ACQUIRE, "agent");
            xb_add(&bar[XB_XGEN(b.x)], 1u);
            asm volatile("s_waitcnt vmcnt(0)" ::: "memory");
        } else {
            XB_SPIN(xb_ld(&bar[XB_XGEN(b.x)]) == gen, bar);
            __builtin_amdgcn_fence(__ATOMIC_ACQUIRE, "agent");
            asm volatile("s_waitcnt vmcnt(0)" ::: "memory");
        }
    }
    __syncthreads();
}


constexpr int LDS_BYTES = 152 * 1024;
constexpr int CW_BAR = 16384;
static_assert((CW_BAR + XCD_BAR_WORDS) * 4 <= (int)CTL_BYTES, "ctl");
#ifndef MK_MULTI
#define MK_MULTI 0
#endif
#define IN(p) (lo <= (p) && (p) < hi)
#ifndef PROBE_MASK
#define PROBE_MASK 0
#endif
#define DUP(bit, call) do { call; } while (0)
#define SEAM(p) do { if ((p) + 1 < hi) { XcdBarrier b_; b_.bar = (unsigned*)(load_args().ws + WS_CTL) + CW_BAR; b_.x = xb_xcc_id(); b_.st = (volatile LAS unsigned*)(C.lds + LDS_BYTES - 16); xcd_barrier(b_); } } while (0)
#define CAS __attribute__((address_space(4)))
__device__ __forceinline__ Args load_args() {
#if defined(__HIP_DEVICE_COMPILE__)
    const CAS Args* p = (const CAS Args*)__builtin_amdgcn_kernarg_segment_ptr(); asm volatile("" : "+s"(p));
    Args a; for (int i = 0; i < 22; ++i) a.in[i] = p->in[i]; a.out = p->out; a.ws = p->ws; a.lo = p->lo; a.hi = p->hi; return a;
#else
    return Args{};
#endif
}
__device__ __forceinline__ Ctx fresh(const Ctx& C) { Ctx R = C; int tz = threadIdx.x; asm volatile("" : "+v"(tz)); R.tid = tz; R.lane = tz & 63; return R; }
template <int L> __device__ __forceinline__ void layer_phases(const Args& args, const Ctx& C, int bar, int lo, int hi) {
    constexpr int pb = 16 * L;
    if (IN(pb + 1)) { DUP(4, phase_cvt_moe(load_args(), fresh(C), L)); __syncthreads(); phase_r1(load_args(), fresh(C), L); SEAM(pb + 1); }
    if (IN(pb + 2)) { DUP(1, phase_g1(load_args(), fresh(C), L)); SEAM(pb + 2); }
    if constexpr ((L & 1) == 0) {
        if (IN(pb + 3)) { DUP(2, phase_s1(load_args(), fresh(C), L)); SEAM(pb + 3); }
        if (IN(pb + 4)) { DUP(2, phase_s2(load_args(), fresh(C))); SEAM(pb + 4); }
        if (IN(pb + 5)) { DUP(2, phase_s3(load_args(), fresh(C), L)); SEAM(pb + 5); }
    } else {
        if (IN(pb + 3)) { DUP(8, phase_conv(load_args(), fresh(C), L)); SEAM(pb + 3); }
    }
    if (IN(pb + 6)) { DUP(1, phase_g2(load_args(), fresh(C), L)); SEAM(pb + 6); }
    if (IN(pb + 7)) { phase_r2(load_args(), fresh(C), L); SEAM(pb + 7); }
    if (IN(pb + 8)) { DUP(1, phase_m1(load_args(), fresh(C), L)); SEAM(pb + 8); }
    if (IN(pb + 9)) { DUP(1, phase_m2(load_args(), fresh(C), L)); SEAM(pb + 9); }
}
__global__ void __launch_bounds__(NT, 2) fwd_kernel(Args args) {
    extern __shared__ __attribute__((aligned(16))) unsigned char lds_raw[];
    Ctx C; C.lds = (LAS unsigned char*)lds_raw; C.tid = threadIdx.x; C.lane = C.tid & 63; C.wave = __builtin_amdgcn_readfirstlane(C.tid >> 6); C.G = gridDim.x; C.bid = blockIdx.x; C.a = &args;
    const int lo = args.lo, hi = args.hi;
    volatile LAS unsigned* xbw = (volatile LAS unsigned*)(C.lds + LDS_BYTES - 16);
    if (C.tid < 4) xbw[C.tid] = 0u;
    __syncthreads();
    if (hi - lo > 1) (void)xcd_barrier_post((unsigned*)(args.ws + WS_CTL) + CW_BAR, xbw);
    const int bar = 0; (void)bar;
    if (IN(0)) { DUP(4, phase_mod(load_args(), fresh(C))); __syncthreads(); DUP(4, phase_cvt_mixer(load_args(), fresh(C))); SEAM(0); }
    layer_phases<0>(args, C, bar, lo, hi);
    layer_phases<1>(args, C, bar, lo, hi);
    layer_phases<2>(args, C, bar, lo, hi);
    layer_phases<3>(args, C, bar, lo, hi);
    if (IN(64)) phase_final(load_args(), fresh(C));
}
#undef IN
#undef SEAM

extern "C" void kernel_launch(void* const* d_in, const int* in_sizes, int n_in, void* d_out, int out_size, void* d_ws, size_t ws_size, hipStream_t stream) {
    static int grid = 0;
    if (grid == 0) {
        if (n_in != 22 || out_size != NL * D || ws_size < WS_END) { fprintf(stderr, "kernel_launch: unexpected shapes (n_in %d out %d ws %zu)\n", n_in, out_size, ws_size); grid = -1; return; }
        int dev = 0, cus = 0, per_cu = 0;
        if (hipGetDevice(&dev) != hipSuccess || hipDeviceGetAttribute(&cus, hipDeviceAttributeMultiprocessorCount, dev) != hipSuccess) { grid = -1; return; }
        if (hipFuncSetAttribute((const void*)fwd_kernel, hipFuncAttributeMaxDynamicSharedMemorySize, LDS_BYTES) != hipSuccess) { grid = -1; return; }
        if (hipOccupancyMaxActiveBlocksPerMultiprocessor(&per_cu, (const void*)fwd_kernel, NT, LDS_BYTES) != hipSuccess || per_cu < 1) { fprintf(stderr, "kernel_launch: occupancy query says %d\n", per_cu); }
        (void)hipGetLastError();
        grid = cus;
    }
    if (grid < 0) return;
    (void)hipMemsetAsync((char*)d_ws + WS_CTL, 0, CTL_BYTES, stream);
    Args a{};
    for (int i = 0; i < 22; ++i) a.in[i] = (const float*)d_in[i];
    a.out = (float*)d_out; a.ws = (unsigned char*)d_ws;
#if MK_MULTI
    int phases[64]; int np = 0;
    phases[np++] = 0;
    for (int l = 0; l < DEPTH; ++l) { const int pb = 16 * l; phases[np++] = pb + 1; phases[np++] = pb + 2; phases[np++] = pb + 3;
        if ((l & 1) == 0) { phases[np++] = pb + 4; phases[np++] = pb + 5; }
        phases[np++] = pb + 6; phases[np++] = pb + 7; phases[np++] = pb + 8; phases[np++] = pb + 9; }
    phases[np++] = 64;
    for (int i = 0; i < np; ++i) { a.lo = phases[i]; a.hi = phases[i] + 1; hipLaunchKernelGGL(fwd_kernel, dim3(grid), dim3(NT), LDS_BYTES, stream, a); }
#else
    a.lo = 0; a.hi = 65;
    hipLaunchKernelGGL(fwd_kernel, dim3(grid), dim3(NT), LDS_BYTES, stream, a);
#ifdef PROBE_PHASES
    { const int pp[] = {PROBE_PHASES};
      for (int rep = 0; rep < PROBE_REPS; ++rep) for (unsigned i = 0; i < sizeof(pp) / sizeof(pp[0]); ++i) { a.lo = pp[i]; a.hi = pp[i] + 1; hipLaunchKernelGGL(fwd_kernel, dim3(grid), dim3(NT), LDS_BYTES, stream, a); } }
#endif
#endif
}
```

```cpp
#include <hip/hip_runtime.h>
#include <cstdio>
#include <cstdint>

#define LAS __attribute__((address_space(3)))
typedef unsigned short bf16;
typedef float f32x4 __attribute__((ext_vector_type(4)));
typedef unsigned u32x4 __attribute__((ext_vector_type(4)));
typedef unsigned u32x2 __attribute__((ext_vector_type(2)));

constexpr int D = 1024, BATCH = 2, SEQ = 16384, DEPTH = 4, CTXL = 256;
constexpr int NL = BATCH * SEQ, NCX = BATCH * CTXL, NR = NL + NCX;
constexpr int NH = 4, DQK = 128, DV = 256, NQ = 512, NV = 1024, PROJ = 3088, PW = 3072;
constexpr int NGRP = 4, EPG = 8, NE = 32, DE = 512;
constexpr int NBLK = 65;
constexpr int NUNIT = BATCH * NH * NBLK;
constexpr int CAP = NR;
constexpr int YROWS = 74752;
constexpr float EPS = 1e-6f;
constexpr int NT = 512, NW = 8;
constexpr int LDS_TAB_END = 152 * 1024 - 16;

constexpr size_t MiB = 1u << 20;
constexpr size_t WS_CTL = 0, CTL_BYTES = 1 * MiB;
constexpr size_t WS_MOD = 1 * MiB;
constexpr size_t WS_GATE = 2 * MiB;
constexpr size_t WS_TOKSLOT = 5 * MiB;
constexpr size_t WS_TOKW = 6 * MiB;
constexpr size_t WS_SLOTTOK = 7 * MiB;
constexpr size_t WS_DN = 12 * MiB;
constexpr size_t WS_NST = 13 * MiB;
constexpr size_t WS_BTOT = 14 * MiB;
constexpr size_t WS_LAT = 16 * MiB;
constexpr size_t WS_HB = 146 * MiB;
constexpr size_t WS_PB = 211 * MiB;
constexpr size_t WS_HM = 406 * MiB;
constexpr size_t WS_DC = 471 * MiB;
constexpr size_t WS_CST = 601 * MiB;
constexpr size_t WS_VT = 666 * MiB;
constexpr size_t WS_WAIN = 731 * MiB;
constexpr size_t WS_WBIN = 743 * MiB;
constexpr size_t WS_WAOUT = 755 * MiB;
constexpr size_t WS_WBOUT = 759 * MiB;
constexpr size_t WS_WGU = 763 * MiB;
constexpr size_t WS_WDN = 827 * MiB;
constexpr size_t WS_H8 = 843 * MiB;
constexpr size_t WS_END = 880 * MiB;
constexpr int CW_CNT = 1024, CNT_STRIDE = 64;

struct Args { const float* in[22]; float* out; unsigned char* ws; int lo, hi; };

typedef short bf16x8 __attribute__((ext_vector_type(8)));
typedef float f32x2 __attribute__((ext_vector_type(2)));
typedef __bf16 bf16x2_t __attribute__((ext_vector_type(2)));
__device__ __forceinline__ unsigned cvt2(float lo, float hi) { const f32x2 v = {lo, hi}; return __builtin_bit_cast(unsigned, __builtin_convertvector(v, bf16x2_t)); }
__device__ __forceinline__ float bf2f(bf16 v) { return __uint_as_float(((unsigned)v) << 16); }
__device__ __forceinline__ unsigned f2bf(float f) { unsigned u = __float_as_uint(f); return (u + 0x7fffu + ((u >> 16) & 1u)) >> 16; }
__device__ __forceinline__ unsigned pk2(float lo, float hi) { return f2bf(lo) | (f2bf(hi) << 16); }
template <int CTRL, int ROWMASK> __device__ __forceinline__ float dpp_mov(float x) { return __int_as_float(__builtin_amdgcn_update_dpp(0, __float_as_int(x), CTRL, ROWMASK, 0xf, false)); }
__device__ __forceinline__ float wave_sum(float v) {
    v += dpp_mov<0xB1, 0xf>(v); v += dpp_mov<0x4E, 0xf>(v); v += dpp_mov<0x141, 0xf>(v); v += dpp_mov<0x140, 0xf>(v);
    v += dpp_mov<0x142, 0xA>(v); v += dpp_mov<0x143, 0xC>(v);
    return __int_as_float(__builtin_amdgcn_readlane(__float_as_int(v), 63));
}
__device__ __forceinline__ float sigmoidf_(float x) { return 1.f / (1.f + __expf(-x)); }
__device__ __forceinline__ float siluf_(float x) { return x / (1.f + __expf(-x)); }
__device__ __forceinline__ float logsigmoidf_(float x) { return fminf(x, 0.f) - log1pf(__expf(-fabsf(x))); }
__device__ __forceinline__ int blk_row0(int b, int blk) { return blk == 0 ? NL + b * CTXL : b * SEQ + (blk - 1) * 256; }
__device__ __forceinline__ int mod_vec_of_row(int row) { return row < NL ? row / SEQ : 2; }

struct Ctx {
    LAS unsigned char* lds; int tid, lane, wave, G, bid;
    const Args* a;
};

__device__ __forceinline__ void slot_bases(const Args& A, int l, LAS int* sb, int tid) {
    if (tid == 0) {
        const unsigned* cnt = (const unsigned*)(A.ws + WS_CTL) + CW_CNT + l * 32 * CNT_STRIDE;
        int acc = 0;
        for (int e = 0; e < NE; ++e) { sb[e] = acc; acc += (((int)cnt[e * CNT_STRIDE] + 255) / 256) * 256; }
        sb[NE] = acc;
    }
    __syncthreads();
}

__device__ __forceinline__ void phase_mod(const Args& A, const Ctx& C) {
    LAS float* sc = (LAS float*)C.lds;
    LAS float* red = sc + 3072;
    const float* c = A.in[1]; const float* cc = A.in[3];
    for (int i = C.tid; i < 3072; i += NT) { const float v = i < 2048 ? c[i] : cc[i - 2048]; sc[i] = siluf_(v); }
    __syncthreads();
    float* MOD = (float*)(A.ws + WS_MOD);
    for (int u = C.bid; u < DEPTH * 96; u += C.G) {
        const int l = u / 96, cg = u % 96, col = cg * 64 + C.lane;
        const float* w = A.in[4] + (size_t)l * D * 6 * D + col;
        float a0 = 0.f, a1 = 0.f, a2 = 0.f;
        for (int k = C.wave * 128; k < C.wave * 128 + 128; ++k) { const float wv = w[(size_t)k * 6 * D]; a0 += sc[k] * wv; a1 += sc[1024 + k] * wv; a2 += sc[2048 + k] * wv; }
        red[(C.wave * 3 + 0) * 64 + C.lane] = a0; red[(C.wave * 3 + 1) * 64 + C.lane] = a1; red[(C.wave * 3 + 2) * 64 + C.lane] = a2;
        __syncthreads();
        if (C.tid < 192) { const int v = C.tid / 64, ln = C.tid % 64; float s = 0.f;
            for (int w8 = 0; w8 < 8; ++w8) s += red[(w8 * 3 + v) * 64 + ln];
            MOD[(size_t)(l * 3 + v) * 6 * D + cg * 64 + ln] = s + A.in[5][(size_t)l * 6 * D + cg * 64 + ln]; }
        __syncthreads();
    }
}

__device__ __forceinline__ void load_row_f32(const float* p, int lane, f32x4 (&v)[4]) {
#pragma unroll
    for (int j = 0; j < 4; ++j) v[j] = *(const f32x4*)(p + 4 * lane + 256 * j);
}
__device__ __forceinline__ void load_row_bf16(const bf16* p, int lane, f32x4 (&v)[4]) {
#pragma unroll
    for (int j = 0; j < 4; ++j) { const u32x2 w = *(const u32x2*)(p + 4 * lane + 256 * j);
        v[j] = (f32x4){__uint_as_float(w.x << 16), __uint_as_float(w.x & 0xffff0000u), __uint_as_float(w.y << 16), __uint_as_float(w.y & 0xffff0000u)}; }
}
__device__ __forceinline__ void store_row_bf16(bf16* p, int lane, const f32x4 (&v)[4]) {
#pragma unroll
    for (int j = 0; j < 4; ++j) { u32x2 w; w.x = pk2(v[j].x, v[j].y); w.y = pk2(v[j].z, v[j].w); *(u32x2*)(p + 4 * lane + 256 * j) = w; }
}
__device__ __forceinline__ void moe_combine(const Args& A, int lp, int row, int lane, LAS const int* sb, f32x4 (&v)[4]) {
    const int* ts = (const int*)(A.ws + WS_TOKSLOT) + row * 2; const float* tw = (const float*)(A.ws + WS_TOKW) + row * 2;
    const bf16* Y = (const bf16*)(A.ws + WS_PB);
    const int t0 = ts[0], t1 = ts[1]; const float w0 = tw[0], w1 = tw[1];
    const size_t s0 = (size_t)(sb[t0 >> 20] + (t0 & 0xfffff)), s1 = (size_t)(sb[t1 >> 20] + (t1 & 0xfffff));
    f32x4 y0[4], y1[4], g2[4];
    load_row_bf16(Y + s0 * D, lane, y0); load_row_bf16(Y + s1 * D, lane, y1);
    load_row_f32((const float*)(A.ws + WS_MOD) + (size_t)(lp * 3 + mod_vec_of_row(row)) * 6 * D + 5 * D, lane, g2);
#pragma unroll
    for (int j = 0; j < 4; ++j) v[j] += g2[j] * (y0[j] * w0 + y1[j] * w1);
}
__device__ __forceinline__ void norm_mod(const f32x4 (&v)[4], const float* g, const float* sh, const float* sc, int lane, f32x4 (&h)[4]) {
    float s = 0.f;
#pragma unroll
    for (int j = 0; j < 4; ++j) s += (v[j].x * v[j].x + v[j].y * v[j].y) + (v[j].z * v[j].z + v[j].w * v[j].w);
    const float r = 1.0f / sqrtf(wave_sum(s) * (1.f / D) + EPS);
    f32x4 gg[4], ss[4], cc[4];
    load_row_f32(g, lane, gg); load_row_f32(sh, lane, ss); load_row_f32(sc, lane, cc);
#pragma unroll
    for (int j = 0; j < 4; ++j) h[j] = (v[j] * r) * gg[j] * (1.f + cc[j]) + ss[j];
}

constexpr int CVT_IG = (D / 64) * (DE / 32), CVT_ID = (DE / 64) * (D / 32), CVT_PER = 2 * CVT_IG + CVT_ID, CVT_ITEMS = NE * CVT_PER;
constexpr int CVT_Q = 48;
__device__ __forceinline__ void cvt_moe_items(const Args& A, const Ctx& C, int l, int it0, int end, int stride);
__device__ __forceinline__ int cvt_t2(int l, int G);
struct RowVec { f32x4 a[4], s[4], g[4]; };
__device__ __forceinline__ void load_rowvec(RowVec& R, const float* ng, const float* sh, const float* sc, const float* gt, int lane) {
    f32x4 n[4], c[4]; load_row_f32(ng, lane, n); load_row_f32(sc, lane, c); load_row_f32(sh, lane, R.s); if (gt) load_row_f32(gt, lane, R.g);
#pragma unroll
    for (int q = 0; q < 4; ++q) R.a[q] = n[q] * (1.f + c[q]);
}
__device__ __forceinline__ void load_row_bf16raw(const bf16* p, int lane, u32x2 (&v)[4]) {
#pragma unroll
    for (int j = 0; j < 4; ++j) v[j] = *(const u32x2*)(p + 4 * lane + 256 * j);
}
__device__ __forceinline__ void store_row_fp8(unsigned char* p, int lane, const f32x4 (&v)[4]) {
#pragma unroll
    for (int j = 0; j < 4; ++j) { int w = 0; w = __builtin_amdgcn_cvt_pk_fp8_f32(v[j].x, v[j].y, w, false); w = __builtin_amdgcn_cvt_pk_fp8_f32(v[j].z, v[j].w, w, true); *(unsigned*)(p + 4 * lane + 256 * j) = (unsigned)w; }
}
__device__ __forceinline__ f32x4 bf4(u32x2 w) { return (f32x4){__uint_as_float(w.x << 16), __uint_as_float(w.x & 0xffff0000u), __uint_as_float(w.y << 16), __uint_as_float(w.y & 0xffff0000u)}; }
__device__ __forceinline__ float row_rstd(const f32x4 (&v)[4]) {
    float s = 0.f;
#pragma unroll
    for (int j = 0; j < 4; ++j) s += (v[j].x * v[j].x + v[j].y * v[j].y) + (v[j].z * v[j].z + v[j].w * v[j].w);
    return 1.0f / sqrtf(wave_sum(s) * (1.f / D) + EPS);
}

__device__ __forceinline__ void phase_r1(const Args& A, const Ctx& C, int l) {
    LAS int* sb = (LAS int*)C.lds;
    LAS float* GW = (LAS float*)(C.lds + 256);
    const bool mls = (l & 1) == 0; const int j = l >> 1;
    if (l > 0) slot_bases(A, l - 1, sb, C.tid);
    if (mls) { const float* w = A.in[8] + (size_t)j * D * PROJ + PW;
        f32x4 t[2][4];
#pragma unroll
        for (int jj = 0; jj < 2; ++jj)
#pragma unroll
            for (int q = 0; q < 4; ++q) t[jj][q] = *(const f32x4*)(w + (size_t)(C.tid + NT * jj) * PROJ + 4 * q);
#pragma unroll
        for (int jj = 0; jj < 2; ++jj)
#pragma unroll
            for (int q = 0; q < 4; ++q) { const int k = C.tid + NT * jj; GW[(4 * q + 0) * D + k] = t[jj][q].x; GW[(4 * q + 1) * D + k] = t[jj][q].y; GW[(4 * q + 2) * D + k] = t[jj][q].z; GW[(4 * q + 3) * D + k] = t[jj][q].w; }
        __syncthreads(); }
    const int nrows = (l <= 2) ? NR : NL;
    bf16* LAT = (bf16*)(A.ws + WS_LAT); bf16* H = (bf16*)(A.ws + WS_HB); float* GATE = (float*)(A.ws + WS_GATE);
    const float* MOD = (const float*)(A.ws + WS_MOD); const bf16* Y = (const bf16*)(A.ws + WS_PB);
    const int* TS = (const int*)(A.ws + WS_TOKSLOT); const float* TW = (const float*)(A.ws + WS_TOKW);
    const int rpw = (((nrows + C.G - 1) / C.G) + 1) & ~1; const int wrow0 = C.bid * rpw; const int wend = min(wrow0 + rpw, nrows);
    for (int sa = wrow0; sa < wend;) {
        const int mvi = mod_vec_of_row(sa); const int bnd = mvi == 0 ? SEQ : (mvi == 1 ? NL : NR); const int sbnd = min(wend, bnd);
        RowVec RV; { const float* mv = MOD + (size_t)(l * 3 + mvi) * 6 * D;
            load_rowvec(RV, A.in[6] + (size_t)(l * 2 + 0) * D, mv + 0 * D, mv + 1 * D, l > 0 ? MOD + (size_t)((l - 1) * 3 + mvi) * 6 * D + 5 * D : nullptr, C.lane); }
        for (int ra = sa + 2 * C.wave; ra < sbnd; ra += 2 * NW) {
            const bool hasb = ra + 1 < sbnd; const int rb = hasb ? ra + 1 : ra;
            f32x4 va[4], vb[4]; float wa0 = 0.f, wa1 = 0.f, wb0 = 0.f, wb1 = 0.f;
            if (l == 0) { load_row_f32(ra < NL ? A.in[0] + (size_t)ra * D : A.in[2] + (size_t)(ra - NL) * D, C.lane, va); load_row_f32(rb < NL ? A.in[0] + (size_t)rb * D : A.in[2] + (size_t)(rb - NL) * D, C.lane, vb); }
            else {
                const int ta0 = TS[ra * 2], ta1 = TS[ra * 2 + 1], tb0 = TS[rb * 2], tb1 = TS[rb * 2 + 1]; wa0 = TW[ra * 2]; wa1 = TW[ra * 2 + 1]; wb0 = TW[rb * 2]; wb1 = TW[rb * 2 + 1];
                load_row_bf16(LAT + (size_t)ra * D, C.lane, va); load_row_bf16(LAT + (size_t)rb * D, C.lane, vb);
                u32x2 ya0[4], ya1[4], yb0[4], yb1[4];
                load_row_bf16raw(Y + (size_t)(sb[ta0 >> 20] + (ta0 & 0xfffff)) * D, C.lane, ya0); load_row_bf16raw(Y + (size_t)(sb[ta1 >> 20] + (ta1 & 0xfffff)) * D, C.lane, ya1);
                load_row_bf16raw(Y + (size_t)(sb[tb0 >> 20] + (tb0 & 0xfffff)) * D, C.lane, yb0); load_row_bf16raw(Y + (size_t)(sb[tb1 >> 20] + (tb1 & 0xfffff)) * D, C.lane, yb1);
#pragma unroll
                for (int q = 0; q < 4; ++q) { va[q] += RV.g[q] * (bf4(ya0[q]) * wa0 + bf4(ya1[q]) * wa1); vb[q] += RV.g[q] * (bf4(yb0[q]) * wb0 + bf4(yb1[q]) * wb1); }
            }
            store_row_bf16(LAT + (size_t)ra * D, C.lane, va); if (hasb) store_row_bf16(LAT + (size_t)rb * D, C.lane, vb);
            const float rra = row_rstd(va), rrb = row_rstd(vb);
            f32x4 ha[4], hb[4];
#pragma unroll
            for (int q = 0; q < 4; ++q) { ha[q] = (va[q] * rra) * RV.a[q] + RV.s[q]; hb[q] = (vb[q] * rrb) * RV.a[q] + RV.s[q]; }
            store_row_bf16(H + (size_t)ra * D, C.lane, ha); if (hasb) store_row_bf16(H + (size_t)rb * D, C.lane, hb);
            if (mls) {
                float ga = 0.f, gb = 0.f;
#pragma unroll 2
                for (int c = 0; c < 16; ++c) { float s0 = 0.f, s1 = 0.f;
#pragma unroll
                    for (int q = 0; q < 4; ++q) { const f32x4 w = *(const LAS f32x4*)(GW + c * D + 4 * C.lane + 256 * q);
                        s0 += (ha[q].x * w.x + ha[q].y * w.y) + (ha[q].z * w.z + ha[q].w * w.w); s1 += (hb[q].x * w.x + hb[q].y * w.y) + (hb[q].z * w.z + hb[q].w * w.w); }
                    s0 = wave_sum(s0); s1 = wave_sum(s1); ga = (C.lane == c) ? s0 : ga; gb = (C.lane == c) ? s1 : gb; }
                if (C.lane < 16) {
                    const float bgt = A.in[9][j * 16 + C.lane]; const int gtype = C.lane >> 2;
                    ga += bgt; gb += bgt;
                    GATE[(size_t)ra * 16 + C.lane] = (gtype & 1) ? logsigmoidf_(ga) : 15.0f * tanhf(ga * (1.0f / 15.0f));
                    if (hasb) GATE[(size_t)rb * 16 + C.lane] = (gtype & 1) ? logsigmoidf_(gb) : 15.0f * tanhf(gb * (1.0f / 15.0f)); }
            }
        }
        sa = sbnd;
    }
}

__device__ __forceinline__ void phase_r2(const Args& A, const Ctx& C, int l) {
    constexpr int WP = 2064;
    LAS unsigned char* RWB = C.lds;
    LAS float* WL = (LAS float*)(C.lds + 48 * WP);
    LAS unsigned* hist = (LAS unsigned*)(WL + 8 * 16 * 48);
    LAS unsigned* gbase = hist + 32;
    constexpr int RCAP = 144;
    LAS int* rec = (LAS int*)(gbase + 32);
    static_assert(48 * WP + 8 * 16 * 48 * 4 + 256 + RCAP * 16 <= LDS_TAB_END, "R2 LDS map");
    cvt_moe_items(A, C, l, cvt_t2(l, C.G) + C.bid * NW + C.wave, CVT_ITEMS, C.G * NW);
    __syncthreads();
    { const float* wg = A.in[15] + (size_t)l * D * NGRP; const float* wr = A.in[17] + (size_t)l * D * NE;
      { const int kp = C.tid; const f32x4 x0 = *(const f32x4*)(wg + (size_t)(2 * kp) * 4), x1 = *(const f32x4*)(wg + (size_t)(2 * kp + 1) * 4);
        *(LAS unsigned*)(RWB + 0 * WP + kp * 4) = cvt2(x0.x, x1.x); *(LAS unsigned*)(RWB + 1 * WP + kp * 4) = cvt2(x0.y, x1.y);
        *(LAS unsigned*)(RWB + 2 * WP + kp * 4) = cvt2(x0.z, x1.z); *(LAS unsigned*)(RWB + 3 * WP + kp * 4) = cvt2(x0.w, x1.w); }
      f32x4 t0[8], t1[8];
#pragma unroll
      for (int jj = 0; jj < 8; ++jj) { const int it = C.tid + NT * jj, kp = it >> 3, cg = it & 7; t0[jj] = *(const f32x4*)(wr + (size_t)(2 * kp) * NE + 4 * cg); t1[jj] = *(const f32x4*)(wr + (size_t)(2 * kp + 1) * NE + 4 * cg); }
#pragma unroll
      for (int jj = 0; jj < 8; ++jj) { const int it = C.tid + NT * jj, kp = it >> 3, c0 = 4 + 4 * (it & 7);
          *(LAS unsigned*)(RWB + (c0 + 0) * WP + kp * 4) = cvt2(t0[jj].x, t1[jj].x); *(LAS unsigned*)(RWB + (c0 + 1) * WP + kp * 4) = cvt2(t0[jj].y, t1[jj].y);
          *(LAS unsigned*)(RWB + (c0 + 2) * WP + kp * 4) = cvt2(t0[jj].z, t1[jj].z); *(LAS unsigned*)(RWB + (c0 + 3) * WP + kp * 4) = cvt2(t0[jj].w, t1[jj].w); }
      for (int i = C.tid; i < 12 * 512; i += NT) *(LAS unsigned*)(RWB + (36 + i / 512) * WP + (i % 512) * 4) = 0u; }
    const int nrows = (l <= 1) ? NR : NL;
    bf16* LAT = (bf16*)(A.ws + WS_LAT); bf16* H = (bf16*)(A.ws + WS_HB); unsigned char* H8 = A.ws + WS_H8;
    const float* MOD = (const float*)(A.ws + WS_MOD);
    unsigned* cnt = (unsigned*)(A.ws + WS_CTL) + CW_CNT + l * 32 * CNT_STRIDE;
    int* TS = (int*)(A.ws + WS_TOKSLOT); float* TW = (float*)(A.ws + WS_TOKW); int* ST = (int*)(A.ws + WS_SLOTTOK);
    const int rpw = (((nrows + C.G - 1) / C.G) + 1) & ~1; const int wrow0 = C.bid * rpw; const int wend0 = min(wrow0 + rpw, nrows);
    const float* bg = A.in[16] + l * NGRP; const float* br = A.in[18] + l * NE;
    for (int cb = wrow0; cb < wend0; cb += RCAP) {
        const int wend = min(cb + RCAP, wend0);
        if (C.tid < 32) hist[C.tid] = 0u;
        for (int sa = cb; sa < wend;) {
            const int mvi = mod_vec_of_row(sa); const int bnd = mvi == 0 ? SEQ : (mvi == 1 ? NL : NR); const int sbnd = min(wend, bnd);
            RowVec RV; { const float* mv = MOD + (size_t)(l * 3 + mvi) * 6 * D; load_rowvec(RV, A.in[6] + (size_t)(l * 2 + 1) * D, mv + 3 * D, mv + 4 * D, mv + 2 * D, C.lane); }
            const int rlast = sbnd - 2;
            u32x2 la[4], lb[4], ya[4], yb[4];
            { const int r0 = min(sa + 2 * C.wave, rlast); load_row_bf16raw(LAT + (size_t)r0 * D, C.lane, la); load_row_bf16raw(LAT + (size_t)(r0 + 1) * D, C.lane, lb);
              load_row_bf16raw(H + (size_t)r0 * D, C.lane, ya); load_row_bf16raw(H + (size_t)(r0 + 1) * D, C.lane, yb); }
            for (int ra = sa + 2 * C.wave; ra < sbnd; ra += 2 * NW) {
                const int rb = ra + 1;
                u32x2 lan[4], lbn[4], yan[4], ybn[4];
                { const int r1 = min(ra + 2 * NW, rlast); load_row_bf16raw(LAT + (size_t)r1 * D, C.lane, lan); load_row_bf16raw(LAT + (size_t)(r1 + 1) * D, C.lane, lbn);
                  load_row_bf16raw(H + (size_t)r1 * D, C.lane, yan); load_row_bf16raw(H + (size_t)(r1 + 1) * D, C.lane, ybn); }
                f32x4 va[4], vb[4];
#pragma unroll
                for (int q = 0; q < 4; ++q) { va[q] = bf4(la[q]) + RV.g[q] * bf4(ya[q]); vb[q] = bf4(lb[q]) + RV.g[q] * bf4(yb[q]); }
                store_row_bf16(LAT + (size_t)ra * D, C.lane, va); store_row_bf16(LAT + (size_t)rb * D, C.lane, vb);
                const float rra = row_rstd(va), rrb = row_rstd(vb);
                f32x4 ha[4], hb[4];
#pragma unroll
                for (int q = 0; q < 4; ++q) { ha[q] = (va[q] * rra) * RV.a[q] + RV.s[q]; hb[q] = (vb[q] * rrb) * RV.a[q] + RV.s[q]; }
                store_row_bf16(H + (size_t)ra * D, C.lane, ha); store_row_bf16(H + (size_t)rb * D, C.lane, hb);
                store_row_fp8(H8 + (size_t)ra * D, C.lane, ha); store_row_fp8(H8 + (size_t)rb * D, C.lane, hb);
#pragma unroll
                for (int q = 0; q < 4; ++q) { la[q] = lan[q]; lb[q] = lbn[q]; ya[q] = yan[q]; yb[q] = ybn[q]; }
            }
            sa = sbnd;
        }
        __syncthreads();
        const int fr = C.lane & 15, fq = C.lane >> 4;
        for (int t = C.wave; t * 16 < wend - cb; t += NW) {
            const int trow = min(cb + 16 * t + fr, wend - 1);
            const bf16* hp = H + (size_t)trow * D + 8 * fq;
            f32x4 acc[3];
#pragma unroll
            for (int ct = 0; ct < 3; ++ct) acc[ct] = (f32x4){0.f, 0.f, 0.f, 0.f};
#pragma unroll 1
            for (int kb = 0; kb < 4; ++kb) {
                bf16x8 av[8];
#pragma unroll
                for (int k8 = 0; k8 < 8; ++k8) av[k8] = *(const bf16x8*)(hp + 32 * (8 * kb + k8));
#pragma unroll
                for (int k8 = 0; k8 < 8; ++k8)
#pragma unroll
                    for (int ct = 0; ct < 3; ++ct) { const bf16x8 bv = *(const LAS bf16x8*)(RWB + (ct * 16 + fr) * WP + (32 * (8 * kb + k8) + 8 * fq) * 2);
                        acc[ct] = __builtin_amdgcn_mfma_f32_16x16x32_bf16(av[k8], bv, acc[ct], 0, 0, 0); }
            }
            LAS float* wl = WL + C.wave * 16 * 48;
#pragma unroll
            for (int ct = 0; ct < 3; ++ct)
#pragma unroll
                for (int jq = 0; jq < 4; ++jq) wl[(4 * fq + jq) * 48 + ct * 16 + fr] = acc[ct][jq];
            asm volatile("s_waitcnt lgkmcnt(0)" ::: "memory");
            const int row = cb + 16 * t + C.lane;
            if (C.lane < 16 && row < wend) {
                LAS const float* wm = wl + C.lane * 48;
                float lg[36];
#pragma unroll
                for (int c = 0; c < 36; ++c) lg[c] = wm[c];
                float gl[4]; int grp = 0; float gm = -3.0e38f;
#pragma unroll
                for (int c = 0; c < 4; ++c) { gl[c] = lg[c] + bg[c]; if (gl[c] > gm) { gm = gl[c]; grp = c; } }
                float gs = 0.f;
#pragma unroll
                for (int c = 0; c < 4; ++c) gs += __expf(gl[c] - gm);
                const float pgrp = 1.0f / gs;
                float rl[8];
#pragma unroll
                for (int i = 0; i < 8; ++i) { float tt = 0.f;
#pragma unroll
                    for (int g = 0; g < 4; ++g) tt = (g == grp) ? lg[4 + g * 8 + i] : tt;
                    rl[i] = tt + br[grp * 8 + i]; }
                int i0 = 0; float m0 = rl[0];
#pragma unroll
                for (int i = 1; i < 8; ++i) if (rl[i] > m0) { m0 = rl[i]; i0 = i; }
                int i1 = -1; float m1 = -3.0e38f;
#pragma unroll
                for (int i = 0; i < 8; ++i) if (i != i0 && rl[i] > m1) { m1 = rl[i]; i1 = i; }
                const float p0 = 1.0f, p1 = __expf(m1 - m0);
                const float w0 = pgrp * p0 / (p0 + p1), w1 = pgrp * p1 / (p0 + p1);
                const int e0 = grp * 8 + i0, e1 = grp * 8 + i1;
                const unsigned q0 = __hip_atomic_fetch_add(hist + e0, 1u, __ATOMIC_RELAXED, __HIP_MEMORY_SCOPE_WORKGROUP), q1 = __hip_atomic_fetch_add(hist + e1, 1u, __ATOMIC_RELAXED, __HIP_MEMORY_SCOPE_WORKGROUP);
                const int li = row - cb;
                rec[li * 4 + 0] = e0 | (e1 << 8); rec[li * 4 + 1] = (int)q0; rec[li * 4 + 2] = (int)q1;
                TW[row * 2 + 0] = w0; TW[row * 2 + 1] = w1;
            }
        }
        __syncthreads();
        if (C.tid < 32) gbase[C.tid] = hist[C.tid] ? atomicAdd(cnt + C.tid * CNT_STRIDE, hist[C.tid]) : 0u;
        __syncthreads();
        for (int i = C.tid; i < wend - cb; i += NT) { const int row = cb + i; const int ee = rec[i * 4], e0 = ee & 255, e1 = ee >> 8;
            const unsigned q0 = gbase[e0] + (unsigned)rec[i * 4 + 1], q1 = gbase[e1] + (unsigned)rec[i * 4 + 2];
            ST[(size_t)e0 * CAP + q0] = row; ST[(size_t)e1 * CAP + q1] = row;
            TS[row * 2 + 0] = (e0 << 20) | (int)q0; TS[row * 2 + 1] = (e1 << 20) | (int)q1; }
        __syncthreads();
    }
}

__device__ __forceinline__ void phase_final(const Args& A, const Ctx& C) {
    LAS int* sb = (LAS int*)C.lds;
    slot_bases(A, 3, sb, C.tid);
    const bf16* LAT = (const bf16*)(A.ws + WS_LAT); const bf16* Y = (const bf16*)(A.ws + WS_PB);
    const int* TS = (const int*)(A.ws + WS_TOKSLOT); const float* TW = (const float*)(A.ws + WS_TOKW);
    const float* MOD = (const float*)(A.ws + WS_MOD);
    f32x4 fg[4]; load_row_f32(A.in[7], C.lane, fg);
    const int rpw = (((NL + C.G - 1) / C.G) + 1) & ~1; const int wrow0 = C.bid * rpw; const int wend = min(wrow0 + rpw, NL);
    for (int sa = wrow0; sa < wend;) {
        const int mvi = mod_vec_of_row(sa); const int sbnd = min(wend, mvi == 0 ? SEQ : NL);
        f32x4 g2[4]; load_row_f32(MOD + (size_t)(3 * 3 + mvi) * 6 * D + 5 * D, C.lane, g2);
        for (int ra = sa + 2 * C.wave; ra < sbnd; ra += 2 * NW) {
            const int rb = ra + 1;
            const int ta0 = TS[ra * 2], ta1 = TS[ra * 2 + 1], tb0 = TS[rb * 2], tb1 = TS[rb * 2 + 1]; const float wa0 = TW[ra * 2], wa1 = TW[ra * 2 + 1], wb0 = TW[rb * 2], wb1 = TW[rb * 2 + 1];
            f32x4 va[4], vb[4]; u32x2 ya0[4], ya1[4], yb0[4], yb1[4];
            load_row_bf16(LAT + (size_t)ra * D, C.lane, va); load_row_bf16(LAT + (size_t)rb * D, C.lane, vb);
            load_row_bf16raw(Y + (size_t)(sb[ta0 >> 20] + (ta0 & 0xfffff)) * D, C.lane, ya0); load_row_bf16raw(Y + (size_t)(sb[ta1 >> 20] + (ta1 & 0xfffff)) * D, C.lane, ya1);
            load_row_bf16raw(Y + (size_t)(sb[tb0 >> 20] + (tb0 & 0xfffff)) * D, C.lane, yb0); load_row_bf16raw(Y + (size_t)(sb[tb1 >> 20] + (tb1 & 0xfffff)) * D, C.lane, yb1);
#pragma unroll
            for (int q = 0; q < 4; ++q) { va[q] += g2[q] * (bf4(ya0[q]) * wa0 + bf4(ya1[q]) * wa1); vb[q] += g2[q] * (bf4(yb0[q]) * wb0 + bf4(yb1[q]) * wb1); }
            const float rra = row_rstd(va), rrb = row_rstd(vb);
#pragma unroll
            for (int q = 0; q < 4; ++q) { *(f32x4*)(A.out + (size_t)ra * D + 4 * C.lane + 256 * q) = (va[q] * rra) * fg[q]; *(f32x4*)(A.out + (size_t)rb * D + 4 * C.lane + 256 * q) = (vb[q] * rrb) * fg[q]; }
        }
        sa = sbnd;
    }
}

__device__ __forceinline__ void phase_conv(const Args& A, const Ctx& C, int l) {
    const int j = l >> 1; const int nrows = (l <= 1) ? NR : NL;
    const bf16* P = (const bf16*)(A.ws + WS_PB); bf16* HM = (bf16*)(A.ws + WS_HM);
    const float* cw = A.in[13] + (size_t)j * 3 * D;
    for (int row = C.bid * NW + C.wave; row < nrows; row += C.G * NW) {
        bool hasl, hasr;
        if (row < NL) { const int t = row & 63; hasl = t != 0; hasr = t != 63; } else { const int t = (row - NL) & 255; hasl = t != 0; hasr = t != 255; }
        f32x4 bg[4], z[4], w0[4], w1[4], w2[4], acc[4];
        const bf16* pr = P + (size_t)row * PW;
        load_row_bf16(pr, C.lane, bg); load_row_bf16(pr + D, C.lane, z);
        load_row_f32(cw, C.lane, w0); load_row_f32(cw + D, C.lane, w1); load_row_f32(cw + 2 * D, C.lane, w2);
#pragma unroll
        for (int q = 0; q < 4; ++q) acc[q] = w1[q] * z[q];
        if (hasl) { load_row_bf16(pr - PW + D, C.lane, z);
#pragma unroll
            for (int q = 0; q < 4; ++q) acc[q] += w0[q] * z[q]; }
        if (hasr) { load_row_bf16(pr + PW + D, C.lane, z);
#pragma unroll
            for (int q = 0; q < 4; ++q) acc[q] += w2[q] * z[q]; }
#pragma unroll
        for (int q = 0; q < 4; ++q) acc[q] *= bg[q];
        store_row_bf16(HM + (size_t)row * D, C.lane, acc);
    }
}

constexpr int BM = 256, BK = 64, HALF = 128, HTB = HALF * BK * 2, STAGE_BYTES = 8 * HTB, NXCD = 8, WGM = 8;
constexpr int LDS_TAB = STAGE_BYTES;
__device__ __forceinline__ int lds_byte(int r, int c) { const int st = (r >> 4) * 2 + (c >> 5), rr = r & 15, cc = c & 31, ob = rr * 64 + cc * 2; return st * 1024 + (ob ^ (((ob >> 9) & 1) << 5)); }
__device__ __forceinline__ void stage_rc(int b, int& R, int& C) { const int st = b / 1024, sb = b % 1024, swz = sb ^ (((sb >> 9) & 1) << 5); R = (st >> 1) * 16 + swz / 64; C = (st & 1) * 32 + (swz % 64) / 2; }
__device__ __forceinline__ int perm32(int rho) { const int n = rho >> 4, i = rho & 15; return 8 * (i >> 2) + 4 * n + (i & 3); }
__device__ __forceinline__ unsigned cvt_pk_bf16(float lo, float hi) { unsigned r; asm volatile("v_cvt_pk_bf16_f32 %0, %1, %2" : "=v"(r) : "v"(lo), "v"(hi)); return r; }

struct GUnit { const char* a; const char* b; int orow, ocol, aux; };

typedef int i32x8 __attribute__((ext_vector_type(8)));
typedef int i32x4 __attribute__((ext_vector_type(4)));
template <class Epi, class Sched, bool GATHER, bool FP8 = false>
__device__ __forceinline__ void gemm_phase(LAS unsigned char* lds, const int K, const Sched& S, const Epi& E) {
    const int tid = threadIdx.x, wid = __builtin_amdgcn_readfirstlane(tid >> 6), lane = tid & 63, wr = wid >> 2, wc = wid & 3, fr = lane & 15, fq = lane >> 4;
    const int RB = FP8 ? K : 2 * K;
    const int nt = RB / (BK * 2);
    unsigned voffB[2], voA[2][2]; int Rr[2], Cc[2];
#pragma unroll
    for (int i = 0; i < 2; ++i) { int R, C; stage_rc(tid * 16 + i * 8192, R, C); const int Rb = (R & ~31) + perm32(R & 31); Rr[i] = R; Cc[i] = C;
        voffB[i] = (unsigned)(Rb * RB + C * 2);
        voA[0][i] = (unsigned)(R * RB + C * 2); voA[1][i] = (unsigned)((R + HALF) * RB + C * 2); }
    const size_t kstep = (size_t)(BK * 2);
    const size_t hstep = (size_t)HALF * RB;
    const unsigned ldsw = (unsigned)wid * 1024u;
    const unsigned ldsbase = (unsigned)(size_t)lds;
    const int aoff = lds_byte(wr * 64 + fr, fq * 8), boff = lds_byte(wc * 32 + fr, fq * 8);
#define PG8_SA(b, h) (((b) * 2 + (h)) * HTB)
#define PG8_SB(b, h) ((4 + (b) * 2 + (h)) * HTB)
#define PG8_STAGE(bufoff, gbase, voff) do { _Pragma("unroll") for (int _i = 0; _i < 2; ++_i) \
        asm volatile("s_mov_b32 m0, %2\n\ts_nop 0\n\tglobal_load_lds_dwordx4 %0, %1" :: "v"((voff)[_i]), "s"((const char*)(gbase)), "s"(ldsbase + (unsigned)(bufoff) + ldsw + (unsigned)(_i * 8192)) : "memory"); } while (0)
#define PG8_STAGE_A1(bufoff, gbase) do { if constexpr (GATHER) PG8_STAGE(bufoff, gbase, voA[1]); else PG8_STAGE(bufoff, (const char*)(gbase) + hstep, voA[0]); } while (0)
#define PG8_LDA(dst, b, h) do { if constexpr (FP8) { _Pragma("unroll") for (int m = 0; m < 4; ++m) { \
        const i32x4 _lo = *(const LAS i32x4*)(lds + PG8_SA(b, h) + aoff + m * 2048), _hi = *(const LAS i32x4*)(lds + PG8_SA(b, h) + aoff + m * 2048 + 1024); \
        dst##8[m] = __builtin_shufflevector(_lo, _hi, 0, 1, 2, 3, 4, 5, 6, 7); } } \
      else { _Pragma("unroll") for (int m = 0; m < 4; ++m) _Pragma("unroll") for (int k = 0; k < 2; ++k) dst[m][k] = *(const LAS bf16x8*)(lds + PG8_SA(b, h) + aoff + m * 2048 + k * 1024); } } while (0)
#define PG8_LDB(dst, b, h) do { if constexpr (FP8) { _Pragma("unroll") for (int n = 0; n < 2; ++n) { \
        const i32x4 _lo = *(const LAS i32x4*)(lds + PG8_SB(b, h) + boff + n * 2048), _hi = *(const LAS i32x4*)(lds + PG8_SB(b, h) + boff + n * 2048 + 1024); \
        dst##8[n] = __builtin_shufflevector(_lo, _hi, 0, 1, 2, 3, 4, 5, 6, 7); } } \
      else { _Pragma("unroll") for (int n = 0; n < 2; ++n) _Pragma("unroll") for (int k = 0; k < 2; ++k) dst[n][k] = *(const LAS bf16x8*)(lds + PG8_SB(b, h) + boff + n * 2048 + k * 1024); } } while (0)
#define PG8_MMA(ai, bj, At, Bt) do { __builtin_amdgcn_s_setprio(1); \
        if constexpr (FP8) { _Pragma("unroll") for (int m = 0; m < 4; ++m) _Pragma("unroll") for (int n = 0; n < 2; ++n) \
            acc[ai][bj][m][n] = __builtin_amdgcn_mfma_scale_f32_16x16x128_f8f6f4(Bt##8[n], At##8[m], acc[ai][bj][m][n], 0, 0, 0, 0x7f7f7f7f, 0, 0x7f7f7f7f); } \
        else { _Pragma("unroll") for (int m = 0; m < 4; ++m) _Pragma("unroll") for (int n = 0; n < 2; ++n) _Pragma("unroll") for (int k = 0; k < 2; ++k) \
            acc[ai][bj][m][n] = __builtin_amdgcn_mfma_f32_16x16x32_bf16(Bt[n][k], At[m][k], acc[ai][bj][m][n], 0, 0, 0); } \
        __builtin_amdgcn_s_setprio(0); } while (0)
#define PG8_WAIT_V(n) asm volatile("s_waitcnt vmcnt(" #n ")" ::: "memory")
#define PG8_WAIT_L(n) asm volatile("s_waitcnt lgkmcnt(" #n ")" ::: "memory")
#define PG8_BAR __builtin_amdgcn_s_barrier()
#define PG8_SCHED __builtin_amdgcn_sched_barrier(0)
    GUnit cur, nxt; int ui = 0;
    if (!S.next(0, cur)) return;
    if constexpr (GATHER) {
#pragma unroll
        for (int h = 0; h < 2; ++h)
#pragma unroll
            for (int i = 0; i < 2; ++i) voA[h][i] = S.arow_off(0, h * HALF + Rr[i]) + (unsigned)Cc[i] * 2u;
    }
    f32x4 acc[2][2][4][2];
#pragma unroll
    for (int a = 0; a < 2; ++a)
#pragma unroll
        for (int b = 0; b < 2; ++b)
#pragma unroll
            for (int m = 0; m < 4; ++m)
#pragma unroll
                for (int n = 0; n < 2; ++n) acc[a][b][m][n] = (f32x4){0.f, 0.f, 0.f, 0.f};
    bf16x8 At[4][2], B0[2][2], B1[2][2]; i32x8 At8[4], B08[2], B18[2];
    const char* cA = cur.a; const char* cB = cur.b;
    PG8_STAGE(PG8_SB(0, 0), cB, voffB); PG8_STAGE(PG8_SB(0, 1), cB + hstep, voffB); PG8_STAGE(PG8_SA(0, 0), cA, voA[0]); PG8_STAGE_A1(PG8_SA(0, 1), cA);
    if (wr == 1) PG8_BAR;
    PG8_WAIT_V(2); PG8_BAR;
    PG8_STAGE(PG8_SB(1, 0), cB + kstep, voffB); PG8_STAGE(PG8_SA(1, 0), cA + kstep, voA[0]); PG8_STAGE(PG8_SB(1, 1), cB + hstep + kstep, voffB);
    PG8_WAIT_V(6); PG8_BAR;
    for (;;) {
        const bool has_next = S.next(ui + 1, nxt);
        const char* nA = has_next ? nxt.a : cA; const char* nB = has_next ? nxt.b : cB;
#pragma unroll 1
        for (int t = 0; t < nt; t += 2) {
            const bool last = (t == nt - 2);
            const char* a1 = cA + (size_t)(t + 1) * kstep;
            const char* a2 = last ? nA : cA + (size_t)(t + 2) * kstep; const char* b2 = last ? nB : cB + (size_t)(t + 2) * kstep;
            const char* a3 = a2 + kstep; const char* b3 = b2 + kstep;
            PG8_LDB(B0, 0, 0); PG8_LDB(B1, 0, 1); PG8_SCHED; PG8_LDA(At, 0, 0); PG8_STAGE_A1(PG8_SA(1, 1), a1);
            if constexpr (GATHER) { if (last && has_next) {
#pragma unroll
                for (int h = 0; h < 2; ++h)
#pragma unroll
                    for (int i = 0; i < 2; ++i) { int R2, C2; stage_rc(tid * 16 + i * 8192, R2, C2); voA[h][i] = S.arow_off(ui + 1, h * HALF + R2) + (unsigned)C2 * 2u; } } }
            PG8_WAIT_V(8); PG8_WAIT_L(0); PG8_BAR; PG8_MMA(0, 0, At, B0); PG8_MMA(0, 1, At, B1); PG8_BAR; PG8_SCHED;
            PG8_LDA(At, 0, 1); PG8_STAGE(PG8_SB(0, 0), b2, voffB); PG8_STAGE(PG8_SB(0, 1), b2 + hstep, voffB); PG8_STAGE(PG8_SA(0, 0), a2, voA[0]);
            PG8_WAIT_V(8); PG8_WAIT_L(0); PG8_BAR; PG8_MMA(1, 0, At, B0); PG8_MMA(1, 1, At, B1); PG8_BAR; PG8_SCHED;
            PG8_LDB(B0, 1, 0); PG8_LDB(B1, 1, 1); PG8_SCHED; PG8_LDA(At, 1, 0); PG8_STAGE_A1(PG8_SA(0, 1), a2);
            PG8_WAIT_V(8); PG8_WAIT_L(0); PG8_BAR; PG8_MMA(0, 0, At, B0); PG8_MMA(0, 1, At, B1); PG8_BAR; PG8_SCHED;
            PG8_LDA(At, 1, 1); PG8_STAGE(PG8_SB(1, 0), b3, voffB); PG8_STAGE(PG8_SB(1, 1), b3 + hstep, voffB); PG8_STAGE(PG8_SA(1, 0), a3, voA[0]);
            PG8_WAIT_V(8); PG8_WAIT_L(0); PG8_BAR; PG8_MMA(1, 0, At, B0); PG8_MMA(1, 1, At, B1); PG8_BAR; PG8_SCHED;
        }
        if (wr == 0) PG8_BAR;
        { int tz = threadIdx.x; asm volatile("" : "+v"(tz));
          const int wz = tz >> 6, lz = tz & 63; E(acc, cur, wz >> 2, wz & 3, lz & 15, lz >> 4); }
        if (!has_next) break;
#pragma unroll
        for (int a = 0; a < 2; ++a)
#pragma unroll
            for (int b = 0; b < 2; ++b)
#pragma unroll
                for (int m = 0; m < 4; ++m)
#pragma unroll
                    for (int n = 0; n < 2; ++n) acc[a][b][m][n] = (f32x4){0.f, 0.f, 0.f, 0.f};
        cur = nxt; cA = nA; cB = nB; ++ui;
        if (wr == 1) PG8_BAR;
    }
    PG8_WAIT_V(0);
    PG8_BAR;
#undef PG8_SA
#undef PG8_SB
#undef PG8_STAGE
#undef PG8_STAGE_A1
#undef PG8_LDA
#undef PG8_LDB
#undef PG8_MMA
#undef PG8_WAIT_V
#undef PG8_WAIT_L
#undef PG8_BAR
#undef PG8_SCHED
}

__device__ __forceinline__ int xcd_remap(int L, int nwg) { const int q = nwg / NXCD, r = nwg % NXCD, xcd = L % NXCD, off = L / NXCD; return (xcd < r ? xcd * (q + 1) : r * (q + 1) + (xcd - r) * q) + off; }

struct DenseSched {
    const char* A; const char* Bt; int nM, nN, nwg, G, c; size_t tstep; int sw_lo, sw_hi;
    __device__ __forceinline__ void init(const void* A_, const void* Bt_, int M, int N, int K, int G_, int c_) { A = (const char*)A_; Bt = (const char*)Bt_; nM = M / BM; nN = N / BM; nwg = nM * nN; G = G_; c = c_; tstep = (size_t)BM * K * 2; sw_lo = 0; sw_hi = 0; }
    __device__ __forceinline__ bool next(int i, GUnit& u) const {
        const long L = (long)i * G + c; if (L >= nwg) return false;
        const int wgid = xcd_remap((int)L, nwg);
        const int nig = WGM * nN, gid = wgid / nig, fm = gid * WGM, gsz = (nM - fm) < WGM ? (nM - fm) : WGM;
        const int pm = fm + ((wgid % nig) % gsz), pn = (wgid % nig) / gsz;
        if (pn >= sw_lo && pn < sw_hi) { u.a = Bt + (size_t)pn * tstep; u.b = A + (size_t)pm * tstep; u.orow = pm; u.ocol = pn - sw_lo; u.aux = 1; }
        else { u.a = A + (size_t)pm * tstep; u.b = Bt + (size_t)pn * tstep; u.orow = pm * BM; u.ocol = pn * BM; u.aux = 0; }
        return true;
    }
    __device__ __forceinline__ unsigned arow_off(int, int) const { return 0u; }
};

constexpr int MAXU = 12;
struct MoeTab { int n; int e[MAXU], mb[MAXU], nt[MAXU]; int sb[NE + 1]; };
struct MoeSched {
    LAS const MoeTab* T; LAS const unsigned* ridx;
    const char* A; const char* W; size_t wstride_e, tstepB; int K; int arow_bytes;
    __device__ __forceinline__ bool next(int i, GUnit& u) const {
        const int n = __builtin_amdgcn_readfirstlane(T->n); if (i >= n) return false;
        const int e = __builtin_amdgcn_readfirstlane(T->e[i]), mb = __builtin_amdgcn_readfirstlane(T->mb[i]), nt = __builtin_amdgcn_readfirstlane(T->nt[i]);
        const int base = __builtin_amdgcn_readfirstlane(T->sb[e]);
        u.orow = base + mb * BM; u.ocol = nt; u.aux = e;
        u.a = A + (size_t)u.orow * arow_bytes;
        u.b = W + (size_t)e * wstride_e + (size_t)nt * tstepB; return true;
    }
    __device__ __forceinline__ unsigned arow_off(int i, int r) const { return ridx[i * 256 + r]; }
};
template <bool GATHER>
__device__ __forceinline__ void moe_tables(const Args& A, const Ctx& C, int l, int ntile_n, LAS MoeTab* T, LAS unsigned* ridx, int arow_bytes) {
    const unsigned* cnt = (const unsigned*)(A.ws + WS_CTL) + CW_CNT + l * 32 * CNT_STRIDE;
    LAS int* ust = (LAS int*)(T + 1);
    if (C.tid == 0) { int acc = 0, ua = 0; for (int e = 0; e < NE; ++e) { T->sb[e] = acc; ust[e] = ua; const int nb = ((int)cnt[e * CNT_STRIDE] + 255) / 256; acc += nb * 256; ua += nb * ntile_n; } T->sb[NE] = acc; ust[NE] = ua;
        const int nwg = ua; int n = 0;
        for (int i = 0; i < MAXU; ++i) { const long L = (long)i * C.G + C.bid; if (L >= nwg) break; const int w = xcd_remap((int)L, nwg); int e = 0; while (w >= ust[e + 1]) ++e;
            const int lu = w - ust[e]; T->e[i] = e; T->mb[i] = lu / ntile_n; T->nt[i] = lu % ntile_n; ++n; }
        T->n = n; }
    __syncthreads();
    if constexpr (GATHER) {
        const int* ST = (const int*)(A.ws + WS_SLOTTOK); const int n = T->n;
        for (int i = C.tid; i < n * 256; i += NT) { const int ui = i >> 8, r = i & 255, e = T->e[ui], m0 = T->mb[ui] * 256, ce = (int)cnt[e * CNT_STRIDE];
            const int rr = (m0 + r < ce) ? m0 + r : ce - 1;
            ridx[i] = (unsigned)ST[(size_t)e * CAP + rr] * (unsigned)arow_bytes; }
        __syncthreads();
    }
}

struct EpiStore { bf16* O; int ldc; float scale_lo; int sig_from; bf16* VT;
    __device__ __forceinline__ void operator()(const f32x4 (&acc)[2][2][4][2], const GUnit& u, int wr, int wc, int fr, int fq) const {
        const bool tr = u.aux != 0;
        const float sc = (!tr && u.ocol < NQ) ? scale_lo : 1.0f; const bool sg = !tr && u.ocol >= sig_from;
        bf16* Ob = tr ? VT + (size_t)(u.orow * NH + u.ocol) * 65536 : O + (size_t)u.orow * ldc + u.ocol; const int ld = tr ? 256 : ldc;
#pragma unroll
        for (int ai = 0; ai < 2; ++ai)
#pragma unroll
            for (int m = 0; m < 4; ++m) { bf16* rowp = Ob + (size_t)(ai * HALF + wr * 64 + m * 16 + fr) * ld + wc * 32 + 8 * fq;
#pragma unroll
                for (int bj = 0; bj < 2; ++bj) { f32x4 v0 = acc[ai][bj][m][0] * sc, v1 = acc[ai][bj][m][1] * sc;
                    if (sg) {
#pragma unroll
                        for (int q = 0; q < 4; ++q) { v0[q] = __builtin_amdgcn_rcpf(1.0f + __expf(-v0[q])); v1[q] = __builtin_amdgcn_rcpf(1.0f + __expf(-v1[q])); } }
                    u32x4 w; w.x = cvt_pk_bf16(v0[0], v0[1]); w.y = cvt_pk_bf16(v0[2], v0[3]); w.z = cvt_pk_bf16(v1[0], v1[1]); w.w = cvt_pk_bf16(v1[2], v1[3]);
                    *(u32x4*)(rowp + bj * HALF) = w; } }
    }
};
__device__ __forceinline__ u32x2 cvt8_fp8(f32x4 a, f32x4 b) { int lo = 0, hi = 0;
    lo = __builtin_amdgcn_cvt_pk_fp8_f32(a[0], a[1], lo, false); lo = __builtin_amdgcn_cvt_pk_fp8_f32(a[2], a[3], lo, true);
    hi = __builtin_amdgcn_cvt_pk_fp8_f32(b[0], b[1], hi, false); hi = __builtin_amdgcn_cvt_pk_fp8_f32(b[2], b[3], hi, true); return (u32x2){(unsigned)lo, (unsigned)hi}; }
struct EpiSwigluF8 { unsigned char* O; int ldc; float s;
    __device__ __forceinline__ void operator()(const f32x4 (&acc)[2][2][4][2], const GUnit& u, int wr, int wc, int fr, int fq) const {
        const int ocol = u.ocol * HALF;
#pragma unroll
        for (int ai = 0; ai < 2; ++ai)
#pragma unroll
            for (int m = 0; m < 4; ++m) { unsigned char* rowp = O + (size_t)(u.orow + ai * HALF + wr * 64 + m * 16 + fr) * ldc + ocol + wc * 32 + 8 * fq;
                f32x4 v0, v1;
#pragma unroll
                for (int q = 0; q < 4; ++q) { const float x0 = acc[ai][0][m][0][q] * s, x1 = acc[ai][0][m][1][q] * s;
                    v0[q] = x0 * __builtin_amdgcn_rcpf(1.0f + __expf(-x0)) * (acc[ai][1][m][0][q] * s); v1[q] = x1 * __builtin_amdgcn_rcpf(1.0f + __expf(-x1)) * (acc[ai][1][m][1][q] * s); }
                *(u32x2*)rowp = cvt8_fp8(v0, v1); }
    }
};
template <int MODE> struct EpiPair { bf16* O; int ldc; int plain_below;
    __device__ __forceinline__ void operator()(const f32x4 (&acc)[2][2][4][2], const GUnit& u, int wr, int wc, int fr, int fq) const {
        if (MODE == 0 && u.ocol < plain_below) {
#pragma unroll
            for (int ai = 0; ai < 2; ++ai)
#pragma unroll
                for (int m = 0; m < 4; ++m) { bf16* rowp = O + (size_t)(u.orow + ai * HALF + wr * 64 + m * 16 + fr) * ldc + u.ocol + wc * 32 + 8 * fq;
#pragma unroll
                    for (int bj = 0; bj < 2; ++bj) { const f32x4 v0 = acc[ai][bj][m][0], v1 = acc[ai][bj][m][1];
                        u32x4 w; w.x = cvt_pk_bf16(v0[0], v0[1]); w.y = cvt_pk_bf16(v0[2], v0[3]); w.z = cvt_pk_bf16(v1[0], v1[1]); w.w = cvt_pk_bf16(v1[2], v1[3]);
                        *(u32x4*)(rowp + bj * HALF) = w; } }
            return;
        }
        const int ocol = (MODE == 0) ? plain_below + (u.ocol - plain_below) / 2 : u.ocol * HALF;
#pragma unroll
        for (int ai = 0; ai < 2; ++ai)
#pragma unroll
            for (int m = 0; m < 4; ++m) { bf16* rowp = O + (size_t)(u.orow + ai * HALF + wr * 64 + m * 16 + fr) * ldc + ocol + wc * 32 + 8 * fq;
                f32x4 v0, v1;
#pragma unroll
                for (int q = 0; q < 4; ++q) {
                    const float x0 = acc[ai][0][m][0][q], x1 = acc[ai][0][m][1][q];
                    const float g0 = (MODE == 1) ? x0 * __builtin_amdgcn_rcpf(1.0f + __expf(-x0)) : x0, g1 = (MODE == 1) ? x1 * __builtin_amdgcn_rcpf(1.0f + __expf(-x1)) : x1;
                    v0[q] = g0 * acc[ai][1][m][0][q]; v1[q] = g1 * acc[ai][1][m][1][q]; }
                u32x4 w; w.x = cvt_pk_bf16(v0[0], v0[1]); w.y = cvt_pk_bf16(v0[2], v0[3]); w.z = cvt_pk_bf16(v1[0], v1[1]); w.w = cvt_pk_bf16(v1[2], v1[3]);
                *(u32x4*)rowp = w; }
    }
};
struct EpiStoreTile { bf16* O; int ldc; float s;
    __device__ __forceinline__ void operator()(const f32x4 (&acc)[2][2][4][2], const GUnit& u, int wr, int wc, int fr, int fq) const {
#pragma unroll
        for (int ai = 0; ai < 2; ++ai)
#pragma unroll
            for (int m = 0; m < 4; ++m) { bf16* rowp = O + (size_t)(u.orow + ai * HALF + wr * 64 + m * 16 + fr) * ldc + u.ocol * BM + wc * 32 + 8 * fq;
#pragma unroll
                for (int bj = 0; bj < 2; ++bj) { const f32x4 v0 = acc[ai][bj][m][0] * s, v1 = acc[ai][bj][m][1] * s;
                    u32x4 w; w.x = cvt_pk_bf16(v0[0], v0[1]); w.y = cvt_pk_bf16(v0[2], v0[3]); w.z = cvt_pk_bf16(v1[0], v1[1]); w.w = cvt_pk_bf16(v1[2], v1[3]);
                    *(u32x4*)(rowp + bj * HALF) = w; } }
    }
};

__device__ __forceinline__ void transpose_item(const float* W, int ldw, int K, bf16* WT, int drow0, int k0, int n0, LAS float* scr, int lane) {
#pragma unroll
    for (int i = 0; i < 32; ++i) { const int kk = 2 * i + (lane >> 5); scr[kk * 33 + (lane & 31)] = W[(size_t)(k0 + kk) * ldw + n0 + (lane & 31)]; }
    asm volatile("s_waitcnt lgkmcnt(0)" ::: "memory");
    const int c = lane & 7;
#pragma unroll
    for (int j = 0; j < 4; ++j) { const int n = (lane >> 3) + 8 * j; const LAS float* s = scr + (8 * c) * 33 + n;
        u32x4 o; o.x = pk2(s[0 * 33], s[1 * 33]); o.y = pk2(s[2 * 33], s[3 * 33]); o.z = pk2(s[4 * 33], s[5 * 33]); o.w = pk2(s[6 * 33], s[7 * 33]);
        *(u32x4*)(WT + (size_t)(drow0 + n) * K + k0 + 8 * c) = o; }
    asm volatile("s_waitcnt lgkmcnt(0)" ::: "memory");
}
__device__ __forceinline__ void transpose_item_fp8(const float* W, int ldw, int K, unsigned char* WT8, int drow0, int k0, int n0, LAS float* scr, int lane, float sc) {
#pragma unroll
    for (int i = 0; i < 32; ++i) { const int kk = 2 * i + (lane >> 5); scr[kk * 33 + (lane & 31)] = W[(size_t)(k0 + kk) * ldw + n0 + (lane & 31)]; }
    asm volatile("s_waitcnt lgkmcnt(0)" ::: "memory");
    const int n = lane >> 1, half = lane & 1; const LAS float* sp = scr + (32 * half) * 33 + n;
    unsigned char* dst = WT8 + (size_t)(drow0 + n) * K + k0 + 32 * half;
#pragma unroll
    for (int c = 0; c < 2; ++c) { u32x4 o;
#pragma unroll
        for (int q = 0; q < 4; ++q) { int p = 0; const LAS float* s4 = sp + (16 * c + 4 * q) * 33;
            p = __builtin_amdgcn_cvt_pk_fp8_f32(s4[0] * sc, s4[33] * sc, p, false); p = __builtin_amdgcn_cvt_pk_fp8_f32(s4[66] * sc, s4[99] * sc, p, true); o[q] = (unsigned)p; }
        *(u32x4*)(dst + 16 * c) = o; }
    asm volatile("s_waitcnt lgkmcnt(0)" ::: "memory");
}
__device__ __forceinline__ int pair_row(int n, int which) { return (n >> 7) * 256 + (n & 127) + which * 128; }
__device__ __forceinline__ void phase_cvt_mixer(const Args& A, const Ctx& C) {
    LAS float* scr = (LAS float*)(C.lds + 16384 + C.wave * 16384);
    const int gw = C.bid * NW + C.wave, NGW = C.G * NW;
    constexpr int I_IN = (D / 64) * (PW / 32), I_OUT = (D / 64) * (D / 32), PER = 2 * (I_IN + I_OUT);
    for (int it = gw; it < 2 * PER; it += NGW) {
        const int kind = it / PER; int r = it % PER; const int j = r / (I_IN + I_OUT); r %= (I_IN + I_OUT);
        if (r < I_IN) { const int kb = r / (PW / 32), nb = r % (PW / 32), n0 = nb * 32;
            bf16* WT = (bf16*)(A.ws + (kind == 0 ? WS_WAIN : WS_WBIN)) + (size_t)j * PW * D;
            if (kind == 0) transpose_item(A.in[8] + (size_t)j * D * PROJ, PROJ, D, WT, n0, kb * 64, n0, scr, C.lane);
            else { const int drow = n0 < D ? n0 : (n0 < 2 * D ? D + pair_row(n0 - D, 0) : D + pair_row(n0 - 2 * D, 1));
                transpose_item(A.in[12] + (size_t)j * D * PW, PW, D, WT, drow, kb * 64, n0, scr, C.lane); } }
        else { r -= I_IN; const int kb = r / (D / 32), nb = r % (D / 32), n0 = nb * 32;
            bf16* WT = (bf16*)(A.ws + (kind == 0 ? WS_WAOUT : WS_WBOUT)) + (size_t)j * D * D;
            transpose_item((kind == 0 ? A.in[11] : A.in[14]) + (size_t)j * D * D, D, D, WT, n0, kb * 64, n0, scr, C.lane); }
    }
}
constexpr float WSCALE = 32.0f;
__device__ __forceinline__ void cvt_moe_items(const Args& A, const Ctx& C, int l, int it0, int end, int stride) {
    LAS float* scr = (LAS float*)(C.lds + 16384 + C.wave * 16384);
    unsigned char* WGU = A.ws + WS_WGU; unsigned char* WDN = A.ws + WS_WDN;
    for (int it = it0; it < end; it += stride) {
        const int e = it / CVT_PER; int r = it % CVT_PER;
        if (r < 2 * CVT_IG) { const int which = r / CVT_IG; r %= CVT_IG; const int kb = r / (DE / 32), nb = r % (DE / 32), n0 = nb * 32;
            transpose_item_fp8((which == 0 ? A.in[19] : A.in[20]) + ((size_t)l * NE + e) * D * DE, DE, D, WGU + (size_t)e * 2 * DE * D, pair_row(n0, which), kb * 64, n0, scr, C.lane, WSCALE); }
        else { r -= 2 * CVT_IG; const int kb = r / (D / 32), nb = r % (D / 32), n0 = nb * 32;
            transpose_item_fp8(A.in[21] + ((size_t)l * NE + e) * DE * D, D, DE, WDN + (size_t)e * D * DE, n0, kb * 64, n0, scr, C.lane, WSCALE); }
    }
}
__device__ __forceinline__ int cvt_idle(int nunits, int G) { const int rem = nunits % G; return rem ? G - rem : 0; }
__device__ __forceinline__ int cvt_t1(int l, int G) { const int n = cvt_idle((((l <= 2) ? NR : NL) / BM) * (PW / BM), G) * CVT_Q; return n < CVT_ITEMS ? n : CVT_ITEMS; }
__device__ __forceinline__ int cvt_t2(int l, int G) { const int n = cvt_t1(l, G) + cvt_idle((((l <= 1) ? NR : NL) / BM) * (D / BM), G) * CVT_Q; return n < CVT_ITEMS ? n : CVT_ITEMS; }
__device__ __forceinline__ void cvt_moe_tail(const Args& A, const Ctx& C, int l, int nunits, int base, int end) {
    const int rem = nunits % C.G;
    if (rem == 0 || C.bid < rem) return;
    const int first = base + (C.bid - rem) * CVT_Q; const int last = min(first + CVT_Q, end);
    cvt_moe_items(A, C, l, first + C.wave, last, NW);
}

__device__ __forceinline__ void phase_g1(const Args& A, const Ctx& C, int l) {
    const bool mls = (l & 1) == 0; const int j = l >> 1; const int nrows = (l <= 2) ? NR : NL;
    DenseSched S; S.init(A.ws + WS_HB, A.ws + (mls ? WS_WAIN : WS_WBIN) + (size_t)j * PW * D * 2, nrows, PW, D, C.G, C.bid);
    if (mls) { S.sw_lo = 4; S.sw_hi = 8; EpiStore E{(bf16*)(A.ws + WS_PB), PW, 0.08838834764831845f, 2 * NQ + NV, (bf16*)(A.ws + WS_VT)}; gemm_phase<EpiStore, DenseSched, false>(C.lds, D, S, E); }
    else { EpiPair<0> E{(bf16*)(A.ws + WS_PB), PW, D}; gemm_phase<EpiPair<0>, DenseSched, false>(C.lds, D, S, E); }
    cvt_moe_tail(A, C, l, S.nwg, 0, cvt_t1(l, C.G));
}
__device__ __forceinline__ void phase_g2(const Args& A, const Ctx& C, int l) {
    const bool mls = (l & 1) == 0; const int j = l >> 1; const int nrows = (l <= 1) ? NR : NL;
    DenseSched S; S.init(A.ws + WS_HM, A.ws + (mls ? WS_WAOUT : WS_WBOUT) + (size_t)j * D * D * 2, nrows, D, D, C.G, C.bid);
    EpiStore E{(bf16*)(A.ws + WS_HB), D, 1.0f, 1 << 30, nullptr}; gemm_phase<EpiStore, DenseSched, false>(C.lds, D, S, E);
    cvt_moe_tail(A, C, l, S.nwg, cvt_t1(l, C.G), cvt_t2(l, C.G));
}
__device__ __forceinline__ void phase_m1(const Args& A, const Ctx& C, int l) {
    LAS MoeTab* T = (LAS MoeTab*)(C.lds + LDS_TAB); LAS unsigned* ridx = (LAS unsigned*)(C.lds + LDS_TAB + 1024);
    moe_tables<true>(A, C, l, 4, T, ridx, D);
    MoeSched S; S.T = T; S.ridx = ridx; S.A = (const char*)(A.ws + WS_H8); S.W = (const char*)(A.ws + WS_WGU); S.wstride_e = (size_t)2 * DE * D; S.tstepB = (size_t)BM * D; S.K = D; S.arow_bytes = 0;
    EpiSwigluF8 E{A.ws + WS_DC, DE, 1.0f / WSCALE}; gemm_phase<EpiSwigluF8, MoeSched, true, true>(C.lds, D, S, E);
}
__device__ __forceinline__ void phase_m2(const Args& A, const Ctx& C, int l) {
    LAS MoeTab* T = (LAS MoeTab*)(C.lds + LDS_TAB); LAS unsigned* ridx = (LAS unsigned*)(C.lds + LDS_TAB + 1024);
    moe_tables<false>(A, C, l, 4, T, ridx, DE);
    MoeSched S; S.T = T; S.ridx = ridx; S.A = (const char*)(A.ws + WS_DC); S.W = (const char*)(A.ws + WS_WDN); S.wstride_e = (size_t)D * DE; S.tstepB = (size_t)BM * DE; S.K = DE; S.arow_bytes = DE;
    EpiStoreTile E{(bf16*)(A.ws + WS_PB), D, 1.0f / WSCALE}; gemm_phase<EpiStoreTile, MoeSched, false, true>(C.lds, DE, S, E);
}

typedef float f32x16 __attribute__((ext_vector_type(16)));
#define MFMA32(a, b, c) __builtin_amdgcn_mfma_f32_32x32x16_bf16((a), (b), (c), 0, 0, 0)
__device__ __forceinline__ bf16x8 pack8(float a0, float a1, float a2, float a3, float a4, float a5, float a6, float a7) {
    u32x4 p; p.x = cvt2(a0, a1); p.y = cvt2(a2, a3); p.z = cvt2(a4, a5); p.w = cvt2(a6, a7); return __builtin_bit_cast(bf16x8, p); }
__device__ __forceinline__ float bflo(unsigned w) { return __uint_as_float(w << 16); }
__device__ __forceinline__ float bfhi(unsigned w) { return __uint_as_float(w & 0xffff0000u); }
__device__ __forceinline__ int vt_tile(int b, int h, int blk) { return (blk == 0 ? 128 + b : b * 64 + blk - 1) * NH + h; }

__device__ __forceinline__ float wave_incl_scan(float v, int lane) {
#pragma unroll
    for (int o = 1; o < 64; o <<= 1) { const float t = __shfl_up(v, o); v += (lane >= o) ? t : 0.f; }
    return v;
}
__device__ __forceinline__ void block_gates(const Args& A, int row0, int h, LAS float* bf, LAS float* bb, LAS float* lif, LAS float* lib, int tid) {
    const float* GATE = (const float*)(A.ws + WS_GATE);
    if (tid < 256) { const float* g = GATE + (size_t)(row0 + tid) * 16; lif[tid] = g[0 + h]; bf[tid] = g[4 + h]; lib[tid] = g[8 + h]; bb[tid] = g[12 + h]; }
    __syncthreads();
    const int lane = tid & 63, wv = tid >> 6;
    if (wv == 0) { f32x4 x = *(LAS f32x4*)(bf + 4 * lane); x.y += x.x; x.z += x.y; x.w += x.z; const float tot = wave_incl_scan(x.w, lane); const float ex = tot - x.w;
        x.x += ex; x.y += ex; x.z += ex; x.w += ex; *(LAS f32x4*)(bf + 4 * lane) = x; }
    if (wv == 1) { f32x4 y = *(LAS f32x4*)(bb + 4 * (63 - lane)); y.z += y.w; y.y += y.z; y.x += y.y; const float tot = wave_incl_scan(y.x, lane); const float ex = tot - y.x;
        y.x += ex; y.y += ex; y.z += ex; y.w += ex; *(LAS f32x4*)(bb + 4 * (63 - lane)) = y; }
    __syncthreads();
}
__device__ __forceinline__ void phase_s1(const Args& A, const Ctx& C, int l) {
    LAS float* bf = (LAS float*)C.lds; LAS float* bb = bf + 256; LAS float* lif = bb + 256; LAS float* lib = lif + 256; LAS float* af = lib + 256; LAS float* ab = af + 256;
    constexpr int KP = 528;
    LAS unsigned char* KTf = C.lds + 8192; LAS unsigned char* KTb = KTf + 128 * KP;
    const bf16* P = (const bf16*)(A.ws + WS_PB); const bf16* VT = (const bf16*)(A.ws + WS_VT);
    float* DC = (float*)(A.ws + WS_DC); float* DN = (float*)(A.ws + WS_DN); float* BT = (float*)(A.ws + WS_BTOT);
    const int r = C.lane & 31, hh = C.lane >> 5, w = C.wave;
    for (int u = C.bid; u < NUNIT; u += C.G) {
        const int blk = u % NBLK, bh = u / NBLK, h = bh % NH, b = bh / NH; const int row0 = blk_row0(b, blk);
        block_gates(A, row0, h, bf, bb, lif, lib, C.tid);
        if (C.tid < 256) { af[C.tid] = __expf(bf[255] - bf[C.tid] + lif[C.tid]); ab[C.tid] = __expf(bb[0] - bb[C.tid] + lib[C.tid]); }
        if (C.tid == 0) { BT[u * 2 + 0] = bf[255]; BT[u * 2 + 1] = bb[0]; }
        __syncthreads();
        { const int sp = C.tid >> 2, dq = C.tid & 3, s0 = 2 * sp;
          const bf16* k0 = P + (size_t)(row0 + s0) * PW + NQ + h * DQK + 32 * dq;
          const float f0 = af[s0], f1 = af[s0 + 1], g0 = ab[s0], g1 = ab[s0 + 1];
#pragma unroll
          for (int c = 0; c < 4; ++c) { const u32x4 x0 = *(const u32x4*)(k0 + 8 * c), x1 = *(const u32x4*)(k0 + PW + 8 * c);
#pragma unroll
              for (int q = 0; q < 4; ++q) { const int d = 32 * dq + 8 * c + 2 * q;
                  const float a0 = bflo(x0[q]), a1 = bfhi(x0[q]), c0 = bflo(x1[q]), c1 = bfhi(x1[q]);
                  *(LAS unsigned*)(KTf + d * KP + s0 * 2) = cvt2(a0 * f0, c0 * f1); *(LAS unsigned*)(KTf + (d + 1) * KP + s0 * 2) = cvt2(a1 * f0, c1 * f1);
                  *(LAS unsigned*)(KTb + d * KP + s0 * 2) = cvt2(a0 * g0, c0 * g1); *(LAS unsigned*)(KTb + (d + 1) * KP + s0 * 2) = cvt2(a1 * g0, c1 * g1); } } }
        __syncthreads();
        if (C.tid < 256) { const int dir = C.tid >> 7, d = C.tid & 127; LAS const unsigned* kr = (LAS const unsigned*)((dir ? KTb : KTf) + d * KP); float s = 0.f;
            for (int i = 0; i < 128; ++i) { const unsigned x = kr[i]; s += bflo(x) + bfhi(x); }
            DN[(size_t)(u * 2 + dir) * DQK + d] = s; }
        const bf16* vt = VT + (size_t)vt_tile(b, h, blk) * 65536 + (size_t)(32 * w + r) * 256 + 8 * hh;
        f32x16 accf[4], accb[4];
#pragma unroll
        for (int dt = 0; dt < 4; ++dt)
#pragma unroll
            for (int i = 0; i < 16; ++i) { accf[dt][i] = 0.f; accb[dt][i] = 0.f; }
#pragma unroll 2
        for (int ks = 0; ks < 16; ++ks) { const bf16x8 a = *(const bf16x8*)(vt + 16 * ks);
#pragma unroll
            for (int dt = 0; dt < 4; ++dt) { const int off = (dt * 32 + r) * KP + (16 * ks + 8 * hh) * 2;
                const bf16x8 b0 = *(const LAS bf16x8*)(KTf + off), b1 = *(const LAS bf16x8*)(KTb + off);
                accf[dt] = MFMA32(a, b0, accf[dt]); accb[dt] = MFMA32(a, b1, accb[dt]); } }
        float* dcf = DC + (size_t)(u * 2 + 0) * DQK * DV + (size_t)(32 * w + 4 * hh) * DQK + r; float* dcb = dcf + DQK * DV;
#pragma unroll
        for (int g = 0; g < 4; ++g) { float* pf = dcf + g * 8 * DQK; float* pb = dcb + g * 8 * DQK; asm volatile("" : "+v"(pf), "+v"(pb));
#pragma unroll
            for (int q = 0; q < 4; ++q)
#pragma unroll
                for (int dt = 0; dt < 4; ++dt) { pf[q * DQK + dt * 32] = accf[dt][4 * g + q]; pb[q * DQK + dt * 32] = accb[dt][4 * g + q]; } }
        __syncthreads();
    }
}
__device__ __forceinline__ void phase_s2(const Args& A, const Ctx& C) {
    const float* __restrict__ DC = (const float*)(A.ws + WS_DC); const float* __restrict__ DN = (const float*)(A.ws + WS_DN); const float* __restrict__ BT = (const float*)(A.ws + WS_BTOT);
    bf16* __restrict__ CST = (bf16*)(A.ws + WS_CST); float* __restrict__ NST = (float*)(A.ws + WS_NST);
    constexpr int EL4 = DQK * DV / 4;
    for (int g = C.bid * NT + C.tid; g < BATCH * NH * 2 * EL4; g += C.G * NT) {
        const int e4 = (g % EL4) * 4, ch = g / EL4, dir = ch & 1, bh = ch >> 1;
        f32x4 st = (f32x4){0.f, 0.f, 0.f, 0.f};
#pragma unroll 13
        for (int idx = 0; idx < NBLK; ++idx) {
            const int blk = dir == 0 ? idx : (idx == 0 ? 0 : NBLK - idx); const int u = bh * NBLK + blk;
            const float dec = __expf(BT[u * 2 + dir]);
            const f32x4 dc = *(const f32x4*)(DC + (size_t)(u * 2 + dir) * DQK * DV + e4);
            u32x2 o; o.x = cvt2(st.x, st.y); o.y = cvt2(st.z, st.w);
            *(u32x2*)(CST + (size_t)(u * 2 + dir) * DQK * DV + e4) = o;
            st = st * dec + dc;
        }
    }
    for (int g = C.bid * NT + C.tid; g < BATCH * NH * 2 * DQK; g += C.G * NT) {
        const int d = g % DQK, ch = g / DQK, dir = ch & 1, bh = ch >> 1; float st = 0.f;
        for (int idx = 0; idx < NBLK; ++idx) {
            const int blk = dir == 0 ? idx : (idx == 0 ? 0 : NBLK - idx); const int u = bh * NBLK + blk;
            NST[(size_t)(u * 2 + dir) * DQK + d] = st; st = __expf(BT[u * 2 + dir]) * st + DN[(size_t)(u * 2 + dir) * DQK + d];
        }
    }
}
__device__ __forceinline__ void lds_barrier() { asm volatile("s_waitcnt lgkmcnt(0)" ::: "memory"); __builtin_amdgcn_s_barrier(); asm volatile("" ::: "memory"); }
__device__ __forceinline__ void phase_s3(const Args& A, const Ctx& C, int l) {
    const int jl = l >> 1; const bool ctx_out = (l == 0);
    LAS float* bf = (LAS float*)C.lds; LAS float* bb = bf + 256; LAS float* gf = bb + 256; LAS float* gb = gf + 256;
    LAS float* nf = gb + 256; LAS float* nb = nf + 128; LAS float* ssx = nb + 128;
    LAS float* cf = ssx + 256; LAS float* cb = cf + 256;
    constexpr int KP = 272, VP = 136, CP = 144, OP = 528;
    LAS unsigned char* Kimg = C.lds + 8192;
    LAS unsigned char* CH = Kimg + 256 * KP;
    static_assert(8192 + 256 * KP + 128 * OP <= LDS_TAB_END, "S3 LDS map");
    const bf16* P = (const bf16*)(A.ws + WS_PB); const bf16* VT = (const bf16*)(A.ws + WS_VT); bf16* HM = (bf16*)(A.ws + WS_HM);
    const bf16* CST = (const bf16*)(A.ws + WS_CST); const float* NST = (const float*)(A.ws + WS_NST);
    const float* hg = A.in[10] + (size_t)jl * NV;
    const int w = C.wave, eh = w >> 2;
    for (int u = C.bid; u < NUNIT; u += C.G) {
        const int blk = u % NBLK, bh = u / NBLK, h = bh % NH, b = bh / NH; const int row0 = blk_row0(b, blk);
        if (blk == 0 && !ctx_out) continue;
        int tu = threadIdx.x; asm volatile("" : "+v"(tu));
        block_gates(A, row0, h, bf, bb, gf, gb, tu);
        if (tu < 256) { gf[tu] -= bf[tu]; gb[tu] -= bb[tu]; cf[tu] = __expf(bf[tu | 31] + gf[tu]); cb[tu] = __expf(bb[tu & ~31] + gb[tu]); }
        else { const int t2 = tu - 256; nf[t2] = NST[(size_t)(u * 2 + (t2 >> 7)) * DQK + (t2 & 127)]; }
        { const int pc = tu & 15, s0 = tu >> 4; const bf16* kr = P + (size_t)(row0 + s0) * PW + NQ + h * DQK + 8 * pc;
#pragma unroll
          for (int i = 0; i < 8; ++i) *(LAS u32x4*)(Kimg + (s0 + 32 * i) * KP + pc * 16) = *(const u32x4*)(kr + (size_t)(32 * i) * PW); }
        __syncthreads();
        const bf16* vtile = VT + (size_t)vt_tile(b, h, blk) * 65536;
        const bf16* ctile = CST + (size_t)(u * 2) * DQK * DV;
#pragma unroll 1
        for (int ps = 0; ps < 2; ++ps) {
            int lz = threadIdx.x & 63; asm volatile("" : "+v"(lz));
            const int r = lz & 31, hh = lz >> 5;
            const int jt = 2 * (w & 3) + ps; const int jrow = row0 + 32 * jt + r;
            bf16x8 qf[8];
            { const bf16* qr = P + (size_t)jrow * PW + h * DQK + 8 * hh;
#pragma unroll
              for (int kk = 0; kk < 8; ++kk) qf[kk] = *(const bf16x8*)(qr + 16 * kk); }
            const float bfj = bf[32 * jt + r], bbj = bb[32 * jt + r];
            float qnf = 0.f, qnb = 0.f;
#pragma unroll
            for (int kk = 0; kk < 8; ++kk) { const u32x4 qq = __builtin_bit_cast(u32x4, qf[kk]); const int d = 16 * kk + 8 * hh;
                const f32x4 n0 = *(const LAS f32x4*)(nf + d), n1 = *(const LAS f32x4*)(nf + d + 4), m0 = *(const LAS f32x4*)(nb + d), m1 = *(const LAS f32x4*)(nb + d + 4);
                qnf += (bflo(qq.x) * n0.x + bfhi(qq.x) * n0.y) + (bflo(qq.y) * n0.z + bfhi(qq.y) * n0.w) + (bflo(qq.z) * n1.x + bfhi(qq.z) * n1.y) + (bflo(qq.w) * n1.z + bfhi(qq.w) * n1.w);
                qnb += (bflo(qq.x) * m0.x + bfhi(qq.x) * m0.y) + (bflo(qq.y) * m0.z + bfhi(qq.y) * m0.w) + (bflo(qq.z) * m1.x + bfhi(qq.z) * m1.y) + (bflo(qq.w) * m1.z + bfhi(qq.w) * m1.w);
                if (kk & 1) asm volatile("" ::: "memory"); }
            qnf += __shfl_xor(qnf, 32); qnb += __shfl_xor(qnb, 32);
            u32x4 pre[4];
            { int tz = threadIdx.x; asm volatile("" : "+v"(tz)); const int pc = tz & 7, e0 = tz >> 3; const bf16* vr = vtile + (size_t)e0 * 256 + 8 * pc;
#pragma unroll
              for (int c4 = 0; c4 < 4; ++c4) pre[c4] = *(const u32x4*)(vr + (size_t)(64 * c4) * 256); }
            float denf = 0.f, denb = 0.f;
#pragma unroll 1
            for (int kt = 0; kt < 8; ++kt) {
                f32x16 c;
#pragma unroll
                for (int i = 0; i < 16; ++i) c[i] = 0.f;
#pragma unroll
                for (int kk = 0; kk < 8; ++kk) { const bf16x8 a = *(const LAS bf16x8*)(Kimg + (kt * 32 + r) * KP + (16 * kk + 8 * hh) * 2); c = MFMA32(a, qf[kk], c); }
                if (kt == jt) {
#pragma unroll
                    for (int g = 0; g < 4; ++g) { const int sl0 = 8 * g + 4 * hh;
                        const f32x4 g4f = *(const LAS f32x4*)(gf + kt * 32 + sl0), g4b = *(const LAS f32x4*)(gb + kt * 32 + sl0);
#pragma unroll
                        for (int q = 0; q < 4; ++q) { const int sl = sl0 + q; const float cv = c[4 * g + q];
                            denf += cv * __expf((sl <= r) ? bfj + g4f[q] : -1.0e30f); denb += cv * __expf((sl >= r) ? bbj + g4b[q] : -1.0e30f); } }
                } else {
                    LAS const float* cx = (kt < jt ? cf : cb) + kt * 32 + 4 * hh; float sm = 0.f;
#pragma unroll
                    for (int g = 0; g < 4; ++g) { const f32x4 c4 = *(const LAS f32x4*)(cx + 8 * g); sm += (c[4 * g] * c4.x + c[4 * g + 1] * c4.y) + (c[4 * g + 2] * c4.z + c[4 * g + 3] * c4.w); }
                    if (kt < jt) denf += sm * __expf(bfj - bf[kt * 32 + 31]); else denb += sm * __expf(bbj - bb[kt * 32]);
                }
            }
            denf += __shfl_xor(denf, 32); denb += __shfl_xor(denb, 32);
            const float ebf = __expf(bfj), ebb = __expf(bbj);
            denf += ebf * qnf; denb += ebb * qnb;
            const float rf = 1.0f / fmaxf(fabsf(denf), 1.0f), rb = 1.0f / fmaxf(fabsf(denb), 1.0f);
            const float scf = ebf * rf, scb = ebb * rb;
            f32x16 acc[4];
#pragma unroll
            for (int et = 0; et < 4; ++et)
#pragma unroll
                for (int i = 0; i < 16; ++i) acc[et][i] = 0.f;
#pragma unroll
            for (int ci = 0; ci < 8; ++ci) {
                lds_barrier();
                { int tz = threadIdx.x; asm volatile("" : "+v"(tz)); const int pc = tz & 7, e0 = tz >> 3;
                  if (ci < 4) {
#pragma unroll
                      for (int c4 = 0; c4 < 4; ++c4) { *(LAS u32x2*)(CH + (e0 + 64 * c4) * VP + pc * 16) = (u32x2){pre[c4].x, pre[c4].y}; *(LAS u32x2*)(CH + (e0 + 64 * c4) * VP + pc * 16 + 8) = (u32x2){pre[c4].z, pre[c4].w}; }
                  } else {
#pragma unroll
                      for (int c4 = 0; c4 < 4; ++c4) *(LAS u32x4*)(CH + (e0 + 64 * c4) * CP + pc * 16) = pre[c4];
                  }
                  if (ci < 7) { const int cn = ci + 1;
                      const bf16* src = (cn < 4) ? vtile + (size_t)e0 * 256 + 64 * cn + 8 * pc : ctile + (size_t)(cn >= 6 ? DQK * DV : 0) + (size_t)e0 * DQK + 64 * (cn & 1) + 8 * pc;
                      const size_t rstep = (cn < 4) ? (size_t)64 * 256 : (size_t)64 * DQK;
#pragma unroll
                      for (int c4 = 0; c4 < 4; ++c4) pre[c4] = *(const u32x4*)(src + c4 * rstep); } }
                lds_barrier();
                if (ci < 4) {
#pragma unroll 1
                    for (int kt2 = 0; kt2 < 2; ++kt2) { const int kt = 2 * ci + kt2;
                        f32x16 c;
#pragma unroll
                        for (int i = 0; i < 16; ++i) c[i] = 0.f;
#pragma unroll
                        for (int kk = 0; kk < 8; ++kk) { const bf16x8 a = *(const LAS bf16x8*)(Kimg + (kt * 32 + r) * KP + (16 * kk + 8 * hh) * 2); c = MFMA32(a, qf[kk], c); }
                        float p[16]; const float bfj2 = bf[32 * jt + r], bbj2 = bb[32 * jt + r];
                        if (kt == jt) {
#pragma unroll
                            for (int g = 0; g < 4; ++g) { const int sl0 = 8 * g + 4 * hh;
                                const f32x4 g4f = *(const LAS f32x4*)(gf + kt * 32 + sl0), g4b = *(const LAS f32x4*)(gb + kt * 32 + sl0);
#pragma unroll
                                for (int q = 0; q < 4; ++q) { const int sl = sl0 + q;
                                    const float wt = rf * __expf((sl <= r) ? bfj2 + g4f[q] : -1.0e30f) + rb * __expf((sl >= r) ? bbj2 + g4b[q] : -1.0e30f);
                                    p[4 * g + q] = c[4 * g + q] * wt; } }
                        } else {
                            LAS const float* cx = (kt < jt ? cf : cb) + kt * 32 + 4 * hh;
                            const float rw = (kt < jt) ? rf * __expf(bfj2 - bf[kt * 32 + 31]) : rb * __expf(bbj2 - bb[kt * 32]);
#pragma unroll
                            for (int g = 0; g < 4; ++g) { const f32x4 c4 = *(const LAS f32x4*)(cx + 8 * g);
                                p[4 * g] = c[4 * g] * (c4.x * rw); p[4 * g + 1] = c[4 * g + 1] * (c4.y * rw); p[4 * g + 2] = c[4 * g + 2] * (c4.z * rw); p[4 * g + 3] = c[4 * g + 3] * (c4.w * rw); }
                        }
                        const bf16x8 pa0 = pack8(p[0], p[1], p[2], p[3], p[4], p[5], p[6], p[7]), pa1 = pack8(p[8], p[9], p[10], p[11], p[12], p[13], p[14], p[15]);
#pragma unroll
                        for (int et = 0; et < 4; ++et) { LAS const unsigned char* vb = CH + ((4 * eh + et) * 32 + r) * VP + (kt2 * 32 + 4 * hh) * 2;
                            const u32x2 l0 = *(LAS const u32x2*)(vb), h0 = *(LAS const u32x2*)(vb + 16), l1 = *(LAS const u32x2*)(vb + 32), h1 = *(LAS const u32x2*)(vb + 48);
                            const bf16x8 a0 = __builtin_bit_cast(bf16x8, (u32x4){l0.x, l0.y, h0.x, h0.y}), a1 = __builtin_bit_cast(bf16x8, (u32x4){l1.x, l1.y, h1.x, h1.y});
                            acc[et] = MFMA32(a0, pa0, acc[et]); acc[et] = MFMA32(a1, pa1, acc[et]); }
                    }
                } else {
                    const int dir = (ci - 4) >> 1, dh = ci & 1;
                    const float sc = dir ? scb : scf;
#pragma unroll
                    for (int k4 = 0; k4 < 4; ++k4) { const u32x4 qq = __builtin_bit_cast(u32x4, qf[4 * dh + k4]);
                        const bf16x8 qs = pack8(bflo(qq.x) * sc, bfhi(qq.x) * sc, bflo(qq.y) * sc, bfhi(qq.y) * sc, bflo(qq.z) * sc, bfhi(qq.z) * sc, bflo(qq.w) * sc, bfhi(qq.w) * sc);
#pragma unroll
                        for (int et = 0; et < 4; ++et) { const bf16x8 a = *(const LAS bf16x8*)(CH + ((4 * eh + et) * 32 + r) * CP + (16 * k4 + 8 * hh) * 2); acc[et] = MFMA32(a, qs, acc[et]); } }
                }
            }
            float ss = 0.f;
#pragma unroll
            for (int et = 0; et < 4; ++et)
#pragma unroll
                for (int i = 0; i < 16; ++i) ss += acc[et][i] * acc[et][i];
            ss += __shfl_xor(ss, 32);
            if (hh == 0) ssx[w * 32 + r] = ss;
            lds_barrier();
            ss += ssx[(w ^ 4) * 32 + r];
            const float rs = 1.0f / sqrtf(ss * (1.0f / DV) + EPS);
            { LAS unsigned char* ob = CH + ((w & 3) * 32 + r) * OP + (eh * 128 + 4 * hh) * 2;
#pragma unroll
              for (int et = 0; et < 4; ++et)
#pragma unroll
                  for (int g = 0; g < 4; ++g) { u32x2 o; o.x = cvt2(acc[et][4 * g + 0] * rs, acc[et][4 * g + 1] * rs); o.y = cvt2(acc[et][4 * g + 2] * rs, acc[et][4 * g + 3] * rs);
                      *(LAS u32x2*)(ob + (et * 32 + 8 * g) * 2) = o; } }
            lds_barrier();
            { int tz = threadIdx.x; asm volatile("" : "+v"(tz)); const int pc = tz & 31, lr0 = tz >> 5;
              const f32x4 g0 = *(const f32x4*)(hg + h * DV + 8 * pc), g1 = *(const f32x4*)(hg + h * DV + 8 * pc + 4);
#pragma unroll
              for (int hf = 0; hf < 2; ++hf) {
              u32x4 ov[4];
#pragma unroll
              for (int i = 0; i < 4; ++i) { const int lr = lr0 + 16 * (4 * hf + i); const int grow = row0 + 64 * (lr >> 5) + 32 * ps + (lr & 31); ov[i] = *(const u32x4*)(P + (size_t)grow * PW + 2 * NQ + NV + h * DV + 8 * pc); }
#pragma unroll
              for (int i = 0; i < 4; ++i) { const int lr = lr0 + 16 * (4 * hf + i); const int grow = row0 + 64 * (lr >> 5) + 32 * ps + (lr & 31);
                  const u32x4 hv = *(const LAS u32x4*)(CH + lr * OP + pc * 16);
                  u32x4 o; o.x = cvt2(bflo(hv.x) * g0.x * bflo(ov[i].x), bfhi(hv.x) * g0.y * bfhi(ov[i].x)); o.y = cvt2(bflo(hv.y) * g0.z * bflo(ov[i].y), bfhi(hv.y) * g0.w * bfhi(ov[i].y));
                  o.z = cvt2(bflo(hv.z) * g1.x * bflo(ov[i].z), bfhi(hv.z) * g1.y * bfhi(ov[i].z)); o.w = cvt2(bflo(hv.w) * g1.z * bflo(ov[i].w), bfhi(hv.w) * g1.w * bfhi(ov[i].w));
                  *(u32x4*)(HM + (size_t)grow * D + h * DV + 8 * pc) = o; }
              asm volatile("" ::: "memory"); } }
        }
        __syncthreads();
    }
}

#define XB_TMO      128
#define XB_XCNT(j)  (256  + 64 * (j))
#define XB_XSUB(j)  (1280 + 64 * (j))
#define XB_XGEN(j)  (2304 + 64 * (j))
#define XB_TOP      3328
#define XB_TOPGEN   3392
#define XCD_BAR_WORDS 3456
#define XB_SPIN_CAP (1u << 18)

__device__ __forceinline__ unsigned xb_ld(unsigned* p)              { return __hip_atomic_load(p, __ATOMIC_RELAXED, __HIP_MEMORY_SCOPE_AGENT); }
__device__ __forceinline__ unsigned xb_add(unsigned* p, unsigned v) { return __hip_atomic_fetch_add(p, v, __ATOMIC_RELAXED, __HIP_MEMORY_SCOPE_AGENT); }
__device__ __forceinline__ unsigned xb_xcc_id() { return (unsigned)__builtin_amdgcn_s_getreg((3 << 11) | 20) & 0xFu; }
#define XB_SPIN(cond, bar) do { unsigned _sp = 0; while (cond) { __builtin_amdgcn_s_sleep(1); \
    if ((++_sp & 255u) == 0u) { if (xb_ld(&(bar)[XB_TMO])) break; if (_sp > XB_SPIN_CAP) { atomicAdd(&(bar)[XB_TMO], 1u); break; } } } } while (0)

struct XcdBarrier {
    unsigned* bar; unsigned x;
    volatile LAS unsigned* st;
};

__device__ __forceinline__ XcdBarrier xcd_barrier_post(unsigned* bar, volatile LAS unsigned* st) {
    XcdBarrier b; b.bar = bar; b.x = xb_xcc_id(); b.st = st;
    if (threadIdx.x == 0) (void)xb_add(&bar[XB_XCNT(b.x)], 1u);
    return b;
}
__device__ __forceinline__ void xcd_barrier_complete(unsigned* bar, unsigned x, unsigned& nloc, unsigned& nx) {
    const unsigned G = gridDim.x * gridDim.y * gridDim.z;
    unsigned sum, cnt, mine, sp = 0u;
    for (;;) {
        sum = 0u; cnt = 0u; mine = 0u;
#pragma unroll
        for (unsigned j = 0; j < 16; ++j) { const unsigned c = xb_ld(&bar[XB_XCNT(j)]); sum += c; cnt += (c > 0u) ? 1u : 0u; mine = (j == x) ? c : mine; }
        if (sum == G) break;
        __builtin_amdgcn_s_sleep(1);
        if ((++sp & 255u) == 0u) { if (xb_ld(&bar[XB_TMO])) break; if (sp > XB_SPIN_CAP) { atomicAdd(&bar[XB_TMO], 1u); break; } }
    }
    nloc = mine > 0u ? mine : 1u; nx = cnt > 0u ? cnt : 1u;
}

__device__ __forceinline__ void xcd_barrier(const XcdBarrier& b) {
    asm volatile("s_waitcnt vmcnt(0)" ::: "memory");
    __syncthreads();
    if (threadIdx.x == 0) {
        unsigned* bar = b.bar;
        __builtin_amdgcn_s_waitcnt(0);
        unsigned nloc = b.st[0], nx = b.st[1];
        if (nloc == 0u) { xcd_barrier_complete(bar, b.x, nloc, nx); b.st[0] = nloc; b.st[1] = nx; }
        const unsigned old = xb_add(&bar[XB_XSUB(b.x)], 1u);
        const unsigned gen = old / nloc;
        if (old + 1u == (gen + 1u) * nloc) {
            __builtin_amdgcn_fence(__ATOMIC_RELEASE, "agent");
            asm volatile("s_waitcnt vmcnt(0)" ::: "memory");
            const unsigned og = xb_add(&bar[XB_TOP], 1u);
            const unsigned tg = og / nx;
            if (og + 1u == (tg + 1u) * nx) xb_add(&bar[XB_TOPGEN], 1u);
            else XB_SPIN(xb_ld(&bar[XB_TOPGEN]) == tg, bar);
            __builtin_amdgcn_fence(__ATOMIC_ACQUIRE, "agent");
            xb_add(&bar[XB_XGEN(b.x)], 1u);
            asm volatile("s_waitcnt vmcnt(0)" ::: "memory");
        } else {
            XB_SPIN(xb_ld(&bar[XB_XGEN(b.x)]) == gen, bar);
            __builtin_amdgcn_fence(__ATOMIC_ACQUIRE, "agent");
            asm volatile("s_waitcnt vmcnt(0)" ::: "memory");
        }
    }
    __syncthreads();
}


constexpr int LDS_BYTES = 152 * 1024;
constexpr int CW_BAR = 16384;
static_assert((CW_BAR + XCD_BAR_WORDS) * 4 <= (int)CTL_BYTES, "ctl");
#ifndef MK_MULTI
#define MK_MULTI 0
#endif
#define IN(p) (lo <= (p) && (p) < hi)
#ifndef PROBE_MASK
#define PROBE_MASK 0
#endif
#define DUP(bit, call) do { call; } while (0)
#define SEAM(p) do { if ((p) + 1 < hi) { XcdBarrier b_; b_.bar = (unsigned*)(load_args().ws + WS_CTL) + CW_BAR; b_.x = xb_xcc_id(); b_.st = (volatile LAS unsigned*)(C.lds + LDS_BYTES - 16); xcd_barrier(b_); } } while (0)
#define CAS __attribute__((address_space(4)))
__device__ __forceinline__ Args load_args() {
#if defined(__HIP_DEVICE_COMPILE__)
    const CAS Args* p = (const CAS Args*)__builtin_amdgcn_kernarg_segment_ptr(); asm volatile("" : "+s"(p));
    Args a; for (int i = 0; i < 22; ++i) a.in[i] = p->in[i]; a.out = p->out; a.ws = p->ws; a.lo = p->lo; a.hi = p->hi; return a;
#else
    return Args{};
#endif
}
__device__ __forceinline__ Ctx fresh(const Ctx& C) { Ctx R = C; int tz = threadIdx.x; asm volatile("" : "+v"(tz)); R.tid = tz; R.lane = tz & 63; return R; }
template <int L> __device__ __forceinline__ void layer_phases(const Args& args, const Ctx& C, int bar, int lo, int hi) {
    constexpr int pb = 16 * L;
    if (IN(pb + 1)) { phase_r1(load_args(), fresh(C), L); SEAM(pb + 1); }
    if (IN(pb + 2)) { DUP(1, phase_g1(load_args(), fresh(C), L)); SEAM(pb + 2); }
    if constexpr ((L & 1) == 0) {
        if (IN(pb + 3)) { DUP(2, phase_s1(load_args(), fresh(C), L)); SEAM(pb + 3); }
        if (IN(pb + 4)) { DUP(2, phase_s2(load_args(), fresh(C))); SEAM(pb + 4); }
        if (IN(pb + 5)) { DUP(2, phase_s3(load_args(), fresh(C), L)); SEAM(pb + 5); }
    } else {
        if (IN(pb + 3)) { DUP(8, phase_conv(load_args(), fresh(C), L)); SEAM(pb + 3); }
    }
    if (IN(pb + 6)) { DUP(1, phase_g2(load_args(), fresh(C), L)); SEAM(pb + 6); }
    if (IN(pb + 7)) { phase_r2(load_args(), fresh(C), L); SEAM(pb + 7); }
    if (IN(pb + 8)) { DUP(1, phase_m1(load_args(), fresh(C), L)); SEAM(pb + 8); }
    if (IN(pb + 9)) { DUP(1, phase_m2(load_args(), fresh(C), L)); SEAM(pb + 9); }
}
__global__ void __launch_bounds__(NT, 2) fwd_kernel(Args args) {
    extern __shared__ __attribute__((aligned(16))) unsigned char lds_raw[];
    Ctx C; C.lds = (LAS unsigned char*)lds_raw; C.tid = threadIdx.x; C.lane = C.tid & 63; C.wave = __builtin_amdgcn_readfirstlane(C.tid >> 6); C.G = gridDim.x; C.bid = blockIdx.x; C.a = &args;
    const int lo = args.lo, hi = args.hi;
    volatile LAS unsigned* xbw = (volatile LAS unsigned*)(C.lds + LDS_BYTES - 16);
    if (C.tid < 4) xbw[C.tid] = 0u;
    __syncthreads();
    if (hi - lo > 1) (void)xcd_barrier_post((unsigned*)(args.ws + WS_CTL) + CW_BAR, xbw);
    const int bar = 0; (void)bar;
    if (IN(0)) { DUP(4, phase_mod(load_args(), fresh(C))); __syncthreads(); DUP(4, phase_cvt_mixer(load_args(), fresh(C))); SEAM(0); }
    layer_phases<0>(args, C, bar, lo, hi);
    layer_phases<1>(args, C, bar, lo, hi);
    layer_phases<2>(args, C, bar, lo, hi);
    layer_phases<3>(args, C, bar, lo, hi);
    if (IN(64)) phase_final(load_args(), fresh(C));
}
#undef IN
#undef SEAM

extern "C" void kernel_launch(void* const* d_in, const int* in_sizes, int n_in, void* d_out, int out_size, void* d_ws, size_t ws_size, hipStream_t stream) {
    static int grid = 0;
    if (grid == 0) {
        if (n_in != 22 || out_size != NL * D || ws_size < WS_END) { fprintf(stderr, "kernel_launch: unexpected shapes (n_in %d out %d ws %zu)\n", n_in, out_size, ws_size); grid = -1; return; }
        int dev = 0, cus = 0, per_cu = 0;
        if (hipGetDevice(&dev) != hipSuccess || hipDeviceGetAttribute(&cus, hipDeviceAttributeMultiprocessorCount, dev) != hipSuccess) { grid = -1; return; }
        if (hipFuncSetAttribute((const void*)fwd_kernel, hipFuncAttributeMaxDynamicSharedMemorySize, LDS_BYTES) != hipSuccess) { grid = -1; return; }
        if (hipOccupancyMaxActiveBlocksPerMultiprocessor(&per_cu, (const void*)fwd_kernel, NT, LDS_BYTES) != hipSuccess || per_cu < 1) { fprintf(stderr, "kernel_launch: occupancy query says %d\n", per_cu); }
        (void)hipGetLastError();
        grid = cus;
    }
    if (grid < 0) return;
    (void)hipMemsetAsync((char*)d_ws + WS_CTL, 0, CTL_BYTES, stream);
    Args a{};
    for (int i = 0; i < 22; ++i) a.in[i] = (const float*)d_in[i];
    a.out = (float*)d_out; a.ws = (unsigned char*)d_ws;
#if MK_MULTI
    int phases[64]; int np = 0;
    phases[np++] = 0;
    for (int l = 0; l < DEPTH; ++l) { const int pb = 16 * l; phases[np++] = pb + 1; phases[np++] = pb + 2; phases[np++] = pb + 3;
        if ((l & 1) == 0) { phases[np++] = pb + 4; phases[np++] = pb + 5; }
        phases[np++] = pb + 6; phases[np++] = pb + 7; phases[np++] = pb + 8; phases[np++] = pb + 9; }
    phases[np++] = 64;
    for (int i = 0; i < np; ++i) { a.lo = phases[i]; a.hi = phases[i] + 1; hipLaunchKernelGGL(fwd_kernel, dim3(grid), dim3(NT), LDS_BYTES, stream, a); }
#else
    a.lo = 0; a.hi = 65;
    hipLaunchKernelGGL(fwd_kernel, dim3(grid), dim3(NT), LDS_BYTES, stream, a);
#ifdef PROBE_PHASES
    { const int pp[] = {PROBE_PHASES};
      for (int rep = 0; rep < PROBE_REPS; ++rep) for (unsigned i = 0; i < sizeof(pp) / sizeof(pp[0]); ++i) { a.lo = pp[i]; a.hi = pp[i] + 1; hipLaunchKernelGGL(fwd_kernel, dim3(grid), dim3(NT), LDS_BYTES, stream, a); } }
#endif
#endif
}
```

```cpp
#include <hip/hip_runtime.h>
#include <cstdio>
#include <cstdint>

#define LAS __attribute__((address_space(3)))
typedef unsigned short bf16;
typedef float f32x4 __attribute__((ext_vector_type(4)));
typedef unsigned u32x4 __attribute__((ext_vector_type(4)));
typedef unsigned u32x2 __attribute__((ext_vector_type(2)));

constexpr int D = 1024, BATCH = 2, SEQ = 16384, DEPTH = 4, CTXL = 256;
constexpr int NL = BATCH * SEQ, NCX = BATCH * CTXL, NR = NL + NCX;
constexpr int NH = 4, DQK = 128, DV = 256, NQ = 512, NV = 1024, PROJ = 3088, PW = 3072;
constexpr int NGRP = 4, EPG = 8, NE = 32, DE = 512;
constexpr int NBLK = 65;
constexpr int NUNIT = BATCH * NH * NBLK;
constexpr int CAP = NR;
constexpr int YROWS = 74752;
constexpr float EPS = 1e-6f;
constexpr float YSCALE = 4.0f;
constexpr int NT = 512, NW = 8;
constexpr int LDS_TAB_END = 152 * 1024 - 16;

constexpr size_t MiB = 1u << 20;
constexpr size_t WS_CTL = 0, CTL_BYTES = 1 * MiB;
constexpr size_t WS_MOD = 1 * MiB;
constexpr size_t WS_GATE = 2 * MiB;
constexpr size_t WS_TOKSLOT = 5 * MiB;
constexpr size_t WS_TOKW = 6 * MiB;
constexpr size_t WS_SLOTTOK = 7 * MiB;
constexpr size_t WS_DN = 12 * MiB;
constexpr size_t WS_NST = 13 * MiB;
constexpr size_t WS_BTOT = 14 * MiB;
constexpr size_t WS_LAT = 16 * MiB;
constexpr size_t WS_HB = 146 * MiB;
constexpr size_t WS_PB = 211 * MiB;
constexpr size_t WS_HM = 406 * MiB;
constexpr size_t WS_DC = 471 * MiB;
constexpr size_t WS_CST = 601 * MiB;
constexpr size_t WS_VT = 666 * MiB;
constexpr size_t WS_WAIN = 731 * MiB;
constexpr size_t WS_WBIN = 743 * MiB;
constexpr size_t WS_WAOUT = 755 * MiB;
constexpr size_t WS_WBOUT = 759 * MiB;
constexpr size_t WS_WGU = 763 * MiB;
constexpr size_t WS_WDN = 827 * MiB;
constexpr size_t WS_H8 = 843 * MiB;
constexpr size_t WS_END = 880 * MiB;
constexpr int CW_CNT = 1024, CNT_STRIDE = 64;

struct Args { const float* in[22]; float* out; unsigned char* ws; int lo, hi; };

typedef short bf16x8 __attribute__((ext_vector_type(8)));
typedef float f32x2 __attribute__((ext_vector_type(2)));
typedef __bf16 bf16x2_t __attribute__((ext_vector_type(2)));
__device__ __forceinline__ unsigned cvt2(float lo, float hi) { const f32x2 v = {lo, hi}; return __builtin_bit_cast(unsigned, __builtin_convertvector(v, bf16x2_t)); }
__device__ __forceinline__ float bf2f(bf16 v) { return __uint_as_float(((unsigned)v) << 16); }
__device__ __forceinline__ unsigned f2bf(float f) { unsigned u = __float_as_uint(f); return (u + 0x7fffu + ((u >> 16) & 1u)) >> 16; }
__device__ __forceinline__ unsigned pk2(float lo, float hi) { return f2bf(lo) | (f2bf(hi) << 16); }
template <int CTRL, int ROWMASK> __device__ __forceinline__ float dpp_mov(float x) { return __int_as_float(__builtin_amdgcn_update_dpp(0, __float_as_int(x), CTRL, ROWMASK, 0xf, false)); }
__device__ __forceinline__ float wave_sum(float v) {
    v += dpp_mov<0xB1, 0xf>(v); v += dpp_mov<0x4E, 0xf>(v); v += dpp_mov<0x141, 0xf>(v); v += dpp_mov<0x140, 0xf>(v);
    v += dpp_mov<0x142, 0xA>(v); v += dpp_mov<0x143, 0xC>(v);
    return __int_as_float(__builtin_amdgcn_readlane(__float_as_int(v), 63));
}
__device__ __forceinline__ float sigmoidf_(float x) { return 1.f / (1.f + __expf(-x)); }
__device__ __forceinline__ float siluf_(float x) { return x / (1.f + __expf(-x)); }
__device__ __forceinline__ float logsigmoidf_(float x) { return fminf(x, 0.f) - log1pf(__expf(-fabsf(x))); }
__device__ __forceinline__ int blk_row0(int b, int blk) { return blk == 0 ? NL + b * CTXL : b * SEQ + (blk - 1) * 256; }
__device__ __forceinline__ int mod_vec_of_row(int row) { return row < NL ? row / SEQ : 2; }

struct Ctx {
    LAS unsigned char* lds; int tid, lane, wave, G, bid;
    const Args* a;
};

__device__ __forceinline__ void slot_bases(const Args& A, int l, LAS int* sb, int tid) {
    if (tid == 0) {
        const unsigned* cnt = (const unsigned*)(A.ws + WS_CTL) + CW_CNT + l * 32 * CNT_STRIDE;
        int acc = 0;
        for (int e = 0; e < NE; ++e) { sb[e] = acc; acc += (((int)cnt[e * CNT_STRIDE] + 255) / 256) * 256; }
        sb[NE] = acc;
    }
    __syncthreads();
}

__device__ __forceinline__ void phase_mod(const Args& A, const Ctx& C) {
    LAS float* sc = (LAS float*)C.lds;
    LAS float* red = sc + 3072;
    const float* c = A.in[1]; const float* cc = A.in[3];
    for (int i = C.tid; i < 3072; i += NT) { const float v = i < 2048 ? c[i] : cc[i - 2048]; sc[i] = siluf_(v); }
    __syncthreads();
    float* MOD = (float*)(A.ws + WS_MOD);
    for (int u = C.bid; u < DEPTH * 96; u += C.G) {
        const int l = u / 96, cg = u % 96, col = cg * 64 + C.lane;
        const float* w = A.in[4] + (size_t)l * D * 6 * D + col;
        float a0 = 0.f, a1 = 0.f, a2 = 0.f;
#pragma unroll 32
        for (int k = C.wave * 128; k < C.wave * 128 + 128; ++k) { const float wv = w[(size_t)k * 6 * D]; a0 += sc[k] * wv; a1 += sc[1024 + k] * wv; a2 += sc[2048 + k] * wv; }
        red[(C.wave * 3 + 0) * 64 + C.lane] = a0; red[(C.wave * 3 + 1) * 64 + C.lane] = a1; red[(C.wave * 3 + 2) * 64 + C.lane] = a2;
        __syncthreads();
        if (C.tid < 192) { const int v = C.tid / 64, ln = C.tid % 64; float s = 0.f;
            for (int w8 = 0; w8 < 8; ++w8) s += red[(w8 * 3 + v) * 64 + ln];
            MOD[(size_t)(l * 3 + v) * 6 * D + cg * 64 + ln] = s + A.in[5][(size_t)l * 6 * D + cg * 64 + ln]; }
        __syncthreads();
    }
}

__device__ __forceinline__ void load_row_f32(const float* p, int lane, f32x4 (&v)[4]) {
#pragma unroll
    for (int j = 0; j < 4; ++j) v[j] = *(const f32x4*)(p + 4 * lane + 256 * j);
}
__device__ __forceinline__ void load_row_bf16(const bf16* p, int lane, f32x4 (&v)[4]) {
#pragma unroll
    for (int j = 0; j < 4; ++j) { const u32x2 w = *(const u32x2*)(p + 4 * lane + 256 * j);
        v[j] = (f32x4){__uint_as_float(w.x << 16), __uint_as_float(w.x & 0xffff0000u), __uint_as_float(w.y << 16), __uint_as_float(w.y & 0xffff0000u)}; }
}
__device__ __forceinline__ void store_row_bf16(bf16* p, int lane, const f32x4 (&v)[4]) {
#pragma unroll
    for (int j = 0; j < 4; ++j) { u32x2 w; w.x = pk2(v[j].x, v[j].y); w.y = pk2(v[j].z, v[j].w); *(u32x2*)(p + 4 * lane + 256 * j) = w; }
}
__device__ __forceinline__ void moe_combine(const Args& A, int lp, int row, int lane, LAS const int* sb, f32x4 (&v)[4]) {
    const int* ts = (const int*)(A.ws + WS_TOKSLOT) + row * 2; const float* tw = (const float*)(A.ws + WS_TOKW) + row * 2;
    const bf16* Y = (const bf16*)(A.ws + WS_PB);
    const int t0 = ts[0], t1 = ts[1]; const float w0 = tw[0], w1 = tw[1];
    const size_t s0 = (size_t)(sb[t0 >> 20] + (t0 & 0xfffff)), s1 = (size_t)(sb[t1 >> 20] + (t1 & 0xfffff));
    f32x4 y0[4], y1[4], g2[4];
    load_row_bf16(Y + s0 * D, lane, y0); load_row_bf16(Y + s1 * D, lane, y1);
    load_row_f32((const float*)(A.ws + WS_MOD) + (size_t)(lp * 3 + mod_vec_of_row(row)) * 6 * D + 5 * D, lane, g2);
#pragma unroll
    for (int j = 0; j < 4; ++j) v[j] += g2[j] * (y0[j] * w0 + y1[j] * w1);
}
__device__ __forceinline__ void norm_mod(const f32x4 (&v)[4], const float* g, const float* sh, const float* sc, int lane, f32x4 (&h)[4]) {
    float s = 0.f;
#pragma unroll
    for (int j = 0; j < 4; ++j) s += (v[j].x * v[j].x + v[j].y * v[j].y) + (v[j].z * v[j].z + v[j].w * v[j].w);
    const float r = 1.0f / sqrtf(wave_sum(s) * (1.f / D) + EPS);
    f32x4 gg[4], ss[4], cc[4];
    load_row_f32(g, lane, gg); load_row_f32(sh, lane, ss); load_row_f32(sc, lane, cc);
#pragma unroll
    for (int j = 0; j < 4; ++j) h[j] = (v[j] * r) * gg[j] * (1.f + cc[j]) + ss[j];
}

constexpr int CVT_IG = (D / 64) * (DE / 32), CVT_ID = (DE / 64) * (D / 32), CVT_PER = 2 * CVT_IG + CVT_ID, CVT_ITEMS = NE * CVT_PER;
constexpr int CVT_Q = 48;
__device__ __forceinline__ void cvt_moe_items(const Args& A, const Ctx& C, int l, int it0, int end, int stride);
__device__ __forceinline__ int cvt_t2(int l, int G);
struct RowVec { f32x4 a[4], s[4], g[4]; };
__device__ __forceinline__ void load_rowvec(RowVec& R, const float* ng, const float* sh, const float* sc, const float* gt, int lane) {
    f32x4 n[4], c[4]; load_row_f32(ng, lane, n); load_row_f32(sc, lane, c); load_row_f32(sh, lane, R.s); if (gt) load_row_f32(gt, lane, R.g);
#pragma unroll
    for (int q = 0; q < 4; ++q) R.a[q] = n[q] * (1.f + c[q]);
}
__device__ __forceinline__ void load_row_bf16raw(const bf16* p, int lane, u32x2 (&v)[4]) {
#pragma unroll
    for (int j = 0; j < 4; ++j) v[j] = *(const u32x2*)(p + 4 * lane + 256 * j);
}
__device__ __forceinline__ void store_row_fp8(unsigned char* p, int lane, const f32x4 (&v)[4]) {
#pragma unroll
    for (int j = 0; j < 4; ++j) { int w = 0; w = __builtin_amdgcn_cvt_pk_fp8_f32(v[j].x, v[j].y, w, false); w = __builtin_amdgcn_cvt_pk_fp8_f32(v[j].z, v[j].w, w, true); *(unsigned*)(p + 4 * lane + 256 * j) = (unsigned)w; }
}
__device__ __forceinline__ void load_row_fp8raw(const unsigned char* p, int lane, unsigned (&v)[4]) {
#pragma unroll
    for (int j = 0; j < 4; ++j) v[j] = *(const unsigned*)(p + 4 * lane + 256 * j);
}
__device__ __forceinline__ f32x4 fp8x4(unsigned w) { const f32x2 lo = __builtin_amdgcn_cvt_pk_f32_fp8((int)w, false), hi = __builtin_amdgcn_cvt_pk_f32_fp8((int)w, true); return (f32x4){lo.x, lo.y, hi.x, hi.y}; }
__device__ __forceinline__ f32x4 bf4(u32x2 w) { return (f32x4){__uint_as_float(w.x << 16), __uint_as_float(w.x & 0xffff0000u), __uint_as_float(w.y << 16), __uint_as_float(w.y & 0xffff0000u)}; }
__device__ __forceinline__ float row_rstd(const f32x4 (&v)[4]) {
    float s = 0.f;
#pragma unroll
    for (int j = 0; j < 4; ++j) s += (v[j].x * v[j].x + v[j].y * v[j].y) + (v[j].z * v[j].z + v[j].w * v[j].w);
    return 1.0f / sqrtf(wave_sum(s) * (1.f / D) + EPS);
}

__device__ __forceinline__ void phase_r1(const Args& A, const Ctx& C, int l) {
    LAS int* sb = (LAS int*)C.lds;
    LAS float* GW = (LAS float*)(C.lds + 256);
    const bool mls = (l & 1) == 0; const int j = l >> 1;
    if (l > 0) slot_bases(A, l - 1, sb, C.tid);
    if (mls) { const float* w = A.in[8] + (size_t)j * D * PROJ + PW;
        f32x4 t[2][4];
#pragma unroll
        for (int jj = 0; jj < 2; ++jj)
#pragma unroll
            for (int q = 0; q < 4; ++q) t[jj][q] = *(const f32x4*)(w + (size_t)(C.tid + NT * jj) * PROJ + 4 * q);
#pragma unroll
        for (int jj = 0; jj < 2; ++jj)
#pragma unroll
            for (int q = 0; q < 4; ++q) { const int k = C.tid + NT * jj; GW[(4 * q + 0) * D + k] = t[jj][q].x; GW[(4 * q + 1) * D + k] = t[jj][q].y; GW[(4 * q + 2) * D + k] = t[jj][q].z; GW[(4 * q + 3) * D + k] = t[jj][q].w; }
        __syncthreads(); }
    const int nrows = (l <= 2) ? NR : NL;
    bf16* LAT = (bf16*)(A.ws + WS_LAT); bf16* H = (bf16*)(A.ws + WS_HB); float* GATE = (float*)(A.ws + WS_GATE);
    const float* MOD = (const float*)(A.ws + WS_MOD); const unsigned char* Y8 = A.ws + WS_PB;
    const int* TS = (const int*)(A.ws + WS_TOKSLOT); const float* TW = (const float*)(A.ws + WS_TOKW);
    const int rpw = (((nrows + C.G - 1) / C.G) + 1) & ~1; const int wrow0 = C.bid * rpw; const int wend = min(wrow0 + rpw, nrows);
    for (int sa = wrow0; sa < wend;) {
        const int mvi = mod_vec_of_row(sa); const int bnd = mvi == 0 ? SEQ : (mvi == 1 ? NL : NR); const int sbnd = min(wend, bnd);
        RowVec RV; { const float* mv = MOD + (size_t)(l * 3 + mvi) * 6 * D;
            load_rowvec(RV, A.in[6] + (size_t)(l * 2 + 0) * D, mv + 0 * D, mv + 1 * D, l > 0 ? MOD + (size_t)((l - 1) * 3 + mvi) * 6 * D + 5 * D : nullptr, C.lane); }
        for (int ra = sa + 2 * C.wave; ra < sbnd; ra += 2 * NW) {
            const bool hasb = ra + 1 < sbnd; const int rb = hasb ? ra + 1 : ra;
            f32x4 va[4], vb[4]; float wa0 = 0.f, wa1 = 0.f, wb0 = 0.f, wb1 = 0.f;
            if (l == 0) { load_row_f32(ra < NL ? A.in[0] + (size_t)ra * D : A.in[2] + (size_t)(ra - NL) * D, C.lane, va); load_row_f32(rb < NL ? A.in[0] + (size_t)rb * D : A.in[2] + (size_t)(rb - NL) * D, C.lane, vb); }
            else {
                const int ta0 = TS[ra * 2], ta1 = TS[ra * 2 + 1], tb0 = TS[rb * 2], tb1 = TS[rb * 2 + 1]; wa0 = TW[ra * 2]; wa1 = TW[ra * 2 + 1]; wb0 = TW[rb * 2]; wb1 = TW[rb * 2 + 1];
                load_row_bf16(LAT + (size_t)ra * D, C.lane, va); load_row_bf16(LAT + (size_t)rb * D, C.lane, vb);
                unsigned ya0[4], ya1[4], yb0[4], yb1[4];
                load_row_fp8raw(Y8 + (size_t)(sb[ta0 >> 20] + (ta0 & 0xfffff)) * D, C.lane, ya0); load_row_fp8raw(Y8 + (size_t)(sb[ta1 >> 20] + (ta1 & 0xfffff)) * D, C.lane, ya1);
                load_row_fp8raw(Y8 + (size_t)(sb[tb0 >> 20] + (tb0 & 0xfffff)) * D, C.lane, yb0); load_row_fp8raw(Y8 + (size_t)(sb[tb1 >> 20] + (tb1 & 0xfffff)) * D, C.lane, yb1);
                wa0 *= 1.0f / YSCALE; wa1 *= 1.0f / YSCALE; wb0 *= 1.0f / YSCALE; wb1 *= 1.0f / YSCALE;
#pragma unroll
                for (int q = 0; q < 4; ++q) { va[q] += RV.g[q] * (fp8x4(ya0[q]) * wa0 + fp8x4(ya1[q]) * wa1); vb[q] += RV.g[q] * (fp8x4(yb0[q]) * wb0 + fp8x4(yb1[q]) * wb1); }
            }
            store_row_bf16(LAT + (size_t)ra * D, C.lane, va); if (hasb) store_row_bf16(LAT + (size_t)rb * D, C.lane, vb);
            const float rra = row_rstd(va), rrb = row_rstd(vb);
            f32x4 ha[4], hb[4];
#pragma unroll
            for (int q = 0; q < 4; ++q) { ha[q] = (va[q] * rra) * RV.a[q] + RV.s[q]; hb[q] = (vb[q] * rrb) * RV.a[q] + RV.s[q]; }
            store_row_bf16(H + (size_t)ra * D, C.lane, ha); if (hasb) store_row_bf16(H + (size_t)rb * D, C.lane, hb);
            if (mls) {
                float ga = 0.f, gb = 0.f;
#pragma unroll 2
                for (int c = 0; c < 16; ++c) { float s0 = 0.f, s1 = 0.f;
#pragma unroll
                    for (int q = 0; q < 4; ++q) { const f32x4 w = *(const LAS f32x4*)(GW + c * D + 4 * C.lane + 256 * q);
                        s0 += (ha[q].x * w.x + ha[q].y * w.y) + (ha[q].z * w.z + ha[q].w * w.w); s1 += (hb[q].x * w.x + hb[q].y * w.y) + (hb[q].z * w.z + hb[q].w * w.w); }
                    s0 = wave_sum(s0); s1 = wave_sum(s1); ga = (C.lane == c) ? s0 : ga; gb = (C.lane == c) ? s1 : gb; }
                if (C.lane < 16) {
                    const float bgt = A.in[9][j * 16 + C.lane]; const int gtype = C.lane >> 2;
                    ga += bgt; gb += bgt;
                    GATE[(size_t)ra * 16 + C.lane] = (gtype & 1) ? logsigmoidf_(ga) : 15.0f * tanhf(ga * (1.0f / 15.0f));
                    if (hasb) GATE[(size_t)rb * 16 + C.lane] = (gtype & 1) ? logsigmoidf_(gb) : 15.0f * tanhf(gb * (1.0f / 15.0f)); }
            }
        }
        sa = sbnd;
    }
}

__device__ __forceinline__ void phase_r2(const Args& A, const Ctx& C, int l) {
    constexpr int WP = 2064;
    LAS unsigned char* RWB = C.lds;
    LAS float* WL = (LAS float*)(C.lds + 48 * WP);
    LAS unsigned* hist = (LAS unsigned*)(WL + 8 * 16 * 48);
    LAS unsigned* gbase = hist + 32;
    constexpr int RCAP = 144;
    LAS int* rec = (LAS int*)(gbase + 32);
    static_assert(48 * WP + 8 * 16 * 48 * 4 + 256 + RCAP * 16 <= LDS_TAB_END, "R2 LDS map");
    cvt_moe_items(A, C, l, cvt_t2(l, C.G) + C.bid * NW + C.wave, CVT_ITEMS, C.G * NW);
    __syncthreads();
    { const float* wg = A.in[15] + (size_t)l * D * NGRP; const float* wr = A.in[17] + (size_t)l * D * NE;
      { const int kp = C.tid; const f32x4 x0 = *(const f32x4*)(wg + (size_t)(2 * kp) * 4), x1 = *(const f32x4*)(wg + (size_t)(2 * kp + 1) * 4);
        *(LAS unsigned*)(RWB + 0 * WP + kp * 4) = cvt2(x0.x, x1.x); *(LAS unsigned*)(RWB + 1 * WP + kp * 4) = cvt2(x0.y, x1.y);
        *(LAS unsigned*)(RWB + 2 * WP + kp * 4) = cvt2(x0.z, x1.z); *(LAS unsigned*)(RWB + 3 * WP + kp * 4) = cvt2(x0.w, x1.w); }
      f32x4 t0[8], t1[8];
#pragma unroll
      for (int jj = 0; jj < 8; ++jj) { const int it = C.tid + NT * jj, kp = it >> 3, cg = it & 7; t0[jj] = *(const f32x4*)(wr + (size_t)(2 * kp) * NE + 4 * cg); t1[jj] = *(const f32x4*)(wr + (size_t)(2 * kp + 1) * NE + 4 * cg); }
#pragma unroll
      for (int jj = 0; jj < 8; ++jj) { const int it = C.tid + NT * jj, kp = it >> 3, c0 = 4 + 4 * (it & 7);
          *(LAS unsigned*)(RWB + (c0 + 0) * WP + kp * 4) = cvt2(t0[jj].x, t1[jj].x); *(LAS unsigned*)(RWB + (c0 + 1) * WP + kp * 4) = cvt2(t0[jj].y, t1[jj].y);
          *(LAS unsigned*)(RWB + (c0 + 2) * WP + kp * 4) = cvt2(t0[jj].z, t1[jj].z); *(LAS unsigned*)(RWB + (c0 + 3) * WP + kp * 4) = cvt2(t0[jj].w, t1[jj].w); }
      for (int i = C.tid; i < 12 * 512; i += NT) *(LAS unsigned*)(RWB + (36 + i / 512) * WP + (i % 512) * 4) = 0u; }
    const int nrows = (l <= 1) ? NR : NL;
    bf16* LAT = (bf16*)(A.ws + WS_LAT); bf16* H = (bf16*)(A.ws + WS_HB); unsigned char* H8 = A.ws + WS_H8;
    const float* MOD = (const float*)(A.ws + WS_MOD);
    unsigned* cnt = (unsigned*)(A.ws + WS_CTL) + CW_CNT + l * 32 * CNT_STRIDE;
    int* TS = (int*)(A.ws + WS_TOKSLOT); float* TW = (float*)(A.ws + WS_TOKW); int* ST = (int*)(A.ws + WS_SLOTTOK);
    const int rpw = (((nrows + C.G - 1) / C.G) + 1) & ~1; const int wrow0 = C.bid * rpw; const int wend0 = min(wrow0 + rpw, nrows);
    const float* bg = A.in[16] + l * NGRP; const float* br = A.in[18] + l * NE;
    for (int cb = wrow0; cb < wend0; cb += RCAP) {
        const int wend = min(cb + RCAP, wend0);
        if (C.tid < 32) hist[C.tid] = 0u;
        for (int sa = cb; sa < wend;) {
            const int mvi = mod_vec_of_row(sa); const int bnd = mvi == 0 ? SEQ : (mvi == 1 ? NL : NR); const int sbnd = min(wend, bnd);
            RowVec RV; { const float* mv = MOD + (size_t)(l * 3 + mvi) * 6 * D; load_rowvec(RV, A.in[6] + (size_t)(l * 2 + 1) * D, mv + 3 * D, mv + 4 * D, mv + 2 * D, C.lane); }
            const int rlast = sbnd - 2;
            u32x2 la[4], lb[4], ya[4], yb[4];
            { const int r0 = min(sa + 2 * C.wave, rlast); load_row_bf16raw(LAT + (size_t)r0 * D, C.lane, la); load_row_bf16raw(LAT + (size_t)(r0 + 1) * D, C.lane, lb);
              load_row_bf16raw(H + (size_t)r0 * D, C.lane, ya); load_row_bf16raw(H + (size_t)(r0 + 1) * D, C.lane, yb); }
            for (int ra = sa + 2 * C.wave; ra < sbnd; ra += 2 * NW) {
                const int rb = ra + 1;
                u32x2 lan[4], lbn[4], yan[4], ybn[4];
                { const int r1 = min(ra + 2 * NW, rlast); load_row_bf16raw(LAT + (size_t)r1 * D, C.lane, lan); load_row_bf16raw(LAT + (size_t)(r1 + 1) * D, C.lane, lbn);
                  load_row_bf16raw(H + (size_t)r1 * D, C.lane, yan); load_row_bf16raw(H + (size_t)(r1 + 1) * D, C.lane, ybn); }
                f32x4 va[4], vb[4];
#pragma unroll
                for (int q = 0; q < 4; ++q) { va[q] = bf4(la[q]) + RV.g[q] * bf4(ya[q]); vb[q] = bf4(lb[q]) + RV.g[q] * bf4(yb[q]); }
                store_row_bf16(LAT + (size_t)ra * D, C.lane, va); store_row_bf16(LAT + (size_t)rb * D, C.lane, vb);
                const float rra = row_rstd(va), rrb = row_rstd(vb);
                f32x4 ha[4], hb[4];
#pragma unroll
                for (int q = 0; q < 4; ++q) { ha[q] = (va[q] * rra) * RV.a[q] + RV.s[q]; hb[q] = (vb[q] * rrb) * RV.a[q] + RV.s[q]; }
                store_row_bf16(H + (size_t)ra * D, C.lane, ha); store_row_bf16(H + (size_t)rb * D, C.lane, hb);
                store_row_fp8(H8 + (size_t)ra * D, C.lane, ha); store_row_fp8(H8 + (size_t)rb * D, C.lane, hb);
#pragma unroll
                for (int q = 0; q < 4; ++q) { la[q] = lan[q]; lb[q] = lbn[q]; ya[q] = yan[q]; yb[q] = ybn[q]; }
            }
            sa = sbnd;
        }
        __syncthreads();
        const int fr = C.lane & 15, fq = C.lane >> 4;
        for (int t = C.wave; t * 16 < wend - cb; t += NW) {
            const int trow = min(cb + 16 * t + fr, wend - 1);
            const bf16* hp = H + (size_t)trow * D + 8 * fq;
            f32x4 acc[3];
#pragma unroll
            for (int ct = 0; ct < 3; ++ct) acc[ct] = (f32x4){0.f, 0.f, 0.f, 0.f};
#pragma unroll 1
            for (int kb = 0; kb < 4; ++kb) {
                bf16x8 av[8];
#pragma unroll
                for (int k8 = 0; k8 < 8; ++k8) av[k8] = *(const bf16x8*)(hp + 32 * (8 * kb + k8));
#pragma unroll
                for (int k8 = 0; k8 < 8; ++k8)
#pragma unroll
                    for (int ct = 0; ct < 3; ++ct) { const bf16x8 bv = *(const LAS bf16x8*)(RWB + (ct * 16 + fr) * WP + (32 * (8 * kb + k8) + 8 * fq) * 2);
                        acc[ct] = __builtin_amdgcn_mfma_f32_16x16x32_bf16(av[k8], bv, acc[ct], 0, 0, 0); }
            }
            LAS float* wl = WL + C.wave * 16 * 48;
#pragma unroll
            for (int ct = 0; ct < 3; ++ct)
#pragma unroll
                for (int jq = 0; jq < 4; ++jq) wl[(4 * fq + jq) * 48 + ct * 16 + fr] = acc[ct][jq];
            asm volatile("s_waitcnt lgkmcnt(0)" ::: "memory");
            const int row = cb + 16 * t + C.lane;
            if (C.lane < 16 && row < wend) {
                LAS const float* wm = wl + C.lane * 48;
                float lg[36];
#pragma unroll
                for (int c = 0; c < 36; ++c) lg[c] = wm[c];
                float gl[4]; int grp = 0; float gm = -3.0e38f;
#pragma unroll
                for (int c = 0; c < 4; ++c) { gl[c] = lg[c] + bg[c]; if (gl[c] > gm) { gm = gl[c]; grp = c; } }
                float gs = 0.f;
#pragma unroll
                for (int c = 0; c < 4; ++c) gs += __expf(gl[c] - gm);
                const float pgrp = 1.0f / gs;
                float rl[8];
#pragma unroll
                for (int i = 0; i < 8; ++i) { float tt = 0.f;
#pragma unroll
                    for (int g = 0; g < 4; ++g) tt = (g == grp) ? lg[4 + g * 8 + i] : tt;
                    rl[i] = tt + br[grp * 8 + i]; }
                int i0 = 0; float m0 = rl[0];
#pragma unroll
                for (int i = 1; i < 8; ++i) if (rl[i] > m0) { m0 = rl[i]; i0 = i; }
                int i1 = -1; float m1 = -3.0e38f;
#pragma unroll
                for (int i = 0; i < 8; ++i) if (i != i0 && rl[i] > m1) { m1 = rl[i]; i1 = i; }
                const float p0 = 1.0f, p1 = __expf(m1 - m0);
                const float w0 = pgrp * p0 / (p0 + p1), w1 = pgrp * p1 / (p0 + p1);
                const int e0 = grp * 8 + i0, e1 = grp * 8 + i1;
                const unsigned q0 = __hip_atomic_fetch_add(hist + e0, 1u, __ATOMIC_RELAXED, __HIP_MEMORY_SCOPE_WORKGROUP), q1 = __hip_atomic_fetch_add(hist + e1, 1u, __ATOMIC_RELAXED, __HIP_MEMORY_SCOPE_WORKGROUP);
                const int li = row - cb;
                rec[li * 4 + 0] = e0 | (e1 << 8); rec[li * 4 + 1] = (int)q0; rec[li * 4 + 2] = (int)q1;
                TW[row * 2 + 0] = w0; TW[row * 2 + 1] = w1;
            }
        }
        __syncthreads();
        if (C.tid < 32) gbase[C.tid] = hist[C.tid] ? atomicAdd(cnt + C.tid * CNT_STRIDE, hist[C.tid]) : 0u;
        __syncthreads();
        for (int i = C.tid; i < wend - cb; i += NT) { const int row = cb + i; const int ee = rec[i * 4], e0 = ee & 255, e1 = ee >> 8;
            const unsigned q0 = gbase[e0] + (unsigned)rec[i * 4 + 1], q1 = gbase[e1] + (unsigned)rec[i * 4 + 2];
            ST[(size_t)e0 * CAP + q0] = row; ST[(size_t)e1 * CAP + q1] = row;
            TS[row * 2 + 0] = (e0 << 20) | (int)q0; TS[row * 2 + 1] = (e1 << 20) | (int)q1; }
        __syncthreads();
    }
}

__device__ __forceinline__ void phase_final(const Args& A, const Ctx& C) {
    LAS int* sb = (LAS int*)C.lds;
    slot_bases(A, 3, sb, C.tid);
    const bf16* LAT = (const bf16*)(A.ws + WS_LAT); const unsigned char* Y8 = A.ws + WS_PB;
    const int* TS = (const int*)(A.ws + WS_TOKSLOT); const float* TW = (const float*)(A.ws + WS_TOKW);
    const float* MOD = (const float*)(A.ws + WS_MOD);
    f32x4 fg[4]; load_row_f32(A.in[7], C.lane, fg);
    const int rpw = (((NL + C.G - 1) / C.G) + 1) & ~1; const int wrow0 = C.bid * rpw; const int wend = min(wrow0 + rpw, NL);
    for (int sa = wrow0; sa < wend;) {
        const int mvi = mod_vec_of_row(sa); const int sbnd = min(wend, mvi == 0 ? SEQ : NL);
        f32x4 g2[4]; load_row_f32(MOD + (size_t)(3 * 3 + mvi) * 6 * D + 5 * D, C.lane, g2);
        for (int ra = sa + 2 * C.wave; ra < sbnd; ra += 2 * NW) {
            const int rb = ra + 1;
            const int ta0 = TS[ra * 2], ta1 = TS[ra * 2 + 1], tb0 = TS[rb * 2], tb1 = TS[rb * 2 + 1]; const float wa0 = TW[ra * 2], wa1 = TW[ra * 2 + 1], wb0 = TW[rb * 2], wb1 = TW[rb * 2 + 1];
            f32x4 va[4], vb[4]; unsigned ya0[4], ya1[4], yb0[4], yb1[4];
            load_row_bf16(LAT + (size_t)ra * D, C.lane, va); load_row_bf16(LAT + (size_t)rb * D, C.lane, vb);
            load_row_fp8raw(Y8 + (size_t)(sb[ta0 >> 20] + (ta0 & 0xfffff)) * D, C.lane, ya0); load_row_fp8raw(Y8 + (size_t)(sb[ta1 >> 20] + (ta1 & 0xfffff)) * D, C.lane, ya1);
            load_row_fp8raw(Y8 + (size_t)(sb[tb0 >> 20] + (tb0 & 0xfffff)) * D, C.lane, yb0); load_row_fp8raw(Y8 + (size_t)(sb[tb1 >> 20] + (tb1 & 0xfffff)) * D, C.lane, yb1);
#pragma unroll
            for (int q = 0; q < 4; ++q) { va[q] += g2[q] * (fp8x4(ya0[q]) * (wa0 * (1.0f / YSCALE)) + fp8x4(ya1[q]) * (wa1 * (1.0f / YSCALE))); vb[q] += g2[q] * (fp8x4(yb0[q]) * (wb0 * (1.0f / YSCALE)) + fp8x4(yb1[q]) * (wb1 * (1.0f / YSCALE))); }
            const float rra = row_rstd(va), rrb = row_rstd(vb);
#pragma unroll
            for (int q = 0; q < 4; ++q) { *(f32x4*)(A.out + (size_t)ra * D + 4 * C.lane + 256 * q) = (va[q] * rra) * fg[q]; *(f32x4*)(A.out + (size_t)rb * D + 4 * C.lane + 256 * q) = (vb[q] * rrb) * fg[q]; }
        }
        sa = sbnd;
    }
}

__device__ __forceinline__ void phase_conv(const Args& A, const Ctx& C, int l) {
    const int j = l >> 1; const int nrows = (l <= 1) ? NR : NL;
    const bf16* P = (const bf16*)(A.ws + WS_PB); bf16* HM = (bf16*)(A.ws + WS_HM);
    const float* cw = A.in[13] + (size_t)j * 3 * D;
    for (int row = C.bid * NW + C.wave; row < nrows; row += C.G * NW) {
        bool hasl, hasr;
        if (row < NL) { const int t = row & 63; hasl = t != 0; hasr = t != 63; } else { const int t = (row - NL) & 255; hasl = t != 0; hasr = t != 255; }
        f32x4 bg[4], z[4], w0[4], w1[4], w2[4], acc[4];
        const bf16* pr = P + (size_t)row * PW;
        load_row_bf16(pr, C.lane, bg); load_row_bf16(pr + D, C.lane, z);
        load_row_f32(cw, C.lane, w0); load_row_f32(cw + D, C.lane, w1); load_row_f32(cw + 2 * D, C.lane, w2);
#pragma unroll
        for (int q = 0; q < 4; ++q) acc[q] = w1[q] * z[q];
        if (hasl) { load_row_bf16(pr - PW + D, C.lane, z);
#pragma unroll
            for (int q = 0; q < 4; ++q) acc[q] += w0[q] * z[q]; }
        if (hasr) { load_row_bf16(pr + PW + D, C.lane, z);
#pragma unroll
            for (int q = 0; q < 4; ++q) acc[q] += w2[q] * z[q]; }
#pragma unroll
        for (int q = 0; q < 4; ++q) acc[q] *= bg[q];
        store_row_bf16(HM + (size_t)row * D, C.lane, acc);
    }
}

constexpr int BM = 256, BK = 64, HALF = 128, HTB = HALF * BK * 2, STAGE_BYTES = 8 * HTB, NXCD = 8, WGM = 8;
constexpr int LDS_TAB = STAGE_BYTES;
__device__ __forceinline__ int lds_byte(int r, int c) { const int st = (r >> 4) * 2 + (c >> 5), rr = r & 15, cc = c & 31, ob = rr * 64 + cc * 2; return st * 1024 + (ob ^ (((ob >> 9) & 1) << 5)); }
__device__ __forceinline__ void stage_rc(int b, int& R, int& C) { const int st = b / 1024, sb = b % 1024, swz = sb ^ (((sb >> 9) & 1) << 5); R = (st >> 1) * 16 + swz / 64; C = (st & 1) * 32 + (swz % 64) / 2; }
__device__ __forceinline__ int perm32(int rho) { const int n = rho >> 4, i = rho & 15; return 8 * (i >> 2) + 4 * n + (i & 3); }
__device__ __forceinline__ unsigned cvt_pk_bf16(float lo, float hi) { unsigned r; asm volatile("v_cvt_pk_bf16_f32 %0, %1, %2" : "=v"(r) : "v"(lo), "v"(hi)); return r; }

struct GUnit { const char* a; const char* b; int orow, ocol, aux; };

typedef int i32x8 __attribute__((ext_vector_type(8)));
typedef int i32x4 __attribute__((ext_vector_type(4)));
template <class Epi, class Sched, bool GATHER, bool FP8 = false>
__device__ __forceinline__ void gemm_phase(LAS unsigned char* lds, const int K, const Sched& S, const Epi& E) {
    const int tid = threadIdx.x, wid = __builtin_amdgcn_readfirstlane(tid >> 6), lane = tid & 63, wr = wid >> 2, wc = wid & 3, fr = lane & 15, fq = lane >> 4;
    const int RB = FP8 ? K : 2 * K;
    const int nt = RB / (BK * 2);
    unsigned voffB[2], voA[2][2]; int Rr[2], Cc[2];
#pragma unroll
    for (int i = 0; i < 2; ++i) { int R, C; stage_rc(tid * 16 + i * 8192, R, C); const int Rb = (R & ~31) + perm32(R & 31); Rr[i] = R; Cc[i] = C;
        voffB[i] = (unsigned)(Rb * RB + C * 2);
        voA[0][i] = (unsigned)(R * RB + C * 2); voA[1][i] = (unsigned)((R + HALF) * RB + C * 2); }
    const size_t kstep = (size_t)(BK * 2);
    const size_t hstep = (size_t)HALF * RB;
    const unsigned ldsw = (unsigned)wid * 1024u;
    const unsigned ldsbase = (unsigned)(size_t)lds;
    const int aoff = lds_byte(wr * 64 + fr, fq * 8), boff = lds_byte(wc * 32 + fr, fq * 8);
#define PG8_SA(b, h) (((b) * 2 + (h)) * HTB)
#define PG8_SB(b, h) ((4 + (b) * 2 + (h)) * HTB)
#define PG8_STAGE(bufoff, gbase, voff) do { _Pragma("unroll") for (int _i = 0; _i < 2; ++_i) \
        asm volatile("s_mov_b32 m0, %2\n\ts_nop 0\n\tglobal_load_lds_dwordx4 %0, %1" :: "v"((voff)[_i]), "s"((const char*)(gbase)), "s"(ldsbase + (unsigned)(bufoff) + ldsw + (unsigned)(_i * 8192)) : "memory"); } while (0)
#define PG8_STAGE_A1(bufoff, gbase) do { if constexpr (GATHER) PG8_STAGE(bufoff, gbase, voA[1]); else PG8_STAGE(bufoff, (const char*)(gbase) + hstep, voA[0]); } while (0)
#define PG8_LDA(dst, b, h) do { if constexpr (FP8) { _Pragma("unroll") for (int m = 0; m < 4; ++m) { \
        const i32x4 _lo = *(const LAS i32x4*)(lds + PG8_SA(b, h) + aoff + m * 2048), _hi = *(const LAS i32x4*)(lds + PG8_SA(b, h) + aoff + m * 2048 + 1024); \
        dst##8[m] = __builtin_shufflevector(_lo, _hi, 0, 1, 2, 3, 4, 5, 6, 7); } } \
      else { _Pragma("unroll") for (int m = 0; m < 4; ++m) _Pragma("unroll") for (int k = 0; k < 2; ++k) dst[m][k] = *(const LAS bf16x8*)(lds + PG8_SA(b, h) + aoff + m * 2048 + k * 1024); } } while (0)
#define PG8_LDB(dst, b, h) do { if constexpr (FP8) { _Pragma("unroll") for (int n = 0; n < 2; ++n) { \
        const i32x4 _lo = *(const LAS i32x4*)(lds + PG8_SB(b, h) + boff + n * 2048), _hi = *(const LAS i32x4*)(lds + PG8_SB(b, h) + boff + n * 2048 + 1024); \
        dst##8[n] = __builtin_shufflevector(_lo, _hi, 0, 1, 2, 3, 4, 5, 6, 7); } } \
      else { _Pragma("unroll") for (int n = 0; n < 2; ++n) _Pragma("unroll") for (int k = 0; k < 2; ++k) dst[n][k] = *(const LAS bf16x8*)(lds + PG8_SB(b, h) + boff + n * 2048 + k * 1024); } } while (0)
#define PG8_MMA(ai, bj, At, Bt) do { __builtin_amdgcn_s_setprio(1); \
        if constexpr (FP8) { _Pragma("unroll") for (int m = 0; m < 4; ++m) _Pragma("unroll") for (int n = 0; n < 2; ++n) \
            acc[ai][bj][m][n] = __builtin_amdgcn_mfma_scale_f32_16x16x128_f8f6f4(Bt##8[n], At##8[m], acc[ai][bj][m][n], 0, 0, 0, 0x7f7f7f7f, 0, 0x7f7f7f7f); } \
        else { _Pragma("unroll") for (int m = 0; m < 4; ++m) _Pragma("unroll") for (int n = 0; n < 2; ++n) _Pragma("unroll") for (int k = 0; k < 2; ++k) \
            acc[ai][bj][m][n] = __builtin_amdgcn_mfma_f32_16x16x32_bf16(Bt[n][k], At[m][k], acc[ai][bj][m][n], 0, 0, 0); } \
        __builtin_amdgcn_s_setprio(0); } while (0)
#define PG8_WAIT_V(n) asm volatile("s_waitcnt vmcnt(" #n ")" ::: "memory")
#define PG8_WAIT_L(n) asm volatile("s_waitcnt lgkmcnt(" #n ")" ::: "memory")
#define PG8_BAR __builtin_amdgcn_s_barrier()
#define PG8_SCHED __builtin_amdgcn_sched_barrier(0)
    GUnit cur, nxt; int ui = 0;
    if (!S.next(0, cur)) return;
    if constexpr (GATHER) {
#pragma unroll
        for (int h = 0; h < 2; ++h)
#pragma unroll
            for (int i = 0; i < 2; ++i) voA[h][i] = S.arow_off(0, h * HALF + Rr[i]) + (unsigned)Cc[i] * 2u;
    }
    f32x4 acc[2][2][4][2];
#pragma unroll
    for (int a = 0; a < 2; ++a)
#pragma unroll
        for (int b = 0; b < 2; ++b)
#pragma unroll
            for (int m = 0; m < 4; ++m)
#pragma unroll
                for (int n = 0; n < 2; ++n) acc[a][b][m][n] = (f32x4){0.f, 0.f, 0.f, 0.f};
    bf16x8 At[4][2], B0[2][2], B1[2][2]; i32x8 At8[4], B08[2], B18[2];
    const char* cA = cur.a; const char* cB = cur.b;
    PG8_STAGE(PG8_SB(0, 0), cB, voffB); PG8_STAGE(PG8_SB(0, 1), cB + hstep, voffB); PG8_STAGE(PG8_SA(0, 0), cA, voA[0]); PG8_STAGE_A1(PG8_SA(0, 1), cA);
    if (wr == 1) PG8_BAR;
    PG8_WAIT_V(2); PG8_BAR;
    PG8_STAGE(PG8_SB(1, 0), cB + kstep, voffB); PG8_STAGE(PG8_SA(1, 0), cA + kstep, voA[0]); PG8_STAGE(PG8_SB(1, 1), cB + hstep + kstep, voffB);
    PG8_WAIT_V(6); PG8_BAR;
    for (;;) {
        const bool has_next = S.next(ui + 1, nxt);
        const char* nA = has_next ? nxt.a : cA; const char* nB = has_next ? nxt.b : cB;
#pragma unroll 1
        for (int t = 0; t < nt; t += 2) {
            const bool last = (t == nt - 2);
            const char* a1 = cA + (size_t)(t + 1) * kstep;
            const char* a2 = last ? nA : cA + (size_t)(t + 2) * kstep; const char* b2 = last ? nB : cB + (size_t)(t + 2) * kstep;
            const char* a3 = a2 + kstep; const char* b3 = b2 + kstep;
            PG8_LDB(B0, 0, 0); PG8_LDB(B1, 0, 1); PG8_SCHED; PG8_LDA(At, 0, 0); PG8_STAGE_A1(PG8_SA(1, 1), a1);
            if constexpr (GATHER) { if (last && has_next) {
#pragma unroll
                for (int h = 0; h < 2; ++h)
#pragma unroll
                    for (int i = 0; i < 2; ++i) { int R2, C2; stage_rc(tid * 16 + i * 8192, R2, C2); voA[h][i] = S.arow_off(ui + 1, h * HALF + R2) + (unsigned)C2 * 2u; } } }
            PG8_WAIT_V(8); PG8_WAIT_L(0); PG8_BAR; PG8_MMA(0, 0, At, B0); PG8_MMA(0, 1, At, B1); PG8_BAR; PG8_SCHED;
            PG8_LDA(At, 0, 1); PG8_STAGE(PG8_SB(0, 0), b2, voffB); PG8_STAGE(PG8_SB(0, 1), b2 + hstep, voffB); PG8_STAGE(PG8_SA(0, 0), a2, voA[0]);
            PG8_WAIT_V(8); PG8_WAIT_L(0); PG8_BAR; PG8_MMA(1, 0, At, B0); PG8_MMA(1, 1, At, B1); PG8_BAR; PG8_SCHED;
            PG8_LDB(B0, 1, 0); PG8_LDB(B1, 1, 1); PG8_SCHED; PG8_LDA(At, 1, 0); PG8_STAGE_A1(PG8_SA(0, 1), a2);
            PG8_WAIT_V(8); PG8_WAIT_L(0); PG8_BAR; PG8_MMA(0, 0, At, B0); PG8_MMA(0, 1, At, B1); PG8_BAR; PG8_SCHED;
            PG8_LDA(At, 1, 1); PG8_STAGE(PG8_SB(1, 0), b3, voffB); PG8_STAGE(PG8_SB(1, 1), b3 + hstep, voffB); PG8_STAGE(PG8_SA(1, 0), a3, voA[0]);
            PG8_WAIT_V(8); PG8_WAIT_L(0); PG8_BAR; PG8_MMA(1, 0, At, B0); PG8_MMA(1, 1, At, B1); PG8_BAR; PG8_SCHED;
        }
        if (wr == 0) PG8_BAR;
        { int tz = threadIdx.x; asm volatile("" : "+v"(tz));
          const int wz = tz >> 6, lz = tz & 63; E(acc, cur, wz >> 2, wz & 3, lz & 15, lz >> 4); }
        if (!has_next) break;
#pragma unroll
        for (int a = 0; a < 2; ++a)
#pragma unroll
            for (int b = 0; b < 2; ++b)
#pragma unroll
                for (int m = 0; m < 4; ++m)
#pragma unroll
                    for (int n = 0; n < 2; ++n) acc[a][b][m][n] = (f32x4){0.f, 0.f, 0.f, 0.f};
        cur = nxt; cA = nA; cB = nB; ++ui;
        if (wr == 1) PG8_BAR;
    }
    PG8_WAIT_V(0);
    PG8_BAR;
#undef PG8_SA
#undef PG8_SB
#undef PG8_STAGE
#undef PG8_STAGE_A1
#undef PG8_LDA
#undef PG8_LDB
#undef PG8_MMA
#undef PG8_WAIT_V
#undef PG8_WAIT_L
#undef PG8_BAR
#undef PG8_SCHED
}

__device__ __forceinline__ int xcd_remap(int L, int nwg) { const int q = nwg / NXCD, r = nwg % NXCD, xcd = L % NXCD, off = L / NXCD; return (xcd < r ? xcd * (q + 1) : r * (q + 1) + (xcd - r) * q) + off; }

struct DenseSched {
    const char* A; const char* Bt; int nM, nN, nwg, G, c; size_t tstep; int sw_lo, sw_hi;
    __device__ __forceinline__ void init(const void* A_, const void* Bt_, int M, int N, int K, int G_, int c_) { A = (const char*)A_; Bt = (const char*)Bt_; nM = M / BM; nN = N / BM; nwg = nM * nN; G = G_; c = c_; tstep = (size_t)BM * K * 2; sw_lo = 0; sw_hi = 0; }
    __device__ __forceinline__ bool next(int i, GUnit& u) const {
        const long L = (long)i * G + c; if (L >= nwg) return false;
        const int wgid = xcd_remap((int)L, nwg);
        const int nig = WGM * nN, gid = wgid / nig, fm = gid * WGM, gsz = (nM - fm) < WGM ? (nM - fm) : WGM;
        const int pm = fm + ((wgid % nig) % gsz), pn = (wgid % nig) / gsz;
        if (pn >= sw_lo && pn < sw_hi) { u.a = Bt + (size_t)pn * tstep; u.b = A + (size_t)pm * tstep; u.orow = pm; u.ocol = pn - sw_lo; u.aux = 1; }
        else { u.a = A + (size_t)pm * tstep; u.b = Bt + (size_t)pn * tstep; u.orow = pm * BM; u.ocol = pn * BM; u.aux = 0; }
        return true;
    }
    __device__ __forceinline__ unsigned arow_off(int, int) const { return 0u; }
};

constexpr int MAXU = 12;
struct MoeTab { int n; int e[MAXU], mb[MAXU], nt[MAXU]; int sb[NE + 1]; };
struct MoeSched {
    LAS const MoeTab* T; LAS const unsigned* ridx;
    const char* A; const char* W; size_t wstride_e, tstepB; int K; int arow_bytes;
    __device__ __forceinline__ bool next(int i, GUnit& u) const {
        const int n = __builtin_amdgcn_readfirstlane(T->n); if (i >= n) return false;
        const int e = __builtin_amdgcn_readfirstlane(T->e[i]), mb = __builtin_amdgcn_readfirstlane(T->mb[i]), nt = __builtin_amdgcn_readfirstlane(T->nt[i]);
        const int base = __builtin_amdgcn_readfirstlane(T->sb[e]);
        u.orow = base + mb * BM; u.ocol = nt; u.aux = e;
        u.a = A + (size_t)u.orow * arow_bytes;
        u.b = W + (size_t)e * wstride_e + (size_t)nt * tstepB; return true;
    }
    __device__ __forceinline__ unsigned arow_off(int i, int r) const { return ridx[i * 256 + r]; }
};
template <bool GATHER>
__device__ __forceinline__ void moe_tables(const Args& A, const Ctx& C, int l, int ntile_n, LAS MoeTab* T, LAS unsigned* ridx, int arow_bytes) {
    const unsigned* cnt = (const unsigned*)(A.ws + WS_CTL) + CW_CNT + l * 32 * CNT_STRIDE;
    LAS int* ust = (LAS int*)(T + 1);
    if (C.tid == 0) { int acc = 0, ua = 0; for (int e = 0; e < NE; ++e) { T->sb[e] = acc; ust[e] = ua; const int nb = ((int)cnt[e * CNT_STRIDE] + 255) / 256; acc += nb * 256; ua += nb * ntile_n; } T->sb[NE] = acc; ust[NE] = ua;
        const int nwg = ua; int n = 0;
        for (int i = 0; i < MAXU; ++i) { const long L = (long)i * C.G + C.bid; if (L >= nwg) break; const int w = xcd_remap((int)L, nwg); int e = 0; while (w >= ust[e + 1]) ++e;
            const int lu = w - ust[e]; T->e[i] = e; T->mb[i] = lu / ntile_n; T->nt[i] = lu % ntile_n; ++n; }
        T->n = n; }
    __syncthreads();
    if constexpr (GATHER) {
        const int* ST = (const int*)(A.ws + WS_SLOTTOK); const int n = T->n;
        for (int i = C.tid; i < n * 256; i += NT) { const int ui = i >> 8, r = i & 255, e = T->e[ui], m0 = T->mb[ui] * 256, ce = (int)cnt[e * CNT_STRIDE];
            const int rr = (m0 + r < ce) ? m0 + r : ce - 1;
            ridx[i] = (unsigned)ST[(size_t)e * CAP + rr] * (unsigned)arow_bytes; }
        __syncthreads();
    }
}

struct EpiStore { bf16* O; int ldc; float scale_lo; int sig_from; bf16* VT;
    __device__ __forceinline__ void operator()(const f32x4 (&acc)[2][2][4][2], const GUnit& u, int wr, int wc, int fr, int fq) const {
        const bool tr = u.aux != 0;
        const float sc = (!tr && u.ocol < NQ) ? scale_lo : 1.0f; const bool sg = !tr && u.ocol >= sig_from;
        bf16* Ob = tr ? VT + (size_t)(u.orow * NH + u.ocol) * 65536 : O + (size_t)u.orow * ldc + u.ocol; const int ld = tr ? 256 : ldc;
#pragma unroll
        for (int ai = 0; ai < 2; ++ai)
#pragma unroll
            for (int m = 0; m < 4; ++m) { bf16* rowp = Ob + (size_t)(ai * HALF + wr * 64 + m * 16 + fr) * ld + wc * 32 + 8 * fq;
#pragma unroll
                for (int bj = 0; bj < 2; ++bj) { f32x4 v0 = acc[ai][bj][m][0] * sc, v1 = acc[ai][bj][m][1] * sc;
                    if (sg) {
#pragma unroll
                        for (int q = 0; q < 4; ++q) { v0[q] = __builtin_amdgcn_rcpf(1.0f + __expf(-v0[q])); v1[q] = __builtin_amdgcn_rcpf(1.0f + __expf(-v1[q])); } }
                    u32x4 w; w.x = cvt_pk_bf16(v0[0], v0[1]); w.y = cvt_pk_bf16(v0[2], v0[3]); w.z = cvt_pk_bf16(v1[0], v1[1]); w.w = cvt_pk_bf16(v1[2], v1[3]);
                    *(u32x4*)(rowp + bj * HALF) = w; } }
    }
};
__device__ __forceinline__ u32x2 cvt8_fp8(f32x4 a, f32x4 b) { int lo = 0, hi = 0;
    lo = __builtin_amdgcn_cvt_pk_fp8_f32(a[0], a[1], lo, false); lo = __builtin_amdgcn_cvt_pk_fp8_f32(a[2], a[3], lo, true);
    hi = __builtin_amdgcn_cvt_pk_fp8_f32(b[0], b[1], hi, false); hi = __builtin_amdgcn_cvt_pk_fp8_f32(b[2], b[3], hi, true); return (u32x2){(unsigned)lo, (unsigned)hi}; }
struct EpiSwigluF8 { unsigned char* O; int ldc; float s;
    __device__ __forceinline__ void operator()(const f32x4 (&acc)[2][2][4][2], const GUnit& u, int wr, int wc, int fr, int fq) const {
        const int ocol = u.ocol * HALF;
#pragma unroll
        for (int ai = 0; ai < 2; ++ai)
#pragma unroll
            for (int m = 0; m < 4; ++m) { unsigned char* rowp = O + (size_t)(u.orow + ai * HALF + wr * 64 + m * 16 + fr) * ldc + ocol + wc * 32 + 8 * fq;
                f32x4 v0, v1;
#pragma unroll
                for (int q = 0; q < 4; ++q) { const float x0 = acc[ai][0][m][0][q] * s, x1 = acc[ai][0][m][1][q] * s;
                    v0[q] = x0 * __builtin_amdgcn_rcpf(1.0f + __expf(-x0)) * (acc[ai][1][m][0][q] * s); v1[q] = x1 * __builtin_amdgcn_rcpf(1.0f + __expf(-x1)) * (acc[ai][1][m][1][q] * s); }
                *(u32x2*)rowp = cvt8_fp8(v0, v1); }
    }
};
template <int MODE> struct EpiPair { bf16* O; int ldc; int plain_below;
    __device__ __forceinline__ void operator()(const f32x4 (&acc)[2][2][4][2], const GUnit& u, int wr, int wc, int fr, int fq) const {
        if (MODE == 0 && u.ocol < plain_below) {
#pragma unroll
            for (int ai = 0; ai < 2; ++ai)
#pragma unroll
                for (int m = 0; m < 4; ++m) { bf16* rowp = O + (size_t)(u.orow + ai * HALF + wr * 64 + m * 16 + fr) * ldc + u.ocol + wc * 32 + 8 * fq;
#pragma unroll
                    for (int bj = 0; bj < 2; ++bj) { const f32x4 v0 = acc[ai][bj][m][0], v1 = acc[ai][bj][m][1];
                        u32x4 w; w.x = cvt_pk_bf16(v0[0], v0[1]); w.y = cvt_pk_bf16(v0[2], v0[3]); w.z = cvt_pk_bf16(v1[0], v1[1]); w.w = cvt_pk_bf16(v1[2], v1[3]);
                        *(u32x4*)(rowp + bj * HALF) = w; } }
            return;
        }
        const int ocol = (MODE == 0) ? plain_below + (u.ocol - plain_below) / 2 : u.ocol * HALF;
#pragma unroll
        for (int ai = 0; ai < 2; ++ai)
#pragma unroll
            for (int m = 0; m < 4; ++m) { bf16* rowp = O + (size_t)(u.orow + ai * HALF + wr * 64 + m * 16 + fr) * ldc + ocol + wc * 32 + 8 * fq;
                f32x4 v0, v1;
#pragma unroll
                for (int q = 0; q < 4; ++q) {
                    const float x0 = acc[ai][0][m][0][q], x1 = acc[ai][0][m][1][q];
                    const float g0 = (MODE == 1) ? x0 * __builtin_amdgcn_rcpf(1.0f + __expf(-x0)) : x0, g1 = (MODE == 1) ? x1 * __builtin_amdgcn_rcpf(1.0f + __expf(-x1)) : x1;
                    v0[q] = g0 * acc[ai][1][m][0][q]; v1[q] = g1 * acc[ai][1][m][1][q]; }
                u32x4 w; w.x = cvt_pk_bf16(v0[0], v0[1]); w.y = cvt_pk_bf16(v0[2], v0[3]); w.z = cvt_pk_bf16(v1[0], v1[1]); w.w = cvt_pk_bf16(v1[2], v1[3]);
                *(u32x4*)rowp = w; }
    }
};
struct EpiStoreTile { unsigned char* O; int ldc; float s;
    __device__ __forceinline__ void operator()(const f32x4 (&acc)[2][2][4][2], const GUnit& u, int wr, int wc, int fr, int fq) const {
#pragma unroll
        for (int ai = 0; ai < 2; ++ai)
#pragma unroll
            for (int m = 0; m < 4; ++m) { unsigned char* rowp = O + (size_t)(u.orow + ai * HALF + wr * 64 + m * 16 + fr) * ldc + u.ocol * BM + wc * 32 + 8 * fq;
#pragma unroll
                for (int bj = 0; bj < 2; ++bj) *(u32x2*)(rowp + bj * HALF) = cvt8_fp8(acc[ai][bj][m][0] * s, acc[ai][bj][m][1] * s); }
    }
};

__device__ __forceinline__ void transpose_item(const float* W, int ldw, int K, bf16* WT, int drow0, int k0, int n0, LAS float* scr, int lane) {
#pragma unroll
    for (int i = 0; i < 32; ++i) { const int kk = 2 * i + (lane >> 5); scr[kk * 33 + (lane & 31)] = W[(size_t)(k0 + kk) * ldw + n0 + (lane & 31)]; }
    asm volatile("s_waitcnt lgkmcnt(0)" ::: "memory");
    const int c = lane & 7;
#pragma unroll
    for (int j = 0; j < 4; ++j) { const int n = (lane >> 3) + 8 * j; const LAS float* s = scr + (8 * c) * 33 + n;
        u32x4 o; o.x = pk2(s[0 * 33], s[1 * 33]); o.y = pk2(s[2 * 33], s[3 * 33]); o.z = pk2(s[4 * 33], s[5 * 33]); o.w = pk2(s[6 * 33], s[7 * 33]);
        *(u32x4*)(WT + (size_t)(drow0 + n) * K + k0 + 8 * c) = o; }
    asm volatile("s_waitcnt lgkmcnt(0)" ::: "memory");
}
__device__ __forceinline__ void transpose_item_fp8(const float* W, int ldw, int K, unsigned char* WT8, int drow0, int k0, int n0, LAS float* scr, int lane, float sc) {
#pragma unroll
    for (int i = 0; i < 32; ++i) { const int kk = 2 * i + (lane >> 5); scr[kk * 33 + (lane & 31)] = W[(size_t)(k0 + kk) * ldw + n0 + (lane & 31)]; }
    asm volatile("s_waitcnt lgkmcnt(0)" ::: "memory");
    const int n = lane >> 1, half = lane & 1; const LAS float* sp = scr + (32 * half) * 33 + n;
    unsigned char* dst = WT8 + (size_t)(drow0 + n) * K + k0 + 32 * half;
#pragma unroll
    for (int c = 0; c < 2; ++c) { u32x4 o;
#pragma unroll
        for (int q = 0; q < 4; ++q) { int p = 0; const LAS float* s4 = sp + (16 * c + 4 * q) * 33;
            p = __builtin_amdgcn_cvt_pk_fp8_f32(s4[0] * sc, s4[33] * sc, p, false); p = __builtin_amdgcn_cvt_pk_fp8_f32(s4[66] * sc, s4[99] * sc, p, true); o[q] = (unsigned)p; }
        *(u32x4*)(dst + 16 * c) = o; }
    asm volatile("s_waitcnt lgkmcnt(0)" ::: "memory");
}
__device__ __forceinline__ int pair_row(int n, int which) { return (n >> 7) * 256 + (n & 127) + which * 128; }
__device__ __forceinline__ void phase_cvt_mixer(const Args& A, const Ctx& C) {
    LAS float* scr = (LAS float*)(C.lds + 16384 + C.wave * 16384);
    const int gw = C.bid * NW + C.wave, NGW = C.G * NW;
    constexpr int I_IN = (D / 64) * (PW / 32), I_OUT = (D / 64) * (D / 32), PER = 2 * (I_IN + I_OUT);
    for (int it = gw; it < 2 * PER; it += NGW) {
        const int kind = it / PER; int r = it % PER; const int j = r / (I_IN + I_OUT); r %= (I_IN + I_OUT);
        if (r < I_IN) { const int kb = r / (PW / 32), nb = r % (PW / 32), n0 = nb * 32;
            bf16* WT = (bf16*)(A.ws + (kind == 0 ? WS_WAIN : WS_WBIN)) + (size_t)j * PW * D;
            if (kind == 0) transpose_item(A.in[8] + (size_t)j * D * PROJ, PROJ, D, WT, n0, kb * 64, n0, scr, C.lane);
            else { const int drow = n0 < D ? n0 : (n0 < 2 * D ? D + pair_row(n0 - D, 0) : D + pair_row(n0 - 2 * D, 1));
                transpose_item(A.in[12] + (size_t)j * D * PW, PW, D, WT, drow, kb * 64, n0, scr, C.lane); } }
        else { r -= I_IN; const int kb = r / (D / 32), nb = r % (D / 32), n0 = nb * 32;
            bf16* WT = (bf16*)(A.ws + (kind == 0 ? WS_WAOUT : WS_WBOUT)) + (size_t)j * D * D;
            transpose_item((kind == 0 ? A.in[11] : A.in[14]) + (size_t)j * D * D, D, D, WT, n0, kb * 64, n0, scr, C.lane); }
    }
}
constexpr float WSCALE = 32.0f;
__device__ __forceinline__ void cvt_moe_items(const Args& A, const Ctx& C, int l, int it0, int end, int stride) {
    LAS float* scr = (LAS float*)(C.lds + 16384 + C.wave * 16384);
    unsigned char* WGU = A.ws + WS_WGU; unsigned char* WDN = A.ws + WS_WDN;
    for (int it = it0; it < end; it += stride) {
        const int e = it / CVT_PER; int r = it % CVT_PER;
        if (r < 2 * CVT_IG) { const int which = r / CVT_IG; r %= CVT_IG; const int kb = r / (DE / 32), nb = r % (DE / 32), n0 = nb * 32;
            transpose_item_fp8((which == 0 ? A.in[19] : A.in[20]) + ((size_t)l * NE + e) * D * DE, DE, D, WGU + (size_t)e * 2 * DE * D, pair_row(n0, which), kb * 64, n0, scr, C.lane, WSCALE); }
        else { r -= 2 * CVT_IG; const int kb = r / (D / 32), nb = r % (D / 32), n0 = nb * 32;
            transpose_item_fp8(A.in[21] + ((size_t)l * NE + e) * DE * D, D, DE, WDN + (size_t)e * D * DE, n0, kb * 64, n0, scr, C.lane, WSCALE); }
    }
}
__device__ __forceinline__ int cvt_idle(int nunits, int G) { const int rem = nunits % G; return rem ? G - rem : 0; }
__device__ __forceinline__ int cvt_t1(int l, int G) { const int n = cvt_idle((((l <= 2) ? NR : NL) / BM) * (PW / BM), G) * CVT_Q; return n < CVT_ITEMS ? n : CVT_ITEMS; }
__device__ __forceinline__ int cvt_t2(int l, int G) { const int n = cvt_t1(l, G) + cvt_idle((((l <= 1) ? NR : NL) / BM) * (D / BM), G) * CVT_Q; return n < CVT_ITEMS ? n : CVT_ITEMS; }
__device__ __forceinline__ void cvt_moe_tail(const Args& A, const Ctx& C, int l, int nunits, int base, int end) {
    const int rem = nunits % C.G;
    if (rem == 0 || C.bid < rem) return;
    const int first = base + (C.bid - rem) * CVT_Q; const int last = min(first + CVT_Q, end);
    cvt_moe_items(A, C, l, first + C.wave, last, NW);
}

__device__ __forceinline__ void phase_g1(const Args& A, const Ctx& C, int l) {
    const bool mls = (l & 1) == 0; const int j = l >> 1; const int nrows = (l <= 2) ? NR : NL;
    DenseSched S; S.init(A.ws + WS_HB, A.ws + (mls ? WS_WAIN : WS_WBIN) + (size_t)j * PW * D * 2, nrows, PW, D, C.G, C.bid);
    if (mls) { S.sw_lo = 4; S.sw_hi = 8; EpiStore E{(bf16*)(A.ws + WS_PB), PW, 0.08838834764831845f, 2 * NQ + NV, (bf16*)(A.ws + WS_VT)}; gemm_phase<EpiStore, DenseSched, false>(C.lds, D, S, E); }
    else { EpiPair<0> E{(bf16*)(A.ws + WS_PB), PW, D}; gemm_phase<EpiPair<0>, DenseSched, false>(C.lds, D, S, E); }
    cvt_moe_tail(A, C, l, S.nwg, 0, cvt_t1(l, C.G));
}
__device__ __forceinline__ void phase_g2(const Args& A, const Ctx& C, int l) {
    const bool mls = (l & 1) == 0; const int j = l >> 1; const int nrows = (l <= 1) ? NR : NL;
    DenseSched S; S.init(A.ws + WS_HM, A.ws + (mls ? WS_WAOUT : WS_WBOUT) + (size_t)j * D * D * 2, nrows, D, D, C.G, C.bid);
    EpiStore E{(bf16*)(A.ws + WS_HB), D, 1.0f, 1 << 30, nullptr}; gemm_phase<EpiStore, DenseSched, false>(C.lds, D, S, E);
    cvt_moe_tail(A, C, l, S.nwg, cvt_t1(l, C.G), cvt_t2(l, C.G));
}
__device__ __forceinline__ void phase_m1(const Args& A, const Ctx& C, int l) {
    LAS MoeTab* T = (LAS MoeTab*)(C.lds + LDS_TAB); LAS unsigned* ridx = (LAS unsigned*)(C.lds + LDS_TAB + 1024);
    moe_tables<true>(A, C, l, 4, T, ridx, D);
    MoeSched S; S.T = T; S.ridx = ridx; S.A = (const char*)(A.ws + WS_H8); S.W = (const char*)(A.ws + WS_WGU); S.wstride_e = (size_t)2 * DE * D; S.tstepB = (size_t)BM * D; S.K = D; S.arow_bytes = 0;
    EpiSwigluF8 E{A.ws + WS_DC, DE, 1.0f / WSCALE}; gemm_phase<EpiSwigluF8, MoeSched, true, true>(C.lds, D, S, E);
}
__device__ __forceinline__ void phase_m2(const Args& A, const Ctx& C, int l) {
    LAS MoeTab* T = (LAS MoeTab*)(C.lds + LDS_TAB); LAS unsigned* ridx = (LAS unsigned*)(C.lds + LDS_TAB + 1024);
    moe_tables<false>(A, C, l, 4, T, ridx, DE);
    MoeSched S; S.T = T; S.ridx = ridx; S.A = (const char*)(A.ws + WS_DC); S.W = (const char*)(A.ws + WS_WDN); S.wstride_e = (size_t)D * DE; S.tstepB = (size_t)BM * DE; S.K = DE; S.arow_bytes = DE;
    EpiStoreTile E{A.ws + WS_PB, D, YSCALE / WSCALE}; gemm_phase<EpiStoreTile, MoeSched, false, true>(C.lds, DE, S, E);
}

typedef float f32x16 __attribute__((ext_vector_type(16)));
#define MFMA32(a, b, c) __builtin_amdgcn_mfma_f32_32x32x16_bf16((a), (b), (c), 0, 0, 0)
__device__ __forceinline__ bf16x8 pack8(float a0, float a1, float a2, float a3, float a4, float a5, float a6, float a7) {
    u32x4 p; p.x = cvt2(a0, a1); p.y = cvt2(a2, a3); p.z = cvt2(a4, a5); p.w = cvt2(a6, a7); return __builtin_bit_cast(bf16x8, p); }
__device__ __forceinline__ float bflo(unsigned w) { return __uint_as_float(w << 16); }
__device__ __forceinline__ float bfhi(unsigned w) { return __uint_as_float(w & 0xffff0000u); }
__device__ __forceinline__ int vt_tile(int b, int h, int blk) { return (blk == 0 ? 128 + b : b * 64 + blk - 1) * NH + h; }

__device__ __forceinline__ float wave_incl_scan(float v, int lane) {
#pragma unroll
    for (int o = 1; o < 64; o <<= 1) { const float t = __shfl_up(v, o); v += (lane >= o) ? t : 0.f; }
    return v;
}
__device__ __forceinline__ void block_gates(const Args& A, int row0, int h, LAS float* bf, LAS float* bb, LAS float* lif, LAS float* lib, int tid) {
    const float* GATE = (const float*)(A.ws + WS_GATE);
    if (tid < 256) { const float* g = GATE + (size_t)(row0 + tid) * 16; lif[tid] = g[0 + h]; bf[tid] = g[4 + h]; lib[tid] = g[8 + h]; bb[tid] = g[12 + h]; }
    __syncthreads();
    const int lane = tid & 63, wv = tid >> 6;
    if (wv == 0) { f32x4 x = *(LAS f32x4*)(bf + 4 * lane); x.y += x.x; x.z += x.y; x.w += x.z; const float tot = wave_incl_scan(x.w, lane); const float ex = tot - x.w;
        x.x += ex; x.y += ex; x.z += ex; x.w += ex; *(LAS f32x4*)(bf + 4 * lane) = x; }
    if (wv == 1) { f32x4 y = *(LAS f32x4*)(bb + 4 * (63 - lane)); y.z += y.w; y.y += y.z; y.x += y.y; const float tot = wave_incl_scan(y.x, lane); const float ex = tot - y.x;
        y.x += ex; y.y += ex; y.z += ex; y.w += ex; *(LAS f32x4*)(bb + 4 * (63 - lane)) = y; }
    __syncthreads();
}
__device__ __forceinline__ void phase_s1(const Args& A, const Ctx& C, int l) {
    LAS float* bf = (LAS float*)C.lds; LAS float* bb = bf + 256; LAS float* lif = bb + 256; LAS float* lib = lif + 256; LAS float* af = lib + 256; LAS float* ab = af + 256;
    constexpr int KP = 528;
    LAS unsigned char* KTf = C.lds + 8192; LAS unsigned char* KTb = KTf + 128 * KP;
    const bf16* P = (const bf16*)(A.ws + WS_PB); const bf16* VT = (const bf16*)(A.ws + WS_VT);
    float* DC = (float*)(A.ws + WS_DC); float* DN = (float*)(A.ws + WS_DN); float* BT = (float*)(A.ws + WS_BTOT);
    const int r = C.lane & 31, hh = C.lane >> 5, w = C.wave;
    for (int u = C.bid; u < NUNIT; u += C.G) {
        const int blk = u % NBLK, bh = u / NBLK, h = bh % NH, b = bh / NH; const int row0 = blk_row0(b, blk);
        block_gates(A, row0, h, bf, bb, lif, lib, C.tid);
        if (C.tid < 256) { af[C.tid] = __expf(bf[255] - bf[C.tid] + lif[C.tid]); ab[C.tid] = __expf(bb[0] - bb[C.tid] + lib[C.tid]); }
        if (C.tid == 0) { BT[u * 2 + 0] = bf[255]; BT[u * 2 + 1] = bb[0]; }
        __syncthreads();
        { const int sp = C.tid >> 2, dq = C.tid & 3, s0 = 2 * sp;
          const bf16* k0 = P + (size_t)(row0 + s0) * PW + NQ + h * DQK + 32 * dq;
          const float f0 = af[s0], f1 = af[s0 + 1], g0 = ab[s0], g1 = ab[s0 + 1];
#pragma unroll
          for (int c = 0; c < 4; ++c) { const u32x4 x0 = *(const u32x4*)(k0 + 8 * c), x1 = *(const u32x4*)(k0 + PW + 8 * c);
#pragma unroll
              for (int q = 0; q < 4; ++q) { const int d = 32 * dq + 8 * c + 2 * q;
                  const float a0 = bflo(x0[q]), a1 = bfhi(x0[q]), c0 = bflo(x1[q]), c1 = bfhi(x1[q]);
                  *(LAS unsigned*)(KTf + d * KP + s0 * 2) = cvt2(a0 * f0, c0 * f1); *(LAS unsigned*)(KTf + (d + 1) * KP + s0 * 2) = cvt2(a1 * f0, c1 * f1);
                  *(LAS unsigned*)(KTb + d * KP + s0 * 2) = cvt2(a0 * g0, c0 * g1); *(LAS unsigned*)(KTb + (d + 1) * KP + s0 * 2) = cvt2(a1 * g0, c1 * g1); } } }
        __syncthreads();
        if (C.tid < 256) { const int dir = C.tid >> 7, d = C.tid & 127; LAS const unsigned* kr = (LAS const unsigned*)((dir ? KTb : KTf) + d * KP); float s = 0.f;
            for (int i = 0; i < 128; ++i) { const unsigned x = kr[i]; s += bflo(x) + bfhi(x); }
            DN[(size_t)(u * 2 + dir) * DQK + d] = s; }
        const bf16* vt = VT + (size_t)vt_tile(b, h, blk) * 65536 + (size_t)(32 * w + r) * 256 + 8 * hh;
        f32x16 accf[4], accb[4];
#pragma unroll
        for (int dt = 0; dt < 4; ++dt)
#pragma unroll
            for (int i = 0; i < 16; ++i) { accf[dt][i] = 0.f; accb[dt][i] = 0.f; }
#pragma unroll 2
        for (int ks = 0; ks < 16; ++ks) { const bf16x8 a = *(const bf16x8*)(vt + 16 * ks);
#pragma unroll
            for (int dt = 0; dt < 4; ++dt) { const int off = (dt * 32 + r) * KP + (16 * ks + 8 * hh) * 2;
                const bf16x8 b0 = *(const LAS bf16x8*)(KTf + off), b1 = *(const LAS bf16x8*)(KTb + off);
                accf[dt] = MFMA32(a, b0, accf[dt]); accb[dt] = MFMA32(a, b1, accb[dt]); } }
        float* dcf = DC + (size_t)(u * 2 + 0) * DQK * DV + (size_t)(32 * w + 4 * hh) * DQK + r; float* dcb = dcf + DQK * DV;
#pragma unroll
        for (int g = 0; g < 4; ++g) { float* pf = dcf + g * 8 * DQK; float* pb = dcb + g * 8 * DQK; asm volatile("" : "+v"(pf), "+v"(pb));
#pragma unroll
            for (int q = 0; q < 4; ++q)
#pragma unroll
                for (int dt = 0; dt < 4; ++dt) { pf[q * DQK + dt * 32] = accf[dt][4 * g + q]; pb[q * DQK + dt * 32] = accb[dt][4 * g + q]; } }
        __syncthreads();
    }
}
__device__ __forceinline__ void phase_s2(const Args& A, const Ctx& C) {
    const float* __restrict__ DC = (const float*)(A.ws + WS_DC); const float* __restrict__ DN = (const float*)(A.ws + WS_DN); const float* __restrict__ BT = (const float*)(A.ws + WS_BTOT);
    bf16* __restrict__ CST = (bf16*)(A.ws + WS_CST); float* __restrict__ NST = (float*)(A.ws + WS_NST);
    constexpr int EL4 = DQK * DV / 4;
    for (int g = C.bid * NT + C.tid; g < BATCH * NH * 2 * EL4; g += C.G * NT) {
        const int e4 = (g % EL4) * 4, ch = g / EL4, dir = ch & 1, bh = ch >> 1;
        f32x4 st = (f32x4){0.f, 0.f, 0.f, 0.f};
#pragma unroll 13
        for (int idx = 0; idx < NBLK; ++idx) {
            const int blk = dir == 0 ? idx : (idx == 0 ? 0 : NBLK - idx); const int u = bh * NBLK + blk;
            const float dec = __expf(BT[u * 2 + dir]);
            const f32x4 dc = *(const f32x4*)(DC + (size_t)(u * 2 + dir) * DQK * DV + e4);
            u32x2 o; o.x = cvt2(st.x, st.y); o.y = cvt2(st.z, st.w);
            *(u32x2*)(CST + (size_t)(u * 2 + dir) * DQK * DV + e4) = o;
            st = st * dec + dc;
        }
    }
    for (int g = C.bid * NT + C.tid; g < BATCH * NH * 2 * DQK; g += C.G * NT) {
        const int d = g % DQK, ch = g / DQK, dir = ch & 1, bh = ch >> 1; float st = 0.f;
        for (int idx = 0; idx < NBLK; ++idx) {
            const int blk = dir == 0 ? idx : (idx == 0 ? 0 : NBLK - idx); const int u = bh * NBLK + blk;
            NST[(size_t)(u * 2 + dir) * DQK + d] = st; st = __expf(BT[u * 2 + dir]) * st + DN[(size_t)(u * 2 + dir) * DQK + d];
        }
    }
}
__device__ __forceinline__ void lds_barrier() { asm volatile("s_waitcnt lgkmcnt(0)" ::: "memory"); __builtin_amdgcn_s_barrier(); asm volatile("" ::: "memory"); }
__device__ __forceinline__ void phase_s3(const Args& A, const Ctx& C, int l) {
    const int jl = l >> 1; const bool ctx_out = (l == 0);
    LAS float* bf = (LAS float*)C.lds; LAS float* bb = bf + 256; LAS float* gf = bb + 256; LAS float* gb = gf + 256;
    LAS float* nf = gb + 256; LAS float* nb = nf + 128; LAS float* ssx = nb + 128;
    LAS float* cf = ssx + 256; LAS float* cb = cf + 256;
    constexpr int KP = 272, VP = 136, CP = 144, OP = 528;
    LAS unsigned char* Kimg = C.lds + 8192;
    LAS unsigned char* CH = Kimg + 256 * KP;
    static_assert(8192 + 256 * KP + 128 * OP <= LDS_TAB_END, "S3 LDS map");
    const bf16* P = (const bf16*)(A.ws + WS_PB); const bf16* VT = (const bf16*)(A.ws + WS_VT); bf16* HM = (bf16*)(A.ws + WS_HM);
    const bf16* CST = (const bf16*)(A.ws + WS_CST); const float* NST = (const float*)(A.ws + WS_NST);
    const float* hg = A.in[10] + (size_t)jl * NV;
    const int w = C.wave, eh = w >> 2;
    for (int u = C.bid; u < NUNIT; u += C.G) {
        const int blk = u % NBLK, bh = u / NBLK, h = bh % NH, b = bh / NH; const int row0 = blk_row0(b, blk);
        if (blk == 0 && !ctx_out) continue;
        int tu = threadIdx.x; asm volatile("" : "+v"(tu));
        block_gates(A, row0, h, bf, bb, gf, gb, tu);
        if (tu < 256) { gf[tu] -= bf[tu]; gb[tu] -= bb[tu]; cf[tu] = __expf(bf[tu | 31] + gf[tu]); cb[tu] = __expf(bb[tu & ~31] + gb[tu]); }
        else { const int t2 = tu - 256; nf[t2] = NST[(size_t)(u * 2 + (t2 >> 7)) * DQK + (t2 & 127)]; }
        { const int pc = tu & 15, s0 = tu >> 4; const bf16* kr = P + (size_t)(row0 + s0) * PW + NQ + h * DQK + 8 * pc;
#pragma unroll
          for (int i = 0; i < 8; ++i) *(LAS u32x4*)(Kimg + (s0 + 32 * i) * KP + pc * 16) = *(const u32x4*)(kr + (size_t)(32 * i) * PW); }
        __syncthreads();
        const bf16* vtile = VT + (size_t)vt_tile(b, h, blk) * 65536;
        const bf16* ctile = CST + (size_t)(u * 2) * DQK * DV;
#pragma unroll 1
        for (int ps = 0; ps < 2; ++ps) {
            int lz = threadIdx.x & 63; asm volatile("" : "+v"(lz));
            const int r = lz & 31, hh = lz >> 5;
            const int jt = 2 * (w & 3) + ps; const int jrow = row0 + 32 * jt + r;
            bf16x8 qf[8];
            { const bf16* qr = P + (size_t)jrow * PW + h * DQK + 8 * hh;
#pragma unroll
              for (int kk = 0; kk < 8; ++kk) qf[kk] = *(const bf16x8*)(qr + 16 * kk); }
            const float bfj = bf[32 * jt + r], bbj = bb[32 * jt + r];
            float qnf = 0.f, qnb = 0.f;
#pragma unroll
            for (int kk = 0; kk < 8; ++kk) { const u32x4 qq = __builtin_bit_cast(u32x4, qf[kk]); const int d = 16 * kk + 8 * hh;
                const f32x4 n0 = *(const LAS f32x4*)(nf + d), n1 = *(const LAS f32x4*)(nf + d + 4), m0 = *(const LAS f32x4*)(nb + d), m1 = *(const LAS f32x4*)(nb + d + 4);
                qnf += (bflo(qq.x) * n0.x + bfhi(qq.x) * n0.y) + (bflo(qq.y) * n0.z + bfhi(qq.y) * n0.w) + (bflo(qq.z) * n1.x + bfhi(qq.z) * n1.y) + (bflo(qq.w) * n1.z + bfhi(qq.w) * n1.w);
                qnb += (bflo(qq.x) * m0.x + bfhi(qq.x) * m0.y) + (bflo(qq.y) * m0.z + bfhi(qq.y) * m0.w) + (bflo(qq.z) * m1.x + bfhi(qq.z) * m1.y) + (bflo(qq.w) * m1.z + bfhi(qq.w) * m1.w);
                if (kk & 1) asm volatile("" ::: "memory"); }
            qnf += __shfl_xor(qnf, 32); qnb += __shfl_xor(qnb, 32);
            u32x4 pre[4];
            { int tz = threadIdx.x; asm volatile("" : "+v"(tz)); const int pc = tz & 7, e0 = tz >> 3; const bf16* vr = vtile + (size_t)e0 * 256 + 8 * pc;
#pragma unroll
              for (int c4 = 0; c4 < 4; ++c4) pre[c4] = *(const u32x4*)(vr + (size_t)(64 * c4) * 256); }
            float denf = 0.f, denb = 0.f;
#pragma unroll 1
            for (int kt = 0; kt < 8; ++kt) {
                f32x16 c;
#pragma unroll
                for (int i = 0; i < 16; ++i) c[i] = 0.f;
#pragma unroll
                for (int kk = 0; kk < 8; ++kk) { const bf16x8 a = *(const LAS bf16x8*)(Kimg + (kt * 32 + r) * KP + (16 * kk + 8 * hh) * 2); c = MFMA32(a, qf[kk], c); }
                if (kt == jt) {
#pragma unroll
                    for (int g = 0; g < 4; ++g) { const int sl0 = 8 * g + 4 * hh;
                        const f32x4 g4f = *(const LAS f32x4*)(gf + kt * 32 + sl0), g4b = *(const LAS f32x4*)(gb + kt * 32 + sl0);
#pragma unroll
                        for (int q = 0; q < 4; ++q) { const int sl = sl0 + q; const float cv = c[4 * g + q];
                            denf += cv * __expf((sl <= r) ? bfj + g4f[q] : -1.0e30f); denb += cv * __expf((sl >= r) ? bbj + g4b[q] : -1.0e30f); } }
                } else {
                    LAS const float* cx = (kt < jt ? cf : cb) + kt * 32 + 4 * hh; float sm = 0.f;
#pragma unroll
                    for (int g = 0; g < 4; ++g) { const f32x4 c4 = *(const LAS f32x4*)(cx + 8 * g); sm += (c[4 * g] * c4.x + c[4 * g + 1] * c4.y) + (c[4 * g + 2] * c4.z + c[4 * g + 3] * c4.w); }
                    if (kt < jt) denf += sm * __expf(bfj - bf[kt * 32 + 31]); else denb += sm * __expf(bbj - bb[kt * 32]);
                }
            }
            denf += __shfl_xor(denf, 32); denb += __shfl_xor(denb, 32);
            const float ebf = __expf(bfj), ebb = __expf(bbj);
            denf += ebf * qnf; denb += ebb * qnb;
            const float rf = 1.0f / fmaxf(fabsf(denf), 1.0f), rb = 1.0f / fmaxf(fabsf(denb), 1.0f);
            const float scf = ebf * rf, scb = ebb * rb;
            f32x16 acc[4];
#pragma unroll
            for (int et = 0; et < 4; ++et)
#pragma unroll
                for (int i = 0; i < 16; ++i) acc[et][i] = 0.f;
#pragma unroll
            for (int ci = 0; ci < 8; ++ci) {
                lds_barrier();
                { int tz = threadIdx.x; asm volatile("" : "+v"(tz)); const int pc = tz & 7, e0 = tz >> 3;
                  if (ci < 4) {
#pragma unroll
                      for (int c4 = 0; c4 < 4; ++c4) { *(LAS u32x2*)(CH + (e0 + 64 * c4) * VP + pc * 16) = (u32x2){pre[c4].x, pre[c4].y}; *(LAS u32x2*)(CH + (e0 + 64 * c4) * VP + pc * 16 + 8) = (u32x2){pre[c4].z, pre[c4].w}; }
                  } else {
#pragma unroll
                      for (int c4 = 0; c4 < 4; ++c4) *(LAS u32x4*)(CH + (e0 + 64 * c4) * CP + pc * 16) = pre[c4];
                  }
                  if (ci < 7) { const int cn = ci + 1;
                      const bf16* src = (cn < 4) ? vtile + (size_t)e0 * 256 + 64 * cn + 8 * pc : ctile + (size_t)(cn >= 6 ? DQK * DV : 0) + (size_t)e0 * DQK + 64 * (cn & 1) + 8 * pc;
                      const size_t rstep = (cn < 4) ? (size_t)64 * 256 : (size_t)64 * DQK;
#pragma unroll
                      for (int c4 = 0; c4 < 4; ++c4) pre[c4] = *(const u32x4*)(src + c4 * rstep); } }
                lds_barrier();
                if (ci < 4) {
#pragma unroll 1
                    for (int kt2 = 0; kt2 < 2; ++kt2) { const int kt = 2 * ci + kt2;
                        f32x16 c;
#pragma unroll
                        for (int i = 0; i < 16; ++i) c[i] = 0.f;
#pragma unroll
                        for (int kk = 0; kk < 8; ++kk) { const bf16x8 a = *(const LAS bf16x8*)(Kimg + (kt * 32 + r) * KP + (16 * kk + 8 * hh) * 2); c = MFMA32(a, qf[kk], c); }
                        float p[16]; const float bfj2 = bf[32 * jt + r], bbj2 = bb[32 * jt + r];
                        if (kt == jt) {
#pragma unroll
                            for (int g = 0; g < 4; ++g) { const int sl0 = 8 * g + 4 * hh;
                                const f32x4 g4f = *(const LAS f32x4*)(gf + kt * 32 + sl0), g4b = *(const LAS f32x4*)(gb + kt * 32 + sl0);
#pragma unroll
                                for (int q = 0; q < 4; ++q) { const int sl = sl0 + q;
                                    const float wt = rf * __expf((sl <= r) ? bfj2 + g4f[q] : -1.0e30f) + rb * __expf((sl >= r) ? bbj2 + g4b[q] : -1.0e30f);
                                    p[4 * g + q] = c[4 * g + q] * wt; } }
                        } else {
                            LAS const float* cx = (kt < jt ? cf : cb) + kt * 32 + 4 * hh;
                            const float rw = (kt < jt) ? rf * __expf(bfj2 - bf[kt * 32 + 31]) : rb * __expf(bbj2 - bb[kt * 32]);
#pragma unroll
                            for (int g = 0; g < 4; ++g) { const f32x4 c4 = *(const LAS f32x4*)(cx + 8 * g);
                                p[4 * g] = c[4 * g] * (c4.x * rw); p[4 * g + 1] = c[4 * g + 1] * (c4.y * rw); p[4 * g + 2] = c[4 * g + 2] * (c4.z * rw); p[4 * g + 3] = c[4 * g + 3] * (c4.w * rw); }
                        }
                        const bf16x8 pa0 = pack8(p[0], p[1], p[2], p[3], p[4], p[5], p[6], p[7]), pa1 = pack8(p[8], p[9], p[10], p[11], p[12], p[13], p[14], p[15]);
#pragma unroll
                        for (int et = 0; et < 4; ++et) { LAS const unsigned char* vb = CH + ((4 * eh + et) * 32 + r) * VP + (kt2 * 32 + 4 * hh) * 2;
                            const u32x2 l0 = *(LAS const u32x2*)(vb), h0 = *(LAS const u32x2*)(vb + 16), l1 = *(LAS const u32x2*)(vb + 32), h1 = *(LAS const u32x2*)(vb + 48);
                            const bf16x8 a0 = __builtin_bit_cast(bf16x8, (u32x4){l0.x, l0.y, h0.x, h0.y}), a1 = __builtin_bit_cast(bf16x8, (u32x4){l1.x, l1.y, h1.x, h1.y});
                            acc[et] = MFMA32(a0, pa0, acc[et]); acc[et] = MFMA32(a1, pa1, acc[et]); }
                    }
                } else {
                    const int dir = (ci - 4) >> 1, dh = ci & 1;
                    const float sc = dir ? scb : scf;
#pragma unroll
                    for (int k4 = 0; k4 < 4; ++k4) { const u32x4 qq = __builtin_bit_cast(u32x4, qf[4 * dh + k4]);
                        const bf16x8 qs = pack8(bflo(qq.x) * sc, bfhi(qq.x) * sc, bflo(qq.y) * sc, bfhi(qq.y) * sc, bflo(qq.z) * sc, bfhi(qq.z) * sc, bflo(qq.w) * sc, bfhi(qq.w) * sc);
#pragma unroll
                        for (int et = 0; et < 4; ++et) { const bf16x8 a = *(const LAS bf16x8*)(CH + ((4 * eh + et) * 32 + r) * CP + (16 * k4 + 8 * hh) * 2); acc[et] = MFMA32(a, qs, acc[et]); } }
                }
            }
            float ss = 0.f;
#pragma unroll
            for (int et = 0; et < 4; ++et)
#pragma unroll
                for (int i = 0; i < 16; ++i) ss += acc[et][i] * acc[et][i];
            ss += __shfl_xor(ss, 32);
            if (hh == 0) ssx[w * 32 + r] = ss;
            lds_barrier();
            ss += ssx[(w ^ 4) * 32 + r];
            const float rs = 1.0f / sqrtf(ss * (1.0f / DV) + EPS);
            { LAS unsigned char* ob = CH + ((w & 3) * 32 + r) * OP + (eh * 128 + 4 * hh) * 2;
#pragma unroll
              for (int et = 0; et < 4; ++et)
#pragma unroll
                  for (int g = 0; g < 4; ++g) { u32x2 o; o.x = cvt2(acc[et][4 * g + 0] * rs, acc[et][4 * g + 1] * rs); o.y = cvt2(acc[et][4 * g + 2] * rs, acc[et][4 * g + 3] * rs);
                      *(LAS u32x2*)(ob + (et * 32 + 8 * g) * 2) = o; } }
            lds_barrier();
            { int tz = threadIdx.x; asm volatile("" : "+v"(tz)); const int pc = tz & 31, lr0 = tz >> 5;
              const f32x4 g0 = *(const f32x4*)(hg + h * DV + 8 * pc), g1 = *(const f32x4*)(hg + h * DV + 8 * pc + 4);
#pragma unroll
              for (int hf = 0; hf < 2; ++hf) {
              u32x4 ov[4];
#pragma unroll
              for (int i = 0; i < 4; ++i) { const int lr = lr0 + 16 * (4 * hf + i); const int grow = row0 + 64 * (lr >> 5) + 32 * ps + (lr & 31); ov[i] = *(const u32x4*)(P + (size_t)grow * PW + 2 * NQ + NV + h * DV + 8 * pc); }
#pragma unroll
              for (int i = 0; i < 4; ++i) { const int lr = lr0 + 16 * (4 * hf + i); const int grow = row0 + 64 * (lr >> 5) + 32 * ps + (lr & 31);
                  const u32x4 hv = *(const LAS u32x4*)(CH + lr * OP + pc * 16);
                  u32x4 o; o.x = cvt2(bflo(hv.x) * g0.x * bflo(ov[i].x), bfhi(hv.x) * g0.y * bfhi(ov[i].x)); o.y = cvt2(bflo(hv.y) * g0.z * bflo(ov[i].y), bfhi(hv.y) * g0.w * bfhi(ov[i].y));
                  o.z = cvt2(bflo(hv.z) * g1.x * bflo(ov[i].z), bfhi(hv.z) * g1.y * bfhi(ov[i].z)); o.w = cvt2(bflo(hv.w) * g1.z * bflo(ov[i].w), bfhi(hv.w) * g1.w * bfhi(ov[i].w));
                  *(u32x4*)(HM + (size_t)grow * D + h * DV + 8 * pc) = o; }
              asm volatile("" ::: "memory"); } }
        }
        __syncthreads();
    }
}

#define XB_TMO      128
#define XB_XCNT(j)  (256  + 64 * (j))
#define XB_XSUB(j)  (1280 + 64 * (j))
#define XB_XGEN(j)  (2304 + 64 * (j))
#define XB_TOP      3328
#define XB_TOPGEN   3392
#define XCD_BAR_WORDS 3456
#define XB_SPIN_CAP (1u << 18)

__device__ __forceinline__ unsigned xb_ld(unsigned* p)              { return __hip_atomic_load(p, __ATOMIC_RELAXED, __HIP_MEMORY_SCOPE_AGENT); }
__device__ __forceinline__ unsigned xb_add(unsigned* p, unsigned v) { return __hip_atomic_fetch_add(p, v, __ATOMIC_RELAXED, __HIP_MEMORY_SCOPE_AGENT); }
__device__ __forceinline__ unsigned xb_xcc_id() { return (unsigned)__builtin_amdgcn_s_getreg((3 << 11) | 20) & 0xFu; }
#define XB_SPIN(cond, bar) do { unsigned _sp = 0; while (cond) { __builtin_amdgcn_s_sleep(1); \
    if ((++_sp & 255u) == 0u) { if (xb_ld(&(bar)[XB_TMO])) break; if (_sp > XB_SPIN_CAP) { atomicAdd(&(bar)[XB_TMO], 1u); break; } } } } while (0)

struct XcdBarrier {
    unsigned* bar; unsigned x;
    volatile LAS unsigned* st;
};

__device__ __forceinline__ XcdBarrier xcd_barrier_post(unsigned* bar, volatile LAS unsigned* st) {
    XcdBarrier b; b.bar = bar; b.x = xb_xcc_id(); b.st = st;
    if (threadIdx.x == 0) (void)xb_add(&bar[XB_XCNT(b.x)], 1u);
    return b;
}
__device__ __forceinline__ void xcd_barrier_complete(unsigned* bar, unsigned x, unsigned& nloc, unsigned& nx) {
    const unsigned G = gridDim.x * gridDim.y * gridDim.z;
    unsigned sum, cnt, mine, sp = 0u;
    for (;;) {
        sum = 0u; cnt = 0u; mine = 0u;
#pragma unroll
        for (unsigned j = 0; j < 16; ++j) { const unsigned c = xb_ld(&bar[XB_XCNT(j)]); sum += c; cnt += (c > 0u) ? 1u : 0u; mine = (j == x) ? c : mine; }
        if (sum == G) break;
        __builtin_amdgcn_s_sleep(1);
        if ((++sp & 255u) == 0u) { if (xb_ld(&bar[XB_TMO])) break; if (sp > XB_SPIN_CAP) { atomicAdd(&bar[XB_TMO], 1u); break; } }
    }
    nloc = mine > 0u ? mine : 1u; nx = cnt > 0u ? cnt : 1u;
}

__device__ __forceinline__ void xcd_barrier(const XcdBarrier& b) {
    asm volatile("s_waitcnt vmcnt(0)" ::: "memory");
    __syncthreads();
    if (threadIdx.x == 0) {
        unsigned* bar = b.bar;
        __builtin_amdgcn_s_waitcnt(0);
        unsigned nloc = b.st[0], nx = b.st[1];
        if (nloc == 0u) { xcd_barrier_complete(bar, b.x, nloc, nx); b.st[0] = nloc; b.st[1] = nx; }
        const unsigned old = xb_add(&bar[XB_XSUB(b.x)], 1u);
        const unsigned gen = old / nloc;
        if (old + 1u == (gen + 1u) * nloc) {
            __builtin_amdgcn_fence(__ATOMIC_RELEASE, "agent");
            asm volatile("s_waitcnt vmcnt(0)" ::: "memory");
            const unsigned og = xb_add(&bar[XB_TOP], 1u);
            const unsigned tg = og / nx;
            if (og + 1u == (tg + 1u) * nx) xb_add(&bar[XB_TOPGEN], 1u);
            else XB_SPIN(xb_ld(&bar[XB_TOPGEN]) == tg, bar);
            __builtin_amdgcn_fence(__ATOMIC_ACQUIRE, "agent");
            xb_add(&bar[XB_XGEN(b.x)], 1u);
            asm volatile("s_waitcnt vmcnt(0)" ::: "memory");
        } else {
            XB_SPIN(xb_ld(&bar[XB_XGEN(b.x)]) == gen, bar);
            __builtin_amdgcn_fence(__ATOMIC_ACQUIRE, "agent");
            asm volatile("s_waitcnt vmcnt(0)" ::: "memory");
        }
    }
    __syncthreads();
}


constexpr int LDS_BYTES = 152 * 1024;
constexpr int CW_BAR = 16384;
static_assert((CW_BAR + XCD_BAR_WORDS) * 4 <= (int)CTL_BYTES, "ctl");
#ifndef MK_MULTI
#define MK_MULTI 0
#endif
#define IN(p) (lo <= (p) && (p) < hi)
#ifndef PROBE_MASK
#define PROBE_MASK 0
#endif
#define DUP(bit, call) do { call; } while (0)
#define SEAM(p) do { if ((p) + 1 < hi) { XcdBarrier b_; b_.bar = (unsigned*)(load_args().ws + WS_CTL) + CW_BAR; b_.x = xb_xcc_id(); b_.st = (volatile LAS unsigned*)(C.lds + LDS_BYTES - 16); xcd_barrier(b_); } } while (0)
#define CAS __attribute__((address_space(4)))
__device__ __forceinline__ Args load_args() {
#if defined(__HIP_DEVICE_COMPILE__)
    const CAS Args* p = (const CAS Args*)__builtin_amdgcn_kernarg_segment_ptr(); asm volatile("" : "+s"(p));
    Args a; for (int i = 0; i < 22; ++i) a.in[i] = p->in[i]; a.out = p->out; a.ws = p->ws; a.lo = p->lo; a.hi = p->hi; return a;
#else
    return Args{};
#endif
}
__device__ __forceinline__ Ctx fresh(const Ctx& C) { Ctx R = C; int tz = threadIdx.x; asm volatile("" : "+v"(tz)); R.tid = tz; R.lane = tz & 63; return R; }
template <int L> __device__ __forceinline__ void layer_phases(const Args& args, const Ctx& C, int bar, int lo, int hi) {
    constexpr int pb = 16 * L;
    if (IN(pb + 1)) { phase_r1(load_args(), fresh(C), L); SEAM(pb + 1); }
    if (IN(pb + 2)) { DUP(1, phase_g1(load_args(), fresh(C), L)); SEAM(pb + 2); }
    if constexpr ((L & 1) == 0) {
        if (IN(pb + 3)) { DUP(2, phase_s1(load_args(), fresh(C), L)); SEAM(pb + 3); }
        if (IN(pb + 4)) { DUP(2, phase_s2(load_args(), fresh(C))); SEAM(pb + 4); }
        if (IN(pb + 5)) { DUP(2, phase_s3(load_args(), fresh(C), L)); SEAM(pb + 5); }
    } else {
        if (IN(pb + 3)) { DUP(8, phase_conv(load_args(), fresh(C), L)); SEAM(pb + 3); }
    }
    if (IN(pb + 6)) { DUP(1, phase_g2(load_args(), fresh(C), L)); SEAM(pb + 6); }
    if (IN(pb + 7)) { phase_r2(load_args(), fresh(C), L); SEAM(pb + 7); }
    if (IN(pb + 8)) { DUP(1, phase_m1(load_args(), fresh(C), L)); SEAM(pb + 8); }
    if (IN(pb + 9)) { DUP(1, phase_m2(load_args(), fresh(C), L)); SEAM(pb + 9); }
}
__global__ void __launch_bounds__(NT, 2) fwd_kernel(Args args) {
    extern __shared__ __attribute__((aligned(16))) unsigned char lds_raw[];
    Ctx C; C.lds = (LAS unsigned char*)lds_raw; C.tid = threadIdx.x; C.lane = C.tid & 63; C.wave = __builtin_amdgcn_readfirstlane(C.tid >> 6); C.G = gridDim.x; C.bid = blockIdx.x; C.a = &args;
    const int lo = args.lo, hi = args.hi;
    volatile LAS unsigned* xbw = (volatile LAS unsigned*)(C.lds + LDS_BYTES - 16);
    if (C.tid < 4) xbw[C.tid] = 0u;
    __syncthreads();
    if (hi - lo > 1) (void)xcd_barrier_post((unsigned*)(args.ws + WS_CTL) + CW_BAR, xbw);
    const int bar = 0; (void)bar;
    if (IN(0)) { DUP(4, phase_mod(load_args(), fresh(C))); __syncthreads(); DUP(4, phase_cvt_mixer(load_args(), fresh(C))); SEAM(0); }
    layer_phases<0>(args, C, bar, lo, hi);
    layer_phases<1>(args, C, bar, lo, hi);
    layer_phases<2>(args, C, bar, lo, hi);
    layer_phases<3>(args, C, bar, lo, hi);
    if (IN(64)) phase_final(load_args(), fresh(C));
}
#undef IN
#undef SEAM

extern "C" void kernel_launch(void* const* d_in, const int* in_sizes, int n_in, void* d_out, int out_size, void* d_ws, size_t ws_size, hipStream_t stream) {
    static int grid = 0;
    if (grid == 0) {
        if (n_in != 22 || out_size != NL * D || ws_size < WS_END) { fprintf(stderr, "kernel_launch: unexpected shapes (n_in %d out %d ws %zu)\n", n_in, out_size, ws_size); grid = -1; return; }
        int dev = 0, cus = 0, per_cu = 0;
        if (hipGetDevice(&dev) != hipSuccess || hipDeviceGetAttribute(&cus, hipDeviceAttributeMultiprocessorCount, dev) != hipSuccess) { grid = -1; return; }
        if (hipFuncSetAttribute((const void*)fwd_kernel, hipFuncAttributeMaxDynamicSharedMemorySize, LDS_BYTES) != hipSuccess) { grid = -1; return; }
        if (hipOccupancyMaxActiveBlocksPerMultiprocessor(&per_cu, (const void*)fwd_kernel, NT, LDS_BYTES) != hipSuccess || per_cu < 1) { fprintf(stderr, "kernel_launch: occupancy query says %d\n", per_cu); }
        (void)hipGetLastError();
        grid = cus;
    }
    if (grid < 0) return;
    (void)hipMemsetAsync((char*)d_ws + WS_CTL, 0, CTL_BYTES, stream);
    Args a{};
    for (int i = 0; i < 22; ++i) a.in[i] = (const float*)d_in[i];
    a.out = (float*)d_out; a.ws = (unsigned char*)d_ws;
#if MK_MULTI
    int phases[64]; int np = 0;
    phases[np++] = 0;
    for (int l = 0; l < DEPTH; ++l) { const int pb = 16 * l; phases[np++] = pb + 1; phases[np++] = pb + 2; phases[np++] = pb + 3;
        if ((l & 1) == 0) { phases[np++] = pb + 4; phases[np++] = pb + 5; }
        phases[np++] = pb + 6; phases[np++] = pb + 7; phases[np++] = pb + 8; phases[np++] = pb + 9; }
    phases[np++] = 64;
    for (int i = 0; i < np; ++i) { a.lo = phases[i]; a.hi = phases[i] + 1; hipLaunchKernelGGL(fwd_kernel, dim3(grid), dim3(NT), LDS_BYTES, stream, a); }
#else
    a.lo = 0; a.hi = 65;
    hipLaunchKernelGGL(fwd_kernel, dim3(grid), dim3(NT), LDS_BYTES, stream, a);
#ifdef PROBE_PHASES
    { const int pp[] = {PROBE_PHASES};
      for (int rep = 0; rep < PROBE_REPS; ++rep) for (unsigned i = 0; i < sizeof(pp) / sizeof(pp[0]); ++i) { a.lo = pp[i]; a.hi = pp[i] + 1; hipLaunchKernelGGL(fwd_kernel, dim3(grid), dim3(NT), LDS_BYTES, stream, a); } }
#endif
#endif
}
```

```cpp
#include <hip/hip_runtime.h>
#include <cstdio>
#include <cstdint>

#define LAS __attribute__((address_space(3)))
typedef unsigned short bf16;
typedef float f32x4 __attribute__((ext_vector_type(4)));
typedef unsigned u32x4 __attribute__((ext_vector_type(4)));
typedef unsigned u32x2 __attribute__((ext_vector_type(2)));

constexpr int D = 1024, BATCH = 2, SEQ = 16384, DEPTH = 4, CTXL = 256;
constexpr int NL = BATCH * SEQ, NCX = BATCH * CTXL, NR = NL + NCX;
constexpr int NH = 4, DQK = 128, DV = 256, NQ = 512, NV = 1024, PROJ = 3088, PW = 3072;
constexpr int NGRP = 4, EPG = 8, NE = 32, DE = 512;
constexpr int NBLK = 65;
constexpr int NUNIT = BATCH * NH * NBLK;
constexpr int CAP = NR;
constexpr int YROWS = 74752;
constexpr float EPS = 1e-6f;
constexpr float WSCALE = 32.0f;
constexpr float YSCALE = 4.0f;
constexpr int NT = 512, NW = 8;
constexpr int LDS_TAB_END = 152 * 1024 - 16;

constexpr size_t MiB = 1u << 20;
constexpr size_t WS_CTL = 0, CTL_BYTES = 1 * MiB;
constexpr size_t WS_MOD = 1 * MiB;
constexpr size_t WS_GATE = 2 * MiB;
constexpr size_t WS_TOKSLOT = 5 * MiB;
constexpr size_t WS_TOKW = 6 * MiB;
constexpr size_t WS_SLOTTOK = 7 * MiB;
constexpr size_t WS_DN = 12 * MiB;
constexpr size_t WS_NST = 13 * MiB;
constexpr size_t WS_BTOT = 14 * MiB;
constexpr size_t WS_LAT = 16 * MiB;
constexpr size_t WS_HB = 146 * MiB;
constexpr size_t WS_PB = 211 * MiB;
constexpr size_t WS_HM = 406 * MiB;
constexpr size_t WS_DC = 471 * MiB;
constexpr size_t WS_CST = 601 * MiB;
constexpr size_t WS_VT = 666 * MiB;
constexpr size_t WS_WAIN = 731 * MiB;
constexpr size_t WS_WBIN = 743 * MiB;
constexpr size_t WS_WAOUT = 755 * MiB;
constexpr size_t WS_WBOUT = 759 * MiB;
constexpr size_t WS_WGU = 763 * MiB;
constexpr size_t WS_WDN = 827 * MiB;
constexpr size_t WS_H8 = 843 * MiB;
constexpr size_t WS_END = 880 * MiB;
constexpr int CW_CNT = 1024, CNT_STRIDE = 64;

struct Args { const float* in[22]; float* out; unsigned char* ws; int lo, hi; };

typedef short bf16x8 __attribute__((ext_vector_type(8)));
typedef float f32x2 __attribute__((ext_vector_type(2)));
typedef __bf16 bf16x2_t __attribute__((ext_vector_type(2)));
__device__ __forceinline__ unsigned cvt2(float lo, float hi) { const f32x2 v = {lo, hi}; return __builtin_bit_cast(unsigned, __builtin_convertvector(v, bf16x2_t)); }
__device__ __forceinline__ float bf2f(bf16 v) { return __uint_as_float(((unsigned)v) << 16); }
__device__ __forceinline__ unsigned f2bf(float f) { unsigned u = __float_as_uint(f); return (u + 0x7fffu + ((u >> 16) & 1u)) >> 16; }
__device__ __forceinline__ unsigned pk2(float lo, float hi) { return f2bf(lo) | (f2bf(hi) << 16); }
template <int CTRL, int ROWMASK> __device__ __forceinline__ float dpp_mov(float x) { return __int_as_float(__builtin_amdgcn_update_dpp(0, __float_as_int(x), CTRL, ROWMASK, 0xf, false)); }
__device__ __forceinline__ float wave_sum(float v) {
    v += dpp_mov<0xB1, 0xf>(v); v += dpp_mov<0x4E, 0xf>(v); v += dpp_mov<0x141, 0xf>(v); v += dpp_mov<0x140, 0xf>(v);
    v += dpp_mov<0x142, 0xA>(v); v += dpp_mov<0x143, 0xC>(v);
    return __int_as_float(__builtin_amdgcn_readlane(__float_as_int(v), 63));
}
__device__ __forceinline__ float sigmoidf_(float x) { return 1.f / (1.f + __expf(-x)); }
__device__ __forceinline__ float siluf_(float x) { return x / (1.f + __expf(-x)); }
__device__ __forceinline__ float logsigmoidf_(float x) { return fminf(x, 0.f) - log1pf(__expf(-fabsf(x))); }
__device__ __forceinline__ int blk_row0(int b, int blk) { return blk == 0 ? NL + b * CTXL : b * SEQ + (blk - 1) * 256; }
__device__ __forceinline__ int mod_vec_of_row(int row) { return row < NL ? row / SEQ : 2; }

struct Ctx {
    LAS unsigned char* lds; int tid, lane, wave, G, bid;
    const Args* a;
};

__device__ __forceinline__ int expert_block_prefix(const unsigned* cnt, int lane, int& nb) {
    nb = lane < NE ? ((int)cnt[lane * CNT_STRIDE] + 255) / 256 : 0; int v = nb;
#pragma unroll
    for (int o = 1; o < 64; o <<= 1) { const int t = __shfl_up(v, o); v += (lane >= o) ? t : 0; }
    return v - nb;
}
__device__ __forceinline__ void slot_bases(const Args& A, int l, LAS int* sb, int tid) {
    if (tid < 64) { int nb; const int ex = expert_block_prefix((const unsigned*)(A.ws + WS_CTL) + CW_CNT + l * 32 * CNT_STRIDE, tid, nb); if (tid <= NE) sb[tid] = ex * 256; }
    __syncthreads();
}

__device__ __forceinline__ void phase_mod(const Args& A, const Ctx& C) {
    LAS float* sc = (LAS float*)C.lds;
    LAS float* red = sc + 3072;
    const float* c = A.in[1]; const float* cc = A.in[3];
    for (int i = C.tid; i < 3072; i += NT) { const float v = i < 2048 ? c[i] : cc[i - 2048]; sc[i] = siluf_(v); }
    __syncthreads();
    float* MOD = (float*)(A.ws + WS_MOD);
    for (int u = C.bid; u < DEPTH * 96; u += C.G) {
        const int l = u / 96, cg = u % 96, col = cg * 64 + C.lane;
        const float* w = A.in[4] + (size_t)l * D * 6 * D + col;
        float a0 = 0.f, a1 = 0.f, a2 = 0.f;
#pragma unroll 32
        for (int k = C.wave * 128; k < C.wave * 128 + 128; ++k) { const float wv = w[(size_t)k * 6 * D]; a0 += sc[k] * wv; a1 += sc[1024 + k] * wv; a2 += sc[2048 + k] * wv; }
        red[(C.wave * 3 + 0) * 64 + C.lane] = a0; red[(C.wave * 3 + 1) * 64 + C.lane] = a1; red[(C.wave * 3 + 2) * 64 + C.lane] = a2;
        __syncthreads();
        if (C.tid < 192) { const int v = C.tid / 64, ln = C.tid % 64; float s = 0.f;
            for (int w8 = 0; w8 < 8; ++w8) s += red[(w8 * 3 + v) * 64 + ln];
            MOD[(size_t)(l * 3 + v) * 6 * D + cg * 64 + ln] = s + A.in[5][(size_t)l * 6 * D + cg * 64 + ln]; }
        __syncthreads();
    }
}

__device__ __forceinline__ void load_row_f32(const float* p, int lane, f32x4 (&v)[4]) {
#pragma unroll
    for (int j = 0; j < 4; ++j) v[j] = *(const f32x4*)(p + 4 * lane + 256 * j);
}
__device__ __forceinline__ void load_row_bf16(const bf16* p, int lane, f32x4 (&v)[4]) {
#pragma unroll
    for (int j = 0; j < 4; ++j) { const u32x2 w = *(const u32x2*)(p + 4 * lane + 256 * j);
        v[j] = (f32x4){__uint_as_float(w.x << 16), __uint_as_float(w.x & 0xffff0000u), __uint_as_float(w.y << 16), __uint_as_float(w.y & 0xffff0000u)}; }
}
__device__ __forceinline__ void store_row_bf16(bf16* p, int lane, const f32x4 (&v)[4]) {
#pragma unroll
    for (int j = 0; j < 4; ++j) { u32x2 w; w.x = pk2(v[j].x, v[j].y); w.y = pk2(v[j].z, v[j].w); *(u32x2*)(p + 4 * lane + 256 * j) = w; }
}
__device__ __forceinline__ void moe_combine(const Args& A, int lp, int row, int lane, LAS const int* sb, f32x4 (&v)[4]) {
    const int* ts = (const int*)(A.ws + WS_TOKSLOT) + row * 2; const float* tw = (const float*)(A.ws + WS_TOKW) + row * 2;
    const bf16* Y = (const bf16*)(A.ws + WS_PB);
    const int t0 = ts[0], t1 = ts[1]; const float w0 = tw[0], w1 = tw[1];
    const size_t s0 = (size_t)(sb[t0 >> 20] + (t0 & 0xfffff)), s1 = (size_t)(sb[t1 >> 20] + (t1 & 0xfffff));
    f32x4 y0[4], y1[4], g2[4];
    load_row_bf16(Y + s0 * D, lane, y0); load_row_bf16(Y + s1 * D, lane, y1);
    load_row_f32((const float*)(A.ws + WS_MOD) + (size_t)(lp * 3 + mod_vec_of_row(row)) * 6 * D + 5 * D, lane, g2);
#pragma unroll
    for (int j = 0; j < 4; ++j) v[j] += g2[j] * (y0[j] * w0 + y1[j] * w1);
}
__device__ __forceinline__ void norm_mod(const f32x4 (&v)[4], const float* g, const float* sh, const float* sc, int lane, f32x4 (&h)[4]) {
    float s = 0.f;
#pragma unroll
    for (int j = 0; j < 4; ++j) s += (v[j].x * v[j].x + v[j].y * v[j].y) + (v[j].z * v[j].z + v[j].w * v[j].w);
    const float r = 1.0f / sqrtf(wave_sum(s) * (1.f / D) + EPS);
    f32x4 gg[4], ss[4], cc[4];
    load_row_f32(g, lane, gg); load_row_f32(sh, lane, ss); load_row_f32(sc, lane, cc);
#pragma unroll
    for (int j = 0; j < 4; ++j) h[j] = (v[j] * r) * gg[j] * (1.f + cc[j]) + ss[j];
}

constexpr int CVT_IG = (D / 64) * (DE / 32), CVT_ID = (DE / 64) * (D / 32), CVT_PER = 2 * CVT_IG + CVT_ID, CVT_ITEMS = NE * CVT_PER;
constexpr int CVT_Q = 48;
__device__ __forceinline__ void cvt_moe_items(const Args& A, const Ctx& C, int l, int it0, int end, int stride);
__device__ __forceinline__ int cvt_t2(int l, int G);
struct RowVec { f32x4 a[4], s[4], g[4]; };
__device__ __forceinline__ void load_rowvec(RowVec& R, const float* ng, const float* sh, const float* sc, const float* gt, int lane) {
    f32x4 n[4], c[4]; load_row_f32(ng, lane, n); load_row_f32(sc, lane, c); load_row_f32(sh, lane, R.s); if (gt) load_row_f32(gt, lane, R.g);
#pragma unroll
    for (int q = 0; q < 4; ++q) R.a[q] = n[q] * (1.f + c[q]);
}
__device__ __forceinline__ void load_row_bf16raw(const bf16* p, int lane, u32x2 (&v)[4]) {
#pragma unroll
    for (int j = 0; j < 4; ++j) v[j] = *(const u32x2*)(p + 4 * lane + 256 * j);
}
__device__ __forceinline__ void store_row_fp8(unsigned char* p, int lane, const f32x4 (&v)[4]) {
#pragma unroll
    for (int j = 0; j < 4; ++j) { int w = 0; w = __builtin_amdgcn_cvt_pk_fp8_f32(v[j].x, v[j].y, w, false); w = __builtin_amdgcn_cvt_pk_fp8_f32(v[j].z, v[j].w, w, true); *(unsigned*)(p + 4 * lane + 256 * j) = (unsigned)w; }
}
__device__ __forceinline__ void load_row_fp8raw(const unsigned char* p, int lane, unsigned (&v)[4]) {
#pragma unroll
    for (int j = 0; j < 4; ++j) v[j] = *(const unsigned*)(p + 4 * lane + 256 * j);
}
__device__ __forceinline__ f32x4 fp8x4(unsigned w) { const f32x2 lo = __builtin_amdgcn_cvt_pk_f32_fp8((int)w, false), hi = __builtin_amdgcn_cvt_pk_f32_fp8((int)w, true); return (f32x4){lo.x, lo.y, hi.x, hi.y}; }
__device__ __forceinline__ f32x4 bf4(u32x2 w) { return (f32x4){__uint_as_float(w.x << 16), __uint_as_float(w.x & 0xffff0000u), __uint_as_float(w.y << 16), __uint_as_float(w.y & 0xffff0000u)}; }
__device__ __forceinline__ float row_rstd(const f32x4 (&v)[4]) {
    float s = 0.f;
#pragma unroll
    for (int j = 0; j < 4; ++j) s += (v[j].x * v[j].x + v[j].y * v[j].y) + (v[j].z * v[j].z + v[j].w * v[j].w);
    return 1.0f / sqrtf(wave_sum(s) * (1.f / D) + EPS);
}

__device__ __forceinline__ void phase_r1(const Args& A, const Ctx& C, int l) {
    LAS int* sb = (LAS int*)C.lds;
    LAS float* GW = (LAS float*)(C.lds + 256);
    const bool mls = (l & 1) == 0; const int j = l >> 1;
    if (l > 0) slot_bases(A, l - 1, sb, C.tid);
    if (mls) { const float* w = A.in[8] + (size_t)j * D * PROJ + PW;
        f32x4 t[2][4];
#pragma unroll
        for (int jj = 0; jj < 2; ++jj)
#pragma unroll
            for (int q = 0; q < 4; ++q) t[jj][q] = *(const f32x4*)(w + (size_t)(C.tid + NT * jj) * PROJ + 4 * q);
#pragma unroll
        for (int jj = 0; jj < 2; ++jj)
#pragma unroll
            for (int q = 0; q < 4; ++q) { const int k = C.tid + NT * jj; GW[(4 * q + 0) * D + k] = t[jj][q].x; GW[(4 * q + 1) * D + k] = t[jj][q].y; GW[(4 * q + 2) * D + k] = t[jj][q].z; GW[(4 * q + 3) * D + k] = t[jj][q].w; }
        __syncthreads(); }
    const int nrows = (l <= 2) ? NR : NL;
    bf16* LAT = (bf16*)(A.ws + WS_LAT); bf16* H = (bf16*)(A.ws + WS_HB); float* GATE = (float*)(A.ws + WS_GATE);
    const float* MOD = (const float*)(A.ws + WS_MOD); const unsigned char* Y8 = A.ws + WS_PB;
    const int* TS = (const int*)(A.ws + WS_TOKSLOT); const float* TW = (const float*)(A.ws + WS_TOKW);
    const int rpw = (((nrows + C.G - 1) / C.G) + 1) & ~1; const int wrow0 = C.bid * rpw; const int wend = min(wrow0 + rpw, nrows);
    for (int sa = wrow0; sa < wend;) {
        const int mvi = mod_vec_of_row(sa); const int bnd = mvi == 0 ? SEQ : (mvi == 1 ? NL : NR); const int sbnd = min(wend, bnd);
        RowVec RV; { const float* mv = MOD + (size_t)(l * 3 + mvi) * 6 * D;
            load_rowvec(RV, A.in[6] + (size_t)(l * 2 + 0) * D, mv + 0 * D, mv + 1 * D, l > 0 ? MOD + (size_t)((l - 1) * 3 + mvi) * 6 * D + 5 * D : nullptr, C.lane); }
        for (int ra = sa + 2 * C.wave; ra < sbnd; ra += 2 * NW) {
            const bool hasb = ra + 1 < sbnd; const int rb = hasb ? ra + 1 : ra;
            f32x4 va[4], vb[4]; float wa0 = 0.f, wa1 = 0.f, wb0 = 0.f, wb1 = 0.f;
            if (l == 0) { load_row_f32(ra < NL ? A.in[0] + (size_t)ra * D : A.in[2] + (size_t)(ra - NL) * D, C.lane, va); load_row_f32(rb < NL ? A.in[0] + (size_t)rb * D : A.in[2] + (size_t)(rb - NL) * D, C.lane, vb); }
            else {
                const int ta0 = TS[ra * 2], ta1 = TS[ra * 2 + 1], tb0 = TS[rb * 2], tb1 = TS[rb * 2 + 1]; wa0 = TW[ra * 2]; wa1 = TW[ra * 2 + 1]; wb0 = TW[rb * 2]; wb1 = TW[rb * 2 + 1];
                load_row_bf16(LAT + (size_t)ra * D, C.lane, va); load_row_bf16(LAT + (size_t)rb * D, C.lane, vb);
                unsigned ya0[4], ya1[4], yb0[4], yb1[4];
                load_row_fp8raw(Y8 + (size_t)(sb[ta0 >> 20] + (ta0 & 0xfffff)) * D, C.lane, ya0); load_row_fp8raw(Y8 + (size_t)(sb[ta1 >> 20] + (ta1 & 0xfffff)) * D, C.lane, ya1);
                load_row_fp8raw(Y8 + (size_t)(sb[tb0 >> 20] + (tb0 & 0xfffff)) * D, C.lane, yb0); load_row_fp8raw(Y8 + (size_t)(sb[tb1 >> 20] + (tb1 & 0xfffff)) * D, C.lane, yb1);
                wa0 *= 1.0f / YSCALE; wa1 *= 1.0f / YSCALE; wb0 *= 1.0f / YSCALE; wb1 *= 1.0f / YSCALE;
#pragma unroll
                for (int q = 0; q < 4; ++q) { va[q] += RV.g[q] * (fp8x4(ya0[q]) * wa0 + fp8x4(ya1[q]) * wa1); vb[q] += RV.g[q] * (fp8x4(yb0[q]) * wb0 + fp8x4(yb1[q]) * wb1); }
            }
            store_row_bf16(LAT + (size_t)ra * D, C.lane, va); if (hasb) store_row_bf16(LAT + (size_t)rb * D, C.lane, vb);
            const float rra = row_rstd(va), rrb = row_rstd(vb);
            f32x4 ha[4], hb[4];
#pragma unroll
            for (int q = 0; q < 4; ++q) { ha[q] = (va[q] * rra) * RV.a[q] + RV.s[q]; hb[q] = (vb[q] * rrb) * RV.a[q] + RV.s[q]; }
            store_row_bf16(H + (size_t)ra * D, C.lane, ha); if (hasb) store_row_bf16(H + (size_t)rb * D, C.lane, hb);
            if (mls) {
                float ga = 0.f, gb = 0.f;
#pragma unroll 2
                for (int c = 0; c < 16; ++c) { float s0 = 0.f, s1 = 0.f;
#pragma unroll
                    for (int q = 0; q < 4; ++q) { const f32x4 w = *(const LAS f32x4*)(GW + c * D + 4 * C.lane + 256 * q);
                        s0 += (ha[q].x * w.x + ha[q].y * w.y) + (ha[q].z * w.z + ha[q].w * w.w); s1 += (hb[q].x * w.x + hb[q].y * w.y) + (hb[q].z * w.z + hb[q].w * w.w); }
                    s0 = wave_sum(s0); s1 = wave_sum(s1); ga = (C.lane == c) ? s0 : ga; gb = (C.lane == c) ? s1 : gb; }
                if (C.lane < 16) {
                    const float bgt = A.in[9][j * 16 + C.lane]; const int gtype = C.lane >> 2;
                    ga += bgt; gb += bgt;
                    GATE[(size_t)ra * 16 + C.lane] = (gtype & 1) ? logsigmoidf_(ga) : 15.0f * tanhf(ga * (1.0f / 15.0f));
                    if (hasb) GATE[(size_t)rb * 16 + C.lane] = (gtype & 1) ? logsigmoidf_(gb) : 15.0f * tanhf(gb * (1.0f / 15.0f)); }
            }
        }
        sa = sbnd;
    }
}

__device__ __forceinline__ void phase_r2(const Args& A, const Ctx& C, int l) {
    constexpr int WP = 2064;
    LAS unsigned char* RWB = C.lds;
    LAS float* WL = (LAS float*)(C.lds + 48 * WP);
    LAS unsigned* hist = (LAS unsigned*)(WL + 8 * 16 * 48);
    LAS unsigned* gbase = hist + 32;
    constexpr int RCAP = 144;
    LAS int* rec = (LAS int*)(gbase + 32);
    static_assert(48 * WP + 8 * 16 * 48 * 4 + 256 + RCAP * 16 <= LDS_TAB_END, "R2 LDS map");
    cvt_moe_items(A, C, l, cvt_t2(l, C.G) + C.bid * NW + C.wave, CVT_ITEMS, C.G * NW);
    __syncthreads();
    { const float* wg = A.in[15] + (size_t)l * D * NGRP; const float* wr = A.in[17] + (size_t)l * D * NE;
      { const int kp = C.tid; const f32x4 x0 = *(const f32x4*)(wg + (size_t)(2 * kp) * 4), x1 = *(const f32x4*)(wg + (size_t)(2 * kp + 1) * 4);
        *(LAS unsigned*)(RWB + 0 * WP + kp * 4) = cvt2(x0.x, x1.x); *(LAS unsigned*)(RWB + 1 * WP + kp * 4) = cvt2(x0.y, x1.y);
        *(LAS unsigned*)(RWB + 2 * WP + kp * 4) = cvt2(x0.z, x1.z); *(LAS unsigned*)(RWB + 3 * WP + kp * 4) = cvt2(x0.w, x1.w); }
      f32x4 t0[8], t1[8];
#pragma unroll
      for (int jj = 0; jj < 8; ++jj) { const int it = C.tid + NT * jj, kp = it >> 3, cg = it & 7; t0[jj] = *(const f32x4*)(wr + (size_t)(2 * kp) * NE + 4 * cg); t1[jj] = *(const f32x4*)(wr + (size_t)(2 * kp + 1) * NE + 4 * cg); }
#pragma unroll
      for (int jj = 0; jj < 8; ++jj) { const int it = C.tid + NT * jj, kp = it >> 3, c0 = 4 + 4 * (it & 7);
          *(LAS unsigned*)(RWB + (c0 + 0) * WP + kp * 4) = cvt2(t0[jj].x, t1[jj].x); *(LAS unsigned*)(RWB + (c0 + 1) * WP + kp * 4) = cvt2(t0[jj].y, t1[jj].y);
          *(LAS unsigned*)(RWB + (c0 + 2) * WP + kp * 4) = cvt2(t0[jj].z, t1[jj].z); *(LAS unsigned*)(RWB + (c0 + 3) * WP + kp * 4) = cvt2(t0[jj].w, t1[jj].w); }
      for (int i = C.tid; i < 12 * 512; i += NT) *(LAS unsigned*)(RWB + (36 + i / 512) * WP + (i % 512) * 4) = 0u; }
    const int nrows = (l <= 1) ? NR : NL;
    bf16* LAT = (bf16*)(A.ws + WS_LAT); bf16* H = (bf16*)(A.ws + WS_HB); unsigned char* H8 = A.ws + WS_H8;
    const float* MOD = (const float*)(A.ws + WS_MOD);
    unsigned* cnt = (unsigned*)(A.ws + WS_CTL) + CW_CNT + l * 32 * CNT_STRIDE;
    int* TS = (int*)(A.ws + WS_TOKSLOT); float* TW = (float*)(A.ws + WS_TOKW); int* ST = (int*)(A.ws + WS_SLOTTOK);
    const int rpw = (((nrows + C.G - 1) / C.G) + 1) & ~1; const int wrow0 = C.bid * rpw; const int wend0 = min(wrow0 + rpw, nrows);
    const float* bg = A.in[16] + l * NGRP; const float* br = A.in[18] + l * NE;
    for (int cb = wrow0; cb < wend0; cb += RCAP) {
        const int wend = min(cb + RCAP, wend0);
        if (C.tid < 32) hist[C.tid] = 0u;
        for (int sa = cb; sa < wend;) {
            const int mvi = mod_vec_of_row(sa); const int bnd = mvi == 0 ? SEQ : (mvi == 1 ? NL : NR); const int sbnd = min(wend, bnd);
            RowVec RV; { const float* mv = MOD + (size_t)(l * 3 + mvi) * 6 * D; load_rowvec(RV, A.in[6] + (size_t)(l * 2 + 1) * D, mv + 3 * D, mv + 4 * D, mv + 2 * D, C.lane); }
            const int rlast = sbnd - 2;
            u32x2 la[4], lb[4], ya[4], yb[4];
            { const int r0 = min(sa + 2 * C.wave, rlast); load_row_bf16raw(LAT + (size_t)r0 * D, C.lane, la); load_row_bf16raw(LAT + (size_t)(r0 + 1) * D, C.lane, lb);
              load_row_bf16raw(H + (size_t)r0 * D, C.lane, ya); load_row_bf16raw(H + (size_t)(r0 + 1) * D, C.lane, yb); }
            for (int ra = sa + 2 * C.wave; ra < sbnd; ra += 2 * NW) {
                const int rb = ra + 1;
                u32x2 lan[4], lbn[4], yan[4], ybn[4];
                { const int r1 = min(ra + 2 * NW, rlast); load_row_bf16raw(LAT + (size_t)r1 * D, C.lane, lan); load_row_bf16raw(LAT + (size_t)(r1 + 1) * D, C.lane, lbn);
                  load_row_bf16raw(H + (size_t)r1 * D, C.lane, yan); load_row_bf16raw(H + (size_t)(r1 + 1) * D, C.lane, ybn); }
                f32x4 va[4], vb[4];
#pragma unroll
                for (int q = 0; q < 4; ++q) { va[q] = bf4(la[q]) + RV.g[q] * bf4(ya[q]); vb[q] = bf4(lb[q]) + RV.g[q] * bf4(yb[q]); }
                store_row_bf16(LAT + (size_t)ra * D, C.lane, va); store_row_bf16(LAT + (size_t)rb * D, C.lane, vb);
                const float rra = row_rstd(va), rrb = row_rstd(vb);
                f32x4 ha[4], hb[4];
#pragma unroll
                for (int q = 0; q < 4; ++q) { ha[q] = (va[q] * rra) * RV.a[q] + RV.s[q]; hb[q] = (vb[q] * rrb) * RV.a[q] + RV.s[q]; }
                store_row_bf16(H + (size_t)ra * D, C.lane, ha); store_row_bf16(H + (size_t)rb * D, C.lane, hb);
                store_row_fp8(H8 + (size_t)ra * D, C.lane, ha); store_row_fp8(H8 + (size_t)rb * D, C.lane, hb);
#pragma unroll
                for (int q = 0; q < 4; ++q) { la[q] = lan[q]; lb[q] = lbn[q]; ya[q] = yan[q]; yb[q] = ybn[q]; }
            }
            sa = sbnd;
        }
        __syncthreads();
        const int fr = C.lane & 15, fq = C.lane >> 4;
        for (int t = C.wave; t * 16 < wend - cb; t += NW) {
            const int trow = min(cb + 16 * t + fr, wend - 1);
            const bf16* hp = H + (size_t)trow * D + 8 * fq;
            f32x4 acc[3];
#pragma unroll
            for (int ct = 0; ct < 3; ++ct) acc[ct] = (f32x4){0.f, 0.f, 0.f, 0.f};
#pragma unroll 1
            for (int kb = 0; kb < 4; ++kb) {
                bf16x8 av[8];
#pragma unroll
                for (int k8 = 0; k8 < 8; ++k8) av[k8] = *(const bf16x8*)(hp + 32 * (8 * kb + k8));
#pragma unroll
                for (int k8 = 0; k8 < 8; ++k8)
#pragma unroll
                    for (int ct = 0; ct < 3; ++ct) { const bf16x8 bv = *(const LAS bf16x8*)(RWB + (ct * 16 + fr) * WP + (32 * (8 * kb + k8) + 8 * fq) * 2);
                        acc[ct] = __builtin_amdgcn_mfma_f32_16x16x32_bf16(av[k8], bv, acc[ct], 0, 0, 0); }
            }
            LAS float* wl = WL + C.wave * 16 * 48;
#pragma unroll
            for (int ct = 0; ct < 3; ++ct)
#pragma unroll
                for (int jq = 0; jq < 4; ++jq) wl[(4 * fq + jq) * 48 + ct * 16 + fr] = acc[ct][jq];
            asm volatile("s_waitcnt lgkmcnt(0)" ::: "memory");
            const int row = cb + 16 * t + C.lane;
            if (C.lane < 16 && row < wend) {
                LAS const float* wm = wl + C.lane * 48;
                float lg[36];
#pragma unroll
                for (int c = 0; c < 36; ++c) lg[c] = wm[c];
                float gl[4]; int grp = 0; float gm = -3.0e38f;
#pragma unroll
                for (int c = 0; c < 4; ++c) { gl[c] = lg[c] + bg[c]; if (gl[c] > gm) { gm = gl[c]; grp = c; } }
                float gs = 0.f;
#pragma unroll
                for (int c = 0; c < 4; ++c) gs += __expf(gl[c] - gm);
                const float pgrp = 1.0f / gs;
                float rl[8];
#pragma unroll
                for (int i = 0; i < 8; ++i) { float tt = 0.f;
#pragma unroll
                    for (int g = 0; g < 4; ++g) tt = (g == grp) ? lg[4 + g * 8 + i] : tt;
                    rl[i] = tt + br[grp * 8 + i]; }
                int i0 = 0; float m0 = rl[0];
#pragma unroll
                for (int i = 1; i < 8; ++i) if (rl[i] > m0) { m0 = rl[i]; i0 = i; }
                int i1 = -1; float m1 = -3.0e38f;
#pragma unroll
                for (int i = 0; i < 8; ++i) if (i != i0 && rl[i] > m1) { m1 = rl[i]; i1 = i; }
                const float p0 = 1.0f, p1 = __expf(m1 - m0);
                const float w0 = pgrp * p0 / (p0 + p1), w1 = pgrp * p1 / (p0 + p1);
                const int e0 = grp * 8 + i0, e1 = grp * 8 + i1;
                const unsigned q0 = __hip_atomic_fetch_add(hist + e0, 1u, __ATOMIC_RELAXED, __HIP_MEMORY_SCOPE_WORKGROUP), q1 = __hip_atomic_fetch_add(hist + e1, 1u, __ATOMIC_RELAXED, __HIP_MEMORY_SCOPE_WORKGROUP);
                const int li = row - cb;
                rec[li * 4 + 0] = e0 | (e1 << 8); rec[li * 4 + 1] = (int)q0; rec[li * 4 + 2] = (int)q1;
                TW[row * 2 + 0] = w0; TW[row * 2 + 1] = w1;
            }
        }
        __syncthreads();
        if (C.tid < 32) gbase[C.tid] = hist[C.tid] ? atomicAdd(cnt + C.tid * CNT_STRIDE, hist[C.tid]) : 0u;
        __syncthreads();
        for (int i = C.tid; i < wend - cb; i += NT) { const int row = cb + i; const int ee = rec[i * 4], e0 = ee & 255, e1 = ee >> 8;
            const unsigned q0 = gbase[e0] + (unsigned)rec[i * 4 + 1], q1 = gbase[e1] + (unsigned)rec[i * 4 + 2];
            ST[(size_t)e0 * CAP + q0] = row; ST[(size_t)e1 * CAP + q1] = row;
            TS[row * 2 + 0] = (e0 << 20) | (int)q0; TS[row * 2 + 1] = (e1 << 20) | (int)q1; }
        __syncthreads();
    }
}

__device__ __forceinline__ void phase_final(const Args& A, const Ctx& C) {
    LAS int* sb = (LAS int*)C.lds;
    slot_bases(A, 3, sb, C.tid);
    const bf16* LAT = (const bf16*)(A.ws + WS_LAT); const unsigned char* Y8 = A.ws + WS_PB;
    const int* TS = (const int*)(A.ws + WS_TOKSLOT); const float* TW = (const float*)(A.ws + WS_TOKW);
    const float* MOD = (const float*)(A.ws + WS_MOD);
    f32x4 fg[4]; load_row_f32(A.in[7], C.lane, fg);
    const int rpw = (((NL + C.G - 1) / C.G) + 1) & ~1; const int wrow0 = C.bid * rpw; const int wend = min(wrow0 + rpw, NL);
    for (int sa = wrow0; sa < wend;) {
        const int mvi = mod_vec_of_row(sa); const int sbnd = min(wend, mvi == 0 ? SEQ : NL);
        f32x4 g2[4]; load_row_f32(MOD + (size_t)(3 * 3 + mvi) * 6 * D + 5 * D, C.lane, g2);
        for (int ra = sa + 2 * C.wave; ra < sbnd; ra += 2 * NW) {
            const int rb = ra + 1;
            const int ta0 = TS[ra * 2], ta1 = TS[ra * 2 + 1], tb0 = TS[rb * 2], tb1 = TS[rb * 2 + 1]; const float wa0 = TW[ra * 2], wa1 = TW[ra * 2 + 1], wb0 = TW[rb * 2], wb1 = TW[rb * 2 + 1];
            f32x4 va[4], vb[4]; unsigned ya0[4], ya1[4], yb0[4], yb1[4];
            load_row_bf16(LAT + (size_t)ra * D, C.lane, va); load_row_bf16(LAT + (size_t)rb * D, C.lane, vb);
            load_row_fp8raw(Y8 + (size_t)(sb[ta0 >> 20] + (ta0 & 0xfffff)) * D, C.lane, ya0); load_row_fp8raw(Y8 + (size_t)(sb[ta1 >> 20] + (ta1 & 0xfffff)) * D, C.lane, ya1);
            load_row_fp8raw(Y8 + (size_t)(sb[tb0 >> 20] + (tb0 & 0xfffff)) * D, C.lane, yb0); load_row_fp8raw(Y8 + (size_t)(sb[tb1 >> 20] + (tb1 & 0xfffff)) * D, C.lane, yb1);
#pragma unroll
            for (int q = 0; q < 4; ++q) { va[q] += g2[q] * (fp8x4(ya0[q]) * (wa0 * (1.0f / YSCALE)) + fp8x4(ya1[q]) * (wa1 * (1.0f / YSCALE))); vb[q] += g2[q] * (fp8x4(yb0[q]) * (wb0 * (1.0f / YSCALE)) + fp8x4(yb1[q]) * (wb1 * (1.0f / YSCALE))); }
            const float rra = row_rstd(va), rrb = row_rstd(vb);
#pragma unroll
            for (int q = 0; q < 4; ++q) { *(f32x4*)(A.out + (size_t)ra * D + 4 * C.lane + 256 * q) = (va[q] * rra) * fg[q]; *(f32x4*)(A.out + (size_t)rb * D + 4 * C.lane + 256 * q) = (vb[q] * rrb) * fg[q]; }
        }
        sa = sbnd;
    }
}

__device__ __forceinline__ void phase_conv(const Args& A, const Ctx& C, int l) {
    const int j = l >> 1; const int nrows = (l <= 1) ? NR : NL;
    const bf16* P = (const bf16*)(A.ws + WS_PB); unsigned char* HM = A.ws + WS_HM;
    const float* cw = A.in[13] + (size_t)j * 3 * D;
    for (int row = C.bid * NW + C.wave; row < nrows; row += C.G * NW) {
        bool hasl, hasr;
        if (row < NL) { const int t = row & 63; hasl = t != 0; hasr = t != 63; } else { const int t = (row - NL) & 255; hasl = t != 0; hasr = t != 255; }
        f32x4 bg[4], z[4], w0[4], w1[4], w2[4], acc[4];
        const bf16* pr = P + (size_t)row * PW;
        load_row_bf16(pr, C.lane, bg); load_row_bf16(pr + D, C.lane, z);
        load_row_f32(cw, C.lane, w0); load_row_f32(cw + D, C.lane, w1); load_row_f32(cw + 2 * D, C.lane, w2);
#pragma unroll
        for (int q = 0; q < 4; ++q) acc[q] = w1[q] * z[q];
        if (hasl) { load_row_bf16(pr - PW + D, C.lane, z);
#pragma unroll
            for (int q = 0; q < 4; ++q) acc[q] += w0[q] * z[q]; }
        if (hasr) { load_row_bf16(pr + PW + D, C.lane, z);
#pragma unroll
            for (int q = 0; q < 4; ++q) acc[q] += w2[q] * z[q]; }
#pragma unroll
        for (int q = 0; q < 4; ++q) acc[q] *= bg[q];
        store_row_fp8(HM + (size_t)row * D, C.lane, acc);
    }
}

constexpr int BM = 256, BK = 64, HALF = 128, HTB = HALF * BK * 2, STAGE_BYTES = 8 * HTB, NXCD = 8, WGM = 8;
constexpr int LDS_TAB = STAGE_BYTES;
__device__ __forceinline__ int lds_byte(int r, int c) { const int st = (r >> 4) * 2 + (c >> 5), rr = r & 15, cc = c & 31, ob = rr * 64 + cc * 2; return st * 1024 + (ob ^ (((ob >> 9) & 1) << 5)); }
__device__ __forceinline__ void stage_rc(int b, int& R, int& C) { const int st = b / 1024, sb = b % 1024, swz = sb ^ (((sb >> 9) & 1) << 5); R = (st >> 1) * 16 + swz / 64; C = (st & 1) * 32 + (swz % 64) / 2; }
__device__ __forceinline__ int perm32(int rho) { const int n = rho >> 4, i = rho & 15; return 8 * (i >> 2) + 4 * n + (i & 3); }
__device__ __forceinline__ unsigned cvt_pk_bf16(float lo, float hi) { unsigned r; asm volatile("v_cvt_pk_bf16_f32 %0, %1, %2" : "=v"(r) : "v"(lo), "v"(hi)); return r; }

struct GUnit { const char* a; const char* b; int orow, ocol, aux; };

typedef int i32x8 __attribute__((ext_vector_type(8)));
typedef int i32x4 __attribute__((ext_vector_type(4)));
template <class Epi, class Sched, bool GATHER, bool FP8 = false>
__device__ __forceinline__ void gemm_phase(LAS unsigned char* lds, const int K, const Sched& S, const Epi& E) {
    const int tid = threadIdx.x, wid = __builtin_amdgcn_readfirstlane(tid >> 6), lane = tid & 63, wr = wid >> 2, wc = wid & 3, fr = lane & 15, fq = lane >> 4;
    const int RB = FP8 ? K : 2 * K;
    const int nt = RB / (BK * 2);
    unsigned voffB[2], voA[2][2]; int Rr[2], Cc[2];
#pragma unroll
    for (int i = 0; i < 2; ++i) { int R, C; stage_rc(tid * 16 + i * 8192, R, C); const int Rb = (R & ~31) + perm32(R & 31); Rr[i] = R; Cc[i] = C;
        voffB[i] = (unsigned)(Rb * RB + C * 2);
        voA[0][i] = (unsigned)(R * RB + C * 2); voA[1][i] = (unsigned)((R + HALF) * RB + C * 2); }
    const size_t kstep = (size_t)(BK * 2);
    const size_t hstep = (size_t)HALF * RB;
    const unsigned ldsw = (unsigned)wid * 1024u;
    const unsigned ldsbase = (unsigned)(size_t)lds;
    const int aoff = lds_byte(wr * 64 + fr, fq * 8), boff = lds_byte(wc * 32 + fr, fq * 8);
#define PG8_SA(b, h) (((b) * 2 + (h)) * HTB)
#define PG8_SB(b, h) ((4 + (b) * 2 + (h)) * HTB)
#define PG8_STAGE(bufoff, gbase, voff) do { _Pragma("unroll") for (int _i = 0; _i < 2; ++_i) \
        asm volatile("s_mov_b32 m0, %2\n\ts_nop 0\n\tglobal_load_lds_dwordx4 %0, %1" :: "v"((voff)[_i]), "s"((const char*)(gbase)), "s"(ldsbase + (unsigned)(bufoff) + ldsw + (unsigned)(_i * 8192)) : "memory"); } while (0)
#define PG8_STAGE_A1(bufoff, gbase) do { if constexpr (GATHER) PG8_STAGE(bufoff, gbase, voA[1]); else PG8_STAGE(bufoff, (const char*)(gbase) + hstep, voA[0]); } while (0)
#define PG8_LDA(dst, b, h) do { if constexpr (FP8) { _Pragma("unroll") for (int m = 0; m < 4; ++m) { \
        const i32x4 _lo = *(const LAS i32x4*)(lds + PG8_SA(b, h) + aoff + m * 2048), _hi = *(const LAS i32x4*)(lds + PG8_SA(b, h) + aoff + m * 2048 + 1024); \
        dst##8[m] = __builtin_shufflevector(_lo, _hi, 0, 1, 2, 3, 4, 5, 6, 7); } } \
      else { _Pragma("unroll") for (int m = 0; m < 4; ++m) _Pragma("unroll") for (int k = 0; k < 2; ++k) dst[m][k] = *(const LAS bf16x8*)(lds + PG8_SA(b, h) + aoff + m * 2048 + k * 1024); } } while (0)
#define PG8_LDB(dst, b, h) do { if constexpr (FP8) { _Pragma("unroll") for (int n = 0; n < 2; ++n) { \
        const i32x4 _lo = *(const LAS i32x4*)(lds + PG8_SB(b, h) + boff + n * 2048), _hi = *(const LAS i32x4*)(lds + PG8_SB(b, h) + boff + n * 2048 + 1024); \
        dst##8[n] = __builtin_shufflevector(_lo, _hi, 0, 1, 2, 3, 4, 5, 6, 7); } } \
      else { _Pragma("unroll") for (int n = 0; n < 2; ++n) _Pragma("unroll") for (int k = 0; k < 2; ++k) dst[n][k] = *(const LAS bf16x8*)(lds + PG8_SB(b, h) + boff + n * 2048 + k * 1024); } } while (0)
#define PG8_MMA(ai, bj, At, Bt) do { __builtin_amdgcn_s_setprio(1); \
        if constexpr (FP8) { _Pragma("unroll") for (int m = 0; m < 4; ++m) _Pragma("unroll") for (int n = 0; n < 2; ++n) \
            acc[ai][bj][m][n] = __builtin_amdgcn_mfma_scale_f32_16x16x128_f8f6f4(Bt##8[n], At##8[m], acc[ai][bj][m][n], 0, 0, 0, 0x7f7f7f7f, 0, 0x7f7f7f7f); } \
        else { _Pragma("unroll") for (int m = 0; m < 4; ++m) _Pragma("unroll") for (int n = 0; n < 2; ++n) _Pragma("unroll") for (int k = 0; k < 2; ++k) \
            acc[ai][bj][m][n] = __builtin_amdgcn_mfma_f32_16x16x32_bf16(Bt[n][k], At[m][k], acc[ai][bj][m][n], 0, 0, 0); } \
        __builtin_amdgcn_s_setprio(0); } while (0)
#define PG8_WAIT_V(n) asm volatile("s_waitcnt vmcnt(" #n ")" ::: "memory")
#define PG8_WAIT_L(n) asm volatile("s_waitcnt lgkmcnt(" #n ")" ::: "memory")
#define PG8_BAR __builtin_amdgcn_s_barrier()
#define PG8_SCHED __builtin_amdgcn_sched_barrier(0)
    GUnit cur, nxt; int ui = 0;
    if (!S.next(0, cur)) return;
    if constexpr (GATHER) {
#pragma unroll
        for (int h = 0; h < 2; ++h)
#pragma unroll
            for (int i = 0; i < 2; ++i) voA[h][i] = S.arow_off(0, h * HALF + Rr[i]) + (unsigned)Cc[i] * 2u;
    }
    f32x4 acc[2][2][4][2];
#pragma unroll
    for (int a = 0; a < 2; ++a)
#pragma unroll
        for (int b = 0; b < 2; ++b)
#pragma unroll
            for (int m = 0; m < 4; ++m)
#pragma unroll
                for (int n = 0; n < 2; ++n) acc[a][b][m][n] = (f32x4){0.f, 0.f, 0.f, 0.f};
    bf16x8 At[4][2], B0[2][2], B1[2][2]; i32x8 At8[4], B08[2], B18[2];
    const char* cA = cur.a; const char* cB = cur.b;
    PG8_STAGE(PG8_SB(0, 0), cB, voffB); PG8_STAGE(PG8_SB(0, 1), cB + hstep, voffB); PG8_STAGE(PG8_SA(0, 0), cA, voA[0]); PG8_STAGE_A1(PG8_SA(0, 1), cA);
    if (wr == 1) PG8_BAR;
    PG8_WAIT_V(2); PG8_BAR;
    PG8_STAGE(PG8_SB(1, 0), cB + kstep, voffB); PG8_STAGE(PG8_SA(1, 0), cA + kstep, voA[0]); PG8_STAGE(PG8_SB(1, 1), cB + hstep + kstep, voffB);
    PG8_WAIT_V(6); PG8_BAR;
    for (;;) {
        const bool has_next = S.next(ui + 1, nxt);
        const char* nA = has_next ? nxt.a : cA; const char* nB = has_next ? nxt.b : cB;
#pragma unroll 1
        for (int t = 0; t < nt; t += 2) {
            const bool last = (t == nt - 2);
            const char* a1 = cA + (size_t)(t + 1) * kstep;
            const char* a2 = last ? nA : cA + (size_t)(t + 2) * kstep; const char* b2 = last ? nB : cB + (size_t)(t + 2) * kstep;
            const char* a3 = a2 + kstep; const char* b3 = b2 + kstep;
            PG8_LDB(B0, 0, 0); PG8_LDB(B1, 0, 1); PG8_SCHED; PG8_LDA(At, 0, 0); PG8_STAGE_A1(PG8_SA(1, 1), a1);
            if constexpr (GATHER) { if (last && has_next) {
#pragma unroll
                for (int h = 0; h < 2; ++h)
#pragma unroll
                    for (int i = 0; i < 2; ++i) { int R2, C2; stage_rc(tid * 16 + i * 8192, R2, C2); voA[h][i] = S.arow_off(ui + 1, h * HALF + R2) + (unsigned)C2 * 2u; } } }
            PG8_WAIT_V(8); PG8_WAIT_L(0); PG8_BAR; PG8_MMA(0, 0, At, B0); PG8_MMA(0, 1, At, B1); PG8_BAR; PG8_SCHED;
            PG8_LDA(At, 0, 1); PG8_STAGE(PG8_SB(0, 0), b2, voffB); PG8_STAGE(PG8_SB(0, 1), b2 + hstep, voffB); PG8_STAGE(PG8_SA(0, 0), a2, voA[0]);
            PG8_WAIT_V(8); PG8_WAIT_L(0); PG8_BAR; PG8_MMA(1, 0, At, B0); PG8_MMA(1, 1, At, B1); PG8_BAR; PG8_SCHED;
            PG8_LDB(B0, 1, 0); PG8_LDB(B1, 1, 1); PG8_SCHED; PG8_LDA(At, 1, 0); PG8_STAGE_A1(PG8_SA(0, 1), a2);
            PG8_WAIT_V(8); PG8_WAIT_L(0); PG8_BAR; PG8_MMA(0, 0, At, B0); PG8_MMA(0, 1, At, B1); PG8_BAR; PG8_SCHED;
            PG8_LDA(At, 1, 1); PG8_STAGE(PG8_SB(1, 0), b3, voffB); PG8_STAGE(PG8_SB(1, 1), b3 + hstep, voffB); PG8_STAGE(PG8_SA(1, 0), a3, voA[0]);
            PG8_WAIT_V(8); PG8_WAIT_L(0); PG8_BAR; PG8_MMA(1, 0, At, B0); PG8_MMA(1, 1, At, B1); PG8_BAR; PG8_SCHED;
        }
        if (wr == 0) PG8_BAR;
        { int tz = threadIdx.x; asm volatile("" : "+v"(tz));
          const int wz = tz >> 6, lz = tz & 63; E(acc, cur, wz >> 2, wz & 3, lz & 15, lz >> 4); }
        if (!has_next) break;
#pragma unroll
        for (int a = 0; a < 2; ++a)
#pragma unroll
            for (int b = 0; b < 2; ++b)
#pragma unroll
                for (int m = 0; m < 4; ++m)
#pragma unroll
                    for (int n = 0; n < 2; ++n) acc[a][b][m][n] = (f32x4){0.f, 0.f, 0.f, 0.f};
        cur = nxt; cA = nA; cB = nB; ++ui;
        if (wr == 1) PG8_BAR;
    }
    PG8_WAIT_V(0);
    PG8_BAR;
#undef PG8_SA
#undef PG8_SB
#undef PG8_STAGE
#undef PG8_STAGE_A1
#undef PG8_LDA
#undef PG8_LDB
#undef PG8_MMA
#undef PG8_WAIT_V
#undef PG8_WAIT_L
#undef PG8_BAR
#undef PG8_SCHED
}

__device__ __forceinline__ int xcd_remap(int L, int nwg) { const int q = nwg / NXCD, r = nwg % NXCD, xcd = L % NXCD, off = L / NXCD; return (xcd < r ? xcd * (q + 1) : r * (q + 1) + (xcd - r) * q) + off; }

struct DenseSched {
    const char* A; const char* Bt; int nM, nN, nwg, G, c; size_t tstep; int sw_lo, sw_hi;
    __device__ __forceinline__ void init(const void* A_, const void* Bt_, int M, int N, int K, int G_, int c_, int ebytes = 2) { A = (const char*)A_; Bt = (const char*)Bt_; nM = M / BM; nN = N / BM; nwg = nM * nN; G = G_; c = c_; tstep = (size_t)BM * K * ebytes; sw_lo = 0; sw_hi = 0; }
    __device__ __forceinline__ bool next(int i, GUnit& u) const {
        const long L = (long)i * G + c; if (L >= nwg) return false;
        const int wgid = xcd_remap((int)L, nwg);
        const int nig = WGM * nN, gid = wgid / nig, fm = gid * WGM, gsz = (nM - fm) < WGM ? (nM - fm) : WGM;
        const int pm = fm + ((wgid % nig) % gsz), pn = (wgid % nig) / gsz;
        if (pn >= sw_lo && pn < sw_hi) { u.a = Bt + (size_t)pn * tstep; u.b = A + (size_t)pm * tstep; u.orow = pm; u.ocol = pn - sw_lo; u.aux = 1; }
        else { u.a = A + (size_t)pm * tstep; u.b = Bt + (size_t)pn * tstep; u.orow = pm * BM; u.ocol = pn * BM; u.aux = 0; }
        return true;
    }
    __device__ __forceinline__ unsigned arow_off(int, int) const { return 0u; }
};

constexpr int MAXU = 12;
struct MoeTab { int n; int e[MAXU], mb[MAXU], nt[MAXU]; int sb[NE + 1]; };
struct MoeSched {
    LAS const MoeTab* T; LAS const unsigned* ridx;
    const char* A; const char* W; size_t wstride_e, tstepB; int K; int arow_bytes;
    __device__ __forceinline__ bool next(int i, GUnit& u) const {
        const int n = __builtin_amdgcn_readfirstlane(T->n); if (i >= n) return false;
        const int e = __builtin_amdgcn_readfirstlane(T->e[i]), mb = __builtin_amdgcn_readfirstlane(T->mb[i]), nt = __builtin_amdgcn_readfirstlane(T->nt[i]);
        const int base = __builtin_amdgcn_readfirstlane(T->sb[e]);
        u.orow = base + mb * BM; u.ocol = nt; u.aux = e;
        u.a = A + (size_t)u.orow * arow_bytes;
        u.b = W + (size_t)e * wstride_e + (size_t)nt * tstepB; return true;
    }
    __device__ __forceinline__ unsigned arow_off(int i, int r) const { return ridx[i * 256 + r]; }
};
template <bool GATHER>
__device__ __forceinline__ void moe_tables(const Args& A, const Ctx& C, int l, int ntile_n, LAS MoeTab* T, LAS unsigned* ridx, int arow_bytes) {
    const unsigned* cnt = (const unsigned*)(A.ws + WS_CTL) + CW_CNT + l * 32 * CNT_STRIDE;
    LAS int* ust = (LAS int*)(T + 1);
    if (C.tid < 64) { int nb; const int ex = expert_block_prefix(cnt, C.tid, nb); if (C.tid <= NE) { T->sb[C.tid] = ex * 256; ust[C.tid] = ex * ntile_n; } }
    __syncthreads();
    if (C.tid < MAXU) { const int nwg = ust[NE]; const long L = (long)C.tid * C.G + C.bid;
        if (L < nwg) { const int w = xcd_remap((int)L, nwg); int e = 0; while (w >= ust[e + 1]) ++e;
            const int lu = w - ust[e]; T->e[C.tid] = e; T->mb[C.tid] = lu / ntile_n; T->nt[C.tid] = lu % ntile_n; } }
    if (C.tid == 0) { const int nwg = ust[NE]; int n = 0; while (n < MAXU && (long)n * C.G + C.bid < nwg) ++n; T->n = n; }
    __syncthreads();
    if constexpr (GATHER) {
        const int* ST = (const int*)(A.ws + WS_SLOTTOK); const int n = T->n;
        for (int i = C.tid; i < n * 256; i += NT) { const int ui = i >> 8, r = i & 255, e = T->e[ui], m0 = T->mb[ui] * 256, ce = (int)cnt[e * CNT_STRIDE];
            const int rr = (m0 + r < ce) ? m0 + r : ce - 1;
            ridx[i] = (unsigned)ST[(size_t)e * CAP + rr] * (unsigned)arow_bytes; }
        __syncthreads();
    }
}

struct EpiStore { bf16* O; int ldc; float scale_lo; int sig_from; bf16* VT; float sall = 1.0f;
    __device__ __forceinline__ void operator()(const f32x4 (&acc)[2][2][4][2], const GUnit& u, int wr, int wc, int fr, int fq) const {
        const bool tr = u.aux != 0;
        const float sc = ((!tr && u.ocol < NQ) ? scale_lo : 1.0f) * sall; const bool sg = !tr && u.ocol >= sig_from;
        bf16* Ob = tr ? VT + (size_t)(u.orow * NH + u.ocol) * 65536 : O + (size_t)u.orow * ldc + u.ocol; const int ld = tr ? 256 : ldc;
#pragma unroll
        for (int ai = 0; ai < 2; ++ai)
#pragma unroll
            for (int m = 0; m < 4; ++m) { bf16* rowp = Ob + (size_t)(ai * HALF + wr * 64 + m * 16 + fr) * ld + wc * 32 + 8 * fq;
#pragma unroll
                for (int bj = 0; bj < 2; ++bj) { f32x4 v0 = acc[ai][bj][m][0] * sc, v1 = acc[ai][bj][m][1] * sc;
                    if (sg) {
#pragma unroll
                        for (int q = 0; q < 4; ++q) { v0[q] = __builtin_amdgcn_rcpf(1.0f + __expf(-v0[q])); v1[q] = __builtin_amdgcn_rcpf(1.0f + __expf(-v1[q])); } }
                    u32x4 w; w.x = cvt_pk_bf16(v0[0], v0[1]); w.y = cvt_pk_bf16(v0[2], v0[3]); w.z = cvt_pk_bf16(v1[0], v1[1]); w.w = cvt_pk_bf16(v1[2], v1[3]);
                    *(u32x4*)(rowp + bj * HALF) = w; } }
    }
};
__device__ __forceinline__ u32x2 cvt8_fp8(f32x4 a, f32x4 b) { int lo = 0, hi = 0;
    lo = __builtin_amdgcn_cvt_pk_fp8_f32(a[0], a[1], lo, false); lo = __builtin_amdgcn_cvt_pk_fp8_f32(a[2], a[3], lo, true);
    hi = __builtin_amdgcn_cvt_pk_fp8_f32(b[0], b[1], hi, false); hi = __builtin_amdgcn_cvt_pk_fp8_f32(b[2], b[3], hi, true); return (u32x2){(unsigned)lo, (unsigned)hi}; }
struct EpiSwigluF8 { unsigned char* O; int ldc; float s;
    __device__ __forceinline__ void operator()(const f32x4 (&acc)[2][2][4][2], const GUnit& u, int wr, int wc, int fr, int fq) const {
        const int ocol = u.ocol * HALF;
#pragma unroll
        for (int ai = 0; ai < 2; ++ai)
#pragma unroll
            for (int m = 0; m < 4; ++m) { unsigned char* rowp = O + (size_t)(u.orow + ai * HALF + wr * 64 + m * 16 + fr) * ldc + ocol + wc * 32 + 8 * fq;
                f32x4 v0, v1;
#pragma unroll
                for (int q = 0; q < 4; ++q) { const float x0 = acc[ai][0][m][0][q] * s, x1 = acc[ai][0][m][1][q] * s;
                    v0[q] = x0 * __builtin_amdgcn_rcpf(1.0f + __expf(-x0)) * (acc[ai][1][m][0][q] * s); v1[q] = x1 * __builtin_amdgcn_rcpf(1.0f + __expf(-x1)) * (acc[ai][1][m][1][q] * s); }
                *(u32x2*)rowp = cvt8_fp8(v0, v1); }
    }
};
template <int MODE> struct EpiPair { bf16* O; int ldc; int plain_below;
    __device__ __forceinline__ void operator()(const f32x4 (&acc)[2][2][4][2], const GUnit& u, int wr, int wc, int fr, int fq) const {
        if (MODE == 0 && u.ocol < plain_below) {
#pragma unroll
            for (int ai = 0; ai < 2; ++ai)
#pragma unroll
                for (int m = 0; m < 4; ++m) { bf16* rowp = O + (size_t)(u.orow + ai * HALF + wr * 64 + m * 16 + fr) * ldc + u.ocol + wc * 32 + 8 * fq;
#pragma unroll
                    for (int bj = 0; bj < 2; ++bj) { const f32x4 v0 = acc[ai][bj][m][0], v1 = acc[ai][bj][m][1];
                        u32x4 w; w.x = cvt_pk_bf16(v0[0], v0[1]); w.y = cvt_pk_bf16(v0[2], v0[3]); w.z = cvt_pk_bf16(v1[0], v1[1]); w.w = cvt_pk_bf16(v1[2], v1[3]);
                        *(u32x4*)(rowp + bj * HALF) = w; } }
            return;
        }
        const int ocol = (MODE == 0) ? plain_below + (u.ocol - plain_below) / 2 : u.ocol * HALF;
#pragma unroll
        for (int ai = 0; ai < 2; ++ai)
#pragma unroll
            for (int m = 0; m < 4; ++m) { bf16* rowp = O + (size_t)(u.orow + ai * HALF + wr * 64 + m * 16 + fr) * ldc + ocol + wc * 32 + 8 * fq;
                f32x4 v0, v1;
#pragma unroll
                for (int q = 0; q < 4; ++q) {
                    const float x0 = acc[ai][0][m][0][q], x1 = acc[ai][0][m][1][q];
                    const float g0 = (MODE == 1) ? x0 * __builtin_amdgcn_rcpf(1.0f + __expf(-x0)) : x0, g1 = (MODE == 1) ? x1 * __builtin_amdgcn_rcpf(1.0f + __expf(-x1)) : x1;
                    v0[q] = g0 * acc[ai][1][m][0][q]; v1[q] = g1 * acc[ai][1][m][1][q]; }
                u32x4 w; w.x = cvt_pk_bf16(v0[0], v0[1]); w.y = cvt_pk_bf16(v0[2], v0[3]); w.z = cvt_pk_bf16(v1[0], v1[1]); w.w = cvt_pk_bf16(v1[2], v1[3]);
                *(u32x4*)rowp = w; }
    }
};
struct EpiStoreTile { unsigned char* O; int ldc; float s;
    __device__ __forceinline__ void operator()(const f32x4 (&acc)[2][2][4][2], const GUnit& u, int wr, int wc, int fr, int fq) const {
#pragma unroll
        for (int ai = 0; ai < 2; ++ai)
#pragma unroll
            for (int m = 0; m < 4; ++m) { unsigned char* rowp = O + (size_t)(u.orow + ai * HALF + wr * 64 + m * 16 + fr) * ldc + u.ocol * BM + wc * 32 + 8 * fq;
#pragma unroll
                for (int bj = 0; bj < 2; ++bj) *(u32x2*)(rowp + bj * HALF) = cvt8_fp8(acc[ai][bj][m][0] * s, acc[ai][bj][m][1] * s); }
    }
};

__device__ __forceinline__ void transpose_item(const float* W, int ldw, int K, bf16* WT, int drow0, int k0, int n0, LAS float* scr, int lane) {
#pragma unroll
    for (int i = 0; i < 32; ++i) { const int kk = 2 * i + (lane >> 5); scr[kk * 33 + (lane & 31)] = W[(size_t)(k0 + kk) * ldw + n0 + (lane & 31)]; }
    asm volatile("s_waitcnt lgkmcnt(0)" ::: "memory");
    const int c = lane & 7;
#pragma unroll
    for (int j = 0; j < 4; ++j) { const int n = (lane >> 3) + 8 * j; const LAS float* s = scr + (8 * c) * 33 + n;
        u32x4 o; o.x = pk2(s[0 * 33], s[1 * 33]); o.y = pk2(s[2 * 33], s[3 * 33]); o.z = pk2(s[4 * 33], s[5 * 33]); o.w = pk2(s[6 * 33], s[7 * 33]);
        *(u32x4*)(WT + (size_t)(drow0 + n) * K + k0 + 8 * c) = o; }
    asm volatile("s_waitcnt lgkmcnt(0)" ::: "memory");
}
__device__ __forceinline__ void transpose_item_fp8(const float* W, int ldw, int K, unsigned char* WT8, int drow0, int k0, int n0, LAS float* scr, int lane, float sc) {
#pragma unroll
    for (int i = 0; i < 32; ++i) { const int kk = 2 * i + (lane >> 5); scr[kk * 33 + (lane & 31)] = W[(size_t)(k0 + kk) * ldw + n0 + (lane & 31)]; }
    asm volatile("s_waitcnt lgkmcnt(0)" ::: "memory");
    const int n = lane >> 1, half = lane & 1; const LAS float* sp = scr + (32 * half) * 33 + n;
    unsigned char* dst = WT8 + (size_t)(drow0 + n) * K + k0 + 32 * half;
#pragma unroll
    for (int c = 0; c < 2; ++c) { u32x4 o;
#pragma unroll
        for (int q = 0; q < 4; ++q) { int p = 0; const LAS float* s4 = sp + (16 * c + 4 * q) * 33;
            p = __builtin_amdgcn_cvt_pk_fp8_f32(s4[0] * sc, s4[33] * sc, p, false); p = __builtin_amdgcn_cvt_pk_fp8_f32(s4[66] * sc, s4[99] * sc, p, true); o[q] = (unsigned)p; }
        *(u32x4*)(dst + 16 * c) = o; }
    asm volatile("s_waitcnt lgkmcnt(0)" ::: "memory");
}
__device__ __forceinline__ int pair_row(int n, int which) { return (n >> 7) * 256 + (n & 127) + which * 128; }
__device__ __forceinline__ void phase_cvt_mixer(const Args& A, const Ctx& C) {
    LAS float* scr = (LAS float*)(C.lds + 16384 + C.wave * 16384);
    const int gw = C.bid * NW + C.wave, NGW = C.G * NW;
    constexpr int I_IN = (D / 64) * (PW / 32), I_OUT = (D / 64) * (D / 32), PER = 2 * (I_IN + I_OUT);
    for (int it = gw; it < 2 * PER; it += NGW) {
        const int kind = it / PER; int r = it % PER; const int j = r / (I_IN + I_OUT); r %= (I_IN + I_OUT);
        if (r < I_IN) { const int kb = r / (PW / 32), nb = r % (PW / 32), n0 = nb * 32;
            bf16* WT = (bf16*)(A.ws + (kind == 0 ? WS_WAIN : WS_WBIN)) + (size_t)j * PW * D;
            if (kind == 0) transpose_item(A.in[8] + (size_t)j * D * PROJ, PROJ, D, WT, n0, kb * 64, n0, scr, C.lane);
            else { const int drow = n0 < D ? n0 : (n0 < 2 * D ? D + pair_row(n0 - D, 0) : D + pair_row(n0 - 2 * D, 1));
                transpose_item(A.in[12] + (size_t)j * D * PW, PW, D, WT, drow, kb * 64, n0, scr, C.lane); } }
        else { r -= I_IN; const int kb = r / (D / 32), nb = r % (D / 32), n0 = nb * 32;
            unsigned char* WT = A.ws + (kind == 0 ? WS_WAOUT : WS_WBOUT) + (size_t)j * D * D;
            transpose_item_fp8((kind == 0 ? A.in[11] : A.in[14]) + (size_t)j * D * D, D, D, WT, n0, kb * 64, n0, scr, C.lane, WSCALE); }
    }
}
__device__ __forceinline__ void cvt_moe_items(const Args& A, const Ctx& C, int l, int it0, int end, int stride) {
    LAS float* scr = (LAS float*)(C.lds + 16384 + C.wave * 16384);
    unsigned char* WGU = A.ws + WS_WGU; unsigned char* WDN = A.ws + WS_WDN;
    for (int it = it0; it < end; it += stride) {
        const int e = it / CVT_PER; int r = it % CVT_PER;
        if (r < 2 * CVT_IG) { const int which = r / CVT_IG; r %= CVT_IG; const int kb = r / (DE / 32), nb = r % (DE / 32), n0 = nb * 32;
            transpose_item_fp8((which == 0 ? A.in[19] : A.in[20]) + ((size_t)l * NE + e) * D * DE, DE, D, WGU + (size_t)e * 2 * DE * D, pair_row(n0, which), kb * 64, n0, scr, C.lane, WSCALE); }
        else { r -= 2 * CVT_IG; const int kb = r / (D / 32), nb = r % (D / 32), n0 = nb * 32;
            transpose_item_fp8(A.in[21] + ((size_t)l * NE + e) * DE * D, D, DE, WDN + (size_t)e * D * DE, n0, kb * 64, n0, scr, C.lane, WSCALE); }
    }
}
__device__ __forceinline__ int cvt_idle(int nunits, int G) { const int rem = nunits % G; return rem ? G - rem : 0; }
__device__ __forceinline__ int cvt_t1(int l, int G) { const int n = cvt_idle((((l <= 2) ? NR : NL) / BM) * (PW / BM), G) * CVT_Q; return n < CVT_ITEMS ? n : CVT_ITEMS; }
__device__ __forceinline__ int cvt_t2(int l, int G) { const int n = cvt_t1(l, G) + cvt_idle((((l <= 1) ? NR : NL) / BM) * (D / BM), G) * CVT_Q; return n < CVT_ITEMS ? n : CVT_ITEMS; }
__device__ __forceinline__ void cvt_moe_tail(const Args& A, const Ctx& C, int l, int nunits, int base, int end) {
    const int rem = nunits % C.G;
    if (rem == 0 || C.bid < rem) return;
    const int first = base + (C.bid - rem) * CVT_Q; const int last = min(first + CVT_Q, end);
    cvt_moe_items(A, C, l, first + C.wave, last, NW);
}

__device__ __forceinline__ void phase_g1(const Args& A, const Ctx& C, int l) {
    const bool mls = (l & 1) == 0; const int j = l >> 1; const int nrows = (l <= 2) ? NR : NL;
    DenseSched S; S.init(A.ws + WS_HB, A.ws + (mls ? WS_WAIN : WS_WBIN) + (size_t)j * PW * D * 2, nrows, PW, D, C.G, C.bid);
    if (mls) { S.sw_lo = 4; S.sw_hi = 8; EpiStore E{(bf16*)(A.ws + WS_PB), PW, 0.08838834764831845f, 2 * NQ + NV, (bf16*)(A.ws + WS_VT)}; gemm_phase<EpiStore, DenseSched, false>(C.lds, D, S, E); }
    else { EpiPair<0> E{(bf16*)(A.ws + WS_PB), PW, D}; gemm_phase<EpiPair<0>, DenseSched, false>(C.lds, D, S, E); }
    cvt_moe_tail(A, C, l, S.nwg, 0, cvt_t1(l, C.G));
}
__device__ __forceinline__ void phase_g2(const Args& A, const Ctx& C, int l) {
    const bool mls = (l & 1) == 0; const int j = l >> 1; const int nrows = (l <= 1) ? NR : NL;
    DenseSched S; S.init(A.ws + WS_HM, A.ws + (mls ? WS_WAOUT : WS_WBOUT) + (size_t)j * D * D, nrows, D, D, C.G, C.bid, 1);
    EpiStore E{(bf16*)(A.ws + WS_HB), D, 1.0f, 1 << 30, nullptr, 1.0f / WSCALE}; gemm_phase<EpiStore, DenseSched, false, true>(C.lds, D, S, E);
    cvt_moe_tail(A, C, l, S.nwg, cvt_t1(l, C.G), cvt_t2(l, C.G));
}
__device__ __forceinline__ void phase_m1(const Args& A, const Ctx& C, int l) {
    LAS MoeTab* T = (LAS MoeTab*)(C.lds + LDS_TAB); LAS unsigned* ridx = (LAS unsigned*)(C.lds + LDS_TAB + 1024);
    moe_tables<true>(A, C, l, 4, T, ridx, D);
    MoeSched S; S.T = T; S.ridx = ridx; S.A = (const char*)(A.ws + WS_H8); S.W = (const char*)(A.ws + WS_WGU); S.wstride_e = (size_t)2 * DE * D; S.tstepB = (size_t)BM * D; S.K = D; S.arow_bytes = 0;
    EpiSwigluF8 E{A.ws + WS_DC, DE, 1.0f / WSCALE}; gemm_phase<EpiSwigluF8, MoeSched, true, true>(C.lds, D, S, E);
}
__device__ __forceinline__ void phase_m2(const Args& A, const Ctx& C, int l) {
    LAS MoeTab* T = (LAS MoeTab*)(C.lds + LDS_TAB); LAS unsigned* ridx = (LAS unsigned*)(C.lds + LDS_TAB + 1024);
    moe_tables<false>(A, C, l, 4, T, ridx, DE);
    MoeSched S; S.T = T; S.ridx = ridx; S.A = (const char*)(A.ws + WS_DC); S.W = (const char*)(A.ws + WS_WDN); S.wstride_e = (size_t)D * DE; S.tstepB = (size_t)BM * DE; S.K = DE; S.arow_bytes = DE;
    EpiStoreTile E{A.ws + WS_PB, D, YSCALE / WSCALE}; gemm_phase<EpiStoreTile, MoeSched, false, true>(C.lds, DE, S, E);
}

typedef float f32x16 __attribute__((ext_vector_type(16)));
#define MFMA32(a, b, c) __builtin_amdgcn_mfma_f32_32x32x16_bf16((a), (b), (c), 0, 0, 0)
__device__ __forceinline__ bf16x8 pack8(float a0, float a1, float a2, float a3, float a4, float a5, float a6, float a7) {
    u32x4 p; p.x = cvt2(a0, a1); p.y = cvt2(a2, a3); p.z = cvt2(a4, a5); p.w = cvt2(a6, a7); return __builtin_bit_cast(bf16x8, p); }
__device__ __forceinline__ float bflo(unsigned w) { return __uint_as_float(w << 16); }
__device__ __forceinline__ float bfhi(unsigned w) { return __uint_as_float(w & 0xffff0000u); }
__device__ __forceinline__ int vt_tile(int b, int h, int blk) { return (blk == 0 ? 128 + b : b * 64 + blk - 1) * NH + h; }

__device__ __forceinline__ float wave_incl_scan(float v, int lane) {
#pragma unroll
    for (int o = 1; o < 64; o <<= 1) { const float t = __shfl_up(v, o); v += (lane >= o) ? t : 0.f; }
    return v;
}
__device__ __forceinline__ void block_gates(const Args& A, int row0, int h, LAS float* bf, LAS float* bb, LAS float* lif, LAS float* lib, int tid) {
    const float* GATE = (const float*)(A.ws + WS_GATE);
    if (tid < 256) { const float* g = GATE + (size_t)(row0 + tid) * 16; lif[tid] = g[0 + h]; bf[tid] = g[4 + h]; lib[tid] = g[8 + h]; bb[tid] = g[12 + h]; }
    __syncthreads();
    const int lane = tid & 63, wv = tid >> 6;
    if (wv == 0) { f32x4 x = *(LAS f32x4*)(bf + 4 * lane); x.y += x.x; x.z += x.y; x.w += x.z; const float tot = wave_incl_scan(x.w, lane); const float ex = tot - x.w;
        x.x += ex; x.y += ex; x.z += ex; x.w += ex; *(LAS f32x4*)(bf + 4 * lane) = x; }
    if (wv == 1) { f32x4 y = *(LAS f32x4*)(bb + 4 * (63 - lane)); y.z += y.w; y.y += y.z; y.x += y.y; const float tot = wave_incl_scan(y.x, lane); const float ex = tot - y.x;
        y.x += ex; y.y += ex; y.z += ex; y.w += ex; *(LAS f32x4*)(bb + 4 * (63 - lane)) = y; }
    __syncthreads();
}
__device__ __forceinline__ void phase_s1(const Args& A, const Ctx& C, int l) {
    LAS float* bf = (LAS float*)C.lds; LAS float* bb = bf + 256; LAS float* lif = bb + 256; LAS float* lib = lif + 256; LAS float* af = lib + 256; LAS float* ab = af + 256;
    constexpr int KP = 528;
    LAS unsigned char* KTf = C.lds + 8192; LAS unsigned char* KTb = KTf + 128 * KP;
    const bf16* P = (const bf16*)(A.ws + WS_PB); const bf16* VT = (const bf16*)(A.ws + WS_VT);
    float* DC = (float*)(A.ws + WS_DC); float* DN = (float*)(A.ws + WS_DN); float* BT = (float*)(A.ws + WS_BTOT);
    const int r = C.lane & 31, hh = C.lane >> 5, w = C.wave;
    for (int u = C.bid; u < NUNIT; u += C.G) {
        const int blk = u % NBLK, bh = u / NBLK, h = bh % NH, b = bh / NH; const int row0 = blk_row0(b, blk);
        block_gates(A, row0, h, bf, bb, lif, lib, C.tid);
        if (C.tid < 256) { af[C.tid] = __expf(bf[255] - bf[C.tid] + lif[C.tid]); ab[C.tid] = __expf(bb[0] - bb[C.tid] + lib[C.tid]); }
        if (C.tid == 0) { BT[u * 2 + 0] = bf[255]; BT[u * 2 + 1] = bb[0]; }
        __syncthreads();
        { const int sp = C.tid >> 2, dq = C.tid & 3, s0 = 2 * sp;
          const bf16* k0 = P + (size_t)(row0 + s0) * PW + NQ + h * DQK + 32 * dq;
          const float f0 = af[s0], f1 = af[s0 + 1], g0 = ab[s0], g1 = ab[s0 + 1];
#pragma unroll
          for (int c = 0; c < 4; ++c) { const u32x4 x0 = *(const u32x4*)(k0 + 8 * c), x1 = *(const u32x4*)(k0 + PW + 8 * c);
#pragma unroll
              for (int q = 0; q < 4; ++q) { const int d = 32 * dq + 8 * c + 2 * q;
                  const float a0 = bflo(x0[q]), a1 = bfhi(x0[q]), c0 = bflo(x1[q]), c1 = bfhi(x1[q]);
                  *(LAS unsigned*)(KTf + d * KP + s0 * 2) = cvt2(a0 * f0, c0 * f1); *(LAS unsigned*)(KTf + (d + 1) * KP + s0 * 2) = cvt2(a1 * f0, c1 * f1);
                  *(LAS unsigned*)(KTb + d * KP + s0 * 2) = cvt2(a0 * g0, c0 * g1); *(LAS unsigned*)(KTb + (d + 1) * KP + s0 * 2) = cvt2(a1 * g0, c1 * g1); } } }
        __syncthreads();
        if (C.tid < 256) { const int dir = C.tid >> 7, d = C.tid & 127; LAS const unsigned* kr = (LAS const unsigned*)((dir ? KTb : KTf) + d * KP); float s = 0.f;
            for (int i = 0; i < 128; ++i) { const unsigned x = kr[i]; s += bflo(x) + bfhi(x); }
            DN[(size_t)(u * 2 + dir) * DQK + d] = s; }
        const bf16* vt = VT + (size_t)vt_tile(b, h, blk) * 65536 + (size_t)(32 * w + r) * 256 + 8 * hh;
        f32x16 accf[4], accb[4];
#pragma unroll
        for (int dt = 0; dt < 4; ++dt)
#pragma unroll
            for (int i = 0; i < 16; ++i) { accf[dt][i] = 0.f; accb[dt][i] = 0.f; }
#pragma unroll 2
        for (int ks = 0; ks < 16; ++ks) { const bf16x8 a = *(const bf16x8*)(vt + 16 * ks);
#pragma unroll
            for (int dt = 0; dt < 4; ++dt) { const int off = (dt * 32 + r) * KP + (16 * ks + 8 * hh) * 2;
                const bf16x8 b0 = *(const LAS bf16x8*)(KTf + off), b1 = *(const LAS bf16x8*)(KTb + off);
                accf[dt] = MFMA32(a, b0, accf[dt]); accb[dt] = MFMA32(a, b1, accb[dt]); } }
        float* dcf = DC + (size_t)(u * 2 + 0) * DQK * DV + (size_t)(32 * w + 4 * hh) * DQK + r; float* dcb = dcf + DQK * DV;
#pragma unroll
        for (int g = 0; g < 4; ++g) { float* pf = dcf + g * 8 * DQK; float* pb = dcb + g * 8 * DQK; asm volatile("" : "+v"(pf), "+v"(pb));
#pragma unroll
            for (int q = 0; q < 4; ++q)
#pragma unroll
                for (int dt = 0; dt < 4; ++dt) { pf[q * DQK + dt * 32] = accf[dt][4 * g + q]; pb[q * DQK + dt * 32] = accb[dt][4 * g + q]; } }
        __syncthreads();
    }
}
__device__ __forceinline__ void phase_s2(const Args& A, const Ctx& C) {
    const float* __restrict__ DC = (const float*)(A.ws + WS_DC); const float* __restrict__ DN = (const float*)(A.ws + WS_DN); const float* __restrict__ BT = (const float*)(A.ws + WS_BTOT);
    bf16* __restrict__ CST = (bf16*)(A.ws + WS_CST); float* __restrict__ NST = (float*)(A.ws + WS_NST);
    constexpr int EL4 = DQK * DV / 4;
    for (int g = C.bid * NT + C.tid; g < BATCH * NH * 2 * EL4; g += C.G * NT) {
        const int e4 = (g % EL4) * 4, ch = g / EL4, dir = ch & 1, bh = ch >> 1;
        f32x4 st = (f32x4){0.f, 0.f, 0.f, 0.f};
#pragma unroll 13
        for (int idx = 0; idx < NBLK; ++idx) {
            const int blk = dir == 0 ? idx : (idx == 0 ? 0 : NBLK - idx); const int u = bh * NBLK + blk;
            const float dec = __expf(BT[u * 2 + dir]);
            const f32x4 dc = *(const f32x4*)(DC + (size_t)(u * 2 + dir) * DQK * DV + e4);
            u32x2 o; o.x = cvt2(st.x, st.y); o.y = cvt2(st.z, st.w);
            *(u32x2*)(CST + (size_t)(u * 2 + dir) * DQK * DV + e4) = o;
            st = st * dec + dc;
        }
    }
    for (int g = C.bid * NT + C.tid; g < BATCH * NH * 2 * DQK; g += C.G * NT) {
        const int d = g % DQK, ch = g / DQK, dir = ch & 1, bh = ch >> 1; float st = 0.f;
        for (int idx = 0; idx < NBLK; ++idx) {
            const int blk = dir == 0 ? idx : (idx == 0 ? 0 : NBLK - idx); const int u = bh * NBLK + blk;
            NST[(size_t)(u * 2 + dir) * DQK + d] = st; st = __expf(BT[u * 2 + dir]) * st + DN[(size_t)(u * 2 + dir) * DQK + d];
        }
    }
}
__device__ __forceinline__ void lds_barrier() { asm volatile("s_waitcnt lgkmcnt(0)" ::: "memory"); __builtin_amdgcn_s_barrier(); asm volatile("" ::: "memory"); }
__device__ __forceinline__ void phase_s3(const Args& A, const Ctx& C, int l) {
    const int jl = l >> 1; const bool ctx_out = (l == 0);
    LAS float* bf = (LAS float*)C.lds; LAS float* bb = bf + 256; LAS float* gf = bb + 256; LAS float* gb = gf + 256;
    LAS float* nf = gb + 256; LAS float* nb = nf + 128; LAS float* ssx = nb + 128;
    LAS float* cf = ssx + 256; LAS float* cb = cf + 256;
    constexpr int KP = 272, VP = 136, CP = 144, OP = 528;
    LAS unsigned char* Kimg = C.lds + 8192;
    LAS unsigned char* CH = Kimg + 256 * KP;
    static_assert(8192 + 256 * KP + 128 * OP <= LDS_TAB_END, "S3 LDS map");
    const bf16* P = (const bf16*)(A.ws + WS_PB); const bf16* VT = (const bf16*)(A.ws + WS_VT); unsigned char* HM = A.ws + WS_HM;
    const bf16* CST = (const bf16*)(A.ws + WS_CST); const float* NST = (const float*)(A.ws + WS_NST);
    const float* hg = A.in[10] + (size_t)jl * NV;
    const int w = C.wave, eh = w >> 2;
    for (int u = C.bid; u < NUNIT; u += C.G) {
        const int blk = u % NBLK, bh = u / NBLK, h = bh % NH, b = bh / NH; const int row0 = blk_row0(b, blk);
        if (blk == 0 && !ctx_out) continue;
        int tu = threadIdx.x; asm volatile("" : "+v"(tu));
        block_gates(A, row0, h, bf, bb, gf, gb, tu);
        if (tu < 256) { gf[tu] -= bf[tu]; gb[tu] -= bb[tu]; cf[tu] = __expf(bf[tu | 31] + gf[tu]); cb[tu] = __expf(bb[tu & ~31] + gb[tu]); }
        else { const int t2 = tu - 256; nf[t2] = NST[(size_t)(u * 2 + (t2 >> 7)) * DQK + (t2 & 127)]; }
        { const int pc = tu & 15, s0 = tu >> 4; const bf16* kr = P + (size_t)(row0 + s0) * PW + NQ + h * DQK + 8 * pc;
#pragma unroll
          for (int i = 0; i < 8; ++i) *(LAS u32x4*)(Kimg + (s0 + 32 * i) * KP + pc * 16) = *(const u32x4*)(kr + (size_t)(32 * i) * PW); }
        __syncthreads();
        const bf16* vtile = VT + (size_t)vt_tile(b, h, blk) * 65536;
        const bf16* ctile = CST + (size_t)(u * 2) * DQK * DV;
#pragma unroll 1
        for (int ps = 0; ps < 2; ++ps) {
            int lz = threadIdx.x & 63; asm volatile("" : "+v"(lz));
            const int r = lz & 31, hh = lz >> 5;
            const int jt = 2 * (w & 3) + ps; const int jrow = row0 + 32 * jt + r;
            bf16x8 qf[8];
            { const bf16* qr = P + (size_t)jrow * PW + h * DQK + 8 * hh;
#pragma unroll
              for (int kk = 0; kk < 8; ++kk) qf[kk] = *(const bf16x8*)(qr + 16 * kk); }
            const float bfj = bf[32 * jt + r], bbj = bb[32 * jt + r];
            float qnf = 0.f, qnb = 0.f;
#pragma unroll
            for (int kk = 0; kk < 8; ++kk) { const u32x4 qq = __builtin_bit_cast(u32x4, qf[kk]); const int d = 16 * kk + 8 * hh;
                const f32x4 n0 = *(const LAS f32x4*)(nf + d), n1 = *(const LAS f32x4*)(nf + d + 4), m0 = *(const LAS f32x4*)(nb + d), m1 = *(const LAS f32x4*)(nb + d + 4);
                qnf += (bflo(qq.x) * n0.x + bfhi(qq.x) * n0.y) + (bflo(qq.y) * n0.z + bfhi(qq.y) * n0.w) + (bflo(qq.z) * n1.x + bfhi(qq.z) * n1.y) + (bflo(qq.w) * n1.z + bfhi(qq.w) * n1.w);
                qnb += (bflo(qq.x) * m0.x + bfhi(qq.x) * m0.y) + (bflo(qq.y) * m0.z + bfhi(qq.y) * m0.w) + (bflo(qq.z) * m1.x + bfhi(qq.z) * m1.y) + (bflo(qq.w) * m1.z + bfhi(qq.w) * m1.w);
                if (kk & 1) asm volatile("" ::: "memory"); }
            qnf += __shfl_xor(qnf, 32); qnb += __shfl_xor(qnb, 32);
            u32x4 pre[4];
            { int tz = threadIdx.x; asm volatile("" : "+v"(tz)); const int pc = tz & 7, e0 = tz >> 3; const bf16* vr = vtile + (size_t)e0 * 256 + 8 * pc;
#pragma unroll
              for (int c4 = 0; c4 < 4; ++c4) pre[c4] = *(const u32x4*)(vr + (size_t)(64 * c4) * 256); }
            float denf = 0.f, denb = 0.f;
#pragma unroll 1
            for (int kt = 0; kt < 8; ++kt) {
                f32x16 c;
#pragma unroll
                for (int i = 0; i < 16; ++i) c[i] = 0.f;
#pragma unroll
                for (int kk = 0; kk < 8; ++kk) { const bf16x8 a = *(const LAS bf16x8*)(Kimg + (kt * 32 + r) * KP + (16 * kk + 8 * hh) * 2); c = MFMA32(a, qf[kk], c); }
                if (kt == jt) {
#pragma unroll
                    for (int g = 0; g < 4; ++g) { const int sl0 = 8 * g + 4 * hh;
                        const f32x4 g4f = *(const LAS f32x4*)(gf + kt * 32 + sl0), g4b = *(const LAS f32x4*)(gb + kt * 32 + sl0);
#pragma unroll
                        for (int q = 0; q < 4; ++q) { const int sl = sl0 + q; const float cv = c[4 * g + q];
                            denf += cv * __expf((sl <= r) ? bfj + g4f[q] : -1.0e30f); denb += cv * __expf((sl >= r) ? bbj + g4b[q] : -1.0e30f); } }
                } else {
                    LAS const float* cx = (kt < jt ? cf : cb) + kt * 32 + 4 * hh; float sm = 0.f;
#pragma unroll
                    for (int g = 0; g < 4; ++g) { const f32x4 c4 = *(const LAS f32x4*)(cx + 8 * g); sm += (c[4 * g] * c4.x + c[4 * g + 1] * c4.y) + (c[4 * g + 2] * c4.z + c[4 * g + 3] * c4.w); }
                    if (kt < jt) denf += sm * __expf(bfj - bf[kt * 32 + 31]); else denb += sm * __expf(bbj - bb[kt * 32]);
                }
            }
            denf += __shfl_xor(denf, 32); denb += __shfl_xor(denb, 32);
            const float ebf = __expf(bfj), ebb = __expf(bbj);
            denf += ebf * qnf; denb += ebb * qnb;
            const float rf = 1.0f / fmaxf(fabsf(denf), 1.0f), rb = 1.0f / fmaxf(fabsf(denb), 1.0f);
            const float scf = ebf * rf, scb = ebb * rb;
            f32x16 acc[4];
#pragma unroll
            for (int et = 0; et < 4; ++et)
#pragma unroll
                for (int i = 0; i < 16; ++i) acc[et][i] = 0.f;
#pragma unroll
            for (int ci = 0; ci < 8; ++ci) {
                lds_barrier();
                { int tz = threadIdx.x; asm volatile("" : "+v"(tz)); const int pc = tz & 7, e0 = tz >> 3;
                  if (ci < 4) {
#pragma unroll
                      for (int c4 = 0; c4 < 4; ++c4) { *(LAS u32x2*)(CH + (e0 + 64 * c4) * VP + pc * 16) = (u32x2){pre[c4].x, pre[c4].y}; *(LAS u32x2*)(CH + (e0 + 64 * c4) * VP + pc * 16 + 8) = (u32x2){pre[c4].z, pre[c4].w}; }
                  } else {
#pragma unroll
                      for (int c4 = 0; c4 < 4; ++c4) *(LAS u32x4*)(CH + (e0 + 64 * c4) * CP + pc * 16) = pre[c4];
                  }
                  if (ci < 7) { const int cn = ci + 1;
                      const bf16* src = (cn < 4) ? vtile + (size_t)e0 * 256 + 64 * cn + 8 * pc : ctile + (size_t)(cn >= 6 ? DQK * DV : 0) + (size_t)e0 * DQK + 64 * (cn & 1) + 8 * pc;
                      const size_t rstep = (cn < 4) ? (size_t)64 * 256 : (size_t)64 * DQK;
#pragma unroll
                      for (int c4 = 0; c4 < 4; ++c4) pre[c4] = *(const u32x4*)(src + c4 * rstep); } }
                lds_barrier();
                if (ci < 4) {
#pragma unroll 1
                    for (int kt2 = 0; kt2 < 2; ++kt2) { const int kt = 2 * ci + kt2;
                        f32x16 c;
#pragma unroll
                        for (int i = 0; i < 16; ++i) c[i] = 0.f;
#pragma unroll
                        for (int kk = 0; kk < 8; ++kk) { const bf16x8 a = *(const LAS bf16x8*)(Kimg + (kt * 32 + r) * KP + (16 * kk + 8 * hh) * 2); c = MFMA32(a, qf[kk], c); }
                        float p[16]; const float bfj2 = bf[32 * jt + r], bbj2 = bb[32 * jt + r];
                        if (kt == jt) {
#pragma unroll
                            for (int g = 0; g < 4; ++g) { const int sl0 = 8 * g + 4 * hh;
                                const f32x4 g4f = *(const LAS f32x4*)(gf + kt * 32 + sl0), g4b = *(const LAS f32x4*)(gb + kt * 32 + sl0);
#pragma unroll
                                for (int q = 0; q < 4; ++q) { const int sl = sl0 + q;
                                    const float wt = rf * __expf((sl <= r) ? bfj2 + g4f[q] : -1.0e30f) + rb * __expf((sl >= r) ? bbj2 + g4b[q] : -1.0e30f);
                                    p[4 * g + q] = c[4 * g + q] * wt; } }
                        } else {
                            LAS const float* cx = (kt < jt ? cf : cb) + kt * 32 + 4 * hh;
                            const float rw = (kt < jt) ? rf * __expf(bfj2 - bf[kt * 32 + 31]) : rb * __expf(bbj2 - bb[kt * 32]);
#pragma unroll
                            for (int g = 0; g < 4; ++g) { const f32x4 c4 = *(const LAS f32x4*)(cx + 8 * g);
                                p[4 * g] = c[4 * g] * (c4.x * rw); p[4 * g + 1] = c[4 * g + 1] * (c4.y * rw); p[4 * g + 2] = c[4 * g + 2] * (c4.z * rw); p[4 * g + 3] = c[4 * g + 3] * (c4.w * rw); }
                        }
                        const bf16x8 pa0 = pack8(p[0], p[1], p[2], p[3], p[4], p[5], p[6], p[7]), pa1 = pack8(p[8], p[9], p[10], p[11], p[12], p[13], p[14], p[15]);
#pragma unroll
                        for (int et = 0; et < 4; ++et) { LAS const unsigned char* vb = CH + ((4 * eh + et) * 32 + r) * VP + (kt2 * 32 + 4 * hh) * 2;
                            const u32x2 l0 = *(LAS const u32x2*)(vb), h0 = *(LAS const u32x2*)(vb + 16), l1 = *(LAS const u32x2*)(vb + 32), h1 = *(LAS const u32x2*)(vb + 48);
                            const bf16x8 a0 = __builtin_bit_cast(bf16x8, (u32x4){l0.x, l0.y, h0.x, h0.y}), a1 = __builtin_bit_cast(bf16x8, (u32x4){l1.x, l1.y, h1.x, h1.y});
                            acc[et] = MFMA32(a0, pa0, acc[et]); acc[et] = MFMA32(a1, pa1, acc[et]); }
                    }
                } else {
                    const int dir = (ci - 4) >> 1, dh = ci & 1;
                    const float sc = dir ? scb : scf;
#pragma unroll
                    for (int k4 = 0; k4 < 4; ++k4) { const u32x4 qq = __builtin_bit_cast(u32x4, qf[4 * dh + k4]);
                        const bf16x8 qs = pack8(bflo(qq.x) * sc, bfhi(qq.x) * sc, bflo(qq.y) * sc, bfhi(qq.y) * sc, bflo(qq.z) * sc, bfhi(qq.z) * sc, bflo(qq.w) * sc, bfhi(qq.w) * sc);
#pragma unroll
                        for (int et = 0; et < 4; ++et) { const bf16x8 a = *(const LAS bf16x8*)(CH + ((4 * eh + et) * 32 + r) * CP + (16 * k4 + 8 * hh) * 2); acc[et] = MFMA32(a, qs, acc[et]); } }
                }
            }
            float ss = 0.f;
#pragma unroll
            for (int et = 0; et < 4; ++et)
#pragma unroll
                for (int i = 0; i < 16; ++i) ss += acc[et][i] * acc[et][i];
            ss += __shfl_xor(ss, 32);
            if (hh == 0) ssx[w * 32 + r] = ss;
            lds_barrier();
            ss += ssx[(w ^ 4) * 32 + r];
            const float rs = 1.0f / sqrtf(ss * (1.0f / DV) + EPS);
            { LAS unsigned char* ob = CH + ((w & 3) * 32 + r) * OP + (eh * 128 + 4 * hh) * 2;
#pragma unroll
              for (int et = 0; et < 4; ++et)
#pragma unroll
                  for (int g = 0; g < 4; ++g) { u32x2 o; o.x = cvt2(acc[et][4 * g + 0] * rs, acc[et][4 * g + 1] * rs); o.y = cvt2(acc[et][4 * g + 2] * rs, acc[et][4 * g + 3] * rs);
                      *(LAS u32x2*)(ob + (et * 32 + 8 * g) * 2) = o; } }
            lds_barrier();
            { int tz = threadIdx.x; asm volatile("" : "+v"(tz)); const int pc = tz & 31, lr0 = tz >> 5;
              const f32x4 g0 = *(const f32x4*)(hg + h * DV + 8 * pc), g1 = *(const f32x4*)(hg + h * DV + 8 * pc + 4);
#pragma unroll
              for (int hf = 0; hf < 2; ++hf) {
              u32x4 ov[4];
#pragma unroll
              for (int i = 0; i < 4; ++i) { const int lr = lr0 + 16 * (4 * hf + i); const int grow = row0 + 64 * (lr >> 5) + 32 * ps + (lr & 31); ov[i] = *(const u32x4*)(P + (size_t)grow * PW + 2 * NQ + NV + h * DV + 8 * pc); }
#pragma unroll
              for (int i = 0; i < 4; ++i) { const int lr = lr0 + 16 * (4 * hf + i); const int grow = row0 + 64 * (lr >> 5) + 32 * ps + (lr & 31);
                  const u32x4 hv = *(const LAS u32x4*)(CH + lr * OP + pc * 16);
                  const f32x4 o0 = (f32x4){bflo(hv.x) * g0.x * bflo(ov[i].x), bfhi(hv.x) * g0.y * bfhi(ov[i].x), bflo(hv.y) * g0.z * bflo(ov[i].y), bfhi(hv.y) * g0.w * bfhi(ov[i].y)};
                  const f32x4 o1 = (f32x4){bflo(hv.z) * g1.x * bflo(ov[i].z), bfhi(hv.z) * g1.y * bfhi(ov[i].z), bflo(hv.w) * g1.z * bflo(ov[i].w), bfhi(hv.w) * g1.w * bfhi(ov[i].w)};
                  *(u32x2*)(HM + (size_t)grow * D + h * DV + 8 * pc) = cvt8_fp8(o0, o1); }
              asm volatile("" ::: "memory"); } }
        }
        __syncthreads();
    }
}

#define XB_TMO      128
#define XB_XCNT(j)  (256  + 64 * (j))
#define XB_XSUB(j)  (1280 + 64 * (j))
#define XB_XGEN(j)  (2304 + 64 * (j))
#define XB_TOP      3328
#define XB_TOPGEN   3392
#define XCD_BAR_WORDS 3456
#define XB_SPIN_CAP (1u << 18)

__device__ __forceinline__ unsigned xb_ld(unsigned* p)              { return __hip_atomic_load(p, __ATOMIC_RELAXED, __HIP_MEMORY_SCOPE_AGENT); }
__device__ __forceinline__ unsigned xb_add(unsigned* p, unsigned v) { return __hip_atomic_fetch_add(p, v, __ATOMIC_RELAXED, __HIP_MEMORY_SCOPE_AGENT); }
__device__ __forceinline__ unsigned xb_xcc_id() { return (unsigned)__builtin_amdgcn_s_getreg((3 << 11) | 20) & 0xFu; }
#define XB_SPIN(cond, bar) do { unsigned _sp = 0; while (cond) { __builtin_amdgcn_s_sleep(1); \
    if ((++_sp & 255u) == 0u) { if (xb_ld(&(bar)[XB_TMO])) break; if (_sp > XB_SPIN_CAP) { atomicAdd(&(bar)[XB_TMO], 1u); break; } } } } while (0)

struct XcdBarrier {
    unsigned* bar; unsigned x;
    volatile LAS unsigned* st;
};

__device__ __forceinline__ XcdBarrier xcd_barrier_post(unsigned* bar, volatile LAS unsigned* st) {
    XcdBarrier b; b.bar = bar; b.x = xb_xcc_id(); b.st = st;
    if (threadIdx.x == 0) (void)xb_add(&bar[XB_XCNT(b.x)], 1u);
    return b;
}
__device__ __forceinline__ void xcd_barrier_complete(unsigned* bar, unsigned x, unsigned& nloc, unsigned& nx) {
    const unsigned G = gridDim.x * gridDim.y * gridDim.z;
    unsigned sum, cnt, mine, sp = 0u;
    for (;;) {
        sum = 0u; cnt = 0u; mine = 0u;
#pragma unroll
        for (unsigned j = 0; j < 16; ++j) { const unsigned c = xb_ld(&bar[XB_XCNT(j)]); sum += c; cnt += (c > 0u) ? 1u : 0u; mine = (j == x) ? c : mine; }
        if (sum == G) break;
        __builtin_amdgcn_s_sleep(1);
        if ((++sp & 255u) == 0u) { if (xb_ld(&bar[XB_TMO])) break; if (sp > XB_SPIN_CAP) { atomicAdd(&bar[XB_TMO], 1u); break; } }
    }
    nloc = mine > 0u ? mine : 1u; nx = cnt > 0u ? cnt : 1u;
}

__device__ __forceinline__ void xcd_barrier(const XcdBarrier& b) {
    asm volatile("s_waitcnt vmcnt(0)" ::: "memory");
    __syncthreads();
    if (threadIdx.x == 0) {
        unsigned* bar = b.bar;
        __builtin_amdgcn_s_waitcnt(0);
        unsigned nloc = b.st[0], nx = b.st[1];
        if (nloc == 0u) { xcd_barrier_complete(bar, b.x, nloc, nx); b.st[0] = nloc; b.st[1] = nx; }
        const unsigned old = xb_add(&bar[XB_XSUB(b.x)], 1u);
        const unsigned gen = old / nloc;
        if (old + 1u == (gen + 1u) * nloc) {
            __builtin_amdgcn_fence(__ATOMIC_RELEASE, "agent");
            asm volatile("s_waitcnt vmcnt(0)" ::: "memory");
            const unsigned og = xb_add(&bar[XB_TOP], 1u);
            const unsigned tg = og / nx;
            if (og + 1u == (tg + 1u) * nx) xb_add(&bar[XB_TOPGEN], 1u);
            else XB_SPIN(xb_ld(&bar[XB_TOPGEN]) == tg, bar);
            __builtin_amdgcn_fence(__ATOMIC_ACQUIRE, "agent");
            xb_add(&bar[XB_XGEN(b.x)], 1u);
            asm volatile("s_waitcnt vmcnt(0)" ::: "memory");
        } else {
            XB_SPIN(xb_ld(&bar[XB_XGEN(b.x)]) == gen, bar);
            __builtin_amdgcn_fence(__ATOMIC_ACQUIRE, "agent");
            asm volatile("s_waitcnt vmcnt(0)" ::: "memory");
        }
    }
    __syncthreads();
}


constexpr int LDS_BYTES = 152 * 1024;
constexpr int CW_BAR = 16384;
static_assert((CW_BAR + XCD_BAR_WORDS) * 4 <= (int)CTL_BYTES, "ctl");
#ifndef MK_MULTI
#define MK_MULTI 0
#endif
#define IN(p) (lo <= (p) && (p) < hi)
#ifndef PROBE_MASK
#define PROBE_MASK 0
#endif
#define DUP(bit, call) do { call; } while (0)
#define SEAM(p) do { if ((p) + 1 < hi) { XcdBarrier b_; b_.bar = (unsigned*)(load_args().ws + WS_CTL) + CW_BAR; b_.x = xb_xcc_id(); b_.st = (volatile LAS unsigned*)(C.lds + LDS_BYTES - 16); xcd_barrier(b_); } } while (0)
#define CAS __attribute__((address_space(4)))
__device__ __forceinline__ Args load_args() {
#if defined(__HIP_DEVICE_COMPILE__)
    const CAS Args* p = (const CAS Args*)__builtin_amdgcn_kernarg_segment_ptr(); asm volatile("" : "+s"(p));
    Args a; for (int i = 0; i < 22; ++i) a.in[i] = p->in[i]; a.out = p->out; a.ws = p->ws; a.lo = p->lo; a.hi = p->hi; return a;
#else
    return Args{};
#endif
}
__device__ __forceinline__ Ctx fresh(const Ctx& C) { Ctx R = C; int tz = threadIdx.x; asm volatile("" : "+v"(tz)); R.tid = tz; R.lane = tz & 63; return R; }
template <int L> __device__ __forceinline__ void layer_phases(const Args& args, const Ctx& C, int bar, int lo, int hi) {
    constexpr int pb = 16 * L;
    if (IN(pb + 1)) { phase_r1(load_args(), fresh(C), L); SEAM(pb + 1); }
    if (IN(pb + 2)) { DUP(1, phase_g1(load_args(), fresh(C), L)); SEAM(pb + 2); }
    if constexpr ((L & 1) == 0) {
        if (IN(pb + 3)) { DUP(2, phase_s1(load_args(), fresh(C), L)); SEAM(pb + 3); }
        if (IN(pb + 4)) { DUP(2, phase_s2(load_args(), fresh(C))); SEAM(pb + 4); }
        if (IN(pb + 5)) { DUP(2, phase_s3(load_args(), fresh(C), L)); SEAM(pb + 5); }
    } else {
        if (IN(pb + 3)) { DUP(8, phase_conv(load_args(), fresh(C), L)); SEAM(pb + 3); }
    }
    if (IN(pb + 6)) { DUP(1, phase_g2(load_args(), fresh(C), L)); SEAM(pb + 6); }
    if (IN(pb + 7)) { phase_r2(load_args(), fresh(C), L); SEAM(pb + 7); }
    if (IN(pb + 8)) { DUP(1, phase_m1(load_args(), fresh(C), L)); SEAM(pb + 8); }
    if (IN(pb + 9)) { DUP(1, phase_m2(load_args(), fresh(C), L)); SEAM(pb + 9); }
}
__global__ void __launch_bounds__(NT, 2) fwd_kernel(Args args) {
    extern __shared__ __attribute__((aligned(16))) unsigned char lds_raw[];
    Ctx C; C.lds = (LAS unsigned char*)lds_raw; C.tid = threadIdx.x; C.lane = C.tid & 63; C.wave = __builtin_amdgcn_readfirstlane(C.tid >> 6); C.G = gridDim.x; C.bid = blockIdx.x; C.a = &args;
    const int lo = args.lo, hi = args.hi;
    volatile LAS unsigned* xbw = (volatile LAS unsigned*)(C.lds + LDS_BYTES - 16);
    if (C.tid < 4) xbw[C.tid] = 0u;
    __syncthreads();
    if (hi - lo > 1) (void)xcd_barrier_post((unsigned*)(args.ws + WS_CTL) + CW_BAR, xbw);
    const int bar = 0; (void)bar;
    if (IN(0)) { DUP(4, phase_mod(load_args(), fresh(C))); __syncthreads(); DUP(4, phase_cvt_mixer(load_args(), fresh(C))); SEAM(0); }
    layer_phases<0>(args, C, bar, lo, hi);
    layer_phases<1>(args, C, bar, lo, hi);
    layer_phases<2>(args, C, bar, lo, hi);
    layer_phases<3>(args, C, bar, lo, hi);
    if (IN(64)) phase_final(load_args(), fresh(C));
}
#undef IN
#undef SEAM

extern "C" void kernel_launch(void* const* d_in, const int* in_sizes, int n_in, void* d_out, int out_size, void* d_ws, size_t ws_size, hipStream_t stream) {
    static int grid = 0;
    if (grid == 0) {
        if (n_in != 22 || out_size != NL * D || ws_size < WS_END) { fprintf(stderr, "kernel_launch: unexpected shapes (n_in %d out %d ws %zu)\n", n_in, out_size, ws_size); grid = -1; return; }
        int dev = 0, cus = 0, per_cu = 0;
        if (hipGetDevice(&dev) != hipSuccess || hipDeviceGetAttribute(&cus, hipDeviceAttributeMultiprocessorCount, dev) != hipSuccess) { grid = -1; return; }
        if (hipFuncSetAttribute((const void*)fwd_kernel, hipFuncAttributeMaxDynamicSharedMemorySize, LDS_BYTES) != hipSuccess) { grid = -1; return; }
        if (hipOccupancyMaxActiveBlocksPerMultiprocessor(&per_cu, (const void*)fwd_kernel, NT, LDS_BYTES) != hipSuccess || per_cu < 1) { fprintf(stderr, "kernel_launch: occupancy query says %d\n", per_cu); }
        (void)hipGetLastError();
        grid = cus;
    }
    if (grid < 0) return;
    (void)hipMemsetAsync((char*)d_ws + WS_CTL, 0, CTL_BYTES, stream);
    Args a{};
    for (int i = 0; i < 22; ++i) a.in[i] = (const float*)d_in[i];
    a.out = (float*)d_out; a.ws = (unsigned char*)d_ws;
#if MK_MULTI
    int phases[64]; int np = 0;
    phases[np++] = 0;
    for (int l = 0; l < DEPTH; ++l) { const int pb = 16 * l; phases[np++] = pb + 1; phases[np++] = pb + 2; phases[np++] = pb + 3;
        if ((l & 1) == 0) { phases[np++] = pb + 4; phases[np++] = pb + 5; }
        phases[np++] = pb + 6; phases[np++] = pb + 7; phases[np++] = pb + 8; phases[np++] = pb + 9; }
    phases[np++] = 64;
    for (int i = 0; i < np; ++i) { a.lo = phases[i]; a.hi = phases[i] + 1; hipLaunchKernelGGL(fwd_kernel, dim3(grid), dim3(NT), LDS_BYTES, stream, a); }
#else
    a.lo = 0; a.hi = 65;
    hipLaunchKernelGGL(fwd_kernel, dim3(grid), dim3(NT), LDS_BYTES, stream, a);
#ifdef PROBE_PHASES
    { const int pp[] = {PROBE_PHASES};
      for (int rep = 0; rep < PROBE_REPS; ++rep) for (unsigned i = 0; i < sizeof(pp) / sizeof(pp[0]); ++i) { a.lo = pp[i]; a.hi = pp[i] + 1; hipLaunchKernelGGL(fwd_kernel, dim3(grid), dim3(NT), LDS_BYTES, stream, a); } }
#endif
#endif
}
```

```cpp
#include <hip/hip_runtime.h>
#include <cstdio>
#include <cstdint>

#define LAS __attribute__((address_space(3)))
typedef unsigned short bf16;
typedef float f32x4 __attribute__((ext_vector_type(4)));
typedef unsigned u32x4 __attribute__((ext_vector_type(4)));
typedef unsigned u32x2 __attribute__((ext_vector_type(2)));

constexpr int D = 1024, BATCH = 2, SEQ = 16384, DEPTH = 4, CTXL = 256;
constexpr int NL = BATCH * SEQ, NCX = BATCH * CTXL, NR = NL + NCX;
constexpr int NH = 4, DQK = 128, DV = 256, NQ = 512, NV = 1024, PROJ = 3088, PW = 3072;
constexpr int NGRP = 4, EPG = 8, NE = 32, DE = 512;
constexpr int NBLK = 65;
constexpr int NUNIT = BATCH * NH * NBLK;
constexpr int CAP = NR;
constexpr int YROWS = 74752;
constexpr float EPS = 1e-6f;
constexpr float WSCALE = 32.0f;
constexpr float YSCALE = 4.0f;
constexpr int NT = 512, NW = 8;
constexpr int LDS_TAB_END = 152 * 1024 - 16;

constexpr size_t MiB = 1u << 20;
constexpr size_t WS_CTL = 0, CTL_BYTES = 1 * MiB;
constexpr size_t WS_MOD = 1 * MiB;
constexpr size_t WS_GATE = 2 * MiB;
constexpr size_t WS_TOKSLOT = 5 * MiB;
constexpr size_t WS_TOKW = 6 * MiB;
constexpr size_t WS_SLOTTOK = 7 * MiB;
constexpr size_t WS_DN = 12 * MiB;
constexpr size_t WS_NST = 13 * MiB;
constexpr size_t WS_BTOT = 14 * MiB;
constexpr size_t WS_LAT = 16 * MiB;
constexpr size_t WS_HB = 146 * MiB;
constexpr size_t WS_PB = 211 * MiB;
constexpr size_t WS_HM = 406 * MiB;
constexpr size_t WS_DC = 471 * MiB;
constexpr size_t WS_CST = 601 * MiB;
constexpr size_t WS_VT = 666 * MiB;
constexpr size_t WS_WAIN = 731 * MiB;
constexpr size_t WS_WBIN = 743 * MiB;
constexpr size_t WS_WAOUT = 755 * MiB;
constexpr size_t WS_WBOUT = 759 * MiB;
constexpr size_t WS_WGU = 763 * MiB;
constexpr size_t WS_WDN = 827 * MiB;
constexpr size_t WS_H8 = 843 * MiB;
constexpr size_t WS_END = 880 * MiB;
constexpr int CW_CNT = 1024, CNT_STRIDE = 64;

struct Args { const float* in[22]; float* out; unsigned char* ws; int lo, hi; };

typedef short bf16x8 __attribute__((ext_vector_type(8)));
typedef float f32x2 __attribute__((ext_vector_type(2)));
typedef __bf16 bf16x2_t __attribute__((ext_vector_type(2)));
__device__ __forceinline__ unsigned cvt2(float lo, float hi) { const f32x2 v = {lo, hi}; return __builtin_bit_cast(unsigned, __builtin_convertvector(v, bf16x2_t)); }
__device__ __forceinline__ float bf2f(bf16 v) { return __uint_as_float(((unsigned)v) << 16); }
__device__ __forceinline__ unsigned f2bf(float f) { unsigned u = __float_as_uint(f); return (u + 0x7fffu + ((u >> 16) & 1u)) >> 16; }
__device__ __forceinline__ unsigned pk2(float lo, float hi) { return f2bf(lo) | (f2bf(hi) << 16); }
template <int CTRL, int ROWMASK> __device__ __forceinline__ float dpp_mov(float x) { return __int_as_float(__builtin_amdgcn_update_dpp(0, __float_as_int(x), CTRL, ROWMASK, 0xf, false)); }
__device__ __forceinline__ float wave_sum(float v) {
    v += dpp_mov<0xB1, 0xf>(v); v += dpp_mov<0x4E, 0xf>(v); v += dpp_mov<0x141, 0xf>(v); v += dpp_mov<0x140, 0xf>(v);
    v += dpp_mov<0x142, 0xA>(v); v += dpp_mov<0x143, 0xC>(v);
    return __int_as_float(__builtin_amdgcn_readlane(__float_as_int(v), 63));
}
__device__ __forceinline__ float sigmoidf_(float x) { return 1.f / (1.f + __expf(-x)); }
__device__ __forceinline__ float siluf_(float x) { return x / (1.f + __expf(-x)); }
__device__ __forceinline__ float logsigmoidf_(float x) { return fminf(x, 0.f) - log1pf(__expf(-fabsf(x))); }
__device__ __forceinline__ int blk_row0(int b, int blk) { return blk == 0 ? NL + b * CTXL : b * SEQ + (blk - 1) * 256; }
__device__ __forceinline__ int mod_vec_of_row(int row) { return row < NL ? row / SEQ : 2; }

struct Ctx {
    LAS unsigned char* lds; int tid, lane, wave, G, bid;
    const Args* a;
};

__device__ __forceinline__ int expert_block_prefix(const unsigned* cnt, int lane, int& nb) {
    nb = lane < NE ? ((int)cnt[lane * CNT_STRIDE] + 255) / 256 : 0; int v = nb;
#pragma unroll
    for (int o = 1; o < 64; o <<= 1) { const int t = __shfl_up(v, o); v += (lane >= o) ? t : 0; }
    return v - nb;
}
__device__ __forceinline__ void slot_bases(const Args& A, int l, LAS int* sb, int tid) {
    if (tid < 64) { int nb; const int ex = expert_block_prefix((const unsigned*)(A.ws + WS_CTL) + CW_CNT + l * 32 * CNT_STRIDE, tid, nb); if (tid <= NE) sb[tid] = ex * 256; }
    __syncthreads();
}

__device__ __forceinline__ void phase_mod(const Args& A, const Ctx& C) {
    LAS float* sc = (LAS float*)C.lds;
    LAS float* red = sc + 3072;
    const float* c = A.in[1]; const float* cc = A.in[3];
    for (int i = C.tid; i < 3072; i += NT) { const float v = i < 2048 ? c[i] : cc[i - 2048]; sc[i] = siluf_(v); }
    __syncthreads();
    float* MOD = (float*)(A.ws + WS_MOD);
    for (int u = C.bid; u < DEPTH * 96; u += C.G) {
        const int l = u / 96, cg = u % 96, col = cg * 64 + C.lane;
        const float* w = A.in[4] + (size_t)l * D * 6 * D + col;
        float a0 = 0.f, a1 = 0.f, a2 = 0.f;
#pragma unroll 32
        for (int k = C.wave * 128; k < C.wave * 128 + 128; ++k) { const float wv = w[(size_t)k * 6 * D]; a0 += sc[k] * wv; a1 += sc[1024 + k] * wv; a2 += sc[2048 + k] * wv; }
        red[(C.wave * 3 + 0) * 64 + C.lane] = a0; red[(C.wave * 3 + 1) * 64 + C.lane] = a1; red[(C.wave * 3 + 2) * 64 + C.lane] = a2;
        __syncthreads();
        if (C.tid < 192) { const int v = C.tid / 64, ln = C.tid % 64; float s = 0.f;
            for (int w8 = 0; w8 < 8; ++w8) s += red[(w8 * 3 + v) * 64 + ln];
            MOD[(size_t)(l * 3 + v) * 6 * D + cg * 64 + ln] = s + A.in[5][(size_t)l * 6 * D + cg * 64 + ln]; }
        __syncthreads();
    }
}

__device__ __forceinline__ void load_row_f32(const float* p, int lane, f32x4 (&v)[4]) {
#pragma unroll
    for (int j = 0; j < 4; ++j) v[j] = *(const f32x4*)(p + 4 * lane + 256 * j);
}
__device__ __forceinline__ void load_row_bf16(const bf16* p, int lane, f32x4 (&v)[4]) {
#pragma unroll
    for (int j = 0; j < 4; ++j) { const u32x2 w = *(const u32x2*)(p + 4 * lane + 256 * j);
        v[j] = (f32x4){__uint_as_float(w.x << 16), __uint_as_float(w.x & 0xffff0000u), __uint_as_float(w.y << 16), __uint_as_float(w.y & 0xffff0000u)}; }
}
__device__ __forceinline__ void store_row_bf16(bf16* p, int lane, const f32x4 (&v)[4]) {
#pragma unroll
    for (int j = 0; j < 4; ++j) { u32x2 w; w.x = pk2(v[j].x, v[j].y); w.y = pk2(v[j].z, v[j].w); *(u32x2*)(p + 4 * lane + 256 * j) = w; }
}
constexpr int CVT_IG = (D / 64) * (DE / 32), CVT_ID = (DE / 64) * (D / 32), CVT_PER = 2 * CVT_IG + CVT_ID, CVT_ITEMS = NE * CVT_PER;
constexpr int CVT_Q = 48;
__device__ __forceinline__ void cvt_moe_items(const Args& A, const Ctx& C, int l, int it0, int end, int stride);
__device__ __forceinline__ int cvt_t2(int l, int G);
struct RowVec { f32x4 a[4], s[4], g[4]; };
__device__ __forceinline__ void load_rowvec(RowVec& R, const float* ng, const float* sh, const float* sc, const float* gt, int lane) {
    f32x4 n[4], c[4]; load_row_f32(ng, lane, n); load_row_f32(sc, lane, c); load_row_f32(sh, lane, R.s); if (gt) load_row_f32(gt, lane, R.g);
#pragma unroll
    for (int q = 0; q < 4; ++q) R.a[q] = n[q] * (1.f + c[q]);
}
__device__ __forceinline__ void load_row_bf16raw(const bf16* p, int lane, u32x2 (&v)[4]) {
#pragma unroll
    for (int j = 0; j < 4; ++j) v[j] = *(const u32x2*)(p + 4 * lane + 256 * j);
}
__device__ __forceinline__ void store_row_fp8(unsigned char* p, int lane, const f32x4 (&v)[4]) {
#pragma unroll
    for (int j = 0; j < 4; ++j) { int w = 0; w = __builtin_amdgcn_cvt_pk_fp8_f32(v[j].x, v[j].y, w, false); w = __builtin_amdgcn_cvt_pk_fp8_f32(v[j].z, v[j].w, w, true); *(unsigned*)(p + 4 * lane + 256 * j) = (unsigned)w; }
}
__device__ __forceinline__ void load_row_fp8raw(const unsigned char* p, int lane, unsigned (&v)[4]) {
#pragma unroll
    for (int j = 0; j < 4; ++j) v[j] = *(const unsigned*)(p + 4 * lane + 256 * j);
}
__device__ __forceinline__ f32x4 fp8x4(unsigned w) { const f32x2 lo = __builtin_amdgcn_cvt_pk_f32_fp8((int)w, false), hi = __builtin_amdgcn_cvt_pk_f32_fp8((int)w, true); return (f32x4){lo.x, lo.y, hi.x, hi.y}; }
__device__ __forceinline__ f32x4 bf4(u32x2 w) { return (f32x4){__uint_as_float(w.x << 16), __uint_as_float(w.x & 0xffff0000u), __uint_as_float(w.y << 16), __uint_as_float(w.y & 0xffff0000u)}; }
__device__ __forceinline__ float row_rstd(const f32x4 (&v)[4]) {
    float s = 0.f;
#pragma unroll
    for (int j = 0; j < 4; ++j) s += (v[j].x * v[j].x + v[j].y * v[j].y) + (v[j].z * v[j].z + v[j].w * v[j].w);
    return 1.0f / sqrtf(wave_sum(s) * (1.f / D) + EPS);
}

__device__ __forceinline__ void phase_r1(const Args& A, const Ctx& C, int l) {
    LAS int* sb = (LAS int*)C.lds;
    LAS float* GW = (LAS float*)(C.lds + 256);
    const bool mls = (l & 1) == 0; const int j = l >> 1;
    if (l > 0) slot_bases(A, l - 1, sb, C.tid);
    if (mls) { const float* w = A.in[8] + (size_t)j * D * PROJ + PW;
        f32x4 t[2][4];
#pragma unroll
        for (int jj = 0; jj < 2; ++jj)
#pragma unroll
            for (int q = 0; q < 4; ++q) t[jj][q] = *(const f32x4*)(w + (size_t)(C.tid + NT * jj) * PROJ + 4 * q);
#pragma unroll
        for (int jj = 0; jj < 2; ++jj)
#pragma unroll
            for (int q = 0; q < 4; ++q) { const int k = C.tid + NT * jj; GW[(4 * q + 0) * D + k] = t[jj][q].x; GW[(4 * q + 1) * D + k] = t[jj][q].y; GW[(4 * q + 2) * D + k] = t[jj][q].z; GW[(4 * q + 3) * D + k] = t[jj][q].w; }
        __syncthreads(); }
    const int nrows = (l <= 2) ? NR : NL;
    bf16* LAT = (bf16*)(A.ws + WS_LAT); bf16* H = (bf16*)(A.ws + WS_HB); float* GATE = (float*)(A.ws + WS_GATE);
    const float* MOD = (const float*)(A.ws + WS_MOD); const unsigned char* Y8 = A.ws + WS_PB;
    const int* TS = (const int*)(A.ws + WS_TOKSLOT); const float* TW = (const float*)(A.ws + WS_TOKW);
    const int rpw = (((nrows + C.G - 1) / C.G) + 1) & ~1; const int wrow0 = C.bid * rpw; const int wend = min(wrow0 + rpw, nrows);
    for (int sa = wrow0; sa < wend;) {
        const int mvi = mod_vec_of_row(sa); const int bnd = mvi == 0 ? SEQ : (mvi == 1 ? NL : NR); const int sbnd = min(wend, bnd);
        RowVec RV; { const float* mv = MOD + (size_t)(l * 3 + mvi) * 6 * D;
            load_rowvec(RV, A.in[6] + (size_t)(l * 2 + 0) * D, mv + 0 * D, mv + 1 * D, l > 0 ? MOD + (size_t)((l - 1) * 3 + mvi) * 6 * D + 5 * D : nullptr, C.lane); }
        for (int ra = sa + 2 * C.wave; ra < sbnd; ra += 2 * NW) {
            const bool hasb = ra + 1 < sbnd; const int rb = hasb ? ra + 1 : ra;
            f32x4 va[4], vb[4]; float wa0 = 0.f, wa1 = 0.f, wb0 = 0.f, wb1 = 0.f;
            if (l == 0) { load_row_f32(ra < NL ? A.in[0] + (size_t)ra * D : A.in[2] + (size_t)(ra - NL) * D, C.lane, va); load_row_f32(rb < NL ? A.in[0] + (size_t)rb * D : A.in[2] + (size_t)(rb - NL) * D, C.lane, vb); }
            else {
                const int ta0 = TS[ra * 2], ta1 = TS[ra * 2 + 1], tb0 = TS[rb * 2], tb1 = TS[rb * 2 + 1]; wa0 = TW[ra * 2]; wa1 = TW[ra * 2 + 1]; wb0 = TW[rb * 2]; wb1 = TW[rb * 2 + 1];
                load_row_bf16(LAT + (size_t)ra * D, C.lane, va); load_row_bf16(LAT + (size_t)rb * D, C.lane, vb);
                unsigned ya0[4], ya1[4], yb0[4], yb1[4];
                load_row_fp8raw(Y8 + (size_t)(sb[ta0 >> 20] + (ta0 & 0xfffff)) * D, C.lane, ya0); load_row_fp8raw(Y8 + (size_t)(sb[ta1 >> 20] + (ta1 & 0xfffff)) * D, C.lane, ya1);
                load_row_fp8raw(Y8 + (size_t)(sb[tb0 >> 20] + (tb0 & 0xfffff)) * D, C.lane, yb0); load_row_fp8raw(Y8 + (size_t)(sb[tb1 >> 20] + (tb1 & 0xfffff)) * D, C.lane, yb1);
                wa0 *= 1.0f / YSCALE; wa1 *= 1.0f / YSCALE; wb0 *= 1.0f / YSCALE; wb1 *= 1.0f / YSCALE;
#pragma unroll
                for (int q = 0; q < 4; ++q) { va[q] += RV.g[q] * (fp8x4(ya0[q]) * wa0 + fp8x4(ya1[q]) * wa1); vb[q] += RV.g[q] * (fp8x4(yb0[q]) * wb0 + fp8x4(yb1[q]) * wb1); }
            }
            store_row_bf16(LAT + (size_t)ra * D, C.lane, va); if (hasb) store_row_bf16(LAT + (size_t)rb * D, C.lane, vb);
            const float rra = row_rstd(va), rrb = row_rstd(vb);
            f32x4 ha[4], hb[4];
#pragma unroll
            for (int q = 0; q < 4; ++q) { ha[q] = (va[q] * rra) * RV.a[q] + RV.s[q]; hb[q] = (vb[q] * rrb) * RV.a[q] + RV.s[q]; }
            store_row_bf16(H + (size_t)ra * D, C.lane, ha); if (hasb) store_row_bf16(H + (size_t)rb * D, C.lane, hb);
            if (mls) {
                float ga = 0.f, gb = 0.f;
#pragma unroll 2
                for (int c = 0; c < 16; ++c) { float s0 = 0.f, s1 = 0.f;
#pragma unroll
                    for (int q = 0; q < 4; ++q) { const f32x4 w = *(const LAS f32x4*)(GW + c * D + 4 * C.lane + 256 * q);
                        s0 += (ha[q].x * w.x + ha[q].y * w.y) + (ha[q].z * w.z + ha[q].w * w.w); s1 += (hb[q].x * w.x + hb[q].y * w.y) + (hb[q].z * w.z + hb[q].w * w.w); }
                    s0 = wave_sum(s0); s1 = wave_sum(s1); ga = (C.lane == c) ? s0 : ga; gb = (C.lane == c) ? s1 : gb; }
                if (C.lane < 16) {
                    const float bgt = A.in[9][j * 16 + C.lane]; const int gtype = C.lane >> 2;
                    ga += bgt; gb += bgt;
                    GATE[(size_t)ra * 16 + C.lane] = (gtype & 1) ? logsigmoidf_(ga) : 15.0f * tanhf(ga * (1.0f / 15.0f));
                    if (hasb) GATE[(size_t)rb * 16 + C.lane] = (gtype & 1) ? logsigmoidf_(gb) : 15.0f * tanhf(gb * (1.0f / 15.0f)); }
            }
        }
        sa = sbnd;
    }
}

__device__ __forceinline__ void phase_r2(const Args& A, const Ctx& C, int l) {
    constexpr int WP = 2064;
    LAS unsigned char* RWB = C.lds;
    LAS float* WL = (LAS float*)(C.lds + 48 * WP);
    LAS unsigned* hist = (LAS unsigned*)(WL + 8 * 16 * 48);
    LAS unsigned* gbase = hist + 32;
    constexpr int RCAP = 144;
    LAS int* rec = (LAS int*)(gbase + 32);
    static_assert(48 * WP + 8 * 16 * 48 * 4 + 256 + RCAP * 16 <= LDS_TAB_END, "R2 LDS map");
    cvt_moe_items(A, C, l, cvt_t2(l, C.G) + C.bid * NW + C.wave, CVT_ITEMS, C.G * NW);
    __syncthreads();
    { const float* wg = A.in[15] + (size_t)l * D * NGRP; const float* wr = A.in[17] + (size_t)l * D * NE;
      { const int kp = C.tid; const f32x4 x0 = *(const f32x4*)(wg + (size_t)(2 * kp) * 4), x1 = *(const f32x4*)(wg + (size_t)(2 * kp + 1) * 4);
        *(LAS unsigned*)(RWB + 0 * WP + kp * 4) = cvt2(x0.x, x1.x); *(LAS unsigned*)(RWB + 1 * WP + kp * 4) = cvt2(x0.y, x1.y);
        *(LAS unsigned*)(RWB + 2 * WP + kp * 4) = cvt2(x0.z, x1.z); *(LAS unsigned*)(RWB + 3 * WP + kp * 4) = cvt2(x0.w, x1.w); }
      f32x4 t0[8], t1[8];
#pragma unroll
      for (int jj = 0; jj < 8; ++jj) { const int it = C.tid + NT * jj, kp = it >> 3, cg = it & 7; t0[jj] = *(const f32x4*)(wr + (size_t)(2 * kp) * NE + 4 * cg); t1[jj] = *(const f32x4*)(wr + (size_t)(2 * kp + 1) * NE + 4 * cg); }
#pragma unroll
      for (int jj = 0; jj < 8; ++jj) { const int it = C.tid + NT * jj, kp = it >> 3, c0 = 4 + 4 * (it & 7);
          *(LAS unsigned*)(RWB + (c0 + 0) * WP + kp * 4) = cvt2(t0[jj].x, t1[jj].x); *(LAS unsigned*)(RWB + (c0 + 1) * WP + kp * 4) = cvt2(t0[jj].y, t1[jj].y);
          *(LAS unsigned*)(RWB + (c0 + 2) * WP + kp * 4) = cvt2(t0[jj].z, t1[jj].z); *(LAS unsigned*)(RWB + (c0 + 3) * WP + kp * 4) = cvt2(t0[jj].w, t1[jj].w); }
      for (int i = C.tid; i < 12 * 512; i += NT) *(LAS unsigned*)(RWB + (36 + i / 512) * WP + (i % 512) * 4) = 0u; }
    const int nrows = (l <= 1) ? NR : NL;
    bf16* LAT = (bf16*)(A.ws + WS_LAT); bf16* H = (bf16*)(A.ws + WS_HB); unsigned char* H8 = A.ws + WS_H8;
    const float* MOD = (const float*)(A.ws + WS_MOD);
    unsigned* cnt = (unsigned*)(A.ws + WS_CTL) + CW_CNT + l * 32 * CNT_STRIDE;
    int* TS = (int*)(A.ws + WS_TOKSLOT); float* TW = (float*)(A.ws + WS_TOKW); int* ST = (int*)(A.ws + WS_SLOTTOK);
    const int rpw = (((nrows + C.G - 1) / C.G) + 1) & ~1; const int wrow0 = C.bid * rpw; const int wend0 = min(wrow0 + rpw, nrows);
    const float* bg = A.in[16] + l * NGRP; const float* br = A.in[18] + l * NE;
    for (int cb = wrow0; cb < wend0; cb += RCAP) {
        const int wend = min(cb + RCAP, wend0);
        if (C.tid < 32) hist[C.tid] = 0u;
        for (int sa = cb; sa < wend;) {
            const int mvi = mod_vec_of_row(sa); const int bnd = mvi == 0 ? SEQ : (mvi == 1 ? NL : NR); const int sbnd = min(wend, bnd);
            RowVec RV; { const float* mv = MOD + (size_t)(l * 3 + mvi) * 6 * D; load_rowvec(RV, A.in[6] + (size_t)(l * 2 + 1) * D, mv + 3 * D, mv + 4 * D, mv + 2 * D, C.lane); }
            const int rlast = sbnd - 2;
            u32x2 la[4], lb[4], ya[4], yb[4];
            { const int r0 = min(sa + 2 * C.wave, rlast); load_row_bf16raw(LAT + (size_t)r0 * D, C.lane, la); load_row_bf16raw(LAT + (size_t)(r0 + 1) * D, C.lane, lb);
              load_row_bf16raw(H + (size_t)r0 * D, C.lane, ya); load_row_bf16raw(H + (size_t)(r0 + 1) * D, C.lane, yb); }
            for (int ra = sa + 2 * C.wave; ra < sbnd; ra += 2 * NW) {
                const int rb = ra + 1;
                u32x2 lan[4], lbn[4], yan[4], ybn[4];
                { const int r1 = min(ra + 2 * NW, rlast); load_row_bf16raw(LAT + (size_t)r1 * D, C.lane, lan); load_row_bf16raw(LAT + (size_t)(r1 + 1) * D, C.lane, lbn);
                  load_row_bf16raw(H + (size_t)r1 * D, C.lane, yan); load_row_bf16raw(H + (size_t)(r1 + 1) * D, C.lane, ybn); }
                f32x4 va[4], vb[4];
#pragma unroll
                for (int q = 0; q < 4; ++q) { va[q] = bf4(la[q]) + RV.g[q] * bf4(ya[q]); vb[q] = bf4(lb[q]) + RV.g[q] * bf4(yb[q]); }
                store_row_bf16(LAT + (size_t)ra * D, C.lane, va); store_row_bf16(LAT + (size_t)rb * D, C.lane, vb);
                const float rra = row_rstd(va), rrb = row_rstd(vb);
                f32x4 ha[4], hb[4];
#pragma unroll
                for (int q = 0; q < 4; ++q) { ha[q] = (va[q] * rra) * RV.a[q] + RV.s[q]; hb[q] = (vb[q] * rrb) * RV.a[q] + RV.s[q]; }
                store_row_bf16(H + (size_t)ra * D, C.lane, ha); store_row_bf16(H + (size_t)rb * D, C.lane, hb);
                store_row_fp8(H8 + (size_t)ra * D, C.lane, ha); store_row_fp8(H8 + (size_t)rb * D, C.lane, hb);
#pragma unroll
                for (int q = 0; q < 4; ++q) { la[q] = lan[q]; lb[q] = lbn[q]; ya[q] = yan[q]; yb[q] = ybn[q]; }
            }
            sa = sbnd;
        }
        __syncthreads();
        const int fr = C.lane & 15, fq = C.lane >> 4;
        for (int t = C.wave; t * 16 < wend - cb; t += NW) {
            const int trow = min(cb + 16 * t + fr, wend - 1);
            const bf16* hp = H + (size_t)trow * D + 8 * fq;
            f32x4 acc[3];
#pragma unroll
            for (int ct = 0; ct < 3; ++ct) acc[ct] = (f32x4){0.f, 0.f, 0.f, 0.f};
#pragma unroll 1
            for (int kb = 0; kb < 4; ++kb) {
                bf16x8 av[8];
#pragma unroll
                for (int k8 = 0; k8 < 8; ++k8) av[k8] = *(const bf16x8*)(hp + 32 * (8 * kb + k8));
#pragma unroll
                for (int k8 = 0; k8 < 8; ++k8)
#pragma unroll
                    for (int ct = 0; ct < 3; ++ct) { const bf16x8 bv = *(const LAS bf16x8*)(RWB + (ct * 16 + fr) * WP + (32 * (8 * kb + k8) + 8 * fq) * 2);
                        acc[ct] = __builtin_amdgcn_mfma_f32_16x16x32_bf16(av[k8], bv, acc[ct], 0, 0, 0); }
            }
            LAS float* wl = WL + C.wave * 16 * 48;
#pragma unroll
            for (int ct = 0; ct < 3; ++ct)
#pragma unroll
                for (int jq = 0; jq < 4; ++jq) wl[(4 * fq + jq) * 48 + ct * 16 + fr] = acc[ct][jq];
            asm volatile("s_waitcnt lgkmcnt(0)" ::: "memory");
            const int row = cb + 16 * t + C.lane;
            if (C.lane < 16 && row < wend) {
                LAS const float* wm = wl + C.lane * 48;
                float lg[36];
#pragma unroll
                for (int c = 0; c < 36; ++c) lg[c] = wm[c];
                float gl[4]; int grp = 0; float gm = -3.0e38f;
#pragma unroll
                for (int c = 0; c < 4; ++c) { gl[c] = lg[c] + bg[c]; if (gl[c] > gm) { gm = gl[c]; grp = c; } }
                float gs = 0.f;
#pragma unroll
                for (int c = 0; c < 4; ++c) gs += __expf(gl[c] - gm);
                const float pgrp = 1.0f / gs;
                float rl[8];
#pragma unroll
                for (int i = 0; i < 8; ++i) { float tt = 0.f;
#pragma unroll
                    for (int g = 0; g < 4; ++g) tt = (g == grp) ? lg[4 + g * 8 + i] : tt;
                    rl[i] = tt + br[grp * 8 + i]; }
                int i0 = 0; float m0 = rl[0];
#pragma unroll
                for (int i = 1; i < 8; ++i) if (rl[i] > m0) { m0 = rl[i]; i0 = i; }
                int i1 = -1; float m1 = -3.0e38f;
#pragma unroll
                for (int i = 0; i < 8; ++i) if (i != i0 && rl[i] > m1) { m1 = rl[i]; i1 = i; }
                const float p0 = 1.0f, p1 = __expf(m1 - m0);
                const float w0 = pgrp * p0 / (p0 + p1), w1 = pgrp * p1 / (p0 + p1);
                const int e0 = grp * 8 + i0, e1 = grp * 8 + i1;
                const unsigned q0 = __hip_atomic_fetch_add(hist + e0, 1u, __ATOMIC_RELAXED, __HIP_MEMORY_SCOPE_WORKGROUP), q1 = __hip_atomic_fetch_add(hist + e1, 1u, __ATOMIC_RELAXED, __HIP_MEMORY_SCOPE_WORKGROUP);
                const int li = row - cb;
                rec[li * 4 + 0] = e0 | (e1 << 8); rec[li * 4 + 1] = (int)q0; rec[li * 4 + 2] = (int)q1;
                TW[row * 2 + 0] = w0; TW[row * 2 + 1] = w1;
            }
        }
        __syncthreads();
        if (C.tid < 32) gbase[C.tid] = hist[C.tid] ? atomicAdd(cnt + C.tid * CNT_STRIDE, hist[C.tid]) : 0u;
        __syncthreads();
        for (int i = C.tid; i < wend - cb; i += NT) { const int row = cb + i; const int ee = rec[i * 4], e0 = ee & 255, e1 = ee >> 8;
            const unsigned q0 = gbase[e0] + (unsigned)rec[i * 4 + 1], q1 = gbase[e1] + (unsigned)rec[i * 4 + 2];
            ST[(size_t)e0 * CAP + q0] = row; ST[(size_t)e1 * CAP + q1] = row;
            TS[row * 2 + 0] = (e0 << 20) | (int)q0; TS[row * 2 + 1] = (e1 << 20) | (int)q1; }
        __syncthreads();
    }
}

__device__ __forceinline__ void phase_final(const Args& A, const Ctx& C) {
    LAS int* sb = (LAS int*)C.lds;
    slot_bases(A, 3, sb, C.tid);
    const bf16* LAT = (const bf16*)(A.ws + WS_LAT); const unsigned char* Y8 = A.ws + WS_PB;
    const int* TS = (const int*)(A.ws + WS_TOKSLOT); const float* TW = (const float*)(A.ws + WS_TOKW);
    const float* MOD = (const float*)(A.ws + WS_MOD);
    f32x4 fg[4]; load_row_f32(A.in[7], C.lane, fg);
    const int rpw = (((NL + C.G - 1) / C.G) + 1) & ~1; const int wrow0 = C.bid * rpw; const int wend = min(wrow0 + rpw, NL);
    for (int sa = wrow0; sa < wend;) {
        const int mvi = mod_vec_of_row(sa); const int sbnd = min(wend, mvi == 0 ? SEQ : NL);
        f32x4 g2[4]; load_row_f32(MOD + (size_t)(3 * 3 + mvi) * 6 * D + 5 * D, C.lane, g2);
        for (int ra = sa + 2 * C.wave; ra < sbnd; ra += 2 * NW) {
            const int rb = ra + 1;
            const int ta0 = TS[ra * 2], ta1 = TS[ra * 2 + 1], tb0 = TS[rb * 2], tb1 = TS[rb * 2 + 1]; const float wa0 = TW[ra * 2], wa1 = TW[ra * 2 + 1], wb0 = TW[rb * 2], wb1 = TW[rb * 2 + 1];
            f32x4 va[4], vb[4]; unsigned ya0[4], ya1[4], yb0[4], yb1[4];
            load_row_bf16(LAT + (size_t)ra * D, C.lane, va); load_row_bf16(LAT + (size_t)rb * D, C.lane, vb);
            load_row_fp8raw(Y8 + (size_t)(sb[ta0 >> 20] + (ta0 & 0xfffff)) * D, C.lane, ya0); load_row_fp8raw(Y8 + (size_t)(sb[ta1 >> 20] + (ta1 & 0xfffff)) * D, C.lane, ya1);
            load_row_fp8raw(Y8 + (size_t)(sb[tb0 >> 20] + (tb0 & 0xfffff)) * D, C.lane, yb0); load_row_fp8raw(Y8 + (size_t)(sb[tb1 >> 20] + (tb1 & 0xfffff)) * D, C.lane, yb1);
#pragma unroll
            for (int q = 0; q < 4; ++q) { va[q] += g2[q] * (fp8x4(ya0[q]) * (wa0 * (1.0f / YSCALE)) + fp8x4(ya1[q]) * (wa1 * (1.0f / YSCALE))); vb[q] += g2[q] * (fp8x4(yb0[q]) * (wb0 * (1.0f / YSCALE)) + fp8x4(yb1[q]) * (wb1 * (1.0f / YSCALE))); }
            const float rra = row_rstd(va), rrb = row_rstd(vb);
#pragma unroll
            for (int q = 0; q < 4; ++q) { *(f32x4*)(A.out + (size_t)ra * D + 4 * C.lane + 256 * q) = (va[q] * rra) * fg[q]; *(f32x4*)(A.out + (size_t)rb * D + 4 * C.lane + 256 * q) = (vb[q] * rrb) * fg[q]; }
        }
        sa = sbnd;
    }
}

__device__ __forceinline__ void phase_conv(const Args& A, const Ctx& C, int l) {
    const int j = l >> 1; const int nrows = (l <= 1) ? NR : NL;
    const bf16* P = (const bf16*)(A.ws + WS_PB); unsigned char* HM = A.ws + WS_HM;
    const float* cw = A.in[13] + (size_t)j * 3 * D;
    for (int row = C.bid * NW + C.wave; row < nrows; row += C.G * NW) {
        bool hasl, hasr;
        if (row < NL) { const int t = row & 63; hasl = t != 0; hasr = t != 63; } else { const int t = (row - NL) & 255; hasl = t != 0; hasr = t != 255; }
        f32x4 bg[4], z[4], w0[4], w1[4], w2[4], acc[4];
        const bf16* pr = P + (size_t)row * PW;
        load_row_bf16(pr, C.lane, bg); load_row_bf16(pr + D, C.lane, z);
        load_row_f32(cw, C.lane, w0); load_row_f32(cw + D, C.lane, w1); load_row_f32(cw + 2 * D, C.lane, w2);
#pragma unroll
        for (int q = 0; q < 4; ++q) acc[q] = w1[q] * z[q];
        if (hasl) { load_row_bf16(pr - PW + D, C.lane, z);
#pragma unroll
            for (int q = 0; q < 4; ++q) acc[q] += w0[q] * z[q]; }
        if (hasr) { load_row_bf16(pr + PW + D, C.lane, z);
#pragma unroll
            for (int q = 0; q < 4; ++q) acc[q] += w2[q] * z[q]; }
#pragma unroll
        for (int q = 0; q < 4; ++q) acc[q] *= bg[q];
        store_row_fp8(HM + (size_t)row * D, C.lane, acc);
    }
}

constexpr int BM = 256, BK = 64, HALF = 128, HTB = HALF * BK * 2, STAGE_BYTES = 8 * HTB, NXCD = 8, WGM = 8;
constexpr int LDS_TAB = STAGE_BYTES;
__device__ __forceinline__ int lds_byte(int r, int c) { const int st = (r >> 4) * 2 + (c >> 5), rr = r & 15, cc = c & 31, ob = rr * 64 + cc * 2; return st * 1024 + (ob ^ (((ob >> 9) & 1) << 5)); }
__device__ __forceinline__ void stage_rc(int b, int& R, int& C) { const int st = b / 1024, sb = b % 1024, swz = sb ^ (((sb >> 9) & 1) << 5); R = (st >> 1) * 16 + swz / 64; C = (st & 1) * 32 + (swz % 64) / 2; }
__device__ __forceinline__ int perm32(int rho) { const int n = rho >> 4, i = rho & 15; return 8 * (i >> 2) + 4 * n + (i & 3); }
__device__ __forceinline__ unsigned cvt_pk_bf16(float lo, float hi) { unsigned r; asm volatile("v_cvt_pk_bf16_f32 %0, %1, %2" : "=v"(r) : "v"(lo), "v"(hi)); return r; }

struct GUnit { const char* a; const char* b; int orow, ocol, aux; };

typedef int i32x8 __attribute__((ext_vector_type(8)));
typedef int i32x4 __attribute__((ext_vector_type(4)));
template <class Epi, class Sched, bool GATHER, bool FP8 = false>
__device__ __forceinline__ void gemm_phase(LAS unsigned char* lds, const int K, const Sched& S, const Epi& E) {
    const int tid = threadIdx.x, wid = __builtin_amdgcn_readfirstlane(tid >> 6), lane = tid & 63, wr = wid >> 2, wc = wid & 3, fr = lane & 15, fq = lane >> 4;
    const int RB = FP8 ? K : 2 * K;
    const int nt = RB / (BK * 2);
    unsigned voffB[2], voA[2][2]; int Rr[2], Cc[2];
#pragma unroll
    for (int i = 0; i < 2; ++i) { int R, C; stage_rc(tid * 16 + i * 8192, R, C); const int Rb = (R & ~31) + perm32(R & 31); Rr[i] = R; Cc[i] = C;
        voffB[i] = (unsigned)(Rb * RB + C * 2);
        voA[0][i] = (unsigned)(R * RB + C * 2); voA[1][i] = (unsigned)((R + HALF) * RB + C * 2); }
    const size_t kstep = (size_t)(BK * 2);
    const size_t hstep = (size_t)HALF * RB;
    const unsigned ldsw = (unsigned)wid * 1024u;
    const unsigned ldsbase = (unsigned)(size_t)lds;
    const int aoff = lds_byte(wr * 64 + fr, fq * 8), boff = lds_byte(wc * 32 + fr, fq * 8);
#define PG8_SA(b, h) (((b) * 2 + (h)) * HTB)
#define PG8_SB(b, h) ((4 + (b) * 2 + (h)) * HTB)
#define PG8_STAGE(bufoff, gbase, voff) do { _Pragma("unroll") for (int _i = 0; _i < 2; ++_i) \
        asm volatile("s_mov_b32 m0, %2\n\ts_nop 0\n\tglobal_load_lds_dwordx4 %0, %1" :: "v"((voff)[_i]), "s"((const char*)(gbase)), "s"(ldsbase + (unsigned)(bufoff) + ldsw + (unsigned)(_i * 8192)) : "memory"); } while (0)
#define PG8_STAGE_A1(bufoff, gbase) do { if constexpr (GATHER) PG8_STAGE(bufoff, gbase, voA[1]); else PG8_STAGE(bufoff, (const char*)(gbase) + hstep, voA[0]); } while (0)
#define PG8_LDA(dst, b, h) do { if constexpr (FP8) { _Pragma("unroll") for (int m = 0; m < 4; ++m) { \
        const i32x4 _lo = *(const LAS i32x4*)(lds + PG8_SA(b, h) + aoff + m * 2048), _hi = *(const LAS i32x4*)(lds + PG8_SA(b, h) + aoff + m * 2048 + 1024); \
        dst##8[m] = __builtin_shufflevector(_lo, _hi, 0, 1, 2, 3, 4, 5, 6, 7); } } \
      else { _Pragma("unroll") for (int m = 0; m < 4; ++m) _Pragma("unroll") for (int k = 0; k < 2; ++k) dst[m][k] = *(const LAS bf16x8*)(lds + PG8_SA(b, h) + aoff + m * 2048 + k * 1024); } } while (0)
#define PG8_LDB(dst, b, h) do { if constexpr (FP8) { _Pragma("unroll") for (int n = 0; n < 2; ++n) { \
        const i32x4 _lo = *(const LAS i32x4*)(lds + PG8_SB(b, h) + boff + n * 2048), _hi = *(const LAS i32x4*)(lds + PG8_SB(b, h) + boff + n * 2048 + 1024); \
        dst##8[n] = __builtin_shufflevector(_lo, _hi, 0, 1, 2, 3, 4, 5, 6, 7); } } \
      else { _Pragma("unroll") for (int n = 0; n < 2; ++n) _Pragma("unroll") for (int k = 0; k < 2; ++k) dst[n][k] = *(const LAS bf16x8*)(lds + PG8_SB(b, h) + boff + n * 2048 + k * 1024); } } while (0)
#define PG8_MMA(ai, bj, At, Bt) do { __builtin_amdgcn_s_setprio(1); \
        if constexpr (FP8) { _Pragma("unroll") for (int m = 0; m < 4; ++m) _Pragma("unroll") for (int n = 0; n < 2; ++n) \
            acc[ai][bj][m][n] = __builtin_amdgcn_mfma_scale_f32_16x16x128_f8f6f4(Bt##8[n], At##8[m], acc[ai][bj][m][n], 0, 0, 0, 0x7f7f7f7f, 0, 0x7f7f7f7f); } \
        else { _Pragma("unroll") for (int m = 0; m < 4; ++m) _Pragma("unroll") for (int n = 0; n < 2; ++n) _Pragma("unroll") for (int k = 0; k < 2; ++k) \
            acc[ai][bj][m][n] = __builtin_amdgcn_mfma_f32_16x16x32_bf16(Bt[n][k], At[m][k], acc[ai][bj][m][n], 0, 0, 0); } \
        __builtin_amdgcn_s_setprio(0); } while (0)
#define PG8_WAIT_V(n) asm volatile("s_waitcnt vmcnt(" #n ")" ::: "memory")
#define PG8_WAIT_L(n) asm volatile("s_waitcnt lgkmcnt(" #n ")" ::: "memory")
#define PG8_BAR __builtin_amdgcn_s_barrier()
#define PG8_SCHED __builtin_amdgcn_sched_barrier(0)
    GUnit cur, nxt; int ui = 0;
    if (!S.next(0, cur)) return;
    if constexpr (GATHER) {
#pragma unroll
        for (int h = 0; h < 2; ++h)
#pragma unroll
            for (int i = 0; i < 2; ++i) voA[h][i] = S.arow_off(0, h * HALF + Rr[i]) + (unsigned)Cc[i] * 2u;
    }
    f32x4 acc[2][2][4][2];
#pragma unroll
    for (int a = 0; a < 2; ++a)
#pragma unroll
        for (int b = 0; b < 2; ++b)
#pragma unroll
            for (int m = 0; m < 4; ++m)
#pragma unroll
                for (int n = 0; n < 2; ++n) acc[a][b][m][n] = (f32x4){0.f, 0.f, 0.f, 0.f};
    bf16x8 At[4][2], B0[2][2], B1[2][2]; i32x8 At8[4], B08[2], B18[2];
    const char* cA = cur.a; const char* cB = cur.b;
    PG8_STAGE(PG8_SB(0, 0), cB, voffB); PG8_STAGE(PG8_SB(0, 1), cB + hstep, voffB); PG8_STAGE(PG8_SA(0, 0), cA, voA[0]); PG8_STAGE_A1(PG8_SA(0, 1), cA);
    if (wr == 1) PG8_BAR;
    PG8_WAIT_V(2); PG8_BAR;
    PG8_STAGE(PG8_SB(1, 0), cB + kstep, voffB); PG8_STAGE(PG8_SA(1, 0), cA + kstep, voA[0]); PG8_STAGE(PG8_SB(1, 1), cB + hstep + kstep, voffB);
    PG8_WAIT_V(6); PG8_BAR;
    for (;;) {
        const bool has_next = S.next(ui + 1, nxt);
        const char* nA = has_next ? nxt.a : cA; const char* nB = has_next ? nxt.b : cB;
#pragma unroll 1
        for (int t = 0; t < nt; t += 2) {
            const bool last = (t == nt - 2);
            const char* a1 = cA + (size_t)(t + 1) * kstep;
            const char* a2 = last ? nA : cA + (size_t)(t + 2) * kstep; const char* b2 = last ? nB : cB + (size_t)(t + 2) * kstep;
            const char* a3 = a2 + kstep; const char* b3 = b2 + kstep;
            PG8_LDB(B0, 0, 0); PG8_LDB(B1, 0, 1); PG8_SCHED; PG8_LDA(At, 0, 0); PG8_STAGE_A1(PG8_SA(1, 1), a1);
            if constexpr (GATHER) { if (last && has_next) {
#pragma unroll
                for (int h = 0; h < 2; ++h)
#pragma unroll
                    for (int i = 0; i < 2; ++i) { int R2, C2; stage_rc(tid * 16 + i * 8192, R2, C2); voA[h][i] = S.arow_off(ui + 1, h * HALF + R2) + (unsigned)C2 * 2u; } } }
            PG8_WAIT_V(8); PG8_WAIT_L(0); PG8_BAR; PG8_MMA(0, 0, At, B0); PG8_MMA(0, 1, At, B1); PG8_BAR; PG8_SCHED;
            PG8_LDA(At, 0, 1); PG8_STAGE(PG8_SB(0, 0), b2, voffB); PG8_STAGE(PG8_SB(0, 1), b2 + hstep, voffB); PG8_STAGE(PG8_SA(0, 0), a2, voA[0]);
            PG8_WAIT_V(8); PG8_WAIT_L(0); PG8_BAR; PG8_MMA(1, 0, At, B0); PG8_MMA(1, 1, At, B1); PG8_BAR; PG8_SCHED;
            PG8_LDB(B0, 1, 0); PG8_LDB(B1, 1, 1); PG8_SCHED; PG8_LDA(At, 1, 0); PG8_STAGE_A1(PG8_SA(0, 1), a2);
            PG8_WAIT_V(8); PG8_WAIT_L(0); PG8_BAR; PG8_MMA(0, 0, At, B0); PG8_MMA(0, 1, At, B1); PG8_BAR; PG8_SCHED;
            PG8_LDA(At, 1, 1); PG8_STAGE(PG8_SB(1, 0), b3, voffB); PG8_STAGE(PG8_SB(1, 1), b3 + hstep, voffB); PG8_STAGE(PG8_SA(1, 0), a3, voA[0]);
            PG8_WAIT_V(8); PG8_WAIT_L(0); PG8_BAR; PG8_MMA(1, 0, At, B0); PG8_MMA(1, 1, At, B1); PG8_BAR; PG8_SCHED;
        }
        if (wr == 0) PG8_BAR;
        { int tz = threadIdx.x; asm volatile("" : "+v"(tz));
          const int wz = tz >> 6, lz = tz & 63; E(acc, cur, wz >> 2, wz & 3, lz & 15, lz >> 4); }
        if (!has_next) break;
#pragma unroll
        for (int a = 0; a < 2; ++a)
#pragma unroll
            for (int b = 0; b < 2; ++b)
#pragma unroll
                for (int m = 0; m < 4; ++m)
#pragma unroll
                    for (int n = 0; n < 2; ++n) acc[a][b][m][n] = (f32x4){0.f, 0.f, 0.f, 0.f};
        cur = nxt; cA = nA; cB = nB; ++ui;
        if (wr == 1) PG8_BAR;
    }
    PG8_WAIT_V(0);
    PG8_BAR;
#undef PG8_SA
#undef PG8_SB
#undef PG8_STAGE
#undef PG8_STAGE_A1
#undef PG8_LDA
#undef PG8_LDB
#undef PG8_MMA
#undef PG8_WAIT_V
#undef PG8_WAIT_L
#undef PG8_BAR
#undef PG8_SCHED
}

__device__ __forceinline__ int xcd_remap(int L, int nwg) { const int q = nwg / NXCD, r = nwg % NXCD, xcd = L % NXCD, off = L / NXCD; return (xcd < r ? xcd * (q + 1) : r * (q + 1) + (xcd - r) * q) + off; }

struct DenseSched {
    const char* A; const char* Bt; int nM, nN, nwg, G, c; size_t tstep; int sw_lo, sw_hi;
    __device__ __forceinline__ void init(const void* A_, const void* Bt_, int M, int N, int K, int G_, int c_, int ebytes = 2) { A = (const char*)A_; Bt = (const char*)Bt_; nM = M / BM; nN = N / BM; nwg = nM * nN; G = G_; c = c_; tstep = (size_t)BM * K * ebytes; sw_lo = 0; sw_hi = 0; }
    __device__ __forceinline__ bool next(int i, GUnit& u) const {
        const long L = (long)i * G + c; if (L >= nwg) return false;
        const int wgid = xcd_remap((int)L, nwg);
        const int nig = WGM * nN, gid = wgid / nig, fm = gid * WGM, gsz = (nM - fm) < WGM ? (nM - fm) : WGM;
        const int pm = fm + ((wgid % nig) % gsz), pn = (wgid % nig) / gsz;
        if (pn >= sw_lo && pn < sw_hi) { u.a = Bt + (size_t)pn * tstep; u.b = A + (size_t)pm * tstep; u.orow = pm; u.ocol = pn - sw_lo; u.aux = 1; }
        else { u.a = A + (size_t)pm * tstep; u.b = Bt + (size_t)pn * tstep; u.orow = pm * BM; u.ocol = pn * BM; u.aux = 0; }
        return true;
    }
    __device__ __forceinline__ unsigned arow_off(int, int) const { return 0u; }
};

constexpr int MAXU = 12;
struct MoeTab { int n; int e[MAXU], mb[MAXU], nt[MAXU]; int sb[NE + 1]; };
struct MoeSched {
    LAS const MoeTab* T; LAS const unsigned* ridx;
    const char* A; const char* W; size_t wstride_e, tstepB; int K; int arow_bytes;
    __device__ __forceinline__ bool next(int i, GUnit& u) const {
        const int n = __builtin_amdgcn_readfirstlane(T->n); if (i >= n) return false;
        const int e = __builtin_amdgcn_readfirstlane(T->e[i]), mb = __builtin_amdgcn_readfirstlane(T->mb[i]), nt = __builtin_amdgcn_readfirstlane(T->nt[i]);
        const int base = __builtin_amdgcn_readfirstlane(T->sb[e]);
        u.orow = base + mb * BM; u.ocol = nt; u.aux = e;
        u.a = A + (size_t)u.orow * arow_bytes;
        u.b = W + (size_t)e * wstride_e + (size_t)nt * tstepB; return true;
    }
    __device__ __forceinline__ unsigned arow_off(int i, int r) const { return ridx[i * 256 + r]; }
};
template <bool GATHER>
__device__ __forceinline__ void moe_tables(const Args& A, const Ctx& C, int l, int ntile_n, LAS MoeTab* T, LAS unsigned* ridx, int arow_bytes) {
    const unsigned* cnt = (const unsigned*)(A.ws + WS_CTL) + CW_CNT + l * 32 * CNT_STRIDE;
    LAS int* ust = (LAS int*)(T + 1);
    if (C.tid < 64) { int nb; const int ex = expert_block_prefix(cnt, C.tid, nb); if (C.tid <= NE) { T->sb[C.tid] = ex * 256; ust[C.tid] = ex * ntile_n; } }
    __syncthreads();
    if (C.tid < MAXU) { const int nwg = ust[NE]; const long L = (long)C.tid * C.G + C.bid;
        if (L < nwg) { const int w = xcd_remap((int)L, nwg); int e = 0; while (w >= ust[e + 1]) ++e;
            const int lu = w - ust[e]; T->e[C.tid] = e; T->mb[C.tid] = lu / ntile_n; T->nt[C.tid] = lu % ntile_n; } }
    if (C.tid == 0) { const int nwg = ust[NE]; int n = 0; while (n < MAXU && (long)n * C.G + C.bid < nwg) ++n; T->n = n; }
    __syncthreads();
    if constexpr (GATHER) {
        const int* ST = (const int*)(A.ws + WS_SLOTTOK); const int n = T->n;
        for (int i = C.tid; i < n * 256; i += NT) { const int ui = i >> 8, r = i & 255, e = T->e[ui], m0 = T->mb[ui] * 256, ce = (int)cnt[e * CNT_STRIDE];
            const int rr = (m0 + r < ce) ? m0 + r : ce - 1;
            ridx[i] = (unsigned)ST[(size_t)e * CAP + rr] * (unsigned)arow_bytes; }
        __syncthreads();
    }
}

struct EpiStore { bf16* O; int ldc; float scale_lo; int sig_from; bf16* VT; float sall = 1.0f;
    __device__ __forceinline__ void operator()(const f32x4 (&acc)[2][2][4][2], const GUnit& u, int wr, int wc, int fr, int fq) const {
        const bool tr = u.aux != 0;
        const float sc = ((!tr && u.ocol < NQ) ? scale_lo : 1.0f) * sall; const bool sg = !tr && u.ocol >= sig_from;
        bf16* Ob = tr ? VT + (size_t)(u.orow * NH + u.ocol) * 65536 : O + (size_t)u.orow * ldc + u.ocol; const int ld = tr ? 256 : ldc;
#pragma unroll
        for (int ai = 0; ai < 2; ++ai)
#pragma unroll
            for (int m = 0; m < 4; ++m) { bf16* rowp = Ob + (size_t)(ai * HALF + wr * 64 + m * 16 + fr) * ld + wc * 32 + 8 * fq;
#pragma unroll
                for (int bj = 0; bj < 2; ++bj) { f32x4 v0 = acc[ai][bj][m][0] * sc, v1 = acc[ai][bj][m][1] * sc;
                    if (sg) {
#pragma unroll
                        for (int q = 0; q < 4; ++q) { v0[q] = __builtin_amdgcn_rcpf(1.0f + __expf(-v0[q])); v1[q] = __builtin_amdgcn_rcpf(1.0f + __expf(-v1[q])); } }
                    u32x4 w; w.x = cvt_pk_bf16(v0[0], v0[1]); w.y = cvt_pk_bf16(v0[2], v0[3]); w.z = cvt_pk_bf16(v1[0], v1[1]); w.w = cvt_pk_bf16(v1[2], v1[3]);
                    *(u32x4*)(rowp + bj * HALF) = w; } }
    }
};
__device__ __forceinline__ u32x2 cvt8_fp8(f32x4 a, f32x4 b) { int lo = 0, hi = 0;
    lo = __builtin_amdgcn_cvt_pk_fp8_f32(a[0], a[1], lo, false); lo = __builtin_amdgcn_cvt_pk_fp8_f32(a[2], a[3], lo, true);
    hi = __builtin_amdgcn_cvt_pk_fp8_f32(b[0], b[1], hi, false); hi = __builtin_amdgcn_cvt_pk_fp8_f32(b[2], b[3], hi, true); return (u32x2){(unsigned)lo, (unsigned)hi}; }
struct EpiSwigluF8 { unsigned char* O; int ldc; float s;
    __device__ __forceinline__ void operator()(const f32x4 (&acc)[2][2][4][2], const GUnit& u, int wr, int wc, int fr, int fq) const {
        const int ocol = u.ocol * HALF;
#pragma unroll
        for (int ai = 0; ai < 2; ++ai)
#pragma unroll
            for (int m = 0; m < 4; ++m) { unsigned char* rowp = O + (size_t)(u.orow + ai * HALF + wr * 64 + m * 16 + fr) * ldc + ocol + wc * 32 + 8 * fq;
                f32x4 v0, v1;
#pragma unroll
                for (int q = 0; q < 4; ++q) { const float x0 = acc[ai][0][m][0][q] * s, x1 = acc[ai][0][m][1][q] * s;
                    v0[q] = x0 * __builtin_amdgcn_rcpf(1.0f + __expf(-x0)) * (acc[ai][1][m][0][q] * s); v1[q] = x1 * __builtin_amdgcn_rcpf(1.0f + __expf(-x1)) * (acc[ai][1][m][1][q] * s); }
                *(u32x2*)rowp = cvt8_fp8(v0, v1); }
    }
};
template <int MODE> struct EpiPair { bf16* O; int ldc; int plain_below;
    __device__ __forceinline__ void operator()(const f32x4 (&acc)[2][2][4][2], const GUnit& u, int wr, int wc, int fr, int fq) const {
        if (MODE == 0 && u.ocol < plain_below) {
#pragma unroll
            for (int ai = 0; ai < 2; ++ai)
#pragma unroll
                for (int m = 0; m < 4; ++m) { bf16* rowp = O + (size_t)(u.orow + ai * HALF + wr * 64 + m * 16 + fr) * ldc + u.ocol + wc * 32 + 8 * fq;
#pragma unroll
                    for (int bj = 0; bj < 2; ++bj) { const f32x4 v0 = acc[ai][bj][m][0], v1 = acc[ai][bj][m][1];
                        u32x4 w; w.x = cvt_pk_bf16(v0[0], v0[1]); w.y = cvt_pk_bf16(v0[2], v0[3]); w.z = cvt_pk_bf16(v1[0], v1[1]); w.w = cvt_pk_bf16(v1[2], v1[3]);
                        *(u32x4*)(rowp + bj * HALF) = w; } }
            return;
        }
        const int ocol = (MODE == 0) ? plain_below + (u.ocol - plain_below) / 2 : u.ocol * HALF;
#pragma unroll
        for (int ai = 0; ai < 2; ++ai)
#pragma unroll
            for (int m = 0; m < 4; ++m) { bf16* rowp = O + (size_t)(u.orow + ai * HALF + wr * 64 + m * 16 + fr) * ldc + ocol + wc * 32 + 8 * fq;
                f32x4 v0, v1;
#pragma unroll
                for (int q = 0; q < 4; ++q) {
                    const float x0 = acc[ai][0][m][0][q], x1 = acc[ai][0][m][1][q];
                    const float g0 = (MODE == 1) ? x0 * __builtin_amdgcn_rcpf(1.0f + __expf(-x0)) : x0, g1 = (MODE == 1) ? x1 * __builtin_amdgcn_rcpf(1.0f + __expf(-x1)) : x1;
                    v0[q] = g0 * acc[ai][1][m][0][q]; v1[q] = g1 * acc[ai][1][m][1][q]; }
                u32x4 w; w.x = cvt_pk_bf16(v0[0], v0[1]); w.y = cvt_pk_bf16(v0[2], v0[3]); w.z = cvt_pk_bf16(v1[0], v1[1]); w.w = cvt_pk_bf16(v1[2], v1[3]);
                *(u32x4*)rowp = w; }
    }
};
struct EpiStoreTile { unsigned char* O; int ldc; float s;
    __device__ __forceinline__ void operator()(const f32x4 (&acc)[2][2][4][2], const GUnit& u, int wr, int wc, int fr, int fq) const {
#pragma unroll
        for (int ai = 0; ai < 2; ++ai)
#pragma unroll
            for (int m = 0; m < 4; ++m) { unsigned char* rowp = O + (size_t)(u.orow + ai * HALF + wr * 64 + m * 16 + fr) * ldc + u.ocol * BM + wc * 32 + 8 * fq;
#pragma unroll
                for (int bj = 0; bj < 2; ++bj) *(u32x2*)(rowp + bj * HALF) = cvt8_fp8(acc[ai][bj][m][0] * s, acc[ai][bj][m][1] * s); }
    }
};

__device__ __forceinline__ void transpose_item(const float* W, int ldw, int K, bf16* WT, int drow0, int k0, int n0, LAS float* scr, int lane) {
#pragma unroll
    for (int i = 0; i < 32; ++i) { const int kk = 2 * i + (lane >> 5); scr[kk * 33 + (lane & 31)] = W[(size_t)(k0 + kk) * ldw + n0 + (lane & 31)]; }
    asm volatile("s_waitcnt lgkmcnt(0)" ::: "memory");
    const int c = lane & 7;
#pragma unroll
    for (int j = 0; j < 4; ++j) { const int n = (lane >> 3) + 8 * j; const LAS float* s = scr + (8 * c) * 33 + n;
        u32x4 o; o.x = pk2(s[0 * 33], s[1 * 33]); o.y = pk2(s[2 * 33], s[3 * 33]); o.z = pk2(s[4 * 33], s[5 * 33]); o.w = pk2(s[6 * 33], s[7 * 33]);
        *(u32x4*)(WT + (size_t)(drow0 + n) * K + k0 + 8 * c) = o; }
    asm volatile("s_waitcnt lgkmcnt(0)" ::: "memory");
}
__device__ __forceinline__ void transpose_item_fp8(const float* W, int ldw, int K, unsigned char* WT8, int drow0, int k0, int n0, LAS float* scr, int lane, float sc) {
#pragma unroll
    for (int i = 0; i < 32; ++i) { const int kk = 2 * i + (lane >> 5); scr[kk * 33 + (lane & 31)] = W[(size_t)(k0 + kk) * ldw + n0 + (lane & 31)]; }
    asm volatile("s_waitcnt lgkmcnt(0)" ::: "memory");
    const int n = lane >> 1, half = lane & 1; const LAS float* sp = scr + (32 * half) * 33 + n;
    unsigned char* dst = WT8 + (size_t)(drow0 + n) * K + k0 + 32 * half;
#pragma unroll
    for (int c = 0; c < 2; ++c) { u32x4 o;
#pragma unroll
        for (int q = 0; q < 4; ++q) { int p = 0; const LAS float* s4 = sp + (16 * c + 4 * q) * 33;
            p = __builtin_amdgcn_cvt_pk_fp8_f32(s4[0] * sc, s4[33] * sc, p, false); p = __builtin_amdgcn_cvt_pk_fp8_f32(s4[66] * sc, s4[99] * sc, p, true); o[q] = (unsigned)p; }
        *(u32x4*)(dst + 16 * c) = o; }
    asm volatile("s_waitcnt lgkmcnt(0)" ::: "memory");
}
__device__ __forceinline__ int pair_row(int n, int which) { return (n >> 7) * 256 + (n & 127) + which * 128; }
__device__ __forceinline__ void phase_cvt_mixer(const Args& A, const Ctx& C) {
    LAS float* scr = (LAS float*)(C.lds + 16384 + C.wave * 16384);
    const int gw = C.bid * NW + C.wave, NGW = C.G * NW;
    constexpr int I_IN = (D / 64) * (PW / 32), I_OUT = (D / 64) * (D / 32), PER = 2 * (I_IN + I_OUT);
    for (int it = gw; it < 2 * PER; it += NGW) {
        const int kind = it / PER; int r = it % PER; const int j = r / (I_IN + I_OUT); r %= (I_IN + I_OUT);
        if (r < I_IN) { const int kb = r / (PW / 32), nb = r % (PW / 32), n0 = nb * 32;
            bf16* WT = (bf16*)(A.ws + (kind == 0 ? WS_WAIN : WS_WBIN)) + (size_t)j * PW * D;
            if (kind == 0) transpose_item(A.in[8] + (size_t)j * D * PROJ, PROJ, D, WT, n0, kb * 64, n0, scr, C.lane);
            else { const int drow = n0 < D ? n0 : (n0 < 2 * D ? D + pair_row(n0 - D, 0) : D + pair_row(n0 - 2 * D, 1));
                transpose_item(A.in[12] + (size_t)j * D * PW, PW, D, WT, drow, kb * 64, n0, scr, C.lane); } }
        else { r -= I_IN; const int kb = r / (D / 32), nb = r % (D / 32), n0 = nb * 32;
            unsigned char* WT = A.ws + (kind == 0 ? WS_WAOUT : WS_WBOUT) + (size_t)j * D * D;
            transpose_item_fp8((kind == 0 ? A.in[11] : A.in[14]) + (size_t)j * D * D, D, D, WT, n0, kb * 64, n0, scr, C.lane, WSCALE); }
    }
}
__device__ __forceinline__ void cvt_moe_items(const Args& A, const Ctx& C, int l, int it0, int end, int stride) {
    LAS float* scr = (LAS float*)(C.lds + 16384 + C.wave * 16384);
    unsigned char* WGU = A.ws + WS_WGU; unsigned char* WDN = A.ws + WS_WDN;
    for (int it = it0; it < end; it += stride) {
        const int e = it / CVT_PER; int r = it % CVT_PER;
        if (r < 2 * CVT_IG) { const int which = r / CVT_IG; r %= CVT_IG; const int kb = r / (DE / 32), nb = r % (DE / 32), n0 = nb * 32;
            transpose_item_fp8((which == 0 ? A.in[19] : A.in[20]) + ((size_t)l * NE + e) * D * DE, DE, D, WGU + (size_t)e * 2 * DE * D, pair_row(n0, which), kb * 64, n0, scr, C.lane, WSCALE); }
        else { r -= 2 * CVT_IG; const int kb = r / (D / 32), nb = r % (D / 32), n0 = nb * 32;
            transpose_item_fp8(A.in[21] + ((size_t)l * NE + e) * DE * D, D, DE, WDN + (size_t)e * D * DE, n0, kb * 64, n0, scr, C.lane, WSCALE); }
    }
}
__device__ __forceinline__ int cvt_idle(int nunits, int G) { const int rem = nunits % G; return rem ? G - rem : 0; }
__device__ __forceinline__ int cvt_t1(int l, int G) { const int n = cvt_idle((((l <= 2) ? NR : NL) / BM) * (PW / BM), G) * CVT_Q; return n < CVT_ITEMS ? n : CVT_ITEMS; }
__device__ __forceinline__ int cvt_t2(int l, int G) { const int n = cvt_t1(l, G) + cvt_idle((((l <= 1) ? NR : NL) / BM) * (D / BM), G) * CVT_Q; return n < CVT_ITEMS ? n : CVT_ITEMS; }
__device__ __forceinline__ void cvt_moe_tail(const Args& A, const Ctx& C, int l, int nunits, int base, int end) {
    const int rem = nunits % C.G;
    if (rem == 0 || C.bid < rem) return;
    const int first = base + (C.bid - rem) * CVT_Q; const int last = min(first + CVT_Q, end);
    cvt_moe_items(A, C, l, first + C.wave, last, NW);
}

__device__ __forceinline__ void phase_g1(const Args& A, const Ctx& C, int l) {
    const bool mls = (l & 1) == 0; const int j = l >> 1; const int nrows = (l <= 2) ? NR : NL;
    DenseSched S; S.init(A.ws + WS_HB, A.ws + (mls ? WS_WAIN : WS_WBIN) + (size_t)j * PW * D * 2, nrows, PW, D, C.G, C.bid);
    if (mls) { S.sw_lo = 4; S.sw_hi = 8; EpiStore E{(bf16*)(A.ws + WS_PB), PW, 0.08838834764831845f, 2 * NQ + NV, (bf16*)(A.ws + WS_VT)}; gemm_phase<EpiStore, DenseSched, false>(C.lds, D, S, E); }
    else { EpiPair<0> E{(bf16*)(A.ws + WS_PB), PW, D}; gemm_phase<EpiPair<0>, DenseSched, false>(C.lds, D, S, E); }
    cvt_moe_tail(A, C, l, S.nwg, 0, cvt_t1(l, C.G));
}
__device__ __forceinline__ void phase_g2(const Args& A, const Ctx& C, int l) {
    const bool mls = (l & 1) == 0; const int j = l >> 1; const int nrows = (l <= 1) ? NR : NL;
    DenseSched S; S.init(A.ws + WS_HM, A.ws + (mls ? WS_WAOUT : WS_WBOUT) + (size_t)j * D * D, nrows, D, D, C.G, C.bid, 1);
    EpiStore E{(bf16*)(A.ws + WS_HB), D, 1.0f, 1 << 30, nullptr, 1.0f / WSCALE}; gemm_phase<EpiStore, DenseSched, false, true>(C.lds, D, S, E);
    cvt_moe_tail(A, C, l, S.nwg, cvt_t1(l, C.G), cvt_t2(l, C.G));
}
__device__ __forceinline__ void phase_m1(const Args& A, const Ctx& C, int l) {
    LAS MoeTab* T = (LAS MoeTab*)(C.lds + LDS_TAB); LAS unsigned* ridx = (LAS unsigned*)(C.lds + LDS_TAB + 1024);
    moe_tables<true>(A, C, l, 4, T, ridx, D);
    MoeSched S; S.T = T; S.ridx = ridx; S.A = (const char*)(A.ws + WS_H8); S.W = (const char*)(A.ws + WS_WGU); S.wstride_e = (size_t)2 * DE * D; S.tstepB = (size_t)BM * D; S.K = D; S.arow_bytes = 0;
    EpiSwigluF8 E{A.ws + WS_DC, DE, 1.0f / WSCALE}; gemm_phase<EpiSwigluF8, MoeSched, true, true>(C.lds, D, S, E);
}
__device__ __forceinline__ void phase_m2(const Args& A, const Ctx& C, int l) {
    LAS MoeTab* T = (LAS MoeTab*)(C.lds + LDS_TAB); LAS unsigned* ridx = (LAS unsigned*)(C.lds + LDS_TAB + 1024);
    moe_tables<false>(A, C, l, 4, T, ridx, DE);
    MoeSched S; S.T = T; S.ridx = ridx; S.A = (const char*)(A.ws + WS_DC); S.W = (const char*)(A.ws + WS_WDN); S.wstride_e = (size_t)D * DE; S.tstepB = (size_t)BM * DE; S.K = DE; S.arow_bytes = DE;
    EpiStoreTile E{A.ws + WS_PB, D, YSCALE / WSCALE}; gemm_phase<EpiStoreTile, MoeSched, false, true>(C.lds, DE, S, E);
}

typedef float f32x16 __attribute__((ext_vector_type(16)));
#define MFMA32(a, b, c) __builtin_amdgcn_mfma_f32_32x32x16_bf16((a), (b), (c), 0, 0, 0)
__device__ __forceinline__ bf16x8 pack8(float a0, float a1, float a2, float a3, float a4, float a5, float a6, float a7) {
    u32x4 p; p.x = cvt2(a0, a1); p.y = cvt2(a2, a3); p.z = cvt2(a4, a5); p.w = cvt2(a6, a7); return __builtin_bit_cast(bf16x8, p); }
__device__ __forceinline__ float bflo(unsigned w) { return __uint_as_float(w << 16); }
__device__ __forceinline__ float bfhi(unsigned w) { return __uint_as_float(w & 0xffff0000u); }
__device__ __forceinline__ int vt_tile(int b, int h, int blk) { return (blk == 0 ? 128 + b : b * 64 + blk - 1) * NH + h; }

__device__ __forceinline__ float wave_incl_scan(float v, int lane) {
#pragma unroll
    for (int o = 1; o < 64; o <<= 1) { const float t = __shfl_up(v, o); v += (lane >= o) ? t : 0.f; }
    return v;
}
__device__ __forceinline__ void block_gates(const Args& A, int row0, int h, LAS float* bf, LAS float* bb, LAS float* lif, LAS float* lib, int tid) {
    const float* GATE = (const float*)(A.ws + WS_GATE);
    if (tid < 256) { const float* g = GATE + (size_t)(row0 + tid) * 16; lif[tid] = g[0 + h]; bf[tid] = g[4 + h]; lib[tid] = g[8 + h]; bb[tid] = g[12 + h]; }
    __syncthreads();
    const int lane = tid & 63, wv = tid >> 6;
    if (wv == 0) { f32x4 x = *(LAS f32x4*)(bf + 4 * lane); x.y += x.x; x.z += x.y; x.w += x.z; const float tot = wave_incl_scan(x.w, lane); const float ex = tot - x.w;
        x.x += ex; x.y += ex; x.z += ex; x.w += ex; *(LAS f32x4*)(bf + 4 * lane) = x; }
    if (wv == 1) { f32x4 y = *(LAS f32x4*)(bb + 4 * (63 - lane)); y.z += y.w; y.y += y.z; y.x += y.y; const float tot = wave_incl_scan(y.x, lane); const float ex = tot - y.x;
        y.x += ex; y.y += ex; y.z += ex; y.w += ex; *(LAS f32x4*)(bb + 4 * (63 - lane)) = y; }
    __syncthreads();
}
__device__ __forceinline__ void phase_s1(const Args& A, const Ctx& C, int l) {
    LAS float* bf = (LAS float*)C.lds; LAS float* bb = bf + 256; LAS float* lif = bb + 256; LAS float* lib = lif + 256; LAS float* af = lib + 256; LAS float* ab = af + 256;
    constexpr int KP = 528;
    LAS unsigned char* KTf = C.lds + 8192; LAS unsigned char* KTb = KTf + 128 * KP;
    const bf16* P = (const bf16*)(A.ws + WS_PB); const bf16* VT = (const bf16*)(A.ws + WS_VT);
    float* DC = (float*)(A.ws + WS_DC); float* DN = (float*)(A.ws + WS_DN); float* BT = (float*)(A.ws + WS_BTOT);
    const int r = C.lane & 31, hh = C.lane >> 5, w = C.wave;
    for (int u = C.bid; u < NUNIT; u += C.G) {
        const int blk = u % NBLK, bh = u / NBLK, h = bh % NH, b = bh / NH; const int row0 = blk_row0(b, blk);
        block_gates(A, row0, h, bf, bb, lif, lib, C.tid);
        if (C.tid < 256) { af[C.tid] = __expf(bf[255] - bf[C.tid] + lif[C.tid]); ab[C.tid] = __expf(bb[0] - bb[C.tid] + lib[C.tid]); }
        if (C.tid == 0) { BT[u * 2 + 0] = bf[255]; BT[u * 2 + 1] = bb[0]; }
        __syncthreads();
        { const int sp = C.tid >> 2, dq = C.tid & 3, s0 = 2 * sp;
          const bf16* k0 = P + (size_t)(row0 + s0) * PW + NQ + h * DQK + 32 * dq;
          const float f0 = af[s0], f1 = af[s0 + 1], g0 = ab[s0], g1 = ab[s0 + 1];
#pragma unroll
          for (int c = 0; c < 4; ++c) { const u32x4 x0 = *(const u32x4*)(k0 + 8 * c), x1 = *(const u32x4*)(k0 + PW + 8 * c);
#pragma unroll
              for (int q = 0; q < 4; ++q) { const int d = 32 * dq + 8 * c + 2 * q;
                  const float a0 = bflo(x0[q]), a1 = bfhi(x0[q]), c0 = bflo(x1[q]), c1 = bfhi(x1[q]);
                  *(LAS unsigned*)(KTf + d * KP + s0 * 2) = cvt2(a0 * f0, c0 * f1); *(LAS unsigned*)(KTf + (d + 1) * KP + s0 * 2) = cvt2(a1 * f0, c1 * f1);
                  *(LAS unsigned*)(KTb + d * KP + s0 * 2) = cvt2(a0 * g0, c0 * g1); *(LAS unsigned*)(KTb + (d + 1) * KP + s0 * 2) = cvt2(a1 * g0, c1 * g1); } } }
        __syncthreads();
        if (C.tid < 256) { const int dir = C.tid >> 7, d = C.tid & 127; LAS const unsigned* kr = (LAS const unsigned*)((dir ? KTb : KTf) + d * KP); float s = 0.f;
            for (int i = 0; i < 128; ++i) { const unsigned x = kr[i]; s += bflo(x) + bfhi(x); }
            DN[(size_t)(u * 2 + dir) * DQK + d] = s; }
        const bf16* vt = VT + (size_t)vt_tile(b, h, blk) * 65536 + (size_t)(32 * w + r) * 256 + 8 * hh;
        f32x16 accf[4], accb[4];
#pragma unroll
        for (int dt = 0; dt < 4; ++dt)
#pragma unroll
            for (int i = 0; i < 16; ++i) { accf[dt][i] = 0.f; accb[dt][i] = 0.f; }
#pragma unroll 2
        for (int ks = 0; ks < 16; ++ks) { const bf16x8 a = *(const bf16x8*)(vt + 16 * ks);
#pragma unroll
            for (int dt = 0; dt < 4; ++dt) { const int off = (dt * 32 + r) * KP + (16 * ks + 8 * hh) * 2;
                const bf16x8 b0 = *(const LAS bf16x8*)(KTf + off), b1 = *(const LAS bf16x8*)(KTb + off);
                accf[dt] = MFMA32(a, b0, accf[dt]); accb[dt] = MFMA32(a, b1, accb[dt]); } }
        float* dcf = DC + (size_t)(u * 2 + 0) * DQK * DV + (size_t)(32 * w + 4 * hh) * DQK + r; float* dcb = dcf + DQK * DV;
#pragma unroll
        for (int g = 0; g < 4; ++g) { float* pf = dcf + g * 8 * DQK; float* pb = dcb + g * 8 * DQK; asm volatile("" : "+v"(pf), "+v"(pb));
#pragma unroll
            for (int q = 0; q < 4; ++q)
#pragma unroll
                for (int dt = 0; dt < 4; ++dt) { pf[q * DQK + dt * 32] = accf[dt][4 * g + q]; pb[q * DQK + dt * 32] = accb[dt][4 * g + q]; } }
        __syncthreads();
    }
}
__device__ __forceinline__ void phase_s2(const Args& A, const Ctx& C) {
    const float* __restrict__ DC = (const float*)(A.ws + WS_DC); const float* __restrict__ DN = (const float*)(A.ws + WS_DN); const float* __restrict__ BT = (const float*)(A.ws + WS_BTOT);
    bf16* __restrict__ CST = (bf16*)(A.ws + WS_CST); float* __restrict__ NST = (float*)(A.ws + WS_NST);
    constexpr int EL4 = DQK * DV / 4;
    for (int g = C.bid * NT + C.tid; g < BATCH * NH * 2 * EL4; g += C.G * NT) {
        const int e4 = (g % EL4) * 4, ch = g / EL4, dir = ch & 1, bh = ch >> 1;
        f32x4 st = (f32x4){0.f, 0.f, 0.f, 0.f};
#pragma unroll 13
        for (int idx = 0; idx < NBLK; ++idx) {
            const int blk = dir == 0 ? idx : (idx == 0 ? 0 : NBLK - idx); const int u = bh * NBLK + blk;
            const float dec = __expf(BT[u * 2 + dir]);
            const f32x4 dc = *(const f32x4*)(DC + (size_t)(u * 2 + dir) * DQK * DV + e4);
            u32x2 o; o.x = cvt2(st.x, st.y); o.y = cvt2(st.z, st.w);
            *(u32x2*)(CST + (size_t)(u * 2 + dir) * DQK * DV + e4) = o;
            st = st * dec + dc;
        }
    }
    for (int g = C.bid * NT + C.tid; g < BATCH * NH * 2 * DQK; g += C.G * NT) {
        const int d = g % DQK, ch = g / DQK, dir = ch & 1, bh = ch >> 1; float st = 0.f;
        for (int idx = 0; idx < NBLK; ++idx) {
            const int blk = dir == 0 ? idx : (idx == 0 ? 0 : NBLK - idx); const int u = bh * NBLK + blk;
            NST[(size_t)(u * 2 + dir) * DQK + d] = st; st = __expf(BT[u * 2 + dir]) * st + DN[(size_t)(u * 2 + dir) * DQK + d];
        }
    }
}
__device__ __forceinline__ void lds_barrier() { asm volatile("s_waitcnt lgkmcnt(0)" ::: "memory"); __builtin_amdgcn_s_barrier(); asm volatile("" ::: "memory"); }
__device__ __forceinline__ void phase_s3(const Args& A, const Ctx& C, int l) {
    const int jl = l >> 1; const bool ctx_out = (l == 0);
    LAS float* bf = (LAS float*)C.lds; LAS float* bb = bf + 256; LAS float* gf = bb + 256; LAS float* gb = gf + 256;
    LAS float* nf = gb + 256; LAS float* nb = nf + 128; LAS float* ssx = nb + 128;
    LAS float* cf = ssx + 256; LAS float* cb = cf + 256;
    constexpr int KP = 272, VP = 136, CP = 144, OP = 528;
    LAS unsigned char* Kimg = C.lds + 8192;
    LAS unsigned char* CH = Kimg + 256 * KP;
    static_assert(8192 + 256 * KP + 128 * OP <= LDS_TAB_END, "S3 LDS map");
    const bf16* P = (const bf16*)(A.ws + WS_PB); const bf16* VT = (const bf16*)(A.ws + WS_VT); unsigned char* HM = A.ws + WS_HM;
    const bf16* CST = (const bf16*)(A.ws + WS_CST); const float* NST = (const float*)(A.ws + WS_NST);
    const float* hg = A.in[10] + (size_t)jl * NV;
    const int w = C.wave, eh = w >> 2;
    for (int u = C.bid; u < NUNIT; u += C.G) {
        const int blk = u % NBLK, bh = u / NBLK, h = bh % NH, b = bh / NH; const int row0 = blk_row0(b, blk);
        if (blk == 0 && !ctx_out) continue;
        int tu = threadIdx.x; asm volatile("" : "+v"(tu));
        block_gates(A, row0, h, bf, bb, gf, gb, tu);
        if (tu < 256) { gf[tu] -= bf[tu]; gb[tu] -= bb[tu]; cf[tu] = __expf(bf[tu | 31] + gf[tu]); cb[tu] = __expf(bb[tu & ~31] + gb[tu]); }
        else { const int t2 = tu - 256; nf[t2] = NST[(size_t)(u * 2 + (t2 >> 7)) * DQK + (t2 & 127)]; }
        { const int pc = tu & 15, s0 = tu >> 4; const bf16* kr = P + (size_t)(row0 + s0) * PW + NQ + h * DQK + 8 * pc;
#pragma unroll
          for (int i = 0; i < 8; ++i) *(LAS u32x4*)(Kimg + (s0 + 32 * i) * KP + pc * 16) = *(const u32x4*)(kr + (size_t)(32 * i) * PW); }
        __syncthreads();
        const bf16* vtile = VT + (size_t)vt_tile(b, h, blk) * 65536;
        const bf16* ctile = CST + (size_t)(u * 2) * DQK * DV;
#pragma unroll 1
        for (int ps = 0; ps < 2; ++ps) {
            int lz = threadIdx.x & 63; asm volatile("" : "+v"(lz));
            const int r = lz & 31, hh = lz >> 5;
            const int jt = 2 * (w & 3) + ps; const int jrow = row0 + 32 * jt + r;
            bf16x8 qf[8];
            { const bf16* qr = P + (size_t)jrow * PW + h * DQK + 8 * hh;
#pragma unroll
              for (int kk = 0; kk < 8; ++kk) qf[kk] = *(const bf16x8*)(qr + 16 * kk); }
            const float bfj = bf[32 * jt + r], bbj = bb[32 * jt + r];
            float qnf = 0.f, qnb = 0.f;
#pragma unroll
            for (int kk = 0; kk < 8; ++kk) { const u32x4 qq = __builtin_bit_cast(u32x4, qf[kk]); const int d = 16 * kk + 8 * hh;
                const f32x4 n0 = *(const LAS f32x4*)(nf + d), n1 = *(const LAS f32x4*)(nf + d + 4), m0 = *(const LAS f32x4*)(nb + d), m1 = *(const LAS f32x4*)(nb + d + 4);
                qnf += (bflo(qq.x) * n0.x + bfhi(qq.x) * n0.y) + (bflo(qq.y) * n0.z + bfhi(qq.y) * n0.w) + (bflo(qq.z) * n1.x + bfhi(qq.z) * n1.y) + (bflo(qq.w) * n1.z + bfhi(qq.w) * n1.w);
                qnb += (bflo(qq.x) * m0.x + bfhi(qq.x) * m0.y) + (bflo(qq.y) * m0.z + bfhi(qq.y) * m0.w) + (bflo(qq.z) * m1.x + bfhi(qq.z) * m1.y) + (bflo(qq.w) * m1.z + bfhi(qq.w) * m1.w);
                if (kk & 1) asm volatile("" ::: "memory"); }
            qnf += __shfl_xor(qnf, 32); qnb += __shfl_xor(qnb, 32);
            u32x4 pre[4];
            { int tz = threadIdx.x; asm volatile("" : "+v"(tz)); const int pc = tz & 7, e0 = tz >> 3; const bf16* vr = vtile + (size_t)e0 * 256 + 8 * pc;
#pragma unroll
              for (int c4 = 0; c4 < 4; ++c4) pre[c4] = *(const u32x4*)(vr + (size_t)(64 * c4) * 256); }
            float denf = 0.f, denb = 0.f;
#pragma unroll 1
            for (int kt = 0; kt < 8; ++kt) {
                f32x16 c;
#pragma unroll
                for (int i = 0; i < 16; ++i) c[i] = 0.f;
#pragma unroll
                for (int kk = 0; kk < 8; ++kk) { const bf16x8 a = *(const LAS bf16x8*)(Kimg + (kt * 32 + r) * KP + (16 * kk + 8 * hh) * 2); c = MFMA32(a, qf[kk], c); }
                if (kt == jt) {
#pragma unroll
                    for (int g = 0; g < 4; ++g) { const int sl0 = 8 * g + 4 * hh;
                        const f32x4 g4f = *(const LAS f32x4*)(gf + kt * 32 + sl0), g4b = *(const LAS f32x4*)(gb + kt * 32 + sl0);
#pragma unroll
                        for (int q = 0; q < 4; ++q) { const int sl = sl0 + q; const float cv = c[4 * g + q];
                            denf += cv * __expf((sl <= r) ? bfj + g4f[q] : -1.0e30f); denb += cv * __expf((sl >= r) ? bbj + g4b[q] : -1.0e30f); } }
                } else {
                    LAS const float* cx = (kt < jt ? cf : cb) + kt * 32 + 4 * hh; float sm = 0.f;
#pragma unroll
                    for (int g = 0; g < 4; ++g) { const f32x4 c4 = *(const LAS f32x4*)(cx + 8 * g); sm += (c[4 * g] * c4.x + c[4 * g + 1] * c4.y) + (c[4 * g + 2] * c4.z + c[4 * g + 3] * c4.w); }
                    if (kt < jt) denf += sm * __expf(bfj - bf[kt * 32 + 31]); else denb += sm * __expf(bbj - bb[kt * 32]);
                }
            }
            denf += __shfl_xor(denf, 32); denb += __shfl_xor(denb, 32);
            const float ebf = __expf(bfj), ebb = __expf(bbj);
            denf += ebf * qnf; denb += ebb * qnb;
            const float rf = 1.0f / fmaxf(fabsf(denf), 1.0f), rb = 1.0f / fmaxf(fabsf(denb), 1.0f);
            const float scf = ebf * rf, scb = ebb * rb;
            f32x16 acc[4];
#pragma unroll
            for (int et = 0; et < 4; ++et)
#pragma unroll
                for (int i = 0; i < 16; ++i) acc[et][i] = 0.f;
#pragma unroll
            for (int ci = 0; ci < 8; ++ci) {
                lds_barrier();
                { int tz = threadIdx.x; asm volatile("" : "+v"(tz)); const int pc = tz & 7, e0 = tz >> 3;
                  if (ci < 4) {
#pragma unroll
                      for (int c4 = 0; c4 < 4; ++c4) { *(LAS u32x2*)(CH + (e0 + 64 * c4) * VP + pc * 16) = (u32x2){pre[c4].x, pre[c4].y}; *(LAS u32x2*)(CH + (e0 + 64 * c4) * VP + pc * 16 + 8) = (u32x2){pre[c4].z, pre[c4].w}; }
                  } else {
#pragma unroll
                      for (int c4 = 0; c4 < 4; ++c4) *(LAS u32x4*)(CH + (e0 + 64 * c4) * CP + pc * 16) = pre[c4];
                  }
                  if (ci < 7) { const int cn = ci + 1;
                      const bf16* src = (cn < 4) ? vtile + (size_t)e0 * 256 + 64 * cn + 8 * pc : ctile + (size_t)(cn >= 6 ? DQK * DV : 0) + (size_t)e0 * DQK + 64 * (cn & 1) + 8 * pc;
                      const size_t rstep = (cn < 4) ? (size_t)64 * 256 : (size_t)64 * DQK;
#pragma unroll
                      for (int c4 = 0; c4 < 4; ++c4) pre[c4] = *(const u32x4*)(src + c4 * rstep); } }
                lds_barrier();
                if (ci < 4) {
#pragma unroll 1
                    for (int kt2 = 0; kt2 < 2; ++kt2) { const int kt = 2 * ci + kt2;
                        f32x16 c;
#pragma unroll
                        for (int i = 0; i < 16; ++i) c[i] = 0.f;
#pragma unroll
                        for (int kk = 0; kk < 8; ++kk) { const bf16x8 a = *(const LAS bf16x8*)(Kimg + (kt * 32 + r) * KP + (16 * kk + 8 * hh) * 2); c = MFMA32(a, qf[kk], c); }
                        float p[16]; const float bfj2 = bf[32 * jt + r], bbj2 = bb[32 * jt + r];
                        if (kt == jt) {
#pragma unroll
                            for (int g = 0; g < 4; ++g) { const int sl0 = 8 * g + 4 * hh;
                                const f32x4 g4f = *(const LAS f32x4*)(gf + kt * 32 + sl0), g4b = *(const LAS f32x4*)(gb + kt * 32 + sl0);
#pragma unroll
                                for (int q = 0; q < 4; ++q) { const int sl = sl0 + q;
                                    const float wt = rf * __expf((sl <= r) ? bfj2 + g4f[q] : -1.0e30f) + rb * __expf((sl >= r) ? bbj2 + g4b[q] : -1.0e30f);
                                    p[4 * g + q] = c[4 * g + q] * wt; } }
                        } else {
                            LAS const float* cx = (kt < jt ? cf : cb) + kt * 32 + 4 * hh;
                            const float rw = (kt < jt) ? rf * __expf(bfj2 - bf[kt * 32 + 31]) : rb * __expf(bbj2 - bb[kt * 32]);
#pragma unroll
                            for (int g = 0; g < 4; ++g) { const f32x4 c4 = *(const LAS f32x4*)(cx + 8 * g);
                                p[4 * g] = c[4 * g] * (c4.x * rw); p[4 * g + 1] = c[4 * g + 1] * (c4.y * rw); p[4 * g + 2] = c[4 * g + 2] * (c4.z * rw); p[4 * g + 3] = c[4 * g + 3] * (c4.w * rw); }
                        }
                        const bf16x8 pa0 = pack8(p[0], p[1], p[2], p[3], p[4], p[5], p[6], p[7]), pa1 = pack8(p[8], p[9], p[10], p[11], p[12], p[13], p[14], p[15]);
#pragma unroll
                        for (int et = 0; et < 4; ++et) { LAS const unsigned char* vb = CH + ((4 * eh + et) * 32 + r) * VP + (kt2 * 32 + 4 * hh) * 2;
                            const u32x2 l0 = *(LAS const u32x2*)(vb), h0 = *(LAS const u32x2*)(vb + 16), l1 = *(LAS const u32x2*)(vb + 32), h1 = *(LAS const u32x2*)(vb + 48);
                            const bf16x8 a0 = __builtin_bit_cast(bf16x8, (u32x4){l0.x, l0.y, h0.x, h0.y}), a1 = __builtin_bit_cast(bf16x8, (u32x4){l1.x, l1.y, h1.x, h1.y});
                            acc[et] = MFMA32(a0, pa0, acc[et]); acc[et] = MFMA32(a1, pa1, acc[et]); }
                    }
                } else {
                    const int dir = (ci - 4) >> 1, dh = ci & 1;
                    const float sc = dir ? scb : scf;
#pragma unroll
                    for (int k4 = 0; k4 < 4; ++k4) { const u32x4 qq = __builtin_bit_cast(u32x4, qf[4 * dh + k4]);
                        const bf16x8 qs = pack8(bflo(qq.x) * sc, bfhi(qq.x) * sc, bflo(qq.y) * sc, bfhi(qq.y) * sc, bflo(qq.z) * sc, bfhi(qq.z) * sc, bflo(qq.w) * sc, bfhi(qq.w) * sc);
#pragma unroll
                        for (int et = 0; et < 4; ++et) { const bf16x8 a = *(const LAS bf16x8*)(CH + ((4 * eh + et) * 32 + r) * CP + (16 * k4 + 8 * hh) * 2); acc[et] = MFMA32(a, qs, acc[et]); } }
                }
            }
            float ss = 0.f;
#pragma unroll
            for (int et = 0; et < 4; ++et)
#pragma unroll
                for (int i = 0; i < 16; ++i) ss += acc[et][i] * acc[et][i];
            ss += __shfl_xor(ss, 32);
            if (hh == 0) ssx[w * 32 + r] = ss;
            lds_barrier();
            ss += ssx[(w ^ 4) * 32 + r];
            const float rs = 1.0f / sqrtf(ss * (1.0f / DV) + EPS);
            { LAS unsigned char* ob = CH + ((w & 3) * 32 + r) * OP + (eh * 128 + 4 * hh) * 2;
#pragma unroll
              for (int et = 0; et < 4; ++et)
#pragma unroll
                  for (int g = 0; g < 4; ++g) { u32x2 o; o.x = cvt2(acc[et][4 * g + 0] * rs, acc[et][4 * g + 1] * rs); o.y = cvt2(acc[et][4 * g + 2] * rs, acc[et][4 * g + 3] * rs);
                      *(LAS u32x2*)(ob + (et * 32 + 8 * g) * 2) = o; } }
            lds_barrier();
            { int tz = threadIdx.x; asm volatile("" : "+v"(tz)); const int pc = tz & 31, lr0 = tz >> 5;
              const f32x4 g0 = *(const f32x4*)(hg + h * DV + 8 * pc), g1 = *(const f32x4*)(hg + h * DV + 8 * pc + 4);
#pragma unroll
              for (int hf = 0; hf < 2; ++hf) {
              u32x4 ov[4];
#pragma unroll
              for (int i = 0; i < 4; ++i) { const int lr = lr0 + 16 * (4 * hf + i); const int grow = row0 + 64 * (lr >> 5) + 32 * ps + (lr & 31); ov[i] = *(const u32x4*)(P + (size_t)grow * PW + 2 * NQ + NV + h * DV + 8 * pc); }
#pragma unroll
              for (int i = 0; i < 4; ++i) { const int lr = lr0 + 16 * (4 * hf + i); const int grow = row0 + 64 * (lr >> 5) + 32 * ps + (lr & 31);
                  const u32x4 hv = *(const LAS u32x4*)(CH + lr * OP + pc * 16);
                  const f32x4 o0 = (f32x4){bflo(hv.x) * g0.x * bflo(ov[i].x), bfhi(hv.x) * g0.y * bfhi(ov[i].x), bflo(hv.y) * g0.z * bflo(ov[i].y), bfhi(hv.y) * g0.w * bfhi(ov[i].y)};
                  const f32x4 o1 = (f32x4){bflo(hv.z) * g1.x * bflo(ov[i].z), bfhi(hv.z) * g1.y * bfhi(ov[i].z), bflo(hv.w) * g1.z * bflo(ov[i].w), bfhi(hv.w) * g1.w * bfhi(ov[i].w)};
                  *(u32x2*)(HM + (size_t)grow * D + h * DV + 8 * pc) = cvt8_fp8(o0, o1); }
              asm volatile("" ::: "memory"); } }
        }
        __syncthreads();
    }
}

#define XB_TMO      128
#define XB_XCNT(j)  (256  + 64 * (j))
#define XB_XSUB(j)  (1280 + 64 * (j))
#define XB_XGEN(j)  (2304 + 64 * (j))
#define XB_TOP      3328
#define XB_TOPGEN   3392
#define XCD_BAR_WORDS 3456
#define XB_SPIN_CAP (1u << 18)

__device__ __forceinline__ unsigned xb_ld(unsigned* p)              { return __hip_atomic_load(p, __ATOMIC_RELAXED, __HIP_MEMORY_SCOPE_AGENT); }
__device__ __forceinline__ unsigned xb_add(unsigned* p, unsigned v) { return __hip_atomic_fetch_add(p, v, __ATOMIC_RELAXED, __HIP_MEMORY_SCOPE_AGENT); }
__device__ __forceinline__ unsigned xb_xcc_id() { return (unsigned)__builtin_amdgcn_s_getreg((3 << 11) | 20) & 0xFu; }
#define XB_SPIN(cond, bar) do { unsigned _sp = 0; while (cond) { __builtin_amdgcn_s_sleep(1); \
    if ((++_sp & 255u) == 0u) { if (xb_ld(&(bar)[XB_TMO])) break; if (_sp > XB_SPIN_CAP) { atomicAdd(&(bar)[XB_TMO], 1u); break; } } } } while (0)

struct XcdBarrier {
    unsigned* bar; unsigned x;
    volatile LAS unsigned* st;
};

__device__ __forceinline__ XcdBarrier xcd_barrier_post(unsigned* bar, volatile LAS unsigned* st) {
    XcdBarrier b; b.bar = bar; b.x = xb_xcc_id(); b.st = st;
    if (threadIdx.x == 0) (void)xb_add(&bar[XB_XCNT(b.x)], 1u);
    return b;
}
__device__ __forceinline__ void xcd_barrier_complete(unsigned* bar, unsigned x, unsigned& nloc, unsigned& nx) {
    const unsigned G = gridDim.x * gridDim.y * gridDim.z;
    unsigned sum, cnt, mine, sp = 0u;
    for (;;) {
        sum = 0u; cnt = 0u; mine = 0u;
#pragma unroll
        for (unsigned j = 0; j < 16; ++j) { const unsigned c = xb_ld(&bar[XB_XCNT(j)]); sum += c; cnt += (c > 0u) ? 1u : 0u; mine = (j == x) ? c : mine; }
        if (sum == G) break;
        __builtin_amdgcn_s_sleep(1);
        if ((++sp & 255u) == 0u) { if (xb_ld(&bar[XB_TMO])) break; if (sp > XB_SPIN_CAP) { atomicAdd(&bar[XB_TMO], 1u); break; } }
    }
    nloc = mine > 0u ? mine : 1u; nx = cnt > 0u ? cnt : 1u;
}

__device__ __forceinline__ void xcd_barrier(const XcdBarrier& b) {
    asm volatile("s_waitcnt vmcnt(0)" ::: "memory");
    __syncthreads();
    if (threadIdx.x == 0) {
        unsigned* bar = b.bar;
        __builtin_amdgcn_s_waitcnt(0);
        unsigned nloc = b.st[0], nx = b.st[1];
        if (nloc == 0u) { xcd_barrier_complete(bar, b.x, nloc, nx); b.st[0] = nloc; b.st[1] = nx; }
        const unsigned old = xb_add(&bar[XB_XSUB(b.x)], 1u);
        const unsigned gen = old / nloc;
        if (old + 1u == (gen + 1u) * nloc) {
            __builtin_amdgcn_fence(__ATOMIC_RELEASE, "agent");
            asm volatile("s_waitcnt vmcnt(0)" ::: "memory");
            const unsigned og = xb_add(&bar[XB_TOP], 1u);
            const unsigned tg = og / nx;
            if (og + 1u == (tg + 1u) * nx) xb_add(&bar[XB_TOPGEN], 1u);
            else XB_SPIN(xb_ld(&bar[XB_TOPGEN]) == tg, bar);
            __builtin_amdgcn_fence(__ATOMIC_ACQUIRE, "agent");
            xb_add(&bar[XB_XGEN(b.x)], 1u);
            asm volatile("s_waitcnt vmcnt(0)" ::: "memory");
        } else {
            XB_SPIN(xb_ld(&bar[XB_XGEN(b.x)]) == gen, bar);
            __builtin_amdgcn_fence(__ATOMIC_ACQUIRE, "agent");
            asm volatile("s_waitcnt vmcnt(0)" ::: "memory");
        }
    }
    __syncthreads();
}


constexpr int LDS_BYTES = 152 * 1024;
constexpr int CW_BAR = 16384;
static_assert((CW_BAR + XCD_BAR_WORDS) * 4 <= (int)CTL_BYTES, "ctl");
#ifndef MK_MULTI
#define MK_MULTI 0
#endif
#define IN(p) (lo <= (p) && (p) < hi)
#define SEAM(p) do { if ((p) + 1 < hi) { XcdBarrier b_; b_.bar = (unsigned*)(load_args().ws + WS_CTL) + CW_BAR; b_.x = xb_xcc_id(); b_.st = (volatile LAS unsigned*)(C.lds + LDS_BYTES - 16); xcd_barrier(b_); } } while (0)
#define CAS __attribute__((address_space(4)))
__device__ __forceinline__ Args load_args() {
#if defined(__HIP_DEVICE_COMPILE__)
    const CAS Args* p = (const CAS Args*)__builtin_amdgcn_kernarg_segment_ptr(); asm volatile("" : "+s"(p));
    Args a; for (int i = 0; i < 22; ++i) a.in[i] = p->in[i]; a.out = p->out; a.ws = p->ws; a.lo = p->lo; a.hi = p->hi; return a;
#else
    return Args{};
#endif
}
__device__ __forceinline__ Ctx fresh(const Ctx& C) { Ctx R = C; int tz = threadIdx.x; asm volatile("" : "+v"(tz)); R.tid = tz; R.lane = tz & 63; return R; }
template <int L> __device__ __forceinline__ void layer_phases(const Args& args, const Ctx& C, int bar, int lo, int hi) {
    constexpr int pb = 16 * L;
    if (IN(pb + 1)) { phase_r1(load_args(), fresh(C), L); SEAM(pb + 1); }
    if (IN(pb + 2)) { phase_g1(load_args(), fresh(C), L); SEAM(pb + 2); }
    if constexpr ((L & 1) == 0) {
        if (IN(pb + 3)) { phase_s1(load_args(), fresh(C), L); SEAM(pb + 3); }
        if (IN(pb + 4)) { phase_s2(load_args(), fresh(C)); SEAM(pb + 4); }
        if (IN(pb + 5)) { phase_s3(load_args(), fresh(C), L); SEAM(pb + 5); }
    } else {
        if (IN(pb + 3)) { phase_conv(load_args(), fresh(C), L); SEAM(pb + 3); }
    }
    if (IN(pb + 6)) { phase_g2(load_args(), fresh(C), L); SEAM(pb + 6); }
    if (IN(pb + 7)) { phase_r2(load_args(), fresh(C), L); SEAM(pb + 7); }
    if (IN(pb + 8)) { phase_m1(load_args(), fresh(C), L); SEAM(pb + 8); }
    if (IN(pb + 9)) { phase_m2(load_args(), fresh(C), L); SEAM(pb + 9); }
}
__global__ void __launch_bounds__(NT, 2) fwd_kernel(Args args) {
    extern __shared__ __attribute__((aligned(16))) unsigned char lds_raw[];
    Ctx C; C.lds = (LAS unsigned char*)lds_raw; C.tid = threadIdx.x; C.lane = C.tid & 63; C.wave = __builtin_amdgcn_readfirstlane(C.tid >> 6); C.G = gridDim.x; C.bid = blockIdx.x; C.a = &args;
    const int lo = args.lo, hi = args.hi;
    volatile LAS unsigned* xbw = (volatile LAS unsigned*)(C.lds + LDS_BYTES - 16);
    if (C.tid < 4) xbw[C.tid] = 0u;
    __syncthreads();
    if (hi - lo > 1) (void)xcd_barrier_post((unsigned*)(args.ws + WS_CTL) + CW_BAR, xbw);
    const int bar = 0; (void)bar;
    if (IN(0)) { phase_mod(load_args(), fresh(C)); __syncthreads(); phase_cvt_mixer(load_args(), fresh(C)); SEAM(0); }
    layer_phases<0>(args, C, bar, lo, hi);
    layer_phases<1>(args, C, bar, lo, hi);
    layer_phases<2>(args, C, bar, lo, hi);
    layer_phases<3>(args, C, bar, lo, hi);
    if (IN(64)) phase_final(load_args(), fresh(C));
}
#undef IN
#undef SEAM

extern "C" void kernel_launch(void* const* d_in, const int* in_sizes, int n_in, void* d_out, int out_size, void* d_ws, size_t ws_size, hipStream_t stream) {
    static int grid = 0;
    if (grid == 0) {
        if (n_in != 22 || out_size != NL * D || ws_size < WS_END) { fprintf(stderr, "kernel_launch: unexpected shapes (n_in %d out %d ws %zu)\n", n_in, out_size, ws_size); grid = -1; return; }
        int dev = 0, cus = 0, per_cu = 0;
        if (hipGetDevice(&dev) != hipSuccess || hipDeviceGetAttribute(&cus, hipDeviceAttributeMultiprocessorCount, dev) != hipSuccess) { grid = -1; return; }
        if (hipFuncSetAttribute((const void*)fwd_kernel, hipFuncAttributeMaxDynamicSharedMemorySize, LDS_BYTES) != hipSuccess) { grid = -1; return; }
        if (hipOccupancyMaxActiveBlocksPerMultiprocessor(&per_cu, (const void*)fwd_kernel, NT, LDS_BYTES) != hipSuccess || per_cu < 1) { fprintf(stderr, "kernel_launch: occupancy query says %d\n", per_cu); }
        (void)hipGetLastError();
        grid = cus;
    }
    if (grid < 0) return;
    (void)hipMemsetAsync((char*)d_ws + WS_CTL, 0, CTL_BYTES, stream);
    Args a{};
    for (int i = 0; i < 22; ++i) a.in[i] = (const float*)d_in[i];
    a.out = (float*)d_out; a.ws = (unsigned char*)d_ws;
#if MK_MULTI
    int phases[64]; int np = 0;
    phases[np++] = 0;
    for (int l = 0; l < DEPTH; ++l) { const int pb = 16 * l; phases[np++] = pb + 1; phases[np++] = pb + 2; phases[np++] = pb + 3;
        if ((l & 1) == 0) { phases[np++] = pb + 4; phases[np++] = pb + 5; }
        phases[np++] = pb + 6; phases[np++] = pb + 7; phases[np++] = pb + 8; phases[np++] = pb + 9; }
    phases[np++] = 64;
    for (int i = 0; i < np; ++i) { a.lo = phases[i]; a.hi = phases[i] + 1; hipLaunchKernelGGL(fwd_kernel, dim3(grid), dim3(NT), LDS_BYTES, stream, a); }
#else
    a.lo = 0; a.hi = 65;
    hipLaunchKernelGGL(fwd_kernel, dim3(grid), dim3(NT), LDS_BYTES, stream, a);
#ifdef PROBE_PHASES
    { const int pp[] = {PROBE_PHASES};
      for (int rep = 0; rep < PROBE_REPS; ++rep) for (unsigned i = 0; i < sizeof(pp) / sizeof(pp[0]); ++i) { a.lo = pp[i]; a.hi = pp[i] + 1; hipLaunchKernelGGL(fwd_kernel, dim3(grid), dim3(NT), LDS_BYTES, stream, a); } }
#endif
#endif
}
```

```cpp
#include <hip/hip_runtime.h>
#include <cstdio>
#include <cstdint>

#define LAS __attribute__((address_space(3)))
typedef unsigned short bf16;
typedef float f32x4 __attribute__((ext_vector_type(4)));
typedef unsigned u32x4 __attribute__((ext_vector_type(4)));
typedef unsigned u32x2 __attribute__((ext_vector_type(2)));
typedef int i32x4r __attribute__((ext_vector_type(4)));

constexpr int D = 1024, BATCH = 2, SEQ = 16384, DEPTH = 4, CTXL = 256;
constexpr int NL = BATCH * SEQ, NCX = BATCH * CTXL, NR = NL + NCX;
constexpr int NH = 4, DQK = 128, DV = 256, NQ = 512, NV = 1024, PROJ = 3088, PW = 3072;
constexpr int NGRP = 4, EPG = 8, NE = 32, DE = 512;
constexpr int NBLK = 65;
constexpr int NUNIT = BATCH * NH * NBLK;
constexpr int CAP = NR;
constexpr int YROWS = 74752;
constexpr float EPS = 1e-6f;
constexpr float WSCALE = 32.0f;
constexpr float YSCALE = 4.0f;
constexpr int NT = 512, NW = 8;
constexpr int LDS_TAB_END = 152 * 1024 - 16;

constexpr size_t MiB = 1u << 20;
constexpr size_t WS_CTL = 0, CTL_BYTES = 1 * MiB;
constexpr size_t WS_MOD = 1 * MiB;
constexpr size_t WS_GATE = 2 * MiB;
constexpr size_t WS_TOKSLOT = 5 * MiB;
constexpr size_t WS_TOKW = 6 * MiB;
constexpr size_t WS_SLOTTOK = 7 * MiB;
constexpr size_t WS_DN = 12 * MiB;
constexpr size_t WS_NST = 13 * MiB;
constexpr size_t WS_BTOT = 14 * MiB;
constexpr size_t WS_LAT = 16 * MiB;
constexpr size_t WS_HB = 146 * MiB;
constexpr size_t WS_PB = 211 * MiB;
constexpr size_t WS_HM = 406 * MiB;
constexpr size_t WS_DC = 471 * MiB;
constexpr size_t WS_CST = 601 * MiB;
constexpr size_t WS_VT = 666 * MiB;
constexpr size_t WS_WAIN = 731 * MiB;
constexpr size_t WS_WBIN = 743 * MiB;
constexpr size_t WS_WAOUT = 755 * MiB;
constexpr size_t WS_WBOUT = 759 * MiB;
constexpr size_t WS_WGU = 763 * MiB;
constexpr size_t WS_WDN = 827 * MiB;
constexpr size_t WS_H8 = 843 * MiB;
constexpr size_t WS_END = 880 * MiB;
constexpr int CW_CNT = 1024, CNT_STRIDE = 64;

struct Args { const float* in[22]; float* out; unsigned char* ws; int lo, hi; };

typedef short bf16x8 __attribute__((ext_vector_type(8)));
typedef float f32x2 __attribute__((ext_vector_type(2)));
typedef __bf16 bf16x2_t __attribute__((ext_vector_type(2)));
__device__ __forceinline__ unsigned cvt2(float lo, float hi) { const f32x2 v = {lo, hi}; return __builtin_bit_cast(unsigned, __builtin_convertvector(v, bf16x2_t)); }
__device__ __forceinline__ float bf2f(bf16 v) { return __uint_as_float(((unsigned)v) << 16); }
__device__ __forceinline__ unsigned f2bf(float f) { unsigned u = __float_as_uint(f); return (u + 0x7fffu + ((u >> 16) & 1u)) >> 16; }
__device__ __forceinline__ unsigned pk2(float lo, float hi) { return f2bf(lo) | (f2bf(hi) << 16); }
template <int CTRL, int ROWMASK> __device__ __forceinline__ float dpp_mov(float x) { return __int_as_float(__builtin_amdgcn_update_dpp(0, __float_as_int(x), CTRL, ROWMASK, 0xf, false)); }
__device__ __forceinline__ float wave_sum(float v) {
    v += dpp_mov<0xB1, 0xf>(v); v += dpp_mov<0x4E, 0xf>(v); v += dpp_mov<0x141, 0xf>(v); v += dpp_mov<0x140, 0xf>(v);
    v += dpp_mov<0x142, 0xA>(v); v += dpp_mov<0x143, 0xC>(v);
    return __int_as_float(__builtin_amdgcn_readlane(__float_as_int(v), 63));
}
__device__ __forceinline__ float sigmoidf_(float x) { return 1.f / (1.f + __expf(-x)); }
__device__ __forceinline__ float siluf_(float x) { return x / (1.f + __expf(-x)); }
__device__ __forceinline__ float logsigmoidf_(float x) { return fminf(x, 0.f) - log1pf(__expf(-fabsf(x))); }
__device__ __forceinline__ int blk_row0(int b, int blk) { return blk == 0 ? NL + b * CTXL : b * SEQ + (blk - 1) * 256; }
__device__ __forceinline__ int mod_vec_of_row(int row) { return row < NL ? row / SEQ : 2; }

struct Ctx {
    LAS unsigned char* lds; int tid, lane, wave, G, bid;
    const Args* a;
};

__device__ __forceinline__ int expert_block_prefix(const unsigned* cnt, int lane, int& nb) {
    nb = lane < NE ? ((int)cnt[lane * CNT_STRIDE] + 255) / 256 : 0; int v = nb;
#pragma unroll
    for (int o = 1; o < 64; o <<= 1) { const int t = __shfl_up(v, o); v += (lane >= o) ? t : 0; }
    return v - nb;
}
__device__ __forceinline__ void slot_bases(const Args& A, int l, LAS int* sb, int tid) {
    if (tid < 64) { int nb; const int ex = expert_block_prefix((const unsigned*)(A.ws + WS_CTL) + CW_CNT + l * 32 * CNT_STRIDE, tid, nb); if (tid <= NE) sb[tid] = ex * 256; }
    __syncthreads();
}

__device__ __forceinline__ void phase_mod(const Args& A, const Ctx& C) {
    LAS float* sc = (LAS float*)C.lds;
    LAS float* red = sc + 3072;
    const float* c = A.in[1]; const float* cc = A.in[3];
    for (int i = C.tid; i < 3072; i += NT) { const float v = i < 2048 ? c[i] : cc[i - 2048]; sc[i] = siluf_(v); }
    __syncthreads();
    float* MOD = (float*)(A.ws + WS_MOD);
    for (int u = C.bid; u < DEPTH * 96; u += C.G) {
        const int l = u / 96, cg = u % 96, col = cg * 64 + C.lane;
        const float* w = A.in[4] + (size_t)l * D * 6 * D + col;
        float a0 = 0.f, a1 = 0.f, a2 = 0.f;
#pragma unroll 32
        for (int k = C.wave * 128; k < C.wave * 128 + 128; ++k) { const float wv = w[(size_t)k * 6 * D]; a0 += sc[k] * wv; a1 += sc[1024 + k] * wv; a2 += sc[2048 + k] * wv; }
        red[(C.wave * 3 + 0) * 64 + C.lane] = a0; red[(C.wave * 3 + 1) * 64 + C.lane] = a1; red[(C.wave * 3 + 2) * 64 + C.lane] = a2;
        __syncthreads();
        if (C.tid < 192) { const int v = C.tid / 64, ln = C.tid % 64; float s = 0.f;
            for (int w8 = 0; w8 < 8; ++w8) s += red[(w8 * 3 + v) * 64 + ln];
            MOD[(size_t)(l * 3 + v) * 6 * D + cg * 64 + ln] = s + A.in[5][(size_t)l * 6 * D + cg * 64 + ln]; }
        __syncthreads();
    }
}

__device__ __forceinline__ void load_row_f32(const float* p, int lane, f32x4 (&v)[4]) {
#pragma unroll
    for (int j = 0; j < 4; ++j) v[j] = *(const f32x4*)(p + 4 * lane + 256 * j);
}
__device__ __forceinline__ void load_row_bf16(const bf16* p, int lane, f32x4 (&v)[4]) {
#pragma unroll
    for (int j = 0; j < 4; ++j) { const u32x2 w = *(const u32x2*)(p + 4 * lane + 256 * j);
        v[j] = (f32x4){__uint_as_float(w.x << 16), __uint_as_float(w.x & 0xffff0000u), __uint_as_float(w.y << 16), __uint_as_float(w.y & 0xffff0000u)}; }
}
__device__ __forceinline__ void store_row_bf16(bf16* p, int lane, const f32x4 (&v)[4]) {
#pragma unroll
    for (int j = 0; j < 4; ++j) { u32x2 w; w.x = pk2(v[j].x, v[j].y); w.y = pk2(v[j].z, v[j].w); *(u32x2*)(p + 4 * lane + 256 * j) = w; }
}
constexpr int CVT_IG = (D / 64) * (DE / 32), CVT_ID = (DE / 64) * (D / 32), CVT_PER = 2 * CVT_IG + CVT_ID, CVT_ITEMS = NE * CVT_PER;
constexpr int CVT_Q = 64;
__device__ __forceinline__ void cvt_moe_items(const Args& A, const Ctx& C, int l, int it0, int end, int stride);
__device__ __forceinline__ int cvt_t2(int l, int G);
struct RowVec { f32x4 a[4], s[4], g[4]; };
__device__ __forceinline__ void load_rowvec(RowVec& R, const float* ng, const float* sh, const float* sc, const float* gt, int lane) {
    f32x4 n[4], c[4]; load_row_f32(ng, lane, n); load_row_f32(sc, lane, c); load_row_f32(sh, lane, R.s); if (gt) load_row_f32(gt, lane, R.g);
#pragma unroll
    for (int q = 0; q < 4; ++q) R.a[q] = n[q] * (1.f + c[q]);
}
__device__ __forceinline__ void load_row_bf16raw(const bf16* p, int lane, u32x2 (&v)[4]) {
#pragma unroll
    for (int j = 0; j < 4; ++j) v[j] = *(const u32x2*)(p + 4 * lane + 256 * j);
}
__device__ __forceinline__ void store_row_fp8(unsigned char* p, int lane, const f32x4 (&v)[4]) {
#pragma unroll
    for (int j = 0; j < 4; ++j) { int w = 0; w = __builtin_amdgcn_cvt_pk_fp8_f32(v[j].x, v[j].y, w, false); w = __builtin_amdgcn_cvt_pk_fp8_f32(v[j].z, v[j].w, w, true); *(unsigned*)(p + 4 * lane + 256 * j) = (unsigned)w; }
}
__device__ __forceinline__ void load_row_fp8raw(const unsigned char* p, int lane, unsigned (&v)[4]) {
#pragma unroll
    for (int j = 0; j < 4; ++j) v[j] = *(const unsigned*)(p + 4 * lane + 256 * j);
}
__device__ __forceinline__ f32x4 fp8x4(unsigned w) { const f32x2 lo = __builtin_amdgcn_cvt_pk_f32_fp8((int)w, false), hi = __builtin_amdgcn_cvt_pk_f32_fp8((int)w, true); return (f32x4){lo.x, lo.y, hi.x, hi.y}; }
__device__ __forceinline__ f32x4 bf4(u32x2 w) { return (f32x4){__uint_as_float(w.x << 16), __uint_as_float(w.x & 0xffff0000u), __uint_as_float(w.y << 16), __uint_as_float(w.y & 0xffff0000u)}; }
__device__ __forceinline__ float row_rstd(const f32x4 (&v)[4]) {
    float s = 0.f;
#pragma unroll
    for (int j = 0; j < 4; ++j) s += (v[j].x * v[j].x + v[j].y * v[j].y) + (v[j].z * v[j].z + v[j].w * v[j].w);
    return 1.0f / sqrtf(wave_sum(s) * (1.f / D) + EPS);
}

__device__ __forceinline__ void phase_r1(const Args& A, const Ctx& C, int l) {
    LAS int* sb = (LAS int*)C.lds;
    LAS float* GW = (LAS float*)(C.lds + 256);
    const bool mls = (l & 1) == 0; const int j = l >> 1;
    if (l > 0) slot_bases(A, l - 1, sb, C.tid);
    if (mls) { const float* w = A.in[8] + (size_t)j * D * PROJ + PW;
        f32x4 t[2][4];
#pragma unroll
        for (int jj = 0; jj < 2; ++jj)
#pragma unroll
            for (int q = 0; q < 4; ++q) t[jj][q] = *(const f32x4*)(w + (size_t)(C.tid + NT * jj) * PROJ + 4 * q);
#pragma unroll
        for (int jj = 0; jj < 2; ++jj)
#pragma unroll
            for (int q = 0; q < 4; ++q) { const int k = C.tid + NT * jj; GW[(4 * q + 0) * D + k] = t[jj][q].x; GW[(4 * q + 1) * D + k] = t[jj][q].y; GW[(4 * q + 2) * D + k] = t[jj][q].z; GW[(4 * q + 3) * D + k] = t[jj][q].w; }
        __syncthreads(); }
    const int nrows = (l <= 2) ? NR : NL;
    bf16* LAT = (bf16*)(A.ws + WS_LAT); bf16* H = (bf16*)(A.ws + WS_HB); float* GATE = (float*)(A.ws + WS_GATE);
    const float* MOD = (const float*)(A.ws + WS_MOD); const unsigned char* Y8 = A.ws + WS_PB;
    const int* TS = (const int*)(A.ws + WS_TOKSLOT); const float* TW = (const float*)(A.ws + WS_TOKW);
    const int rpw = (((nrows + C.G - 1) / C.G) + 1) & ~1; const int wrow0 = C.bid * rpw; const int wend = min(wrow0 + rpw, nrows);
    for (int sa = wrow0; sa < wend;) {
        const int mvi = mod_vec_of_row(sa); const int bnd = mvi == 0 ? SEQ : (mvi == 1 ? NL : NR); const int sbnd = min(wend, bnd);
        RowVec RV; { const float* mv = MOD + (size_t)(l * 3 + mvi) * 6 * D;
            load_rowvec(RV, A.in[6] + (size_t)(l * 2 + 0) * D, mv + 0 * D, mv + 1 * D, l > 0 ? MOD + (size_t)((l - 1) * 3 + mvi) * 6 * D + 5 * D : nullptr, C.lane); }
        const int rlast = sbnd - 2;
        i32x4r tsn = (i32x4r){0, 0, 0, 0}; f32x4 twn = (f32x4){0.f, 0.f, 0.f, 0.f};
        if (l > 0) { const int r0 = min(sa + 2 * C.wave, rlast); tsn = *(const i32x4r*)(TS + r0 * 2); twn = *(const f32x4*)(TW + r0 * 2); }
        for (int ra = sa + 2 * C.wave; ra < sbnd; ra += 2 * NW) {
            const bool hasb = true; const int rb = ra + 1;
            const i32x4r tsc = tsn; const f32x4 twc = twn;
            if (l > 0) { const int r1 = min(ra + 2 * NW, rlast); tsn = *(const i32x4r*)(TS + r1 * 2); twn = *(const f32x4*)(TW + r1 * 2); }
            f32x4 va[4], vb[4]; float wa0 = 0.f, wa1 = 0.f, wb0 = 0.f, wb1 = 0.f;
            if (l == 0) { load_row_f32(ra < NL ? A.in[0] + (size_t)ra * D : A.in[2] + (size_t)(ra - NL) * D, C.lane, va); load_row_f32(rb < NL ? A.in[0] + (size_t)rb * D : A.in[2] + (size_t)(rb - NL) * D, C.lane, vb); }
            else {
                const int ta0 = tsc.x, ta1 = tsc.y, tb0 = tsc.z, tb1 = tsc.w; wa0 = twc.x; wa1 = twc.y; wb0 = twc.z; wb1 = twc.w;
                load_row_bf16(LAT + (size_t)ra * D, C.lane, va); load_row_bf16(LAT + (size_t)rb * D, C.lane, vb);
                unsigned ya0[4], ya1[4], yb0[4], yb1[4];
                load_row_fp8raw(Y8 + (size_t)(sb[ta0 >> 20] + (ta0 & 0xfffff)) * D, C.lane, ya0); load_row_fp8raw(Y8 + (size_t)(sb[ta1 >> 20] + (ta1 & 0xfffff)) * D, C.lane, ya1);
                load_row_fp8raw(Y8 + (size_t)(sb[tb0 >> 20] + (tb0 & 0xfffff)) * D, C.lane, yb0); load_row_fp8raw(Y8 + (size_t)(sb[tb1 >> 20] + (tb1 & 0xfffff)) * D, C.lane, yb1);
                wa0 *= 1.0f / YSCALE; wa1 *= 1.0f / YSCALE; wb0 *= 1.0f / YSCALE; wb1 *= 1.0f / YSCALE;
#pragma unroll
                for (int q = 0; q < 4; ++q) { va[q] += RV.g[q] * (fp8x4(ya0[q]) * wa0 + fp8x4(ya1[q]) * wa1); vb[q] += RV.g[q] * (fp8x4(yb0[q]) * wb0 + fp8x4(yb1[q]) * wb1); }
            }
            store_row_bf16(LAT + (size_t)ra * D, C.lane, va); if (hasb) store_row_bf16(LAT + (size_t)rb * D, C.lane, vb);
            const float rra = row_rstd(va), rrb = row_rstd(vb);
            f32x4 ha[4], hb[4];
#pragma unroll
            for (int q = 0; q < 4; ++q) { ha[q] = (va[q] * rra) * RV.a[q] + RV.s[q]; hb[q] = (vb[q] * rrb) * RV.a[q] + RV.s[q]; }
            store_row_bf16(H + (size_t)ra * D, C.lane, ha); if (hasb) store_row_bf16(H + (size_t)rb * D, C.lane, hb);
            if (mls) {
                float ga = 0.f, gb = 0.f;
#pragma unroll 2
                for (int c = 0; c < 16; ++c) { float s0 = 0.f, s1 = 0.f;
#pragma unroll
                    for (int q = 0; q < 4; ++q) { const f32x4 w = *(const LAS f32x4*)(GW + c * D + 4 * C.lane + 256 * q);
                        s0 += (ha[q].x * w.x + ha[q].y * w.y) + (ha[q].z * w.z + ha[q].w * w.w); s1 += (hb[q].x * w.x + hb[q].y * w.y) + (hb[q].z * w.z + hb[q].w * w.w); }
                    s0 = wave_sum(s0); s1 = wave_sum(s1); ga = (C.lane == c) ? s0 : ga; gb = (C.lane == c) ? s1 : gb; }
                if (C.lane < 16) {
                    const float bgt = A.in[9][j * 16 + C.lane]; const int gtype = C.lane >> 2;
                    ga += bgt; gb += bgt;
                    GATE[(size_t)ra * 16 + C.lane] = (gtype & 1) ? logsigmoidf_(ga) : 15.0f * tanhf(ga * (1.0f / 15.0f));
                    if (hasb) GATE[(size_t)rb * 16 + C.lane] = (gtype & 1) ? logsigmoidf_(gb) : 15.0f * tanhf(gb * (1.0f / 15.0f)); }
            }
        }
        sa = sbnd;
    }
}

__device__ __forceinline__ void phase_r2(const Args& A, const Ctx& C, int l) {
    constexpr int WP = 2064;
    LAS unsigned char* RWB = C.lds;
    LAS float* WL = (LAS float*)(C.lds + 48 * WP);
    LAS unsigned* hist = (LAS unsigned*)(WL + 8 * 16 * 48);
    LAS unsigned* gbase = hist + 32;
    constexpr int RCAP = 144;
    LAS int* rec = (LAS int*)(gbase + 32);
    static_assert(48 * WP + 8 * 16 * 48 * 4 + 256 + RCAP * 16 <= LDS_TAB_END, "R2 LDS map");
    cvt_moe_items(A, C, l, cvt_t2(l, C.G) + C.bid * NW + C.wave, CVT_ITEMS, C.G * NW);
    __syncthreads();
    { const float* wg = A.in[15] + (size_t)l * D * NGRP; const float* wr = A.in[17] + (size_t)l * D * NE;
      { const int kp = C.tid; const f32x4 x0 = *(const f32x4*)(wg + (size_t)(2 * kp) * 4), x1 = *(const f32x4*)(wg + (size_t)(2 * kp + 1) * 4);
        *(LAS unsigned*)(RWB + 0 * WP + kp * 4) = cvt2(x0.x, x1.x); *(LAS unsigned*)(RWB + 1 * WP + kp * 4) = cvt2(x0.y, x1.y);
        *(LAS unsigned*)(RWB + 2 * WP + kp * 4) = cvt2(x0.z, x1.z); *(LAS unsigned*)(RWB + 3 * WP + kp * 4) = cvt2(x0.w, x1.w); }
      f32x4 t0[8], t1[8];
#pragma unroll
      for (int jj = 0; jj < 8; ++jj) { const int it = C.tid + NT * jj, kp = it >> 3, cg = it & 7; t0[jj] = *(const f32x4*)(wr + (size_t)(2 * kp) * NE + 4 * cg); t1[jj] = *(const f32x4*)(wr + (size_t)(2 * kp + 1) * NE + 4 * cg); }
#pragma unroll
      for (int jj = 0; jj < 8; ++jj) { const int it = C.tid + NT * jj, kp = it >> 3, c0 = 4 + 4 * (it & 7);
          *(LAS unsigned*)(RWB + (c0 + 0) * WP + kp * 4) = cvt2(t0[jj].x, t1[jj].x); *(LAS unsigned*)(RWB + (c0 + 1) * WP + kp * 4) = cvt2(t0[jj].y, t1[jj].y);
          *(LAS unsigned*)(RWB + (c0 + 2) * WP + kp * 4) = cvt2(t0[jj].z, t1[jj].z); *(LAS unsigned*)(RWB + (c0 + 3) * WP + kp * 4) = cvt2(t0[jj].w, t1[jj].w); }
      for (int i = C.tid; i < 12 * 512; i += NT) *(LAS unsigned*)(RWB + (36 + i / 512) * WP + (i % 512) * 4) = 0u; }
    const int nrows = (l <= 1) ? NR : NL;
    bf16* LAT = (bf16*)(A.ws + WS_LAT); bf16* H = (bf16*)(A.ws + WS_HB); unsigned char* H8 = A.ws + WS_H8;
    const float* MOD = (const float*)(A.ws + WS_MOD);
    unsigned* cnt = (unsigned*)(A.ws + WS_CTL) + CW_CNT + l * 32 * CNT_STRIDE;
    int* TS = (int*)(A.ws + WS_TOKSLOT); float* TW = (float*)(A.ws + WS_TOKW); int* ST = (int*)(A.ws + WS_SLOTTOK);
    const int rpw = (((nrows + C.G - 1) / C.G) + 1) & ~1; const int wrow0 = C.bid * rpw; const int wend0 = min(wrow0 + rpw, nrows);
    const float* bg = A.in[16] + l * NGRP; const float* br = A.in[18] + l * NE;
    for (int cb = wrow0; cb < wend0; cb += RCAP) {
        const int wend = min(cb + RCAP, wend0);
        if (C.tid < 32) hist[C.tid] = 0u;
        for (int sa = cb; sa < wend;) {
            const int mvi = mod_vec_of_row(sa); const int bnd = mvi == 0 ? SEQ : (mvi == 1 ? NL : NR); const int sbnd = min(wend, bnd);
            RowVec RV; { const float* mv = MOD + (size_t)(l * 3 + mvi) * 6 * D; load_rowvec(RV, A.in[6] + (size_t)(l * 2 + 1) * D, mv + 3 * D, mv + 4 * D, mv + 2 * D, C.lane); }
            const int rlast = sbnd - 2;
            u32x2 la[4], lb[4], ya[4], yb[4];
            { const int r0 = min(sa + 2 * C.wave, rlast); load_row_bf16raw(LAT + (size_t)r0 * D, C.lane, la); load_row_bf16raw(LAT + (size_t)(r0 + 1) * D, C.lane, lb);
              load_row_bf16raw(H + (size_t)r0 * D, C.lane, ya); load_row_bf16raw(H + (size_t)(r0 + 1) * D, C.lane, yb); }
            for (int ra = sa + 2 * C.wave; ra < sbnd; ra += 2 * NW) {
                const int rb = ra + 1;
                u32x2 lan[4], lbn[4], yan[4], ybn[4];
                { const int r1 = min(ra + 2 * NW, rlast); load_row_bf16raw(LAT + (size_t)r1 * D, C.lane, lan); load_row_bf16raw(LAT + (size_t)(r1 + 1) * D, C.lane, lbn);
                  load_row_bf16raw(H + (size_t)r1 * D, C.lane, yan); load_row_bf16raw(H + (size_t)(r1 + 1) * D, C.lane, ybn); }
                f32x4 va[4], vb[4];
#pragma unroll
                for (int q = 0; q < 4; ++q) { va[q] = bf4(la[q]) + RV.g[q] * bf4(ya[q]); vb[q] = bf4(lb[q]) + RV.g[q] * bf4(yb[q]); }
                store_row_bf16(LAT + (size_t)ra * D, C.lane, va); store_row_bf16(LAT + (size_t)rb * D, C.lane, vb);
                const float rra = row_rstd(va), rrb = row_rstd(vb);
                f32x4 ha[4], hb[4];
#pragma unroll
                for (int q = 0; q < 4; ++q) { ha[q] = (va[q] * rra) * RV.a[q] + RV.s[q]; hb[q] = (vb[q] * rrb) * RV.a[q] + RV.s[q]; }
                store_row_bf16(H + (size_t)ra * D, C.lane, ha); store_row_bf16(H + (size_t)rb * D, C.lane, hb);
                store_row_fp8(H8 + (size_t)ra * D, C.lane, ha); store_row_fp8(H8 + (size_t)rb * D, C.lane, hb);
#pragma unroll
                for (int q = 0; q < 4; ++q) { la[q] = lan[q]; lb[q] = lbn[q]; ya[q] = yan[q]; yb[q] = ybn[q]; }
            }
            sa = sbnd;
        }
        __syncthreads();
        const int fr = C.lane & 15, fq = C.lane >> 4;
        for (int t = C.wave; t * 16 < wend - cb; t += NW) {
            const int trow = min(cb + 16 * t + fr, wend - 1);
            const bf16* hp = H + (size_t)trow * D + 8 * fq;
            f32x4 acc[3];
#pragma unroll
            for (int ct = 0; ct < 3; ++ct) acc[ct] = (f32x4){0.f, 0.f, 0.f, 0.f};
#pragma unroll 1
            for (int kb = 0; kb < 4; ++kb) {
                bf16x8 av[8];
#pragma unroll
                for (int k8 = 0; k8 < 8; ++k8) av[k8] = *(const bf16x8*)(hp + 32 * (8 * kb + k8));
#pragma unroll
                for (int k8 = 0; k8 < 8; ++k8)
#pragma unroll
                    for (int ct = 0; ct < 3; ++ct) { const bf16x8 bv = *(const LAS bf16x8*)(RWB + (ct * 16 + fr) * WP + (32 * (8 * kb + k8) + 8 * fq) * 2);
                        acc[ct] = __builtin_amdgcn_mfma_f32_16x16x32_bf16(av[k8], bv, acc[ct], 0, 0, 0); }
            }
            LAS float* wl = WL + C.wave * 16 * 48;
#pragma unroll
            for (int ct = 0; ct < 3; ++ct)
#pragma unroll
                for (int jq = 0; jq < 4; ++jq) wl[(4 * fq + jq) * 48 + ct * 16 + fr] = acc[ct][jq];
            asm volatile("s_waitcnt lgkmcnt(0)" ::: "memory");
            const int row = cb + 16 * t + C.lane;
            if (C.lane < 16 && row < wend) {
                LAS const float* wm = wl + C.lane * 48;
                float lg[36];
#pragma unroll
                for (int c = 0; c < 36; ++c) lg[c] = wm[c];
                float gl[4]; int grp = 0; float gm = -3.0e38f;
#pragma unroll
                for (int c = 0; c < 4; ++c) { gl[c] = lg[c] + bg[c]; if (gl[c] > gm) { gm = gl[c]; grp = c; } }
                float gs = 0.f;
#pragma unroll
                for (int c = 0; c < 4; ++c) gs += __expf(gl[c] - gm);
                const float pgrp = 1.0f / gs;
                float rl[8];
#pragma unroll
                for (int i = 0; i < 8; ++i) { float tt = 0.f;
#pragma unroll
                    for (int g = 0; g < 4; ++g) tt = (g == grp) ? lg[4 + g * 8 + i] : tt;
                    rl[i] = tt + br[grp * 8 + i]; }
                int i0 = 0; float m0 = rl[0];
#pragma unroll
                for (int i = 1; i < 8; ++i) if (rl[i] > m0) { m0 = rl[i]; i0 = i; }
                int i1 = -1; float m1 = -3.0e38f;
#pragma unroll
                for (int i = 0; i < 8; ++i) if (i != i0 && rl[i] > m1) { m1 = rl[i]; i1 = i; }
                const float p0 = 1.0f, p1 = __expf(m1 - m0);
                const float w0 = pgrp * p0 / (p0 + p1), w1 = pgrp * p1 / (p0 + p1);
                const int e0 = grp * 8 + i0, e1 = grp * 8 + i1;
                const unsigned q0 = __hip_atomic_fetch_add(hist + e0, 1u, __ATOMIC_RELAXED, __HIP_MEMORY_SCOPE_WORKGROUP), q1 = __hip_atomic_fetch_add(hist + e1, 1u, __ATOMIC_RELAXED, __HIP_MEMORY_SCOPE_WORKGROUP);
                const int li = row - cb;
                rec[li * 4 + 0] = e0 | (e1 << 8); rec[li * 4 + 1] = (int)q0; rec[li * 4 + 2] = (int)q1;
                TW[row * 2 + 0] = w0; TW[row * 2 + 1] = w1;
            }
        }
        __syncthreads();
        if (C.tid < 32) gbase[C.tid] = hist[C.tid] ? atomicAdd(cnt + C.tid * CNT_STRIDE, hist[C.tid]) : 0u;
        __syncthreads();
        for (int i = C.tid; i < wend - cb; i += NT) { const int row = cb + i; const int ee = rec[i * 4], e0 = ee & 255, e1 = ee >> 8;
            const unsigned q0 = gbase[e0] + (unsigned)rec[i * 4 + 1], q1 = gbase[e1] + (unsigned)rec[i * 4 + 2];
            ST[(size_t)e0 * CAP + q0] = row; ST[(size_t)e1 * CAP + q1] = row;
            TS[row * 2 + 0] = (e0 << 20) | (int)q0; TS[row * 2 + 1] = (e1 << 20) | (int)q1; }
        __syncthreads();
    }
}

__device__ __forceinline__ void phase_final(const Args& A, const Ctx& C) {
    LAS int* sb = (LAS int*)C.lds;
    slot_bases(A, 3, sb, C.tid);
    const bf16* LAT = (const bf16*)(A.ws + WS_LAT); const unsigned char* Y8 = A.ws + WS_PB;
    const int* TS = (const int*)(A.ws + WS_TOKSLOT); const float* TW = (const float*)(A.ws + WS_TOKW);
    const float* MOD = (const float*)(A.ws + WS_MOD);
    f32x4 fg[4]; load_row_f32(A.in[7], C.lane, fg);
    const int rpw = (((NL + C.G - 1) / C.G) + 1) & ~1; const int wrow0 = C.bid * rpw; const int wend = min(wrow0 + rpw, NL);
    for (int sa = wrow0; sa < wend;) {
        const int mvi = mod_vec_of_row(sa); const int sbnd = min(wend, mvi == 0 ? SEQ : NL);
        f32x4 g2[4]; load_row_f32(MOD + (size_t)(3 * 3 + mvi) * 6 * D + 5 * D, C.lane, g2);
        for (int ra = sa + 2 * C.wave; ra < sbnd; ra += 2 * NW) {
            const int rb = ra + 1;
            const int ta0 = TS[ra * 2], ta1 = TS[ra * 2 + 1], tb0 = TS[rb * 2], tb1 = TS[rb * 2 + 1]; const float wa0 = TW[ra * 2], wa1 = TW[ra * 2 + 1], wb0 = TW[rb * 2], wb1 = TW[rb * 2 + 1];
            f32x4 va[4], vb[4]; unsigned ya0[4], ya1[4], yb0[4], yb1[4];
            load_row_bf16(LAT + (size_t)ra * D, C.lane, va); load_row_bf16(LAT + (size_t)rb * D, C.lane, vb);
            load_row_fp8raw(Y8 + (size_t)(sb[ta0 >> 20] + (ta0 & 0xfffff)) * D, C.lane, ya0); load_row_fp8raw(Y8 + (size_t)(sb[ta1 >> 20] + (ta1 & 0xfffff)) * D, C.lane, ya1);
            load_row_fp8raw(Y8 + (size_t)(sb[tb0 >> 20] + (tb0 & 0xfffff)) * D, C.lane, yb0); load_row_fp8raw(Y8 + (size_t)(sb[tb1 >> 20] + (tb1 & 0xfffff)) * D, C.lane, yb1);
#pragma unroll
            for (int q = 0; q < 4; ++q) { va[q] += g2[q] * (fp8x4(ya0[q]) * (wa0 * (1.0f / YSCALE)) + fp8x4(ya1[q]) * (wa1 * (1.0f / YSCALE))); vb[q] += g2[q] * (fp8x4(yb0[q]) * (wb0 * (1.0f / YSCALE)) + fp8x4(yb1[q]) * (wb1 * (1.0f / YSCALE))); }
            const float rra = row_rstd(va), rrb = row_rstd(vb);
#pragma unroll
            for (int q = 0; q < 4; ++q) { *(f32x4*)(A.out + (size_t)ra * D + 4 * C.lane + 256 * q) = (va[q] * rra) * fg[q]; *(f32x4*)(A.out + (size_t)rb * D + 4 * C.lane + 256 * q) = (vb[q] * rrb) * fg[q]; }
        }
        sa = sbnd;
    }
}

__device__ __forceinline__ void phase_conv(const Args& A, const Ctx& C, int l) {
    const int j = l >> 1; const int nrows = (l <= 1) ? NR : NL;
    const bf16* P = (const bf16*)(A.ws + WS_PB); unsigned char* HM = A.ws + WS_HM;
    const float* cw = A.in[13] + (size_t)j * 3 * D;
    f32x4 w0[4], w1[4], w2[4];
    load_row_f32(cw, C.lane, w0); load_row_f32(cw + D, C.lane, w1); load_row_f32(cw + 2 * D, C.lane, w2);
    const int rpw = (((nrows + C.G - 1) / C.G) + 1) & ~1; const int wrow0 = C.bid * rpw; const int wend = min(wrow0 + rpw, nrows);
    for (int ra = wrow0 + 2 * C.wave; ra < wend; ra += 2 * NW) {
        const int rb = ra + 1;
        const int ta = ra < NL ? (ra & 63) : ((ra - NL) & 255), tb1 = rb < NL ? (rb & 63) : ((rb - NL) & 255), tlast = ra < NL ? 63 : 255;
        const bool hasl = ta != 0, hasr = tb1 != tlast;
        const bf16* pa = P + (size_t)ra * PW;
        u32x2 bga[4], bgb[4], zm[4], z0[4], z1[4], z2[4];
        load_row_bf16raw(pa, C.lane, bga); load_row_bf16raw(pa + PW, C.lane, bgb);
        load_row_bf16raw(pa + D, C.lane, z0); load_row_bf16raw(pa + PW + D, C.lane, z1);
        load_row_bf16raw(hasl ? pa - PW + D : pa + D, C.lane, zm); load_row_bf16raw(hasr ? pa + 2 * PW + D : pa + D, C.lane, z2);
        const float fl = hasl ? 1.f : 0.f, fr = hasr ? 1.f : 0.f;
        f32x4 oa[4], ob[4];
#pragma unroll
        for (int q = 0; q < 4; ++q) { const f32x4 a0 = bf4(z0[q]), a1 = bf4(z1[q]);
            oa[q] = bf4(bga[q]) * (w0[q] * (bf4(zm[q]) * fl) + w1[q] * a0 + w2[q] * a1);
            ob[q] = bf4(bgb[q]) * (w0[q] * a0 + w1[q] * a1 + w2[q] * (bf4(z2[q]) * fr)); }
        store_row_fp8(HM + (size_t)ra * D, C.lane, oa); store_row_fp8(HM + (size_t)rb * D, C.lane, ob);
    }
}

constexpr int BM = 256, BK = 64, HALF = 128, HTB = HALF * BK * 2, STAGE_BYTES = 8 * HTB, NXCD = 8, WGM = 8;
constexpr int LDS_TAB = STAGE_BYTES;
__device__ __forceinline__ int lds_byte(int r, int c) { const int st = (r >> 4) * 2 + (c >> 5), rr = r & 15, cc = c & 31, ob = rr * 64 + cc * 2; return st * 1024 + (ob ^ (((ob >> 9) & 1) << 5)); }
__device__ __forceinline__ void stage_rc(int b, int& R, int& C) { const int st = b / 1024, sb = b % 1024, swz = sb ^ (((sb >> 9) & 1) << 5); R = (st >> 1) * 16 + swz / 64; C = (st & 1) * 32 + (swz % 64) / 2; }
__device__ __forceinline__ int perm32(int rho) { const int n = rho >> 4, i = rho & 15; return 8 * (i >> 2) + 4 * n + (i & 3); }
__device__ __forceinline__ unsigned cvt_pk_bf16(float lo, float hi) { unsigned r; asm volatile("v_cvt_pk_bf16_f32 %0, %1, %2" : "=v"(r) : "v"(lo), "v"(hi)); return r; }

struct GUnit { const char* a; const char* b; int orow, ocol, aux; };

typedef int i32x8 __attribute__((ext_vector_type(8)));
typedef int i32x4 __attribute__((ext_vector_type(4)));
template <class Epi, class Sched, bool GATHER, bool FP8 = false>
__device__ __forceinline__ void gemm_phase(LAS unsigned char* lds, const int K, const Sched& S, const Epi& E) {
    const int tid = threadIdx.x, wid = __builtin_amdgcn_readfirstlane(tid >> 6), lane = tid & 63, wr = wid >> 2, wc = wid & 3, fr = lane & 15, fq = lane >> 4;
    const int RB = FP8 ? K : 2 * K;
    const int nt = RB / (BK * 2);
    unsigned voffB[2], voA[2][2]; int Rr[2], Cc[2];
#pragma unroll
    for (int i = 0; i < 2; ++i) { int R, C; stage_rc(tid * 16 + i * 8192, R, C); const int Rb = (R & ~31) + perm32(R & 31); Rr[i] = R; Cc[i] = C;
        voffB[i] = (unsigned)(Rb * RB + C * 2);
        voA[0][i] = (unsigned)(R * RB + C * 2); voA[1][i] = (unsigned)((R + HALF) * RB + C * 2); }
    const size_t kstep = (size_t)(BK * 2);
    const size_t hstep = (size_t)HALF * RB;
    const unsigned ldsw = (unsigned)wid * 1024u;
    const unsigned ldsbase = (unsigned)(size_t)lds;
    const int aoff = lds_byte(wr * 64 + fr, fq * 8), boff = lds_byte(wc * 32 + fr, fq * 8);
#define PG8_SA(b, h) (((b) * 2 + (h)) * HTB)
#define PG8_SB(b, h) ((4 + (b) * 2 + (h)) * HTB)
#define PG8_STAGE(bufoff, gbase, voff) do { _Pragma("unroll") for (int _i = 0; _i < 2; ++_i) \
        asm volatile("s_mov_b32 m0, %2\n\ts_nop 0\n\tglobal_load_lds_dwordx4 %0, %1" :: "v"((voff)[_i]), "s"((const char*)(gbase)), "s"(ldsbase + (unsigned)(bufoff) + ldsw + (unsigned)(_i * 8192)) : "memory"); } while (0)
#define PG8_STAGE_A1(bufoff, gbase) do { if constexpr (GATHER) PG8_STAGE(bufoff, gbase, voA[1]); else PG8_STAGE(bufoff, (const char*)(gbase) + hstep, voA[0]); } while (0)
#define PG8_LDA(dst, b, h) do { if constexpr (FP8) { _Pragma("unroll") for (int m = 0; m < 4; ++m) { \
        const i32x4 _lo = *(const LAS i32x4*)(lds + PG8_SA(b, h) + aoff + m * 2048), _hi = *(const LAS i32x4*)(lds + PG8_SA(b, h) + aoff + m * 2048 + 1024); \
        dst##8[m] = __builtin_shufflevector(_lo, _hi, 0, 1, 2, 3, 4, 5, 6, 7); } } \
      else { _Pragma("unroll") for (int m = 0; m < 4; ++m) _Pragma("unroll") for (int k = 0; k < 2; ++k) dst[m][k] = *(const LAS bf16x8*)(lds + PG8_SA(b, h) + aoff + m * 2048 + k * 1024); } } while (0)
#define PG8_LDB(dst, b, h) do { if constexpr (FP8) { _Pragma("unroll") for (int n = 0; n < 2; ++n) { \
        const i32x4 _lo = *(const LAS i32x4*)(lds + PG8_SB(b, h) + boff + n * 2048), _hi = *(const LAS i32x4*)(lds + PG8_SB(b, h) + boff + n * 2048 + 1024); \
        dst##8[n] = __builtin_shufflevector(_lo, _hi, 0, 1, 2, 3, 4, 5, 6, 7); } } \
      else { _Pragma("unroll") for (int n = 0; n < 2; ++n) _Pragma("unroll") for (int k = 0; k < 2; ++k) dst[n][k] = *(const LAS bf16x8*)(lds + PG8_SB(b, h) + boff + n * 2048 + k * 1024); } } while (0)
#define PG8_MMA(ai, bj, At, Bt) do { __builtin_amdgcn_s_setprio(1); \
        if constexpr (FP8) { _Pragma("unroll") for (int m = 0; m < 4; ++m) _Pragma("unroll") for (int n = 0; n < 2; ++n) \
            acc[ai][bj][m][n] = __builtin_amdgcn_mfma_scale_f32_16x16x128_f8f6f4(Bt##8[n], At##8[m], acc[ai][bj][m][n], 0, 0, 0, 0x7f7f7f7f, 0, 0x7f7f7f7f); } \
        else { _Pragma("unroll") for (int m = 0; m < 4; ++m) _Pragma("unroll") for (int n = 0; n < 2; ++n) _Pragma("unroll") for (int k = 0; k < 2; ++k) \
            acc[ai][bj][m][n] = __builtin_amdgcn_mfma_f32_16x16x32_bf16(Bt[n][k], At[m][k], acc[ai][bj][m][n], 0, 0, 0); } \
        __builtin_amdgcn_s_setprio(0); } while (0)
#define PG8_WAIT_V(n) asm volatile("s_waitcnt vmcnt(" #n ")" ::: "memory")
#define PG8_WAIT_L(n) asm volatile("s_waitcnt lgkmcnt(" #n ")" ::: "memory")
#define PG8_BAR __builtin_amdgcn_s_barrier()
#define PG8_SCHED __builtin_amdgcn_sched_barrier(0)
    GUnit cur, nxt; int ui = 0;
    if (!S.next(0, cur)) return;
    if constexpr (GATHER) {
#pragma unroll
        for (int h = 0; h < 2; ++h)
#pragma unroll
            for (int i = 0; i < 2; ++i) voA[h][i] = S.arow_off(0, h * HALF + Rr[i]) + (unsigned)Cc[i] * 2u;
    }
    f32x4 acc[2][2][4][2];
#pragma unroll
    for (int a = 0; a < 2; ++a)
#pragma unroll
        for (int b = 0; b < 2; ++b)
#pragma unroll
            for (int m = 0; m < 4; ++m)
#pragma unroll
                for (int n = 0; n < 2; ++n) acc[a][b][m][n] = (f32x4){0.f, 0.f, 0.f, 0.f};
    bf16x8 At[4][2], B0[2][2], B1[2][2]; i32x8 At8[4], B08[2], B18[2];
    const char* cA = cur.a; const char* cB = cur.b;
    PG8_STAGE(PG8_SB(0, 0), cB, voffB); PG8_STAGE(PG8_SB(0, 1), cB + hstep, voffB); PG8_STAGE(PG8_SA(0, 0), cA, voA[0]); PG8_STAGE_A1(PG8_SA(0, 1), cA);
    if (wr == 1) PG8_BAR;
    PG8_WAIT_V(2); PG8_BAR;
    PG8_STAGE(PG8_SB(1, 0), cB + kstep, voffB); PG8_STAGE(PG8_SA(1, 0), cA + kstep, voA[0]); PG8_STAGE(PG8_SB(1, 1), cB + hstep + kstep, voffB);
    PG8_WAIT_V(6); PG8_BAR;
    for (;;) {
        const bool has_next = S.next(ui + 1, nxt);
        const char* nA = has_next ? nxt.a : cA; const char* nB = has_next ? nxt.b : cB;
#pragma unroll 1
        for (int t = 0; t < nt; t += 2) {
            const bool last = (t == nt - 2);
            const char* a1 = cA + (size_t)(t + 1) * kstep;
            const char* a2 = last ? nA : cA + (size_t)(t + 2) * kstep; const char* b2 = last ? nB : cB + (size_t)(t + 2) * kstep;
            const char* a3 = a2 + kstep; const char* b3 = b2 + kstep;
            PG8_LDB(B0, 0, 0); PG8_LDB(B1, 0, 1); PG8_SCHED; PG8_LDA(At, 0, 0); PG8_STAGE_A1(PG8_SA(1, 1), a1);
            if constexpr (GATHER) { if (last && has_next) {
#pragma unroll
                for (int h = 0; h < 2; ++h)
#pragma unroll
                    for (int i = 0; i < 2; ++i) { int R2, C2; stage_rc(tid * 16 + i * 8192, R2, C2); voA[h][i] = S.arow_off(ui + 1, h * HALF + R2) + (unsigned)C2 * 2u; } } }
            PG8_WAIT_V(8); PG8_WAIT_L(0); PG8_BAR; PG8_MMA(0, 0, At, B0); PG8_MMA(0, 1, At, B1); PG8_BAR; PG8_SCHED;
            PG8_LDA(At, 0, 1); PG8_STAGE(PG8_SB(0, 0), b2, voffB); PG8_STAGE(PG8_SB(0, 1), b2 + hstep, voffB); PG8_STAGE(PG8_SA(0, 0), a2, voA[0]);
            PG8_WAIT_V(8); PG8_WAIT_L(0); PG8_BAR; PG8_MMA(1, 0, At, B0); PG8_MMA(1, 1, At, B1); PG8_BAR; PG8_SCHED;
            PG8_LDB(B0, 1, 0); PG8_LDB(B1, 1, 1); PG8_SCHED; PG8_LDA(At, 1, 0); PG8_STAGE_A1(PG8_SA(0, 1), a2);
            PG8_WAIT_V(8); PG8_WAIT_L(0); PG8_BAR; PG8_MMA(0, 0, At, B0); PG8_MMA(0, 1, At, B1); PG8_BAR; PG8_SCHED;
            PG8_LDA(At, 1, 1); PG8_STAGE(PG8_SB(1, 0), b3, voffB); PG8_STAGE(PG8_SB(1, 1), b3 + hstep, voffB); PG8_STAGE(PG8_SA(1, 0), a3, voA[0]);
            PG8_WAIT_V(8); PG8_WAIT_L(0); PG8_BAR; PG8_MMA(1, 0, At, B0); PG8_MMA(1, 1, At, B1); PG8_BAR; PG8_SCHED;
        }
        if (wr == 0) PG8_BAR;
        { int tz = threadIdx.x; asm volatile("" : "+v"(tz));
          const int wz = tz >> 6, lz = tz & 63; E(acc, cur, wz >> 2, wz & 3, lz & 15, lz >> 4); }
        if (!has_next) break;
#pragma unroll
        for (int a = 0; a < 2; ++a)
#pragma unroll
            for (int b = 0; b < 2; ++b)
#pragma unroll
                for (int m = 0; m < 4; ++m)
#pragma unroll
                    for (int n = 0; n < 2; ++n) acc[a][b][m][n] = (f32x4){0.f, 0.f, 0.f, 0.f};
        cur = nxt; cA = nA; cB = nB; ++ui;
        if (wr == 1) PG8_BAR;
    }
    PG8_WAIT_V(0);
    PG8_BAR;
#undef PG8_SA
#undef PG8_SB
#undef PG8_STAGE
#undef PG8_STAGE_A1
#undef PG8_LDA
#undef PG8_LDB
#undef PG8_MMA
#undef PG8_WAIT_V
#undef PG8_WAIT_L
#undef PG8_BAR
#undef PG8_SCHED
}

__device__ __forceinline__ int xcd_remap(int L, int nwg) { const int q = nwg / NXCD, r = nwg % NXCD, xcd = L % NXCD, off = L / NXCD; return (xcd < r ? xcd * (q + 1) : r * (q + 1) + (xcd - r) * q) + off; }

struct DenseSched {
    const char* A; const char* Bt; int nM, nN, nwg, G, c; size_t tstep; int sw_lo, sw_hi;
    __device__ __forceinline__ void init(const void* A_, const void* Bt_, int M, int N, int K, int G_, int c_, int ebytes = 2) { A = (const char*)A_; Bt = (const char*)Bt_; nM = M / BM; nN = N / BM; nwg = nM * nN; G = G_; c = c_; tstep = (size_t)BM * K * ebytes; sw_lo = 0; sw_hi = 0; }
    __device__ __forceinline__ bool next(int i, GUnit& u) const {
        const long L = (long)i * G + c; if (L >= nwg) return false;
        const int wgid = xcd_remap((int)L, nwg);
        const int nig = WGM * nN, gid = wgid / nig, fm = gid * WGM, gsz = (nM - fm) < WGM ? (nM - fm) : WGM;
        const int pm = fm + ((wgid % nig) % gsz), pn = (wgid % nig) / gsz;
        if (pn >= sw_lo && pn < sw_hi) { u.a = Bt + (size_t)pn * tstep; u.b = A + (size_t)pm * tstep; u.orow = pm; u.ocol = pn - sw_lo; u.aux = 1; }
        else { u.a = A + (size_t)pm * tstep; u.b = Bt + (size_t)pn * tstep; u.orow = pm * BM; u.ocol = pn * BM; u.aux = 0; }
        return true;
    }
    __device__ __forceinline__ unsigned arow_off(int, int) const { return 0u; }
};

constexpr int MAXU = 12;
struct MoeTab { int n; int e[MAXU], mb[MAXU], nt[MAXU]; int sb[NE + 1]; };
struct MoeSched {
    LAS const MoeTab* T; LAS const unsigned* ridx;
    const char* A; const char* W; size_t wstride_e, tstepB; int K; int arow_bytes;
    __device__ __forceinline__ bool next(int i, GUnit& u) const {
        const int n = __builtin_amdgcn_readfirstlane(T->n); if (i >= n) return false;
        const int e = __builtin_amdgcn_readfirstlane(T->e[i]), mb = __builtin_amdgcn_readfirstlane(T->mb[i]), nt = __builtin_amdgcn_readfirstlane(T->nt[i]);
        const int base = __builtin_amdgcn_readfirstlane(T->sb[e]);
        u.orow = base + mb * BM; u.ocol = nt; u.aux = e;
        u.a = A + (size_t)u.orow * arow_bytes;
        u.b = W + (size_t)e * wstride_e + (size_t)nt * tstepB; return true;
    }
    __device__ __forceinline__ unsigned arow_off(int i, int r) const { return ridx[i * 256 + r]; }
};
template <bool GATHER>
__device__ __forceinline__ void moe_tables(const Args& A, const Ctx& C, int l, int ntile_n, LAS MoeTab* T, LAS unsigned* ridx, int arow_bytes) {
    const unsigned* cnt = (const unsigned*)(A.ws + WS_CTL) + CW_CNT + l * 32 * CNT_STRIDE;
    LAS int* ust = (LAS int*)(T + 1);
    if (C.tid < 64) { int nb; const int ex = expert_block_prefix(cnt, C.tid, nb); if (C.tid <= NE) { T->sb[C.tid] = ex * 256; ust[C.tid] = ex * ntile_n; } }
    __syncthreads();
    if (C.tid < MAXU) { const int nwg = ust[NE]; const long L = (long)C.tid * C.G + C.bid;
        if (L < nwg) { const int w = xcd_remap((int)L, nwg); int e = 0; while (w >= ust[e + 1]) ++e;
            const int lu = w - ust[e]; T->e[C.tid] = e; T->mb[C.tid] = lu / ntile_n; T->nt[C.tid] = lu % ntile_n; } }
    if (C.tid == 0) { const int nwg = ust[NE]; int n = 0; while (n < MAXU && (long)n * C.G + C.bid < nwg) ++n; T->n = n; }
    __syncthreads();
    if constexpr (GATHER) {
        const int* ST = (const int*)(A.ws + WS_SLOTTOK); const int n = T->n;
        for (int i = C.tid; i < n * 256; i += NT) { const int ui = i >> 8, r = i & 255, e = T->e[ui], m0 = T->mb[ui] * 256, ce = (int)cnt[e * CNT_STRIDE];
            const int rr = (m0 + r < ce) ? m0 + r : ce - 1;
            ridx[i] = (unsigned)ST[(size_t)e * CAP + rr] * (unsigned)arow_bytes; }
        __syncthreads();
    }
}

struct EpiStore { bf16* O; int ldc; float scale_lo; int sig_from; bf16* VT; float sall = 1.0f;
    __device__ __forceinline__ void operator()(const f32x4 (&acc)[2][2][4][2], const GUnit& u, int wr, int wc, int fr, int fq) const {
        const bool tr = u.aux != 0;
        const float sc = ((!tr && u.ocol < NQ) ? scale_lo : 1.0f) * sall; const bool sg = !tr && u.ocol >= sig_from;
        bf16* Ob = tr ? VT + (size_t)(u.orow * NH + u.ocol) * 65536 : O + (size_t)u.orow * ldc + u.ocol; const int ld = tr ? 256 : ldc;
#pragma unroll
        for (int ai = 0; ai < 2; ++ai)
#pragma unroll
            for (int m = 0; m < 4; ++m) { bf16* rowp = Ob + (size_t)(ai * HALF + wr * 64 + m * 16 + fr) * ld + wc * 32 + 8 * fq;
#pragma unroll
                for (int bj = 0; bj < 2; ++bj) { f32x4 v0 = acc[ai][bj][m][0] * sc, v1 = acc[ai][bj][m][1] * sc;
                    if (sg) {
#pragma unroll
                        for (int q = 0; q < 4; ++q) { v0[q] = __builtin_amdgcn_rcpf(1.0f + __expf(-v0[q])); v1[q] = __builtin_amdgcn_rcpf(1.0f + __expf(-v1[q])); } }
                    u32x4 w; w.x = cvt_pk_bf16(v0[0], v0[1]); w.y = cvt_pk_bf16(v0[2], v0[3]); w.z = cvt_pk_bf16(v1[0], v1[1]); w.w = cvt_pk_bf16(v1[2], v1[3]);
                    *(u32x4*)(rowp + bj * HALF) = w; } }
    }
};
__device__ __forceinline__ u32x2 cvt8_fp8(f32x4 a, f32x4 b) { int lo = 0, hi = 0;
    lo = __builtin_amdgcn_cvt_pk_fp8_f32(a[0], a[1], lo, false); lo = __builtin_amdgcn_cvt_pk_fp8_f32(a[2], a[3], lo, true);
    hi = __builtin_amdgcn_cvt_pk_fp8_f32(b[0], b[1], hi, false); hi = __builtin_amdgcn_cvt_pk_fp8_f32(b[2], b[3], hi, true); return (u32x2){(unsigned)lo, (unsigned)hi}; }
struct EpiSwigluF8 { unsigned char* O; int ldc; float s;
    __device__ __forceinline__ void operator()(const f32x4 (&acc)[2][2][4][2], const GUnit& u, int wr, int wc, int fr, int fq) const {
        const int ocol = u.ocol * HALF;
#pragma unroll
        for (int ai = 0; ai < 2; ++ai)
#pragma unroll
            for (int m = 0; m < 4; ++m) { unsigned char* rowp = O + (size_t)(u.orow + ai * HALF + wr * 64 + m * 16 + fr) * ldc + ocol + wc * 32 + 8 * fq;
                f32x4 v0, v1;
#pragma unroll
                for (int q = 0; q < 4; ++q) { const float x0 = acc[ai][0][m][0][q] * s, x1 = acc[ai][0][m][1][q] * s;
                    v0[q] = x0 * __builtin_amdgcn_rcpf(1.0f + __expf(-x0)) * (acc[ai][1][m][0][q] * s); v1[q] = x1 * __builtin_amdgcn_rcpf(1.0f + __expf(-x1)) * (acc[ai][1][m][1][q] * s); }
                *(u32x2*)rowp = cvt8_fp8(v0, v1); }
    }
};
template <int MODE> struct EpiPair { bf16* O; int ldc; int plain_below;
    __device__ __forceinline__ void operator()(const f32x4 (&acc)[2][2][4][2], const GUnit& u, int wr, int wc, int fr, int fq) const {
        if (MODE == 0 && u.ocol < plain_below) {
#pragma unroll
            for (int ai = 0; ai < 2; ++ai)
#pragma unroll
                for (int m = 0; m < 4; ++m) { bf16* rowp = O + (size_t)(u.orow + ai * HALF + wr * 64 + m * 16 + fr) * ldc + u.ocol + wc * 32 + 8 * fq;
#pragma unroll
                    for (int bj = 0; bj < 2; ++bj) { const f32x4 v0 = acc[ai][bj][m][0], v1 = acc[ai][bj][m][1];
                        u32x4 w; w.x = cvt_pk_bf16(v0[0], v0[1]); w.y = cvt_pk_bf16(v0[2], v0[3]); w.z = cvt_pk_bf16(v1[0], v1[1]); w.w = cvt_pk_bf16(v1[2], v1[3]);
                        *(u32x4*)(rowp + bj * HALF) = w; } }
            return;
        }
        const int ocol = (MODE == 0) ? plain_below + (u.ocol - plain_below) / 2 : u.ocol * HALF;
#pragma unroll
        for (int ai = 0; ai < 2; ++ai)
#pragma unroll
            for (int m = 0; m < 4; ++m) { bf16* rowp = O + (size_t)(u.orow + ai * HALF + wr * 64 + m * 16 + fr) * ldc + ocol + wc * 32 + 8 * fq;
                f32x4 v0, v1;
#pragma unroll
                for (int q = 0; q < 4; ++q) {
                    const float x0 = acc[ai][0][m][0][q], x1 = acc[ai][0][m][1][q];
                    const float g0 = (MODE == 1) ? x0 * __builtin_amdgcn_rcpf(1.0f + __expf(-x0)) : x0, g1 = (MODE == 1) ? x1 * __builtin_amdgcn_rcpf(1.0f + __expf(-x1)) : x1;
                    v0[q] = g0 * acc[ai][1][m][0][q]; v1[q] = g1 * acc[ai][1][m][1][q]; }
                u32x4 w; w.x = cvt_pk_bf16(v0[0], v0[1]); w.y = cvt_pk_bf16(v0[2], v0[3]); w.z = cvt_pk_bf16(v1[0], v1[1]); w.w = cvt_pk_bf16(v1[2], v1[3]);
                *(u32x4*)rowp = w; }
    }
};
struct EpiStoreTile { unsigned char* O; int ldc; float s;
    __device__ __forceinline__ void operator()(const f32x4 (&acc)[2][2][4][2], const GUnit& u, int wr, int wc, int fr, int fq) const {
#pragma unroll
        for (int ai = 0; ai < 2; ++ai)
#pragma unroll
            for (int m = 0; m < 4; ++m) { unsigned char* rowp = O + (size_t)(u.orow + ai * HALF + wr * 64 + m * 16 + fr) * ldc + u.ocol * BM + wc * 32 + 8 * fq;
#pragma unroll
                for (int bj = 0; bj < 2; ++bj) *(u32x2*)(rowp + bj * HALF) = cvt8_fp8(acc[ai][bj][m][0] * s, acc[ai][bj][m][1] * s); }
    }
};

__device__ __forceinline__ void transpose_item(const float* W, int ldw, int K, bf16* WT, int drow0, int k0, int n0, LAS float* scr, int lane) {
#pragma unroll
    for (int i = 0; i < 32; ++i) { const int kk = 2 * i + (lane >> 5); scr[kk * 33 + (lane & 31)] = W[(size_t)(k0 + kk) * ldw + n0 + (lane & 31)]; }
    asm volatile("s_waitcnt lgkmcnt(0)" ::: "memory");
    const int c = lane & 7;
#pragma unroll
    for (int j = 0; j < 4; ++j) { const int n = (lane >> 3) + 8 * j; const LAS float* s = scr + (8 * c) * 33 + n;
        u32x4 o; o.x = pk2(s[0 * 33], s[1 * 33]); o.y = pk2(s[2 * 33], s[3 * 33]); o.z = pk2(s[4 * 33], s[5 * 33]); o.w = pk2(s[6 * 33], s[7 * 33]);
        *(u32x4*)(WT + (size_t)(drow0 + n) * K + k0 + 8 * c) = o; }
    asm volatile("s_waitcnt lgkmcnt(0)" ::: "memory");
}
__device__ __forceinline__ void transpose_item_fp8(const float* W, int ldw, int K, unsigned char* WT8, int drow0, int k0, int n0, LAS float* scr, int lane, float sc) {
#pragma unroll
    for (int i = 0; i < 32; ++i) { const int kk = 2 * i + (lane >> 5); scr[kk * 33 + (lane & 31)] = W[(size_t)(k0 + kk) * ldw + n0 + (lane & 31)]; }
    asm volatile("s_waitcnt lgkmcnt(0)" ::: "memory");
    const int n = lane >> 1, half = lane & 1; const LAS float* sp = scr + (32 * half) * 33 + n;
    unsigned char* dst = WT8 + (size_t)(drow0 + n) * K + k0 + 32 * half;
#pragma unroll
    for (int c = 0; c < 2; ++c) { u32x4 o;
#pragma unroll
        for (int q = 0; q < 4; ++q) { int p = 0; const LAS float* s4 = sp + (16 * c + 4 * q) * 33;
            p = __builtin_amdgcn_cvt_pk_fp8_f32(s4[0] * sc, s4[33] * sc, p, false); p = __builtin_amdgcn_cvt_pk_fp8_f32(s4[66] * sc, s4[99] * sc, p, true); o[q] = (unsigned)p; }
        *(u32x4*)(dst + 16 * c) = o; }
    asm volatile("s_waitcnt lgkmcnt(0)" ::: "memory");
}
__device__ __forceinline__ int pair_row(int n, int which) { return (n >> 7) * 256 + (n & 127) + which * 128; }
__device__ __forceinline__ void phase_cvt_mixer(const Args& A, const Ctx& C) {
    LAS float* scr = (LAS float*)(C.lds + 16384 + C.wave * 16384);
    const int gw = C.bid * NW + C.wave, NGW = C.G * NW;
    constexpr int I_IN = (D / 64) * (PW / 32), I_OUT = (D / 64) * (D / 32), PER = 2 * (I_IN + I_OUT);
    for (int it = gw; it < 2 * PER; it += NGW) {
        const int kind = it / PER; int r = it % PER; const int j = r / (I_IN + I_OUT); r %= (I_IN + I_OUT);
        if (r < I_IN) { const int kb = r / (PW / 32), nb = r % (PW / 32), n0 = nb * 32;
            bf16* WT = (bf16*)(A.ws + (kind == 0 ? WS_WAIN : WS_WBIN)) + (size_t)j * PW * D;
            if (kind == 0) transpose_item(A.in[8] + (size_t)j * D * PROJ, PROJ, D, WT, n0, kb * 64, n0, scr, C.lane);
            else { const int drow = n0 < D ? n0 : (n0 < 2 * D ? D + pair_row(n0 - D, 0) : D + pair_row(n0 - 2 * D, 1));
                transpose_item(A.in[12] + (size_t)j * D * PW, PW, D, WT, drow, kb * 64, n0, scr, C.lane); } }
        else { r -= I_IN; const int kb = r / (D / 32), nb = r % (D / 32), n0 = nb * 32;
            unsigned char* WT = A.ws + (kind == 0 ? WS_WAOUT : WS_WBOUT) + (size_t)j * D * D;
            transpose_item_fp8((kind == 0 ? A.in[11] : A.in[14]) + (size_t)j * D * D, D, D, WT, n0, kb * 64, n0, scr, C.lane, WSCALE); }
    }
}
__device__ __forceinline__ void cvt_moe_items(const Args& A, const Ctx& C, int l, int it0, int end, int stride) {
    LAS float* scr = (LAS float*)(C.lds + 16384 + C.wave * 16384);
    unsigned char* WGU = A.ws + WS_WGU; unsigned char* WDN = A.ws + WS_WDN;
    for (int it = it0; it < end; it += stride) {
        const int e = it / CVT_PER; int r = it % CVT_PER;
        if (r < 2 * CVT_IG) { const int which = r / CVT_IG; r %= CVT_IG; const int kb = r / (DE / 32), nb = r % (DE / 32), n0 = nb * 32;
            transpose_item_fp8((which == 0 ? A.in[19] : A.in[20]) + ((size_t)l * NE + e) * D * DE, DE, D, WGU + (size_t)e * 2 * DE * D, pair_row(n0, which), kb * 64, n0, scr, C.lane, WSCALE); }
        else { r -= 2 * CVT_IG; const int kb = r / (D / 32), nb = r % (D / 32), n0 = nb * 32;
            transpose_item_fp8(A.in[21] + ((size_t)l * NE + e) * DE * D, D, DE, WDN + (size_t)e * D * DE, n0, kb * 64, n0, scr, C.lane, WSCALE); }
    }
}
__device__ __forceinline__ int cvt_idle(int nunits, int G) { const int rem = nunits % G; return rem ? G - rem : 0; }
__device__ __forceinline__ int cvt_t1(int l, int G) { const int n = cvt_idle((((l <= 2) ? NR : NL) / BM) * (PW / BM), G) * CVT_Q; return n < CVT_ITEMS ? n : CVT_ITEMS; }
__device__ __forceinline__ int cvt_t2(int l, int G) { const int n = cvt_t1(l, G) + cvt_idle((((l <= 1) ? NR : NL) / BM) * (D / BM), G) * CVT_Q; return n < CVT_ITEMS ? n : CVT_ITEMS; }
__device__ __forceinline__ void cvt_moe_tail(const Args& A, const Ctx& C, int l, int nunits, int base, int end) {
    const int rem = nunits % C.G;
    if (rem == 0 || C.bid < rem) return;
    const int first = base + (C.bid - rem) * CVT_Q; const int last = min(first + CVT_Q, end);
    cvt_moe_items(A, C, l, first + C.wave, last, NW);
}

__device__ __forceinline__ void phase_g1(const Args& A, const Ctx& C, int l) {
    const bool mls = (l & 1) == 0; const int j = l >> 1; const int nrows = (l <= 2) ? NR : NL;
    DenseSched S; S.init(A.ws + WS_HB, A.ws + (mls ? WS_WAIN : WS_WBIN) + (size_t)j * PW * D * 2, nrows, PW, D, C.G, C.bid);
    if (mls) { S.sw_lo = 4; S.sw_hi = 8; EpiStore E{(bf16*)(A.ws + WS_PB), PW, 0.08838834764831845f, 2 * NQ + NV, (bf16*)(A.ws + WS_VT)}; gemm_phase<EpiStore, DenseSched, false>(C.lds, D, S, E); }
    else { EpiPair<0> E{(bf16*)(A.ws + WS_PB), PW, D}; gemm_phase<EpiPair<0>, DenseSched, false>(C.lds, D, S, E); }
    cvt_moe_tail(A, C, l, S.nwg, 0, cvt_t1(l, C.G));
}
__device__ __forceinline__ void phase_g2(const Args& A, const Ctx& C, int l) {
    const bool mls = (l & 1) == 0; const int j = l >> 1; const int nrows = (l <= 1) ? NR : NL;
    DenseSched S; S.init(A.ws + WS_HM, A.ws + (mls ? WS_WAOUT : WS_WBOUT) + (size_t)j * D * D, nrows, D, D, C.G, C.bid, 1);
    EpiStore E{(bf16*)(A.ws + WS_HB), D, 1.0f, 1 << 30, nullptr, 1.0f / WSCALE}; gemm_phase<EpiStore, DenseSched, false, true>(C.lds, D, S, E);
    cvt_moe_tail(A, C, l, S.nwg, cvt_t1(l, C.G), cvt_t2(l, C.G));
}
__device__ __forceinline__ void phase_m1(const Args& A, const Ctx& C, int l) {
    LAS MoeTab* T = (LAS MoeTab*)(C.lds + LDS_TAB); LAS unsigned* ridx = (LAS unsigned*)(C.lds + LDS_TAB + 1024);
    moe_tables<true>(A, C, l, 4, T, ridx, D);
    MoeSched S; S.T = T; S.ridx = ridx; S.A = (const char*)(A.ws + WS_H8); S.W = (const char*)(A.ws + WS_WGU); S.wstride_e = (size_t)2 * DE * D; S.tstepB = (size_t)BM * D; S.K = D; S.arow_bytes = 0;
    EpiSwigluF8 E{A.ws + WS_DC, DE, 1.0f / WSCALE}; gemm_phase<EpiSwigluF8, MoeSched, true, true>(C.lds, D, S, E);
}
__device__ __forceinline__ void phase_m2(const Args& A, const Ctx& C, int l) {
    LAS MoeTab* T = (LAS MoeTab*)(C.lds + LDS_TAB); LAS unsigned* ridx = (LAS unsigned*)(C.lds + LDS_TAB + 1024);
    moe_tables<false>(A, C, l, 4, T, ridx, DE);
    MoeSched S; S.T = T; S.ridx = ridx; S.A = (const char*)(A.ws + WS_DC); S.W = (const char*)(A.ws + WS_WDN); S.wstride_e = (size_t)D * DE; S.tstepB = (size_t)BM * DE; S.K = DE; S.arow_bytes = DE;
    EpiStoreTile E{A.ws + WS_PB, D, YSCALE / WSCALE}; gemm_phase<EpiStoreTile, MoeSched, false, true>(C.lds, DE, S, E);
}

typedef float f32x16 __attribute__((ext_vector_type(16)));
#define MFMA32(a, b, c) __builtin_amdgcn_mfma_f32_32x32x16_bf16((a), (b), (c), 0, 0, 0)
__device__ __forceinline__ bf16x8 pack8(float a0, float a1, float a2, float a3, float a4, float a5, float a6, float a7) {
    u32x4 p; p.x = cvt2(a0, a1); p.y = cvt2(a2, a3); p.z = cvt2(a4, a5); p.w = cvt2(a6, a7); return __builtin_bit_cast(bf16x8, p); }
__device__ __forceinline__ float bflo(unsigned w) { return __uint_as_float(w << 16); }
__device__ __forceinline__ float bfhi(unsigned w) { return __uint_as_float(w & 0xffff0000u); }
__device__ __forceinline__ int vt_tile(int b, int h, int blk) { return (blk == 0 ? 128 + b : b * 64 + blk - 1) * NH + h; }

__device__ __forceinline__ float wave_incl_scan(float v, int lane) {
#pragma unroll
    for (int o = 1; o < 64; o <<= 1) { const float t = __shfl_up(v, o); v += (lane >= o) ? t : 0.f; }
    return v;
}
__device__ __forceinline__ void block_gates(const Args& A, int row0, int h, LAS float* bf, LAS float* bb, LAS float* lif, LAS float* lib, int tid) {
    const float* GATE = (const float*)(A.ws + WS_GATE);
    if (tid < 256) { const float* g = GATE + (size_t)(row0 + tid) * 16; lif[tid] = g[0 + h]; bf[tid] = g[4 + h]; lib[tid] = g[8 + h]; bb[tid] = g[12 + h]; }
    __syncthreads();
    const int lane = tid & 63, wv = tid >> 6;
    if (wv == 0) { f32x4 x = *(LAS f32x4*)(bf + 4 * lane); x.y += x.x; x.z += x.y; x.w += x.z; const float tot = wave_incl_scan(x.w, lane); const float ex = tot - x.w;
        x.x += ex; x.y += ex; x.z += ex; x.w += ex; *(LAS f32x4*)(bf + 4 * lane) = x; }
    if (wv == 1) { f32x4 y = *(LAS f32x4*)(bb + 4 * (63 - lane)); y.z += y.w; y.y += y.z; y.x += y.y; const float tot = wave_incl_scan(y.x, lane); const float ex = tot - y.x;
        y.x += ex; y.y += ex; y.z += ex; y.w += ex; *(LAS f32x4*)(bb + 4 * (63 - lane)) = y; }
    __syncthreads();
}
__device__ __forceinline__ void phase_s1(const Args& A, const Ctx& C, int l) {
    LAS float* bf = (LAS float*)C.lds; LAS float* bb = bf + 256; LAS float* lif = bb + 256; LAS float* lib = lif + 256; LAS float* af = lib + 256; LAS float* ab = af + 256;
    constexpr int KP = 528;
    LAS unsigned char* KTf = C.lds + 8192; LAS unsigned char* KTb = KTf + 128 * KP;
    const bf16* P = (const bf16*)(A.ws + WS_PB); const bf16* VT = (const bf16*)(A.ws + WS_VT);
    float* DC = (float*)(A.ws + WS_DC); float* DN = (float*)(A.ws + WS_DN); float* BT = (float*)(A.ws + WS_BTOT);
    const int r = C.lane & 31, hh = C.lane >> 5, w = C.wave;
    for (int u = C.bid; u < NUNIT; u += C.G) {
        const int blk = u % NBLK, bh = u / NBLK, h = bh % NH, b = bh / NH; const int row0 = blk_row0(b, blk);
        block_gates(A, row0, h, bf, bb, lif, lib, C.tid);
        if (C.tid < 256) { af[C.tid] = __expf(bf[255] - bf[C.tid] + lif[C.tid]); ab[C.tid] = __expf(bb[0] - bb[C.tid] + lib[C.tid]); }
        if (C.tid == 0) { BT[u * 2 + 0] = bf[255]; BT[u * 2 + 1] = bb[0]; }
        __syncthreads();
        { const int sp = C.tid >> 2, dq = C.tid & 3, s0 = 2 * sp;
          const bf16* k0 = P + (size_t)(row0 + s0) * PW + NQ + h * DQK + 32 * dq;
          const float f0 = af[s0], f1 = af[s0 + 1], g0 = ab[s0], g1 = ab[s0 + 1];
#pragma unroll
          for (int c = 0; c < 4; ++c) { const u32x4 x0 = *(const u32x4*)(k0 + 8 * c), x1 = *(const u32x4*)(k0 + PW + 8 * c);
#pragma unroll
              for (int q = 0; q < 4; ++q) { const int d = 32 * dq + 8 * c + 2 * q;
                  const float a0 = bflo(x0[q]), a1 = bfhi(x0[q]), c0 = bflo(x1[q]), c1 = bfhi(x1[q]);
                  *(LAS unsigned*)(KTf + d * KP + s0 * 2) = cvt2(a0 * f0, c0 * f1); *(LAS unsigned*)(KTf + (d + 1) * KP + s0 * 2) = cvt2(a1 * f0, c1 * f1);
                  *(LAS unsigned*)(KTb + d * KP + s0 * 2) = cvt2(a0 * g0, c0 * g1); *(LAS unsigned*)(KTb + (d + 1) * KP + s0 * 2) = cvt2(a1 * g0, c1 * g1); } } }
        __syncthreads();
        if (C.tid < 256) { const int dir = C.tid >> 7, d = C.tid & 127; LAS const unsigned* kr = (LAS const unsigned*)((dir ? KTb : KTf) + d * KP); float s = 0.f;
            for (int i = 0; i < 128; ++i) { const unsigned x = kr[i]; s += bflo(x) + bfhi(x); }
            DN[(size_t)(u * 2 + dir) * DQK + d] = s; }
        const bf16* vt = VT + (size_t)vt_tile(b, h, blk) * 65536 + (size_t)(32 * w + r) * 256 + 8 * hh;
        f32x16 accf[4], accb[4];
#pragma unroll
        for (int dt = 0; dt < 4; ++dt)
#pragma unroll
            for (int i = 0; i < 16; ++i) { accf[dt][i] = 0.f; accb[dt][i] = 0.f; }
#pragma unroll 2
        for (int ks = 0; ks < 16; ++ks) { const bf16x8 a = *(const bf16x8*)(vt + 16 * ks);
#pragma unroll
            for (int dt = 0; dt < 4; ++dt) { const int off = (dt * 32 + r) * KP + (16 * ks + 8 * hh) * 2;
                const bf16x8 b0 = *(const LAS bf16x8*)(KTf + off), b1 = *(const LAS bf16x8*)(KTb + off);
                accf[dt] = MFMA32(a, b0, accf[dt]); accb[dt] = MFMA32(a, b1, accb[dt]); } }
        float* dcf = DC + (size_t)(u * 2 + 0) * DQK * DV + (size_t)(32 * w + 4 * hh) * DQK + r; float* dcb = dcf + DQK * DV;
#pragma unroll
        for (int g = 0; g < 4; ++g) { float* pf = dcf + g * 8 * DQK; float* pb = dcb + g * 8 * DQK; asm volatile("" : "+v"(pf), "+v"(pb));
#pragma unroll
            for (int q = 0; q < 4; ++q)
#pragma unroll
                for (int dt = 0; dt < 4; ++dt) { pf[q * DQK + dt * 32] = accf[dt][4 * g + q]; pb[q * DQK + dt * 32] = accb[dt][4 * g + q]; } }
        __syncthreads();
    }
}
__device__ __forceinline__ void phase_s2(const Args& A, const Ctx& C) {
    const float* __restrict__ DC = (const float*)(A.ws + WS_DC); const float* __restrict__ DN = (const float*)(A.ws + WS_DN); const float* __restrict__ BT = (const float*)(A.ws + WS_BTOT);
    bf16* __restrict__ CST = (bf16*)(A.ws + WS_CST); float* __restrict__ NST = (float*)(A.ws + WS_NST);
    constexpr int EL4 = DQK * DV / 4;
    for (int g = C.bid * NT + C.tid; g < BATCH * NH * 2 * EL4; g += C.G * NT) {
        const int e4 = (g % EL4) * 4, ch = g / EL4, dir = ch & 1, bh = ch >> 1;
        f32x4 st = (f32x4){0.f, 0.f, 0.f, 0.f};
#pragma unroll 13
        for (int idx = 0; idx < NBLK; ++idx) {
            const int blk = dir == 0 ? idx : (idx == 0 ? 0 : NBLK - idx); const int u = bh * NBLK + blk;
            const float dec = __expf(BT[u * 2 + dir]);
            const f32x4 dc = *(const f32x4*)(DC + (size_t)(u * 2 + dir) * DQK * DV + e4);
            u32x2 o; o.x = cvt2(st.x, st.y); o.y = cvt2(st.z, st.w);
            *(u32x2*)(CST + (size_t)(u * 2 + dir) * DQK * DV + e4) = o;
            st = st * dec + dc;
        }
    }
    for (int g = C.bid * NT + C.tid; g < BATCH * NH * 2 * DQK; g += C.G * NT) {
        const int d = g % DQK, ch = g / DQK, dir = ch & 1, bh = ch >> 1; float st = 0.f;
        for (int idx = 0; idx < NBLK; ++idx) {
            const int blk = dir == 0 ? idx : (idx == 0 ? 0 : NBLK - idx); const int u = bh * NBLK + blk;
            NST[(size_t)(u * 2 + dir) * DQK + d] = st; st = __expf(BT[u * 2 + dir]) * st + DN[(size_t)(u * 2 + dir) * DQK + d];
        }
    }
}
__device__ __forceinline__ void lds_barrier() { asm volatile("s_waitcnt lgkmcnt(0)" ::: "memory"); __builtin_amdgcn_s_barrier(); asm volatile("" ::: "memory"); }
__device__ __forceinline__ void phase_s3(const Args& A, const Ctx& C, int l) {
    const int jl = l >> 1; const bool ctx_out = (l == 0);
    LAS float* bf = (LAS float*)C.lds; LAS float* bb = bf + 256; LAS float* gf = bb + 256; LAS float* gb = gf + 256;
    LAS float* nf = gb + 256; LAS float* nb = nf + 128; LAS float* ssx = nb + 128;
    LAS float* cf = ssx + 256; LAS float* cb = cf + 256;
    constexpr int KP = 272, VP = 136, CP = 144, OP = 528;
    LAS unsigned char* Kimg = C.lds + 8192;
    LAS unsigned char* CH = Kimg + 256 * KP;
    static_assert(8192 + 256 * KP + 128 * OP <= LDS_TAB_END, "S3 LDS map");
    const bf16* P = (const bf16*)(A.ws + WS_PB); const bf16* VT = (const bf16*)(A.ws + WS_VT); unsigned char* HM = A.ws + WS_HM;
    const bf16* CST = (const bf16*)(A.ws + WS_CST); const float* NST = (const float*)(A.ws + WS_NST);
    const float* hg = A.in[10] + (size_t)jl * NV;
    const int w = C.wave, eh = w >> 2;
    for (int u = C.bid; u < NUNIT; u += C.G) {
        const int blk = u % NBLK, bh = u / NBLK, h = bh % NH, b = bh / NH; const int row0 = blk_row0(b, blk);
        if (blk == 0 && !ctx_out) continue;
        int tu = threadIdx.x; asm volatile("" : "+v"(tu));
        block_gates(A, row0, h, bf, bb, gf, gb, tu);
        if (tu < 256) { gf[tu] -= bf[tu]; gb[tu] -= bb[tu]; cf[tu] = __expf(bf[tu | 31] + gf[tu]); cb[tu] = __expf(bb[tu & ~31] + gb[tu]); }
        else { const int t2 = tu - 256; nf[t2] = NST[(size_t)(u * 2 + (t2 >> 7)) * DQK + (t2 & 127)]; }
        { const int pc = tu & 15, s0 = tu >> 4; const bf16* kr = P + (size_t)(row0 + s0) * PW + NQ + h * DQK + 8 * pc;
#pragma unroll
          for (int i = 0; i < 8; ++i) *(LAS u32x4*)(Kimg + (s0 + 32 * i) * KP + pc * 16) = *(const u32x4*)(kr + (size_t)(32 * i) * PW); }
        __syncthreads();
        const bf16* vtile = VT + (size_t)vt_tile(b, h, blk) * 65536;
        const bf16* ctile = CST + (size_t)(u * 2) * DQK * DV;
#pragma unroll 1
        for (int ps = 0; ps < 2; ++ps) {
            int lz = threadIdx.x & 63; asm volatile("" : "+v"(lz));
            const int r = lz & 31, hh = lz >> 5;
            const int jt = 2 * (w & 3) + ps; const int jrow = row0 + 32 * jt + r;
            bf16x8 qf[8];
            { const bf16* qr = P + (size_t)jrow * PW + h * DQK + 8 * hh;
#pragma unroll
              for (int kk = 0; kk < 8; ++kk) qf[kk] = *(const bf16x8*)(qr + 16 * kk); }
            const float bfj = bf[32 * jt + r], bbj = bb[32 * jt + r];
            float qnf = 0.f, qnb = 0.f;
#pragma unroll
            for (int kk = 0; kk < 8; ++kk) { const u32x4 qq = __builtin_bit_cast(u32x4, qf[kk]); const int d = 16 * kk + 8 * hh;
                const f32x4 n0 = *(const LAS f32x4*)(nf + d), n1 = *(const LAS f32x4*)(nf + d + 4), m0 = *(const LAS f32x4*)(nb + d), m1 = *(const LAS f32x4*)(nb + d + 4);
                qnf += (bflo(qq.x) * n0.x + bfhi(qq.x) * n0.y) + (bflo(qq.y) * n0.z + bfhi(qq.y) * n0.w) + (bflo(qq.z) * n1.x + bfhi(qq.z) * n1.y) + (bflo(qq.w) * n1.z + bfhi(qq.w) * n1.w);
                qnb += (bflo(qq.x) * m0.x + bfhi(qq.x) * m0.y) + (bflo(qq.y) * m0.z + bfhi(qq.y) * m0.w) + (bflo(qq.z) * m1.x + bfhi(qq.z) * m1.y) + (bflo(qq.w) * m1.z + bfhi(qq.w) * m1.w);
                if (kk & 1) asm volatile("" ::: "memory"); }
            qnf += __shfl_xor(qnf, 32); qnb += __shfl_xor(qnb, 32);
            u32x4 pre[4];
            { int tz = threadIdx.x; asm volatile("" : "+v"(tz)); const int pc = tz & 7, e0 = tz >> 3; const bf16* vr = vtile + (size_t)e0 * 256 + 8 * pc;
#pragma unroll
              for (int c4 = 0; c4 < 4; ++c4) pre[c4] = *(const u32x4*)(vr + (size_t)(64 * c4) * 256); }
            float denf = 0.f, denb = 0.f;
#pragma unroll 1
            for (int kt = 0; kt < 8; ++kt) {
                f32x16 c;
#pragma unroll
                for (int i = 0; i < 16; ++i) c[i] = 0.f;
#pragma unroll
                for (int kk = 0; kk < 8; ++kk) { const bf16x8 a = *(const LAS bf16x8*)(Kimg + (kt * 32 + r) * KP + (16 * kk + 8 * hh) * 2); c = MFMA32(a, qf[kk], c); }
                if (kt == jt) {
#pragma unroll
                    for (int g = 0; g < 4; ++g) { const int sl0 = 8 * g + 4 * hh;
                        const f32x4 g4f = *(const LAS f32x4*)(gf + kt * 32 + sl0), g4b = *(const LAS f32x4*)(gb + kt * 32 + sl0);
#pragma unroll
                        for (int q = 0; q < 4; ++q) { const int sl = sl0 + q; const float cv = c[4 * g + q];
                            denf += cv * __expf((sl <= r) ? bfj + g4f[q] : -1.0e30f); denb += cv * __expf((sl >= r) ? bbj + g4b[q] : -1.0e30f); } }
                } else {
                    LAS const float* cx = (kt < jt ? cf : cb) + kt * 32 + 4 * hh; float sm = 0.f;
#pragma unroll
                    for (int g = 0; g < 4; ++g) { const f32x4 c4 = *(const LAS f32x4*)(cx + 8 * g); sm += (c[4 * g] * c4.x + c[4 * g + 1] * c4.y) + (c[4 * g + 2] * c4.z + c[4 * g + 3] * c4.w); }
                    if (kt < jt) denf += sm * __expf(bfj - bf[kt * 32 + 31]); else denb += sm * __expf(bbj - bb[kt * 32]);
                }
            }
            denf += __shfl_xor(denf, 32); denb += __shfl_xor(denb, 32);
            const float ebf = __expf(bfj), ebb = __expf(bbj);
            denf += ebf * qnf; denb += ebb * qnb;
            const float rf = 1.0f / fmaxf(fabsf(denf), 1.0f), rb = 1.0f / fmaxf(fabsf(denb), 1.0f);
            const float scf = ebf * rf, scb = ebb * rb;
            f32x16 acc[4];
#pragma unroll
            for (int et = 0; et < 4; ++et)
#pragma unroll
                for (int i = 0; i < 16; ++i) acc[et][i] = 0.f;
#pragma unroll
            for (int ci = 0; ci < 8; ++ci) {
                lds_barrier();
                { int tz = threadIdx.x; asm volatile("" : "+v"(tz)); const int pc = tz & 7, e0 = tz >> 3;
                  if (ci < 4) {
#pragma unroll
                      for (int c4 = 0; c4 < 4; ++c4) { *(LAS u32x2*)(CH + (e0 + 64 * c4) * VP + pc * 16) = (u32x2){pre[c4].x, pre[c4].y}; *(LAS u32x2*)(CH + (e0 + 64 * c4) * VP + pc * 16 + 8) = (u32x2){pre[c4].z, pre[c4].w}; }
                  } else {
#pragma unroll
                      for (int c4 = 0; c4 < 4; ++c4) *(LAS u32x4*)(CH + (e0 + 64 * c4) * CP + pc * 16) = pre[c4];
                  }
                  if (ci < 7) { const int cn = ci + 1;
                      const bf16* src = (cn < 4) ? vtile + (size_t)e0 * 256 + 64 * cn + 8 * pc : ctile + (size_t)(cn >= 6 ? DQK * DV : 0) + (size_t)e0 * DQK + 64 * (cn & 1) + 8 * pc;
                      const size_t rstep = (cn < 4) ? (size_t)64 * 256 : (size_t)64 * DQK;
#pragma unroll
                      for (int c4 = 0; c4 < 4; ++c4) pre[c4] = *(const u32x4*)(src + c4 * rstep); } }
                lds_barrier();
                if (ci < 4) {
#pragma unroll 1
                    for (int kt2 = 0; kt2 < 2; ++kt2) { const int kt = 2 * ci + kt2;
                        f32x16 c;
#pragma unroll
                        for (int i = 0; i < 16; ++i) c[i] = 0.f;
#pragma unroll
                        for (int kk = 0; kk < 8; ++kk) { const bf16x8 a = *(const LAS bf16x8*)(Kimg + (kt * 32 + r) * KP + (16 * kk + 8 * hh) * 2); c = MFMA32(a, qf[kk], c); }
                        float p[16]; const float bfj2 = bf[32 * jt + r], bbj2 = bb[32 * jt + r];
                        if (kt == jt) {
#pragma unroll
                            for (int g = 0; g < 4; ++g) { const int sl0 = 8 * g + 4 * hh;
                                const f32x4 g4f = *(const LAS f32x4*)(gf + kt * 32 + sl0), g4b = *(const LAS f32x4*)(gb + kt * 32 + sl0);
#pragma unroll
                                for (int q = 0; q < 4; ++q) { const int sl = sl0 + q;
                                    const float wt = rf * __expf((sl <= r) ? bfj2 + g4f[q] : -1.0e30f) + rb * __expf((sl >= r) ? bbj2 + g4b[q] : -1.0e30f);
                                    p[4 * g + q] = c[4 * g + q] * wt; } }
                        } else {
                            LAS const float* cx = (kt < jt ? cf : cb) + kt * 32 + 4 * hh;
                            const float rw = (kt < jt) ? rf * __expf(bfj2 - bf[kt * 32 + 31]) : rb * __expf(bbj2 - bb[kt * 32]);
#pragma unroll
                            for (int g = 0; g < 4; ++g) { const f32x4 c4 = *(const LAS f32x4*)(cx + 8 * g);
                                p[4 * g] = c[4 * g] * (c4.x * rw); p[4 * g + 1] = c[4 * g + 1] * (c4.y * rw); p[4 * g + 2] = c[4 * g + 2] * (c4.z * rw); p[4 * g + 3] = c[4 * g + 3] * (c4.w * rw); }
                        }
                        const bf16x8 pa0 = pack8(p[0], p[1], p[2], p[3], p[4], p[5], p[6], p[7]), pa1 = pack8(p[8], p[9], p[10], p[11], p[12], p[13], p[14], p[15]);
#pragma unroll
                        for (int et = 0; et < 4; ++et) { LAS const unsigned char* vb = CH + ((4 * eh + et) * 32 + r) * VP + (kt2 * 32 + 4 * hh) * 2;
                            const u32x2 l0 = *(LAS const u32x2*)(vb), h0 = *(LAS const u32x2*)(vb + 16), l1 = *(LAS const u32x2*)(vb + 32), h1 = *(LAS const u32x2*)(vb + 48);
                            const bf16x8 a0 = __builtin_bit_cast(bf16x8, (u32x4){l0.x, l0.y, h0.x, h0.y}), a1 = __builtin_bit_cast(bf16x8, (u32x4){l1.x, l1.y, h1.x, h1.y});
                            acc[et] = MFMA32(a0, pa0, acc[et]); acc[et] = MFMA32(a1, pa1, acc[et]); }
                    }
                } else {
                    const int dir = (ci - 4) >> 1, dh = ci & 1;
                    const float sc = dir ? scb : scf;
#pragma unroll
                    for (int k4 = 0; k4 < 4; ++k4) { const u32x4 qq = __builtin_bit_cast(u32x4, qf[4 * dh + k4]);
                        const bf16x8 qs = pack8(bflo(qq.x) * sc, bfhi(qq.x) * sc, bflo(qq.y) * sc, bfhi(qq.y) * sc, bflo(qq.z) * sc, bfhi(qq.z) * sc, bflo(qq.w) * sc, bfhi(qq.w) * sc);
#pragma unroll
                        for (int et = 0; et < 4; ++et) { const bf16x8 a = *(const LAS bf16x8*)(CH + ((4 * eh + et) * 32 + r) * CP + (16 * k4 + 8 * hh) * 2); acc[et] = MFMA32(a, qs, acc[et]); } }
                }
            }
            float ss = 0.f;
#pragma unroll
            for (int et = 0; et < 4; ++et)
#pragma unroll
                for (int i = 0; i < 16; ++i) ss += acc[et][i] * acc[et][i];
            ss += __shfl_xor(ss, 32);
            if (hh == 0) ssx[w * 32 + r] = ss;
            lds_barrier();
            ss += ssx[(w ^ 4) * 32 + r];
            const float rs = 1.0f / sqrtf(ss * (1.0f / DV) + EPS);
            { LAS unsigned char* ob = CH + ((w & 3) * 32 + r) * OP + (eh * 128 + 4 * hh) * 2;
#pragma unroll
              for (int et = 0; et < 4; ++et)
#pragma unroll
                  for (int g = 0; g < 4; ++g) { u32x2 o; o.x = cvt2(acc[et][4 * g + 0] * rs, acc[et][4 * g + 1] * rs); o.y = cvt2(acc[et][4 * g + 2] * rs, acc[et][4 * g + 3] * rs);
                      *(LAS u32x2*)(ob + (et * 32 + 8 * g) * 2) = o; } }
            lds_barrier();
            { int tz = threadIdx.x; asm volatile("" : "+v"(tz)); const int pc = tz & 31, lr0 = tz >> 5;
              const f32x4 g0 = *(const f32x4*)(hg + h * DV + 8 * pc), g1 = *(const f32x4*)(hg + h * DV + 8 * pc + 4);
#pragma unroll
              for (int hf = 0; hf < 2; ++hf) {
              u32x4 ov[4];
#pragma unroll
              for (int i = 0; i < 4; ++i) { const int lr = lr0 + 16 * (4 * hf + i); const int grow = row0 + 64 * (lr >> 5) + 32 * ps + (lr & 31); ov[i] = *(const u32x4*)(P + (size_t)grow * PW + 2 * NQ + NV + h * DV + 8 * pc); }
#pragma unroll
              for (int i = 0; i < 4; ++i) { const int lr = lr0 + 16 * (4 * hf + i); const int grow = row0 + 64 * (lr >> 5) + 32 * ps + (lr & 31);
                  const u32x4 hv = *(const LAS u32x4*)(CH + lr * OP + pc * 16);
                  const f32x4 o0 = (f32x4){bflo(hv.x) * g0.x * bflo(ov[i].x), bfhi(hv.x) * g0.y * bfhi(ov[i].x), bflo(hv.y) * g0.z * bflo(ov[i].y), bfhi(hv.y) * g0.w * bfhi(ov[i].y)};
                  const f32x4 o1 = (f32x4){bflo(hv.z) * g1.x * bflo(ov[i].z), bfhi(hv.z) * g1.y * bfhi(ov[i].z), bflo(hv.w) * g1.z * bflo(ov[i].w), bfhi(hv.w) * g1.w * bfhi(ov[i].w)};
                  *(u32x2*)(HM + (size_t)grow * D + h * DV + 8 * pc) = cvt8_fp8(o0, o1); }
              asm volatile("" ::: "memory"); } }
        }
        __syncthreads();
    }
}

#define XB_TMO      128
#define XB_XCNT(j)  (256  + 64 * (j))
#define XB_XSUB(j)  (1280 + 64 * (j))
#define XB_XGEN(j)  (2304 + 64 * (j))
#define XB_TOP      3328
#define XB_TOPGEN   3392
#define XCD_BAR_WORDS 3456
#define XB_SPIN_CAP (1u << 18)

__device__ __forceinline__ unsigned xb_ld(unsigned* p)              { return __hip_atomic_load(p, __ATOMIC_RELAXED, __HIP_MEMORY_SCOPE_AGENT); }
__device__ __forceinline__ unsigned xb_add(unsigned* p, unsigned v) { return __hip_atomic_fetch_add(p, v, __ATOMIC_RELAXED, __HIP_MEMORY_SCOPE_AGENT); }
__device__ __forceinline__ unsigned xb_xcc_id() { return (unsigned)__builtin_amdgcn_s_getreg((3 << 11) | 20) & 0xFu; }
#define XB_SPIN(cond, bar) do { unsigned _sp = 0; while (cond) { __builtin_amdgcn_s_sleep(1); \
    if ((++_sp & 255u) == 0u) { if (xb_ld(&(bar)[XB_TMO])) break; if (_sp > XB_SPIN_CAP) { atomicAdd(&(bar)[XB_TMO], 1u); break; } } } } while (0)

struct XcdBarrier {
    unsigned* bar; unsigned x;
    volatile LAS unsigned* st;
};

__device__ __forceinline__ XcdBarrier xcd_barrier_post(unsigned* bar, volatile LAS unsigned* st) {
    XcdBarrier b; b.bar = bar; b.x = xb_xcc_id(); b.st = st;
    if (threadIdx.x == 0) (void)xb_add(&bar[XB_XCNT(b.x)], 1u);
    return b;
}
__device__ __forceinline__ void xcd_barrier_complete(unsigned* bar, unsigned x, unsigned& nloc, unsigned& nx) {
    const unsigned G = gridDim.x * gridDim.y * gridDim.z;
    unsigned sum, cnt, mine, sp = 0u;
    for (;;) {
        sum = 0u; cnt = 0u; mine = 0u;
#pragma unroll
        for (unsigned j = 0; j < 16; ++j) { const unsigned c = xb_ld(&bar[XB_XCNT(j)]); sum += c; cnt += (c > 0u) ? 1u : 0u; mine = (j == x) ? c : mine; }
        if (sum == G) break;
        __builtin_amdgcn_s_sleep(1);
        if ((++sp & 255u) == 0u) { if (xb_ld(&bar[XB_TMO])) break; if (sp > XB_SPIN_CAP) { atomicAdd(&bar[XB_TMO], 1u); break; } }
    }
    nloc = mine > 0u ? mine : 1u; nx = cnt > 0u ? cnt : 1u;
}

__device__ __forceinline__ void xcd_barrier(const XcdBarrier& b) {
    asm volatile("s_waitcnt vmcnt(0)" ::: "memory");
    __syncthreads();
    if (threadIdx.x == 0) {
        unsigned* bar = b.bar;
        __builtin_amdgcn_s_waitcnt(0);
        unsigned nloc = b.st[0], nx = b.st[1];
        if (nloc == 0u) { xcd_barrier_complete(bar, b.x, nloc, nx); b.st[0] = nloc; b.st[1] = nx; }
        const unsigned old = xb_add(&bar[XB_XSUB(b.x)], 1u);
        const unsigned gen = old / nloc;
        if (old + 1u == (gen + 1u) * nloc) {
            __builtin_amdgcn_fence(__ATOMIC_RELEASE, "agent");
            asm volatile("s_waitcnt vmcnt(0)" ::: "memory");
            const unsigned og = xb_add(&bar[XB_TOP], 1u);
            const unsigned tg = og / nx;
            if (og + 1u == (tg + 1u) * nx) xb_add(&bar[XB_TOPGEN], 1u);
            else XB_SPIN(xb_ld(&bar[XB_TOPGEN]) == tg, bar);
            __builtin_amdgcn_fence(__ATOMIC_ACQUIRE, "agent");
            xb_add(&bar[XB_XGEN(b.x)], 1u);
            asm volatile("s_waitcnt vmcnt(0)" ::: "memory");
        } else {
            XB_SPIN(xb_ld(&bar[XB_XGEN(b.x)]) == gen, bar);
            __builtin_amdgcn_fence(__ATOMIC_ACQUIRE, "agent");
            asm volatile("s_waitcnt vmcnt(0)" ::: "memory");
        }
    }
    __syncthreads();
}


constexpr int LDS_BYTES = 152 * 1024;
constexpr int CW_BAR = 16384;
static_assert((CW_BAR + XCD_BAR_WORDS) * 4 <= (int)CTL_BYTES, "ctl");
#ifndef MK_MULTI
#define MK_MULTI 0
#endif
#define IN(p) (lo <= (p) && (p) < hi)
#define SEAM(p) do { if ((p) + 1 < hi) { XcdBarrier b_; b_.bar = (unsigned*)(load_args().ws + WS_CTL) + CW_BAR; b_.x = xb_xcc_id(); b_.st = (volatile LAS unsigned*)(C.lds + LDS_BYTES - 16); xcd_barrier(b_); } } while (0)
#define CAS __attribute__((address_space(4)))
__device__ __forceinline__ Args load_args() {
#if defined(__HIP_DEVICE_COMPILE__)
    const CAS Args* p = (const CAS Args*)__builtin_amdgcn_kernarg_segment_ptr(); asm volatile("" : "+s"(p));
    Args a; for (int i = 0; i < 22; ++i) a.in[i] = p->in[i]; a.out = p->out; a.ws = p->ws; a.lo = p->lo; a.hi = p->hi; return a;
#else
    return Args{};
#endif
}
__device__ __forceinline__ Ctx fresh(const Ctx& C) { Ctx R = C; int tz = threadIdx.x; asm volatile("" : "+v"(tz)); R.tid = tz; R.lane = tz & 63; return R; }
template <int L> __device__ __forceinline__ void layer_phases(const Args& args, const Ctx& C, int bar, int lo, int hi) {
    constexpr int pb = 16 * L;
    if (IN(pb + 1)) { phase_r1(load_args(), fresh(C), L); SEAM(pb + 1); }
    if (IN(pb + 2)) { phase_g1(load_args(), fresh(C), L); SEAM(pb + 2); }
    if constexpr ((L & 1) == 0) {
        if (IN(pb + 3)) { phase_s1(load_args(), fresh(C), L); SEAM(pb + 3); }
        if (IN(pb + 4)) { phase_s2(load_args(), fresh(C)); SEAM(pb + 4); }
        if (IN(pb + 5)) { phase_s3(load_args(), fresh(C), L); SEAM(pb + 5); }
    } else {
        if (IN(pb + 3)) { phase_conv(load_args(), fresh(C), L); SEAM(pb + 3); }
    }
    if (IN(pb + 6)) { phase_g2(load_args(), fresh(C), L); SEAM(pb + 6); }
    if (IN(pb + 7)) { phase_r2(load_args(), fresh(C), L); SEAM(pb + 7); }
    if (IN(pb + 8)) { phase_m1(load_args(), fresh(C), L); SEAM(pb + 8); }
    if (IN(pb + 9)) { phase_m2(load_args(), fresh(C), L); SEAM(pb + 9); }
}
__global__ void __launch_bounds__(NT, 2) fwd_kernel(Args args) {
    extern __shared__ __attribute__((aligned(16))) unsigned char lds_raw[];
    Ctx C; C.lds = (LAS unsigned char*)lds_raw; C.tid = threadIdx.x; C.lane = C.tid & 63; C.wave = __builtin_amdgcn_readfirstlane(C.tid >> 6); C.G = gridDim.x; C.bid = blockIdx.x; C.a = &args;
    const int lo = args.lo, hi = args.hi;
    volatile LAS unsigned* xbw = (volatile LAS unsigned*)(C.lds + LDS_BYTES - 16);
    if (C.tid < 4) xbw[C.tid] = 0u;
    __syncthreads();
    if (hi - lo > 1) (void)xcd_barrier_post((unsigned*)(args.ws + WS_CTL) + CW_BAR, xbw);
    const int bar = 0; (void)bar;
    if (IN(0)) { phase_mod(load_args(), fresh(C)); __syncthreads(); phase_cvt_mixer(load_args(), fresh(C)); SEAM(0); }
    layer_phases<0>(args, C, bar, lo, hi);
    layer_phases<1>(args, C, bar, lo, hi);
    layer_phases<2>(args, C, bar, lo, hi);
    layer_phases<3>(args, C, bar, lo, hi);
    if (IN(64)) phase_final(load_args(), fresh(C));
}
#undef IN
#undef SEAM

extern "C" void kernel_launch(void* const* d_in, const int* in_sizes, int n_in, void* d_out, int out_size, void* d_ws, size_t ws_size, hipStream_t stream) {
    static int grid = 0;
    if (grid == 0) {
        if (n_in != 22 || out_size != NL * D || ws_size < WS_END) { fprintf(stderr, "kernel_launch: unexpected shapes (n_in %d out %d ws %zu)\n", n_in, out_size, ws_size); grid = -1; return; }
        int dev = 0, cus = 0, per_cu = 0;
        if (hipGetDevice(&dev) != hipSuccess || hipDeviceGetAttribute(&cus, hipDeviceAttributeMultiprocessorCount, dev) != hipSuccess) { grid = -1; return; }
        if (hipFuncSetAttribute((const void*)fwd_kernel, hipFuncAttributeMaxDynamicSharedMemorySize, LDS_BYTES) != hipSuccess) { grid = -1; return; }
        if (hipOccupancyMaxActiveBlocksPerMultiprocessor(&per_cu, (const void*)fwd_kernel, NT, LDS_BYTES) != hipSuccess || per_cu < 1) { fprintf(stderr, "kernel_launch: occupancy query says %d\n", per_cu); }
        (void)hipGetLastError();
        grid = cus;
    }
    if (grid < 0) return;
    (void)hipMemsetAsync((char*)d_ws + WS_CTL, 0, CTL_BYTES, stream);
    Args a{};
    for (int i = 0; i < 22; ++i) a.in[i] = (const float*)d_in[i];
    a.out = (float*)d_out; a.ws = (unsigned char*)d_ws;
#if MK_MULTI
    int phases[64]; int np = 0;
    phases[np++] = 0;
    for (int l = 0; l < DEPTH; ++l) { const int pb = 16 * l; phases[np++] = pb + 1; phases[np++] = pb + 2; phases[np++] = pb + 3;
        if ((l & 1) == 0) { phases[np++] = pb + 4; phases[np++] = pb + 5; }
        phases[np++] = pb + 6; phases[np++] = pb + 7; phases[np++] = pb + 8; phases[np++] = pb + 9; }
    phases[np++] = 64;
    for (int i = 0; i < np; ++i) { a.lo = phases[i]; a.hi = phases[i] + 1; hipLaunchKernelGGL(fwd_kernel, dim3(grid), dim3(NT), LDS_BYTES, stream, a); }
#else
    a.lo = 0; a.hi = 65;
    hipLaunchKernelGGL(fwd_kernel, dim3(grid), dim3(NT), LDS_BYTES, stream, a);
#ifdef PROBE_PHASES
    { const int pp[] = {PROBE_PHASES};
      for (int rep = 0; rep < PROBE_REPS; ++rep) for (unsigned i = 0; i < sizeof(pp) / sizeof(pp[0]); ++i) { a.lo = pp[i]; a.hi = pp[i] + 1; hipLaunchKernelGGL(fwd_kernel, dim3(grid), dim3(NT), LDS_BYTES, stream, a); } }
#endif
#endif
}
```

```cpp
#include <hip/hip_runtime.h>
#include <cstdio>
#include <cstdint>

#define LAS __attribute__((address_space(3)))
typedef unsigned short bf16;
typedef float f32x4 __attribute__((ext_vector_type(4)));
typedef unsigned u32x4 __attribute__((ext_vector_type(4)));
typedef unsigned u32x2 __attribute__((ext_vector_type(2)));
typedef int i32x4r __attribute__((ext_vector_type(4)));

constexpr int D = 1024, BATCH = 2, SEQ = 16384, DEPTH = 4, CTXL = 256;
constexpr int NL = BATCH * SEQ, NCX = BATCH * CTXL, NR = NL + NCX;
constexpr int NH = 4, DQK = 128, DV = 256, NQ = 512, NV = 1024, PROJ = 3088, PW = 3072;
constexpr int NGRP = 4, EPG = 8, NE = 32, DE = 512;
constexpr int NBLK = 65;
constexpr int NUNIT = BATCH * NH * NBLK;
constexpr int CAP = NR;
constexpr int YROWS = 74752;
constexpr float EPS = 1e-6f;
constexpr float WSCALE = 32.0f;
constexpr float YSCALE = 4.0f;
constexpr int NT = 512, NW = 8;
constexpr int LDS_TAB_END = 152 * 1024 - 16;

constexpr size_t MiB = 1u << 20;
constexpr size_t WS_CTL = 0, CTL_BYTES = 1 * MiB;
constexpr size_t WS_MOD = 1 * MiB;
constexpr size_t WS_GATE = 2 * MiB;
constexpr size_t WS_TOKSLOT = 5 * MiB;
constexpr size_t WS_TOKW = 6 * MiB;
constexpr size_t WS_SLOTTOK = 7 * MiB;
constexpr size_t WS_DN = 12 * MiB;
constexpr size_t WS_NST = 13 * MiB;
constexpr size_t WS_BTOT = 14 * MiB;
constexpr size_t WS_RSC = 15 * MiB;
constexpr size_t WS_LAT = 16 * MiB;
constexpr size_t WS_HB = 146 * MiB;
constexpr size_t WS_PB = 211 * MiB;
constexpr size_t WS_HM = 406 * MiB;
constexpr size_t WS_DC = 471 * MiB;
constexpr size_t WS_CST = 601 * MiB;
constexpr size_t WS_VT = 666 * MiB;
constexpr size_t WS_WAIN = 731 * MiB;
constexpr size_t WS_WBIN = 743 * MiB;
constexpr size_t WS_WAOUT = 755 * MiB;
constexpr size_t WS_WBOUT = 759 * MiB;
constexpr size_t WS_WGU = 763 * MiB;
constexpr size_t WS_WDN = 827 * MiB;
constexpr size_t WS_H8 = 843 * MiB;
constexpr size_t WS_END = 880 * MiB;
constexpr int CW_WMAX = 256;
constexpr int CW_CNT = 1024, CNT_STRIDE = 64;

struct Args { const float* in[22]; float* out; unsigned char* ws; int lo, hi; };

typedef short bf16x8 __attribute__((ext_vector_type(8)));
typedef float f32x2 __attribute__((ext_vector_type(2)));
typedef __bf16 bf16x2_t __attribute__((ext_vector_type(2)));
__device__ __forceinline__ unsigned cvt2(float lo, float hi) { const f32x2 v = {lo, hi}; return __builtin_bit_cast(unsigned, __builtin_convertvector(v, bf16x2_t)); }
__device__ __forceinline__ float bf2f(bf16 v) { return __uint_as_float(((unsigned)v) << 16); }
__device__ __forceinline__ unsigned f2bf(float f) { unsigned u = __float_as_uint(f); return (u + 0x7fffu + ((u >> 16) & 1u)) >> 16; }
__device__ __forceinline__ unsigned pk2(float lo, float hi) { return f2bf(lo) | (f2bf(hi) << 16); }
template <int CTRL, int ROWMASK> __device__ __forceinline__ float dpp_mov(float x) { return __int_as_float(__builtin_amdgcn_update_dpp(0, __float_as_int(x), CTRL, ROWMASK, 0xf, false)); }
__device__ __forceinline__ float wave_sum(float v) {
    v += dpp_mov<0xB1, 0xf>(v); v += dpp_mov<0x4E, 0xf>(v); v += dpp_mov<0x141, 0xf>(v); v += dpp_mov<0x140, 0xf>(v);
    v += dpp_mov<0x142, 0xA>(v); v += dpp_mov<0x143, 0xC>(v);
    return __int_as_float(__builtin_amdgcn_readlane(__float_as_int(v), 63));
}
__device__ __forceinline__ float wave_max_nn(float v) {
    v = fmaxf(v, dpp_mov<0xB1, 0xf>(v)); v = fmaxf(v, dpp_mov<0x4E, 0xf>(v)); v = fmaxf(v, dpp_mov<0x141, 0xf>(v)); v = fmaxf(v, dpp_mov<0x140, 0xf>(v));
    v = fmaxf(v, dpp_mov<0x142, 0xA>(v)); v = fmaxf(v, dpp_mov<0x143, 0xC>(v));
    return __int_as_float(__builtin_amdgcn_readlane(__float_as_int(v), 63));
}
__device__ __forceinline__ unsigned pack_i8(f32x4 v) {
    const int a = (int)__builtin_rintf(fminf(fmaxf(v.x, -127.f), 127.f)), b = (int)__builtin_rintf(fminf(fmaxf(v.y, -127.f), 127.f)), c = (int)__builtin_rintf(fminf(fmaxf(v.z, -127.f), 127.f)), d = (int)__builtin_rintf(fminf(fmaxf(v.w, -127.f), 127.f));
    return (unsigned)(a & 255) | ((unsigned)(b & 255) << 8) | ((unsigned)(c & 255) << 16) | ((unsigned)d << 24);
}
__device__ __forceinline__ float sigmoidf_(float x) { return 1.f / (1.f + __expf(-x)); }
__device__ __forceinline__ float siluf_(float x) { return x / (1.f + __expf(-x)); }
__device__ __forceinline__ float logsigmoidf_(float x) { return fminf(x, 0.f) - log1pf(__expf(-fabsf(x))); }
__device__ __forceinline__ int blk_row0(int b, int blk) { return blk == 0 ? NL + b * CTXL : b * SEQ + (blk - 1) * 256; }
__device__ __forceinline__ int mod_vec_of_row(int row) { return row < NL ? row / SEQ : 2; }

struct Ctx {
    LAS unsigned char* lds; int tid, lane, wave, G, bid;
    const Args* a;
};

__device__ __forceinline__ int expert_block_prefix(const unsigned* cnt, int lane, int& nb) {
    nb = lane < NE ? ((int)cnt[lane * CNT_STRIDE] + 255) / 256 : 0; int v = nb;
#pragma unroll
    for (int o = 1; o < 64; o <<= 1) { const int t = __shfl_up(v, o); v += (lane >= o) ? t : 0; }
    return v - nb;
}
__device__ __forceinline__ void slot_bases(const Args& A, int l, LAS int* sb, int tid) {
    if (tid < 64) { int nb; const int ex = expert_block_prefix((const unsigned*)(A.ws + WS_CTL) + CW_CNT + l * 32 * CNT_STRIDE, tid, nb); if (tid <= NE) sb[tid] = ex * 256; }
    __syncthreads();
}

__device__ __forceinline__ void phase_mod(const Args& A, const Ctx& C) {
    LAS float* sc = (LAS float*)C.lds;
    LAS float* red = sc + 3072;
    const float* c = A.in[1]; const float* cc = A.in[3];
    for (int i = C.tid; i < 3072; i += NT) { const float v = i < 2048 ? c[i] : cc[i - 2048]; sc[i] = siluf_(v); }
    __syncthreads();
    float* MOD = (float*)(A.ws + WS_MOD);
    for (int u = C.bid; u < DEPTH * 96; u += C.G) {
        const int l = u / 96, cg = u % 96, col = cg * 64 + C.lane;
        const float* w = A.in[4] + (size_t)l * D * 6 * D + col;
        float a0 = 0.f, a1 = 0.f, a2 = 0.f;
#pragma unroll 32
        for (int k = C.wave * 128; k < C.wave * 128 + 128; ++k) { const float wv = w[(size_t)k * 6 * D]; a0 += sc[k] * wv; a1 += sc[1024 + k] * wv; a2 += sc[2048 + k] * wv; }
        red[(C.wave * 3 + 0) * 64 + C.lane] = a0; red[(C.wave * 3 + 1) * 64 + C.lane] = a1; red[(C.wave * 3 + 2) * 64 + C.lane] = a2;
        __syncthreads();
        if (C.tid < 192) { const int v = C.tid / 64, ln = C.tid % 64; float s = 0.f;
            for (int w8 = 0; w8 < 8; ++w8) s += red[(w8 * 3 + v) * 64 + ln];
            MOD[(size_t)(l * 3 + v) * 6 * D + cg * 64 + ln] = s + A.in[5][(size_t)l * 6 * D + cg * 64 + ln]; }
        __syncthreads();
    }
}

__device__ __forceinline__ void load_row_f32(const float* p, int lane, f32x4 (&v)[4]) {
#pragma unroll
    for (int j = 0; j < 4; ++j) v[j] = *(const f32x4*)(p + 4 * lane + 256 * j);
}
__device__ __forceinline__ void load_row_bf16(const bf16* p, int lane, f32x4 (&v)[4]) {
#pragma unroll
    for (int j = 0; j < 4; ++j) { const u32x2 w = *(const u32x2*)(p + 4 * lane + 256 * j);
        v[j] = (f32x4){__uint_as_float(w.x << 16), __uint_as_float(w.x & 0xffff0000u), __uint_as_float(w.y << 16), __uint_as_float(w.y & 0xffff0000u)}; }
}
__device__ __forceinline__ void store_row_bf16(bf16* p, int lane, const f32x4 (&v)[4]) {
#pragma unroll
    for (int j = 0; j < 4; ++j) { u32x2 w; w.x = pk2(v[j].x, v[j].y); w.y = pk2(v[j].z, v[j].w); *(u32x2*)(p + 4 * lane + 256 * j) = w; }
}
constexpr int CVT_IG = (D / 64) * (DE / 32), CVT_ID = (DE / 64) * (D / 32), CVT_PER = 2 * CVT_IG + CVT_ID, CVT_ITEMS = NE * CVT_PER;
constexpr int CVT_Q = 64;
__device__ __forceinline__ void cvt_moe_items(const Args& A, const Ctx& C, int l, int it0, int end, int stride);
__device__ __forceinline__ void cvt_win_i8(const Args& A, const Ctx& C);
__device__ __forceinline__ int cvt_t2(int l, int G);
struct RowVec { f32x4 a[4], s[4], g[4]; };
__device__ __forceinline__ void load_rowvec(RowVec& R, const float* ng, const float* sh, const float* sc, const float* gt, int lane) {
    f32x4 n[4], c[4]; load_row_f32(ng, lane, n); load_row_f32(sc, lane, c); load_row_f32(sh, lane, R.s); if (gt) load_row_f32(gt, lane, R.g);
#pragma unroll
    for (int q = 0; q < 4; ++q) R.a[q] = n[q] * (1.f + c[q]);
}
__device__ __forceinline__ void load_row_bf16raw(const bf16* p, int lane, u32x2 (&v)[4]) {
#pragma unroll
    for (int j = 0; j < 4; ++j) v[j] = *(const u32x2*)(p + 4 * lane + 256 * j);
}
__device__ __forceinline__ void store_row_fp8(unsigned char* p, int lane, const f32x4 (&v)[4]) {
#pragma unroll
    for (int j = 0; j < 4; ++j) { int w = 0; w = __builtin_amdgcn_cvt_pk_fp8_f32(v[j].x, v[j].y, w, false); w = __builtin_amdgcn_cvt_pk_fp8_f32(v[j].z, v[j].w, w, true); *(unsigned*)(p + 4 * lane + 256 * j) = (unsigned)w; }
}
__device__ __forceinline__ void load_row_fp8raw(const unsigned char* p, int lane, unsigned (&v)[4]) {
#pragma unroll
    for (int j = 0; j < 4; ++j) v[j] = *(const unsigned*)(p + 4 * lane + 256 * j);
}
__device__ __forceinline__ f32x4 fp8x4(unsigned w) { const f32x2 lo = __builtin_amdgcn_cvt_pk_f32_fp8((int)w, false), hi = __builtin_amdgcn_cvt_pk_f32_fp8((int)w, true); return (f32x4){lo.x, lo.y, hi.x, hi.y}; }
__device__ __forceinline__ f32x4 bf4(u32x2 w) { return (f32x4){__uint_as_float(w.x << 16), __uint_as_float(w.x & 0xffff0000u), __uint_as_float(w.y << 16), __uint_as_float(w.y & 0xffff0000u)}; }
__device__ __forceinline__ float row_rstd(const f32x4 (&v)[4]) {
    float s = 0.f;
#pragma unroll
    for (int j = 0; j < 4; ++j) s += (v[j].x * v[j].x + v[j].y * v[j].y) + (v[j].z * v[j].z + v[j].w * v[j].w);
    return 1.0f / sqrtf(wave_sum(s) * (1.f / D) + EPS);
}

__device__ __forceinline__ void phase_r1(const Args& A, const Ctx& C, int l) {
    LAS int* sb = (LAS int*)C.lds;
    LAS float* GW = (LAS float*)(C.lds + 256);
    const bool mls = (l & 1) == 0; const int j = l >> 1;
    if (l == 0) { cvt_win_i8(A, C); __syncthreads(); }
    if (l > 0) slot_bases(A, l - 1, sb, C.tid);
    if (mls) { const float* w = A.in[8] + (size_t)j * D * PROJ + PW;
        f32x4 t[2][4];
#pragma unroll
        for (int jj = 0; jj < 2; ++jj)
#pragma unroll
            for (int q = 0; q < 4; ++q) t[jj][q] = *(const f32x4*)(w + (size_t)(C.tid + NT * jj) * PROJ + 4 * q);
#pragma unroll
        for (int jj = 0; jj < 2; ++jj)
#pragma unroll
            for (int q = 0; q < 4; ++q) { const int k = C.tid + NT * jj; GW[(4 * q + 0) * D + k] = t[jj][q].x; GW[(4 * q + 1) * D + k] = t[jj][q].y; GW[(4 * q + 2) * D + k] = t[jj][q].z; GW[(4 * q + 3) * D + k] = t[jj][q].w; }
        __syncthreads(); }
    const int nrows = (l <= 2) ? NR : NL;
    bf16* LAT = (bf16*)(A.ws + WS_LAT); unsigned char* HI8 = A.ws + WS_H8; float* RSC = (float*)(A.ws + WS_RSC); float* GATE = (float*)(A.ws + WS_GATE);
    const float* MOD = (const float*)(A.ws + WS_MOD); const unsigned char* Y8 = A.ws + WS_PB;
    const int* TS = (const int*)(A.ws + WS_TOKSLOT); const float* TW = (const float*)(A.ws + WS_TOKW);
    const int rpw = (((nrows + C.G - 1) / C.G) + 1) & ~1; const int wrow0 = C.bid * rpw; const int wend = min(wrow0 + rpw, nrows);
    for (int sa = wrow0; sa < wend;) {
        const int mvi = mod_vec_of_row(sa); const int bnd = mvi == 0 ? SEQ : (mvi == 1 ? NL : NR); const int sbnd = min(wend, bnd);
        RowVec RV; { const float* mv = MOD + (size_t)(l * 3 + mvi) * 6 * D;
            load_rowvec(RV, A.in[6] + (size_t)(l * 2 + 0) * D, mv + 0 * D, mv + 1 * D, l > 0 ? MOD + (size_t)((l - 1) * 3 + mvi) * 6 * D + 5 * D : nullptr, C.lane); }
        const int rlast = sbnd - 2;
        i32x4r tsn = (i32x4r){0, 0, 0, 0}; f32x4 twn = (f32x4){0.f, 0.f, 0.f, 0.f};
        if (l > 0) { const int r0 = min(sa + 2 * C.wave, rlast); tsn = *(const i32x4r*)(TS + r0 * 2); twn = *(const f32x4*)(TW + r0 * 2); }
        for (int ra = sa + 2 * C.wave; ra < sbnd; ra += 2 * NW) {
            const bool hasb = true; const int rb = ra + 1;
            const i32x4r tsc = tsn; const f32x4 twc = twn;
            if (l > 0) { const int r1 = min(ra + 2 * NW, rlast); tsn = *(const i32x4r*)(TS + r1 * 2); twn = *(const f32x4*)(TW + r1 * 2); }
            f32x4 va[4], vb[4]; float wa0 = 0.f, wa1 = 0.f, wb0 = 0.f, wb1 = 0.f;
            if (l == 0) { load_row_f32(ra < NL ? A.in[0] + (size_t)ra * D : A.in[2] + (size_t)(ra - NL) * D, C.lane, va); load_row_f32(rb < NL ? A.in[0] + (size_t)rb * D : A.in[2] + (size_t)(rb - NL) * D, C.lane, vb); }
            else {
                const int ta0 = tsc.x, ta1 = tsc.y, tb0 = tsc.z, tb1 = tsc.w; wa0 = twc.x; wa1 = twc.y; wb0 = twc.z; wb1 = twc.w;
                load_row_bf16(LAT + (size_t)ra * D, C.lane, va); load_row_bf16(LAT + (size_t)rb * D, C.lane, vb);
                unsigned ya0[4], ya1[4], yb0[4], yb1[4];
                load_row_fp8raw(Y8 + (size_t)(sb[ta0 >> 20] + (ta0 & 0xfffff)) * D, C.lane, ya0); load_row_fp8raw(Y8 + (size_t)(sb[ta1 >> 20] + (ta1 & 0xfffff)) * D, C.lane, ya1);
                load_row_fp8raw(Y8 + (size_t)(sb[tb0 >> 20] + (tb0 & 0xfffff)) * D, C.lane, yb0); load_row_fp8raw(Y8 + (size_t)(sb[tb1 >> 20] + (tb1 & 0xfffff)) * D, C.lane, yb1);
                wa0 *= 1.0f / YSCALE; wa1 *= 1.0f / YSCALE; wb0 *= 1.0f / YSCALE; wb1 *= 1.0f / YSCALE;
#pragma unroll
                for (int q = 0; q < 4; ++q) { va[q] += RV.g[q] * (fp8x4(ya0[q]) * wa0 + fp8x4(ya1[q]) * wa1); vb[q] += RV.g[q] * (fp8x4(yb0[q]) * wb0 + fp8x4(yb1[q]) * wb1); }
            }
            store_row_bf16(LAT + (size_t)ra * D, C.lane, va); if (hasb) store_row_bf16(LAT + (size_t)rb * D, C.lane, vb);
            const float rra = row_rstd(va), rrb = row_rstd(vb);
            f32x4 ha[4], hb[4];
#pragma unroll
            for (int q = 0; q < 4; ++q) { ha[q] = (va[q] * rra) * RV.a[q] + RV.s[q]; hb[q] = (vb[q] * rrb) * RV.a[q] + RV.s[q]; }
            { float ma = 0.f, mb = 0.f;
#pragma unroll
              for (int q = 0; q < 4; ++q) { ma = fmaxf(ma, fmaxf(fmaxf(fabsf(ha[q].x), fabsf(ha[q].y)), fmaxf(fabsf(ha[q].z), fabsf(ha[q].w)))); mb = fmaxf(mb, fmaxf(fmaxf(fabsf(hb[q].x), fabsf(hb[q].y)), fmaxf(fabsf(hb[q].z), fabsf(hb[q].w)))); }
              ma = fmaxf(wave_max_nn(ma), 1.0e-20f); mb = fmaxf(wave_max_nn(mb), 1.0e-20f);
              const float ia = 127.0f / ma, ib = 127.0f / mb;
#pragma unroll
              for (int q = 0; q < 4; ++q) { *(unsigned*)(HI8 + (size_t)ra * D + 4 * C.lane + 256 * q) = pack_i8(ha[q] * ia); *(unsigned*)(HI8 + (size_t)rb * D + 4 * C.lane + 256 * q) = pack_i8(hb[q] * ib); }
              if (C.lane == 0) { RSC[ra] = ma * (1.0f / 127.0f); RSC[rb] = mb * (1.0f / 127.0f); } }
            if (mls) {
                float ga = 0.f, gb = 0.f;
#pragma unroll 2
                for (int c = 0; c < 16; ++c) { float s0 = 0.f, s1 = 0.f;
#pragma unroll
                    for (int q = 0; q < 4; ++q) { const f32x4 w = *(const LAS f32x4*)(GW + c * D + 4 * C.lane + 256 * q);
                        s0 += (ha[q].x * w.x + ha[q].y * w.y) + (ha[q].z * w.z + ha[q].w * w.w); s1 += (hb[q].x * w.x + hb[q].y * w.y) + (hb[q].z * w.z + hb[q].w * w.w); }
                    s0 = wave_sum(s0); s1 = wave_sum(s1); ga = (C.lane == c) ? s0 : ga; gb = (C.lane == c) ? s1 : gb; }
                if (C.lane < 16) {
                    const float bgt = A.in[9][j * 16 + C.lane]; const int gtype = C.lane >> 2;
                    ga += bgt; gb += bgt;
                    GATE[(size_t)ra * 16 + C.lane] = (gtype & 1) ? logsigmoidf_(ga) : 15.0f * tanhf(ga * (1.0f / 15.0f));
                    if (hasb) GATE[(size_t)rb * 16 + C.lane] = (gtype & 1) ? logsigmoidf_(gb) : 15.0f * tanhf(gb * (1.0f / 15.0f)); }
            }
        }
        sa = sbnd;
    }
}

__device__ __forceinline__ void phase_r2(const Args& A, const Ctx& C, int l) {
    constexpr int WP = 2064;
    LAS unsigned char* RWB = C.lds;
    LAS float* WL = (LAS float*)(C.lds + 48 * WP);
    LAS unsigned* hist = (LAS unsigned*)(WL + 8 * 16 * 48);
    LAS unsigned* gbase = hist + 32;
    constexpr int RCAP = 144;
    LAS int* rec = (LAS int*)(gbase + 32);
    static_assert(48 * WP + 8 * 16 * 48 * 4 + 256 + RCAP * 16 <= LDS_TAB_END, "R2 LDS map");
    cvt_moe_items(A, C, l, cvt_t2(l, C.G) + C.bid * NW + C.wave, CVT_ITEMS, C.G * NW);
    __syncthreads();
    { const float* wg = A.in[15] + (size_t)l * D * NGRP; const float* wr = A.in[17] + (size_t)l * D * NE;
      { const int kp = C.tid; const f32x4 x0 = *(const f32x4*)(wg + (size_t)(2 * kp) * 4), x1 = *(const f32x4*)(wg + (size_t)(2 * kp + 1) * 4);
        *(LAS unsigned*)(RWB + 0 * WP + kp * 4) = cvt2(x0.x, x1.x); *(LAS unsigned*)(RWB + 1 * WP + kp * 4) = cvt2(x0.y, x1.y);
        *(LAS unsigned*)(RWB + 2 * WP + kp * 4) = cvt2(x0.z, x1.z); *(LAS unsigned*)(RWB + 3 * WP + kp * 4) = cvt2(x0.w, x1.w); }
      f32x4 t0[8], t1[8];
#pragma unroll
      for (int jj = 0; jj < 8; ++jj) { const int it = C.tid + NT * jj, kp = it >> 3, cg = it & 7; t0[jj] = *(const f32x4*)(wr + (size_t)(2 * kp) * NE + 4 * cg); t1[jj] = *(const f32x4*)(wr + (size_t)(2 * kp + 1) * NE + 4 * cg); }
#pragma unroll
      for (int jj = 0; jj < 8; ++jj) { const int it = C.tid + NT * jj, kp = it >> 3, c0 = 4 + 4 * (it & 7);
          *(LAS unsigned*)(RWB + (c0 + 0) * WP + kp * 4) = cvt2(t0[jj].x, t1[jj].x); *(LAS unsigned*)(RWB + (c0 + 1) * WP + kp * 4) = cvt2(t0[jj].y, t1[jj].y);
          *(LAS unsigned*)(RWB + (c0 + 2) * WP + kp * 4) = cvt2(t0[jj].z, t1[jj].z); *(LAS unsigned*)(RWB + (c0 + 3) * WP + kp * 4) = cvt2(t0[jj].w, t1[jj].w); }
      for (int i = C.tid; i < 12 * 512; i += NT) *(LAS unsigned*)(RWB + (36 + i / 512) * WP + (i % 512) * 4) = 0u; }
    const int nrows = (l <= 1) ? NR : NL;
    bf16* LAT = (bf16*)(A.ws + WS_LAT); bf16* H = (bf16*)(A.ws + WS_HB); unsigned char* H8 = A.ws + WS_H8;
    const float* MOD = (const float*)(A.ws + WS_MOD);
    unsigned* cnt = (unsigned*)(A.ws + WS_CTL) + CW_CNT + l * 32 * CNT_STRIDE;
    int* TS = (int*)(A.ws + WS_TOKSLOT); float* TW = (float*)(A.ws + WS_TOKW); int* ST = (int*)(A.ws + WS_SLOTTOK);
    const int rpw = (((nrows + C.G - 1) / C.G) + 1) & ~1; const int wrow0 = C.bid * rpw; const int wend0 = min(wrow0 + rpw, nrows);
    const float* bg = A.in[16] + l * NGRP; const float* br = A.in[18] + l * NE;
    for (int cb = wrow0; cb < wend0; cb += RCAP) {
        const int wend = min(cb + RCAP, wend0);
        if (C.tid < 32) hist[C.tid] = 0u;
        for (int sa = cb; sa < wend;) {
            const int mvi = mod_vec_of_row(sa); const int bnd = mvi == 0 ? SEQ : (mvi == 1 ? NL : NR); const int sbnd = min(wend, bnd);
            RowVec RV; { const float* mv = MOD + (size_t)(l * 3 + mvi) * 6 * D; load_rowvec(RV, A.in[6] + (size_t)(l * 2 + 1) * D, mv + 3 * D, mv + 4 * D, mv + 2 * D, C.lane); }
            const int rlast = sbnd - 2;
            u32x2 la[4], lb[4], ya[4], yb[4];
            { const int r0 = min(sa + 2 * C.wave, rlast); load_row_bf16raw(LAT + (size_t)r0 * D, C.lane, la); load_row_bf16raw(LAT + (size_t)(r0 + 1) * D, C.lane, lb);
              load_row_bf16raw(H + (size_t)r0 * D, C.lane, ya); load_row_bf16raw(H + (size_t)(r0 + 1) * D, C.lane, yb); }
            for (int ra = sa + 2 * C.wave; ra < sbnd; ra += 2 * NW) {
                const int rb = ra + 1;
                u32x2 lan[4], lbn[4], yan[4], ybn[4];
                { const int r1 = min(ra + 2 * NW, rlast); load_row_bf16raw(LAT + (size_t)r1 * D, C.lane, lan); load_row_bf16raw(LAT + (size_t)(r1 + 1) * D, C.lane, lbn);
                  load_row_bf16raw(H + (size_t)r1 * D, C.lane, yan); load_row_bf16raw(H + (size_t)(r1 + 1) * D, C.lane, ybn); }
                f32x4 va[4], vb[4];
#pragma unroll
                for (int q = 0; q < 4; ++q) { va[q] = bf4(la[q]) + RV.g[q] * bf4(ya[q]); vb[q] = bf4(lb[q]) + RV.g[q] * bf4(yb[q]); }
                store_row_bf16(LAT + (size_t)ra * D, C.lane, va); store_row_bf16(LAT + (size_t)rb * D, C.lane, vb);
                const float rra = row_rstd(va), rrb = row_rstd(vb);
                f32x4 ha[4], hb[4];
#pragma unroll
                for (int q = 0; q < 4; ++q) { ha[q] = (va[q] * rra) * RV.a[q] + RV.s[q]; hb[q] = (vb[q] * rrb) * RV.a[q] + RV.s[q]; }
                store_row_bf16(H + (size_t)ra * D, C.lane, ha); store_row_bf16(H + (size_t)rb * D, C.lane, hb);
                store_row_fp8(H8 + (size_t)ra * D, C.lane, ha); store_row_fp8(H8 + (size_t)rb * D, C.lane, hb);
#pragma unroll
                for (int q = 0; q < 4; ++q) { la[q] = lan[q]; lb[q] = lbn[q]; ya[q] = yan[q]; yb[q] = ybn[q]; }
            }
            sa = sbnd;
        }
        __syncthreads();
        const int fr = C.lane & 15, fq = C.lane >> 4;
        for (int t = C.wave; t * 16 < wend - cb; t += NW) {
            const int trow = min(cb + 16 * t + fr, wend - 1);
            const bf16* hp = H + (size_t)trow * D + 8 * fq;
            f32x4 acc[3];
#pragma unroll
            for (int ct = 0; ct < 3; ++ct) acc[ct] = (f32x4){0.f, 0.f, 0.f, 0.f};
#pragma unroll 1
            for (int kb = 0; kb < 4; ++kb) {
                bf16x8 av[8];
#pragma unroll
                for (int k8 = 0; k8 < 8; ++k8) av[k8] = *(const bf16x8*)(hp + 32 * (8 * kb + k8));
#pragma unroll
                for (int k8 = 0; k8 < 8; ++k8)
#pragma unroll
                    for (int ct = 0; ct < 3; ++ct) { const bf16x8 bv = *(const LAS bf16x8*)(RWB + (ct * 16 + fr) * WP + (32 * (8 * kb + k8) + 8 * fq) * 2);
                        acc[ct] = __builtin_amdgcn_mfma_f32_16x16x32_bf16(av[k8], bv, acc[ct], 0, 0, 0); }
            }
            LAS float* wl = WL + C.wave * 16 * 48;
#pragma unroll
            for (int ct = 0; ct < 3; ++ct)
#pragma unroll
                for (int jq = 0; jq < 4; ++jq) wl[(4 * fq + jq) * 48 + ct * 16 + fr] = acc[ct][jq];
            asm volatile("s_waitcnt lgkmcnt(0)" ::: "memory");
            const int row = cb + 16 * t + C.lane;
            if (C.lane < 16 && row < wend) {
                LAS const float* wm = wl + C.lane * 48;
                float lg[36];
#pragma unroll
                for (int c = 0; c < 36; ++c) lg[c] = wm[c];
                float gl[4]; int grp = 0; float gm = -3.0e38f;
#pragma unroll
                for (int c = 0; c < 4; ++c) { gl[c] = lg[c] + bg[c]; if (gl[c] > gm) { gm = gl[c]; grp = c; } }
                float gs = 0.f;
#pragma unroll
                for (int c = 0; c < 4; ++c) gs += __expf(gl[c] - gm);
                const float pgrp = 1.0f / gs;
                float rl[8];
#pragma unroll
                for (int i = 0; i < 8; ++i) { float tt = 0.f;
#pragma unroll
                    for (int g = 0; g < 4; ++g) tt = (g == grp) ? lg[4 + g * 8 + i] : tt;
                    rl[i] = tt + br[grp * 8 + i]; }
                int i0 = 0; float m0 = rl[0];
#pragma unroll
                for (int i = 1; i < 8; ++i) if (rl[i] > m0) { m0 = rl[i]; i0 = i; }
                int i1 = -1; float m1 = -3.0e38f;
#pragma unroll
                for (int i = 0; i < 8; ++i) if (i != i0 && rl[i] > m1) { m1 = rl[i]; i1 = i; }
                const float p0 = 1.0f, p1 = __expf(m1 - m0);
                const float w0 = pgrp * p0 / (p0 + p1), w1 = pgrp * p1 / (p0 + p1);
                const int e0 = grp * 8 + i0, e1 = grp * 8 + i1;
                const unsigned q0 = __hip_atomic_fetch_add(hist + e0, 1u, __ATOMIC_RELAXED, __HIP_MEMORY_SCOPE_WORKGROUP), q1 = __hip_atomic_fetch_add(hist + e1, 1u, __ATOMIC_RELAXED, __HIP_MEMORY_SCOPE_WORKGROUP);
                const int li = row - cb;
                rec[li * 4 + 0] = e0 | (e1 << 8); rec[li * 4 + 1] = (int)q0; rec[li * 4 + 2] = (int)q1;
                TW[row * 2 + 0] = w0; TW[row * 2 + 1] = w1;
            }
        }
        __syncthreads();
        if (C.tid < 32) gbase[C.tid] = hist[C.tid] ? atomicAdd(cnt + C.tid * CNT_STRIDE, hist[C.tid]) : 0u;
        __syncthreads();
        for (int i = C.tid; i < wend - cb; i += NT) { const int row = cb + i; const int ee = rec[i * 4], e0 = ee & 255, e1 = ee >> 8;
            const unsigned q0 = gbase[e0] + (unsigned)rec[i * 4 + 1], q1 = gbase[e1] + (unsigned)rec[i * 4 + 2];
            ST[(size_t)e0 * CAP + q0] = row; ST[(size_t)e1 * CAP + q1] = row;
            TS[row * 2 + 0] = (e0 << 20) | (int)q0; TS[row * 2 + 1] = (e1 << 20) | (int)q1; }
        __syncthreads();
    }
}

__device__ __forceinline__ void phase_final(const Args& A, const Ctx& C) {
    LAS int* sb = (LAS int*)C.lds;
    slot_bases(A, 3, sb, C.tid);
    const bf16* LAT = (const bf16*)(A.ws + WS_LAT); const unsigned char* Y8 = A.ws + WS_PB;
    const int* TS = (const int*)(A.ws + WS_TOKSLOT); const float* TW = (const float*)(A.ws + WS_TOKW);
    const float* MOD = (const float*)(A.ws + WS_MOD);
    f32x4 fg[4]; load_row_f32(A.in[7], C.lane, fg);
    const int rpw = (((NL + C.G - 1) / C.G) + 1) & ~1; const int wrow0 = C.bid * rpw; const int wend = min(wrow0 + rpw, NL);
    for (int sa = wrow0; sa < wend;) {
        const int mvi = mod_vec_of_row(sa); const int sbnd = min(wend, mvi == 0 ? SEQ : NL);
        f32x4 g2[4]; load_row_f32(MOD + (size_t)(3 * 3 + mvi) * 6 * D + 5 * D, C.lane, g2);
        for (int ra = sa + 2 * C.wave; ra < sbnd; ra += 2 * NW) {
            const int rb = ra + 1;
            const int ta0 = TS[ra * 2], ta1 = TS[ra * 2 + 1], tb0 = TS[rb * 2], tb1 = TS[rb * 2 + 1]; const float wa0 = TW[ra * 2], wa1 = TW[ra * 2 + 1], wb0 = TW[rb * 2], wb1 = TW[rb * 2 + 1];
            f32x4 va[4], vb[4]; unsigned ya0[4], ya1[4], yb0[4], yb1[4];
            load_row_bf16(LAT + (size_t)ra * D, C.lane, va); load_row_bf16(LAT + (size_t)rb * D, C.lane, vb);
            load_row_fp8raw(Y8 + (size_t)(sb[ta0 >> 20] + (ta0 & 0xfffff)) * D, C.lane, ya0); load_row_fp8raw(Y8 + (size_t)(sb[ta1 >> 20] + (ta1 & 0xfffff)) * D, C.lane, ya1);
            load_row_fp8raw(Y8 + (size_t)(sb[tb0 >> 20] + (tb0 & 0xfffff)) * D, C.lane, yb0); load_row_fp8raw(Y8 + (size_t)(sb[tb1 >> 20] + (tb1 & 0xfffff)) * D, C.lane, yb1);
#pragma unroll
            for (int q = 0; q < 4; ++q) { va[q] += g2[q] * (fp8x4(ya0[q]) * (wa0 * (1.0f / YSCALE)) + fp8x4(ya1[q]) * (wa1 * (1.0f / YSCALE))); vb[q] += g2[q] * (fp8x4(yb0[q]) * (wb0 * (1.0f / YSCALE)) + fp8x4(yb1[q]) * (wb1 * (1.0f / YSCALE))); }
            const float rra = row_rstd(va), rrb = row_rstd(vb);
#pragma unroll
            for (int q = 0; q < 4; ++q) { *(f32x4*)(A.out + (size_t)ra * D + 4 * C.lane + 256 * q) = (va[q] * rra) * fg[q]; *(f32x4*)(A.out + (size_t)rb * D + 4 * C.lane + 256 * q) = (vb[q] * rrb) * fg[q]; }
        }
        sa = sbnd;
    }
}

__device__ __forceinline__ void phase_conv(const Args& A, const Ctx& C, int l) {
    const int j = l >> 1; const int nrows = (l <= 1) ? NR : NL;
    const bf16* P = (const bf16*)(A.ws + WS_PB); unsigned char* HM = A.ws + WS_HM; float* RSC = (float*)(A.ws + WS_RSC);
    const float* cw = A.in[13] + (size_t)j * 3 * D;
    f32x4 w0[4], w1[4], w2[4];
    load_row_f32(cw, C.lane, w0); load_row_f32(cw + D, C.lane, w1); load_row_f32(cw + 2 * D, C.lane, w2);
    const int rpw = (((nrows + C.G - 1) / C.G) + 1) & ~1; const int wrow0 = C.bid * rpw; const int wend = min(wrow0 + rpw, nrows);
    for (int ra = wrow0 + 2 * C.wave; ra < wend; ra += 2 * NW) {
        const int rb = ra + 1;
        const int ta = ra < NL ? (ra & 63) : ((ra - NL) & 255), tb1 = rb < NL ? (rb & 63) : ((rb - NL) & 255), tlast = ra < NL ? 63 : 255;
        const bool hasl = ta != 0, hasr = tb1 != tlast;
        const bf16* pa = P + (size_t)ra * PW;
        u32x2 bga[4], bgb[4], zm[4], z0[4], z1[4], z2[4];
        load_row_bf16raw(pa, C.lane, bga); load_row_bf16raw(pa + PW, C.lane, bgb);
        load_row_bf16raw(pa + D, C.lane, z0); load_row_bf16raw(pa + PW + D, C.lane, z1);
        load_row_bf16raw(hasl ? pa - PW + D : pa + D, C.lane, zm); load_row_bf16raw(hasr ? pa + 2 * PW + D : pa + D, C.lane, z2);
        const float fl = hasl ? 1.f : 0.f, fr = hasr ? 1.f : 0.f;
        f32x4 oa[4], ob[4];
#pragma unroll
        for (int q = 0; q < 4; ++q) { const f32x4 a0 = bf4(z0[q]), a1 = bf4(z1[q]);
            oa[q] = bf4(bga[q]) * (w0[q] * (bf4(zm[q]) * fl) + w1[q] * a0 + w2[q] * a1);
            ob[q] = bf4(bgb[q]) * (w0[q] * a0 + w1[q] * a1 + w2[q] * (bf4(z2[q]) * fr)); }
        float ma = 0.f, mb = 0.f;
#pragma unroll
        for (int q = 0; q < 4; ++q) { ma = fmaxf(ma, fmaxf(fmaxf(fabsf(oa[q].x), fabsf(oa[q].y)), fmaxf(fabsf(oa[q].z), fabsf(oa[q].w)))); mb = fmaxf(mb, fmaxf(fmaxf(fabsf(ob[q].x), fabsf(ob[q].y)), fmaxf(fabsf(ob[q].z), fabsf(ob[q].w)))); }
        ma = fmaxf(wave_max_nn(ma), 1.0e-20f); mb = fmaxf(wave_max_nn(mb), 1.0e-20f);
        const float ia = 127.0f / ma, ib = 127.0f / mb;
#pragma unroll
        for (int q = 0; q < 4; ++q) { *(unsigned*)(HM + (size_t)ra * D + 4 * C.lane + 256 * q) = pack_i8(oa[q] * ia); *(unsigned*)(HM + (size_t)rb * D + 4 * C.lane + 256 * q) = pack_i8(ob[q] * ib); }
        if (C.lane == 0) { RSC[ra] = ma * (1.0f / 127.0f); RSC[rb] = mb * (1.0f / 127.0f); }
    }
}

constexpr int BM = 256, BK = 64, HALF = 128, HTB = HALF * BK * 2, STAGE_BYTES = 8 * HTB, NXCD = 8, WGM = 8;
constexpr int LDS_TAB = STAGE_BYTES;
__device__ __forceinline__ int lds_byte(int r, int c) { const int st = (r >> 4) * 2 + (c >> 5), rr = r & 15, cc = c & 31, ob = rr * 64 + cc * 2; return st * 1024 + (ob ^ (((ob >> 9) & 1) << 5)); }
__device__ __forceinline__ void stage_rc(int b, int& R, int& C) { const int st = b / 1024, sb = b % 1024, swz = sb ^ (((sb >> 9) & 1) << 5); R = (st >> 1) * 16 + swz / 64; C = (st & 1) * 32 + (swz % 64) / 2; }
__device__ __forceinline__ int perm32(int rho) { const int n = rho >> 4, i = rho & 15; return 8 * (i >> 2) + 4 * n + (i & 3); }
__device__ __forceinline__ unsigned cvt_pk_bf16(float lo, float hi) { unsigned r; asm volatile("v_cvt_pk_bf16_f32 %0, %1, %2" : "=v"(r) : "v"(lo), "v"(hi)); return r; }

struct GUnit { const char* a; const char* b; int orow, ocol, aux; };

typedef int i32x8 __attribute__((ext_vector_type(8)));
typedef int i32x4 __attribute__((ext_vector_type(4)));
template <class Epi, class Sched, bool GATHER, int OPM = 0>
__device__ __forceinline__ void gemm_phase(LAS unsigned char* lds, const int K, const Sched& S, const Epi& E) {
    const int tid = threadIdx.x, wid = __builtin_amdgcn_readfirstlane(tid >> 6), lane = tid & 63, wr = wid >> 2, wc = wid & 3, fr = lane & 15, fq = lane >> 4;
    constexpr bool FP8 = (OPM == 1), I8 = (OPM == 2);
    const int RB = (OPM != 0) ? K : 2 * K;
    const int nt = RB / (BK * 2);
    unsigned voffB[2], voA[2][2]; int Rr[2], Cc[2];
#pragma unroll
    for (int i = 0; i < 2; ++i) { int R, C; stage_rc(tid * 16 + i * 8192, R, C); const int Rb = (R & ~31) + perm32(R & 31); Rr[i] = R; Cc[i] = C;
        voffB[i] = (unsigned)(Rb * RB + C * 2);
        voA[0][i] = (unsigned)(R * RB + C * 2); voA[1][i] = (unsigned)((R + HALF) * RB + C * 2); }
    const size_t kstep = (size_t)(BK * 2);
    const size_t hstep = (size_t)HALF * RB;
    const unsigned ldsw = (unsigned)wid * 1024u;
    const unsigned ldsbase = (unsigned)(size_t)lds;
    const int aoff = lds_byte(wr * 64 + fr, fq * 8), boff = lds_byte(wc * 32 + fr, fq * 8);
#define PG8_SA(b, h) (((b) * 2 + (h)) * HTB)
#define PG8_SB(b, h) ((4 + (b) * 2 + (h)) * HTB)
#define PG8_STAGE(bufoff, gbase, voff) do { _Pragma("unroll") for (int _i = 0; _i < 2; ++_i) \
        asm volatile("s_mov_b32 m0, %2\n\ts_nop 0\n\tglobal_load_lds_dwordx4 %0, %1" :: "v"((voff)[_i]), "s"((const char*)(gbase)), "s"(ldsbase + (unsigned)(bufoff) + ldsw + (unsigned)(_i * 8192)) : "memory"); } while (0)
#define PG8_STAGE_A1(bufoff, gbase) do { if constexpr (GATHER) PG8_STAGE(bufoff, gbase, voA[1]); else PG8_STAGE(bufoff, (const char*)(gbase) + hstep, voA[0]); } while (0)
#define PG8_LDA(dst, b, h) do { if constexpr (FP8) { _Pragma("unroll") for (int m = 0; m < 4; ++m) { \
        const i32x4 _lo = *(const LAS i32x4*)(lds + PG8_SA(b, h) + aoff + m * 2048), _hi = *(const LAS i32x4*)(lds + PG8_SA(b, h) + aoff + m * 2048 + 1024); \
        dst##8[m] = __builtin_shufflevector(_lo, _hi, 0, 1, 2, 3, 4, 5, 6, 7); } } \
      else { _Pragma("unroll") for (int m = 0; m < 4; ++m) _Pragma("unroll") for (int k = 0; k < 2; ++k) dst[m][k] = *(const LAS bf16x8*)(lds + PG8_SA(b, h) + aoff + m * 2048 + k * 1024); } } while (0)
#define PG8_LDB(dst, b, h) do { if constexpr (FP8) { _Pragma("unroll") for (int n = 0; n < 2; ++n) { \
        const i32x4 _lo = *(const LAS i32x4*)(lds + PG8_SB(b, h) + boff + n * 2048), _hi = *(const LAS i32x4*)(lds + PG8_SB(b, h) + boff + n * 2048 + 1024); \
        dst##8[n] = __builtin_shufflevector(_lo, _hi, 0, 1, 2, 3, 4, 5, 6, 7); } } \
      else { _Pragma("unroll") for (int n = 0; n < 2; ++n) _Pragma("unroll") for (int k = 0; k < 2; ++k) dst[n][k] = *(const LAS bf16x8*)(lds + PG8_SB(b, h) + boff + n * 2048 + k * 1024); } } while (0)
#define PG8_MMA(ai, bj, At, Bt) do { __builtin_amdgcn_s_setprio(1); \
        if constexpr (FP8) { _Pragma("unroll") for (int m = 0; m < 4; ++m) _Pragma("unroll") for (int n = 0; n < 2; ++n) \
            acc[ai][bj][m][n] = __builtin_amdgcn_mfma_scale_f32_16x16x128_f8f6f4(Bt##8[n], At##8[m], acc[ai][bj][m][n], 0, 0, 0, 0x7f7f7f7f, 0, 0x7f7f7f7f); } \
        else if constexpr (I8) { _Pragma("unroll") for (int m = 0; m < 4; ++m) _Pragma("unroll") for (int n = 0; n < 2; ++n) _Pragma("unroll") for (int k = 0; k < 2; ++k) \
            acc[ai][bj][m][n] = __builtin_bit_cast(f32x4, __builtin_amdgcn_mfma_i32_16x16x64_i8(__builtin_bit_cast(i32x4, Bt[n][k]), __builtin_bit_cast(i32x4, At[m][k]), __builtin_bit_cast(i32x4, acc[ai][bj][m][n]), 0, 0, 0)); } \
        else { _Pragma("unroll") for (int m = 0; m < 4; ++m) _Pragma("unroll") for (int n = 0; n < 2; ++n) _Pragma("unroll") for (int k = 0; k < 2; ++k) \
            acc[ai][bj][m][n] = __builtin_amdgcn_mfma_f32_16x16x32_bf16(Bt[n][k], At[m][k], acc[ai][bj][m][n], 0, 0, 0); } \
        __builtin_amdgcn_s_setprio(0); } while (0)
#define PG8_WAIT_V(n) asm volatile("s_waitcnt vmcnt(" #n ")" ::: "memory")
#define PG8_WAIT_L(n) asm volatile("s_waitcnt lgkmcnt(" #n ")" ::: "memory")
#define PG8_BAR __builtin_amdgcn_s_barrier()
#define PG8_SCHED __builtin_amdgcn_sched_barrier(0)
    GUnit cur, nxt; int ui = 0;
    if (!S.next(0, cur)) return;
    if constexpr (GATHER) {
#pragma unroll
        for (int h = 0; h < 2; ++h)
#pragma unroll
            for (int i = 0; i < 2; ++i) voA[h][i] = S.arow_off(0, h * HALF + Rr[i]) + (unsigned)Cc[i] * 2u;
    }
    f32x4 acc[2][2][4][2];
#pragma unroll
    for (int a = 0; a < 2; ++a)
#pragma unroll
        for (int b = 0; b < 2; ++b)
#pragma unroll
            for (int m = 0; m < 4; ++m)
#pragma unroll
                for (int n = 0; n < 2; ++n) acc[a][b][m][n] = (f32x4){0.f, 0.f, 0.f, 0.f};
    bf16x8 At[4][2], B0[2][2], B1[2][2]; i32x8 At8[4], B08[2], B18[2];
    const char* cA = cur.a; const char* cB = cur.b;
    PG8_STAGE(PG8_SB(0, 0), cB, voffB); PG8_STAGE(PG8_SB(0, 1), cB + hstep, voffB); PG8_STAGE(PG8_SA(0, 0), cA, voA[0]); PG8_STAGE_A1(PG8_SA(0, 1), cA);
    if (wr == 1) PG8_BAR;
    PG8_WAIT_V(2); PG8_BAR;
    PG8_STAGE(PG8_SB(1, 0), cB + kstep, voffB); PG8_STAGE(PG8_SA(1, 0), cA + kstep, voA[0]); PG8_STAGE(PG8_SB(1, 1), cB + hstep + kstep, voffB);
    PG8_WAIT_V(6); PG8_BAR;
    for (;;) {
        const bool has_next = S.next(ui + 1, nxt);
        const char* nA = has_next ? nxt.a : cA; const char* nB = has_next ? nxt.b : cB;
#pragma unroll 1
        for (int t = 0; t < nt; t += 2) {
            const bool last = (t == nt - 2);
            const char* a1 = cA + (size_t)(t + 1) * kstep;
            const char* a2 = last ? nA : cA + (size_t)(t + 2) * kstep; const char* b2 = last ? nB : cB + (size_t)(t + 2) * kstep;
            const char* a3 = a2 + kstep; const char* b3 = b2 + kstep;
            PG8_LDB(B0, 0, 0); PG8_LDB(B1, 0, 1); PG8_SCHED; PG8_LDA(At, 0, 0); PG8_STAGE_A1(PG8_SA(1, 1), a1);
            if constexpr (GATHER) { if (last && has_next) {
#pragma unroll
                for (int h = 0; h < 2; ++h)
#pragma unroll
                    for (int i = 0; i < 2; ++i) { int R2, C2; stage_rc(tid * 16 + i * 8192, R2, C2); voA[h][i] = S.arow_off(ui + 1, h * HALF + R2) + (unsigned)C2 * 2u; } } }
            PG8_WAIT_V(8); PG8_WAIT_L(0); PG8_BAR; PG8_MMA(0, 0, At, B0); PG8_MMA(0, 1, At, B1); PG8_BAR; PG8_SCHED;
            PG8_LDA(At, 0, 1); PG8_STAGE(PG8_SB(0, 0), b2, voffB); PG8_STAGE(PG8_SB(0, 1), b2 + hstep, voffB); PG8_STAGE(PG8_SA(0, 0), a2, voA[0]);
            PG8_WAIT_V(8); PG8_WAIT_L(0); PG8_BAR; PG8_MMA(1, 0, At, B0); PG8_MMA(1, 1, At, B1); PG8_BAR; PG8_SCHED;
            PG8_LDB(B0, 1, 0); PG8_LDB(B1, 1, 1); PG8_SCHED; PG8_LDA(At, 1, 0); PG8_STAGE_A1(PG8_SA(0, 1), a2);
            PG8_WAIT_V(8); PG8_WAIT_L(0); PG8_BAR; PG8_MMA(0, 0, At, B0); PG8_MMA(0, 1, At, B1); PG8_BAR; PG8_SCHED;
            PG8_LDA(At, 1, 1); PG8_STAGE(PG8_SB(1, 0), b3, voffB); PG8_STAGE(PG8_SB(1, 1), b3 + hstep, voffB); PG8_STAGE(PG8_SA(1, 0), a3, voA[0]);
            PG8_WAIT_V(8); PG8_WAIT_L(0); PG8_BAR; PG8_MMA(1, 0, At, B0); PG8_MMA(1, 1, At, B1); PG8_BAR; PG8_SCHED;
        }
        if (wr == 0) PG8_BAR;
        { int tz = threadIdx.x; asm volatile("" : "+v"(tz));
          if constexpr (I8) {
#pragma unroll
              for (int a_ = 0; a_ < 2; ++a_)
#pragma unroll
                  for (int b_ = 0; b_ < 2; ++b_)
#pragma unroll
                      for (int m = 0; m < 4; ++m)
#pragma unroll
                          for (int n = 0; n < 2; ++n) acc[a_][b_][m][n] = __builtin_convertvector(__builtin_bit_cast(i32x4, acc[a_][b_][m][n]), f32x4); }
          const int wz = tz >> 6, lz = tz & 63; E(acc, cur, wz >> 2, wz & 3, lz & 15, lz >> 4); }
        if (!has_next) break;
#pragma unroll
        for (int a = 0; a < 2; ++a)
#pragma unroll
            for (int b = 0; b < 2; ++b)
#pragma unroll
                for (int m = 0; m < 4; ++m)
#pragma unroll
                    for (int n = 0; n < 2; ++n) acc[a][b][m][n] = (f32x4){0.f, 0.f, 0.f, 0.f};
        cur = nxt; cA = nA; cB = nB; ++ui;
        if (wr == 1) PG8_BAR;
    }
    PG8_WAIT_V(0);
    PG8_BAR;
#undef PG8_SA
#undef PG8_SB
#undef PG8_STAGE
#undef PG8_STAGE_A1
#undef PG8_LDA
#undef PG8_LDB
#undef PG8_MMA
#undef PG8_WAIT_V
#undef PG8_WAIT_L
#undef PG8_BAR
#undef PG8_SCHED
}

__device__ __forceinline__ int xcd_remap(int L, int nwg) { const int q = nwg / NXCD, r = nwg % NXCD, xcd = L % NXCD, off = L / NXCD; return (xcd < r ? xcd * (q + 1) : r * (q + 1) + (xcd - r) * q) + off; }

struct DenseSched {
    const char* A; const char* Bt; int nM, nN, nwg, G, c; size_t tstep; int sw_lo, sw_hi;
    __device__ __forceinline__ void init(const void* A_, const void* Bt_, int M, int N, int K, int G_, int c_, int ebytes = 2) { A = (const char*)A_; Bt = (const char*)Bt_; nM = M / BM; nN = N / BM; nwg = nM * nN; G = G_; c = c_; tstep = (size_t)BM * K * ebytes; sw_lo = 0; sw_hi = 0; }
    __device__ __forceinline__ bool next(int i, GUnit& u) const {
        const long L = (long)i * G + c; if (L >= nwg) return false;
        const int wgid = xcd_remap((int)L, nwg);
        const int nig = WGM * nN, gid = wgid / nig, fm = gid * WGM, gsz = (nM - fm) < WGM ? (nM - fm) : WGM;
        const int pm = fm + ((wgid % nig) % gsz), pn = (wgid % nig) / gsz;
        if (pn >= sw_lo && pn < sw_hi) { u.a = Bt + (size_t)pn * tstep; u.b = A + (size_t)pm * tstep; u.orow = pm; u.ocol = pn - sw_lo; u.aux = 1; }
        else { u.a = A + (size_t)pm * tstep; u.b = Bt + (size_t)pn * tstep; u.orow = pm * BM; u.ocol = pn * BM; u.aux = 0; }
        return true;
    }
    __device__ __forceinline__ unsigned arow_off(int, int) const { return 0u; }
};

constexpr int MAXU = 12;
struct MoeTab { int n; int e[MAXU], mb[MAXU], nt[MAXU]; int sb[NE + 1]; };
struct MoeSched {
    LAS const MoeTab* T; LAS const unsigned* ridx;
    const char* A; const char* W; size_t wstride_e, tstepB; int K; int arow_bytes;
    __device__ __forceinline__ bool next(int i, GUnit& u) const {
        const int n = __builtin_amdgcn_readfirstlane(T->n); if (i >= n) return false;
        const int e = __builtin_amdgcn_readfirstlane(T->e[i]), mb = __builtin_amdgcn_readfirstlane(T->mb[i]), nt = __builtin_amdgcn_readfirstlane(T->nt[i]);
        const int base = __builtin_amdgcn_readfirstlane(T->sb[e]);
        u.orow = base + mb * BM; u.ocol = nt; u.aux = e;
        u.a = A + (size_t)u.orow * arow_bytes;
        u.b = W + (size_t)e * wstride_e + (size_t)nt * tstepB; return true;
    }
    __device__ __forceinline__ unsigned arow_off(int i, int r) const { return ridx[i * 256 + r]; }
};
template <bool GATHER>
__device__ __forceinline__ void moe_tables(const Args& A, const Ctx& C, int l, int ntile_n, LAS MoeTab* T, LAS unsigned* ridx, int arow_bytes) {
    const unsigned* cnt = (const unsigned*)(A.ws + WS_CTL) + CW_CNT + l * 32 * CNT_STRIDE;
    LAS int* ust = (LAS int*)(T + 1);
    if (C.tid < 64) { int nb; const int ex = expert_block_prefix(cnt, C.tid, nb); if (C.tid <= NE) { T->sb[C.tid] = ex * 256; ust[C.tid] = ex * ntile_n; } }
    __syncthreads();
    if (C.tid < MAXU) { const int nwg = ust[NE]; const long L = (long)C.tid * C.G + C.bid;
        if (L < nwg) { const int w = xcd_remap((int)L, nwg); int e = 0; while (w >= ust[e + 1]) ++e;
            const int lu = w - ust[e]; T->e[C.tid] = e; T->mb[C.tid] = lu / ntile_n; T->nt[C.tid] = lu % ntile_n; } }
    if (C.tid == 0) { const int nwg = ust[NE]; int n = 0; while (n < MAXU && (long)n * C.G + C.bid < nwg) ++n; T->n = n; }
    __syncthreads();
    if constexpr (GATHER) {
        const int* ST = (const int*)(A.ws + WS_SLOTTOK); const int n = T->n;
        for (int i = C.tid; i < n * 256; i += NT) { const int ui = i >> 8, r = i & 255, e = T->e[ui], m0 = T->mb[ui] * 256, ce = (int)cnt[e * CNT_STRIDE];
            const int rr = (m0 + r < ce) ? m0 + r : ce - 1;
            ridx[i] = (unsigned)ST[(size_t)e * CAP + rr] * (unsigned)arow_bytes; }
        __syncthreads();
    }
}

struct EpiStore { bf16* O; int ldc; float scale_lo; int sig_from; bf16* VT; float sall = 1.0f; const float* rs = nullptr;
    __device__ __forceinline__ void operator()(const f32x4 (&acc)[2][2][4][2], const GUnit& u, int wr, int wc, int fr, int fq) const {
        const bool tr = u.aux != 0;
        const float sc = ((!tr && u.ocol < NQ) ? scale_lo : 1.0f) * sall; const bool sg = !tr && u.ocol >= sig_from;
        bf16* Ob = tr ? VT + (size_t)(u.orow * NH + u.ocol) * 65536 : O + (size_t)u.orow * ldc + u.ocol; const int ld = tr ? 256 : ldc;
        f32x4 cs[2][2];
#pragma unroll
        for (int bj = 0; bj < 2; ++bj) { const f32x4 one = (f32x4){1.f, 1.f, 1.f, 1.f};
            cs[bj][0] = (rs && tr) ? *(const f32x4*)(rs + u.orow * BM + bj * HALF + wc * 32 + 8 * fq) : one; cs[bj][1] = (rs && tr) ? *(const f32x4*)(rs + u.orow * BM + bj * HALF + wc * 32 + 8 * fq + 4) : one; }
#pragma unroll
        for (int ai = 0; ai < 2; ++ai)
#pragma unroll
            for (int m = 0; m < 4; ++m) { const int rl = ai * HALF + wr * 64 + m * 16 + fr; bf16* rowp = Ob + (size_t)rl * ld + wc * 32 + 8 * fq;
                const float scr = (rs && !tr) ? sc * rs[u.orow + rl] : sc;
#pragma unroll
                for (int bj = 0; bj < 2; ++bj) { f32x4 v0 = acc[ai][bj][m][0] * scr * cs[bj][0], v1 = acc[ai][bj][m][1] * scr * cs[bj][1];
                    if (sg) {
#pragma unroll
                        for (int q = 0; q < 4; ++q) { v0[q] = __builtin_amdgcn_rcpf(1.0f + __expf(-v0[q])); v1[q] = __builtin_amdgcn_rcpf(1.0f + __expf(-v1[q])); } }
                    u32x4 w; w.x = cvt_pk_bf16(v0[0], v0[1]); w.y = cvt_pk_bf16(v0[2], v0[3]); w.z = cvt_pk_bf16(v1[0], v1[1]); w.w = cvt_pk_bf16(v1[2], v1[3]);
                    *(u32x4*)(rowp + bj * HALF) = w; } }
    }
};
__device__ __forceinline__ u32x2 cvt8_fp8(f32x4 a, f32x4 b) { int lo = 0, hi = 0;
    lo = __builtin_amdgcn_cvt_pk_fp8_f32(a[0], a[1], lo, false); lo = __builtin_amdgcn_cvt_pk_fp8_f32(a[2], a[3], lo, true);
    hi = __builtin_amdgcn_cvt_pk_fp8_f32(b[0], b[1], hi, false); hi = __builtin_amdgcn_cvt_pk_fp8_f32(b[2], b[3], hi, true); return (u32x2){(unsigned)lo, (unsigned)hi}; }
struct EpiSwigluF8 { unsigned char* O; int ldc; float s;
    __device__ __forceinline__ void operator()(const f32x4 (&acc)[2][2][4][2], const GUnit& u, int wr, int wc, int fr, int fq) const {
        const int ocol = u.ocol * HALF;
#pragma unroll
        for (int ai = 0; ai < 2; ++ai)
#pragma unroll
            for (int m = 0; m < 4; ++m) { unsigned char* rowp = O + (size_t)(u.orow + ai * HALF + wr * 64 + m * 16 + fr) * ldc + ocol + wc * 32 + 8 * fq;
                f32x4 v0, v1;
#pragma unroll
                for (int q = 0; q < 4; ++q) { const float x0 = acc[ai][0][m][0][q] * s, x1 = acc[ai][0][m][1][q] * s;
                    v0[q] = x0 * __builtin_amdgcn_rcpf(1.0f + __expf(-x0)) * (acc[ai][1][m][0][q] * s); v1[q] = x1 * __builtin_amdgcn_rcpf(1.0f + __expf(-x1)) * (acc[ai][1][m][1][q] * s); }
                *(u32x2*)rowp = cvt8_fp8(v0, v1); }
    }
};
template <int MODE> struct EpiPair { bf16* O; int ldc; int plain_below; float sall = 1.0f; const float* rs = nullptr;
    __device__ __forceinline__ void operator()(const f32x4 (&acc)[2][2][4][2], const GUnit& u, int wr, int wc, int fr, int fq) const {
        if (MODE == 0 && u.ocol < plain_below) {
#pragma unroll
            for (int ai = 0; ai < 2; ++ai)
#pragma unroll
                for (int m = 0; m < 4; ++m) { const int rg = u.orow + ai * HALF + wr * 64 + m * 16 + fr; bf16* rowp = O + (size_t)rg * ldc + u.ocol + wc * 32 + 8 * fq;
                    const float scr = rs ? sall * rs[rg] : sall;
#pragma unroll
                    for (int bj = 0; bj < 2; ++bj) { const f32x4 v0 = acc[ai][bj][m][0] * scr, v1 = acc[ai][bj][m][1] * scr;
                        u32x4 w; w.x = cvt_pk_bf16(v0[0], v0[1]); w.y = cvt_pk_bf16(v0[2], v0[3]); w.z = cvt_pk_bf16(v1[0], v1[1]); w.w = cvt_pk_bf16(v1[2], v1[3]);
                        *(u32x4*)(rowp + bj * HALF) = w; } }
            return;
        }
        const int ocol = (MODE == 0) ? plain_below + (u.ocol - plain_below) / 2 : u.ocol * HALF;
#pragma unroll
        for (int ai = 0; ai < 2; ++ai)
#pragma unroll
            for (int m = 0; m < 4; ++m) { const int rg = u.orow + ai * HALF + wr * 64 + m * 16 + fr; bf16* rowp = O + (size_t)rg * ldc + ocol + wc * 32 + 8 * fq;
                const float scr = rs ? sall * rs[rg] : sall; const float sc2 = scr * scr;
                f32x4 v0, v1;
#pragma unroll
                for (int q = 0; q < 4; ++q) {
                    const float x0 = acc[ai][0][m][0][q], x1 = acc[ai][0][m][1][q];
                    const float g0 = (MODE == 1) ? x0 * __builtin_amdgcn_rcpf(1.0f + __expf(-x0)) : x0, g1 = (MODE == 1) ? x1 * __builtin_amdgcn_rcpf(1.0f + __expf(-x1)) : x1;
                    v0[q] = g0 * acc[ai][1][m][0][q] * sc2; v1[q] = g1 * acc[ai][1][m][1][q] * sc2; }
                u32x4 w; w.x = cvt_pk_bf16(v0[0], v0[1]); w.y = cvt_pk_bf16(v0[2], v0[3]); w.z = cvt_pk_bf16(v1[0], v1[1]); w.w = cvt_pk_bf16(v1[2], v1[3]);
                *(u32x4*)rowp = w; }
    }
};
struct EpiStoreTile { unsigned char* O; int ldc; float s;
    __device__ __forceinline__ void operator()(const f32x4 (&acc)[2][2][4][2], const GUnit& u, int wr, int wc, int fr, int fq) const {
#pragma unroll
        for (int ai = 0; ai < 2; ++ai)
#pragma unroll
            for (int m = 0; m < 4; ++m) { unsigned char* rowp = O + (size_t)(u.orow + ai * HALF + wr * 64 + m * 16 + fr) * ldc + u.ocol * BM + wc * 32 + 8 * fq;
#pragma unroll
                for (int bj = 0; bj < 2; ++bj) *(u32x2*)(rowp + bj * HALF) = cvt8_fp8(acc[ai][bj][m][0] * s, acc[ai][bj][m][1] * s); }
    }
};

__device__ __forceinline__ void transpose_item(const float* W, int ldw, int K, bf16* WT, int drow0, int k0, int n0, LAS float* scr, int lane) {
#pragma unroll
    for (int i = 0; i < 32; ++i) { const int kk = 2 * i + (lane >> 5); scr[kk * 33 + (lane & 31)] = W[(size_t)(k0 + kk) * ldw + n0 + (lane & 31)]; }
    asm volatile("s_waitcnt lgkmcnt(0)" ::: "memory");
    const int c = lane & 7;
#pragma unroll
    for (int j = 0; j < 4; ++j) { const int n = (lane >> 3) + 8 * j; const LAS float* s = scr + (8 * c) * 33 + n;
        u32x4 o; o.x = pk2(s[0 * 33], s[1 * 33]); o.y = pk2(s[2 * 33], s[3 * 33]); o.z = pk2(s[4 * 33], s[5 * 33]); o.w = pk2(s[6 * 33], s[7 * 33]);
        *(u32x4*)(WT + (size_t)(drow0 + n) * K + k0 + 8 * c) = o; }
    asm volatile("s_waitcnt lgkmcnt(0)" ::: "memory");
}
__device__ __forceinline__ void transpose_item_fp8(const float* W, int ldw, int K, unsigned char* WT8, int drow0, int k0, int n0, LAS float* scr, int lane, float sc) {
#pragma unroll
    for (int i = 0; i < 32; ++i) { const int kk = 2 * i + (lane >> 5); scr[kk * 33 + (lane & 31)] = W[(size_t)(k0 + kk) * ldw + n0 + (lane & 31)]; }
    asm volatile("s_waitcnt lgkmcnt(0)" ::: "memory");
    const int n = lane >> 1, half = lane & 1; const LAS float* sp = scr + (32 * half) * 33 + n;
    unsigned char* dst = WT8 + (size_t)(drow0 + n) * K + k0 + 32 * half;
#pragma unroll
    for (int c = 0; c < 2; ++c) { u32x4 o;
#pragma unroll
        for (int q = 0; q < 4; ++q) { int p = 0; const LAS float* s4 = sp + (16 * c + 4 * q) * 33;
            p = __builtin_amdgcn_cvt_pk_fp8_f32(s4[0] * sc, s4[33] * sc, p, false); p = __builtin_amdgcn_cvt_pk_fp8_f32(s4[66] * sc, s4[99] * sc, p, true); o[q] = (unsigned)p; }
        *(u32x4*)(dst + 16 * c) = o; }
    asm volatile("s_waitcnt lgkmcnt(0)" ::: "memory");
}
__device__ __forceinline__ void transpose_item_i8(const float* W, int ldw, int K, unsigned char* WT8, int drow0, int k0, int n0, LAS float* scr, int lane, float inv) {
#pragma unroll
    for (int i = 0; i < 32; ++i) { const int kk = 2 * i + (lane >> 5); scr[kk * 33 + (lane & 31)] = W[(size_t)(k0 + kk) * ldw + n0 + (lane & 31)]; }
    asm volatile("s_waitcnt lgkmcnt(0)" ::: "memory");
    const int n = lane >> 1, half = lane & 1; const LAS float* sp = scr + (32 * half) * 33 + n;
    unsigned char* dst = WT8 + (size_t)(drow0 + n) * K + k0 + 32 * half;
#pragma unroll
    for (int c = 0; c < 2; ++c) { u32x4 o;
#pragma unroll
        for (int q = 0; q < 4; ++q) { const LAS float* s4 = sp + (16 * c + 4 * q) * 33; o[q] = pack_i8((f32x4){s4[0] * inv, s4[33] * inv, s4[66] * inv, s4[99] * inv}); }
        *(u32x4*)(dst + 16 * c) = o; }
    asm volatile("s_waitcnt lgkmcnt(0)" ::: "memory");
}
__device__ __forceinline__ int pair_row(int n, int which) { return (n >> 7) * 256 + (n & 127) + which * 128; }
constexpr float HMR = 6.0f;
__device__ __forceinline__ void phase_cvt_mixer(const Args& A, const Ctx& C) {
    const int gw = C.bid * NW + C.wave, NGW = C.G * NW;
    unsigned* wmax = (unsigned*)(A.ws + WS_CTL) + CW_WMAX;
    for (int m8 = 0; m8 < 8; ++m8) {
        const float* W = m8 < 2 ? A.in[8] + (size_t)m8 * D * PROJ : m8 < 4 ? A.in[12] + (size_t)(m8 - 2) * D * PW : m8 < 6 ? A.in[11] + (size_t)(m8 - 4) * D * D : A.in[14] + (size_t)(m8 - 6) * D * D;
        const size_t n4 = (size_t)D * (m8 < 2 ? PROJ : m8 < 4 ? PW : D) / 4;
        float mx = 0.f;
        for (size_t i = (size_t)gw * 64 + C.lane; i < n4; i += (size_t)NGW * 64) { const f32x4 v = *(const f32x4*)(W + 4 * i); mx = fmaxf(mx, fmaxf(fmaxf(fabsf(v.x), fabsf(v.y)), fmaxf(fabsf(v.z), fabsf(v.w)))); }
        mx = wave_max_nn(mx);
        if (C.lane == 0 && mx > 0.f) atomicMax(wmax + m8 * CNT_STRIDE, __float_as_uint(mx));
    }
}
__device__ __forceinline__ void cvt_win_i8(const Args& A, const Ctx& C) {
    LAS float* scr = (LAS float*)(C.lds + 16384 + C.wave * 16384);
    const int gw = C.bid * NW + C.wave, NGW = C.G * NW;
    constexpr int I_IN = (D / 64) * (PW / 32);
    const unsigned* wmax = (const unsigned*)(A.ws + WS_CTL) + CW_WMAX;
    constexpr int I_OUT = (D / 64) * (D / 32);
    for (int it = gw; it < 4 * I_OUT; it += NGW) {
        const int m4 = it / I_OUT, kind = m4 >> 1, j = m4 & 1, r = it % I_OUT; const int kb = r / (D / 32), nb = r % (D / 32), n0 = nb * 32;
        const float inv = 127.0f / fmaxf(__uint_as_float(wmax[(4 + m4) * CNT_STRIDE]), 1.0e-30f);
        transpose_item_i8((kind == 0 ? A.in[11] : A.in[14]) + (size_t)j * D * D, D, D, A.ws + (kind == 0 ? WS_WAOUT : WS_WBOUT) + (size_t)j * D * D, n0, kb * 64, n0, scr, C.lane, inv); }
    for (int it = gw; it < 4 * I_IN; it += NGW) {
        const int m4 = it / I_IN, kind = m4 >> 1, j = m4 & 1, r = it % I_IN; const int kb = r / (PW / 32), nb = r % (PW / 32), n0 = nb * 32;
        const float inv = 127.0f / fmaxf(__uint_as_float(wmax[m4 * CNT_STRIDE]), 1.0e-30f);
        unsigned char* WT = A.ws + (kind == 0 ? WS_WAIN : WS_WBIN) + (size_t)j * PW * D;
        if (kind == 0) transpose_item_i8(A.in[8] + (size_t)j * D * PROJ, PROJ, D, WT, n0, kb * 64, n0, scr, C.lane, inv);
        else { const int drow = n0 < D ? n0 : (n0 < 2 * D ? D + pair_row(n0 - D, 0) : D + pair_row(n0 - 2 * D, 1));
            transpose_item_i8(A.in[12] + (size_t)j * D * PW, PW, D, WT, drow, kb * 64, n0, scr, C.lane, inv); }
    }
}
__device__ __forceinline__ void cvt_moe_items(const Args& A, const Ctx& C, int l, int it0, int end, int stride) {
    LAS float* scr = (LAS float*)(C.lds + 16384 + C.wave * 16384);
    unsigned char* WGU = A.ws + WS_WGU; unsigned char* WDN = A.ws + WS_WDN;
    for (int it = it0; it < end; it += stride) {
        const int e = it / CVT_PER; int r = it % CVT_PER;
        if (r < 2 * CVT_IG) { const int which = r / CVT_IG; r %= CVT_IG; const int kb = r / (DE / 32), nb = r % (DE / 32), n0 = nb * 32;
            transpose_item_fp8((which == 0 ? A.in[19] : A.in[20]) + ((size_t)l * NE + e) * D * DE, DE, D, WGU + (size_t)e * 2 * DE * D, pair_row(n0, which), kb * 64, n0, scr, C.lane, WSCALE); }
        else { r -= 2 * CVT_IG; const int kb = r / (D / 32), nb = r % (D / 32), n0 = nb * 32;
            transpose_item_fp8(A.in[21] + ((size_t)l * NE + e) * DE * D, D, DE, WDN + (size_t)e * D * DE, n0, kb * 64, n0, scr, C.lane, WSCALE); }
    }
}
__device__ __forceinline__ int cvt_idle(int nunits, int G) { const int rem = nunits % G; return rem ? G - rem : 0; }
__device__ __forceinline__ int cvt_t1(int l, int G) { const int n = cvt_idle((((l <= 2) ? NR : NL) / BM) * (PW / BM), G) * CVT_Q; return n < CVT_ITEMS ? n : CVT_ITEMS; }
__device__ __forceinline__ int cvt_t2(int l, int G) { const int n = cvt_t1(l, G) + cvt_idle((((l <= 1) ? NR : NL) / BM) * (D / BM), G) * CVT_Q; return n < CVT_ITEMS ? n : CVT_ITEMS; }
__device__ __forceinline__ void cvt_moe_tail(const Args& A, const Ctx& C, int l, int nunits, int base, int end) {
    const int rem = nunits % C.G;
    if (rem == 0 || C.bid < rem) return;
    const int first = base + (C.bid - rem) * CVT_Q; const int last = min(first + CVT_Q, end);
    cvt_moe_items(A, C, l, first + C.wave, last, NW);
}

__device__ __forceinline__ void phase_g1(const Args& A, const Ctx& C, int l) {
    const bool mls = (l & 1) == 0; const int j = l >> 1; const int nrows = (l <= 2) ? NR : NL;
    DenseSched S; S.init(A.ws + WS_H8, A.ws + (mls ? WS_WAIN : WS_WBIN) + (size_t)j * PW * D, nrows, PW, D, C.G, C.bid, 1);
    const float wsc = __uint_as_float(((const unsigned*)(A.ws + WS_CTL))[CW_WMAX + ((mls ? 0 : 2) + j) * CNT_STRIDE]) * (1.0f / 127.0f);
    const float* rs = (const float*)(A.ws + WS_RSC);
    if (mls) { S.sw_lo = 4; S.sw_hi = 8; EpiStore E{(bf16*)(A.ws + WS_PB), PW, 0.08838834764831845f, 2 * NQ + NV, (bf16*)(A.ws + WS_VT), wsc, rs}; gemm_phase<EpiStore, DenseSched, false, 2>(C.lds, D, S, E); }
    else { EpiPair<0> E{(bf16*)(A.ws + WS_PB), PW, D, wsc, rs}; gemm_phase<EpiPair<0>, DenseSched, false, 2>(C.lds, D, S, E); }
    cvt_moe_tail(A, C, l, S.nwg, 0, cvt_t1(l, C.G));
}
__device__ __forceinline__ void phase_g2(const Args& A, const Ctx& C, int l) {
    const bool mls = (l & 1) == 0; const int j = l >> 1; const int nrows = (l <= 1) ? NR : NL;
    DenseSched S; S.init(A.ws + WS_HM, A.ws + (mls ? WS_WAOUT : WS_WBOUT) + (size_t)j * D * D, nrows, D, D, C.G, C.bid, 1);
    const float wsc = __uint_as_float(((const unsigned*)(A.ws + WS_CTL))[CW_WMAX + (4 + (mls ? 0 : 2) + j) * CNT_STRIDE]) * (1.0f / 127.0f);
    EpiStore E{(bf16*)(A.ws + WS_HB), D, 1.0f, 1 << 30, nullptr, mls ? wsc * (HMR / 127.0f) : wsc, mls ? nullptr : (const float*)(A.ws + WS_RSC)}; gemm_phase<EpiStore, DenseSched, false, 2>(C.lds, D, S, E);
    cvt_moe_tail(A, C, l, S.nwg, cvt_t1(l, C.G), cvt_t2(l, C.G));
}
__device__ __forceinline__ void phase_m1(const Args& A, const Ctx& C, int l) {
    LAS MoeTab* T = (LAS MoeTab*)(C.lds + LDS_TAB); LAS unsigned* ridx = (LAS unsigned*)(C.lds + LDS_TAB + 1024);
    moe_tables<true>(A, C, l, 4, T, ridx, D);
    MoeSched S; S.T = T; S.ridx = ridx; S.A = (const char*)(A.ws + WS_H8); S.W = (const char*)(A.ws + WS_WGU); S.wstride_e = (size_t)2 * DE * D; S.tstepB = (size_t)BM * D; S.K = D; S.arow_bytes = 0;
    EpiSwigluF8 E{A.ws + WS_DC, DE, 1.0f / WSCALE}; gemm_phase<EpiSwigluF8, MoeSched, true, 1>(C.lds, D, S, E);
}
__device__ __forceinline__ void phase_m2(const Args& A, const Ctx& C, int l) {
    LAS MoeTab* T = (LAS MoeTab*)(C.lds + LDS_TAB); LAS unsigned* ridx = (LAS unsigned*)(C.lds + LDS_TAB + 1024);
    moe_tables<false>(A, C, l, 4, T, ridx, DE);
    MoeSched S; S.T = T; S.ridx = ridx; S.A = (const char*)(A.ws + WS_DC); S.W = (const char*)(A.ws + WS_WDN); S.wstride_e = (size_t)D * DE; S.tstepB = (size_t)BM * DE; S.K = DE; S.arow_bytes = DE;
    EpiStoreTile E{A.ws + WS_PB, D, YSCALE / WSCALE}; gemm_phase<EpiStoreTile, MoeSched, false, 1>(C.lds, DE, S, E);
}

typedef float f32x16 __attribute__((ext_vector_type(16)));
#define MFMA32(a, b, c) __builtin_amdgcn_mfma_f32_32x32x16_bf16((a), (b), (c), 0, 0, 0)
__device__ __forceinline__ bf16x8 pack8(float a0, float a1, float a2, float a3, float a4, float a5, float a6, float a7) {
    u32x4 p; p.x = cvt2(a0, a1); p.y = cvt2(a2, a3); p.z = cvt2(a4, a5); p.w = cvt2(a6, a7); return __builtin_bit_cast(bf16x8, p); }
__device__ __forceinline__ float bflo(unsigned w) { return __uint_as_float(w << 16); }
__device__ __forceinline__ float bfhi(unsigned w) { return __uint_as_float(w & 0xffff0000u); }
__device__ __forceinline__ int vt_tile(int b, int h, int blk) { return (blk == 0 ? 128 + b : b * 64 + blk - 1) * NH + h; }

__device__ __forceinline__ float wave_incl_scan(float v, int lane) {
#pragma unroll
    for (int o = 1; o < 64; o <<= 1) { const float t = __shfl_up(v, o); v += (lane >= o) ? t : 0.f; }
    return v;
}
__device__ __forceinline__ void block_gates(const Args& A, int row0, int h, LAS float* bf, LAS float* bb, LAS float* lif, LAS float* lib, int tid) {
    const float* GATE = (const float*)(A.ws + WS_GATE);
    if (tid < 256) { const float* g = GATE + (size_t)(row0 + tid) * 16; lif[tid] = g[0 + h]; bf[tid] = g[4 + h]; lib[tid] = g[8 + h]; bb[tid] = g[12 + h]; }
    __syncthreads();
    const int lane = tid & 63, wv = tid >> 6;
    if (wv == 0) { f32x4 x = *(LAS f32x4*)(bf + 4 * lane); x.y += x.x; x.z += x.y; x.w += x.z; const float tot = wave_incl_scan(x.w, lane); const float ex = tot - x.w;
        x.x += ex; x.y += ex; x.z += ex; x.w += ex; *(LAS f32x4*)(bf + 4 * lane) = x; }
    if (wv == 1) { f32x4 y = *(LAS f32x4*)(bb + 4 * (63 - lane)); y.z += y.w; y.y += y.z; y.x += y.y; const float tot = wave_incl_scan(y.x, lane); const float ex = tot - y.x;
        y.x += ex; y.y += ex; y.z += ex; y.w += ex; *(LAS f32x4*)(bb + 4 * (63 - lane)) = y; }
    __syncthreads();
}
__device__ __forceinline__ void phase_s1(const Args& A, const Ctx& C, int l) {
    LAS float* bf = (LAS float*)C.lds; LAS float* bb = bf + 256; LAS float* lif = bb + 256; LAS float* lib = lif + 256; LAS float* af = lib + 256; LAS float* ab = af + 256;
    constexpr int KP = 528;
    LAS unsigned char* KTf = C.lds + 8192; LAS unsigned char* KTb = KTf + 128 * KP;
    const bf16* P = (const bf16*)(A.ws + WS_PB); const bf16* VT = (const bf16*)(A.ws + WS_VT);
    float* DC = (float*)(A.ws + WS_DC); float* DN = (float*)(A.ws + WS_DN); float* BT = (float*)(A.ws + WS_BTOT);
    const int r = C.lane & 31, hh = C.lane >> 5, w = C.wave;
    for (int u = C.bid; u < NUNIT; u += C.G) {
        const int blk = u % NBLK, bh = u / NBLK, h = bh % NH, b = bh / NH; const int row0 = blk_row0(b, blk);
        block_gates(A, row0, h, bf, bb, lif, lib, C.tid);
        if (C.tid < 256) { af[C.tid] = __expf(bf[255] - bf[C.tid] + lif[C.tid]); ab[C.tid] = __expf(bb[0] - bb[C.tid] + lib[C.tid]); }
        if (C.tid == 0) { BT[u * 2 + 0] = bf[255]; BT[u * 2 + 1] = bb[0]; }
        __syncthreads();
        { const int sp = C.tid >> 2, dq = C.tid & 3, s0 = 2 * sp;
          const bf16* k0 = P + (size_t)(row0 + s0) * PW + NQ + h * DQK + 32 * dq;
          const float f0 = af[s0], f1 = af[s0 + 1], g0 = ab[s0], g1 = ab[s0 + 1];
#pragma unroll
          for (int c = 0; c < 4; ++c) { const u32x4 x0 = *(const u32x4*)(k0 + 8 * c), x1 = *(const u32x4*)(k0 + PW + 8 * c);
#pragma unroll
              for (int q = 0; q < 4; ++q) { const int d = 32 * dq + 8 * c + 2 * q;
                  const float a0 = bflo(x0[q]), a1 = bfhi(x0[q]), c0 = bflo(x1[q]), c1 = bfhi(x1[q]);
                  *(LAS unsigned*)(KTf + d * KP + s0 * 2) = cvt2(a0 * f0, c0 * f1); *(LAS unsigned*)(KTf + (d + 1) * KP + s0 * 2) = cvt2(a1 * f0, c1 * f1);
                  *(LAS unsigned*)(KTb + d * KP + s0 * 2) = cvt2(a0 * g0, c0 * g1); *(LAS unsigned*)(KTb + (d + 1) * KP + s0 * 2) = cvt2(a1 * g0, c1 * g1); } } }
        __syncthreads();
        if (C.tid < 256) { const int dir = C.tid >> 7, d = C.tid & 127; LAS const unsigned* kr = (LAS const unsigned*)((dir ? KTb : KTf) + d * KP); float s = 0.f;
            for (int i = 0; i < 128; ++i) { const unsigned x = kr[i]; s += bflo(x) + bfhi(x); }
            DN[(size_t)(u * 2 + dir) * DQK + d] = s; }
        const bf16* vt = VT + (size_t)vt_tile(b, h, blk) * 65536 + (size_t)(32 * w + r) * 256 + 8 * hh;
        f32x16 accf[4], accb[4];
#pragma unroll
        for (int dt = 0; dt < 4; ++dt)
#pragma unroll
            for (int i = 0; i < 16; ++i) { accf[dt][i] = 0.f; accb[dt][i] = 0.f; }
#pragma unroll 2
        for (int ks = 0; ks < 16; ++ks) { const bf16x8 a = *(const bf16x8*)(vt + 16 * ks);
#pragma unroll
            for (int dt = 0; dt < 4; ++dt) { const int off = (dt * 32 + r) * KP + (16 * ks + 8 * hh) * 2;
                const bf16x8 b0 = *(const LAS bf16x8*)(KTf + off), b1 = *(const LAS bf16x8*)(KTb + off);
                accf[dt] = MFMA32(a, b0, accf[dt]); accb[dt] = MFMA32(a, b1, accb[dt]); } }
        float* dcf = DC + (size_t)(u * 2 + 0) * DQK * DV + (size_t)(32 * w + 4 * hh) * DQK + r; float* dcb = dcf + DQK * DV;
#pragma unroll
        for (int g = 0; g < 4; ++g) { float* pf = dcf + g * 8 * DQK; float* pb = dcb + g * 8 * DQK; asm volatile("" : "+v"(pf), "+v"(pb));
#pragma unroll
            for (int q = 0; q < 4; ++q)
#pragma unroll
                for (int dt = 0; dt < 4; ++dt) { pf[q * DQK + dt * 32] = accf[dt][4 * g + q]; pb[q * DQK + dt * 32] = accb[dt][4 * g + q]; } }
        __syncthreads();
    }
}
__device__ __forceinline__ void phase_s2(const Args& A, const Ctx& C) {
    const float* __restrict__ DC = (const float*)(A.ws + WS_DC); const float* __restrict__ DN = (const float*)(A.ws + WS_DN); const float* __restrict__ BT = (const float*)(A.ws + WS_BTOT);
    bf16* __restrict__ CST = (bf16*)(A.ws + WS_CST); float* __restrict__ NST = (float*)(A.ws + WS_NST);
    constexpr int EL4 = DQK * DV / 4;
    for (int g = C.bid * NT + C.tid; g < BATCH * NH * 2 * EL4; g += C.G * NT) {
        const int e4 = (g % EL4) * 4, ch = g / EL4, dir = ch & 1, bh = ch >> 1;
        f32x4 st = (f32x4){0.f, 0.f, 0.f, 0.f};
#pragma unroll 13
        for (int idx = 0; idx < NBLK; ++idx) {
            const int blk = dir == 0 ? idx : (idx == 0 ? 0 : NBLK - idx); const int u = bh * NBLK + blk;
            const float dec = __expf(BT[u * 2 + dir]);
            const f32x4 dc = *(const f32x4*)(DC + (size_t)(u * 2 + dir) * DQK * DV + e4);
            u32x2 o; o.x = cvt2(st.x, st.y); o.y = cvt2(st.z, st.w);
            *(u32x2*)(CST + (size_t)(u * 2 + dir) * DQK * DV + e4) = o;
            st = st * dec + dc;
        }
    }
    for (int g = C.bid * NT + C.tid; g < BATCH * NH * 2 * DQK; g += C.G * NT) {
        const int d = g % DQK, ch = g / DQK, dir = ch & 1, bh = ch >> 1; float st = 0.f;
        for (int idx = 0; idx < NBLK; ++idx) {
            const int blk = dir == 0 ? idx : (idx == 0 ? 0 : NBLK - idx); const int u = bh * NBLK + blk;
            NST[(size_t)(u * 2 + dir) * DQK + d] = st; st = __expf(BT[u * 2 + dir]) * st + DN[(size_t)(u * 2 + dir) * DQK + d];
        }
    }
}
__device__ __forceinline__ void lds_barrier() { asm volatile("s_waitcnt lgkmcnt(0)" ::: "memory"); __builtin_amdgcn_s_barrier(); asm volatile("" ::: "memory"); }
__device__ __forceinline__ void phase_s3(const Args& A, const Ctx& C, int l) {
    const int jl = l >> 1; const bool ctx_out = (l == 0);
    LAS float* bf = (LAS float*)C.lds; LAS float* bb = bf + 256; LAS float* gf = bb + 256; LAS float* gb = gf + 256;
    LAS float* nf = gb + 256; LAS float* nb = nf + 128; LAS float* ssx = nb + 128;
    LAS float* cf = ssx + 256; LAS float* cb = cf + 256;
    constexpr int KP = 272, OP = 528, CHB = 16384, NCHB = 4;
    LAS unsigned char* Kimg = C.lds + 8192;
    LAS unsigned char* CH = Kimg + 256 * KP;
    static_assert(8192 + 256 * KP + 128 * OP <= LDS_TAB_END && NCHB * CHB <= 128 * OP, "S3 LDS map");
    const bf16* P = (const bf16*)(A.ws + WS_PB); const bf16* VT = (const bf16*)(A.ws + WS_VT); unsigned char* HM = A.ws + WS_HM;
    const bf16* CST = (const bf16*)(A.ws + WS_CST); const float* NST = (const float*)(A.ws + WS_NST);
    const float* hg = A.in[10] + (size_t)jl * NV;
    const int w = C.wave, eh = w >> 2;
    for (int u = C.bid; u < NUNIT; u += C.G) {
        const int blk = u % NBLK, bh = u / NBLK, h = bh % NH, b = bh / NH; const int row0 = blk_row0(b, blk);
        if (blk == 0 && !ctx_out) continue;
        bf16x8 qf[8];
#define S3_LOAD_Q(ps_) do { int lq = threadIdx.x & 63; asm volatile("" : "+v"(lq)); const bf16* qr = P + (size_t)(row0 + 32 * (2 * (w & 3) + (ps_)) + (lq & 31)) * PW + h * DQK + 8 * (lq >> 5); \
            _Pragma("unroll") for (int kk = 0; kk < 8; ++kk) qf[kk] = *(const bf16x8*)(qr + 16 * kk); } while (0)
        S3_LOAD_Q(0);
        int tu = threadIdx.x; asm volatile("" : "+v"(tu));
        block_gates(A, row0, h, bf, bb, gf, gb, tu);
        if (tu < 256) { gf[tu] -= bf[tu]; gb[tu] -= bb[tu]; cf[tu] = __expf(bf[tu | 31] + gf[tu]); cb[tu] = __expf(bb[tu & ~31] + gb[tu]); }
        else { const int t2 = tu - 256; nf[t2] = NST[(size_t)(u * 2 + (t2 >> 7)) * DQK + (t2 & 127)]; }
        { const int pc = tu & 15, s0 = tu >> 4; const bf16* kr = P + (size_t)(row0 + s0) * PW + NQ + h * DQK + 8 * pc;
#pragma unroll
          for (int i = 0; i < 8; ++i) *(LAS u32x4*)(Kimg + (s0 + 32 * i) * KP + pc * 16) = *(const u32x4*)(kr + (size_t)(32 * i) * PW); }
        __syncthreads();
        const bf16* vtile = VT + (size_t)vt_tile(b, h, blk) * 65536;
        const bf16* ctile = CST + (size_t)(u * 2) * DQK * DV;
#pragma unroll 1
        for (int ps = 0; ps < 2; ++ps) {
            int lz = threadIdx.x & 63; asm volatile("" : "+v"(lz));
            const int r = lz & 31, hh = lz >> 5;
            const int jt = 2 * (w & 3) + ps; const int jrow = row0 + 32 * jt + r;
            const float bfj = bf[32 * jt + r], bbj = bb[32 * jt + r];
            float qnf = 0.f, qnb = 0.f;
#pragma unroll
            for (int kk = 0; kk < 8; ++kk) { const u32x4 qq = __builtin_bit_cast(u32x4, qf[kk]); const int d = 16 * kk + 8 * hh;
                const f32x4 n0 = *(const LAS f32x4*)(nf + d), n1 = *(const LAS f32x4*)(nf + d + 4), m0 = *(const LAS f32x4*)(nb + d), m1 = *(const LAS f32x4*)(nb + d + 4);
                qnf += (bflo(qq.x) * n0.x + bfhi(qq.x) * n0.y) + (bflo(qq.y) * n0.z + bfhi(qq.y) * n0.w) + (bflo(qq.z) * n1.x + bfhi(qq.z) * n1.y) + (bflo(qq.w) * n1.z + bfhi(qq.w) * n1.w);
                qnb += (bflo(qq.x) * m0.x + bfhi(qq.x) * m0.y) + (bflo(qq.y) * m0.z + bfhi(qq.y) * m0.w) + (bflo(qq.z) * m1.x + bfhi(qq.z) * m1.y) + (bflo(qq.w) * m1.z + bfhi(qq.w) * m1.w);
                if (kk & 1) asm volatile("" ::: "memory"); }
            qnf += __shfl_xor(qnf, 32); qnb += __shfl_xor(qnb, 32);
            float denf = 0.f, denb = 0.f;
#pragma unroll 1
            for (int kt = 0; kt < 8; ++kt) {
                f32x16 c;
#pragma unroll
                for (int i = 0; i < 16; ++i) c[i] = 0.f;
#pragma unroll
                for (int kk = 0; kk < 8; ++kk) { const bf16x8 a = *(const LAS bf16x8*)(Kimg + (kt * 32 + r) * KP + (16 * kk + 8 * hh) * 2); c = MFMA32(a, qf[kk], c); }
                if (kt == jt) {
#pragma unroll
                    for (int g = 0; g < 4; ++g) { const int sl0 = 8 * g + 4 * hh;
                        const f32x4 g4f = *(const LAS f32x4*)(gf + kt * 32 + sl0), g4b = *(const LAS f32x4*)(gb + kt * 32 + sl0);
#pragma unroll
                        for (int q = 0; q < 4; ++q) { const int sl = sl0 + q; const float cv = c[4 * g + q];
                            denf += cv * __expf((sl <= r) ? bfj + g4f[q] : -1.0e30f); denb += cv * __expf((sl >= r) ? bbj + g4b[q] : -1.0e30f); } }
                } else {
                    LAS const float* cx = (kt < jt ? cf : cb) + kt * 32 + 4 * hh; float sm = 0.f;
#pragma unroll
                    for (int g = 0; g < 4; ++g) { const f32x4 c4 = *(const LAS f32x4*)(cx + 8 * g); sm += (c[4 * g] * c4.x + c[4 * g + 1] * c4.y) + (c[4 * g + 2] * c4.z + c[4 * g + 3] * c4.w); }
                    if (kt < jt) denf += sm * __expf(bfj - bf[kt * 32 + 31]); else denb += sm * __expf(bbj - bb[kt * 32]);
                }
            }
            denf += __shfl_xor(denf, 32); denb += __shfl_xor(denb, 32);
            const float ebf = __expf(bfj), ebb = __expf(bbj);
            denf += ebf * qnf; denb += ebb * qnb;
            const float rf = 1.0f / fmaxf(fabsf(denf), 1.0f), rb = 1.0f / fmaxf(fabsf(denb), 1.0f);
            const float scf = ebf * rf, scb = ebb * rb;
            f32x16 acc[4];
#pragma unroll
            for (int et = 0; et < 4; ++et)
#pragma unroll
                for (int i = 0; i < 16; ++i) acc[et][i] = 0.f;
            const unsigned ringb = (unsigned)(size_t)CH + (unsigned)w * 2048u;
            const unsigned dlp = (unsigned)(((lz & 3) ^ ((lz >> 4) & 3)) * 16), drow = (unsigned)(32 * w + (lz >> 2));
#define S3_DMA(c_) do { const int cc_ = (c_); const bool isv_ = cc_ < 8; \
                const unsigned long long gp_ = (unsigned long long)(isv_ ? (const char*)vtile + 64 * cc_ : (const char*)ctile + (cc_ >= 12 ? 2 * DQK * DV : 0) + 64 * ((cc_ - 8) & 3)); \
                const char* gb_ = (const char*)(((unsigned long long)(unsigned)__builtin_amdgcn_readfirstlane((int)(unsigned)(gp_ >> 32)) << 32) | (unsigned)__builtin_amdgcn_readfirstlane((int)(unsigned)gp_)); \
                _Pragma("unroll") for (int jj = 0; jj < 2; ++jj) \
                    asm volatile("s_mov_b32 m0, %2\n\ts_nop 0\n\tglobal_load_lds_dwordx4 %0, %1" :: "v"(((drow + 16u * jj) << (isv_ ? 9 : 8)) + dlp), "s"(gb_), "s"(ringb + (unsigned)((cc_ & 3) * CHB + jj * 1024)) : "memory"); } while (0)
            asm volatile("s_waitcnt vmcnt(0)" ::: "memory");
            lds_barrier();
            S3_DMA(0); S3_DMA(1); S3_DMA(2);
            const int swz = (r >> 2) & 3;
#pragma unroll 1
            for (int ci = 0; ci < 8; ++ci) {
                asm volatile("s_waitcnt vmcnt(4)" ::: "memory");
                lds_barrier();
                S3_DMA(ci + 3);
                LAS const unsigned char* CHc = CH + (ci & 3) * CHB;
                { const int kt = ci;
                        f32x16 c;
#pragma unroll
                        for (int i = 0; i < 16; ++i) c[i] = 0.f;
#pragma unroll
                        for (int kk = 0; kk < 8; ++kk) { const bf16x8 a = *(const LAS bf16x8*)(Kimg + (kt * 32 + r) * KP + (16 * kk + 8 * hh) * 2); c = MFMA32(a, qf[kk], c); }
                        float p[16]; const float bfj2 = bf[32 * jt + r], bbj2 = bb[32 * jt + r];
                        if (kt == jt) {
#pragma unroll
                            for (int g = 0; g < 4; ++g) { const int sl0 = 8 * g + 4 * hh;
                                const f32x4 g4f = *(const LAS f32x4*)(gf + kt * 32 + sl0), g4b = *(const LAS f32x4*)(gb + kt * 32 + sl0);
#pragma unroll
                                for (int q = 0; q < 4; ++q) { const int sl = sl0 + q;
                                    const float wt = rf * __expf((sl <= r) ? bfj2 + g4f[q] : -1.0e30f) + rb * __expf((sl >= r) ? bbj2 + g4b[q] : -1.0e30f);
                                    p[4 * g + q] = c[4 * g + q] * wt; } }
                        } else {
                            LAS const float* cx = (kt < jt ? cf : cb) + kt * 32 + 4 * hh;
                            const float rw = (kt < jt) ? rf * __expf(bfj2 - bf[kt * 32 + 31]) : rb * __expf(bbj2 - bb[kt * 32]);
#pragma unroll
                            for (int g = 0; g < 4; ++g) { const f32x4 c4 = *(const LAS f32x4*)(cx + 8 * g);
                                p[4 * g] = c[4 * g] * (c4.x * rw); p[4 * g + 1] = c[4 * g + 1] * (c4.y * rw); p[4 * g + 2] = c[4 * g + 2] * (c4.z * rw); p[4 * g + 3] = c[4 * g + 3] * (c4.w * rw); }
                        }
                        const bf16x8 pa0 = pack8(p[0], p[1], p[2], p[3], p[4], p[5], p[6], p[7]), pa1 = pack8(p[8], p[9], p[10], p[11], p[12], p[13], p[14], p[15]);
#pragma unroll
                        for (int et = 0; et < 4; ++et) { LAS const unsigned char* vb = CHc + ((4 * eh + et) * 32 + r) * 64 + 8 * hh;
                            const u32x2 l0 = *(LAS const u32x2*)(vb + ((0 ^ swz) << 4)), h0 = *(LAS const u32x2*)(vb + ((1 ^ swz) << 4)), l1 = *(LAS const u32x2*)(vb + ((2 ^ swz) << 4)), h1 = *(LAS const u32x2*)(vb + ((3 ^ swz) << 4));
                            const bf16x8 a0 = __builtin_bit_cast(bf16x8, (u32x4){l0.x, l0.y, h0.x, h0.y}), a1 = __builtin_bit_cast(bf16x8, (u32x4){l1.x, l1.y, h1.x, h1.y});
                            acc[et] = MFMA32(a0, pa0, acc[et]); acc[et] = MFMA32(a1, pa1, acc[et]); }
                }
            }
#pragma unroll
            for (int ci = 8; ci < 16; ++ci) {
                if (ci <= 13) asm volatile("s_waitcnt vmcnt(4)" ::: "memory"); else if (ci == 14) asm volatile("s_waitcnt vmcnt(2)" ::: "memory"); else asm volatile("s_waitcnt vmcnt(0)" ::: "memory");
                lds_barrier();
                if (ci + 3 < 16) S3_DMA(ci + 3);
                LAS const unsigned char* CHc = CH + (ci & 3) * CHB;
                {
                    const int dir = (ci - 8) >> 2, dq = (ci - 8) & 3;
                    const float sc = dir ? scb : scf;
#pragma unroll
                    for (int k2 = 0; k2 < 2; ++k2) { const u32x4 qq = __builtin_bit_cast(u32x4, qf[2 * dq + k2]);
                        const bf16x8 qs = pack8(bflo(qq.x) * sc, bfhi(qq.x) * sc, bflo(qq.y) * sc, bfhi(qq.y) * sc, bflo(qq.z) * sc, bfhi(qq.z) * sc, bflo(qq.w) * sc, bfhi(qq.w) * sc);
#pragma unroll
                        for (int et = 0; et < 4; ++et) { const bf16x8 a = *(const LAS bf16x8*)(CHc + ((4 * eh + et) * 32 + r) * 64 + (((2 * k2 + hh) ^ swz) << 4)); acc[et] = MFMA32(a, qs, acc[et]); } }
                }
            }
#undef S3_DMA
            if (ps == 0) S3_LOAD_Q(1);
            u32x4 ov[8]; f32x4 g0, g1;
            { int tz = threadIdx.x; asm volatile("" : "+v"(tz)); const int pc = tz & 31, lr0 = tz >> 5;
              g0 = *(const f32x4*)(hg + h * DV + 8 * pc); g1 = *(const f32x4*)(hg + h * DV + 8 * pc + 4);
#pragma unroll
              for (int i = 0; i < 8; ++i) { const int lr = lr0 + 16 * i; const int grow = row0 + 64 * (lr >> 5) + 32 * ps + (lr & 31); ov[i] = *(const u32x4*)(P + (size_t)grow * PW + 2 * NQ + NV + h * DV + 8 * pc); } }
            float ss = 0.f;
#pragma unroll
            for (int et = 0; et < 4; ++et)
#pragma unroll
                for (int i = 0; i < 16; ++i) ss += acc[et][i] * acc[et][i];
            ss += __shfl_xor(ss, 32);
            if (hh == 0) ssx[w * 32 + r] = ss;
            lds_barrier();
            ss += ssx[(w ^ 4) * 32 + r];
            const float rs = 1.0f / sqrtf(ss * (1.0f / DV) + EPS);
            { LAS unsigned char* ob = CH + ((w & 3) * 32 + r) * OP + (eh * 128 + 4 * hh) * 2;
#pragma unroll
              for (int et = 0; et < 4; ++et)
#pragma unroll
                  for (int g = 0; g < 4; ++g) { u32x2 o; o.x = cvt2(acc[et][4 * g + 0] * rs, acc[et][4 * g + 1] * rs); o.y = cvt2(acc[et][4 * g + 2] * rs, acc[et][4 * g + 3] * rs);
                      *(LAS u32x2*)(ob + (et * 32 + 8 * g) * 2) = o; } }
            lds_barrier();
            { int tz = threadIdx.x; asm volatile("" : "+v"(tz)); const int pc = tz & 31, lr0 = tz >> 5;
#pragma unroll
              for (int i = 0; i < 8; ++i) { const int lr = lr0 + 16 * i; const int grow = row0 + 64 * (lr >> 5) + 32 * ps + (lr & 31);
                  const u32x4 hv = *(const LAS u32x4*)(CH + lr * OP + pc * 16);
                  const f32x4 o0 = (f32x4){bflo(hv.x) * g0.x * bflo(ov[i].x), bfhi(hv.x) * g0.y * bfhi(ov[i].x), bflo(hv.y) * g0.z * bflo(ov[i].y), bfhi(hv.y) * g0.w * bfhi(ov[i].y)};
                  const f32x4 o1 = (f32x4){bflo(hv.z) * g1.x * bflo(ov[i].z), bfhi(hv.z) * g1.y * bfhi(ov[i].z), bflo(hv.w) * g1.z * bflo(ov[i].w), bfhi(hv.w) * g1.w * bfhi(ov[i].w)};
                  *(u32x2*)(HM + (size_t)grow * D + h * DV + 8 * pc) = (u32x2){pack_i8(o0 * (127.0f / HMR)), pack_i8(o1 * (127.0f / HMR))}; } }
        }
        __syncthreads();
    }
#undef S3_LOAD_Q
}

#define XB_TMO      128
#define XB_XCNT(j)  (256  + 64 * (j))
#define XB_XSUB(j)  (1280 + 64 * (j))
#define XB_XGEN(j)  (2304 + 64 * (j))
#define XB_TOP      3328
#define XB_TOPGEN   3392
#define XCD_BAR_WORDS 3456
#define XB_SPIN_CAP (1u << 18)

__device__ __forceinline__ unsigned xb_ld(unsigned* p)              { return __hip_atomic_load(p, __ATOMIC_RELAXED, __HIP_MEMORY_SCOPE_AGENT); }
__device__ __forceinline__ unsigned xb_add(unsigned* p, unsigned v) { return __hip_atomic_fetch_add(p, v, __ATOMIC_RELAXED, __HIP_MEMORY_SCOPE_AGENT); }
__device__ __forceinline__ unsigned xb_xcc_id() { return (unsigned)__builtin_amdgcn_s_getreg((3 << 11) | 20) & 0xFu; }
#define XB_SPIN(cond, bar) do { unsigned _sp = 0; while (cond) { __builtin_amdgcn_s_sleep(1); \
    if ((++_sp & 255u) == 0u) { if (xb_ld(&(bar)[XB_TMO])) break; if (_sp > XB_SPIN_CAP) { atomicAdd(&(bar)[XB_TMO], 1u); break; } } } } while (0)

struct XcdBarrier {
    unsigned* bar; unsigned x;
    volatile LAS unsigned* st;
};

__device__ __forceinline__ XcdBarrier xcd_barrier_post(unsigned* bar, volatile LAS unsigned* st) {
    XcdBarrier b; b.bar = bar; b.x = xb_xcc_id(); b.st = st;
    if (threadIdx.x == 0) (void)xb_add(&bar[XB_XCNT(b.x)], 1u);
    return b;
}
__device__ __forceinline__ void xcd_barrier_complete(unsigned* bar, unsigned x, unsigned& nloc, unsigned& nx) {
    const unsigned G = gridDim.x * gridDim.y * gridDim.z;
    unsigned sum, cnt, mine, sp = 0u;
    for (;;) {
        sum = 0u; cnt = 0u; mine = 0u;
#pragma unroll
        for (unsigned j = 0; j < 16; ++j) { const unsigned c = xb_ld(&bar[XB_XCNT(j)]); sum += c; cnt += (c > 0u) ? 1u : 0u; mine = (j == x) ? c : mine; }
        if (sum == G) break;
        __builtin_amdgcn_s_sleep(1);
        if ((++sp & 255u) == 0u) { if (xb_ld(&bar[XB_TMO])) break; if (sp > XB_SPIN_CAP) { atomicAdd(&bar[XB_TMO], 1u); break; } }
    }
    nloc = mine > 0u ? mine : 1u; nx = cnt > 0u ? cnt : 1u;
}

__device__ __forceinline__ void xcd_barrier(const XcdBarrier& b) {
    asm volatile("s_waitcnt vmcnt(0)" ::: "memory");
    __syncthreads();
    if (threadIdx.x == 0) {
        unsigned* bar = b.bar;
        __builtin_amdgcn_s_waitcnt(0);
        unsigned nloc = b.st[0], nx = b.st[1];
        if (nloc == 0u) { xcd_barrier_complete(bar, b.x, nloc, nx); b.st[0] = nloc; b.st[1] = nx; }
        const unsigned old = xb_add(&bar[XB_XSUB(b.x)], 1u);
        const unsigned gen = old / nloc;
        if (old + 1u == (gen + 1u) * nloc) {
            __builtin_amdgcn_fence(__ATOMIC_RELEASE, "agent");
            asm volatile("s_waitcnt vmcnt(0)" ::: "memory");
            const unsigned og = xb_add(&bar[XB_TOP], 1u);
            const unsigned tg = og / nx;
            if (og + 1u == (tg + 1u) * nx) xb_add(&bar[XB_TOPGEN], 1u);
            else XB_SPIN(xb_ld(&bar[XB_TOPGEN]) == tg, bar);
            __builtin_amdgcn_fence(__ATOMIC_ACQUIRE, "agent");
            xb_add(&bar[XB_XGEN(b.x)], 1u);
            asm volatile("s_waitcnt vmcnt(0)" ::: "memory");
        } else {
            XB_SPIN(xb_ld(&bar[XB_XGEN(b.x)]) == gen, bar);
            __builtin_amdgcn_fence(__ATOMIC_ACQUIRE, "agent");
            asm volatile("s_waitcnt vmcnt(0)" ::: "memory");
        }
    }
    __syncthreads();
}


constexpr int LDS_BYTES = 152 * 1024;
constexpr int CW_BAR = 16384;
static_assert((CW_BAR + XCD_BAR_WORDS) * 4 <= (int)CTL_BYTES, "ctl");
#ifndef MK_MULTI
#define MK_MULTI 0
#endif
#define IN(p) (lo <= (p) && (p) < hi)
#define SEAM(p) do { if ((p) + 1 < hi) { XcdBarrier b_; b_.bar = (unsigned*)(load_args().ws + WS_CTL) + CW_BAR; b_.x = xb_xcc_id(); b_.st = (volatile LAS unsigned*)(C.lds + LDS_BYTES - 16); xcd_barrier(b_); } } while (0)
#define CAS __attribute__((address_space(4)))
__device__ __forceinline__ Args load_args() {
#if defined(__HIP_DEVICE_COMPILE__)
    const CAS Args* p = (const CAS Args*)__builtin_amdgcn_kernarg_segment_ptr(); asm volatile("" : "+s"(p));
    Args a; for (int i = 0; i < 22; ++i) a.in[i] = p->in[i]; a.out = p->out; a.ws = p->ws; a.lo = p->lo; a.hi = p->hi; return a;
#else
    return Args{};
#endif
}
__device__ __forceinline__ Ctx fresh(const Ctx& C) { Ctx R = C; int tz = threadIdx.x; asm volatile("" : "+v"(tz)); R.tid = tz; R.lane = tz & 63; return R; }
template <int L> __device__ __forceinline__ void layer_phases(const Args& args, const Ctx& C, int bar, int lo, int hi) {
    constexpr int pb = 16 * L;
    if (IN(pb + 1)) { phase_r1(load_args(), fresh(C), L); SEAM(pb + 1); }
    if (IN(pb + 2)) { phase_g1(load_args(), fresh(C), L); SEAM(pb + 2); }
    if constexpr ((L & 1) == 0) {
        if (IN(pb + 3)) { phase_s1(load_args(), fresh(C), L); SEAM(pb + 3); }
        if (IN(pb + 4)) { phase_s2(load_args(), fresh(C)); SEAM(pb + 4); }
        if (IN(pb + 5)) { phase_s3(load_args(), fresh(C), L); SEAM(pb + 5); }
    } else {
        if (IN(pb + 3)) { phase_conv(load_args(), fresh(C), L); SEAM(pb + 3); }
    }
    if (IN(pb + 6)) { phase_g2(load_args(), fresh(C), L); SEAM(pb + 6); }
    if (IN(pb + 7)) { phase_r2(load_args(), fresh(C), L); SEAM(pb + 7); }
    if (IN(pb + 8)) { phase_m1(load_args(), fresh(C), L); SEAM(pb + 8); }
    if (IN(pb + 9)) { phase_m2(load_args(), fresh(C), L); SEAM(pb + 9); }
}
__global__ void __launch_bounds__(NT, 2) fwd_kernel(Args args) {
    extern __shared__ __attribute__((aligned(16))) unsigned char lds_raw[];
    Ctx C; C.lds = (LAS unsigned char*)lds_raw; C.tid = threadIdx.x; C.lane = C.tid & 63; C.wave = __builtin_amdgcn_readfirstlane(C.tid >> 6); C.G = gridDim.x; C.bid = blockIdx.x; C.a = &args;
    const int lo = args.lo, hi = args.hi;
    volatile LAS unsigned* xbw = (volatile LAS unsigned*)(C.lds + LDS_BYTES - 16);
    if (C.tid < 4) xbw[C.tid] = 0u;
    __syncthreads();
    if (hi - lo > 1) (void)xcd_barrier_post((unsigned*)(args.ws + WS_CTL) + CW_BAR, xbw);
    const int bar = 0; (void)bar;
    if (IN(0)) { phase_mod(load_args(), fresh(C)); __syncthreads(); phase_cvt_mixer(load_args(), fresh(C)); SEAM(0); }
    layer_phases<0>(args, C, bar, lo, hi);
    layer_phases<1>(args, C, bar, lo, hi);
    layer_phases<2>(args, C, bar, lo, hi);
    layer_phases<3>(args, C, bar, lo, hi);
    if (IN(64)) phase_final(load_args(), fresh(C));
}
#undef IN
#undef SEAM

extern "C" void kernel_launch(void* const* d_in, const int* in_sizes, int n_in, void* d_out, int out_size, void* d_ws, size_t ws_size, hipStream_t stream) {
    static int grid = 0;
    if (grid == 0) {
        if (n_in != 22 || out_size != NL * D || ws_size < WS_END) { fprintf(stderr, "kernel_launch: unexpected shapes (n_in %d out %d ws %zu)\n", n_in, out_size, ws_size); grid = -1; return; }
        int dev = 0, cus = 0, per_cu = 0;
        if (hipGetDevice(&dev) != hipSuccess || hipDeviceGetAttribute(&cus, hipDeviceAttributeMultiprocessorCount, dev) != hipSuccess) { grid = -1; return; }
        if (hipFuncSetAttribute((const void*)fwd_kernel, hipFuncAttributeMaxDynamicSharedMemorySize, LDS_BYTES) != hipSuccess) { grid = -1; return; }
        if (hipOccupancyMaxActiveBlocksPerMultiprocessor(&per_cu, (const void*)fwd_kernel, NT, LDS_BYTES) != hipSuccess || per_cu < 1) { fprintf(stderr, "kernel_launch: occupancy query says %d\n", per_cu); }
        (void)hipGetLastError();
        grid = cus;
    }
    if (grid < 0) return;
    (void)hipMemsetAsync((char*)d_ws + WS_CTL, 0, CTL_BYTES, stream);
    Args a{};
    for (int i = 0; i < 22; ++i) a.in[i] = (const float*)d_in[i];
    a.out = (float*)d_out; a.ws = (unsigned char*)d_ws;
#if MK_MULTI
    int phases[64]; int np = 0;
    phases[np++] = 0;
    for (int l = 0; l < DEPTH; ++l) { const int pb = 16 * l; phases[np++] = pb + 1; phases[np++] = pb + 2; phases[np++] = pb + 3;
        if ((l & 1) == 0) { phases[np++] = pb + 4; phases[np++] = pb + 5; }
        phases[np++] = pb + 6; phases[np++] = pb + 7; phases[np++] = pb + 8; phases[np++] = pb + 9; }
    phases[np++] = 64;
    for (int i = 0; i < np; ++i) { a.lo = phases[i]; a.hi = phases[i] + 1; hipLaunchKernelGGL(fwd_kernel, dim3(grid), dim3(NT), LDS_BYTES, stream, a); }
#else
    a.lo = 0; a.hi = 65;
    hipLaunchKernelGGL(fwd_kernel, dim3(grid), dim3(NT), LDS_BYTES, stream, a);
#ifdef PROBE_PHASES
    { const int pp[] = {PROBE_PHASES};
      for (int rep = 0; rep < PROBE_REPS; ++rep) for (unsigned i = 0; i < sizeof(pp) / sizeof(pp[0]); ++i) { a.lo = pp[i]; a.hi = pp[i] + 1; hipLaunchKernelGGL(fwd_kernel, dim3(grid), dim3(NT), LDS_BYTES, stream, a); } }
#endif
#endif
}
```

```cpp
#include <hip/hip_runtime.h>
#include <cstdio>
#include <cstdint>

#define LAS __attribute__((address_space(3)))
typedef unsigned short bf16;
typedef float f32x4 __attribute__((ext_vector_type(4)));
typedef unsigned u32x4 __attribute__((ext_vector_type(4)));
typedef unsigned u32x2 __attribute__((ext_vector_type(2)));
typedef int i32x4r __attribute__((ext_vector_type(4)));

constexpr int D = 1024, BATCH = 2, SEQ = 16384, DEPTH = 4, CTXL = 256;
constexpr int NL = BATCH * SEQ, NCX = BATCH * CTXL, NR = NL + NCX;
constexpr int NH = 4, DQK = 128, DV = 256, NQ = 512, NV = 1024, PROJ = 3088, PW = 3072;
constexpr int NGRP = 4, EPG = 8, NE = 32, DE = 512;
constexpr int NBLK = 65;
constexpr int NUNIT = BATCH * NH * NBLK;
constexpr int CAP = NR;
constexpr int YROWS = 74752;
constexpr float EPS = 1e-6f;
constexpr float WSCALE = 32.0f;
constexpr float YSCALE = 4.0f;
constexpr int NT = 512, NW = 8;
constexpr int LDS_TAB_END = 152 * 1024 - 16;

constexpr size_t MiB = 1u << 20;
constexpr size_t WS_CTL = 0, CTL_BYTES = 1 * MiB;
constexpr size_t WS_MOD = 1 * MiB;
constexpr size_t WS_GATE = 2 * MiB;
constexpr size_t WS_TOKSLOT = 5 * MiB;
constexpr size_t WS_TOKW = 6 * MiB;
constexpr size_t WS_SLOTTOK = 7 * MiB;
constexpr size_t WS_DN = 12 * MiB;
constexpr size_t WS_NST = 13 * MiB;
constexpr size_t WS_BTOT = 14 * MiB;
constexpr size_t WS_RSC = 15 * MiB;
constexpr size_t WS_LAT = 16 * MiB;
constexpr size_t WS_HB = 146 * MiB;
constexpr size_t WS_PB = 211 * MiB;
constexpr size_t WS_HM = 406 * MiB;
constexpr size_t WS_DC = 471 * MiB;
constexpr size_t WS_CST = 601 * MiB;
constexpr size_t WS_VT = 666 * MiB;
constexpr size_t WS_WAIN = 731 * MiB;
constexpr size_t WS_WBIN = 743 * MiB;
constexpr size_t WS_WAOUT = 755 * MiB;
constexpr size_t WS_WBOUT = 759 * MiB;
constexpr size_t WS_WGU = 763 * MiB;
constexpr size_t WS_WDN = 827 * MiB;
constexpr size_t WS_H8 = 843 * MiB;
constexpr size_t WS_END = 880 * MiB;
constexpr int CW_WMAX = 256;
constexpr int CW_CNT = 1024, CNT_STRIDE = 64;

struct Args { const float* in[22]; float* out; unsigned char* ws; int lo, hi; };

typedef short bf16x8 __attribute__((ext_vector_type(8)));
typedef float f32x2 __attribute__((ext_vector_type(2)));
typedef __bf16 bf16x2_t __attribute__((ext_vector_type(2)));
__device__ __forceinline__ unsigned cvt2(float lo, float hi) { const f32x2 v = {lo, hi}; return __builtin_bit_cast(unsigned, __builtin_convertvector(v, bf16x2_t)); }
__device__ __forceinline__ float bf2f(bf16 v) { return __uint_as_float(((unsigned)v) << 16); }
__device__ __forceinline__ unsigned f2bf(float f) { unsigned u = __float_as_uint(f); return (u + 0x7fffu + ((u >> 16) & 1u)) >> 16; }
__device__ __forceinline__ unsigned pk2(float lo, float hi) { return f2bf(lo) | (f2bf(hi) << 16); }
template <int CTRL, int ROWMASK> __device__ __forceinline__ float dpp_mov(float x) { return __int_as_float(__builtin_amdgcn_update_dpp(0, __float_as_int(x), CTRL, ROWMASK, 0xf, false)); }
__device__ __forceinline__ float wave_sum(float v) {
    v += dpp_mov<0xB1, 0xf>(v); v += dpp_mov<0x4E, 0xf>(v); v += dpp_mov<0x141, 0xf>(v); v += dpp_mov<0x140, 0xf>(v);
    v += dpp_mov<0x142, 0xA>(v); v += dpp_mov<0x143, 0xC>(v);
    return __int_as_float(__builtin_amdgcn_readlane(__float_as_int(v), 63));
}
__device__ __forceinline__ float wave_max_nn(float v) {
    v = fmaxf(v, dpp_mov<0xB1, 0xf>(v)); v = fmaxf(v, dpp_mov<0x4E, 0xf>(v)); v = fmaxf(v, dpp_mov<0x141, 0xf>(v)); v = fmaxf(v, dpp_mov<0x140, 0xf>(v));
    v = fmaxf(v, dpp_mov<0x142, 0xA>(v)); v = fmaxf(v, dpp_mov<0x143, 0xC>(v));
    return __int_as_float(__builtin_amdgcn_readlane(__float_as_int(v), 63));
}
__device__ __forceinline__ unsigned pack_i8(f32x4 v) {
    const int a = (int)__builtin_rintf(fminf(fmaxf(v.x, -127.f), 127.f)), b = (int)__builtin_rintf(fminf(fmaxf(v.y, -127.f), 127.f)), c = (int)__builtin_rintf(fminf(fmaxf(v.z, -127.f), 127.f)), d = (int)__builtin_rintf(fminf(fmaxf(v.w, -127.f), 127.f));
    return (unsigned)(a & 255) | ((unsigned)(b & 255) << 8) | ((unsigned)(c & 255) << 16) | ((unsigned)d << 24);
}
__device__ __forceinline__ float sigmoidf_(float x) { return 1.f / (1.f + __expf(-x)); }
__device__ __forceinline__ float siluf_(float x) { return x / (1.f + __expf(-x)); }
__device__ __forceinline__ float logsigmoidf_(float x) { return fminf(x, 0.f) - log1pf(__expf(-fabsf(x))); }
__device__ __forceinline__ int blk_row0(int b, int blk) { return blk == 0 ? NL + b * CTXL : b * SEQ + (blk - 1) * 256; }
__device__ __forceinline__ int mod_vec_of_row(int row) { return row < NL ? row / SEQ : 2; }

struct Ctx {
    LAS unsigned char* lds; int tid, lane, wave, G, bid;
    const Args* a;
};

__device__ __forceinline__ int expert_block_prefix(const unsigned* cnt, int lane, int& nb) {
    nb = lane < NE ? ((int)cnt[lane * CNT_STRIDE] + 255) / 256 : 0; int v = nb;
#pragma unroll
    for (int o = 1; o < 64; o <<= 1) { const int t = __shfl_up(v, o); v += (lane >= o) ? t : 0; }
    return v - nb;
}
__device__ __forceinline__ void slot_bases(const Args& A, int l, LAS int* sb, int tid) {
    if (tid < 64) { int nb; const int ex = expert_block_prefix((const unsigned*)(A.ws + WS_CTL) + CW_CNT + l * 32 * CNT_STRIDE, tid, nb); if (tid <= NE) sb[tid] = ex * 256; }
    __syncthreads();
}

__device__ __forceinline__ void phase_mod(const Args& A, const Ctx& C) {
    LAS float* sc = (LAS float*)C.lds;
    LAS float* red = sc + 3072;
    const float* c = A.in[1]; const float* cc = A.in[3];
    for (int i = C.tid; i < 3072; i += NT) { const float v = i < 2048 ? c[i] : cc[i - 2048]; sc[i] = siluf_(v); }
    __syncthreads();
    float* MOD = (float*)(A.ws + WS_MOD);
    for (int u = C.bid; u < DEPTH * 96; u += C.G) {
        const int l = u / 96, cg = u % 96, col = cg * 64 + C.lane;
        const float* w = A.in[4] + (size_t)l * D * 6 * D + col;
        float a0 = 0.f, a1 = 0.f, a2 = 0.f;
#pragma unroll 32
        for (int k = C.wave * 128; k < C.wave * 128 + 128; ++k) { const float wv = w[(size_t)k * 6 * D]; a0 += sc[k] * wv; a1 += sc[1024 + k] * wv; a2 += sc[2048 + k] * wv; }
        red[(C.wave * 3 + 0) * 64 + C.lane] = a0; red[(C.wave * 3 + 1) * 64 + C.lane] = a1; red[(C.wave * 3 + 2) * 64 + C.lane] = a2;
        __syncthreads();
        if (C.tid < 192) { const int v = C.tid / 64, ln = C.tid % 64; float s = 0.f;
            for (int w8 = 0; w8 < 8; ++w8) s += red[(w8 * 3 + v) * 64 + ln];
            MOD[(size_t)(l * 3 + v) * 6 * D + cg * 64 + ln] = s + A.in[5][(size_t)l * 6 * D + cg * 64 + ln]; }
        __syncthreads();
    }
}

__device__ __forceinline__ void load_row_f32(const float* p, int lane, f32x4 (&v)[4]) {
#pragma unroll
    for (int j = 0; j < 4; ++j) v[j] = *(const f32x4*)(p + 4 * lane + 256 * j);
}
__device__ __forceinline__ void load_row_bf16(const bf16* p, int lane, f32x4 (&v)[4]) {
#pragma unroll
    for (int j = 0; j < 4; ++j) { const u32x2 w = *(const u32x2*)(p + 4 * lane + 256 * j);
        v[j] = (f32x4){__uint_as_float(w.x << 16), __uint_as_float(w.x & 0xffff0000u), __uint_as_float(w.y << 16), __uint_as_float(w.y & 0xffff0000u)}; }
}
__device__ __forceinline__ void store_row_bf16(bf16* p, int lane, const f32x4 (&v)[4]) {
#pragma unroll
    for (int j = 0; j < 4; ++j) { u32x2 w; w.x = pk2(v[j].x, v[j].y); w.y = pk2(v[j].z, v[j].w); *(u32x2*)(p + 4 * lane + 256 * j) = w; }
}
constexpr int CVT_IG = (D / 64) * (DE / 32), CVT_ID = (DE / 64) * (D / 32), CVT_PER = 2 * CVT_IG + CVT_ID, CVT_ITEMS = NE * CVT_PER;
constexpr int CVT_Q = 24;
__device__ __forceinline__ void cvt_moe_items(const Args& A, const Ctx& C, int l, int it0, int end, int stride);
__device__ __forceinline__ void cvt_win_i8(const Args& A, const Ctx& C);
__device__ __forceinline__ int cvt_t2(int l, int G);
struct RowVec { f32x4 a[4], s[4], g[4]; };
__device__ __forceinline__ void load_rowvec(RowVec& R, const float* ng, const float* sh, const float* sc, const float* gt, int lane) {
    f32x4 n[4], c[4]; load_row_f32(ng, lane, n); load_row_f32(sc, lane, c); load_row_f32(sh, lane, R.s); if (gt) load_row_f32(gt, lane, R.g);
#pragma unroll
    for (int q = 0; q < 4; ++q) R.a[q] = n[q] * (1.f + c[q]);
}
__device__ __forceinline__ void load_row_bf16raw(const bf16* p, int lane, u32x2 (&v)[4]) {
#pragma unroll
    for (int j = 0; j < 4; ++j) v[j] = *(const u32x2*)(p + 4 * lane + 256 * j);
}
__device__ __forceinline__ void store_row_fp8(unsigned char* p, int lane, const f32x4 (&v)[4]) {
#pragma unroll
    for (int j = 0; j < 4; ++j) { int w = 0; w = __builtin_amdgcn_cvt_pk_fp8_f32(v[j].x, v[j].y, w, false); w = __builtin_amdgcn_cvt_pk_fp8_f32(v[j].z, v[j].w, w, true); *(unsigned*)(p + 4 * lane + 256 * j) = (unsigned)w; }
}
__device__ __forceinline__ void load_row_fp8raw(const unsigned char* p, int lane, unsigned (&v)[4]) {
#pragma unroll
    for (int j = 0; j < 4; ++j) v[j] = *(const unsigned*)(p + 4 * lane + 256 * j);
}
__device__ __forceinline__ f32x4 fp8x4(unsigned w) { const f32x2 lo = __builtin_amdgcn_cvt_pk_f32_fp8((int)w, false), hi = __builtin_amdgcn_cvt_pk_f32_fp8((int)w, true); return (f32x4){lo.x, lo.y, hi.x, hi.y}; }
__device__ __forceinline__ f32x4 bf4(u32x2 w) { return (f32x4){__uint_as_float(w.x << 16), __uint_as_float(w.x & 0xffff0000u), __uint_as_float(w.y << 16), __uint_as_float(w.y & 0xffff0000u)}; }
__device__ __forceinline__ float row_rstd(const f32x4 (&v)[4]) {
    float s = 0.f;
#pragma unroll
    for (int j = 0; j < 4; ++j) s += (v[j].x * v[j].x + v[j].y * v[j].y) + (v[j].z * v[j].z + v[j].w * v[j].w);
    return 1.0f / sqrtf(wave_sum(s) * (1.f / D) + EPS);
}

__device__ __forceinline__ void phase_r1(const Args& A, const Ctx& C, int l) {
    LAS int* sb = (LAS int*)C.lds;
    LAS float* GW = (LAS float*)(C.lds + 256);
    const bool mls = (l & 1) == 0; const int j = l >> 1;
    if (l == 0) { cvt_win_i8(A, C); __syncthreads(); }
    if (l > 0) slot_bases(A, l - 1, sb, C.tid);
    if (mls) { const float* w = A.in[8] + (size_t)j * D * PROJ + PW;
        f32x4 t[2][4];
#pragma unroll
        for (int jj = 0; jj < 2; ++jj)
#pragma unroll
            for (int q = 0; q < 4; ++q) t[jj][q] = *(const f32x4*)(w + (size_t)(C.tid + NT * jj) * PROJ + 4 * q);
#pragma unroll
        for (int jj = 0; jj < 2; ++jj)
#pragma unroll
            for (int q = 0; q < 4; ++q) { const int k = C.tid + NT * jj; GW[(4 * q + 0) * D + k] = t[jj][q].x; GW[(4 * q + 1) * D + k] = t[jj][q].y; GW[(4 * q + 2) * D + k] = t[jj][q].z; GW[(4 * q + 3) * D + k] = t[jj][q].w; }
        __syncthreads(); }
    const int nrows = (l <= 2) ? NR : NL;
    bf16* LAT = (bf16*)(A.ws + WS_LAT); unsigned char* HI8 = A.ws + WS_H8; float* RSC = (float*)(A.ws + WS_RSC); float* GATE = (float*)(A.ws + WS_GATE);
    const float* MOD = (const float*)(A.ws + WS_MOD); const unsigned char* Y8 = A.ws + WS_PB;
    const int* TS = (const int*)(A.ws + WS_TOKSLOT); const float* TW = (const float*)(A.ws + WS_TOKW);
    const int rpw = (((nrows + C.G - 1) / C.G) + 1) & ~1; const int wrow0 = C.bid * rpw; const int wend = min(wrow0 + rpw, nrows);
    for (int sa = wrow0; sa < wend;) {
        const int mvi = mod_vec_of_row(sa); const int bnd = mvi == 0 ? SEQ : (mvi == 1 ? NL : NR); const int sbnd = min(wend, bnd);
        RowVec RV; { const float* mv = MOD + (size_t)(l * 3 + mvi) * 6 * D;
            load_rowvec(RV, A.in[6] + (size_t)(l * 2 + 0) * D, mv + 0 * D, mv + 1 * D, l > 0 ? MOD + (size_t)((l - 1) * 3 + mvi) * 6 * D + 5 * D : nullptr, C.lane); }
        const int rlast = sbnd - 2;
        i32x4r tsn = (i32x4r){0, 0, 0, 0}; f32x4 twn = (f32x4){0.f, 0.f, 0.f, 0.f};
        if (l > 0) { const int r0 = min(sa + 2 * C.wave, rlast); tsn = *(const i32x4r*)(TS + r0 * 2); twn = *(const f32x4*)(TW + r0 * 2); }
        for (int ra = sa + 2 * C.wave; ra < sbnd; ra += 2 * NW) {
            const bool hasb = true; const int rb = ra + 1;
            const i32x4r tsc = tsn; const f32x4 twc = twn;
            if (l > 0) { const int r1 = min(ra + 2 * NW, rlast); tsn = *(const i32x4r*)(TS + r1 * 2); twn = *(const f32x4*)(TW + r1 * 2); }
            f32x4 va[4], vb[4]; float wa0 = 0.f, wa1 = 0.f, wb0 = 0.f, wb1 = 0.f;
            if (l == 0) { load_row_f32(ra < NL ? A.in[0] + (size_t)ra * D : A.in[2] + (size_t)(ra - NL) * D, C.lane, va); load_row_f32(rb < NL ? A.in[0] + (size_t)rb * D : A.in[2] + (size_t)(rb - NL) * D, C.lane, vb); }
            else {
                const int ta0 = tsc.x, ta1 = tsc.y, tb0 = tsc.z, tb1 = tsc.w; wa0 = twc.x; wa1 = twc.y; wb0 = twc.z; wb1 = twc.w;
                load_row_bf16(LAT + (size_t)ra * D, C.lane, va); load_row_bf16(LAT + (size_t)rb * D, C.lane, vb);
                unsigned ya0[4], ya1[4], yb0[4], yb1[4];
                load_row_fp8raw(Y8 + (size_t)(sb[ta0 >> 20] + (ta0 & 0xfffff)) * D, C.lane, ya0); load_row_fp8raw(Y8 + (size_t)(sb[ta1 >> 20] + (ta1 & 0xfffff)) * D, C.lane, ya1);
                load_row_fp8raw(Y8 + (size_t)(sb[tb0 >> 20] + (tb0 & 0xfffff)) * D, C.lane, yb0); load_row_fp8raw(Y8 + (size_t)(sb[tb1 >> 20] + (tb1 & 0xfffff)) * D, C.lane, yb1);
                wa0 *= 1.0f / YSCALE; wa1 *= 1.0f / YSCALE; wb0 *= 1.0f / YSCALE; wb1 *= 1.0f / YSCALE;
#pragma unroll
                for (int q = 0; q < 4; ++q) { va[q] += RV.g[q] * (fp8x4(ya0[q]) * wa0 + fp8x4(ya1[q]) * wa1); vb[q] += RV.g[q] * (fp8x4(yb0[q]) * wb0 + fp8x4(yb1[q]) * wb1); }
            }
            store_row_bf16(LAT + (size_t)ra * D, C.lane, va); if (hasb) store_row_bf16(LAT + (size_t)rb * D, C.lane, vb);
            const float rra = row_rstd(va), rrb = row_rstd(vb);
            f32x4 ha[4], hb[4];
#pragma unroll
            for (int q = 0; q < 4; ++q) { ha[q] = (va[q] * rra) * RV.a[q] + RV.s[q]; hb[q] = (vb[q] * rrb) * RV.a[q] + RV.s[q]; }
            { float ma = 0.f, mb = 0.f;
#pragma unroll
              for (int q = 0; q < 4; ++q) { ma = fmaxf(ma, fmaxf(fmaxf(fabsf(ha[q].x), fabsf(ha[q].y)), fmaxf(fabsf(ha[q].z), fabsf(ha[q].w)))); mb = fmaxf(mb, fmaxf(fmaxf(fabsf(hb[q].x), fabsf(hb[q].y)), fmaxf(fabsf(hb[q].z), fabsf(hb[q].w)))); }
              ma = fmaxf(wave_max_nn(ma), 1.0e-20f); mb = fmaxf(wave_max_nn(mb), 1.0e-20f);
              const float ia = 127.0f / ma, ib = 127.0f / mb;
#pragma unroll
              for (int q = 0; q < 4; ++q) { *(unsigned*)(HI8 + (size_t)ra * D + 4 * C.lane + 256 * q) = pack_i8(ha[q] * ia); *(unsigned*)(HI8 + (size_t)rb * D + 4 * C.lane + 256 * q) = pack_i8(hb[q] * ib); }
              if (C.lane == 0) { RSC[ra] = ma * (1.0f / 127.0f); RSC[rb] = mb * (1.0f / 127.0f); } }
            if (mls) {
                float ga = 0.f, gb = 0.f;
#pragma unroll 2
                for (int c = 0; c < 16; ++c) { float s0 = 0.f, s1 = 0.f;
#pragma unroll
                    for (int q = 0; q < 4; ++q) { const f32x4 w = *(const LAS f32x4*)(GW + c * D + 4 * C.lane + 256 * q);
                        s0 += (ha[q].x * w.x + ha[q].y * w.y) + (ha[q].z * w.z + ha[q].w * w.w); s1 += (hb[q].x * w.x + hb[q].y * w.y) + (hb[q].z * w.z + hb[q].w * w.w); }
                    s0 = wave_sum(s0); s1 = wave_sum(s1); ga = (C.lane == c) ? s0 : ga; gb = (C.lane == c) ? s1 : gb; }
                if (C.lane < 16) {
                    const float bgt = A.in[9][j * 16 + C.lane]; const int gtype = C.lane >> 2;
                    ga += bgt; gb += bgt;
                    GATE[(size_t)ra * 16 + C.lane] = (gtype & 1) ? logsigmoidf_(ga) : 15.0f * tanhf(ga * (1.0f / 15.0f));
                    if (hasb) GATE[(size_t)rb * 16 + C.lane] = (gtype & 1) ? logsigmoidf_(gb) : 15.0f * tanhf(gb * (1.0f / 15.0f)); }
            }
        }
        sa = sbnd;
    }
}

__device__ __forceinline__ void phase_r2(const Args& A, const Ctx& C, int l) {
    constexpr int WP = 2064;
    LAS unsigned char* RWB = C.lds;
    LAS float* WL = (LAS float*)(C.lds + 48 * WP);
    LAS unsigned* hist = (LAS unsigned*)(WL + 8 * 16 * 48);
    LAS unsigned* gbase = hist + 32;
    constexpr int RCAP = 144;
    LAS int* rec = (LAS int*)(gbase + 32);
    static_assert(48 * WP + 8 * 16 * 48 * 4 + 256 + RCAP * 16 <= LDS_TAB_END, "R2 LDS map");
    cvt_moe_items(A, C, l, cvt_t2(l, C.G) + C.bid * NW + C.wave, CVT_ITEMS, C.G * NW);
    __syncthreads();
    { const float* wg = A.in[15] + (size_t)l * D * NGRP; const float* wr = A.in[17] + (size_t)l * D * NE;
      { const int kp = C.tid; const f32x4 x0 = *(const f32x4*)(wg + (size_t)(2 * kp) * 4), x1 = *(const f32x4*)(wg + (size_t)(2 * kp + 1) * 4);
        *(LAS unsigned*)(RWB + 0 * WP + kp * 4) = cvt2(x0.x, x1.x); *(LAS unsigned*)(RWB + 1 * WP + kp * 4) = cvt2(x0.y, x1.y);
        *(LAS unsigned*)(RWB + 2 * WP + kp * 4) = cvt2(x0.z, x1.z); *(LAS unsigned*)(RWB + 3 * WP + kp * 4) = cvt2(x0.w, x1.w); }
      f32x4 t0[8], t1[8];
#pragma unroll
      for (int jj = 0; jj < 8; ++jj) { const int it = C.tid + NT * jj, kp = it >> 3, cg = it & 7; t0[jj] = *(const f32x4*)(wr + (size_t)(2 * kp) * NE + 4 * cg); t1[jj] = *(const f32x4*)(wr + (size_t)(2 * kp + 1) * NE + 4 * cg); }
#pragma unroll
      for (int jj = 0; jj < 8; ++jj) { const int it = C.tid + NT * jj, kp = it >> 3, c0 = 4 + 4 * (it & 7);
          *(LAS unsigned*)(RWB + (c0 + 0) * WP + kp * 4) = cvt2(t0[jj].x, t1[jj].x); *(LAS unsigned*)(RWB + (c0 + 1) * WP + kp * 4) = cvt2(t0[jj].y, t1[jj].y);
          *(LAS unsigned*)(RWB + (c0 + 2) * WP + kp * 4) = cvt2(t0[jj].z, t1[jj].z); *(LAS unsigned*)(RWB + (c0 + 3) * WP + kp * 4) = cvt2(t0[jj].w, t1[jj].w); }
      for (int i = C.tid; i < 12 * 512; i += NT) *(LAS unsigned*)(RWB + (36 + i / 512) * WP + (i % 512) * 4) = 0u; }
    const int nrows = (l <= 1) ? NR : NL;
    bf16* LAT = (bf16*)(A.ws + WS_LAT); bf16* H = (bf16*)(A.ws + WS_HB); unsigned char* H8 = A.ws + WS_H8;
    const float* MOD = (const float*)(A.ws + WS_MOD);
    unsigned* cnt = (unsigned*)(A.ws + WS_CTL) + CW_CNT + l * 32 * CNT_STRIDE;
    int* TS = (int*)(A.ws + WS_TOKSLOT); float* TW = (float*)(A.ws + WS_TOKW); int* ST = (int*)(A.ws + WS_SLOTTOK);
    const int rpw = (((nrows + C.G - 1) / C.G) + 1) & ~1; const int wrow0 = C.bid * rpw; const int wend0 = min(wrow0 + rpw, nrows);
    const float* bg = A.in[16] + l * NGRP; const float* br = A.in[18] + l * NE;
    for (int cb = wrow0; cb < wend0; cb += RCAP) {
        const int wend = min(cb + RCAP, wend0);
        if (C.tid < 32) hist[C.tid] = 0u;
        for (int sa = cb; sa < wend;) {
            const int mvi = mod_vec_of_row(sa); const int bnd = mvi == 0 ? SEQ : (mvi == 1 ? NL : NR); const int sbnd = min(wend, bnd);
            RowVec RV; { const float* mv = MOD + (size_t)(l * 3 + mvi) * 6 * D; load_rowvec(RV, A.in[6] + (size_t)(l * 2 + 1) * D, mv + 3 * D, mv + 4 * D, mv + 2 * D, C.lane); }
            const int rlast = sbnd - 2;
            u32x2 la[4], lb[4], ya[4], yb[4];
            { const int r0 = min(sa + 2 * C.wave, rlast); load_row_bf16raw(LAT + (size_t)r0 * D, C.lane, la); load_row_bf16raw(LAT + (size_t)(r0 + 1) * D, C.lane, lb);
              load_row_bf16raw(H + (size_t)r0 * D, C.lane, ya); load_row_bf16raw(H + (size_t)(r0 + 1) * D, C.lane, yb); }
            for (int ra = sa + 2 * C.wave; ra < sbnd; ra += 2 * NW) {
                const int rb = ra + 1;
                u32x2 lan[4], lbn[4], yan[4], ybn[4];
                { const int r1 = min(ra + 2 * NW, rlast); load_row_bf16raw(LAT + (size_t)r1 * D, C.lane, lan); load_row_bf16raw(LAT + (size_t)(r1 + 1) * D, C.lane, lbn);
                  load_row_bf16raw(H + (size_t)r1 * D, C.lane, yan); load_row_bf16raw(H + (size_t)(r1 + 1) * D, C.lane, ybn); }
                f32x4 va[4], vb[4];
#pragma unroll
                for (int q = 0; q < 4; ++q) { va[q] = bf4(la[q]) + RV.g[q] * bf4(ya[q]); vb[q] = bf4(lb[q]) + RV.g[q] * bf4(yb[q]); }
                store_row_bf16(LAT + (size_t)ra * D, C.lane, va); store_row_bf16(LAT + (size_t)rb * D, C.lane, vb);
                const float rra = row_rstd(va), rrb = row_rstd(vb);
                f32x4 ha[4], hb[4];
#pragma unroll
                for (int q = 0; q < 4; ++q) { ha[q] = (va[q] * rra) * RV.a[q] + RV.s[q]; hb[q] = (vb[q] * rrb) * RV.a[q] + RV.s[q]; }
                store_row_bf16(H + (size_t)ra * D, C.lane, ha); store_row_bf16(H + (size_t)rb * D, C.lane, hb);
                store_row_fp8(H8 + (size_t)ra * D, C.lane, ha); store_row_fp8(H8 + (size_t)rb * D, C.lane, hb);
#pragma unroll
                for (int q = 0; q < 4; ++q) { la[q] = lan[q]; lb[q] = lbn[q]; ya[q] = yan[q]; yb[q] = ybn[q]; }
            }
            sa = sbnd;
        }
        __syncthreads();
        const int fr = C.lane & 15, fq = C.lane >> 4;
        for (int t = C.wave; t * 16 < wend - cb; t += NW) {
            const int trow = min(cb + 16 * t + fr, wend - 1);
            const bf16* hp = H + (size_t)trow * D + 8 * fq;
            f32x4 acc[3];
#pragma unroll
            for (int ct = 0; ct < 3; ++ct) acc[ct] = (f32x4){0.f, 0.f, 0.f, 0.f};
#pragma unroll 1
            for (int kb = 0; kb < 4; ++kb) {
                bf16x8 av[8];
#pragma unroll
                for (int k8 = 0; k8 < 8; ++k8) av[k8] = *(const bf16x8*)(hp + 32 * (8 * kb + k8));
#pragma unroll
                for (int k8 = 0; k8 < 8; ++k8)
#pragma unroll
                    for (int ct = 0; ct < 3; ++ct) { const bf16x8 bv = *(const LAS bf16x8*)(RWB + (ct * 16 + fr) * WP + (32 * (8 * kb + k8) + 8 * fq) * 2);
                        acc[ct] = __builtin_amdgcn_mfma_f32_16x16x32_bf16(av[k8], bv, acc[ct], 0, 0, 0); }
            }
            LAS float* wl = WL + C.wave * 16 * 48;
#pragma unroll
            for (int ct = 0; ct < 3; ++ct)
#pragma unroll
                for (int jq = 0; jq < 4; ++jq) wl[(4 * fq + jq) * 48 + ct * 16 + fr] = acc[ct][jq];
            asm volatile("s_waitcnt lgkmcnt(0)" ::: "memory");
            const int row = cb + 16 * t + C.lane;
            if (C.lane < 16 && row < wend) {
                LAS const float* wm = wl + C.lane * 48;
                float lg[36];
#pragma unroll
                for (int c = 0; c < 36; ++c) lg[c] = wm[c];
                float gl[4]; int grp = 0; float gm = -3.0e38f;
#pragma unroll
                for (int c = 0; c < 4; ++c) { gl[c] = lg[c] + bg[c]; if (gl[c] > gm) { gm = gl[c]; grp = c; } }
                float gs = 0.f;
#pragma unroll
                for (int c = 0; c < 4; ++c) gs += __expf(gl[c] - gm);
                const float pgrp = 1.0f / gs;
                float rl[8];
#pragma unroll
                for (int i = 0; i < 8; ++i) { float tt = 0.f;
#pragma unroll
                    for (int g = 0; g < 4; ++g) tt = (g == grp) ? lg[4 + g * 8 + i] : tt;
                    rl[i] = tt + br[grp * 8 + i]; }
                int i0 = 0; float m0 = rl[0];
#pragma unroll
                for (int i = 1; i < 8; ++i) if (rl[i] > m0) { m0 = rl[i]; i0 = i; }
                int i1 = -1; float m1 = -3.0e38f;
#pragma unroll
                for (int i = 0; i < 8; ++i) if (i != i0 && rl[i] > m1) { m1 = rl[i]; i1 = i; }
                const float p0 = 1.0f, p1 = __expf(m1 - m0);
                const float w0 = pgrp * p0 / (p0 + p1), w1 = pgrp * p1 / (p0 + p1);
                const int e0 = grp * 8 + i0, e1 = grp * 8 + i1;
                const unsigned q0 = __hip_atomic_fetch_add(hist + e0, 1u, __ATOMIC_RELAXED, __HIP_MEMORY_SCOPE_WORKGROUP), q1 = __hip_atomic_fetch_add(hist + e1, 1u, __ATOMIC_RELAXED, __HIP_MEMORY_SCOPE_WORKGROUP);
                const int li = row - cb;
                rec[li * 4 + 0] = e0 | (e1 << 8); rec[li * 4 + 1] = (int)q0; rec[li * 4 + 2] = (int)q1;
                TW[row * 2 + 0] = w0; TW[row * 2 + 1] = w1;
            }
        }
        __syncthreads();
        if (C.tid < 32) gbase[C.tid] = hist[C.tid] ? atomicAdd(cnt + C.tid * CNT_STRIDE, hist[C.tid]) : 0u;
        __syncthreads();
        for (int i = C.tid; i < wend - cb; i += NT) { const int row = cb + i; const int ee = rec[i * 4], e0 = ee & 255, e1 = ee >> 8;
            const unsigned q0 = gbase[e0] + (unsigned)rec[i * 4 + 1], q1 = gbase[e1] + (unsigned)rec[i * 4 + 2];
            ST[(size_t)e0 * CAP + q0] = row; ST[(size_t)e1 * CAP + q1] = row;
            TS[row * 2 + 0] = (e0 << 20) | (int)q0; TS[row * 2 + 1] = (e1 << 20) | (int)q1; }
        __syncthreads();
    }
}

__device__ __forceinline__ void phase_final(const Args& A, const Ctx& C) {
    LAS int* sb = (LAS int*)C.lds;
    slot_bases(A, 3, sb, C.tid);
    const bf16* LAT = (const bf16*)(A.ws + WS_LAT); const unsigned char* Y8 = A.ws + WS_PB;
    const int* TS = (const int*)(A.ws + WS_TOKSLOT); const float* TW = (const float*)(A.ws + WS_TOKW);
    const float* MOD = (const float*)(A.ws + WS_MOD);
    f32x4 fg[4]; load_row_f32(A.in[7], C.lane, fg);
    const int rpw = (((NL + C.G - 1) / C.G) + 1) & ~1; const int wrow0 = C.bid * rpw; const int wend = min(wrow0 + rpw, NL);
    for (int sa = wrow0; sa < wend;) {
        const int mvi = mod_vec_of_row(sa); const int sbnd = min(wend, mvi == 0 ? SEQ : NL);
        f32x4 g2[4]; load_row_f32(MOD + (size_t)(3 * 3 + mvi) * 6 * D + 5 * D, C.lane, g2);
        for (int ra = sa + 2 * C.wave; ra < sbnd; ra += 2 * NW) {
            const int rb = ra + 1;
            const int ta0 = TS[ra * 2], ta1 = TS[ra * 2 + 1], tb0 = TS[rb * 2], tb1 = TS[rb * 2 + 1]; const float wa0 = TW[ra * 2], wa1 = TW[ra * 2 + 1], wb0 = TW[rb * 2], wb1 = TW[rb * 2 + 1];
            f32x4 va[4], vb[4]; unsigned ya0[4], ya1[4], yb0[4], yb1[4];
            load_row_bf16(LAT + (size_t)ra * D, C.lane, va); load_row_bf16(LAT + (size_t)rb * D, C.lane, vb);
            load_row_fp8raw(Y8 + (size_t)(sb[ta0 >> 20] + (ta0 & 0xfffff)) * D, C.lane, ya0); load_row_fp8raw(Y8 + (size_t)(sb[ta1 >> 20] + (ta1 & 0xfffff)) * D, C.lane, ya1);
            load_row_fp8raw(Y8 + (size_t)(sb[tb0 >> 20] + (tb0 & 0xfffff)) * D, C.lane, yb0); load_row_fp8raw(Y8 + (size_t)(sb[tb1 >> 20] + (tb1 & 0xfffff)) * D, C.lane, yb1);
#pragma unroll
            for (int q = 0; q < 4; ++q) { va[q] += g2[q] * (fp8x4(ya0[q]) * (wa0 * (1.0f / YSCALE)) + fp8x4(ya1[q]) * (wa1 * (1.0f / YSCALE))); vb[q] += g2[q] * (fp8x4(yb0[q]) * (wb0 * (1.0f / YSCALE)) + fp8x4(yb1[q]) * (wb1 * (1.0f / YSCALE))); }
            const float rra = row_rstd(va), rrb = row_rstd(vb);
#pragma unroll
            for (int q = 0; q < 4; ++q) { *(f32x4*)(A.out + (size_t)ra * D + 4 * C.lane + 256 * q) = (va[q] * rra) * fg[q]; *(f32x4*)(A.out + (size_t)rb * D + 4 * C.lane + 256 * q) = (vb[q] * rrb) * fg[q]; }
        }
        sa = sbnd;
    }
}

__device__ __forceinline__ void phase_conv(const Args& A, const Ctx& C, int l) {
    const int j = l >> 1; const int nrows = (l <= 1) ? NR : NL;
    const bf16* P = (const bf16*)(A.ws + WS_PB); unsigned char* HM = A.ws + WS_HM; float* RSC = (float*)(A.ws + WS_RSC);
    const float* cw = A.in[13] + (size_t)j * 3 * D;
    f32x4 w0[4], w1[4], w2[4];
    load_row_f32(cw, C.lane, w0); load_row_f32(cw + D, C.lane, w1); load_row_f32(cw + 2 * D, C.lane, w2);
    const int rpw = (((nrows + C.G - 1) / C.G) + 1) & ~1; const int wrow0 = C.bid * rpw; const int wend = min(wrow0 + rpw, nrows);
    for (int ra = wrow0 + 2 * C.wave; ra < wend; ra += 2 * NW) {
        const int rb = ra + 1;
        const int ta = ra < NL ? (ra & 63) : ((ra - NL) & 255), tb1 = rb < NL ? (rb & 63) : ((rb - NL) & 255), tlast = ra < NL ? 63 : 255;
        const bool hasl = ta != 0, hasr = tb1 != tlast;
        const bf16* pa = P + (size_t)ra * PW;
        u32x2 bga[4], bgb[4], zm[4], z0[4], z1[4], z2[4];
        load_row_bf16raw(pa, C.lane, bga); load_row_bf16raw(pa + PW, C.lane, bgb);
        load_row_bf16raw(pa + D, C.lane, z0); load_row_bf16raw(pa + PW + D, C.lane, z1);
        load_row_bf16raw(hasl ? pa - PW + D : pa + D, C.lane, zm); load_row_bf16raw(hasr ? pa + 2 * PW + D : pa + D, C.lane, z2);
        const float fl = hasl ? 1.f : 0.f, fr = hasr ? 1.f : 0.f;
        f32x4 oa[4], ob[4];
#pragma unroll
        for (int q = 0; q < 4; ++q) { const f32x4 a0 = bf4(z0[q]), a1 = bf4(z1[q]);
            oa[q] = bf4(bga[q]) * (w0[q] * (bf4(zm[q]) * fl) + w1[q] * a0 + w2[q] * a1);
            ob[q] = bf4(bgb[q]) * (w0[q] * a0 + w1[q] * a1 + w2[q] * (bf4(z2[q]) * fr)); }
        float ma = 0.f, mb = 0.f;
#pragma unroll
        for (int q = 0; q < 4; ++q) { ma = fmaxf(ma, fmaxf(fmaxf(fabsf(oa[q].x), fabsf(oa[q].y)), fmaxf(fabsf(oa[q].z), fabsf(oa[q].w)))); mb = fmaxf(mb, fmaxf(fmaxf(fabsf(ob[q].x), fabsf(ob[q].y)), fmaxf(fabsf(ob[q].z), fabsf(ob[q].w)))); }
        ma = fmaxf(wave_max_nn(ma), 1.0e-20f); mb = fmaxf(wave_max_nn(mb), 1.0e-20f);
        const float ia = 127.0f / ma, ib = 127.0f / mb;
#pragma unroll
        for (int q = 0; q < 4; ++q) { *(unsigned*)(HM + (size_t)ra * D + 4 * C.lane + 256 * q) = pack_i8(oa[q] * ia); *(unsigned*)(HM + (size_t)rb * D + 4 * C.lane + 256 * q) = pack_i8(ob[q] * ib); }
        if (C.lane == 0) { RSC[ra] = ma * (1.0f / 127.0f); RSC[rb] = mb * (1.0f / 127.0f); }
    }
}

constexpr int BM = 256, BK = 64, HALF = 128, HTB = HALF * BK * 2, STAGE_BYTES = 8 * HTB, NXCD = 8, WGM = 8;
constexpr int LDS_TAB = STAGE_BYTES;
__device__ __forceinline__ int lds_byte(int r, int c) { const int st = (r >> 4) * 2 + (c >> 5), rr = r & 15, cc = c & 31, ob = rr * 64 + cc * 2; return st * 1024 + (ob ^ (((ob >> 9) & 1) << 5)); }
__device__ __forceinline__ void stage_rc(int b, int& R, int& C) { const int st = b / 1024, sb = b % 1024, swz = sb ^ (((sb >> 9) & 1) << 5); R = (st >> 1) * 16 + swz / 64; C = (st & 1) * 32 + (swz % 64) / 2; }
__device__ __forceinline__ int perm32(int rho) { const int n = rho >> 4, i = rho & 15; return 8 * (i >> 2) + 4 * n + (i & 3); }
__device__ __forceinline__ unsigned cvt_pk_bf16(float lo, float hi) { unsigned r; asm volatile("v_cvt_pk_bf16_f32 %0, %1, %2" : "=v"(r) : "v"(lo), "v"(hi)); return r; }

struct GUnit { const char* a; const char* b; int orow, ocol, aux; };

typedef int i32x8 __attribute__((ext_vector_type(8)));
typedef int i32x4 __attribute__((ext_vector_type(4)));
template <class Epi, class Sched, bool GATHER, int OPM = 0>
__device__ __forceinline__ void gemm_phase(LAS unsigned char* lds, const int K, const Sched& S, const Epi& E) {
    const int tid = threadIdx.x, wid = __builtin_amdgcn_readfirstlane(tid >> 6), lane = tid & 63, wr = wid >> 2, wc = wid & 3, fr = lane & 15, fq = lane >> 4;
    constexpr bool FP8 = (OPM == 1), I8 = (OPM == 2);
    const int RB = (OPM != 0) ? K : 2 * K;
    const int nt = RB / (BK * 2);
    unsigned voffB[2], voA[2][2]; int Rr[2], Cc[2];
#pragma unroll
    for (int i = 0; i < 2; ++i) { int R, C; stage_rc(tid * 16 + i * 8192, R, C); const int Rb = (R & ~31) + perm32(R & 31); Rr[i] = R; Cc[i] = C;
        voffB[i] = (unsigned)(Rb * RB + C * 2);
        voA[0][i] = (unsigned)(R * RB + C * 2); voA[1][i] = (unsigned)((R + HALF) * RB + C * 2); }
    const size_t kstep = (size_t)(BK * 2);
    const size_t hstep = (size_t)HALF * RB;
    const unsigned ldsw = (unsigned)wid * 1024u;
    const unsigned ldsbase = (unsigned)(size_t)lds;
    const int aoff = lds_byte(wr * 64 + fr, fq * 8), boff = lds_byte(wc * 32 + fr, fq * 8);
#define PG8_SA(b, h) (((b) * 2 + (h)) * HTB)
#define PG8_SB(b, h) ((4 + (b) * 2 + (h)) * HTB)
#define PG8_STAGE(bufoff, gbase, voff) do { _Pragma("unroll") for (int _i = 0; _i < 2; ++_i) \
        asm volatile("s_mov_b32 m0, %2\n\ts_nop 0\n\tglobal_load_lds_dwordx4 %0, %1" :: "v"((voff)[_i]), "s"((const char*)(gbase)), "s"(ldsbase + (unsigned)(bufoff) + ldsw + (unsigned)(_i * 8192)) : "memory"); } while (0)
#define PG8_STAGE_A1(bufoff, gbase) do { if constexpr (GATHER) PG8_STAGE(bufoff, gbase, voA[1]); else PG8_STAGE(bufoff, (const char*)(gbase) + hstep, voA[0]); } while (0)
#define PG8_LDA(dst, b, h) do { if constexpr (FP8) { _Pragma("unroll") for (int m = 0; m < 4; ++m) { \
        const i32x4 _lo = *(const LAS i32x4*)(lds + PG8_SA(b, h) + aoff + m * 2048), _hi = *(const LAS i32x4*)(lds + PG8_SA(b, h) + aoff + m * 2048 + 1024); \
        dst##8[m] = __builtin_shufflevector(_lo, _hi, 0, 1, 2, 3, 4, 5, 6, 7); } } \
      else { _Pragma("unroll") for (int m = 0; m < 4; ++m) _Pragma("unroll") for (int k = 0; k < 2; ++k) dst[m][k] = *(const LAS bf16x8*)(lds + PG8_SA(b, h) + aoff + m * 2048 + k * 1024); } } while (0)
#define PG8_LDB(dst, b, h) do { if constexpr (FP8) { _Pragma("unroll") for (int n = 0; n < 2; ++n) { \
        const i32x4 _lo = *(const LAS i32x4*)(lds + PG8_SB(b, h) + boff + n * 2048), _hi = *(const LAS i32x4*)(lds + PG8_SB(b, h) + boff + n * 2048 + 1024); \
        dst##8[n] = __builtin_shufflevector(_lo, _hi, 0, 1, 2, 3, 4, 5, 6, 7); } } \
      else { _Pragma("unroll") for (int n = 0; n < 2; ++n) _Pragma("unroll") for (int k = 0; k < 2; ++k) dst[n][k] = *(const LAS bf16x8*)(lds + PG8_SB(b, h) + boff + n * 2048 + k * 1024); } } while (0)
#define PG8_MMA(ai, bj, At, Bt) do { __builtin_amdgcn_s_setprio(1); \
        if constexpr (FP8) { _Pragma("unroll") for (int m = 0; m < 4; ++m) _Pragma("unroll") for (int n = 0; n < 2; ++n) \
            acc[ai][bj][m][n] = __builtin_amdgcn_mfma_scale_f32_16x16x128_f8f6f4(Bt##8[n], At##8[m], acc[ai][bj][m][n], 0, 0, 0, 0x7f7f7f7f, 0, 0x7f7f7f7f); } \
        else if constexpr (I8) { _Pragma("unroll") for (int m = 0; m < 4; ++m) _Pragma("unroll") for (int n = 0; n < 2; ++n) _Pragma("unroll") for (int k = 0; k < 2; ++k) \
            acc[ai][bj][m][n] = __builtin_bit_cast(f32x4, __builtin_amdgcn_mfma_i32_16x16x64_i8(__builtin_bit_cast(i32x4, Bt[n][k]), __builtin_bit_cast(i32x4, At[m][k]), __builtin_bit_cast(i32x4, acc[ai][bj][m][n]), 0, 0, 0)); } \
        else { _Pragma("unroll") for (int m = 0; m < 4; ++m) _Pragma("unroll") for (int n = 0; n < 2; ++n) _Pragma("unroll") for (int k = 0; k < 2; ++k) \
            acc[ai][bj][m][n] = __builtin_amdgcn_mfma_f32_16x16x32_bf16(Bt[n][k], At[m][k], acc[ai][bj][m][n], 0, 0, 0); } \
        __builtin_amdgcn_s_setprio(0); } while (0)
#define PG8_WAIT_V(n) asm volatile("s_waitcnt vmcnt(" #n ")" ::: "memory")
#define PG8_WAIT_L(n) asm volatile("s_waitcnt lgkmcnt(" #n ")" ::: "memory")
#define PG8_BAR __builtin_amdgcn_s_barrier()
#define PG8_SCHED __builtin_amdgcn_sched_barrier(0)
    GUnit cur, nxt; int ui = 0;
    if (!S.next(0, cur)) return;
    if constexpr (GATHER) {
#pragma unroll
        for (int h = 0; h < 2; ++h)
#pragma unroll
            for (int i = 0; i < 2; ++i) voA[h][i] = S.arow_off(0, h * HALF + Rr[i]) + (unsigned)Cc[i] * 2u;
    }
    f32x4 acc[2][2][4][2];
#pragma unroll
    for (int a = 0; a < 2; ++a)
#pragma unroll
        for (int b = 0; b < 2; ++b)
#pragma unroll
            for (int m = 0; m < 4; ++m)
#pragma unroll
                for (int n = 0; n < 2; ++n) acc[a][b][m][n] = (f32x4){0.f, 0.f, 0.f, 0.f};
    bf16x8 At[4][2], B0[2][2], B1[2][2]; i32x8 At8[4], B08[2], B18[2];
    const char* cA = cur.a; const char* cB = cur.b;
    PG8_STAGE(PG8_SB(0, 0), cB, voffB); PG8_STAGE(PG8_SB(0, 1), cB + hstep, voffB); PG8_STAGE(PG8_SA(0, 0), cA, voA[0]); PG8_STAGE_A1(PG8_SA(0, 1), cA);
    if (wr == 1) PG8_BAR;
    PG8_WAIT_V(2); PG8_BAR;
    PG8_STAGE(PG8_SB(1, 0), cB + kstep, voffB); PG8_STAGE(PG8_SA(1, 0), cA + kstep, voA[0]); PG8_STAGE(PG8_SB(1, 1), cB + hstep + kstep, voffB);
    PG8_WAIT_V(6); PG8_BAR;
    for (;;) {
        const bool has_next = S.next(ui + 1, nxt);
        const char* nA = has_next ? nxt.a : cA; const char* nB = has_next ? nxt.b : cB;
#pragma unroll 1
        for (int t = 0; t < nt; t += 2) {
            const bool last = (t == nt - 2);
            const char* a1 = cA + (size_t)(t + 1) * kstep;
            const char* a2 = last ? nA : cA + (size_t)(t + 2) * kstep; const char* b2 = last ? nB : cB + (size_t)(t + 2) * kstep;
            const char* a3 = a2 + kstep; const char* b3 = b2 + kstep;
            PG8_LDB(B0, 0, 0); PG8_LDB(B1, 0, 1); PG8_SCHED; PG8_LDA(At, 0, 0); PG8_STAGE_A1(PG8_SA(1, 1), a1);
            if constexpr (GATHER) { if (last && has_next) {
#pragma unroll
                for (int h = 0; h < 2; ++h)
#pragma unroll
                    for (int i = 0; i < 2; ++i) { int R2, C2; stage_rc(tid * 16 + i * 8192, R2, C2); voA[h][i] = S.arow_off(ui + 1, h * HALF + R2) + (unsigned)C2 * 2u; } } }
            PG8_WAIT_V(8); PG8_WAIT_L(0); PG8_BAR; PG8_MMA(0, 0, At, B0); PG8_MMA(0, 1, At, B1); PG8_BAR; PG8_SCHED;
            PG8_LDA(At, 0, 1); PG8_STAGE(PG8_SB(0, 0), b2, voffB); PG8_STAGE(PG8_SB(0, 1), b2 + hstep, voffB); PG8_STAGE(PG8_SA(0, 0), a2, voA[0]);
            PG8_WAIT_V(8); PG8_WAIT_L(0); PG8_BAR; PG8_MMA(1, 0, At, B0); PG8_MMA(1, 1, At, B1); PG8_BAR; PG8_SCHED;
            PG8_LDB(B0, 1, 0); PG8_LDB(B1, 1, 1); PG8_SCHED; PG8_LDA(At, 1, 0); PG8_STAGE_A1(PG8_SA(0, 1), a2);
            PG8_WAIT_V(8); PG8_WAIT_L(0); PG8_BAR; PG8_MMA(0, 0, At, B0); PG8_MMA(0, 1, At, B1); PG8_BAR; PG8_SCHED;
            PG8_LDA(At, 1, 1); PG8_STAGE(PG8_SB(1, 0), b3, voffB); PG8_STAGE(PG8_SB(1, 1), b3 + hstep, voffB); PG8_STAGE(PG8_SA(1, 0), a3, voA[0]);
            PG8_WAIT_V(8); PG8_WAIT_L(0); PG8_BAR; PG8_MMA(1, 0, At, B0); PG8_MMA(1, 1, At, B1); PG8_BAR; PG8_SCHED;
        }
        if (wr == 0) PG8_BAR;
        { int tz = threadIdx.x; asm volatile("" : "+v"(tz));
          if constexpr (I8) {
#pragma unroll
              for (int a_ = 0; a_ < 2; ++a_)
#pragma unroll
                  for (int b_ = 0; b_ < 2; ++b_)
#pragma unroll
                      for (int m = 0; m < 4; ++m)
#pragma unroll
                          for (int n = 0; n < 2; ++n) acc[a_][b_][m][n] = __builtin_convertvector(__builtin_bit_cast(i32x4, acc[a_][b_][m][n]), f32x4); }
          const int wz = tz >> 6, lz = tz & 63; E(acc, cur, wz >> 2, wz & 3, lz & 15, lz >> 4); }
        if (!has_next) break;
#pragma unroll
        for (int a = 0; a < 2; ++a)
#pragma unroll
            for (int b = 0; b < 2; ++b)
#pragma unroll
                for (int m = 0; m < 4; ++m)
#pragma unroll
                    for (int n = 0; n < 2; ++n) acc[a][b][m][n] = (f32x4){0.f, 0.f, 0.f, 0.f};
        cur = nxt; cA = nA; cB = nB; ++ui;
        if (wr == 1) PG8_BAR;
    }
    PG8_WAIT_V(0);
    PG8_BAR;
#undef PG8_SA
#undef PG8_SB
#undef PG8_STAGE
#undef PG8_STAGE_A1
#undef PG8_LDA
#undef PG8_LDB
#undef PG8_MMA
#undef PG8_WAIT_V
#undef PG8_WAIT_L
#undef PG8_BAR
#undef PG8_SCHED
}

__device__ __forceinline__ int xcd_remap(int L, int nwg) { const int q = nwg / NXCD, r = nwg % NXCD, xcd = L % NXCD, off = L / NXCD; return (xcd < r ? xcd * (q + 1) : r * (q + 1) + (xcd - r) * q) + off; }

struct DenseSched {
    const char* A; const char* Bt; int nM, nN, nwg, G, c; size_t tstep; int sw_lo, sw_hi;
    __device__ __forceinline__ void init(const void* A_, const void* Bt_, int M, int N, int K, int G_, int c_, int ebytes = 2) { A = (const char*)A_; Bt = (const char*)Bt_; nM = M / BM; nN = N / BM; nwg = nM * nN; G = G_; c = c_; tstep = (size_t)BM * K * ebytes; sw_lo = 0; sw_hi = 0; }
    __device__ __forceinline__ bool next(int i, GUnit& u) const {
        const long L = (long)i * G + c; if (L >= nwg) return false;
        const int wgid = xcd_remap((int)L, nwg);
        const int nig = WGM * nN, gid = wgid / nig, fm = gid * WGM, gsz = (nM - fm) < WGM ? (nM - fm) : WGM;
        const int pm = fm + ((wgid % nig) % gsz), pn = (wgid % nig) / gsz;
        if (pn >= sw_lo && pn < sw_hi) { u.a = Bt + (size_t)pn * tstep; u.b = A + (size_t)pm * tstep; u.orow = pm; u.ocol = pn - sw_lo; u.aux = 1; }
        else { u.a = A + (size_t)pm * tstep; u.b = Bt + (size_t)pn * tstep; u.orow = pm * BM; u.ocol = pn * BM; u.aux = 0; }
        return true;
    }
    __device__ __forceinline__ unsigned arow_off(int, int) const { return 0u; }
};

constexpr int MAXU = 12;
struct MoeTab { int n; int e[MAXU], mb[MAXU], nt[MAXU]; int sb[NE + 1]; };
struct MoeSched {
    LAS const MoeTab* T; LAS const unsigned* ridx;
    const char* A; const char* W; size_t wstride_e, tstepB; int K; int arow_bytes;
    __device__ __forceinline__ bool next(int i, GUnit& u) const {
        const int n = __builtin_amdgcn_readfirstlane(T->n); if (i >= n) return false;
        const int e = __builtin_amdgcn_readfirstlane(T->e[i]), mb = __builtin_amdgcn_readfirstlane(T->mb[i]), nt = __builtin_amdgcn_readfirstlane(T->nt[i]);
        const int base = __builtin_amdgcn_readfirstlane(T->sb[e]);
        u.orow = base + mb * BM; u.ocol = nt; u.aux = e;
        u.a = A + (size_t)u.orow * arow_bytes;
        u.b = W + (size_t)e * wstride_e + (size_t)nt * tstepB; return true;
    }
    __device__ __forceinline__ unsigned arow_off(int i, int r) const { return ridx[i * 256 + r]; }
};
template <bool GATHER>
__device__ __forceinline__ void moe_tables(const Args& A, const Ctx& C, int l, int ntile_n, LAS MoeTab* T, LAS unsigned* ridx, int arow_bytes) {
    const unsigned* cnt = (const unsigned*)(A.ws + WS_CTL) + CW_CNT + l * 32 * CNT_STRIDE;
    LAS int* ust = (LAS int*)(T + 1);
    if (C.tid < 64) { int nb; const int ex = expert_block_prefix(cnt, C.tid, nb); if (C.tid <= NE) { T->sb[C.tid] = ex * 256; ust[C.tid] = ex * ntile_n; } }
    __syncthreads();
    if (C.tid < MAXU) { const int nwg = ust[NE]; const long L = (long)C.tid * C.G + C.bid;
        if (L < nwg) { const int w = xcd_remap((int)L, nwg); int e = 0; while (w >= ust[e + 1]) ++e;
            const int lu = w - ust[e]; T->e[C.tid] = e; T->mb[C.tid] = lu / ntile_n; T->nt[C.tid] = lu % ntile_n; } }
    if (C.tid == 0) { const int nwg = ust[NE]; int n = 0; while (n < MAXU && (long)n * C.G + C.bid < nwg) ++n; T->n = n; }
    __syncthreads();
    if constexpr (GATHER) {
        const int* ST = (const int*)(A.ws + WS_SLOTTOK); const int n = T->n;
        for (int i = C.tid; i < n * 256; i += NT) { const int ui = i >> 8, r = i & 255, e = T->e[ui], m0 = T->mb[ui] * 256, ce = (int)cnt[e * CNT_STRIDE];
            const int rr = (m0 + r < ce) ? m0 + r : ce - 1;
            ridx[i] = (unsigned)ST[(size_t)e * CAP + rr] * (unsigned)arow_bytes; }
        __syncthreads();
    }
}

struct EpiStore { bf16* O; int ldc; float scale_lo; int sig_from; bf16* VT; float sall = 1.0f; const float* rs = nullptr;
    __device__ __forceinline__ void operator()(const f32x4 (&acc)[2][2][4][2], const GUnit& u, int wr, int wc, int fr, int fq) const {
        const bool tr = u.aux != 0;
        const float sc = ((!tr && u.ocol < NQ) ? scale_lo : 1.0f) * sall; const bool sg = !tr && u.ocol >= sig_from;
        bf16* Ob = tr ? VT + (size_t)(u.orow * NH + u.ocol) * 65536 : O + (size_t)u.orow * ldc + u.ocol; const int ld = tr ? 256 : ldc;
        f32x4 cs[2][2];
#pragma unroll
        for (int bj = 0; bj < 2; ++bj) { const f32x4 one = (f32x4){1.f, 1.f, 1.f, 1.f};
            cs[bj][0] = (rs && tr) ? *(const f32x4*)(rs + u.orow * BM + bj * HALF + wc * 32 + 8 * fq) : one; cs[bj][1] = (rs && tr) ? *(const f32x4*)(rs + u.orow * BM + bj * HALF + wc * 32 + 8 * fq + 4) : one; }
#pragma unroll
        for (int ai = 0; ai < 2; ++ai)
#pragma unroll
            for (int m = 0; m < 4; ++m) { const int rl = ai * HALF + wr * 64 + m * 16 + fr; bf16* rowp = Ob + (size_t)rl * ld + wc * 32 + 8 * fq;
                const float scr = (rs && !tr) ? sc * rs[u.orow + rl] : sc;
#pragma unroll
                for (int bj = 0; bj < 2; ++bj) { f32x4 v0 = acc[ai][bj][m][0] * scr * cs[bj][0], v1 = acc[ai][bj][m][1] * scr * cs[bj][1];
                    if (sg) {
#pragma unroll
                        for (int q = 0; q < 4; ++q) { v0[q] = __builtin_amdgcn_rcpf(1.0f + __expf(-v0[q])); v1[q] = __builtin_amdgcn_rcpf(1.0f + __expf(-v1[q])); } }
                    u32x4 w; w.x = cvt_pk_bf16(v0[0], v0[1]); w.y = cvt_pk_bf16(v0[2], v0[3]); w.z = cvt_pk_bf16(v1[0], v1[1]); w.w = cvt_pk_bf16(v1[2], v1[3]);
                    *(u32x4*)(rowp + bj * HALF) = w; } }
    }
};
__device__ __forceinline__ u32x2 cvt8_fp8(f32x4 a, f32x4 b) { int lo = 0, hi = 0;
    lo = __builtin_amdgcn_cvt_pk_fp8_f32(a[0], a[1], lo, false); lo = __builtin_amdgcn_cvt_pk_fp8_f32(a[2], a[3], lo, true);
    hi = __builtin_amdgcn_cvt_pk_fp8_f32(b[0], b[1], hi, false); hi = __builtin_amdgcn_cvt_pk_fp8_f32(b[2], b[3], hi, true); return (u32x2){(unsigned)lo, (unsigned)hi}; }
struct EpiSwigluF8 { unsigned char* O; int ldc; float s;
    __device__ __forceinline__ void operator()(const f32x4 (&acc)[2][2][4][2], const GUnit& u, int wr, int wc, int fr, int fq) const {
        const int ocol = u.ocol * HALF;
#pragma unroll
        for (int ai = 0; ai < 2; ++ai)
#pragma unroll
            for (int m = 0; m < 4; ++m) { unsigned char* rowp = O + (size_t)(u.orow + ai * HALF + wr * 64 + m * 16 + fr) * ldc + ocol + wc * 32 + 8 * fq;
                f32x4 v0, v1;
#pragma unroll
                for (int q = 0; q < 4; ++q) { const float x0 = acc[ai][0][m][0][q] * s, x1 = acc[ai][0][m][1][q] * s;
                    v0[q] = x0 * __builtin_amdgcn_rcpf(1.0f + __expf(-x0)) * (acc[ai][1][m][0][q] * s); v1[q] = x1 * __builtin_amdgcn_rcpf(1.0f + __expf(-x1)) * (acc[ai][1][m][1][q] * s); }
                *(u32x2*)rowp = cvt8_fp8(v0, v1); }
    }
};
template <int MODE> struct EpiPair { bf16* O; int ldc; int plain_below; float sall = 1.0f; const float* rs = nullptr;
    __device__ __forceinline__ void operator()(const f32x4 (&acc)[2][2][4][2], const GUnit& u, int wr, int wc, int fr, int fq) const {
        if (MODE == 0 && u.ocol < plain_below) {
#pragma unroll
            for (int ai = 0; ai < 2; ++ai)
#pragma unroll
                for (int m = 0; m < 4; ++m) { const int rg = u.orow + ai * HALF + wr * 64 + m * 16 + fr; bf16* rowp = O + (size_t)rg * ldc + u.ocol + wc * 32 + 8 * fq;
                    const float scr = rs ? sall * rs[rg] : sall;
#pragma unroll
                    for (int bj = 0; bj < 2; ++bj) { const f32x4 v0 = acc[ai][bj][m][0] * scr, v1 = acc[ai][bj][m][1] * scr;
                        u32x4 w; w.x = cvt_pk_bf16(v0[0], v0[1]); w.y = cvt_pk_bf16(v0[2], v0[3]); w.z = cvt_pk_bf16(v1[0], v1[1]); w.w = cvt_pk_bf16(v1[2], v1[3]);
                        *(u32x4*)(rowp + bj * HALF) = w; } }
            return;
        }
        const int ocol = (MODE == 0) ? plain_below + (u.ocol - plain_below) / 2 : u.ocol * HALF;
#pragma unroll
        for (int ai = 0; ai < 2; ++ai)
#pragma unroll
            for (int m = 0; m < 4; ++m) { const int rg = u.orow + ai * HALF + wr * 64 + m * 16 + fr; bf16* rowp = O + (size_t)rg * ldc + ocol + wc * 32 + 8 * fq;
                const float scr = rs ? sall * rs[rg] : sall; const float sc2 = scr * scr;
                f32x4 v0, v1;
#pragma unroll
                for (int q = 0; q < 4; ++q) {
                    const float x0 = acc[ai][0][m][0][q], x1 = acc[ai][0][m][1][q];
                    const float g0 = (MODE == 1) ? x0 * __builtin_amdgcn_rcpf(1.0f + __expf(-x0)) : x0, g1 = (MODE == 1) ? x1 * __builtin_amdgcn_rcpf(1.0f + __expf(-x1)) : x1;
                    v0[q] = g0 * acc[ai][1][m][0][q] * sc2; v1[q] = g1 * acc[ai][1][m][1][q] * sc2; }
                u32x4 w; w.x = cvt_pk_bf16(v0[0], v0[1]); w.y = cvt_pk_bf16(v0[2], v0[3]); w.z = cvt_pk_bf16(v1[0], v1[1]); w.w = cvt_pk_bf16(v1[2], v1[3]);
                *(u32x4*)rowp = w; }
    }
};
struct EpiStoreTile { unsigned char* O; int ldc; float s;
    __device__ __forceinline__ void operator()(const f32x4 (&acc)[2][2][4][2], const GUnit& u, int wr, int wc, int fr, int fq) const {
#pragma unroll
        for (int ai = 0; ai < 2; ++ai)
#pragma unroll
            for (int m = 0; m < 4; ++m) { unsigned char* rowp = O + (size_t)(u.orow + ai * HALF + wr * 64 + m * 16 + fr) * ldc + u.ocol * BM + wc * 32 + 8 * fq;
#pragma unroll
                for (int bj = 0; bj < 2; ++bj) *(u32x2*)(rowp + bj * HALF) = cvt8_fp8(acc[ai][bj][m][0] * s, acc[ai][bj][m][1] * s); }
    }
};

__device__ __forceinline__ void transpose_item(const float* W, int ldw, int K, bf16* WT, int drow0, int k0, int n0, LAS float* scr, int lane) {
#pragma unroll
    for (int i = 0; i < 32; ++i) { const int kk = 2 * i + (lane >> 5); scr[kk * 33 + (lane & 31)] = W[(size_t)(k0 + kk) * ldw + n0 + (lane & 31)]; }
    asm volatile("s_waitcnt lgkmcnt(0)" ::: "memory");
    const int c = lane & 7;
#pragma unroll
    for (int j = 0; j < 4; ++j) { const int n = (lane >> 3) + 8 * j; const LAS float* s = scr + (8 * c) * 33 + n;
        u32x4 o; o.x = pk2(s[0 * 33], s[1 * 33]); o.y = pk2(s[2 * 33], s[3 * 33]); o.z = pk2(s[4 * 33], s[5 * 33]); o.w = pk2(s[6 * 33], s[7 * 33]);
        *(u32x4*)(WT + (size_t)(drow0 + n) * K + k0 + 8 * c) = o; }
    asm volatile("s_waitcnt lgkmcnt(0)" ::: "memory");
}
__device__ __forceinline__ void transpose_item_fp8(const float* W, int ldw, int K, unsigned char* WT8, int drow0, int k0, int n0, LAS float* scr, int lane, float sc) {
#pragma unroll
    for (int i = 0; i < 32; ++i) { const int kk = 2 * i + (lane >> 5); scr[kk * 33 + (lane & 31)] = W[(size_t)(k0 + kk) * ldw + n0 + (lane & 31)]; }
    asm volatile("s_waitcnt lgkmcnt(0)" ::: "memory");
    const int n = lane >> 1, half = lane & 1; const LAS float* sp = scr + (32 * half) * 33 + n;
    unsigned char* dst = WT8 + (size_t)(drow0 + n) * K + k0 + 32 * half;
#pragma unroll
    for (int c = 0; c < 2; ++c) { u32x4 o;
#pragma unroll
        for (int q = 0; q < 4; ++q) { int p = 0; const LAS float* s4 = sp + (16 * c + 4 * q) * 33;
            p = __builtin_amdgcn_cvt_pk_fp8_f32(s4[0] * sc, s4[33] * sc, p, false); p = __builtin_amdgcn_cvt_pk_fp8_f32(s4[66] * sc, s4[99] * sc, p, true); o[q] = (unsigned)p; }
        *(u32x4*)(dst + 16 * c) = o; }
    asm volatile("s_waitcnt lgkmcnt(0)" ::: "memory");
}
__device__ __forceinline__ void transpose_item_i8(const float* W, int ldw, int K, unsigned char* WT8, int drow0, int k0, int n0, LAS float* scr, int lane, float inv) {
#pragma unroll
    for (int i = 0; i < 32; ++i) { const int kk = 2 * i + (lane >> 5); scr[kk * 33 + (lane & 31)] = W[(size_t)(k0 + kk) * ldw + n0 + (lane & 31)]; }
    asm volatile("s_waitcnt lgkmcnt(0)" ::: "memory");
    const int n = lane >> 1, half = lane & 1; const LAS float* sp = scr + (32 * half) * 33 + n;
    unsigned char* dst = WT8 + (size_t)(drow0 + n) * K + k0 + 32 * half;
#pragma unroll
    for (int c = 0; c < 2; ++c) { u32x4 o;
#pragma unroll
        for (int q = 0; q < 4; ++q) { const LAS float* s4 = sp + (16 * c + 4 * q) * 33; o[q] = pack_i8((f32x4){s4[0] * inv, s4[33] * inv, s4[66] * inv, s4[99] * inv}); }
        *(u32x4*)(dst + 16 * c) = o; }
    asm volatile("s_waitcnt lgkmcnt(0)" ::: "memory");
}
__device__ __forceinline__ int pair_row(int n, int which) { return (n >> 7) * 256 + (n & 127) + which * 128; }
constexpr float HMR = 6.0f;
__device__ __forceinline__ void phase_cvt_mixer(const Args& A, const Ctx& C) {
    const int gw = C.bid * NW + C.wave, NGW = C.G * NW;
    unsigned* wmax = (unsigned*)(A.ws + WS_CTL) + CW_WMAX;
    for (int m8 = 0; m8 < 8; ++m8) {
        const float* W = m8 < 2 ? A.in[8] + (size_t)m8 * D * PROJ : m8 < 4 ? A.in[12] + (size_t)(m8 - 2) * D * PW : m8 < 6 ? A.in[11] + (size_t)(m8 - 4) * D * D : A.in[14] + (size_t)(m8 - 6) * D * D;
        const size_t n4 = (size_t)D * (m8 < 2 ? PROJ : m8 < 4 ? PW : D) / 4;
        float mx = 0.f;
        for (size_t i = (size_t)gw * 64 + C.lane; i < n4; i += (size_t)NGW * 64) { const f32x4 v = *(const f32x4*)(W + 4 * i); mx = fmaxf(mx, fmaxf(fmaxf(fabsf(v.x), fabsf(v.y)), fmaxf(fabsf(v.z), fabsf(v.w)))); }
        mx = wave_max_nn(mx);
        if (C.lane == 0 && mx > 0.f) atomicMax(wmax + m8 * CNT_STRIDE, __float_as_uint(mx));
    }
}
__device__ __forceinline__ void cvt_win_i8(const Args& A, const Ctx& C) {
    LAS float* scr = (LAS float*)(C.lds + 16384 + C.wave * 16384);
    const int gw = C.bid * NW + C.wave, NGW = C.G * NW;
    constexpr int I_IN = (D / 64) * (PW / 32);
    const unsigned* wmax = (const unsigned*)(A.ws + WS_CTL) + CW_WMAX;
    constexpr int I_OUT = (D / 64) * (D / 32);
    for (int it = gw; it < 4 * I_OUT; it += NGW) {
        const int m4 = it / I_OUT, kind = m4 >> 1, j = m4 & 1, r = it % I_OUT; const int kb = r / (D / 32), nb = r % (D / 32), n0 = nb * 32;
        const float inv = 127.0f / fmaxf(__uint_as_float(wmax[(4 + m4) * CNT_STRIDE]), 1.0e-30f);
        transpose_item_i8((kind == 0 ? A.in[11] : A.in[14]) + (size_t)j * D * D, D, D, A.ws + (kind == 0 ? WS_WAOUT : WS_WBOUT) + (size_t)j * D * D, n0, kb * 64, n0, scr, C.lane, inv); }
    for (int it = gw; it < 4 * I_IN; it += NGW) {
        const int m4 = it / I_IN, kind = m4 >> 1, j = m4 & 1, r = it % I_IN; const int kb = r / (PW / 32), nb = r % (PW / 32), n0 = nb * 32;
        const float inv = 127.0f / fmaxf(__uint_as_float(wmax[m4 * CNT_STRIDE]), 1.0e-30f);
        unsigned char* WT = A.ws + (kind == 0 ? WS_WAIN : WS_WBIN) + (size_t)j * PW * D;
        if (kind == 0) transpose_item_i8(A.in[8] + (size_t)j * D * PROJ, PROJ, D, WT, n0, kb * 64, n0, scr, C.lane, inv);
        else { const int drow = n0 < D ? n0 : (n0 < 2 * D ? D + pair_row(n0 - D, 0) : D + pair_row(n0 - 2 * D, 1));
            transpose_item_i8(A.in[12] + (size_t)j * D * PW, PW, D, WT, drow, kb * 64, n0, scr, C.lane, inv); }
    }
}
__device__ __forceinline__ void cvt_moe_items(const Args& A, const Ctx& C, int l, int it0, int end, int stride) {
    LAS float* scr = (LAS float*)(C.lds + 16384 + C.wave * 16384);
    unsigned char* WGU = A.ws + WS_WGU; unsigned char* WDN = A.ws + WS_WDN;
    for (int it = it0; it < end; it += stride) {
        const int e = it / CVT_PER; int r = it % CVT_PER;
        if (r < 2 * CVT_IG) { const int which = r / CVT_IG; r %= CVT_IG; const int kb = r / (DE / 32), nb = r % (DE / 32), n0 = nb * 32;
            transpose_item_fp8((which == 0 ? A.in[19] : A.in[20]) + ((size_t)l * NE + e) * D * DE, DE, D, WGU + (size_t)e * 2 * DE * D, pair_row(n0, which), kb * 64, n0, scr, C.lane, WSCALE); }
        else { r -= 2 * CVT_IG; const int kb = r / (D / 32), nb = r % (D / 32), n0 = nb * 32;
            transpose_item_fp8(A.in[21] + ((size_t)l * NE + e) * DE * D, D, DE, WDN + (size_t)e * D * DE, n0, kb * 64, n0, scr, C.lane, WSCALE); }
    }
}
__device__ __forceinline__ int cvt_idle(int nunits, int G) { const int rem = nunits % G; return rem ? G - rem : 0; }
__device__ __forceinline__ int cvt_t1(int l, int G) { const int n = cvt_idle((((l <= 2) ? NR : NL) / BM) * (PW / BM), G) * CVT_Q; return n < CVT_ITEMS ? n : CVT_ITEMS; }
__device__ __forceinline__ int cvt_t2(int l, int G) { const int n = cvt_t1(l, G) + cvt_idle((((l <= 1) ? NR : NL) / BM) * (D / BM), G) * CVT_Q; return n < CVT_ITEMS ? n : CVT_ITEMS; }
__device__ __forceinline__ void cvt_moe_tail(const Args& A, const Ctx& C, int l, int nunits, int base, int end) {
    const int rem = nunits % C.G;
    if (rem == 0 || C.bid < rem) return;
    const int first = base + (C.bid - rem) * CVT_Q; const int last = min(first + CVT_Q, end);
    cvt_moe_items(A, C, l, first + C.wave, last, NW);
}

__device__ __forceinline__ void phase_g1(const Args& A, const Ctx& C, int l) {
    const bool mls = (l & 1) == 0; const int j = l >> 1; const int nrows = (l <= 2) ? NR : NL;
    DenseSched S; S.init(A.ws + WS_H8, A.ws + (mls ? WS_WAIN : WS_WBIN) + (size_t)j * PW * D, nrows, PW, D, C.G, C.bid, 1);
    const float wsc = __uint_as_float(((const unsigned*)(A.ws + WS_CTL))[CW_WMAX + ((mls ? 0 : 2) + j) * CNT_STRIDE]) * (1.0f / 127.0f);
    const float* rs = (const float*)(A.ws + WS_RSC);
    if (mls) { S.sw_lo = 4; S.sw_hi = 8; EpiStore E{(bf16*)(A.ws + WS_PB), PW, 0.08838834764831845f, 2 * NQ + NV, (bf16*)(A.ws + WS_VT), wsc, rs}; gemm_phase<EpiStore, DenseSched, false, 2>(C.lds, D, S, E); }
    else { EpiPair<0> E{(bf16*)(A.ws + WS_PB), PW, D, wsc, rs}; gemm_phase<EpiPair<0>, DenseSched, false, 2>(C.lds, D, S, E); }
    cvt_moe_tail(A, C, l, S.nwg, 0, cvt_t1(l, C.G));
}
__device__ __forceinline__ void phase_g2(const Args& A, const Ctx& C, int l) {
    const bool mls = (l & 1) == 0; const int j = l >> 1; const int nrows = (l <= 1) ? NR : NL;
    DenseSched S; S.init(A.ws + WS_HM, A.ws + (mls ? WS_WAOUT : WS_WBOUT) + (size_t)j * D * D, nrows, D, D, C.G, C.bid, 1);
    const float wsc = __uint_as_float(((const unsigned*)(A.ws + WS_CTL))[CW_WMAX + (4 + (mls ? 0 : 2) + j) * CNT_STRIDE]) * (1.0f / 127.0f);
    EpiStore E{(bf16*)(A.ws + WS_HB), D, 1.0f, 1 << 30, nullptr, mls ? wsc * (HMR / 127.0f) : wsc, mls ? nullptr : (const float*)(A.ws + WS_RSC)}; gemm_phase<EpiStore, DenseSched, false, 2>(C.lds, D, S, E);
    cvt_moe_tail(A, C, l, S.nwg, cvt_t1(l, C.G), cvt_t2(l, C.G));
}
__device__ __forceinline__ void phase_m1(const Args& A, const Ctx& C, int l) {
    LAS MoeTab* T = (LAS MoeTab*)(C.lds + LDS_TAB); LAS unsigned* ridx = (LAS unsigned*)(C.lds + LDS_TAB + 1024);
    moe_tables<true>(A, C, l, 4, T, ridx, D);
    MoeSched S; S.T = T; S.ridx = ridx; S.A = (const char*)(A.ws + WS_H8); S.W = (const char*)(A.ws + WS_WGU); S.wstride_e = (size_t)2 * DE * D; S.tstepB = (size_t)BM * D; S.K = D; S.arow_bytes = 0;
    EpiSwigluF8 E{A.ws + WS_DC, DE, 1.0f / WSCALE}; gemm_phase<EpiSwigluF8, MoeSched, true, 1>(C.lds, D, S, E);
}
__device__ __forceinline__ void phase_m2(const Args& A, const Ctx& C, int l) {
    LAS MoeTab* T = (LAS MoeTab*)(C.lds + LDS_TAB); LAS unsigned* ridx = (LAS unsigned*)(C.lds + LDS_TAB + 1024);
    moe_tables<false>(A, C, l, 4, T, ridx, DE);
    MoeSched S; S.T = T; S.ridx = ridx; S.A = (const char*)(A.ws + WS_DC); S.W = (const char*)(A.ws + WS_WDN); S.wstride_e = (size_t)D * DE; S.tstepB = (size_t)BM * DE; S.K = DE; S.arow_bytes = DE;
    EpiStoreTile E{A.ws + WS_PB, D, YSCALE / WSCALE}; gemm_phase<EpiStoreTile, MoeSched, false, 1>(C.lds, DE, S, E);
}

typedef float f32x16 __attribute__((ext_vector_type(16)));
#define MFMA32(a, b, c) __builtin_amdgcn_mfma_f32_32x32x16_bf16((a), (b), (c), 0, 0, 0)
__device__ __forceinline__ bf16x8 pack8(float a0, float a1, float a2, float a3, float a4, float a5, float a6, float a7) {
    u32x4 p; p.x = cvt2(a0, a1); p.y = cvt2(a2, a3); p.z = cvt2(a4, a5); p.w = cvt2(a6, a7); return __builtin_bit_cast(bf16x8, p); }
__device__ __forceinline__ float bflo(unsigned w) { return __uint_as_float(w << 16); }
__device__ __forceinline__ float bfhi(unsigned w) { return __uint_as_float(w & 0xffff0000u); }
__device__ __forceinline__ int vt_tile(int b, int h, int blk) { return (blk == 0 ? 128 + b : b * 64 + blk - 1) * NH + h; }

__device__ __forceinline__ float wave_incl_scan(float v, int lane) {
#pragma unroll
    for (int o = 1; o < 64; o <<= 1) { const float t = __shfl_up(v, o); v += (lane >= o) ? t : 0.f; }
    return v;
}
__device__ __forceinline__ void block_gates(const Args& A, int row0, int h, LAS float* bf, LAS float* bb, LAS float* lif, LAS float* lib, int tid) {
    const float* GATE = (const float*)(A.ws + WS_GATE);
    if (tid < 256) { const float* g = GATE + (size_t)(row0 + tid) * 16; lif[tid] = g[0 + h]; bf[tid] = g[4 + h]; lib[tid] = g[8 + h]; bb[tid] = g[12 + h]; }
    __syncthreads();
    const int lane = tid & 63, wv = tid >> 6;
    if (wv == 0) { f32x4 x = *(LAS f32x4*)(bf + 4 * lane); x.y += x.x; x.z += x.y; x.w += x.z; const float tot = wave_incl_scan(x.w, lane); const float ex = tot - x.w;
        x.x += ex; x.y += ex; x.z += ex; x.w += ex; *(LAS f32x4*)(bf + 4 * lane) = x; }
    if (wv == 1) { f32x4 y = *(LAS f32x4*)(bb + 4 * (63 - lane)); y.z += y.w; y.y += y.z; y.x += y.y; const float tot = wave_incl_scan(y.x, lane); const float ex = tot - y.x;
        y.x += ex; y.y += ex; y.z += ex; y.w += ex; *(LAS f32x4*)(bb + 4 * (63 - lane)) = y; }
    __syncthreads();
}
__device__ __forceinline__ void phase_s1(const Args& A, const Ctx& C, int l) {
    LAS float* bf = (LAS float*)C.lds; LAS float* bb = bf + 256; LAS float* lif = bb + 256; LAS float* lib = lif + 256; LAS float* af = lib + 256; LAS float* ab = af + 256;
    constexpr int KP = 528;
    LAS unsigned char* KTf = C.lds + 8192; LAS unsigned char* KTb = KTf + 128 * KP;
    const bf16* P = (const bf16*)(A.ws + WS_PB); const bf16* VT = (const bf16*)(A.ws + WS_VT);
    float* DC = (float*)(A.ws + WS_DC); float* DN = (float*)(A.ws + WS_DN); float* BT = (float*)(A.ws + WS_BTOT);
    const int r = C.lane & 31, hh = C.lane >> 5, w = C.wave;
    for (int u = C.bid; u < NUNIT; u += C.G) {
        const int blk = u % NBLK, bh = u / NBLK, h = bh % NH, b = bh / NH; const int row0 = blk_row0(b, blk);
        block_gates(A, row0, h, bf, bb, lif, lib, C.tid);
        if (C.tid < 256) { af[C.tid] = __expf(bf[255] - bf[C.tid] + lif[C.tid]); ab[C.tid] = __expf(bb[0] - bb[C.tid] + lib[C.tid]); }
        if (C.tid == 0) { BT[u * 2 + 0] = bf[255]; BT[u * 2 + 1] = bb[0]; }
        __syncthreads();
        { const int sp = C.tid >> 2, dq = C.tid & 3, s0 = 2 * sp;
          const bf16* k0 = P + (size_t)(row0 + s0) * PW + NQ + h * DQK + 32 * dq;
          const float f0 = af[s0], f1 = af[s0 + 1], g0 = ab[s0], g1 = ab[s0 + 1];
#pragma unroll
          for (int c = 0; c < 4; ++c) { const u32x4 x0 = *(const u32x4*)(k0 + 8 * c), x1 = *(const u32x4*)(k0 + PW + 8 * c);
#pragma unroll
              for (int q = 0; q < 4; ++q) { const int d = 32 * dq + 8 * c + 2 * q;
                  const float a0 = bflo(x0[q]), a1 = bfhi(x0[q]), c0 = bflo(x1[q]), c1 = bfhi(x1[q]);
                  *(LAS unsigned*)(KTf + d * KP + s0 * 2) = cvt2(a0 * f0, c0 * f1); *(LAS unsigned*)(KTf + (d + 1) * KP + s0 * 2) = cvt2(a1 * f0, c1 * f1);
                  *(LAS unsigned*)(KTb + d * KP + s0 * 2) = cvt2(a0 * g0, c0 * g1); *(LAS unsigned*)(KTb + (d + 1) * KP + s0 * 2) = cvt2(a1 * g0, c1 * g1); } } }
        __syncthreads();
        if (C.tid < 256) { const int dir = C.tid >> 7, d = C.tid & 127; LAS const unsigned* kr = (LAS const unsigned*)((dir ? KTb : KTf) + d * KP); float s = 0.f;
            for (int i = 0; i < 128; ++i) { const unsigned x = kr[i]; s += bflo(x) + bfhi(x); }
            DN[(size_t)(u * 2 + dir) * DQK + d] = s; }
        const bf16* vt = VT + (size_t)vt_tile(b, h, blk) * 65536 + (size_t)(32 * w + r) * 256 + 8 * hh;
        f32x16 accf[4], accb[4];
#pragma unroll
        for (int dt = 0; dt < 4; ++dt)
#pragma unroll
            for (int i = 0; i < 16; ++i) { accf[dt][i] = 0.f; accb[dt][i] = 0.f; }
#pragma unroll 2
        for (int ks = 0; ks < 16; ++ks) { const bf16x8 a = *(const bf16x8*)(vt + 16 * ks);
#pragma unroll
            for (int dt = 0; dt < 4; ++dt) { const int off = (dt * 32 + r) * KP + (16 * ks + 8 * hh) * 2;
                const bf16x8 b0 = *(const LAS bf16x8*)(KTf + off), b1 = *(const LAS bf16x8*)(KTb + off);
                accf[dt] = MFMA32(a, b0, accf[dt]); accb[dt] = MFMA32(a, b1, accb[dt]); } }
        float* dcf = DC + (size_t)(u * 2 + 0) * DQK * DV + (size_t)(32 * w + 4 * hh) * DQK + r; float* dcb = dcf + DQK * DV;
#pragma unroll
        for (int g = 0; g < 4; ++g) { float* pf = dcf + g * 8 * DQK; float* pb = dcb + g * 8 * DQK; asm volatile("" : "+v"(pf), "+v"(pb));
#pragma unroll
            for (int q = 0; q < 4; ++q)
#pragma unroll
                for (int dt = 0; dt < 4; ++dt) { pf[q * DQK + dt * 32] = accf[dt][4 * g + q]; pb[q * DQK + dt * 32] = accb[dt][4 * g + q]; } }
        __syncthreads();
    }
}
__device__ __forceinline__ void phase_s2(const Args& A, const Ctx& C) {
    const float* __restrict__ DC = (const float*)(A.ws + WS_DC); const float* __restrict__ DN = (const float*)(A.ws + WS_DN); const float* __restrict__ BT = (const float*)(A.ws + WS_BTOT);
    bf16* __restrict__ CST = (bf16*)(A.ws + WS_CST); float* __restrict__ NST = (float*)(A.ws + WS_NST);
    constexpr int EL4 = DQK * DV / 4;
    for (int g = C.bid * NT + C.tid; g < BATCH * NH * 2 * EL4; g += C.G * NT) {
        const int e4 = (g % EL4) * 4, ch = g / EL4, dir = ch & 1, bh = ch >> 1;
        f32x4 st = (f32x4){0.f, 0.f, 0.f, 0.f};
#pragma unroll 13
        for (int idx = 0; idx < NBLK; ++idx) {
            const int blk = dir == 0 ? idx : (idx == 0 ? 0 : NBLK - idx); const int u = bh * NBLK + blk;
            const float dec = __expf(BT[u * 2 + dir]);
            const f32x4 dc = *(const f32x4*)(DC + (size_t)(u * 2 + dir) * DQK * DV + e4);
            u32x2 o; o.x = cvt2(st.x, st.y); o.y = cvt2(st.z, st.w);
            *(u32x2*)(CST + (size_t)(u * 2 + dir) * DQK * DV + e4) = o;
            st = st * dec + dc;
        }
    }
    for (int g = C.bid * NT + C.tid; g < BATCH * NH * 2 * DQK; g += C.G * NT) {
        const int d = g % DQK, ch = g / DQK, dir = ch & 1, bh = ch >> 1; float st = 0.f;
        for (int idx = 0; idx < NBLK; ++idx) {
            const int blk = dir == 0 ? idx : (idx == 0 ? 0 : NBLK - idx); const int u = bh * NBLK + blk;
            NST[(size_t)(u * 2 + dir) * DQK + d] = st; st = __expf(BT[u * 2 + dir]) * st + DN[(size_t)(u * 2 + dir) * DQK + d];
        }
    }
}
__device__ __forceinline__ void lds_barrier() { asm volatile("s_waitcnt lgkmcnt(0)" ::: "memory"); __builtin_amdgcn_s_barrier(); asm volatile("" ::: "memory"); }
__device__ __forceinline__ void phase_s3(const Args& A, const Ctx& C, int l) {
    const int jl = l >> 1; const bool ctx_out = (l == 0);
    LAS float* bf = (LAS float*)C.lds; LAS float* bb = bf + 256; LAS float* gf = bb + 256; LAS float* gb = gf + 256;
    LAS float* nf = gb + 256; LAS float* nb = nf + 128; LAS float* ssx = nb + 128;
    LAS float* cf = ssx + 256; LAS float* cb = cf + 256;
    constexpr int KP = 272, OP = 528, CHB = 16384, NCHB = 4;
    LAS unsigned char* Kimg = C.lds + 8192;
    LAS unsigned char* CH = Kimg + 256 * KP;
    static_assert(8192 + 256 * KP + 128 * OP <= LDS_TAB_END && NCHB * CHB <= 128 * OP, "S3 LDS map");
    const bf16* P = (const bf16*)(A.ws + WS_PB); const bf16* VT = (const bf16*)(A.ws + WS_VT); unsigned char* HM = A.ws + WS_HM;
    const bf16* CST = (const bf16*)(A.ws + WS_CST); const float* NST = (const float*)(A.ws + WS_NST);
    const float* hg = A.in[10] + (size_t)jl * NV;
    const int w = C.wave, eh = w >> 2;
    for (int u = C.bid; u < NUNIT; u += C.G) {
        const int blk = u % NBLK, bh = u / NBLK, h = bh % NH, b = bh / NH; const int row0 = blk_row0(b, blk);
        if (blk == 0 && !ctx_out) continue;
        bf16x8 qf[8];
#define S3_LOAD_Q(ps_) do { int lq = threadIdx.x & 63; asm volatile("" : "+v"(lq)); const bf16* qr = P + (size_t)(row0 + 32 * (2 * (w & 3) + (ps_)) + (lq & 31)) * PW + h * DQK + 8 * (lq >> 5); \
            _Pragma("unroll") for (int kk = 0; kk < 8; ++kk) qf[kk] = *(const bf16x8*)(qr + 16 * kk); } while (0)
        S3_LOAD_Q(0);
        int tu = threadIdx.x; asm volatile("" : "+v"(tu));
        block_gates(A, row0, h, bf, bb, gf, gb, tu);
        if (tu < 256) { gf[tu] -= bf[tu]; gb[tu] -= bb[tu]; cf[tu] = __expf(bf[tu | 31] + gf[tu]); cb[tu] = __expf(bb[tu & ~31] + gb[tu]); }
        else { const int t2 = tu - 256; nf[t2] = NST[(size_t)(u * 2 + (t2 >> 7)) * DQK + (t2 & 127)]; }
        { const int pc = tu & 15, s0 = tu >> 4; const bf16* kr = P + (size_t)(row0 + s0) * PW + NQ + h * DQK + 8 * pc;
#pragma unroll
          for (int i = 0; i < 8; ++i) *(LAS u32x4*)(Kimg + (s0 + 32 * i) * KP + pc * 16) = *(const u32x4*)(kr + (size_t)(32 * i) * PW); }
        __syncthreads();
        const bf16* vtile = VT + (size_t)vt_tile(b, h, blk) * 65536;
        const bf16* ctile = CST + (size_t)(u * 2) * DQK * DV;
#pragma unroll 1
        for (int ps = 0; ps < 2; ++ps) {
            int lz = threadIdx.x & 63; asm volatile("" : "+v"(lz));
            const int r = lz & 31, hh = lz >> 5;
            const int jt = 2 * (w & 3) + ps; const int jrow = row0 + 32 * jt + r;
            const float bfj = bf[32 * jt + r], bbj = bb[32 * jt + r];
            float qnf = 0.f, qnb = 0.f;
#pragma unroll
            for (int kk = 0; kk < 8; ++kk) { const u32x4 qq = __builtin_bit_cast(u32x4, qf[kk]); const int d = 16 * kk + 8 * hh;
                const f32x4 n0 = *(const LAS f32x4*)(nf + d), n1 = *(const LAS f32x4*)(nf + d + 4), m0 = *(const LAS f32x4*)(nb + d), m1 = *(const LAS f32x4*)(nb + d + 4);
                qnf += (bflo(qq.x) * n0.x + bfhi(qq.x) * n0.y) + (bflo(qq.y) * n0.z + bfhi(qq.y) * n0.w) + (bflo(qq.z) * n1.x + bfhi(qq.z) * n1.y) + (bflo(qq.w) * n1.z + bfhi(qq.w) * n1.w);
                qnb += (bflo(qq.x) * m0.x + bfhi(qq.x) * m0.y) + (bflo(qq.y) * m0.z + bfhi(qq.y) * m0.w) + (bflo(qq.z) * m1.x + bfhi(qq.z) * m1.y) + (bflo(qq.w) * m1.z + bfhi(qq.w) * m1.w);
                if (kk & 1) asm volatile("" ::: "memory"); }
            qnf += __shfl_xor(qnf, 32); qnb += __shfl_xor(qnb, 32);
            float denf = 0.f, denb = 0.f;
#pragma unroll 1
            for (int kt = 0; kt < 8; ++kt) {
                f32x16 c;
#pragma unroll
                for (int i = 0; i < 16; ++i) c[i] = 0.f;
#pragma unroll
                for (int kk = 0; kk < 8; ++kk) { const bf16x8 a = *(const LAS bf16x8*)(Kimg + (kt * 32 + r) * KP + (16 * kk + 8 * hh) * 2); c = MFMA32(a, qf[kk], c); }
                if (kt == jt) {
#pragma unroll
                    for (int g = 0; g < 4; ++g) { const int sl0 = 8 * g + 4 * hh;
                        const f32x4 g4f = *(const LAS f32x4*)(gf + kt * 32 + sl0), g4b = *(const LAS f32x4*)(gb + kt * 32 + sl0);
#pragma unroll
                        for (int q = 0; q < 4; ++q) { const int sl = sl0 + q; const float cv = c[4 * g + q];
                            denf += cv * __expf((sl <= r) ? bfj + g4f[q] : -1.0e30f); denb += cv * __expf((sl >= r) ? bbj + g4b[q] : -1.0e30f); } }
                } else {
                    LAS const float* cx = (kt < jt ? cf : cb) + kt * 32 + 4 * hh; float sm = 0.f;
#pragma unroll
                    for (int g = 0; g < 4; ++g) { const f32x4 c4 = *(const LAS f32x4*)(cx + 8 * g); sm += (c[4 * g] * c4.x + c[4 * g + 1] * c4.y) + (c[4 * g + 2] * c4.z + c[4 * g + 3] * c4.w); }
                    if (kt < jt) denf += sm * __expf(bfj - bf[kt * 32 + 31]); else denb += sm * __expf(bbj - bb[kt * 32]);
                }
            }
            denf += __shfl_xor(denf, 32); denb += __shfl_xor(denb, 32);
            const float ebf = __expf(bfj), ebb = __expf(bbj);
            denf += ebf * qnf; denb += ebb * qnb;
            const float rf = 1.0f / fmaxf(fabsf(denf), 1.0f), rb = 1.0f / fmaxf(fabsf(denb), 1.0f);
            const float scf = ebf * rf, scb = ebb * rb;
            f32x16 acc[4];
#pragma unroll
            for (int et = 0; et < 4; ++et)
#pragma unroll
                for (int i = 0; i < 16; ++i) acc[et][i] = 0.f;
            const unsigned ringb = (unsigned)(size_t)CH + (unsigned)w * 2048u;
            const unsigned dlp = (unsigned)(((lz & 3) ^ ((lz >> 4) & 3)) * 16), drow = (unsigned)(32 * w + (lz >> 2));
#define S3_DMA(c_) do { const int cc_ = (c_); const bool isv_ = cc_ < 8; \
                const unsigned long long gp_ = (unsigned long long)(isv_ ? (const char*)vtile + 64 * cc_ : (const char*)ctile + (cc_ >= 12 ? 2 * DQK * DV : 0) + 64 * ((cc_ - 8) & 3)); \
                const char* gb_ = (const char*)(((unsigned long long)(unsigned)__builtin_amdgcn_readfirstlane((int)(unsigned)(gp_ >> 32)) << 32) | (unsigned)__builtin_amdgcn_readfirstlane((int)(unsigned)gp_)); \
                _Pragma("unroll") for (int jj = 0; jj < 2; ++jj) \
                    asm volatile("s_mov_b32 m0, %2\n\ts_nop 0\n\tglobal_load_lds_dwordx4 %0, %1" :: "v"(((drow + 16u * jj) << (isv_ ? 9 : 8)) + dlp), "s"(gb_), "s"(ringb + (unsigned)((cc_ & 3) * CHB + jj * 1024)) : "memory"); } while (0)
            asm volatile("s_waitcnt vmcnt(0)" ::: "memory");
            lds_barrier();
            S3_DMA(0); S3_DMA(1); S3_DMA(2);
            const int swz = (r >> 2) & 3;
#pragma unroll 1
            for (int ci = 0; ci < 8; ++ci) {
                asm volatile("s_waitcnt vmcnt(4)" ::: "memory");
                lds_barrier();
                S3_DMA(ci + 3);
                LAS const unsigned char* CHc = CH + (ci & 3) * CHB;
                { const int kt = ci;
                        f32x16 c;
#pragma unroll
                        for (int i = 0; i < 16; ++i) c[i] = 0.f;
#pragma unroll
                        for (int kk = 0; kk < 8; ++kk) { const bf16x8 a = *(const LAS bf16x8*)(Kimg + (kt * 32 + r) * KP + (16 * kk + 8 * hh) * 2); c = MFMA32(a, qf[kk], c); }
                        float p[16]; const float bfj2 = bf[32 * jt + r], bbj2 = bb[32 * jt + r];
                        if (kt == jt) {
#pragma unroll
                            for (int g = 0; g < 4; ++g) { const int sl0 = 8 * g + 4 * hh;
                                const f32x4 g4f = *(const LAS f32x4*)(gf + kt * 32 + sl0), g4b = *(const LAS f32x4*)(gb + kt * 32 + sl0);
#pragma unroll
                                for (int q = 0; q < 4; ++q) { const int sl = sl0 + q;
                                    const float wt = rf * __expf((sl <= r) ? bfj2 + g4f[q] : -1.0e30f) + rb * __expf((sl >= r) ? bbj2 + g4b[q] : -1.0e30f);
                                    p[4 * g + q] = c[4 * g + q] * wt; } }
                        } else {
                            LAS const float* cx = (kt < jt ? cf : cb) + kt * 32 + 4 * hh;
                            const float rw = (kt < jt) ? rf * __expf(bfj2 - bf[kt * 32 + 31]) : rb * __expf(bbj2 - bb[kt * 32]);
#pragma unroll
                            for (int g = 0; g < 4; ++g) { const f32x4 c4 = *(const LAS f32x4*)(cx + 8 * g);
                                p[4 * g] = c[4 * g] * (c4.x * rw); p[4 * g + 1] = c[4 * g + 1] * (c4.y * rw); p[4 * g + 2] = c[4 * g + 2] * (c4.z * rw); p[4 * g + 3] = c[4 * g + 3] * (c4.w * rw); }
                        }
                        const bf16x8 pa0 = pack8(p[0], p[1], p[2], p[3], p[4], p[5], p[6], p[7]), pa1 = pack8(p[8], p[9], p[10], p[11], p[12], p[13], p[14], p[15]);
#pragma unroll
                        for (int et = 0; et < 4; ++et) { LAS const unsigned char* vb = CHc + ((4 * eh + et) * 32 + r) * 64 + 8 * hh;
                            const u32x2 l0 = *(LAS const u32x2*)(vb + ((0 ^ swz) << 4)), h0 = *(LAS const u32x2*)(vb + ((1 ^ swz) << 4)), l1 = *(LAS const u32x2*)(vb + ((2 ^ swz) << 4)), h1 = *(LAS const u32x2*)(vb + ((3 ^ swz) << 4));
                            const bf16x8 a0 = __builtin_bit_cast(bf16x8, (u32x4){l0.x, l0.y, h0.x, h0.y}), a1 = __builtin_bit_cast(bf16x8, (u32x4){l1.x, l1.y, h1.x, h1.y});
                            acc[et] = MFMA32(a0, pa0, acc[et]); acc[et] = MFMA32(a1, pa1, acc[et]); }
                }
            }
#pragma unroll
            for (int ci = 8; ci < 16; ++ci) {
                if (ci <= 13) asm volatile("s_waitcnt vmcnt(4)" ::: "memory"); else if (ci == 14) asm volatile("s_waitcnt vmcnt(2)" ::: "memory"); else asm volatile("s_waitcnt vmcnt(0)" ::: "memory");
                lds_barrier();
                if (ci + 3 < 16) S3_DMA(ci + 3);
                LAS const unsigned char* CHc = CH + (ci & 3) * CHB;
                {
                    const int dir = (ci - 8) >> 2, dq = (ci - 8) & 3;
                    const float sc = dir ? scb : scf;
#pragma unroll
                    for (int k2 = 0; k2 < 2; ++k2) { const u32x4 qq = __builtin_bit_cast(u32x4, qf[2 * dq + k2]);
                        const bf16x8 qs = pack8(bflo(qq.x) * sc, bfhi(qq.x) * sc, bflo(qq.y) * sc, bfhi(qq.y) * sc, bflo(qq.z) * sc, bfhi(qq.z) * sc, bflo(qq.w) * sc, bfhi(qq.w) * sc);
#pragma unroll
                        for (int et = 0; et < 4; ++et) { const bf16x8 a = *(const LAS bf16x8*)(CHc + ((4 * eh + et) * 32 + r) * 64 + (((2 * k2 + hh) ^ swz) << 4)); acc[et] = MFMA32(a, qs, acc[et]); } }
                }
            }
#undef S3_DMA
            if (ps == 0) S3_LOAD_Q(1);
            u32x4 ov[8]; f32x4 g0, g1;
            { int tz = threadIdx.x; asm volatile("" : "+v"(tz)); const int pc = tz & 31, lr0 = tz >> 5;
              g0 = *(const f32x4*)(hg + h * DV + 8 * pc); g1 = *(const f32x4*)(hg + h * DV + 8 * pc + 4);
#pragma unroll
              for (int i = 0; i < 8; ++i) { const int lr = lr0 + 16 * i; const int grow = row0 + 64 * (lr >> 5) + 32 * ps + (lr & 31); ov[i] = *(const u32x4*)(P + (size_t)grow * PW + 2 * NQ + NV + h * DV + 8 * pc); } }
            float ss = 0.f;
#pragma unroll
            for (int et = 0; et < 4; ++et)
#pragma unroll
                for (int i = 0; i < 16; ++i) ss += acc[et][i] * acc[et][i];
            ss += __shfl_xor(ss, 32);
            if (hh == 0) ssx[w * 32 + r] = ss;
            lds_barrier();
            ss += ssx[(w ^ 4) * 32 + r];
            const float rs = 1.0f / sqrtf(ss * (1.0f / DV) + EPS);
            { LAS unsigned char* ob = CH + ((w & 3) * 32 + r) * OP + (eh * 128 + 4 * hh) * 2;
#pragma unroll
              for (int et = 0; et < 4; ++et)
#pragma unroll
                  for (int g = 0; g < 4; ++g) { u32x2 o; o.x = cvt2(acc[et][4 * g + 0] * rs, acc[et][4 * g + 1] * rs); o.y = cvt2(acc[et][4 * g + 2] * rs, acc[et][4 * g + 3] * rs);
                      *(LAS u32x2*)(ob + (et * 32 + 8 * g) * 2) = o; } }
            lds_barrier();
            { int tz = threadIdx.x; asm volatile("" : "+v"(tz)); const int pc = tz & 31, lr0 = tz >> 5;
#pragma unroll
              for (int i = 0; i < 8; ++i) { const int lr = lr0 + 16 * i; const int grow = row0 + 64 * (lr >> 5) + 32 * ps + (lr & 31);
                  const u32x4 hv = *(const LAS u32x4*)(CH + lr * OP + pc * 16);
                  const f32x4 o0 = (f32x4){bflo(hv.x) * g0.x * bflo(ov[i].x), bfhi(hv.x) * g0.y * bfhi(ov[i].x), bflo(hv.y) * g0.z * bflo(ov[i].y), bfhi(hv.y) * g0.w * bfhi(ov[i].y)};
                  const f32x4 o1 = (f32x4){bflo(hv.z) * g1.x * bflo(ov[i].z), bfhi(hv.z) * g1.y * bfhi(ov[i].z), bflo(hv.w) * g1.z * bflo(ov[i].w), bfhi(hv.w) * g1.w * bfhi(ov[i].w)};
                  *(u32x2*)(HM + (size_t)grow * D + h * DV + 8 * pc) = (u32x2){pack_i8(o0 * (127.0f / HMR)), pack_i8(o1 * (127.0f / HMR))}; } }
        }
        __syncthreads();
    }
#undef S3_LOAD_Q
}

#define XB_TMO      128
#define XB_XCNT(j)  (256  + 64 * (j))
#define XB_XSUB(j)  (1280 + 64 * (j))
#define XB_XGEN(j)  (2304 + 64 * (j))
#define XB_TOP      3328
#define XB_TOPGEN   3392
#define XCD_BAR_WORDS 3456
#define XB_SPIN_CAP (1u << 18)

__device__ __forceinline__ unsigned xb_ld(unsigned* p)              { return __hip_atomic_load(p, __ATOMIC_RELAXED, __HIP_MEMORY_SCOPE_AGENT); }
__device__ __forceinline__ unsigned xb_add(unsigned* p, unsigned v) { return __hip_atomic_fetch_add(p, v, __ATOMIC_RELAXED, __HIP_MEMORY_SCOPE_AGENT); }
__device__ __forceinline__ unsigned xb_xcc_id() { return (unsigned)__builtin_amdgcn_s_getreg((3 << 11) | 20) & 0xFu; }
#define XB_SPIN(cond, bar) do { unsigned _sp = 0; while (cond) { __builtin_amdgcn_s_sleep(1); \
    if ((++_sp & 255u) == 0u) { if (xb_ld(&(bar)[XB_TMO])) break; if (_sp > XB_SPIN_CAP) { atomicAdd(&(bar)[XB_TMO], 1u); break; } } } } while (0)

struct XcdBarrier {
    unsigned* bar; unsigned x;
    volatile LAS unsigned* st;
};

__device__ __forceinline__ XcdBarrier xcd_barrier_post(unsigned* bar, volatile LAS unsigned* st) {
    XcdBarrier b; b.bar = bar; b.x = xb_xcc_id(); b.st = st;
    if (threadIdx.x == 0) (void)xb_add(&bar[XB_XCNT(b.x)], 1u);
    return b;
}
__device__ __forceinline__ void xcd_barrier_complete(unsigned* bar, unsigned x, unsigned& nloc, unsigned& nx) {
    const unsigned G = gridDim.x * gridDim.y * gridDim.z;
    unsigned sum, cnt, mine, sp = 0u;
    for (;;) {
        sum = 0u; cnt = 0u; mine = 0u;
#pragma unroll
        for (unsigned j = 0; j < 16; ++j) { const unsigned c = xb_ld(&bar[XB_XCNT(j)]); sum += c; cnt += (c > 0u) ? 1u : 0u; mine = (j == x) ? c : mine; }
        if (sum == G) break;
        __builtin_amdgcn_s_sleep(1);
        if ((++sp & 255u) == 0u) { if (xb_ld(&bar[XB_TMO])) break; if (sp > XB_SPIN_CAP) { atomicAdd(&bar[XB_TMO], 1u); break; } }
    }
    nloc = mine > 0u ? mine : 1u; nx = cnt > 0u ? cnt : 1u;
}

__device__ __forceinline__ void xcd_barrier(const XcdBarrier& b) {
    asm volatile("s_waitcnt vmcnt(0)" ::: "memory");
    __syncthreads();
    if (threadIdx.x == 0) {
        unsigned* bar = b.bar;
        __builtin_amdgcn_s_waitcnt(0);
        unsigned nloc = b.st[0], nx = b.st[1];
        if (nloc == 0u) { xcd_barrier_complete(bar, b.x, nloc, nx); b.st[0] = nloc; b.st[1] = nx; }
        const unsigned old = xb_add(&bar[XB_XSUB(b.x)], 1u);
        const unsigned gen = old / nloc;
        if (old + 1u == (gen + 1u) * nloc) {
            __builtin_amdgcn_fence(__ATOMIC_RELEASE, "agent");
            asm volatile("s_waitcnt vmcnt(0)" ::: "memory");
            const unsigned og = xb_add(&bar[XB_TOP], 1u);
            const unsigned tg = og / nx;
            if (og + 1u == (tg + 1u) * nx) xb_add(&bar[XB_TOPGEN], 1u);
            else XB_SPIN(xb_ld(&bar[XB_TOPGEN]) == tg, bar);
            __builtin_amdgcn_fence(__ATOMIC_ACQUIRE, "agent");
            xb_add(&bar[XB_XGEN(b.x)], 1u);
            asm volatile("s_waitcnt vmcnt(0)" ::: "memory");
        } else {
            XB_SPIN(xb_ld(&bar[XB_XGEN(b.x)]) == gen, bar);
            __builtin_amdgcn_fence(__ATOMIC_ACQUIRE, "agent");
            asm volatile("s_waitcnt vmcnt(0)" ::: "memory");
        }
    }
    __syncthreads();
}


constexpr int LDS_BYTES = 152 * 1024;
constexpr int CW_BAR = 16384;
static_assert((CW_BAR + XCD_BAR_WORDS) * 4 <= (int)CTL_BYTES, "ctl");
#ifndef MK_MULTI
#define MK_MULTI 0
#endif
#define IN(p) (lo <= (p) && (p) < hi)
#define SEAM(p) do { if ((p) + 1 < hi) { XcdBarrier b_; b_.bar = (unsigned*)(load_args().ws + WS_CTL) + CW_BAR; b_.x = xb_xcc_id(); b_.st = (volatile LAS unsigned*)(C.lds + LDS_BYTES - 16); xcd_barrier(b_); } } while (0)
#define CAS __attribute__((address_space(4)))
__device__ __forceinline__ Args load_args() {
#if defined(__HIP_DEVICE_COMPILE__)
    const CAS Args* p = (const CAS Args*)__builtin_amdgcn_kernarg_segment_ptr(); asm volatile("" : "+s"(p));
    Args a; for (int i = 0; i < 22; ++i) a.in[i] = p->in[i]; a.out = p->out; a.ws = p->ws; a.lo = p->lo; a.hi = p->hi; return a;
#else
    return Args{};
#endif
}
__device__ __forceinline__ Ctx fresh(const Ctx& C) { Ctx R = C; int tz = threadIdx.x; asm volatile("" : "+v"(tz)); R.tid = tz; R.lane = tz & 63; return R; }
template <int L> __device__ __forceinline__ void layer_phases(const Args& args, const Ctx& C, int bar, int lo, int hi) {
    constexpr int pb = 16 * L;
    if (IN(pb + 1)) { phase_r1(load_args(), fresh(C), L); SEAM(pb + 1); }
    if (IN(pb + 2)) { phase_g1(load_args(), fresh(C), L); SEAM(pb + 2); }
    if constexpr ((L & 1) == 0) {
        if (IN(pb + 3)) { phase_s1(load_args(), fresh(C), L); SEAM(pb + 3); }
        if (IN(pb + 4)) { phase_s2(load_args(), fresh(C)); SEAM(pb + 4); }
        if (IN(pb + 5)) { phase_s3(load_args(), fresh(C), L); SEAM(pb + 5); }
    } else {
        if (IN(pb + 3)) { phase_conv(load_args(), fresh(C), L); SEAM(pb + 3); }
    }
    if (IN(pb + 6)) { phase_g2(load_args(), fresh(C), L); SEAM(pb + 6); }
    if (IN(pb + 7)) { phase_r2(load_args(), fresh(C), L); SEAM(pb + 7); }
    if (IN(pb + 8)) { phase_m1(load_args(), fresh(C), L); SEAM(pb + 8); }
    if (IN(pb + 9)) { phase_m2(load_args(), fresh(C), L); SEAM(pb + 9); }
}
__global__ void __launch_bounds__(NT, 2) fwd_kernel(Args args) {
    extern __shared__ __attribute__((aligned(16))) unsigned char lds_raw[];
    Ctx C; C.lds = (LAS unsigned char*)lds_raw; C.tid = threadIdx.x; C.lane = C.tid & 63; C.wave = __builtin_amdgcn_readfirstlane(C.tid >> 6); C.G = gridDim.x; C.bid = blockIdx.x; C.a = &args;
    const int lo = args.lo, hi = args.hi;
    volatile LAS unsigned* xbw = (volatile LAS unsigned*)(C.lds + LDS_BYTES - 16);
    if (C.tid < 4) xbw[C.tid] = 0u;
    __syncthreads();
    if (hi - lo > 1) (void)xcd_barrier_post((unsigned*)(args.ws + WS_CTL) + CW_BAR, xbw);
    const int bar = 0; (void)bar;
    if (IN(0)) { phase_mod(load_args(), fresh(C)); __syncthreads(); phase_cvt_mixer(load_args(), fresh(C)); SEAM(0); }
    layer_phases<0>(args, C, bar, lo, hi);
    layer_phases<1>(args, C, bar, lo, hi);
    layer_phases<2>(args, C, bar, lo, hi);
    layer_phases<3>(args, C, bar, lo, hi);
    if (IN(64)) phase_final(load_args(), fresh(C));
}
#undef IN
#undef SEAM

extern "C" void kernel_launch(void* const* d_in, const int* in_sizes, int n_in, void* d_out, int out_size, void* d_ws, size_t ws_size, hipStream_t stream) {
    static int grid = 0;
    if (grid == 0) {
        if (n_in != 22 || out_size != NL * D || ws_size < WS_END) { fprintf(stderr, "kernel_launch: unexpected shapes (n_in %d out %d ws %zu)\n", n_in, out_size, ws_size); grid = -1; return; }
        int dev = 0, cus = 0, per_cu = 0;
        if (hipGetDevice(&dev) != hipSuccess || hipDeviceGetAttribute(&cus, hipDeviceAttributeMultiprocessorCount, dev) != hipSuccess) { grid = -1; return; }
        if (hipFuncSetAttribute((const void*)fwd_kernel, hipFuncAttributeMaxDynamicSharedMemorySize, LDS_BYTES) != hipSuccess) { grid = -1; return; }
        if (hipOccupancyMaxActiveBlocksPerMultiprocessor(&per_cu, (const void*)fwd_kernel, NT, LDS_BYTES) != hipSuccess || per_cu < 1) { fprintf(stderr, "kernel_launch: occupancy query says %d\n", per_cu); }
        (void)hipGetLastError();
        grid = cus;
    }
    if (grid < 0) return;
    (void)hipMemsetAsync((char*)d_ws + WS_CTL, 0, CTL_BYTES, stream);
    Args a{};
    for (int i = 0; i < 22; ++i) a.in[i] = (const float*)d_in[i];
    a.out = (float*)d_out; a.ws = (unsigned char*)d_ws;
#if MK_MULTI
    int phases[64]; int np = 0;
    phases[np++] = 0;
    for (int l = 0; l < DEPTH; ++l) { const int pb = 16 * l; phases[np++] = pb + 1; phases[np++] = pb + 2; phases[np++] = pb + 3;
        if ((l & 1) == 0) { phases[np++] = pb + 4; phases[np++] = pb + 5; }
        phases[np++] = pb + 6; phases[np++] = pb + 7; phases[np++] = pb + 8; phases[np++] = pb + 9; }
    phases[np++] = 64;
    for (int i = 0; i < np; ++i) { a.lo = phases[i]; a.hi = phases[i] + 1; hipLaunchKernelGGL(fwd_kernel, dim3(grid), dim3(NT), LDS_BYTES, stream, a); }
#else
    a.lo = 0; a.hi = 65;
    hipLaunchKernelGGL(fwd_kernel, dim3(grid), dim3(NT), LDS_BYTES, stream, a);
#ifdef PROBE_PHASES
    { const int pp[] = {PROBE_PHASES};
      for (int rep = 0; rep < PROBE_REPS; ++rep) for (unsigned i = 0; i < sizeof(pp) / sizeof(pp[0]); ++i) { a.lo = pp[i]; a.hi = pp[i] + 1; hipLaunchKernelGGL(fwd_kernel, dim3(grid), dim3(NT), LDS_BYTES, stream, a); } }
#endif
#endif
}
```

```cpp
#include <hip/hip_runtime.h>
#include <cstdio>
#include <cstdint>

#define LAS __attribute__((address_space(3)))
typedef unsigned short bf16;
typedef float f32x4 __attribute__((ext_vector_type(4)));
typedef unsigned u32x4 __attribute__((ext_vector_type(4)));
typedef unsigned u32x2 __attribute__((ext_vector_type(2)));
typedef int i32x4r __attribute__((ext_vector_type(4)));

constexpr int D = 1024, BATCH = 2, SEQ = 16384, DEPTH = 4, CTXL = 256;
constexpr int NL = BATCH * SEQ, NCX = BATCH * CTXL, NR = NL + NCX;
constexpr int NH = 4, DQK = 128, DV = 256, NQ = 512, NV = 1024, PROJ = 3088, PW = 3072;
constexpr int NGRP = 4, EPG = 8, NE = 32, DE = 512;
constexpr int NBLK = 65;
constexpr int NUNIT = BATCH * NH * NBLK;
constexpr int CAP = NR;
constexpr int YROWS = 74752;
constexpr float EPS = 1e-6f;
constexpr float WSCALE = 32.0f;
constexpr float YSCALE = 4.0f;
constexpr int NT = 512, NW = 8;
constexpr int LDS_TAB_END = 152 * 1024 - 16;

constexpr size_t MiB = 1u << 20;
constexpr size_t WS_CTL = 0, CTL_BYTES = 1 * MiB;
constexpr size_t WS_MOD = 1 * MiB;
constexpr size_t WS_GATE = 2 * MiB;
constexpr size_t WS_TOKSLOT = 5 * MiB;
constexpr size_t WS_TOKW = 6 * MiB;
constexpr size_t WS_SLOTTOK = 7 * MiB;
constexpr size_t WS_DN = 12 * MiB;
constexpr size_t WS_NST = 13 * MiB;
constexpr size_t WS_BTOT = 14 * MiB;
constexpr size_t WS_RSC = 15 * MiB;
constexpr size_t WS_LAT = 16 * MiB;
constexpr size_t WS_HB = 146 * MiB;
constexpr size_t WS_PB = 211 * MiB;
constexpr size_t WS_HM = 406 * MiB;
constexpr size_t WS_DC = 471 * MiB;
constexpr size_t WS_CST = 601 * MiB;
constexpr size_t WS_VT = 666 * MiB;
constexpr size_t WS_WAIN = 731 * MiB;
constexpr size_t WS_WBIN = 743 * MiB;
constexpr size_t WS_WAOUT = 755 * MiB;
constexpr size_t WS_WBOUT = 759 * MiB;
constexpr size_t WS_WGU = 763 * MiB;
constexpr size_t WS_WDN = 827 * MiB;
constexpr size_t WS_H8 = 843 * MiB;
constexpr size_t WS_END = 880 * MiB;
constexpr int CW_WMAX = 256;
constexpr int CW_CNT = 1024, CNT_STRIDE = 64;

struct Args { const float* in[22]; float* out; unsigned char* ws; int lo, hi; };

typedef short bf16x8 __attribute__((ext_vector_type(8)));
typedef float f32x2 __attribute__((ext_vector_type(2)));
typedef __bf16 bf16x2_t __attribute__((ext_vector_type(2)));
__device__ __forceinline__ unsigned cvt2(float lo, float hi) { const f32x2 v = {lo, hi}; return __builtin_bit_cast(unsigned, __builtin_convertvector(v, bf16x2_t)); }
__device__ __forceinline__ float bf2f(bf16 v) { return __uint_as_float(((unsigned)v) << 16); }
__device__ __forceinline__ unsigned f2bf(float f) { unsigned u = __float_as_uint(f); return (u + 0x7fffu + ((u >> 16) & 1u)) >> 16; }
__device__ __forceinline__ unsigned pk2(float lo, float hi) { return f2bf(lo) | (f2bf(hi) << 16); }
template <int CTRL, int ROWMASK> __device__ __forceinline__ float dpp_mov(float x) { return __int_as_float(__builtin_amdgcn_update_dpp(0, __float_as_int(x), CTRL, ROWMASK, 0xf, false)); }
__device__ __forceinline__ float wave_sum(float v) {
    v += dpp_mov<0xB1, 0xf>(v); v += dpp_mov<0x4E, 0xf>(v); v += dpp_mov<0x141, 0xf>(v); v += dpp_mov<0x140, 0xf>(v);
    v += dpp_mov<0x142, 0xA>(v); v += dpp_mov<0x143, 0xC>(v);
    return __int_as_float(__builtin_amdgcn_readlane(__float_as_int(v), 63));
}
__device__ __forceinline__ float wave_max_nn(float v) {
    v = fmaxf(v, dpp_mov<0xB1, 0xf>(v)); v = fmaxf(v, dpp_mov<0x4E, 0xf>(v)); v = fmaxf(v, dpp_mov<0x141, 0xf>(v)); v = fmaxf(v, dpp_mov<0x140, 0xf>(v));
    v = fmaxf(v, dpp_mov<0x142, 0xA>(v)); v = fmaxf(v, dpp_mov<0x143, 0xC>(v));
    return __int_as_float(__builtin_amdgcn_readlane(__float_as_int(v), 63));
}
__device__ __forceinline__ unsigned pack_i8(f32x4 v) {
    const int a = (int)__builtin_rintf(fminf(fmaxf(v.x, -127.f), 127.f)), b = (int)__builtin_rintf(fminf(fmaxf(v.y, -127.f), 127.f)), c = (int)__builtin_rintf(fminf(fmaxf(v.z, -127.f), 127.f)), d = (int)__builtin_rintf(fminf(fmaxf(v.w, -127.f), 127.f));
    return (unsigned)(a & 255) | ((unsigned)(b & 255) << 8) | ((unsigned)(c & 255) << 16) | ((unsigned)d << 24);
}
__device__ __forceinline__ float sigmoidf_(float x) { return 1.f / (1.f + __expf(-x)); }
__device__ __forceinline__ float siluf_(float x) { return x / (1.f + __expf(-x)); }
__device__ __forceinline__ float logsigmoidf_(float x) { return fminf(x, 0.f) - log1pf(__expf(-fabsf(x))); }
__device__ __forceinline__ int blk_row0(int b, int blk) { return blk == 0 ? NL + b * CTXL : b * SEQ + (blk - 1) * 256; }
__device__ __forceinline__ int mod_vec_of_row(int row) { return row < NL ? row / SEQ : 2; }

struct Ctx {
    LAS unsigned char* lds; int tid, lane, wave, G, bid;
    const Args* a;
};

__device__ __forceinline__ int expert_block_prefix(const unsigned* cnt, int lane, int& nb) {
    nb = lane < NE ? ((int)cnt[lane * CNT_STRIDE] + 255) / 256 : 0; int v = nb;
#pragma unroll
    for (int o = 1; o < 64; o <<= 1) { const int t = __shfl_up(v, o); v += (lane >= o) ? t : 0; }
    return v - nb;
}
__device__ __forceinline__ void slot_bases(const Args& A, int l, LAS int* sb, int tid) {
    if (tid < 64) { int nb; const int ex = expert_block_prefix((const unsigned*)(A.ws + WS_CTL) + CW_CNT + l * 32 * CNT_STRIDE, tid, nb); if (tid <= NE) sb[tid] = ex * 256; }
    __syncthreads();
}

__device__ __forceinline__ void phase_mod(const Args& A, const Ctx& C) {
    LAS float* sc = (LAS float*)C.lds;
    LAS float* red = sc + 3072;
    const float* c = A.in[1]; const float* cc = A.in[3];
    for (int i = C.tid; i < 3072; i += NT) { const float v = i < 2048 ? c[i] : cc[i - 2048]; sc[i] = siluf_(v); }
    __syncthreads();
    float* MOD = (float*)(A.ws + WS_MOD);
    for (int u = C.bid; u < DEPTH * 96; u += C.G) {
        const int l = u / 96, cg = u % 96, col = cg * 64 + C.lane;
        const float* w = A.in[4] + (size_t)l * D * 6 * D + col;
        float a0 = 0.f, a1 = 0.f, a2 = 0.f;
#pragma unroll 32
        for (int k = C.wave * 128; k < C.wave * 128 + 128; ++k) { const float wv = w[(size_t)k * 6 * D]; a0 += sc[k] * wv; a1 += sc[1024 + k] * wv; a2 += sc[2048 + k] * wv; }
        red[(C.wave * 3 + 0) * 64 + C.lane] = a0; red[(C.wave * 3 + 1) * 64 + C.lane] = a1; red[(C.wave * 3 + 2) * 64 + C.lane] = a2;
        __syncthreads();
        if (C.tid < 192) { const int v = C.tid / 64, ln = C.tid % 64; float s = 0.f;
            for (int w8 = 0; w8 < 8; ++w8) s += red[(w8 * 3 + v) * 64 + ln];
            MOD[(size_t)(l * 3 + v) * 6 * D + cg * 64 + ln] = s + A.in[5][(size_t)l * 6 * D + cg * 64 + ln]; }
        __syncthreads();
    }
}

__device__ __forceinline__ void load_row_f32(const float* p, int lane, f32x4 (&v)[4]) {
#pragma unroll
    for (int j = 0; j < 4; ++j) v[j] = *(const f32x4*)(p + 4 * lane + 256 * j);
}
__device__ __forceinline__ void load_row_bf16(const bf16* p, int lane, f32x4 (&v)[4]) {
#pragma unroll
    for (int j = 0; j < 4; ++j) { const u32x2 w = *(const u32x2*)(p + 4 * lane + 256 * j);
        v[j] = (f32x4){__uint_as_float(w.x << 16), __uint_as_float(w.x & 0xffff0000u), __uint_as_float(w.y << 16), __uint_as_float(w.y & 0xffff0000u)}; }
}
__device__ __forceinline__ void store_row_bf16(bf16* p, int lane, const f32x4 (&v)[4]) {
#pragma unroll
    for (int j = 0; j < 4; ++j) { u32x2 w; w.x = pk2(v[j].x, v[j].y); w.y = pk2(v[j].z, v[j].w); *(u32x2*)(p + 4 * lane + 256 * j) = w; }
}
constexpr int CVT_IG = (D / 64) * (DE / 32), CVT_ID = (DE / 64) * (D / 32), CVT_PER = 2 * CVT_IG + CVT_ID, CVT_ITEMS = NE * CVT_PER;
constexpr int CVT_Q = 24;
__device__ __forceinline__ void cvt_moe_items(const Args& A, const Ctx& C, int l, int it0, int end, int stride);
__device__ __forceinline__ void cvt_win_i8(const Args& A, const Ctx& C);
__device__ __forceinline__ int cvt_t2(int l, int G);
struct RowVec { f32x4 a[4], s[4], g[4]; };
__device__ __forceinline__ void load_rowvec(RowVec& R, const float* ng, const float* sh, const float* sc, const float* gt, int lane) {
    f32x4 n[4], c[4]; load_row_f32(ng, lane, n); load_row_f32(sc, lane, c); load_row_f32(sh, lane, R.s); if (gt) load_row_f32(gt, lane, R.g);
#pragma unroll
    for (int q = 0; q < 4; ++q) R.a[q] = n[q] * (1.f + c[q]);
}
__device__ __forceinline__ void load_row_bf16raw(const bf16* p, int lane, u32x2 (&v)[4]) {
#pragma unroll
    for (int j = 0; j < 4; ++j) v[j] = *(const u32x2*)(p + 4 * lane + 256 * j);
}
__device__ __forceinline__ void store_row_fp8(unsigned char* p, int lane, const f32x4 (&v)[4]) {
#pragma unroll
    for (int j = 0; j < 4; ++j) { int w = 0; w = __builtin_amdgcn_cvt_pk_fp8_f32(v[j].x, v[j].y, w, false); w = __builtin_amdgcn_cvt_pk_fp8_f32(v[j].z, v[j].w, w, true); *(unsigned*)(p + 4 * lane + 256 * j) = (unsigned)w; }
}
__device__ __forceinline__ void load_row_fp8raw(const unsigned char* p, int lane, unsigned (&v)[4]) {
#pragma unroll
    for (int j = 0; j < 4; ++j) v[j] = *(const unsigned*)(p + 4 * lane + 256 * j);
}
__device__ __forceinline__ f32x4 fp8x4(unsigned w) { const f32x2 lo = __builtin_amdgcn_cvt_pk_f32_fp8((int)w, false), hi = __builtin_amdgcn_cvt_pk_f32_fp8((int)w, true); return (f32x4){lo.x, lo.y, hi.x, hi.y}; }
__device__ __forceinline__ f32x4 bf4(u32x2 w) { return (f32x4){__uint_as_float(w.x << 16), __uint_as_float(w.x & 0xffff0000u), __uint_as_float(w.y << 16), __uint_as_float(w.y & 0xffff0000u)}; }
__device__ __forceinline__ float row_rstd(const f32x4 (&v)[4]) {
    float s = 0.f;
#pragma unroll
    for (int j = 0; j < 4; ++j) s += (v[j].x * v[j].x + v[j].y * v[j].y) + (v[j].z * v[j].z + v[j].w * v[j].w);
    return 1.0f / sqrtf(wave_sum(s) * (1.f / D) + EPS);
}

__device__ __forceinline__ void phase_r1(const Args& A, const Ctx& C, int l) {
    LAS int* sb = (LAS int*)C.lds;
    LAS float* GW = (LAS float*)(C.lds + 256);
    const bool mls = (l & 1) == 0; const int j = l >> 1;
    if (l == 0) { cvt_win_i8(A, C); __syncthreads(); }
    if (l > 0) slot_bases(A, l - 1, sb, C.tid);
    if (mls) { const float* w = A.in[8] + (size_t)j * D * PROJ + PW;
        f32x4 t[2][4];
#pragma unroll
        for (int jj = 0; jj < 2; ++jj)
#pragma unroll
            for (int q = 0; q < 4; ++q) t[jj][q] = *(const f32x4*)(w + (size_t)(C.tid + NT * jj) * PROJ + 4 * q);
#pragma unroll
        for (int jj = 0; jj < 2; ++jj)
#pragma unroll
            for (int q = 0; q < 4; ++q) { const int k = C.tid + NT * jj; GW[(4 * q + 0) * D + k] = t[jj][q].x; GW[(4 * q + 1) * D + k] = t[jj][q].y; GW[(4 * q + 2) * D + k] = t[jj][q].z; GW[(4 * q + 3) * D + k] = t[jj][q].w; }
        __syncthreads(); }
    const int nrows = (l <= 2) ? NR : NL;
    bf16* LAT = (bf16*)(A.ws + WS_LAT); unsigned char* HI8 = A.ws + WS_H8; float* RSC = (float*)(A.ws + WS_RSC); float* GATE = (float*)(A.ws + WS_GATE);
    const float* MOD = (const float*)(A.ws + WS_MOD); const unsigned char* Y8 = A.ws + WS_PB;
    const int* TS = (const int*)(A.ws + WS_TOKSLOT); const float* TW = (const float*)(A.ws + WS_TOKW);
    const int rpw = (((nrows + C.G - 1) / C.G) + 1) & ~1; const int wrow0 = C.bid * rpw; const int wend = min(wrow0 + rpw, nrows);
    for (int sa = wrow0; sa < wend;) {
        const int mvi = mod_vec_of_row(sa); const int bnd = mvi == 0 ? SEQ : (mvi == 1 ? NL : NR); const int sbnd = min(wend, bnd);
        RowVec RV; { const float* mv = MOD + (size_t)(l * 3 + mvi) * 6 * D;
            load_rowvec(RV, A.in[6] + (size_t)(l * 2 + 0) * D, mv + 0 * D, mv + 1 * D, l > 0 ? MOD + (size_t)((l - 1) * 3 + mvi) * 6 * D + 5 * D : nullptr, C.lane); }
        const int rlast = sbnd - 2;
        i32x4r tsn = (i32x4r){0, 0, 0, 0}; f32x4 twn = (f32x4){0.f, 0.f, 0.f, 0.f};
        if (l > 0) { const int r0 = min(sa + 2 * C.wave, rlast); tsn = *(const i32x4r*)(TS + r0 * 2); twn = *(const f32x4*)(TW + r0 * 2); }
        for (int ra = sa + 2 * C.wave; ra < sbnd; ra += 2 * NW) {
            const bool hasb = true; const int rb = ra + 1;
            const i32x4r tsc = tsn; const f32x4 twc = twn;
            if (l > 0) { const int r1 = min(ra + 2 * NW, rlast); tsn = *(const i32x4r*)(TS + r1 * 2); twn = *(const f32x4*)(TW + r1 * 2); }
            f32x4 va[4], vb[4]; float wa0 = 0.f, wa1 = 0.f, wb0 = 0.f, wb1 = 0.f;
            if (l == 0) { load_row_f32(ra < NL ? A.in[0] + (size_t)ra * D : A.in[2] + (size_t)(ra - NL) * D, C.lane, va); load_row_f32(rb < NL ? A.in[0] + (size_t)rb * D : A.in[2] + (size_t)(rb - NL) * D, C.lane, vb); }
            else {
                const int ta0 = tsc.x, ta1 = tsc.y, tb0 = tsc.z, tb1 = tsc.w; wa0 = twc.x; wa1 = twc.y; wb0 = twc.z; wb1 = twc.w;
                load_row_bf16(LAT + (size_t)ra * D, C.lane, va); load_row_bf16(LAT + (size_t)rb * D, C.lane, vb);
                unsigned ya0[4], ya1[4], yb0[4], yb1[4];
                load_row_fp8raw(Y8 + (size_t)(sb[ta0 >> 20] + (ta0 & 0xfffff)) * D, C.lane, ya0); load_row_fp8raw(Y8 + (size_t)(sb[ta1 >> 20] + (ta1 & 0xfffff)) * D, C.lane, ya1);
                load_row_fp8raw(Y8 + (size_t)(sb[tb0 >> 20] + (tb0 & 0xfffff)) * D, C.lane, yb0); load_row_fp8raw(Y8 + (size_t)(sb[tb1 >> 20] + (tb1 & 0xfffff)) * D, C.lane, yb1);
                wa0 *= 1.0f / YSCALE; wa1 *= 1.0f / YSCALE; wb0 *= 1.0f / YSCALE; wb1 *= 1.0f / YSCALE;
#pragma unroll
                for (int q = 0; q < 4; ++q) { va[q] += RV.g[q] * (fp8x4(ya0[q]) * wa0 + fp8x4(ya1[q]) * wa1); vb[q] += RV.g[q] * (fp8x4(yb0[q]) * wb0 + fp8x4(yb1[q]) * wb1); }
            }
            store_row_bf16(LAT + (size_t)ra * D, C.lane, va); if (hasb) store_row_bf16(LAT + (size_t)rb * D, C.lane, vb);
            const float rra = row_rstd(va), rrb = row_rstd(vb);
            f32x4 ha[4], hb[4];
#pragma unroll
            for (int q = 0; q < 4; ++q) { ha[q] = (va[q] * rra) * RV.a[q] + RV.s[q]; hb[q] = (vb[q] * rrb) * RV.a[q] + RV.s[q]; }
            { float ma = 0.f, mb = 0.f;
#pragma unroll
              for (int q = 0; q < 4; ++q) { ma = fmaxf(ma, fmaxf(fmaxf(fabsf(ha[q].x), fabsf(ha[q].y)), fmaxf(fabsf(ha[q].z), fabsf(ha[q].w)))); mb = fmaxf(mb, fmaxf(fmaxf(fabsf(hb[q].x), fabsf(hb[q].y)), fmaxf(fabsf(hb[q].z), fabsf(hb[q].w)))); }
              ma = fmaxf(wave_max_nn(ma), 1.0e-20f); mb = fmaxf(wave_max_nn(mb), 1.0e-20f);
              const float ia = 127.0f / ma, ib = 127.0f / mb;
#pragma unroll
              for (int q = 0; q < 4; ++q) { *(unsigned*)(HI8 + (size_t)ra * D + 4 * C.lane + 256 * q) = pack_i8(ha[q] * ia); *(unsigned*)(HI8 + (size_t)rb * D + 4 * C.lane + 256 * q) = pack_i8(hb[q] * ib); }
              if (C.lane == 0) { RSC[ra] = ma * (1.0f / 127.0f); RSC[rb] = mb * (1.0f / 127.0f); } }
            if (mls) {
                float ga = 0.f, gb = 0.f;
#pragma unroll 2
                for (int c = 0; c < 16; ++c) { float s0 = 0.f, s1 = 0.f;
#pragma unroll
                    for (int q = 0; q < 4; ++q) { const f32x4 w = *(const LAS f32x4*)(GW + c * D + 4 * C.lane + 256 * q);
                        s0 += (ha[q].x * w.x + ha[q].y * w.y) + (ha[q].z * w.z + ha[q].w * w.w); s1 += (hb[q].x * w.x + hb[q].y * w.y) + (hb[q].z * w.z + hb[q].w * w.w); }
                    s0 = wave_sum(s0); s1 = wave_sum(s1); ga = (C.lane == c) ? s0 : ga; gb = (C.lane == c) ? s1 : gb; }
                if (C.lane < 16) {
                    const float bgt = A.in[9][j * 16 + C.lane]; const int gtype = C.lane >> 2;
                    ga += bgt; gb += bgt;
                    GATE[(size_t)ra * 16 + C.lane] = (gtype & 1) ? logsigmoidf_(ga) : 15.0f * tanhf(ga * (1.0f / 15.0f));
                    if (hasb) GATE[(size_t)rb * 16 + C.lane] = (gtype & 1) ? logsigmoidf_(gb) : 15.0f * tanhf(gb * (1.0f / 15.0f)); }
            }
        }
        sa = sbnd;
    }
}

__device__ __forceinline__ void phase_r2(const Args& A, const Ctx& C, int l) {
    constexpr int WP = 2064;
    LAS unsigned char* RWB = C.lds;
    LAS float* WL = (LAS float*)(C.lds + 48 * WP);
    LAS unsigned* hist = (LAS unsigned*)(WL + 8 * 16 * 48);
    LAS unsigned* gbase = hist + 32;
    constexpr int RCAP = 144;
    LAS int* rec = (LAS int*)(gbase + 32);
    static_assert(48 * WP + 8 * 16 * 48 * 4 + 256 + RCAP * 16 <= LDS_TAB_END, "R2 LDS map");
    cvt_moe_items(A, C, l, cvt_t2(l, C.G) + C.bid * NW + C.wave, CVT_ITEMS, C.G * NW);
    __syncthreads();
    { const float* wg = A.in[15] + (size_t)l * D * NGRP; const float* wr = A.in[17] + (size_t)l * D * NE;
      { const int kp = C.tid; const f32x4 x0 = *(const f32x4*)(wg + (size_t)(2 * kp) * 4), x1 = *(const f32x4*)(wg + (size_t)(2 * kp + 1) * 4);
        *(LAS unsigned*)(RWB + 0 * WP + kp * 4) = cvt2(x0.x, x1.x); *(LAS unsigned*)(RWB + 1 * WP + kp * 4) = cvt2(x0.y, x1.y);
        *(LAS unsigned*)(RWB + 2 * WP + kp * 4) = cvt2(x0.z, x1.z); *(LAS unsigned*)(RWB + 3 * WP + kp * 4) = cvt2(x0.w, x1.w); }
      f32x4 t0[8], t1[8];
#pragma unroll
      for (int jj = 0; jj < 8; ++jj) { const int it = C.tid + NT * jj, kp = it >> 3, cg = it & 7; t0[jj] = *(const f32x4*)(wr + (size_t)(2 * kp) * NE + 4 * cg); t1[jj] = *(const f32x4*)(wr + (size_t)(2 * kp + 1) * NE + 4 * cg); }
#pragma unroll
      for (int jj = 0; jj < 8; ++jj) { const int it = C.tid + NT * jj, kp = it >> 3, c0 = 4 + 4 * (it & 7);
          *(LAS unsigned*)(RWB + (c0 + 0) * WP + kp * 4) = cvt2(t0[jj].x, t1[jj].x); *(LAS unsigned*)(RWB + (c0 + 1) * WP + kp * 4) = cvt2(t0[jj].y, t1[jj].y);
          *(LAS unsigned*)(RWB + (c0 + 2) * WP + kp * 4) = cvt2(t0[jj].z, t1[jj].z); *(LAS unsigned*)(RWB + (c0 + 3) * WP + kp * 4) = cvt2(t0[jj].w, t1[jj].w); }
      for (int i = C.tid; i < 12 * 512; i += NT) *(LAS unsigned*)(RWB + (36 + i / 512) * WP + (i % 512) * 4) = 0u; }
    const int nrows = (l <= 1) ? NR : NL;
    bf16* LAT = (bf16*)(A.ws + WS_LAT); bf16* H = (bf16*)(A.ws + WS_HB); unsigned char* H8 = A.ws + WS_H8;
    const float* MOD = (const float*)(A.ws + WS_MOD);
    unsigned* cnt = (unsigned*)(A.ws + WS_CTL) + CW_CNT + l * 32 * CNT_STRIDE;
    int* TS = (int*)(A.ws + WS_TOKSLOT); float* TW = (float*)(A.ws + WS_TOKW); int* ST = (int*)(A.ws + WS_SLOTTOK);
    const int rpw = (((nrows + C.G - 1) / C.G) + 1) & ~1; const int wrow0 = C.bid * rpw; const int wend0 = min(wrow0 + rpw, nrows);
    const float* bg = A.in[16] + l * NGRP; const float* br = A.in[18] + l * NE;
    for (int cb = wrow0; cb < wend0; cb += RCAP) {
        const int wend = min(cb + RCAP, wend0);
        if (C.tid < 32) hist[C.tid] = 0u;
        for (int sa = cb; sa < wend;) {
            const int mvi = mod_vec_of_row(sa); const int bnd = mvi == 0 ? SEQ : (mvi == 1 ? NL : NR); const int sbnd = min(wend, bnd);
            RowVec RV; { const float* mv = MOD + (size_t)(l * 3 + mvi) * 6 * D; load_rowvec(RV, A.in[6] + (size_t)(l * 2 + 1) * D, mv + 3 * D, mv + 4 * D, mv + 2 * D, C.lane); }
            const int rlast = sbnd - 2;
            u32x2 la[4], lb[4], ya[4], yb[4];
            { const int r0 = min(sa + 2 * C.wave, rlast); load_row_bf16raw(LAT + (size_t)r0 * D, C.lane, la); load_row_bf16raw(LAT + (size_t)(r0 + 1) * D, C.lane, lb);
              load_row_bf16raw(H + (size_t)r0 * D, C.lane, ya); load_row_bf16raw(H + (size_t)(r0 + 1) * D, C.lane, yb); }
            for (int ra = sa + 2 * C.wave; ra < sbnd; ra += 2 * NW) {
                const int rb = ra + 1;
                u32x2 lan[4], lbn[4], yan[4], ybn[4];
                { const int r1 = min(ra + 2 * NW, rlast); load_row_bf16raw(LAT + (size_t)r1 * D, C.lane, lan); load_row_bf16raw(LAT + (size_t)(r1 + 1) * D, C.lane, lbn);
                  load_row_bf16raw(H + (size_t)r1 * D, C.lane, yan); load_row_bf16raw(H + (size_t)(r1 + 1) * D, C.lane, ybn); }
                f32x4 va[4], vb[4];
#pragma unroll
                for (int q = 0; q < 4; ++q) { va[q] = bf4(la[q]) + RV.g[q] * bf4(ya[q]); vb[q] = bf4(lb[q]) + RV.g[q] * bf4(yb[q]); }
                store_row_bf16(LAT + (size_t)ra * D, C.lane, va); store_row_bf16(LAT + (size_t)rb * D, C.lane, vb);
                const float rra = row_rstd(va), rrb = row_rstd(vb);
                f32x4 ha[4], hb[4];
#pragma unroll
                for (int q = 0; q < 4; ++q) { ha[q] = (va[q] * rra) * RV.a[q] + RV.s[q]; hb[q] = (vb[q] * rrb) * RV.a[q] + RV.s[q]; }
                store_row_bf16(H + (size_t)ra * D, C.lane, ha); store_row_bf16(H + (size_t)rb * D, C.lane, hb);
                store_row_fp8(H8 + (size_t)ra * D, C.lane, ha); store_row_fp8(H8 + (size_t)rb * D, C.lane, hb);
#pragma unroll
                for (int q = 0; q < 4; ++q) { la[q] = lan[q]; lb[q] = lbn[q]; ya[q] = yan[q]; yb[q] = ybn[q]; }
            }
            sa = sbnd;
        }
        __syncthreads();
        const int fr = C.lane & 15, fq = C.lane >> 4;
        for (int t = C.wave; t * 16 < wend - cb; t += NW) {
            const int trow = min(cb + 16 * t + fr, wend - 1);
            const bf16* hp = H + (size_t)trow * D + 8 * fq;
            f32x4 acc[3];
#pragma unroll
            for (int ct = 0; ct < 3; ++ct) acc[ct] = (f32x4){0.f, 0.f, 0.f, 0.f};
#pragma unroll 1
            for (int kb = 0; kb < 4; ++kb) {
                bf16x8 av[8];
#pragma unroll
                for (int k8 = 0; k8 < 8; ++k8) av[k8] = *(const bf16x8*)(hp + 32 * (8 * kb + k8));
#pragma unroll
                for (int k8 = 0; k8 < 8; ++k8)
#pragma unroll
                    for (int ct = 0; ct < 3; ++ct) { const bf16x8 bv = *(const LAS bf16x8*)(RWB + (ct * 16 + fr) * WP + (32 * (8 * kb + k8) + 8 * fq) * 2);
                        acc[ct] = __builtin_amdgcn_mfma_f32_16x16x32_bf16(av[k8], bv, acc[ct], 0, 0, 0); }
            }
            LAS float* wl = WL + C.wave * 16 * 48;
#pragma unroll
            for (int ct = 0; ct < 3; ++ct)
#pragma unroll
                for (int jq = 0; jq < 4; ++jq) wl[(4 * fq + jq) * 48 + ct * 16 + fr] = acc[ct][jq];
            asm volatile("s_waitcnt lgkmcnt(0)" ::: "memory");
            const int row = cb + 16 * t + C.lane;
            if (C.lane < 16 && row < wend) {
                LAS const float* wm = wl + C.lane * 48;
                float lg[36];
#pragma unroll
                for (int c = 0; c < 36; ++c) lg[c] = wm[c];
                float gl[4]; int grp = 0; float gm = -3.0e38f;
#pragma unroll
                for (int c = 0; c < 4; ++c) { gl[c] = lg[c] + bg[c]; if (gl[c] > gm) { gm = gl[c]; grp = c; } }
                float gs = 0.f;
#pragma unroll
                for (int c = 0; c < 4; ++c) gs += __expf(gl[c] - gm);
                const float pgrp = 1.0f / gs;
                float rl[8];
#pragma unroll
                for (int i = 0; i < 8; ++i) { float tt = 0.f;
#pragma unroll
                    for (int g = 0; g < 4; ++g) tt = (g == grp) ? lg[4 + g * 8 + i] : tt;
                    rl[i] = tt + br[grp * 8 + i]; }
                int i0 = 0; float m0 = rl[0];
#pragma unroll
                for (int i = 1; i < 8; ++i) if (rl[i] > m0) { m0 = rl[i]; i0 = i; }
                int i1 = -1; float m1 = -3.0e38f;
#pragma unroll
                for (int i = 0; i < 8; ++i) if (i != i0 && rl[i] > m1) { m1 = rl[i]; i1 = i; }
                const float p0 = 1.0f, p1 = __expf(m1 - m0);
                const float w0 = pgrp * p0 / (p0 + p1), w1 = pgrp * p1 / (p0 + p1);
                const int e0 = grp * 8 + i0, e1 = grp * 8 + i1;
                const unsigned q0 = __hip_atomic_fetch_add(hist + e0, 1u, __ATOMIC_RELAXED, __HIP_MEMORY_SCOPE_WORKGROUP), q1 = __hip_atomic_fetch_add(hist + e1, 1u, __ATOMIC_RELAXED, __HIP_MEMORY_SCOPE_WORKGROUP);
                const int li = row - cb;
                rec[li * 4 + 0] = e0 | (e1 << 8); rec[li * 4 + 1] = (int)q0; rec[li * 4 + 2] = (int)q1;
                TW[row * 2 + 0] = w0; TW[row * 2 + 1] = w1;
            }
        }
        __syncthreads();
        if (C.tid < 32) gbase[C.tid] = hist[C.tid] ? atomicAdd(cnt + C.tid * CNT_STRIDE, hist[C.tid]) : 0u;
        __syncthreads();
        for (int i = C.tid; i < wend - cb; i += NT) { const int row = cb + i; const int ee = rec[i * 4], e0 = ee & 255, e1 = ee >> 8;
            const unsigned q0 = gbase[e0] + (unsigned)rec[i * 4 + 1], q1 = gbase[e1] + (unsigned)rec[i * 4 + 2];
            ST[(size_t)e0 * CAP + q0] = row; ST[(size_t)e1 * CAP + q1] = row;
            TS[row * 2 + 0] = (e0 << 20) | (int)q0; TS[row * 2 + 1] = (e1 << 20) | (int)q1; }
        __syncthreads();
    }
}

__device__ __forceinline__ void phase_final(const Args& A, const Ctx& C) {
    LAS int* sb = (LAS int*)C.lds;
    slot_bases(A, 3, sb, C.tid);
    const bf16* LAT = (const bf16*)(A.ws + WS_LAT); const unsigned char* Y8 = A.ws + WS_PB;
    const int* TS = (const int*)(A.ws + WS_TOKSLOT); const float* TW = (const float*)(A.ws + WS_TOKW);
    const float* MOD = (const float*)(A.ws + WS_MOD);
    f32x4 fg[4]; load_row_f32(A.in[7], C.lane, fg);
    const int rpw = (((NL + C.G - 1) / C.G) + 1) & ~1; const int wrow0 = C.bid * rpw; const int wend = min(wrow0 + rpw, NL);
    for (int sa = wrow0; sa < wend;) {
        const int mvi = mod_vec_of_row(sa); const int sbnd = min(wend, mvi == 0 ? SEQ : NL);
        f32x4 g2[4]; load_row_f32(MOD + (size_t)(3 * 3 + mvi) * 6 * D + 5 * D, C.lane, g2);
        for (int ra = sa + 2 * C.wave; ra < sbnd; ra += 2 * NW) {
            const int rb = ra + 1;
            const int ta0 = TS[ra * 2], ta1 = TS[ra * 2 + 1], tb0 = TS[rb * 2], tb1 = TS[rb * 2 + 1]; const float wa0 = TW[ra * 2], wa1 = TW[ra * 2 + 1], wb0 = TW[rb * 2], wb1 = TW[rb * 2 + 1];
            f32x4 va[4], vb[4]; unsigned ya0[4], ya1[4], yb0[4], yb1[4];
            load_row_bf16(LAT + (size_t)ra * D, C.lane, va); load_row_bf16(LAT + (size_t)rb * D, C.lane, vb);
            load_row_fp8raw(Y8 + (size_t)(sb[ta0 >> 20] + (ta0 & 0xfffff)) * D, C.lane, ya0); load_row_fp8raw(Y8 + (size_t)(sb[ta1 >> 20] + (ta1 & 0xfffff)) * D, C.lane, ya1);
            load_row_fp8raw(Y8 + (size_t)(sb[tb0 >> 20] + (tb0 & 0xfffff)) * D, C.lane, yb0); load_row_fp8raw(Y8 + (size_t)(sb[tb1 >> 20] + (tb1 & 0xfffff)) * D, C.lane, yb1);
#pragma unroll
            for (int q = 0; q < 4; ++q) { va[q] += g2[q] * (fp8x4(ya0[q]) * (wa0 * (1.0f / YSCALE)) + fp8x4(ya1[q]) * (wa1 * (1.0f / YSCALE))); vb[q] += g2[q] * (fp8x4(yb0[q]) * (wb0 * (1.0f / YSCALE)) + fp8x4(yb1[q]) * (wb1 * (1.0f / YSCALE))); }
            const float rra = row_rstd(va), rrb = row_rstd(vb);
#pragma unroll
            for (int q = 0; q < 4; ++q) { *(f32x4*)(A.out + (size_t)ra * D + 4 * C.lane + 256 * q) = (va[q] * rra) * fg[q]; *(f32x4*)(A.out + (size_t)rb * D + 4 * C.lane + 256 * q) = (vb[q] * rrb) * fg[q]; }
        }
        sa = sbnd;
    }
}

__device__ __forceinline__ void phase_conv(const Args& A, const Ctx& C, int l) {
    const int j = l >> 1; const int nrows = (l <= 1) ? NR : NL;
    const bf16* P = (const bf16*)(A.ws + WS_PB); unsigned char* HM = A.ws + WS_HM; float* RSC = (float*)(A.ws + WS_RSC);
    const float* cw = A.in[13] + (size_t)j * 3 * D;
    f32x4 w0[4], w1[4], w2[4];
    load_row_f32(cw, C.lane, w0); load_row_f32(cw + D, C.lane, w1); load_row_f32(cw + 2 * D, C.lane, w2);
    const int rpw = (((nrows + C.G - 1) / C.G) + 1) & ~1; const int wrow0 = C.bid * rpw; const int wend = min(wrow0 + rpw, nrows);
    for (int ra = wrow0 + 2 * C.wave; ra < wend; ra += 2 * NW) {
        const int rb = ra + 1;
        const int ta = ra < NL ? (ra & 63) : ((ra - NL) & 255), tb1 = rb < NL ? (rb & 63) : ((rb - NL) & 255), tlast = ra < NL ? 63 : 255;
        const bool hasl = ta != 0, hasr = tb1 != tlast;
        const bf16* pa = P + (size_t)ra * PW;
        u32x2 bga[4], bgb[4], zm[4], z0[4], z1[4], z2[4];
        load_row_bf16raw(pa, C.lane, bga); load_row_bf16raw(pa + PW, C.lane, bgb);
        load_row_bf16raw(pa + D, C.lane, z0); load_row_bf16raw(pa + PW + D, C.lane, z1);
        load_row_bf16raw(hasl ? pa - PW + D : pa + D, C.lane, zm); load_row_bf16raw(hasr ? pa + 2 * PW + D : pa + D, C.lane, z2);
        const float fl = hasl ? 1.f : 0.f, fr = hasr ? 1.f : 0.f;
        f32x4 oa[4], ob[4];
#pragma unroll
        for (int q = 0; q < 4; ++q) { const f32x4 a0 = bf4(z0[q]), a1 = bf4(z1[q]);
            oa[q] = bf4(bga[q]) * (w0[q] * (bf4(zm[q]) * fl) + w1[q] * a0 + w2[q] * a1);
            ob[q] = bf4(bgb[q]) * (w0[q] * a0 + w1[q] * a1 + w2[q] * (bf4(z2[q]) * fr)); }
        float ma = 0.f, mb = 0.f;
#pragma unroll
        for (int q = 0; q < 4; ++q) { ma = fmaxf(ma, fmaxf(fmaxf(fabsf(oa[q].x), fabsf(oa[q].y)), fmaxf(fabsf(oa[q].z), fabsf(oa[q].w)))); mb = fmaxf(mb, fmaxf(fmaxf(fabsf(ob[q].x), fabsf(ob[q].y)), fmaxf(fabsf(ob[q].z), fabsf(ob[q].w)))); }
        ma = fmaxf(wave_max_nn(ma), 1.0e-20f); mb = fmaxf(wave_max_nn(mb), 1.0e-20f);
        const float ia = 127.0f / ma, ib = 127.0f / mb;
#pragma unroll
        for (int q = 0; q < 4; ++q) { *(unsigned*)(HM + (size_t)ra * D + 4 * C.lane + 256 * q) = pack_i8(oa[q] * ia); *(unsigned*)(HM + (size_t)rb * D + 4 * C.lane + 256 * q) = pack_i8(ob[q] * ib); }
        if (C.lane == 0) { RSC[ra] = ma * (1.0f / 127.0f); RSC[rb] = mb * (1.0f / 127.0f); }
    }
}

constexpr int BM = 256, BK = 64, HALF = 128, HTB = HALF * BK * 2, STAGE_BYTES = 8 * HTB, NXCD = 8, WGM = 8;
constexpr int LDS_TAB = STAGE_BYTES;
__device__ __forceinline__ int lds_byte(int r, int c) { const int st = (r >> 4) * 2 + (c >> 5), rr = r & 15, cc = c & 31, ob = rr * 64 + cc * 2; return st * 1024 + (ob ^ (((ob >> 9) & 1) << 5)); }
__device__ __forceinline__ void stage_rc(int b, int& R, int& C) { const int st = b / 1024, sb = b % 1024, swz = sb ^ (((sb >> 9) & 1) << 5); R = (st >> 1) * 16 + swz / 64; C = (st & 1) * 32 + (swz % 64) / 2; }
__device__ __forceinline__ int perm32(int rho) { const int n = rho >> 4, i = rho & 15; return 8 * (i >> 2) + 4 * n + (i & 3); }
__device__ __forceinline__ unsigned cvt_pk_bf16(float lo, float hi) { unsigned r; asm volatile("v_cvt_pk_bf16_f32 %0, %1, %2" : "=v"(r) : "v"(lo), "v"(hi)); return r; }

struct GUnit { const char* a; const char* b; int orow, ocol, aux; };

typedef int i32x8 __attribute__((ext_vector_type(8)));
typedef int i32x4 __attribute__((ext_vector_type(4)));
template <class Epi, class Sched, bool GATHER, int OPM = 0>
__device__ __forceinline__ void gemm_phase(LAS unsigned char* lds, const int K, const Sched& S, const Epi& E) {
    const int tid = threadIdx.x, wid = __builtin_amdgcn_readfirstlane(tid >> 6), lane = tid & 63, wr = wid >> 2, wc = wid & 3, fr = lane & 15, fq = lane >> 4;
    constexpr bool FP8 = (OPM == 1), I8 = (OPM == 2);
    const int RB = (OPM != 0) ? K : 2 * K;
    const int nt = RB / (BK * 2);
    unsigned voffB[2], voA[2][2]; int Rr[2], Cc[2];
#pragma unroll
    for (int i = 0; i < 2; ++i) { int R, C; stage_rc(tid * 16 + i * 8192, R, C); const int Rb = (R & ~31) + perm32(R & 31); Rr[i] = R; Cc[i] = C;
        voffB[i] = (unsigned)(Rb * RB + C * 2);
        voA[0][i] = (unsigned)(R * RB + C * 2); voA[1][i] = (unsigned)((R + HALF) * RB + C * 2); }
    const size_t kstep = (size_t)(BK * 2);
    const size_t hstep = (size_t)HALF * RB;
    const unsigned ldsw = (unsigned)wid * 1024u;
    const unsigned ldsbase = (unsigned)(size_t)lds;
    const int aoff = lds_byte(wr * 64 + fr, fq * 8), boff = lds_byte(wc * 32 + fr, fq * 8);
#define PG8_SA(b, h) (((b) * 2 + (h)) * HTB)
#define PG8_SB(b, h) ((4 + (b) * 2 + (h)) * HTB)
#define PG8_STAGE(bufoff, gbase, voff) do { _Pragma("unroll") for (int _i = 0; _i < 2; ++_i) \
        asm volatile("s_mov_b32 m0, %2\n\ts_nop 0\n\tglobal_load_lds_dwordx4 %0, %1" :: "v"((voff)[_i]), "s"((const char*)(gbase)), "s"(ldsbase + (unsigned)(bufoff) + ldsw + (unsigned)(_i * 8192)) : "memory"); } while (0)
#define PG8_STAGE_A1(bufoff, gbase) do { if constexpr (GATHER) PG8_STAGE(bufoff, gbase, voA[1]); else PG8_STAGE(bufoff, (const char*)(gbase) + hstep, voA[0]); } while (0)
#define PG8_LDA(dst, b, h) do { if constexpr (FP8) { _Pragma("unroll") for (int m = 0; m < 4; ++m) { \
        const i32x4 _lo = *(const LAS i32x4*)(lds + PG8_SA(b, h) + aoff + m * 2048), _hi = *(const LAS i32x4*)(lds + PG8_SA(b, h) + aoff + m * 2048 + 1024); \
        dst##8[m] = __builtin_shufflevector(_lo, _hi, 0, 1, 2, 3, 4, 5, 6, 7); } } \
      else { _Pragma("unroll") for (int m = 0; m < 4; ++m) _Pragma("unroll") for (int k = 0; k < 2; ++k) dst[m][k] = *(const LAS bf16x8*)(lds + PG8_SA(b, h) + aoff + m * 2048 + k * 1024); } } while (0)
#define PG8_LDB(dst, b, h) do { if constexpr (FP8) { _Pragma("unroll") for (int n = 0; n < 2; ++n) { \
        const i32x4 _lo = *(const LAS i32x4*)(lds + PG8_SB(b, h) + boff + n * 2048), _hi = *(const LAS i32x4*)(lds + PG8_SB(b, h) + boff + n * 2048 + 1024); \
        dst##8[n] = __builtin_shufflevector(_lo, _hi, 0, 1, 2, 3, 4, 5, 6, 7); } } \
      else { _Pragma("unroll") for (int n = 0; n < 2; ++n) _Pragma("unroll") for (int k = 0; k < 2; ++k) dst[n][k] = *(const LAS bf16x8*)(lds + PG8_SB(b, h) + boff + n * 2048 + k * 1024); } } while (0)
#define PG8_MMA(ai, bj, At, Bt) do { __builtin_amdgcn_s_setprio(1); \
        if constexpr (FP8) { _Pragma("unroll") for (int m = 0; m < 4; ++m) _Pragma("unroll") for (int n = 0; n < 2; ++n) \
            acc[ai][bj][m][n] = __builtin_amdgcn_mfma_scale_f32_16x16x128_f8f6f4(Bt##8[n], At##8[m], acc[ai][bj][m][n], 0, 0, 0, 0x7f7f7f7f, 0, 0x7f7f7f7f); } \
        else if constexpr (I8) { _Pragma("unroll") for (int m = 0; m < 4; ++m) _Pragma("unroll") for (int n = 0; n < 2; ++n) _Pragma("unroll") for (int k = 0; k < 2; ++k) \
            acc[ai][bj][m][n] = __builtin_bit_cast(f32x4, __builtin_amdgcn_mfma_i32_16x16x64_i8(__builtin_bit_cast(i32x4, Bt[n][k]), __builtin_bit_cast(i32x4, At[m][k]), __builtin_bit_cast(i32x4, acc[ai][bj][m][n]), 0, 0, 0)); } \
        else { _Pragma("unroll") for (int m = 0; m < 4; ++m) _Pragma("unroll") for (int n = 0; n < 2; ++n) _Pragma("unroll") for (int k = 0; k < 2; ++k) \
            acc[ai][bj][m][n] = __builtin_amdgcn_mfma_f32_16x16x32_bf16(Bt[n][k], At[m][k], acc[ai][bj][m][n], 0, 0, 0); } \
        __builtin_amdgcn_s_setprio(0); } while (0)
#define PG8_WAIT_V(n) asm volatile("s_waitcnt vmcnt(" #n ")" ::: "memory")
#define PG8_WAIT_L(n) asm volatile("s_waitcnt lgkmcnt(" #n ")" ::: "memory")
#define PG8_BAR __builtin_amdgcn_s_barrier()
#define PG8_SCHED __builtin_amdgcn_sched_barrier(0)
    GUnit cur, nxt; int ui = 0;
    if (!S.next(0, cur)) return;
    if constexpr (GATHER) {
#pragma unroll
        for (int h = 0; h < 2; ++h)
#pragma unroll
            for (int i = 0; i < 2; ++i) voA[h][i] = S.arow_off(0, h * HALF + Rr[i]) + (unsigned)Cc[i] * 2u;
    }
    f32x4 acc[2][2][4][2];
#pragma unroll
    for (int a = 0; a < 2; ++a)
#pragma unroll
        for (int b = 0; b < 2; ++b)
#pragma unroll
            for (int m = 0; m < 4; ++m)
#pragma unroll
                for (int n = 0; n < 2; ++n) acc[a][b][m][n] = (f32x4){0.f, 0.f, 0.f, 0.f};
    bf16x8 At[4][2], B0[2][2], B1[2][2]; i32x8 At8[4], B08[2], B18[2];
    const char* cA = cur.a; const char* cB = cur.b;
    PG8_STAGE(PG8_SB(0, 0), cB, voffB); PG8_STAGE(PG8_SB(0, 1), cB + hstep, voffB); PG8_STAGE(PG8_SA(0, 0), cA, voA[0]); PG8_STAGE_A1(PG8_SA(0, 1), cA);
    if (wr == 1) PG8_BAR;
    PG8_WAIT_V(2); PG8_BAR;
    PG8_STAGE(PG8_SB(1, 0), cB + kstep, voffB); PG8_STAGE(PG8_SA(1, 0), cA + kstep, voA[0]); PG8_STAGE(PG8_SB(1, 1), cB + hstep + kstep, voffB);
    PG8_WAIT_V(6); PG8_BAR;
    for (;;) {
        const bool has_next = S.next(ui + 1, nxt);
        const char* nA = has_next ? nxt.a : cA; const char* nB = has_next ? nxt.b : cB;
#pragma unroll 1
        for (int t = 0; t < nt; t += 2) {
            const bool last = (t == nt - 2);
            const char* a1 = cA + (size_t)(t + 1) * kstep;
            const char* a2 = last ? nA : cA + (size_t)(t + 2) * kstep; const char* b2 = last ? nB : cB + (size_t)(t + 2) * kstep;
            const char* a3 = a2 + kstep; const char* b3 = b2 + kstep;
            PG8_LDB(B0, 0, 0); PG8_LDB(B1, 0, 1); PG8_SCHED; PG8_LDA(At, 0, 0); PG8_STAGE_A1(PG8_SA(1, 1), a1);
            if constexpr (GATHER) { if (last && has_next) {
#pragma unroll
                for (int h = 0; h < 2; ++h)
#pragma unroll
                    for (int i = 0; i < 2; ++i) { int R2, C2; stage_rc(tid * 16 + i * 8192, R2, C2); voA[h][i] = S.arow_off(ui + 1, h * HALF + R2) + (unsigned)C2 * 2u; } } }
            PG8_WAIT_V(8); PG8_WAIT_L(0); PG8_BAR; PG8_MMA(0, 0, At, B0); PG8_MMA(0, 1, At, B1); PG8_BAR; PG8_SCHED;
            PG8_LDA(At, 0, 1); PG8_STAGE(PG8_SB(0, 0), b2, voffB); PG8_STAGE(PG8_SB(0, 1), b2 + hstep, voffB); PG8_STAGE(PG8_SA(0, 0), a2, voA[0]);
            PG8_WAIT_V(8); PG8_WAIT_L(0); PG8_BAR; PG8_MMA(1, 0, At, B0); PG8_MMA(1, 1, At, B1); PG8_BAR; PG8_SCHED;
            PG8_LDB(B0, 1, 0); PG8_LDB(B1, 1, 1); PG8_SCHED; PG8_LDA(At, 1, 0); PG8_STAGE_A1(PG8_SA(0, 1), a2);
            PG8_WAIT_V(8); PG8_WAIT_L(0); PG8_BAR; PG8_MMA(0, 0, At, B0); PG8_MMA(0, 1, At, B1); PG8_BAR; PG8_SCHED;
            PG8_LDA(At, 1, 1); PG8_STAGE(PG8_SB(1, 0), b3, voffB); PG8_STAGE(PG8_SB(1, 1), b3 + hstep, voffB); PG8_STAGE(PG8_SA(1, 0), a3, voA[0]);
            PG8_WAIT_V(8); PG8_WAIT_L(0); PG8_BAR; PG8_MMA(1, 0, At, B0); PG8_MMA(1, 1, At, B1); PG8_BAR; PG8_SCHED;
        }
        if (wr == 0) PG8_BAR;
        { int tz = threadIdx.x; asm volatile("" : "+v"(tz));
          if constexpr (I8) {
#pragma unroll
              for (int a_ = 0; a_ < 2; ++a_)
#pragma unroll
                  for (int b_ = 0; b_ < 2; ++b_)
#pragma unroll
                      for (int m = 0; m < 4; ++m)
#pragma unroll
                          for (int n = 0; n < 2; ++n) acc[a_][b_][m][n] = __builtin_convertvector(__builtin_bit_cast(i32x4, acc[a_][b_][m][n]), f32x4); }
          const int wz = tz >> 6, lz = tz & 63; E(acc, cur, wz >> 2, wz & 3, lz & 15, lz >> 4); }
        if (!has_next) break;
#pragma unroll
        for (int a = 0; a < 2; ++a)
#pragma unroll
            for (int b = 0; b < 2; ++b)
#pragma unroll
                for (int m = 0; m < 4; ++m)
#pragma unroll
                    for (int n = 0; n < 2; ++n) acc[a][b][m][n] = (f32x4){0.f, 0.f, 0.f, 0.f};
        cur = nxt; cA = nA; cB = nB; ++ui;
        if (wr == 1) PG8_BAR;
    }
    PG8_WAIT_V(0);
    PG8_BAR;
#undef PG8_SA
#undef PG8_SB
#undef PG8_STAGE
#undef PG8_STAGE_A1
#undef PG8_LDA
#undef PG8_LDB
#undef PG8_MMA
#undef PG8_WAIT_V
#undef PG8_WAIT_L
#undef PG8_BAR
#undef PG8_SCHED
}

__device__ __forceinline__ int xcd_remap(int L, int nwg) { const int q = nwg / NXCD, r = nwg % NXCD, xcd = L % NXCD, off = L / NXCD; return (xcd < r ? xcd * (q + 1) : r * (q + 1) + (xcd - r) * q) + off; }

struct DenseSched {
    const char* A; const char* Bt; int nM, nN, nwg, G, c; size_t tstep; int sw_lo, sw_hi;
    __device__ __forceinline__ void init(const void* A_, const void* Bt_, int M, int N, int K, int G_, int c_, int ebytes = 2) { A = (const char*)A_; Bt = (const char*)Bt_; nM = M / BM; nN = N / BM; nwg = nM * nN; G = G_; c = c_; tstep = (size_t)BM * K * ebytes; sw_lo = 0; sw_hi = 0; }
    __device__ __forceinline__ bool next(int i, GUnit& u) const {
        const long L = (long)i * G + c; if (L >= nwg) return false;
        const int wgid = xcd_remap((int)L, nwg);
        const int nig = WGM * nN, gid = wgid / nig, fm = gid * WGM, gsz = (nM - fm) < WGM ? (nM - fm) : WGM;
        const int pm = fm + ((wgid % nig) % gsz), pn = (wgid % nig) / gsz;
        if (pn >= sw_lo && pn < sw_hi) { u.a = Bt + (size_t)pn * tstep; u.b = A + (size_t)pm * tstep; u.orow = pm; u.ocol = pn - sw_lo; u.aux = 1; }
        else { u.a = A + (size_t)pm * tstep; u.b = Bt + (size_t)pn * tstep; u.orow = pm * BM; u.ocol = pn * BM; u.aux = 0; }
        return true;
    }
    __device__ __forceinline__ unsigned arow_off(int, int) const { return 0u; }
};

constexpr int MAXU = 12;
struct MoeTab { int n; int e[MAXU], mb[MAXU], nt[MAXU]; int sb[NE + 1]; };
struct MoeSched {
    LAS const MoeTab* T; LAS const unsigned* ridx;
    const char* A; const char* W; size_t wstride_e, tstepB; int K; int arow_bytes;
    __device__ __forceinline__ bool next(int i, GUnit& u) const {
        const int n = __builtin_amdgcn_readfirstlane(T->n); if (i >= n) return false;
        const int e = __builtin_amdgcn_readfirstlane(T->e[i]), mb = __builtin_amdgcn_readfirstlane(T->mb[i]), nt = __builtin_amdgcn_readfirstlane(T->nt[i]);
        const int base = __builtin_amdgcn_readfirstlane(T->sb[e]);
        u.orow = base + mb * BM; u.ocol = nt; u.aux = e;
        u.a = A + (size_t)u.orow * arow_bytes;
        u.b = W + (size_t)e * wstride_e + (size_t)nt * tstepB; return true;
    }
    __device__ __forceinline__ unsigned arow_off(int i, int r) const { return ridx[i * 256 + r]; }
};
template <bool GATHER>
__device__ __forceinline__ void moe_tables(const Args& A, const Ctx& C, int l, int ntile_n, LAS MoeTab* T, LAS unsigned* ridx, int arow_bytes) {
    const unsigned* cnt = (const unsigned*)(A.ws + WS_CTL) + CW_CNT + l * 32 * CNT_STRIDE;
    LAS int* ust = (LAS int*)(T + 1);
    if (C.tid < 64) { int nb; const int ex = expert_block_prefix(cnt, C.tid, nb); if (C.tid <= NE) { T->sb[C.tid] = ex * 256; ust[C.tid] = ex * ntile_n; } }
    __syncthreads();
    if (C.tid < MAXU) { const int nwg = ust[NE]; const long L = (long)C.tid * C.G + C.bid;
        if (L < nwg) { const int w = xcd_remap((int)L, nwg); int e = 0; while (w >= ust[e + 1]) ++e;
            const int lu = w - ust[e]; T->e[C.tid] = e; T->mb[C.tid] = lu / ntile_n; T->nt[C.tid] = lu % ntile_n; } }
    if (C.tid == 0) { const int nwg = ust[NE]; int n = 0; while (n < MAXU && (long)n * C.G + C.bid < nwg) ++n; T->n = n; }
    __syncthreads();
    if constexpr (GATHER) {
        const int* ST = (const int*)(A.ws + WS_SLOTTOK); const int n = T->n;
        for (int i = C.tid; i < n * 256; i += NT) { const int ui = i >> 8, r = i & 255, e = T->e[ui], m0 = T->mb[ui] * 256, ce = (int)cnt[e * CNT_STRIDE];
            const int rr = (m0 + r < ce) ? m0 + r : ce - 1;
            ridx[i] = (unsigned)ST[(size_t)e * CAP + rr] * (unsigned)arow_bytes; }
        __syncthreads();
    }
}

struct EpiStore { bf16* O; int ldc; float scale_lo; int sig_from; bf16* VT; float sall = 1.0f; const float* rs = nullptr;
    __device__ __forceinline__ void operator()(const f32x4 (&acc)[2][2][4][2], const GUnit& u, int wr, int wc, int fr, int fq) const {
        const bool tr = u.aux != 0;
        const float sc = ((!tr && u.ocol < NQ) ? scale_lo : 1.0f) * sall; const bool sg = !tr && u.ocol >= sig_from;
        bf16* Ob = tr ? VT + (size_t)(u.orow * NH + u.ocol) * 65536 : O + (size_t)u.orow * ldc + u.ocol; const int ld = tr ? 256 : ldc;
        f32x4 cs[2][2];
#pragma unroll
        for (int bj = 0; bj < 2; ++bj) { const f32x4 one = (f32x4){1.f, 1.f, 1.f, 1.f};
            cs[bj][0] = (rs && tr) ? *(const f32x4*)(rs + u.orow * BM + bj * HALF + wc * 32 + 8 * fq) : one; cs[bj][1] = (rs && tr) ? *(const f32x4*)(rs + u.orow * BM + bj * HALF + wc * 32 + 8 * fq + 4) : one; }
#pragma unroll
        for (int ai = 0; ai < 2; ++ai)
#pragma unroll
            for (int m = 0; m < 4; ++m) { const int rl = ai * HALF + wr * 64 + m * 16 + fr; bf16* rowp = Ob + (size_t)rl * ld + wc * 32 + 8 * fq;
                const float scr = (rs && !tr) ? sc * rs[u.orow + rl] : sc;
#pragma unroll
                for (int bj = 0; bj < 2; ++bj) { f32x4 v0 = acc[ai][bj][m][0] * scr * cs[bj][0], v1 = acc[ai][bj][m][1] * scr * cs[bj][1];
                    if (sg) {
#pragma unroll
                        for (int q = 0; q < 4; ++q) { v0[q] = __builtin_amdgcn_rcpf(1.0f + __expf(-v0[q])); v1[q] = __builtin_amdgcn_rcpf(1.0f + __expf(-v1[q])); } }
                    u32x4 w; w.x = cvt_pk_bf16(v0[0], v0[1]); w.y = cvt_pk_bf16(v0[2], v0[3]); w.z = cvt_pk_bf16(v1[0], v1[1]); w.w = cvt_pk_bf16(v1[2], v1[3]);
                    *(u32x4*)(rowp + bj * HALF) = w; } }
    }
};
__device__ __forceinline__ u32x2 cvt8_fp8(f32x4 a, f32x4 b) { int lo = 0, hi = 0;
    lo = __builtin_amdgcn_cvt_pk_fp8_f32(a[0], a[1], lo, false); lo = __builtin_amdgcn_cvt_pk_fp8_f32(a[2], a[3], lo, true);
    hi = __builtin_amdgcn_cvt_pk_fp8_f32(b[0], b[1], hi, false); hi = __builtin_amdgcn_cvt_pk_fp8_f32(b[2], b[3], hi, true); return (u32x2){(unsigned)lo, (unsigned)hi}; }
struct EpiSwigluF8 { unsigned char* O; int ldc; float s;
    __device__ __forceinline__ void operator()(const f32x4 (&acc)[2][2][4][2], const GUnit& u, int wr, int wc, int fr, int fq) const {
        const int ocol = u.ocol * HALF;
#pragma unroll
        for (int ai = 0; ai < 2; ++ai)
#pragma unroll
            for (int m = 0; m < 4; ++m) { unsigned char* rowp = O + (size_t)(u.orow + ai * HALF + wr * 64 + m * 16 + fr) * ldc + ocol + wc * 32 + 8 * fq;
                f32x4 v0, v1;
#pragma unroll
                for (int q = 0; q < 4; ++q) { const float x0 = acc[ai][0][m][0][q] * s, x1 = acc[ai][0][m][1][q] * s;
                    v0[q] = x0 * __builtin_amdgcn_rcpf(1.0f + __expf(-x0)) * (acc[ai][1][m][0][q] * s); v1[q] = x1 * __builtin_amdgcn_rcpf(1.0f + __expf(-x1)) * (acc[ai][1][m][1][q] * s); }
                *(u32x2*)rowp = cvt8_fp8(v0, v1); }
    }
};
template <int MODE> struct EpiPair { bf16* O; int ldc; int plain_below; float sall = 1.0f; const float* rs = nullptr;
    __device__ __forceinline__ void operator()(const f32x4 (&acc)[2][2][4][2], const GUnit& u, int wr, int wc, int fr, int fq) const {
        if (MODE == 0 && u.ocol < plain_below) {
#pragma unroll
            for (int ai = 0; ai < 2; ++ai)
#pragma unroll
                for (int m = 0; m < 4; ++m) { const int rg = u.orow + ai * HALF + wr * 64 + m * 16 + fr; bf16* rowp = O + (size_t)rg * ldc + u.ocol + wc * 32 + 8 * fq;
                    const float scr = rs ? sall * rs[rg] : sall;
#pragma unroll
                    for (int bj = 0; bj < 2; ++bj) { const f32x4 v0 = acc[ai][bj][m][0] * scr, v1 = acc[ai][bj][m][1] * scr;
                        u32x4 w; w.x = cvt_pk_bf16(v0[0], v0[1]); w.y = cvt_pk_bf16(v0[2], v0[3]); w.z = cvt_pk_bf16(v1[0], v1[1]); w.w = cvt_pk_bf16(v1[2], v1[3]);
                        *(u32x4*)(rowp + bj * HALF) = w; } }
            return;
        }
        const int ocol = (MODE == 0) ? plain_below + (u.ocol - plain_below) / 2 : u.ocol * HALF;
#pragma unroll
        for (int ai = 0; ai < 2; ++ai)
#pragma unroll
            for (int m = 0; m < 4; ++m) { const int rg = u.orow + ai * HALF + wr * 64 + m * 16 + fr; bf16* rowp = O + (size_t)rg * ldc + ocol + wc * 32 + 8 * fq;
                const float scr = rs ? sall * rs[rg] : sall; const float sc2 = scr * scr;
                f32x4 v0, v1;
#pragma unroll
                for (int q = 0; q < 4; ++q) {
                    const float x0 = acc[ai][0][m][0][q], x1 = acc[ai][0][m][1][q];
                    const float g0 = (MODE == 1) ? x0 * __builtin_amdgcn_rcpf(1.0f + __expf(-x0)) : x0, g1 = (MODE == 1) ? x1 * __builtin_amdgcn_rcpf(1.0f + __expf(-x1)) : x1;
                    v0[q] = g0 * acc[ai][1][m][0][q] * sc2; v1[q] = g1 * acc[ai][1][m][1][q] * sc2; }
                u32x4 w; w.x = cvt_pk_bf16(v0[0], v0[1]); w.y = cvt_pk_bf16(v0[2], v0[3]); w.z = cvt_pk_bf16(v1[0], v1[1]); w.w = cvt_pk_bf16(v1[2], v1[3]);
                *(u32x4*)rowp = w; }
    }
};
struct EpiStoreTile { unsigned char* O; int ldc; float s;
    __device__ __forceinline__ void operator()(const f32x4 (&acc)[2][2][4][2], const GUnit& u, int wr, int wc, int fr, int fq) const {
#pragma unroll
        for (int ai = 0; ai < 2; ++ai)
#pragma unroll
            for (int m = 0; m < 4; ++m) { unsigned char* rowp = O + (size_t)(u.orow + ai * HALF + wr * 64 + m * 16 + fr) * ldc + u.ocol * BM + wc * 32 + 8 * fq;
#pragma unroll
                for (int bj = 0; bj < 2; ++bj) *(u32x2*)(rowp + bj * HALF) = cvt8_fp8(acc[ai][bj][m][0] * s, acc[ai][bj][m][1] * s); }
    }
};

__device__ __forceinline__ void transpose_item(const float* W, int ldw, int K, bf16* WT, int drow0, int k0, int n0, LAS float* scr, int lane) {
#pragma unroll
    for (int i = 0; i < 32; ++i) { const int kk = 2 * i + (lane >> 5); scr[kk * 33 + (lane & 31)] = W[(size_t)(k0 + kk) * ldw + n0 + (lane & 31)]; }
    asm volatile("s_waitcnt lgkmcnt(0)" ::: "memory");
    const int c = lane & 7;
#pragma unroll
    for (int j = 0; j < 4; ++j) { const int n = (lane >> 3) + 8 * j; const LAS float* s = scr + (8 * c) * 33 + n;
        u32x4 o; o.x = pk2(s[0 * 33], s[1 * 33]); o.y = pk2(s[2 * 33], s[3 * 33]); o.z = pk2(s[4 * 33], s[5 * 33]); o.w = pk2(s[6 * 33], s[7 * 33]);
        *(u32x4*)(WT + (size_t)(drow0 + n) * K + k0 + 8 * c) = o; }
    asm volatile("s_waitcnt lgkmcnt(0)" ::: "memory");
}
__device__ __forceinline__ void transpose_item_fp8(const float* W, int ldw, int K, unsigned char* WT8, int drow0, int k0, int n0, LAS float* scr, int lane, float sc) {
#pragma unroll
    for (int i = 0; i < 32; ++i) { const int kk = 2 * i + (lane >> 5); scr[kk * 33 + (lane & 31)] = W[(size_t)(k0 + kk) * ldw + n0 + (lane & 31)]; }
    asm volatile("s_waitcnt lgkmcnt(0)" ::: "memory");
    const int n = lane >> 1, half = lane & 1; const LAS float* sp = scr + (32 * half) * 33 + n;
    unsigned char* dst = WT8 + (size_t)(drow0 + n) * K + k0 + 32 * half;
#pragma unroll
    for (int c = 0; c < 2; ++c) { u32x4 o;
#pragma unroll
        for (int q = 0; q < 4; ++q) { int p = 0; const LAS float* s4 = sp + (16 * c + 4 * q) * 33;
            p = __builtin_amdgcn_cvt_pk_fp8_f32(s4[0] * sc, s4[33] * sc, p, false); p = __builtin_amdgcn_cvt_pk_fp8_f32(s4[66] * sc, s4[99] * sc, p, true); o[q] = (unsigned)p; }
        *(u32x4*)(dst + 16 * c) = o; }
    asm volatile("s_waitcnt lgkmcnt(0)" ::: "memory");
}
__device__ __forceinline__ void transpose_item_i8(const float* W, int ldw, int K, unsigned char* WT8, int drow0, int k0, int n0, LAS float* scr, int lane, float inv) {
#pragma unroll
    for (int i = 0; i < 32; ++i) { const int kk = 2 * i + (lane >> 5); scr[kk * 33 + (lane & 31)] = W[(size_t)(k0 + kk) * ldw + n0 + (lane & 31)]; }
    asm volatile("s_waitcnt lgkmcnt(0)" ::: "memory");
    const int n = lane >> 1, half = lane & 1; const LAS float* sp = scr + (32 * half) * 33 + n;
    unsigned char* dst = WT8 + (size_t)(drow0 + n) * K + k0 + 32 * half;
#pragma unroll
    for (int c = 0; c < 2; ++c) { u32x4 o;
#pragma unroll
        for (int q = 0; q < 4; ++q) { const LAS float* s4 = sp + (16 * c + 4 * q) * 33; o[q] = pack_i8((f32x4){s4[0] * inv, s4[33] * inv, s4[66] * inv, s4[99] * inv}); }
        *(u32x4*)(dst + 16 * c) = o; }
    asm volatile("s_waitcnt lgkmcnt(0)" ::: "memory");
}
__device__ __forceinline__ int pair_row(int n, int which) { return (n >> 7) * 256 + (n & 127) + which * 128; }
constexpr float HMR = 6.0f;
__device__ __forceinline__ void phase_cvt_mixer(const Args& A, const Ctx& C) {
    const int gw = C.bid * NW + C.wave, NGW = C.G * NW;
    unsigned* wmax = (unsigned*)(A.ws + WS_CTL) + CW_WMAX;
    for (int m8 = 0; m8 < 8; ++m8) {
        const float* W = m8 < 2 ? A.in[8] + (size_t)m8 * D * PROJ : m8 < 4 ? A.in[12] + (size_t)(m8 - 2) * D * PW : m8 < 6 ? A.in[11] + (size_t)(m8 - 4) * D * D : A.in[14] + (size_t)(m8 - 6) * D * D;
        const size_t n4 = (size_t)D * (m8 < 2 ? PROJ : m8 < 4 ? PW : D) / 4;
        float mx = 0.f;
        for (size_t i = (size_t)gw * 64 + C.lane; i < n4; i += (size_t)NGW * 64) { const f32x4 v = *(const f32x4*)(W + 4 * i); mx = fmaxf(mx, fmaxf(fmaxf(fabsf(v.x), fabsf(v.y)), fmaxf(fabsf(v.z), fabsf(v.w)))); }
        mx = wave_max_nn(mx);
        if (C.lane == 0 && mx > 0.f) atomicMax(wmax + m8 * CNT_STRIDE, __float_as_uint(mx));
    }
}
__device__ __forceinline__ void cvt_win_i8(const Args& A, const Ctx& C) {
    LAS float* scr = (LAS float*)(C.lds + 16384 + C.wave * 16384);
    const int gw = C.bid * NW + C.wave, NGW = C.G * NW;
    constexpr int I_IN = (D / 64) * (PW / 32);
    const unsigned* wmax = (const unsigned*)(A.ws + WS_CTL) + CW_WMAX;
    constexpr int I_OUT = (D / 64) * (D / 32);
    for (int it = gw; it < 4 * I_OUT; it += NGW) {
        const int m4 = it / I_OUT, kind = m4 >> 1, j = m4 & 1, r = it % I_OUT; const int kb = r / (D / 32), nb = r % (D / 32), n0 = nb * 32;
        const float inv = 127.0f / fmaxf(__uint_as_float(wmax[(4 + m4) * CNT_STRIDE]), 1.0e-30f);
        transpose_item_i8((kind == 0 ? A.in[11] : A.in[14]) + (size_t)j * D * D, D, D, A.ws + (kind == 0 ? WS_WAOUT : WS_WBOUT) + (size_t)j * D * D, n0, kb * 64, n0, scr, C.lane, inv); }
    for (int it = gw; it < 4 * I_IN; it += NGW) {
        const int m4 = it / I_IN, kind = m4 >> 1, j = m4 & 1, r = it % I_IN; const int kb = r / (PW / 32), nb = r % (PW / 32), n0 = nb * 32;
        const float inv = 127.0f / fmaxf(__uint_as_float(wmax[m4 * CNT_STRIDE]), 1.0e-30f);
        unsigned char* WT = A.ws + (kind == 0 ? WS_WAIN : WS_WBIN) + (size_t)j * PW * D;
        if (kind == 0) transpose_item_i8(A.in[8] + (size_t)j * D * PROJ, PROJ, D, WT, n0, kb * 64, n0, scr, C.lane, inv);
        else { const int drow = n0 < D ? n0 : (n0 < 2 * D ? D + pair_row(n0 - D, 0) : D + pair_row(n0 - 2 * D, 1));
            transpose_item_i8(A.in[12] + (size_t)j * D * PW, PW, D, WT, drow, kb * 64, n0, scr, C.lane, inv); }
    }
}
__device__ __forceinline__ void cvt_moe_items(const Args& A, const Ctx& C, int l, int it0, int end, int stride) {
    LAS float* scr = (LAS float*)(C.lds + 16384 + C.wave * 16384);
    unsigned char* WGU = A.ws + WS_WGU; unsigned char* WDN = A.ws + WS_WDN;
    for (int it = it0; it < end; it += stride) {
        const int e = it / CVT_PER; int r = it % CVT_PER;
        if (r < 2 * CVT_IG) { const int which = r / CVT_IG; r %= CVT_IG; const int kb = r / (DE / 32), nb = r % (DE / 32), n0 = nb * 32;
            transpose_item_fp8((which == 0 ? A.in[19] : A.in[20]) + ((size_t)l * NE + e) * D * DE, DE, D, WGU + (size_t)e * 2 * DE * D, pair_row(n0, which), kb * 64, n0, scr, C.lane, WSCALE); }
        else { r -= 2 * CVT_IG; const int kb = r / (D / 32), nb = r % (D / 32), n0 = nb * 32;
            transpose_item_fp8(A.in[21] + ((size_t)l * NE + e) * DE * D, D, DE, WDN + (size_t)e * D * DE, n0, kb * 64, n0, scr, C.lane, WSCALE); }
    }
}
__device__ __forceinline__ int cvt_idle(int nunits, int G) { const int rem = nunits % G; return rem ? G - rem : 0; }
__device__ __forceinline__ int cvt_t1(int l, int G) { const int n = cvt_idle((((l <= 2) ? NR : NL) / BM) * (PW / BM), G) * CVT_Q; return n < CVT_ITEMS ? n : CVT_ITEMS; }
__device__ __forceinline__ int cvt_t2(int l, int G) { const int n = cvt_t1(l, G) + cvt_idle((((l <= 1) ? NR : NL) / BM) * (D / BM), G) * CVT_Q; return n < CVT_ITEMS ? n : CVT_ITEMS; }
__device__ __forceinline__ void cvt_moe_tail(const Args& A, const Ctx& C, int l, int nunits, int base, int end) {
    const int rem = nunits % C.G;
    if (rem == 0 || C.bid < rem) return;
    const int first = base + (C.bid - rem) * CVT_Q; const int last = min(first + CVT_Q, end);
    cvt_moe_items(A, C, l, first + C.wave, last, NW);
}

__device__ __forceinline__ void phase_g1(const Args& A, const Ctx& C, int l) {
    const bool mls = (l & 1) == 0; const int j = l >> 1; const int nrows = (l <= 2) ? NR : NL;
    DenseSched S; S.init(A.ws + WS_H8, A.ws + (mls ? WS_WAIN : WS_WBIN) + (size_t)j * PW * D, nrows, PW, D, C.G, C.bid, 1);
    const float wsc = __uint_as_float(((const unsigned*)(A.ws + WS_CTL))[CW_WMAX + ((mls ? 0 : 2) + j) * CNT_STRIDE]) * (1.0f / 127.0f);
    const float* rs = (const float*)(A.ws + WS_RSC);
    if (mls) { S.sw_lo = 4; S.sw_hi = 8; EpiStore E{(bf16*)(A.ws + WS_PB), PW, 0.08838834764831845f, 2 * NQ + NV, (bf16*)(A.ws + WS_VT), wsc, rs}; gemm_phase<EpiStore, DenseSched, false, 2>(C.lds, D, S, E); }
    else { EpiPair<0> E{(bf16*)(A.ws + WS_PB), PW, D, wsc, rs}; gemm_phase<EpiPair<0>, DenseSched, false, 2>(C.lds, D, S, E); }
    cvt_moe_tail(A, C, l, S.nwg, 0, cvt_t1(l, C.G));
}
__device__ __forceinline__ void phase_g2(const Args& A, const Ctx& C, int l) {
    const bool mls = (l & 1) == 0; const int j = l >> 1; const int nrows = (l <= 1) ? NR : NL;
    DenseSched S; S.init(A.ws + WS_HM, A.ws + (mls ? WS_WAOUT : WS_WBOUT) + (size_t)j * D * D, nrows, D, D, C.G, C.bid, 1);
    const float wsc = __uint_as_float(((const unsigned*)(A.ws + WS_CTL))[CW_WMAX + (4 + (mls ? 0 : 2) + j) * CNT_STRIDE]) * (1.0f / 127.0f);
    EpiStore E{(bf16*)(A.ws + WS_HB), D, 1.0f, 1 << 30, nullptr, mls ? wsc * (HMR / 127.0f) : wsc, mls ? nullptr : (const float*)(A.ws + WS_RSC)}; gemm_phase<EpiStore, DenseSched, false, 2>(C.lds, D, S, E);
    cvt_moe_tail(A, C, l, S.nwg, cvt_t1(l, C.G), cvt_t2(l, C.G));
}
__device__ __forceinline__ void phase_m1(const Args& A, const Ctx& C, int l) {
    LAS MoeTab* T = (LAS MoeTab*)(C.lds + LDS_TAB); LAS unsigned* ridx = (LAS unsigned*)(C.lds + LDS_TAB + 1024);
    moe_tables<true>(A, C, l, 4, T, ridx, D);
    MoeSched S; S.T = T; S.ridx = ridx; S.A = (const char*)(A.ws + WS_H8); S.W = (const char*)(A.ws + WS_WGU); S.wstride_e = (size_t)2 * DE * D; S.tstepB = (size_t)BM * D; S.K = D; S.arow_bytes = 0;
    EpiSwigluF8 E{A.ws + WS_DC, DE, 1.0f / WSCALE}; gemm_phase<EpiSwigluF8, MoeSched, true, 1>(C.lds, D, S, E);
}
__device__ __forceinline__ void phase_m2(const Args& A, const Ctx& C, int l) {
    LAS MoeTab* T = (LAS MoeTab*)(C.lds + LDS_TAB); LAS unsigned* ridx = (LAS unsigned*)(C.lds + LDS_TAB + 1024);
    moe_tables<false>(A, C, l, 4, T, ridx, DE);
    MoeSched S; S.T = T; S.ridx = ridx; S.A = (const char*)(A.ws + WS_DC); S.W = (const char*)(A.ws + WS_WDN); S.wstride_e = (size_t)D * DE; S.tstepB = (size_t)BM * DE; S.K = DE; S.arow_bytes = DE;
    EpiStoreTile E{A.ws + WS_PB, D, YSCALE / WSCALE}; gemm_phase<EpiStoreTile, MoeSched, false, 1>(C.lds, DE, S, E);
}

typedef float f32x16 __attribute__((ext_vector_type(16)));
#define MFMA32(a, b, c) __builtin_amdgcn_mfma_f32_32x32x16_bf16((a), (b), (c), 0, 0, 0)
__device__ __forceinline__ bf16x8 pack8(float a0, float a1, float a2, float a3, float a4, float a5, float a6, float a7) {
    u32x4 p; p.x = cvt2(a0, a1); p.y = cvt2(a2, a3); p.z = cvt2(a4, a5); p.w = cvt2(a6, a7); return __builtin_bit_cast(bf16x8, p); }
__device__ __forceinline__ float bflo(unsigned w) { return __uint_as_float(w << 16); }
__device__ __forceinline__ float bfhi(unsigned w) { return __uint_as_float(w & 0xffff0000u); }
__device__ __forceinline__ int vt_tile(int b, int h, int blk) { return (blk == 0 ? 128 + b : b * 64 + blk - 1) * NH + h; }

__device__ __forceinline__ float wave_incl_scan(float v, int lane) {
#pragma unroll
    for (int o = 1; o < 64; o <<= 1) { const float t = __shfl_up(v, o); v += (lane >= o) ? t : 0.f; }
    return v;
}
__device__ __forceinline__ void block_gates(const Args& A, int row0, int h, LAS float* bf, LAS float* bb, LAS float* lif, LAS float* lib, int tid) {
    const float* GATE = (const float*)(A.ws + WS_GATE);
    if (tid < 256) { const float* g = GATE + (size_t)(row0 + tid) * 16; lif[tid] = g[0 + h]; bf[tid] = g[4 + h]; lib[tid] = g[8 + h]; bb[tid] = g[12 + h]; }
    __syncthreads();
    const int lane = tid & 63, wv = tid >> 6;
    if (wv == 0) { f32x4 x = *(LAS f32x4*)(bf + 4 * lane); x.y += x.x; x.z += x.y; x.w += x.z; const float tot = wave_incl_scan(x.w, lane); const float ex = tot - x.w;
        x.x += ex; x.y += ex; x.z += ex; x.w += ex; *(LAS f32x4*)(bf + 4 * lane) = x; }
    if (wv == 1) { f32x4 y = *(LAS f32x4*)(bb + 4 * (63 - lane)); y.z += y.w; y.y += y.z; y.x += y.y; const float tot = wave_incl_scan(y.x, lane); const float ex = tot - y.x;
        y.x += ex; y.y += ex; y.z += ex; y.w += ex; *(LAS f32x4*)(bb + 4 * (63 - lane)) = y; }
    __syncthreads();
}
__device__ __forceinline__ void phase_s1(const Args& A, const Ctx& C, int l) {
    LAS float* bf = (LAS float*)C.lds; LAS float* bb = bf + 256; LAS float* lif = bb + 256; LAS float* lib = lif + 256; LAS float* af = lib + 256; LAS float* ab = af + 256;
    constexpr int KP = 528;
    LAS unsigned char* KTf = C.lds + 8192; LAS unsigned char* KTb = KTf + 128 * KP;
    const bf16* P = (const bf16*)(A.ws + WS_PB); const bf16* VT = (const bf16*)(A.ws + WS_VT);
    float* DC = (float*)(A.ws + WS_DC); float* DN = (float*)(A.ws + WS_DN); float* BT = (float*)(A.ws + WS_BTOT);
    const int r = C.lane & 31, hh = C.lane >> 5, w = C.wave;
    for (int u = C.bid; u < NUNIT; u += C.G) {
        const int blk = u % NBLK, bh = u / NBLK, h = bh % NH, b = bh / NH; const int row0 = blk_row0(b, blk);
        block_gates(A, row0, h, bf, bb, lif, lib, C.tid);
        if (C.tid < 256) { af[C.tid] = __expf(bf[255] - bf[C.tid] + lif[C.tid]); ab[C.tid] = __expf(bb[0] - bb[C.tid] + lib[C.tid]); }
        if (C.tid == 0) { BT[u * 2 + 0] = bf[255]; BT[u * 2 + 1] = bb[0]; }
        __syncthreads();
        { const int sp = C.tid >> 2, dq = C.tid & 3, s0 = 2 * sp;
          const bf16* k0 = P + (size_t)(row0 + s0) * PW + NQ + h * DQK + 32 * dq;
          const float f0 = af[s0], f1 = af[s0 + 1], g0 = ab[s0], g1 = ab[s0 + 1];
#pragma unroll
          for (int c = 0; c < 4; ++c) { const u32x4 x0 = *(const u32x4*)(k0 + 8 * c), x1 = *(const u32x4*)(k0 + PW + 8 * c);
#pragma unroll
              for (int q = 0; q < 4; ++q) { const int d = 32 * dq + 8 * c + 2 * q;
                  const float a0 = bflo(x0[q]), a1 = bfhi(x0[q]), c0 = bflo(x1[q]), c1 = bfhi(x1[q]);
                  *(LAS unsigned*)(KTf + d * KP + s0 * 2) = cvt2(a0 * f0, c0 * f1); *(LAS unsigned*)(KTf + (d + 1) * KP + s0 * 2) = cvt2(a1 * f0, c1 * f1);
                  *(LAS unsigned*)(KTb + d * KP + s0 * 2) = cvt2(a0 * g0, c0 * g1); *(LAS unsigned*)(KTb + (d + 1) * KP + s0 * 2) = cvt2(a1 * g0, c1 * g1); } } }
        __syncthreads();
        if (C.tid < 256) { const int dir = C.tid >> 7, d = C.tid & 127; LAS const unsigned* kr = (LAS const unsigned*)((dir ? KTb : KTf) + d * KP); float s = 0.f;
            for (int i = 0; i < 128; ++i) { const unsigned x = kr[i]; s += bflo(x) + bfhi(x); }
            DN[(size_t)(u * 2 + dir) * DQK + d] = s; }
        const bf16* vt = VT + (size_t)vt_tile(b, h, blk) * 65536 + (size_t)(32 * w + r) * 256 + 8 * hh;
        f32x16 accf[4], accb[4];
#pragma unroll
        for (int dt = 0; dt < 4; ++dt)
#pragma unroll
            for (int i = 0; i < 16; ++i) { accf[dt][i] = 0.f; accb[dt][i] = 0.f; }
#pragma unroll 2
        for (int ks = 0; ks < 16; ++ks) { const bf16x8 a = *(const bf16x8*)(vt + 16 * ks);
#pragma unroll
            for (int dt = 0; dt < 4; ++dt) { const int off = (dt * 32 + r) * KP + (16 * ks + 8 * hh) * 2;
                const bf16x8 b0 = *(const LAS bf16x8*)(KTf + off), b1 = *(const LAS bf16x8*)(KTb + off);
                accf[dt] = MFMA32(a, b0, accf[dt]); accb[dt] = MFMA32(a, b1, accb[dt]); } }
        float* dcf = DC + (size_t)(u * 2 + 0) * DQK * DV + (size_t)(32 * w + 4 * hh) * DQK + r; float* dcb = dcf + DQK * DV;
#pragma unroll
        for (int g = 0; g < 4; ++g) { float* pf = dcf + g * 8 * DQK; float* pb = dcb + g * 8 * DQK; asm volatile("" : "+v"(pf), "+v"(pb));
#pragma unroll
            for (int q = 0; q < 4; ++q)
#pragma unroll
                for (int dt = 0; dt < 4; ++dt) { pf[q * DQK + dt * 32] = accf[dt][4 * g + q]; pb[q * DQK + dt * 32] = accb[dt][4 * g + q]; } }
        __syncthreads();
    }
}
__device__ __forceinline__ void phase_s2(const Args& A, const Ctx& C) {
    const float* __restrict__ DC = (const float*)(A.ws + WS_DC); const float* __restrict__ DN = (const float*)(A.ws + WS_DN); const float* __restrict__ BT = (const float*)(A.ws + WS_BTOT);
    bf16* __restrict__ CST = (bf16*)(A.ws + WS_CST); float* __restrict__ NST = (float*)(A.ws + WS_NST);
    constexpr int EL4 = DQK * DV / 4;
    for (int g = C.bid * NT + C.tid; g < BATCH * NH * 2 * EL4; g += C.G * NT) {
        const int e4 = (g % EL4) * 4, ch = g / EL4, dir = ch & 1, bh = ch >> 1;
        f32x4 st = (f32x4){0.f, 0.f, 0.f, 0.f};
#pragma unroll 13
        for (int idx = 0; idx < NBLK; ++idx) {
            const int blk = dir == 0 ? idx : (idx == 0 ? 0 : NBLK - idx); const int u = bh * NBLK + blk;
            const float dec = __expf(BT[u * 2 + dir]);
            const f32x4 dc = *(const f32x4*)(DC + (size_t)(u * 2 + dir) * DQK * DV + e4);
            u32x2 o; o.x = cvt2(st.x, st.y); o.y = cvt2(st.z, st.w);
            *(u32x2*)(CST + (size_t)(u * 2 + dir) * DQK * DV + e4) = o;
            st = st * dec + dc;
        }
    }
    for (int g = C.bid * NT + C.tid; g < BATCH * NH * 2 * DQK; g += C.G * NT) {
        const int d = g % DQK, ch = g / DQK, dir = ch & 1, bh = ch >> 1; float st = 0.f;
        for (int idx = 0; idx < NBLK; ++idx) {
            const int blk = dir == 0 ? idx : (idx == 0 ? 0 : NBLK - idx); const int u = bh * NBLK + blk;
            NST[(size_t)(u * 2 + dir) * DQK + d] = st; st = __expf(BT[u * 2 + dir]) * st + DN[(size_t)(u * 2 + dir) * DQK + d];
        }
    }
}
__device__ __forceinline__ void lds_barrier() { asm volatile("s_waitcnt lgkmcnt(0)" ::: "memory"); __builtin_amdgcn_s_barrier(); asm volatile("" ::: "memory"); }
__device__ __forceinline__ void phase_s3(const Args& A, const Ctx& C, int l) {
    const int jl = l >> 1; const bool ctx_out = (l == 0);
    LAS float* bf = (LAS float*)C.lds; LAS float* bb = bf + 256; LAS float* gf = bb + 256; LAS float* gb = gf + 256;
    LAS float* nf = gb + 256; LAS float* nb = nf + 128; LAS float* ssx = nb + 128;
    LAS float* cf = ssx + 256; LAS float* cb = cf + 256;
    constexpr int KP = 272, OP = 528, CHB = 16384, NCHB = 4;
    LAS unsigned char* Kimg = C.lds + 8192;
    LAS unsigned char* CH = Kimg + 256 * KP;
    static_assert(8192 + 256 * KP + 128 * OP <= LDS_TAB_END && NCHB * CHB <= 128 * OP, "S3 LDS map");
    const bf16* P = (const bf16*)(A.ws + WS_PB); const bf16* VT = (const bf16*)(A.ws + WS_VT); unsigned char* HM = A.ws + WS_HM;
    const bf16* CST = (const bf16*)(A.ws + WS_CST); const float* NST = (const float*)(A.ws + WS_NST);
    const float* hg = A.in[10] + (size_t)jl * NV;
    const int w = C.wave, eh = w >> 2;
    for (int u = C.bid; u < NUNIT; u += C.G) {
        const int blk = u % NBLK, bh = u / NBLK, h = bh % NH, b = bh / NH; const int row0 = blk_row0(b, blk);
        if (blk == 0 && !ctx_out) continue;
        bf16x8 qf[8];
#define S3_LOAD_Q(ps_) do { int lq = threadIdx.x & 63; asm volatile("" : "+v"(lq)); const bf16* qr = P + (size_t)(row0 + 32 * (2 * (w & 3) + (ps_)) + (lq & 31)) * PW + h * DQK + 8 * (lq >> 5); \
            _Pragma("unroll") for (int kk = 0; kk < 8; ++kk) qf[kk] = *(const bf16x8*)(qr + 16 * kk); } while (0)
        S3_LOAD_Q(0);
        int tu = threadIdx.x; asm volatile("" : "+v"(tu));
        block_gates(A, row0, h, bf, bb, gf, gb, tu);
        if (tu < 256) { gf[tu] -= bf[tu]; gb[tu] -= bb[tu]; cf[tu] = __expf(bf[tu | 31] + gf[tu]); cb[tu] = __expf(bb[tu & ~31] + gb[tu]); }
        else { const int t2 = tu - 256; nf[t2] = NST[(size_t)(u * 2 + (t2 >> 7)) * DQK + (t2 & 127)]; }
        { const int pc = tu & 15, s0 = tu >> 4; const bf16* kr = P + (size_t)(row0 + s0) * PW + NQ + h * DQK + 8 * pc;
#pragma unroll
          for (int i = 0; i < 8; ++i) *(LAS u32x4*)(Kimg + (s0 + 32 * i) * KP + pc * 16) = *(const u32x4*)(kr + (size_t)(32 * i) * PW); }
        __syncthreads();
        const bf16* vtile = VT + (size_t)vt_tile(b, h, blk) * 65536;
        const bf16* ctile = CST + (size_t)(u * 2) * DQK * DV;
#pragma unroll 1
        for (int ps = 0; ps < 2; ++ps) {
            int lz = threadIdx.x & 63; asm volatile("" : "+v"(lz));
            const int r = lz & 31, hh = lz >> 5;
            const int jt = 2 * (w & 3) + ps; const int jrow = row0 + 32 * jt + r;
            const float bfj = bf[32 * jt + r], bbj = bb[32 * jt + r];
            float qnf = 0.f, qnb = 0.f;
#pragma unroll
            for (int kk = 0; kk < 8; ++kk) { const u32x4 qq = __builtin_bit_cast(u32x4, qf[kk]); const int d = 16 * kk + 8 * hh;
                const f32x4 n0 = *(const LAS f32x4*)(nf + d), n1 = *(const LAS f32x4*)(nf + d + 4), m0 = *(const LAS f32x4*)(nb + d), m1 = *(const LAS f32x4*)(nb + d + 4);
                qnf += (bflo(qq.x) * n0.x + bfhi(qq.x) * n0.y) + (bflo(qq.y) * n0.z + bfhi(qq.y) * n0.w) + (bflo(qq.z) * n1.x + bfhi(qq.z) * n1.y) + (bflo(qq.w) * n1.z + bfhi(qq.w) * n1.w);
                qnb += (bflo(qq.x) * m0.x + bfhi(qq.x) * m0.y) + (bflo(qq.y) * m0.z + bfhi(qq.y) * m0.w) + (bflo(qq.z) * m1.x + bfhi(qq.z) * m1.y) + (bflo(qq.w) * m1.z + bfhi(qq.w) * m1.w);
                if (kk & 1) asm volatile("" ::: "memory"); }
            qnf += __shfl_xor(qnf, 32); qnb += __shfl_xor(qnb, 32);
            float denf = 0.f, denb = 0.f;
#pragma unroll 1
            for (int kt = 0; kt < 8; ++kt) {
                f32x16 c;
#pragma unroll
                for (int i = 0; i < 16; ++i) c[i] = 0.f;
#pragma unroll
                for (int kk = 0; kk < 8; ++kk) { const bf16x8 a = *(const LAS bf16x8*)(Kimg + (kt * 32 + r) * KP + (16 * kk + 8 * hh) * 2); c = MFMA32(a, qf[kk], c); }
                if (kt == jt) {
#pragma unroll
                    for (int g = 0; g < 4; ++g) { const int sl0 = 8 * g + 4 * hh;
                        const f32x4 g4f = *(const LAS f32x4*)(gf + kt * 32 + sl0), g4b = *(const LAS f32x4*)(gb + kt * 32 + sl0);
#pragma unroll
                        for (int q = 0; q < 4; ++q) { const int sl = sl0 + q; const float cv = c[4 * g + q];
                            denf += cv * __expf((sl <= r) ? bfj + g4f[q] : -1.0e30f); denb += cv * __expf((sl >= r) ? bbj + g4b[q] : -1.0e30f); } }
                } else {
                    LAS const float* cx = (kt < jt ? cf : cb) + kt * 32 + 4 * hh; float sm = 0.f;
#pragma unroll
                    for (int g = 0; g < 4; ++g) { const f32x4 c4 = *(const LAS f32x4*)(cx + 8 * g); sm += (c[4 * g] * c4.x + c[4 * g + 1] * c4.y) + (c[4 * g + 2] * c4.z + c[4 * g + 3] * c4.w); }
                    if (kt < jt) denf += sm * __expf(bfj - bf[kt * 32 + 31]); else denb += sm * __expf(bbj - bb[kt * 32]);
                }
            }
            denf += __shfl_xor(denf, 32); denb += __shfl_xor(denb, 32);
            const float ebf = __expf(bfj), ebb = __expf(bbj);
            denf += ebf * qnf; denb += ebb * qnb;
            const float rf = 1.0f / fmaxf(fabsf(denf), 1.0f), rb = 1.0f / fmaxf(fabsf(denb), 1.0f);
            const float scf = ebf * rf, scb = ebb * rb;
            float wdg[16];
#pragma unroll
            for (int g = 0; g < 4; ++g) { const int sl0 = 8 * g + 4 * hh;
                const f32x4 g4f = *(const LAS f32x4*)(gf + jt * 32 + sl0), g4b = *(const LAS f32x4*)(gb + jt * 32 + sl0);
#pragma unroll
                for (int q = 0; q < 4; ++q) { const int sl = sl0 + q; wdg[4 * g + q] = rf * __expf((sl <= r) ? bfj + g4f[q] : -1.0e30f) + rb * __expf((sl >= r) ? bbj + g4b[q] : -1.0e30f); } }
            f32x16 acc[4];
#pragma unroll
            for (int et = 0; et < 4; ++et)
#pragma unroll
                for (int i = 0; i < 16; ++i) acc[et][i] = 0.f;
            const unsigned ringb = (unsigned)(size_t)CH + (unsigned)w * 2048u;
            const unsigned dlp = (unsigned)(((lz & 3) ^ ((lz >> 4) & 3)) * 16), drow = (unsigned)(32 * w + (lz >> 2));
#define S3_DMA(c_) do { const int cc_ = (c_); const bool isv_ = cc_ < 8; \
                const unsigned long long gp_ = (unsigned long long)(isv_ ? (const char*)vtile + 64 * cc_ : (const char*)ctile + (cc_ >= 12 ? 2 * DQK * DV : 0) + 64 * ((cc_ - 8) & 3)); \
                const char* gb_ = (const char*)(((unsigned long long)(unsigned)__builtin_amdgcn_readfirstlane((int)(unsigned)(gp_ >> 32)) << 32) | (unsigned)__builtin_amdgcn_readfirstlane((int)(unsigned)gp_)); \
                _Pragma("unroll") for (int jj = 0; jj < 2; ++jj) \
                    asm volatile("s_mov_b32 m0, %2\n\ts_nop 0\n\tglobal_load_lds_dwordx4 %0, %1" :: "v"(((drow + 16u * jj) << (isv_ ? 9 : 8)) + dlp), "s"(gb_), "s"(ringb + (unsigned)((cc_ & 3) * CHB + jj * 1024)) : "memory"); } while (0)
            asm volatile("s_waitcnt vmcnt(0)" ::: "memory");
            lds_barrier();
            S3_DMA(0); S3_DMA(1); S3_DMA(2);
            const int swz = (r >> 2) & 3;
#pragma unroll 1
            for (int ci = 0; ci < 8; ++ci) {
                asm volatile("s_waitcnt vmcnt(4)" ::: "memory");
                lds_barrier();
                S3_DMA(ci + 3);
                LAS const unsigned char* CHc = CH + (ci & 3) * CHB;
                { const int kt = ci;
                        f32x16 c;
#pragma unroll
                        for (int i = 0; i < 16; ++i) c[i] = 0.f;
#pragma unroll
                        for (int kk = 0; kk < 8; ++kk) { const bf16x8 a = *(const LAS bf16x8*)(Kimg + (kt * 32 + r) * KP + (16 * kk + 8 * hh) * 2); c = MFMA32(a, qf[kk], c); }
                        float p[16]; const float bfj2 = bf[32 * jt + r], bbj2 = bb[32 * jt + r];
                        if (kt == jt) {
#pragma unroll
                            for (int i = 0; i < 16; ++i) p[i] = c[i] * wdg[i];
                        } else {
                            LAS const float* cx = (kt < jt ? cf : cb) + kt * 32 + 4 * hh;
                            const float rw = (kt < jt) ? rf * __expf(bfj2 - bf[kt * 32 + 31]) : rb * __expf(bbj2 - bb[kt * 32]);
#pragma unroll
                            for (int g = 0; g < 4; ++g) { const f32x4 c4 = *(const LAS f32x4*)(cx + 8 * g);
                                p[4 * g] = c[4 * g] * (c4.x * rw); p[4 * g + 1] = c[4 * g + 1] * (c4.y * rw); p[4 * g + 2] = c[4 * g + 2] * (c4.z * rw); p[4 * g + 3] = c[4 * g + 3] * (c4.w * rw); }
                        }
                        const bf16x8 pa0 = pack8(p[0], p[1], p[2], p[3], p[4], p[5], p[6], p[7]), pa1 = pack8(p[8], p[9], p[10], p[11], p[12], p[13], p[14], p[15]);
#pragma unroll
                        for (int et = 0; et < 4; ++et) { LAS const unsigned char* vb = CHc + ((4 * eh + et) * 32 + r) * 64 + 8 * hh;
                            const u32x2 l0 = *(LAS const u32x2*)(vb + ((0 ^ swz) << 4)), h0 = *(LAS const u32x2*)(vb + ((1 ^ swz) << 4)), l1 = *(LAS const u32x2*)(vb + ((2 ^ swz) << 4)), h1 = *(LAS const u32x2*)(vb + ((3 ^ swz) << 4));
                            const bf16x8 a0 = __builtin_bit_cast(bf16x8, (u32x4){l0.x, l0.y, h0.x, h0.y}), a1 = __builtin_bit_cast(bf16x8, (u32x4){l1.x, l1.y, h1.x, h1.y});
                            acc[et] = MFMA32(a0, pa0, acc[et]); acc[et] = MFMA32(a1, pa1, acc[et]); }
                }
            }
#pragma unroll
            for (int ci = 8; ci < 16; ++ci) {
                if (ci <= 13) asm volatile("s_waitcnt vmcnt(4)" ::: "memory"); else if (ci == 14) asm volatile("s_waitcnt vmcnt(2)" ::: "memory"); else asm volatile("s_waitcnt vmcnt(0)" ::: "memory");
                lds_barrier();
                if (ci + 3 < 16) S3_DMA(ci + 3);
                LAS const unsigned char* CHc = CH + (ci & 3) * CHB;
                {
                    const int dir = (ci - 8) >> 2, dq = (ci - 8) & 3;
                    const float sc = dir ? scb : scf;
#pragma unroll
                    for (int k2 = 0; k2 < 2; ++k2) { const u32x4 qq = __builtin_bit_cast(u32x4, qf[2 * dq + k2]);
                        const bf16x8 qs = pack8(bflo(qq.x) * sc, bfhi(qq.x) * sc, bflo(qq.y) * sc, bfhi(qq.y) * sc, bflo(qq.z) * sc, bfhi(qq.z) * sc, bflo(qq.w) * sc, bfhi(qq.w) * sc);
#pragma unroll
                        for (int et = 0; et < 4; ++et) { const bf16x8 a = *(const LAS bf16x8*)(CHc + ((4 * eh + et) * 32 + r) * 64 + (((2 * k2 + hh) ^ swz) << 4)); acc[et] = MFMA32(a, qs, acc[et]); } }
                }
            }
#undef S3_DMA
            if (ps == 0) S3_LOAD_Q(1);
            u32x4 ov[8]; f32x4 g0, g1;
            { int tz = threadIdx.x; asm volatile("" : "+v"(tz)); const int pc = tz & 31, lr0 = tz >> 5;
              g0 = *(const f32x4*)(hg + h * DV + 8 * pc); g1 = *(const f32x4*)(hg + h * DV + 8 * pc + 4);
#pragma unroll
              for (int i = 0; i < 8; ++i) { const int lr = lr0 + 16 * i; const int grow = row0 + 64 * (lr >> 5) + 32 * ps + (lr & 31); ov[i] = *(const u32x4*)(P + (size_t)grow * PW + 2 * NQ + NV + h * DV + 8 * pc); } }
            float ss = 0.f;
#pragma unroll
            for (int et = 0; et < 4; ++et)
#pragma unroll
                for (int i = 0; i < 16; ++i) ss += acc[et][i] * acc[et][i];
            ss += __shfl_xor(ss, 32);
            if (hh == 0) ssx[w * 32 + r] = ss;
            lds_barrier();
            ss += ssx[(w ^ 4) * 32 + r];
            const float rs = 1.0f / sqrtf(ss * (1.0f / DV) + EPS);
            { LAS unsigned char* ob = CH + ((w & 3) * 32 + r) * OP + (eh * 128 + 4 * hh) * 2;
#pragma unroll
              for (int et = 0; et < 4; ++et)
#pragma unroll
                  for (int g = 0; g < 4; ++g) { u32x2 o; o.x = cvt2(acc[et][4 * g + 0] * rs, acc[et][4 * g + 1] * rs); o.y = cvt2(acc[et][4 * g + 2] * rs, acc[et][4 * g + 3] * rs);
                      *(LAS u32x2*)(ob + (et * 32 + 8 * g) * 2) = o; } }
            lds_barrier();
            { int tz = threadIdx.x; asm volatile("" : "+v"(tz)); const int pc = tz & 31, lr0 = tz >> 5;
#pragma unroll
              for (int i = 0; i < 8; ++i) { const int lr = lr0 + 16 * i; const int grow = row0 + 64 * (lr >> 5) + 32 * ps + (lr & 31);
                  const u32x4 hv = *(const LAS u32x4*)(CH + lr * OP + pc * 16);
                  const f32x4 o0 = (f32x4){bflo(hv.x) * g0.x * bflo(ov[i].x), bfhi(hv.x) * g0.y * bfhi(ov[i].x), bflo(hv.y) * g0.z * bflo(ov[i].y), bfhi(hv.y) * g0.w * bfhi(ov[i].y)};
                  const f32x4 o1 = (f32x4){bflo(hv.z) * g1.x * bflo(ov[i].z), bfhi(hv.z) * g1.y * bfhi(ov[i].z), bflo(hv.w) * g1.z * bflo(ov[i].w), bfhi(hv.w) * g1.w * bfhi(ov[i].w)};
                  *(u32x2*)(HM + (size_t)grow * D + h * DV + 8 * pc) = (u32x2){pack_i8(o0 * (127.0f / HMR)), pack_i8(o1 * (127.0f / HMR))}; } }
        }
        __syncthreads();
    }
#undef S3_LOAD_Q
}

#define XB_TMO      128
#define XB_XCNT(j)  (256  + 64 * (j))
#define XB_XSUB(j)  (1280 + 64 * (j))
#define XB_XGEN(j)  (2304 + 64 * (j))
#define XB_TOP      3328
#define XB_TOPGEN   3392
#define XCD_BAR_WORDS 3456
#define XB_SPIN_CAP (1u << 18)

__device__ __forceinline__ unsigned xb_ld(unsigned* p)              { return __hip_atomic_load(p, __ATOMIC_RELAXED, __HIP_MEMORY_SCOPE_AGENT); }
__device__ __forceinline__ unsigned xb_add(unsigned* p, unsigned v) { return __hip_atomic_fetch_add(p, v, __ATOMIC_RELAXED, __HIP_MEMORY_SCOPE_AGENT); }
__device__ __forceinline__ unsigned xb_xcc_id() { return (unsigned)__builtin_amdgcn_s_getreg((3 << 11) | 20) & 0xFu; }
#define XB_SPIN(cond, bar) do { unsigned _sp = 0; while (cond) { __builtin_amdgcn_s_sleep(1); \
    if ((++_sp & 255u) == 0u) { if (xb_ld(&(bar)[XB_TMO])) break; if (_sp > XB_SPIN_CAP) { atomicAdd(&(bar)[XB_TMO], 1u); break; } } } } while (0)

struct XcdBarrier {
    unsigned* bar; unsigned x;
    volatile LAS unsigned* st;
};

__device__ __forceinline__ XcdBarrier xcd_barrier_post(unsigned* bar, volatile LAS unsigned* st) {
    XcdBarrier b; b.bar = bar; b.x = xb_xcc_id(); b.st = st;
    if (threadIdx.x == 0) (void)xb_add(&bar[XB_XCNT(b.x)], 1u);
    return b;
}
__device__ __forceinline__ void xcd_barrier_complete(unsigned* bar, unsigned x, unsigned& nloc, unsigned& nx) {
    const unsigned G = gridDim.x * gridDim.y * gridDim.z;
    unsigned sum, cnt, mine, sp = 0u;
    for (;;) {
        sum = 0u; cnt = 0u; mine = 0u;
#pragma unroll
        for (unsigned j = 0; j < 16; ++j) { const unsigned c = xb_ld(&bar[XB_XCNT(j)]); sum += c; cnt += (c > 0u) ? 1u : 0u; mine = (j == x) ? c : mine; }
        if (sum == G) break;
        __builtin_amdgcn_s_sleep(1);
        if ((++sp & 255u) == 0u) { if (xb_ld(&bar[XB_TMO])) break; if (sp > XB_SPIN_CAP) { atomicAdd(&bar[XB_TMO], 1u); break; } }
    }
    nloc = mine > 0u ? mine : 1u; nx = cnt > 0u ? cnt : 1u;
}

__device__ __forceinline__ void xcd_barrier(const XcdBarrier& b) {
    asm volatile("s_waitcnt vmcnt(0)" ::: "memory");
    __syncthreads();
    if (threadIdx.x == 0) {
        unsigned* bar = b.bar;
        __builtin_amdgcn_s_waitcnt(0);
        unsigned nloc = b.st[0], nx = b.st[1];
        if (nloc == 0u) { xcd_barrier_complete(bar, b.x, nloc, nx); b.st[0] = nloc; b.st[1] = nx; }
        const unsigned old = xb_add(&bar[XB_XSUB(b.x)], 1u);
        const unsigned gen = old / nloc;
        if (old + 1u == (gen + 1u) * nloc) {
            __builtin_amdgcn_fence(__ATOMIC_RELEASE, "agent");
            asm volatile("s_waitcnt vmcnt(0)" ::: "memory");
            const unsigned og = xb_add(&bar[XB_TOP], 1u);
            const unsigned tg = og / nx;
            if (og + 1u == (tg + 1u) * nx) xb_add(&bar[XB_TOPGEN], 1u);
            else XB_SPIN(xb_ld(&bar[XB_TOPGEN]) == tg, bar);
            __builtin_amdgcn_fence(__ATOMIC_ACQUIRE, "agent");
            xb_add(&bar[XB_XGEN(b.x)], 1u);
            asm volatile("s_waitcnt vmcnt(0)" ::: "memory");
        } else {
            XB_SPIN(xb_ld(&bar[XB_XGEN(b.x)]) == gen, bar);
            __builtin_amdgcn_fence(__ATOMIC_ACQUIRE, "agent");
            asm volatile("s_waitcnt vmcnt(0)" ::: "memory");
        }
    }
    __syncthreads();
}


constexpr int LDS_BYTES = 152 * 1024;
constexpr int CW_BAR = 16384;
static_assert((CW_BAR + XCD_BAR_WORDS) * 4 <= (int)CTL_BYTES, "ctl");
#ifndef MK_MULTI
#define MK_MULTI 0
#endif
#define IN(p) (lo <= (p) && (p) < hi)
#define SEAM(p) do { if ((p) + 1 < hi) { XcdBarrier b_; b_.bar = (unsigned*)(load_args().ws + WS_CTL) + CW_BAR; b_.x = xb_xcc_id(); b_.st = (volatile LAS unsigned*)(C.lds + LDS_BYTES - 16); xcd_barrier(b_); } } while (0)
#define CAS __attribute__((address_space(4)))
__device__ __forceinline__ Args load_args() {
#if defined(__HIP_DEVICE_COMPILE__)
    const CAS Args* p = (const CAS Args*)__builtin_amdgcn_kernarg_segment_ptr(); asm volatile("" : "+s"(p));
    Args a; for (int i = 0; i < 22; ++i) a.in[i] = p->in[i]; a.out = p->out; a.ws = p->ws; a.lo = p->lo; a.hi = p->hi; return a;
#else
    return Args{};
#endif
}
__device__ __forceinline__ Ctx fresh(const Ctx& C) { Ctx R = C; int tz = threadIdx.x; asm volatile("" : "+v"(tz)); R.tid = tz; R.lane = tz & 63; return R; }
template <int L> __device__ __forceinline__ void layer_phases(const Args& args, const Ctx& C, int bar, int lo, int hi) {
    constexpr int pb = 16 * L;
    if (IN(pb + 1)) { phase_r1(load_args(), fresh(C), L); SEAM(pb + 1); }
    if (IN(pb + 2)) { phase_g1(load_args(), fresh(C), L); SEAM(pb + 2); }
    if constexpr ((L & 1) == 0) {
        if (IN(pb + 3)) { phase_s1(load_args(), fresh(C), L); SEAM(pb + 3); }
        if (IN(pb + 4)) { phase_s2(load_args(), fresh(C)); SEAM(pb + 4); }
        if (IN(pb + 5)) { phase_s3(load_args(), fresh(C), L); SEAM(pb + 5); }
    } else {
        if (IN(pb + 3)) { phase_conv(load_args(), fresh(C), L); SEAM(pb + 3); }
    }
    if (IN(pb + 6)) { phase_g2(load_args(), fresh(C), L); SEAM(pb + 6); }
    if (IN(pb + 7)) { phase_r2(load_args(), fresh(C), L); SEAM(pb + 7); }
    if (IN(pb + 8)) { phase_m1(load_args(), fresh(C), L); SEAM(pb + 8); }
    if (IN(pb + 9)) { phase_m2(load_args(), fresh(C), L); SEAM(pb + 9); }
}
__global__ void __launch_bounds__(NT, 2) fwd_kernel(Args args) {
    extern __shared__ __attribute__((aligned(16))) unsigned char lds_raw[];
    Ctx C; C.lds = (LAS unsigned char*)lds_raw; C.tid = threadIdx.x; C.lane = C.tid & 63; C.wave = __builtin_amdgcn_readfirstlane(C.tid >> 6); C.G = gridDim.x; C.bid = blockIdx.x; C.a = &args;
    const int lo = args.lo, hi = args.hi;
    volatile LAS unsigned* xbw = (volatile LAS unsigned*)(C.lds + LDS_BYTES - 16);
    if (C.tid < 4) xbw[C.tid] = 0u;
    __syncthreads();
    if (hi - lo > 1) (void)xcd_barrier_post((unsigned*)(args.ws + WS_CTL) + CW_BAR, xbw);
    const int bar = 0; (void)bar;
    if (IN(0)) { phase_mod(load_args(), fresh(C)); __syncthreads(); phase_cvt_mixer(load_args(), fresh(C)); SEAM(0); }
    layer_phases<0>(args, C, bar, lo, hi);
    layer_phases<1>(args, C, bar, lo, hi);
    layer_phases<2>(args, C, bar, lo, hi);
    layer_phases<3>(args, C, bar, lo, hi);
    if (IN(64)) phase_final(load_args(), fresh(C));
}
#undef IN
#undef SEAM

extern "C" void kernel_launch(void* const* d_in, const int* in_sizes, int n_in, void* d_out, int out_size, void* d_ws, size_t ws_size, hipStream_t stream) {
    static int grid = 0;
    if (grid == 0) {
        if (n_in != 22 || out_size != NL * D || ws_size < WS_END) { fprintf(stderr, "kernel_launch: unexpected shapes (n_in %d out %d ws %zu)\n", n_in, out_size, ws_size); grid = -1; return; }
        int dev = 0, cus = 0, per_cu = 0;
        if (hipGetDevice(&dev) != hipSuccess || hipDeviceGetAttribute(&cus, hipDeviceAttributeMultiprocessorCount, dev) != hipSuccess) { grid = -1; return; }
        if (hipFuncSetAttribute((const void*)fwd_kernel, hipFuncAttributeMaxDynamicSharedMemorySize, LDS_BYTES) != hipSuccess) { grid = -1; return; }
        if (hipOccupancyMaxActiveBlocksPerMultiprocessor(&per_cu, (const void*)fwd_kernel, NT, LDS_BYTES) != hipSuccess || per_cu < 1) { fprintf(stderr, "kernel_launch: occupancy query says %d\n", per_cu); }
        (void)hipGetLastError();
        grid = cus;
    }
    if (grid < 0) return;
    (void)hipMemsetAsync((char*)d_ws + WS_CTL, 0, CTL_BYTES, stream);
    Args a{};
    for (int i = 0; i < 22; ++i) a.in[i] = (const float*)d_in[i];
    a.out = (float*)d_out; a.ws = (unsigned char*)d_ws;
#if MK_MULTI
    int phases[64]; int np = 0;
    phases[np++] = 0;
    for (int l = 0; l < DEPTH; ++l) { const int pb = 16 * l; phases[np++] = pb + 1; phases[np++] = pb + 2; phases[np++] = pb + 3;
        if ((l & 1) == 0) { phases[np++] = pb + 4; phases[np++] = pb + 5; }
        phases[np++] = pb + 6; phases[np++] = pb + 7; phases[np++] = pb + 8; phases[np++] = pb + 9; }
    phases[np++] = 64;
    for (int i = 0; i < np; ++i) { a.lo = phases[i]; a.hi = phases[i] + 1; hipLaunchKernelGGL(fwd_kernel, dim3(grid), dim3(NT), LDS_BYTES, stream, a); }
#else
    a.lo = 0; a.hi = 65;
    hipLaunchKernelGGL(fwd_kernel, dim3(grid), dim3(NT), LDS_BYTES, stream, a);
#ifdef PROBE_PHASES
    { const int pp[] = {PROBE_PHASES};
      for (int rep = 0; rep < PROBE_REPS; ++rep) for (unsigned i = 0; i < sizeof(pp) / sizeof(pp[0]); ++i) { a.lo = pp[i]; a.hi = pp[i] + 1; hipLaunchKernelGGL(fwd_kernel, dim3(grid), dim3(NT), LDS_BYTES, stream, a); } }
#endif
#endif
}
```

```cpp
#include <hip/hip_runtime.h>
#include <cstdio>
#include <cstdint>

#define LAS __attribute__((address_space(3)))
typedef unsigned short bf16;
typedef float f32x4 __attribute__((ext_vector_type(4)));
typedef unsigned u32x4 __attribute__((ext_vector_type(4)));
typedef unsigned u32x2 __attribute__((ext_vector_type(2)));
typedef int i32x4r __attribute__((ext_vector_type(4)));

constexpr int D = 1024, BATCH = 2, SEQ = 16384, DEPTH = 4, CTXL = 256;
constexpr int NL = BATCH * SEQ, NCX = BATCH * CTXL, NR = NL + NCX;
constexpr int NH = 4, DQK = 128, DV = 256, NQ = 512, NV = 1024, PROJ = 3088, PW = 3072;
constexpr int NGRP = 4, EPG = 8, NE = 32, DE = 512;
constexpr int NBLK = 65;
constexpr int NUNIT = BATCH * NH * NBLK;
constexpr int CAP = NR;
constexpr int YROWS = 74752;
constexpr float EPS = 1e-6f;
constexpr float WSCALE = 32.0f;
constexpr float YSCALE = 4.0f;
constexpr int NT = 512, NW = 8;
constexpr int LDS_TAB_END = 152 * 1024 - 16;

constexpr size_t MiB = 1u << 20;
constexpr size_t WS_CTL = 0, CTL_BYTES = 1 * MiB;
constexpr size_t WS_MOD = 1 * MiB;
constexpr size_t WS_GATE = 2 * MiB;
constexpr size_t WS_TOKSLOT = 5 * MiB;
constexpr size_t WS_TOKW = 6 * MiB;
constexpr size_t WS_SLOTTOK = 7 * MiB;
constexpr size_t WS_DN = 12 * MiB;
constexpr size_t WS_NST = 13 * MiB;
constexpr size_t WS_BTOT = 14 * MiB;
constexpr size_t WS_RSC = 15 * MiB;
constexpr size_t WS_LAT = 16 * MiB;
constexpr size_t WS_HB = 146 * MiB;
constexpr size_t WS_PB = 211 * MiB;
constexpr size_t WS_HM = 406 * MiB;
constexpr size_t WS_DC = 471 * MiB;
constexpr size_t WS_CST = 601 * MiB;
constexpr size_t WS_VT = 666 * MiB;
constexpr size_t WS_WAIN = 731 * MiB;
constexpr size_t WS_WBIN = 743 * MiB;
constexpr size_t WS_WAOUT = 755 * MiB;
constexpr size_t WS_WBOUT = 759 * MiB;
constexpr size_t WS_WGU = 763 * MiB;
constexpr size_t WS_WDN = 827 * MiB;
constexpr size_t WS_H8 = 843 * MiB;
constexpr size_t WS_END = 880 * MiB;
constexpr int CW_WMAX = 256;
constexpr int CW_CNT = 1024, CNT_STRIDE = 64;

struct Args { const float* in[22]; float* out; unsigned char* ws; int lo, hi; };

typedef short bf16x8 __attribute__((ext_vector_type(8)));
typedef float f32x2 __attribute__((ext_vector_type(2)));
typedef __bf16 bf16x2_t __attribute__((ext_vector_type(2)));
__device__ __forceinline__ unsigned cvt2(float lo, float hi) { const f32x2 v = {lo, hi}; return __builtin_bit_cast(unsigned, __builtin_convertvector(v, bf16x2_t)); }
__device__ __forceinline__ float bf2f(bf16 v) { return __uint_as_float(((unsigned)v) << 16); }
__device__ __forceinline__ unsigned f2bf(float f) { unsigned u = __float_as_uint(f); return (u + 0x7fffu + ((u >> 16) & 1u)) >> 16; }
__device__ __forceinline__ unsigned pk2(float lo, float hi) { return f2bf(lo) | (f2bf(hi) << 16); }
template <int CTRL, int ROWMASK> __device__ __forceinline__ float dpp_mov(float x) { return __int_as_float(__builtin_amdgcn_update_dpp(0, __float_as_int(x), CTRL, ROWMASK, 0xf, false)); }
__device__ __forceinline__ float wave_sum(float v) {
    v += dpp_mov<0xB1, 0xf>(v); v += dpp_mov<0x4E, 0xf>(v); v += dpp_mov<0x141, 0xf>(v); v += dpp_mov<0x140, 0xf>(v);
    v += dpp_mov<0x142, 0xA>(v); v += dpp_mov<0x143, 0xC>(v);
    return __int_as_float(__builtin_amdgcn_readlane(__float_as_int(v), 63));
}
__device__ __forceinline__ float wave_max_nn(float v) {
    v = fmaxf(v, dpp_mov<0xB1, 0xf>(v)); v = fmaxf(v, dpp_mov<0x4E, 0xf>(v)); v = fmaxf(v, dpp_mov<0x141, 0xf>(v)); v = fmaxf(v, dpp_mov<0x140, 0xf>(v));
    v = fmaxf(v, dpp_mov<0x142, 0xA>(v)); v = fmaxf(v, dpp_mov<0x143, 0xC>(v));
    return __int_as_float(__builtin_amdgcn_readlane(__float_as_int(v), 63));
}
__device__ __forceinline__ unsigned pack_i8(f32x4 v) {
    const int a = (int)__builtin_rintf(fminf(fmaxf(v.x, -127.f), 127.f)), b = (int)__builtin_rintf(fminf(fmaxf(v.y, -127.f), 127.f)), c = (int)__builtin_rintf(fminf(fmaxf(v.z, -127.f), 127.f)), d = (int)__builtin_rintf(fminf(fmaxf(v.w, -127.f), 127.f));
    return (unsigned)(a & 255) | ((unsigned)(b & 255) << 8) | ((unsigned)(c & 255) << 16) | ((unsigned)d << 24);
}
__device__ __forceinline__ float sigmoidf_(float x) { return 1.f / (1.f + __expf(-x)); }
__device__ __forceinline__ float siluf_(float x) { return x / (1.f + __expf(-x)); }
__device__ __forceinline__ float logsigmoidf_(float x) { return fminf(x, 0.f) - log1pf(__expf(-fabsf(x))); }
__device__ __forceinline__ int blk_row0(int b, int blk) { return blk == 0 ? NL + b * CTXL : b * SEQ + (blk - 1) * 256; }
__device__ __forceinline__ int mod_vec_of_row(int row) { return row < NL ? row / SEQ : 2; }

struct Ctx {
    LAS unsigned char* lds; int tid, lane, wave, G, bid;
    const Args* a;
};

__device__ __forceinline__ int expert_block_prefix(const unsigned* cnt, int lane, int& nb) {
    nb = lane < NE ? ((int)cnt[lane * CNT_STRIDE] + 255) / 256 : 0; int v = nb;
#pragma unroll
    for (int o = 1; o < 64; o <<= 1) { const int t = __shfl_up(v, o); v += (lane >= o) ? t : 0; }
    return v - nb;
}
__device__ __forceinline__ void slot_bases(const Args& A, int l, LAS int* sb, int tid) {
    if (tid < 64) { int nb; const int ex = expert_block_prefix((const unsigned*)(A.ws + WS_CTL) + CW_CNT + l * 32 * CNT_STRIDE, tid, nb); if (tid <= NE) sb[tid] = ex * 256; }
    __syncthreads();
}

__device__ __forceinline__ void phase_mod(const Args& A, const Ctx& C) {
    LAS float* sc = (LAS float*)C.lds;
    LAS float* red = sc + 3072;
    const float* c = A.in[1]; const float* cc = A.in[3];
    for (int i = C.tid; i < 3072; i += NT) { const float v = i < 2048 ? c[i] : cc[i - 2048]; sc[i] = siluf_(v); }
    __syncthreads();
    float* MOD = (float*)(A.ws + WS_MOD);
    for (int u = C.bid; u < DEPTH * 96; u += C.G) {
        const int l = u / 96, cg = u % 96, col = cg * 64 + C.lane;
        const float* w = A.in[4] + (size_t)l * D * 6 * D + col;
        float a0 = 0.f, a1 = 0.f, a2 = 0.f;
#pragma unroll 32
        for (int k = C.wave * 128; k < C.wave * 128 + 128; ++k) { const float wv = w[(size_t)k * 6 * D]; a0 += sc[k] * wv; a1 += sc[1024 + k] * wv; a2 += sc[2048 + k] * wv; }
        red[(C.wave * 3 + 0) * 64 + C.lane] = a0; red[(C.wave * 3 + 1) * 64 + C.lane] = a1; red[(C.wave * 3 + 2) * 64 + C.lane] = a2;
        __syncthreads();
        if (C.tid < 192) { const int v = C.tid / 64, ln = C.tid % 64; float s = 0.f;
            for (int w8 = 0; w8 < 8; ++w8) s += red[(w8 * 3 + v) * 64 + ln];
            MOD[(size_t)(l * 3 + v) * 6 * D + cg * 64 + ln] = s + A.in[5][(size_t)l * 6 * D + cg * 64 + ln]; }
        __syncthreads();
    }
}

__device__ __forceinline__ void load_row_f32(const float* p, int lane, f32x4 (&v)[4]) {
#pragma unroll
    for (int j = 0; j < 4; ++j) v[j] = *(const f32x4*)(p + 4 * lane + 256 * j);
}
__device__ __forceinline__ void load_row_bf16(const bf16* p, int lane, f32x4 (&v)[4]) {
#pragma unroll
    for (int j = 0; j < 4; ++j) { const u32x2 w = *(const u32x2*)(p + 4 * lane + 256 * j);
        v[j] = (f32x4){__uint_as_float(w.x << 16), __uint_as_float(w.x & 0xffff0000u), __uint_as_float(w.y << 16), __uint_as_float(w.y & 0xffff0000u)}; }
}
__device__ __forceinline__ void store_row_bf16(bf16* p, int lane, const f32x4 (&v)[4]) {
#pragma unroll
    for (int j = 0; j < 4; ++j) { u32x2 w; w.x = pk2(v[j].x, v[j].y); w.y = pk2(v[j].z, v[j].w); *(u32x2*)(p + 4 * lane + 256 * j) = w; }
}
constexpr int CVT_IG = (D / 64) * (DE / 32), CVT_ID = (DE / 64) * (D / 32), CVT_PER = 2 * CVT_IG + CVT_ID, CVT_ITEMS = NE * CVT_PER;
constexpr int CVT_Q = 24;
__device__ __forceinline__ void cvt_moe_items(const Args& A, const Ctx& C, int l, int it0, int end, int stride);
__device__ __forceinline__ void cvt_win_i8(const Args& A, const Ctx& C);
__device__ __forceinline__ int cvt_t2(int l, int G);
struct RowVec { f32x4 a[4], s[4], g[4]; };
__device__ __forceinline__ void load_rowvec(RowVec& R, const float* ng, const float* sh, const float* sc, const float* gt, int lane) {
    f32x4 n[4], c[4]; load_row_f32(ng, lane, n); load_row_f32(sc, lane, c); load_row_f32(sh, lane, R.s); if (gt) load_row_f32(gt, lane, R.g);
#pragma unroll
    for (int q = 0; q < 4; ++q) R.a[q] = n[q] * (1.f + c[q]);
}
__device__ __forceinline__ void load_row_bf16raw(const bf16* p, int lane, u32x2 (&v)[4]) {
#pragma unroll
    for (int j = 0; j < 4; ++j) v[j] = *(const u32x2*)(p + 4 * lane + 256 * j);
}
__device__ __forceinline__ void store_row_fp8(unsigned char* p, int lane, const f32x4 (&v)[4]) {
#pragma unroll
    for (int j = 0; j < 4; ++j) { int w = 0; w = __builtin_amdgcn_cvt_pk_fp8_f32(v[j].x, v[j].y, w, false); w = __builtin_amdgcn_cvt_pk_fp8_f32(v[j].z, v[j].w, w, true); *(unsigned*)(p + 4 * lane + 256 * j) = (unsigned)w; }
}
__device__ __forceinline__ void load_row_fp8raw(const unsigned char* p, int lane, unsigned (&v)[4]) {
#pragma unroll
    for (int j = 0; j < 4; ++j) v[j] = *(const unsigned*)(p + 4 * lane + 256 * j);
}
__device__ __forceinline__ f32x4 fp8x4(unsigned w) { const f32x2 lo = __builtin_amdgcn_cvt_pk_f32_fp8((int)w, false), hi = __builtin_amdgcn_cvt_pk_f32_fp8((int)w, true); return (f32x4){lo.x, lo.y, hi.x, hi.y}; }
__device__ __forceinline__ f32x4 bf4(u32x2 w) { return (f32x4){__uint_as_float(w.x << 16), __uint_as_float(w.x & 0xffff0000u), __uint_as_float(w.y << 16), __uint_as_float(w.y & 0xffff0000u)}; }
__device__ __forceinline__ float row_rstd(const f32x4 (&v)[4]) {
    float s = 0.f;
#pragma unroll
    for (int j = 0; j < 4; ++j) s += (v[j].x * v[j].x + v[j].y * v[j].y) + (v[j].z * v[j].z + v[j].w * v[j].w);
    return 1.0f / sqrtf(wave_sum(s) * (1.f / D) + EPS);
}

__device__ __forceinline__ void phase_r1(const Args& A, const Ctx& C, int l) {
    LAS int* sb = (LAS int*)C.lds;
    LAS float* GW = (LAS float*)(C.lds + 256);
    const bool mls = (l & 1) == 0; const int j = l >> 1;
    if (l == 0) { cvt_win_i8(A, C); __syncthreads(); }
    if (l > 0) slot_bases(A, l - 1, sb, C.tid);
    if (mls) { const float* w = A.in[8] + (size_t)j * D * PROJ + PW;
        f32x4 t[2][4];
#pragma unroll
        for (int jj = 0; jj < 2; ++jj)
#pragma unroll
            for (int q = 0; q < 4; ++q) t[jj][q] = *(const f32x4*)(w + (size_t)(C.tid + NT * jj) * PROJ + 4 * q);
#pragma unroll
        for (int jj = 0; jj < 2; ++jj)
#pragma unroll
            for (int q = 0; q < 4; ++q) { const int k = C.tid + NT * jj; GW[(4 * q + 0) * D + k] = t[jj][q].x; GW[(4 * q + 1) * D + k] = t[jj][q].y; GW[(4 * q + 2) * D + k] = t[jj][q].z; GW[(4 * q + 3) * D + k] = t[jj][q].w; }
        __syncthreads(); }
    const int nrows = (l <= 2) ? NR : NL;
    bf16* LAT = (bf16*)(A.ws + WS_LAT); unsigned char* HI8 = A.ws + WS_H8; float* RSC = (float*)(A.ws + WS_RSC); float* GATE = (float*)(A.ws + WS_GATE);
    const float* MOD = (const float*)(A.ws + WS_MOD); const unsigned char* Y8 = A.ws + WS_PB;
    const int* TS = (const int*)(A.ws + WS_TOKSLOT); const float* TW = (const float*)(A.ws + WS_TOKW);
    const int rpw = (((nrows + C.G - 1) / C.G) + 1) & ~1; const int wrow0 = C.bid * rpw; const int wend = min(wrow0 + rpw, nrows);
    for (int sa = wrow0; sa < wend;) {
        const int mvi = mod_vec_of_row(sa); const int bnd = mvi == 0 ? SEQ : (mvi == 1 ? NL : NR); const int sbnd = min(wend, bnd);
        RowVec RV; { const float* mv = MOD + (size_t)(l * 3 + mvi) * 6 * D;
            load_rowvec(RV, A.in[6] + (size_t)(l * 2 + 0) * D, mv + 0 * D, mv + 1 * D, l > 0 ? MOD + (size_t)((l - 1) * 3 + mvi) * 6 * D + 5 * D : nullptr, C.lane); }
        const int rlast = sbnd - 2;
        i32x4r tsn = (i32x4r){0, 0, 0, 0}; f32x4 twn = (f32x4){0.f, 0.f, 0.f, 0.f};
        if (l > 0) { const int r0 = min(sa + 2 * C.wave, rlast); tsn = *(const i32x4r*)(TS + r0 * 2); twn = *(const f32x4*)(TW + r0 * 2); }
        for (int ra = sa + 2 * C.wave; ra < sbnd; ra += 2 * NW) {
            const bool hasb = true; const int rb = ra + 1;
            const i32x4r tsc = tsn; const f32x4 twc = twn;
            if (l > 0) { const int r1 = min(ra + 2 * NW, rlast); tsn = *(const i32x4r*)(TS + r1 * 2); twn = *(const f32x4*)(TW + r1 * 2); }
            f32x4 va[4], vb[4]; float wa0 = 0.f, wa1 = 0.f, wb0 = 0.f, wb1 = 0.f;
            if (l == 0) { load_row_f32(ra < NL ? A.in[0] + (size_t)ra * D : A.in[2] + (size_t)(ra - NL) * D, C.lane, va); load_row_f32(rb < NL ? A.in[0] + (size_t)rb * D : A.in[2] + (size_t)(rb - NL) * D, C.lane, vb); }
            else {
                const int ta0 = tsc.x, ta1 = tsc.y, tb0 = tsc.z, tb1 = tsc.w; wa0 = twc.x; wa1 = twc.y; wb0 = twc.z; wb1 = twc.w;
                load_row_bf16(LAT + (size_t)ra * D, C.lane, va); load_row_bf16(LAT + (size_t)rb * D, C.lane, vb);
                unsigned ya0[4], ya1[4], yb0[4], yb1[4];
                load_row_fp8raw(Y8 + (size_t)(sb[ta0 >> 20] + (ta0 & 0xfffff)) * D, C.lane, ya0); load_row_fp8raw(Y8 + (size_t)(sb[ta1 >> 20] + (ta1 & 0xfffff)) * D, C.lane, ya1);
                load_row_fp8raw(Y8 + (size_t)(sb[tb0 >> 20] + (tb0 & 0xfffff)) * D, C.lane, yb0); load_row_fp8raw(Y8 + (size_t)(sb[tb1 >> 20] + (tb1 & 0xfffff)) * D, C.lane, yb1);
                wa0 *= 1.0f / YSCALE; wa1 *= 1.0f / YSCALE; wb0 *= 1.0f / YSCALE; wb1 *= 1.0f / YSCALE;
#pragma unroll
                for (int q = 0; q < 4; ++q) { va[q] += RV.g[q] * (fp8x4(ya0[q]) * wa0 + fp8x4(ya1[q]) * wa1); vb[q] += RV.g[q] * (fp8x4(yb0[q]) * wb0 + fp8x4(yb1[q]) * wb1); }
            }
            store_row_bf16(LAT + (size_t)ra * D, C.lane, va); if (hasb) store_row_bf16(LAT + (size_t)rb * D, C.lane, vb);
            const float rra = row_rstd(va), rrb = row_rstd(vb);
            f32x4 ha[4], hb[4];
#pragma unroll
            for (int q = 0; q < 4; ++q) { ha[q] = (va[q] * rra) * RV.a[q] + RV.s[q]; hb[q] = (vb[q] * rrb) * RV.a[q] + RV.s[q]; }
            { float ma = 0.f, mb = 0.f;
#pragma unroll
              for (int q = 0; q < 4; ++q) { ma = fmaxf(ma, fmaxf(fmaxf(fabsf(ha[q].x), fabsf(ha[q].y)), fmaxf(fabsf(ha[q].z), fabsf(ha[q].w)))); mb = fmaxf(mb, fmaxf(fmaxf(fabsf(hb[q].x), fabsf(hb[q].y)), fmaxf(fabsf(hb[q].z), fabsf(hb[q].w)))); }
              ma = fmaxf(wave_max_nn(ma), 1.0e-20f); mb = fmaxf(wave_max_nn(mb), 1.0e-20f);
              const float ia = 127.0f / ma, ib = 127.0f / mb;
#pragma unroll
              for (int q = 0; q < 4; ++q) { *(unsigned*)(HI8 + (size_t)ra * D + 4 * C.lane + 256 * q) = pack_i8(ha[q] * ia); *(unsigned*)(HI8 + (size_t)rb * D + 4 * C.lane + 256 * q) = pack_i8(hb[q] * ib); }
              if (C.lane == 0) { RSC[ra] = ma * (1.0f / 127.0f); RSC[rb] = mb * (1.0f / 127.0f); } }
            if (mls) {
                float ga = 0.f, gb = 0.f;
#pragma unroll 2
                for (int c = 0; c < 16; ++c) { float s0 = 0.f, s1 = 0.f;
#pragma unroll
                    for (int q = 0; q < 4; ++q) { const f32x4 w = *(const LAS f32x4*)(GW + c * D + 4 * C.lane + 256 * q);
                        s0 += (ha[q].x * w.x + ha[q].y * w.y) + (ha[q].z * w.z + ha[q].w * w.w); s1 += (hb[q].x * w.x + hb[q].y * w.y) + (hb[q].z * w.z + hb[q].w * w.w); }
                    s0 = wave_sum(s0); s1 = wave_sum(s1); ga = (C.lane == c) ? s0 : ga; gb = (C.lane == c) ? s1 : gb; }
                if (C.lane < 16) {
                    const float bgt = A.in[9][j * 16 + C.lane]; const int gtype = C.lane >> 2;
                    ga += bgt; gb += bgt;
                    GATE[(size_t)ra * 16 + C.lane] = (gtype & 1) ? logsigmoidf_(ga) : 15.0f * tanhf(ga * (1.0f / 15.0f));
                    if (hasb) GATE[(size_t)rb * 16 + C.lane] = (gtype & 1) ? logsigmoidf_(gb) : 15.0f * tanhf(gb * (1.0f / 15.0f)); }
            }
        }
        sa = sbnd;
    }
}

__device__ __forceinline__ void phase_r2(const Args& A, const Ctx& C, int l) {
    constexpr int WP = 2064;
    LAS unsigned char* RWB = C.lds;
    LAS float* WL = (LAS float*)(C.lds + 48 * WP);
    LAS unsigned* hist = (LAS unsigned*)(WL + 8 * 16 * 48);
    LAS unsigned* gbase = hist + 32;
    constexpr int RCAP = 144;
    LAS int* rec = (LAS int*)(gbase + 32);
    static_assert(48 * WP + 8 * 16 * 48 * 4 + 256 + RCAP * 16 <= LDS_TAB_END, "R2 LDS map");
    cvt_moe_items(A, C, l, cvt_t2(l, C.G) + C.bid * NW + C.wave, CVT_ITEMS, C.G * NW);
    __syncthreads();
    { const float* wg = A.in[15] + (size_t)l * D * NGRP; const float* wr = A.in[17] + (size_t)l * D * NE;
      { const int kp = C.tid; const f32x4 x0 = *(const f32x4*)(wg + (size_t)(2 * kp) * 4), x1 = *(const f32x4*)(wg + (size_t)(2 * kp + 1) * 4);
        *(LAS unsigned*)(RWB + 0 * WP + kp * 4) = cvt2(x0.x, x1.x); *(LAS unsigned*)(RWB + 1 * WP + kp * 4) = cvt2(x0.y, x1.y);
        *(LAS unsigned*)(RWB + 2 * WP + kp * 4) = cvt2(x0.z, x1.z); *(LAS unsigned*)(RWB + 3 * WP + kp * 4) = cvt2(x0.w, x1.w); }
      f32x4 t0[8], t1[8];
#pragma unroll
      for (int jj = 0; jj < 8; ++jj) { const int it = C.tid + NT * jj, kp = it >> 3, cg = it & 7; t0[jj] = *(const f32x4*)(wr + (size_t)(2 * kp) * NE + 4 * cg); t1[jj] = *(const f32x4*)(wr + (size_t)(2 * kp + 1) * NE + 4 * cg); }
#pragma unroll
      for (int jj = 0; jj < 8; ++jj) { const int it = C.tid + NT * jj, kp = it >> 3, c0 = 4 + 4 * (it & 7);
          *(LAS unsigned*)(RWB + (c0 + 0) * WP + kp * 4) = cvt2(t0[jj].x, t1[jj].x); *(LAS unsigned*)(RWB + (c0 + 1) * WP + kp * 4) = cvt2(t0[jj].y, t1[jj].y);
          *(LAS unsigned*)(RWB + (c0 + 2) * WP + kp * 4) = cvt2(t0[jj].z, t1[jj].z); *(LAS unsigned*)(RWB + (c0 + 3) * WP + kp * 4) = cvt2(t0[jj].w, t1[jj].w); }
      for (int i = C.tid; i < 12 * 512; i += NT) *(LAS unsigned*)(RWB + (36 + i / 512) * WP + (i % 512) * 4) = 0u; }
    const int nrows = (l <= 1) ? NR : NL;
    bf16* LAT = (bf16*)(A.ws + WS_LAT); bf16* H = (bf16*)(A.ws + WS_HB); unsigned char* H8 = A.ws + WS_H8;
    const float* MOD = (const float*)(A.ws + WS_MOD);
    unsigned* cnt = (unsigned*)(A.ws + WS_CTL) + CW_CNT + l * 32 * CNT_STRIDE;
    int* TS = (int*)(A.ws + WS_TOKSLOT); float* TW = (float*)(A.ws + WS_TOKW); int* ST = (int*)(A.ws + WS_SLOTTOK);
    const int rpw = (((nrows + C.G - 1) / C.G) + 1) & ~1; const int wrow0 = C.bid * rpw; const int wend0 = min(wrow0 + rpw, nrows);
    const float* bg = A.in[16] + l * NGRP; const float* br = A.in[18] + l * NE;
    for (int cb = wrow0; cb < wend0; cb += RCAP) {
        const int wend = min(cb + RCAP, wend0);
        if (C.tid < 32) hist[C.tid] = 0u;
        for (int sa = cb; sa < wend;) {
            const int mvi = mod_vec_of_row(sa); const int bnd = mvi == 0 ? SEQ : (mvi == 1 ? NL : NR); const int sbnd = min(wend, bnd);
            RowVec RV; { const float* mv = MOD + (size_t)(l * 3 + mvi) * 6 * D; load_rowvec(RV, A.in[6] + (size_t)(l * 2 + 1) * D, mv + 3 * D, mv + 4 * D, mv + 2 * D, C.lane); }
            const int rlast = sbnd - 2;
            u32x2 la[4], lb[4], ya[4], yb[4];
            { const int r0 = min(sa + 2 * C.wave, rlast); load_row_bf16raw(LAT + (size_t)r0 * D, C.lane, la); load_row_bf16raw(LAT + (size_t)(r0 + 1) * D, C.lane, lb);
              load_row_bf16raw(H + (size_t)r0 * D, C.lane, ya); load_row_bf16raw(H + (size_t)(r0 + 1) * D, C.lane, yb); }
            for (int ra = sa + 2 * C.wave; ra < sbnd; ra += 2 * NW) {
                const int rb = ra + 1;
                u32x2 lan[4], lbn[4], yan[4], ybn[4];
                { const int r1 = min(ra + 2 * NW, rlast); load_row_bf16raw(LAT + (size_t)r1 * D, C.lane, lan); load_row_bf16raw(LAT + (size_t)(r1 + 1) * D, C.lane, lbn);
                  load_row_bf16raw(H + (size_t)r1 * D, C.lane, yan); load_row_bf16raw(H + (size_t)(r1 + 1) * D, C.lane, ybn); }
                f32x4 va[4], vb[4];
#pragma unroll
                for (int q = 0; q < 4; ++q) { va[q] = bf4(la[q]) + RV.g[q] * bf4(ya[q]); vb[q] = bf4(lb[q]) + RV.g[q] * bf4(yb[q]); }
                store_row_bf16(LAT + (size_t)ra * D, C.lane, va); store_row_bf16(LAT + (size_t)rb * D, C.lane, vb);
                const float rra = row_rstd(va), rrb = row_rstd(vb);
                f32x4 ha[4], hb[4];
#pragma unroll
                for (int q = 0; q < 4; ++q) { ha[q] = (va[q] * rra) * RV.a[q] + RV.s[q]; hb[q] = (vb[q] * rrb) * RV.a[q] + RV.s[q]; }
                store_row_bf16(H + (size_t)ra * D, C.lane, ha); store_row_bf16(H + (size_t)rb * D, C.lane, hb);
                store_row_fp8(H8 + (size_t)ra * D, C.lane, ha); store_row_fp8(H8 + (size_t)rb * D, C.lane, hb);
#pragma unroll
                for (int q = 0; q < 4; ++q) { la[q] = lan[q]; lb[q] = lbn[q]; ya[q] = yan[q]; yb[q] = ybn[q]; }
            }
            sa = sbnd;
        }
        __syncthreads();
        const int fr = C.lane & 15, fq = C.lane >> 4;
        for (int t = C.wave; t * 16 < wend - cb; t += NW) {
            const int trow = min(cb + 16 * t + fr, wend - 1);
            const bf16* hp = H + (size_t)trow * D + 8 * fq;
            f32x4 acc[3];
#pragma unroll
            for (int ct = 0; ct < 3; ++ct) acc[ct] = (f32x4){0.f, 0.f, 0.f, 0.f};
#pragma unroll 1
            for (int kb = 0; kb < 4; ++kb) {
                bf16x8 av[8];
#pragma unroll
                for (int k8 = 0; k8 < 8; ++k8) av[k8] = *(const bf16x8*)(hp + 32 * (8 * kb + k8));
#pragma unroll
                for (int k8 = 0; k8 < 8; ++k8)
#pragma unroll
                    for (int ct = 0; ct < 3; ++ct) { const bf16x8 bv = *(const LAS bf16x8*)(RWB + (ct * 16 + fr) * WP + (32 * (8 * kb + k8) + 8 * fq) * 2);
                        acc[ct] = __builtin_amdgcn_mfma_f32_16x16x32_bf16(av[k8], bv, acc[ct], 0, 0, 0); }
            }
            LAS float* wl = WL + C.wave * 16 * 48;
#pragma unroll
            for (int ct = 0; ct < 3; ++ct)
#pragma unroll
                for (int jq = 0; jq < 4; ++jq) wl[(4 * fq + jq) * 48 + ct * 16 + fr] = acc[ct][jq];
            asm volatile("s_waitcnt lgkmcnt(0)" ::: "memory");
            const int row = cb + 16 * t + C.lane;
            if (C.lane < 16 && row < wend) {
                LAS const float* wm = wl + C.lane * 48;
                float lg[36];
#pragma unroll
                for (int c = 0; c < 36; ++c) lg[c] = wm[c];
                float gl[4]; int grp = 0; float gm = -3.0e38f;
#pragma unroll
                for (int c = 0; c < 4; ++c) { gl[c] = lg[c] + bg[c]; if (gl[c] > gm) { gm = gl[c]; grp = c; } }
                float gs = 0.f;
#pragma unroll
                for (int c = 0; c < 4; ++c) gs += __expf(gl[c] - gm);
                const float pgrp = 1.0f / gs;
                float rl[8];
#pragma unroll
                for (int i = 0; i < 8; ++i) { float tt = 0.f;
#pragma unroll
                    for (int g = 0; g < 4; ++g) tt = (g == grp) ? lg[4 + g * 8 + i] : tt;
                    rl[i] = tt + br[grp * 8 + i]; }
                int i0 = 0; float m0 = rl[0];
#pragma unroll
                for (int i = 1; i < 8; ++i) if (rl[i] > m0) { m0 = rl[i]; i0 = i; }
                int i1 = -1; float m1 = -3.0e38f;
#pragma unroll
                for (int i = 0; i < 8; ++i) if (i != i0 && rl[i] > m1) { m1 = rl[i]; i1 = i; }
                const float p0 = 1.0f, p1 = __expf(m1 - m0);
                const float w0 = pgrp * p0 / (p0 + p1), w1 = pgrp * p1 / (p0 + p1);
                const int e0 = grp * 8 + i0, e1 = grp * 8 + i1;
                const unsigned q0 = __hip_atomic_fetch_add(hist + e0, 1u, __ATOMIC_RELAXED, __HIP_MEMORY_SCOPE_WORKGROUP), q1 = __hip_atomic_fetch_add(hist + e1, 1u, __ATOMIC_RELAXED, __HIP_MEMORY_SCOPE_WORKGROUP);
                const int li = row - cb;
                rec[li * 4 + 0] = e0 | (e1 << 8); rec[li * 4 + 1] = (int)q0; rec[li * 4 + 2] = (int)q1;
                TW[row * 2 + 0] = w0; TW[row * 2 + 1] = w1;
            }
        }
        __syncthreads();
        if (C.tid < 32) gbase[C.tid] = hist[C.tid] ? atomicAdd(cnt + C.tid * CNT_STRIDE, hist[C.tid]) : 0u;
        __syncthreads();
        for (int i = C.tid; i < wend - cb; i += NT) { const int row = cb + i; const int ee = rec[i * 4], e0 = ee & 255, e1 = ee >> 8;
            const unsigned q0 = gbase[e0] + (unsigned)rec[i * 4 + 1], q1 = gbase[e1] + (unsigned)rec[i * 4 + 2];
            ST[(size_t)e0 * CAP + q0] = row; ST[(size_t)e1 * CAP + q1] = row;
            TS[row * 2 + 0] = (e0 << 20) | (int)q0; TS[row * 2 + 1] = (e1 << 20) | (int)q1; }
        __syncthreads();
    }
}

__device__ __forceinline__ void phase_final(const Args& A, const Ctx& C) {
    LAS int* sb = (LAS int*)C.lds;
    slot_bases(A, 3, sb, C.tid);
    const bf16* LAT = (const bf16*)(A.ws + WS_LAT); const unsigned char* Y8 = A.ws + WS_PB;
    const int* TS = (const int*)(A.ws + WS_TOKSLOT); const float* TW = (const float*)(A.ws + WS_TOKW);
    const float* MOD = (const float*)(A.ws + WS_MOD);
    f32x4 fg[4]; load_row_f32(A.in[7], C.lane, fg);
    const int rpw = (((NL + C.G - 1) / C.G) + 1) & ~1; const int wrow0 = C.bid * rpw; const int wend = min(wrow0 + rpw, NL);
    for (int sa = wrow0; sa < wend;) {
        const int mvi = mod_vec_of_row(sa); const int sbnd = min(wend, mvi == 0 ? SEQ : NL);
        f32x4 g2[4]; load_row_f32(MOD + (size_t)(3 * 3 + mvi) * 6 * D + 5 * D, C.lane, g2);
        for (int ra = sa + 2 * C.wave; ra < sbnd; ra += 2 * NW) {
            const int rb = ra + 1;
            const int ta0 = TS[ra * 2], ta1 = TS[ra * 2 + 1], tb0 = TS[rb * 2], tb1 = TS[rb * 2 + 1]; const float wa0 = TW[ra * 2], wa1 = TW[ra * 2 + 1], wb0 = TW[rb * 2], wb1 = TW[rb * 2 + 1];
            f32x4 va[4], vb[4]; unsigned ya0[4], ya1[4], yb0[4], yb1[4];
            load_row_bf16(LAT + (size_t)ra * D, C.lane, va); load_row_bf16(LAT + (size_t)rb * D, C.lane, vb);
            load_row_fp8raw(Y8 + (size_t)(sb[ta0 >> 20] + (ta0 & 0xfffff)) * D, C.lane, ya0); load_row_fp8raw(Y8 + (size_t)(sb[ta1 >> 20] + (ta1 & 0xfffff)) * D, C.lane, ya1);
            load_row_fp8raw(Y8 + (size_t)(sb[tb0 >> 20] + (tb0 & 0xfffff)) * D, C.lane, yb0); load_row_fp8raw(Y8 + (size_t)(sb[tb1 >> 20] + (tb1 & 0xfffff)) * D, C.lane, yb1);
#pragma unroll
            for (int q = 0; q < 4; ++q) { va[q] += g2[q] * (fp8x4(ya0[q]) * (wa0 * (1.0f / YSCALE)) + fp8x4(ya1[q]) * (wa1 * (1.0f / YSCALE))); vb[q] += g2[q] * (fp8x4(yb0[q]) * (wb0 * (1.0f / YSCALE)) + fp8x4(yb1[q]) * (wb1 * (1.0f / YSCALE))); }
            const float rra = row_rstd(va), rrb = row_rstd(vb);
#pragma unroll
            for (int q = 0; q < 4; ++q) { *(f32x4*)(A.out + (size_t)ra * D + 4 * C.lane + 256 * q) = (va[q] * rra) * fg[q]; *(f32x4*)(A.out + (size_t)rb * D + 4 * C.lane + 256 * q) = (vb[q] * rrb) * fg[q]; }
        }
        sa = sbnd;
    }
}

__device__ __forceinline__ void phase_conv(const Args& A, const Ctx& C, int l) {
    const int j = l >> 1; const int nrows = (l <= 1) ? NR : NL;
    const bf16* P = (const bf16*)(A.ws + WS_PB); unsigned char* HM = A.ws + WS_HM; float* RSC = (float*)(A.ws + WS_RSC);
    const float* cw = A.in[13] + (size_t)j * 3 * D;
    f32x4 w0[4], w1[4], w2[4];
    load_row_f32(cw, C.lane, w0); load_row_f32(cw + D, C.lane, w1); load_row_f32(cw + 2 * D, C.lane, w2);
    const int rpw = (((nrows + C.G - 1) / C.G) + 1) & ~1; const int wrow0 = C.bid * rpw; const int wend = min(wrow0 + rpw, nrows);
    for (int ra = wrow0 + 2 * C.wave; ra < wend; ra += 2 * NW) {
        const int rb = ra + 1;
        const int ta = ra < NL ? (ra & 63) : ((ra - NL) & 255), tb1 = rb < NL ? (rb & 63) : ((rb - NL) & 255), tlast = ra < NL ? 63 : 255;
        const bool hasl = ta != 0, hasr = tb1 != tlast;
        const bf16* pa = P + (size_t)ra * PW;
        u32x2 bga[4], bgb[4], zm[4], z0[4], z1[4], z2[4];
        load_row_bf16raw(pa, C.lane, bga); load_row_bf16raw(pa + PW, C.lane, bgb);
        load_row_bf16raw(pa + D, C.lane, z0); load_row_bf16raw(pa + PW + D, C.lane, z1);
        load_row_bf16raw(hasl ? pa - PW + D : pa + D, C.lane, zm); load_row_bf16raw(hasr ? pa + 2 * PW + D : pa + D, C.lane, z2);
        const float fl = hasl ? 1.f : 0.f, fr = hasr ? 1.f : 0.f;
        f32x4 oa[4], ob[4];
#pragma unroll
        for (int q = 0; q < 4; ++q) { const f32x4 a0 = bf4(z0[q]), a1 = bf4(z1[q]);
            oa[q] = bf4(bga[q]) * (w0[q] * (bf4(zm[q]) * fl) + w1[q] * a0 + w2[q] * a1);
            ob[q] = bf4(bgb[q]) * (w0[q] * a0 + w1[q] * a1 + w2[q] * (bf4(z2[q]) * fr)); }
        float ma = 0.f, mb = 0.f;
#pragma unroll
        for (int q = 0; q < 4; ++q) { ma = fmaxf(ma, fmaxf(fmaxf(fabsf(oa[q].x), fabsf(oa[q].y)), fmaxf(fabsf(oa[q].z), fabsf(oa[q].w)))); mb = fmaxf(mb, fmaxf(fmaxf(fabsf(ob[q].x), fabsf(ob[q].y)), fmaxf(fabsf(ob[q].z), fabsf(ob[q].w)))); }
        ma = fmaxf(wave_max_nn(ma), 1.0e-20f); mb = fmaxf(wave_max_nn(mb), 1.0e-20f);
        const float ia = 127.0f / ma, ib = 127.0f / mb;
#pragma unroll
        for (int q = 0; q < 4; ++q) { *(unsigned*)(HM + (size_t)ra * D + 4 * C.lane + 256 * q) = pack_i8(oa[q] * ia); *(unsigned*)(HM + (size_t)rb * D + 4 * C.lane + 256 * q) = pack_i8(ob[q] * ib); }
        if (C.lane == 0) { RSC[ra] = ma * (1.0f / 127.0f); RSC[rb] = mb * (1.0f / 127.0f); }
    }
}

constexpr int BM = 256, BK = 64, HALF = 128, HTB = HALF * BK * 2, STAGE_BYTES = 8 * HTB, NXCD = 8, WGM = 8;
constexpr int LDS_TAB = STAGE_BYTES;
__device__ __forceinline__ int lds_byte(int r, int c) { const int st = (r >> 4) * 2 + (c >> 5), rr = r & 15, cc = c & 31, ob = rr * 64 + cc * 2; return st * 1024 + (ob ^ (((ob >> 9) & 1) << 5)); }
__device__ __forceinline__ void stage_rc(int b, int& R, int& C) { const int st = b / 1024, sb = b % 1024, swz = sb ^ (((sb >> 9) & 1) << 5); R = (st >> 1) * 16 + swz / 64; C = (st & 1) * 32 + (swz % 64) / 2; }
__device__ __forceinline__ int perm32(int rho) { const int n = rho >> 4, i = rho & 15; return 8 * (i >> 2) + 4 * n + (i & 3); }
__device__ __forceinline__ unsigned cvt_pk_bf16(float lo, float hi) { unsigned r; asm volatile("v_cvt_pk_bf16_f32 %0, %1, %2" : "=v"(r) : "v"(lo), "v"(hi)); return r; }

struct GUnit { const char* a; const char* b; int orow, ocol, aux; };

typedef int i32x8 __attribute__((ext_vector_type(8)));
typedef int i32x4 __attribute__((ext_vector_type(4)));
template <class Epi, class Sched, bool GATHER, int OPM = 0>
__device__ __forceinline__ void gemm_phase(LAS unsigned char* lds, const int K, const Sched& S, const Epi& E) {
    const int tid = threadIdx.x, wid = __builtin_amdgcn_readfirstlane(tid >> 6), lane = tid & 63, wr = wid >> 2, wc = wid & 3, fr = lane & 15, fq = lane >> 4;
    constexpr bool FP8 = (OPM == 1), I8 = (OPM == 2);
    const int RB = (OPM != 0) ? K : 2 * K;
    const int nt = RB / (BK * 2);
    unsigned voffB[2], voA[2][2]; int Rr[2], Cc[2];
#pragma unroll
    for (int i = 0; i < 2; ++i) { int R, C; stage_rc(tid * 16 + i * 8192, R, C); const int Rb = (R & ~31) + perm32(R & 31); Rr[i] = R; Cc[i] = C;
        voffB[i] = (unsigned)(Rb * RB + C * 2);
        voA[0][i] = (unsigned)(R * RB + C * 2); voA[1][i] = (unsigned)((R + HALF) * RB + C * 2); }
    const size_t kstep = (size_t)(BK * 2);
    const size_t hstep = (size_t)HALF * RB;
    const unsigned ldsw = (unsigned)wid * 1024u;
    const unsigned ldsbase = (unsigned)(size_t)lds;
    const int aoff = lds_byte(wr * 64 + fr, fq * 8), boff = lds_byte(wc * 32 + fr, fq * 8);
#define PG8_SA(b, h) (((b) * 2 + (h)) * HTB)
#define PG8_SB(b, h) ((4 + (b) * 2 + (h)) * HTB)
#define PG8_STAGE(bufoff, gbase, voff) do { _Pragma("unroll") for (int _i = 0; _i < 2; ++_i) \
        asm volatile("s_mov_b32 m0, %2\n\ts_nop 0\n\tglobal_load_lds_dwordx4 %0, %1" :: "v"((voff)[_i]), "s"((const char*)(gbase)), "s"(ldsbase + (unsigned)(bufoff) + ldsw + (unsigned)(_i * 8192)) : "memory"); } while (0)
#define PG8_STAGE_A1(bufoff, gbase) do { if constexpr (GATHER) PG8_STAGE(bufoff, gbase, voA[1]); else PG8_STAGE(bufoff, (const char*)(gbase) + hstep, voA[0]); } while (0)
#define PG8_LDA(dst, b, h) do { if constexpr (FP8) { _Pragma("unroll") for (int m = 0; m < 4; ++m) { \
        const i32x4 _lo = *(const LAS i32x4*)(lds + PG8_SA(b, h) + aoff + m * 2048), _hi = *(const LAS i32x4*)(lds + PG8_SA(b, h) + aoff + m * 2048 + 1024); \
        dst##8[m] = __builtin_shufflevector(_lo, _hi, 0, 1, 2, 3, 4, 5, 6, 7); } } \
      else { _Pragma("unroll") for (int m = 0; m < 4; ++m) _Pragma("unroll") for (int k = 0; k < 2; ++k) dst[m][k] = *(const LAS bf16x8*)(lds + PG8_SA(b, h) + aoff + m * 2048 + k * 1024); } } while (0)
#define PG8_LDB(dst, b, h) do { if constexpr (FP8) { _Pragma("unroll") for (int n = 0; n < 2; ++n) { \
        const i32x4 _lo = *(const LAS i32x4*)(lds + PG8_SB(b, h) + boff + n * 2048), _hi = *(const LAS i32x4*)(lds + PG8_SB(b, h) + boff + n * 2048 + 1024); \
        dst##8[n] = __builtin_shufflevector(_lo, _hi, 0, 1, 2, 3, 4, 5, 6, 7); } } \
      else { _Pragma("unroll") for (int n = 0; n < 2; ++n) _Pragma("unroll") for (int k = 0; k < 2; ++k) dst[n][k] = *(const LAS bf16x8*)(lds + PG8_SB(b, h) + boff + n * 2048 + k * 1024); } } while (0)
#define PG8_MMA(ai, bj, At, Bt) do { __builtin_amdgcn_s_setprio(1); \
        if constexpr (FP8) { _Pragma("unroll") for (int m = 0; m < 4; ++m) _Pragma("unroll") for (int n = 0; n < 2; ++n) \
            acc[ai][bj][m][n] = __builtin_amdgcn_mfma_scale_f32_16x16x128_f8f6f4(Bt##8[n], At##8[m], acc[ai][bj][m][n], 0, 0, 0, 0x7f7f7f7f, 0, 0x7f7f7f7f); } \
        else if constexpr (I8) { _Pragma("unroll") for (int m = 0; m < 4; ++m) _Pragma("unroll") for (int n = 0; n < 2; ++n) _Pragma("unroll") for (int k = 0; k < 2; ++k) \
            acc[ai][bj][m][n] = __builtin_bit_cast(f32x4, __builtin_amdgcn_mfma_i32_16x16x64_i8(__builtin_bit_cast(i32x4, Bt[n][k]), __builtin_bit_cast(i32x4, At[m][k]), __builtin_bit_cast(i32x4, acc[ai][bj][m][n]), 0, 0, 0)); } \
        else { _Pragma("unroll") for (int m = 0; m < 4; ++m) _Pragma("unroll") for (int n = 0; n < 2; ++n) _Pragma("unroll") for (int k = 0; k < 2; ++k) \
            acc[ai][bj][m][n] = __builtin_amdgcn_mfma_f32_16x16x32_bf16(Bt[n][k], At[m][k], acc[ai][bj][m][n], 0, 0, 0); } \
        __builtin_amdgcn_s_setprio(0); } while (0)
#define PG8_WAIT_V(n) asm volatile("s_waitcnt vmcnt(" #n ")" ::: "memory")
#define PG8_WAIT_L(n) asm volatile("s_waitcnt lgkmcnt(" #n ")" ::: "memory")
#define PG8_BAR __builtin_amdgcn_s_barrier()
#define PG8_SCHED __builtin_amdgcn_sched_barrier(0)
    GUnit cur, nxt; int ui = 0;
    if (!S.next(0, cur)) return;
    if constexpr (GATHER) {
#pragma unroll
        for (int h = 0; h < 2; ++h)
#pragma unroll
            for (int i = 0; i < 2; ++i) voA[h][i] = S.arow_off(0, h * HALF + Rr[i]) + (unsigned)Cc[i] * 2u;
    }
    f32x4 acc[2][2][4][2];
#pragma unroll
    for (int a = 0; a < 2; ++a)
#pragma unroll
        for (int b = 0; b < 2; ++b)
#pragma unroll
            for (int m = 0; m < 4; ++m)
#pragma unroll
                for (int n = 0; n < 2; ++n) acc[a][b][m][n] = (f32x4){0.f, 0.f, 0.f, 0.f};
    bf16x8 At[4][2], B0[2][2], B1[2][2]; i32x8 At8[4], B08[2], B18[2];
    const char* cA = cur.a; const char* cB = cur.b;
    PG8_STAGE(PG8_SB(0, 0), cB, voffB); PG8_STAGE(PG8_SB(0, 1), cB + hstep, voffB); PG8_STAGE(PG8_SA(0, 0), cA, voA[0]); PG8_STAGE_A1(PG8_SA(0, 1), cA);
    if (wr == 1) PG8_BAR;
    PG8_WAIT_V(2); PG8_BAR;
    PG8_STAGE(PG8_SB(1, 0), cB + kstep, voffB); PG8_STAGE(PG8_SA(1, 0), cA + kstep, voA[0]); PG8_STAGE(PG8_SB(1, 1), cB + hstep + kstep, voffB);
    PG8_WAIT_V(6); PG8_BAR;
    for (;;) {
        const bool has_next = S.next(ui + 1, nxt);
        const char* nA = has_next ? nxt.a : cA; const char* nB = has_next ? nxt.b : cB;
#pragma unroll 1
        for (int t = 0; t < nt; t += 2) {
            const bool last = (t == nt - 2);
            const char* a1 = cA + (size_t)(t + 1) * kstep;
            const char* a2 = last ? nA : cA + (size_t)(t + 2) * kstep; const char* b2 = last ? nB : cB + (size_t)(t + 2) * kstep;
            const char* a3 = a2 + kstep; const char* b3 = b2 + kstep;
            PG8_LDB(B0, 0, 0); PG8_LDB(B1, 0, 1); PG8_SCHED; PG8_LDA(At, 0, 0); PG8_STAGE_A1(PG8_SA(1, 1), a1);
            if constexpr (GATHER) { if (last && has_next) {
#pragma unroll
                for (int h = 0; h < 2; ++h)
#pragma unroll
                    for (int i = 0; i < 2; ++i) { int R2, C2; stage_rc(tid * 16 + i * 8192, R2, C2); voA[h][i] = S.arow_off(ui + 1, h * HALF + R2) + (unsigned)C2 * 2u; } } }
            PG8_WAIT_V(8); PG8_WAIT_L(0); PG8_BAR; PG8_MMA(0, 0, At, B0); PG8_MMA(0, 1, At, B1); PG8_BAR; PG8_SCHED;
            PG8_LDA(At, 0, 1); PG8_STAGE(PG8_SB(0, 0), b2, voffB); PG8_STAGE(PG8_SB(0, 1), b2 + hstep, voffB); PG8_STAGE(PG8_SA(0, 0), a2, voA[0]);
            PG8_WAIT_V(8); PG8_WAIT_L(0); PG8_BAR; PG8_MMA(1, 0, At, B0); PG8_MMA(1, 1, At, B1); PG8_BAR; PG8_SCHED;
            PG8_LDB(B0, 1, 0); PG8_LDB(B1, 1, 1); PG8_SCHED; PG8_LDA(At, 1, 0); PG8_STAGE_A1(PG8_SA(0, 1), a2);
            PG8_WAIT_V(8); PG8_WAIT_L(0); PG8_BAR; PG8_MMA(0, 0, At, B0); PG8_MMA(0, 1, At, B1); PG8_BAR; PG8_SCHED;
            PG8_LDA(At, 1, 1); PG8_STAGE(PG8_SB(1, 0), b3, voffB); PG8_STAGE(PG8_SB(1, 1), b3 + hstep, voffB); PG8_STAGE(PG8_SA(1, 0), a3, voA[0]);
            PG8_WAIT_V(8); PG8_WAIT_L(0); PG8_BAR; PG8_MMA(1, 0, At, B0); PG8_MMA(1, 1, At, B1); PG8_BAR; PG8_SCHED;
        }
        if (wr == 0) PG8_BAR;
        { int tz = threadIdx.x; asm volatile("" : "+v"(tz));
          if constexpr (I8) {
#pragma unroll
              for (int a_ = 0; a_ < 2; ++a_)
#pragma unroll
                  for (int b_ = 0; b_ < 2; ++b_)
#pragma unroll
                      for (int m = 0; m < 4; ++m)
#pragma unroll
                          for (int n = 0; n < 2; ++n) acc[a_][b_][m][n] = __builtin_convertvector(__builtin_bit_cast(i32x4, acc[a_][b_][m][n]), f32x4); }
          const int wz = tz >> 6, lz = tz & 63; E(acc, cur, wz >> 2, wz & 3, lz & 15, lz >> 4); }
        if (!has_next) break;
#pragma unroll
        for (int a = 0; a < 2; ++a)
#pragma unroll
            for (int b = 0; b < 2; ++b)
#pragma unroll
                for (int m = 0; m < 4; ++m)
#pragma unroll
                    for (int n = 0; n < 2; ++n) acc[a][b][m][n] = (f32x4){0.f, 0.f, 0.f, 0.f};
        cur = nxt; cA = nA; cB = nB; ++ui;
        if (wr == 1) PG8_BAR;
    }
    PG8_WAIT_V(0);
    PG8_BAR;
#undef PG8_SA
#undef PG8_SB
#undef PG8_STAGE
#undef PG8_STAGE_A1
#undef PG8_LDA
#undef PG8_LDB
#undef PG8_MMA
#undef PG8_WAIT_V
#undef PG8_WAIT_L
#undef PG8_BAR
#undef PG8_SCHED
}

__device__ __forceinline__ int xcd_remap(int L, int nwg) { const int q = nwg / NXCD, r = nwg % NXCD, xcd = L % NXCD, off = L / NXCD; return (xcd < r ? xcd * (q + 1) : r * (q + 1) + (xcd - r) * q) + off; }

struct DenseSched {
    const char* A; const char* Bt; int nM, nN, nwg, G, c; size_t tstep; int sw_lo, sw_hi;
    __device__ __forceinline__ void init(const void* A_, const void* Bt_, int M, int N, int K, int G_, int c_, int ebytes = 2) { A = (const char*)A_; Bt = (const char*)Bt_; nM = M / BM; nN = N / BM; nwg = nM * nN; G = G_; c = c_; tstep = (size_t)BM * K * ebytes; sw_lo = 0; sw_hi = 0; }
    __device__ __forceinline__ bool next(int i, GUnit& u) const {
        const long L = (long)i * G + c; if (L >= nwg) return false;
        const int wgid = xcd_remap((int)L, nwg);
        const int nig = WGM * nN, gid = wgid / nig, fm = gid * WGM, gsz = (nM - fm) < WGM ? (nM - fm) : WGM;
        const int pm = fm + ((wgid % nig) % gsz), pn = (wgid % nig) / gsz;
        if (pn >= sw_lo && pn < sw_hi) { u.a = Bt + (size_t)pn * tstep; u.b = A + (size_t)pm * tstep; u.orow = pm; u.ocol = pn - sw_lo; u.aux = 1; }
        else { u.a = A + (size_t)pm * tstep; u.b = Bt + (size_t)pn * tstep; u.orow = pm * BM; u.ocol = pn * BM; u.aux = 0; }
        return true;
    }
    __device__ __forceinline__ unsigned arow_off(int, int) const { return 0u; }
};

constexpr int MAXU = 12;
struct MoeTab { int n; int e[MAXU], mb[MAXU], nt[MAXU]; int sb[NE + 1]; };
struct MoeSched {
    LAS const MoeTab* T; LAS const unsigned* ridx;
    const char* A; const char* W; size_t wstride_e, tstepB; int K; int arow_bytes;
    __device__ __forceinline__ bool next(int i, GUnit& u) const {
        const int n = __builtin_amdgcn_readfirstlane(T->n); if (i >= n) return false;
        const int e = __builtin_amdgcn_readfirstlane(T->e[i]), mb = __builtin_amdgcn_readfirstlane(T->mb[i]), nt = __builtin_amdgcn_readfirstlane(T->nt[i]);
        const int base = __builtin_amdgcn_readfirstlane(T->sb[e]);
        u.orow = base + mb * BM; u.ocol = nt; u.aux = e;
        u.a = A + (size_t)u.orow * arow_bytes;
        u.b = W + (size_t)e * wstride_e + (size_t)nt * tstepB; return true;
    }
    __device__ __forceinline__ unsigned arow_off(int i, int r) const { return ridx[i * 256 + r]; }
};
template <bool GATHER>
__device__ __forceinline__ void moe_tables(const Args& A, const Ctx& C, int l, int ntile_n, LAS MoeTab* T, LAS unsigned* ridx, int arow_bytes) {
    const unsigned* cnt = (const unsigned*)(A.ws + WS_CTL) + CW_CNT + l * 32 * CNT_STRIDE;
    LAS int* ust = (LAS int*)(T + 1);
    if (C.tid < 64) { int nb; const int ex = expert_block_prefix(cnt, C.tid, nb); if (C.tid <= NE) { T->sb[C.tid] = ex * 256; ust[C.tid] = ex * ntile_n; } }
    __syncthreads();
    if (C.tid < MAXU) { const int nwg = ust[NE]; const long L = (long)C.tid * C.G + C.bid;
        if (L < nwg) { const int w = xcd_remap((int)L, nwg); int e = 0; while (w >= ust[e + 1]) ++e;
            const int lu = w - ust[e]; T->e[C.tid] = e; T->mb[C.tid] = lu / ntile_n; T->nt[C.tid] = lu % ntile_n; } }
    if (C.tid == 0) { const int nwg = ust[NE]; int n = 0; while (n < MAXU && (long)n * C.G + C.bid < nwg) ++n; T->n = n; }
    __syncthreads();
    if constexpr (GATHER) {
        const int* ST = (const int*)(A.ws + WS_SLOTTOK); const int n = T->n;
        for (int i = C.tid; i < n * 256; i += NT) { const int ui = i >> 8, r = i & 255, e = T->e[ui], m0 = T->mb[ui] * 256, ce = (int)cnt[e * CNT_STRIDE];
            const int rr = (m0 + r < ce) ? m0 + r : ce - 1;
            ridx[i] = (unsigned)ST[(size_t)e * CAP + rr] * (unsigned)arow_bytes; }
        __syncthreads();
    }
}

struct EpiStore { bf16* O; int ldc; float scale_lo; int sig_from; bf16* VT; float sall = 1.0f; const float* rs = nullptr;
    __device__ __forceinline__ void operator()(const f32x4 (&acc)[2][2][4][2], const GUnit& u, int wr, int wc, int fr, int fq) const {
        const bool tr = u.aux != 0;
        const float sc = ((!tr && u.ocol < NQ) ? scale_lo : 1.0f) * sall; const bool sg = !tr && u.ocol >= sig_from;
        bf16* Ob = tr ? VT + (size_t)(u.orow * NH + u.ocol) * 65536 : O + (size_t)u.orow * ldc + u.ocol; const int ld = tr ? 256 : ldc;
        f32x4 cs[2][2];
#pragma unroll
        for (int bj = 0; bj < 2; ++bj) { const f32x4 one = (f32x4){1.f, 1.f, 1.f, 1.f};
            cs[bj][0] = (rs && tr) ? *(const f32x4*)(rs + u.orow * BM + bj * HALF + wc * 32 + 8 * fq) : one; cs[bj][1] = (rs && tr) ? *(const f32x4*)(rs + u.orow * BM + bj * HALF + wc * 32 + 8 * fq + 4) : one; }
#pragma unroll
        for (int ai = 0; ai < 2; ++ai)
#pragma unroll
            for (int m = 0; m < 4; ++m) { const int rl = ai * HALF + wr * 64 + m * 16 + fr; bf16* rowp = Ob + (size_t)rl * ld + wc * 32 + 8 * fq;
                const float scr = (rs && !tr) ? sc * rs[u.orow + rl] : sc;
#pragma unroll
                for (int bj = 0; bj < 2; ++bj) { f32x4 v0 = acc[ai][bj][m][0] * scr * cs[bj][0], v1 = acc[ai][bj][m][1] * scr * cs[bj][1];
                    if (sg) {
#pragma unroll
                        for (int q = 0; q < 4; ++q) { v0[q] = __builtin_amdgcn_rcpf(1.0f + __expf(-v0[q])); v1[q] = __builtin_amdgcn_rcpf(1.0f + __expf(-v1[q])); } }
                    u32x4 w; w.x = cvt_pk_bf16(v0[0], v0[1]); w.y = cvt_pk_bf16(v0[2], v0[3]); w.z = cvt_pk_bf16(v1[0], v1[1]); w.w = cvt_pk_bf16(v1[2], v1[3]);
                    *(u32x4*)(rowp + bj * HALF) = w; } }
    }
};
__device__ __forceinline__ u32x2 cvt8_fp8(f32x4 a, f32x4 b) { int lo = 0, hi = 0;
    lo = __builtin_amdgcn_cvt_pk_fp8_f32(a[0], a[1], lo, false); lo = __builtin_amdgcn_cvt_pk_fp8_f32(a[2], a[3], lo, true);
    hi = __builtin_amdgcn_cvt_pk_fp8_f32(b[0], b[1], hi, false); hi = __builtin_amdgcn_cvt_pk_fp8_f32(b[2], b[3], hi, true); return (u32x2){(unsigned)lo, (unsigned)hi}; }
struct EpiSwigluF8 { unsigned char* O; int ldc; float s;
    __device__ __forceinline__ void operator()(const f32x4 (&acc)[2][2][4][2], const GUnit& u, int wr, int wc, int fr, int fq) const {
        const int ocol = u.ocol * HALF;
#pragma unroll
        for (int ai = 0; ai < 2; ++ai)
#pragma unroll
            for (int m = 0; m < 4; ++m) { unsigned char* rowp = O + (size_t)(u.orow + ai * HALF + wr * 64 + m * 16 + fr) * ldc + ocol + wc * 32 + 8 * fq;
                f32x4 v0, v1;
#pragma unroll
                for (int q = 0; q < 4; ++q) { const float x0 = acc[ai][0][m][0][q] * s, x1 = acc[ai][0][m][1][q] * s;
                    v0[q] = x0 * __builtin_amdgcn_rcpf(1.0f + __expf(-x0)) * (acc[ai][1][m][0][q] * s); v1[q] = x1 * __builtin_amdgcn_rcpf(1.0f + __expf(-x1)) * (acc[ai][1][m][1][q] * s); }
                *(u32x2*)rowp = cvt8_fp8(v0, v1); }
    }
};
template <int MODE> struct EpiPair { bf16* O; int ldc; int plain_below; float sall = 1.0f; const float* rs = nullptr;
    __device__ __forceinline__ void operator()(const f32x4 (&acc)[2][2][4][2], const GUnit& u, int wr, int wc, int fr, int fq) const {
        if (MODE == 0 && u.ocol < plain_below) {
#pragma unroll
            for (int ai = 0; ai < 2; ++ai)
#pragma unroll
                for (int m = 0; m < 4; ++m) { const int rg = u.orow + ai * HALF + wr * 64 + m * 16 + fr; bf16* rowp = O + (size_t)rg * ldc + u.ocol + wc * 32 + 8 * fq;
                    const float scr = rs ? sall * rs[rg] : sall;
#pragma unroll
                    for (int bj = 0; bj < 2; ++bj) { const f32x4 v0 = acc[ai][bj][m][0] * scr, v1 = acc[ai][bj][m][1] * scr;
                        u32x4 w; w.x = cvt_pk_bf16(v0[0], v0[1]); w.y = cvt_pk_bf16(v0[2], v0[3]); w.z = cvt_pk_bf16(v1[0], v1[1]); w.w = cvt_pk_bf16(v1[2], v1[3]);
                        *(u32x4*)(rowp + bj * HALF) = w; } }
            return;
        }
        const int ocol = (MODE == 0) ? plain_below + (u.ocol - plain_below) / 2 : u.ocol * HALF;
#pragma unroll
        for (int ai = 0; ai < 2; ++ai)
#pragma unroll
            for (int m = 0; m < 4; ++m) { const int rg = u.orow + ai * HALF + wr * 64 + m * 16 + fr; bf16* rowp = O + (size_t)rg * ldc + ocol + wc * 32 + 8 * fq;
                const float scr = rs ? sall * rs[rg] : sall; const float sc2 = scr * scr;
                f32x4 v0, v1;
#pragma unroll
                for (int q = 0; q < 4; ++q) {
                    const float x0 = acc[ai][0][m][0][q], x1 = acc[ai][0][m][1][q];
                    const float g0 = (MODE == 1) ? x0 * __builtin_amdgcn_rcpf(1.0f + __expf(-x0)) : x0, g1 = (MODE == 1) ? x1 * __builtin_amdgcn_rcpf(1.0f + __expf(-x1)) : x1;
                    v0[q] = g0 * acc[ai][1][m][0][q] * sc2; v1[q] = g1 * acc[ai][1][m][1][q] * sc2; }
                u32x4 w; w.x = cvt_pk_bf16(v0[0], v0[1]); w.y = cvt_pk_bf16(v0[2], v0[3]); w.z = cvt_pk_bf16(v1[0], v1[1]); w.w = cvt_pk_bf16(v1[2], v1[3]);
                *(u32x4*)rowp = w; }
    }
};
struct EpiStoreTile { unsigned char* O; int ldc; float s;
    __device__ __forceinline__ void operator()(const f32x4 (&acc)[2][2][4][2], const GUnit& u, int wr, int wc, int fr, int fq) const {
#pragma unroll
        for (int ai = 0; ai < 2; ++ai)
#pragma unroll
            for (int m = 0; m < 4; ++m) { unsigned char* rowp = O + (size_t)(u.orow + ai * HALF + wr * 64 + m * 16 + fr) * ldc + u.ocol * BM + wc * 32 + 8 * fq;
#pragma unroll
                for (int bj = 0; bj < 2; ++bj) *(u32x2*)(rowp + bj * HALF) = cvt8_fp8(acc[ai][bj][m][0] * s, acc[ai][bj][m][1] * s); }
    }
};

__device__ __forceinline__ void transpose_item(const float* W, int ldw, int K, bf16* WT, int drow0, int k0, int n0, LAS float* scr, int lane) {
#pragma unroll
    for (int i = 0; i < 32; ++i) { const int kk = 2 * i + (lane >> 5); scr[kk * 33 + (lane & 31)] = W[(size_t)(k0 + kk) * ldw + n0 + (lane & 31)]; }
    asm volatile("s_waitcnt lgkmcnt(0)" ::: "memory");
    const int c = lane & 7;
#pragma unroll
    for (int j = 0; j < 4; ++j) { const int n = (lane >> 3) + 8 * j; const LAS float* s = scr + (8 * c) * 33 + n;
        u32x4 o; o.x = pk2(s[0 * 33], s[1 * 33]); o.y = pk2(s[2 * 33], s[3 * 33]); o.z = pk2(s[4 * 33], s[5 * 33]); o.w = pk2(s[6 * 33], s[7 * 33]);
        *(u32x4*)(WT + (size_t)(drow0 + n) * K + k0 + 8 * c) = o; }
    asm volatile("s_waitcnt lgkmcnt(0)" ::: "memory");
}
__device__ __forceinline__ void transpose_item_fp8(const float* W, int ldw, int K, unsigned char* WT8, int drow0, int k0, int n0, LAS float* scr, int lane, float sc) {
#pragma unroll
    for (int i = 0; i < 32; ++i) { const int kk = 2 * i + (lane >> 5); scr[kk * 33 + (lane & 31)] = W[(size_t)(k0 + kk) * ldw + n0 + (lane & 31)]; }
    asm volatile("s_waitcnt lgkmcnt(0)" ::: "memory");
    const int n = lane >> 1, half = lane & 1; const LAS float* sp = scr + (32 * half) * 33 + n;
    unsigned char* dst = WT8 + (size_t)(drow0 + n) * K + k0 + 32 * half;
#pragma unroll
    for (int c = 0; c < 2; ++c) { u32x4 o;
#pragma unroll
        for (int q = 0; q < 4; ++q) { int p = 0; const LAS float* s4 = sp + (16 * c + 4 * q) * 33;
            p = __builtin_amdgcn_cvt_pk_fp8_f32(s4[0] * sc, s4[33] * sc, p, false); p = __builtin_amdgcn_cvt_pk_fp8_f32(s4[66] * sc, s4[99] * sc, p, true); o[q] = (unsigned)p; }
        *(u32x4*)(dst + 16 * c) = o; }
    asm volatile("s_waitcnt lgkmcnt(0)" ::: "memory");
}
__device__ __forceinline__ void transpose_item_i8(const float* W, int ldw, int K, unsigned char* WT8, int drow0, int k0, int n0, LAS float* scr, int lane, float inv) {
#pragma unroll
    for (int i = 0; i < 32; ++i) { const int kk = 2 * i + (lane >> 5); scr[kk * 33 + (lane & 31)] = W[(size_t)(k0 + kk) * ldw + n0 + (lane & 31)]; }
    asm volatile("s_waitcnt lgkmcnt(0)" ::: "memory");
    const int n = lane >> 1, half = lane & 1; const LAS float* sp = scr + (32 * half) * 33 + n;
    unsigned char* dst = WT8 + (size_t)(drow0 + n) * K + k0 + 32 * half;
#pragma unroll
    for (int c = 0; c < 2; ++c) { u32x4 o;
#pragma unroll
        for (int q = 0; q < 4; ++q) { const LAS float* s4 = sp + (16 * c + 4 * q) * 33; o[q] = pack_i8((f32x4){s4[0] * inv, s4[33] * inv, s4[66] * inv, s4[99] * inv}); }
        *(u32x4*)(dst + 16 * c) = o; }
    asm volatile("s_waitcnt lgkmcnt(0)" ::: "memory");
}
__device__ __forceinline__ int pair_row(int n, int which) { return (n >> 7) * 256 + (n & 127) + which * 128; }
constexpr float HMR = 6.0f;
__device__ __forceinline__ void phase_cvt_mixer(const Args& A, const Ctx& C) {
    const int gw = C.bid * NW + C.wave, NGW = C.G * NW;
    unsigned* wmax = (unsigned*)(A.ws + WS_CTL) + CW_WMAX;
    for (int m8 = 0; m8 < 8; ++m8) {
        const float* W = m8 < 2 ? A.in[8] + (size_t)m8 * D * PROJ : m8 < 4 ? A.in[12] + (size_t)(m8 - 2) * D * PW : m8 < 6 ? A.in[11] + (size_t)(m8 - 4) * D * D : A.in[14] + (size_t)(m8 - 6) * D * D;
        const size_t n4 = (size_t)D * (m8 < 2 ? PROJ : m8 < 4 ? PW : D) / 4;
        float mx = 0.f;
        for (size_t i = (size_t)gw * 64 + C.lane; i < n4; i += (size_t)NGW * 64) { const f32x4 v = *(const f32x4*)(W + 4 * i); mx = fmaxf(mx, fmaxf(fmaxf(fabsf(v.x), fabsf(v.y)), fmaxf(fabsf(v.z), fabsf(v.w)))); }
        mx = wave_max_nn(mx);
        if (C.lane == 0 && mx > 0.f) atomicMax(wmax + m8 * CNT_STRIDE, __float_as_uint(mx));
    }
}
__device__ __forceinline__ void cvt_win_i8(const Args& A, const Ctx& C) {
    LAS float* scr = (LAS float*)(C.lds + 16384 + C.wave * 16384);
    const int gw = C.bid * NW + C.wave, NGW = C.G * NW;
    constexpr int I_IN = (D / 64) * (PW / 32);
    const unsigned* wmax = (const unsigned*)(A.ws + WS_CTL) + CW_WMAX;
    constexpr int I_OUT = (D / 64) * (D / 32);
    for (int it = gw; it < 4 * I_OUT; it += NGW) {
        const int m4 = it / I_OUT, kind = m4 >> 1, j = m4 & 1, r = it % I_OUT; const int kb = r / (D / 32), nb = r % (D / 32), n0 = nb * 32;
        const float inv = 127.0f / fmaxf(__uint_as_float(wmax[(4 + m4) * CNT_STRIDE]), 1.0e-30f);
        transpose_item_i8((kind == 0 ? A.in[11] : A.in[14]) + (size_t)j * D * D, D, D, A.ws + (kind == 0 ? WS_WAOUT : WS_WBOUT) + (size_t)j * D * D, n0, kb * 64, n0, scr, C.lane, inv); }
    for (int it = gw; it < 4 * I_IN; it += NGW) {
        const int m4 = it / I_IN, kind = m4 >> 1, j = m4 & 1, r = it % I_IN; const int kb = r / (PW / 32), nb = r % (PW / 32), n0 = nb * 32;
        const float inv = 127.0f / fmaxf(__uint_as_float(wmax[m4 * CNT_STRIDE]), 1.0e-30f);
        unsigned char* WT = A.ws + (kind == 0 ? WS_WAIN : WS_WBIN) + (size_t)j * PW * D;
        if (kind == 0) transpose_item_i8(A.in[8] + (size_t)j * D * PROJ, PROJ, D, WT, n0, kb * 64, n0, scr, C.lane, inv);
        else { const int drow = n0 < D ? n0 : (n0 < 2 * D ? D + pair_row(n0 - D, 0) : D + pair_row(n0 - 2 * D, 1));
            transpose_item_i8(A.in[12] + (size_t)j * D * PW, PW, D, WT, drow, kb * 64, n0, scr, C.lane, inv); }
    }
}
__device__ __forceinline__ void cvt_moe_items(const Args& A, const Ctx& C, int l, int it0, int end, int stride) {
    LAS float* scr = (LAS float*)(C.lds + 16384 + C.wave * 16384);
    unsigned char* WGU = A.ws + WS_WGU; unsigned char* WDN = A.ws + WS_WDN;
    for (int it = it0; it < end; it += stride) {
        const int e = it / CVT_PER; int r = it % CVT_PER;
        if (r < 2 * CVT_IG) { const int which = r / CVT_IG; r %= CVT_IG; const int kb = r / (DE / 32), nb = r % (DE / 32), n0 = nb * 32;
            transpose_item_fp8((which == 0 ? A.in[19] : A.in[20]) + ((size_t)l * NE + e) * D * DE, DE, D, WGU + (size_t)e * 2 * DE * D, pair_row(n0, which), kb * 64, n0, scr, C.lane, WSCALE); }
        else { r -= 2 * CVT_IG; const int kb = r / (D / 32), nb = r % (D / 32), n0 = nb * 32;
            transpose_item_fp8(A.in[21] + ((size_t)l * NE + e) * DE * D, D, DE, WDN + (size_t)e * D * DE, n0, kb * 64, n0, scr, C.lane, WSCALE); }
    }
}
__device__ __forceinline__ int cvt_idle(int nunits, int G) { const int rem = nunits % G; return rem ? G - rem : 0; }
__device__ __forceinline__ int cvt_t1(int l, int G) { const int n = cvt_idle((((l <= 2) ? NR : NL) / BM) * (PW / BM), G) * CVT_Q; return n < CVT_ITEMS ? n : CVT_ITEMS; }
__device__ __forceinline__ int cvt_t2(int l, int G) { const int n = cvt_t1(l, G) + cvt_idle((((l <= 1) ? NR : NL) / BM) * (D / BM), G) * CVT_Q; return n < CVT_ITEMS ? n : CVT_ITEMS; }
__device__ __forceinline__ void cvt_moe_tail(const Args& A, const Ctx& C, int l, int nunits, int base, int end) {
    const int rem = nunits % C.G;
    if (rem == 0 || C.bid < rem) return;
    const int first = base + (C.bid - rem) * CVT_Q; const int last = min(first + CVT_Q, end);
    cvt_moe_items(A, C, l, first + C.wave, last, NW);
}

__device__ __forceinline__ void phase_g1(const Args& A, const Ctx& C, int l) {
    const bool mls = (l & 1) == 0; const int j = l >> 1; const int nrows = (l <= 2) ? NR : NL;
    DenseSched S; S.init(A.ws + WS_H8, A.ws + (mls ? WS_WAIN : WS_WBIN) + (size_t)j * PW * D, nrows, PW, D, C.G, C.bid, 1);
    const float wsc = __uint_as_float(((const unsigned*)(A.ws + WS_CTL))[CW_WMAX + ((mls ? 0 : 2) + j) * CNT_STRIDE]) * (1.0f / 127.0f);
    const float* rs = (const float*)(A.ws + WS_RSC);
    if (mls) { S.sw_lo = 4; S.sw_hi = 8; EpiStore E{(bf16*)(A.ws + WS_PB), PW, 0.08838834764831845f, 2 * NQ + NV, (bf16*)(A.ws + WS_VT), wsc, rs}; gemm_phase<EpiStore, DenseSched, false, 2>(C.lds, D, S, E); }
    else { EpiPair<0> E{(bf16*)(A.ws + WS_PB), PW, D, wsc, rs}; gemm_phase<EpiPair<0>, DenseSched, false, 2>(C.lds, D, S, E); }
    cvt_moe_tail(A, C, l, S.nwg, 0, cvt_t1(l, C.G));
}
__device__ __forceinline__ void phase_g2(const Args& A, const Ctx& C, int l) {
    const bool mls = (l & 1) == 0; const int j = l >> 1; const int nrows = (l <= 1) ? NR : NL;
    DenseSched S; S.init(A.ws + WS_HM, A.ws + (mls ? WS_WAOUT : WS_WBOUT) + (size_t)j * D * D, nrows, D, D, C.G, C.bid, 1);
    const float wsc = __uint_as_float(((const unsigned*)(A.ws + WS_CTL))[CW_WMAX + (4 + (mls ? 0 : 2) + j) * CNT_STRIDE]) * (1.0f / 127.0f);
    EpiStore E{(bf16*)(A.ws + WS_HB), D, 1.0f, 1 << 30, nullptr, mls ? wsc * (HMR / 127.0f) : wsc, mls ? nullptr : (const float*)(A.ws + WS_RSC)}; gemm_phase<EpiStore, DenseSched, false, 2>(C.lds, D, S, E);
    cvt_moe_tail(A, C, l, S.nwg, cvt_t1(l, C.G), cvt_t2(l, C.G));
}
__device__ __forceinline__ void phase_m1(const Args& A, const Ctx& C, int l) {
    LAS MoeTab* T = (LAS MoeTab*)(C.lds + LDS_TAB); LAS unsigned* ridx = (LAS unsigned*)(C.lds + LDS_TAB + 1024);
    moe_tables<true>(A, C, l, 4, T, ridx, D);
    MoeSched S; S.T = T; S.ridx = ridx; S.A = (const char*)(A.ws + WS_H8); S.W = (const char*)(A.ws + WS_WGU); S.wstride_e = (size_t)2 * DE * D; S.tstepB = (size_t)BM * D; S.K = D; S.arow_bytes = 0;
    EpiSwigluF8 E{A.ws + WS_DC, DE, 1.0f / WSCALE}; gemm_phase<EpiSwigluF8, MoeSched, true, 1>(C.lds, D, S, E);
}
__device__ __forceinline__ void phase_m2(const Args& A, const Ctx& C, int l) {
    LAS MoeTab* T = (LAS MoeTab*)(C.lds + LDS_TAB); LAS unsigned* ridx = (LAS unsigned*)(C.lds + LDS_TAB + 1024);
    moe_tables<false>(A, C, l, 4, T, ridx, DE);
    MoeSched S; S.T = T; S.ridx = ridx; S.A = (const char*)(A.ws + WS_DC); S.W = (const char*)(A.ws + WS_WDN); S.wstride_e = (size_t)D * DE; S.tstepB = (size_t)BM * DE; S.K = DE; S.arow_bytes = DE;
    EpiStoreTile E{A.ws + WS_PB, D, YSCALE / WSCALE}; gemm_phase<EpiStoreTile, MoeSched, false, 1>(C.lds, DE, S, E);
}

typedef float f32x16 __attribute__((ext_vector_type(16)));
#define MFMA32(a, b, c) __builtin_amdgcn_mfma_f32_32x32x16_bf16((a), (b), (c), 0, 0, 0)
__device__ __forceinline__ bf16x8 pack8(float a0, float a1, float a2, float a3, float a4, float a5, float a6, float a7) {
    u32x4 p; p.x = cvt2(a0, a1); p.y = cvt2(a2, a3); p.z = cvt2(a4, a5); p.w = cvt2(a6, a7); return __builtin_bit_cast(bf16x8, p); }
__device__ __forceinline__ float bflo(unsigned w) { return __uint_as_float(w << 16); }
__device__ __forceinline__ float bfhi(unsigned w) { return __uint_as_float(w & 0xffff0000u); }
__device__ __forceinline__ int vt_tile(int b, int h, int blk) { return (blk == 0 ? 128 + b : b * 64 + blk - 1) * NH + h; }

__device__ __forceinline__ float wave_incl_scan(float v, int lane) {
#pragma unroll
    for (int o = 1; o < 64; o <<= 1) { const float t = __shfl_up(v, o); v += (lane >= o) ? t : 0.f; }
    return v;
}
__device__ __forceinline__ void block_gates(const Args& A, int row0, int h, LAS float* bf, LAS float* bb, LAS float* lif, LAS float* lib, int tid) {
    const float* GATE = (const float*)(A.ws + WS_GATE);
    if (tid < 256) { const float* g = GATE + (size_t)(row0 + tid) * 16; lif[tid] = g[0 + h]; bf[tid] = g[4 + h]; lib[tid] = g[8 + h]; bb[tid] = g[12 + h]; }
    __syncthreads();
    const int lane = tid & 63, wv = tid >> 6;
    if (wv == 0) { f32x4 x = *(LAS f32x4*)(bf + 4 * lane); x.y += x.x; x.z += x.y; x.w += x.z; const float tot = wave_incl_scan(x.w, lane); const float ex = tot - x.w;
        x.x += ex; x.y += ex; x.z += ex; x.w += ex; *(LAS f32x4*)(bf + 4 * lane) = x; }
    if (wv == 1) { f32x4 y = *(LAS f32x4*)(bb + 4 * (63 - lane)); y.z += y.w; y.y += y.z; y.x += y.y; const float tot = wave_incl_scan(y.x, lane); const float ex = tot - y.x;
        y.x += ex; y.y += ex; y.z += ex; y.w += ex; *(LAS f32x4*)(bb + 4 * (63 - lane)) = y; }
    __syncthreads();
}
__device__ __forceinline__ void phase_s1(const Args& A, const Ctx& C, int l) {
    LAS float* bf = (LAS float*)C.lds; LAS float* bb = bf + 256; LAS float* lif = bb + 256; LAS float* lib = lif + 256; LAS float* af = lib + 256; LAS float* ab = af + 256;
    constexpr int KP = 528;
    LAS unsigned char* KTf = C.lds + 8192; LAS unsigned char* KTb = KTf + 128 * KP;
    const bf16* P = (const bf16*)(A.ws + WS_PB); const bf16* VT = (const bf16*)(A.ws + WS_VT);
    float* DC = (float*)(A.ws + WS_DC); float* DN = (float*)(A.ws + WS_DN); float* BT = (float*)(A.ws + WS_BTOT);
    const int r = C.lane & 31, hh = C.lane >> 5, w = C.wave;
    for (int u = C.bid; u < NUNIT; u += C.G) {
        const int blk = u % NBLK, bh = u / NBLK, h = bh % NH, b = bh / NH; const int row0 = blk_row0(b, blk);
        block_gates(A, row0, h, bf, bb, lif, lib, C.tid);
        if (C.tid < 256) { af[C.tid] = __expf(bf[255] - bf[C.tid] + lif[C.tid]); ab[C.tid] = __expf(bb[0] - bb[C.tid] + lib[C.tid]); }
        if (C.tid == 0) { BT[u * 2 + 0] = bf[255]; BT[u * 2 + 1] = bb[0]; }
        __syncthreads();
        { const int sp = C.tid >> 2, dq = C.tid & 3, s0 = 2 * sp;
          const bf16* k0 = P + (size_t)(row0 + s0) * PW + NQ + h * DQK + 32 * dq;
          const float f0 = af[s0], f1 = af[s0 + 1], g0 = ab[s0], g1 = ab[s0 + 1];
#pragma unroll
          for (int c = 0; c < 4; ++c) { const u32x4 x0 = *(const u32x4*)(k0 + 8 * c), x1 = *(const u32x4*)(k0 + PW + 8 * c);
#pragma unroll
              for (int q = 0; q < 4; ++q) { const int d = 32 * dq + 8 * c + 2 * q;
                  const float a0 = bflo(x0[q]), a1 = bfhi(x0[q]), c0 = bflo(x1[q]), c1 = bfhi(x1[q]);
                  *(LAS unsigned*)(KTf + d * KP + s0 * 2) = cvt2(a0 * f0, c0 * f1); *(LAS unsigned*)(KTf + (d + 1) * KP + s0 * 2) = cvt2(a1 * f0, c1 * f1);
                  *(LAS unsigned*)(KTb + d * KP + s0 * 2) = cvt2(a0 * g0, c0 * g1); *(LAS unsigned*)(KTb + (d + 1) * KP + s0 * 2) = cvt2(a1 * g0, c1 * g1); } } }
        __syncthreads();
        if (C.tid < 256) { const int dir = C.tid >> 7, d = C.tid & 127; LAS const unsigned* kr = (LAS const unsigned*)((dir ? KTb : KTf) + d * KP); float s = 0.f;
            for (int i = 0; i < 128; ++i) { const unsigned x = kr[i]; s += bflo(x) + bfhi(x); }
            DN[(size_t)(u * 2 + dir) * DQK + d] = s; }
        const bf16* vt = VT + (size_t)vt_tile(b, h, blk) * 65536 + (size_t)(32 * w + r) * 256 + 8 * hh;
        bf16x8 av[16];
#pragma unroll
        for (int ks = 0; ks < 16; ++ks) av[ks] = *(const bf16x8*)(vt + 16 * ks);
#pragma unroll 1
        for (int dir = 0; dir < 2; ++dir) {
            LAS const unsigned char* KT = dir ? KTb : KTf;
            f32x16 acc[4];
#pragma unroll
            for (int dt = 0; dt < 4; ++dt)
#pragma unroll
                for (int i = 0; i < 16; ++i) acc[dt][i] = 0.f;
#pragma unroll
            for (int ks = 0; ks < 16; ++ks) {
#pragma unroll
                for (int dt = 0; dt < 4; ++dt) { const bf16x8 b0 = *(const LAS bf16x8*)(KT + (dt * 32 + r) * KP + (16 * ks + 8 * hh) * 2); acc[dt] = MFMA32(av[ks], b0, acc[dt]); }
                if ((ks & 3) == 3) asm volatile("" ::: "memory"); }
            float* dc = DC + (size_t)(u * 2 + dir) * DQK * DV + (size_t)(32 * w + 4 * hh) * DQK + r;
#pragma unroll
            for (int g = 0; g < 4; ++g) { float* pf = dc + g * 8 * DQK; asm volatile("" : "+v"(pf));
#pragma unroll
                for (int q = 0; q < 4; ++q)
#pragma unroll
                    for (int dt = 0; dt < 4; ++dt) pf[q * DQK + dt * 32] = acc[dt][4 * g + q]; }
        }
        __syncthreads();
    }
}
__device__ __forceinline__ void phase_s2(const Args& A, const Ctx& C) {
    const float* __restrict__ DC = (const float*)(A.ws + WS_DC); const float* __restrict__ DN = (const float*)(A.ws + WS_DN); const float* __restrict__ BT = (const float*)(A.ws + WS_BTOT);
    bf16* __restrict__ CST = (bf16*)(A.ws + WS_CST); float* __restrict__ NST = (float*)(A.ws + WS_NST);
    constexpr int EL4 = DQK * DV / 4;
    for (int g = C.bid * NT + C.tid; g < BATCH * NH * 2 * EL4; g += C.G * NT) {
        const int e4 = (g % EL4) * 4, ch = g / EL4, dir = ch & 1, bh = ch >> 1;
        f32x4 st = (f32x4){0.f, 0.f, 0.f, 0.f};
#pragma unroll 13
        for (int idx = 0; idx < NBLK; ++idx) {
            const int blk = dir == 0 ? idx : (idx == 0 ? 0 : NBLK - idx); const int u = bh * NBLK + blk;
            const float dec = __expf(BT[u * 2 + dir]);
            const f32x4 dc = *(const f32x4*)(DC + (size_t)(u * 2 + dir) * DQK * DV + e4);
            u32x2 o; o.x = cvt2(st.x, st.y); o.y = cvt2(st.z, st.w);
            *(u32x2*)(CST + (size_t)(u * 2 + dir) * DQK * DV + e4) = o;
            st = st * dec + dc;
        }
    }
    for (int g = C.bid * NT + C.tid; g < BATCH * NH * 2 * DQK; g += C.G * NT) {
        const int d = g % DQK, ch = g / DQK, dir = ch & 1, bh = ch >> 1; float st = 0.f;
        for (int idx = 0; idx < NBLK; ++idx) {
            const int blk = dir == 0 ? idx : (idx == 0 ? 0 : NBLK - idx); const int u = bh * NBLK + blk;
            NST[(size_t)(u * 2 + dir) * DQK + d] = st; st = __expf(BT[u * 2 + dir]) * st + DN[(size_t)(u * 2 + dir) * DQK + d];
        }
    }
}
__device__ __forceinline__ void lds_barrier() { asm volatile("s_waitcnt lgkmcnt(0)" ::: "memory"); __builtin_amdgcn_s_barrier(); asm volatile("" ::: "memory"); }
__device__ __forceinline__ void phase_s3(const Args& A, const Ctx& C, int l) {
    const int jl = l >> 1; const bool ctx_out = (l == 0);
    LAS float* bf = (LAS float*)C.lds; LAS float* bb = bf + 256; LAS float* gf = bb + 256; LAS float* gb = gf + 256;
    LAS float* nf = gb + 256; LAS float* nb = nf + 128; LAS float* ssx = nb + 128;
    LAS float* cf = ssx + 256; LAS float* cb = cf + 256;
    constexpr int KP = 272, OP = 528, CHB = 16384, NCHB = 4;
    LAS unsigned char* Kimg = C.lds + 8192;
    LAS unsigned char* CH = Kimg + 256 * KP;
    static_assert(8192 + 256 * KP + 128 * OP <= LDS_TAB_END && NCHB * CHB <= 128 * OP, "S3 LDS map");
    const bf16* P = (const bf16*)(A.ws + WS_PB); const bf16* VT = (const bf16*)(A.ws + WS_VT); unsigned char* HM = A.ws + WS_HM;
    const bf16* CST = (const bf16*)(A.ws + WS_CST); const float* NST = (const float*)(A.ws + WS_NST);
    const float* hg = A.in[10] + (size_t)jl * NV;
    const int w = C.wave, eh = w >> 2;
    for (int u = C.bid; u < NUNIT; u += C.G) {
        const int blk = u % NBLK, bh = u / NBLK, h = bh % NH, b = bh / NH; const int row0 = blk_row0(b, blk);
        if (blk == 0 && !ctx_out) continue;
        bf16x8 qf[8];
#define S3_LOAD_Q(ps_) do { int lq = threadIdx.x & 63; asm volatile("" : "+v"(lq)); const bf16* qr = P + (size_t)(row0 + 32 * (2 * (w & 3) + (ps_)) + (lq & 31)) * PW + h * DQK + 8 * (lq >> 5); \
            _Pragma("unroll") for (int kk = 0; kk < 8; ++kk) qf[kk] = *(const bf16x8*)(qr + 16 * kk); } while (0)
        S3_LOAD_Q(0);
        int tu = threadIdx.x; asm volatile("" : "+v"(tu));
        block_gates(A, row0, h, bf, bb, gf, gb, tu);
        if (tu < 256) { gf[tu] -= bf[tu]; gb[tu] -= bb[tu]; cf[tu] = __expf(bf[tu | 31] + gf[tu]); cb[tu] = __expf(bb[tu & ~31] + gb[tu]); }
        else { const int t2 = tu - 256; nf[t2] = NST[(size_t)(u * 2 + (t2 >> 7)) * DQK + (t2 & 127)]; }
        { const int pc = tu & 15, s0 = tu >> 4; const bf16* kr = P + (size_t)(row0 + s0) * PW + NQ + h * DQK + 8 * pc;
#pragma unroll
          for (int i = 0; i < 8; ++i) *(LAS u32x4*)(Kimg + (s0 + 32 * i) * KP + pc * 16) = *(const u32x4*)(kr + (size_t)(32 * i) * PW); }
        __syncthreads();
        const bf16* vtile = VT + (size_t)vt_tile(b, h, blk) * 65536;
        const bf16* ctile = CST + (size_t)(u * 2) * DQK * DV;
#pragma unroll 1
        for (int ps = 0; ps < 2; ++ps) {
            int lz = threadIdx.x & 63; asm volatile("" : "+v"(lz));
            const int r = lz & 31, hh = lz >> 5;
            const int jt = 2 * (w & 3) + ps; const int jrow = row0 + 32 * jt + r;
            const float bfj = bf[32 * jt + r], bbj = bb[32 * jt + r];
            float qnf = 0.f, qnb = 0.f;
#pragma unroll
            for (int kk = 0; kk < 8; ++kk) { const u32x4 qq = __builtin_bit_cast(u32x4, qf[kk]); const int d = 16 * kk + 8 * hh;
                const f32x4 n0 = *(const LAS f32x4*)(nf + d), n1 = *(const LAS f32x4*)(nf + d + 4), m0 = *(const LAS f32x4*)(nb + d), m1 = *(const LAS f32x4*)(nb + d + 4);
                qnf += (bflo(qq.x) * n0.x + bfhi(qq.x) * n0.y) + (bflo(qq.y) * n0.z + bfhi(qq.y) * n0.w) + (bflo(qq.z) * n1.x + bfhi(qq.z) * n1.y) + (bflo(qq.w) * n1.z + bfhi(qq.w) * n1.w);
                qnb += (bflo(qq.x) * m0.x + bfhi(qq.x) * m0.y) + (bflo(qq.y) * m0.z + bfhi(qq.y) * m0.w) + (bflo(qq.z) * m1.x + bfhi(qq.z) * m1.y) + (bflo(qq.w) * m1.z + bfhi(qq.w) * m1.w);
                if (kk & 1) asm volatile("" ::: "memory"); }
            qnf += __shfl_xor(qnf, 32); qnb += __shfl_xor(qnb, 32);
            float denf = 0.f, denb = 0.f;
#pragma unroll 1
            for (int kt = 0; kt < 8; ++kt) {
                f32x16 c;
#pragma unroll
                for (int i = 0; i < 16; ++i) c[i] = 0.f;
#pragma unroll
                for (int kk = 0; kk < 8; ++kk) { const bf16x8 a = *(const LAS bf16x8*)(Kimg + (kt * 32 + r) * KP + (16 * kk + 8 * hh) * 2); c = MFMA32(a, qf[kk], c); }
                if (kt == jt) {
#pragma unroll
                    for (int g = 0; g < 4; ++g) { const int sl0 = 8 * g + 4 * hh;
                        const f32x4 g4f = *(const LAS f32x4*)(gf + kt * 32 + sl0), g4b = *(const LAS f32x4*)(gb + kt * 32 + sl0);
#pragma unroll
                        for (int q = 0; q < 4; ++q) { const int sl = sl0 + q; const float cv = c[4 * g + q];
                            denf += cv * __expf((sl <= r) ? bfj + g4f[q] : -1.0e30f); denb += cv * __expf((sl >= r) ? bbj + g4b[q] : -1.0e30f); } }
                } else {
                    LAS const float* cx = (kt < jt ? cf : cb) + kt * 32 + 4 * hh; float sm = 0.f;
#pragma unroll
                    for (int g = 0; g < 4; ++g) { const f32x4 c4 = *(const LAS f32x4*)(cx + 8 * g); sm += (c[4 * g] * c4.x + c[4 * g + 1] * c4.y) + (c[4 * g + 2] * c4.z + c[4 * g + 3] * c4.w); }
                    if (kt < jt) denf += sm * __expf(bfj - bf[kt * 32 + 31]); else denb += sm * __expf(bbj - bb[kt * 32]);
                }
            }
            denf += __shfl_xor(denf, 32); denb += __shfl_xor(denb, 32);
            const float ebf = __expf(bfj), ebb = __expf(bbj);
            denf += ebf * qnf; denb += ebb * qnb;
            const float rf = 1.0f / fmaxf(fabsf(denf), 1.0f), rb = 1.0f / fmaxf(fabsf(denb), 1.0f);
            const float scf = ebf * rf, scb = ebb * rb;
            float wdg[16];
#pragma unroll
            for (int g = 0; g < 4; ++g) { const int sl0 = 8 * g + 4 * hh;
                const f32x4 g4f = *(const LAS f32x4*)(gf + jt * 32 + sl0), g4b = *(const LAS f32x4*)(gb + jt * 32 + sl0);
#pragma unroll
                for (int q = 0; q < 4; ++q) { const int sl = sl0 + q; wdg[4 * g + q] = rf * __expf((sl <= r) ? bfj + g4f[q] : -1.0e30f) + rb * __expf((sl >= r) ? bbj + g4b[q] : -1.0e30f); } }
            f32x16 acc[4];
#pragma unroll
            for (int et = 0; et < 4; ++et)
#pragma unroll
                for (int i = 0; i < 16; ++i) acc[et][i] = 0.f;
            const unsigned ringb = (unsigned)(size_t)CH + (unsigned)w * 2048u;
            const unsigned dlp = (unsigned)(((lz & 3) ^ ((lz >> 4) & 3)) * 16), drow = (unsigned)(32 * w + (lz >> 2));
#define S3_DMA(c_) do { const int cc_ = (c_); const bool isv_ = cc_ < 8; \
                const unsigned long long gp_ = (unsigned long long)(isv_ ? (const char*)vtile + 64 * cc_ : (const char*)ctile + (cc_ >= 12 ? 2 * DQK * DV : 0) + 64 * ((cc_ - 8) & 3)); \
                const char* gb_ = (const char*)(((unsigned long long)(unsigned)__builtin_amdgcn_readfirstlane((int)(unsigned)(gp_ >> 32)) << 32) | (unsigned)__builtin_amdgcn_readfirstlane((int)(unsigned)gp_)); \
                _Pragma("unroll") for (int jj = 0; jj < 2; ++jj) \
                    asm volatile("s_mov_b32 m0, %2\n\ts_nop 0\n\tglobal_load_lds_dwordx4 %0, %1" :: "v"(((drow + 16u * jj) << (isv_ ? 9 : 8)) + dlp), "s"(gb_), "s"(ringb + (unsigned)((cc_ & 3) * CHB + jj * 1024)) : "memory"); } while (0)
            asm volatile("s_waitcnt vmcnt(0)" ::: "memory");
            lds_barrier();
            S3_DMA(0); S3_DMA(1); S3_DMA(2);
            const int swz = (r >> 2) & 3;
#pragma unroll 1
            for (int ci = 0; ci < 8; ++ci) {
                asm volatile("s_waitcnt vmcnt(4)" ::: "memory");
                lds_barrier();
                S3_DMA(ci + 3);
                LAS const unsigned char* CHc = CH + (ci & 3) * CHB;
                { const int kt = ci;
                        f32x16 c;
#pragma unroll
                        for (int i = 0; i < 16; ++i) c[i] = 0.f;
#pragma unroll
                        for (int kk = 0; kk < 8; ++kk) { const bf16x8 a = *(const LAS bf16x8*)(Kimg + (kt * 32 + r) * KP + (16 * kk + 8 * hh) * 2); c = MFMA32(a, qf[kk], c); }
                        float p[16]; const float bfj2 = bf[32 * jt + r], bbj2 = bb[32 * jt + r];
                        if (kt == jt) {
#pragma unroll
                            for (int i = 0; i < 16; ++i) p[i] = c[i] * wdg[i];
                        } else {
                            LAS const float* cx = (kt < jt ? cf : cb) + kt * 32 + 4 * hh;
                            const float rw = (kt < jt) ? rf * __expf(bfj2 - bf[kt * 32 + 31]) : rb * __expf(bbj2 - bb[kt * 32]);
#pragma unroll
                            for (int g = 0; g < 4; ++g) { const f32x4 c4 = *(const LAS f32x4*)(cx + 8 * g);
                                p[4 * g] = c[4 * g] * (c4.x * rw); p[4 * g + 1] = c[4 * g + 1] * (c4.y * rw); p[4 * g + 2] = c[4 * g + 2] * (c4.z * rw); p[4 * g + 3] = c[4 * g + 3] * (c4.w * rw); }
                        }
                        const bf16x8 pa0 = pack8(p[0], p[1], p[2], p[3], p[4], p[5], p[6], p[7]), pa1 = pack8(p[8], p[9], p[10], p[11], p[12], p[13], p[14], p[15]);
#pragma unroll
                        for (int et = 0; et < 4; ++et) { LAS const unsigned char* vb = CHc + ((4 * eh + et) * 32 + r) * 64 + 8 * hh;
                            const u32x2 l0 = *(LAS const u32x2*)(vb + ((0 ^ swz) << 4)), h0 = *(LAS const u32x2*)(vb + ((1 ^ swz) << 4)), l1 = *(LAS const u32x2*)(vb + ((2 ^ swz) << 4)), h1 = *(LAS const u32x2*)(vb + ((3 ^ swz) << 4));
                            const bf16x8 a0 = __builtin_bit_cast(bf16x8, (u32x4){l0.x, l0.y, h0.x, h0.y}), a1 = __builtin_bit_cast(bf16x8, (u32x4){l1.x, l1.y, h1.x, h1.y});
                            acc[et] = MFMA32(a0, pa0, acc[et]); acc[et] = MFMA32(a1, pa1, acc[et]); }
                }
            }
#pragma unroll
            for (int ci = 8; ci < 16; ++ci) {
                if (ci <= 13) asm volatile("s_waitcnt vmcnt(4)" ::: "memory"); else if (ci == 14) asm volatile("s_waitcnt vmcnt(2)" ::: "memory"); else asm volatile("s_waitcnt vmcnt(0)" ::: "memory");
                lds_barrier();
                if (ci + 3 < 16) S3_DMA(ci + 3);
                LAS const unsigned char* CHc = CH + (ci & 3) * CHB;
                {
                    const int dir = (ci - 8) >> 2, dq = (ci - 8) & 3;
                    const float sc = dir ? scb : scf;
#pragma unroll
                    for (int k2 = 0; k2 < 2; ++k2) { const u32x4 qq = __builtin_bit_cast(u32x4, qf[2 * dq + k2]);
                        const bf16x8 qs = pack8(bflo(qq.x) * sc, bfhi(qq.x) * sc, bflo(qq.y) * sc, bfhi(qq.y) * sc, bflo(qq.z) * sc, bfhi(qq.z) * sc, bflo(qq.w) * sc, bfhi(qq.w) * sc);
#pragma unroll
                        for (int et = 0; et < 4; ++et) { const bf16x8 a = *(const LAS bf16x8*)(CHc + ((4 * eh + et) * 32 + r) * 64 + (((2 * k2 + hh) ^ swz) << 4)); acc[et] = MFMA32(a, qs, acc[et]); } }
                }
            }
#undef S3_DMA
            if (ps == 0) S3_LOAD_Q(1);
            u32x4 ov[8]; f32x4 g0, g1;
            { int tz = threadIdx.x; asm volatile("" : "+v"(tz)); const int pc = tz & 31, lr0 = tz >> 5;
              g0 = *(const f32x4*)(hg + h * DV + 8 * pc); g1 = *(const f32x4*)(hg + h * DV + 8 * pc + 4);
#pragma unroll
              for (int i = 0; i < 8; ++i) { const int lr = lr0 + 16 * i; const int grow = row0 + 64 * (lr >> 5) + 32 * ps + (lr & 31); ov[i] = *(const u32x4*)(P + (size_t)grow * PW + 2 * NQ + NV + h * DV + 8 * pc); } }
            float ss = 0.f;
#pragma unroll
            for (int et = 0; et < 4; ++et)
#pragma unroll
                for (int i = 0; i < 16; ++i) ss += acc[et][i] * acc[et][i];
            ss += __shfl_xor(ss, 32);
            if (hh == 0) ssx[w * 32 + r] = ss;
            lds_barrier();
            ss += ssx[(w ^ 4) * 32 + r];
            const float rs = 1.0f / sqrtf(ss * (1.0f / DV) + EPS);
            { LAS unsigned char* ob = CH + ((w & 3) * 32 + r) * OP + (eh * 128 + 4 * hh) * 2;
#pragma unroll
              for (int et = 0; et < 4; ++et)
#pragma unroll
                  for (int g = 0; g < 4; ++g) { u32x2 o; o.x = cvt2(acc[et][4 * g + 0] * rs, acc[et][4 * g + 1] * rs); o.y = cvt2(acc[et][4 * g + 2] * rs, acc[et][4 * g + 3] * rs);
                      *(LAS u32x2*)(ob + (et * 32 + 8 * g) * 2) = o; } }
            lds_barrier();
            { int tz = threadIdx.x; asm volatile("" : "+v"(tz)); const int pc = tz & 31, lr0 = tz >> 5;
#pragma unroll
              for (int i = 0; i < 8; ++i) { const int lr = lr0 + 16 * i; const int grow = row0 + 64 * (lr >> 5) + 32 * ps + (lr & 31);
                  const u32x4 hv = *(const LAS u32x4*)(CH + lr * OP + pc * 16);
                  const f32x4 o0 = (f32x4){bflo(hv.x) * g0.x * bflo(ov[i].x), bfhi(hv.x) * g0.y * bfhi(ov[i].x), bflo(hv.y) * g0.z * bflo(ov[i].y), bfhi(hv.y) * g0.w * bfhi(ov[i].y)};
                  const f32x4 o1 = (f32x4){bflo(hv.z) * g1.x * bflo(ov[i].z), bfhi(hv.z) * g1.y * bfhi(ov[i].z), bflo(hv.w) * g1.z * bflo(ov[i].w), bfhi(hv.w) * g1.w * bfhi(ov[i].w)};
                  *(u32x2*)(HM + (size_t)grow * D + h * DV + 8 * pc) = (u32x2){pack_i8(o0 * (127.0f / HMR)), pack_i8(o1 * (127.0f / HMR))}; } }
        }
        __syncthreads();
    }
#undef S3_LOAD_Q
}

#define XB_TMO      128
#define XB_XCNT(j)  (256  + 64 * (j))
#define XB_XSUB(j)  (1280 + 64 * (j))
#define XB_XGEN(j)  (2304 + 64 * (j))
#define XB_TOP      3328
#define XB_TOPGEN   3392
#define XCD_BAR_WORDS 3456
#define XB_SPIN_CAP (1u << 18)

__device__ __forceinline__ unsigned xb_ld(unsigned* p)              { return __hip_atomic_load(p, __ATOMIC_RELAXED, __HIP_MEMORY_SCOPE_AGENT); }
__device__ __forceinline__ unsigned xb_add(unsigned* p, unsigned v) { return __hip_atomic_fetch_add(p, v, __ATOMIC_RELAXED, __HIP_MEMORY_SCOPE_AGENT); }
__device__ __forceinline__ unsigned xb_xcc_id() { return (unsigned)__builtin_amdgcn_s_getreg((3 << 11) | 20) & 0xFu; }
#define XB_SPIN(cond, bar) do { unsigned _sp = 0; while (cond) { __builtin_amdgcn_s_sleep(1); \
    if ((++_sp & 255u) == 0u) { if (xb_ld(&(bar)[XB_TMO])) break; if (_sp > XB_SPIN_CAP) { atomicAdd(&(bar)[XB_TMO], 1u); break; } } } } while (0)

struct XcdBarrier {
    unsigned* bar; unsigned x;
    volatile LAS unsigned* st;
};

__device__ __forceinline__ XcdBarrier xcd_barrier_post(unsigned* bar, volatile LAS unsigned* st) {
    XcdBarrier b; b.bar = bar; b.x = xb_xcc_id(); b.st = st;
    if (threadIdx.x == 0) (void)xb_add(&bar[XB_XCNT(b.x)], 1u);
    return b;
}
__device__ __forceinline__ void xcd_barrier_complete(unsigned* bar, unsigned x, unsigned& nloc, unsigned& nx) {
    const unsigned G = gridDim.x * gridDim.y * gridDim.z;
    unsigned sum, cnt, mine, sp = 0u;
    for (;;) {
        sum = 0u; cnt = 0u; mine = 0u;
#pragma unroll
        for (unsigned j = 0; j < 16; ++j) { const unsigned c = xb_ld(&bar[XB_XCNT(j)]); sum += c; cnt += (c > 0u) ? 1u : 0u; mine = (j == x) ? c : mine; }
        if (sum == G) break;
        __builtin_amdgcn_s_sleep(1);
        if ((++sp & 255u) == 0u) { if (xb_ld(&bar[XB_TMO])) break; if (sp > XB_SPIN_CAP) { atomicAdd(&bar[XB_TMO], 1u); break; } }
    }
    nloc = mine > 0u ? mine : 1u; nx = cnt > 0u ? cnt : 1u;
}

__device__ __forceinline__ void xcd_barrier(const XcdBarrier& b) {
    asm volatile("s_waitcnt vmcnt(0)" ::: "memory");
    __syncthreads();
    if (threadIdx.x == 0) {
        unsigned* bar = b.bar;
        __builtin_amdgcn_s_waitcnt(0);
        unsigned nloc = b.st[0], nx = b.st[1];
        if (nloc == 0u) { xcd_barrier_complete(bar, b.x, nloc, nx); b.st[0] = nloc; b.st[1] = nx; }
        const unsigned old = xb_add(&bar[XB_XSUB(b.x)], 1u);
        const unsigned gen = old / nloc;
        if (old + 1u == (gen + 1u) * nloc) {
            __builtin_amdgcn_fence(__ATOMIC_RELEASE, "agent");
            asm volatile("s_waitcnt vmcnt(0)" ::: "memory");
            const unsigned og = xb_add(&bar[XB_TOP], 1u);
            const unsigned tg = og / nx;
            if (og + 1u == (tg + 1u) * nx) xb_add(&bar[XB_TOPGEN], 1u);
            else XB_SPIN(xb_ld(&bar[XB_TOPGEN]) == tg, bar);
            __builtin_amdgcn_fence(__ATOMIC_ACQUIRE, "agent");
            xb_add(&bar[XB_XGEN(b.x)], 1u);
            asm volatile("s_waitcnt vmcnt(0)" ::: "memory");
        } else {
            XB_SPIN(xb_ld(&bar[XB_XGEN(b.x)]) == gen, bar);
            __builtin_amdgcn_fence(__ATOMIC_ACQUIRE, "agent");
            asm volatile("s_waitcnt vmcnt(0)" ::: "memory");
        }
    }
    __syncthreads();
}


constexpr int LDS_BYTES = 152 * 1024;
constexpr int CW_BAR = 16384;
static_assert((CW_BAR + XCD_BAR_WORDS) * 4 <= (int)CTL_BYTES, "ctl");
#ifndef MK_MULTI
#define MK_MULTI 0
#endif
#define IN(p) (lo <= (p) && (p) < hi)
#define SEAM(p) do { if ((p) + 1 < hi) { XcdBarrier b_; b_.bar = (unsigned*)(load_args().ws + WS_CTL) + CW_BAR; b_.x = xb_xcc_id(); b_.st = (volatile LAS unsigned*)(C.lds + LDS_BYTES - 16); xcd_barrier(b_); } } while (0)
#define CAS __attribute__((address_space(4)))
__device__ __forceinline__ Args load_args() {
#if defined(__HIP_DEVICE_COMPILE__)
    const CAS Args* p = (const CAS Args*)__builtin_amdgcn_kernarg_segment_ptr(); asm volatile("" : "+s"(p));
    Args a; for (int i = 0; i < 22; ++i) a.in[i] = p->in[i]; a.out = p->out; a.ws = p->ws; a.lo = p->lo; a.hi = p->hi; return a;
#else
    return Args{};
#endif
}
__device__ __forceinline__ Ctx fresh(const Ctx& C) { Ctx R = C; int tz = threadIdx.x; asm volatile("" : "+v"(tz)); R.tid = tz; R.lane = tz & 63; return R; }
template <int L> __device__ __forceinline__ void layer_phases(const Args& args, const Ctx& C, int bar, int lo, int hi) {
    constexpr int pb = 16 * L;
    if (IN(pb + 1)) { phase_r1(load_args(), fresh(C), L); SEAM(pb + 1); }
    if (IN(pb + 2)) { phase_g1(load_args(), fresh(C), L); SEAM(pb + 2); }
    if constexpr ((L & 1) == 0) {
        if (IN(pb + 3)) { phase_s1(load_args(), fresh(C), L); SEAM(pb + 3); }
        if (IN(pb + 4)) { phase_s2(load_args(), fresh(C)); SEAM(pb + 4); }
        if (IN(pb + 5)) { phase_s3(load_args(), fresh(C), L); SEAM(pb + 5); }
    } else {
        if (IN(pb + 3)) { phase_conv(load_args(), fresh(C), L); SEAM(pb + 3); }
    }
    if (IN(pb + 6)) { phase_g2(load_args(), fresh(C), L); SEAM(pb + 6); }
    if (IN(pb + 7)) { phase_r2(load_args(), fresh(C), L); SEAM(pb + 7); }
    if (IN(pb + 8)) { phase_m1(load_args(), fresh(C), L); SEAM(pb + 8); }
    if (IN(pb + 9)) { phase_m2(load_args(), fresh(C), L); SEAM(pb + 9); }
}
__global__ void __launch_bounds__(NT, 2) fwd_kernel(Args args) {
    extern __shared__ __attribute__((aligned(16))) unsigned char lds_raw[];
    Ctx C; C.lds = (LAS unsigned char*)lds_raw; C.tid = threadIdx.x; C.lane = C.tid & 63; C.wave = __builtin_amdgcn_readfirstlane(C.tid >> 6); C.G = gridDim.x; C.bid = blockIdx.x; C.a = &args;
    const int lo = args.lo, hi = args.hi;
    volatile LAS unsigned* xbw = (volatile LAS unsigned*)(C.lds + LDS_BYTES - 16);
    if (C.tid < 4) xbw[C.tid] = 0u;
    __syncthreads();
    if (hi - lo > 1) (void)xcd_barrier_post((unsigned*)(args.ws + WS_CTL) + CW_BAR, xbw);
    const int bar = 0; (void)bar;
    if (IN(0)) { phase_mod(load_args(), fresh(C)); __syncthreads(); phase_cvt_mixer(load_args(), fresh(C)); SEAM(0); }
    layer_phases<0>(args, C, bar, lo, hi);
    layer_phases<1>(args, C, bar, lo, hi);
    layer_phases<2>(args, C, bar, lo, hi);
    layer_phases<3>(args, C, bar, lo, hi);
    if (IN(64)) phase_final(load_args(), fresh(C));
}
#undef IN
#undef SEAM

extern "C" void kernel_launch(void* const* d_in, const int* in_sizes, int n_in, void* d_out, int out_size, void* d_ws, size_t ws_size, hipStream_t stream) {
    static int grid = 0;
    if (grid == 0) {
        if (n_in != 22 || out_size != NL * D || ws_size < WS_END) { fprintf(stderr, "kernel_launch: unexpected shapes (n_in %d out %d ws %zu)\n", n_in, out_size, ws_size); grid = -1; return; }
        int dev = 0, cus = 0, per_cu = 0;
        if (hipGetDevice(&dev) != hipSuccess || hipDeviceGetAttribute(&cus, hipDeviceAttributeMultiprocessorCount, dev) != hipSuccess) { grid = -1; return; }
        if (hipFuncSetAttribute((const void*)fwd_kernel, hipFuncAttributeMaxDynamicSharedMemorySize, LDS_BYTES) != hipSuccess) { grid = -1; return; }
        if (hipOccupancyMaxActiveBlocksPerMultiprocessor(&per_cu, (const void*)fwd_kernel, NT, LDS_BYTES) != hipSuccess || per_cu < 1) { fprintf(stderr, "kernel_launch: occupancy query says %d\n", per_cu); }
        (void)hipGetLastError();
        grid = cus;
    }
    if (grid < 0) return;
    (void)hipMemsetAsync((char*)d_ws + WS_CTL, 0, CTL_BYTES, stream);
    Args a{};
    for (int i = 0; i < 22; ++i) a.in[i] = (const float*)d_in[i];
    a.out = (float*)d_out; a.ws = (unsigned char*)d_ws;
#if MK_MULTI
    int phases[64]; int np = 0;
    phases[np++] = 0;
    for (int l = 0; l < DEPTH; ++l) { const int pb = 16 * l; phases[np++] = pb + 1; phases[np++] = pb + 2; phases[np++] = pb + 3;
        if ((l & 1) == 0) { phases[np++] = pb + 4; phases[np++] = pb + 5; }
        phases[np++] = pb + 6; phases[np++] = pb + 7; phases[np++] = pb + 8; phases[np++] = pb + 9; }
    phases[np++] = 64;
    for (int i = 0; i < np; ++i) { a.lo = phases[i]; a.hi = phases[i] + 1; hipLaunchKernelGGL(fwd_kernel, dim3(grid), dim3(NT), LDS_BYTES, stream, a); }
#else
    a.lo = 0; a.hi = 65;
    hipLaunchKernelGGL(fwd_kernel, dim3(grid), dim3(NT), LDS_BYTES, stream, a);
#ifdef PROBE_PHASES
    { const int pp[] = {PROBE_PHASES};
      for (int rep = 0; rep < PROBE_REPS; ++rep) for (unsigned i = 0; i < sizeof(pp) / sizeof(pp[0]); ++i) { a.lo = pp[i]; a.hi = pp[i] + 1; hipLaunchKernelGGL(fwd_kernel, dim3(grid), dim3(NT), LDS_BYTES, stream, a); } }
#endif
#endif
}
```

```cpp
#include <hip/hip_runtime.h>
#include <cstdio>
#include <cstdint>

#define LAS __attribute__((address_space(3)))
typedef unsigned short bf16;
typedef float f32x4 __attribute__((ext_vector_type(4)));
typedef unsigned u32x4 __attribute__((ext_vector_type(4)));
typedef unsigned u32x2 __attribute__((ext_vector_type(2)));
typedef int i32x4r __attribute__((ext_vector_type(4)));

constexpr int D = 1024, BATCH = 2, SEQ = 16384, DEPTH = 4, CTXL = 256;
constexpr int NL = BATCH * SEQ, NCX = BATCH * CTXL, NR = NL + NCX;
constexpr int NH = 4, DQK = 128, DV = 256, NQ = 512, NV = 1024, PROJ = 3088, PW = 3072;
constexpr int NGRP = 4, EPG = 8, NE = 32, DE = 512;
constexpr int NBLK = 65;
constexpr int NUNIT = BATCH * NH * NBLK;
constexpr int CAP = NR;
constexpr int YROWS = 74752;
constexpr float EPS = 1e-6f;
constexpr float WSCALE = 32.0f;
constexpr float YSCALE = 4.0f;
constexpr int NT = 512, NW = 8;
constexpr int LDS_TAB_END = 152 * 1024 - 16;

constexpr size_t MiB = 1u << 20;
constexpr size_t WS_CTL = 0, CTL_BYTES = 1 * MiB;
constexpr size_t WS_MOD = 1 * MiB;
constexpr size_t WS_GATE = 2 * MiB;
constexpr size_t WS_TOKSLOT = 5 * MiB;
constexpr size_t WS_TOKW = 6 * MiB;
constexpr size_t WS_SLOTTOK = 7 * MiB;
constexpr size_t WS_DN = 12 * MiB;
constexpr size_t WS_NST = 13 * MiB;
constexpr size_t WS_BTOT = 14 * MiB;
constexpr size_t WS_RSC = 15 * MiB;
constexpr size_t WS_LAT = 16 * MiB;
constexpr size_t WS_HB = 146 * MiB;
constexpr size_t WS_PB = 211 * MiB;
constexpr size_t WS_HM = 406 * MiB;
constexpr size_t WS_DC = 471 * MiB;
constexpr size_t WS_CST = 601 * MiB;
constexpr size_t WS_VT = 666 * MiB;
constexpr size_t WS_WAIN = 731 * MiB;
constexpr size_t WS_WBIN = 743 * MiB;
constexpr size_t WS_WAOUT = 755 * MiB;
constexpr size_t WS_WBOUT = 759 * MiB;
constexpr size_t WS_WGU = 763 * MiB;
constexpr size_t WS_WDN = 827 * MiB;
constexpr size_t WS_H8 = 843 * MiB;
constexpr size_t WS_END = 880 * MiB;
constexpr int CW_WMAX = 256;
constexpr int CW_CNT = 1024, CNT_STRIDE = 64;

struct Args { const float* in[22]; float* out; unsigned char* ws; int lo, hi; };

typedef short bf16x8 __attribute__((ext_vector_type(8)));
typedef float f32x2 __attribute__((ext_vector_type(2)));
typedef __bf16 bf16x2_t __attribute__((ext_vector_type(2)));
__device__ __forceinline__ unsigned cvt2(float lo, float hi) { const f32x2 v = {lo, hi}; return __builtin_bit_cast(unsigned, __builtin_convertvector(v, bf16x2_t)); }
__device__ __forceinline__ float bf2f(bf16 v) { return __uint_as_float(((unsigned)v) << 16); }
__device__ __forceinline__ unsigned f2bf(float f) { unsigned u = __float_as_uint(f); return (u + 0x7fffu + ((u >> 16) & 1u)) >> 16; }
__device__ __forceinline__ unsigned pk2(float lo, float hi) { return f2bf(lo) | (f2bf(hi) << 16); }
template <int CTRL, int ROWMASK> __device__ __forceinline__ float dpp_mov(float x) { return __int_as_float(__builtin_amdgcn_update_dpp(0, __float_as_int(x), CTRL, ROWMASK, 0xf, false)); }
__device__ __forceinline__ float wave_sum(float v) {
    v += dpp_mov<0xB1, 0xf>(v); v += dpp_mov<0x4E, 0xf>(v); v += dpp_mov<0x141, 0xf>(v); v += dpp_mov<0x140, 0xf>(v);
    v += dpp_mov<0x142, 0xA>(v); v += dpp_mov<0x143, 0xC>(v);
    return __int_as_float(__builtin_amdgcn_readlane(__float_as_int(v), 63));
}
__device__ __forceinline__ float wave_max_nn(float v) {
    v = fmaxf(v, dpp_mov<0xB1, 0xf>(v)); v = fmaxf(v, dpp_mov<0x4E, 0xf>(v)); v = fmaxf(v, dpp_mov<0x141, 0xf>(v)); v = fmaxf(v, dpp_mov<0x140, 0xf>(v));
    v = fmaxf(v, dpp_mov<0x142, 0xA>(v)); v = fmaxf(v, dpp_mov<0x143, 0xC>(v));
    return __int_as_float(__builtin_amdgcn_readlane(__float_as_int(v), 63));
}
__device__ __forceinline__ unsigned pack_i8(f32x4 v) {
    const int a = (int)__builtin_rintf(fminf(fmaxf(v.x, -127.f), 127.f)), b = (int)__builtin_rintf(fminf(fmaxf(v.y, -127.f), 127.f)), c = (int)__builtin_rintf(fminf(fmaxf(v.z, -127.f), 127.f)), d = (int)__builtin_rintf(fminf(fmaxf(v.w, -127.f), 127.f));
    return (unsigned)(a & 255) | ((unsigned)(b & 255) << 8) | ((unsigned)(c & 255) << 16) | ((unsigned)d << 24);
}
__device__ __forceinline__ float sigmoidf_(float x) { return 1.f / (1.f + __expf(-x)); }
__device__ __forceinline__ float siluf_(float x) { return x / (1.f + __expf(-x)); }
__device__ __forceinline__ float logsigmoidf_(float x) { return fminf(x, 0.f) - log1pf(__expf(-fabsf(x))); }
__device__ __forceinline__ int blk_row0(int b, int blk) { return blk == 0 ? NL + b * CTXL : b * SEQ + (blk - 1) * 256; }
__device__ __forceinline__ int mod_vec_of_row(int row) { return row < NL ? row / SEQ : 2; }

struct Ctx {
    LAS unsigned char* lds; int tid, lane, wave, G, bid;
    const Args* a;
};

__device__ __forceinline__ int expert_block_prefix(const unsigned* cnt, int lane, int& nb) {
    nb = lane < NE ? ((int)cnt[lane * CNT_STRIDE] + 255) / 256 : 0; int v = nb;
#pragma unroll
    for (int o = 1; o < 64; o <<= 1) { const int t = __shfl_up(v, o); v += (lane >= o) ? t : 0; }
    return v - nb;
}
__device__ __forceinline__ void slot_bases(const Args& A, int l, LAS int* sb, int tid) {
    if (tid < 64) { int nb; const int ex = expert_block_prefix((const unsigned*)(A.ws + WS_CTL) + CW_CNT + l * 32 * CNT_STRIDE, tid, nb); if (tid <= NE) sb[tid] = ex * 256; }
    __syncthreads();
}

__device__ __forceinline__ void phase_mod(const Args& A, const Ctx& C) {
    LAS float* sc = (LAS float*)C.lds;
    LAS float* red = sc + 3072;
    const float* c = A.in[1]; const float* cc = A.in[3];
    for (int i = C.tid; i < 3072; i += NT) { const float v = i < 2048 ? c[i] : cc[i - 2048]; sc[i] = siluf_(v); }
    __syncthreads();
    float* MOD = (float*)(A.ws + WS_MOD);
    for (int u = C.bid; u < DEPTH * 96; u += C.G) {
        const int l = u / 96, cg = u % 96, col = cg * 64 + C.lane;
        const float* w = A.in[4] + (size_t)l * D * 6 * D + col;
        float a0 = 0.f, a1 = 0.f, a2 = 0.f;
#pragma unroll 32
        for (int k = C.wave * 128; k < C.wave * 128 + 128; ++k) { const float wv = w[(size_t)k * 6 * D]; a0 += sc[k] * wv; a1 += sc[1024 + k] * wv; a2 += sc[2048 + k] * wv; }
        red[(C.wave * 3 + 0) * 64 + C.lane] = a0; red[(C.wave * 3 + 1) * 64 + C.lane] = a1; red[(C.wave * 3 + 2) * 64 + C.lane] = a2;
        __syncthreads();
        if (C.tid < 192) { const int v = C.tid / 64, ln = C.tid % 64; float s = 0.f;
            for (int w8 = 0; w8 < 8; ++w8) s += red[(w8 * 3 + v) * 64 + ln];
            MOD[(size_t)(l * 3 + v) * 6 * D + cg * 64 + ln] = s + A.in[5][(size_t)l * 6 * D + cg * 64 + ln]; }
        __syncthreads();
    }
}

__device__ __forceinline__ void load_row_f32(const float* p, int lane, f32x4 (&v)[4]) {
#pragma unroll
    for (int j = 0; j < 4; ++j) v[j] = *(const f32x4*)(p + 4 * lane + 256 * j);
}
__device__ __forceinline__ void load_row_bf16(const bf16* p, int lane, f32x4 (&v)[4]) {
#pragma unroll
    for (int j = 0; j < 4; ++j) { const u32x2 w = *(const u32x2*)(p + 4 * lane + 256 * j);
        v[j] = (f32x4){__uint_as_float(w.x << 16), __uint_as_float(w.x & 0xffff0000u), __uint_as_float(w.y << 16), __uint_as_float(w.y & 0xffff0000u)}; }
}
__device__ __forceinline__ void store_row_bf16(bf16* p, int lane, const f32x4 (&v)[4]) {
#pragma unroll
    for (int j = 0; j < 4; ++j) { u32x2 w; w.x = pk2(v[j].x, v[j].y); w.y = pk2(v[j].z, v[j].w); *(u32x2*)(p + 4 * lane + 256 * j) = w; }
}
constexpr int CVT_IG = (D / 64) * (DE / 32), CVT_ID = (DE / 64) * (D / 32), CVT_PER = 2 * CVT_IG + CVT_ID, CVT_ITEMS = NE * CVT_PER;
constexpr int CVT_Q = 24;
__device__ __forceinline__ void cvt_moe_items(const Args& A, const Ctx& C, int l, int it0, int end, int stride);
__device__ __forceinline__ void cvt_win_i8(const Args& A, const Ctx& C);
__device__ __forceinline__ int cvt_t2(int l, int G);
struct RowVec { f32x4 a[4], s[4], g[4]; };
__device__ __forceinline__ void load_rowvec(RowVec& R, const float* ng, const float* sh, const float* sc, const float* gt, int lane) {
    f32x4 n[4], c[4]; load_row_f32(ng, lane, n); load_row_f32(sc, lane, c); load_row_f32(sh, lane, R.s); if (gt) load_row_f32(gt, lane, R.g);
#pragma unroll
    for (int q = 0; q < 4; ++q) R.a[q] = n[q] * (1.f + c[q]);
}
__device__ __forceinline__ void load_row_bf16raw(const bf16* p, int lane, u32x2 (&v)[4]) {
#pragma unroll
    for (int j = 0; j < 4; ++j) v[j] = *(const u32x2*)(p + 4 * lane + 256 * j);
}
__device__ __forceinline__ void store_row_fp8(unsigned char* p, int lane, const f32x4 (&v)[4]) {
#pragma unroll
    for (int j = 0; j < 4; ++j) { int w = 0; w = __builtin_amdgcn_cvt_pk_fp8_f32(v[j].x, v[j].y, w, false); w = __builtin_amdgcn_cvt_pk_fp8_f32(v[j].z, v[j].w, w, true); *(unsigned*)(p + 4 * lane + 256 * j) = (unsigned)w; }
}
__device__ __forceinline__ void load_row_fp8raw(const unsigned char* p, int lane, unsigned (&v)[4]) {
#pragma unroll
    for (int j = 0; j < 4; ++j) v[j] = *(const unsigned*)(p + 4 * lane + 256 * j);
}
__device__ __forceinline__ f32x4 fp8x4(unsigned w) { const f32x2 lo = __builtin_amdgcn_cvt_pk_f32_fp8((int)w, false), hi = __builtin_amdgcn_cvt_pk_f32_fp8((int)w, true); return (f32x4){lo.x, lo.y, hi.x, hi.y}; }
__device__ __forceinline__ f32x4 bf4(u32x2 w) { return (f32x4){__uint_as_float(w.x << 16), __uint_as_float(w.x & 0xffff0000u), __uint_as_float(w.y << 16), __uint_as_float(w.y & 0xffff0000u)}; }
__device__ __forceinline__ float row_rstd(const f32x4 (&v)[4]) {
    float s = 0.f;
#pragma unroll
    for (int j = 0; j < 4; ++j) s += (v[j].x * v[j].x + v[j].y * v[j].y) + (v[j].z * v[j].z + v[j].w * v[j].w);
    return 1.0f / sqrtf(wave_sum(s) * (1.f / D) + EPS);
}

__device__ __forceinline__ void phase_r1(const Args& A, const Ctx& C, int l) {
    LAS int* sb = (LAS int*)C.lds;
    LAS float* GW = (LAS float*)(C.lds + 256);
    const bool mls = (l & 1) == 0; const int j = l >> 1;
    if (l == 0) { cvt_win_i8(A, C); __syncthreads(); }
    if (l > 0) slot_bases(A, l - 1, sb, C.tid);
    if (mls) { const float* w = A.in[8] + (size_t)j * D * PROJ + PW;
        f32x4 t[2][4];
#pragma unroll
        for (int jj = 0; jj < 2; ++jj)
#pragma unroll
            for (int q = 0; q < 4; ++q) t[jj][q] = *(const f32x4*)(w + (size_t)(C.tid + NT * jj) * PROJ + 4 * q);
#pragma unroll
        for (int jj = 0; jj < 2; ++jj)
#pragma unroll
            for (int q = 0; q < 4; ++q) { const int k = C.tid + NT * jj; GW[(4 * q + 0) * D + k] = t[jj][q].x; GW[(4 * q + 1) * D + k] = t[jj][q].y; GW[(4 * q + 2) * D + k] = t[jj][q].z; GW[(4 * q + 3) * D + k] = t[jj][q].w; }
        __syncthreads(); }
    const int nrows = (l <= 2) ? NR : NL;
    bf16* LAT = (bf16*)(A.ws + WS_LAT); unsigned char* HI8 = A.ws + WS_H8; float* RSC = (float*)(A.ws + WS_RSC); float* GATE = (float*)(A.ws + WS_GATE);
    const float* MOD = (const float*)(A.ws + WS_MOD); const unsigned char* Y8 = A.ws + WS_PB;
    const int* TS = (const int*)(A.ws + WS_TOKSLOT); const float* TW = (const float*)(A.ws + WS_TOKW);
    const int rpw = (((nrows + C.G - 1) / C.G) + 1) & ~1; const int wrow0 = C.bid * rpw; const int wend = min(wrow0 + rpw, nrows);
    for (int sa = wrow0; sa < wend;) {
        const int mvi = mod_vec_of_row(sa); const int bnd = mvi == 0 ? SEQ : (mvi == 1 ? NL : NR); const int sbnd = min(wend, bnd);
        RowVec RV; { const float* mv = MOD + (size_t)(l * 3 + mvi) * 6 * D;
            load_rowvec(RV, A.in[6] + (size_t)(l * 2 + 0) * D, mv + 0 * D, mv + 1 * D, l > 0 ? MOD + (size_t)((l - 1) * 3 + mvi) * 6 * D + 5 * D : nullptr, C.lane); }
        const int rlast = sbnd - 2;
        i32x4r tsn = (i32x4r){0, 0, 0, 0}; f32x4 twn = (f32x4){0.f, 0.f, 0.f, 0.f};
        if (l > 0) { const int r0 = min(sa + 2 * C.wave, rlast); tsn = *(const i32x4r*)(TS + r0 * 2); twn = *(const f32x4*)(TW + r0 * 2); }
        for (int ra = sa + 2 * C.wave; ra < sbnd; ra += 2 * NW) {
            const bool hasb = true; const int rb = ra + 1;
            const i32x4r tsc = tsn; const f32x4 twc = twn;
            if (l > 0) { const int r1 = min(ra + 2 * NW, rlast); tsn = *(const i32x4r*)(TS + r1 * 2); twn = *(const f32x4*)(TW + r1 * 2); }
            f32x4 va[4], vb[4]; float wa0 = 0.f, wa1 = 0.f, wb0 = 0.f, wb1 = 0.f;
            if (l == 0) { load_row_f32(ra < NL ? A.in[0] + (size_t)ra * D : A.in[2] + (size_t)(ra - NL) * D, C.lane, va); load_row_f32(rb < NL ? A.in[0] + (size_t)rb * D : A.in[2] + (size_t)(rb - NL) * D, C.lane, vb); }
            else {
                const int ta0 = tsc.x, ta1 = tsc.y, tb0 = tsc.z, tb1 = tsc.w; wa0 = twc.x; wa1 = twc.y; wb0 = twc.z; wb1 = twc.w;
                load_row_bf16(LAT + (size_t)ra * D, C.lane, va); load_row_bf16(LAT + (size_t)rb * D, C.lane, vb);
                unsigned ya0[4], ya1[4], yb0[4], yb1[4];
                load_row_fp8raw(Y8 + (size_t)(sb[ta0 >> 20] + (ta0 & 0xfffff)) * D, C.lane, ya0); load_row_fp8raw(Y8 + (size_t)(sb[ta1 >> 20] + (ta1 & 0xfffff)) * D, C.lane, ya1);
                load_row_fp8raw(Y8 + (size_t)(sb[tb0 >> 20] + (tb0 & 0xfffff)) * D, C.lane, yb0); load_row_fp8raw(Y8 + (size_t)(sb[tb1 >> 20] + (tb1 & 0xfffff)) * D, C.lane, yb1);
                wa0 *= 1.0f / YSCALE; wa1 *= 1.0f / YSCALE; wb0 *= 1.0f / YSCALE; wb1 *= 1.0f / YSCALE;
#pragma unroll
                for (int q = 0; q < 4; ++q) { va[q] += RV.g[q] * (fp8x4(ya0[q]) * wa0 + fp8x4(ya1[q]) * wa1); vb[q] += RV.g[q] * (fp8x4(yb0[q]) * wb0 + fp8x4(yb1[q]) * wb1); }
            }
            store_row_bf16(LAT + (size_t)ra * D, C.lane, va); if (hasb) store_row_bf16(LAT + (size_t)rb * D, C.lane, vb);
            const float rra = row_rstd(va), rrb = row_rstd(vb);
            f32x4 ha[4], hb[4];
#pragma unroll
            for (int q = 0; q < 4; ++q) { ha[q] = (va[q] * rra) * RV.a[q] + RV.s[q]; hb[q] = (vb[q] * rrb) * RV.a[q] + RV.s[q]; }
            { float ma = 0.f, mb = 0.f;
#pragma unroll
              for (int q = 0; q < 4; ++q) { ma = fmaxf(ma, fmaxf(fmaxf(fabsf(ha[q].x), fabsf(ha[q].y)), fmaxf(fabsf(ha[q].z), fabsf(ha[q].w)))); mb = fmaxf(mb, fmaxf(fmaxf(fabsf(hb[q].x), fabsf(hb[q].y)), fmaxf(fabsf(hb[q].z), fabsf(hb[q].w)))); }
              ma = fmaxf(wave_max_nn(ma), 1.0e-20f); mb = fmaxf(wave_max_nn(mb), 1.0e-20f);
              const float ia = 127.0f / ma, ib = 127.0f / mb;
#pragma unroll
              for (int q = 0; q < 4; ++q) { *(unsigned*)(HI8 + (size_t)ra * D + 4 * C.lane + 256 * q) = pack_i8(ha[q] * ia); *(unsigned*)(HI8 + (size_t)rb * D + 4 * C.lane + 256 * q) = pack_i8(hb[q] * ib); }
              if (C.lane == 0) { RSC[ra] = ma * (1.0f / 127.0f); RSC[rb] = mb * (1.0f / 127.0f); } }
            if (mls) {
                float ga = 0.f, gb = 0.f;
#pragma unroll 2
                for (int c = 0; c < 16; ++c) { float s0 = 0.f, s1 = 0.f;
#pragma unroll
                    for (int q = 0; q < 4; ++q) { const f32x4 w = *(const LAS f32x4*)(GW + c * D + 4 * C.lane + 256 * q);
                        s0 += (ha[q].x * w.x + ha[q].y * w.y) + (ha[q].z * w.z + ha[q].w * w.w); s1 += (hb[q].x * w.x + hb[q].y * w.y) + (hb[q].z * w.z + hb[q].w * w.w); }
                    s0 = wave_sum(s0); s1 = wave_sum(s1); ga = (C.lane == c) ? s0 : ga; gb = (C.lane == c) ? s1 : gb; }
                if (C.lane < 16) {
                    const float bgt = A.in[9][j * 16 + C.lane]; const int gtype = C.lane >> 2;
                    ga += bgt; gb += bgt;
                    GATE[(size_t)ra * 16 + C.lane] = (gtype & 1) ? logsigmoidf_(ga) : 15.0f * tanhf(ga * (1.0f / 15.0f));
                    if (hasb) GATE[(size_t)rb * 16 + C.lane] = (gtype & 1) ? logsigmoidf_(gb) : 15.0f * tanhf(gb * (1.0f / 15.0f)); }
            }
        }
        sa = sbnd;
    }
}

__device__ __forceinline__ void phase_r2(const Args& A, const Ctx& C, int l) {
    constexpr int WP = 2064;
    LAS unsigned char* RWB = C.lds;
    LAS float* WL = (LAS float*)(C.lds + 48 * WP);
    LAS unsigned* hist = (LAS unsigned*)(WL + 8 * 16 * 48);
    LAS unsigned* gbase = hist + 32;
    constexpr int RCAP = 144;
    LAS int* rec = (LAS int*)(gbase + 32);
    static_assert(48 * WP + 8 * 16 * 48 * 4 + 256 + RCAP * 16 <= LDS_TAB_END, "R2 LDS map");
    cvt_moe_items(A, C, l, cvt_t2(l, C.G) + C.bid * NW + C.wave, CVT_ITEMS, C.G * NW);
    __syncthreads();
    { const float* wg = A.in[15] + (size_t)l * D * NGRP; const float* wr = A.in[17] + (size_t)l * D * NE;
      { const int kp = C.tid; const f32x4 x0 = *(const f32x4*)(wg + (size_t)(2 * kp) * 4), x1 = *(const f32x4*)(wg + (size_t)(2 * kp + 1) * 4);
        *(LAS unsigned*)(RWB + 0 * WP + kp * 4) = cvt2(x0.x, x1.x); *(LAS unsigned*)(RWB + 1 * WP + kp * 4) = cvt2(x0.y, x1.y);
        *(LAS unsigned*)(RWB + 2 * WP + kp * 4) = cvt2(x0.z, x1.z); *(LAS unsigned*)(RWB + 3 * WP + kp * 4) = cvt2(x0.w, x1.w); }
      f32x4 t0[8], t1[8];
#pragma unroll
      for (int jj = 0; jj < 8; ++jj) { const int it = C.tid + NT * jj, kp = it >> 3, cg = it & 7; t0[jj] = *(const f32x4*)(wr + (size_t)(2 * kp) * NE + 4 * cg); t1[jj] = *(const f32x4*)(wr + (size_t)(2 * kp + 1) * NE + 4 * cg); }
#pragma unroll
      for (int jj = 0; jj < 8; ++jj) { const int it = C.tid + NT * jj, kp = it >> 3, c0 = 4 + 4 * (it & 7);
          *(LAS unsigned*)(RWB + (c0 + 0) * WP + kp * 4) = cvt2(t0[jj].x, t1[jj].x); *(LAS unsigned*)(RWB + (c0 + 1) * WP + kp * 4) = cvt2(t0[jj].y, t1[jj].y);
          *(LAS unsigned*)(RWB + (c0 + 2) * WP + kp * 4) = cvt2(t0[jj].z, t1[jj].z); *(LAS unsigned*)(RWB + (c0 + 3) * WP + kp * 4) = cvt2(t0[jj].w, t1[jj].w); }
      for (int i = C.tid; i < 12 * 512; i += NT) *(LAS unsigned*)(RWB + (36 + i / 512) * WP + (i % 512) * 4) = 0u; }
    const int nrows = (l <= 1) ? NR : NL;
    bf16* LAT = (bf16*)(A.ws + WS_LAT); bf16* H = (bf16*)(A.ws + WS_HB); unsigned char* H8 = A.ws + WS_H8;
    const float* MOD = (const float*)(A.ws + WS_MOD);
    unsigned* cnt = (unsigned*)(A.ws + WS_CTL) + CW_CNT + l * 32 * CNT_STRIDE;
    int* TS = (int*)(A.ws + WS_TOKSLOT); float* TW = (float*)(A.ws + WS_TOKW); int* ST = (int*)(A.ws + WS_SLOTTOK);
    const int rpw = (((nrows + C.G - 1) / C.G) + 1) & ~1; const int wrow0 = C.bid * rpw; const int wend0 = min(wrow0 + rpw, nrows);
    const float* bg = A.in[16] + l * NGRP; const float* br = A.in[18] + l * NE;
    for (int cb = wrow0; cb < wend0; cb += RCAP) {
        const int wend = min(cb + RCAP, wend0);
        if (C.tid < 32) hist[C.tid] = 0u;
        for (int sa = cb; sa < wend;) {
            const int mvi = mod_vec_of_row(sa); const int bnd = mvi == 0 ? SEQ : (mvi == 1 ? NL : NR); const int sbnd = min(wend, bnd);
            RowVec RV; { const float* mv = MOD + (size_t)(l * 3 + mvi) * 6 * D; load_rowvec(RV, A.in[6] + (size_t)(l * 2 + 1) * D, mv + 3 * D, mv + 4 * D, mv + 2 * D, C.lane); }
            const int rlast = sbnd - 2;
            u32x2 la[4], lb[4], ya[4], yb[4];
            { const int r0 = min(sa + 2 * C.wave, rlast); load_row_bf16raw(LAT + (size_t)r0 * D, C.lane, la); load_row_bf16raw(LAT + (size_t)(r0 + 1) * D, C.lane, lb);
              load_row_bf16raw(H + (size_t)r0 * D, C.lane, ya); load_row_bf16raw(H + (size_t)(r0 + 1) * D, C.lane, yb); }
            for (int ra = sa + 2 * C.wave; ra < sbnd; ra += 2 * NW) {
                const int rb = ra + 1;
                u32x2 lan[4], lbn[4], yan[4], ybn[4];
                { const int r1 = min(ra + 2 * NW, rlast); load_row_bf16raw(LAT + (size_t)r1 * D, C.lane, lan); load_row_bf16raw(LAT + (size_t)(r1 + 1) * D, C.lane, lbn);
                  load_row_bf16raw(H + (size_t)r1 * D, C.lane, yan); load_row_bf16raw(H + (size_t)(r1 + 1) * D, C.lane, ybn); }
                f32x4 va[4], vb[4];
#pragma unroll
                for (int q = 0; q < 4; ++q) { va[q] = bf4(la[q]) + RV.g[q] * bf4(ya[q]); vb[q] = bf4(lb[q]) + RV.g[q] * bf4(yb[q]); }
                store_row_bf16(LAT + (size_t)ra * D, C.lane, va); store_row_bf16(LAT + (size_t)rb * D, C.lane, vb);
                const float rra = row_rstd(va), rrb = row_rstd(vb);
                f32x4 ha[4], hb[4];
#pragma unroll
                for (int q = 0; q < 4; ++q) { ha[q] = (va[q] * rra) * RV.a[q] + RV.s[q]; hb[q] = (vb[q] * rrb) * RV.a[q] + RV.s[q]; }
                store_row_bf16(H + (size_t)ra * D, C.lane, ha); store_row_bf16(H + (size_t)rb * D, C.lane, hb);
                store_row_fp8(H8 + (size_t)ra * D, C.lane, ha); store_row_fp8(H8 + (size_t)rb * D, C.lane, hb);
#pragma unroll
                for (int q = 0; q < 4; ++q) { la[q] = lan[q]; lb[q] = lbn[q]; ya[q] = yan[q]; yb[q] = ybn[q]; }
            }
            sa = sbnd;
        }
        __syncthreads();
        const int fr = C.lane & 15, fq = C.lane >> 4;
        for (int t = C.wave; t * 16 < wend - cb; t += NW) {
            const int trow = min(cb + 16 * t + fr, wend - 1);
            const bf16* hp = H + (size_t)trow * D + 8 * fq;
            f32x4 acc[3];
#pragma unroll
            for (int ct = 0; ct < 3; ++ct) acc[ct] = (f32x4){0.f, 0.f, 0.f, 0.f};
#pragma unroll 1
            for (int kb = 0; kb < 4; ++kb) {
                bf16x8 av[8];
#pragma unroll
                for (int k8 = 0; k8 < 8; ++k8) av[k8] = *(const bf16x8*)(hp + 32 * (8 * kb + k8));
#pragma unroll
                for (int k8 = 0; k8 < 8; ++k8)
#pragma unroll
                    for (int ct = 0; ct < 3; ++ct) { const bf16x8 bv = *(const LAS bf16x8*)(RWB + (ct * 16 + fr) * WP + (32 * (8 * kb + k8) + 8 * fq) * 2);
                        acc[ct] = __builtin_amdgcn_mfma_f32_16x16x32_bf16(av[k8], bv, acc[ct], 0, 0, 0); }
            }
            LAS float* wl = WL + C.wave * 16 * 48;
#pragma unroll
            for (int ct = 0; ct < 3; ++ct)
#pragma unroll
                for (int jq = 0; jq < 4; ++jq) wl[(4 * fq + jq) * 48 + ct * 16 + fr] = acc[ct][jq];
            asm volatile("s_waitcnt lgkmcnt(0)" ::: "memory");
            const int row = cb + 16 * t + C.lane;
            if (C.lane < 16 && row < wend) {
                LAS const float* wm = wl + C.lane * 48;
                float lg[36];
#pragma unroll
                for (int c = 0; c < 36; ++c) lg[c] = wm[c];
                float gl[4]; int grp = 0; float gm = -3.0e38f;
#pragma unroll
                for (int c = 0; c < 4; ++c) { gl[c] = lg[c] + bg[c]; if (gl[c] > gm) { gm = gl[c]; grp = c; } }
                float gs = 0.f;
#pragma unroll
                for (int c = 0; c < 4; ++c) gs += __expf(gl[c] - gm);
                const float pgrp = 1.0f / gs;
                float rl[8];
#pragma unroll
                for (int i = 0; i < 8; ++i) { float tt = 0.f;
#pragma unroll
                    for (int g = 0; g < 4; ++g) tt = (g == grp) ? lg[4 + g * 8 + i] : tt;
                    rl[i] = tt + br[grp * 8 + i]; }
                int i0 = 0; float m0 = rl[0];
#pragma unroll
                for (int i = 1; i < 8; ++i) if (rl[i] > m0) { m0 = rl[i]; i0 = i; }
                int i1 = -1; float m1 = -3.0e38f;
#pragma unroll
                for (int i = 0; i < 8; ++i) if (i != i0 && rl[i] > m1) { m1 = rl[i]; i1 = i; }
                const float p0 = 1.0f, p1 = __expf(m1 - m0);
                const float w0 = pgrp * p0 / (p0 + p1), w1 = pgrp * p1 / (p0 + p1);
                const int e0 = grp * 8 + i0, e1 = grp * 8 + i1;
                const unsigned q0 = __hip_atomic_fetch_add(hist + e0, 1u, __ATOMIC_RELAXED, __HIP_MEMORY_SCOPE_WORKGROUP), q1 = __hip_atomic_fetch_add(hist + e1, 1u, __ATOMIC_RELAXED, __HIP_MEMORY_SCOPE_WORKGROUP);
                const int li = row - cb;
                rec[li * 4 + 0] = e0 | (e1 << 8); rec[li * 4 + 1] = (int)q0; rec[li * 4 + 2] = (int)q1;
                TW[row * 2 + 0] = w0; TW[row * 2 + 1] = w1;
            }
        }
        __syncthreads();
        if (C.tid < 32) gbase[C.tid] = hist[C.tid] ? atomicAdd(cnt + C.tid * CNT_STRIDE, hist[C.tid]) : 0u;
        __syncthreads();
        for (int i = C.tid; i < wend - cb; i += NT) { const int row = cb + i; const int ee = rec[i * 4], e0 = ee & 255, e1 = ee >> 8;
            const unsigned q0 = gbase[e0] + (unsigned)rec[i * 4 + 1], q1 = gbase[e1] + (unsigned)rec[i * 4 + 2];
            ST[(size_t)e0 * CAP + q0] = row; ST[(size_t)e1 * CAP + q1] = row;
            TS[row * 2 + 0] = (e0 << 20) | (int)q0; TS[row * 2 + 1] = (e1 << 20) | (int)q1; }
        __syncthreads();
    }
}

__device__ __forceinline__ void phase_final(const Args& A, const Ctx& C) {
    LAS int* sb = (LAS int*)C.lds;
    slot_bases(A, 3, sb, C.tid);
    const bf16* LAT = (const bf16*)(A.ws + WS_LAT); const unsigned char* Y8 = A.ws + WS_PB;
    const int* TS = (const int*)(A.ws + WS_TOKSLOT); const float* TW = (const float*)(A.ws + WS_TOKW);
    const float* MOD = (const float*)(A.ws + WS_MOD);
    f32x4 fg[4]; load_row_f32(A.in[7], C.lane, fg);
    const int rpw = (((NL + C.G - 1) / C.G) + 1) & ~1; const int wrow0 = C.bid * rpw; const int wend = min(wrow0 + rpw, NL);
    for (int sa = wrow0; sa < wend;) {
        const int mvi = mod_vec_of_row(sa); const int sbnd = min(wend, mvi == 0 ? SEQ : NL);
        f32x4 g2[4]; load_row_f32(MOD + (size_t)(3 * 3 + mvi) * 6 * D + 5 * D, C.lane, g2);
        for (int ra = sa + 2 * C.wave; ra < sbnd; ra += 2 * NW) {
            const int rb = ra + 1;
            const int ta0 = TS[ra * 2], ta1 = TS[ra * 2 + 1], tb0 = TS[rb * 2], tb1 = TS[rb * 2 + 1]; const float wa0 = TW[ra * 2], wa1 = TW[ra * 2 + 1], wb0 = TW[rb * 2], wb1 = TW[rb * 2 + 1];
            f32x4 va[4], vb[4]; unsigned ya0[4], ya1[4], yb0[4], yb1[4];
            load_row_bf16(LAT + (size_t)ra * D, C.lane, va); load_row_bf16(LAT + (size_t)rb * D, C.lane, vb);
            load_row_fp8raw(Y8 + (size_t)(sb[ta0 >> 20] + (ta0 & 0xfffff)) * D, C.lane, ya0); load_row_fp8raw(Y8 + (size_t)(sb[ta1 >> 20] + (ta1 & 0xfffff)) * D, C.lane, ya1);
            load_row_fp8raw(Y8 + (size_t)(sb[tb0 >> 20] + (tb0 & 0xfffff)) * D, C.lane, yb0); load_row_fp8raw(Y8 + (size_t)(sb[tb1 >> 20] + (tb1 & 0xfffff)) * D, C.lane, yb1);
#pragma unroll
            for (int q = 0; q < 4; ++q) { va[q] += g2[q] * (fp8x4(ya0[q]) * (wa0 * (1.0f / YSCALE)) + fp8x4(ya1[q]) * (wa1 * (1.0f / YSCALE))); vb[q] += g2[q] * (fp8x4(yb0[q]) * (wb0 * (1.0f / YSCALE)) + fp8x4(yb1[q]) * (wb1 * (1.0f / YSCALE))); }
            const float rra = row_rstd(va), rrb = row_rstd(vb);
#pragma unroll
            for (int q = 0; q < 4; ++q) { *(f32x4*)(A.out + (size_t)ra * D + 4 * C.lane + 256 * q) = (va[q] * rra) * fg[q]; *(f32x4*)(A.out + (size_t)rb * D + 4 * C.lane + 256 * q) = (vb[q] * rrb) * fg[q]; }
        }
        sa = sbnd;
    }
}

__device__ __forceinline__ void phase_conv(const Args& A, const Ctx& C, int l) {
    const int j = l >> 1; const int nrows = (l <= 1) ? NR : NL;
    const bf16* P = (const bf16*)(A.ws + WS_PB); unsigned char* HM = A.ws + WS_HM; float* RSC = (float*)(A.ws + WS_RSC);
    const float* cw = A.in[13] + (size_t)j * 3 * D;
    f32x4 w0[4], w1[4], w2[4];
    load_row_f32(cw, C.lane, w0); load_row_f32(cw + D, C.lane, w1); load_row_f32(cw + 2 * D, C.lane, w2);
    const int rpw = (((nrows + C.G - 1) / C.G) + 1) & ~1; const int wrow0 = C.bid * rpw; const int wend = min(wrow0 + rpw, nrows);
    for (int ra = wrow0 + 2 * C.wave; ra < wend; ra += 2 * NW) {
        const int rb = ra + 1;
        const int ta = ra < NL ? (ra & 63) : ((ra - NL) & 255), tb1 = rb < NL ? (rb & 63) : ((rb - NL) & 255), tlast = ra < NL ? 63 : 255;
        const bool hasl = ta != 0, hasr = tb1 != tlast;
        const bf16* pa = P + (size_t)ra * PW;
        u32x2 bga[4], bgb[4], zm[4], z0[4], z1[4], z2[4];
        load_row_bf16raw(pa, C.lane, bga); load_row_bf16raw(pa + PW, C.lane, bgb);
        load_row_bf16raw(pa + D, C.lane, z0); load_row_bf16raw(pa + PW + D, C.lane, z1);
        load_row_bf16raw(hasl ? pa - PW + D : pa + D, C.lane, zm); load_row_bf16raw(hasr ? pa + 2 * PW + D : pa + D, C.lane, z2);
        const float fl = hasl ? 1.f : 0.f, fr = hasr ? 1.f : 0.f;
        f32x4 oa[4], ob[4];
#pragma unroll
        for (int q = 0; q < 4; ++q) { const f32x4 a0 = bf4(z0[q]), a1 = bf4(z1[q]);
            oa[q] = bf4(bga[q]) * (w0[q] * (bf4(zm[q]) * fl) + w1[q] * a0 + w2[q] * a1);
            ob[q] = bf4(bgb[q]) * (w0[q] * a0 + w1[q] * a1 + w2[q] * (bf4(z2[q]) * fr)); }
        float ma = 0.f, mb = 0.f;
#pragma unroll
        for (int q = 0; q < 4; ++q) { ma = fmaxf(ma, fmaxf(fmaxf(fabsf(oa[q].x), fabsf(oa[q].y)), fmaxf(fabsf(oa[q].z), fabsf(oa[q].w)))); mb = fmaxf(mb, fmaxf(fmaxf(fabsf(ob[q].x), fabsf(ob[q].y)), fmaxf(fabsf(ob[q].z), fabsf(ob[q].w)))); }
        ma = fmaxf(wave_max_nn(ma), 1.0e-20f); mb = fmaxf(wave_max_nn(mb), 1.0e-20f);
        const float ia = 127.0f / ma, ib = 127.0f / mb;
#pragma unroll
        for (int q = 0; q < 4; ++q) { *(unsigned*)(HM + (size_t)ra * D + 4 * C.lane + 256 * q) = pack_i8(oa[q] * ia); *(unsigned*)(HM + (size_t)rb * D + 4 * C.lane + 256 * q) = pack_i8(ob[q] * ib); }
        if (C.lane == 0) { RSC[ra] = ma * (1.0f / 127.0f); RSC[rb] = mb * (1.0f / 127.0f); }
    }
}

constexpr int BM = 256, BK = 64, HALF = 128, HTB = HALF * BK * 2, STAGE_BYTES = 8 * HTB, NXCD = 8, WGM = 8;
constexpr int LDS_TAB = STAGE_BYTES;
__device__ __forceinline__ int lds_byte(int r, int c) { const int st = (r >> 4) * 2 + (c >> 5), rr = r & 15, cc = c & 31, ob = rr * 64 + cc * 2; return st * 1024 + (ob ^ (((ob >> 9) & 1) << 5)); }
__device__ __forceinline__ void stage_rc(int b, int& R, int& C) { const int st = b / 1024, sb = b % 1024, swz = sb ^ (((sb >> 9) & 1) << 5); R = (st >> 1) * 16 + swz / 64; C = (st & 1) * 32 + (swz % 64) / 2; }
__device__ __forceinline__ int perm32(int rho) { const int n = rho >> 4, i = rho & 15; return 8 * (i >> 2) + 4 * n + (i & 3); }
__device__ __forceinline__ unsigned cvt_pk_bf16(float lo, float hi) { unsigned r; asm volatile("v_cvt_pk_bf16_f32 %0, %1, %2" : "=v"(r) : "v"(lo), "v"(hi)); return r; }

struct GUnit { const char* a; const char* b; int orow, ocol, aux; };

typedef int i32x8 __attribute__((ext_vector_type(8)));
typedef int i32x4 __attribute__((ext_vector_type(4)));
template <class Epi, class Sched, bool GATHER, int OPM = 0>
__device__ __forceinline__ void gemm_phase(LAS unsigned char* lds, const int K, const Sched& S, const Epi& E) {
    const int tid = threadIdx.x, wid = __builtin_amdgcn_readfirstlane(tid >> 6), lane = tid & 63, wr = wid >> 2, wc = wid & 3, fr = lane & 15, fq = lane >> 4;
    constexpr bool FP8 = (OPM == 1), I8 = (OPM == 2);
    const int RB = (OPM != 0) ? K : 2 * K;
    const int nt = RB / (BK * 2);
    unsigned voffB[2], voA[2][2]; int Rr[2], Cc[2];
#pragma unroll
    for (int i = 0; i < 2; ++i) { int R, C; stage_rc(tid * 16 + i * 8192, R, C); const int Rb = (R & ~31) + perm32(R & 31); Rr[i] = R; Cc[i] = C;
        voffB[i] = (unsigned)(Rb * RB + C * 2);
        voA[0][i] = (unsigned)(R * RB + C * 2); voA[1][i] = (unsigned)((R + HALF) * RB + C * 2); }
    const size_t kstep = (size_t)(BK * 2);
    const size_t hstep = (size_t)HALF * RB;
    const unsigned ldsw = (unsigned)wid * 1024u;
    const unsigned ldsbase = (unsigned)(size_t)lds;
    const int aoff = lds_byte(wr * 64 + fr, fq * 8), boff = lds_byte(wc * 32 + fr, fq * 8);
#define PG8_SA(b, h) (((b) * 2 + (h)) * HTB)
#define PG8_SB(b, h) ((4 + (b) * 2 + (h)) * HTB)
#define PG8_STAGE(bufoff, gbase, voff) do { _Pragma("unroll") for (int _i = 0; _i < 2; ++_i) \
        asm volatile("s_mov_b32 m0, %2\n\ts_nop 0\n\tglobal_load_lds_dwordx4 %0, %1" :: "v"((voff)[_i]), "s"((const char*)(gbase)), "s"(ldsbase + (unsigned)(bufoff) + ldsw + (unsigned)(_i * 8192)) : "memory"); } while (0)
#define PG8_STAGE_A1(bufoff, gbase) do { if constexpr (GATHER) PG8_STAGE(bufoff, gbase, voA[1]); else PG8_STAGE(bufoff, (const char*)(gbase) + hstep, voA[0]); } while (0)
#define PG8_LDA(dst, b, h) do { if constexpr (FP8) { _Pragma("unroll") for (int m = 0; m < 4; ++m) { \
        const i32x4 _lo = *(const LAS i32x4*)(lds + PG8_SA(b, h) + aoff + m * 2048), _hi = *(const LAS i32x4*)(lds + PG8_SA(b, h) + aoff + m * 2048 + 1024); \
        dst##8[m] = __builtin_shufflevector(_lo, _hi, 0, 1, 2, 3, 4, 5, 6, 7); } } \
      else { _Pragma("unroll") for (int m = 0; m < 4; ++m) _Pragma("unroll") for (int k = 0; k < 2; ++k) dst[m][k] = *(const LAS bf16x8*)(lds + PG8_SA(b, h) + aoff + m * 2048 + k * 1024); } } while (0)
#define PG8_LDB(dst, b, h) do { if constexpr (FP8) { _Pragma("unroll") for (int n = 0; n < 2; ++n) { \
        const i32x4 _lo = *(const LAS i32x4*)(lds + PG8_SB(b, h) + boff + n * 2048), _hi = *(const LAS i32x4*)(lds + PG8_SB(b, h) + boff + n * 2048 + 1024); \
        dst##8[n] = __builtin_shufflevector(_lo, _hi, 0, 1, 2, 3, 4, 5, 6, 7); } } \
      else { _Pragma("unroll") for (int n = 0; n < 2; ++n) _Pragma("unroll") for (int k = 0; k < 2; ++k) dst[n][k] = *(const LAS bf16x8*)(lds + PG8_SB(b, h) + boff + n * 2048 + k * 1024); } } while (0)
#define PG8_MMA(ai, bj, At, Bt) do { __builtin_amdgcn_s_setprio(1); \
        if constexpr (FP8) { _Pragma("unroll") for (int m = 0; m < 4; ++m) _Pragma("unroll") for (int n = 0; n < 2; ++n) \
            acc[ai][bj][m][n] = __builtin_amdgcn_mfma_scale_f32_16x16x128_f8f6f4(Bt##8[n], At##8[m], acc[ai][bj][m][n], 0, 0, 0, 0x7f7f7f7f, 0, 0x7f7f7f7f); } \
        else if constexpr (I8) { _Pragma("unroll") for (int m = 0; m < 4; ++m) _Pragma("unroll") for (int n = 0; n < 2; ++n) _Pragma("unroll") for (int k = 0; k < 2; ++k) \
            acc[ai][bj][m][n] = __builtin_bit_cast(f32x4, __builtin_amdgcn_mfma_i32_16x16x64_i8(__builtin_bit_cast(i32x4, Bt[n][k]), __builtin_bit_cast(i32x4, At[m][k]), __builtin_bit_cast(i32x4, acc[ai][bj][m][n]), 0, 0, 0)); } \
        else { _Pragma("unroll") for (int m = 0; m < 4; ++m) _Pragma("unroll") for (int n = 0; n < 2; ++n) _Pragma("unroll") for (int k = 0; k < 2; ++k) \
            acc[ai][bj][m][n] = __builtin_amdgcn_mfma_f32_16x16x32_bf16(Bt[n][k], At[m][k], acc[ai][bj][m][n], 0, 0, 0); } \
        __builtin_amdgcn_s_setprio(0); } while (0)
#define PG8_WAIT_V(n) asm volatile("s_waitcnt vmcnt(" #n ")" ::: "memory")
#define PG8_WAIT_L(n) asm volatile("s_waitcnt lgkmcnt(" #n ")" ::: "memory")
#define PG8_BAR __builtin_amdgcn_s_barrier()
#define PG8_SCHED __builtin_amdgcn_sched_barrier(0)
    GUnit cur, nxt; int ui = 0;
    if (!S.next(0, cur)) return;
    if constexpr (GATHER) {
#pragma unroll
        for (int h = 0; h < 2; ++h)
#pragma unroll
            for (int i = 0; i < 2; ++i) voA[h][i] = S.arow_off(0, h * HALF + Rr[i]) + (unsigned)Cc[i] * 2u;
    }
    f32x4 acc[2][2][4][2];
#pragma unroll
    for (int a = 0; a < 2; ++a)
#pragma unroll
        for (int b = 0; b < 2; ++b)
#pragma unroll
            for (int m = 0; m < 4; ++m)
#pragma unroll
                for (int n = 0; n < 2; ++n) acc[a][b][m][n] = (f32x4){0.f, 0.f, 0.f, 0.f};
    bf16x8 At[4][2], B0[2][2], B1[2][2]; i32x8 At8[4], B08[2], B18[2];
    const char* cA = cur.a; const char* cB = cur.b;
    PG8_STAGE(PG8_SB(0, 0), cB, voffB); PG8_STAGE(PG8_SB(0, 1), cB + hstep, voffB); PG8_STAGE(PG8_SA(0, 0), cA, voA[0]); PG8_STAGE_A1(PG8_SA(0, 1), cA);
    if (wr == 1) PG8_BAR;
    PG8_WAIT_V(2); PG8_BAR;
    PG8_STAGE(PG8_SB(1, 0), cB + kstep, voffB); PG8_STAGE(PG8_SA(1, 0), cA + kstep, voA[0]); PG8_STAGE(PG8_SB(1, 1), cB + hstep + kstep, voffB);
    PG8_WAIT_V(6); PG8_BAR;
    for (;;) {
        const bool has_next = S.next(ui + 1, nxt);
        const char* nA = has_next ? nxt.a : cA; const char* nB = has_next ? nxt.b : cB;
#pragma unroll 1
        for (int t = 0; t < nt; t += 2) {
            const bool last = (t == nt - 2);
            const char* a1 = cA + (size_t)(t + 1) * kstep;
            const char* a2 = last ? nA : cA + (size_t)(t + 2) * kstep; const char* b2 = last ? nB : cB + (size_t)(t + 2) * kstep;
            const char* a3 = a2 + kstep; const char* b3 = b2 + kstep;
            PG8_LDB(B0, 0, 0); PG8_LDB(B1, 0, 1); PG8_SCHED; PG8_LDA(At, 0, 0); PG8_STAGE_A1(PG8_SA(1, 1), a1);
            if constexpr (GATHER) { if (last && has_next) {
#pragma unroll
                for (int h = 0; h < 2; ++h)
#pragma unroll
                    for (int i = 0; i < 2; ++i) { int R2, C2; stage_rc(tid * 16 + i * 8192, R2, C2); voA[h][i] = S.arow_off(ui + 1, h * HALF + R2) + (unsigned)C2 * 2u; } } }
            PG8_WAIT_V(8); PG8_WAIT_L(0); PG8_BAR; PG8_MMA(0, 0, At, B0); PG8_MMA(0, 1, At, B1); PG8_BAR; PG8_SCHED;
            PG8_LDA(At, 0, 1); PG8_STAGE(PG8_SB(0, 0), b2, voffB); PG8_STAGE(PG8_SB(0, 1), b2 + hstep, voffB); PG8_STAGE(PG8_SA(0, 0), a2, voA[0]);
            PG8_WAIT_V(8); PG8_WAIT_L(0); PG8_BAR; PG8_MMA(1, 0, At, B0); PG8_MMA(1, 1, At, B1); PG8_BAR; PG8_SCHED;
            PG8_LDB(B0, 1, 0); PG8_LDB(B1, 1, 1); PG8_SCHED; PG8_LDA(At, 1, 0); PG8_STAGE_A1(PG8_SA(0, 1), a2);
            PG8_WAIT_V(8); PG8_WAIT_L(0); PG8_BAR; PG8_MMA(0, 0, At, B0); PG8_MMA(0, 1, At, B1); PG8_BAR; PG8_SCHED;
            PG8_LDA(At, 1, 1); PG8_STAGE(PG8_SB(1, 0), b3, voffB); PG8_STAGE(PG8_SB(1, 1), b3 + hstep, voffB); PG8_STAGE(PG8_SA(1, 0), a3, voA[0]);
            PG8_WAIT_V(8); PG8_WAIT_L(0); PG8_BAR; PG8_MMA(1, 0, At, B0); PG8_MMA(1, 1, At, B1); PG8_BAR; PG8_SCHED;
        }
        if (wr == 0) PG8_BAR;
        { int tz = threadIdx.x; asm volatile("" : "+v"(tz));
          if constexpr (I8) {
#pragma unroll
              for (int a_ = 0; a_ < 2; ++a_)
#pragma unroll
                  for (int b_ = 0; b_ < 2; ++b_)
#pragma unroll
                      for (int m = 0; m < 4; ++m)
#pragma unroll
                          for (int n = 0; n < 2; ++n) acc[a_][b_][m][n] = __builtin_convertvector(__builtin_bit_cast(i32x4, acc[a_][b_][m][n]), f32x4); }
          const int wz = tz >> 6, lz = tz & 63; E(acc, cur, wz >> 2, wz & 3, lz & 15, lz >> 4); }
        if (!has_next) break;
#pragma unroll
        for (int a = 0; a < 2; ++a)
#pragma unroll
            for (int b = 0; b < 2; ++b)
#pragma unroll
                for (int m = 0; m < 4; ++m)
#pragma unroll
                    for (int n = 0; n < 2; ++n) acc[a][b][m][n] = (f32x4){0.f, 0.f, 0.f, 0.f};
        cur = nxt; cA = nA; cB = nB; ++ui;
        if (wr == 1) PG8_BAR;
    }
    PG8_WAIT_V(0);
    PG8_BAR;
#undef PG8_SA
#undef PG8_SB
#undef PG8_STAGE
#undef PG8_STAGE_A1
#undef PG8_LDA
#undef PG8_LDB
#undef PG8_MMA
#undef PG8_WAIT_V
#undef PG8_WAIT_L
#undef PG8_BAR
#undef PG8_SCHED
}

__device__ __forceinline__ int xcd_remap(int L, int nwg) { const int q = nwg / NXCD, r = nwg % NXCD, xcd = L % NXCD, off = L / NXCD; return (xcd < r ? xcd * (q + 1) : r * (q + 1) + (xcd - r) * q) + off; }

struct DenseSched {
    const char* A; const char* Bt; int nM, nN, nwg, G, c; size_t tstep; int sw_lo, sw_hi;
    __device__ __forceinline__ void init(const void* A_, const void* Bt_, int M, int N, int K, int G_, int c_, int ebytes = 2) { A = (const char*)A_; Bt = (const char*)Bt_; nM = M / BM; nN = N / BM; nwg = nM * nN; G = G_; c = c_; tstep = (size_t)BM * K * ebytes; sw_lo = 0; sw_hi = 0; }
    __device__ __forceinline__ bool next(int i, GUnit& u) const {
        const long L = (long)i * G + c; if (L >= nwg) return false;
        const int wgid = xcd_remap((int)L, nwg);
        const int nig = WGM * nN, gid = wgid / nig, fm = gid * WGM, gsz = (nM - fm) < WGM ? (nM - fm) : WGM;
        const int pm = fm + ((wgid % nig) % gsz), pn = (wgid % nig) / gsz;
        if (pn >= sw_lo && pn < sw_hi) { u.a = Bt + (size_t)pn * tstep; u.b = A + (size_t)pm * tstep; u.orow = pm; u.ocol = pn - sw_lo; u.aux = 1; }
        else { u.a = A + (size_t)pm * tstep; u.b = Bt + (size_t)pn * tstep; u.orow = pm * BM; u.ocol = pn * BM; u.aux = 0; }
        return true;
    }
    __device__ __forceinline__ unsigned arow_off(int, int) const { return 0u; }
};

constexpr int MAXU = 12;
struct MoeTab { int n; int e[MAXU], mb[MAXU], nt[MAXU]; int sb[NE + 1]; };
struct MoeSched {
    LAS const MoeTab* T; LAS const unsigned* ridx;
    const char* A; const char* W; size_t wstride_e, tstepB; int K; int arow_bytes;
    __device__ __forceinline__ bool next(int i, GUnit& u) const {
        const int n = __builtin_amdgcn_readfirstlane(T->n); if (i >= n) return false;
        const int e = __builtin_amdgcn_readfirstlane(T->e[i]), mb = __builtin_amdgcn_readfirstlane(T->mb[i]), nt = __builtin_amdgcn_readfirstlane(T->nt[i]);
        const int base = __builtin_amdgcn_readfirstlane(T->sb[e]);
        u.orow = base + mb * BM; u.ocol = nt; u.aux = e;
        u.a = A + (size_t)u.orow * arow_bytes;
        u.b = W + (size_t)e * wstride_e + (size_t)nt * tstepB; return true;
    }
    __device__ __forceinline__ unsigned arow_off(int i, int r) const { return ridx[i * 256 + r]; }
};
template <bool GATHER>
__device__ __forceinline__ void moe_tables(const Args& A, const Ctx& C, int l, int ntile_n, LAS MoeTab* T, LAS unsigned* ridx, int arow_bytes) {
    const unsigned* cnt = (const unsigned*)(A.ws + WS_CTL) + CW_CNT + l * 32 * CNT_STRIDE;
    LAS int* ust = (LAS int*)(T + 1);
    if (C.tid < 64) { int nb; const int ex = expert_block_prefix(cnt, C.tid, nb); if (C.tid <= NE) { T->sb[C.tid] = ex * 256; ust[C.tid] = ex * ntile_n; } }
    __syncthreads();
    if (C.tid < MAXU) { const int nwg = ust[NE]; const long L = (long)C.tid * C.G + C.bid;
        if (L < nwg) { const int w = xcd_remap((int)L, nwg); int e = 0; while (w >= ust[e + 1]) ++e;
            const int lu = w - ust[e]; T->e[C.tid] = e; T->mb[C.tid] = lu / ntile_n; T->nt[C.tid] = lu % ntile_n; } }
    if (C.tid == 0) { const int nwg = ust[NE]; int n = 0; while (n < MAXU && (long)n * C.G + C.bid < nwg) ++n; T->n = n; }
    __syncthreads();
    if constexpr (GATHER) {
        const int* ST = (const int*)(A.ws + WS_SLOTTOK); const int n = T->n;
        for (int i = C.tid; i < n * 256; i += NT) { const int ui = i >> 8, r = i & 255, e = T->e[ui], m0 = T->mb[ui] * 256, ce = (int)cnt[e * CNT_STRIDE];
            const int rr = (m0 + r < ce) ? m0 + r : ce - 1;
            ridx[i] = (unsigned)ST[(size_t)e * CAP + rr] * (unsigned)arow_bytes; }
        __syncthreads();
    }
}

struct EpiStore { bf16* O; int ldc; float scale_lo; int sig_from; bf16* VT; float sall = 1.0f; const float* rs = nullptr;
    __device__ __forceinline__ void operator()(const f32x4 (&acc)[2][2][4][2], const GUnit& u, int wr, int wc, int fr, int fq) const {
        const bool tr = u.aux != 0;
        const float sc = ((!tr && u.ocol < NQ) ? scale_lo : 1.0f) * sall; const bool sg = !tr && u.ocol >= sig_from;
        bf16* Ob = tr ? VT + (size_t)(u.orow * NH + u.ocol) * 65536 : O + (size_t)u.orow * ldc + u.ocol; const int ld = tr ? 256 : ldc;
        f32x4 cs[2][2];
#pragma unroll
        for (int bj = 0; bj < 2; ++bj) { const f32x4 one = (f32x4){1.f, 1.f, 1.f, 1.f};
            cs[bj][0] = (rs && tr) ? *(const f32x4*)(rs + u.orow * BM + bj * HALF + wc * 32 + 8 * fq) : one; cs[bj][1] = (rs && tr) ? *(const f32x4*)(rs + u.orow * BM + bj * HALF + wc * 32 + 8 * fq + 4) : one; }
#pragma unroll
        for (int ai = 0; ai < 2; ++ai)
#pragma unroll
            for (int m = 0; m < 4; ++m) { const int rl = ai * HALF + wr * 64 + m * 16 + fr; bf16* rowp = Ob + (size_t)rl * ld + wc * 32 + 8 * fq;
                const float scr = (rs && !tr) ? sc * rs[u.orow + rl] : sc;
#pragma unroll
                for (int bj = 0; bj < 2; ++bj) { f32x4 v0 = acc[ai][bj][m][0] * scr * cs[bj][0], v1 = acc[ai][bj][m][1] * scr * cs[bj][1];
                    if (sg) {
#pragma unroll
                        for (int q = 0; q < 4; ++q) { v0[q] = __builtin_amdgcn_rcpf(1.0f + __expf(-v0[q])); v1[q] = __builtin_amdgcn_rcpf(1.0f + __expf(-v1[q])); } }
                    u32x4 w; w.x = cvt_pk_bf16(v0[0], v0[1]); w.y = cvt_pk_bf16(v0[2], v0[3]); w.z = cvt_pk_bf16(v1[0], v1[1]); w.w = cvt_pk_bf16(v1[2], v1[3]);
                    *(u32x4*)(rowp + bj * HALF) = w; } }
    }
};
__device__ __forceinline__ u32x2 cvt8_fp8(f32x4 a, f32x4 b) { int lo = 0, hi = 0;
    lo = __builtin_amdgcn_cvt_pk_fp8_f32(a[0], a[1], lo, false); lo = __builtin_amdgcn_cvt_pk_fp8_f32(a[2], a[3], lo, true);
    hi = __builtin_amdgcn_cvt_pk_fp8_f32(b[0], b[1], hi, false); hi = __builtin_amdgcn_cvt_pk_fp8_f32(b[2], b[3], hi, true); return (u32x2){(unsigned)lo, (unsigned)hi}; }
struct EpiSwigluF8 { unsigned char* O; int ldc; float s;
    __device__ __forceinline__ void operator()(const f32x4 (&acc)[2][2][4][2], const GUnit& u, int wr, int wc, int fr, int fq) const {
        const int ocol = u.ocol * HALF;
#pragma unroll
        for (int ai = 0; ai < 2; ++ai)
#pragma unroll
            for (int m = 0; m < 4; ++m) { unsigned char* rowp = O + (size_t)(u.orow + ai * HALF + wr * 64 + m * 16 + fr) * ldc + ocol + wc * 32 + 8 * fq;
                f32x4 v0, v1;
#pragma unroll
                for (int q = 0; q < 4; ++q) { const float x0 = acc[ai][0][m][0][q] * s, x1 = acc[ai][0][m][1][q] * s;
                    v0[q] = x0 * __builtin_amdgcn_rcpf(1.0f + __expf(-x0)) * (acc[ai][1][m][0][q] * s); v1[q] = x1 * __builtin_amdgcn_rcpf(1.0f + __expf(-x1)) * (acc[ai][1][m][1][q] * s); }
                *(u32x2*)rowp = cvt8_fp8(v0, v1); }
    }
};
template <int MODE> struct EpiPair { bf16* O; int ldc; int plain_below; float sall = 1.0f; const float* rs = nullptr;
    __device__ __forceinline__ void operator()(const f32x4 (&acc)[2][2][4][2], const GUnit& u, int wr, int wc, int fr, int fq) const {
        if (MODE == 0 && u.ocol < plain_below) {
#pragma unroll
            for (int ai = 0; ai < 2; ++ai)
#pragma unroll
                for (int m = 0; m < 4; ++m) { const int rg = u.orow + ai * HALF + wr * 64 + m * 16 + fr; bf16* rowp = O + (size_t)rg * ldc + u.ocol + wc * 32 + 8 * fq;
                    const float scr = rs ? sall * rs[rg] : sall;
#pragma unroll
                    for (int bj = 0; bj < 2; ++bj) { const f32x4 v0 = acc[ai][bj][m][0] * scr, v1 = acc[ai][bj][m][1] * scr;
                        u32x4 w; w.x = cvt_pk_bf16(v0[0], v0[1]); w.y = cvt_pk_bf16(v0[2], v0[3]); w.z = cvt_pk_bf16(v1[0], v1[1]); w.w = cvt_pk_bf16(v1[2], v1[3]);
                        *(u32x4*)(rowp + bj * HALF) = w; } }
            return;
        }
        const int ocol = (MODE == 0) ? plain_below + (u.ocol - plain_below) / 2 : u.ocol * HALF;
#pragma unroll
        for (int ai = 0; ai < 2; ++ai)
#pragma unroll
            for (int m = 0; m < 4; ++m) { const int rg = u.orow + ai * HALF + wr * 64 + m * 16 + fr; bf16* rowp = O + (size_t)rg * ldc + ocol + wc * 32 + 8 * fq;
                const float scr = rs ? sall * rs[rg] : sall; const float sc2 = scr * scr;
                f32x4 v0, v1;
#pragma unroll
                for (int q = 0; q < 4; ++q) {
                    const float x0 = acc[ai][0][m][0][q], x1 = acc[ai][0][m][1][q];
                    const float g0 = (MODE == 1) ? x0 * __builtin_amdgcn_rcpf(1.0f + __expf(-x0)) : x0, g1 = (MODE == 1) ? x1 * __builtin_amdgcn_rcpf(1.0f + __expf(-x1)) : x1;
                    v0[q] = g0 * acc[ai][1][m][0][q] * sc2; v1[q] = g1 * acc[ai][1][m][1][q] * sc2; }
                u32x4 w; w.x = cvt_pk_bf16(v0[0], v0[1]); w.y = cvt_pk_bf16(v0[2], v0[3]); w.z = cvt_pk_bf16(v1[0], v1[1]); w.w = cvt_pk_bf16(v1[2], v1[3]);
                *(u32x4*)rowp = w; }
    }
};
struct EpiStoreTile { unsigned char* O; int ldc; float s;
    __device__ __forceinline__ void operator()(const f32x4 (&acc)[2][2][4][2], const GUnit& u, int wr, int wc, int fr, int fq) const {
#pragma unroll
        for (int ai = 0; ai < 2; ++ai)
#pragma unroll
            for (int m = 0; m < 4; ++m) { unsigned char* rowp = O + (size_t)(u.orow + ai * HALF + wr * 64 + m * 16 + fr) * ldc + u.ocol * BM + wc * 32 + 8 * fq;
#pragma unroll
                for (int bj = 0; bj < 2; ++bj) *(u32x2*)(rowp + bj * HALF) = cvt8_fp8(acc[ai][bj][m][0] * s, acc[ai][bj][m][1] * s); }
    }
};

__device__ __forceinline__ void transpose_item(const float* W, int ldw, int K, bf16* WT, int drow0, int k0, int n0, LAS float* scr, int lane) {
#pragma unroll
    for (int i = 0; i < 32; ++i) { const int kk = 2 * i + (lane >> 5); scr[kk * 33 + (lane & 31)] = W[(size_t)(k0 + kk) * ldw + n0 + (lane & 31)]; }
    asm volatile("s_waitcnt lgkmcnt(0)" ::: "memory");
    const int c = lane & 7;
#pragma unroll
    for (int j = 0; j < 4; ++j) { const int n = (lane >> 3) + 8 * j; const LAS float* s = scr + (8 * c) * 33 + n;
        u32x4 o; o.x = pk2(s[0 * 33], s[1 * 33]); o.y = pk2(s[2 * 33], s[3 * 33]); o.z = pk2(s[4 * 33], s[5 * 33]); o.w = pk2(s[6 * 33], s[7 * 33]);
        *(u32x4*)(WT + (size_t)(drow0 + n) * K + k0 + 8 * c) = o; }
    asm volatile("s_waitcnt lgkmcnt(0)" ::: "memory");
}
__device__ __forceinline__ void transpose_item_fp8(const float* W, int ldw, int K, unsigned char* WT8, int drow0, int k0, int n0, LAS float* scr, int lane, float sc) {
#pragma unroll
    for (int i = 0; i < 32; ++i) { const int kk = 2 * i + (lane >> 5); scr[kk * 33 + (lane & 31)] = W[(size_t)(k0 + kk) * ldw + n0 + (lane & 31)]; }
    asm volatile("s_waitcnt lgkmcnt(0)" ::: "memory");
    const int n = lane >> 1, half = lane & 1; const LAS float* sp = scr + (32 * half) * 33 + n;
    unsigned char* dst = WT8 + (size_t)(drow0 + n) * K + k0 + 32 * half;
#pragma unroll
    for (int c = 0; c < 2; ++c) { u32x4 o;
#pragma unroll
        for (int q = 0; q < 4; ++q) { int p = 0; const LAS float* s4 = sp + (16 * c + 4 * q) * 33;
            p = __builtin_amdgcn_cvt_pk_fp8_f32(s4[0] * sc, s4[33] * sc, p, false); p = __builtin_amdgcn_cvt_pk_fp8_f32(s4[66] * sc, s4[99] * sc, p, true); o[q] = (unsigned)p; }
        *(u32x4*)(dst + 16 * c) = o; }
    asm volatile("s_waitcnt lgkmcnt(0)" ::: "memory");
}
__device__ __forceinline__ void transpose_item_i8(const float* W, int ldw, int K, unsigned char* WT8, int drow0, int k0, int n0, LAS float* scr, int lane, float inv) {
#pragma unroll
    for (int i = 0; i < 32; ++i) { const int kk = 2 * i + (lane >> 5); scr[kk * 33 + (lane & 31)] = W[(size_t)(k0 + kk) * ldw + n0 + (lane & 31)]; }
    asm volatile("s_waitcnt lgkmcnt(0)" ::: "memory");
    const int n = lane >> 1, half = lane & 1; const LAS float* sp = scr + (32 * half) * 33 + n;
    unsigned char* dst = WT8 + (size_t)(drow0 + n) * K + k0 + 32 * half;
#pragma unroll
    for (int c = 0; c < 2; ++c) { u32x4 o;
#pragma unroll
        for (int q = 0; q < 4; ++q) { const LAS float* s4 = sp + (16 * c + 4 * q) * 33; o[q] = pack_i8((f32x4){s4[0] * inv, s4[33] * inv, s4[66] * inv, s4[99] * inv}); }
        *(u32x4*)(dst + 16 * c) = o; }
    asm volatile("s_waitcnt lgkmcnt(0)" ::: "memory");
}
__device__ __forceinline__ int pair_row(int n, int which) { return (n >> 7) * 256 + (n & 127) + which * 128; }
constexpr float HMR = 6.0f;
__device__ __forceinline__ void phase_cvt_mixer(const Args& A, const Ctx& C) {
    const int gw = C.bid * NW + C.wave, NGW = C.G * NW;
    unsigned* wmax = (unsigned*)(A.ws + WS_CTL) + CW_WMAX;
    for (int m8 = 0; m8 < 8; ++m8) {
        const float* W = m8 < 2 ? A.in[8] + (size_t)m8 * D * PROJ : m8 < 4 ? A.in[12] + (size_t)(m8 - 2) * D * PW : m8 < 6 ? A.in[11] + (size_t)(m8 - 4) * D * D : A.in[14] + (size_t)(m8 - 6) * D * D;
        const size_t n4 = (size_t)D * (m8 < 2 ? PROJ : m8 < 4 ? PW : D) / 4;
        float mx = 0.f;
        for (size_t i = (size_t)gw * 64 + C.lane; i < n4; i += (size_t)NGW * 64) { const f32x4 v = *(const f32x4*)(W + 4 * i); mx = fmaxf(mx, fmaxf(fmaxf(fabsf(v.x), fabsf(v.y)), fmaxf(fabsf(v.z), fabsf(v.w)))); }
        mx = wave_max_nn(mx);
        if (C.lane == 0 && mx > 0.f) atomicMax(wmax + m8 * CNT_STRIDE, __float_as_uint(mx));
    }
}
__device__ __forceinline__ void cvt_win_i8(const Args& A, const Ctx& C) {
    LAS float* scr = (LAS float*)(C.lds + 16384 + C.wave * 16384);
    const int gw = C.bid * NW + C.wave, NGW = C.G * NW;
    constexpr int I_IN = (D / 64) * (PW / 32);
    const unsigned* wmax = (const unsigned*)(A.ws + WS_CTL) + CW_WMAX;
    constexpr int I_OUT = (D / 64) * (D / 32);
    for (int it = gw; it < 4 * I_OUT; it += NGW) {
        const int m4 = it / I_OUT, kind = m4 >> 1, j = m4 & 1, r = it % I_OUT; const int kb = r / (D / 32), nb = r % (D / 32), n0 = nb * 32;
        const float inv = 127.0f / fmaxf(__uint_as_float(wmax[(4 + m4) * CNT_STRIDE]), 1.0e-30f);
        transpose_item_i8((kind == 0 ? A.in[11] : A.in[14]) + (size_t)j * D * D, D, D, A.ws + (kind == 0 ? WS_WAOUT : WS_WBOUT) + (size_t)j * D * D, n0, kb * 64, n0, scr, C.lane, inv); }
    for (int it = gw; it < 4 * I_IN; it += NGW) {
        const int m4 = it / I_IN, kind = m4 >> 1, j = m4 & 1, r = it % I_IN; const int kb = r / (PW / 32), nb = r % (PW / 32), n0 = nb * 32;
        const float inv = 127.0f / fmaxf(__uint_as_float(wmax[m4 * CNT_STRIDE]), 1.0e-30f);
        unsigned char* WT = A.ws + (kind == 0 ? WS_WAIN : WS_WBIN) + (size_t)j * PW * D;
        if (kind == 0) transpose_item_i8(A.in[8] + (size_t)j * D * PROJ, PROJ, D, WT, n0, kb * 64, n0, scr, C.lane, inv);
        else { const int drow = n0 < D ? n0 : (n0 < 2 * D ? D + pair_row(n0 - D, 0) : D + pair_row(n0 - 2 * D, 1));
            transpose_item_i8(A.in[12] + (size_t)j * D * PW, PW, D, WT, drow, kb * 64, n0, scr, C.lane, inv); }
    }
}
__device__ __forceinline__ void cvt_moe_items(const Args& A, const Ctx& C, int l, int it0, int end, int stride) {
    LAS float* scr = (LAS float*)(C.lds + 16384 + C.wave * 16384);
    unsigned char* WGU = A.ws + WS_WGU; unsigned char* WDN = A.ws + WS_WDN;
    for (int it = it0; it < end; it += stride) {
        const int e = it / CVT_PER; int r = it % CVT_PER;
        if (r < 2 * CVT_IG) { const int which = r / CVT_IG; r %= CVT_IG; const int kb = r / (DE / 32), nb = r % (DE / 32), n0 = nb * 32;
            transpose_item_fp8((which == 0 ? A.in[19] : A.in[20]) + ((size_t)l * NE + e) * D * DE, DE, D, WGU + (size_t)e * 2 * DE * D, pair_row(n0, which), kb * 64, n0, scr, C.lane, WSCALE); }
        else { r -= 2 * CVT_IG; const int kb = r / (D / 32), nb = r % (D / 32), n0 = nb * 32;
            transpose_item_fp8(A.in[21] + ((size_t)l * NE + e) * DE * D, D, DE, WDN + (size_t)e * D * DE, n0, kb * 64, n0, scr, C.lane, WSCALE); }
    }
}
__device__ __forceinline__ int cvt_idle(int nunits, int G) { const int rem = nunits % G; return rem ? G - rem : 0; }
__device__ __forceinline__ int cvt_t1(int l, int G) { const int n = cvt_idle((((l <= 2) ? NR : NL) / BM) * (PW / BM), G) * CVT_Q; return n < CVT_ITEMS ? n : CVT_ITEMS; }
__device__ __forceinline__ int cvt_t2(int l, int G) { const int n = cvt_t1(l, G) + cvt_idle((((l <= 1) ? NR : NL) / BM) * (D / BM), G) * CVT_Q; return n < CVT_ITEMS ? n : CVT_ITEMS; }
__device__ __forceinline__ void cvt_moe_tail(const Args& A, const Ctx& C, int l, int nunits, int base, int end) {
    const int rem = nunits % C.G;
    if (rem == 0 || C.bid < rem) return;
    const int first = base + (C.bid - rem) * CVT_Q; const int last = min(first + CVT_Q, end);
    cvt_moe_items(A, C, l, first + C.wave, last, NW);
}

__device__ __forceinline__ void phase_g1(const Args& A, const Ctx& C, int l) {
    const bool mls = (l & 1) == 0; const int j = l >> 1; const int nrows = (l <= 2) ? NR : NL;
    DenseSched S; S.init(A.ws + WS_H8, A.ws + (mls ? WS_WAIN : WS_WBIN) + (size_t)j * PW * D, nrows, PW, D, C.G, C.bid, 1);
    const float wsc = __uint_as_float(((const unsigned*)(A.ws + WS_CTL))[CW_WMAX + ((mls ? 0 : 2) + j) * CNT_STRIDE]) * (1.0f / 127.0f);
    const float* rs = (const float*)(A.ws + WS_RSC);
    if (mls) { S.sw_lo = 4; S.sw_hi = 8; EpiStore E{(bf16*)(A.ws + WS_PB), PW, 0.08838834764831845f, 2 * NQ + NV, (bf16*)(A.ws + WS_VT), wsc, rs}; gemm_phase<EpiStore, DenseSched, false, 2>(C.lds, D, S, E); }
    else { EpiPair<0> E{(bf16*)(A.ws + WS_PB), PW, D, wsc, rs}; gemm_phase<EpiPair<0>, DenseSched, false, 2>(C.lds, D, S, E); }
    cvt_moe_tail(A, C, l, S.nwg, 0, cvt_t1(l, C.G));
}
__device__ __forceinline__ void phase_g2(const Args& A, const Ctx& C, int l) {
    const bool mls = (l & 1) == 0; const int j = l >> 1; const int nrows = (l <= 1) ? NR : NL;
    DenseSched S; S.init(A.ws + WS_HM, A.ws + (mls ? WS_WAOUT : WS_WBOUT) + (size_t)j * D * D, nrows, D, D, C.G, C.bid, 1);
    const float wsc = __uint_as_float(((const unsigned*)(A.ws + WS_CTL))[CW_WMAX + (4 + (mls ? 0 : 2) + j) * CNT_STRIDE]) * (1.0f / 127.0f);
    EpiStore E{(bf16*)(A.ws + WS_HB), D, 1.0f, 1 << 30, nullptr, mls ? wsc * (HMR / 127.0f) : wsc, mls ? nullptr : (const float*)(A.ws + WS_RSC)}; gemm_phase<EpiStore, DenseSched, false, 2>(C.lds, D, S, E);
    cvt_moe_tail(A, C, l, S.nwg, cvt_t1(l, C.G), cvt_t2(l, C.G));
}
__device__ __forceinline__ void phase_m1(const Args& A, const Ctx& C, int l) {
    LAS MoeTab* T = (LAS MoeTab*)(C.lds + LDS_TAB); LAS unsigned* ridx = (LAS unsigned*)(C.lds + LDS_TAB + 1024);
    moe_tables<true>(A, C, l, 4, T, ridx, D);
    MoeSched S; S.T = T; S.ridx = ridx; S.A = (const char*)(A.ws + WS_H8); S.W = (const char*)(A.ws + WS_WGU); S.wstride_e = (size_t)2 * DE * D; S.tstepB = (size_t)BM * D; S.K = D; S.arow_bytes = 0;
    EpiSwigluF8 E{A.ws + WS_DC, DE, 1.0f / WSCALE}; gemm_phase<EpiSwigluF8, MoeSched, true, 1>(C.lds, D, S, E);
}
__device__ __forceinline__ void phase_m2(const Args& A, const Ctx& C, int l) {
    LAS MoeTab* T = (LAS MoeTab*)(C.lds + LDS_TAB); LAS unsigned* ridx = (LAS unsigned*)(C.lds + LDS_TAB + 1024);
    moe_tables<false>(A, C, l, 4, T, ridx, DE);
    MoeSched S; S.T = T; S.ridx = ridx; S.A = (const char*)(A.ws + WS_DC); S.W = (const char*)(A.ws + WS_WDN); S.wstride_e = (size_t)D * DE; S.tstepB = (size_t)BM * DE; S.K = DE; S.arow_bytes = DE;
    EpiStoreTile E{A.ws + WS_PB, D, YSCALE / WSCALE}; gemm_phase<EpiStoreTile, MoeSched, false, 1>(C.lds, DE, S, E);
}

typedef float f32x16 __attribute__((ext_vector_type(16)));
#define MFMA32(a, b, c) __builtin_amdgcn_mfma_f32_32x32x16_bf16((a), (b), (c), 0, 0, 0)
__device__ __forceinline__ bf16x8 pack8(float a0, float a1, float a2, float a3, float a4, float a5, float a6, float a7) {
    u32x4 p; p.x = cvt2(a0, a1); p.y = cvt2(a2, a3); p.z = cvt2(a4, a5); p.w = cvt2(a6, a7); return __builtin_bit_cast(bf16x8, p); }
__device__ __forceinline__ float bflo(unsigned w) { return __uint_as_float(w << 16); }
__device__ __forceinline__ float bfhi(unsigned w) { return __uint_as_float(w & 0xffff0000u); }
__device__ __forceinline__ int vt_tile(int b, int h, int blk) { return (blk == 0 ? 128 + b : b * 64 + blk - 1) * NH + h; }

__device__ __forceinline__ float wave_incl_scan(float v, int lane) {
#pragma unroll
    for (int o = 1; o < 64; o <<= 1) { const float t = __shfl_up(v, o); v += (lane >= o) ? t : 0.f; }
    return v;
}
__device__ __forceinline__ void block_gates(const Args& A, int row0, int h, LAS float* bf, LAS float* bb, LAS float* lif, LAS float* lib, int tid) {
    const float* GATE = (const float*)(A.ws + WS_GATE);
    if (tid < 256) { const float* g = GATE + (size_t)(row0 + tid) * 16; lif[tid] = g[0 + h]; bf[tid] = g[4 + h]; lib[tid] = g[8 + h]; bb[tid] = g[12 + h]; }
    __syncthreads();
    const int lane = tid & 63, wv = tid >> 6;
    if (wv == 0) { f32x4 x = *(LAS f32x4*)(bf + 4 * lane); x.y += x.x; x.z += x.y; x.w += x.z; const float tot = wave_incl_scan(x.w, lane); const float ex = tot - x.w;
        x.x += ex; x.y += ex; x.z += ex; x.w += ex; *(LAS f32x4*)(bf + 4 * lane) = x; }
    if (wv == 1) { f32x4 y = *(LAS f32x4*)(bb + 4 * (63 - lane)); y.z += y.w; y.y += y.z; y.x += y.y; const float tot = wave_incl_scan(y.x, lane); const float ex = tot - y.x;
        y.x += ex; y.y += ex; y.z += ex; y.w += ex; *(LAS f32x4*)(bb + 4 * (63 - lane)) = y; }
    __syncthreads();
}
__device__ __forceinline__ void phase_s1(const Args& A, const Ctx& C, int l) {
    LAS float* bf = (LAS float*)C.lds; LAS float* bb = bf + 256; LAS float* lif = bb + 256; LAS float* lib = lif + 256; LAS float* af = lib + 256; LAS float* ab = af + 256;
    constexpr int KP = 528;
    LAS unsigned char* KTf = C.lds + 8192; LAS unsigned char* KTb = KTf + 128 * KP;
    const bf16* P = (const bf16*)(A.ws + WS_PB); const bf16* VT = (const bf16*)(A.ws + WS_VT);
    float* DC = (float*)(A.ws + WS_DC); float* DN = (float*)(A.ws + WS_DN); float* BT = (float*)(A.ws + WS_BTOT);
    const int r = C.lane & 31, hh = C.lane >> 5, w = C.wave;
    for (int u = C.bid; u < NUNIT; u += C.G) {
        const int blk = u % NBLK, bh = u / NBLK, h = bh % NH, b = bh / NH; const int row0 = blk_row0(b, blk);
        block_gates(A, row0, h, bf, bb, lif, lib, C.tid);
        if (C.tid < 256) { af[C.tid] = __expf(bf[255] - bf[C.tid] + lif[C.tid]); ab[C.tid] = __expf(bb[0] - bb[C.tid] + lib[C.tid]); }
        if (C.tid == 0) { BT[u * 2 + 0] = bf[255]; BT[u * 2 + 1] = bb[0]; }
        __syncthreads();
        { const int sp = C.tid >> 2, dq = C.tid & 3, s0 = 2 * sp;
          const bf16* k0 = P + (size_t)(row0 + s0) * PW + NQ + h * DQK + 32 * dq;
          const float f0 = af[s0], f1 = af[s0 + 1], g0 = ab[s0], g1 = ab[s0 + 1];
#pragma unroll
          for (int c = 0; c < 4; ++c) { const u32x4 x0 = *(const u32x4*)(k0 + 8 * c), x1 = *(const u32x4*)(k0 + PW + 8 * c);
#pragma unroll
              for (int q = 0; q < 4; ++q) { const int d = 32 * dq + 8 * c + 2 * q;
                  const float a0 = bflo(x0[q]), a1 = bfhi(x0[q]), c0 = bflo(x1[q]), c1 = bfhi(x1[q]);
                  *(LAS unsigned*)(KTf + d * KP + s0 * 2) = cvt2(a0 * f0, c0 * f1); *(LAS unsigned*)(KTf + (d + 1) * KP + s0 * 2) = cvt2(a1 * f0, c1 * f1);
                  *(LAS unsigned*)(KTb + d * KP + s0 * 2) = cvt2(a0 * g0, c0 * g1); *(LAS unsigned*)(KTb + (d + 1) * KP + s0 * 2) = cvt2(a1 * g0, c1 * g1); } } }
        __syncthreads();
        if (C.tid < 256) { const int dir = C.tid >> 7, d = C.tid & 127; LAS const unsigned* kr = (LAS const unsigned*)((dir ? KTb : KTf) + d * KP); float s = 0.f;
            for (int i = 0; i < 128; ++i) { const unsigned x = kr[i]; s += bflo(x) + bfhi(x); }
            DN[(size_t)(u * 2 + dir) * DQK + d] = s; }
        const bf16* vt = VT + (size_t)vt_tile(b, h, blk) * 65536 + (size_t)(32 * w + r) * 256 + 8 * hh;
        bf16x8 av[16];
#pragma unroll
        for (int ks = 0; ks < 16; ++ks) av[ks] = *(const bf16x8*)(vt + 16 * ks);
#pragma unroll 1
        for (int dir = 0; dir < 2; ++dir) {
            LAS const unsigned char* KT = dir ? KTb : KTf;
            f32x16 acc[4];
#pragma unroll
            for (int dt = 0; dt < 4; ++dt)
#pragma unroll
                for (int i = 0; i < 16; ++i) acc[dt][i] = 0.f;
#pragma unroll
            for (int ks = 0; ks < 16; ++ks) {
#pragma unroll
                for (int dt = 0; dt < 4; ++dt) { const bf16x8 b0 = *(const LAS bf16x8*)(KT + (dt * 32 + r) * KP + (16 * ks + 8 * hh) * 2); acc[dt] = MFMA32(av[ks], b0, acc[dt]); }
                if ((ks & 3) == 3) asm volatile("" ::: "memory"); }
            float* dc = DC + (size_t)(u * 2 + dir) * DQK * DV + (size_t)(32 * w + 4 * hh) * DQK + r;
#pragma unroll
            for (int g = 0; g < 4; ++g) { float* pf = dc + g * 8 * DQK; asm volatile("" : "+v"(pf));
#pragma unroll
                for (int q = 0; q < 4; ++q)
#pragma unroll
                    for (int dt = 0; dt < 4; ++dt) pf[q * DQK + dt * 32] = acc[dt][4 * g + q]; }
        }
        __syncthreads();
    }
}
__device__ __forceinline__ void phase_s2(const Args& A, const Ctx& C) {
    const float* __restrict__ DC = (const float*)(A.ws + WS_DC); const float* __restrict__ DN = (const float*)(A.ws + WS_DN); const float* __restrict__ BT = (const float*)(A.ws + WS_BTOT);
    bf16* __restrict__ CST = (bf16*)(A.ws + WS_CST); float* __restrict__ NST = (float*)(A.ws + WS_NST);
    constexpr int EL4 = DQK * DV / 4;
    for (int g = C.bid * NT + C.tid; g < BATCH * NH * 2 * EL4; g += C.G * NT) {
        const int e4 = (g % EL4) * 4, ch = g / EL4, dir = ch & 1, bh = ch >> 1;
        f32x4 st = (f32x4){0.f, 0.f, 0.f, 0.f};
#pragma unroll 13
        for (int idx = 0; idx < NBLK; ++idx) {
            const int blk = dir == 0 ? idx : (idx == 0 ? 0 : NBLK - idx); const int u = bh * NBLK + blk;
            const float dec = __expf(BT[u * 2 + dir]);
            const f32x4 dc = *(const f32x4*)(DC + (size_t)(u * 2 + dir) * DQK * DV + e4);
            u32x2 o; o.x = cvt2(st.x, st.y); o.y = cvt2(st.z, st.w);
            *(u32x2*)(CST + (size_t)(u * 2 + dir) * DQK * DV + e4) = o;
            st = st * dec + dc;
        }
    }
    for (int g = C.bid * NT + C.tid; g < BATCH * NH * 2 * DQK; g += C.G * NT) {
        const int d = g % DQK, ch = g / DQK, dir = ch & 1, bh = ch >> 1; float st = 0.f;
        for (int idx = 0; idx < NBLK; ++idx) {
            const int blk = dir == 0 ? idx : (idx == 0 ? 0 : NBLK - idx); const int u = bh * NBLK + blk;
            NST[(size_t)(u * 2 + dir) * DQK + d] = st; st = __expf(BT[u * 2 + dir]) * st + DN[(size_t)(u * 2 + dir) * DQK + d];
        }
    }
}
__device__ __forceinline__ void lds_barrier() { asm volatile("s_waitcnt lgkmcnt(0)" ::: "memory"); __builtin_amdgcn_s_barrier(); asm volatile("" ::: "memory"); }
__device__ __forceinline__ void phase_s3(const Args& A, const Ctx& C, int l) {
    const int jl = l >> 1; const bool ctx_out = (l == 0);
    LAS float* bf = (LAS float*)C.lds; LAS float* bb = bf + 256; LAS float* gf = bb + 256; LAS float* gb = gf + 256;
    LAS float* nf = gb + 256; LAS float* nb = nf + 128; LAS float* ssx = nb + 128;
    LAS float* cf = ssx + 256; LAS float* cb = cf + 256;
    constexpr int KP = 272, OP = 528, CHB = 16384, NCHB = 4;
    LAS unsigned char* Kimg = C.lds + 8192;
    LAS unsigned char* CH = Kimg + 256 * KP;
    LAS unsigned char* OUT = Kimg;
    static_assert(8192 + 256 * KP + NCHB * CHB <= LDS_TAB_END && 8192 + 256 * OP <= LDS_TAB_END, "S3 LDS map");
    const bf16* P = (const bf16*)(A.ws + WS_PB); const bf16* VT = (const bf16*)(A.ws + WS_VT); unsigned char* HM = A.ws + WS_HM;
    const bf16* CST = (const bf16*)(A.ws + WS_CST); const float* NST = (const float*)(A.ws + WS_NST);
    const float* hg = A.in[10] + (size_t)jl * NV;
    const int w = C.wave;
    for (int u = C.bid; u < NUNIT; u += C.G) {
        const int blk = u % NBLK, bh = u / NBLK, h = bh % NH, b = bh / NH; const int row0 = blk_row0(b, blk);
        if (blk == 0 && !ctx_out) continue;
        const bf16* vtile = VT + (size_t)vt_tile(b, h, blk) * 65536;
        const bf16* ctile = CST + (size_t)(u * 2) * DQK * DV;
#define S3_DMA(c_) do { const int cc_ = (c_); const bool isv_ = cc_ < 8; int ld_ = threadIdx.x & 63; asm volatile("" : "+v"(ld_)); \
                const unsigned dlp_ = (unsigned)(((ld_ & 3) ^ ((ld_ >> 4) & 3)) * 16), drow_ = (unsigned)(32 * w + (ld_ >> 2)); \
                const unsigned long long gp_ = (unsigned long long)(isv_ ? (const char*)vtile + 64 * cc_ : (const char*)ctile + (cc_ >= 12 ? 2 * DQK * DV : 0) + 64 * ((cc_ - 8) & 3)); \
                const char* gb_ = (const char*)(((unsigned long long)(unsigned)__builtin_amdgcn_readfirstlane((int)(unsigned)(gp_ >> 32)) << 32) | (unsigned)__builtin_amdgcn_readfirstlane((int)(unsigned)gp_)); \
                _Pragma("unroll") for (int jj = 0; jj < 2; ++jj) \
                    asm volatile("s_mov_b32 m0, %2\n\ts_nop 0\n\tglobal_load_lds_dwordx4 %0, %1" :: "v"(((drow_ + 16u * jj) << (isv_ ? 9 : 8)) + dlp_), "s"(gb_), "s"((unsigned)(size_t)CH + (unsigned)w * 2048u + (unsigned)((cc_ & 3) * CHB + jj * 1024)) : "memory"); } while (0)
        S3_DMA(0); S3_DMA(1); S3_DMA(2);
        bf16x8 qf[8];
        { int lq = threadIdx.x & 63; asm volatile("" : "+v"(lq)); const bf16* qr = P + (size_t)(row0 + 32 * w + (lq & 31)) * PW + h * DQK + 8 * (lq >> 5);
#pragma unroll
          for (int kk = 0; kk < 8; ++kk) qf[kk] = *(const bf16x8*)(qr + 16 * kk); }
        int tu = threadIdx.x; asm volatile("" : "+v"(tu));
        block_gates(A, row0, h, bf, bb, gf, gb, tu);
        if (tu < 256) { gf[tu] -= bf[tu]; gb[tu] -= bb[tu]; cf[tu] = __expf(bf[tu | 31] + gf[tu]); cb[tu] = __expf(bb[tu & ~31] + gb[tu]); }
        else { const int t2 = tu - 256; nf[t2] = NST[(size_t)(u * 2 + (t2 >> 7)) * DQK + (t2 & 127)]; }
        { const int pc = tu & 15, s0 = tu >> 4; const bf16* kr = P + (size_t)(row0 + s0) * PW + NQ + h * DQK + 8 * pc;
#pragma unroll
          for (int i = 0; i < 8; ++i) *(LAS u32x4*)(Kimg + (s0 + 32 * i) * KP + pc * 16) = *(const u32x4*)(kr + (size_t)(32 * i) * PW); }
        __syncthreads();
        {
            int lz = threadIdx.x & 63; asm volatile("" : "+v"(lz));
            const int r = lz & 31, hh = lz >> 5;
            const int jt = w;
            const float bfj = bf[32 * jt + r], bbj = bb[32 * jt + r];
            float qnf = 0.f, qnb = 0.f;
#pragma unroll
            for (int kk = 0; kk < 8; ++kk) { u32x4 qq = __builtin_bit_cast(u32x4, qf[kk]); asm volatile("" : "+v"(qq));
                const int d = 16 * kk + 8 * hh;
                const f32x4 n0 = *(const LAS f32x4*)(nf + d), n1 = *(const LAS f32x4*)(nf + d + 4), m0 = *(const LAS f32x4*)(nb + d), m1 = *(const LAS f32x4*)(nb + d + 4);
                qnf += (bflo(qq.x) * n0.x + bfhi(qq.x) * n0.y) + (bflo(qq.y) * n0.z + bfhi(qq.y) * n0.w) + (bflo(qq.z) * n1.x + bfhi(qq.z) * n1.y) + (bflo(qq.w) * n1.z + bfhi(qq.w) * n1.w);
                qnb += (bflo(qq.x) * m0.x + bfhi(qq.x) * m0.y) + (bflo(qq.y) * m0.z + bfhi(qq.y) * m0.w) + (bflo(qq.z) * m1.x + bfhi(qq.z) * m1.y) + (bflo(qq.w) * m1.z + bfhi(qq.w) * m1.w);
                if (kk & 1) asm volatile("" ::: "memory"); }
            qnf += __shfl_xor(qnf, 32); qnb += __shfl_xor(qnb, 32);
            float denf = 0.f, denb = 0.f;
#pragma unroll 1
            for (int kt = 0; kt < 8; ++kt) {
                f32x16 c;
#pragma unroll
                for (int i = 0; i < 16; ++i) c[i] = 0.f;
#pragma unroll
                for (int kk = 0; kk < 8; ++kk) { const bf16x8 a = *(const LAS bf16x8*)(Kimg + (kt * 32 + r) * KP + (16 * kk + 8 * hh) * 2); c = MFMA32(a, qf[kk], c); }
                if (kt == jt) {
#pragma unroll
                    for (int g = 0; g < 4; ++g) { const int sl0 = 8 * g + 4 * hh;
                        const f32x4 g4f = *(const LAS f32x4*)(gf + kt * 32 + sl0), g4b = *(const LAS f32x4*)(gb + kt * 32 + sl0);
#pragma unroll
                        for (int q = 0; q < 4; ++q) { const int sl = sl0 + q; const float cv = c[4 * g + q];
                            denf += cv * __expf((sl <= r) ? bfj + g4f[q] : -1.0e30f); denb += cv * __expf((sl >= r) ? bbj + g4b[q] : -1.0e30f); } }
                } else {
                    LAS const float* cx = (kt < jt ? cf : cb) + kt * 32 + 4 * hh; float sm = 0.f;
#pragma unroll
                    for (int g = 0; g < 4; ++g) { const f32x4 c4 = *(const LAS f32x4*)(cx + 8 * g); sm += (c[4 * g] * c4.x + c[4 * g + 1] * c4.y) + (c[4 * g + 2] * c4.z + c[4 * g + 3] * c4.w); }
                    if (kt < jt) denf += sm * __expf(bfj - bf[kt * 32 + 31]); else denb += sm * __expf(bbj - bb[kt * 32]);
                }
            }
            denf += __shfl_xor(denf, 32); denb += __shfl_xor(denb, 32);
            const float ebf = __expf(bfj), ebb = __expf(bbj);
            denf += ebf * qnf; denb += ebb * qnb;
            const float rf = 1.0f / fmaxf(fabsf(denf), 1.0f), rb = 1.0f / fmaxf(fabsf(denb), 1.0f);
            const float scf = ebf * rf, scb = ebb * rb;
            unsigned wdg[8];
#pragma unroll
            for (int g = 0; g < 4; ++g) { const int sl0 = 8 * g + 4 * hh;
                const f32x4 g4f = *(const LAS f32x4*)(gf + jt * 32 + sl0), g4b = *(const LAS f32x4*)(gb + jt * 32 + sl0);
                float wv[4];
#pragma unroll
                for (int q = 0; q < 4; ++q) { const int sl = sl0 + q; wv[q] = rf * __expf((sl <= r) ? bfj + g4f[q] : -1.0e30f) + rb * __expf((sl >= r) ? bbj + g4b[q] : -1.0e30f); }
                wdg[2 * g] = cvt2(wv[0], wv[1]); wdg[2 * g + 1] = cvt2(wv[2], wv[3]); }
            f32x16 acc[8];
#pragma unroll
            for (int et = 0; et < 8; ++et)
#pragma unroll
                for (int i = 0; i < 16; ++i) acc[et][i] = 0.f;
            asm volatile("s_waitcnt vmcnt(0)" ::: "memory");
            const int swz = (r >> 2) & 3;
#pragma unroll 1
            for (int ci = 0; ci < 8; ++ci) {
                if (ci) asm volatile("s_waitcnt vmcnt(4)" ::: "memory");
                lds_barrier();
                S3_DMA(ci + 3);
                LAS const unsigned char* CHc = CH + (ci & 3) * CHB;
                { const int kt = ci;
                        f32x16 c;
#pragma unroll
                        for (int i = 0; i < 16; ++i) c[i] = 0.f;
#pragma unroll
                        for (int kk = 0; kk < 8; ++kk) { const bf16x8 a = *(const LAS bf16x8*)(Kimg + (kt * 32 + r) * KP + (16 * kk + 8 * hh) * 2); c = MFMA32(a, qf[kk], c); }
                        float p[16];
                        if (kt == jt) {
#pragma unroll
                            for (int i = 0; i < 8; ++i) { p[2 * i] = c[2 * i] * bflo(wdg[i]); p[2 * i + 1] = c[2 * i + 1] * bfhi(wdg[i]); }
                        } else {
                            LAS const float* cx = (kt < jt ? cf : cb) + kt * 32 + 4 * hh;
                            const float rw = (kt < jt) ? rf * __expf(bfj - bf[kt * 32 + 31]) : rb * __expf(bbj - bb[kt * 32]);
#pragma unroll
                            for (int g = 0; g < 4; ++g) { const f32x4 c4 = *(const LAS f32x4*)(cx + 8 * g);
                                p[4 * g] = c[4 * g] * (c4.x * rw); p[4 * g + 1] = c[4 * g + 1] * (c4.y * rw); p[4 * g + 2] = c[4 * g + 2] * (c4.z * rw); p[4 * g + 3] = c[4 * g + 3] * (c4.w * rw); }
                        }
                        const bf16x8 pa0 = pack8(p[0], p[1], p[2], p[3], p[4], p[5], p[6], p[7]), pa1 = pack8(p[8], p[9], p[10], p[11], p[12], p[13], p[14], p[15]);
#pragma unroll
                        for (int et = 0; et < 8; ++et) { LAS const unsigned char* vb = CHc + (et * 32 + r) * 64 + 8 * hh;
                            const u32x2 l0 = *(LAS const u32x2*)(vb + ((0 ^ swz) << 4)), h0 = *(LAS const u32x2*)(vb + ((1 ^ swz) << 4)), l1 = *(LAS const u32x2*)(vb + ((2 ^ swz) << 4)), h1 = *(LAS const u32x2*)(vb + ((3 ^ swz) << 4));
                            const bf16x8 a0 = __builtin_bit_cast(bf16x8, (u32x4){l0.x, l0.y, h0.x, h0.y}), a1 = __builtin_bit_cast(bf16x8, (u32x4){l1.x, l1.y, h1.x, h1.y});
                            acc[et] = MFMA32(a0, pa0, acc[et]); acc[et] = MFMA32(a1, pa1, acc[et]);
                            if (et & 1) asm volatile("" ::: "memory"); }
                }
            }
#pragma unroll
            for (int ci = 8; ci < 16; ++ci) {
                if (ci <= 13) asm volatile("s_waitcnt vmcnt(4)" ::: "memory"); else if (ci == 14) asm volatile("s_waitcnt vmcnt(2)" ::: "memory"); else asm volatile("s_waitcnt vmcnt(0)" ::: "memory");
                lds_barrier();
                if (ci + 3 < 16) S3_DMA(ci + 3);
                LAS const unsigned char* CHc = CH + (ci & 3) * CHB;
                {
                    const int dir = (ci - 8) >> 2, dq = (ci - 8) & 3;
                    const float sc = dir ? scb : scf;
#pragma unroll
                    for (int k2 = 0; k2 < 2; ++k2) { const u32x4 qq = __builtin_bit_cast(u32x4, qf[2 * dq + k2]);
                        const bf16x8 qs = pack8(bflo(qq.x) * sc, bfhi(qq.x) * sc, bflo(qq.y) * sc, bfhi(qq.y) * sc, bflo(qq.z) * sc, bfhi(qq.z) * sc, bflo(qq.w) * sc, bfhi(qq.w) * sc);
#pragma unroll
                        for (int et = 0; et < 8; ++et) { const bf16x8 a = *(const LAS bf16x8*)(CHc + (et * 32 + r) * 64 + (((2 * k2 + hh) ^ swz) << 4)); acc[et] = MFMA32(a, qs, acc[et]);
                            if ((et & 3) == 3) asm volatile("" ::: "memory"); } }
                }
            }
            u32x4 ov[8]; f32x4 g0, g1;
            { int tz = threadIdx.x & 63; asm volatile("" : "+v"(tz)); const int pc = tz & 31, lr0 = tz >> 5;
              g0 = *(const f32x4*)(hg + h * DV + 8 * pc); g1 = *(const f32x4*)(hg + h * DV + 8 * pc + 4);
#pragma unroll
              for (int i = 0; i < 8; ++i) ov[i] = *(const u32x4*)(P + (size_t)(row0 + 32 * w + lr0 + 2 * i) * PW + 2 * NQ + NV + h * DV + 8 * pc); }
            float ss = 0.f;
#pragma unroll
            for (int et = 0; et < 8; ++et)
#pragma unroll
                for (int i = 0; i < 16; ++i) ss += acc[et][i] * acc[et][i];
            ss += __shfl_xor(ss, 32);
            const float rs = 1.0f / sqrtf(ss * (1.0f / DV) + EPS);
            lds_barrier();
            { LAS unsigned char* ob = OUT + (w * 32 + r) * OP + (4 * hh) * 2;
#pragma unroll
              for (int et = 0; et < 8; ++et)
#pragma unroll
                  for (int g = 0; g < 4; ++g) { u32x2 o; o.x = cvt2(acc[et][4 * g + 0] * rs, acc[et][4 * g + 1] * rs); o.y = cvt2(acc[et][4 * g + 2] * rs, acc[et][4 * g + 3] * rs);
                      *(LAS u32x2*)(ob + (et * 32 + 8 * g) * 2) = o; } }
            asm volatile("s_waitcnt lgkmcnt(0)" ::: "memory");
#pragma unroll
            for (int hf = 0; hf < 2; ++hf) {
                int tz = threadIdx.x & 63; asm volatile("" : "+v"(tz)); const int pc = tz & 31, lr0 = tz >> 5;
                if (hf == 1) {
#pragma unroll
                    for (int i = 0; i < 8; ++i) ov[i] = *(const u32x4*)(P + (size_t)(row0 + 32 * w + lr0 + 16 + 2 * i) * PW + 2 * NQ + NV + h * DV + 8 * pc); }
#pragma unroll
                for (int i = 0; i < 8; ++i) { const int lr = 32 * w + lr0 + 16 * hf + 2 * i; const int grow = row0 + lr;
                    const u32x4 hv = *(const LAS u32x4*)(OUT + lr * OP + pc * 16);
                    const f32x4 o0 = (f32x4){bflo(hv.x) * g0.x * bflo(ov[i].x), bfhi(hv.x) * g0.y * bfhi(ov[i].x), bflo(hv.y) * g0.z * bflo(ov[i].y), bfhi(hv.y) * g0.w * bfhi(ov[i].y)};
                    const f32x4 o1 = (f32x4){bflo(hv.z) * g1.x * bflo(ov[i].z), bfhi(hv.z) * g1.y * bfhi(ov[i].z), bflo(hv.w) * g1.z * bflo(ov[i].w), bfhi(hv.w) * g1.w * bfhi(ov[i].w)};
                    *(u32x2*)(HM + (size_t)grow * D + h * DV + 8 * pc) = (u32x2){pack_i8(o0 * (127.0f / HMR)), pack_i8(o1 * (127.0f / HMR))}; }
            }
        }
#undef S3_DMA
        __syncthreads();
    }
}

#define XB_TMO      128
#define XB_XCNT(j)  (256  + 64 * (j))
#define XB_XSUB(j)  (1280 + 64 * (j))
#define XB_XGEN(j)  (2304 + 64 * (j))
#define XB_TOP      3328
#define XB_TOPGEN   3392
#define XCD_BAR_WORDS 3456
#define XB_SPIN_CAP (1u << 18)

__device__ __forceinline__ unsigned xb_ld(unsigned* p)              { return __hip_atomic_load(p, __ATOMIC_RELAXED, __HIP_MEMORY_SCOPE_AGENT); }
__device__ __forceinline__ unsigned xb_add(unsigned* p, unsigned v) { return __hip_atomic_fetch_add(p, v, __ATOMIC_RELAXED, __HIP_MEMORY_SCOPE_AGENT); }
__device__ __forceinline__ unsigned xb_xcc_id() { return (unsigned)__builtin_amdgcn_s_getreg((3 << 11) | 20) & 0xFu; }
#define XB_SPIN(cond, bar) do { unsigned _sp = 0; while (cond) { __builtin_amdgcn_s_sleep(1); \
    if ((++_sp & 255u) == 0u) { if (xb_ld(&(bar)[XB_TMO])) break; if (_sp > XB_SPIN_CAP) { atomicAdd(&(bar)[XB_TMO], 1u); break; } } } } while (0)

struct XcdBarrier {
    unsigned* bar; unsigned x;
    volatile LAS unsigned* st;
};

__device__ __forceinline__ XcdBarrier xcd_barrier_post(unsigned* bar, volatile LAS unsigned* st) {
    XcdBarrier b; b.bar = bar; b.x = xb_xcc_id(); b.st = st;
    if (threadIdx.x == 0) (void)xb_add(&bar[XB_XCNT(b.x)], 1u);
    return b;
}
__device__ __forceinline__ void xcd_barrier_complete(unsigned* bar, unsigned x, unsigned& nloc, unsigned& nx) {
    const unsigned G = gridDim.x * gridDim.y * gridDim.z;
    unsigned sum, cnt, mine, sp = 0u;
    for (;;) {
        sum = 0u; cnt = 0u; mine = 0u;
#pragma unroll
        for (unsigned j = 0; j < 16; ++j) { const unsigned c = xb_ld(&bar[XB_XCNT(j)]); sum += c; cnt += (c > 0u) ? 1u : 0u; mine = (j == x) ? c : mine; }
        if (sum == G) break;
        __builtin_amdgcn_s_sleep(1);
        if ((++sp & 255u) == 0u) { if (xb_ld(&bar[XB_TMO])) break; if (sp > XB_SPIN_CAP) { atomicAdd(&bar[XB_TMO], 1u); break; } }
    }
    nloc = mine > 0u ? mine : 1u; nx = cnt > 0u ? cnt : 1u;
}

__device__ __forceinline__ void xcd_barrier(const XcdBarrier& b) {
    asm volatile("s_waitcnt vmcnt(0)" ::: "memory");
    __syncthreads();
    if (threadIdx.x == 0) {
        unsigned* bar = b.bar;
        __builtin_amdgcn_s_waitcnt(0);
        unsigned nloc = b.st[0], nx = b.st[1];
        if (nloc == 0u) { xcd_barrier_complete(bar, b.x, nloc, nx); b.st[0] = nloc; b.st[1] = nx; }
        const unsigned old = xb_add(&bar[XB_XSUB(b.x)], 1u);
        const unsigned gen = old / nloc;
        if (old + 1u == (gen + 1u) * nloc) {
            __builtin_amdgcn_fence(__ATOMIC_RELEASE, "agent");
            asm volatile("s_waitcnt vmcnt(0)" ::: "memory");
            const unsigned og = xb_add(&bar[XB_TOP], 1u);
            const unsigned tg = og / nx;
            if (og + 1u == (tg + 1u) * nx) xb_add(&bar[XB_TOPGEN], 1u);
            else XB_SPIN(xb_ld(&bar[XB_TOPGEN]) == tg, bar);
            __builtin_amdgcn_fence(__ATOMIC_ACQUIRE, "agent");
            xb_add(&bar[XB_XGEN(b.x)], 1u);
            asm volatile("s_waitcnt vmcnt(0)" ::: "memory");
        } else {
            XB_SPIN(xb_ld(&bar[XB_XGEN(b.x)]) == gen, bar);
            __builtin_amdgcn_fence(__ATOMIC_ACQUIRE, "agent");
            asm volatile("s_waitcnt vmcnt(0)" ::: "memory");
        }
    }
    __syncthreads();
}


constexpr int LDS_BYTES = 152 * 1024;
constexpr int CW_BAR = 16384;
static_assert((CW_BAR + XCD_BAR_WORDS) * 4 <= (int)CTL_BYTES, "ctl");
#ifndef MK_MULTI
#define MK_MULTI 0
#endif
#define IN(p) (lo <= (p) && (p) < hi)
#define SEAM(p) do { if ((p) + 1 < hi) { XcdBarrier b_; b_.bar = (unsigned*)(load_args().ws + WS_CTL) + CW_BAR; b_.x = xb_xcc_id(); b_.st = (volatile LAS unsigned*)(C.lds + LDS_BYTES - 16); xcd_barrier(b_); } } while (0)
#define CAS __attribute__((address_space(4)))
__device__ __forceinline__ Args load_args() {
#if defined(__HIP_DEVICE_COMPILE__)
    const CAS Args* p = (const CAS Args*)__builtin_amdgcn_kernarg_segment_ptr(); asm volatile("" : "+s"(p));
    Args a; for (int i = 0; i < 22; ++i) a.in[i] = p->in[i]; a.out = p->out; a.ws = p->ws; a.lo = p->lo; a.hi = p->hi; return a;
#else
    return Args{};
#endif
}
__device__ __forceinline__ Ctx fresh(const Ctx& C) { Ctx R = C; int tz = threadIdx.x; asm volatile("" : "+v"(tz)); R.tid = tz; R.lane = tz & 63; return R; }
template <int L> __device__ __forceinline__ void layer_phases(const Args& args, const Ctx& C, int bar, int lo, int hi) {
    constexpr int pb = 16 * L;
    if (IN(pb + 1)) { phase_r1(load_args(), fresh(C), L); SEAM(pb + 1); }
    if (IN(pb + 2)) { phase_g1(load_args(), fresh(C), L); SEAM(pb + 2); }
    if constexpr ((L & 1) == 0) {
        if (IN(pb + 3)) { phase_s1(load_args(), fresh(C), L); SEAM(pb + 3); }
        if (IN(pb + 4)) { phase_s2(load_args(), fresh(C)); SEAM(pb + 4); }
        if (IN(pb + 5)) { phase_s3(load_args(), fresh(C), L); SEAM(pb + 5); }
    } else {
        if (IN(pb + 3)) { phase_conv(load_args(), fresh(C), L); SEAM(pb + 3); }
    }
    if (IN(pb + 6)) { phase_g2(load_args(), fresh(C), L); SEAM(pb + 6); }
    if (IN(pb + 7)) { phase_r2(load_args(), fresh(C), L); SEAM(pb + 7); }
    if (IN(pb + 8)) { phase_m1(load_args(), fresh(C), L); SEAM(pb + 8); }
    if (IN(pb + 9)) { phase_m2(load_args(), fresh(C), L); SEAM(pb + 9); }
}
__global__ void __launch_bounds__(NT, 2) fwd_kernel(Args args) {
    extern __shared__ __attribute__((aligned(16))) unsigned char lds_raw[];
    Ctx C; C.lds = (LAS unsigned char*)lds_raw; C.tid = threadIdx.x; C.lane = C.tid & 63; C.wave = __builtin_amdgcn_readfirstlane(C.tid >> 6); C.G = gridDim.x; C.bid = blockIdx.x; C.a = &args;
    const int lo = args.lo, hi = args.hi;
    volatile LAS unsigned* xbw = (volatile LAS unsigned*)(C.lds + LDS_BYTES - 16);
    if (C.tid < 4) xbw[C.tid] = 0u;
    __syncthreads();
    if (hi - lo > 1) (void)xcd_barrier_post((unsigned*)(args.ws + WS_CTL) + CW_BAR, xbw);
    const int bar = 0; (void)bar;
    if (IN(0)) { phase_mod(load_args(), fresh(C)); __syncthreads(); phase_cvt_mixer(load_args(), fresh(C)); SEAM(0); }
    layer_phases<0>(args, C, bar, lo, hi);
    layer_phases<1>(args, C, bar, lo, hi);
    layer_phases<2>(args, C, bar, lo, hi);
    layer_phases<3>(args, C, bar, lo, hi);
    if (IN(64)) phase_final(load_args(), fresh(C));
}
#undef IN
#undef SEAM

extern "C" void kernel_launch(void* const* d_in, const int* in_sizes, int n_in, void* d_out, int out_size, void* d_ws, size_t ws_size, hipStream_t stream) {
    static int grid = 0;
    if (grid == 0) {
        if (n_in != 22 || out_size != NL * D || ws_size < WS_END) { fprintf(stderr, "kernel_launch: unexpected shapes (n_in %d out %d ws %zu)\n", n_in, out_size, ws_size); grid = -1; return; }
        int dev = 0, cus = 0, per_cu = 0;
        if (hipGetDevice(&dev) != hipSuccess || hipDeviceGetAttribute(&cus, hipDeviceAttributeMultiprocessorCount, dev) != hipSuccess) { grid = -1; return; }
        if (hipFuncSetAttribute((const void*)fwd_kernel, hipFuncAttributeMaxDynamicSharedMemorySize, LDS_BYTES) != hipSuccess) { grid = -1; return; }
        if (hipOccupancyMaxActiveBlocksPerMultiprocessor(&per_cu, (const void*)fwd_kernel, NT, LDS_BYTES) != hipSuccess || per_cu < 1) { fprintf(stderr, "kernel_launch: occupancy query says %d\n", per_cu); }
        (void)hipGetLastError();
        grid = cus;
    }
    if (grid < 0) return;
    (void)hipMemsetAsync((char*)d_ws + WS_CTL, 0, CTL_BYTES, stream);
    Args a{};
    for (int i = 0; i < 22; ++i) a.in[i] = (const float*)d_in[i];
    a.out = (float*)d_out; a.ws = (unsigned char*)d_ws;
#if MK_MULTI
    int phases[64]; int np = 0;
    phases[np++] = 0;
    for (int l = 0; l < DEPTH; ++l) { const int pb = 16 * l; phases[np++] = pb + 1; phases[np++] = pb + 2; phases[np++] = pb + 3;
        if ((l & 1) == 0) { phases[np++] = pb + 4; phases[np++] = pb + 5; }
        phases[np++] = pb + 6; phases[np++] = pb + 7; phases[np++] = pb + 8; phases[np++] = pb + 9; }
    phases[np++] = 64;
    for (int i = 0; i < np; ++i) { a.lo = phases[i]; a.hi = phases[i] + 1; hipLaunchKernelGGL(fwd_kernel, dim3(grid), dim3(NT), LDS_BYTES, stream, a); }
#else
    a.lo = 0; a.hi = 65;
    hipLaunchKernelGGL(fwd_kernel, dim3(grid), dim3(NT), LDS_BYTES, stream, a);
#ifdef PROBE_PHASES
    { const int pp[] = {PROBE_PHASES};
      for (int rep = 0; rep < PROBE_REPS; ++rep) for (unsigned i = 0; i < sizeof(pp) / sizeof(pp[0]); ++i) { a.lo = pp[i]; a.hi = pp[i] + 1; hipLaunchKernelGGL(fwd_kernel, dim3(grid), dim3(NT), LDS_BYTES, stream, a); } }
#endif
#endif
}
```

```cpp
#include <hip/hip_runtime.h>
#include <cstdio>
#include <cstdint>

#define LAS __attribute__((address_space(3)))
typedef unsigned short bf16;
typedef float f32x4 __attribute__((ext_vector_type(4)));
typedef unsigned u32x4 __attribute__((ext_vector_type(4)));
typedef unsigned u32x2 __attribute__((ext_vector_type(2)));
typedef int i32x4r __attribute__((ext_vector_type(4)));

constexpr int D = 1024, BATCH = 2, SEQ = 16384, DEPTH = 4, CTXL = 256;
constexpr int NL = BATCH * SEQ, NCX = BATCH * CTXL, NR = NL + NCX;
constexpr int NH = 4, DQK = 128, DV = 256, NQ = 512, NV = 1024, PROJ = 3088, PW = 3072;
constexpr int NGRP = 4, EPG = 8, NE = 32, DE = 512;
constexpr int NBLK = 65;
constexpr int NUNIT = BATCH * NH * NBLK;
constexpr int CAP = NR;
constexpr int YROWS = 74752;
constexpr float EPS = 1e-6f;
constexpr float WSCALE = 32.0f;
constexpr float YSCALE = 4.0f;
constexpr int NT = 512, NW = 8;
constexpr int LDS_TAB_END = 152 * 1024 - 16;

constexpr size_t MiB = 1u << 20;
constexpr size_t WS_CTL = 0, CTL_BYTES = 1 * MiB;
constexpr size_t WS_MOD = 1 * MiB;
constexpr size_t WS_GATE = 2 * MiB;
constexpr size_t WS_TOKSLOT = 5 * MiB;
constexpr size_t WS_TOKW = 6 * MiB;
constexpr size_t WS_SLOTTOK = 7 * MiB;
constexpr size_t WS_DN = 12 * MiB;
constexpr size_t WS_NST = 13 * MiB;
constexpr size_t WS_BTOT = 14 * MiB;
constexpr size_t WS_RSC = 15 * MiB;
constexpr size_t WS_LAT = 16 * MiB;
constexpr size_t WS_HB = 146 * MiB;
constexpr size_t WS_PB = 211 * MiB;
constexpr size_t WS_HM = 406 * MiB;
constexpr size_t WS_DC = 471 * MiB;
constexpr size_t WS_CST = 601 * MiB;
constexpr size_t WS_VT = 666 * MiB;
constexpr size_t WS_WAIN = 731 * MiB;
constexpr size_t WS_WBIN = 743 * MiB;
constexpr size_t WS_WAOUT = 755 * MiB;
constexpr size_t WS_WBOUT = 759 * MiB;
constexpr size_t WS_WGU = 763 * MiB;
constexpr size_t WS_WDN = 827 * MiB;
constexpr size_t WS_H8 = 843 * MiB;
constexpr size_t WS_END = 880 * MiB;
constexpr int CW_WMAX = 256;
constexpr int CW_CNT = 1024, CNT_STRIDE = 64;

struct Args { const float* in[22]; float* out; unsigned char* ws; int lo, hi; };

typedef short bf16x8 __attribute__((ext_vector_type(8)));
typedef float f32x2 __attribute__((ext_vector_type(2)));
typedef __bf16 bf16x2_t __attribute__((ext_vector_type(2)));
__device__ __forceinline__ unsigned cvt2(float lo, float hi) { const f32x2 v = {lo, hi}; return __builtin_bit_cast(unsigned, __builtin_convertvector(v, bf16x2_t)); }
__device__ __forceinline__ float bf2f(bf16 v) { return __uint_as_float(((unsigned)v) << 16); }
__device__ __forceinline__ unsigned f2bf(float f) { unsigned u = __float_as_uint(f); return (u + 0x7fffu + ((u >> 16) & 1u)) >> 16; }
__device__ __forceinline__ unsigned pk2(float lo, float hi) { return f2bf(lo) | (f2bf(hi) << 16); }
template <int CTRL, int ROWMASK> __device__ __forceinline__ float dpp_mov(float x) { return __int_as_float(__builtin_amdgcn_update_dpp(0, __float_as_int(x), CTRL, ROWMASK, 0xf, false)); }
__device__ __forceinline__ float wave_sum(float v) {
    v += dpp_mov<0xB1, 0xf>(v); v += dpp_mov<0x4E, 0xf>(v); v += dpp_mov<0x141, 0xf>(v); v += dpp_mov<0x140, 0xf>(v);
    v += dpp_mov<0x142, 0xA>(v); v += dpp_mov<0x143, 0xC>(v);
    return __int_as_float(__builtin_amdgcn_readlane(__float_as_int(v), 63));
}
__device__ __forceinline__ float wave_max_nn(float v) {
    v = fmaxf(v, dpp_mov<0xB1, 0xf>(v)); v = fmaxf(v, dpp_mov<0x4E, 0xf>(v)); v = fmaxf(v, dpp_mov<0x141, 0xf>(v)); v = fmaxf(v, dpp_mov<0x140, 0xf>(v));
    v = fmaxf(v, dpp_mov<0x142, 0xA>(v)); v = fmaxf(v, dpp_mov<0x143, 0xC>(v));
    return __int_as_float(__builtin_amdgcn_readlane(__float_as_int(v), 63));
}
__device__ __forceinline__ unsigned pack_i8(f32x4 v) {
    const int a = (int)__builtin_rintf(fminf(fmaxf(v.x, -127.f), 127.f)), b = (int)__builtin_rintf(fminf(fmaxf(v.y, -127.f), 127.f)), c = (int)__builtin_rintf(fminf(fmaxf(v.z, -127.f), 127.f)), d = (int)__builtin_rintf(fminf(fmaxf(v.w, -127.f), 127.f));
    return (unsigned)(a & 255) | ((unsigned)(b & 255) << 8) | ((unsigned)(c & 255) << 16) | ((unsigned)d << 24);
}
__device__ __forceinline__ float sigmoidf_(float x) { return 1.f / (1.f + __expf(-x)); }
__device__ __forceinline__ float siluf_(float x) { return x / (1.f + __expf(-x)); }
__device__ __forceinline__ float logsigmoidf_(float x) { return fminf(x, 0.f) - log1pf(__expf(-fabsf(x))); }
__device__ __forceinline__ int blk_row0(int b, int blk) { return blk == 0 ? NL + b * CTXL : b * SEQ + (blk - 1) * 256; }
__device__ __forceinline__ int mod_vec_of_row(int row) { return row < NL ? row / SEQ : 2; }

struct Ctx {
    LAS unsigned char* lds; int tid, lane, wave, G, bid;
    const Args* a;
};

__device__ __forceinline__ int expert_block_prefix(const unsigned* cnt, int lane, int& nb) {
    nb = lane < NE ? ((int)cnt[lane * CNT_STRIDE] + 255) / 256 : 0; int v = nb;
#pragma unroll
    for (int o = 1; o < 64; o <<= 1) { const int t = __shfl_up(v, o); v += (lane >= o) ? t : 0; }
    return v - nb;
}
__device__ __forceinline__ void slot_bases(const Args& A, int l, LAS int* sb, int tid) {
    if (tid < 64) { int nb; const int ex = expert_block_prefix((const unsigned*)(A.ws + WS_CTL) + CW_CNT + l * 32 * CNT_STRIDE, tid, nb); if (tid <= NE) sb[tid] = ex * 256; }
    __syncthreads();
}

__device__ __forceinline__ void phase_mod(const Args& A, const Ctx& C) {
    LAS float* sc = (LAS float*)C.lds;
    LAS float* red = sc + 3072;
    const float* c = A.in[1]; const float* cc = A.in[3];
    for (int i = C.tid; i < 3072; i += NT) { const float v = i < 2048 ? c[i] : cc[i - 2048]; sc[i] = siluf_(v); }
    __syncthreads();
    float* MOD = (float*)(A.ws + WS_MOD);
    for (int u = C.bid; u < DEPTH * 96; u += C.G) {
        const int l = u / 96, cg = u % 96, col = cg * 64 + C.lane;
        const float* w = A.in[4] + (size_t)l * D * 6 * D + col;
        float a0 = 0.f, a1 = 0.f, a2 = 0.f;
#pragma unroll 32
        for (int k = C.wave * 128; k < C.wave * 128 + 128; ++k) { const float wv = w[(size_t)k * 6 * D]; a0 += sc[k] * wv; a1 += sc[1024 + k] * wv; a2 += sc[2048 + k] * wv; }
        red[(C.wave * 3 + 0) * 64 + C.lane] = a0; red[(C.wave * 3 + 1) * 64 + C.lane] = a1; red[(C.wave * 3 + 2) * 64 + C.lane] = a2;
        __syncthreads();
        if (C.tid < 192) { const int v = C.tid / 64, ln = C.tid % 64; float s = 0.f;
            for (int w8 = 0; w8 < 8; ++w8) s += red[(w8 * 3 + v) * 64 + ln];
            MOD[(size_t)(l * 3 + v) * 6 * D + cg * 64 + ln] = s + A.in[5][(size_t)l * 6 * D + cg * 64 + ln]; }
        __syncthreads();
    }
}

__device__ __forceinline__ void load_row_f32(const float* p, int lane, f32x4 (&v)[4]) {
#pragma unroll
    for (int j = 0; j < 4; ++j) v[j] = *(const f32x4*)(p + 4 * lane + 256 * j);
}
__device__ __forceinline__ void load_row_bf16(const bf16* p, int lane, f32x4 (&v)[4]) {
#pragma unroll
    for (int j = 0; j < 4; ++j) { const u32x2 w = *(const u32x2*)(p + 4 * lane + 256 * j);
        v[j] = (f32x4){__uint_as_float(w.x << 16), __uint_as_float(w.x & 0xffff0000u), __uint_as_float(w.y << 16), __uint_as_float(w.y & 0xffff0000u)}; }
}
__device__ __forceinline__ void store_row_bf16(bf16* p, int lane, const f32x4 (&v)[4]) {
#pragma unroll
    for (int j = 0; j < 4; ++j) { u32x2 w; w.x = pk2(v[j].x, v[j].y); w.y = pk2(v[j].z, v[j].w); *(u32x2*)(p + 4 * lane + 256 * j) = w; }
}
constexpr int CVT_IG = (D / 64) * (DE / 32), CVT_ID = (DE / 64) * (D / 32), CVT_PER = 2 * CVT_IG + CVT_ID, CVT_ITEMS = NE * CVT_PER;
constexpr int CVT_Q = 24;
__device__ __forceinline__ void cvt_moe_items(const Args& A, const Ctx& C, int l, int it0, int end, int stride);
__device__ __forceinline__ void cvt_win_i8(const Args& A, const Ctx& C);
__device__ __forceinline__ int cvt_t2(int l, int G);
struct RowVec { f32x4 a[4], s[4], g[4]; };
__device__ __forceinline__ void load_rowvec(RowVec& R, const float* ng, const float* sh, const float* sc, const float* gt, int lane) {
    f32x4 n[4], c[4]; load_row_f32(ng, lane, n); load_row_f32(sc, lane, c); load_row_f32(sh, lane, R.s); if (gt) load_row_f32(gt, lane, R.g);
#pragma unroll
    for (int q = 0; q < 4; ++q) R.a[q] = n[q] * (1.f + c[q]);
}
__device__ __forceinline__ void load_row_bf16raw(const bf16* p, int lane, u32x2 (&v)[4]) {
#pragma unroll
    for (int j = 0; j < 4; ++j) v[j] = *(const u32x2*)(p + 4 * lane + 256 * j);
}
__device__ __forceinline__ void store_row_fp8(unsigned char* p, int lane, const f32x4 (&v)[4]) {
#pragma unroll
    for (int j = 0; j < 4; ++j) { int w = 0; w = __builtin_amdgcn_cvt_pk_fp8_f32(v[j].x, v[j].y, w, false); w = __builtin_amdgcn_cvt_pk_fp8_f32(v[j].z, v[j].w, w, true); *(unsigned*)(p + 4 * lane + 256 * j) = (unsigned)w; }
}
__device__ __forceinline__ void load_row_fp8raw(const unsigned char* p, int lane, unsigned (&v)[4]) {
#pragma unroll
    for (int j = 0; j < 4; ++j) v[j] = *(const unsigned*)(p + 4 * lane + 256 * j);
}
__device__ __forceinline__ f32x4 fp8x4(unsigned w) { const f32x2 lo = __builtin_amdgcn_cvt_pk_f32_fp8((int)w, false), hi = __builtin_amdgcn_cvt_pk_f32_fp8((int)w, true); return (f32x4){lo.x, lo.y, hi.x, hi.y}; }
__device__ __forceinline__ f32x4 bf4(u32x2 w) { return (f32x4){__uint_as_float(w.x << 16), __uint_as_float(w.x & 0xffff0000u), __uint_as_float(w.y << 16), __uint_as_float(w.y & 0xffff0000u)}; }
__device__ __forceinline__ float row_rstd(const f32x4 (&v)[4]) {
    float s = 0.f;
#pragma unroll
    for (int j = 0; j < 4; ++j) s += (v[j].x * v[j].x + v[j].y * v[j].y) + (v[j].z * v[j].z + v[j].w * v[j].w);
    return 1.0f / sqrtf(wave_sum(s) * (1.f / D) + EPS);
}

__device__ __forceinline__ void phase_r1(const Args& A, const Ctx& C, int l) {
    LAS int* sb = (LAS int*)C.lds;
    LAS float* GW = (LAS float*)(C.lds + 256);
    const bool mls = (l & 1) == 0; const int j = l >> 1;
    if (l == 0) { cvt_win_i8(A, C); __syncthreads(); }
    if (l > 0) slot_bases(A, l - 1, sb, C.tid);
    if (mls) { const float* w = A.in[8] + (size_t)j * D * PROJ + PW;
        f32x4 t[2][4];
#pragma unroll
        for (int jj = 0; jj < 2; ++jj)
#pragma unroll
            for (int q = 0; q < 4; ++q) t[jj][q] = *(const f32x4*)(w + (size_t)(C.tid + NT * jj) * PROJ + 4 * q);
#pragma unroll
        for (int jj = 0; jj < 2; ++jj)
#pragma unroll
            for (int q = 0; q < 4; ++q) { const int k = C.tid + NT * jj; GW[(4 * q + 0) * D + k] = t[jj][q].x; GW[(4 * q + 1) * D + k] = t[jj][q].y; GW[(4 * q + 2) * D + k] = t[jj][q].z; GW[(4 * q + 3) * D + k] = t[jj][q].w; }
        __syncthreads(); }
    const int nrows = (l <= 2) ? NR : NL;
    bf16* LAT = (bf16*)(A.ws + WS_LAT); unsigned char* HI8 = A.ws + WS_H8; float* RSC = (float*)(A.ws + WS_RSC); float* GATE = (float*)(A.ws + WS_GATE);
    const float* MOD = (const float*)(A.ws + WS_MOD); const unsigned char* Y8 = A.ws + WS_PB;
    const int* TS = (const int*)(A.ws + WS_TOKSLOT); const float* TW = (const float*)(A.ws + WS_TOKW);
    const int rpw = (((nrows + C.G - 1) / C.G) + 1) & ~1; const int wrow0 = C.bid * rpw; const int wend = min(wrow0 + rpw, nrows);
    for (int sa = wrow0; sa < wend;) {
        const int mvi = mod_vec_of_row(sa); const int bnd = mvi == 0 ? SEQ : (mvi == 1 ? NL : NR); const int sbnd = min(wend, bnd);
        RowVec RV; { const float* mv = MOD + (size_t)(l * 3 + mvi) * 6 * D;
            load_rowvec(RV, A.in[6] + (size_t)(l * 2 + 0) * D, mv + 0 * D, mv + 1 * D, l > 0 ? MOD + (size_t)((l - 1) * 3 + mvi) * 6 * D + 5 * D : nullptr, C.lane); }
        const int rlast = sbnd - 2;
        i32x4r tsn = (i32x4r){0, 0, 0, 0}; f32x4 twn = (f32x4){0.f, 0.f, 0.f, 0.f};
        if (l > 0) { const int r0 = min(sa + 2 * C.wave, rlast); tsn = *(const i32x4r*)(TS + r0 * 2); twn = *(const f32x4*)(TW + r0 * 2); }
        for (int ra = sa + 2 * C.wave; ra < sbnd; ra += 2 * NW) {
            const bool hasb = true; const int rb = ra + 1;
            const i32x4r tsc = tsn; const f32x4 twc = twn;
            if (l > 0) { const int r1 = min(ra + 2 * NW, rlast); tsn = *(const i32x4r*)(TS + r1 * 2); twn = *(const f32x4*)(TW + r1 * 2); }
            f32x4 va[4], vb[4]; float wa0 = 0.f, wa1 = 0.f, wb0 = 0.f, wb1 = 0.f;
            if (l == 0) { load_row_f32(ra < NL ? A.in[0] + (size_t)ra * D : A.in[2] + (size_t)(ra - NL) * D, C.lane, va); load_row_f32(rb < NL ? A.in[0] + (size_t)rb * D : A.in[2] + (size_t)(rb - NL) * D, C.lane, vb); }
            else {
                const int ta0 = tsc.x, ta1 = tsc.y, tb0 = tsc.z, tb1 = tsc.w; wa0 = twc.x; wa1 = twc.y; wb0 = twc.z; wb1 = twc.w;
                load_row_bf16(LAT + (size_t)ra * D, C.lane, va); load_row_bf16(LAT + (size_t)rb * D, C.lane, vb);
                unsigned ya0[4], ya1[4], yb0[4], yb1[4];
                load_row_fp8raw(Y8 + (size_t)(sb[ta0 >> 20] + (ta0 & 0xfffff)) * D, C.lane, ya0); load_row_fp8raw(Y8 + (size_t)(sb[ta1 >> 20] + (ta1 & 0xfffff)) * D, C.lane, ya1);
                load_row_fp8raw(Y8 + (size_t)(sb[tb0 >> 20] + (tb0 & 0xfffff)) * D, C.lane, yb0); load_row_fp8raw(Y8 + (size_t)(sb[tb1 >> 20] + (tb1 & 0xfffff)) * D, C.lane, yb1);
                wa0 *= 1.0f / YSCALE; wa1 *= 1.0f / YSCALE; wb0 *= 1.0f / YSCALE; wb1 *= 1.0f / YSCALE;
#pragma unroll
                for (int q = 0; q < 4; ++q) { va[q] += RV.g[q] * (fp8x4(ya0[q]) * wa0 + fp8x4(ya1[q]) * wa1); vb[q] += RV.g[q] * (fp8x4(yb0[q]) * wb0 + fp8x4(yb1[q]) * wb1); }
            }
            store_row_bf16(LAT + (size_t)ra * D, C.lane, va); if (hasb) store_row_bf16(LAT + (size_t)rb * D, C.lane, vb);
            const float rra = row_rstd(va), rrb = row_rstd(vb);
            f32x4 ha[4], hb[4];
#pragma unroll
            for (int q = 0; q < 4; ++q) { ha[q] = (va[q] * rra) * RV.a[q] + RV.s[q]; hb[q] = (vb[q] * rrb) * RV.a[q] + RV.s[q]; }
            { float ma = 0.f, mb = 0.f;
#pragma unroll
              for (int q = 0; q < 4; ++q) { ma = fmaxf(ma, fmaxf(fmaxf(fabsf(ha[q].x), fabsf(ha[q].y)), fmaxf(fabsf(ha[q].z), fabsf(ha[q].w)))); mb = fmaxf(mb, fmaxf(fmaxf(fabsf(hb[q].x), fabsf(hb[q].y)), fmaxf(fabsf(hb[q].z), fabsf(hb[q].w)))); }
              ma = fmaxf(wave_max_nn(ma), 1.0e-20f); mb = fmaxf(wave_max_nn(mb), 1.0e-20f);
              const float ia = 127.0f / ma, ib = 127.0f / mb;
#pragma unroll
              for (int q = 0; q < 4; ++q) { *(unsigned*)(HI8 + (size_t)ra * D + 4 * C.lane + 256 * q) = pack_i8(ha[q] * ia); *(unsigned*)(HI8 + (size_t)rb * D + 4 * C.lane + 256 * q) = pack_i8(hb[q] * ib); }
              if (C.lane == 0) { RSC[ra] = ma * (1.0f / 127.0f); RSC[rb] = mb * (1.0f / 127.0f); } }
            if (mls) {
                float ga = 0.f, gb = 0.f;
#pragma unroll 2
                for (int c = 0; c < 16; ++c) { float s0 = 0.f, s1 = 0.f;
#pragma unroll
                    for (int q = 0; q < 4; ++q) { const f32x4 w = *(const LAS f32x4*)(GW + c * D + 4 * C.lane + 256 * q);
                        s0 += (ha[q].x * w.x + ha[q].y * w.y) + (ha[q].z * w.z + ha[q].w * w.w); s1 += (hb[q].x * w.x + hb[q].y * w.y) + (hb[q].z * w.z + hb[q].w * w.w); }
                    s0 = wave_sum(s0); s1 = wave_sum(s1); ga = (C.lane == c) ? s0 : ga; gb = (C.lane == c) ? s1 : gb; }
                if (C.lane < 16) {
                    const float bgt = A.in[9][j * 16 + C.lane]; const int gtype = C.lane >> 2;
                    ga += bgt; gb += bgt;
                    GATE[(size_t)ra * 16 + C.lane] = (gtype & 1) ? logsigmoidf_(ga) : 15.0f * tanhf(ga * (1.0f / 15.0f));
                    if (hasb) GATE[(size_t)rb * 16 + C.lane] = (gtype & 1) ? logsigmoidf_(gb) : 15.0f * tanhf(gb * (1.0f / 15.0f)); }
            }
        }
        sa = sbnd;
    }
}

__device__ __forceinline__ void phase_r2(const Args& A, const Ctx& C, int l) {
    constexpr int WP = 2064;
    LAS unsigned char* RWB = C.lds;
    LAS float* WL = (LAS float*)(C.lds + 48 * WP);
    LAS unsigned* hist = (LAS unsigned*)(WL + 8 * 16 * 48);
    LAS unsigned* gbase = hist + 32;
    constexpr int RCAP = 144;
    LAS int* rec = (LAS int*)(gbase + 32);
    static_assert(48 * WP + 8 * 16 * 48 * 4 + 256 + RCAP * 16 <= LDS_TAB_END, "R2 LDS map");
    cvt_moe_items(A, C, l, cvt_t2(l, C.G) + C.bid * NW + C.wave, CVT_ITEMS, C.G * NW);
    __syncthreads();
    { const float* wg = A.in[15] + (size_t)l * D * NGRP; const float* wr = A.in[17] + (size_t)l * D * NE;
      { const int kp = C.tid; const f32x4 x0 = *(const f32x4*)(wg + (size_t)(2 * kp) * 4), x1 = *(const f32x4*)(wg + (size_t)(2 * kp + 1) * 4);
        *(LAS unsigned*)(RWB + 0 * WP + kp * 4) = cvt2(x0.x, x1.x); *(LAS unsigned*)(RWB + 1 * WP + kp * 4) = cvt2(x0.y, x1.y);
        *(LAS unsigned*)(RWB + 2 * WP + kp * 4) = cvt2(x0.z, x1.z); *(LAS unsigned*)(RWB + 3 * WP + kp * 4) = cvt2(x0.w, x1.w); }
      f32x4 t0[8], t1[8];
#pragma unroll
      for (int jj = 0; jj < 8; ++jj) { const int it = C.tid + NT * jj, kp = it >> 3, cg = it & 7; t0[jj] = *(const f32x4*)(wr + (size_t)(2 * kp) * NE + 4 * cg); t1[jj] = *(const f32x4*)(wr + (size_t)(2 * kp + 1) * NE + 4 * cg); }
#pragma unroll
      for (int jj = 0; jj < 8; ++jj) { const int it = C.tid + NT * jj, kp = it >> 3, c0 = 4 + 4 * (it & 7);
          *(LAS unsigned*)(RWB + (c0 + 0) * WP + kp * 4) = cvt2(t0[jj].x, t1[jj].x); *(LAS unsigned*)(RWB + (c0 + 1) * WP + kp * 4) = cvt2(t0[jj].y, t1[jj].y);
          *(LAS unsigned*)(RWB + (c0 + 2) * WP + kp * 4) = cvt2(t0[jj].z, t1[jj].z); *(LAS unsigned*)(RWB + (c0 + 3) * WP + kp * 4) = cvt2(t0[jj].w, t1[jj].w); }
      for (int i = C.tid; i < 12 * 512; i += NT) *(LAS unsigned*)(RWB + (36 + i / 512) * WP + (i % 512) * 4) = 0u; }
    const int nrows = (l <= 1) ? NR : NL;
    bf16* LAT = (bf16*)(A.ws + WS_LAT); bf16* H = (bf16*)(A.ws + WS_HB); unsigned char* H8 = A.ws + WS_H8;
    const float* MOD = (const float*)(A.ws + WS_MOD);
    unsigned* cnt = (unsigned*)(A.ws + WS_CTL) + CW_CNT + l * 32 * CNT_STRIDE;
    int* TS = (int*)(A.ws + WS_TOKSLOT); float* TW = (float*)(A.ws + WS_TOKW); int* ST = (int*)(A.ws + WS_SLOTTOK);
    const int rpw = (((nrows + C.G - 1) / C.G) + 1) & ~1; const int wrow0 = C.bid * rpw; const int wend0 = min(wrow0 + rpw, nrows);
    const float* bg = A.in[16] + l * NGRP; const float* br = A.in[18] + l * NE;
    for (int cb = wrow0; cb < wend0; cb += RCAP) {
        const int wend = min(cb + RCAP, wend0);
        if (C.tid < 32) hist[C.tid] = 0u;
        for (int sa = cb; sa < wend;) {
            const int mvi = mod_vec_of_row(sa); const int bnd = mvi == 0 ? SEQ : (mvi == 1 ? NL : NR); const int sbnd = min(wend, bnd);
            RowVec RV; { const float* mv = MOD + (size_t)(l * 3 + mvi) * 6 * D; load_rowvec(RV, A.in[6] + (size_t)(l * 2 + 1) * D, mv + 3 * D, mv + 4 * D, mv + 2 * D, C.lane); }
            const int rlast = sbnd - 2;
            u32x2 la[4], lb[4], ya[4], yb[4];
            { const int r0 = min(sa + 2 * C.wave, rlast); load_row_bf16raw(LAT + (size_t)r0 * D, C.lane, la); load_row_bf16raw(LAT + (size_t)(r0 + 1) * D, C.lane, lb);
              load_row_bf16raw(H + (size_t)r0 * D, C.lane, ya); load_row_bf16raw(H + (size_t)(r0 + 1) * D, C.lane, yb); }
            for (int ra = sa + 2 * C.wave; ra < sbnd; ra += 2 * NW) {
                const int rb = ra + 1;
                u32x2 lan[4], lbn[4], yan[4], ybn[4];
                { const int r1 = min(ra + 2 * NW, rlast); load_row_bf16raw(LAT + (size_t)r1 * D, C.lane, lan); load_row_bf16raw(LAT + (size_t)(r1 + 1) * D, C.lane, lbn);
                  load_row_bf16raw(H + (size_t)r1 * D, C.lane, yan); load_row_bf16raw(H + (size_t)(r1 + 1) * D, C.lane, ybn); }
                f32x4 va[4], vb[4];
#pragma unroll
                for (int q = 0; q < 4; ++q) { va[q] = bf4(la[q]) + RV.g[q] * bf4(ya[q]); vb[q] = bf4(lb[q]) + RV.g[q] * bf4(yb[q]); }
                store_row_bf16(LAT + (size_t)ra * D, C.lane, va); store_row_bf16(LAT + (size_t)rb * D, C.lane, vb);
                const float rra = row_rstd(va), rrb = row_rstd(vb);
                f32x4 ha[4], hb[4];
#pragma unroll
                for (int q = 0; q < 4; ++q) { ha[q] = (va[q] * rra) * RV.a[q] + RV.s[q]; hb[q] = (vb[q] * rrb) * RV.a[q] + RV.s[q]; }
                store_row_bf16(H + (size_t)ra * D, C.lane, ha); store_row_bf16(H + (size_t)rb * D, C.lane, hb);
                store_row_fp8(H8 + (size_t)ra * D, C.lane, ha); store_row_fp8(H8 + (size_t)rb * D, C.lane, hb);
#pragma unroll
                for (int q = 0; q < 4; ++q) { la[q] = lan[q]; lb[q] = lbn[q]; ya[q] = yan[q]; yb[q] = ybn[q]; }
            }
            sa = sbnd;
        }
        __syncthreads();
        const int fr = C.lane & 15, fq = C.lane >> 4;
        for (int t = C.wave; t * 16 < wend - cb; t += NW) {
            const int trow = min(cb + 16 * t + fr, wend - 1);
            const bf16* hp = H + (size_t)trow * D + 8 * fq;
            f32x4 acc[3];
#pragma unroll
            for (int ct = 0; ct < 3; ++ct) acc[ct] = (f32x4){0.f, 0.f, 0.f, 0.f};
#pragma unroll 1
            for (int kb = 0; kb < 4; ++kb) {
                bf16x8 av[8];
#pragma unroll
                for (int k8 = 0; k8 < 8; ++k8) av[k8] = *(const bf16x8*)(hp + 32 * (8 * kb + k8));
#pragma unroll
                for (int k8 = 0; k8 < 8; ++k8)
#pragma unroll
                    for (int ct = 0; ct < 3; ++ct) { const bf16x8 bv = *(const LAS bf16x8*)(RWB + (ct * 16 + fr) * WP + (32 * (8 * kb + k8) + 8 * fq) * 2);
                        acc[ct] = __builtin_amdgcn_mfma_f32_16x16x32_bf16(av[k8], bv, acc[ct], 0, 0, 0); }
            }
            LAS float* wl = WL + C.wave * 16 * 48;
#pragma unroll
            for (int ct = 0; ct < 3; ++ct)
#pragma unroll
                for (int jq = 0; jq < 4; ++jq) wl[(4 * fq + jq) * 48 + ct * 16 + fr] = acc[ct][jq];
            asm volatile("s_waitcnt lgkmcnt(0)" ::: "memory");
            const int row = cb + 16 * t + C.lane;
            if (C.lane < 16 && row < wend) {
                LAS const float* wm = wl + C.lane * 48;
                float lg[36];
#pragma unroll
                for (int c = 0; c < 36; ++c) lg[c] = wm[c];
                float gl[4]; int grp = 0; float gm = -3.0e38f;
#pragma unroll
                for (int c = 0; c < 4; ++c) { gl[c] = lg[c] + bg[c]; if (gl[c] > gm) { gm = gl[c]; grp = c; } }
                float gs = 0.f;
#pragma unroll
                for (int c = 0; c < 4; ++c) gs += __expf(gl[c] - gm);
                const float pgrp = 1.0f / gs;
                float rl[8];
#pragma unroll
                for (int i = 0; i < 8; ++i) { float tt = 0.f;
#pragma unroll
                    for (int g = 0; g < 4; ++g) tt = (g == grp) ? lg[4 + g * 8 + i] : tt;
                    rl[i] = tt + br[grp * 8 + i]; }
                int i0 = 0; float m0 = rl[0];
#pragma unroll
                for (int i = 1; i < 8; ++i) if (rl[i] > m0) { m0 = rl[i]; i0 = i; }
                int i1 = -1; float m1 = -3.0e38f;
#pragma unroll
                for (int i = 0; i < 8; ++i) if (i != i0 && rl[i] > m1) { m1 = rl[i]; i1 = i; }
                const float p0 = 1.0f, p1 = __expf(m1 - m0);
                const float w0 = pgrp * p0 / (p0 + p1), w1 = pgrp * p1 / (p0 + p1);
                const int e0 = grp * 8 + i0, e1 = grp * 8 + i1;
                const unsigned q0 = __hip_atomic_fetch_add(hist + e0, 1u, __ATOMIC_RELAXED, __HIP_MEMORY_SCOPE_WORKGROUP), q1 = __hip_atomic_fetch_add(hist + e1, 1u, __ATOMIC_RELAXED, __HIP_MEMORY_SCOPE_WORKGROUP);
                const int li = row - cb;
                rec[li * 4 + 0] = e0 | (e1 << 8); rec[li * 4 + 1] = (int)q0; rec[li * 4 + 2] = (int)q1;
                TW[row * 2 + 0] = w0; TW[row * 2 + 1] = w1;
            }
        }
        __syncthreads();
        if (C.tid < 32) gbase[C.tid] = hist[C.tid] ? atomicAdd(cnt + C.tid * CNT_STRIDE, hist[C.tid]) : 0u;
        __syncthreads();
        for (int i = C.tid; i < wend - cb; i += NT) { const int row = cb + i; const int ee = rec[i * 4], e0 = ee & 255, e1 = ee >> 8;
            const unsigned q0 = gbase[e0] + (unsigned)rec[i * 4 + 1], q1 = gbase[e1] + (unsigned)rec[i * 4 + 2];
            ST[(size_t)e0 * CAP + q0] = row; ST[(size_t)e1 * CAP + q1] = row;
            TS[row * 2 + 0] = (e0 << 20) | (int)q0; TS[row * 2 + 1] = (e1 << 20) | (int)q1; }
        __syncthreads();
    }
}

__device__ __forceinline__ void phase_final(const Args& A, const Ctx& C) {
    LAS int* sb = (LAS int*)C.lds;
    slot_bases(A, 3, sb, C.tid);
    const bf16* LAT = (const bf16*)(A.ws + WS_LAT); const unsigned char* Y8 = A.ws + WS_PB;
    const int* TS = (const int*)(A.ws + WS_TOKSLOT); const float* TW = (const float*)(A.ws + WS_TOKW);
    const float* MOD = (const float*)(A.ws + WS_MOD);
    f32x4 fg[4]; load_row_f32(A.in[7], C.lane, fg);
    const int rpw = (((NL + C.G - 1) / C.G) + 1) & ~1; const int wrow0 = C.bid * rpw; const int wend = min(wrow0 + rpw, NL);
    for (int sa = wrow0; sa < wend;) {
        const int mvi = mod_vec_of_row(sa); const int sbnd = min(wend, mvi == 0 ? SEQ : NL);
        f32x4 g2[4]; load_row_f32(MOD + (size_t)(3 * 3 + mvi) * 6 * D + 5 * D, C.lane, g2);
        for (int ra = sa + 2 * C.wave; ra < sbnd; ra += 2 * NW) {
            const int rb = ra + 1;
            const int ta0 = TS[ra * 2], ta1 = TS[ra * 2 + 1], tb0 = TS[rb * 2], tb1 = TS[rb * 2 + 1]; const float wa0 = TW[ra * 2], wa1 = TW[ra * 2 + 1], wb0 = TW[rb * 2], wb1 = TW[rb * 2 + 1];
            f32x4 va[4], vb[4]; unsigned ya0[4], ya1[4], yb0[4], yb1[4];
            load_row_bf16(LAT + (size_t)ra * D, C.lane, va); load_row_bf16(LAT + (size_t)rb * D, C.lane, vb);
            load_row_fp8raw(Y8 + (size_t)(sb[ta0 >> 20] + (ta0 & 0xfffff)) * D, C.lane, ya0); load_row_fp8raw(Y8 + (size_t)(sb[ta1 >> 20] + (ta1 & 0xfffff)) * D, C.lane, ya1);
            load_row_fp8raw(Y8 + (size_t)(sb[tb0 >> 20] + (tb0 & 0xfffff)) * D, C.lane, yb0); load_row_fp8raw(Y8 + (size_t)(sb[tb1 >> 20] + (tb1 & 0xfffff)) * D, C.lane, yb1);
#pragma unroll
            for (int q = 0; q < 4; ++q) { va[q] += g2[q] * (fp8x4(ya0[q]) * (wa0 * (1.0f / YSCALE)) + fp8x4(ya1[q]) * (wa1 * (1.0f / YSCALE))); vb[q] += g2[q] * (fp8x4(yb0[q]) * (wb0 * (1.0f / YSCALE)) + fp8x4(yb1[q]) * (wb1 * (1.0f / YSCALE))); }
            const float rra = row_rstd(va), rrb = row_rstd(vb);
#pragma unroll
            for (int q = 0; q < 4; ++q) { *(f32x4*)(A.out + (size_t)ra * D + 4 * C.lane + 256 * q) = (va[q] * rra) * fg[q]; *(f32x4*)(A.out + (size_t)rb * D + 4 * C.lane + 256 * q) = (vb[q] * rrb) * fg[q]; }
        }
        sa = sbnd;
    }
}

__device__ __forceinline__ void phase_conv(const Args& A, const Ctx& C, int l) {
    const int j = l >> 1; const int nrows = (l <= 1) ? NR : NL;
    const bf16* P = (const bf16*)(A.ws + WS_PB); unsigned char* HM = A.ws + WS_HM; float* RSC = (float*)(A.ws + WS_RSC);
    const float* cw = A.in[13] + (size_t)j * 3 * D;
    f32x4 w0[4], w1[4], w2[4];
    load_row_f32(cw, C.lane, w0); load_row_f32(cw + D, C.lane, w1); load_row_f32(cw + 2 * D, C.lane, w2);
    const int rpw = (((nrows + C.G - 1) / C.G) + 1) & ~1; const int wrow0 = C.bid * rpw; const int wend = min(wrow0 + rpw, nrows);
    for (int ra = wrow0 + 2 * C.wave; ra < wend; ra += 2 * NW) {
        const int rb = ra + 1;
        const int ta = ra < NL ? (ra & 63) : ((ra - NL) & 255), tb1 = rb < NL ? (rb & 63) : ((rb - NL) & 255), tlast = ra < NL ? 63 : 255;
        const bool hasl = ta != 0, hasr = tb1 != tlast;
        const bf16* pa = P + (size_t)ra * PW;
        u32x2 bga[4], bgb[4], zm[4], z0[4], z1[4], z2[4];
        load_row_bf16raw(pa, C.lane, bga); load_row_bf16raw(pa + PW, C.lane, bgb);
        load_row_bf16raw(pa + D, C.lane, z0); load_row_bf16raw(pa + PW + D, C.lane, z1);
        load_row_bf16raw(hasl ? pa - PW + D : pa + D, C.lane, zm); load_row_bf16raw(hasr ? pa + 2 * PW + D : pa + D, C.lane, z2);
        const float fl = hasl ? 1.f : 0.f, fr = hasr ? 1.f : 0.f;
        f32x4 oa[4], ob[4];
#pragma unroll
        for (int q = 0; q < 4; ++q) { const f32x4 a0 = bf4(z0[q]), a1 = bf4(z1[q]);
            oa[q] = bf4(bga[q]) * (w0[q] * (bf4(zm[q]) * fl) + w1[q] * a0 + w2[q] * a1);
            ob[q] = bf4(bgb[q]) * (w0[q] * a0 + w1[q] * a1 + w2[q] * (bf4(z2[q]) * fr)); }
        float ma = 0.f, mb = 0.f;
#pragma unroll
        for (int q = 0; q < 4; ++q) { ma = fmaxf(ma, fmaxf(fmaxf(fabsf(oa[q].x), fabsf(oa[q].y)), fmaxf(fabsf(oa[q].z), fabsf(oa[q].w)))); mb = fmaxf(mb, fmaxf(fmaxf(fabsf(ob[q].x), fabsf(ob[q].y)), fmaxf(fabsf(ob[q].z), fabsf(ob[q].w)))); }
        ma = fmaxf(wave_max_nn(ma), 1.0e-20f); mb = fmaxf(wave_max_nn(mb), 1.0e-20f);
        const float ia = 127.0f / ma, ib = 127.0f / mb;
#pragma unroll
        for (int q = 0; q < 4; ++q) { *(unsigned*)(HM + (size_t)ra * D + 4 * C.lane + 256 * q) = pack_i8(oa[q] * ia); *(unsigned*)(HM + (size_t)rb * D + 4 * C.lane + 256 * q) = pack_i8(ob[q] * ib); }
        if (C.lane == 0) { RSC[ra] = ma * (1.0f / 127.0f); RSC[rb] = mb * (1.0f / 127.0f); }
    }
}

constexpr int BM = 256, BK = 64, HALF = 128, HTB = HALF * BK * 2, STAGE_BYTES = 8 * HTB, NXCD = 8, WGM = 8;
constexpr int LDS_TAB = STAGE_BYTES;
__device__ __forceinline__ int lds_byte(int r, int c) { const int st = (r >> 4) * 2 + (c >> 5), rr = r & 15, cc = c & 31, ob = rr * 64 + cc * 2; return st * 1024 + (ob ^ (((ob >> 9) & 1) << 5)); }
__device__ __forceinline__ void stage_rc(int b, int& R, int& C) { const int st = b / 1024, sb = b % 1024, swz = sb ^ (((sb >> 9) & 1) << 5); R = (st >> 1) * 16 + swz / 64; C = (st & 1) * 32 + (swz % 64) / 2; }
__device__ __forceinline__ int perm32(int rho) { const int n = rho >> 4, i = rho & 15; return 8 * (i >> 2) + 4 * n + (i & 3); }
__device__ __forceinline__ unsigned cvt_pk_bf16(float lo, float hi) { unsigned r; asm volatile("v_cvt_pk_bf16_f32 %0, %1, %2" : "=v"(r) : "v"(lo), "v"(hi)); return r; }

struct GUnit { const char* a; const char* b; int orow, ocol, aux; };

typedef int i32x8 __attribute__((ext_vector_type(8)));
typedef int i32x4 __attribute__((ext_vector_type(4)));
template <class Epi, class Sched, bool GATHER, int OPM = 0>
__device__ __forceinline__ void gemm_phase(LAS unsigned char* lds, const int K, const Sched& S, const Epi& E) {
    const int tid = threadIdx.x, wid = __builtin_amdgcn_readfirstlane(tid >> 6), lane = tid & 63, wr = wid >> 2, wc = wid & 3, fr = lane & 15, fq = lane >> 4;
    constexpr bool FP8 = (OPM == 1), I8 = (OPM == 2);
    const int RB = (OPM != 0) ? K : 2 * K;
    const int nt = RB / (BK * 2);
    unsigned voffB[2], voA[2][2]; int Rr[2], Cc[2];
#pragma unroll
    for (int i = 0; i < 2; ++i) { int R, C; stage_rc(tid * 16 + i * 8192, R, C); const int Rb = (R & ~31) + perm32(R & 31); Rr[i] = R; Cc[i] = C;
        voffB[i] = (unsigned)(Rb * RB + C * 2);
        voA[0][i] = (unsigned)(R * RB + C * 2); voA[1][i] = (unsigned)((R + HALF) * RB + C * 2); }
    const size_t kstep = (size_t)(BK * 2);
    const size_t hstep = (size_t)HALF * RB;
    const unsigned ldsw = (unsigned)wid * 1024u;
    const unsigned ldsbase = (unsigned)(size_t)lds;
    const int aoff = lds_byte(wr * 64 + fr, fq * 8), boff = lds_byte(wc * 32 + fr, fq * 8);
#define PG8_SA(b, h) (((b) * 2 + (h)) * HTB)
#define PG8_SB(b, h) ((4 + (b) * 2 + (h)) * HTB)
#define PG8_STAGE(bufoff, gbase, voff) do { _Pragma("unroll") for (int _i = 0; _i < 2; ++_i) \
        asm volatile("s_mov_b32 m0, %2\n\ts_nop 0\n\tglobal_load_lds_dwordx4 %0, %1" :: "v"((voff)[_i]), "s"((const char*)(gbase)), "s"(ldsbase + (unsigned)(bufoff) + ldsw + (unsigned)(_i * 8192)) : "memory"); } while (0)
#define PG8_STAGE_A1(bufoff, gbase) do { if constexpr (GATHER) PG8_STAGE(bufoff, gbase, voA[1]); else PG8_STAGE(bufoff, (const char*)(gbase) + hstep, voA[0]); } while (0)
#define PG8_LDA(dst, b, h) do { if constexpr (FP8) { _Pragma("unroll") for (int m = 0; m < 4; ++m) { \
        const i32x4 _lo = *(const LAS i32x4*)(lds + PG8_SA(b, h) + aoff + m * 2048), _hi = *(const LAS i32x4*)(lds + PG8_SA(b, h) + aoff + m * 2048 + 1024); \
        dst##8[m] = __builtin_shufflevector(_lo, _hi, 0, 1, 2, 3, 4, 5, 6, 7); } } \
      else { _Pragma("unroll") for (int m = 0; m < 4; ++m) _Pragma("unroll") for (int k = 0; k < 2; ++k) dst[m][k] = *(const LAS bf16x8*)(lds + PG8_SA(b, h) + aoff + m * 2048 + k * 1024); } } while (0)
#define PG8_LDB(dst, b, h) do { if constexpr (FP8) { _Pragma("unroll") for (int n = 0; n < 2; ++n) { \
        const i32x4 _lo = *(const LAS i32x4*)(lds + PG8_SB(b, h) + boff + n * 2048), _hi = *(const LAS i32x4*)(lds + PG8_SB(b, h) + boff + n * 2048 + 1024); \
        dst##8[n] = __builtin_shufflevector(_lo, _hi, 0, 1, 2, 3, 4, 5, 6, 7); } } \
      else { _Pragma("unroll") for (int n = 0; n < 2; ++n) _Pragma("unroll") for (int k = 0; k < 2; ++k) dst[n][k] = *(const LAS bf16x8*)(lds + PG8_SB(b, h) + boff + n * 2048 + k * 1024); } } while (0)
#define PG8_MMA(ai, bj, At, Bt) do { __builtin_amdgcn_s_setprio(1); \
        if constexpr (FP8) { _Pragma("unroll") for (int m = 0; m < 4; ++m) _Pragma("unroll") for (int n = 0; n < 2; ++n) \
            acc[ai][bj][m][n] = __builtin_amdgcn_mfma_scale_f32_16x16x128_f8f6f4(Bt##8[n], At##8[m], acc[ai][bj][m][n], 0, 0, 0, 0x7f7f7f7f, 0, 0x7f7f7f7f); } \
        else if constexpr (I8) { _Pragma("unroll") for (int m = 0; m < 4; ++m) _Pragma("unroll") for (int n = 0; n < 2; ++n) _Pragma("unroll") for (int k = 0; k < 2; ++k) \
            acc[ai][bj][m][n] = __builtin_bit_cast(f32x4, __builtin_amdgcn_mfma_i32_16x16x64_i8(__builtin_bit_cast(i32x4, Bt[n][k]), __builtin_bit_cast(i32x4, At[m][k]), __builtin_bit_cast(i32x4, acc[ai][bj][m][n]), 0, 0, 0)); } \
        else { _Pragma("unroll") for (int m = 0; m < 4; ++m) _Pragma("unroll") for (int n = 0; n < 2; ++n) _Pragma("unroll") for (int k = 0; k < 2; ++k) \
            acc[ai][bj][m][n] = __builtin_amdgcn_mfma_f32_16x16x32_bf16(Bt[n][k], At[m][k], acc[ai][bj][m][n], 0, 0, 0); } \
        __builtin_amdgcn_s_setprio(0); } while (0)
#define PG8_WAIT_V(n) asm volatile("s_waitcnt vmcnt(" #n ")" ::: "memory")
#define PG8_WAIT_L(n) asm volatile("s_waitcnt lgkmcnt(" #n ")" ::: "memory")
#define PG8_BAR __builtin_amdgcn_s_barrier()
#define PG8_SCHED __builtin_amdgcn_sched_barrier(0)
    GUnit cur, nxt; int ui = 0;
    if (!S.next(0, cur)) return;
    if constexpr (GATHER) {
#pragma unroll
        for (int h = 0; h < 2; ++h)
#pragma unroll
            for (int i = 0; i < 2; ++i) voA[h][i] = S.arow_off(0, h * HALF + Rr[i]) + (unsigned)Cc[i] * 2u;
    }
    f32x4 acc[2][2][4][2];
#pragma unroll
    for (int a = 0; a < 2; ++a)
#pragma unroll
        for (int b = 0; b < 2; ++b)
#pragma unroll
            for (int m = 0; m < 4; ++m)
#pragma unroll
                for (int n = 0; n < 2; ++n) acc[a][b][m][n] = (f32x4){0.f, 0.f, 0.f, 0.f};
    bf16x8 At[4][2], B0[2][2], B1[2][2]; i32x8 At8[4], B08[2], B18[2];
    const char* cA = cur.a; const char* cB = cur.b;
    PG8_STAGE(PG8_SB(0, 0), cB, voffB); PG8_STAGE(PG8_SB(0, 1), cB + hstep, voffB); PG8_STAGE(PG8_SA(0, 0), cA, voA[0]); PG8_STAGE_A1(PG8_SA(0, 1), cA);
    if (wr == 1) PG8_BAR;
    PG8_WAIT_V(2); PG8_BAR;
    PG8_STAGE(PG8_SB(1, 0), cB + kstep, voffB); PG8_STAGE(PG8_SA(1, 0), cA + kstep, voA[0]); PG8_STAGE(PG8_SB(1, 1), cB + hstep + kstep, voffB);
    PG8_WAIT_V(6); PG8_BAR;
    for (;;) {
        const bool has_next = S.next(ui + 1, nxt);
        const char* nA = has_next ? nxt.a : cA; const char* nB = has_next ? nxt.b : cB;
#pragma unroll 1
        for (int t = 0; t < nt; t += 2) {
            const bool last = (t == nt - 2);
            const char* a1 = cA + (size_t)(t + 1) * kstep;
            const char* a2 = last ? nA : cA + (size_t)(t + 2) * kstep; const char* b2 = last ? nB : cB + (size_t)(t + 2) * kstep;
            const char* a3 = a2 + kstep; const char* b3 = b2 + kstep;
            PG8_LDB(B0, 0, 0); PG8_LDB(B1, 0, 1); PG8_SCHED; PG8_LDA(At, 0, 0); PG8_STAGE_A1(PG8_SA(1, 1), a1);
            if constexpr (GATHER) { if (last && has_next) {
#pragma unroll
                for (int h = 0; h < 2; ++h)
#pragma unroll
                    for (int i = 0; i < 2; ++i) { int R2, C2; stage_rc(tid * 16 + i * 8192, R2, C2); voA[h][i] = S.arow_off(ui + 1, h * HALF + R2) + (unsigned)C2 * 2u; } } }
            PG8_WAIT_V(8); PG8_WAIT_L(0); PG8_BAR; PG8_MMA(0, 0, At, B0); PG8_MMA(0, 1, At, B1); PG8_BAR; PG8_SCHED;
            PG8_LDA(At, 0, 1); PG8_STAGE(PG8_SB(0, 0), b2, voffB); PG8_STAGE(PG8_SB(0, 1), b2 + hstep, voffB); PG8_STAGE(PG8_SA(0, 0), a2, voA[0]);
            PG8_WAIT_V(8); PG8_WAIT_L(0); PG8_BAR; PG8_MMA(1, 0, At, B0); PG8_MMA(1, 1, At, B1); PG8_BAR; PG8_SCHED;
            PG8_LDB(B0, 1, 0); PG8_LDB(B1, 1, 1); PG8_SCHED; PG8_LDA(At, 1, 0); PG8_STAGE_A1(PG8_SA(0, 1), a2);
            PG8_WAIT_V(8); PG8_WAIT_L(0); PG8_BAR; PG8_MMA(0, 0, At, B0); PG8_MMA(0, 1, At, B1); PG8_BAR; PG8_SCHED;
            PG8_LDA(At, 1, 1); PG8_STAGE(PG8_SB(1, 0), b3, voffB); PG8_STAGE(PG8_SB(1, 1), b3 + hstep, voffB); PG8_STAGE(PG8_SA(1, 0), a3, voA[0]);
            PG8_WAIT_V(8); PG8_WAIT_L(0); PG8_BAR; PG8_MMA(1, 0, At, B0); PG8_MMA(1, 1, At, B1); PG8_BAR; PG8_SCHED;
        }
        if (wr == 0) PG8_BAR;
        { int tz = threadIdx.x; asm volatile("" : "+v"(tz));
          if constexpr (I8) {
#pragma unroll
              for (int a_ = 0; a_ < 2; ++a_)
#pragma unroll
                  for (int b_ = 0; b_ < 2; ++b_)
#pragma unroll
                      for (int m = 0; m < 4; ++m)
#pragma unroll
                          for (int n = 0; n < 2; ++n) acc[a_][b_][m][n] = __builtin_convertvector(__builtin_bit_cast(i32x4, acc[a_][b_][m][n]), f32x4); }
          const int wz = tz >> 6, lz = tz & 63; E(acc, cur, wz >> 2, wz & 3, lz & 15, lz >> 4); }
        if (!has_next) break;
#pragma unroll
        for (int a = 0; a < 2; ++a)
#pragma unroll
            for (int b = 0; b < 2; ++b)
#pragma unroll
                for (int m = 0; m < 4; ++m)
#pragma unroll
                    for (int n = 0; n < 2; ++n) acc[a][b][m][n] = (f32x4){0.f, 0.f, 0.f, 0.f};
        cur = nxt; cA = nA; cB = nB; ++ui;
        if (wr == 1) PG8_BAR;
    }
    PG8_WAIT_V(0);
    PG8_BAR;
#undef PG8_SA
#undef PG8_SB
#undef PG8_STAGE
#undef PG8_STAGE_A1
#undef PG8_LDA
#undef PG8_LDB
#undef PG8_MMA
#undef PG8_WAIT_V
#undef PG8_WAIT_L
#undef PG8_BAR
#undef PG8_SCHED
}

__device__ __forceinline__ int xcd_remap(int L, int nwg) { const int q = nwg / NXCD, r = nwg % NXCD, xcd = L % NXCD, off = L / NXCD; return (xcd < r ? xcd * (q + 1) : r * (q + 1) + (xcd - r) * q) + off; }

struct DenseSched {
    const char* A; const char* Bt; int nM, nN, nwg, G, c; size_t tstep; int sw_lo, sw_hi;
    __device__ __forceinline__ void init(const void* A_, const void* Bt_, int M, int N, int K, int G_, int c_, int ebytes = 2) { A = (const char*)A_; Bt = (const char*)Bt_; nM = M / BM; nN = N / BM; nwg = nM * nN; G = G_; c = c_; tstep = (size_t)BM * K * ebytes; sw_lo = 0; sw_hi = 0; }
    __device__ __forceinline__ bool next(int i, GUnit& u) const {
        const long L = (long)i * G + c; if (L >= nwg) return false;
        const int wgid = xcd_remap((int)L, nwg);
        const int nig = WGM * nN, gid = wgid / nig, fm = gid * WGM, gsz = (nM - fm) < WGM ? (nM - fm) : WGM;
        const int pm = fm + ((wgid % nig) % gsz), pn = (wgid % nig) / gsz;
        if (pn >= sw_lo && pn < sw_hi) { u.a = Bt + (size_t)pn * tstep; u.b = A + (size_t)pm * tstep; u.orow = pm; u.ocol = pn - sw_lo; u.aux = 1; }
        else { u.a = A + (size_t)pm * tstep; u.b = Bt + (size_t)pn * tstep; u.orow = pm * BM; u.ocol = pn * BM; u.aux = 0; }
        return true;
    }
    __device__ __forceinline__ unsigned arow_off(int, int) const { return 0u; }
};

constexpr int MAXU = 12;
struct MoeTab { int n; int e[MAXU], mb[MAXU], nt[MAXU]; int sb[NE + 1]; };
struct MoeSched {
    LAS const MoeTab* T; LAS const unsigned* ridx;
    const char* A; const char* W; size_t wstride_e, tstepB; int K; int arow_bytes;
    __device__ __forceinline__ bool next(int i, GUnit& u) const {
        const int n = __builtin_amdgcn_readfirstlane(T->n); if (i >= n) return false;
        const int e = __builtin_amdgcn_readfirstlane(T->e[i]), mb = __builtin_amdgcn_readfirstlane(T->mb[i]), nt = __builtin_amdgcn_readfirstlane(T->nt[i]);
        const int base = __builtin_amdgcn_readfirstlane(T->sb[e]);
        u.orow = base + mb * BM; u.ocol = nt; u.aux = e;
        u.a = A + (size_t)u.orow * arow_bytes;
        u.b = W + (size_t)e * wstride_e + (size_t)nt * tstepB; return true;
    }
    __device__ __forceinline__ unsigned arow_off(int i, int r) const { return ridx[i * 256 + r]; }
};
template <bool GATHER>
__device__ __forceinline__ void moe_tables(const Args& A, const Ctx& C, int l, int ntile_n, LAS MoeTab* T, LAS unsigned* ridx, int arow_bytes) {
    const unsigned* cnt = (const unsigned*)(A.ws + WS_CTL) + CW_CNT + l * 32 * CNT_STRIDE;
    LAS int* ust = (LAS int*)(T + 1);
    if (C.tid < 64) { int nb; const int ex = expert_block_prefix(cnt, C.tid, nb); if (C.tid <= NE) { T->sb[C.tid] = ex * 256; ust[C.tid] = ex * ntile_n; } }
    __syncthreads();
    if (C.tid < MAXU) { const int nwg = ust[NE]; const long L = (long)C.tid * C.G + C.bid;
        if (L < nwg) { const int w = xcd_remap((int)L, nwg); int e = 0; while (w >= ust[e + 1]) ++e;
            const int lu = w - ust[e]; T->e[C.tid] = e; T->mb[C.tid] = lu / ntile_n; T->nt[C.tid] = lu % ntile_n; } }
    if (C.tid == 0) { const int nwg = ust[NE]; int n = 0; while (n < MAXU && (long)n * C.G + C.bid < nwg) ++n; T->n = n; }
    __syncthreads();
    if constexpr (GATHER) {
        const int* ST = (const int*)(A.ws + WS_SLOTTOK); const int n = T->n;
        for (int i = C.tid; i < n * 256; i += NT) { const int ui = i >> 8, r = i & 255, e = T->e[ui], m0 = T->mb[ui] * 256, ce = (int)cnt[e * CNT_STRIDE];
            const int rr = (m0 + r < ce) ? m0 + r : ce - 1;
            ridx[i] = (unsigned)ST[(size_t)e * CAP + rr] * (unsigned)arow_bytes; }
        __syncthreads();
    }
}

struct EpiStore { bf16* O; int ldc; float scale_lo; int sig_from; bf16* VT; float sall = 1.0f; const float* rs = nullptr;
    __device__ __forceinline__ void operator()(const f32x4 (&acc)[2][2][4][2], const GUnit& u, int wr, int wc, int fr, int fq) const {
        const bool tr = u.aux != 0;
        const float sc = ((!tr && u.ocol < NQ) ? scale_lo : 1.0f) * sall; const bool sg = !tr && u.ocol >= sig_from;
        bf16* Ob = tr ? VT + (size_t)(u.orow * NH + u.ocol) * 65536 : O + (size_t)u.orow * ldc + u.ocol; const int ld = tr ? 256 : ldc;
        f32x4 cs[2][2];
#pragma unroll
        for (int bj = 0; bj < 2; ++bj) { const f32x4 one = (f32x4){1.f, 1.f, 1.f, 1.f};
            cs[bj][0] = (rs && tr) ? *(const f32x4*)(rs + u.orow * BM + bj * HALF + wc * 32 + 8 * fq) : one; cs[bj][1] = (rs && tr) ? *(const f32x4*)(rs + u.orow * BM + bj * HALF + wc * 32 + 8 * fq + 4) : one; }
#pragma unroll
        for (int ai = 0; ai < 2; ++ai)
#pragma unroll
            for (int m = 0; m < 4; ++m) { const int rl = ai * HALF + wr * 64 + m * 16 + fr; bf16* rowp = Ob + (size_t)rl * ld + wc * 32 + 8 * fq;
                const float scr = (rs && !tr) ? sc * rs[u.orow + rl] : sc;
#pragma unroll
                for (int bj = 0; bj < 2; ++bj) { f32x4 v0 = acc[ai][bj][m][0] * scr * cs[bj][0], v1 = acc[ai][bj][m][1] * scr * cs[bj][1];
                    if (sg) {
#pragma unroll
                        for (int q = 0; q < 4; ++q) { v0[q] = __builtin_amdgcn_rcpf(1.0f + __expf(-v0[q])); v1[q] = __builtin_amdgcn_rcpf(1.0f + __expf(-v1[q])); } }
                    u32x4 w; w.x = cvt_pk_bf16(v0[0], v0[1]); w.y = cvt_pk_bf16(v0[2], v0[3]); w.z = cvt_pk_bf16(v1[0], v1[1]); w.w = cvt_pk_bf16(v1[2], v1[3]);
                    *(u32x4*)(rowp + bj * HALF) = w; } }
    }
};
__device__ __forceinline__ u32x2 cvt8_fp8(f32x4 a, f32x4 b) { int lo = 0, hi = 0;
    lo = __builtin_amdgcn_cvt_pk_fp8_f32(a[0], a[1], lo, false); lo = __builtin_amdgcn_cvt_pk_fp8_f32(a[2], a[3], lo, true);
    hi = __builtin_amdgcn_cvt_pk_fp8_f32(b[0], b[1], hi, false); hi = __builtin_amdgcn_cvt_pk_fp8_f32(b[2], b[3], hi, true); return (u32x2){(unsigned)lo, (unsigned)hi}; }
struct EpiSwigluF8 { unsigned char* O; int ldc; float s;
    __device__ __forceinline__ void operator()(const f32x4 (&acc)[2][2][4][2], const GUnit& u, int wr, int wc, int fr, int fq) const {
        const int ocol = u.ocol * HALF;
#pragma unroll
        for (int ai = 0; ai < 2; ++ai)
#pragma unroll
            for (int m = 0; m < 4; ++m) { unsigned char* rowp = O + (size_t)(u.orow + ai * HALF + wr * 64 + m * 16 + fr) * ldc + ocol + wc * 32 + 8 * fq;
                f32x4 v0, v1;
#pragma unroll
                for (int q = 0; q < 4; ++q) { const float x0 = acc[ai][0][m][0][q] * s, x1 = acc[ai][0][m][1][q] * s;
                    v0[q] = x0 * __builtin_amdgcn_rcpf(1.0f + __expf(-x0)) * (acc[ai][1][m][0][q] * s); v1[q] = x1 * __builtin_amdgcn_rcpf(1.0f + __expf(-x1)) * (acc[ai][1][m][1][q] * s); }
                *(u32x2*)rowp = cvt8_fp8(v0, v1); }
    }
};
template <int MODE> struct EpiPair { bf16* O; int ldc; int plain_below; float sall = 1.0f; const float* rs = nullptr;
    __device__ __forceinline__ void operator()(const f32x4 (&acc)[2][2][4][2], const GUnit& u, int wr, int wc, int fr, int fq) const {
        if (MODE == 0 && u.ocol < plain_below) {
#pragma unroll
            for (int ai = 0; ai < 2; ++ai)
#pragma unroll
                for (int m = 0; m < 4; ++m) { const int rg = u.orow + ai * HALF + wr * 64 + m * 16 + fr; bf16* rowp = O + (size_t)rg * ldc + u.ocol + wc * 32 + 8 * fq;
                    const float scr = rs ? sall * rs[rg] : sall;
#pragma unroll
                    for (int bj = 0; bj < 2; ++bj) { const f32x4 v0 = acc[ai][bj][m][0] * scr, v1 = acc[ai][bj][m][1] * scr;
                        u32x4 w; w.x = cvt_pk_bf16(v0[0], v0[1]); w.y = cvt_pk_bf16(v0[2], v0[3]); w.z = cvt_pk_bf16(v1[0], v1[1]); w.w = cvt_pk_bf16(v1[2], v1[3]);
                        *(u32x4*)(rowp + bj * HALF) = w; } }
            return;
        }
        const int ocol = (MODE == 0) ? plain_below + (u.ocol - plain_below) / 2 : u.ocol * HALF;
#pragma unroll
        for (int ai = 0; ai < 2; ++ai)
#pragma unroll
            for (int m = 0; m < 4; ++m) { const int rg = u.orow + ai * HALF + wr * 64 + m * 16 + fr; bf16* rowp = O + (size_t)rg * ldc + ocol + wc * 32 + 8 * fq;
                const float scr = rs ? sall * rs[rg] : sall; const float sc2 = scr * scr;
                f32x4 v0, v1;
#pragma unroll
                for (int q = 0; q < 4; ++q) {
                    const float x0 = acc[ai][0][m][0][q], x1 = acc[ai][0][m][1][q];
                    const float g0 = (MODE == 1) ? x0 * __builtin_amdgcn_rcpf(1.0f + __expf(-x0)) : x0, g1 = (MODE == 1) ? x1 * __builtin_amdgcn_rcpf(1.0f + __expf(-x1)) : x1;
                    v0[q] = g0 * acc[ai][1][m][0][q] * sc2; v1[q] = g1 * acc[ai][1][m][1][q] * sc2; }
                u32x4 w; w.x = cvt_pk_bf16(v0[0], v0[1]); w.y = cvt_pk_bf16(v0[2], v0[3]); w.z = cvt_pk_bf16(v1[0], v1[1]); w.w = cvt_pk_bf16(v1[2], v1[3]);
                *(u32x4*)rowp = w; }
    }
};
struct EpiStoreTile { unsigned char* O; int ldc; float s;
    __device__ __forceinline__ void operator()(const f32x4 (&acc)[2][2][4][2], const GUnit& u, int wr, int wc, int fr, int fq) const {
#pragma unroll
        for (int ai = 0; ai < 2; ++ai)
#pragma unroll
            for (int m = 0; m < 4; ++m) { unsigned char* rowp = O + (size_t)(u.orow + ai * HALF + wr * 64 + m * 16 + fr) * ldc + u.ocol * BM + wc * 32 + 8 * fq;
#pragma unroll
                for (int bj = 0; bj < 2; ++bj) *(u32x2*)(rowp + bj * HALF) = cvt8_fp8(acc[ai][bj][m][0] * s, acc[ai][bj][m][1] * s); }
    }
};

__device__ __forceinline__ void transpose_item(const float* W, int ldw, int K, bf16* WT, int drow0, int k0, int n0, LAS float* scr, int lane) {
#pragma unroll
    for (int i = 0; i < 32; ++i) { const int kk = 2 * i + (lane >> 5); scr[kk * 33 + (lane & 31)] = W[(size_t)(k0 + kk) * ldw + n0 + (lane & 31)]; }
    asm volatile("s_waitcnt lgkmcnt(0)" ::: "memory");
    const int c = lane & 7;
#pragma unroll
    for (int j = 0; j < 4; ++j) { const int n = (lane >> 3) + 8 * j; const LAS float* s = scr + (8 * c) * 33 + n;
        u32x4 o; o.x = pk2(s[0 * 33], s[1 * 33]); o.y = pk2(s[2 * 33], s[3 * 33]); o.z = pk2(s[4 * 33], s[5 * 33]); o.w = pk2(s[6 * 33], s[7 * 33]);
        *(u32x4*)(WT + (size_t)(drow0 + n) * K + k0 + 8 * c) = o; }
    asm volatile("s_waitcnt lgkmcnt(0)" ::: "memory");
}
__device__ __forceinline__ void transpose_item_fp8(const float* W, int ldw, int K, unsigned char* WT8, int drow0, int k0, int n0, LAS float* scr, int lane, float sc) {
#pragma unroll
    for (int i = 0; i < 32; ++i) { const int kk = 2 * i + (lane >> 5); scr[kk * 33 + (lane & 31)] = W[(size_t)(k0 + kk) * ldw + n0 + (lane & 31)]; }
    asm volatile("s_waitcnt lgkmcnt(0)" ::: "memory");
    const int n = lane >> 1, half = lane & 1; const LAS float* sp = scr + (32 * half) * 33 + n;
    unsigned char* dst = WT8 + (size_t)(drow0 + n) * K + k0 + 32 * half;
#pragma unroll
    for (int c = 0; c < 2; ++c) { u32x4 o;
#pragma unroll
        for (int q = 0; q < 4; ++q) { int p = 0; const LAS float* s4 = sp + (16 * c + 4 * q) * 33;
            p = __builtin_amdgcn_cvt_pk_fp8_f32(s4[0] * sc, s4[33] * sc, p, false); p = __builtin_amdgcn_cvt_pk_fp8_f32(s4[66] * sc, s4[99] * sc, p, true); o[q] = (unsigned)p; }
        *(u32x4*)(dst + 16 * c) = o; }
    asm volatile("s_waitcnt lgkmcnt(0)" ::: "memory");
}
__device__ __forceinline__ void transpose_item_i8(const float* W, int ldw, int K, unsigned char* WT8, int drow0, int k0, int n0, LAS float* scr, int lane, float inv) {
#pragma unroll
    for (int i = 0; i < 32; ++i) { const int kk = 2 * i + (lane >> 5); scr[kk * 33 + (lane & 31)] = W[(size_t)(k0 + kk) * ldw + n0 + (lane & 31)]; }
    asm volatile("s_waitcnt lgkmcnt(0)" ::: "memory");
    const int n = lane >> 1, half = lane & 1; const LAS float* sp = scr + (32 * half) * 33 + n;
    unsigned char* dst = WT8 + (size_t)(drow0 + n) * K + k0 + 32 * half;
#pragma unroll
    for (int c = 0; c < 2; ++c) { u32x4 o;
#pragma unroll
        for (int q = 0; q < 4; ++q) { const LAS float* s4 = sp + (16 * c + 4 * q) * 33; o[q] = pack_i8((f32x4){s4[0] * inv, s4[33] * inv, s4[66] * inv, s4[99] * inv}); }
        *(u32x4*)(dst + 16 * c) = o; }
    asm volatile("s_waitcnt lgkmcnt(0)" ::: "memory");
}
__device__ __forceinline__ int pair_row(int n, int which) { return (n >> 7) * 256 + (n & 127) + which * 128; }
constexpr float HMR = 6.0f;
__device__ __forceinline__ void phase_cvt_mixer(const Args& A, const Ctx& C) {
    const int gw = C.bid * NW + C.wave, NGW = C.G * NW;
    unsigned* wmax = (unsigned*)(A.ws + WS_CTL) + CW_WMAX;
    for (int m8 = 0; m8 < 8; ++m8) {
        const float* W = m8 < 2 ? A.in[8] + (size_t)m8 * D * PROJ : m8 < 4 ? A.in[12] + (size_t)(m8 - 2) * D * PW : m8 < 6 ? A.in[11] + (size_t)(m8 - 4) * D * D : A.in[14] + (size_t)(m8 - 6) * D * D;
        const size_t n4 = (size_t)D * (m8 < 2 ? PROJ : m8 < 4 ? PW : D) / 4;
        float mx = 0.f;
        for (size_t i = (size_t)gw * 64 + C.lane; i < n4; i += (size_t)NGW * 64) { const f32x4 v = *(const f32x4*)(W + 4 * i); mx = fmaxf(mx, fmaxf(fmaxf(fabsf(v.x), fabsf(v.y)), fmaxf(fabsf(v.z), fabsf(v.w)))); }
        mx = wave_max_nn(mx);
        if (C.lane == 0 && mx > 0.f) atomicMax(wmax + m8 * CNT_STRIDE, __float_as_uint(mx));
    }
}
__device__ __forceinline__ void cvt_win_i8(const Args& A, const Ctx& C) {
    LAS float* scr = (LAS float*)(C.lds + 16384 + C.wave * 16384);
    const int gw = C.bid * NW + C.wave, NGW = C.G * NW;
    constexpr int I_IN = (D / 64) * (PW / 32);
    const unsigned* wmax = (const unsigned*)(A.ws + WS_CTL) + CW_WMAX;
    constexpr int I_OUT = (D / 64) * (D / 32);
    for (int it = gw; it < 4 * I_OUT; it += NGW) {
        const int m4 = it / I_OUT, kind = m4 >> 1, j = m4 & 1, r = it % I_OUT; const int kb = r / (D / 32), nb = r % (D / 32), n0 = nb * 32;
        const float inv = 127.0f / fmaxf(__uint_as_float(wmax[(4 + m4) * CNT_STRIDE]), 1.0e-30f);
        transpose_item_i8((kind == 0 ? A.in[11] : A.in[14]) + (size_t)j * D * D, D, D, A.ws + (kind == 0 ? WS_WAOUT : WS_WBOUT) + (size_t)j * D * D, n0, kb * 64, n0, scr, C.lane, inv); }
    for (int it = gw; it < 4 * I_IN; it += NGW) {
        const int m4 = it / I_IN, kind = m4 >> 1, j = m4 & 1, r = it % I_IN; const int kb = r / (PW / 32), nb = r % (PW / 32), n0 = nb * 32;
        const float inv = 127.0f / fmaxf(__uint_as_float(wmax[m4 * CNT_STRIDE]), 1.0e-30f);
        unsigned char* WT = A.ws + (kind == 0 ? WS_WAIN : WS_WBIN) + (size_t)j * PW * D;
        if (kind == 0) transpose_item_i8(A.in[8] + (size_t)j * D * PROJ, PROJ, D, WT, n0, kb * 64, n0, scr, C.lane, inv);
        else { const int drow = n0 < D ? n0 : (n0 < 2 * D ? D + pair_row(n0 - D, 0) : D + pair_row(n0 - 2 * D, 1));
            transpose_item_i8(A.in[12] + (size_t)j * D * PW, PW, D, WT, drow, kb * 64, n0, scr, C.lane, inv); }
    }
}
__device__ __forceinline__ void cvt_moe_items(const Args& A, const Ctx& C, int l, int it0, int end, int stride) {
    LAS float* scr = (LAS float*)(C.lds + 16384 + C.wave * 16384);
    unsigned char* WGU = A.ws + WS_WGU; unsigned char* WDN = A.ws + WS_WDN;
    for (int it = it0; it < end; it += stride) {
        const int e = it / CVT_PER; int r = it % CVT_PER;
        if (r < 2 * CVT_IG) { const int which = r / CVT_IG; r %= CVT_IG; const int kb = r / (DE / 32), nb = r % (DE / 32), n0 = nb * 32;
            transpose_item_fp8((which == 0 ? A.in[19] : A.in[20]) + ((size_t)l * NE + e) * D * DE, DE, D, WGU + (size_t)e * 2 * DE * D, pair_row(n0, which), kb * 64, n0, scr, C.lane, WSCALE); }
        else { r -= 2 * CVT_IG; const int kb = r / (D / 32), nb = r % (D / 32), n0 = nb * 32;
            transpose_item_fp8(A.in[21] + ((size_t)l * NE + e) * DE * D, D, DE, WDN + (size_t)e * D * DE, n0, kb * 64, n0, scr, C.lane, WSCALE); }
    }
}
__device__ __forceinline__ int cvt_idle(int nunits, int G) { const int rem = nunits % G; return rem ? G - rem : 0; }
__device__ __forceinline__ int cvt_t1(int l, int G) { const int n = cvt_idle((((l <= 2) ? NR : NL) / BM) * (PW / BM), G) * CVT_Q; return n < CVT_ITEMS ? n : CVT_ITEMS; }
__device__ __forceinline__ int cvt_t2(int l, int G) { const int n = cvt_t1(l, G) + cvt_idle((((l <= 1) ? NR : NL) / BM) * (D / BM), G) * CVT_Q; return n < CVT_ITEMS ? n : CVT_ITEMS; }
__device__ __forceinline__ void cvt_moe_tail(const Args& A, const Ctx& C, int l, int nunits, int base, int end) {
    const int rem = nunits % C.G;
    if (rem == 0 || C.bid < rem) return;
    const int first = base + (C.bid - rem) * CVT_Q; const int last = min(first + CVT_Q, end);
    cvt_moe_items(A, C, l, first + C.wave, last, NW);
}

__device__ __forceinline__ void phase_g1(const Args& A, const Ctx& C, int l) {
    const bool mls = (l & 1) == 0; const int j = l >> 1; const int nrows = (l <= 2) ? NR : NL;
    DenseSched S; S.init(A.ws + WS_H8, A.ws + (mls ? WS_WAIN : WS_WBIN) + (size_t)j * PW * D, nrows, PW, D, C.G, C.bid, 1);
    const float wsc = __uint_as_float(((const unsigned*)(A.ws + WS_CTL))[CW_WMAX + ((mls ? 0 : 2) + j) * CNT_STRIDE]) * (1.0f / 127.0f);
    const float* rs = (const float*)(A.ws + WS_RSC);
    if (mls) { S.sw_lo = 4; S.sw_hi = 8; EpiStore E{(bf16*)(A.ws + WS_PB), PW, 0.08838834764831845f, 2 * NQ + NV, (bf16*)(A.ws + WS_VT), wsc, rs}; gemm_phase<EpiStore, DenseSched, false, 2>(C.lds, D, S, E); }
    else { EpiPair<0> E{(bf16*)(A.ws + WS_PB), PW, D, wsc, rs}; gemm_phase<EpiPair<0>, DenseSched, false, 2>(C.lds, D, S, E); }
    cvt_moe_tail(A, C, l, S.nwg, 0, cvt_t1(l, C.G));
}
__device__ __forceinline__ void phase_g2(const Args& A, const Ctx& C, int l) {
    const bool mls = (l & 1) == 0; const int j = l >> 1; const int nrows = (l <= 1) ? NR : NL;
    DenseSched S; S.init(A.ws + WS_HM, A.ws + (mls ? WS_WAOUT : WS_WBOUT) + (size_t)j * D * D, nrows, D, D, C.G, C.bid, 1);
    const float wsc = __uint_as_float(((const unsigned*)(A.ws + WS_CTL))[CW_WMAX + (4 + (mls ? 0 : 2) + j) * CNT_STRIDE]) * (1.0f / 127.0f);
    EpiStore E{(bf16*)(A.ws + WS_HB), D, 1.0f, 1 << 30, nullptr, mls ? wsc * (HMR / 127.0f) : wsc, mls ? nullptr : (const float*)(A.ws + WS_RSC)}; gemm_phase<EpiStore, DenseSched, false, 2>(C.lds, D, S, E);
    cvt_moe_tail(A, C, l, S.nwg, cvt_t1(l, C.G), cvt_t2(l, C.G));
}
__device__ __forceinline__ void phase_m1(const Args& A, const Ctx& C, int l) {
    LAS MoeTab* T = (LAS MoeTab*)(C.lds + LDS_TAB); LAS unsigned* ridx = (LAS unsigned*)(C.lds + LDS_TAB + 1024);
    moe_tables<true>(A, C, l, 4, T, ridx, D);
    MoeSched S; S.T = T; S.ridx = ridx; S.A = (const char*)(A.ws + WS_H8); S.W = (const char*)(A.ws + WS_WGU); S.wstride_e = (size_t)2 * DE * D; S.tstepB = (size_t)BM * D; S.K = D; S.arow_bytes = 0;
    EpiSwigluF8 E{A.ws + WS_DC, DE, 1.0f / WSCALE}; gemm_phase<EpiSwigluF8, MoeSched, true, 1>(C.lds, D, S, E);
}
__device__ __forceinline__ void phase_m2(const Args& A, const Ctx& C, int l) {
    LAS MoeTab* T = (LAS MoeTab*)(C.lds + LDS_TAB); LAS unsigned* ridx = (LAS unsigned*)(C.lds + LDS_TAB + 1024);
    moe_tables<false>(A, C, l, 4, T, ridx, DE);
    MoeSched S; S.T = T; S.ridx = ridx; S.A = (const char*)(A.ws + WS_DC); S.W = (const char*)(A.ws + WS_WDN); S.wstride_e = (size_t)D * DE; S.tstepB = (size_t)BM * DE; S.K = DE; S.arow_bytes = DE;
    EpiStoreTile E{A.ws + WS_PB, D, YSCALE / WSCALE}; gemm_phase<EpiStoreTile, MoeSched, false, 1>(C.lds, DE, S, E);
}

typedef float f32x16 __attribute__((ext_vector_type(16)));
#define MFMA32(a, b, c) __builtin_amdgcn_mfma_f32_32x32x16_bf16((a), (b), (c), 0, 0, 0)
__device__ __forceinline__ bf16x8 pack8(float a0, float a1, float a2, float a3, float a4, float a5, float a6, float a7) {
    u32x4 p; p.x = cvt2(a0, a1); p.y = cvt2(a2, a3); p.z = cvt2(a4, a5); p.w = cvt2(a6, a7); return __builtin_bit_cast(bf16x8, p); }
__device__ __forceinline__ float bflo(unsigned w) { return __uint_as_float(w << 16); }
__device__ __forceinline__ float bfhi(unsigned w) { return __uint_as_float(w & 0xffff0000u); }
__device__ __forceinline__ int vt_tile(int b, int h, int blk) { return (blk == 0 ? 128 + b : b * 64 + blk - 1) * NH + h; }

__device__ __forceinline__ float wave_incl_scan(float v, int lane) {
#pragma unroll
    for (int o = 1; o < 64; o <<= 1) { const float t = __shfl_up(v, o); v += (lane >= o) ? t : 0.f; }
    return v;
}
__device__ __forceinline__ void block_gates(const Args& A, int row0, int h, LAS float* bf, LAS float* bb, LAS float* lif, LAS float* lib, int tid) {
    const float* GATE = (const float*)(A.ws + WS_GATE);
    if (tid < 256) { const float* g = GATE + (size_t)(row0 + tid) * 16; lif[tid] = g[0 + h]; bf[tid] = g[4 + h]; lib[tid] = g[8 + h]; bb[tid] = g[12 + h]; }
    __syncthreads();
    const int lane = tid & 63, wv = tid >> 6;
    if (wv == 0) { f32x4 x = *(LAS f32x4*)(bf + 4 * lane); x.y += x.x; x.z += x.y; x.w += x.z; const float tot = wave_incl_scan(x.w, lane); const float ex = tot - x.w;
        x.x += ex; x.y += ex; x.z += ex; x.w += ex; *(LAS f32x4*)(bf + 4 * lane) = x; }
    if (wv == 1) { f32x4 y = *(LAS f32x4*)(bb + 4 * (63 - lane)); y.z += y.w; y.y += y.z; y.x += y.y; const float tot = wave_incl_scan(y.x, lane); const float ex = tot - y.x;
        y.x += ex; y.y += ex; y.z += ex; y.w += ex; *(LAS f32x4*)(bb + 4 * (63 - lane)) = y; }
    __syncthreads();
}
__device__ __forceinline__ void phase_s1(const Args& A, const Ctx& C, int l) {
    LAS float* bf = (LAS float*)C.lds; LAS float* bb = bf + 256; LAS float* lif = bb + 256; LAS float* lib = lif + 256; LAS float* af = lib + 256; LAS float* ab = af + 256;
    constexpr int KP = 528;
    LAS unsigned char* KTf = C.lds + 8192; LAS unsigned char* KTb = KTf + 128 * KP;
    const bf16* P = (const bf16*)(A.ws + WS_PB); const bf16* VT = (const bf16*)(A.ws + WS_VT);
    bf16* DC = (bf16*)(A.ws + WS_DC); float* DN = (float*)(A.ws + WS_DN); float* BT = (float*)(A.ws + WS_BTOT);
    const int r = C.lane & 31, hh = C.lane >> 5, w = C.wave;
    for (int it = C.bid; it < BATCH * NH * (NBLK - 1) + 2 * BATCH * NH; it += C.G) {
        const bool isctx = it >= BATCH * NH * (NBLK - 1); const int ci_ = it - BATCH * NH * (NBLK - 1);
        const int bh = isctx ? (ci_ >> 1) : it / (NBLK - 1), blk = isctx ? 0 : 1 + it % (NBLK - 1), h = bh % NH, b = bh / NH; const int u = bh * NBLK + blk; const int row0 = blk_row0(b, blk);
        const int dlo = isctx ? (ci_ & 1) : 0, dhi = isctx ? (ci_ & 1) + 1 : 2;
        block_gates(A, row0, h, bf, bb, lif, lib, C.tid);
        if (C.tid < 256) { af[C.tid] = __expf(bf[255] - bf[C.tid] + lif[C.tid]); ab[C.tid] = __expf(bb[0] - bb[C.tid] + lib[C.tid]); }
        if (C.tid == 0) { BT[u * 2 + 0] = bf[255]; BT[u * 2 + 1] = bb[0]; }
        __syncthreads();
        { const int sp = C.tid >> 2, dq = C.tid & 3, s0 = 2 * sp;
          const bf16* k0 = P + (size_t)(row0 + s0) * PW + NQ + h * DQK + 32 * dq;
          const float f0 = af[s0], f1 = af[s0 + 1], g0 = ab[s0], g1 = ab[s0 + 1];
#pragma unroll
          for (int c = 0; c < 4; ++c) { const u32x4 x0 = *(const u32x4*)(k0 + 8 * c), x1 = *(const u32x4*)(k0 + PW + 8 * c);
#pragma unroll
              for (int q = 0; q < 4; ++q) { const int d = 32 * dq + 8 * c + 2 * q;
                  const float a0 = bflo(x0[q]), a1 = bfhi(x0[q]), c0 = bflo(x1[q]), c1 = bfhi(x1[q]);
                  *(LAS unsigned*)(KTf + d * KP + s0 * 2) = cvt2(a0 * f0, c0 * f1); *(LAS unsigned*)(KTf + (d + 1) * KP + s0 * 2) = cvt2(a1 * f0, c1 * f1);
                  *(LAS unsigned*)(KTb + d * KP + s0 * 2) = cvt2(a0 * g0, c0 * g1); *(LAS unsigned*)(KTb + (d + 1) * KP + s0 * 2) = cvt2(a1 * g0, c1 * g1); } } }
        __syncthreads();
        if (C.tid < 256) { const int dir = C.tid >> 7, d = C.tid & 127; LAS const unsigned* kr = (LAS const unsigned*)((dir ? KTb : KTf) + d * KP); float s = 0.f;
            for (int i = 0; i < 128; ++i) { const unsigned x = kr[i]; s += bflo(x) + bfhi(x); }
            DN[(size_t)(u * 2 + dir) * DQK + d] = s; }
        const bf16* vt = VT + (size_t)vt_tile(b, h, blk) * 65536 + (size_t)(32 * w + r) * 256 + 8 * hh;
        bf16x8 av[16];
#pragma unroll
        for (int ks = 0; ks < 16; ++ks) av[ks] = *(const bf16x8*)(vt + 16 * ks);
#pragma unroll 1
        for (int dir = dlo; dir < dhi; ++dir) {
            LAS const unsigned char* KT = dir ? KTb : KTf;
            f32x16 acc[4];
#pragma unroll
            for (int dt = 0; dt < 4; ++dt)
#pragma unroll
                for (int i = 0; i < 16; ++i) acc[dt][i] = 0.f;
#pragma unroll
            for (int ks = 0; ks < 16; ++ks) {
#pragma unroll
                for (int dt = 0; dt < 4; ++dt) { const bf16x8 b0 = *(const LAS bf16x8*)(KT + (dt * 32 + r) * KP + (16 * ks + 8 * hh) * 2); acc[dt] = MFMA32(av[ks], b0, acc[dt]); }
                if ((ks & 3) == 3) asm volatile("" ::: "memory"); }
            bf16* dc = DC + (size_t)(u * 2 + dir) * DQK * DV + (size_t)(32 * w + 4 * hh) * DQK + r;
#pragma unroll
            for (int g = 0; g < 4; ++g) { bf16* pf = dc + g * 8 * DQK; asm volatile("" : "+v"(pf));
#pragma unroll
                for (int q = 0; q < 4; ++q)
#pragma unroll
                    for (int dt = 0; dt < 4; ++dt) pf[q * DQK + dt * 32] = (bf16)f2bf(acc[dt][4 * g + q]); }
        }
        __syncthreads();
    }
}
__device__ __forceinline__ void phase_s2(const Args& A, const Ctx& C) {
    const bf16* __restrict__ DC = (const bf16*)(A.ws + WS_DC); const float* __restrict__ DN = (const float*)(A.ws + WS_DN); const float* __restrict__ BT = (const float*)(A.ws + WS_BTOT);
    bf16* __restrict__ CST = (bf16*)(A.ws + WS_CST); float* __restrict__ NST = (float*)(A.ws + WS_NST);
    constexpr int EL4 = DQK * DV / 4;
    for (int g = C.bid * NT + C.tid; g < BATCH * NH * 2 * EL4; g += C.G * NT) {
        const int e4 = (g % EL4) * 4, ch = g / EL4, dir = ch & 1, bh = ch >> 1;
        f32x4 st = (f32x4){0.f, 0.f, 0.f, 0.f};
#pragma unroll 13
        for (int idx = 0; idx < NBLK; ++idx) {
            const int blk = dir == 0 ? idx : (idx == 0 ? 0 : NBLK - idx); const int u = bh * NBLK + blk;
            const float dec = __expf(BT[u * 2 + dir]);
            const f32x4 dc = bf4(*(const u32x2*)(DC + (size_t)(u * 2 + dir) * DQK * DV + e4));
            u32x2 o; o.x = cvt2(st.x, st.y); o.y = cvt2(st.z, st.w);
            *(u32x2*)(CST + (size_t)(u * 2 + dir) * DQK * DV + e4) = o;
            st = st * dec + dc;
        }
    }
    for (int g = C.bid * NT + C.tid; g < BATCH * NH * 2 * DQK; g += C.G * NT) {
        const int d = g % DQK, ch = g / DQK, dir = ch & 1, bh = ch >> 1; float st = 0.f;
        for (int idx = 0; idx < NBLK; ++idx) {
            const int blk = dir == 0 ? idx : (idx == 0 ? 0 : NBLK - idx); const int u = bh * NBLK + blk;
            NST[(size_t)(u * 2 + dir) * DQK + d] = st; st = __expf(BT[u * 2 + dir]) * st + DN[(size_t)(u * 2 + dir) * DQK + d];
        }
    }
}
__device__ __forceinline__ void lds_barrier() { asm volatile("s_waitcnt lgkmcnt(0)" ::: "memory"); __builtin_amdgcn_s_barrier(); asm volatile("" ::: "memory"); }
__device__ __forceinline__ void phase_s3(const Args& A, const Ctx& C, int l) {
    const int jl = l >> 1; const bool ctx_out = (l == 0);
    LAS float* bf = (LAS float*)C.lds; LAS float* bb = bf + 256; LAS float* gf = bb + 256; LAS float* gb = gf + 256;
    LAS float* nf = gb + 256; LAS float* nb = nf + 128; LAS float* ssx = nb + 128;
    LAS float* cf = ssx + 256; LAS float* cb = cf + 256;
    constexpr int KP = 272, OP = 528, CHB = 16384, NCHB = 4;
    LAS unsigned char* Kimg = C.lds + 8192;
    LAS unsigned char* CH = Kimg + 256 * KP;
    LAS unsigned char* OUT = Kimg;
    static_assert(8192 + 256 * KP + NCHB * CHB <= LDS_TAB_END && 8192 + 256 * OP <= LDS_TAB_END, "S3 LDS map");
    const bf16* P = (const bf16*)(A.ws + WS_PB); const bf16* VT = (const bf16*)(A.ws + WS_VT); unsigned char* HM = A.ws + WS_HM;
    const bf16* CST = (const bf16*)(A.ws + WS_CST); const float* NST = (const float*)(A.ws + WS_NST);
    const float* hg = A.in[10] + (size_t)jl * NV;
    const int w = C.wave;
    bf16x8 qf[8]; u32x4 kr8[8]; f32x4 gl;
#define S3_SKIP(u_) (((u_) % NBLK) == 0 && !ctx_out)
#define S3_LOAD_IN(u_) do { const int u2_ = (u_); const int blk_ = u2_ % NBLK, bh_ = u2_ / NBLK, h_ = bh_ % NH, b_ = bh_ / NH; const int row0_ = blk_row0(b_, blk_); \
        int tq_ = threadIdx.x; asm volatile("" : "+v"(tq_)); const int lq_ = tq_ & 63; \
        { const bf16* qr_ = P + (size_t)(row0_ + 32 * w + (lq_ & 31)) * PW + h_ * DQK + 8 * (lq_ >> 5); \
          _Pragma("unroll") for (int kk = 0; kk < 8; ++kk) qf[kk] = *(const bf16x8*)(qr_ + 16 * kk); } \
        { const bf16* kr_ = P + (size_t)(row0_ + (tq_ >> 4)) * PW + NQ + h_ * DQK + 8 * (tq_ & 15); \
          _Pragma("unroll") for (int i = 0; i < 8; ++i) kr8[i] = *(const u32x4*)(kr_ + (size_t)(32 * i) * PW); } \
        if (tq_ < 256) { const float* g_ = (const float*)(A.ws + WS_GATE) + (size_t)(row0_ + tq_) * 16 + h_; gl = (f32x4){g_[0], g_[4], g_[8], g_[12]}; } \
        else { const int t2_ = tq_ - 256; gl = (f32x4){NST[(size_t)(u2_ * 2 + (t2_ >> 7)) * DQK + (t2_ & 127)], 0.f, 0.f, 0.f}; } } while (0)
    int u = C.bid;
    while (u < NUNIT && S3_SKIP(u)) u += C.G;
    if (u < NUNIT) S3_LOAD_IN(u);
    while (u < NUNIT) {
        const int blk = u % NBLK, bh = u / NBLK, h = bh % NH, b = bh / NH; const int row0 = blk_row0(b, blk);
        int un = u + C.G;
        while (un < NUNIT && S3_SKIP(un)) un += C.G;
        const bf16* vtile = VT + (size_t)vt_tile(b, h, blk) * 65536;
        const bf16* ctile = CST + (size_t)(u * 2) * DQK * DV;
#define S3_DMA(c_) do { const int cc_ = (c_); const bool isv_ = cc_ < 8; int ld_ = threadIdx.x & 63; asm volatile("" : "+v"(ld_)); \
                const unsigned dlp_ = (unsigned)(((ld_ & 3) ^ ((ld_ >> 4) & 3)) * 16), drow_ = (unsigned)(32 * w + (ld_ >> 2)); \
                const unsigned long long gp_ = (unsigned long long)(isv_ ? (const char*)vtile + 64 * cc_ : (const char*)ctile + (cc_ >= 12 ? 2 * DQK * DV : 0) + 64 * ((cc_ - 8) & 3)); \
                const char* gb_ = (const char*)(((unsigned long long)(unsigned)__builtin_amdgcn_readfirstlane((int)(unsigned)(gp_ >> 32)) << 32) | (unsigned)__builtin_amdgcn_readfirstlane((int)(unsigned)gp_)); \
                _Pragma("unroll") for (int jj = 0; jj < 2; ++jj) \
                    asm volatile("s_mov_b32 m0, %2\n\ts_nop 0\n\tglobal_load_lds_dwordx4 %0, %1" :: "v"(((drow_ + 16u * jj) << (isv_ ? 9 : 8)) + dlp_), "s"(gb_), "s"((unsigned)(size_t)CH + (unsigned)w * 2048u + (unsigned)((cc_ & 3) * CHB + jj * 1024)) : "memory"); } while (0)
        S3_DMA(0); S3_DMA(1); S3_DMA(2);
        { int tu = threadIdx.x; asm volatile("" : "+v"(tu));
          if (tu < 256) { gf[tu] = gl.x; bf[tu] = gl.y; gb[tu] = gl.z; bb[tu] = gl.w; } else nf[tu - 256] = gl.x;
          { const int pc = tu & 15, s0 = tu >> 4, ps0 = (s0 & ~12) | ((s0 & 4) << 1) | ((s0 & 8) >> 1);
#pragma unroll
            for (int i = 0; i < 8; ++i) *(LAS u32x4*)(Kimg + (ps0 + 32 * i) * KP + pc * 16) = kr8[i]; }
          lds_barrier();
          const int lane = tu & 63, wv = tu >> 6;
          if (wv == 0) { f32x4 x = *(LAS f32x4*)(bf + 4 * lane); x.y += x.x; x.z += x.y; x.w += x.z; const float tot = wave_incl_scan(x.w, lane); const float ex = tot - x.w;
              x.x += ex; x.y += ex; x.z += ex; x.w += ex; *(LAS f32x4*)(bf + 4 * lane) = x; }
          if (wv == 1) { f32x4 y = *(LAS f32x4*)(bb + 4 * (63 - lane)); y.z += y.w; y.y += y.z; y.x += y.y; const float tot = wave_incl_scan(y.x, lane); const float ex = tot - y.x;
              y.x += ex; y.y += ex; y.z += ex; y.w += ex; *(LAS f32x4*)(bb + 4 * (63 - lane)) = y; }
          lds_barrier();
          if (tu < 256) { const float a0 = gf[tu] - bf[tu], a1 = gb[tu] - bb[tu]; gf[tu] = a0; gb[tu] = a1; cf[tu] = __expf(bf[tu | 31] + a0); cb[tu] = __expf(bb[tu & ~31] + a1); }
          lds_barrier(); }
        {
            int lz = threadIdx.x & 63; asm volatile("" : "+v"(lz));
            const int r = lz & 31, hh = lz >> 5;
            const int jt = w;
            const float bfj = bf[32 * jt + r], bbj = bb[32 * jt + r];
            float qnf = 0.f, qnb = 0.f;
#pragma unroll
            for (int kk = 0; kk < 8; ++kk) { u32x4 qq = __builtin_bit_cast(u32x4, qf[kk]); asm volatile("" : "+v"(qq));
                const int d = 16 * kk + 8 * hh;
                const f32x4 n0 = *(const LAS f32x4*)(nf + d), n1 = *(const LAS f32x4*)(nf + d + 4), m0 = *(const LAS f32x4*)(nb + d), m1 = *(const LAS f32x4*)(nb + d + 4);
                qnf += (bflo(qq.x) * n0.x + bfhi(qq.x) * n0.y) + (bflo(qq.y) * n0.z + bfhi(qq.y) * n0.w) + (bflo(qq.z) * n1.x + bfhi(qq.z) * n1.y) + (bflo(qq.w) * n1.z + bfhi(qq.w) * n1.w);
                qnb += (bflo(qq.x) * m0.x + bfhi(qq.x) * m0.y) + (bflo(qq.y) * m0.z + bfhi(qq.y) * m0.w) + (bflo(qq.z) * m1.x + bfhi(qq.z) * m1.y) + (bflo(qq.w) * m1.z + bfhi(qq.w) * m1.w);
                if (kk & 1) asm volatile("" ::: "memory"); }
            qnf += __shfl_xor(qnf, 32); qnb += __shfl_xor(qnb, 32);
            float denf = 0.f, denb = 0.f;
#pragma unroll 1
            for (int kt = 0; kt < 8; ++kt) {
                f32x16 c;
#pragma unroll
                for (int i = 0; i < 16; ++i) c[i] = 0.f;
#pragma unroll
                for (int kk = 0; kk < 8; ++kk) { const bf16x8 a = *(const LAS bf16x8*)(Kimg + (kt * 32 + r) * KP + (16 * kk + 8 * hh) * 2); c = MFMA32(a, qf[kk], c); }
                if (kt == jt) {
#pragma unroll
                    for (int g = 0; g < 4; ++g) { const int sl0 = 16 * (g >> 1) + 8 * hh + 4 * (g & 1);
                        const f32x4 g4f = *(const LAS f32x4*)(gf + kt * 32 + sl0), g4b = *(const LAS f32x4*)(gb + kt * 32 + sl0);
#pragma unroll
                        for (int q = 0; q < 4; ++q) { const int sl = sl0 + q; const float cv = c[4 * g + q];
                            denf += cv * __expf((sl <= r) ? bfj + g4f[q] : -1.0e30f); denb += cv * __expf((sl >= r) ? bbj + g4b[q] : -1.0e30f); } }
                } else {
                    LAS const float* cx = (kt < jt ? cf : cb) + kt * 32 + 8 * hh; float sm = 0.f;
#pragma unroll
                    for (int g = 0; g < 4; ++g) { const f32x4 c4 = *(const LAS f32x4*)(cx + 16 * (g >> 1) + 4 * (g & 1)); sm += (c[4 * g] * c4.x + c[4 * g + 1] * c4.y) + (c[4 * g + 2] * c4.z + c[4 * g + 3] * c4.w); }
                    if (kt < jt) denf += sm * __expf(bfj - bf[kt * 32 + 31]); else denb += sm * __expf(bbj - bb[kt * 32]);
                }
            }
            denf += __shfl_xor(denf, 32); denb += __shfl_xor(denb, 32);
            const float ebf = __expf(bfj), ebb = __expf(bbj);
            denf += ebf * qnf; denb += ebb * qnb;
            const float rf = 1.0f / fmaxf(fabsf(denf), 1.0f), rb = 1.0f / fmaxf(fabsf(denb), 1.0f);
            const float scf = ebf * rf, scb = ebb * rb;
            unsigned wdg[8];
#pragma unroll
            for (int g = 0; g < 4; ++g) { const int sl0 = 16 * (g >> 1) + 8 * hh + 4 * (g & 1);
                const f32x4 g4f = *(const LAS f32x4*)(gf + jt * 32 + sl0), g4b = *(const LAS f32x4*)(gb + jt * 32 + sl0);
                float wv[4];
#pragma unroll
                for (int q = 0; q < 4; ++q) { const int sl = sl0 + q; wv[q] = rf * __expf((sl <= r) ? bfj + g4f[q] : -1.0e30f) + rb * __expf((sl >= r) ? bbj + g4b[q] : -1.0e30f); }
                wdg[2 * g] = cvt2(wv[0], wv[1]); wdg[2 * g + 1] = cvt2(wv[2], wv[3]); }
            f32x16 acc[8];
#pragma unroll
            for (int et = 0; et < 8; ++et)
#pragma unroll
                for (int i = 0; i < 16; ++i) acc[et][i] = 0.f;
            asm volatile("s_waitcnt vmcnt(0)" ::: "memory");
            const int swz = (r >> 2) & 3;
#pragma unroll 1
            for (int ci = 0; ci < 8; ++ci) {
                if (ci) asm volatile("s_waitcnt vmcnt(4)" ::: "memory");
                lds_barrier();
                S3_DMA(ci + 3);
                LAS const unsigned char* CHc = CH + (ci & 3) * CHB;
                { const int kt = ci;
                        f32x16 c;
#pragma unroll
                        for (int i = 0; i < 16; ++i) c[i] = 0.f;
#pragma unroll
                        for (int kk = 0; kk < 8; ++kk) { const bf16x8 a = *(const LAS bf16x8*)(Kimg + (kt * 32 + r) * KP + (16 * kk + 8 * hh) * 2); c = MFMA32(a, qf[kk], c); }
                        float p[16];
                        if (kt == jt) {
#pragma unroll
                            for (int i = 0; i < 8; ++i) { p[2 * i] = c[2 * i] * bflo(wdg[i]); p[2 * i + 1] = c[2 * i + 1] * bfhi(wdg[i]); }
                        } else {
                            LAS const float* cx = (kt < jt ? cf : cb) + kt * 32 + 8 * hh;
                            const float rw = (kt < jt) ? rf * __expf(bfj - bf[kt * 32 + 31]) : rb * __expf(bbj - bb[kt * 32]);
#pragma unroll
                            for (int g = 0; g < 4; ++g) { const f32x4 c4 = *(const LAS f32x4*)(cx + 16 * (g >> 1) + 4 * (g & 1));
                                p[4 * g] = c[4 * g] * (c4.x * rw); p[4 * g + 1] = c[4 * g + 1] * (c4.y * rw); p[4 * g + 2] = c[4 * g + 2] * (c4.z * rw); p[4 * g + 3] = c[4 * g + 3] * (c4.w * rw); }
                        }
                        const bf16x8 pa0 = pack8(p[0], p[1], p[2], p[3], p[4], p[5], p[6], p[7]), pa1 = pack8(p[8], p[9], p[10], p[11], p[12], p[13], p[14], p[15]);
#pragma unroll
                        for (int et = 0; et < 8; ++et) { LAS const unsigned char* vb = CHc + (et * 32 + r) * 64;
                            const bf16x8 a0 = *(const LAS bf16x8*)(vb + ((hh ^ swz) << 4)), a1 = *(const LAS bf16x8*)(vb + (((2 + hh) ^ swz) << 4));
                            acc[et] = MFMA32(a0, pa0, acc[et]); acc[et] = MFMA32(a1, pa1, acc[et]);
                            if (et & 1) asm volatile("" ::: "memory"); }
                }
            }
#pragma unroll
            for (int ci = 8; ci < 16; ++ci) {
                if (ci <= 13) asm volatile("s_waitcnt vmcnt(4)" ::: "memory"); else if (ci == 14) asm volatile("s_waitcnt vmcnt(2)" ::: "memory"); else asm volatile("s_waitcnt vmcnt(0)" ::: "memory");
                lds_barrier();
                if (ci + 3 < 16) S3_DMA(ci + 3);
                LAS const unsigned char* CHc = CH + (ci & 3) * CHB;
                {
                    const int dir = (ci - 8) >> 2, dq = (ci - 8) & 3;
                    const float sc = dir ? scb : scf;
#pragma unroll
                    for (int k2 = 0; k2 < 2; ++k2) { const u32x4 qq = __builtin_bit_cast(u32x4, qf[2 * dq + k2]);
                        const bf16x8 qs = pack8(bflo(qq.x) * sc, bfhi(qq.x) * sc, bflo(qq.y) * sc, bfhi(qq.y) * sc, bflo(qq.z) * sc, bfhi(qq.z) * sc, bflo(qq.w) * sc, bfhi(qq.w) * sc);
#pragma unroll
                        for (int et = 0; et < 8; ++et) { const bf16x8 a = *(const LAS bf16x8*)(CHc + (et * 32 + r) * 64 + (((2 * k2 + hh) ^ swz) << 4)); acc[et] = MFMA32(a, qs, acc[et]);
                            if ((et & 3) == 3) asm volatile("" ::: "memory"); } }
                }
            }
            u32x4 ov[16]; f32x4 g0, g1;
            { int tz = threadIdx.x & 63; asm volatile("" : "+v"(tz)); const int pc = tz & 31, lr0 = tz >> 5;
              g0 = *(const f32x4*)(hg + h * DV + 8 * pc); g1 = *(const f32x4*)(hg + h * DV + 8 * pc + 4);
#pragma unroll
              for (int i = 0; i < 16; ++i) ov[i] = *(const u32x4*)(P + (size_t)(row0 + 32 * w + lr0 + 2 * i) * PW + 2 * NQ + NV + h * DV + 8 * pc); }
            float ss = 0.f;
#pragma unroll
            for (int et = 0; et < 8; ++et)
#pragma unroll
                for (int i = 0; i < 16; ++i) ss += acc[et][i] * acc[et][i];
            ss += __shfl_xor(ss, 32);
            const float rs = 1.0f / sqrtf(ss * (1.0f / DV) + EPS);
            lds_barrier();
            { LAS unsigned char* ob = OUT + (w * 32 + r) * OP + (4 * hh) * 2;
#pragma unroll
              for (int et = 0; et < 8; ++et)
#pragma unroll
                  for (int g = 0; g < 4; ++g) { u32x2 o; o.x = cvt2(acc[et][4 * g + 0] * rs, acc[et][4 * g + 1] * rs); o.y = cvt2(acc[et][4 * g + 2] * rs, acc[et][4 * g + 3] * rs);
                      *(LAS u32x2*)(ob + (et * 32 + 8 * g) * 2) = o; } }
            asm volatile("s_waitcnt lgkmcnt(0)" ::: "memory");
            S3_LOAD_IN(un < NUNIT ? un : u);
            { int tz = threadIdx.x & 63; asm volatile("" : "+v"(tz)); const int pc = tz & 31, lr0 = tz >> 5;
#pragma unroll
              for (int i = 0; i < 16; ++i) { const int lr = 32 * w + lr0 + 2 * i; const int grow = row0 + lr;
                  const u32x4 hv = *(const LAS u32x4*)(OUT + lr * OP + pc * 16);
                  const f32x4 o0 = (f32x4){bflo(hv.x) * g0.x * bflo(ov[i].x), bfhi(hv.x) * g0.y * bfhi(ov[i].x), bflo(hv.y) * g0.z * bflo(ov[i].y), bfhi(hv.y) * g0.w * bfhi(ov[i].y)};
                  const f32x4 o1 = (f32x4){bflo(hv.z) * g1.x * bflo(ov[i].z), bfhi(hv.z) * g1.y * bfhi(ov[i].z), bflo(hv.w) * g1.z * bflo(ov[i].w), bfhi(hv.w) * g1.w * bfhi(ov[i].w)};
                  *(u32x2*)(HM + (size_t)grow * D + h * DV + 8 * pc) = (u32x2){pack_i8(o0 * (127.0f / HMR)), pack_i8(o1 * (127.0f / HMR))};
                  if ((i & 3) == 3) asm volatile("" ::: "memory"); } }
        }
#undef S3_DMA
        lds_barrier();
        u = un;
    }
#undef S3_LOAD_IN
#undef S3_SKIP
}

#define XB_TMO      128
#define XB_XCNT(j)  (256  + 64 * (j))
#define XB_XSUB(j)  (1280 + 64 * (j))
#define XB_XGEN(j)  (2304 + 64 * (j))
#define XB_TOP      3328
#define XB_TOPGEN   3392
#define XCD_BAR_WORDS 3456
#define XB_SPIN_CAP (1u << 18)

__device__ __forceinline__ unsigned xb_ld(unsigned* p)              { return __hip_atomic_load(p, __ATOMIC_RELAXED, __HIP_MEMORY_SCOPE_AGENT); }
__device__ __forceinline__ unsigned xb_add(unsigned* p, unsigned v) { return __hip_atomic_fetch_add(p, v, __ATOMIC_RELAXED, __HIP_MEMORY_SCOPE_AGENT); }
__device__ __forceinline__ unsigned xb_xcc_id() { return (unsigned)__builtin_amdgcn_s_getreg((3 << 11) | 20) & 0xFu; }
#define XB_SPIN(cond, bar) do { unsigned _sp = 0; while (cond) { __builtin_amdgcn_s_sleep(1); \
    if ((++_sp & 255u) == 0u) { if (xb_ld(&(bar)[XB_TMO])) break; if (_sp > XB_SPIN_CAP) { atomicAdd(&(bar)[XB_TMO], 1u); break; } } } } while (0)

struct XcdBarrier {
    unsigned* bar; unsigned x;
    volatile LAS unsigned* st;
};

__device__ __forceinline__ XcdBarrier xcd_barrier_post(unsigned* bar, volatile LAS unsigned* st) {
    XcdBarrier b; b.bar = bar; b.x = xb_xcc_id(); b.st = st;
    if (threadIdx.x == 0) (void)xb_add(&bar[XB_XCNT(b.x)], 1u);
    return b;
}
__device__ __forceinline__ void xcd_barrier_complete(unsigned* bar, unsigned x, unsigned& nloc, unsigned& nx) {
    const unsigned G = gridDim.x * gridDim.y * gridDim.z;
    unsigned sum, cnt, mine, sp = 0u;
    for (;;) {
        sum = 0u; cnt = 0u; mine = 0u;
#pragma unroll
        for (unsigned j = 0; j < 16; ++j) { const unsigned c = xb_ld(&bar[XB_XCNT(j)]); sum += c; cnt += (c > 0u) ? 1u : 0u; mine = (j == x) ? c : mine; }
        if (sum == G) break;
        __builtin_amdgcn_s_sleep(1);
        if ((++sp & 255u) == 0u) { if (xb_ld(&bar[XB_TMO])) break; if (sp > XB_SPIN_CAP) { atomicAdd(&bar[XB_TMO], 1u); break; } }
    }
    nloc = mine > 0u ? mine : 1u; nx = cnt > 0u ? cnt : 1u;
}

__device__ __forceinline__ void xcd_barrier(const XcdBarrier& b) {
    asm volatile("s_waitcnt vmcnt(0)" ::: "memory");
    __syncthreads();
    if (threadIdx.x == 0) {
        unsigned* bar = b.bar;
        __builtin_amdgcn_s_waitcnt(0);
        unsigned nloc = b.st[0], nx = b.st[1];
        if (nloc == 0u) { xcd_barrier_complete(bar, b.x, nloc, nx); b.st[0] = nloc; b.st[1] = nx; }
        const unsigned old = xb_add(&bar[XB_XSUB(b.x)], 1u);
        const unsigned gen = old / nloc;
        if (old + 1u == (gen + 1u) * nloc) {
            __builtin_amdgcn_fence(__ATOMIC_RELEASE, "agent");
            asm volatile("s_waitcnt vmcnt(0)" ::: "memory");
            const unsigned og = xb_add(&bar[XB_TOP], 1u);
            const unsigned tg = og / nx;
            if (og + 1u == (tg + 1u) * nx) xb_add(&bar[XB_TOPGEN], 1u);
            else XB_SPIN(xb_ld(&bar[XB_TOPGEN]) == tg, bar);
            __builtin_amdgcn_fence(__ATOMIC_ACQUIRE, "agent");
            xb_add(&bar[XB_XGEN(b.x)], 1u);
            asm volatile("s_waitcnt vmcnt(0)" ::: "memory");
        } else {
            XB_SPIN(xb_ld(&bar[XB_XGEN(b.x)]) == gen, bar);
            __builtin_amdgcn_fence(__ATOMIC_ACQUIRE, "agent");
            asm volatile("s_waitcnt vmcnt(0)" ::: "memory");
        }
    }
    __syncthreads();
}


constexpr int LDS_BYTES = 152 * 1024;
constexpr int CW_BAR = 16384;
static_assert((CW_BAR + XCD_BAR_WORDS) * 4 <= (int)CTL_BYTES, "ctl");
#ifndef MK_MULTI
#define MK_MULTI 0
#endif
#define IN(p) (lo <= (p) && (p) < hi)
#define SEAM(p) do { if ((p) + 1 < hi) { XcdBarrier b_; b_.bar = (unsigned*)(load_args().ws + WS_CTL) + CW_BAR; b_.x = xb_xcc_id(); b_.st = (volatile LAS unsigned*)(C.lds + LDS_BYTES - 16); xcd_barrier(b_); } } while (0)
#define CAS __attribute__((address_space(4)))
__device__ __forceinline__ Args load_args() {
#if defined(__HIP_DEVICE_COMPILE__)
    const CAS Args* p = (const CAS Args*)__builtin_amdgcn_kernarg_segment_ptr(); asm volatile("" : "+s"(p));
    Args a; for (int i = 0; i < 22; ++i) a.in[i] = p->in[i]; a.out = p->out; a.ws = p->ws; a.lo = p->lo; a.hi = p->hi; return a;
#else
    return Args{};
#endif
}
__device__ __forceinline__ Ctx fresh(const Ctx& C) { Ctx R = C; int tz = threadIdx.x; asm volatile("" : "+v"(tz)); R.tid = tz; R.lane = tz & 63; return R; }
template <int L> __device__ __forceinline__ void layer_phases(const Args& args, const Ctx& C, int bar, int lo, int hi) {
    constexpr int pb = 16 * L;
    if (IN(pb + 1)) { phase_r1(load_args(), fresh(C), L); SEAM(pb + 1); }
    if (IN(pb + 2)) { phase_g1(load_args(), fresh(C), L); SEAM(pb + 2); }
    if constexpr ((L & 1) == 0) {
        if (IN(pb + 3)) { phase_s1(load_args(), fresh(C), L); SEAM(pb + 3); }
        if (IN(pb + 4)) { phase_s2(load_args(), fresh(C)); SEAM(pb + 4); }
        if (IN(pb + 5)) { phase_s3(load_args(), fresh(C), L); SEAM(pb + 5); }
    } else {
        if (IN(pb + 3)) { phase_conv(load_args(), fresh(C), L); SEAM(pb + 3); }
    }
    if (IN(pb + 6)) { phase_g2(load_args(), fresh(C), L); SEAM(pb + 6); }
    if (IN(pb + 7)) { phase_r2(load_args(), fresh(C), L); SEAM(pb + 7); }
    if (IN(pb + 8)) { phase_m1(load_args(), fresh(C), L); SEAM(pb + 8); }
    if (IN(pb + 9)) { phase_m2(load_args(), fresh(C), L); SEAM(pb + 9); }
}
__global__ void __launch_bounds__(NT, 2) fwd_kernel(Args args) {
    extern __shared__ __attribute__((aligned(16))) unsigned char lds_raw[];
    Ctx C; C.lds = (LAS unsigned char*)lds_raw; C.tid = threadIdx.x; C.lane = C.tid & 63; C.wave = __builtin_amdgcn_readfirstlane(C.tid >> 6); C.G = gridDim.x; C.bid = blockIdx.x; C.a = &args;
    const int lo = args.lo, hi = args.hi;
    volatile LAS unsigned* xbw = (volatile LAS unsigned*)(C.lds + LDS_BYTES - 16);
    if (C.tid < 4) xbw[C.tid] = 0u;
    __syncthreads();
    if (hi - lo > 1) (void)xcd_barrier_post((unsigned*)(args.ws + WS_CTL) + CW_BAR, xbw);
    const int bar = 0; (void)bar;
    if (IN(0)) { phase_mod(load_args(), fresh(C)); __syncthreads(); phase_cvt_mixer(load_args(), fresh(C)); SEAM(0); }
    layer_phases<0>(args, C, bar, lo, hi);
    layer_phases<1>(args, C, bar, lo, hi);
    layer_phases<2>(args, C, bar, lo, hi);
    layer_phases<3>(args, C, bar, lo, hi);
    if (IN(64)) phase_final(load_args(), fresh(C));
}
#undef IN
#undef SEAM

extern "C" void kernel_launch(void* const* d_in, const int* in_sizes, int n_in, void* d_out, int out_size, void* d_ws, size_t ws_size, hipStream_t stream) {
    static int grid = 0;
    if (grid == 0) {
        if (n_in != 22 || out_size != NL * D || ws_size < WS_END) { fprintf(stderr, "kernel_launch: unexpected shapes (n_in %d out %d ws %zu)\n", n_in, out_size, ws_size); grid = -1; return; }
        int dev = 0, cus = 0, per_cu = 0;
        if (hipGetDevice(&dev) != hipSuccess || hipDeviceGetAttribute(&cus, hipDeviceAttributeMultiprocessorCount, dev) != hipSuccess) { grid = -1; return; }
        if (hipFuncSetAttribute((const void*)fwd_kernel, hipFuncAttributeMaxDynamicSharedMemorySize, LDS_BYTES) != hipSuccess) { grid = -1; return; }
        if (hipOccupancyMaxActiveBlocksPerMultiprocessor(&per_cu, (const void*)fwd_kernel, NT, LDS_BYTES) != hipSuccess || per_cu < 1) { fprintf(stderr, "kernel_launch: occupancy query says %d\n", per_cu); }
        (void)hipGetLastError();
        grid = cus;
    }
    if (grid < 0) return;
    (void)hipMemsetAsync((char*)d_ws + WS_CTL, 0, CTL_BYTES, stream);
    Args a{};
    for (int i = 0; i < 22; ++i) a.in[i] = (const float*)d_in[i];
    a.out = (float*)d_out; a.ws = (unsigned char*)d_ws;
#if MK_MULTI
    int phases[64]; int np = 0;
    phases[np++] = 0;
    for (int l = 0; l < DEPTH; ++l) { const int pb = 16 * l; phases[np++] = pb + 1; phases[np++] = pb + 2; phases[np++] = pb + 3;
        if ((l & 1) == 0) { phases[np++] = pb + 4; phases[np++] = pb + 5; }
        phases[np++] = pb + 6; phases[np++] = pb + 7; phases[np++] = pb + 8; phases[np++] = pb + 9; }
    phases[np++] = 64;
    for (int i = 0; i < np; ++i) { a.lo = phases[i]; a.hi = phases[i] + 1; hipLaunchKernelGGL(fwd_kernel, dim3(grid), dim3(NT), LDS_BYTES, stream, a); }
#else
    a.lo = 0; a.hi = 65;
    hipLaunchKernelGGL(fwd_kernel, dim3(grid), dim3(NT), LDS_BYTES, stream, a);
#ifdef PROBE_PHASES
    { const int pp[] = {PROBE_PHASES};
      for (int rep = 0; rep < PROBE_REPS; ++rep) for (unsigned i = 0; i < sizeof(pp) / sizeof(pp[0]); ++i) { a.lo = pp[i]; a.hi = pp[i] + 1; hipLaunchKernelGGL(fwd_kernel, dim3(grid), dim3(NT), LDS_BYTES, stream, a); } }
#endif
#endif
}
```

```cpp
#include <hip/hip_runtime.h>
#include <cstdio>
#include <cstdint>

#define LAS __attribute__((address_space(3)))
typedef unsigned short bf16;
typedef float f32x4 __attribute__((ext_vector_type(4)));
typedef unsigned u32x4 __attribute__((ext_vector_type(4)));
typedef unsigned u32x2 __attribute__((ext_vector_type(2)));
typedef int i32x4r __attribute__((ext_vector_type(4)));

constexpr int D = 1024, BATCH = 2, SEQ = 16384, DEPTH = 4, CTXL = 256;
constexpr int NL = BATCH * SEQ, NCX = BATCH * CTXL, NR = NL + NCX;
constexpr int NH = 4, DQK = 128, DV = 256, NQ = 512, NV = 1024, PROJ = 3088, PW = 3072;
constexpr int NGRP = 4, EPG = 8, NE = 32, DE = 512;
constexpr int NBLK = 65;
constexpr int NUNIT = BATCH * NH * NBLK;
constexpr int CAP = NR;
constexpr int YROWS = 74752;
constexpr float EPS = 1e-6f;
constexpr float WSCALE = 32.0f;
constexpr float YSCALE = 4.0f;
constexpr int NT = 512, NW = 8;
constexpr int LDS_TAB_END = 152 * 1024 - 16;

constexpr size_t MiB = 1u << 20;
constexpr size_t WS_CTL = 0, CTL_BYTES = 1 * MiB;
constexpr size_t WS_MOD = 1 * MiB;
constexpr size_t WS_GATE = 2 * MiB;
constexpr size_t WS_TOKSLOT = 5 * MiB;
constexpr size_t WS_TOKW = 6 * MiB;
constexpr size_t WS_SLOTTOK = 7 * MiB;
constexpr size_t WS_DN = 12 * MiB;
constexpr size_t WS_NST = 13 * MiB;
constexpr size_t WS_BTOT = 14 * MiB;
constexpr size_t WS_RSC = 15 * MiB;
constexpr size_t WS_LAT = 16 * MiB;
constexpr size_t WS_HB = 146 * MiB;
constexpr size_t WS_PB = 211 * MiB;
constexpr size_t WS_HM = 406 * MiB;
constexpr size_t WS_DC = 471 * MiB;
constexpr size_t WS_CST = 601 * MiB;
constexpr size_t WS_VT = 666 * MiB;
constexpr size_t WS_WAIN = 731 * MiB;
constexpr size_t WS_WBIN = 743 * MiB;
constexpr size_t WS_WAOUT = 755 * MiB;
constexpr size_t WS_WBOUT = 759 * MiB;
constexpr size_t WS_WGU = 763 * MiB;
constexpr size_t WS_WDN = 827 * MiB;
constexpr size_t WS_H8 = 843 * MiB;
constexpr size_t WS_END = 880 * MiB;
constexpr int CW_WMAX = 256;
constexpr int CW_CNT = 1024, CNT_STRIDE = 64;

struct Args { const float* in[22]; float* out; unsigned char* ws; int lo, hi; };

typedef short bf16x8 __attribute__((ext_vector_type(8)));
typedef float f32x2 __attribute__((ext_vector_type(2)));
typedef __bf16 bf16x2_t __attribute__((ext_vector_type(2)));
__device__ __forceinline__ unsigned cvt2(float lo, float hi) { const f32x2 v = {lo, hi}; return __builtin_bit_cast(unsigned, __builtin_convertvector(v, bf16x2_t)); }
__device__ __forceinline__ float bf2f(bf16 v) { return __uint_as_float(((unsigned)v) << 16); }
__device__ __forceinline__ unsigned f2bf(float f) { unsigned u = __float_as_uint(f); return (u + 0x7fffu + ((u >> 16) & 1u)) >> 16; }
__device__ __forceinline__ unsigned pk2(float lo, float hi) { return f2bf(lo) | (f2bf(hi) << 16); }
template <int CTRL, int ROWMASK> __device__ __forceinline__ float dpp_mov(float x) { return __int_as_float(__builtin_amdgcn_update_dpp(0, __float_as_int(x), CTRL, ROWMASK, 0xf, false)); }
__device__ __forceinline__ float wave_sum(float v) {
    v += dpp_mov<0xB1, 0xf>(v); v += dpp_mov<0x4E, 0xf>(v); v += dpp_mov<0x141, 0xf>(v); v += dpp_mov<0x140, 0xf>(v);
    v += dpp_mov<0x142, 0xA>(v); v += dpp_mov<0x143, 0xC>(v);
    return __int_as_float(__builtin_amdgcn_readlane(__float_as_int(v), 63));
}
__device__ __forceinline__ float wave_max_nn(float v) {
    v = fmaxf(v, dpp_mov<0xB1, 0xf>(v)); v = fmaxf(v, dpp_mov<0x4E, 0xf>(v)); v = fmaxf(v, dpp_mov<0x141, 0xf>(v)); v = fmaxf(v, dpp_mov<0x140, 0xf>(v));
    v = fmaxf(v, dpp_mov<0x142, 0xA>(v)); v = fmaxf(v, dpp_mov<0x143, 0xC>(v));
    return __int_as_float(__builtin_amdgcn_readlane(__float_as_int(v), 63));
}
__device__ __forceinline__ unsigned pack_i8(f32x4 v) {
    const int a = (int)__builtin_rintf(fminf(fmaxf(v.x, -127.f), 127.f)), b = (int)__builtin_rintf(fminf(fmaxf(v.y, -127.f), 127.f)), c = (int)__builtin_rintf(fminf(fmaxf(v.z, -127.f), 127.f)), d = (int)__builtin_rintf(fminf(fmaxf(v.w, -127.f), 127.f));
    return (unsigned)(a & 255) | ((unsigned)(b & 255) << 8) | ((unsigned)(c & 255) << 16) | ((unsigned)d << 24);
}
__device__ __forceinline__ float sigmoidf_(float x) { return 1.f / (1.f + __expf(-x)); }
__device__ __forceinline__ float siluf_(float x) { return x / (1.f + __expf(-x)); }
__device__ __forceinline__ float logsigmoidf_(float x) { return fminf(x, 0.f) - log1pf(__expf(-fabsf(x))); }
__device__ __forceinline__ int blk_row0(int b, int blk) { return blk == 0 ? NL + b * CTXL : b * SEQ + (blk - 1) * 256; }
__device__ __forceinline__ int mod_vec_of_row(int row) { return row < NL ? row / SEQ : 2; }

struct Ctx {
    LAS unsigned char* lds; int tid, lane, wave, G, bid;
    const Args* a;
};

__device__ __forceinline__ int expert_block_prefix(const unsigned* cnt, int lane, int& nb) {
    nb = lane < NE ? ((int)cnt[lane * CNT_STRIDE] + 255) / 256 : 0; int v = nb;
#pragma unroll
    for (int o = 1; o < 64; o <<= 1) { const int t = __shfl_up(v, o); v += (lane >= o) ? t : 0; }
    return v - nb;
}
__device__ __forceinline__ void slot_bases(const Args& A, int l, LAS int* sb, int tid) {
    if (tid < 64) { int nb; const int ex = expert_block_prefix((const unsigned*)(A.ws + WS_CTL) + CW_CNT + l * 32 * CNT_STRIDE, tid, nb); if (tid <= NE) sb[tid] = ex * 256; }
    __syncthreads();
}

__device__ __forceinline__ void phase_mod(const Args& A, const Ctx& C) {
    LAS float* sc = (LAS float*)C.lds;
    LAS float* red = sc + 3072;
    const float* c = A.in[1]; const float* cc = A.in[3];
    for (int i = C.tid; i < 3072; i += NT) { const float v = i < 2048 ? c[i] : cc[i - 2048]; sc[i] = siluf_(v); }
    __syncthreads();
    float* MOD = (float*)(A.ws + WS_MOD);
    for (int u = C.bid; u < DEPTH * 96; u += C.G) {
        const int l = u / 96, cg = u % 96, col = cg * 64 + C.lane;
        const float* w = A.in[4] + (size_t)l * D * 6 * D + col;
        float a0 = 0.f, a1 = 0.f, a2 = 0.f;
#pragma unroll 32
        for (int k = C.wave * 128; k < C.wave * 128 + 128; ++k) { const float wv = w[(size_t)k * 6 * D]; a0 += sc[k] * wv; a1 += sc[1024 + k] * wv; a2 += sc[2048 + k] * wv; }
        red[(C.wave * 3 + 0) * 64 + C.lane] = a0; red[(C.wave * 3 + 1) * 64 + C.lane] = a1; red[(C.wave * 3 + 2) * 64 + C.lane] = a2;
        __syncthreads();
        if (C.tid < 192) { const int v = C.tid / 64, ln = C.tid % 64; float s = 0.f;
            for (int w8 = 0; w8 < 8; ++w8) s += red[(w8 * 3 + v) * 64 + ln];
            MOD[(size_t)(l * 3 + v) * 6 * D + cg * 64 + ln] = s + A.in[5][(size_t)l * 6 * D + cg * 64 + ln]; }
        __syncthreads();
    }
}

__device__ __forceinline__ void load_row_f32(const float* p, int lane, f32x4 (&v)[4]) {
#pragma unroll
    for (int j = 0; j < 4; ++j) v[j] = *(const f32x4*)(p + 4 * lane + 256 * j);
}
__device__ __forceinline__ void load_row_bf16(const bf16* p, int lane, f32x4 (&v)[4]) {
#pragma unroll
    for (int j = 0; j < 4; ++j) { const u32x2 w = *(const u32x2*)(p + 4 * lane + 256 * j);
        v[j] = (f32x4){__uint_as_float(w.x << 16), __uint_as_float(w.x & 0xffff0000u), __uint_as_float(w.y << 16), __uint_as_float(w.y & 0xffff0000u)}; }
}
__device__ __forceinline__ void store_row_bf16(bf16* p, int lane, const f32x4 (&v)[4]) {
#pragma unroll
    for (int j = 0; j < 4; ++j) { u32x2 w; w.x = pk2(v[j].x, v[j].y); w.y = pk2(v[j].z, v[j].w); *(u32x2*)(p + 4 * lane + 256 * j) = w; }
}
constexpr int CVT_IG = (D / 64) * (DE / 32), CVT_ID = (DE / 64) * (D / 32), CVT_PER = 2 * CVT_IG + CVT_ID, CVT_ITEMS = NE * CVT_PER;
constexpr int CVT_Q = 24;
__device__ __forceinline__ void cvt_moe_items(const Args& A, const Ctx& C, int l, int it0, int end, int stride);
__device__ __forceinline__ void cvt_win_i8(const Args& A, const Ctx& C);
__device__ __forceinline__ int cvt_t2(int l, int G);
struct RowVec { f32x4 a[4], s[4], g[4]; };
__device__ __forceinline__ void load_rowvec(RowVec& R, const float* ng, const float* sh, const float* sc, const float* gt, int lane) {
    f32x4 n[4], c[4]; load_row_f32(ng, lane, n); load_row_f32(sc, lane, c); load_row_f32(sh, lane, R.s); if (gt) load_row_f32(gt, lane, R.g);
#pragma unroll
    for (int q = 0; q < 4; ++q) R.a[q] = n[q] * (1.f + c[q]);
}
__device__ __forceinline__ void load_row_bf16raw(const bf16* p, int lane, u32x2 (&v)[4]) {
#pragma unroll
    for (int j = 0; j < 4; ++j) v[j] = *(const u32x2*)(p + 4 * lane + 256 * j);
}
__device__ __forceinline__ void store_row_fp8(unsigned char* p, int lane, const f32x4 (&v)[4]) {
#pragma unroll
    for (int j = 0; j < 4; ++j) { int w = 0; w = __builtin_amdgcn_cvt_pk_fp8_f32(v[j].x, v[j].y, w, false); w = __builtin_amdgcn_cvt_pk_fp8_f32(v[j].z, v[j].w, w, true); *(unsigned*)(p + 4 * lane + 256 * j) = (unsigned)w; }
}
__device__ __forceinline__ void load_row_fp8raw(const unsigned char* p, int lane, unsigned (&v)[4]) {
#pragma unroll
    for (int j = 0; j < 4; ++j) v[j] = *(const unsigned*)(p + 4 * lane + 256 * j);
}
__device__ __forceinline__ f32x4 fp8x4(unsigned w) { const f32x2 lo = __builtin_amdgcn_cvt_pk_f32_fp8((int)w, false), hi = __builtin_amdgcn_cvt_pk_f32_fp8((int)w, true); return (f32x4){lo.x, lo.y, hi.x, hi.y}; }
__device__ __forceinline__ f32x4 bf4(u32x2 w) { return (f32x4){__uint_as_float(w.x << 16), __uint_as_float(w.x & 0xffff0000u), __uint_as_float(w.y << 16), __uint_as_float(w.y & 0xffff0000u)}; }
__device__ __forceinline__ float row_rstd(const f32x4 (&v)[4]) {
    float s = 0.f;
#pragma unroll
    for (int j = 0; j < 4; ++j) s += (v[j].x * v[j].x + v[j].y * v[j].y) + (v[j].z * v[j].z + v[j].w * v[j].w);
    return 1.0f / sqrtf(wave_sum(s) * (1.f / D) + EPS);
}

__device__ __forceinline__ void phase_r1(const Args& A, const Ctx& C, int l) {
    LAS int* sb = (LAS int*)C.lds;
    constexpr int GWP = 2064;
    LAS unsigned char* GW = C.lds + 256;
    LAS unsigned char* HS = C.lds + 256 + 16 * GWP + C.wave * 2 * GWP;
    const bool mls = (l & 1) == 0; const int j = l >> 1;
    if (l == 0) { cvt_win_i8(A, C); __syncthreads(); }
    if (l > 0) slot_bases(A, l - 1, sb, C.tid);
    if (mls) { const float* w = A.in[8] + (size_t)j * D * PROJ + PW;
        f32x4 t[2][4];
#pragma unroll
        for (int jj = 0; jj < 2; ++jj)
#pragma unroll
            for (int q = 0; q < 4; ++q) t[jj][q] = *(const f32x4*)(w + (size_t)(C.tid + NT * jj) * PROJ + 4 * q);
#pragma unroll
        for (int jj = 0; jj < 2; ++jj)
#pragma unroll
            for (int q = 0; q < 4; ++q) { const int k = C.tid + NT * jj;
#pragma unroll
                for (int c = 0; c < 4; ++c) *(LAS unsigned short*)(GW + (4 * q + c) * GWP + k * 2) = (unsigned short)f2bf(t[jj][q][c]); }
        __syncthreads(); }
    const int nrows = (l <= 2) ? NR : NL;
    bf16* LAT = (bf16*)(A.ws + WS_LAT); unsigned char* HI8 = A.ws + WS_H8; float* RSC = (float*)(A.ws + WS_RSC); float* GATE = (float*)(A.ws + WS_GATE);
    const float* MOD = (const float*)(A.ws + WS_MOD); const unsigned char* Y8 = A.ws + WS_PB;
    const int* TS = (const int*)(A.ws + WS_TOKSLOT); const float* TW = (const float*)(A.ws + WS_TOKW);
    const int rpw = (((nrows + C.G - 1) / C.G) + 1) & ~1; const int wrow0 = C.bid * rpw; const int wend = min(wrow0 + rpw, nrows);
    for (int sa = wrow0; sa < wend;) {
        const int mvi = mod_vec_of_row(sa); const int bnd = mvi == 0 ? SEQ : (mvi == 1 ? NL : NR); const int sbnd = min(wend, bnd);
        RowVec RV; { const float* mv = MOD + (size_t)(l * 3 + mvi) * 6 * D;
            load_rowvec(RV, A.in[6] + (size_t)(l * 2 + 0) * D, mv + 0 * D, mv + 1 * D, l > 0 ? MOD + (size_t)((l - 1) * 3 + mvi) * 6 * D + 5 * D : nullptr, C.lane); }
        const int rlast = sbnd - 2;
        i32x4r tsn = (i32x4r){0, 0, 0, 0}; f32x4 twn = (f32x4){0.f, 0.f, 0.f, 0.f};
        if (l > 0) { const int r0 = min(sa + 2 * C.wave, rlast); tsn = *(const i32x4r*)(TS + r0 * 2); twn = *(const f32x4*)(TW + r0 * 2); }
        for (int ra = sa + 2 * C.wave; ra < sbnd; ra += 2 * NW) {
            const bool hasb = true; const int rb = ra + 1;
            const i32x4r tsc = tsn; const f32x4 twc = twn;
            if (l > 0) { const int r1 = min(ra + 2 * NW, rlast); tsn = *(const i32x4r*)(TS + r1 * 2); twn = *(const f32x4*)(TW + r1 * 2); }
            f32x4 va[4], vb[4]; float wa0 = 0.f, wa1 = 0.f, wb0 = 0.f, wb1 = 0.f;
            if (l == 0) { load_row_f32(ra < NL ? A.in[0] + (size_t)ra * D : A.in[2] + (size_t)(ra - NL) * D, C.lane, va); load_row_f32(rb < NL ? A.in[0] + (size_t)rb * D : A.in[2] + (size_t)(rb - NL) * D, C.lane, vb); }
            else {
                const int ta0 = tsc.x, ta1 = tsc.y, tb0 = tsc.z, tb1 = tsc.w; wa0 = twc.x; wa1 = twc.y; wb0 = twc.z; wb1 = twc.w;
                load_row_bf16(LAT + (size_t)ra * D, C.lane, va); load_row_bf16(LAT + (size_t)rb * D, C.lane, vb);
                unsigned ya0[4], ya1[4], yb0[4], yb1[4];
                load_row_fp8raw(Y8 + (size_t)(sb[ta0 >> 20] + (ta0 & 0xfffff)) * D, C.lane, ya0); load_row_fp8raw(Y8 + (size_t)(sb[ta1 >> 20] + (ta1 & 0xfffff)) * D, C.lane, ya1);
                load_row_fp8raw(Y8 + (size_t)(sb[tb0 >> 20] + (tb0 & 0xfffff)) * D, C.lane, yb0); load_row_fp8raw(Y8 + (size_t)(sb[tb1 >> 20] + (tb1 & 0xfffff)) * D, C.lane, yb1);
                wa0 *= 1.0f / YSCALE; wa1 *= 1.0f / YSCALE; wb0 *= 1.0f / YSCALE; wb1 *= 1.0f / YSCALE;
#pragma unroll
                for (int q = 0; q < 4; ++q) { va[q] += RV.g[q] * (fp8x4(ya0[q]) * wa0 + fp8x4(ya1[q]) * wa1); vb[q] += RV.g[q] * (fp8x4(yb0[q]) * wb0 + fp8x4(yb1[q]) * wb1); }
            }
            store_row_bf16(LAT + (size_t)ra * D, C.lane, va); if (hasb) store_row_bf16(LAT + (size_t)rb * D, C.lane, vb);
            const float rra = row_rstd(va), rrb = row_rstd(vb);
            f32x4 ha[4], hb[4];
#pragma unroll
            for (int q = 0; q < 4; ++q) { ha[q] = (va[q] * rra) * RV.a[q] + RV.s[q]; hb[q] = (vb[q] * rrb) * RV.a[q] + RV.s[q]; }
            { float ma = 0.f, mb = 0.f;
#pragma unroll
              for (int q = 0; q < 4; ++q) { ma = fmaxf(ma, fmaxf(fmaxf(fabsf(ha[q].x), fabsf(ha[q].y)), fmaxf(fabsf(ha[q].z), fabsf(ha[q].w)))); mb = fmaxf(mb, fmaxf(fmaxf(fabsf(hb[q].x), fabsf(hb[q].y)), fmaxf(fabsf(hb[q].z), fabsf(hb[q].w)))); }
              ma = fmaxf(wave_max_nn(ma), 1.0e-20f); mb = fmaxf(wave_max_nn(mb), 1.0e-20f);
              const float ia = 127.0f / ma, ib = 127.0f / mb;
#pragma unroll
              for (int q = 0; q < 4; ++q) { *(unsigned*)(HI8 + (size_t)ra * D + 4 * C.lane + 256 * q) = pack_i8(ha[q] * ia); *(unsigned*)(HI8 + (size_t)rb * D + 4 * C.lane + 256 * q) = pack_i8(hb[q] * ib); }
              if (C.lane == 0) { RSC[ra] = ma * (1.0f / 127.0f); RSC[rb] = mb * (1.0f / 127.0f); } }
            if (mls) {
#pragma unroll
                for (int q = 0; q < 4; ++q) { *(LAS u32x2*)(HS + (4 * C.lane + 256 * q) * 2) = (u32x2){cvt2(ha[q].x, ha[q].y), cvt2(ha[q].z, ha[q].w)}; *(LAS u32x2*)(HS + GWP + (4 * C.lane + 256 * q) * 2) = (u32x2){cvt2(hb[q].x, hb[q].y), cvt2(hb[q].z, hb[q].w)}; }
                asm volatile("s_waitcnt lgkmcnt(0)" ::: "memory");
                f32x4 gacc = (f32x4){0.f, 0.f, 0.f, 0.f};
                { const int gi = C.lane & 15, kg = C.lane >> 4; LAS const unsigned char* ap = HS + (gi & 1) * GWP + kg * 16; LAS const unsigned char* bp = GW + gi * GWP + kg * 16;
#pragma unroll 8
                  for (int s2 = 0; s2 < 32; ++s2) { bf16x8 av = *(const LAS bf16x8*)(ap + s2 * 64); const bf16x8 bv = *(const LAS bf16x8*)(bp + s2 * 64);
                      if (gi >= 2) av = (bf16x8){0, 0, 0, 0, 0, 0, 0, 0};
                      gacc = __builtin_amdgcn_mfma_f32_16x16x32_bf16(av, bv, gacc, 0, 0, 0); } }
                float ga = gacc[0], gb = gacc[1];
                if (C.lane < 16) {
                    const float bgt = A.in[9][j * 16 + C.lane]; const int gtype = C.lane >> 2;
                    ga += bgt; gb += bgt;
                    GATE[(size_t)ra * 16 + C.lane] = (gtype & 1) ? logsigmoidf_(ga) : 15.0f * tanhf(ga * (1.0f / 15.0f));
                    if (hasb) GATE[(size_t)rb * 16 + C.lane] = (gtype & 1) ? logsigmoidf_(gb) : 15.0f * tanhf(gb * (1.0f / 15.0f)); }
            }
        }
        sa = sbnd;
    }
}

__device__ __forceinline__ void phase_r2(const Args& A, const Ctx& C, int l) {
    constexpr int WP = 2064;
    LAS unsigned char* RWB = C.lds;
    LAS float* WL = (LAS float*)(C.lds + 48 * WP);
    LAS unsigned* hist = (LAS unsigned*)(WL + 8 * 16 * 48);
    LAS unsigned* gbase = hist + 32;
    constexpr int RCAP = 144;
    LAS int* rec = (LAS int*)(gbase + 32);
    static_assert(48 * WP + 8 * 16 * 48 * 4 + 256 + RCAP * 16 <= LDS_TAB_END, "R2 LDS map");
    cvt_moe_items(A, C, l, cvt_t2(l, C.G) + C.bid * NW + C.wave, CVT_ITEMS, C.G * NW);
    __syncthreads();
    { const float* wg = A.in[15] + (size_t)l * D * NGRP; const float* wr = A.in[17] + (size_t)l * D * NE;
      { const int kp = C.tid; const f32x4 x0 = *(const f32x4*)(wg + (size_t)(2 * kp) * 4), x1 = *(const f32x4*)(wg + (size_t)(2 * kp + 1) * 4);
        *(LAS unsigned*)(RWB + 0 * WP + kp * 4) = cvt2(x0.x, x1.x); *(LAS unsigned*)(RWB + 1 * WP + kp * 4) = cvt2(x0.y, x1.y);
        *(LAS unsigned*)(RWB + 2 * WP + kp * 4) = cvt2(x0.z, x1.z); *(LAS unsigned*)(RWB + 3 * WP + kp * 4) = cvt2(x0.w, x1.w); }
      f32x4 t0[8], t1[8];
#pragma unroll
      for (int jj = 0; jj < 8; ++jj) { const int it = C.tid + NT * jj, kp = it >> 3, cg = it & 7; t0[jj] = *(const f32x4*)(wr + (size_t)(2 * kp) * NE + 4 * cg); t1[jj] = *(const f32x4*)(wr + (size_t)(2 * kp + 1) * NE + 4 * cg); }
#pragma unroll
      for (int jj = 0; jj < 8; ++jj) { const int it = C.tid + NT * jj, kp = it >> 3, c0 = 4 + 4 * (it & 7);
          *(LAS unsigned*)(RWB + (c0 + 0) * WP + kp * 4) = cvt2(t0[jj].x, t1[jj].x); *(LAS unsigned*)(RWB + (c0 + 1) * WP + kp * 4) = cvt2(t0[jj].y, t1[jj].y);
          *(LAS unsigned*)(RWB + (c0 + 2) * WP + kp * 4) = cvt2(t0[jj].z, t1[jj].z); *(LAS unsigned*)(RWB + (c0 + 3) * WP + kp * 4) = cvt2(t0[jj].w, t1[jj].w); }
      for (int i = C.tid; i < 12 * 512; i += NT) *(LAS unsigned*)(RWB + (36 + i / 512) * WP + (i % 512) * 4) = 0u; }
    const int nrows = (l <= 1) ? NR : NL;
    bf16* LAT = (bf16*)(A.ws + WS_LAT); bf16* H = (bf16*)(A.ws + WS_HB); unsigned char* H8 = A.ws + WS_H8;
    const float* MOD = (const float*)(A.ws + WS_MOD);
    unsigned* cnt = (unsigned*)(A.ws + WS_CTL) + CW_CNT + l * 32 * CNT_STRIDE;
    int* TS = (int*)(A.ws + WS_TOKSLOT); float* TW = (float*)(A.ws + WS_TOKW); int* ST = (int*)(A.ws + WS_SLOTTOK);
    const int rpw = (((nrows + C.G - 1) / C.G) + 1) & ~1; const int wrow0 = C.bid * rpw; const int wend0 = min(wrow0 + rpw, nrows);
    const float* bg = A.in[16] + l * NGRP; const float* br = A.in[18] + l * NE;
    for (int cb = wrow0; cb < wend0; cb += RCAP) {
        const int wend = min(cb + RCAP, wend0);
        if (C.tid < 32) hist[C.tid] = 0u;
        for (int sa = cb; sa < wend;) {
            const int mvi = mod_vec_of_row(sa); const int bnd = mvi == 0 ? SEQ : (mvi == 1 ? NL : NR); const int sbnd = min(wend, bnd);
            RowVec RV; { const float* mv = MOD + (size_t)(l * 3 + mvi) * 6 * D; load_rowvec(RV, A.in[6] + (size_t)(l * 2 + 1) * D, mv + 3 * D, mv + 4 * D, mv + 2 * D, C.lane); }
            const int rlast = sbnd - 2;
            u32x2 la[4], lb[4], ya[4], yb[4];
            { const int r0 = min(sa + 2 * C.wave, rlast); load_row_bf16raw(LAT + (size_t)r0 * D, C.lane, la); load_row_bf16raw(LAT + (size_t)(r0 + 1) * D, C.lane, lb);
              load_row_bf16raw(H + (size_t)r0 * D, C.lane, ya); load_row_bf16raw(H + (size_t)(r0 + 1) * D, C.lane, yb); }
            for (int ra = sa + 2 * C.wave; ra < sbnd; ra += 2 * NW) {
                const int rb = ra + 1;
                u32x2 lan[4], lbn[4], yan[4], ybn[4];
                { const int r1 = min(ra + 2 * NW, rlast); load_row_bf16raw(LAT + (size_t)r1 * D, C.lane, lan); load_row_bf16raw(LAT + (size_t)(r1 + 1) * D, C.lane, lbn);
                  load_row_bf16raw(H + (size_t)r1 * D, C.lane, yan); load_row_bf16raw(H + (size_t)(r1 + 1) * D, C.lane, ybn); }
                f32x4 va[4], vb[4];
#pragma unroll
                for (int q = 0; q < 4; ++q) { va[q] = bf4(la[q]) + RV.g[q] * bf4(ya[q]); vb[q] = bf4(lb[q]) + RV.g[q] * bf4(yb[q]); }
                store_row_bf16(LAT + (size_t)ra * D, C.lane, va); store_row_bf16(LAT + (size_t)rb * D, C.lane, vb);
                const float rra = row_rstd(va), rrb = row_rstd(vb);
                f32x4 ha[4], hb[4];
#pragma unroll
                for (int q = 0; q < 4; ++q) { ha[q] = (va[q] * rra) * RV.a[q] + RV.s[q]; hb[q] = (vb[q] * rrb) * RV.a[q] + RV.s[q]; }
                store_row_bf16(H + (size_t)ra * D, C.lane, ha); store_row_bf16(H + (size_t)rb * D, C.lane, hb);
                store_row_fp8(H8 + (size_t)ra * D, C.lane, ha); store_row_fp8(H8 + (size_t)rb * D, C.lane, hb);
#pragma unroll
                for (int q = 0; q < 4; ++q) { la[q] = lan[q]; lb[q] = lbn[q]; ya[q] = yan[q]; yb[q] = ybn[q]; }
            }
            sa = sbnd;
        }
        __syncthreads();
        const int fr = C.lane & 15, fq = C.lane >> 4;
        for (int t = C.wave; t * 16 < wend - cb; t += NW) {
            const int trow = min(cb + 16 * t + fr, wend - 1);
            const bf16* hp = H + (size_t)trow * D + 8 * fq;
            f32x4 acc[3];
#pragma unroll
            for (int ct = 0; ct < 3; ++ct) acc[ct] = (f32x4){0.f, 0.f, 0.f, 0.f};
#pragma unroll 1
            for (int kb = 0; kb < 4; ++kb) {
                bf16x8 av[8];
#pragma unroll
                for (int k8 = 0; k8 < 8; ++k8) av[k8] = *(const bf16x8*)(hp + 32 * (8 * kb + k8));
#pragma unroll
                for (int k8 = 0; k8 < 8; ++k8)
#pragma unroll
                    for (int ct = 0; ct < 3; ++ct) { const bf16x8 bv = *(const LAS bf16x8*)(RWB + (ct * 16 + fr) * WP + (32 * (8 * kb + k8) + 8 * fq) * 2);
                        acc[ct] = __builtin_amdgcn_mfma_f32_16x16x32_bf16(av[k8], bv, acc[ct], 0, 0, 0); }
            }
            LAS float* wl = WL + C.wave * 16 * 48;
#pragma unroll
            for (int ct = 0; ct < 3; ++ct)
#pragma unroll
                for (int jq = 0; jq < 4; ++jq) wl[(4 * fq + jq) * 48 + ct * 16 + fr] = acc[ct][jq];
            asm volatile("s_waitcnt lgkmcnt(0)" ::: "memory");
            const int row = cb + 16 * t + C.lane;
            if (C.lane < 16 && row < wend) {
                LAS const float* wm = wl + C.lane * 48;
                float lg[36];
#pragma unroll
                for (int c = 0; c < 36; ++c) lg[c] = wm[c];
                float gl[4]; int grp = 0; float gm = -3.0e38f;
#pragma unroll
                for (int c = 0; c < 4; ++c) { gl[c] = lg[c] + bg[c]; if (gl[c] > gm) { gm = gl[c]; grp = c; } }
                float gs = 0.f;
#pragma unroll
                for (int c = 0; c < 4; ++c) gs += __expf(gl[c] - gm);
                const float pgrp = 1.0f / gs;
                float rl[8];
#pragma unroll
                for (int i = 0; i < 8; ++i) { float tt = 0.f;
#pragma unroll
                    for (int g = 0; g < 4; ++g) tt = (g == grp) ? lg[4 + g * 8 + i] : tt;
                    rl[i] = tt + br[grp * 8 + i]; }
                int i0 = 0; float m0 = rl[0];
#pragma unroll
                for (int i = 1; i < 8; ++i) if (rl[i] > m0) { m0 = rl[i]; i0 = i; }
                int i1 = -1; float m1 = -3.0e38f;
#pragma unroll
                for (int i = 0; i < 8; ++i) if (i != i0 && rl[i] > m1) { m1 = rl[i]; i1 = i; }
                const float p0 = 1.0f, p1 = __expf(m1 - m0);
                const float w0 = pgrp * p0 / (p0 + p1), w1 = pgrp * p1 / (p0 + p1);
                const int e0 = grp * 8 + i0, e1 = grp * 8 + i1;
                const unsigned q0 = __hip_atomic_fetch_add(hist + e0, 1u, __ATOMIC_RELAXED, __HIP_MEMORY_SCOPE_WORKGROUP), q1 = __hip_atomic_fetch_add(hist + e1, 1u, __ATOMIC_RELAXED, __HIP_MEMORY_SCOPE_WORKGROUP);
                const int li = row - cb;
                rec[li * 4 + 0] = e0 | (e1 << 8); rec[li * 4 + 1] = (int)q0; rec[li * 4 + 2] = (int)q1;
                TW[row * 2 + 0] = w0; TW[row * 2 + 1] = w1;
            }
        }
        __syncthreads();
        if (C.tid < 32) gbase[C.tid] = hist[C.tid] ? atomicAdd(cnt + C.tid * CNT_STRIDE, hist[C.tid]) : 0u;
        __syncthreads();
        for (int i = C.tid; i < wend - cb; i += NT) { const int row = cb + i; const int ee = rec[i * 4], e0 = ee & 255, e1 = ee >> 8;
            const unsigned q0 = gbase[e0] + (unsigned)rec[i * 4 + 1], q1 = gbase[e1] + (unsigned)rec[i * 4 + 2];
            ST[(size_t)e0 * CAP + q0] = row; ST[(size_t)e1 * CAP + q1] = row;
            TS[row * 2 + 0] = (e0 << 20) | (int)q0; TS[row * 2 + 1] = (e1 << 20) | (int)q1; }
        __syncthreads();
    }
}

__device__ __forceinline__ void phase_final(const Args& A, const Ctx& C) {
    LAS int* sb = (LAS int*)C.lds;
    slot_bases(A, 3, sb, C.tid);
    const bf16* LAT = (const bf16*)(A.ws + WS_LAT); const unsigned char* Y8 = A.ws + WS_PB;
    const int* TS = (const int*)(A.ws + WS_TOKSLOT); const float* TW = (const float*)(A.ws + WS_TOKW);
    const float* MOD = (const float*)(A.ws + WS_MOD);
    f32x4 fg[4]; load_row_f32(A.in[7], C.lane, fg);
    const int rpw = (((NL + C.G - 1) / C.G) + 1) & ~1; const int wrow0 = C.bid * rpw; const int wend = min(wrow0 + rpw, NL);
    for (int sa = wrow0; sa < wend;) {
        const int mvi = mod_vec_of_row(sa); const int sbnd = min(wend, mvi == 0 ? SEQ : NL);
        f32x4 g2[4]; load_row_f32(MOD + (size_t)(3 * 3 + mvi) * 6 * D + 5 * D, C.lane, g2);
        for (int ra = sa + 2 * C.wave; ra < sbnd; ra += 2 * NW) {
            const int rb = ra + 1;
            const int ta0 = TS[ra * 2], ta1 = TS[ra * 2 + 1], tb0 = TS[rb * 2], tb1 = TS[rb * 2 + 1]; const float wa0 = TW[ra * 2], wa1 = TW[ra * 2 + 1], wb0 = TW[rb * 2], wb1 = TW[rb * 2 + 1];
            f32x4 va[4], vb[4]; unsigned ya0[4], ya1[4], yb0[4], yb1[4];
            load_row_bf16(LAT + (size_t)ra * D, C.lane, va); load_row_bf16(LAT + (size_t)rb * D, C.lane, vb);
            load_row_fp8raw(Y8 + (size_t)(sb[ta0 >> 20] + (ta0 & 0xfffff)) * D, C.lane, ya0); load_row_fp8raw(Y8 + (size_t)(sb[ta1 >> 20] + (ta1 & 0xfffff)) * D, C.lane, ya1);
            load_row_fp8raw(Y8 + (size_t)(sb[tb0 >> 20] + (tb0 & 0xfffff)) * D, C.lane, yb0); load_row_fp8raw(Y8 + (size_t)(sb[tb1 >> 20] + (tb1 & 0xfffff)) * D, C.lane, yb1);
#pragma unroll
            for (int q = 0; q < 4; ++q) { va[q] += g2[q] * (fp8x4(ya0[q]) * (wa0 * (1.0f / YSCALE)) + fp8x4(ya1[q]) * (wa1 * (1.0f / YSCALE))); vb[q] += g2[q] * (fp8x4(yb0[q]) * (wb0 * (1.0f / YSCALE)) + fp8x4(yb1[q]) * (wb1 * (1.0f / YSCALE))); }
            const float rra = row_rstd(va), rrb = row_rstd(vb);
#pragma unroll
            for (int q = 0; q < 4; ++q) { *(f32x4*)(A.out + (size_t)ra * D + 4 * C.lane + 256 * q) = (va[q] * rra) * fg[q]; *(f32x4*)(A.out + (size_t)rb * D + 4 * C.lane + 256 * q) = (vb[q] * rrb) * fg[q]; }
        }
        sa = sbnd;
    }
}

__device__ __forceinline__ void phase_conv(const Args& A, const Ctx& C, int l) {
    const int j = l >> 1; const int nrows = (l <= 1) ? NR : NL;
    const bf16* P = (const bf16*)(A.ws + WS_PB); unsigned char* HM = A.ws + WS_HM; float* RSC = (float*)(A.ws + WS_RSC);
    const float* cw = A.in[13] + (size_t)j * 3 * D;
    f32x4 w0[4], w1[4], w2[4];
    load_row_f32(cw, C.lane, w0); load_row_f32(cw + D, C.lane, w1); load_row_f32(cw + 2 * D, C.lane, w2);
    const int rpw = (((nrows + C.G - 1) / C.G) + 1) & ~1; const int wrow0 = C.bid * rpw; const int wend = min(wrow0 + rpw, nrows);
    for (int ra = wrow0 + 2 * C.wave; ra < wend; ra += 2 * NW) {
        const int rb = ra + 1;
        const int ta = ra < NL ? (ra & 63) : ((ra - NL) & 255), tb1 = rb < NL ? (rb & 63) : ((rb - NL) & 255), tlast = ra < NL ? 63 : 255;
        const bool hasl = ta != 0, hasr = tb1 != tlast;
        const bf16* pa = P + (size_t)ra * PW;
        u32x2 bga[4], bgb[4], zm[4], z0[4], z1[4], z2[4];
        load_row_bf16raw(pa, C.lane, bga); load_row_bf16raw(pa + PW, C.lane, bgb);
        load_row_bf16raw(pa + D, C.lane, z0); load_row_bf16raw(pa + PW + D, C.lane, z1);
        load_row_bf16raw(hasl ? pa - PW + D : pa + D, C.lane, zm); load_row_bf16raw(hasr ? pa + 2 * PW + D : pa + D, C.lane, z2);
        const float fl = hasl ? 1.f : 0.f, fr = hasr ? 1.f : 0.f;
        f32x4 oa[4], ob[4];
#pragma unroll
        for (int q = 0; q < 4; ++q) { const f32x4 a0 = bf4(z0[q]), a1 = bf4(z1[q]);
            oa[q] = bf4(bga[q]) * (w0[q] * (bf4(zm[q]) * fl) + w1[q] * a0 + w2[q] * a1);
            ob[q] = bf4(bgb[q]) * (w0[q] * a0 + w1[q] * a1 + w2[q] * (bf4(z2[q]) * fr)); }
        float ma = 0.f, mb = 0.f;
#pragma unroll
        for (int q = 0; q < 4; ++q) { ma = fmaxf(ma, fmaxf(fmaxf(fabsf(oa[q].x), fabsf(oa[q].y)), fmaxf(fabsf(oa[q].z), fabsf(oa[q].w)))); mb = fmaxf(mb, fmaxf(fmaxf(fabsf(ob[q].x), fabsf(ob[q].y)), fmaxf(fabsf(ob[q].z), fabsf(ob[q].w)))); }
        ma = fmaxf(wave_max_nn(ma), 1.0e-20f); mb = fmaxf(wave_max_nn(mb), 1.0e-20f);
        const float ia = 127.0f / ma, ib = 127.0f / mb;
#pragma unroll
        for (int q = 0; q < 4; ++q) { *(unsigned*)(HM + (size_t)ra * D + 4 * C.lane + 256 * q) = pack_i8(oa[q] * ia); *(unsigned*)(HM + (size_t)rb * D + 4 * C.lane + 256 * q) = pack_i8(ob[q] * ib); }
        if (C.lane == 0) { RSC[ra] = ma * (1.0f / 127.0f); RSC[rb] = mb * (1.0f / 127.0f); }
    }
}

constexpr int BM = 256, BK = 64, HALF = 128, HTB = HALF * BK * 2, STAGE_BYTES = 8 * HTB, NXCD = 8, WGM = 8;
constexpr int LDS_TAB = STAGE_BYTES;
__device__ __forceinline__ int lds_byte(int r, int c) { const int st = (r >> 4) * 2 + (c >> 5), rr = r & 15, cc = c & 31, ob = rr * 64 + cc * 2; return st * 1024 + (ob ^ (((ob >> 9) & 1) << 5)); }
__device__ __forceinline__ void stage_rc(int b, int& R, int& C) { const int st = b / 1024, sb = b % 1024, swz = sb ^ (((sb >> 9) & 1) << 5); R = (st >> 1) * 16 + swz / 64; C = (st & 1) * 32 + (swz % 64) / 2; }
__device__ __forceinline__ int perm32(int rho) { const int n = rho >> 4, i = rho & 15; return 8 * (i >> 2) + 4 * n + (i & 3); }
__device__ __forceinline__ unsigned cvt_pk_bf16(float lo, float hi) { unsigned r; asm volatile("v_cvt_pk_bf16_f32 %0, %1, %2" : "=v"(r) : "v"(lo), "v"(hi)); return r; }

struct GUnit { const char* a; const char* b; int orow, ocol, aux; };

typedef int i32x8 __attribute__((ext_vector_type(8)));
typedef int i32x4 __attribute__((ext_vector_type(4)));
template <class Epi, class Sched, bool GATHER, int OPM = 0>
__device__ __forceinline__ void gemm_phase(LAS unsigned char* lds, const int K, const Sched& S, const Epi& E) {
    const int tid = threadIdx.x, wid = __builtin_amdgcn_readfirstlane(tid >> 6), lane = tid & 63, wr = wid >> 2, wc = wid & 3, fr = lane & 15, fq = lane >> 4;
    constexpr bool FP8 = (OPM == 1), I8 = (OPM == 2);
    const int RB = (OPM != 0) ? K : 2 * K;
    const int nt = RB / (BK * 2);
    unsigned voffB[2], voA[2][2]; int Rr[2], Cc[2];
#pragma unroll
    for (int i = 0; i < 2; ++i) { int R, C; stage_rc(tid * 16 + i * 8192, R, C); const int Rb = (R & ~31) + perm32(R & 31); Rr[i] = R; Cc[i] = C;
        voffB[i] = (unsigned)(Rb * RB + C * 2);
        voA[0][i] = (unsigned)(R * RB + C * 2); voA[1][i] = (unsigned)((R + HALF) * RB + C * 2); }
    const size_t kstep = (size_t)(BK * 2);
    const size_t hstep = (size_t)HALF * RB;
    const unsigned ldsw = (unsigned)wid * 1024u;
    const unsigned ldsbase = (unsigned)(size_t)lds;
    const int aoff = lds_byte(wr * 64 + fr, fq * 8), boff = lds_byte(wc * 32 + fr, fq * 8);
#define PG8_SA(b, h) (((b) * 2 + (h)) * HTB)
#define PG8_SB(b, h) ((4 + (b) * 2 + (h)) * HTB)
#define PG8_STAGE(bufoff, gbase, voff) do { _Pragma("unroll") for (int _i = 0; _i < 2; ++_i) \
        asm volatile("s_mov_b32 m0, %2\n\ts_nop 0\n\tglobal_load_lds_dwordx4 %0, %1" :: "v"((voff)[_i]), "s"((const char*)(gbase)), "s"(ldsbase + (unsigned)(bufoff) + ldsw + (unsigned)(_i * 8192)) : "memory"); } while (0)
#define PG8_STAGE_A1(bufoff, gbase) do { if constexpr (GATHER) PG8_STAGE(bufoff, gbase, voA[1]); else PG8_STAGE(bufoff, (const char*)(gbase) + hstep, voA[0]); } while (0)
#define PG8_LDA(dst, b, h) do { if constexpr (FP8) { _Pragma("unroll") for (int m = 0; m < 4; ++m) { \
        const i32x4 _lo = *(const LAS i32x4*)(lds + PG8_SA(b, h) + aoff + m * 2048), _hi = *(const LAS i32x4*)(lds + PG8_SA(b, h) + aoff + m * 2048 + 1024); \
        dst##8[m] = __builtin_shufflevector(_lo, _hi, 0, 1, 2, 3, 4, 5, 6, 7); } } \
      else { _Pragma("unroll") for (int m = 0; m < 4; ++m) _Pragma("unroll") for (int k = 0; k < 2; ++k) dst[m][k] = *(const LAS bf16x8*)(lds + PG8_SA(b, h) + aoff + m * 2048 + k * 1024); } } while (0)
#define PG8_LDB(dst, b, h) do { if constexpr (FP8) { _Pragma("unroll") for (int n = 0; n < 2; ++n) { \
        const i32x4 _lo = *(const LAS i32x4*)(lds + PG8_SB(b, h) + boff + n * 2048), _hi = *(const LAS i32x4*)(lds + PG8_SB(b, h) + boff + n * 2048 + 1024); \
        dst##8[n] = __builtin_shufflevector(_lo, _hi, 0, 1, 2, 3, 4, 5, 6, 7); } } \
      else { _Pragma("unroll") for (int n = 0; n < 2; ++n) _Pragma("unroll") for (int k = 0; k < 2; ++k) dst[n][k] = *(const LAS bf16x8*)(lds + PG8_SB(b, h) + boff + n * 2048 + k * 1024); } } while (0)
#define PG8_MMA(ai, bj, At, Bt) do { __builtin_amdgcn_s_setprio(1); \
        if constexpr (FP8) { _Pragma("unroll") for (int m = 0; m < 4; ++m) _Pragma("unroll") for (int n = 0; n < 2; ++n) \
            acc[ai][bj][m][n] = __builtin_amdgcn_mfma_scale_f32_16x16x128_f8f6f4(Bt##8[n], At##8[m], acc[ai][bj][m][n], 0, 0, 0, 0x7f7f7f7f, 0, 0x7f7f7f7f); } \
        else if constexpr (I8) { _Pragma("unroll") for (int m = 0; m < 4; ++m) _Pragma("unroll") for (int n = 0; n < 2; ++n) _Pragma("unroll") for (int k = 0; k < 2; ++k) \
            acc[ai][bj][m][n] = __builtin_bit_cast(f32x4, __builtin_amdgcn_mfma_i32_16x16x64_i8(__builtin_bit_cast(i32x4, Bt[n][k]), __builtin_bit_cast(i32x4, At[m][k]), __builtin_bit_cast(i32x4, acc[ai][bj][m][n]), 0, 0, 0)); } \
        else { _Pragma("unroll") for (int m = 0; m < 4; ++m) _Pragma("unroll") for (int n = 0; n < 2; ++n) _Pragma("unroll") for (int k = 0; k < 2; ++k) \
            acc[ai][bj][m][n] = __builtin_amdgcn_mfma_f32_16x16x32_bf16(Bt[n][k], At[m][k], acc[ai][bj][m][n], 0, 0, 0); } \
        __builtin_amdgcn_s_setprio(0); } while (0)
#define PG8_WAIT_V(n) asm volatile("s_waitcnt vmcnt(" #n ")" ::: "memory")
#define PG8_WAIT_L(n) asm volatile("s_waitcnt lgkmcnt(" #n ")" ::: "memory")
#define PG8_BAR __builtin_amdgcn_s_barrier()
#define PG8_SCHED __builtin_amdgcn_sched_barrier(0)
    GUnit cur, nxt; int ui = 0;
    if (!S.next(0, cur)) return;
    if constexpr (GATHER) {
#pragma unroll
        for (int h = 0; h < 2; ++h)
#pragma unroll
            for (int i = 0; i < 2; ++i) voA[h][i] = S.arow_off(0, h * HALF + Rr[i]) + (unsigned)Cc[i] * 2u;
    }
    f32x4 acc[2][2][4][2];
#pragma unroll
    for (int a = 0; a < 2; ++a)
#pragma unroll
        for (int b = 0; b < 2; ++b)
#pragma unroll
            for (int m = 0; m < 4; ++m)
#pragma unroll
                for (int n = 0; n < 2; ++n) acc[a][b][m][n] = (f32x4){0.f, 0.f, 0.f, 0.f};
    bf16x8 At[4][2], B0[2][2], B1[2][2]; i32x8 At8[4], B08[2], B18[2];
    const char* cA = cur.a; const char* cB = cur.b;
    PG8_STAGE(PG8_SB(0, 0), cB, voffB); PG8_STAGE(PG8_SB(0, 1), cB + hstep, voffB); PG8_STAGE(PG8_SA(0, 0), cA, voA[0]); PG8_STAGE_A1(PG8_SA(0, 1), cA);
    if (wr == 1) PG8_BAR;
    PG8_WAIT_V(2); PG8_BAR;
    PG8_STAGE(PG8_SB(1, 0), cB + kstep, voffB); PG8_STAGE(PG8_SA(1, 0), cA + kstep, voA[0]); PG8_STAGE(PG8_SB(1, 1), cB + hstep + kstep, voffB);
    PG8_WAIT_V(6); PG8_BAR;
    for (;;) {
        const bool has_next = S.next(ui + 1, nxt);
        const char* nA = has_next ? nxt.a : cA; const char* nB = has_next ? nxt.b : cB;
#pragma unroll 1
        for (int t = 0; t < nt; t += 2) {
            const bool last = (t == nt - 2);
            const char* a1 = cA + (size_t)(t + 1) * kstep;
            const char* a2 = last ? nA : cA + (size_t)(t + 2) * kstep; const char* b2 = last ? nB : cB + (size_t)(t + 2) * kstep;
            const char* a3 = a2 + kstep; const char* b3 = b2 + kstep;
            PG8_LDB(B0, 0, 0); PG8_LDB(B1, 0, 1); PG8_SCHED; PG8_LDA(At, 0, 0); PG8_STAGE_A1(PG8_SA(1, 1), a1);
            if constexpr (GATHER) { if (last && has_next) {
#pragma unroll
                for (int h = 0; h < 2; ++h)
#pragma unroll
                    for (int i = 0; i < 2; ++i) { int R2, C2; stage_rc(tid * 16 + i * 8192, R2, C2); voA[h][i] = S.arow_off(ui + 1, h * HALF + R2) + (unsigned)C2 * 2u; } } }
            PG8_WAIT_V(8); PG8_WAIT_L(0); PG8_BAR; PG8_MMA(0, 0, At, B0); PG8_MMA(0, 1, At, B1); PG8_BAR; PG8_SCHED;
            PG8_LDA(At, 0, 1); PG8_STAGE(PG8_SB(0, 0), b2, voffB); PG8_STAGE(PG8_SB(0, 1), b2 + hstep, voffB); PG8_STAGE(PG8_SA(0, 0), a2, voA[0]);
            PG8_WAIT_V(8); PG8_WAIT_L(0); PG8_BAR; PG8_MMA(1, 0, At, B0); PG8_MMA(1, 1, At, B1); PG8_BAR; PG8_SCHED;
            PG8_LDB(B0, 1, 0); PG8_LDB(B1, 1, 1); PG8_SCHED; PG8_LDA(At, 1, 0); PG8_STAGE_A1(PG8_SA(0, 1), a2);
            PG8_WAIT_V(8); PG8_WAIT_L(0); PG8_BAR; PG8_MMA(0, 0, At, B0); PG8_MMA(0, 1, At, B1); PG8_BAR; PG8_SCHED;
            PG8_LDA(At, 1, 1); PG8_STAGE(PG8_SB(1, 0), b3, voffB); PG8_STAGE(PG8_SB(1, 1), b3 + hstep, voffB); PG8_STAGE(PG8_SA(1, 0), a3, voA[0]);
            PG8_WAIT_V(8); PG8_WAIT_L(0); PG8_BAR; PG8_MMA(1, 0, At, B0); PG8_MMA(1, 1, At, B1); PG8_BAR; PG8_SCHED;
        }
        if (wr == 0) PG8_BAR;
        { int tz = threadIdx.x; asm volatile("" : "+v"(tz));
          if constexpr (I8) {
#pragma unroll
              for (int a_ = 0; a_ < 2; ++a_)
#pragma unroll
                  for (int b_ = 0; b_ < 2; ++b_)
#pragma unroll
                      for (int m = 0; m < 4; ++m)
#pragma unroll
                          for (int n = 0; n < 2; ++n) acc[a_][b_][m][n] = __builtin_convertvector(__builtin_bit_cast(i32x4, acc[a_][b_][m][n]), f32x4); }
          const int wz = tz >> 6, lz = tz & 63; E(acc, cur, wz >> 2, wz & 3, lz & 15, lz >> 4); }
        if (!has_next) break;
#pragma unroll
        for (int a = 0; a < 2; ++a)
#pragma unroll
            for (int b = 0; b < 2; ++b)
#pragma unroll
                for (int m = 0; m < 4; ++m)
#pragma unroll
                    for (int n = 0; n < 2; ++n) acc[a][b][m][n] = (f32x4){0.f, 0.f, 0.f, 0.f};
        cur = nxt; cA = nA; cB = nB; ++ui;
        if (wr == 1) PG8_BAR;
    }
    PG8_WAIT_V(0);
    PG8_BAR;
#undef PG8_SA
#undef PG8_SB
#undef PG8_STAGE
#undef PG8_STAGE_A1
#undef PG8_LDA
#undef PG8_LDB
#undef PG8_MMA
#undef PG8_WAIT_V
#undef PG8_WAIT_L
#undef PG8_BAR
#undef PG8_SCHED
}

__device__ __forceinline__ int xcd_remap(int L, int nwg) { const int q = nwg / NXCD, r = nwg % NXCD, xcd = L % NXCD, off = L / NXCD; return (xcd < r ? xcd * (q + 1) : r * (q + 1) + (xcd - r) * q) + off; }

struct DenseSched {
    const char* A; const char* Bt; int nM, nN, nwg, G, c; size_t tstep; int sw_lo, sw_hi;
    __device__ __forceinline__ void init(const void* A_, const void* Bt_, int M, int N, int K, int G_, int c_, int ebytes = 2) { A = (const char*)A_; Bt = (const char*)Bt_; nM = M / BM; nN = N / BM; nwg = nM * nN; G = G_; c = c_; tstep = (size_t)BM * K * ebytes; sw_lo = 0; sw_hi = 0; }
    __device__ __forceinline__ bool next(int i, GUnit& u) const {
        const long L = (long)i * G + c; if (L >= nwg) return false;
        const int wgid = xcd_remap((int)L, nwg);
        const int nig = WGM * nN, gid = wgid / nig, fm = gid * WGM, gsz = (nM - fm) < WGM ? (nM - fm) : WGM;
        const int pm = fm + ((wgid % nig) % gsz), pn = (wgid % nig) / gsz;
        if (pn >= sw_lo && pn < sw_hi) { u.a = Bt + (size_t)pn * tstep; u.b = A + (size_t)pm * tstep; u.orow = pm; u.ocol = pn - sw_lo; u.aux = 1; }
        else { u.a = A + (size_t)pm * tstep; u.b = Bt + (size_t)pn * tstep; u.orow = pm * BM; u.ocol = pn * BM; u.aux = 0; }
        return true;
    }
    __device__ __forceinline__ unsigned arow_off(int, int) const { return 0u; }
};

constexpr int MAXU = 12;
struct MoeTab { int n; int e[MAXU], mb[MAXU], nt[MAXU]; int sb[NE + 1]; };
struct MoeSched {
    LAS const MoeTab* T; LAS const unsigned* ridx;
    const char* A; const char* W; size_t wstride_e, tstepB; int K; int arow_bytes;
    __device__ __forceinline__ bool next(int i, GUnit& u) const {
        const int n = __builtin_amdgcn_readfirstlane(T->n); if (i >= n) return false;
        const int e = __builtin_amdgcn_readfirstlane(T->e[i]), mb = __builtin_amdgcn_readfirstlane(T->mb[i]), nt = __builtin_amdgcn_readfirstlane(T->nt[i]);
        const int base = __builtin_amdgcn_readfirstlane(T->sb[e]);
        u.orow = base + mb * BM; u.ocol = nt; u.aux = e;
        u.a = A + (size_t)u.orow * arow_bytes;
        u.b = W + (size_t)e * wstride_e + (size_t)nt * tstepB; return true;
    }
    __device__ __forceinline__ unsigned arow_off(int i, int r) const { return ridx[i * 256 + r]; }
};
template <bool GATHER>
__device__ __forceinline__ void moe_tables(const Args& A, const Ctx& C, int l, int ntile_n, LAS MoeTab* T, LAS unsigned* ridx, int arow_bytes) {
    const unsigned* cnt = (const unsigned*)(A.ws + WS_CTL) + CW_CNT + l * 32 * CNT_STRIDE;
    LAS int* ust = (LAS int*)(T + 1);
    if (C.tid < 64) { int nb; const int ex = expert_block_prefix(cnt, C.tid, nb); if (C.tid <= NE) { T->sb[C.tid] = ex * 256; ust[C.tid] = ex * ntile_n; } }
    __syncthreads();
    if (C.tid < MAXU) { const int nwg = ust[NE]; const long L = (long)C.tid * C.G + C.bid;
        if (L < nwg) { const int w = xcd_remap((int)L, nwg); int e = 0; while (w >= ust[e + 1]) ++e;
            const int lu = w - ust[e]; T->e[C.tid] = e; T->mb[C.tid] = lu / ntile_n; T->nt[C.tid] = lu % ntile_n; } }
    if (C.tid == 0) { const int nwg = ust[NE]; int n = 0; while (n < MAXU && (long)n * C.G + C.bid < nwg) ++n; T->n = n; }
    __syncthreads();
    if constexpr (GATHER) {
        const int* ST = (const int*)(A.ws + WS_SLOTTOK); const int n = T->n;
        for (int i = C.tid; i < n * 256; i += NT) { const int ui = i >> 8, r = i & 255, e = T->e[ui], m0 = T->mb[ui] * 256, ce = (int)cnt[e * CNT_STRIDE];
            const int rr = (m0 + r < ce) ? m0 + r : ce - 1;
            ridx[i] = (unsigned)ST[(size_t)e * CAP + rr] * (unsigned)arow_bytes; }
        __syncthreads();
    }
}

struct EpiStore { bf16* O; int ldc; float scale_lo; int sig_from; bf16* VT; float sall = 1.0f; const float* rs = nullptr;
    __device__ __forceinline__ void operator()(const f32x4 (&acc)[2][2][4][2], const GUnit& u, int wr, int wc, int fr, int fq) const {
        const bool tr = u.aux != 0;
        const float sc = ((!tr && u.ocol < NQ) ? scale_lo : 1.0f) * sall; const bool sg = !tr && u.ocol >= sig_from;
        bf16* Ob = tr ? VT + (size_t)(u.orow * NH + u.ocol) * 65536 : O + (size_t)u.orow * ldc + u.ocol; const int ld = tr ? 256 : ldc;
        f32x4 cs[2][2];
#pragma unroll
        for (int bj = 0; bj < 2; ++bj) { const f32x4 one = (f32x4){1.f, 1.f, 1.f, 1.f};
            cs[bj][0] = (rs && tr) ? *(const f32x4*)(rs + u.orow * BM + bj * HALF + wc * 32 + 8 * fq) : one; cs[bj][1] = (rs && tr) ? *(const f32x4*)(rs + u.orow * BM + bj * HALF + wc * 32 + 8 * fq + 4) : one; }
#pragma unroll
        for (int ai = 0; ai < 2; ++ai)
#pragma unroll
            for (int m = 0; m < 4; ++m) { const int rl = ai * HALF + wr * 64 + m * 16 + fr; bf16* rowp = Ob + (size_t)rl * ld + wc * 32 + 8 * fq;
                const float scr = (rs && !tr) ? sc * rs[u.orow + rl] : sc;
#pragma unroll
                for (int bj = 0; bj < 2; ++bj) { f32x4 v0 = acc[ai][bj][m][0] * scr * cs[bj][0], v1 = acc[ai][bj][m][1] * scr * cs[bj][1];
                    if (sg) {
#pragma unroll
                        for (int q = 0; q < 4; ++q) { v0[q] = __builtin_amdgcn_rcpf(1.0f + __expf(-v0[q])); v1[q] = __builtin_amdgcn_rcpf(1.0f + __expf(-v1[q])); } }
                    u32x4 w; w.x = cvt_pk_bf16(v0[0], v0[1]); w.y = cvt_pk_bf16(v0[2], v0[3]); w.z = cvt_pk_bf16(v1[0], v1[1]); w.w = cvt_pk_bf16(v1[2], v1[3]);
                    *(u32x4*)(rowp + bj * HALF) = w; } }
    }
};
__device__ __forceinline__ u32x2 cvt8_fp8(f32x4 a, f32x4 b) { int lo = 0, hi = 0;
    lo = __builtin_amdgcn_cvt_pk_fp8_f32(a[0], a[1], lo, false); lo = __builtin_amdgcn_cvt_pk_fp8_f32(a[2], a[3], lo, true);
    hi = __builtin_amdgcn_cvt_pk_fp8_f32(b[0], b[1], hi, false); hi = __builtin_amdgcn_cvt_pk_fp8_f32(b[2], b[3], hi, true); return (u32x2){(unsigned)lo, (unsigned)hi}; }
struct EpiSwigluF8 { unsigned char* O; int ldc; float s;
    __device__ __forceinline__ void operator()(const f32x4 (&acc)[2][2][4][2], const GUnit& u, int wr, int wc, int fr, int fq) const {
        const int ocol = u.ocol * HALF;
#pragma unroll
        for (int ai = 0; ai < 2; ++ai)
#pragma unroll
            for (int m = 0; m < 4; ++m) { unsigned char* rowp = O + (size_t)(u.orow + ai * HALF + wr * 64 + m * 16 + fr) * ldc + ocol + wc * 32 + 8 * fq;
                f32x4 v0, v1;
#pragma unroll
                for (int q = 0; q < 4; ++q) { const float x0 = acc[ai][0][m][0][q] * s, x1 = acc[ai][0][m][1][q] * s;
                    v0[q] = x0 * __builtin_amdgcn_rcpf(1.0f + __expf(-x0)) * (acc[ai][1][m][0][q] * s); v1[q] = x1 * __builtin_amdgcn_rcpf(1.0f + __expf(-x1)) * (acc[ai][1][m][1][q] * s); }
                *(u32x2*)rowp = cvt8_fp8(v0, v1); }
    }
};
template <int MODE> struct EpiPair { bf16* O; int ldc; int plain_below; float sall = 1.0f; const float* rs = nullptr;
    __device__ __forceinline__ void operator()(const f32x4 (&acc)[2][2][4][2], const GUnit& u, int wr, int wc, int fr, int fq) const {
        if (MODE == 0 && u.ocol < plain_below) {
#pragma unroll
            for (int ai = 0; ai < 2; ++ai)
#pragma unroll
                for (int m = 0; m < 4; ++m) { const int rg = u.orow + ai * HALF + wr * 64 + m * 16 + fr; bf16* rowp = O + (size_t)rg * ldc + u.ocol + wc * 32 + 8 * fq;
                    const float scr = rs ? sall * rs[rg] : sall;
#pragma unroll
                    for (int bj = 0; bj < 2; ++bj) { const f32x4 v0 = acc[ai][bj][m][0] * scr, v1 = acc[ai][bj][m][1] * scr;
                        u32x4 w; w.x = cvt_pk_bf16(v0[0], v0[1]); w.y = cvt_pk_bf16(v0[2], v0[3]); w.z = cvt_pk_bf16(v1[0], v1[1]); w.w = cvt_pk_bf16(v1[2], v1[3]);
                        *(u32x4*)(rowp + bj * HALF) = w; } }
            return;
        }
        const int ocol = (MODE == 0) ? plain_below + (u.ocol - plain_below) / 2 : u.ocol * HALF;
#pragma unroll
        for (int ai = 0; ai < 2; ++ai)
#pragma unroll
            for (int m = 0; m < 4; ++m) { const int rg = u.orow + ai * HALF + wr * 64 + m * 16 + fr; bf16* rowp = O + (size_t)rg * ldc + ocol + wc * 32 + 8 * fq;
                const float scr = rs ? sall * rs[rg] : sall; const float sc2 = scr * scr;
                f32x4 v0, v1;
#pragma unroll
                for (int q = 0; q < 4; ++q) {
                    const float x0 = acc[ai][0][m][0][q], x1 = acc[ai][0][m][1][q];
                    const float g0 = (MODE == 1) ? x0 * __builtin_amdgcn_rcpf(1.0f + __expf(-x0)) : x0, g1 = (MODE == 1) ? x1 * __builtin_amdgcn_rcpf(1.0f + __expf(-x1)) : x1;
                    v0[q] = g0 * acc[ai][1][m][0][q] * sc2; v1[q] = g1 * acc[ai][1][m][1][q] * sc2; }
                u32x4 w; w.x = cvt_pk_bf16(v0[0], v0[1]); w.y = cvt_pk_bf16(v0[2], v0[3]); w.z = cvt_pk_bf16(v1[0], v1[1]); w.w = cvt_pk_bf16(v1[2], v1[3]);
                *(u32x4*)rowp = w; }
    }
};
struct EpiStoreTile { unsigned char* O; int ldc; float s;
    __device__ __forceinline__ void operator()(const f32x4 (&acc)[2][2][4][2], const GUnit& u, int wr, int wc, int fr, int fq) const {
#pragma unroll
        for (int ai = 0; ai < 2; ++ai)
#pragma unroll
            for (int m = 0; m < 4; ++m) { unsigned char* rowp = O + (size_t)(u.orow + ai * HALF + wr * 64 + m * 16 + fr) * ldc + u.ocol * BM + wc * 32 + 8 * fq;
#pragma unroll
                for (int bj = 0; bj < 2; ++bj) *(u32x2*)(rowp + bj * HALF) = cvt8_fp8(acc[ai][bj][m][0] * s, acc[ai][bj][m][1] * s); }
    }
};

__device__ __forceinline__ void transpose_item(const float* W, int ldw, int K, bf16* WT, int drow0, int k0, int n0, LAS float* scr, int lane) {
#pragma unroll
    for (int i = 0; i < 32; ++i) { const int kk = 2 * i + (lane >> 5); scr[kk * 33 + (lane & 31)] = W[(size_t)(k0 + kk) * ldw + n0 + (lane & 31)]; }
    asm volatile("s_waitcnt lgkmcnt(0)" ::: "memory");
    const int c = lane & 7;
#pragma unroll
    for (int j = 0; j < 4; ++j) { const int n = (lane >> 3) + 8 * j; const LAS float* s = scr + (8 * c) * 33 + n;
        u32x4 o; o.x = pk2(s[0 * 33], s[1 * 33]); o.y = pk2(s[2 * 33], s[3 * 33]); o.z = pk2(s[4 * 33], s[5 * 33]); o.w = pk2(s[6 * 33], s[7 * 33]);
        *(u32x4*)(WT + (size_t)(drow0 + n) * K + k0 + 8 * c) = o; }
    asm volatile("s_waitcnt lgkmcnt(0)" ::: "memory");
}
__device__ __forceinline__ void transpose_item_fp8(const float* W, int ldw, int K, unsigned char* WT8, int drow0, int k0, int n0, LAS float* scr, int lane, float sc) {
#pragma unroll
    for (int i = 0; i < 32; ++i) { const int kk = 2 * i + (lane >> 5); scr[kk * 33 + (lane & 31)] = W[(size_t)(k0 + kk) * ldw + n0 + (lane & 31)]; }
    asm volatile("s_waitcnt lgkmcnt(0)" ::: "memory");
    const int n = lane >> 1, half = lane & 1; const LAS float* sp = scr + (32 * half) * 33 + n;
    unsigned char* dst = WT8 + (size_t)(drow0 + n) * K + k0 + 32 * half;
#pragma unroll
    for (int c = 0; c < 2; ++c) { u32x4 o;
#pragma unroll
        for (int q = 0; q < 4; ++q) { int p = 0; const LAS float* s4 = sp + (16 * c + 4 * q) * 33;
            p = __builtin_amdgcn_cvt_pk_fp8_f32(s4[0] * sc, s4[33] * sc, p, false); p = __builtin_amdgcn_cvt_pk_fp8_f32(s4[66] * sc, s4[99] * sc, p, true); o[q] = (unsigned)p; }
        *(u32x4*)(dst + 16 * c) = o; }
    asm volatile("s_waitcnt lgkmcnt(0)" ::: "memory");
}
__device__ __forceinline__ void transpose_item_i8(const float* W, int ldw, int K, unsigned char* WT8, int drow0, int k0, int n0, LAS float* scr, int lane, float inv) {
#pragma unroll
    for (int i = 0; i < 32; ++i) { const int kk = 2 * i + (lane >> 5); scr[kk * 33 + (lane & 31)] = W[(size_t)(k0 + kk) * ldw + n0 + (lane & 31)]; }
    asm volatile("s_waitcnt lgkmcnt(0)" ::: "memory");
    const int n = lane >> 1, half = lane & 1; const LAS float* sp = scr + (32 * half) * 33 + n;
    unsigned char* dst = WT8 + (size_t)(drow0 + n) * K + k0 + 32 * half;
#pragma unroll
    for (int c = 0; c < 2; ++c) { u32x4 o;
#pragma unroll
        for (int q = 0; q < 4; ++q) { const LAS float* s4 = sp + (16 * c + 4 * q) * 33; o[q] = pack_i8((f32x4){s4[0] * inv, s4[33] * inv, s4[66] * inv, s4[99] * inv}); }
        *(u32x4*)(dst + 16 * c) = o; }
    asm volatile("s_waitcnt lgkmcnt(0)" ::: "memory");
}
__device__ __forceinline__ int pair_row(int n, int which) { return (n >> 7) * 256 + (n & 127) + which * 128; }
constexpr float HMR = 6.0f;
__device__ __forceinline__ void phase_cvt_mixer(const Args& A, const Ctx& C) {
    const int gw = C.bid * NW + C.wave, NGW = C.G * NW;
    unsigned* wmax = (unsigned*)(A.ws + WS_CTL) + CW_WMAX;
    for (int m8 = 0; m8 < 8; ++m8) {
        const float* W = m8 < 2 ? A.in[8] + (size_t)m8 * D * PROJ : m8 < 4 ? A.in[12] + (size_t)(m8 - 2) * D * PW : m8 < 6 ? A.in[11] + (size_t)(m8 - 4) * D * D : A.in[14] + (size_t)(m8 - 6) * D * D;
        const size_t n4 = (size_t)D * (m8 < 2 ? PROJ : m8 < 4 ? PW : D) / 4;
        float mx = 0.f;
        for (size_t i = (size_t)gw * 64 + C.lane; i < n4; i += (size_t)NGW * 64) { const f32x4 v = *(const f32x4*)(W + 4 * i); mx = fmaxf(mx, fmaxf(fmaxf(fabsf(v.x), fabsf(v.y)), fmaxf(fabsf(v.z), fabsf(v.w)))); }
        mx = wave_max_nn(mx);
        if (C.lane == 0 && mx > 0.f) atomicMax(wmax + m8 * CNT_STRIDE, __float_as_uint(mx));
    }
}
__device__ __forceinline__ void cvt_win_i8(const Args& A, const Ctx& C) {
    LAS float* scr = (LAS float*)(C.lds + 16384 + C.wave * 16384);
    const int gw = C.bid * NW + C.wave, NGW = C.G * NW;
    constexpr int I_IN = (D / 64) * (PW / 32);
    const unsigned* wmax = (const unsigned*)(A.ws + WS_CTL) + CW_WMAX;
    constexpr int I_OUT = (D / 64) * (D / 32);
    for (int it = gw; it < 4 * I_OUT; it += NGW) {
        const int m4 = it / I_OUT, kind = m4 >> 1, j = m4 & 1, r = it % I_OUT; const int kb = r / (D / 32), nb = r % (D / 32), n0 = nb * 32;
        const float inv = 127.0f / fmaxf(__uint_as_float(wmax[(4 + m4) * CNT_STRIDE]), 1.0e-30f);
        transpose_item_i8((kind == 0 ? A.in[11] : A.in[14]) + (size_t)j * D * D, D, D, A.ws + (kind == 0 ? WS_WAOUT : WS_WBOUT) + (size_t)j * D * D, n0, kb * 64, n0, scr, C.lane, inv); }
    for (int it = gw; it < 4 * I_IN; it += NGW) {
        const int m4 = it / I_IN, kind = m4 >> 1, j = m4 & 1, r = it % I_IN; const int kb = r / (PW / 32), nb = r % (PW / 32), n0 = nb * 32;
        const float inv = 127.0f / fmaxf(__uint_as_float(wmax[m4 * CNT_STRIDE]), 1.0e-30f);
        unsigned char* WT = A.ws + (kind == 0 ? WS_WAIN : WS_WBIN) + (size_t)j * PW * D;
        if (kind == 0) transpose_item_i8(A.in[8] + (size_t)j * D * PROJ, PROJ, D, WT, n0, kb * 64, n0, scr, C.lane, inv);
        else { const int drow = n0 < D ? n0 : (n0 < 2 * D ? D + pair_row(n0 - D, 0) : D + pair_row(n0 - 2 * D, 1));
            transpose_item_i8(A.in[12] + (size_t)j * D * PW, PW, D, WT, drow, kb * 64, n0, scr, C.lane, inv); }
    }
}
__device__ __forceinline__ void cvt_moe_items(const Args& A, const Ctx& C, int l, int it0, int end, int stride) {
    LAS float* scr = (LAS float*)(C.lds + 16384 + C.wave * 16384);
    unsigned char* WGU = A.ws + WS_WGU; unsigned char* WDN = A.ws + WS_WDN;
    for (int it = it0; it < end; it += stride) {
        const int e = it / CVT_PER; int r = it % CVT_PER;
        if (r < 2 * CVT_IG) { const int which = r / CVT_IG; r %= CVT_IG; const int kb = r / (DE / 32), nb = r % (DE / 32), n0 = nb * 32;
            transpose_item_fp8((which == 0 ? A.in[19] : A.in[20]) + ((size_t)l * NE + e) * D * DE, DE, D, WGU + (size_t)e * 2 * DE * D, pair_row(n0, which), kb * 64, n0, scr, C.lane, WSCALE); }
        else { r -= 2 * CVT_IG; const int kb = r / (D / 32), nb = r % (D / 32), n0 = nb * 32;
            transpose_item_fp8(A.in[21] + ((size_t)l * NE + e) * DE * D, D, DE, WDN + (size_t)e * D * DE, n0, kb * 64, n0, scr, C.lane, WSCALE); }
    }
}
__device__ __forceinline__ int cvt_idle(int nunits, int G) { const int rem = nunits % G; return rem ? G - rem : 0; }
__device__ __forceinline__ int cvt_t1(int l, int G) { const int n = cvt_idle((((l <= 2) ? NR : NL) / BM) * (PW / BM), G) * CVT_Q; return n < CVT_ITEMS ? n : CVT_ITEMS; }
__device__ __forceinline__ int cvt_t2(int l, int G) { const int n = cvt_t1(l, G) + cvt_idle((((l <= 1) ? NR : NL) / BM) * (D / BM), G) * CVT_Q; return n < CVT_ITEMS ? n : CVT_ITEMS; }
__device__ __forceinline__ void cvt_moe_tail(const Args& A, const Ctx& C, int l, int nunits, int base, int end) {
    const int rem = nunits % C.G;
    if (rem == 0 || C.bid < rem) return;
    const int first = base + (C.bid - rem) * CVT_Q; const int last = min(first + CVT_Q, end);
    cvt_moe_items(A, C, l, first + C.wave, last, NW);
}

__device__ __forceinline__ void phase_g1(const Args& A, const Ctx& C, int l) {
    const bool mls = (l & 1) == 0; const int j = l >> 1; const int nrows = (l <= 2) ? NR : NL;
    DenseSched S; S.init(A.ws + WS_H8, A.ws + (mls ? WS_WAIN : WS_WBIN) + (size_t)j * PW * D, nrows, PW, D, C.G, C.bid, 1);
    const float wsc = __uint_as_float(((const unsigned*)(A.ws + WS_CTL))[CW_WMAX + ((mls ? 0 : 2) + j) * CNT_STRIDE]) * (1.0f / 127.0f);
    const float* rs = (const float*)(A.ws + WS_RSC);
    if (mls) { S.sw_lo = 4; S.sw_hi = 8; EpiStore E{(bf16*)(A.ws + WS_PB), PW, 0.08838834764831845f, 2 * NQ + NV, (bf16*)(A.ws + WS_VT), wsc, rs}; gemm_phase<EpiStore, DenseSched, false, 2>(C.lds, D, S, E); }
    else { EpiPair<0> E{(bf16*)(A.ws + WS_PB), PW, D, wsc, rs}; gemm_phase<EpiPair<0>, DenseSched, false, 2>(C.lds, D, S, E); }
    cvt_moe_tail(A, C, l, S.nwg, 0, cvt_t1(l, C.G));
}
__device__ __forceinline__ void phase_g2(const Args& A, const Ctx& C, int l) {
    const bool mls = (l & 1) == 0; const int j = l >> 1; const int nrows = (l <= 1) ? NR : NL;
    DenseSched S; S.init(A.ws + WS_HM, A.ws + (mls ? WS_WAOUT : WS_WBOUT) + (size_t)j * D * D, nrows, D, D, C.G, C.bid, 1);
    const float wsc = __uint_as_float(((const unsigned*)(A.ws + WS_CTL))[CW_WMAX + (4 + (mls ? 0 : 2) + j) * CNT_STRIDE]) * (1.0f / 127.0f);
    EpiStore E{(bf16*)(A.ws + WS_HB), D, 1.0f, 1 << 30, nullptr, mls ? wsc * (HMR / 127.0f) : wsc, mls ? nullptr : (const float*)(A.ws + WS_RSC)}; gemm_phase<EpiStore, DenseSched, false, 2>(C.lds, D, S, E);
    cvt_moe_tail(A, C, l, S.nwg, cvt_t1(l, C.G), cvt_t2(l, C.G));
}
__device__ __forceinline__ void phase_m1(const Args& A, const Ctx& C, int l) {
    LAS MoeTab* T = (LAS MoeTab*)(C.lds + LDS_TAB); LAS unsigned* ridx = (LAS unsigned*)(C.lds + LDS_TAB + 1024);
    moe_tables<true>(A, C, l, 4, T, ridx, D);
    MoeSched S; S.T = T; S.ridx = ridx; S.A = (const char*)(A.ws + WS_H8); S.W = (const char*)(A.ws + WS_WGU); S.wstride_e = (size_t)2 * DE * D; S.tstepB = (size_t)BM * D; S.K = D; S.arow_bytes = 0;
    EpiSwigluF8 E{A.ws + WS_DC, DE, 1.0f / WSCALE}; gemm_phase<EpiSwigluF8, MoeSched, true, 1>(C.lds, D, S, E);
}
__device__ __forceinline__ void phase_m2(const Args& A, const Ctx& C, int l) {
    LAS MoeTab* T = (LAS MoeTab*)(C.lds + LDS_TAB); LAS unsigned* ridx = (LAS unsigned*)(C.lds + LDS_TAB + 1024);
    moe_tables<false>(A, C, l, 4, T, ridx, DE);
    MoeSched S; S.T = T; S.ridx = ridx; S.A = (const char*)(A.ws + WS_DC); S.W = (const char*)(A.ws + WS_WDN); S.wstride_e = (size_t)D * DE; S.tstepB = (size_t)BM * DE; S.K = DE; S.arow_bytes = DE;
    EpiStoreTile E{A.ws + WS_PB, D, YSCALE / WSCALE}; gemm_phase<EpiStoreTile, MoeSched, false, 1>(C.lds, DE, S, E);
}

typedef float f32x16 __attribute__((ext_vector_type(16)));
#define MFMA32(a, b, c) __builtin_amdgcn_mfma_f32_32x32x16_bf16((a), (b), (c), 0, 0, 0)
__device__ __forceinline__ bf16x8 pack8(float a0, float a1, float a2, float a3, float a4, float a5, float a6, float a7) {
    u32x4 p; p.x = cvt2(a0, a1); p.y = cvt2(a2, a3); p.z = cvt2(a4, a5); p.w = cvt2(a6, a7); return __builtin_bit_cast(bf16x8, p); }
__device__ __forceinline__ float bflo(unsigned w) { return __uint_as_float(w << 16); }
__device__ __forceinline__ float bfhi(unsigned w) { return __uint_as_float(w & 0xffff0000u); }
__device__ __forceinline__ int vt_tile(int b, int h, int blk) { return (blk == 0 ? 128 + b : b * 64 + blk - 1) * NH + h; }

__device__ __forceinline__ float wave_incl_scan(float v, int lane) {
#pragma unroll
    for (int o = 1; o < 64; o <<= 1) { const float t = __shfl_up(v, o); v += (lane >= o) ? t : 0.f; }
    return v;
}
__device__ __forceinline__ void block_gates(const Args& A, int row0, int h, LAS float* bf, LAS float* bb, LAS float* lif, LAS float* lib, int tid) {
    const float* GATE = (const float*)(A.ws + WS_GATE);
    if (tid < 256) { const float* g = GATE + (size_t)(row0 + tid) * 16; lif[tid] = g[0 + h]; bf[tid] = g[4 + h]; lib[tid] = g[8 + h]; bb[tid] = g[12 + h]; }
    __syncthreads();
    const int lane = tid & 63, wv = tid >> 6;
    if (wv == 0) { f32x4 x = *(LAS f32x4*)(bf + 4 * lane); x.y += x.x; x.z += x.y; x.w += x.z; const float tot = wave_incl_scan(x.w, lane); const float ex = tot - x.w;
        x.x += ex; x.y += ex; x.z += ex; x.w += ex; *(LAS f32x4*)(bf + 4 * lane) = x; }
    if (wv == 1) { f32x4 y = *(LAS f32x4*)(bb + 4 * (63 - lane)); y.z += y.w; y.y += y.z; y.x += y.y; const float tot = wave_incl_scan(y.x, lane); const float ex = tot - y.x;
        y.x += ex; y.y += ex; y.z += ex; y.w += ex; *(LAS f32x4*)(bb + 4 * (63 - lane)) = y; }
    __syncthreads();
}
__device__ __forceinline__ void phase_s1(const Args& A, const Ctx& C, int l) {
    LAS float* bf = (LAS float*)C.lds; LAS float* bb = bf + 256; LAS float* lif = bb + 256; LAS float* lib = lif + 256; LAS float* af = lib + 256; LAS float* ab = af + 256;
    constexpr int KP = 528;
    LAS unsigned char* KTf = C.lds + 8192; LAS unsigned char* KTb = KTf + 128 * KP;
    const bf16* P = (const bf16*)(A.ws + WS_PB); const bf16* VT = (const bf16*)(A.ws + WS_VT);
    bf16* DC = (bf16*)(A.ws + WS_DC); float* DN = (float*)(A.ws + WS_DN); float* BT = (float*)(A.ws + WS_BTOT);
    const int r = C.lane & 31, hh = C.lane >> 5, w = C.wave;
    for (int it = C.bid; it < BATCH * NH * (NBLK - 1) + 2 * BATCH * NH; it += C.G) {
        const bool isctx = it >= BATCH * NH * (NBLK - 1); const int ci_ = it - BATCH * NH * (NBLK - 1);
        const int bh = isctx ? (ci_ >> 1) : it / (NBLK - 1), blk = isctx ? 0 : 1 + it % (NBLK - 1), h = bh % NH, b = bh / NH; const int u = bh * NBLK + blk; const int row0 = blk_row0(b, blk);
        const int dlo = isctx ? (ci_ & 1) : 0, dhi = isctx ? (ci_ & 1) + 1 : 2;
        block_gates(A, row0, h, bf, bb, lif, lib, C.tid);
        if (C.tid < 256) { af[C.tid] = __expf(bf[255] - bf[C.tid] + lif[C.tid]); ab[C.tid] = __expf(bb[0] - bb[C.tid] + lib[C.tid]); }
        if (C.tid == 0) { BT[u * 2 + 0] = bf[255]; BT[u * 2 + 1] = bb[0]; }
        __syncthreads();
        { const int sp = C.tid >> 2, dq = C.tid & 3, s0 = 2 * sp;
          const bf16* k0 = P + (size_t)(row0 + s0) * PW + NQ + h * DQK + 32 * dq;
          const float f0 = af[s0], f1 = af[s0 + 1], g0 = ab[s0], g1 = ab[s0 + 1];
#pragma unroll
          for (int c = 0; c < 4; ++c) { const u32x4 x0 = *(const u32x4*)(k0 + 8 * c), x1 = *(const u32x4*)(k0 + PW + 8 * c);
#pragma unroll
              for (int q = 0; q < 4; ++q) { const int d = 32 * dq + 8 * c + 2 * q;
                  const float a0 = bflo(x0[q]), a1 = bfhi(x0[q]), c0 = bflo(x1[q]), c1 = bfhi(x1[q]);
                  *(LAS unsigned*)(KTf + d * KP + s0 * 2) = cvt2(a0 * f0, c0 * f1); *(LAS unsigned*)(KTf + (d + 1) * KP + s0 * 2) = cvt2(a1 * f0, c1 * f1);
                  *(LAS unsigned*)(KTb + d * KP + s0 * 2) = cvt2(a0 * g0, c0 * g1); *(LAS unsigned*)(KTb + (d + 1) * KP + s0 * 2) = cvt2(a1 * g0, c1 * g1); } } }
        __syncthreads();
        if (C.tid < 256) { const int dir = C.tid >> 7, d = C.tid & 127; LAS const unsigned* kr = (LAS const unsigned*)((dir ? KTb : KTf) + d * KP); float s = 0.f;
            for (int i = 0; i < 128; ++i) { const unsigned x = kr[i]; s += bflo(x) + bfhi(x); }
            DN[(size_t)(u * 2 + dir) * DQK + d] = s; }
        const bf16* vt = VT + (size_t)vt_tile(b, h, blk) * 65536 + (size_t)(32 * w + r) * 256 + 8 * hh;
        bf16x8 av[16];
#pragma unroll
        for (int ks = 0; ks < 16; ++ks) av[ks] = *(const bf16x8*)(vt + 16 * ks);
#pragma unroll 1
        for (int dir = dlo; dir < dhi; ++dir) {
            LAS const unsigned char* KT = dir ? KTb : KTf;
            f32x16 acc[4];
#pragma unroll
            for (int dt = 0; dt < 4; ++dt)
#pragma unroll
                for (int i = 0; i < 16; ++i) acc[dt][i] = 0.f;
#pragma unroll
            for (int ks = 0; ks < 16; ++ks) {
#pragma unroll
                for (int dt = 0; dt < 4; ++dt) { const bf16x8 b0 = *(const LAS bf16x8*)(KT + (dt * 32 + r) * KP + (16 * ks + 8 * hh) * 2); acc[dt] = MFMA32(av[ks], b0, acc[dt]); }
                if ((ks & 3) == 3) asm volatile("" ::: "memory"); }
            bf16* dc = DC + (size_t)(u * 2 + dir) * DQK * DV + (size_t)(32 * w + 4 * hh) * DQK + r;
#pragma unroll
            for (int g = 0; g < 4; ++g) { bf16* pf = dc + g * 8 * DQK; asm volatile("" : "+v"(pf));
#pragma unroll
                for (int q = 0; q < 4; ++q)
#pragma unroll
                    for (int dt = 0; dt < 4; ++dt) pf[q * DQK + dt * 32] = (bf16)f2bf(acc[dt][4 * g + q]); }
        }
        __syncthreads();
    }
}
__device__ __forceinline__ void phase_s2(const Args& A, const Ctx& C) {
    const bf16* __restrict__ DC = (const bf16*)(A.ws + WS_DC); const float* __restrict__ DN = (const float*)(A.ws + WS_DN); const float* __restrict__ BT = (const float*)(A.ws + WS_BTOT);
    bf16* __restrict__ CST = (bf16*)(A.ws + WS_CST); float* __restrict__ NST = (float*)(A.ws + WS_NST);
    constexpr int EL4 = DQK * DV / 4;
    for (int g = C.bid * NT + C.tid; g < BATCH * NH * 2 * EL4; g += C.G * NT) {
        const int e4 = (g % EL4) * 4, ch = g / EL4, dir = ch & 1, bh = ch >> 1;
        f32x4 st = (f32x4){0.f, 0.f, 0.f, 0.f};
#pragma unroll 13
        for (int idx = 0; idx < NBLK; ++idx) {
            const int blk = dir == 0 ? idx : (idx == 0 ? 0 : NBLK - idx); const int u = bh * NBLK + blk;
            const float dec = __expf(BT[u * 2 + dir]);
            const f32x4 dc = bf4(*(const u32x2*)(DC + (size_t)(u * 2 + dir) * DQK * DV + e4));
            u32x2 o; o.x = cvt2(st.x, st.y); o.y = cvt2(st.z, st.w);
            *(u32x2*)(CST + (size_t)(u * 2 + dir) * DQK * DV + e4) = o;
            st = st * dec + dc;
        }
    }
    for (int g = C.bid * NT + C.tid; g < BATCH * NH * 2 * DQK; g += C.G * NT) {
        const int d = g % DQK, ch = g / DQK, dir = ch & 1, bh = ch >> 1; float st = 0.f;
        for (int idx = 0; idx < NBLK; ++idx) {
            const int blk = dir == 0 ? idx : (idx == 0 ? 0 : NBLK - idx); const int u = bh * NBLK + blk;
            NST[(size_t)(u * 2 + dir) * DQK + d] = st; st = __expf(BT[u * 2 + dir]) * st + DN[(size_t)(u * 2 + dir) * DQK + d];
        }
    }
}
__device__ __forceinline__ void lds_barrier() { asm volatile("s_waitcnt lgkmcnt(0)" ::: "memory"); __builtin_amdgcn_s_barrier(); asm volatile("" ::: "memory"); }
__device__ __forceinline__ void phase_s3(const Args& A, const Ctx& C, int l) {
    const int jl = l >> 1; const bool ctx_out = (l == 0);
    LAS float* bf = (LAS float*)C.lds; LAS float* bb = bf + 256; LAS float* gf = bb + 256; LAS float* gb = gf + 256;
    LAS float* nf = gb + 256; LAS float* nb = nf + 128; LAS float* ssx = nb + 128;
    LAS float* cf = ssx + 256; LAS float* cb = cf + 256;
    constexpr int KP = 272, OP = 528, CHB = 16384, NCHB = 4;
    LAS unsigned char* Kimg = C.lds + 8192;
    LAS unsigned char* CH = Kimg + 256 * KP;
    LAS unsigned char* OUT = Kimg;
    static_assert(8192 + 256 * KP + NCHB * CHB <= LDS_TAB_END && 8192 + 256 * OP <= LDS_TAB_END, "S3 LDS map");
    const bf16* P = (const bf16*)(A.ws + WS_PB); const bf16* VT = (const bf16*)(A.ws + WS_VT); unsigned char* HM = A.ws + WS_HM;
    const bf16* CST = (const bf16*)(A.ws + WS_CST); const float* NST = (const float*)(A.ws + WS_NST);
    const float* hg = A.in[10] + (size_t)jl * NV;
    const int w = C.wave;
    bf16x8 qf[8]; u32x4 kr8[8]; f32x4 gl;
#define S3_SKIP(u_) (((u_) % NBLK) == 0 && !ctx_out)
#define S3_LOAD_IN(u_) do { const int u2_ = (u_); const int blk_ = u2_ % NBLK, bh_ = u2_ / NBLK, h_ = bh_ % NH, b_ = bh_ / NH; const int row0_ = blk_row0(b_, blk_); \
        int tq_ = threadIdx.x; asm volatile("" : "+v"(tq_)); const int lq_ = tq_ & 63; \
        { const bf16* qr_ = P + (size_t)(row0_ + 32 * w + (lq_ & 31)) * PW + h_ * DQK + 8 * (lq_ >> 5); \
          _Pragma("unroll") for (int kk = 0; kk < 8; ++kk) qf[kk] = *(const bf16x8*)(qr_ + 16 * kk); } \
        { const bf16* kr_ = P + (size_t)(row0_ + (tq_ >> 4)) * PW + NQ + h_ * DQK + 8 * (tq_ & 15); \
          _Pragma("unroll") for (int i = 0; i < 8; ++i) kr8[i] = *(const u32x4*)(kr_ + (size_t)(32 * i) * PW); } \
        if (tq_ < 256) { const float* g_ = (const float*)(A.ws + WS_GATE) + (size_t)(row0_ + tq_) * 16 + h_; gl = (f32x4){g_[0], g_[4], g_[8], g_[12]}; } \
        else { const int t2_ = tq_ - 256; gl = (f32x4){NST[(size_t)(u2_ * 2 + (t2_ >> 7)) * DQK + (t2_ & 127)], 0.f, 0.f, 0.f}; } } while (0)
    int u = C.bid;
    while (u < NUNIT && S3_SKIP(u)) u += C.G;
    if (u < NUNIT) S3_LOAD_IN(u);
    while (u < NUNIT) {
        const int blk = u % NBLK, bh = u / NBLK, h = bh % NH, b = bh / NH; const int row0 = blk_row0(b, blk);
        int un = u + C.G;
        while (un < NUNIT && S3_SKIP(un)) un += C.G;
        const bf16* vtile = VT + (size_t)vt_tile(b, h, blk) * 65536;
        const bf16* ctile = CST + (size_t)(u * 2) * DQK * DV;
#define S3_DMA(c_) do { const int cc_ = (c_); const bool isv_ = cc_ < 8; int ld_ = threadIdx.x & 63; asm volatile("" : "+v"(ld_)); \
                const unsigned dlp_ = (unsigned)(((ld_ & 3) ^ ((ld_ >> 4) & 3)) * 16), drow_ = (unsigned)(32 * w + (ld_ >> 2)); \
                const unsigned long long gp_ = (unsigned long long)(isv_ ? (const char*)vtile + 64 * cc_ : (const char*)ctile + (cc_ >= 12 ? 2 * DQK * DV : 0) + 64 * ((cc_ - 8) & 3)); \
                const char* gb_ = (const char*)(((unsigned long long)(unsigned)__builtin_amdgcn_readfirstlane((int)(unsigned)(gp_ >> 32)) << 32) | (unsigned)__builtin_amdgcn_readfirstlane((int)(unsigned)gp_)); \
                _Pragma("unroll") for (int jj = 0; jj < 2; ++jj) \
                    asm volatile("s_mov_b32 m0, %2\n\ts_nop 0\n\tglobal_load_lds_dwordx4 %0, %1" :: "v"(((drow_ + 16u * jj) << (isv_ ? 9 : 8)) + dlp_), "s"(gb_), "s"((unsigned)(size_t)CH + (unsigned)w * 2048u + (unsigned)((cc_ & 3) * CHB + jj * 1024)) : "memory"); } while (0)
        S3_DMA(0); S3_DMA(1); S3_DMA(2);
        { int tu = threadIdx.x; asm volatile("" : "+v"(tu));
          if (tu < 256) { gf[tu] = gl.x; bf[tu] = gl.y; gb[tu] = gl.z; bb[tu] = gl.w; } else nf[tu - 256] = gl.x;
          { const int pc = tu & 15, s0 = tu >> 4, ps0 = (s0 & ~12) | ((s0 & 4) << 1) | ((s0 & 8) >> 1);
#pragma unroll
            for (int i = 0; i < 8; ++i) *(LAS u32x4*)(Kimg + (ps0 + 32 * i) * KP + pc * 16) = kr8[i]; }
          lds_barrier();
          const int lane = tu & 63, wv = tu >> 6;
          if (wv == 0) { f32x4 x = *(LAS f32x4*)(bf + 4 * lane); x.y += x.x; x.z += x.y; x.w += x.z; const float tot = wave_incl_scan(x.w, lane); const float ex = tot - x.w;
              x.x += ex; x.y += ex; x.z += ex; x.w += ex; *(LAS f32x4*)(bf + 4 * lane) = x; }
          if (wv == 1) { f32x4 y = *(LAS f32x4*)(bb + 4 * (63 - lane)); y.z += y.w; y.y += y.z; y.x += y.y; const float tot = wave_incl_scan(y.x, lane); const float ex = tot - y.x;
              y.x += ex; y.y += ex; y.z += ex; y.w += ex; *(LAS f32x4*)(bb + 4 * (63 - lane)) = y; }
          lds_barrier();
          if (tu < 256) { const float a0 = gf[tu] - bf[tu], a1 = gb[tu] - bb[tu]; gf[tu] = a0; gb[tu] = a1; cf[tu] = __expf(bf[tu | 31] + a0); cb[tu] = __expf(bb[tu & ~31] + a1); }
          lds_barrier(); }
        {
            int lz = threadIdx.x & 63; asm volatile("" : "+v"(lz));
            const int r = lz & 31, hh = lz >> 5;
            const int jt = w;
            const float bfj = bf[32 * jt + r], bbj = bb[32 * jt + r];
            float qnf = 0.f, qnb = 0.f;
#pragma unroll
            for (int kk = 0; kk < 8; ++kk) { u32x4 qq = __builtin_bit_cast(u32x4, qf[kk]); asm volatile("" : "+v"(qq));
                const int d = 16 * kk + 8 * hh;
                const f32x4 n0 = *(const LAS f32x4*)(nf + d), n1 = *(const LAS f32x4*)(nf + d + 4), m0 = *(const LAS f32x4*)(nb + d), m1 = *(const LAS f32x4*)(nb + d + 4);
                qnf += (bflo(qq.x) * n0.x + bfhi(qq.x) * n0.y) + (bflo(qq.y) * n0.z + bfhi(qq.y) * n0.w) + (bflo(qq.z) * n1.x + bfhi(qq.z) * n1.y) + (bflo(qq.w) * n1.z + bfhi(qq.w) * n1.w);
                qnb += (bflo(qq.x) * m0.x + bfhi(qq.x) * m0.y) + (bflo(qq.y) * m0.z + bfhi(qq.y) * m0.w) + (bflo(qq.z) * m1.x + bfhi(qq.z) * m1.y) + (bflo(qq.w) * m1.z + bfhi(qq.w) * m1.w);
                if (kk & 1) asm volatile("" ::: "memory"); }
            qnf += __shfl_xor(qnf, 32); qnb += __shfl_xor(qnb, 32);
            float denf = 0.f, denb = 0.f;
#pragma unroll 1
            for (int kt = 0; kt < 8; ++kt) {
                f32x16 c;
#pragma unroll
                for (int i = 0; i < 16; ++i) c[i] = 0.f;
#pragma unroll
                for (int kk = 0; kk < 8; ++kk) { const bf16x8 a = *(const LAS bf16x8*)(Kimg + (kt * 32 + r) * KP + (16 * kk + 8 * hh) * 2); c = MFMA32(a, qf[kk], c); }
                if (kt == jt) {
#pragma unroll
                    for (int g = 0; g < 4; ++g) { const int sl0 = 16 * (g >> 1) + 8 * hh + 4 * (g & 1);
                        const f32x4 g4f = *(const LAS f32x4*)(gf + kt * 32 + sl0), g4b = *(const LAS f32x4*)(gb + kt * 32 + sl0);
#pragma unroll
                        for (int q = 0; q < 4; ++q) { const int sl = sl0 + q; const float cv = c[4 * g + q];
                            denf += cv * __expf((sl <= r) ? bfj + g4f[q] : -1.0e30f); denb += cv * __expf((sl >= r) ? bbj + g4b[q] : -1.0e30f); } }
                } else {
                    LAS const float* cx = (kt < jt ? cf : cb) + kt * 32 + 8 * hh; float sm = 0.f;
#pragma unroll
                    for (int g = 0; g < 4; ++g) { const f32x4 c4 = *(const LAS f32x4*)(cx + 16 * (g >> 1) + 4 * (g & 1)); sm += (c[4 * g] * c4.x + c[4 * g + 1] * c4.y) + (c[4 * g + 2] * c4.z + c[4 * g + 3] * c4.w); }
                    if (kt < jt) denf += sm * __expf(bfj - bf[kt * 32 + 31]); else denb += sm * __expf(bbj - bb[kt * 32]);
                }
            }
            denf += __shfl_xor(denf, 32); denb += __shfl_xor(denb, 32);
            const float ebf = __expf(bfj), ebb = __expf(bbj);
            denf += ebf * qnf; denb += ebb * qnb;
            const float rf = 1.0f / fmaxf(fabsf(denf), 1.0f), rb = 1.0f / fmaxf(fabsf(denb), 1.0f);
            const float scf = ebf * rf, scb = ebb * rb;
            unsigned wdg[8];
#pragma unroll
            for (int g = 0; g < 4; ++g) { const int sl0 = 16 * (g >> 1) + 8 * hh + 4 * (g & 1);
                const f32x4 g4f = *(const LAS f32x4*)(gf + jt * 32 + sl0), g4b = *(const LAS f32x4*)(gb + jt * 32 + sl0);
                float wv[4];
#pragma unroll
                for (int q = 0; q < 4; ++q) { const int sl = sl0 + q; wv[q] = rf * __expf((sl <= r) ? bfj + g4f[q] : -1.0e30f) + rb * __expf((sl >= r) ? bbj + g4b[q] : -1.0e30f); }
                wdg[2 * g] = cvt2(wv[0], wv[1]); wdg[2 * g + 1] = cvt2(wv[2], wv[3]); }
            f32x16 acc[8];
#pragma unroll
            for (int et = 0; et < 8; ++et)
#pragma unroll
                for (int i = 0; i < 16; ++i) acc[et][i] = 0.f;
            asm volatile("s_waitcnt vmcnt(0)" ::: "memory");
            const int swz = (r >> 2) & 3;
#pragma unroll 1
            for (int ci = 0; ci < 8; ++ci) {
                if (ci) asm volatile("s_waitcnt vmcnt(4)" ::: "memory");
                lds_barrier();
                S3_DMA(ci + 3);
                LAS const unsigned char* CHc = CH + (ci & 3) * CHB;
                { const int kt = ci;
                        f32x16 c;
#pragma unroll
                        for (int i = 0; i < 16; ++i) c[i] = 0.f;
#pragma unroll
                        for (int kk = 0; kk < 8; ++kk) { const bf16x8 a = *(const LAS bf16x8*)(Kimg + (kt * 32 + r) * KP + (16 * kk + 8 * hh) * 2); c = MFMA32(a, qf[kk], c); }
                        float p[16];
                        if (kt == jt) {
#pragma unroll
                            for (int i = 0; i < 8; ++i) { p[2 * i] = c[2 * i] * bflo(wdg[i]); p[2 * i + 1] = c[2 * i + 1] * bfhi(wdg[i]); }
                        } else {
                            LAS const float* cx = (kt < jt ? cf : cb) + kt * 32 + 8 * hh;
                            const float rw = (kt < jt) ? rf * __expf(bfj - bf[kt * 32 + 31]) : rb * __expf(bbj - bb[kt * 32]);
#pragma unroll
                            for (int g = 0; g < 4; ++g) { const f32x4 c4 = *(const LAS f32x4*)(cx + 16 * (g >> 1) + 4 * (g & 1));
                                p[4 * g] = c[4 * g] * (c4.x * rw); p[4 * g + 1] = c[4 * g + 1] * (c4.y * rw); p[4 * g + 2] = c[4 * g + 2] * (c4.z * rw); p[4 * g + 3] = c[4 * g + 3] * (c4.w * rw); }
                        }
                        const bf16x8 pa0 = pack8(p[0], p[1], p[2], p[3], p[4], p[5], p[6], p[7]), pa1 = pack8(p[8], p[9], p[10], p[11], p[12], p[13], p[14], p[15]);
#pragma unroll
                        for (int et = 0; et < 8; ++et) { LAS const unsigned char* vb = CHc + (et * 32 + r) * 64;
                            const bf16x8 a0 = *(const LAS bf16x8*)(vb + ((hh ^ swz) << 4)), a1 = *(const LAS bf16x8*)(vb + (((2 + hh) ^ swz) << 4));
                            acc[et] = MFMA32(a0, pa0, acc[et]); acc[et] = MFMA32(a1, pa1, acc[et]);
                            if (et & 1) asm volatile("" ::: "memory"); }
                }
            }
#pragma unroll
            for (int ci = 8; ci < 16; ++ci) {
                if (ci <= 13) asm volatile("s_waitcnt vmcnt(4)" ::: "memory"); else if (ci == 14) asm volatile("s_waitcnt vmcnt(2)" ::: "memory"); else asm volatile("s_waitcnt vmcnt(0)" ::: "memory");
                lds_barrier();
                if (ci + 3 < 16) S3_DMA(ci + 3);
                LAS const unsigned char* CHc = CH + (ci & 3) * CHB;
                {
                    const int dir = (ci - 8) >> 2, dq = (ci - 8) & 3;
                    const float sc = dir ? scb : scf;
#pragma unroll
                    for (int k2 = 0; k2 < 2; ++k2) { const u32x4 qq = __builtin_bit_cast(u32x4, qf[2 * dq + k2]);
                        const bf16x8 qs = pack8(bflo(qq.x) * sc, bfhi(qq.x) * sc, bflo(qq.y) * sc, bfhi(qq.y) * sc, bflo(qq.z) * sc, bfhi(qq.z) * sc, bflo(qq.w) * sc, bfhi(qq.w) * sc);
#pragma unroll
                        for (int et = 0; et < 8; ++et) { const bf16x8 a = *(const LAS bf16x8*)(CHc + (et * 32 + r) * 64 + (((2 * k2 + hh) ^ swz) << 4)); acc[et] = MFMA32(a, qs, acc[et]);
                            if ((et & 3) == 3) asm volatile("" ::: "memory"); } }
                }
            }
            u32x4 ov[16]; f32x4 g0, g1;
            { int tz = threadIdx.x & 63; asm volatile("" : "+v"(tz)); const int pc = tz & 31, lr0 = tz >> 5;
              g0 = *(const f32x4*)(hg + h * DV + 8 * pc); g1 = *(const f32x4*)(hg + h * DV + 8 * pc + 4);
#pragma unroll
              for (int i = 0; i < 16; ++i) ov[i] = *(const u32x4*)(P + (size_t)(row0 + 32 * w + lr0 + 2 * i) * PW + 2 * NQ + NV + h * DV + 8 * pc); }
            float ss = 0.f;
#pragma unroll
            for (int et = 0; et < 8; ++et)
#pragma unroll
                for (int i = 0; i < 16; ++i) ss += acc[et][i] * acc[et][i];
            ss += __shfl_xor(ss, 32);
            const float rs = 1.0f / sqrtf(ss * (1.0f / DV) + EPS);
            lds_barrier();
            { LAS unsigned char* ob = OUT + (w * 32 + r) * OP + (4 * hh) * 2;
#pragma unroll
              for (int et = 0; et < 8; ++et)
#pragma unroll
                  for (int g = 0; g < 4; ++g) { u32x2 o; o.x = cvt2(acc[et][4 * g + 0] * rs, acc[et][4 * g + 1] * rs); o.y = cvt2(acc[et][4 * g + 2] * rs, acc[et][4 * g + 3] * rs);
                      *(LAS u32x2*)(ob + (et * 32 + 8 * g) * 2) = o; } }
            asm volatile("s_waitcnt lgkmcnt(0)" ::: "memory");
            S3_LOAD_IN(un < NUNIT ? un : u);
            { int tz = threadIdx.x & 63; asm volatile("" : "+v"(tz)); const int pc = tz & 31, lr0 = tz >> 5;
#pragma unroll
              for (int i = 0; i < 16; ++i) { const int lr = 32 * w + lr0 + 2 * i; const int grow = row0 + lr;
                  const u32x4 hv = *(const LAS u32x4*)(OUT + lr * OP + pc * 16);
                  const f32x4 o0 = (f32x4){bflo(hv.x) * g0.x * bflo(ov[i].x), bfhi(hv.x) * g0.y * bfhi(ov[i].x), bflo(hv.y) * g0.z * bflo(ov[i].y), bfhi(hv.y) * g0.w * bfhi(ov[i].y)};
                  const f32x4 o1 = (f32x4){bflo(hv.z) * g1.x * bflo(ov[i].z), bfhi(hv.z) * g1.y * bfhi(ov[i].z), bflo(hv.w) * g1.z * bflo(ov[i].w), bfhi(hv.w) * g1.w * bfhi(ov[i].w)};
                  *(u32x2*)(HM + (size_t)grow * D + h * DV + 8 * pc) = (u32x2){pack_i8(o0 * (127.0f / HMR)), pack_i8(o1 * (127.0f / HMR))};
                  if ((i & 3) == 3) asm volatile("" ::: "memory"); } }
        }
#undef S3_DMA
        lds_barrier();
        u = un;
    }
#undef S3_LOAD_IN
#undef S3_SKIP
}

#define XB_TMO      128
#define XB_XCNT(j)  (256  + 64 * (j))
#define XB_XSUB(j)  (1280 + 64 * (j))
#define XB_XGEN(j)  (2304 + 64 * (j))
#define XB_TOP      3328
#define XB_TOPGEN   3392
#define XCD_BAR_WORDS 3456
#define XB_SPIN_CAP (1u << 18)

__device__ __forceinline__ unsigned xb_ld(unsigned* p)              { return __hip_atomic_load(p, __ATOMIC_RELAXED, __HIP_MEMORY_SCOPE_AGENT); }
__device__ __forceinline__ unsigned xb_add(unsigned* p, unsigned v) { return __hip_atomic_fetch_add(p, v, __ATOMIC_RELAXED, __HIP_MEMORY_SCOPE_AGENT); }
__device__ __forceinline__ unsigned xb_xcc_id() { return (unsigned)__builtin_amdgcn_s_getreg((3 << 11) | 20) & 0xFu; }
#define XB_SPIN(cond, bar) do { unsigned _sp = 0; while (cond) { __builtin_amdgcn_s_sleep(1); \
    if ((++_sp & 255u) == 0u) { if (xb_ld(&(bar)[XB_TMO])) break; if (_sp > XB_SPIN_CAP) { atomicAdd(&(bar)[XB_TMO], 1u); break; } } } } while (0)

struct XcdBarrier {
    unsigned* bar; unsigned x;
    volatile LAS unsigned* st;
};

__device__ __forceinline__ XcdBarrier xcd_barrier_post(unsigned* bar, volatile LAS unsigned* st) {
    XcdBarrier b; b.bar = bar; b.x = xb_xcc_id(); b.st = st;
    if (threadIdx.x == 0) (void)xb_add(&bar[XB_XCNT(b.x)], 1u);
    return b;
}
__device__ __forceinline__ void xcd_barrier_complete(unsigned* bar, unsigned x, unsigned& nloc, unsigned& nx) {
    const unsigned G = gridDim.x * gridDim.y * gridDim.z;
    unsigned sum, cnt, mine, sp = 0u;
    for (;;) {
        sum = 0u; cnt = 0u; mine = 0u;
#pragma unroll
        for (unsigned j = 0; j < 16; ++j) { const unsigned c = xb_ld(&bar[XB_XCNT(j)]); sum += c; cnt += (c > 0u) ? 1u : 0u; mine = (j == x) ? c : mine; }
        if (sum == G) break;
        __builtin_amdgcn_s_sleep(1);
        if ((++sp & 255u) == 0u) { if (xb_ld(&bar[XB_TMO])) break; if (sp > XB_SPIN_CAP) { atomicAdd(&bar[XB_TMO], 1u); break; } }
    }
    nloc = mine > 0u ? mine : 1u; nx = cnt > 0u ? cnt : 1u;
}

__device__ __forceinline__ void xcd_barrier(const XcdBarrier& b) {
    asm volatile("s_waitcnt vmcnt(0)" ::: "memory");
    __syncthreads();
    if (threadIdx.x == 0) {
        unsigned* bar = b.bar;
        __builtin_amdgcn_s_waitcnt(0);
        unsigned nloc = b.st[0], nx = b.st[1];
        if (nloc == 0u) { xcd_barrier_complete(bar, b.x, nloc, nx); b.st[0] = nloc; b.st[1] = nx; }
        const unsigned old = xb_add(&bar[XB_XSUB(b.x)], 1u);
        const unsigned gen = old / nloc;
        if (old + 1u == (gen + 1u) * nloc) {
            __builtin_amdgcn_fence(__ATOMIC_RELEASE, "agent");
            asm volatile("s_waitcnt vmcnt(0)" ::: "memory");
            const unsigned og = xb_add(&bar[XB_TOP], 1u);
            const unsigned tg = og / nx;
            if (og + 1u == (tg + 1u) * nx) xb_add(&bar[XB_TOPGEN], 1u);
            else XB_SPIN(xb_ld(&bar[XB_TOPGEN]) == tg, bar);
            __builtin_amdgcn_fence(__ATOMIC_ACQUIRE, "agent");
            xb_add(&bar[XB_XGEN(b.x)], 1u);
            asm volatile("s_waitcnt vmcnt(0)" ::: "memory");
        } else {
            XB_SPIN(xb_ld(&bar[XB_XGEN(b.x)]) == gen, bar);
            __builtin_amdgcn_fence(__ATOMIC_ACQUIRE, "agent");
            asm volatile("s_waitcnt vmcnt(0)" ::: "memory");
        }
    }
    __syncthreads();
}


constexpr int LDS_BYTES = 152 * 1024;
constexpr int CW_BAR = 16384;
static_assert((CW_BAR + XCD_BAR_WORDS) * 4 <= (int)CTL_BYTES, "ctl");
#ifndef MK_MULTI
#define MK_MULTI 0
#endif
#define IN(p) (lo <= (p) && (p) < hi)
#define SEAM(p) do { if ((p) + 1 < hi) { XcdBarrier b_; b_.bar = (unsigned*)(load_args().ws + WS_CTL) + CW_BAR; b_.x = xb_xcc_id(); b_.st = (volatile LAS unsigned*)(C.lds + LDS_BYTES - 16); xcd_barrier(b_); } } while (0)
#define CAS __attribute__((address_space(4)))
__device__ __forceinline__ Args load_args() {
#if defined(__HIP_DEVICE_COMPILE__)
    const CAS Args* p = (const CAS Args*)__builtin_amdgcn_kernarg_segment_ptr(); asm volatile("" : "+s"(p));
    Args a; for (int i = 0; i < 22; ++i) a.in[i] = p->in[i]; a.out = p->out; a.ws = p->ws; a.lo = p->lo; a.hi = p->hi; return a;
#else
    return Args{};
#endif
}
__device__ __forceinline__ Ctx fresh(const Ctx& C) { Ctx R = C; int tz = threadIdx.x; asm volatile("" : "+v"(tz)); R.tid = tz; R.lane = tz & 63; return R; }
template <int L> __device__ __forceinline__ void layer_phases(const Args& args, const Ctx& C, int bar, int lo, int hi) {
    constexpr int pb = 16 * L;
    if (IN(pb + 1)) { phase_r1(load_args(), fresh(C), L); SEAM(pb + 1); }
    if (IN(pb + 2)) { phase_g1(load_args(), fresh(C), L); SEAM(pb + 2); }
    if constexpr ((L & 1) == 0) {
        if (IN(pb + 3)) { phase_s1(load_args(), fresh(C), L); SEAM(pb + 3); }
        if (IN(pb + 4)) { phase_s2(load_args(), fresh(C)); SEAM(pb + 4); }
        if (IN(pb + 5)) { phase_s3(load_args(), fresh(C), L); SEAM(pb + 5); }
    } else {
        if (IN(pb + 3)) { phase_conv(load_args(), fresh(C), L); SEAM(pb + 3); }
    }
    if (IN(pb + 6)) { phase_g2(load_args(), fresh(C), L); SEAM(pb + 6); }
    if (IN(pb + 7)) { phase_r2(load_args(), fresh(C), L); SEAM(pb + 7); }
    if (IN(pb + 8)) { phase_m1(load_args(), fresh(C), L); SEAM(pb + 8); }
    if (IN(pb + 9)) { phase_m2(load_args(), fresh(C), L); SEAM(pb + 9); }
}
__global__ void __launch_bounds__(NT, 2) fwd_kernel(Args args) {
    extern __shared__ __attribute__((aligned(16))) unsigned char lds_raw[];
    Ctx C; C.lds = (LAS unsigned char*)lds_raw; C.tid = threadIdx.x; C.lane = C.tid & 63; C.wave = __builtin_amdgcn_readfirstlane(C.tid >> 6); C.G = gridDim.x; C.bid = blockIdx.x; C.a = &args;
    const int lo = args.lo, hi = args.hi;
    volatile LAS unsigned* xbw = (volatile LAS unsigned*)(C.lds + LDS_BYTES - 16);
    if (C.tid < 4) xbw[C.tid] = 0u;
    __syncthreads();
    if (hi - lo > 1) (void)xcd_barrier_post((unsigned*)(args.ws + WS_CTL) + CW_BAR, xbw);
    const int bar = 0; (void)bar;
    if (IN(0)) { phase_mod(load_args(), fresh(C)); __syncthreads(); phase_cvt_mixer(load_args(), fresh(C)); SEAM(0); }
    layer_phases<0>(args, C, bar, lo, hi);
    layer_phases<1>(args, C, bar, lo, hi);
    layer_phases<2>(args, C, bar, lo, hi);
    layer_phases<3>(args, C, bar, lo, hi);
    if (IN(64)) phase_final(load_args(), fresh(C));
}
#undef IN
#undef SEAM

extern "C" void kernel_launch(void* const* d_in, const int* in_sizes, int n_in, void* d_out, int out_size, void* d_ws, size_t ws_size, hipStream_t stream) {
    static int grid = 0;
    if (grid == 0) {
        if (n_in != 22 || out_size != NL * D || ws_size < WS_END) { fprintf(stderr, "kernel_launch: unexpected shapes (n_in %d out %d ws %zu)\n", n_in, out_size, ws_size); grid = -1; return; }
        int dev = 0, cus = 0, per_cu = 0;
        if (hipGetDevice(&dev) != hipSuccess || hipDeviceGetAttribute(&cus, hipDeviceAttributeMultiprocessorCount, dev) != hipSuccess) { grid = -1; return; }
        if (hipFuncSetAttribute((const void*)fwd_kernel, hipFuncAttributeMaxDynamicSharedMemorySize, LDS_BYTES) != hipSuccess) { grid = -1; return; }
        if (hipOccupancyMaxActiveBlocksPerMultiprocessor(&per_cu, (const void*)fwd_kernel, NT, LDS_BYTES) != hipSuccess || per_cu < 1) { fprintf(stderr, "kernel_launch: occupancy query says %d\n", per_cu); }
        (void)hipGetLastError();
        grid = cus;
    }
    if (grid < 0) return;
    (void)hipMemsetAsync((char*)d_ws + WS_CTL, 0, CTL_BYTES, stream);
    Args a{};
    for (int i = 0; i < 22; ++i) a.in[i] = (const float*)d_in[i];
    a.out = (float*)d_out; a.ws = (unsigned char*)d_ws;
#if MK_MULTI
    int phases[64]; int np = 0;
    phases[np++] = 0;
    for (int l = 0; l < DEPTH; ++l) { const int pb = 16 * l; phases[np++] = pb + 1; phases[np++] = pb + 2; phases[np++] = pb + 3;
        if ((l & 1) == 0) { phases[np++] = pb + 4; phases[np++] = pb + 5; }
        phases[np++] = pb + 6; phases[np++] = pb + 7; phases[np++] = pb + 8; phases[np++] = pb + 9; }
    phases[np++] = 64;
    for (int i = 0; i < np; ++i) { a.lo = phases[i]; a.hi = phases[i] + 1; hipLaunchKernelGGL(fwd_kernel, dim3(grid), dim3(NT), LDS_BYTES, stream, a); }
#else
    a.lo = 0; a.hi = 65;
    hipLaunchKernelGGL(fwd_kernel, dim3(grid), dim3(NT), LDS_BYTES, stream, a);
#ifdef PROBE_PHASES
    { const int pp[] = {PROBE_PHASES};
      for (int rep = 0; rep < PROBE_REPS; ++rep) for (unsigned i = 0; i < sizeof(pp) / sizeof(pp[0]); ++i) { a.lo = pp[i]; a.hi = pp[i] + 1; hipLaunchKernelGGL(fwd_kernel, dim3(grid), dim3(NT), LDS_BYTES, stream, a); } }
#endif
#endif
}
```

```cpp
#include <hip/hip_runtime.h>
#include <cstdio>
#include <cstdint>

#define LAS __attribute__((address_space(3)))
typedef unsigned short bf16;
typedef float f32x4 __attribute__((ext_vector_type(4)));
typedef unsigned u32x4 __attribute__((ext_vector_type(4)));
typedef unsigned u32x2 __attribute__((ext_vector_type(2)));
typedef int i32x4r __attribute__((ext_vector_type(4)));

constexpr int D = 1024, BATCH = 2, SEQ = 16384, DEPTH = 4, CTXL = 256;
constexpr int NL = BATCH * SEQ, NCX = BATCH * CTXL, NR = NL + NCX;
constexpr int NH = 4, DQK = 128, DV = 256, NQ = 512, NV = 1024, PROJ = 3088, PW = 3072;
constexpr int NGRP = 4, EPG = 8, NE = 32, DE = 512;
constexpr int NBLK = 65;
constexpr int NUNIT = BATCH * NH * NBLK;
constexpr int CAP = NR;
constexpr int YROWS = 74752;
constexpr float EPS = 1e-6f;
constexpr float WSCALE = 32.0f;
constexpr float YSCALE = 4.0f;
constexpr int NT = 512, NW = 8;
constexpr int LDS_TAB_END = 152 * 1024 - 16;

constexpr size_t MiB = 1u << 20;
constexpr size_t WS_CTL = 0, CTL_BYTES = 1 * MiB;
constexpr size_t WS_MOD = 1 * MiB;
constexpr size_t WS_GATE = 2 * MiB;
constexpr size_t WS_TOKSLOT = 5 * MiB;
constexpr size_t WS_TOKW = 6 * MiB;
constexpr size_t WS_SLOTTOK = 7 * MiB;
constexpr size_t WS_DN = 12 * MiB;
constexpr size_t WS_NST = 13 * MiB;
constexpr size_t WS_BTOT = 14 * MiB;
constexpr size_t WS_RSC = 15 * MiB;
constexpr size_t WS_LAT = 16 * MiB;
constexpr size_t WS_HB = 146 * MiB;
constexpr size_t WS_PB = 211 * MiB;
constexpr size_t WS_HM = 406 * MiB;
constexpr size_t WS_DC = 471 * MiB;
constexpr size_t WS_CST = 601 * MiB;
constexpr size_t WS_VT = 666 * MiB;
constexpr size_t WS_WAIN = 731 * MiB;
constexpr size_t WS_WBIN = 743 * MiB;
constexpr size_t WS_WAOUT = 755 * MiB;
constexpr size_t WS_WBOUT = 759 * MiB;
constexpr size_t WS_WGU = 763 * MiB;
constexpr size_t WS_WDN = 827 * MiB;
constexpr size_t WS_H8 = 843 * MiB;
constexpr size_t WS_END = 880 * MiB;
constexpr int CW_WMAX = 256;
constexpr int CW_CNT = 1024, CNT_STRIDE = 64;

struct Args { const float* in[22]; float* out; unsigned char* ws; int lo, hi; };

typedef short bf16x8 __attribute__((ext_vector_type(8)));
typedef float f32x2 __attribute__((ext_vector_type(2)));
typedef __bf16 bf16x2_t __attribute__((ext_vector_type(2)));
__device__ __forceinline__ unsigned cvt2(float lo, float hi) { const f32x2 v = {lo, hi}; return __builtin_bit_cast(unsigned, __builtin_convertvector(v, bf16x2_t)); }
__device__ __forceinline__ float bf2f(bf16 v) { return __uint_as_float(((unsigned)v) << 16); }
__device__ __forceinline__ unsigned f2bf(float f) { unsigned u = __float_as_uint(f); return (u + 0x7fffu + ((u >> 16) & 1u)) >> 16; }
__device__ __forceinline__ unsigned pk2(float lo, float hi) { return f2bf(lo) | (f2bf(hi) << 16); }
template <int CTRL, int ROWMASK> __device__ __forceinline__ float dpp_mov(float x) { return __int_as_float(__builtin_amdgcn_update_dpp(0, __float_as_int(x), CTRL, ROWMASK, 0xf, false)); }
__device__ __forceinline__ float wave_sum(float v) {
    v += dpp_mov<0xB1, 0xf>(v); v += dpp_mov<0x4E, 0xf>(v); v += dpp_mov<0x141, 0xf>(v); v += dpp_mov<0x140, 0xf>(v);
    v += dpp_mov<0x142, 0xA>(v); v += dpp_mov<0x143, 0xC>(v);
    return __int_as_float(__builtin_amdgcn_readlane(__float_as_int(v), 63));
}
__device__ __forceinline__ float wave_max_nn(float v) {
    v = fmaxf(v, dpp_mov<0xB1, 0xf>(v)); v = fmaxf(v, dpp_mov<0x4E, 0xf>(v)); v = fmaxf(v, dpp_mov<0x141, 0xf>(v)); v = fmaxf(v, dpp_mov<0x140, 0xf>(v));
    v = fmaxf(v, dpp_mov<0x142, 0xA>(v)); v = fmaxf(v, dpp_mov<0x143, 0xC>(v));
    return __int_as_float(__builtin_amdgcn_readlane(__float_as_int(v), 63));
}
__device__ __forceinline__ unsigned pack_i8(f32x4 v) {
    const int a = (int)__builtin_rintf(fminf(fmaxf(v.x, -127.f), 127.f)), b = (int)__builtin_rintf(fminf(fmaxf(v.y, -127.f), 127.f)), c = (int)__builtin_rintf(fminf(fmaxf(v.z, -127.f), 127.f)), d = (int)__builtin_rintf(fminf(fmaxf(v.w, -127.f), 127.f));
    return (unsigned)(a & 255) | ((unsigned)(b & 255) << 8) | ((unsigned)(c & 255) << 16) | ((unsigned)d << 24);
}
__device__ __forceinline__ float sigmoidf_(float x) { return 1.f / (1.f + __expf(-x)); }
__device__ __forceinline__ float siluf_(float x) { return x / (1.f + __expf(-x)); }
__device__ __forceinline__ float logsigmoidf_(float x) { return fminf(x, 0.f) - log1pf(__expf(-fabsf(x))); }
__device__ __forceinline__ int blk_row0(int b, int blk) { return blk == 0 ? NL + b * CTXL : b * SEQ + (blk - 1) * 256; }
__device__ __forceinline__ int mod_vec_of_row(int row) { return row < NL ? row / SEQ : 2; }

struct Ctx {
    LAS unsigned char* lds; int tid, lane, wave, G, bid;
    const Args* a;
};

__device__ __forceinline__ int expert_block_prefix(const unsigned* cnt, int lane, int& nb) {
    nb = lane < NE ? ((int)cnt[lane * CNT_STRIDE] + 255) / 256 : 0; int v = nb;
#pragma unroll
    for (int o = 1; o < 64; o <<= 1) { const int t = __shfl_up(v, o); v += (lane >= o) ? t : 0; }
    return v - nb;
}
__device__ __forceinline__ void slot_bases(const Args& A, int l, LAS int* sb, int tid) {
    if (tid < 64) { int nb; const int ex = expert_block_prefix((const unsigned*)(A.ws + WS_CTL) + CW_CNT + l * 32 * CNT_STRIDE, tid, nb); if (tid <= NE) sb[tid] = ex * 256; }
    __syncthreads();
}

__device__ __forceinline__ void phase_mod(const Args& A, const Ctx& C) {
    LAS float* sc = (LAS float*)C.lds;
    LAS float* red = sc + 3072;
    const float* c = A.in[1]; const float* cc = A.in[3];
    for (int i = C.tid; i < 3072; i += NT) { const float v = i < 2048 ? c[i] : cc[i - 2048]; sc[i] = siluf_(v); }
    __syncthreads();
    float* MOD = (float*)(A.ws + WS_MOD);
    for (int u = C.bid; u < DEPTH * 96; u += C.G) {
        const int l = u / 96, cg = u % 96, col = cg * 64 + C.lane;
        const float* w = A.in[4] + (size_t)l * D * 6 * D + col;
        float a0 = 0.f, a1 = 0.f, a2 = 0.f;
#pragma unroll 32
        for (int k = C.wave * 128; k < C.wave * 128 + 128; ++k) { const float wv = w[(size_t)k * 6 * D]; a0 += sc[k] * wv; a1 += sc[1024 + k] * wv; a2 += sc[2048 + k] * wv; }
        red[(C.wave * 3 + 0) * 64 + C.lane] = a0; red[(C.wave * 3 + 1) * 64 + C.lane] = a1; red[(C.wave * 3 + 2) * 64 + C.lane] = a2;
        __syncthreads();
        if (C.tid < 192) { const int v = C.tid / 64, ln = C.tid % 64; float s = 0.f;
            for (int w8 = 0; w8 < 8; ++w8) s += red[(w8 * 3 + v) * 64 + ln];
            MOD[(size_t)(l * 3 + v) * 6 * D + cg * 64 + ln] = s + A.in[5][(size_t)l * 6 * D + cg * 64 + ln]; }
        __syncthreads();
    }
}

__device__ __forceinline__ void load_row_f32(const float* p, int lane, f32x4 (&v)[4]) {
#pragma unroll
    for (int j = 0; j < 4; ++j) v[j] = *(const f32x4*)(p + 4 * lane + 256 * j);
}
__device__ __forceinline__ void load_row_bf16(const bf16* p, int lane, f32x4 (&v)[4]) {
#pragma unroll
    for (int j = 0; j < 4; ++j) { const u32x2 w = *(const u32x2*)(p + 4 * lane + 256 * j);
        v[j] = (f32x4){__uint_as_float(w.x << 16), __uint_as_float(w.x & 0xffff0000u), __uint_as_float(w.y << 16), __uint_as_float(w.y & 0xffff0000u)}; }
}
__device__ __forceinline__ void store_row_bf16(bf16* p, int lane, const f32x4 (&v)[4]) {
#pragma unroll
    for (int j = 0; j < 4; ++j) { u32x2 w; w.x = pk2(v[j].x, v[j].y); w.y = pk2(v[j].z, v[j].w); *(u32x2*)(p + 4 * lane + 256 * j) = w; }
}
constexpr int CVT_IG = (D / 64) * (DE / 32), CVT_ID = (DE / 64) * (D / 32), CVT_PER = 2 * CVT_IG + CVT_ID, CVT_ITEMS = NE * CVT_PER;
constexpr int CVT_Q = 24;
__device__ __forceinline__ void cvt_moe_items(const Args& A, const Ctx& C, int l, int it0, int end, int stride);
__device__ __forceinline__ void cvt_win_i8(const Args& A, const Ctx& C);
__device__ __forceinline__ int cvt_t2(int l, int G);
struct RowVec { f32x4 a[4], s[4], g[4]; };
__device__ __forceinline__ void load_rowvec(RowVec& R, const float* ng, const float* sh, const float* sc, const float* gt, int lane) {
    f32x4 n[4], c[4]; load_row_f32(ng, lane, n); load_row_f32(sc, lane, c); load_row_f32(sh, lane, R.s); if (gt) load_row_f32(gt, lane, R.g);
#pragma unroll
    for (int q = 0; q < 4; ++q) R.a[q] = n[q] * (1.f + c[q]);
}
__device__ __forceinline__ void load_row_bf16raw(const bf16* p, int lane, u32x2 (&v)[4]) {
#pragma unroll
    for (int j = 0; j < 4; ++j) v[j] = *(const u32x2*)(p + 4 * lane + 256 * j);
}
__device__ __forceinline__ void store_row_fp8(unsigned char* p, int lane, const f32x4 (&v)[4]) {
#pragma unroll
    for (int j = 0; j < 4; ++j) { int w = 0; w = __builtin_amdgcn_cvt_pk_fp8_f32(v[j].x, v[j].y, w, false); w = __builtin_amdgcn_cvt_pk_fp8_f32(v[j].z, v[j].w, w, true); *(unsigned*)(p + 4 * lane + 256 * j) = (unsigned)w; }
}
__device__ __forceinline__ void load_row_fp8raw(const unsigned char* p, int lane, unsigned (&v)[4]) {
#pragma unroll
    for (int j = 0; j < 4; ++j) v[j] = *(const unsigned*)(p + 4 * lane + 256 * j);
}
__device__ __forceinline__ f32x4 fp8x4(unsigned w) { const f32x2 lo = __builtin_amdgcn_cvt_pk_f32_fp8((int)w, false), hi = __builtin_amdgcn_cvt_pk_f32_fp8((int)w, true); return (f32x4){lo.x, lo.y, hi.x, hi.y}; }
__device__ __forceinline__ f32x4 bf4(u32x2 w) { return (f32x4){__uint_as_float(w.x << 16), __uint_as_float(w.x & 0xffff0000u), __uint_as_float(w.y << 16), __uint_as_float(w.y & 0xffff0000u)}; }
__device__ __forceinline__ float row_rstd(const f32x4 (&v)[4]) {
    float s = 0.f;
#pragma unroll
    for (int j = 0; j < 4; ++j) s += (v[j].x * v[j].x + v[j].y * v[j].y) + (v[j].z * v[j].z + v[j].w * v[j].w);
    return 1.0f / sqrtf(wave_sum(s) * (1.f / D) + EPS);
}

__device__ __forceinline__ void phase_r1(const Args& A, const Ctx& C, int l) {
    LAS int* sb = (LAS int*)C.lds;
    constexpr int GWP = 2064;
    LAS unsigned char* GW = C.lds + 256;
    LAS unsigned char* HS = C.lds + 256 + 16 * GWP + C.wave * 2 * GWP;
    const bool mls = (l & 1) == 0; const int j = l >> 1;
    if (l == 0) { cvt_win_i8(A, C); __syncthreads(); }
    if (l > 0) slot_bases(A, l - 1, sb, C.tid);
    if (mls) { const float* w = A.in[8] + (size_t)j * D * PROJ + PW;
        f32x4 t[2][4];
#pragma unroll
        for (int jj = 0; jj < 2; ++jj)
#pragma unroll
            for (int q = 0; q < 4; ++q) t[jj][q] = *(const f32x4*)(w + (size_t)(C.tid + NT * jj) * PROJ + 4 * q);
#pragma unroll
        for (int jj = 0; jj < 2; ++jj)
#pragma unroll
            for (int q = 0; q < 4; ++q) { const int k = C.tid + NT * jj;
#pragma unroll
                for (int c = 0; c < 4; ++c) *(LAS unsigned short*)(GW + (4 * q + c) * GWP + k * 2) = (unsigned short)f2bf(t[jj][q][c]); }
        __syncthreads(); }
    const int nrows = (l <= 2) ? NR : NL;
    bf16* LAT = (bf16*)(A.ws + WS_LAT); unsigned char* HI8 = A.ws + WS_H8; float* RSC = (float*)(A.ws + WS_RSC); float* GATE = (float*)(A.ws + WS_GATE);
    const float* MOD = (const float*)(A.ws + WS_MOD); const unsigned char* Y8 = A.ws + WS_PB;
    const int* TS = (const int*)(A.ws + WS_TOKSLOT); const float* TW = (const float*)(A.ws + WS_TOKW);
    const int rpw = (((nrows + C.G - 1) / C.G) + 1) & ~1; const int wrow0 = C.bid * rpw; const int wend = min(wrow0 + rpw, nrows);
    for (int sa = wrow0; sa < wend;) {
        const int mvi = mod_vec_of_row(sa); const int bnd = mvi == 0 ? SEQ : (mvi == 1 ? NL : NR); const int sbnd = min(wend, bnd);
        RowVec RV; { const float* mv = MOD + (size_t)(l * 3 + mvi) * 6 * D;
            load_rowvec(RV, A.in[6] + (size_t)(l * 2 + 0) * D, mv + 0 * D, mv + 1 * D, l > 0 ? MOD + (size_t)((l - 1) * 3 + mvi) * 6 * D + 5 * D : nullptr, C.lane); }
        const int rlast = sbnd - 2; const int rfirst = sa + 2 * C.wave;
        i32x4r ts1 = (i32x4r){0, 0, 0, 0}, ts2 = ts1; f32x4 tw1 = (f32x4){0.f, 0.f, 0.f, 0.f}, tw2 = tw1;
        u32x2 nla[4], nlb[4]; unsigned nya0[4], nya1[4], nyb0[4], nyb1[4]; f32x4 nxa[4], nxb[4];
#define R1_FETCH(r_, ts_) do { const int fa_ = (r_), fb_ = fa_ + 1; \
            if (l == 0) { load_row_f32(fa_ < NL ? A.in[0] + (size_t)fa_ * D : A.in[2] + (size_t)(fa_ - NL) * D, C.lane, nxa); load_row_f32(fb_ < NL ? A.in[0] + (size_t)fb_ * D : A.in[2] + (size_t)(fb_ - NL) * D, C.lane, nxb); } \
            else { load_row_bf16raw(LAT + (size_t)fa_ * D, C.lane, nla); load_row_bf16raw(LAT + (size_t)fb_ * D, C.lane, nlb); \
                load_row_fp8raw(Y8 + (size_t)(sb[(ts_).x >> 20] + ((ts_).x & 0xfffff)) * D, C.lane, nya0); load_row_fp8raw(Y8 + (size_t)(sb[(ts_).y >> 20] + ((ts_).y & 0xfffff)) * D, C.lane, nya1); \
                load_row_fp8raw(Y8 + (size_t)(sb[(ts_).z >> 20] + ((ts_).z & 0xfffff)) * D, C.lane, nyb0); load_row_fp8raw(Y8 + (size_t)(sb[(ts_).w >> 20] + ((ts_).w & 0xfffff)) * D, C.lane, nyb1); } } while (0)
        if (l > 0) { const int r0 = min(rfirst, rlast), r1 = min(rfirst + 2 * NW, rlast);
            ts1 = *(const i32x4r*)(TS + r0 * 2); tw1 = *(const f32x4*)(TW + r0 * 2); ts2 = *(const i32x4r*)(TS + r1 * 2); tw2 = *(const f32x4*)(TW + r1 * 2); }
        R1_FETCH(min(rfirst, rlast), ts1);
        for (int ra = rfirst; ra < sbnd; ra += 2 * NW) {
            const bool hasb = true; const int rb = ra + 1;
            f32x4 va[4], vb[4];
            if (l == 0) {
#pragma unroll
                for (int q = 0; q < 4; ++q) { va[q] = nxa[q]; vb[q] = nxb[q]; }
                R1_FETCH(min(ra + 2 * NW, rlast), ts1);
            } else {
                u32x2 la[4], lb[4]; unsigned ya0[4], ya1[4], yb0[4], yb1[4];
#pragma unroll
                for (int q = 0; q < 4; ++q) { la[q] = nla[q]; lb[q] = nlb[q]; ya0[q] = nya0[q]; ya1[q] = nya1[q]; yb0[q] = nyb0[q]; yb1[q] = nyb1[q]; }
                const f32x4 twc = tw1;
                ts1 = ts2; tw1 = tw2;
                { const int r2 = min(ra + 4 * NW, rlast); ts2 = *(const i32x4r*)(TS + r2 * 2); tw2 = *(const f32x4*)(TW + r2 * 2); }
                R1_FETCH(min(ra + 2 * NW, rlast), ts1);
                const float wa0 = twc.x * (1.0f / YSCALE), wa1 = twc.y * (1.0f / YSCALE), wb0 = twc.z * (1.0f / YSCALE), wb1 = twc.w * (1.0f / YSCALE);
#pragma unroll
                for (int q = 0; q < 4; ++q) { va[q] = bf4(la[q]) + RV.g[q] * (fp8x4(ya0[q]) * wa0 + fp8x4(ya1[q]) * wa1); vb[q] = bf4(lb[q]) + RV.g[q] * (fp8x4(yb0[q]) * wb0 + fp8x4(yb1[q]) * wb1); }
            }
            store_row_bf16(LAT + (size_t)ra * D, C.lane, va); if (hasb) store_row_bf16(LAT + (size_t)rb * D, C.lane, vb);
            const float rra = row_rstd(va), rrb = row_rstd(vb);
            f32x4 ha[4], hb[4];
#pragma unroll
            for (int q = 0; q < 4; ++q) { ha[q] = (va[q] * rra) * RV.a[q] + RV.s[q]; hb[q] = (vb[q] * rrb) * RV.a[q] + RV.s[q]; }
            { float ma = 0.f, mb = 0.f;
#pragma unroll
              for (int q = 0; q < 4; ++q) { ma = fmaxf(ma, fmaxf(fmaxf(fabsf(ha[q].x), fabsf(ha[q].y)), fmaxf(fabsf(ha[q].z), fabsf(ha[q].w)))); mb = fmaxf(mb, fmaxf(fmaxf(fabsf(hb[q].x), fabsf(hb[q].y)), fmaxf(fabsf(hb[q].z), fabsf(hb[q].w)))); }
              ma = fmaxf(wave_max_nn(ma), 1.0e-20f); mb = fmaxf(wave_max_nn(mb), 1.0e-20f);
              const float ia = 127.0f / ma, ib = 127.0f / mb;
#pragma unroll
              for (int q = 0; q < 4; ++q) { *(unsigned*)(HI8 + (size_t)ra * D + 4 * C.lane + 256 * q) = pack_i8(ha[q] * ia); *(unsigned*)(HI8 + (size_t)rb * D + 4 * C.lane + 256 * q) = pack_i8(hb[q] * ib); }
              if (C.lane == 0) { RSC[ra] = ma * (1.0f / 127.0f); RSC[rb] = mb * (1.0f / 127.0f); } }
            if (mls) {
#pragma unroll
                for (int q = 0; q < 4; ++q) { *(LAS u32x2*)(HS + (4 * C.lane + 256 * q) * 2) = (u32x2){cvt2(ha[q].x, ha[q].y), cvt2(ha[q].z, ha[q].w)}; *(LAS u32x2*)(HS + GWP + (4 * C.lane + 256 * q) * 2) = (u32x2){cvt2(hb[q].x, hb[q].y), cvt2(hb[q].z, hb[q].w)}; }
                asm volatile("s_waitcnt lgkmcnt(0)" ::: "memory");
                f32x4 gacc = (f32x4){0.f, 0.f, 0.f, 0.f};
                { const int gi = C.lane & 15, kg = C.lane >> 4; LAS const unsigned char* ap = HS + (gi & 1) * GWP + kg * 16; LAS const unsigned char* bp = GW + gi * GWP + kg * 16;
#pragma unroll 8
                  for (int s2 = 0; s2 < 32; ++s2) { bf16x8 av = *(const LAS bf16x8*)(ap + s2 * 64); const bf16x8 bv = *(const LAS bf16x8*)(bp + s2 * 64);
                      if (gi >= 2) av = (bf16x8){0, 0, 0, 0, 0, 0, 0, 0};
                      gacc = __builtin_amdgcn_mfma_f32_16x16x32_bf16(av, bv, gacc, 0, 0, 0); } }
                float ga = gacc[0], gb = gacc[1];
                if (C.lane < 16) {
                    const float bgt = A.in[9][j * 16 + C.lane]; const int gtype = C.lane >> 2;
                    ga += bgt; gb += bgt;
                    GATE[(size_t)ra * 16 + C.lane] = (gtype & 1) ? logsigmoidf_(ga) : 15.0f * tanhf(ga * (1.0f / 15.0f));
                    if (hasb) GATE[(size_t)rb * 16 + C.lane] = (gtype & 1) ? logsigmoidf_(gb) : 15.0f * tanhf(gb * (1.0f / 15.0f)); }
            }
        }
#undef R1_FETCH
        sa = sbnd;
    }
}

__device__ __forceinline__ void phase_r2(const Args& A, const Ctx& C, int l) {
    constexpr int WP = 2064;
    LAS unsigned char* RWB = C.lds;
    LAS float* WL = (LAS float*)(C.lds + 48 * WP);
    LAS unsigned* hist = (LAS unsigned*)(WL + 8 * 16 * 48);
    LAS unsigned* gbase = hist + 32;
    constexpr int RCAP = 144;
    LAS int* rec = (LAS int*)(gbase + 32);
    static_assert(48 * WP + 8 * 16 * 48 * 4 + 256 + RCAP * 16 <= LDS_TAB_END, "R2 LDS map");
    cvt_moe_items(A, C, l, cvt_t2(l, C.G) + C.bid * NW + C.wave, CVT_ITEMS, C.G * NW);
    __syncthreads();
    { const float* wg = A.in[15] + (size_t)l * D * NGRP; const float* wr = A.in[17] + (size_t)l * D * NE;
      { const int kp = C.tid; const f32x4 x0 = *(const f32x4*)(wg + (size_t)(2 * kp) * 4), x1 = *(const f32x4*)(wg + (size_t)(2 * kp + 1) * 4);
        *(LAS unsigned*)(RWB + 0 * WP + kp * 4) = cvt2(x0.x, x1.x); *(LAS unsigned*)(RWB + 1 * WP + kp * 4) = cvt2(x0.y, x1.y);
        *(LAS unsigned*)(RWB + 2 * WP + kp * 4) = cvt2(x0.z, x1.z); *(LAS unsigned*)(RWB + 3 * WP + kp * 4) = cvt2(x0.w, x1.w); }
      f32x4 t0[8], t1[8];
#pragma unroll
      for (int jj = 0; jj < 8; ++jj) { const int it = C.tid + NT * jj, kp = it >> 3, cg = it & 7; t0[jj] = *(const f32x4*)(wr + (size_t)(2 * kp) * NE + 4 * cg); t1[jj] = *(const f32x4*)(wr + (size_t)(2 * kp + 1) * NE + 4 * cg); }
#pragma unroll
      for (int jj = 0; jj < 8; ++jj) { const int it = C.tid + NT * jj, kp = it >> 3, c0 = 4 + 4 * (it & 7);
          *(LAS unsigned*)(RWB + (c0 + 0) * WP + kp * 4) = cvt2(t0[jj].x, t1[jj].x); *(LAS unsigned*)(RWB + (c0 + 1) * WP + kp * 4) = cvt2(t0[jj].y, t1[jj].y);
          *(LAS unsigned*)(RWB + (c0 + 2) * WP + kp * 4) = cvt2(t0[jj].z, t1[jj].z); *(LAS unsigned*)(RWB + (c0 + 3) * WP + kp * 4) = cvt2(t0[jj].w, t1[jj].w); }
      for (int i = C.tid; i < 12 * 512; i += NT) *(LAS unsigned*)(RWB + (36 + i / 512) * WP + (i % 512) * 4) = 0u; }
    const int nrows = (l <= 1) ? NR : NL;
    bf16* LAT = (bf16*)(A.ws + WS_LAT); bf16* H = (bf16*)(A.ws + WS_HB); unsigned char* H8 = A.ws + WS_H8;
    const float* MOD = (const float*)(A.ws + WS_MOD);
    unsigned* cnt = (unsigned*)(A.ws + WS_CTL) + CW_CNT + l * 32 * CNT_STRIDE;
    int* TS = (int*)(A.ws + WS_TOKSLOT); float* TW = (float*)(A.ws + WS_TOKW); int* ST = (int*)(A.ws + WS_SLOTTOK);
    const int rpw = (((nrows + C.G - 1) / C.G) + 1) & ~1; const int wrow0 = C.bid * rpw; const int wend0 = min(wrow0 + rpw, nrows);
    const float* bg = A.in[16] + l * NGRP; const float* br = A.in[18] + l * NE;
    for (int cb = wrow0; cb < wend0; cb += RCAP) {
        const int wend = min(cb + RCAP, wend0);
        if (C.tid < 32) hist[C.tid] = 0u;
        for (int sa = cb; sa < wend;) {
            const int mvi = mod_vec_of_row(sa); const int bnd = mvi == 0 ? SEQ : (mvi == 1 ? NL : NR); const int sbnd = min(wend, bnd);
            RowVec RV; { const float* mv = MOD + (size_t)(l * 3 + mvi) * 6 * D; load_rowvec(RV, A.in[6] + (size_t)(l * 2 + 1) * D, mv + 3 * D, mv + 4 * D, mv + 2 * D, C.lane); }
            const int rlast = sbnd - 2;
            u32x2 la[4], lb[4];
            { const int r0 = min(sa + 2 * C.wave, rlast); load_row_bf16raw(LAT + (size_t)r0 * D, C.lane, la); load_row_bf16raw(LAT + (size_t)(r0 + 1) * D, C.lane, lb); }
            for (int ra = sa + 2 * C.wave; ra < sbnd; ra += 2 * NW) {
                const int rb = ra + 1;
                u32x2 lan[4], lbn[4];
                { const int r1 = min(ra + 2 * NW, rlast); load_row_bf16raw(LAT + (size_t)r1 * D, C.lane, lan); load_row_bf16raw(LAT + (size_t)(r1 + 1) * D, C.lane, lbn); }
                f32x4 va[4], vb[4];
#pragma unroll
                for (int q = 0; q < 4; ++q) { va[q] = bf4(la[q]); vb[q] = bf4(lb[q]); }
                const float rra = row_rstd(va), rrb = row_rstd(vb);
                f32x4 ha[4], hb[4];
#pragma unroll
                for (int q = 0; q < 4; ++q) { ha[q] = (va[q] * rra) * RV.a[q] + RV.s[q]; hb[q] = (vb[q] * rrb) * RV.a[q] + RV.s[q]; }
                store_row_bf16(H + (size_t)ra * D, C.lane, ha); store_row_bf16(H + (size_t)rb * D, C.lane, hb);
                store_row_fp8(H8 + (size_t)ra * D, C.lane, ha); store_row_fp8(H8 + (size_t)rb * D, C.lane, hb);
#pragma unroll
                for (int q = 0; q < 4; ++q) { la[q] = lan[q]; lb[q] = lbn[q]; }
            }
            sa = sbnd;
        }
        __syncthreads();
        const int fr = C.lane & 15, fq = C.lane >> 4;
        for (int t = C.wave; t * 16 < wend - cb; t += NW) {
            const int trow = min(cb + 16 * t + fr, wend - 1);
            const bf16* hp = H + (size_t)trow * D + 8 * fq;
            f32x4 acc[3];
#pragma unroll
            for (int ct = 0; ct < 3; ++ct) acc[ct] = (f32x4){0.f, 0.f, 0.f, 0.f};
#pragma unroll 1
            for (int kb = 0; kb < 4; ++kb) {
                bf16x8 av[8];
#pragma unroll
                for (int k8 = 0; k8 < 8; ++k8) av[k8] = *(const bf16x8*)(hp + 32 * (8 * kb + k8));
#pragma unroll
                for (int k8 = 0; k8 < 8; ++k8)
#pragma unroll
                    for (int ct = 0; ct < 3; ++ct) { const bf16x8 bv = *(const LAS bf16x8*)(RWB + (ct * 16 + fr) * WP + (32 * (8 * kb + k8) + 8 * fq) * 2);
                        acc[ct] = __builtin_amdgcn_mfma_f32_16x16x32_bf16(av[k8], bv, acc[ct], 0, 0, 0); }
            }
            LAS float* wl = WL + C.wave * 16 * 48;
#pragma unroll
            for (int ct = 0; ct < 3; ++ct)
#pragma unroll
                for (int jq = 0; jq < 4; ++jq) wl[(4 * fq + jq) * 48 + ct * 16 + fr] = acc[ct][jq];
            asm volatile("s_waitcnt lgkmcnt(0)" ::: "memory");
            const int row = cb + 16 * t + C.lane;
            if (C.lane < 16 && row < wend) {
                LAS const float* wm = wl + C.lane * 48;
                float lg[36];
#pragma unroll
                for (int c = 0; c < 36; ++c) lg[c] = wm[c];
                float gl[4]; int grp = 0; float gm = -3.0e38f;
#pragma unroll
                for (int c = 0; c < 4; ++c) { gl[c] = lg[c] + bg[c]; if (gl[c] > gm) { gm = gl[c]; grp = c; } }
                float gs = 0.f;
#pragma unroll
                for (int c = 0; c < 4; ++c) gs += __expf(gl[c] - gm);
                const float pgrp = 1.0f / gs;
                float rl[8];
#pragma unroll
                for (int i = 0; i < 8; ++i) { float tt = 0.f;
#pragma unroll
                    for (int g = 0; g < 4; ++g) tt = (g == grp) ? lg[4 + g * 8 + i] : tt;
                    rl[i] = tt + br[grp * 8 + i]; }
                int i0 = 0; float m0 = rl[0];
#pragma unroll
                for (int i = 1; i < 8; ++i) if (rl[i] > m0) { m0 = rl[i]; i0 = i; }
                int i1 = -1; float m1 = -3.0e38f;
#pragma unroll
                for (int i = 0; i < 8; ++i) if (i != i0 && rl[i] > m1) { m1 = rl[i]; i1 = i; }
                const float p0 = 1.0f, p1 = __expf(m1 - m0);
                const float w0 = pgrp * p0 / (p0 + p1), w1 = pgrp * p1 / (p0 + p1);
                const int e0 = grp * 8 + i0, e1 = grp * 8 + i1;
                const unsigned q0 = __hip_atomic_fetch_add(hist + e0, 1u, __ATOMIC_RELAXED, __HIP_MEMORY_SCOPE_WORKGROUP), q1 = __hip_atomic_fetch_add(hist + e1, 1u, __ATOMIC_RELAXED, __HIP_MEMORY_SCOPE_WORKGROUP);
                const int li = row - cb;
                rec[li * 4 + 0] = e0 | (e1 << 8); rec[li * 4 + 1] = (int)q0; rec[li * 4 + 2] = (int)q1;
                TW[row * 2 + 0] = w0; TW[row * 2 + 1] = w1;
            }
        }
        __syncthreads();
        if (C.tid < 32) gbase[C.tid] = hist[C.tid] ? atomicAdd(cnt + C.tid * CNT_STRIDE, hist[C.tid]) : 0u;
        __syncthreads();
        for (int i = C.tid; i < wend - cb; i += NT) { const int row = cb + i; const int ee = rec[i * 4], e0 = ee & 255, e1 = ee >> 8;
            const unsigned q0 = gbase[e0] + (unsigned)rec[i * 4 + 1], q1 = gbase[e1] + (unsigned)rec[i * 4 + 2];
            ST[(size_t)e0 * CAP + q0] = row; ST[(size_t)e1 * CAP + q1] = row;
            TS[row * 2 + 0] = (e0 << 20) | (int)q0; TS[row * 2 + 1] = (e1 << 20) | (int)q1; }
        __syncthreads();
    }
}

__device__ __forceinline__ void phase_final(const Args& A, const Ctx& C) {
    LAS int* sb = (LAS int*)C.lds;
    slot_bases(A, 3, sb, C.tid);
    const bf16* LAT = (const bf16*)(A.ws + WS_LAT); const unsigned char* Y8 = A.ws + WS_PB;
    const int* TS = (const int*)(A.ws + WS_TOKSLOT); const float* TW = (const float*)(A.ws + WS_TOKW);
    const float* MOD = (const float*)(A.ws + WS_MOD);
    f32x4 fg[4]; load_row_f32(A.in[7], C.lane, fg);
    const int rpw = (((NL + C.G - 1) / C.G) + 1) & ~1; const int wrow0 = C.bid * rpw; const int wend = min(wrow0 + rpw, NL);
    for (int sa = wrow0; sa < wend;) {
        const int mvi = mod_vec_of_row(sa); const int sbnd = min(wend, mvi == 0 ? SEQ : NL);
        f32x4 g2[4]; load_row_f32(MOD + (size_t)(3 * 3 + mvi) * 6 * D + 5 * D, C.lane, g2);
        for (int ra = sa + 2 * C.wave; ra < sbnd; ra += 2 * NW) {
            const int rb = ra + 1;
            const int ta0 = TS[ra * 2], ta1 = TS[ra * 2 + 1], tb0 = TS[rb * 2], tb1 = TS[rb * 2 + 1]; const float wa0 = TW[ra * 2], wa1 = TW[ra * 2 + 1], wb0 = TW[rb * 2], wb1 = TW[rb * 2 + 1];
            f32x4 va[4], vb[4]; unsigned ya0[4], ya1[4], yb0[4], yb1[4];
            load_row_bf16(LAT + (size_t)ra * D, C.lane, va); load_row_bf16(LAT + (size_t)rb * D, C.lane, vb);
            load_row_fp8raw(Y8 + (size_t)(sb[ta0 >> 20] + (ta0 & 0xfffff)) * D, C.lane, ya0); load_row_fp8raw(Y8 + (size_t)(sb[ta1 >> 20] + (ta1 & 0xfffff)) * D, C.lane, ya1);
            load_row_fp8raw(Y8 + (size_t)(sb[tb0 >> 20] + (tb0 & 0xfffff)) * D, C.lane, yb0); load_row_fp8raw(Y8 + (size_t)(sb[tb1 >> 20] + (tb1 & 0xfffff)) * D, C.lane, yb1);
#pragma unroll
            for (int q = 0; q < 4; ++q) { va[q] += g2[q] * (fp8x4(ya0[q]) * (wa0 * (1.0f / YSCALE)) + fp8x4(ya1[q]) * (wa1 * (1.0f / YSCALE))); vb[q] += g2[q] * (fp8x4(yb0[q]) * (wb0 * (1.0f / YSCALE)) + fp8x4(yb1[q]) * (wb1 * (1.0f / YSCALE))); }
            const float rra = row_rstd(va), rrb = row_rstd(vb);
#pragma unroll
            for (int q = 0; q < 4; ++q) { *(f32x4*)(A.out + (size_t)ra * D + 4 * C.lane + 256 * q) = (va[q] * rra) * fg[q]; *(f32x4*)(A.out + (size_t)rb * D + 4 * C.lane + 256 * q) = (vb[q] * rrb) * fg[q]; }
        }
        sa = sbnd;
    }
}

__device__ __forceinline__ void phase_conv(const Args& A, const Ctx& C, int l) {
    const int j = l >> 1; const int nrows = (l <= 1) ? NR : NL;
    const bf16* P = (const bf16*)(A.ws + WS_PB); unsigned char* HM = A.ws + WS_HM; float* RSC = (float*)(A.ws + WS_RSC);
    const float* cw = A.in[13] + (size_t)j * 3 * D;
    f32x4 w0[4], w1[4], w2[4];
    load_row_f32(cw, C.lane, w0); load_row_f32(cw + D, C.lane, w1); load_row_f32(cw + 2 * D, C.lane, w2);
    const int rpw = (((nrows + C.G - 1) / C.G) + 1) & ~1; const int wrow0 = C.bid * rpw; const int wend = min(wrow0 + rpw, nrows);
    for (int ra = wrow0 + 2 * C.wave; ra < wend; ra += 2 * NW) {
        const int rb = ra + 1;
        const int ta = ra < NL ? (ra & 63) : ((ra - NL) & 255), tb1 = rb < NL ? (rb & 63) : ((rb - NL) & 255), tlast = ra < NL ? 63 : 255;
        const bool hasl = ta != 0, hasr = tb1 != tlast;
        const bf16* pa = P + (size_t)ra * PW;
        u32x2 bga[4], bgb[4], zm[4], z0[4], z1[4], z2[4];
        load_row_bf16raw(pa, C.lane, bga); load_row_bf16raw(pa + PW, C.lane, bgb);
        load_row_bf16raw(pa + D, C.lane, z0); load_row_bf16raw(pa + PW + D, C.lane, z1);
        load_row_bf16raw(hasl ? pa - PW + D : pa + D, C.lane, zm); load_row_bf16raw(hasr ? pa + 2 * PW + D : pa + D, C.lane, z2);
        const float fl = hasl ? 1.f : 0.f, fr = hasr ? 1.f : 0.f;
        f32x4 oa[4], ob[4];
#pragma unroll
        for (int q = 0; q < 4; ++q) { const f32x4 a0 = bf4(z0[q]), a1 = bf4(z1[q]);
            oa[q] = bf4(bga[q]) * (w0[q] * (bf4(zm[q]) * fl) + w1[q] * a0 + w2[q] * a1);
            ob[q] = bf4(bgb[q]) * (w0[q] * a0 + w1[q] * a1 + w2[q] * (bf4(z2[q]) * fr)); }
        float ma = 0.f, mb = 0.f;
#pragma unroll
        for (int q = 0; q < 4; ++q) { ma = fmaxf(ma, fmaxf(fmaxf(fabsf(oa[q].x), fabsf(oa[q].y)), fmaxf(fabsf(oa[q].z), fabsf(oa[q].w)))); mb = fmaxf(mb, fmaxf(fmaxf(fabsf(ob[q].x), fabsf(ob[q].y)), fmaxf(fabsf(ob[q].z), fabsf(ob[q].w)))); }
        ma = fmaxf(wave_max_nn(ma), 1.0e-20f); mb = fmaxf(wave_max_nn(mb), 1.0e-20f);
        const float ia = 127.0f / ma, ib = 127.0f / mb;
#pragma unroll
        for (int q = 0; q < 4; ++q) { *(unsigned*)(HM + (size_t)ra * D + 4 * C.lane + 256 * q) = pack_i8(oa[q] * ia); *(unsigned*)(HM + (size_t)rb * D + 4 * C.lane + 256 * q) = pack_i8(ob[q] * ib); }
        if (C.lane == 0) { RSC[ra] = ma * (1.0f / 127.0f); RSC[rb] = mb * (1.0f / 127.0f); }
    }
}

constexpr int BM = 256, BK = 64, HALF = 128, HTB = HALF * BK * 2, STAGE_BYTES = 8 * HTB, NXCD = 8, WGM = 8;
constexpr int LDS_TAB = STAGE_BYTES;
__device__ __forceinline__ int lds_byte(int r, int c) { const int st = (r >> 4) * 2 + (c >> 5), rr = r & 15, cc = c & 31, ob = rr * 64 + cc * 2; return st * 1024 + (ob ^ (((ob >> 9) & 1) << 5)); }
__device__ __forceinline__ void stage_rc(int b, int& R, int& C) { const int st = b / 1024, sb = b % 1024, swz = sb ^ (((sb >> 9) & 1) << 5); R = (st >> 1) * 16 + swz / 64; C = (st & 1) * 32 + (swz % 64) / 2; }
__device__ __forceinline__ int perm32(int rho) { const int n = rho >> 4, i = rho & 15; return 8 * (i >> 2) + 4 * n + (i & 3); }
__device__ __forceinline__ unsigned cvt_pk_bf16(float lo, float hi) { unsigned r; asm volatile("v_cvt_pk_bf16_f32 %0, %1, %2" : "=v"(r) : "v"(lo), "v"(hi)); return r; }

struct GUnit { const char* a; const char* b; int orow, ocol, aux; };

typedef int i32x8 __attribute__((ext_vector_type(8)));
typedef int i32x4 __attribute__((ext_vector_type(4)));
template <class Epi, class Sched, bool GATHER, int OPM = 0>
__device__ __forceinline__ void gemm_phase(LAS unsigned char* lds, const int K, const Sched& S, const Epi& E) {
    const int tid = threadIdx.x, wid = __builtin_amdgcn_readfirstlane(tid >> 6), lane = tid & 63, wr = wid >> 2, wc = wid & 3, fr = lane & 15, fq = lane >> 4;
    constexpr bool FP8 = (OPM == 1), I8 = (OPM == 2);
    const int RB = (OPM != 0) ? K : 2 * K;
    const int nt = RB / (BK * 2);
    unsigned voffB[2], voA[2][2]; int Rr[2], Cc[2];
#pragma unroll
    for (int i = 0; i < 2; ++i) { int R, C; stage_rc(tid * 16 + i * 8192, R, C); const int Rb = (R & ~31) + perm32(R & 31); Rr[i] = R; Cc[i] = C;
        voffB[i] = (unsigned)(Rb * RB + C * 2);
        voA[0][i] = (unsigned)(R * RB + C * 2); voA[1][i] = (unsigned)((R + HALF) * RB + C * 2); }
    const size_t kstep = (size_t)(BK * 2);
    const size_t hstep = (size_t)HALF * RB;
    const unsigned ldsw = (unsigned)wid * 1024u;
    const unsigned ldsbase = (unsigned)(size_t)lds;
    const int aoff = lds_byte(wr * 64 + fr, fq * 8), boff = lds_byte(wc * 32 + fr, fq * 8);
#define PG8_SA(b, h) (((b) * 2 + (h)) * HTB)
#define PG8_SB(b, h) ((4 + (b) * 2 + (h)) * HTB)
#define PG8_STAGE(bufoff, gbase, voff) do { _Pragma("unroll") for (int _i = 0; _i < 2; ++_i) \
        asm volatile("s_mov_b32 m0, %2\n\ts_nop 0\n\tglobal_load_lds_dwordx4 %0, %1" :: "v"((voff)[_i]), "s"((const char*)(gbase)), "s"(ldsbase + (unsigned)(bufoff) + ldsw + (unsigned)(_i * 8192)) : "memory"); } while (0)
#define PG8_STAGE_A1(bufoff, gbase) do { if constexpr (GATHER) PG8_STAGE(bufoff, gbase, voA[1]); else PG8_STAGE(bufoff, (const char*)(gbase) + hstep, voA[0]); } while (0)
#define PG8_LDA(dst, b, h) do { if constexpr (FP8) { _Pragma("unroll") for (int m = 0; m < 4; ++m) { \
        const i32x4 _lo = *(const LAS i32x4*)(lds + PG8_SA(b, h) + aoff + m * 2048), _hi = *(const LAS i32x4*)(lds + PG8_SA(b, h) + aoff + m * 2048 + 1024); \
        dst##8[m] = __builtin_shufflevector(_lo, _hi, 0, 1, 2, 3, 4, 5, 6, 7); } } \
      else { _Pragma("unroll") for (int m = 0; m < 4; ++m) _Pragma("unroll") for (int k = 0; k < 2; ++k) dst[m][k] = *(const LAS bf16x8*)(lds + PG8_SA(b, h) + aoff + m * 2048 + k * 1024); } } while (0)
#define PG8_LDB(dst, b, h) do { if constexpr (FP8) { _Pragma("unroll") for (int n = 0; n < 2; ++n) { \
        const i32x4 _lo = *(const LAS i32x4*)(lds + PG8_SB(b, h) + boff + n * 2048), _hi = *(const LAS i32x4*)(lds + PG8_SB(b, h) + boff + n * 2048 + 1024); \
        dst##8[n] = __builtin_shufflevector(_lo, _hi, 0, 1, 2, 3, 4, 5, 6, 7); } } \
      else { _Pragma("unroll") for (int n = 0; n < 2; ++n) _Pragma("unroll") for (int k = 0; k < 2; ++k) dst[n][k] = *(const LAS bf16x8*)(lds + PG8_SB(b, h) + boff + n * 2048 + k * 1024); } } while (0)
#define PG8_MMA(ai, bj, At, Bt) do { __builtin_amdgcn_s_setprio(1); \
        if constexpr (FP8) { _Pragma("unroll") for (int m = 0; m < 4; ++m) _Pragma("unroll") for (int n = 0; n < 2; ++n) \
            acc[ai][bj][m][n] = __builtin_amdgcn_mfma_scale_f32_16x16x128_f8f6f4(Bt##8[n], At##8[m], acc[ai][bj][m][n], 0, 0, 0, 0x7f7f7f7f, 0, 0x7f7f7f7f); } \
        else if constexpr (I8) { _Pragma("unroll") for (int m = 0; m < 4; ++m) _Pragma("unroll") for (int n = 0; n < 2; ++n) _Pragma("unroll") for (int k = 0; k < 2; ++k) \
            acc[ai][bj][m][n] = __builtin_bit_cast(f32x4, __builtin_amdgcn_mfma_i32_16x16x64_i8(__builtin_bit_cast(i32x4, Bt[n][k]), __builtin_bit_cast(i32x4, At[m][k]), __builtin_bit_cast(i32x4, acc[ai][bj][m][n]), 0, 0, 0)); } \
        else { _Pragma("unroll") for (int m = 0; m < 4; ++m) _Pragma("unroll") for (int n = 0; n < 2; ++n) _Pragma("unroll") for (int k = 0; k < 2; ++k) \
            acc[ai][bj][m][n] = __builtin_amdgcn_mfma_f32_16x16x32_bf16(Bt[n][k], At[m][k], acc[ai][bj][m][n], 0, 0, 0); } \
        __builtin_amdgcn_s_setprio(0); } while (0)
#define PG8_WAIT_V(n) asm volatile("s_waitcnt vmcnt(" #n ")" ::: "memory")
#define PG8_WAIT_L(n) asm volatile("s_waitcnt lgkmcnt(" #n ")" ::: "memory")
#define PG8_BAR __builtin_amdgcn_s_barrier()
#define PG8_SCHED __builtin_amdgcn_sched_barrier(0)
    GUnit cur, nxt; int ui = 0;
    if (!S.next(0, cur)) return;
    if constexpr (GATHER) {
#pragma unroll
        for (int h = 0; h < 2; ++h)
#pragma unroll
            for (int i = 0; i < 2; ++i) voA[h][i] = S.arow_off(0, h * HALF + Rr[i]) + (unsigned)Cc[i] * 2u;
    }
    f32x4 acc[2][2][4][2];
#pragma unroll
    for (int a = 0; a < 2; ++a)
#pragma unroll
        for (int b = 0; b < 2; ++b)
#pragma unroll
            for (int m = 0; m < 4; ++m)
#pragma unroll
                for (int n = 0; n < 2; ++n) acc[a][b][m][n] = (f32x4){0.f, 0.f, 0.f, 0.f};
    bf16x8 At[4][2], B0[2][2], B1[2][2]; i32x8 At8[4], B08[2], B18[2];
    const char* cA = cur.a; const char* cB = cur.b;
    PG8_STAGE(PG8_SB(0, 0), cB, voffB); PG8_STAGE(PG8_SB(0, 1), cB + hstep, voffB); PG8_STAGE(PG8_SA(0, 0), cA, voA[0]); PG8_STAGE_A1(PG8_SA(0, 1), cA);
    if (wr == 1) PG8_BAR;
    PG8_WAIT_V(2); PG8_BAR;
    PG8_STAGE(PG8_SB(1, 0), cB + kstep, voffB); PG8_STAGE(PG8_SA(1, 0), cA + kstep, voA[0]); PG8_STAGE(PG8_SB(1, 1), cB + hstep + kstep, voffB);
    PG8_WAIT_V(6); PG8_BAR;
    for (;;) {
        const bool has_next = S.next(ui + 1, nxt);
        const char* nA = has_next ? nxt.a : cA; const char* nB = has_next ? nxt.b : cB;
#pragma unroll 1
        for (int t = 0; t < nt; t += 2) {
            const bool last = (t == nt - 2);
            const char* a1 = cA + (size_t)(t + 1) * kstep;
            const char* a2 = last ? nA : cA + (size_t)(t + 2) * kstep; const char* b2 = last ? nB : cB + (size_t)(t + 2) * kstep;
            const char* a3 = a2 + kstep; const char* b3 = b2 + kstep;
            PG8_LDB(B0, 0, 0); PG8_LDB(B1, 0, 1); PG8_SCHED; PG8_LDA(At, 0, 0); PG8_STAGE_A1(PG8_SA(1, 1), a1);
            if constexpr (GATHER) { if (last && has_next) {
#pragma unroll
                for (int h = 0; h < 2; ++h)
#pragma unroll
                    for (int i = 0; i < 2; ++i) { int R2, C2; stage_rc(tid * 16 + i * 8192, R2, C2); voA[h][i] = S.arow_off(ui + 1, h * HALF + R2) + (unsigned)C2 * 2u; } } }
            PG8_WAIT_V(8); PG8_WAIT_L(0); PG8_BAR; PG8_MMA(0, 0, At, B0); PG8_MMA(0, 1, At, B1); PG8_BAR; PG8_SCHED;
            PG8_LDA(At, 0, 1); PG8_STAGE(PG8_SB(0, 0), b2, voffB); PG8_STAGE(PG8_SB(0, 1), b2 + hstep, voffB); PG8_STAGE(PG8_SA(0, 0), a2, voA[0]);
            PG8_WAIT_V(8); PG8_WAIT_L(0); PG8_BAR; PG8_MMA(1, 0, At, B0); PG8_MMA(1, 1, At, B1); PG8_BAR; PG8_SCHED;
            PG8_LDB(B0, 1, 0); PG8_LDB(B1, 1, 1); PG8_SCHED; PG8_LDA(At, 1, 0); PG8_STAGE_A1(PG8_SA(0, 1), a2);
            PG8_WAIT_V(8); PG8_WAIT_L(0); PG8_BAR; PG8_MMA(0, 0, At, B0); PG8_MMA(0, 1, At, B1); PG8_BAR; PG8_SCHED;
            PG8_LDA(At, 1, 1); PG8_STAGE(PG8_SB(1, 0), b3, voffB); PG8_STAGE(PG8_SB(1, 1), b3 + hstep, voffB); PG8_STAGE(PG8_SA(1, 0), a3, voA[0]);
            PG8_WAIT_V(8); PG8_WAIT_L(0); PG8_BAR; PG8_MMA(1, 0, At, B0); PG8_MMA(1, 1, At, B1); PG8_BAR; PG8_SCHED;
        }
        if (wr == 0) PG8_BAR;
        { int tz = threadIdx.x; asm volatile("" : "+v"(tz));
          if constexpr (I8) {
#pragma unroll
              for (int a_ = 0; a_ < 2; ++a_)
#pragma unroll
                  for (int b_ = 0; b_ < 2; ++b_)
#pragma unroll
                      for (int m = 0; m < 4; ++m)
#pragma unroll
                          for (int n = 0; n < 2; ++n) acc[a_][b_][m][n] = __builtin_convertvector(__builtin_bit_cast(i32x4, acc[a_][b_][m][n]), f32x4); }
          const int wz = tz >> 6, lz = tz & 63; E(acc, cur, wz >> 2, wz & 3, lz & 15, lz >> 4); }
        if (!has_next) break;
#pragma unroll
        for (int a = 0; a < 2; ++a)
#pragma unroll
            for (int b = 0; b < 2; ++b)
#pragma unroll
                for (int m = 0; m < 4; ++m)
#pragma unroll
                    for (int n = 0; n < 2; ++n) acc[a][b][m][n] = (f32x4){0.f, 0.f, 0.f, 0.f};
        cur = nxt; cA = nA; cB = nB; ++ui;
        if (wr == 1) PG8_BAR;
    }
    PG8_WAIT_V(0);
    PG8_BAR;
#undef PG8_SA
#undef PG8_SB
#undef PG8_STAGE
#undef PG8_STAGE_A1
#undef PG8_LDA
#undef PG8_LDB
#undef PG8_MMA
#undef PG8_WAIT_V
#undef PG8_WAIT_L
#undef PG8_BAR
#undef PG8_SCHED
}

__device__ __forceinline__ int xcd_remap(int L, int nwg) { const int q = nwg / NXCD, r = nwg % NXCD, xcd = L % NXCD, off = L / NXCD; return (xcd < r ? xcd * (q + 1) : r * (q + 1) + (xcd - r) * q) + off; }

struct DenseSched {
    const char* A; const char* Bt; int nM, nN, nwg, G, c; size_t tstep; int sw_lo, sw_hi;
    __device__ __forceinline__ void init(const void* A_, const void* Bt_, int M, int N, int K, int G_, int c_, int ebytes = 2) { A = (const char*)A_; Bt = (const char*)Bt_; nM = M / BM; nN = N / BM; nwg = nM * nN; G = G_; c = c_; tstep = (size_t)BM * K * ebytes; sw_lo = 0; sw_hi = 0; }
    __device__ __forceinline__ bool next(int i, GUnit& u) const {
        const long L = (long)i * G + c; if (L >= nwg) return false;
        const int wgid = xcd_remap((int)L, nwg);
        const int nig = WGM * nN, gid = wgid / nig, fm = gid * WGM, gsz = (nM - fm) < WGM ? (nM - fm) : WGM;
        const int pm = fm + ((wgid % nig) % gsz), pn = (wgid % nig) / gsz;
        if (pn >= sw_lo && pn < sw_hi) { u.a = Bt + (size_t)pn * tstep; u.b = A + (size_t)pm * tstep; u.orow = pm; u.ocol = pn - sw_lo; u.aux = 1; }
        else { u.a = A + (size_t)pm * tstep; u.b = Bt + (size_t)pn * tstep; u.orow = pm * BM; u.ocol = pn * BM; u.aux = 0; }
        return true;
    }
    __device__ __forceinline__ unsigned arow_off(int, int) const { return 0u; }
};

constexpr int MAXU = 12;
struct MoeTab { int n; int e[MAXU], mb[MAXU], nt[MAXU]; int sb[NE + 1]; };
struct MoeSched {
    LAS const MoeTab* T; LAS const unsigned* ridx;
    const char* A; const char* W; size_t wstride_e, tstepB; int K; int arow_bytes;
    __device__ __forceinline__ bool next(int i, GUnit& u) const {
        const int n = __builtin_amdgcn_readfirstlane(T->n); if (i >= n) return false;
        const int e = __builtin_amdgcn_readfirstlane(T->e[i]), mb = __builtin_amdgcn_readfirstlane(T->mb[i]), nt = __builtin_amdgcn_readfirstlane(T->nt[i]);
        const int base = __builtin_amdgcn_readfirstlane(T->sb[e]);
        u.orow = base + mb * BM; u.ocol = nt; u.aux = e;
        u.a = A + (size_t)u.orow * arow_bytes;
        u.b = W + (size_t)e * wstride_e + (size_t)nt * tstepB; return true;
    }
    __device__ __forceinline__ unsigned arow_off(int i, int r) const { return ridx[i * 256 + r]; }
};
template <bool GATHER>
__device__ __forceinline__ void moe_tables(const Args& A, const Ctx& C, int l, int ntile_n, LAS MoeTab* T, LAS unsigned* ridx, int arow_bytes) {
    const unsigned* cnt = (const unsigned*)(A.ws + WS_CTL) + CW_CNT + l * 32 * CNT_STRIDE;
    LAS int* ust = (LAS int*)(T + 1);
    if (C.tid < 64) { int nb; const int ex = expert_block_prefix(cnt, C.tid, nb); if (C.tid <= NE) { T->sb[C.tid] = ex * 256; ust[C.tid] = ex * ntile_n; } }
    __syncthreads();
    if (C.tid < MAXU) { const int nwg = ust[NE]; const long L = (long)C.tid * C.G + C.bid;
        if (L < nwg) { const int w = xcd_remap((int)L, nwg); int e = 0; while (w >= ust[e + 1]) ++e;
            const int lu = w - ust[e]; T->e[C.tid] = e; T->mb[C.tid] = lu / ntile_n; T->nt[C.tid] = lu % ntile_n; } }
    if (C.tid == 0) { const int nwg = ust[NE]; int n = 0; while (n < MAXU && (long)n * C.G + C.bid < nwg) ++n; T->n = n; }
    __syncthreads();
    if constexpr (GATHER) {
        const int* ST = (const int*)(A.ws + WS_SLOTTOK); const int n = T->n;
        for (int i = C.tid; i < n * 256; i += NT) { const int ui = i >> 8, r = i & 255, e = T->e[ui], m0 = T->mb[ui] * 256, ce = (int)cnt[e * CNT_STRIDE];
            const int rr = (m0 + r < ce) ? m0 + r : ce - 1;
            ridx[i] = (unsigned)ST[(size_t)e * CAP + rr] * (unsigned)arow_bytes; }
        __syncthreads();
    }
}

struct EpiStore { bf16* O; int ldc; float scale_lo; int sig_from; bf16* VT; float sall = 1.0f; const float* rs = nullptr;
    __device__ __forceinline__ void operator()(const f32x4 (&acc)[2][2][4][2], const GUnit& u, int wr, int wc, int fr, int fq) const {
        const bool tr = u.aux != 0;
        const float sc = ((!tr && u.ocol < NQ) ? scale_lo : 1.0f) * sall; const bool sg = !tr && u.ocol >= sig_from;
        bf16* Ob = tr ? VT + (size_t)(u.orow * NH + u.ocol) * 65536 : O + (size_t)u.orow * ldc + u.ocol; const int ld = tr ? 256 : ldc;
        f32x4 cs[2][2];
#pragma unroll
        for (int bj = 0; bj < 2; ++bj) { const f32x4 one = (f32x4){1.f, 1.f, 1.f, 1.f};
            cs[bj][0] = (rs && tr) ? *(const f32x4*)(rs + u.orow * BM + bj * HALF + wc * 32 + 8 * fq) : one; cs[bj][1] = (rs && tr) ? *(const f32x4*)(rs + u.orow * BM + bj * HALF + wc * 32 + 8 * fq + 4) : one; }
#pragma unroll
        for (int ai = 0; ai < 2; ++ai)
#pragma unroll
            for (int m = 0; m < 4; ++m) { const int rl = ai * HALF + wr * 64 + m * 16 + fr; bf16* rowp = Ob + (size_t)rl * ld + wc * 32 + 8 * fq;
                const float scr = (rs && !tr) ? sc * rs[u.orow + rl] : sc;
#pragma unroll
                for (int bj = 0; bj < 2; ++bj) { f32x4 v0 = acc[ai][bj][m][0] * scr * cs[bj][0], v1 = acc[ai][bj][m][1] * scr * cs[bj][1];
                    if (sg) {
#pragma unroll
                        for (int q = 0; q < 4; ++q) { v0[q] = __builtin_amdgcn_rcpf(1.0f + __expf(-v0[q])); v1[q] = __builtin_amdgcn_rcpf(1.0f + __expf(-v1[q])); } }
                    u32x4 w; w.x = cvt_pk_bf16(v0[0], v0[1]); w.y = cvt_pk_bf16(v0[2], v0[3]); w.z = cvt_pk_bf16(v1[0], v1[1]); w.w = cvt_pk_bf16(v1[2], v1[3]);
                    *(u32x4*)(rowp + bj * HALF) = w; } }
    }
};
__device__ __forceinline__ u32x2 cvt8_fp8(f32x4 a, f32x4 b) { int lo = 0, hi = 0;
    lo = __builtin_amdgcn_cvt_pk_fp8_f32(a[0], a[1], lo, false); lo = __builtin_amdgcn_cvt_pk_fp8_f32(a[2], a[3], lo, true);
    hi = __builtin_amdgcn_cvt_pk_fp8_f32(b[0], b[1], hi, false); hi = __builtin_amdgcn_cvt_pk_fp8_f32(b[2], b[3], hi, true); return (u32x2){(unsigned)lo, (unsigned)hi}; }
struct EpiSwigluF8 { unsigned char* O; int ldc; float s;
    __device__ __forceinline__ void operator()(const f32x4 (&acc)[2][2][4][2], const GUnit& u, int wr, int wc, int fr, int fq) const {
        const int ocol = u.ocol * HALF;
#pragma unroll
        for (int ai = 0; ai < 2; ++ai)
#pragma unroll
            for (int m = 0; m < 4; ++m) { unsigned char* rowp = O + (size_t)(u.orow + ai * HALF + wr * 64 + m * 16 + fr) * ldc + ocol + wc * 32 + 8 * fq;
                f32x4 v0, v1;
#pragma unroll
                for (int q = 0; q < 4; ++q) { const float x0 = acc[ai][0][m][0][q] * s, x1 = acc[ai][0][m][1][q] * s;
                    v0[q] = x0 * __builtin_amdgcn_rcpf(1.0f + __expf(-x0)) * (acc[ai][1][m][0][q] * s); v1[q] = x1 * __builtin_amdgcn_rcpf(1.0f + __expf(-x1)) * (acc[ai][1][m][1][q] * s); }
                *(u32x2*)rowp = cvt8_fp8(v0, v1); }
    }
};
template <int MODE> struct EpiPair { bf16* O; int ldc; int plain_below; float sall = 1.0f; const float* rs = nullptr;
    __device__ __forceinline__ void operator()(const f32x4 (&acc)[2][2][4][2], const GUnit& u, int wr, int wc, int fr, int fq) const {
        if (MODE == 0 && u.ocol < plain_below) {
#pragma unroll
            for (int ai = 0; ai < 2; ++ai)
#pragma unroll
                for (int m = 0; m < 4; ++m) { const int rg = u.orow + ai * HALF + wr * 64 + m * 16 + fr; bf16* rowp = O + (size_t)rg * ldc + u.ocol + wc * 32 + 8 * fq;
                    const float scr = rs ? sall * rs[rg] : sall;
#pragma unroll
                    for (int bj = 0; bj < 2; ++bj) { const f32x4 v0 = acc[ai][bj][m][0] * scr, v1 = acc[ai][bj][m][1] * scr;
                        u32x4 w; w.x = cvt_pk_bf16(v0[0], v0[1]); w.y = cvt_pk_bf16(v0[2], v0[3]); w.z = cvt_pk_bf16(v1[0], v1[1]); w.w = cvt_pk_bf16(v1[2], v1[3]);
                        *(u32x4*)(rowp + bj * HALF) = w; } }
            return;
        }
        const int ocol = (MODE == 0) ? plain_below + (u.ocol - plain_below) / 2 : u.ocol * HALF;
#pragma unroll
        for (int ai = 0; ai < 2; ++ai)
#pragma unroll
            for (int m = 0; m < 4; ++m) { const int rg = u.orow + ai * HALF + wr * 64 + m * 16 + fr; bf16* rowp = O + (size_t)rg * ldc + ocol + wc * 32 + 8 * fq;
                const float scr = rs ? sall * rs[rg] : sall; const float sc2 = scr * scr;
                f32x4 v0, v1;
#pragma unroll
                for (int q = 0; q < 4; ++q) {
                    const float x0 = acc[ai][0][m][0][q], x1 = acc[ai][0][m][1][q];
                    const float g0 = (MODE == 1) ? x0 * __builtin_amdgcn_rcpf(1.0f + __expf(-x0)) : x0, g1 = (MODE == 1) ? x1 * __builtin_amdgcn_rcpf(1.0f + __expf(-x1)) : x1;
                    v0[q] = g0 * acc[ai][1][m][0][q] * sc2; v1[q] = g1 * acc[ai][1][m][1][q] * sc2; }
                u32x4 w; w.x = cvt_pk_bf16(v0[0], v0[1]); w.y = cvt_pk_bf16(v0[2], v0[3]); w.z = cvt_pk_bf16(v1[0], v1[1]); w.w = cvt_pk_bf16(v1[2], v1[3]);
                *(u32x4*)rowp = w; }
    }
};
struct EpiResid { bf16* LAT; const float* g1; float sall; const float* rs;
    __device__ __forceinline__ void operator()(const f32x4 (&acc)[2][2][4][2], const GUnit& u, int wr, int wc, int fr, int fq) const {
        bf16* Ob = LAT + (size_t)u.orow * D + u.ocol + wc * 32 + 8 * fq;
        u32x4 old[2][4][2];
#pragma unroll
        for (int ai = 0; ai < 2; ++ai)
#pragma unroll
            for (int m = 0; m < 4; ++m)
#pragma unroll
                for (int bj = 0; bj < 2; ++bj) old[ai][m][bj] = *(const u32x4*)(Ob + (size_t)(ai * HALF + wr * 64 + m * 16 + fr) * D + bj * HALF);
        const float* gv = g1 + (size_t)mod_vec_of_row(u.orow) * 6 * D + u.ocol + wc * 32 + 8 * fq;
        f32x4 g[2][2];
#pragma unroll
        for (int bj = 0; bj < 2; ++bj) { g[bj][0] = *(const f32x4*)(gv + bj * HALF); g[bj][1] = *(const f32x4*)(gv + bj * HALF + 4); }
#pragma unroll
        for (int ai = 0; ai < 2; ++ai)
#pragma unroll
            for (int m = 0; m < 4; ++m) { const int rl = ai * HALF + wr * 64 + m * 16 + fr; bf16* rowp = Ob + (size_t)rl * D;
                const float scr = rs ? sall * rs[u.orow + rl] : sall;
#pragma unroll
                for (int bj = 0; bj < 2; ++bj) { const u32x4 o = old[ai][m][bj];
                    const f32x4 v0 = bf4((u32x2){o.x, o.y}) + g[bj][0] * (acc[ai][bj][m][0] * scr), v1 = bf4((u32x2){o.z, o.w}) + g[bj][1] * (acc[ai][bj][m][1] * scr);
                    u32x4 w; w.x = cvt_pk_bf16(v0[0], v0[1]); w.y = cvt_pk_bf16(v0[2], v0[3]); w.z = cvt_pk_bf16(v1[0], v1[1]); w.w = cvt_pk_bf16(v1[2], v1[3]);
                    *(u32x4*)(rowp + bj * HALF) = w; } }
    }
};
struct EpiStoreTile { unsigned char* O; int ldc; float s;
    __device__ __forceinline__ void operator()(const f32x4 (&acc)[2][2][4][2], const GUnit& u, int wr, int wc, int fr, int fq) const {
#pragma unroll
        for (int ai = 0; ai < 2; ++ai)
#pragma unroll
            for (int m = 0; m < 4; ++m) { unsigned char* rowp = O + (size_t)(u.orow + ai * HALF + wr * 64 + m * 16 + fr) * ldc + u.ocol * BM + wc * 32 + 8 * fq;
#pragma unroll
                for (int bj = 0; bj < 2; ++bj) *(u32x2*)(rowp + bj * HALF) = cvt8_fp8(acc[ai][bj][m][0] * s, acc[ai][bj][m][1] * s); }
    }
};

__device__ __forceinline__ void transpose_item(const float* W, int ldw, int K, bf16* WT, int drow0, int k0, int n0, LAS float* scr, int lane) {
#pragma unroll
    for (int i = 0; i < 32; ++i) { const int kk = 2 * i + (lane >> 5); scr[kk * 33 + (lane & 31)] = W[(size_t)(k0 + kk) * ldw + n0 + (lane & 31)]; }
    asm volatile("s_waitcnt lgkmcnt(0)" ::: "memory");
    const int c = lane & 7;
#pragma unroll
    for (int j = 0; j < 4; ++j) { const int n = (lane >> 3) + 8 * j; const LAS float* s = scr + (8 * c) * 33 + n;
        u32x4 o; o.x = pk2(s[0 * 33], s[1 * 33]); o.y = pk2(s[2 * 33], s[3 * 33]); o.z = pk2(s[4 * 33], s[5 * 33]); o.w = pk2(s[6 * 33], s[7 * 33]);
        *(u32x4*)(WT + (size_t)(drow0 + n) * K + k0 + 8 * c) = o; }
    asm volatile("s_waitcnt lgkmcnt(0)" ::: "memory");
}
__device__ __forceinline__ void transpose_item_fp8(const float* W, int ldw, int K, unsigned char* WT8, int drow0, int k0, int n0, LAS float* scr, int lane, float sc) {
#pragma unroll
    for (int i = 0; i < 32; ++i) { const int kk = 2 * i + (lane >> 5); scr[kk * 33 + (lane & 31)] = W[(size_t)(k0 + kk) * ldw + n0 + (lane & 31)]; }
    asm volatile("s_waitcnt lgkmcnt(0)" ::: "memory");
    const int n = lane >> 1, half = lane & 1; const LAS float* sp = scr + (32 * half) * 33 + n;
    unsigned char* dst = WT8 + (size_t)(drow0 + n) * K + k0 + 32 * half;
#pragma unroll
    for (int c = 0; c < 2; ++c) { u32x4 o;
#pragma unroll
        for (int q = 0; q < 4; ++q) { int p = 0; const LAS float* s4 = sp + (16 * c + 4 * q) * 33;
            p = __builtin_amdgcn_cvt_pk_fp8_f32(s4[0] * sc, s4[33] * sc, p, false); p = __builtin_amdgcn_cvt_pk_fp8_f32(s4[66] * sc, s4[99] * sc, p, true); o[q] = (unsigned)p; }
        *(u32x4*)(dst + 16 * c) = o; }
    asm volatile("s_waitcnt lgkmcnt(0)" ::: "memory");
}
__device__ __forceinline__ void transpose_item_i8(const float* W, int ldw, int K, unsigned char* WT8, int drow0, int k0, int n0, LAS float* scr, int lane, float inv) {
#pragma unroll
    for (int i = 0; i < 32; ++i) { const int kk = 2 * i + (lane >> 5); scr[kk * 33 + (lane & 31)] = W[(size_t)(k0 + kk) * ldw + n0 + (lane & 31)]; }
    asm volatile("s_waitcnt lgkmcnt(0)" ::: "memory");
    const int n = lane >> 1, half = lane & 1; const LAS float* sp = scr + (32 * half) * 33 + n;
    unsigned char* dst = WT8 + (size_t)(drow0 + n) * K + k0 + 32 * half;
#pragma unroll
    for (int c = 0; c < 2; ++c) { u32x4 o;
#pragma unroll
        for (int q = 0; q < 4; ++q) { const LAS float* s4 = sp + (16 * c + 4 * q) * 33; o[q] = pack_i8((f32x4){s4[0] * inv, s4[33] * inv, s4[66] * inv, s4[99] * inv}); }
        *(u32x4*)(dst + 16 * c) = o; }
    asm volatile("s_waitcnt lgkmcnt(0)" ::: "memory");
}
__device__ __forceinline__ int pair_row(int n, int which) { return (n >> 7) * 256 + (n & 127) + which * 128; }
constexpr float HMR = 6.0f;
__device__ __forceinline__ void phase_cvt_mixer(const Args& A, const Ctx& C) {
    const int gw = C.bid * NW + C.wave, NGW = C.G * NW;
    unsigned* wmax = (unsigned*)(A.ws + WS_CTL) + CW_WMAX;
    for (int m8 = 0; m8 < 8; ++m8) {
        const float* W = m8 < 2 ? A.in[8] + (size_t)m8 * D * PROJ : m8 < 4 ? A.in[12] + (size_t)(m8 - 2) * D * PW : m8 < 6 ? A.in[11] + (size_t)(m8 - 4) * D * D : A.in[14] + (size_t)(m8 - 6) * D * D;
        const size_t n4 = (size_t)D * (m8 < 2 ? PROJ : m8 < 4 ? PW : D) / 4;
        float mx = 0.f;
        for (size_t i = (size_t)gw * 64 + C.lane; i < n4; i += (size_t)NGW * 64) { const f32x4 v = *(const f32x4*)(W + 4 * i); mx = fmaxf(mx, fmaxf(fmaxf(fabsf(v.x), fabsf(v.y)), fmaxf(fabsf(v.z), fabsf(v.w)))); }
        mx = wave_max_nn(mx);
        if (C.lane == 0 && mx > 0.f) atomicMax(wmax + m8 * CNT_STRIDE, __float_as_uint(mx));
    }
}
__device__ __forceinline__ void cvt_win_i8(const Args& A, const Ctx& C) {
    LAS float* scr = (LAS float*)(C.lds + 16384 + C.wave * 16384);
    const int gw = C.bid * NW + C.wave, NGW = C.G * NW;
    constexpr int I_IN = (D / 64) * (PW / 32);
    const unsigned* wmax = (const unsigned*)(A.ws + WS_CTL) + CW_WMAX;
    constexpr int I_OUT = (D / 64) * (D / 32);
    for (int it = gw; it < 4 * I_OUT; it += NGW) {
        const int m4 = it / I_OUT, kind = m4 >> 1, j = m4 & 1, r = it % I_OUT; const int kb = r / (D / 32), nb = r % (D / 32), n0 = nb * 32;
        const float inv = 127.0f / fmaxf(__uint_as_float(wmax[(4 + m4) * CNT_STRIDE]), 1.0e-30f);
        transpose_item_i8((kind == 0 ? A.in[11] : A.in[14]) + (size_t)j * D * D, D, D, A.ws + (kind == 0 ? WS_WAOUT : WS_WBOUT) + (size_t)j * D * D, n0, kb * 64, n0, scr, C.lane, inv); }
    for (int it = gw; it < 4 * I_IN; it += NGW) {
        const int m4 = it / I_IN, kind = m4 >> 1, j = m4 & 1, r = it % I_IN; const int kb = r / (PW / 32), nb = r % (PW / 32), n0 = nb * 32;
        const float inv = 127.0f / fmaxf(__uint_as_float(wmax[m4 * CNT_STRIDE]), 1.0e-30f);
        unsigned char* WT = A.ws + (kind == 0 ? WS_WAIN : WS_WBIN) + (size_t)j * PW * D;
        if (kind == 0) transpose_item_i8(A.in[8] + (size_t)j * D * PROJ, PROJ, D, WT, n0, kb * 64, n0, scr, C.lane, inv);
        else { const int drow = n0 < D ? n0 : (n0 < 2 * D ? D + pair_row(n0 - D, 0) : D + pair_row(n0 - 2 * D, 1));
            transpose_item_i8(A.in[12] + (size_t)j * D * PW, PW, D, WT, drow, kb * 64, n0, scr, C.lane, inv); }
    }
}
__device__ __forceinline__ void cvt_moe_items(const Args& A, const Ctx& C, int l, int it0, int end, int stride) {
    LAS float* scr = (LAS float*)(C.lds + 16384 + C.wave * 16384);
    unsigned char* WGU = A.ws + WS_WGU; unsigned char* WDN = A.ws + WS_WDN;
    for (int it = it0; it < end; it += stride) {
        const int e = it / CVT_PER; int r = it % CVT_PER;
        if (r < 2 * CVT_IG) { const int which = r / CVT_IG; r %= CVT_IG; const int kb = r / (DE / 32), nb = r % (DE / 32), n0 = nb * 32;
            transpose_item_fp8((which == 0 ? A.in[19] : A.in[20]) + ((size_t)l * NE + e) * D * DE, DE, D, WGU + (size_t)e * 2 * DE * D, pair_row(n0, which), kb * 64, n0, scr, C.lane, WSCALE); }
        else { r -= 2 * CVT_IG; const int kb = r / (D / 32), nb = r % (D / 32), n0 = nb * 32;
            transpose_item_fp8(A.in[21] + ((size_t)l * NE + e) * DE * D, D, DE, WDN + (size_t)e * D * DE, n0, kb * 64, n0, scr, C.lane, WSCALE); }
    }
}
__device__ __forceinline__ int cvt_idle(int nunits, int G) { const int rem = nunits % G; return rem ? G - rem : 0; }
__device__ __forceinline__ int cvt_t1(int l, int G) { const int n = cvt_idle((((l <= 2) ? NR : NL) / BM) * (PW / BM), G) * CVT_Q; return n < CVT_ITEMS ? n : CVT_ITEMS; }
__device__ __forceinline__ int cvt_t2(int l, int G) { const int n = cvt_t1(l, G) + cvt_idle((((l <= 1) ? NR : NL) / BM) * (D / BM), G) * CVT_Q; return n < CVT_ITEMS ? n : CVT_ITEMS; }
__device__ __forceinline__ void cvt_moe_tail(const Args& A, const Ctx& C, int l, int nunits, int base, int end) {
    const int rem = nunits % C.G;
    if (rem == 0 || C.bid < rem) return;
    const int first = base + (C.bid - rem) * CVT_Q; const int last = min(first + CVT_Q, end);
    cvt_moe_items(A, C, l, first + C.wave, last, NW);
}

__device__ __forceinline__ void phase_g1(const Args& A, const Ctx& C, int l) {
    const bool mls = (l & 1) == 0; const int j = l >> 1; const int nrows = (l <= 2) ? NR : NL;
    DenseSched S; S.init(A.ws + WS_H8, A.ws + (mls ? WS_WAIN : WS_WBIN) + (size_t)j * PW * D, nrows, PW, D, C.G, C.bid, 1);
    const float wsc = __uint_as_float(((const unsigned*)(A.ws + WS_CTL))[CW_WMAX + ((mls ? 0 : 2) + j) * CNT_STRIDE]) * (1.0f / 127.0f);
    const float* rs = (const float*)(A.ws + WS_RSC);
    if (mls) { S.sw_lo = 4; S.sw_hi = 8; EpiStore E{(bf16*)(A.ws + WS_PB), PW, 0.08838834764831845f, 2 * NQ + NV, (bf16*)(A.ws + WS_VT), wsc, rs}; gemm_phase<EpiStore, DenseSched, false, 2>(C.lds, D, S, E); }
    else { EpiPair<0> E{(bf16*)(A.ws + WS_PB), PW, D, wsc, rs}; gemm_phase<EpiPair<0>, DenseSched, false, 2>(C.lds, D, S, E); }
    cvt_moe_tail(A, C, l, S.nwg, 0, cvt_t1(l, C.G));
}
__device__ __forceinline__ void phase_g2(const Args& A, const Ctx& C, int l) {
    const bool mls = (l & 1) == 0; const int j = l >> 1; const int nrows = (l <= 1) ? NR : NL;
    DenseSched S; S.init(A.ws + WS_HM, A.ws + (mls ? WS_WAOUT : WS_WBOUT) + (size_t)j * D * D, nrows, D, D, C.G, C.bid, 1);
    const float wsc = __uint_as_float(((const unsigned*)(A.ws + WS_CTL))[CW_WMAX + (4 + (mls ? 0 : 2) + j) * CNT_STRIDE]) * (1.0f / 127.0f);
    EpiResid E{(bf16*)(A.ws + WS_LAT), (const float*)(A.ws + WS_MOD) + (size_t)(l * 3) * 6 * D + 2 * D, mls ? wsc * (HMR / 127.0f) : wsc, mls ? nullptr : (const float*)(A.ws + WS_RSC)}; gemm_phase<EpiResid, DenseSched, false, 2>(C.lds, D, S, E);
    cvt_moe_tail(A, C, l, S.nwg, cvt_t1(l, C.G), cvt_t2(l, C.G));
}
__device__ __forceinline__ void phase_m1(const Args& A, const Ctx& C, int l) {
    LAS MoeTab* T = (LAS MoeTab*)(C.lds + LDS_TAB); LAS unsigned* ridx = (LAS unsigned*)(C.lds + LDS_TAB + 1024);
    moe_tables<true>(A, C, l, 4, T, ridx, D);
    MoeSched S; S.T = T; S.ridx = ridx; S.A = (const char*)(A.ws + WS_H8); S.W = (const char*)(A.ws + WS_WGU); S.wstride_e = (size_t)2 * DE * D; S.tstepB = (size_t)BM * D; S.K = D; S.arow_bytes = 0;
    EpiSwigluF8 E{A.ws + WS_DC, DE, 1.0f / WSCALE}; gemm_phase<EpiSwigluF8, MoeSched, true, 1>(C.lds, D, S, E);
}
__device__ __forceinline__ void phase_m2(const Args& A, const Ctx& C, int l) {
    LAS MoeTab* T = (LAS MoeTab*)(C.lds + LDS_TAB); LAS unsigned* ridx = (LAS unsigned*)(C.lds + LDS_TAB + 1024);
    moe_tables<false>(A, C, l, 4, T, ridx, DE);
    MoeSched S; S.T = T; S.ridx = ridx; S.A = (const char*)(A.ws + WS_DC); S.W = (const char*)(A.ws + WS_WDN); S.wstride_e = (size_t)D * DE; S.tstepB = (size_t)BM * DE; S.K = DE; S.arow_bytes = DE;
    EpiStoreTile E{A.ws + WS_PB, D, YSCALE / WSCALE}; gemm_phase<EpiStoreTile, MoeSched, false, 1>(C.lds, DE, S, E);
}

typedef float f32x16 __attribute__((ext_vector_type(16)));
#define MFMA32(a, b, c) __builtin_amdgcn_mfma_f32_32x32x16_bf16((a), (b), (c), 0, 0, 0)
__device__ __forceinline__ bf16x8 pack8(float a0, float a1, float a2, float a3, float a4, float a5, float a6, float a7) {
    u32x4 p; p.x = cvt2(a0, a1); p.y = cvt2(a2, a3); p.z = cvt2(a4, a5); p.w = cvt2(a6, a7); return __builtin_bit_cast(bf16x8, p); }
__device__ __forceinline__ float bflo(unsigned w) { return __uint_as_float(w << 16); }
__device__ __forceinline__ float bfhi(unsigned w) { return __uint_as_float(w & 0xffff0000u); }
__device__ __forceinline__ int vt_tile(int b, int h, int blk) { return (blk == 0 ? 128 + b : b * 64 + blk - 1) * NH + h; }

__device__ __forceinline__ float wave_incl_scan(float v, int lane) {
#pragma unroll
    for (int o = 1; o < 64; o <<= 1) { const float t = __shfl_up(v, o); v += (lane >= o) ? t : 0.f; }
    return v;
}
__device__ __forceinline__ void block_gates(const Args& A, int row0, int h, LAS float* bf, LAS float* bb, LAS float* lif, LAS float* lib, int tid) {
    const float* GATE = (const float*)(A.ws + WS_GATE);
    if (tid < 256) { const float* g = GATE + (size_t)(row0 + tid) * 16; lif[tid] = g[0 + h]; bf[tid] = g[4 + h]; lib[tid] = g[8 + h]; bb[tid] = g[12 + h]; }
    __syncthreads();
    const int lane = tid & 63, wv = tid >> 6;
    if (wv == 0) { f32x4 x = *(LAS f32x4*)(bf + 4 * lane); x.y += x.x; x.z += x.y; x.w += x.z; const float tot = wave_incl_scan(x.w, lane); const float ex = tot - x.w;
        x.x += ex; x.y += ex; x.z += ex; x.w += ex; *(LAS f32x4*)(bf + 4 * lane) = x; }
    if (wv == 1) { f32x4 y = *(LAS f32x4*)(bb + 4 * (63 - lane)); y.z += y.w; y.y += y.z; y.x += y.y; const float tot = wave_incl_scan(y.x, lane); const float ex = tot - y.x;
        y.x += ex; y.y += ex; y.z += ex; y.w += ex; *(LAS f32x4*)(bb + 4 * (63 - lane)) = y; }
    __syncthreads();
}
__device__ __forceinline__ void phase_s1(const Args& A, const Ctx& C, int l) {
    LAS float* bf = (LAS float*)C.lds; LAS float* bb = bf + 256; LAS float* lif = bb + 256; LAS float* lib = lif + 256; LAS float* af = lib + 256; LAS float* ab = af + 256;
    constexpr int KP = 528;
    LAS unsigned char* KTf = C.lds + 8192; LAS unsigned char* KTb = KTf + 128 * KP;
    const bf16* P = (const bf16*)(A.ws + WS_PB); const bf16* VT = (const bf16*)(A.ws + WS_VT);
    bf16* DC = (bf16*)(A.ws + WS_DC); float* DN = (float*)(A.ws + WS_DN); float* BT = (float*)(A.ws + WS_BTOT);
    const int r = C.lane & 31, hh = C.lane >> 5, w = C.wave;
    for (int it = C.bid; it < BATCH * NH * (NBLK - 1) + 2 * BATCH * NH; it += C.G) {
        const bool isctx = it >= BATCH * NH * (NBLK - 1); const int ci_ = it - BATCH * NH * (NBLK - 1);
        const int bh = isctx ? (ci_ >> 1) : it / (NBLK - 1), blk = isctx ? 0 : 1 + it % (NBLK - 1), h = bh % NH, b = bh / NH; const int u = bh * NBLK + blk; const int row0 = blk_row0(b, blk);
        const int dlo = isctx ? (ci_ & 1) : 0, dhi = isctx ? (ci_ & 1) + 1 : 2;
        block_gates(A, row0, h, bf, bb, lif, lib, C.tid);
        if (C.tid < 256) { af[C.tid] = __expf(bf[255] - bf[C.tid] + lif[C.tid]); ab[C.tid] = __expf(bb[0] - bb[C.tid] + lib[C.tid]); }
        if (C.tid == 0) { BT[u * 2 + 0] = bf[255]; BT[u * 2 + 1] = bb[0]; }
        __syncthreads();
        { const int sp = C.tid >> 2, dq = C.tid & 3, s0 = 2 * sp;
          const bf16* k0 = P + (size_t)(row0 + s0) * PW + NQ + h * DQK + 32 * dq;
          const float f0 = af[s0], f1 = af[s0 + 1], g0 = ab[s0], g1 = ab[s0 + 1];
#pragma unroll
          for (int c = 0; c < 4; ++c) { const u32x4 x0 = *(const u32x4*)(k0 + 8 * c), x1 = *(const u32x4*)(k0 + PW + 8 * c);
#pragma unroll
              for (int q = 0; q < 4; ++q) { const int d = 32 * dq + 8 * c + 2 * q;
                  const float a0 = bflo(x0[q]), a1 = bfhi(x0[q]), c0 = bflo(x1[q]), c1 = bfhi(x1[q]);
                  *(LAS unsigned*)(KTf + d * KP + s0 * 2) = cvt2(a0 * f0, c0 * f1); *(LAS unsigned*)(KTf + (d + 1) * KP + s0 * 2) = cvt2(a1 * f0, c1 * f1);
                  *(LAS unsigned*)(KTb + d * KP + s0 * 2) = cvt2(a0 * g0, c0 * g1); *(LAS unsigned*)(KTb + (d + 1) * KP + s0 * 2) = cvt2(a1 * g0, c1 * g1); } } }
        __syncthreads();
        if (C.tid < 256) { const int dir = C.tid >> 7, d = C.tid & 127; LAS const unsigned* kr = (LAS const unsigned*)((dir ? KTb : KTf) + d * KP); float s = 0.f;
            for (int i = 0; i < 128; ++i) { const unsigned x = kr[i]; s += bflo(x) + bfhi(x); }
            DN[(size_t)(u * 2 + dir) * DQK + d] = s; }
        const bf16* vt = VT + (size_t)vt_tile(b, h, blk) * 65536 + (size_t)(32 * w + r) * 256 + 8 * hh;
        bf16x8 av[16];
#pragma unroll
        for (int ks = 0; ks < 16; ++ks) av[ks] = *(const bf16x8*)(vt + 16 * ks);
#pragma unroll 1
        for (int dir = dlo; dir < dhi; ++dir) {
            LAS const unsigned char* KT = dir ? KTb : KTf;
            f32x16 acc[4];
#pragma unroll
            for (int dt = 0; dt < 4; ++dt)
#pragma unroll
                for (int i = 0; i < 16; ++i) acc[dt][i] = 0.f;
#pragma unroll
            for (int ks = 0; ks < 16; ++ks) {
#pragma unroll
                for (int dt = 0; dt < 4; ++dt) { const bf16x8 b0 = *(const LAS bf16x8*)(KT + (dt * 32 + r) * KP + (16 * ks + 8 * hh) * 2); acc[dt] = MFMA32(av[ks], b0, acc[dt]); }
                if ((ks & 3) == 3) asm volatile("" ::: "memory"); }
            bf16* dc = DC + (size_t)(u * 2 + dir) * DQK * DV + (size_t)(32 * w + 4 * hh) * DQK + r;
#pragma unroll
            for (int g = 0; g < 4; ++g) { bf16* pf = dc + g * 8 * DQK; asm volatile("" : "+v"(pf));
#pragma unroll
                for (int q = 0; q < 4; ++q)
#pragma unroll
                    for (int dt = 0; dt < 4; ++dt) pf[q * DQK + dt * 32] = (bf16)f2bf(acc[dt][4 * g + q]); }
        }
        __syncthreads();
    }
}
__device__ __forceinline__ void phase_s2(const Args& A, const Ctx& C) {
    const bf16* __restrict__ DC = (const bf16*)(A.ws + WS_DC); const float* __restrict__ DN = (const float*)(A.ws + WS_DN); const float* __restrict__ BT = (const float*)(A.ws + WS_BTOT);
    bf16* __restrict__ CST = (bf16*)(A.ws + WS_CST); float* __restrict__ NST = (float*)(A.ws + WS_NST);
    constexpr int EL4 = DQK * DV / 4;
    for (int g = C.bid * NT + C.tid; g < BATCH * NH * 2 * EL4; g += C.G * NT) {
        const int e4 = (g % EL4) * 4, ch = g / EL4, dir = ch & 1, bh = ch >> 1;
        f32x4 st = (f32x4){0.f, 0.f, 0.f, 0.f};
#pragma unroll 13
        for (int idx = 0; idx < NBLK; ++idx) {
            const int blk = dir == 0 ? idx : (idx == 0 ? 0 : NBLK - idx); const int u = bh * NBLK + blk;
            const float dec = __expf(BT[u * 2 + dir]);
            const f32x4 dc = bf4(*(const u32x2*)(DC + (size_t)(u * 2 + dir) * DQK * DV + e4));
            u32x2 o; o.x = cvt2(st.x, st.y); o.y = cvt2(st.z, st.w);
            *(u32x2*)(CST + (size_t)(u * 2 + dir) * DQK * DV + e4) = o;
            st = st * dec + dc;
        }
    }
    for (int g = C.bid * NT + C.tid; g < BATCH * NH * 2 * DQK; g += C.G * NT) {
        const int d = g % DQK, ch = g / DQK, dir = ch & 1, bh = ch >> 1; float st = 0.f;
        for (int idx = 0; idx < NBLK; ++idx) {
            const int blk = dir == 0 ? idx : (idx == 0 ? 0 : NBLK - idx); const int u = bh * NBLK + blk;
            NST[(size_t)(u * 2 + dir) * DQK + d] = st; st = __expf(BT[u * 2 + dir]) * st + DN[(size_t)(u * 2 + dir) * DQK + d];
        }
    }
}
__device__ __forceinline__ void lds_barrier() { asm volatile("s_waitcnt lgkmcnt(0)" ::: "memory"); __builtin_amdgcn_s_barrier(); asm volatile("" ::: "memory"); }
__device__ __forceinline__ void phase_s3(const Args& A, const Ctx& C, int l) {
    const int jl = l >> 1; const bool ctx_out = (l == 0);
    LAS float* bf = (LAS float*)C.lds; LAS float* bb = bf + 256; LAS float* gf = bb + 256; LAS float* gb = gf + 256;
    LAS float* nf = gb + 256; LAS float* nb = nf + 128; LAS float* ssx = nb + 128;
    LAS float* cf = ssx + 256; LAS float* cb = cf + 256;
    constexpr int KP = 272, OP = 528, CHB = 16384, NCHB = 4;
    LAS unsigned char* Kimg = C.lds + 8192;
    LAS unsigned char* CH = Kimg + 256 * KP;
    LAS unsigned char* OUT = Kimg;
    static_assert(8192 + 256 * KP + NCHB * CHB <= LDS_TAB_END && 8192 + 256 * OP <= LDS_TAB_END, "S3 LDS map");
    const bf16* P = (const bf16*)(A.ws + WS_PB); const bf16* VT = (const bf16*)(A.ws + WS_VT); unsigned char* HM = A.ws + WS_HM;
    const bf16* CST = (const bf16*)(A.ws + WS_CST); const float* NST = (const float*)(A.ws + WS_NST);
    const float* hg = A.in[10] + (size_t)jl * NV;
    const int w = C.wave;
    bf16x8 qf[8]; u32x4 kr8[8]; f32x4 gl;
#define S3_SKIP(u_) (((u_) % NBLK) == 0 && !ctx_out)
#define S3_LOAD_IN(u_) do { const int u2_ = (u_); const int blk_ = u2_ % NBLK, bh_ = u2_ / NBLK, h_ = bh_ % NH, b_ = bh_ / NH; const int row0_ = blk_row0(b_, blk_); \
        int tq_ = threadIdx.x; asm volatile("" : "+v"(tq_)); const int lq_ = tq_ & 63; \
        { const bf16* qr_ = P + (size_t)(row0_ + 32 * w + (lq_ & 31)) * PW + h_ * DQK + 8 * (lq_ >> 5); \
          _Pragma("unroll") for (int kk = 0; kk < 8; ++kk) qf[kk] = *(const bf16x8*)(qr_ + 16 * kk); } \
        { const bf16* kr_ = P + (size_t)(row0_ + (tq_ >> 4)) * PW + NQ + h_ * DQK + 8 * (tq_ & 15); \
          _Pragma("unroll") for (int i = 0; i < 8; ++i) kr8[i] = *(const u32x4*)(kr_ + (size_t)(32 * i) * PW); } \
        if (tq_ < 256) { const float* g_ = (const float*)(A.ws + WS_GATE) + (size_t)(row0_ + tq_) * 16 + h_; gl = (f32x4){g_[0], g_[4], g_[8], g_[12]}; } \
        else { const int t2_ = tq_ - 256; gl = (f32x4){NST[(size_t)(u2_ * 2 + (t2_ >> 7)) * DQK + (t2_ & 127)], 0.f, 0.f, 0.f}; } } while (0)
    int u = C.bid;
    while (u < NUNIT && S3_SKIP(u)) u += C.G;
    if (u < NUNIT) S3_LOAD_IN(u);
    while (u < NUNIT) {
        const int blk = u % NBLK, bh = u / NBLK, h = bh % NH, b = bh / NH; const int row0 = blk_row0(b, blk);
        int un = u + C.G;
        while (un < NUNIT && S3_SKIP(un)) un += C.G;
        const bf16* vtile = VT + (size_t)vt_tile(b, h, blk) * 65536;
        const bf16* ctile = CST + (size_t)(u * 2) * DQK * DV;
#define S3_DMA(c_) do { const int cc_ = (c_); const bool isv_ = cc_ < 8; int ld_ = threadIdx.x & 63; asm volatile("" : "+v"(ld_)); \
                const unsigned dlp_ = (unsigned)(((ld_ & 3) ^ ((ld_ >> 4) & 3)) * 16), drow_ = (unsigned)(32 * w + (ld_ >> 2)); \
                const unsigned long long gp_ = (unsigned long long)(isv_ ? (const char*)vtile + 64 * cc_ : (const char*)ctile + (cc_ >= 12 ? 2 * DQK * DV : 0) + 64 * ((cc_ - 8) & 3)); \
                const char* gb_ = (const char*)(((unsigned long long)(unsigned)__builtin_amdgcn_readfirstlane((int)(unsigned)(gp_ >> 32)) << 32) | (unsigned)__builtin_amdgcn_readfirstlane((int)(unsigned)gp_)); \
                _Pragma("unroll") for (int jj = 0; jj < 2; ++jj) \
                    asm volatile("s_mov_b32 m0, %2\n\ts_nop 0\n\tglobal_load_lds_dwordx4 %0, %1" :: "v"(((drow_ + 16u * jj) << (isv_ ? 9 : 8)) + dlp_), "s"(gb_), "s"((unsigned)(size_t)CH + (unsigned)w * 2048u + (unsigned)((cc_ & 3) * CHB + jj * 1024)) : "memory"); } while (0)
        S3_DMA(0); S3_DMA(1); S3_DMA(2);
        { int tu = threadIdx.x; asm volatile("" : "+v"(tu));
          if (tu < 256) { gf[tu] = gl.x; bf[tu] = gl.y; gb[tu] = gl.z; bb[tu] = gl.w; } else nf[tu - 256] = gl.x;
          { const int pc = tu & 15, s0 = tu >> 4, ps0 = (s0 & ~12) | ((s0 & 4) << 1) | ((s0 & 8) >> 1);
#pragma unroll
            for (int i = 0; i < 8; ++i) *(LAS u32x4*)(Kimg + (ps0 + 32 * i) * KP + pc * 16) = kr8[i]; }
          lds_barrier();
          const int lane = tu & 63, wv = tu >> 6;
          if (wv == 0) { f32x4 x = *(LAS f32x4*)(bf + 4 * lane); x.y += x.x; x.z += x.y; x.w += x.z; const float tot = wave_incl_scan(x.w, lane); const float ex = tot - x.w;
              x.x += ex; x.y += ex; x.z += ex; x.w += ex; *(LAS f32x4*)(bf + 4 * lane) = x; }
          if (wv == 1) { f32x4 y = *(LAS f32x4*)(bb + 4 * (63 - lane)); y.z += y.w; y.y += y.z; y.x += y.y; const float tot = wave_incl_scan(y.x, lane); const float ex = tot - y.x;
              y.x += ex; y.y += ex; y.z += ex; y.w += ex; *(LAS f32x4*)(bb + 4 * (63 - lane)) = y; }
          lds_barrier();
          if (tu < 256) { const float a0 = gf[tu] - bf[tu], a1 = gb[tu] - bb[tu]; gf[tu] = a0; gb[tu] = a1; cf[tu] = __expf(bf[tu | 31] + a0); cb[tu] = __expf(bb[tu & ~31] + a1); }
          lds_barrier(); }
        {
            int lz = threadIdx.x & 63; asm volatile("" : "+v"(lz));
            const int r = lz & 31, hh = lz >> 5;
            const int jt = w;
            const float bfj = bf[32 * jt + r], bbj = bb[32 * jt + r];
            float qnf = 0.f, qnb = 0.f;
#pragma unroll
            for (int kk = 0; kk < 8; ++kk) { u32x4 qq = __builtin_bit_cast(u32x4, qf[kk]); asm volatile("" : "+v"(qq));
                const int d = 16 * kk + 8 * hh;
                const f32x4 n0 = *(const LAS f32x4*)(nf + d), n1 = *(const LAS f32x4*)(nf + d + 4), m0 = *(const LAS f32x4*)(nb + d), m1 = *(const LAS f32x4*)(nb + d + 4);
                qnf += (bflo(qq.x) * n0.x + bfhi(qq.x) * n0.y) + (bflo(qq.y) * n0.z + bfhi(qq.y) * n0.w) + (bflo(qq.z) * n1.x + bfhi(qq.z) * n1.y) + (bflo(qq.w) * n1.z + bfhi(qq.w) * n1.w);
                qnb += (bflo(qq.x) * m0.x + bfhi(qq.x) * m0.y) + (bflo(qq.y) * m0.z + bfhi(qq.y) * m0.w) + (bflo(qq.z) * m1.x + bfhi(qq.z) * m1.y) + (bflo(qq.w) * m1.z + bfhi(qq.w) * m1.w);
                if (kk & 1) asm volatile("" ::: "memory"); }
            qnf += __shfl_xor(qnf, 32); qnb += __shfl_xor(qnb, 32);
            float denf = 0.f, denb = 0.f;
#pragma unroll 1
            for (int kt = 0; kt < 8; ++kt) {
                f32x16 c;
#pragma unroll
                for (int i = 0; i < 16; ++i) c[i] = 0.f;
#pragma unroll
                for (int kk = 0; kk < 8; ++kk) { const bf16x8 a = *(const LAS bf16x8*)(Kimg + (kt * 32 + r) * KP + (16 * kk + 8 * hh) * 2); c = MFMA32(a, qf[kk], c); }
                if (kt == jt) {
#pragma unroll
                    for (int g = 0; g < 4; ++g) { const int sl0 = 16 * (g >> 1) + 8 * hh + 4 * (g & 1);
                        const f32x4 g4f = *(const LAS f32x4*)(gf + kt * 32 + sl0), g4b = *(const LAS f32x4*)(gb + kt * 32 + sl0);
#pragma unroll
                        for (int q = 0; q < 4; ++q) { const int sl = sl0 + q; const float cv = c[4 * g + q];
                            denf += cv * __expf((sl <= r) ? bfj + g4f[q] : -1.0e30f); denb += cv * __expf((sl >= r) ? bbj + g4b[q] : -1.0e30f); } }
                } else {
                    LAS const float* cx = (kt < jt ? cf : cb) + kt * 32 + 8 * hh; float sm = 0.f;
#pragma unroll
                    for (int g = 0; g < 4; ++g) { const f32x4 c4 = *(const LAS f32x4*)(cx + 16 * (g >> 1) + 4 * (g & 1)); sm += (c[4 * g] * c4.x + c[4 * g + 1] * c4.y) + (c[4 * g + 2] * c4.z + c[4 * g + 3] * c4.w); }
                    if (kt < jt) denf += sm * __expf(bfj - bf[kt * 32 + 31]); else denb += sm * __expf(bbj - bb[kt * 32]);
                }
            }
            denf += __shfl_xor(denf, 32); denb += __shfl_xor(denb, 32);
            const float ebf = __expf(bfj), ebb = __expf(bbj);
            denf += ebf * qnf; denb += ebb * qnb;
            const float rf = 1.0f / fmaxf(fabsf(denf), 1.0f), rb = 1.0f / fmaxf(fabsf(denb), 1.0f);
            const float scf = ebf * rf, scb = ebb * rb;
            unsigned wdg[8];
#pragma unroll
            for (int g = 0; g < 4; ++g) { const int sl0 = 16 * (g >> 1) + 8 * hh + 4 * (g & 1);
                const f32x4 g4f = *(const LAS f32x4*)(gf + jt * 32 + sl0), g4b = *(const LAS f32x4*)(gb + jt * 32 + sl0);
                float wv[4];
#pragma unroll
                for (int q = 0; q < 4; ++q) { const int sl = sl0 + q; wv[q] = rf * __expf((sl <= r) ? bfj + g4f[q] : -1.0e30f) + rb * __expf((sl >= r) ? bbj + g4b[q] : -1.0e30f); }
                wdg[2 * g] = cvt2(wv[0], wv[1]); wdg[2 * g + 1] = cvt2(wv[2], wv[3]); }
            f32x16 acc[8];
#pragma unroll
            for (int et = 0; et < 8; ++et)
#pragma unroll
                for (int i = 0; i < 16; ++i) acc[et][i] = 0.f;
            asm volatile("s_waitcnt vmcnt(0)" ::: "memory");
            const int swz = (r >> 2) & 3;
#pragma unroll 1
            for (int ci = 0; ci < 8; ++ci) {
                if (ci) asm volatile("s_waitcnt vmcnt(4)" ::: "memory");
                lds_barrier();
                S3_DMA(ci + 3);
                LAS const unsigned char* CHc = CH + (ci & 3) * CHB;
                { const int kt = ci;
                        f32x16 c;
#pragma unroll
                        for (int i = 0; i < 16; ++i) c[i] = 0.f;
#pragma unroll
                        for (int kk = 0; kk < 8; ++kk) { const bf16x8 a = *(const LAS bf16x8*)(Kimg + (kt * 32 + r) * KP + (16 * kk + 8 * hh) * 2); c = MFMA32(a, qf[kk], c); }
                        float p[16];
                        if (kt == jt) {
#pragma unroll
                            for (int i = 0; i < 8; ++i) { p[2 * i] = c[2 * i] * bflo(wdg[i]); p[2 * i + 1] = c[2 * i + 1] * bfhi(wdg[i]); }
                        } else {
                            LAS const float* cx = (kt < jt ? cf : cb) + kt * 32 + 8 * hh;
                            const float rw = (kt < jt) ? rf * __expf(bfj - bf[kt * 32 + 31]) : rb * __expf(bbj - bb[kt * 32]);
#pragma unroll
                            for (int g = 0; g < 4; ++g) { const f32x4 c4 = *(const LAS f32x4*)(cx + 16 * (g >> 1) + 4 * (g & 1));
                                p[4 * g] = c[4 * g] * (c4.x * rw); p[4 * g + 1] = c[4 * g + 1] * (c4.y * rw); p[4 * g + 2] = c[4 * g + 2] * (c4.z * rw); p[4 * g + 3] = c[4 * g + 3] * (c4.w * rw); }
                        }
                        const bf16x8 pa0 = pack8(p[0], p[1], p[2], p[3], p[4], p[5], p[6], p[7]), pa1 = pack8(p[8], p[9], p[10], p[11], p[12], p[13], p[14], p[15]);
#pragma unroll
                        for (int et = 0; et < 8; ++et) { LAS const unsigned char* vb = CHc + (et * 32 + r) * 64;
                            const bf16x8 a0 = *(const LAS bf16x8*)(vb + ((hh ^ swz) << 4)), a1 = *(const LAS bf16x8*)(vb + (((2 + hh) ^ swz) << 4));
                            acc[et] = MFMA32(a0, pa0, acc[et]); acc[et] = MFMA32(a1, pa1, acc[et]);
                            if (et & 1) asm volatile("" ::: "memory"); }
                }
            }
#pragma unroll
            for (int ci = 8; ci < 16; ++ci) {
                if (ci <= 13) asm volatile("s_waitcnt vmcnt(4)" ::: "memory"); else if (ci == 14) asm volatile("s_waitcnt vmcnt(2)" ::: "memory"); else asm volatile("s_waitcnt vmcnt(0)" ::: "memory");
                lds_barrier();
                if (ci + 3 < 16) S3_DMA(ci + 3);
                LAS const unsigned char* CHc = CH + (ci & 3) * CHB;
                {
                    const int dir = (ci - 8) >> 2, dq = (ci - 8) & 3;
                    const float sc = dir ? scb : scf;
#pragma unroll
                    for (int k2 = 0; k2 < 2; ++k2) { const u32x4 qq = __builtin_bit_cast(u32x4, qf[2 * dq + k2]);
                        const bf16x8 qs = pack8(bflo(qq.x) * sc, bfhi(qq.x) * sc, bflo(qq.y) * sc, bfhi(qq.y) * sc, bflo(qq.z) * sc, bfhi(qq.z) * sc, bflo(qq.w) * sc, bfhi(qq.w) * sc);
#pragma unroll
                        for (int et = 0; et < 8; ++et) { const bf16x8 a = *(const LAS bf16x8*)(CHc + (et * 32 + r) * 64 + (((2 * k2 + hh) ^ swz) << 4)); acc[et] = MFMA32(a, qs, acc[et]);
                            if ((et & 3) == 3) asm volatile("" ::: "memory"); } }
                }
            }
            u32x4 ov[16]; f32x4 g0, g1;
            { int tz = threadIdx.x & 63; asm volatile("" : "+v"(tz)); const int pc = tz & 31, lr0 = tz >> 5;
              g0 = *(const f32x4*)(hg + h * DV + 8 * pc); g1 = *(const f32x4*)(hg + h * DV + 8 * pc + 4);
#pragma unroll
              for (int i = 0; i < 16; ++i) ov[i] = *(const u32x4*)(P + (size_t)(row0 + 32 * w + lr0 + 2 * i) * PW + 2 * NQ + NV + h * DV + 8 * pc); }
            float ss = 0.f;
#pragma unroll
            for (int et = 0; et < 8; ++et)
#pragma unroll
                for (int i = 0; i < 16; ++i) ss += acc[et][i] * acc[et][i];
            ss += __shfl_xor(ss, 32);
            const float rs = 1.0f / sqrtf(ss * (1.0f / DV) + EPS);
            lds_barrier();
            { LAS unsigned char* ob = OUT + (w * 32 + r) * OP + (4 * hh) * 2;
#pragma unroll
              for (int et = 0; et < 8; ++et)
#pragma unroll
                  for (int g = 0; g < 4; ++g) { u32x2 o; o.x = cvt2(acc[et][4 * g + 0] * rs, acc[et][4 * g + 1] * rs); o.y = cvt2(acc[et][4 * g + 2] * rs, acc[et][4 * g + 3] * rs);
                      *(LAS u32x2*)(ob + (et * 32 + 8 * g) * 2) = o; } }
            asm volatile("s_waitcnt lgkmcnt(0)" ::: "memory");
            S3_LOAD_IN(un < NUNIT ? un : u);
            { int tz = threadIdx.x & 63; asm volatile("" : "+v"(tz)); const int pc = tz & 31, lr0 = tz >> 5;
#pragma unroll
              for (int i = 0; i < 16; ++i) { const int lr = 32 * w + lr0 + 2 * i; const int grow = row0 + lr;
                  const u32x4 hv = *(const LAS u32x4*)(OUT + lr * OP + pc * 16);
                  const f32x4 o0 = (f32x4){bflo(hv.x) * g0.x * bflo(ov[i].x), bfhi(hv.x) * g0.y * bfhi(ov[i].x), bflo(hv.y) * g0.z * bflo(ov[i].y), bfhi(hv.y) * g0.w * bfhi(ov[i].y)};
                  const f32x4 o1 = (f32x4){bflo(hv.z) * g1.x * bflo(ov[i].z), bfhi(hv.z) * g1.y * bfhi(ov[i].z), bflo(hv.w) * g1.z * bflo(ov[i].w), bfhi(hv.w) * g1.w * bfhi(ov[i].w)};
                  *(u32x2*)(HM + (size_t)grow * D + h * DV + 8 * pc) = (u32x2){pack_i8(o0 * (127.0f / HMR)), pack_i8(o1 * (127.0f / HMR))};
                  if ((i & 3) == 3) asm volatile("" ::: "memory"); } }
        }
#undef S3_DMA
        lds_barrier();
        u = un;
    }
#undef S3_LOAD_IN
#undef S3_SKIP
}

#define XB_TMO      128
#define XB_XCNT(j)  (256  + 64 * (j))
#define XB_XSUB(j)  (1280 + 64 * (j))
#define XB_XGEN(j)  (2304 + 64 * (j))
#define XB_TOP      3328
#define XB_TOPGEN   3392
#define XCD_BAR_WORDS 3456
#define XB_SPIN_CAP (1u << 18)

__device__ __forceinline__ unsigned xb_ld(unsigned* p)              { return __hip_atomic_load(p, __ATOMIC_RELAXED, __HIP_MEMORY_SCOPE_AGENT); }
__device__ __forceinline__ unsigned xb_add(unsigned* p, unsigned v) { return __hip_atomic_fetch_add(p, v, __ATOMIC_RELAXED, __HIP_MEMORY_SCOPE_AGENT); }
__device__ __forceinline__ unsigned xb_xcc_id() { return (unsigned)__builtin_amdgcn_s_getreg((3 << 11) | 20) & 0xFu; }
#define XB_SPIN(cond, bar) do { unsigned _sp = 0; while (cond) { __builtin_amdgcn_s_sleep(1); \
    if ((++_sp & 255u) == 0u) { if (xb_ld(&(bar)[XB_TMO])) break; if (_sp > XB_SPIN_CAP) { atomicAdd(&(bar)[XB_TMO], 1u); break; } } } } while (0)

struct XcdBarrier {
    unsigned* bar; unsigned x;
    volatile LAS unsigned* st;
};

__device__ __forceinline__ XcdBarrier xcd_barrier_post(unsigned* bar, volatile LAS unsigned* st) {
    XcdBarrier b; b.bar = bar; b.x = xb_xcc_id(); b.st = st;
    if (threadIdx.x == 0) (void)xb_add(&bar[XB_XCNT(b.x)], 1u);
    return b;
}
__device__ __forceinline__ void xcd_barrier_complete(unsigned* bar, unsigned x, unsigned& nloc, unsigned& nx) {
    const unsigned G = gridDim.x * gridDim.y * gridDim.z;
    unsigned sum, cnt, mine, sp = 0u;
    for (;;) {
        sum = 0u; cnt = 0u; mine = 0u;
#pragma unroll
        for (unsigned j = 0; j < 16; ++j) { const unsigned c = xb_ld(&bar[XB_XCNT(j)]); sum += c; cnt += (c > 0u) ? 1u : 0u; mine = (j == x) ? c : mine; }
        if (sum == G) break;
        __builtin_amdgcn_s_sleep(1);
        if ((++sp & 255u) == 0u) { if (xb_ld(&bar[XB_TMO])) break; if (sp > XB_SPIN_CAP) { atomicAdd(&bar[XB_TMO], 1u); break; } }
    }
    nloc = mine > 0u ? mine : 1u; nx = cnt > 0u ? cnt : 1u;
}

__device__ __forceinline__ void xcd_barrier(const XcdBarrier& b) {
    asm volatile("s_waitcnt vmcnt(0)" ::: "memory");
    __syncthreads();
    if (threadIdx.x == 0) {
        unsigned* bar = b.bar;
        __builtin_amdgcn_s_waitcnt(0);
        unsigned nloc = b.st[0], nx = b.st[1];
        if (nloc == 0u) { xcd_barrier_complete(bar, b.x, nloc, nx); b.st[0] = nloc; b.st[1] = nx; }
        const unsigned old = xb_add(&bar[XB_XSUB(b.x)], 1u);
        const unsigned gen = old / nloc;
        if (old + 1u == (gen + 1u) * nloc) {
            __builtin_amdgcn_fence(__ATOMIC_RELEASE, "agent");
            asm volatile("s_waitcnt vmcnt(0)" ::: "memory");
            const unsigned og = xb_add(&bar[XB_TOP], 1u);
            const unsigned tg = og / nx;
            if (og + 1u == (tg + 1u) * nx) xb_add(&bar[XB_TOPGEN], 1u);
            else XB_SPIN(xb_ld(&bar[XB_TOPGEN]) == tg, bar);
            __builtin_amdgcn_fence(__ATOMIC_ACQUIRE, "agent");
            xb_add(&bar[XB_XGEN(b.x)], 1u);
            asm volatile("s_waitcnt vmcnt(0)" ::: "memory");
        } else {
            XB_SPIN(xb_ld(&bar[XB_XGEN(b.x)]) == gen, bar);
            __builtin_amdgcn_fence(__ATOMIC_ACQUIRE, "agent");
            asm volatile("s_waitcnt vmcnt(0)" ::: "memory");
        }
    }
    __syncthreads();
}


constexpr int LDS_BYTES = 152 * 1024;
constexpr int CW_BAR = 16384;
static_assert((CW_BAR + XCD_BAR_WORDS) * 4 <= (int)CTL_BYTES, "ctl");
#ifndef MK_MULTI
#define MK_MULTI 0
#endif
#define IN(p) (lo <= (p) && (p) < hi)
#define SEAM(p) do { if ((p) + 1 < hi) { XcdBarrier b_; b_.bar = (unsigned*)(load_args().ws + WS_CTL) + CW_BAR; b_.x = xb_xcc_id(); b_.st = (volatile LAS unsigned*)(C.lds + LDS_BYTES - 16); xcd_barrier(b_); } } while (0)
#define CAS __attribute__((address_space(4)))
__device__ __forceinline__ Args load_args() {
#if defined(__HIP_DEVICE_COMPILE__)
    const CAS Args* p = (const CAS Args*)__builtin_amdgcn_kernarg_segment_ptr(); asm volatile("" : "+s"(p));
    Args a; for (int i = 0; i < 22; ++i) a.in[i] = p->in[i]; a.out = p->out; a.ws = p->ws; a.lo = p->lo; a.hi = p->hi; return a;
#else
    return Args{};
#endif
}
__device__ __forceinline__ Ctx fresh(const Ctx& C) { Ctx R = C; int tz = threadIdx.x; asm volatile("" : "+v"(tz)); R.tid = tz; R.lane = tz & 63; return R; }
template <int L> __device__ __forceinline__ void layer_phases(const Args& args, const Ctx& C, int bar, int lo, int hi) {
    constexpr int pb = 16 * L;
    if (IN(pb + 1)) { phase_r1(load_args(), fresh(C), L); SEAM(pb + 1); }
    if (IN(pb + 2)) { phase_g1(load_args(), fresh(C), L); SEAM(pb + 2); }
    if constexpr ((L & 1) == 0) {
        if (IN(pb + 3)) { phase_s1(load_args(), fresh(C), L); SEAM(pb + 3); }
        if (IN(pb + 4)) { phase_s2(load_args(), fresh(C)); SEAM(pb + 4); }
        if (IN(pb + 5)) { phase_s3(load_args(), fresh(C), L); SEAM(pb + 5); }
    } else {
        if (IN(pb + 3)) { phase_conv(load_args(), fresh(C), L); SEAM(pb + 3); }
    }
    if (IN(pb + 6)) { phase_g2(load_args(), fresh(C), L); SEAM(pb + 6); }
    if (IN(pb + 7)) { phase_r2(load_args(), fresh(C), L); SEAM(pb + 7); }
    if (IN(pb + 8)) { phase_m1(load_args(), fresh(C), L); SEAM(pb + 8); }
    if (IN(pb + 9)) { phase_m2(load_args(), fresh(C), L); SEAM(pb + 9); }
}
__global__ void __launch_bounds__(NT, 2) fwd_kernel(Args args) {
    extern __shared__ __attribute__((aligned(16))) unsigned char lds_raw[];
    Ctx C; C.lds = (LAS unsigned char*)lds_raw; C.tid = threadIdx.x; C.lane = C.tid & 63; C.wave = __builtin_amdgcn_readfirstlane(C.tid >> 6); C.G = gridDim.x; C.bid = blockIdx.x; C.a = &args;
    const int lo = args.lo, hi = args.hi;
    volatile LAS unsigned* xbw = (volatile LAS unsigned*)(C.lds + LDS_BYTES - 16);
    if (C.tid < 4) xbw[C.tid] = 0u;
    __syncthreads();
    if (hi - lo > 1) (void)xcd_barrier_post((unsigned*)(args.ws + WS_CTL) + CW_BAR, xbw);
    const int bar = 0; (void)bar;
    if (IN(0)) { phase_mod(load_args(), fresh(C)); __syncthreads(); phase_cvt_mixer(load_args(), fresh(C)); SEAM(0); }
    layer_phases<0>(args, C, bar, lo, hi);
    layer_phases<1>(args, C, bar, lo, hi);
    layer_phases<2>(args, C, bar, lo, hi);
    layer_phases<3>(args, C, bar, lo, hi);
    if (IN(64)) phase_final(load_args(), fresh(C));
}
#undef IN
#undef SEAM

extern "C" void kernel_launch(void* const* d_in, const int* in_sizes, int n_in, void* d_out, int out_size, void* d_ws, size_t ws_size, hipStream_t stream) {
    static int grid = 0;
    if (grid == 0) {
        if (n_in != 22 || out_size != NL * D || ws_size < WS_END) { fprintf(stderr, "kernel_launch: unexpected shapes (n_in %d out %d ws %zu)\n", n_in, out_size, ws_size); grid = -1; return; }
        int dev = 0, cus = 0, per_cu = 0;
        if (hipGetDevice(&dev) != hipSuccess || hipDeviceGetAttribute(&cus, hipDeviceAttributeMultiprocessorCount, dev) != hipSuccess) { grid = -1; return; }
        if (hipFuncSetAttribute((const void*)fwd_kernel, hipFuncAttributeMaxDynamicSharedMemorySize, LDS_BYTES) != hipSuccess) { grid = -1; return; }
        if (hipOccupancyMaxActiveBlocksPerMultiprocessor(&per_cu, (const void*)fwd_kernel, NT, LDS_BYTES) != hipSuccess || per_cu < 1) { fprintf(stderr, "kernel_launch: occupancy query says %d\n", per_cu); }
        (void)hipGetLastError();
        grid = cus;
    }
    if (grid < 0) return;
    (void)hipMemsetAsync((char*)d_ws + WS_CTL, 0, CTL_BYTES, stream);
    Args a{};
    for (int i = 0; i < 22; ++i) a.in[i] = (const float*)d_in[i];
    a.out = (float*)d_out; a.ws = (unsigned char*)d_ws;
#if MK_MULTI
    int phases[64]; int np = 0;
    phases[np++] = 0;
    for (int l = 0; l < DEPTH; ++l) { const int pb = 16 * l; phases[np++] = pb + 1; phases[np++] = pb + 2; phases[np++] = pb + 3;
        if ((l & 1) == 0) { phases[np++] = pb + 4; phases[np++] = pb + 5; }
        phases[np++] = pb + 6; phases[np++] = pb + 7; phases[np++] = pb + 8; phases[np++] = pb + 9; }
    phases[np++] = 64;
    for (int i = 0; i < np; ++i) { a.lo = phases[i]; a.hi = phases[i] + 1; hipLaunchKernelGGL(fwd_kernel, dim3(grid), dim3(NT), LDS_BYTES, stream, a); }
#else
    a.lo = 0; a.hi = 65;
    hipLaunchKernelGGL(fwd_kernel, dim3(grid), dim3(NT), LDS_BYTES, stream, a);
#ifdef PROBE_PHASES
    { const int pp[] = {PROBE_PHASES};
      for (int rep = 0; rep < PROBE_REPS; ++rep) for (unsigned i = 0; i < sizeof(pp) / sizeof(pp[0]); ++i) { a.lo = pp[i]; a.hi = pp[i] + 1; hipLaunchKernelGGL(fwd_kernel, dim3(grid), dim3(NT), LDS_BYTES, stream, a); } }
#endif
#endif
}
```

```cpp
#include <hip/hip_runtime.h>
#include <cstdio>
#include <cstdint>

#define LAS __attribute__((address_space(3)))
typedef unsigned short bf16;
typedef float f32x4 __attribute__((ext_vector_type(4)));
typedef unsigned u32x4 __attribute__((ext_vector_type(4)));
typedef unsigned u32x2 __attribute__((ext_vector_type(2)));
typedef int i32x4r __attribute__((ext_vector_type(4)));

constexpr int D = 1024, BATCH = 2, SEQ = 16384, DEPTH = 4, CTXL = 256;
constexpr int NL = BATCH * SEQ, NCX = BATCH * CTXL, NR = NL + NCX;
constexpr int NH = 4, DQK = 128, DV = 256, NQ = 512, NV = 1024, PROJ = 3088, PW = 3072;
constexpr int NGRP = 4, EPG = 8, NE = 32, DE = 512;
constexpr int NBLK = 65;
constexpr int NUNIT = BATCH * NH * NBLK;
constexpr int CAP = NR;
constexpr int YROWS = 74752;
constexpr float EPS = 1e-6f;
constexpr float WSCALE = 32.0f;
constexpr float YSCALE = 4.0f;
constexpr int NT = 512, NW = 8;
constexpr int LDS_TAB_END = 152 * 1024 - 16;

constexpr size_t MiB = 1u << 20;
constexpr size_t WS_CTL = 0, CTL_BYTES = 1 * MiB;
constexpr size_t WS_MOD = 1 * MiB;
constexpr size_t WS_GATE = 2 * MiB;
constexpr size_t WS_TOKSLOT = 5 * MiB;
constexpr size_t WS_TOKW = 6 * MiB;
constexpr size_t WS_SLOTTOK = 7 * MiB;
constexpr size_t WS_DN = 12 * MiB;
constexpr size_t WS_NST = 13 * MiB;
constexpr size_t WS_BTOT = 14 * MiB;
constexpr size_t WS_RSC = 15 * MiB;
constexpr size_t WS_LAT = 16 * MiB;
constexpr size_t WS_HB = 146 * MiB;
constexpr size_t WS_PB = 211 * MiB;
constexpr size_t WS_HM = 406 * MiB;
constexpr size_t WS_DC = 471 * MiB;
constexpr size_t WS_CST = 601 * MiB;
constexpr size_t WS_VT = 666 * MiB;
constexpr size_t WS_WAIN = 731 * MiB;
constexpr size_t WS_WBIN = 743 * MiB;
constexpr size_t WS_WAOUT = 755 * MiB;
constexpr size_t WS_WBOUT = 759 * MiB;
constexpr size_t WS_WGU = 763 * MiB;
constexpr size_t WS_WDN = 827 * MiB;
constexpr size_t WS_H8 = 843 * MiB;
constexpr size_t WS_END = 880 * MiB;
constexpr int CW_WMAX = 256;
constexpr int CW_CNT = 1024, CNT_STRIDE = 64;

struct Args { const float* in[22]; float* out; unsigned char* ws; int lo, hi; };

typedef short bf16x8 __attribute__((ext_vector_type(8)));
typedef float f32x2 __attribute__((ext_vector_type(2)));
typedef __bf16 bf16x2_t __attribute__((ext_vector_type(2)));
__device__ __forceinline__ unsigned cvt2(float lo, float hi) { const f32x2 v = {lo, hi}; return __builtin_bit_cast(unsigned, __builtin_convertvector(v, bf16x2_t)); }
__device__ __forceinline__ float bf2f(bf16 v) { return __uint_as_float(((unsigned)v) << 16); }
__device__ __forceinline__ unsigned f2bf(float f) { unsigned u = __float_as_uint(f); return (u + 0x7fffu + ((u >> 16) & 1u)) >> 16; }
__device__ __forceinline__ unsigned pk2(float lo, float hi) { return f2bf(lo) | (f2bf(hi) << 16); }
template <int CTRL, int ROWMASK> __device__ __forceinline__ float dpp_mov(float x) { return __int_as_float(__builtin_amdgcn_update_dpp(0, __float_as_int(x), CTRL, ROWMASK, 0xf, false)); }
__device__ __forceinline__ float wave_sum(float v) {
    v += dpp_mov<0xB1, 0xf>(v); v += dpp_mov<0x4E, 0xf>(v); v += dpp_mov<0x141, 0xf>(v); v += dpp_mov<0x140, 0xf>(v);
    v += dpp_mov<0x142, 0xA>(v); v += dpp_mov<0x143, 0xC>(v);
    return __int_as_float(__builtin_amdgcn_readlane(__float_as_int(v), 63));
}
__device__ __forceinline__ float wave_max_nn(float v) {
    v = fmaxf(v, dpp_mov<0xB1, 0xf>(v)); v = fmaxf(v, dpp_mov<0x4E, 0xf>(v)); v = fmaxf(v, dpp_mov<0x141, 0xf>(v)); v = fmaxf(v, dpp_mov<0x140, 0xf>(v));
    v = fmaxf(v, dpp_mov<0x142, 0xA>(v)); v = fmaxf(v, dpp_mov<0x143, 0xC>(v));
    return __int_as_float(__builtin_amdgcn_readlane(__float_as_int(v), 63));
}
__device__ __forceinline__ unsigned pack_i8(f32x4 v) {
    const int a = (int)__builtin_rintf(fminf(fmaxf(v.x, -127.f), 127.f)), b = (int)__builtin_rintf(fminf(fmaxf(v.y, -127.f), 127.f)), c = (int)__builtin_rintf(fminf(fmaxf(v.z, -127.f), 127.f)), d = (int)__builtin_rintf(fminf(fmaxf(v.w, -127.f), 127.f));
    return (unsigned)(a & 255) | ((unsigned)(b & 255) << 8) | ((unsigned)(c & 255) << 16) | ((unsigned)d << 24);
}
__device__ __forceinline__ float sigmoidf_(float x) { return 1.f / (1.f + __expf(-x)); }
__device__ __forceinline__ float siluf_(float x) { return x / (1.f + __expf(-x)); }
__device__ __forceinline__ float logsigmoidf_(float x) { return fminf(x, 0.f) - log1pf(__expf(-fabsf(x))); }
__device__ __forceinline__ int blk_row0(int b, int blk) { return blk == 0 ? NL + b * CTXL : b * SEQ + (blk - 1) * 256; }
__device__ __forceinline__ int mod_vec_of_row(int row) { return row < NL ? row / SEQ : 2; }

struct Ctx {
    LAS unsigned char* lds; int tid, lane, wave, G, bid;
    const Args* a;
};

__device__ __forceinline__ int expert_block_prefix(const unsigned* cnt, int lane, int& nb) {
    nb = lane < NE ? ((int)cnt[lane * CNT_STRIDE] + 255) / 256 : 0; int v = nb;
#pragma unroll
    for (int o = 1; o < 64; o <<= 1) { const int t = __shfl_up(v, o); v += (lane >= o) ? t : 0; }
    return v - nb;
}
__device__ __forceinline__ void slot_bases(const Args& A, int l, LAS int* sb, int tid) {
    if (tid < 64) { int nb; const int ex = expert_block_prefix((const unsigned*)(A.ws + WS_CTL) + CW_CNT + l * 32 * CNT_STRIDE, tid, nb); if (tid <= NE) sb[tid] = ex * 256; }
    __syncthreads();
}

__device__ __forceinline__ void phase_mod(const Args& A, const Ctx& C) {
    LAS float* sc = (LAS float*)C.lds;
    LAS float* red = sc + 3072;
    const float* c = A.in[1]; const float* cc = A.in[3];
    for (int i = C.tid; i < 3072; i += NT) { const float v = i < 2048 ? c[i] : cc[i - 2048]; sc[i] = siluf_(v); }
    __syncthreads();
    float* MOD = (float*)(A.ws + WS_MOD);
    for (int u = C.bid; u < DEPTH * 96; u += C.G) {
        const int l = u / 96, cg = u % 96, col = cg * 64 + C.lane;
        const float* w = A.in[4] + (size_t)l * D * 6 * D + col;
        float a0 = 0.f, a1 = 0.f, a2 = 0.f;
#pragma unroll 32
        for (int k = C.wave * 128; k < C.wave * 128 + 128; ++k) { const float wv = w[(size_t)k * 6 * D]; a0 += sc[k] * wv; a1 += sc[1024 + k] * wv; a2 += sc[2048 + k] * wv; }
        red[(C.wave * 3 + 0) * 64 + C.lane] = a0; red[(C.wave * 3 + 1) * 64 + C.lane] = a1; red[(C.wave * 3 + 2) * 64 + C.lane] = a2;
        __syncthreads();
        if (C.tid < 192) { const int v = C.tid / 64, ln = C.tid % 64; float s = 0.f;
            for (int w8 = 0; w8 < 8; ++w8) s += red[(w8 * 3 + v) * 64 + ln];
            MOD[(size_t)(l * 3 + v) * 6 * D + cg * 64 + ln] = s + A.in[5][(size_t)l * 6 * D + cg * 64 + ln]; }
        __syncthreads();
    }
}

__device__ __forceinline__ void load_row_f32(const float* p, int lane, f32x4 (&v)[4]) {
#pragma unroll
    for (int j = 0; j < 4; ++j) v[j] = *(const f32x4*)(p + 4 * lane + 256 * j);
}
__device__ __forceinline__ void load_row_bf16(const bf16* p, int lane, f32x4 (&v)[4]) {
#pragma unroll
    for (int j = 0; j < 4; ++j) { const u32x2 w = *(const u32x2*)(p + 4 * lane + 256 * j);
        v[j] = (f32x4){__uint_as_float(w.x << 16), __uint_as_float(w.x & 0xffff0000u), __uint_as_float(w.y << 16), __uint_as_float(w.y & 0xffff0000u)}; }
}
__device__ __forceinline__ void store_row_bf16(bf16* p, int lane, const f32x4 (&v)[4]) {
#pragma unroll
    for (int j = 0; j < 4; ++j) { u32x2 w; w.x = pk2(v[j].x, v[j].y); w.y = pk2(v[j].z, v[j].w); *(u32x2*)(p + 4 * lane + 256 * j) = w; }
}
constexpr int CVT_IG = (D / 64) * (DE / 32), CVT_ID = (DE / 64) * (D / 32), CVT_PER = 2 * CVT_IG + CVT_ID, CVT_ITEMS = NE * CVT_PER;
constexpr int CVT_Q = 24;
__device__ __forceinline__ void cvt_moe_items(const Args& A, const Ctx& C, int l, int it0, int end, int stride);
__device__ __forceinline__ void cvt_win_i8(const Args& A, const Ctx& C);
__device__ __forceinline__ int cvt_t2(int l, int G);
struct RowVec { f32x4 a[4], s[4], g[4]; };
__device__ __forceinline__ void load_rowvec(RowVec& R, const float* ng, const float* sh, const float* sc, const float* gt, int lane) {
    f32x4 n[4], c[4]; load_row_f32(ng, lane, n); load_row_f32(sc, lane, c); load_row_f32(sh, lane, R.s); if (gt) load_row_f32(gt, lane, R.g);
#pragma unroll
    for (int q = 0; q < 4; ++q) R.a[q] = n[q] * (1.f + c[q]);
}
__device__ __forceinline__ void load_row_bf16raw(const bf16* p, int lane, u32x2 (&v)[4]) {
#pragma unroll
    for (int j = 0; j < 4; ++j) v[j] = *(const u32x2*)(p + 4 * lane + 256 * j);
}
__device__ __forceinline__ void store_row_fp8(unsigned char* p, int lane, const f32x4 (&v)[4]) {
#pragma unroll
    for (int j = 0; j < 4; ++j) { int w = 0; w = __builtin_amdgcn_cvt_pk_fp8_f32(v[j].x, v[j].y, w, false); w = __builtin_amdgcn_cvt_pk_fp8_f32(v[j].z, v[j].w, w, true); *(unsigned*)(p + 4 * lane + 256 * j) = (unsigned)w; }
}
__device__ __forceinline__ void load_row_fp8raw(const unsigned char* p, int lane, unsigned (&v)[4]) {
#pragma unroll
    for (int j = 0; j < 4; ++j) v[j] = *(const unsigned*)(p + 4 * lane + 256 * j);
}
__device__ __forceinline__ f32x4 fp8x4(unsigned w) { const f32x2 lo = __builtin_amdgcn_cvt_pk_f32_fp8((int)w, false), hi = __builtin_amdgcn_cvt_pk_f32_fp8((int)w, true); return (f32x4){lo.x, lo.y, hi.x, hi.y}; }
__device__ __forceinline__ f32x4 bf4(u32x2 w) { return (f32x4){__uint_as_float(w.x << 16), __uint_as_float(w.x & 0xffff0000u), __uint_as_float(w.y << 16), __uint_as_float(w.y & 0xffff0000u)}; }
__device__ __forceinline__ float row_rstd(const f32x4 (&v)[4]) {
    float s = 0.f;
#pragma unroll
    for (int j = 0; j < 4; ++j) s += (v[j].x * v[j].x + v[j].y * v[j].y) + (v[j].z * v[j].z + v[j].w * v[j].w);
    return 1.0f / sqrtf(wave_sum(s) * (1.f / D) + EPS);
}

__device__ __forceinline__ void phase_r1(const Args& A, const Ctx& C, int l) {
    LAS int* sb = (LAS int*)C.lds;
    constexpr int GWP = 2064;
    LAS unsigned char* GW = C.lds + 256;
    LAS unsigned char* HS = C.lds + 256 + 16 * GWP + C.wave * 2 * GWP;
    const bool mls = (l & 1) == 0; const int j = l >> 1;
    if (l == 0) { cvt_win_i8(A, C); __syncthreads(); }
    if (l > 0) slot_bases(A, l - 1, sb, C.tid);
    if (mls) { const float* w = A.in[8] + (size_t)j * D * PROJ + PW;
        f32x4 t[2][4];
#pragma unroll
        for (int jj = 0; jj < 2; ++jj)
#pragma unroll
            for (int q = 0; q < 4; ++q) t[jj][q] = *(const f32x4*)(w + (size_t)(C.tid + NT * jj) * PROJ + 4 * q);
#pragma unroll
        for (int jj = 0; jj < 2; ++jj)
#pragma unroll
            for (int q = 0; q < 4; ++q) { const int k = C.tid + NT * jj;
#pragma unroll
                for (int c = 0; c < 4; ++c) *(LAS unsigned short*)(GW + (4 * q + c) * GWP + k * 2) = (unsigned short)f2bf(t[jj][q][c]); }
        __syncthreads(); }
    const int nrows = (l <= 2) ? NR : NL;
    bf16* LAT = (bf16*)(A.ws + WS_LAT); unsigned char* HI8 = A.ws + WS_H8; float* RSC = (float*)(A.ws + WS_RSC); float* GATE = (float*)(A.ws + WS_GATE);
    const float* MOD = (const float*)(A.ws + WS_MOD); const unsigned char* Y8 = A.ws + WS_PB;
    const int* TS = (const int*)(A.ws + WS_TOKSLOT); const float* TW = (const float*)(A.ws + WS_TOKW);
    const int rpw = (((nrows + C.G - 1) / C.G) + 1) & ~1; const int wrow0 = C.bid * rpw; const int wend = min(wrow0 + rpw, nrows);
    for (int sa = wrow0; sa < wend;) {
        const int mvi = mod_vec_of_row(sa); const int bnd = mvi == 0 ? SEQ : (mvi == 1 ? NL : NR); const int sbnd = min(wend, bnd);
        RowVec RV; { const float* mv = MOD + (size_t)(l * 3 + mvi) * 6 * D;
            load_rowvec(RV, A.in[6] + (size_t)(l * 2 + 0) * D, mv + 0 * D, mv + 1 * D, l > 0 ? MOD + (size_t)((l - 1) * 3 + mvi) * 6 * D + 5 * D : nullptr, C.lane); }
        const int rlast = sbnd - 2; const int rfirst = sa + 2 * C.wave;
        i32x4r ts1 = (i32x4r){0, 0, 0, 0}, ts2 = ts1; f32x4 tw1 = (f32x4){0.f, 0.f, 0.f, 0.f}, tw2 = tw1;
        u32x2 nla[4], nlb[4]; unsigned nya0[4], nya1[4], nyb0[4], nyb1[4]; f32x4 nxa[4], nxb[4];
#define R1_FETCH(r_, ts_) do { const int fa_ = (r_), fb_ = fa_ + 1; \
            if (l == 0) { load_row_f32(fa_ < NL ? A.in[0] + (size_t)fa_ * D : A.in[2] + (size_t)(fa_ - NL) * D, C.lane, nxa); load_row_f32(fb_ < NL ? A.in[0] + (size_t)fb_ * D : A.in[2] + (size_t)(fb_ - NL) * D, C.lane, nxb); } \
            else { load_row_bf16raw(LAT + (size_t)fa_ * D, C.lane, nla); load_row_bf16raw(LAT + (size_t)fb_ * D, C.lane, nlb); \
                load_row_fp8raw(Y8 + (size_t)(sb[(ts_).x >> 20] + ((ts_).x & 0xfffff)) * D, C.lane, nya0); load_row_fp8raw(Y8 + (size_t)(sb[(ts_).y >> 20] + ((ts_).y & 0xfffff)) * D, C.lane, nya1); \
                load_row_fp8raw(Y8 + (size_t)(sb[(ts_).z >> 20] + ((ts_).z & 0xfffff)) * D, C.lane, nyb0); load_row_fp8raw(Y8 + (size_t)(sb[(ts_).w >> 20] + ((ts_).w & 0xfffff)) * D, C.lane, nyb1); } } while (0)
        if (l > 0) { const int r0 = min(rfirst, rlast), r1 = min(rfirst + 2 * NW, rlast);
            ts1 = *(const i32x4r*)(TS + r0 * 2); tw1 = *(const f32x4*)(TW + r0 * 2); ts2 = *(const i32x4r*)(TS + r1 * 2); tw2 = *(const f32x4*)(TW + r1 * 2); }
        R1_FETCH(min(rfirst, rlast), ts1);
        for (int ra = rfirst; ra < sbnd; ra += 2 * NW) {
            const bool hasb = true; const int rb = ra + 1;
            f32x4 va[4], vb[4];
            if (l == 0) {
#pragma unroll
                for (int q = 0; q < 4; ++q) { va[q] = nxa[q]; vb[q] = nxb[q]; }
                R1_FETCH(min(ra + 2 * NW, rlast), ts1);
            } else {
                u32x2 la[4], lb[4]; unsigned ya0[4], ya1[4], yb0[4], yb1[4];
#pragma unroll
                for (int q = 0; q < 4; ++q) { la[q] = nla[q]; lb[q] = nlb[q]; ya0[q] = nya0[q]; ya1[q] = nya1[q]; yb0[q] = nyb0[q]; yb1[q] = nyb1[q]; }
                const f32x4 twc = tw1;
                ts1 = ts2; tw1 = tw2;
                { const int r2 = min(ra + 4 * NW, rlast); ts2 = *(const i32x4r*)(TS + r2 * 2); tw2 = *(const f32x4*)(TW + r2 * 2); }
                R1_FETCH(min(ra + 2 * NW, rlast), ts1);
                const float wa0 = twc.x * (1.0f / YSCALE), wa1 = twc.y * (1.0f / YSCALE), wb0 = twc.z * (1.0f / YSCALE), wb1 = twc.w * (1.0f / YSCALE);
#pragma unroll
                for (int q = 0; q < 4; ++q) { va[q] = bf4(la[q]) + RV.g[q] * (fp8x4(ya0[q]) * wa0 + fp8x4(ya1[q]) * wa1); vb[q] = bf4(lb[q]) + RV.g[q] * (fp8x4(yb0[q]) * wb0 + fp8x4(yb1[q]) * wb1); }
            }
            store_row_bf16(LAT + (size_t)ra * D, C.lane, va); if (hasb) store_row_bf16(LAT + (size_t)rb * D, C.lane, vb);
            const float rra = row_rstd(va), rrb = row_rstd(vb);
            f32x4 ha[4], hb[4];
#pragma unroll
            for (int q = 0; q < 4; ++q) { ha[q] = (va[q] * rra) * RV.a[q] + RV.s[q]; hb[q] = (vb[q] * rrb) * RV.a[q] + RV.s[q]; }
            { float ma = 0.f, mb = 0.f;
#pragma unroll
              for (int q = 0; q < 4; ++q) { ma = fmaxf(ma, fmaxf(fmaxf(fabsf(ha[q].x), fabsf(ha[q].y)), fmaxf(fabsf(ha[q].z), fabsf(ha[q].w)))); mb = fmaxf(mb, fmaxf(fmaxf(fabsf(hb[q].x), fabsf(hb[q].y)), fmaxf(fabsf(hb[q].z), fabsf(hb[q].w)))); }
              ma = fmaxf(wave_max_nn(ma), 1.0e-20f); mb = fmaxf(wave_max_nn(mb), 1.0e-20f);
              const float ia = 127.0f / ma, ib = 127.0f / mb;
#pragma unroll
              for (int q = 0; q < 4; ++q) { *(unsigned*)(HI8 + (size_t)ra * D + 4 * C.lane + 256 * q) = pack_i8(ha[q] * ia); *(unsigned*)(HI8 + (size_t)rb * D + 4 * C.lane + 256 * q) = pack_i8(hb[q] * ib); }
              if (C.lane == 0) { RSC[ra] = ma * (1.0f / 127.0f); RSC[rb] = mb * (1.0f / 127.0f); } }
            if (mls) {
#pragma unroll
                for (int q = 0; q < 4; ++q) { *(LAS u32x2*)(HS + (4 * C.lane + 256 * q) * 2) = (u32x2){cvt2(ha[q].x, ha[q].y), cvt2(ha[q].z, ha[q].w)}; *(LAS u32x2*)(HS + GWP + (4 * C.lane + 256 * q) * 2) = (u32x2){cvt2(hb[q].x, hb[q].y), cvt2(hb[q].z, hb[q].w)}; }
                asm volatile("s_waitcnt lgkmcnt(0)" ::: "memory");
                f32x4 gacc = (f32x4){0.f, 0.f, 0.f, 0.f};
                { const int gi = C.lane & 15, kg = C.lane >> 4; LAS const unsigned char* ap = HS + (gi & 1) * GWP + kg * 16; LAS const unsigned char* bp = GW + gi * GWP + kg * 16;
#pragma unroll 8
                  for (int s2 = 0; s2 < 32; ++s2) { bf16x8 av = *(const LAS bf16x8*)(ap + s2 * 64); const bf16x8 bv = *(const LAS bf16x8*)(bp + s2 * 64);
                      if (gi >= 2) av = (bf16x8){0, 0, 0, 0, 0, 0, 0, 0};
                      gacc = __builtin_amdgcn_mfma_f32_16x16x32_bf16(av, bv, gacc, 0, 0, 0); } }
                float ga = gacc[0], gb = gacc[1];
                if (C.lane < 16) {
                    const float bgt = A.in[9][j * 16 + C.lane]; const int gtype = C.lane >> 2;
                    ga += bgt; gb += bgt;
                    GATE[(size_t)ra * 16 + C.lane] = (gtype & 1) ? logsigmoidf_(ga) : 15.0f * tanhf(ga * (1.0f / 15.0f));
                    if (hasb) GATE[(size_t)rb * 16 + C.lane] = (gtype & 1) ? logsigmoidf_(gb) : 15.0f * tanhf(gb * (1.0f / 15.0f)); }
            }
        }
#undef R1_FETCH
        sa = sbnd;
    }
}

__device__ __forceinline__ void phase_r2(const Args& A, const Ctx& C, int l) {
    constexpr int WP = 2064;
    LAS unsigned char* RWB = C.lds;
    LAS float* WL = (LAS float*)(C.lds + 48 * WP);
    LAS unsigned* hist = (LAS unsigned*)(WL + 8 * 16 * 48);
    LAS unsigned* gbase = hist + 32;
    constexpr int RCAP = 144;
    LAS int* rec = (LAS int*)(gbase + 32);
    static_assert(48 * WP + 8 * 16 * 48 * 4 + 256 + RCAP * 16 <= LDS_TAB_END, "R2 LDS map");
    cvt_moe_items(A, C, l, cvt_t2(l, C.G) + C.bid * NW + C.wave, CVT_ITEMS, C.G * NW);
    __syncthreads();
    { const float* wg = A.in[15] + (size_t)l * D * NGRP; const float* wr = A.in[17] + (size_t)l * D * NE;
      { const int kp = C.tid; const f32x4 x0 = *(const f32x4*)(wg + (size_t)(2 * kp) * 4), x1 = *(const f32x4*)(wg + (size_t)(2 * kp + 1) * 4);
        *(LAS unsigned*)(RWB + 0 * WP + kp * 4) = cvt2(x0.x, x1.x); *(LAS unsigned*)(RWB + 1 * WP + kp * 4) = cvt2(x0.y, x1.y);
        *(LAS unsigned*)(RWB + 2 * WP + kp * 4) = cvt2(x0.z, x1.z); *(LAS unsigned*)(RWB + 3 * WP + kp * 4) = cvt2(x0.w, x1.w); }
      f32x4 t0[8], t1[8];
#pragma unroll
      for (int jj = 0; jj < 8; ++jj) { const int it = C.tid + NT * jj, kp = it >> 3, cg = it & 7; t0[jj] = *(const f32x4*)(wr + (size_t)(2 * kp) * NE + 4 * cg); t1[jj] = *(const f32x4*)(wr + (size_t)(2 * kp + 1) * NE + 4 * cg); }
#pragma unroll
      for (int jj = 0; jj < 8; ++jj) { const int it = C.tid + NT * jj, kp = it >> 3, c0 = 4 + 4 * (it & 7);
          *(LAS unsigned*)(RWB + (c0 + 0) * WP + kp * 4) = cvt2(t0[jj].x, t1[jj].x); *(LAS unsigned*)(RWB + (c0 + 1) * WP + kp * 4) = cvt2(t0[jj].y, t1[jj].y);
          *(LAS unsigned*)(RWB + (c0 + 2) * WP + kp * 4) = cvt2(t0[jj].z, t1[jj].z); *(LAS unsigned*)(RWB + (c0 + 3) * WP + kp * 4) = cvt2(t0[jj].w, t1[jj].w); }
      for (int i = C.tid; i < 12 * 512; i += NT) *(LAS unsigned*)(RWB + (36 + i / 512) * WP + (i % 512) * 4) = 0u; }
    const int nrows = (l <= 1) ? NR : NL;
    bf16* LAT = (bf16*)(A.ws + WS_LAT); bf16* H = (bf16*)(A.ws + WS_HB); unsigned char* H8 = A.ws + WS_H8;
    const float* MOD = (const float*)(A.ws + WS_MOD);
    unsigned* cnt = (unsigned*)(A.ws + WS_CTL) + CW_CNT + l * 32 * CNT_STRIDE;
    int* TS = (int*)(A.ws + WS_TOKSLOT); float* TW = (float*)(A.ws + WS_TOKW); int* ST = (int*)(A.ws + WS_SLOTTOK);
    const int rpw = (((nrows + C.G - 1) / C.G) + 1) & ~1; const int wrow0 = C.bid * rpw; const int wend0 = min(wrow0 + rpw, nrows);
    const float* bg = A.in[16] + l * NGRP; const float* br = A.in[18] + l * NE;
    for (int cb = wrow0; cb < wend0; cb += RCAP) {
        const int wend = min(cb + RCAP, wend0);
        if (C.tid < 32) hist[C.tid] = 0u;
        for (int sa = cb; sa < wend;) {
            const int mvi = mod_vec_of_row(sa); const int bnd = mvi == 0 ? SEQ : (mvi == 1 ? NL : NR); const int sbnd = min(wend, bnd);
            RowVec RV; { const float* mv = MOD + (size_t)(l * 3 + mvi) * 6 * D; load_rowvec(RV, A.in[6] + (size_t)(l * 2 + 1) * D, mv + 3 * D, mv + 4 * D, mv + 2 * D, C.lane); }
            const int rlast = sbnd - 2;
            u32x2 la[4], lb[4];
            { const int r0 = min(sa + 2 * C.wave, rlast); load_row_bf16raw(LAT + (size_t)r0 * D, C.lane, la); load_row_bf16raw(LAT + (size_t)(r0 + 1) * D, C.lane, lb); }
            for (int ra = sa + 2 * C.wave; ra < sbnd; ra += 2 * NW) {
                const int rb = ra + 1;
                u32x2 lan[4], lbn[4];
                { const int r1 = min(ra + 2 * NW, rlast); load_row_bf16raw(LAT + (size_t)r1 * D, C.lane, lan); load_row_bf16raw(LAT + (size_t)(r1 + 1) * D, C.lane, lbn); }
                f32x4 va[4], vb[4];
#pragma unroll
                for (int q = 0; q < 4; ++q) { va[q] = bf4(la[q]); vb[q] = bf4(lb[q]); }
                const float rra = row_rstd(va), rrb = row_rstd(vb);
                f32x4 ha[4], hb[4];
#pragma unroll
                for (int q = 0; q < 4; ++q) { ha[q] = (va[q] * rra) * RV.a[q] + RV.s[q]; hb[q] = (vb[q] * rrb) * RV.a[q] + RV.s[q]; }
                store_row_bf16(H + (size_t)ra * D, C.lane, ha); store_row_bf16(H + (size_t)rb * D, C.lane, hb);
                store_row_fp8(H8 + (size_t)ra * D, C.lane, ha); store_row_fp8(H8 + (size_t)rb * D, C.lane, hb);
#pragma unroll
                for (int q = 0; q < 4; ++q) { la[q] = lan[q]; lb[q] = lbn[q]; }
            }
            sa = sbnd;
        }
        __syncthreads();
        const int fr = C.lane & 15, fq = C.lane >> 4;
        for (int t = C.wave; t * 16 < wend - cb; t += NW) {
            const int trow = min(cb + 16 * t + fr, wend - 1);
            const bf16* hp = H + (size_t)trow * D + 8 * fq;
            f32x4 acc[3];
#pragma unroll
            for (int ct = 0; ct < 3; ++ct) acc[ct] = (f32x4){0.f, 0.f, 0.f, 0.f};
#pragma unroll 1
            for (int kb = 0; kb < 4; ++kb) {
                bf16x8 av[8];
#pragma unroll
                for (int k8 = 0; k8 < 8; ++k8) av[k8] = *(const bf16x8*)(hp + 32 * (8 * kb + k8));
#pragma unroll
                for (int k8 = 0; k8 < 8; ++k8)
#pragma unroll
                    for (int ct = 0; ct < 3; ++ct) { const bf16x8 bv = *(const LAS bf16x8*)(RWB + (ct * 16 + fr) * WP + (32 * (8 * kb + k8) + 8 * fq) * 2);
                        acc[ct] = __builtin_amdgcn_mfma_f32_16x16x32_bf16(av[k8], bv, acc[ct], 0, 0, 0); }
            }
            LAS float* wl = WL + C.wave * 16 * 48;
#pragma unroll
            for (int ct = 0; ct < 3; ++ct)
#pragma unroll
                for (int jq = 0; jq < 4; ++jq) wl[(4 * fq + jq) * 48 + ct * 16 + fr] = acc[ct][jq];
            asm volatile("s_waitcnt lgkmcnt(0)" ::: "memory");
            const int row = cb + 16 * t + C.lane;
            if (C.lane < 16 && row < wend) {
                LAS const float* wm = wl + C.lane * 48;
                float lg[36];
#pragma unroll
                for (int c = 0; c < 36; ++c) lg[c] = wm[c];
                float gl[4]; int grp = 0; float gm = -3.0e38f;
#pragma unroll
                for (int c = 0; c < 4; ++c) { gl[c] = lg[c] + bg[c]; if (gl[c] > gm) { gm = gl[c]; grp = c; } }
                float gs = 0.f;
#pragma unroll
                for (int c = 0; c < 4; ++c) gs += __expf(gl[c] - gm);
                const float pgrp = 1.0f / gs;
                float rl[8];
#pragma unroll
                for (int i = 0; i < 8; ++i) { float tt = 0.f;
#pragma unroll
                    for (int g = 0; g < 4; ++g) tt = (g == grp) ? lg[4 + g * 8 + i] : tt;
                    rl[i] = tt + br[grp * 8 + i]; }
                int i0 = 0; float m0 = rl[0];
#pragma unroll
                for (int i = 1; i < 8; ++i) if (rl[i] > m0) { m0 = rl[i]; i0 = i; }
                int i1 = -1; float m1 = -3.0e38f;
#pragma unroll
                for (int i = 0; i < 8; ++i) if (i != i0 && rl[i] > m1) { m1 = rl[i]; i1 = i; }
                const float p0 = 1.0f, p1 = __expf(m1 - m0);
                const float w0 = pgrp * p0 / (p0 + p1), w1 = pgrp * p1 / (p0 + p1);
                const int e0 = grp * 8 + i0, e1 = grp * 8 + i1;
                const unsigned q0 = __hip_atomic_fetch_add(hist + e0, 1u, __ATOMIC_RELAXED, __HIP_MEMORY_SCOPE_WORKGROUP), q1 = __hip_atomic_fetch_add(hist + e1, 1u, __ATOMIC_RELAXED, __HIP_MEMORY_SCOPE_WORKGROUP);
                const int li = row - cb;
                rec[li * 4 + 0] = e0 | (e1 << 8); rec[li * 4 + 1] = (int)q0; rec[li * 4 + 2] = (int)q1;
                TW[row * 2 + 0] = w0; TW[row * 2 + 1] = w1;
            }
        }
        __syncthreads();
        if (C.tid < 32) gbase[C.tid] = hist[C.tid] ? atomicAdd(cnt + C.tid * CNT_STRIDE, hist[C.tid]) : 0u;
        __syncthreads();
        for (int i = C.tid; i < wend - cb; i += NT) { const int row = cb + i; const int ee = rec[i * 4], e0 = ee & 255, e1 = ee >> 8;
            const unsigned q0 = gbase[e0] + (unsigned)rec[i * 4 + 1], q1 = gbase[e1] + (unsigned)rec[i * 4 + 2];
            ST[(size_t)e0 * CAP + q0] = row; ST[(size_t)e1 * CAP + q1] = row;
            TS[row * 2 + 0] = (e0 << 20) | (int)q0; TS[row * 2 + 1] = (e1 << 20) | (int)q1; }
        __syncthreads();
    }
}

__device__ __forceinline__ void phase_final(const Args& A, const Ctx& C) {
    LAS int* sb = (LAS int*)C.lds;
    slot_bases(A, 3, sb, C.tid);
    const bf16* LAT = (const bf16*)(A.ws + WS_LAT); const unsigned char* Y8 = A.ws + WS_PB;
    const int* TS = (const int*)(A.ws + WS_TOKSLOT); const float* TW = (const float*)(A.ws + WS_TOKW);
    const float* MOD = (const float*)(A.ws + WS_MOD);
    f32x4 fg[4]; load_row_f32(A.in[7], C.lane, fg);
    const int rpw = (((NL + C.G - 1) / C.G) + 1) & ~1; const int wrow0 = C.bid * rpw; const int wend = min(wrow0 + rpw, NL);
    for (int sa = wrow0; sa < wend;) {
        const int mvi = mod_vec_of_row(sa); const int sbnd = min(wend, mvi == 0 ? SEQ : NL);
        f32x4 g2[4]; load_row_f32(MOD + (size_t)(3 * 3 + mvi) * 6 * D + 5 * D, C.lane, g2);
        for (int ra = sa + 2 * C.wave; ra < sbnd; ra += 2 * NW) {
            const int rb = ra + 1;
            const int ta0 = TS[ra * 2], ta1 = TS[ra * 2 + 1], tb0 = TS[rb * 2], tb1 = TS[rb * 2 + 1]; const float wa0 = TW[ra * 2], wa1 = TW[ra * 2 + 1], wb0 = TW[rb * 2], wb1 = TW[rb * 2 + 1];
            f32x4 va[4], vb[4]; unsigned ya0[4], ya1[4], yb0[4], yb1[4];
            load_row_bf16(LAT + (size_t)ra * D, C.lane, va); load_row_bf16(LAT + (size_t)rb * D, C.lane, vb);
            load_row_fp8raw(Y8 + (size_t)(sb[ta0 >> 20] + (ta0 & 0xfffff)) * D, C.lane, ya0); load_row_fp8raw(Y8 + (size_t)(sb[ta1 >> 20] + (ta1 & 0xfffff)) * D, C.lane, ya1);
            load_row_fp8raw(Y8 + (size_t)(sb[tb0 >> 20] + (tb0 & 0xfffff)) * D, C.lane, yb0); load_row_fp8raw(Y8 + (size_t)(sb[tb1 >> 20] + (tb1 & 0xfffff)) * D, C.lane, yb1);
#pragma unroll
            for (int q = 0; q < 4; ++q) { va[q] += g2[q] * (fp8x4(ya0[q]) * (wa0 * (1.0f / YSCALE)) + fp8x4(ya1[q]) * (wa1 * (1.0f / YSCALE))); vb[q] += g2[q] * (fp8x4(yb0[q]) * (wb0 * (1.0f / YSCALE)) + fp8x4(yb1[q]) * (wb1 * (1.0f / YSCALE))); }
            const float rra = row_rstd(va), rrb = row_rstd(vb);
#pragma unroll
            for (int q = 0; q < 4; ++q) { *(f32x4*)(A.out + (size_t)ra * D + 4 * C.lane + 256 * q) = (va[q] * rra) * fg[q]; *(f32x4*)(A.out + (size_t)rb * D + 4 * C.lane + 256 * q) = (vb[q] * rrb) * fg[q]; }
        }
        sa = sbnd;
    }
}

__device__ __forceinline__ void phase_conv(const Args& A, const Ctx& C, int l) {
    const int j = l >> 1; const int nrows = (l <= 1) ? NR : NL;
    const bf16* P = (const bf16*)(A.ws + WS_PB); unsigned char* HM = A.ws + WS_HM; float* RSC = (float*)(A.ws + WS_RSC);
    const float* cw = A.in[13] + (size_t)j * 3 * D;
    f32x4 w0[4], w1[4], w2[4];
    load_row_f32(cw, C.lane, w0); load_row_f32(cw + D, C.lane, w1); load_row_f32(cw + 2 * D, C.lane, w2);
    const int rpw = (((nrows + C.G - 1) / C.G) + 1) & ~1; const int wrow0 = C.bid * rpw; const int wend = min(wrow0 + rpw, nrows);
    for (int ra = wrow0 + 2 * C.wave; ra < wend; ra += 2 * NW) {
        const int rb = ra + 1;
        const int ta = ra < NL ? (ra & 63) : ((ra - NL) & 255), tb1 = rb < NL ? (rb & 63) : ((rb - NL) & 255), tlast = ra < NL ? 63 : 255;
        const bool hasl = ta != 0, hasr = tb1 != tlast;
        const bf16* pa = P + (size_t)ra * PW;
        u32x2 bga[4], bgb[4], zm[4], z0[4], z1[4], z2[4];
        load_row_bf16raw(pa, C.lane, bga); load_row_bf16raw(pa + PW, C.lane, bgb);
        load_row_bf16raw(pa + D, C.lane, z0); load_row_bf16raw(pa + PW + D, C.lane, z1);
        load_row_bf16raw(hasl ? pa - PW + D : pa + D, C.lane, zm); load_row_bf16raw(hasr ? pa + 2 * PW + D : pa + D, C.lane, z2);
        const float fl = hasl ? 1.f : 0.f, fr = hasr ? 1.f : 0.f;
        f32x4 oa[4], ob[4];
#pragma unroll
        for (int q = 0; q < 4; ++q) { const f32x4 a0 = bf4(z0[q]), a1 = bf4(z1[q]);
            oa[q] = bf4(bga[q]) * (w0[q] * (bf4(zm[q]) * fl) + w1[q] * a0 + w2[q] * a1);
            ob[q] = bf4(bgb[q]) * (w0[q] * a0 + w1[q] * a1 + w2[q] * (bf4(z2[q]) * fr)); }
        float ma = 0.f, mb = 0.f;
#pragma unroll
        for (int q = 0; q < 4; ++q) { ma = fmaxf(ma, fmaxf(fmaxf(fabsf(oa[q].x), fabsf(oa[q].y)), fmaxf(fabsf(oa[q].z), fabsf(oa[q].w)))); mb = fmaxf(mb, fmaxf(fmaxf(fabsf(ob[q].x), fabsf(ob[q].y)), fmaxf(fabsf(ob[q].z), fabsf(ob[q].w)))); }
        ma = fmaxf(wave_max_nn(ma), 1.0e-20f); mb = fmaxf(wave_max_nn(mb), 1.0e-20f);
        const float ia = 127.0f / ma, ib = 127.0f / mb;
#pragma unroll
        for (int q = 0; q < 4; ++q) { *(unsigned*)(HM + (size_t)ra * D + 4 * C.lane + 256 * q) = pack_i8(oa[q] * ia); *(unsigned*)(HM + (size_t)rb * D + 4 * C.lane + 256 * q) = pack_i8(ob[q] * ib); }
        if (C.lane == 0) { RSC[ra] = ma * (1.0f / 127.0f); RSC[rb] = mb * (1.0f / 127.0f); }
    }
}

constexpr int BM = 256, BK = 64, HALF = 128, HTB = HALF * BK * 2, STAGE_BYTES = 8 * HTB, NXCD = 8, WGM = 8;
constexpr int LDS_TAB = STAGE_BYTES;
__device__ __forceinline__ int lds_byte(int r, int c) { const int st = (r >> 4) * 2 + (c >> 5), rr = r & 15, cc = c & 31, ob = rr * 64 + cc * 2; return st * 1024 + (ob ^ (((ob >> 9) & 1) << 5)); }
__device__ __forceinline__ void stage_rc(int b, int& R, int& C) { const int st = b / 1024, sb = b % 1024, swz = sb ^ (((sb >> 9) & 1) << 5); R = (st >> 1) * 16 + swz / 64; C = (st & 1) * 32 + (swz % 64) / 2; }
__device__ __forceinline__ int perm32(int rho) { const int n = rho >> 4, i = rho & 15; return 8 * (i >> 2) + 4 * n + (i & 3); }
__device__ __forceinline__ unsigned cvt_pk_bf16(float lo, float hi) { unsigned r; asm volatile("v_cvt_pk_bf16_f32 %0, %1, %2" : "=v"(r) : "v"(lo), "v"(hi)); return r; }

struct GUnit { const char* a; const char* b; int orow, ocol, aux; };

typedef int i32x8 __attribute__((ext_vector_type(8)));
typedef int i32x4 __attribute__((ext_vector_type(4)));
template <class Epi, class Sched, bool GATHER, int OPM = 0>
__device__ __forceinline__ void gemm_phase(LAS unsigned char* lds, const int K, const Sched& S, const Epi& E) {
    const int tid = threadIdx.x, wid = __builtin_amdgcn_readfirstlane(tid >> 6), lane = tid & 63, wr = wid >> 2, wc = wid & 3, fr = lane & 15, fq = lane >> 4;
    constexpr bool FP8 = (OPM == 1), I8 = (OPM == 2);
    const int RB = (OPM != 0) ? K : 2 * K;
    const int nt = RB / (BK * 2);
    unsigned voffB[2], voA[2][2]; int Rr[2], Cc[2];
#pragma unroll
    for (int i = 0; i < 2; ++i) { int R, C; stage_rc(tid * 16 + i * 8192, R, C); const int Rb = (R & ~31) + perm32(R & 31); Rr[i] = R; Cc[i] = C;
        voffB[i] = (unsigned)(Rb * RB + C * 2);
        voA[0][i] = (unsigned)(R * RB + C * 2); voA[1][i] = (unsigned)((R + HALF) * RB + C * 2); }
    const size_t kstep = (size_t)(BK * 2);
    const size_t hstep = (size_t)HALF * RB;
    const unsigned ldsw = (unsigned)wid * 1024u;
    const unsigned ldsbase = (unsigned)(size_t)lds;
    const int aoff = lds_byte(wr * 64 + fr, fq * 8), boff = lds_byte(wc * 32 + fr, fq * 8);
#define PG8_SA(b, h) (((b) * 2 + (h)) * HTB)
#define PG8_SB(b, h) ((4 + (b) * 2 + (h)) * HTB)
#define PG8_STAGE(bufoff, gbase, voff) do { _Pragma("unroll") for (int _i = 0; _i < 2; ++_i) \
        asm volatile("s_mov_b32 m0, %2\n\ts_nop 0\n\tglobal_load_lds_dwordx4 %0, %1" :: "v"((voff)[_i]), "s"((const char*)(gbase)), "s"(ldsbase + (unsigned)(bufoff) + ldsw + (unsigned)(_i * 8192)) : "memory"); } while (0)
#define PG8_STAGE_A1(bufoff, gbase) do { if constexpr (GATHER) PG8_STAGE(bufoff, gbase, voA[1]); else PG8_STAGE(bufoff, (const char*)(gbase) + hstep, voA[0]); } while (0)
#define PG8_LDA(dst, b, h) do { if constexpr (FP8) { _Pragma("unroll") for (int m = 0; m < 4; ++m) { \
        const i32x4 _lo = *(const LAS i32x4*)(lds + PG8_SA(b, h) + aoff + m * 2048), _hi = *(const LAS i32x4*)(lds + PG8_SA(b, h) + aoff + m * 2048 + 1024); \
        dst##8[m] = __builtin_shufflevector(_lo, _hi, 0, 1, 2, 3, 4, 5, 6, 7); } } \
      else { _Pragma("unroll") for (int m = 0; m < 4; ++m) _Pragma("unroll") for (int k = 0; k < 2; ++k) dst[m][k] = *(const LAS bf16x8*)(lds + PG8_SA(b, h) + aoff + m * 2048 + k * 1024); } } while (0)
#define PG8_LDB(dst, b, h) do { if constexpr (FP8) { _Pragma("unroll") for (int n = 0; n < 2; ++n) { \
        const i32x4 _lo = *(const LAS i32x4*)(lds + PG8_SB(b, h) + boff + n * 2048), _hi = *(const LAS i32x4*)(lds + PG8_SB(b, h) + boff + n * 2048 + 1024); \
        dst##8[n] = __builtin_shufflevector(_lo, _hi, 0, 1, 2, 3, 4, 5, 6, 7); } } \
      else { _Pragma("unroll") for (int n = 0; n < 2; ++n) _Pragma("unroll") for (int k = 0; k < 2; ++k) dst[n][k] = *(const LAS bf16x8*)(lds + PG8_SB(b, h) + boff + n * 2048 + k * 1024); } } while (0)
#define PG8_MMA(ai, bj, At, Bt) do { __builtin_amdgcn_s_setprio(1); \
        if constexpr (FP8) { _Pragma("unroll") for (int m = 0; m < 4; ++m) _Pragma("unroll") for (int n = 0; n < 2; ++n) \
            acc[ai][bj][m][n] = __builtin_amdgcn_mfma_scale_f32_16x16x128_f8f6f4(Bt##8[n], At##8[m], acc[ai][bj][m][n], 0, 0, 0, 0x7f7f7f7f, 0, 0x7f7f7f7f); } \
        else if constexpr (I8) { _Pragma("unroll") for (int m = 0; m < 4; ++m) _Pragma("unroll") for (int n = 0; n < 2; ++n) _Pragma("unroll") for (int k = 0; k < 2; ++k) \
            acc[ai][bj][m][n] = __builtin_bit_cast(f32x4, __builtin_amdgcn_mfma_i32_16x16x64_i8(__builtin_bit_cast(i32x4, Bt[n][k]), __builtin_bit_cast(i32x4, At[m][k]), __builtin_bit_cast(i32x4, acc[ai][bj][m][n]), 0, 0, 0)); } \
        else { _Pragma("unroll") for (int m = 0; m < 4; ++m) _Pragma("unroll") for (int n = 0; n < 2; ++n) _Pragma("unroll") for (int k = 0; k < 2; ++k) \
            acc[ai][bj][m][n] = __builtin_amdgcn_mfma_f32_16x16x32_bf16(Bt[n][k], At[m][k], acc[ai][bj][m][n], 0, 0, 0); } \
        __builtin_amdgcn_s_setprio(0); } while (0)
#define PG8_WAIT_V(n) asm volatile("s_waitcnt vmcnt(" #n ")" ::: "memory")
#define PG8_WAIT_L(n) asm volatile("s_waitcnt lgkmcnt(" #n ")" ::: "memory")
#define PG8_BAR __builtin_amdgcn_s_barrier()
#define PG8_SCHED __builtin_amdgcn_sched_barrier(0)
    GUnit cur, nxt; int ui = 0;
    if (!S.next(0, cur)) return;
    if constexpr (GATHER) {
#pragma unroll
        for (int h = 0; h < 2; ++h)
#pragma unroll
            for (int i = 0; i < 2; ++i) voA[h][i] = S.arow_off(0, h * HALF + Rr[i]) + (unsigned)Cc[i] * 2u;
    }
    f32x4 acc[2][2][4][2];
#pragma unroll
    for (int a = 0; a < 2; ++a)
#pragma unroll
        for (int b = 0; b < 2; ++b)
#pragma unroll
            for (int m = 0; m < 4; ++m)
#pragma unroll
                for (int n = 0; n < 2; ++n) acc[a][b][m][n] = (f32x4){0.f, 0.f, 0.f, 0.f};
    bf16x8 At[4][2], B0[2][2], B1[2][2]; i32x8 At8[4], B08[2], B18[2];
    const char* cA = cur.a; const char* cB = cur.b;
    PG8_STAGE(PG8_SB(0, 0), cB, voffB); PG8_STAGE(PG8_SB(0, 1), cB + hstep, voffB); PG8_STAGE(PG8_SA(0, 0), cA, voA[0]); PG8_STAGE_A1(PG8_SA(0, 1), cA);
    if (wr == 1) PG8_BAR;
    PG8_WAIT_V(2); PG8_BAR;
    PG8_STAGE(PG8_SB(1, 0), cB + kstep, voffB); PG8_STAGE(PG8_SA(1, 0), cA + kstep, voA[0]); PG8_STAGE(PG8_SB(1, 1), cB + hstep + kstep, voffB);
    PG8_WAIT_V(6); PG8_BAR;
    for (;;) {
        const bool has_next = S.next(ui + 1, nxt);
        const char* nA = has_next ? nxt.a : cA; const char* nB = has_next ? nxt.b : cB;
#pragma unroll 1
        for (int t = 0; t < nt; t += 2) {
            const bool last = (t == nt - 2);
            const char* a1 = cA + (size_t)(t + 1) * kstep;
            const char* a2 = last ? nA : cA + (size_t)(t + 2) * kstep; const char* b2 = last ? nB : cB + (size_t)(t + 2) * kstep;
            const char* a3 = a2 + kstep; const char* b3 = b2 + kstep;
            PG8_LDB(B0, 0, 0); PG8_LDB(B1, 0, 1); PG8_SCHED; PG8_LDA(At, 0, 0); PG8_STAGE_A1(PG8_SA(1, 1), a1);
            if constexpr (GATHER) { if (last && has_next) {
#pragma unroll
                for (int h = 0; h < 2; ++h)
#pragma unroll
                    for (int i = 0; i < 2; ++i) { int R2, C2; stage_rc(tid * 16 + i * 8192, R2, C2); voA[h][i] = S.arow_off(ui + 1, h * HALF + R2) + (unsigned)C2 * 2u; } } }
            PG8_WAIT_V(8); PG8_WAIT_L(0); PG8_BAR; PG8_MMA(0, 0, At, B0); PG8_MMA(0, 1, At, B1); PG8_BAR; PG8_SCHED;
            PG8_LDA(At, 0, 1); PG8_STAGE(PG8_SB(0, 0), b2, voffB); PG8_STAGE(PG8_SB(0, 1), b2 + hstep, voffB); PG8_STAGE(PG8_SA(0, 0), a2, voA[0]);
            PG8_WAIT_V(8); PG8_WAIT_L(0); PG8_BAR; PG8_MMA(1, 0, At, B0); PG8_MMA(1, 1, At, B1); PG8_BAR; PG8_SCHED;
            PG8_LDB(B0, 1, 0); PG8_LDB(B1, 1, 1); PG8_SCHED; PG8_LDA(At, 1, 0); PG8_STAGE_A1(PG8_SA(0, 1), a2);
            PG8_WAIT_V(8); PG8_WAIT_L(0); PG8_BAR; PG8_MMA(0, 0, At, B0); PG8_MMA(0, 1, At, B1); PG8_BAR; PG8_SCHED;
            PG8_LDA(At, 1, 1); PG8_STAGE(PG8_SB(1, 0), b3, voffB); PG8_STAGE(PG8_SB(1, 1), b3 + hstep, voffB); PG8_STAGE(PG8_SA(1, 0), a3, voA[0]);
            PG8_WAIT_V(8); PG8_WAIT_L(0); PG8_BAR; PG8_MMA(1, 0, At, B0); PG8_MMA(1, 1, At, B1); PG8_BAR; PG8_SCHED;
        }
        if (wr == 0) PG8_BAR;
        { int tz = threadIdx.x; asm volatile("" : "+v"(tz));
          if constexpr (I8) {
#pragma unroll
              for (int a_ = 0; a_ < 2; ++a_)
#pragma unroll
                  for (int b_ = 0; b_ < 2; ++b_)
#pragma unroll
                      for (int m = 0; m < 4; ++m)
#pragma unroll
                          for (int n = 0; n < 2; ++n) acc[a_][b_][m][n] = __builtin_convertvector(__builtin_bit_cast(i32x4, acc[a_][b_][m][n]), f32x4); }
          const int wz = tz >> 6, lz = tz & 63; E(acc, cur, wz >> 2, wz & 3, lz & 15, lz >> 4); }
        if (!has_next) break;
#pragma unroll
        for (int a = 0; a < 2; ++a)
#pragma unroll
            for (int b = 0; b < 2; ++b)
#pragma unroll
                for (int m = 0; m < 4; ++m)
#pragma unroll
                    for (int n = 0; n < 2; ++n) acc[a][b][m][n] = (f32x4){0.f, 0.f, 0.f, 0.f};
        cur = nxt; cA = nA; cB = nB; ++ui;
        if (wr == 1) PG8_BAR;
    }
    PG8_WAIT_V(0);
    PG8_BAR;
#undef PG8_SA
#undef PG8_SB
#undef PG8_STAGE
#undef PG8_STAGE_A1
#undef PG8_LDA
#undef PG8_LDB
#undef PG8_MMA
#undef PG8_WAIT_V
#undef PG8_WAIT_L
#undef PG8_BAR
#undef PG8_SCHED
}

__device__ __forceinline__ int xcd_remap(int L, int nwg) { const int q = nwg / NXCD, r = nwg % NXCD, xcd = L % NXCD, off = L / NXCD; return (xcd < r ? xcd * (q + 1) : r * (q + 1) + (xcd - r) * q) + off; }

struct DenseSched {
    const char* A; const char* Bt; int nM, nN, nwg, G, c; size_t tstep; int sw_lo, sw_hi;
    __device__ __forceinline__ void init(const void* A_, const void* Bt_, int M, int N, int K, int G_, int c_, int ebytes = 2) { A = (const char*)A_; Bt = (const char*)Bt_; nM = M / BM; nN = N / BM; nwg = nM * nN; G = G_; c = c_; tstep = (size_t)BM * K * ebytes; sw_lo = 0; sw_hi = 0; }
    __device__ __forceinline__ bool next(int i, GUnit& u) const {
        const long L = (long)i * G + c; if (L >= nwg) return false;
        const int wgid = xcd_remap((int)L, nwg);
        const int nig = WGM * nN, gid = wgid / nig, fm = gid * WGM, gsz = (nM - fm) < WGM ? (nM - fm) : WGM;
        const int pm = fm + ((wgid % nig) % gsz), pn = (wgid % nig) / gsz;
        if (pn >= sw_lo && pn < sw_hi) { u.a = Bt + (size_t)pn * tstep; u.b = A + (size_t)pm * tstep; u.orow = pm; u.ocol = pn - sw_lo; u.aux = 1; }
        else { u.a = A + (size_t)pm * tstep; u.b = Bt + (size_t)pn * tstep; u.orow = pm * BM; u.ocol = pn * BM; u.aux = 0; }
        return true;
    }
    __device__ __forceinline__ unsigned arow_off(int, int) const { return 0u; }
};

constexpr int MAXU = 12;
struct MoeTab { int n; int e[MAXU], mb[MAXU], nt[MAXU]; int sb[NE + 1]; };
struct MoeSched {
    LAS const MoeTab* T; LAS const unsigned* ridx;
    const char* A; const char* W; size_t wstride_e, tstepB; int K; int arow_bytes;
    __device__ __forceinline__ bool next(int i, GUnit& u) const {
        const int n = __builtin_amdgcn_readfirstlane(T->n); if (i >= n) return false;
        const int e = __builtin_amdgcn_readfirstlane(T->e[i]), mb = __builtin_amdgcn_readfirstlane(T->mb[i]), nt = __builtin_amdgcn_readfirstlane(T->nt[i]);
        const int base = __builtin_amdgcn_readfirstlane(T->sb[e]);
        u.orow = base + mb * BM; u.ocol = nt; u.aux = e;
        u.a = A + (size_t)u.orow * arow_bytes;
        u.b = W + (size_t)e * wstride_e + (size_t)nt * tstepB; return true;
    }
    __device__ __forceinline__ unsigned arow_off(int i, int r) const { return ridx[i * 256 + r]; }
};
template <bool GATHER>
__device__ __forceinline__ void moe_tables(const Args& A, const Ctx& C, int l, int ntile_n, LAS MoeTab* T, LAS unsigned* ridx, int arow_bytes) {
    const unsigned* cnt = (const unsigned*)(A.ws + WS_CTL) + CW_CNT + l * 32 * CNT_STRIDE;
    LAS int* ust = (LAS int*)(T + 1);
    if (C.tid < 64) { int nb; const int ex = expert_block_prefix(cnt, C.tid, nb); if (C.tid <= NE) { T->sb[C.tid] = ex * 256; ust[C.tid] = ex * ntile_n; } }
    __syncthreads();
    if (C.tid < MAXU) { const int nwg = ust[NE]; const long L = (long)C.tid * C.G + C.bid;
        if (L < nwg) { const int w = xcd_remap((int)L, nwg); int e = 0; while (w >= ust[e + 1]) ++e;
            const int lu = w - ust[e]; T->e[C.tid] = e; T->mb[C.tid] = lu / ntile_n; T->nt[C.tid] = lu % ntile_n; } }
    if (C.tid == 0) { const int nwg = ust[NE]; int n = 0; while (n < MAXU && (long)n * C.G + C.bid < nwg) ++n; T->n = n; }
    __syncthreads();
    if constexpr (GATHER) {
        const int* ST = (const int*)(A.ws + WS_SLOTTOK); const int n = T->n;
        for (int i = C.tid; i < n * 256; i += NT) { const int ui = i >> 8, r = i & 255, e = T->e[ui], m0 = T->mb[ui] * 256, ce = (int)cnt[e * CNT_STRIDE];
            const int rr = (m0 + r < ce) ? m0 + r : ce - 1;
            ridx[i] = (unsigned)ST[(size_t)e * CAP + rr] * (unsigned)arow_bytes; }
        __syncthreads();
    }
}

struct EpiStore { bf16* O; int ldc; float scale_lo; int sig_from; bf16* VT; float sall = 1.0f; const float* rs = nullptr;
    __device__ __forceinline__ void operator()(const f32x4 (&acc)[2][2][4][2], const GUnit& u, int wr, int wc, int fr, int fq) const {
        const bool tr = u.aux != 0;
        const float sc = ((!tr && u.ocol < NQ) ? scale_lo : 1.0f) * sall; const bool sg = !tr && u.ocol >= sig_from;
        bf16* Ob = tr ? VT + (size_t)(u.orow * NH + u.ocol) * 65536 : O + (size_t)u.orow * ldc + u.ocol; const int ld = tr ? 256 : ldc;
        f32x4 cs[2][2];
#pragma unroll
        for (int bj = 0; bj < 2; ++bj) { const f32x4 one = (f32x4){1.f, 1.f, 1.f, 1.f};
            cs[bj][0] = (rs && tr) ? *(const f32x4*)(rs + u.orow * BM + bj * HALF + wc * 32 + 8 * fq) : one; cs[bj][1] = (rs && tr) ? *(const f32x4*)(rs + u.orow * BM + bj * HALF + wc * 32 + 8 * fq + 4) : one; }
#pragma unroll
        for (int ai = 0; ai < 2; ++ai)
#pragma unroll
            for (int m = 0; m < 4; ++m) { const int rl = ai * HALF + wr * 64 + m * 16 + fr; bf16* rowp = tr ? Ob + wc * 8192 + rl * 32 + 8 * fq : Ob + (size_t)rl * ld + wc * 32 + 8 * fq;

                const float scr = (rs && !tr) ? sc * rs[u.orow + rl] : sc;
#pragma unroll
                for (int bj = 0; bj < 2; ++bj) { f32x4 v0 = acc[ai][bj][m][0] * scr * cs[bj][0], v1 = acc[ai][bj][m][1] * scr * cs[bj][1];
                    if (sg) {
#pragma unroll
                        for (int q = 0; q < 4; ++q) { v0[q] = __builtin_amdgcn_rcpf(1.0f + __expf(-v0[q])); v1[q] = __builtin_amdgcn_rcpf(1.0f + __expf(-v1[q])); } }
                    u32x4 w; w.x = cvt_pk_bf16(v0[0], v0[1]); w.y = cvt_pk_bf16(v0[2], v0[3]); w.z = cvt_pk_bf16(v1[0], v1[1]); w.w = cvt_pk_bf16(v1[2], v1[3]);
                    *(u32x4*)(rowp + (tr ? bj * 4 * 8192 : bj * HALF)) = w; } }
    }
};
__device__ __forceinline__ u32x2 cvt8_fp8(f32x4 a, f32x4 b) { int lo = 0, hi = 0;
    lo = __builtin_amdgcn_cvt_pk_fp8_f32(a[0], a[1], lo, false); lo = __builtin_amdgcn_cvt_pk_fp8_f32(a[2], a[3], lo, true);
    hi = __builtin_amdgcn_cvt_pk_fp8_f32(b[0], b[1], hi, false); hi = __builtin_amdgcn_cvt_pk_fp8_f32(b[2], b[3], hi, true); return (u32x2){(unsigned)lo, (unsigned)hi}; }
struct EpiSwigluF8 { unsigned char* O; int ldc; float s;
    __device__ __forceinline__ void operator()(const f32x4 (&acc)[2][2][4][2], const GUnit& u, int wr, int wc, int fr, int fq) const {
        const int ocol = u.ocol * HALF;
#pragma unroll
        for (int ai = 0; ai < 2; ++ai)
#pragma unroll
            for (int m = 0; m < 4; ++m) { unsigned char* rowp = O + (size_t)(u.orow + ai * HALF + wr * 64 + m * 16 + fr) * ldc + ocol + wc * 32 + 8 * fq;
                f32x4 v0, v1;
#pragma unroll
                for (int q = 0; q < 4; ++q) { const float x0 = acc[ai][0][m][0][q] * s, x1 = acc[ai][0][m][1][q] * s;
                    v0[q] = x0 * __builtin_amdgcn_rcpf(1.0f + __expf(-x0)) * (acc[ai][1][m][0][q] * s); v1[q] = x1 * __builtin_amdgcn_rcpf(1.0f + __expf(-x1)) * (acc[ai][1][m][1][q] * s); }
                *(u32x2*)rowp = cvt8_fp8(v0, v1); }
    }
};
template <int MODE> struct EpiPair { bf16* O; int ldc; int plain_below; float sall = 1.0f; const float* rs = nullptr;
    __device__ __forceinline__ void operator()(const f32x4 (&acc)[2][2][4][2], const GUnit& u, int wr, int wc, int fr, int fq) const {
        if (MODE == 0 && u.ocol < plain_below) {
#pragma unroll
            for (int ai = 0; ai < 2; ++ai)
#pragma unroll
                for (int m = 0; m < 4; ++m) { const int rg = u.orow + ai * HALF + wr * 64 + m * 16 + fr; bf16* rowp = O + (size_t)rg * ldc + u.ocol + wc * 32 + 8 * fq;
                    const float scr = rs ? sall * rs[rg] : sall;
#pragma unroll
                    for (int bj = 0; bj < 2; ++bj) { const f32x4 v0 = acc[ai][bj][m][0] * scr, v1 = acc[ai][bj][m][1] * scr;
                        u32x4 w; w.x = cvt_pk_bf16(v0[0], v0[1]); w.y = cvt_pk_bf16(v0[2], v0[3]); w.z = cvt_pk_bf16(v1[0], v1[1]); w.w = cvt_pk_bf16(v1[2], v1[3]);
                        *(u32x4*)(rowp + bj * HALF) = w; } }
            return;
        }
        const int ocol = (MODE == 0) ? plain_below + (u.ocol - plain_below) / 2 : u.ocol * HALF;
#pragma unroll
        for (int ai = 0; ai < 2; ++ai)
#pragma unroll
            for (int m = 0; m < 4; ++m) { const int rg = u.orow + ai * HALF + wr * 64 + m * 16 + fr; bf16* rowp = O + (size_t)rg * ldc + ocol + wc * 32 + 8 * fq;
                const float scr = rs ? sall * rs[rg] : sall; const float sc2 = scr * scr;
                f32x4 v0, v1;
#pragma unroll
                for (int q = 0; q < 4; ++q) {
                    const float x0 = acc[ai][0][m][0][q], x1 = acc[ai][0][m][1][q];
                    const float g0 = (MODE == 1) ? x0 * __builtin_amdgcn_rcpf(1.0f + __expf(-x0)) : x0, g1 = (MODE == 1) ? x1 * __builtin_amdgcn_rcpf(1.0f + __expf(-x1)) : x1;
                    v0[q] = g0 * acc[ai][1][m][0][q] * sc2; v1[q] = g1 * acc[ai][1][m][1][q] * sc2; }
                u32x4 w; w.x = cvt_pk_bf16(v0[0], v0[1]); w.y = cvt_pk_bf16(v0[2], v0[3]); w.z = cvt_pk_bf16(v1[0], v1[1]); w.w = cvt_pk_bf16(v1[2], v1[3]);
                *(u32x4*)rowp = w; }
    }
};
struct EpiResid { bf16* LAT; const float* g1; float sall; const float* rs;
    __device__ __forceinline__ void operator()(const f32x4 (&acc)[2][2][4][2], const GUnit& u, int wr, int wc, int fr, int fq) const {
        bf16* Ob = LAT + (size_t)u.orow * D + u.ocol + wc * 32 + 8 * fq;
        u32x4 old[2][4][2];
#pragma unroll
        for (int ai = 0; ai < 2; ++ai)
#pragma unroll
            for (int m = 0; m < 4; ++m)
#pragma unroll
                for (int bj = 0; bj < 2; ++bj) old[ai][m][bj] = *(const u32x4*)(Ob + (size_t)(ai * HALF + wr * 64 + m * 16 + fr) * D + bj * HALF);
        const float* gv = g1 + (size_t)mod_vec_of_row(u.orow) * 6 * D + u.ocol + wc * 32 + 8 * fq;
        f32x4 g[2][2];
#pragma unroll
        for (int bj = 0; bj < 2; ++bj) { g[bj][0] = *(const f32x4*)(gv + bj * HALF); g[bj][1] = *(const f32x4*)(gv + bj * HALF + 4); }
#pragma unroll
        for (int ai = 0; ai < 2; ++ai)
#pragma unroll
            for (int m = 0; m < 4; ++m) { const int rl = ai * HALF + wr * 64 + m * 16 + fr; bf16* rowp = Ob + (size_t)rl * D;
                const float scr = rs ? sall * rs[u.orow + rl] : sall;
#pragma unroll
                for (int bj = 0; bj < 2; ++bj) { const u32x4 o = old[ai][m][bj];
                    const f32x4 v0 = bf4((u32x2){o.x, o.y}) + g[bj][0] * (acc[ai][bj][m][0] * scr), v1 = bf4((u32x2){o.z, o.w}) + g[bj][1] * (acc[ai][bj][m][1] * scr);
                    u32x4 w; w.x = cvt_pk_bf16(v0[0], v0[1]); w.y = cvt_pk_bf16(v0[2], v0[3]); w.z = cvt_pk_bf16(v1[0], v1[1]); w.w = cvt_pk_bf16(v1[2], v1[3]);
                    *(u32x4*)(rowp + bj * HALF) = w; } }
    }
};
struct EpiStoreTile { unsigned char* O; int ldc; float s;
    __device__ __forceinline__ void operator()(const f32x4 (&acc)[2][2][4][2], const GUnit& u, int wr, int wc, int fr, int fq) const {
#pragma unroll
        for (int ai = 0; ai < 2; ++ai)
#pragma unroll
            for (int m = 0; m < 4; ++m) { unsigned char* rowp = O + (size_t)(u.orow + ai * HALF + wr * 64 + m * 16 + fr) * ldc + u.ocol * BM + wc * 32 + 8 * fq;
#pragma unroll
                for (int bj = 0; bj < 2; ++bj) *(u32x2*)(rowp + bj * HALF) = cvt8_fp8(acc[ai][bj][m][0] * s, acc[ai][bj][m][1] * s); }
    }
};

__device__ __forceinline__ void transpose_item(const float* W, int ldw, int K, bf16* WT, int drow0, int k0, int n0, LAS float* scr, int lane) {
#pragma unroll
    for (int i = 0; i < 32; ++i) { const int kk = 2 * i + (lane >> 5); scr[kk * 33 + (lane & 31)] = W[(size_t)(k0 + kk) * ldw + n0 + (lane & 31)]; }
    asm volatile("s_waitcnt lgkmcnt(0)" ::: "memory");
    const int c = lane & 7;
#pragma unroll
    for (int j = 0; j < 4; ++j) { const int n = (lane >> 3) + 8 * j; const LAS float* s = scr + (8 * c) * 33 + n;
        u32x4 o; o.x = pk2(s[0 * 33], s[1 * 33]); o.y = pk2(s[2 * 33], s[3 * 33]); o.z = pk2(s[4 * 33], s[5 * 33]); o.w = pk2(s[6 * 33], s[7 * 33]);
        *(u32x4*)(WT + (size_t)(drow0 + n) * K + k0 + 8 * c) = o; }
    asm volatile("s_waitcnt lgkmcnt(0)" ::: "memory");
}
__device__ __forceinline__ void transpose_item_fp8(const float* W, int ldw, int K, unsigned char* WT8, int drow0, int k0, int n0, LAS float* scr, int lane, float sc) {
#pragma unroll
    for (int i = 0; i < 32; ++i) { const int kk = 2 * i + (lane >> 5); scr[kk * 33 + (lane & 31)] = W[(size_t)(k0 + kk) * ldw + n0 + (lane & 31)]; }
    asm volatile("s_waitcnt lgkmcnt(0)" ::: "memory");
    const int n = lane >> 1, half = lane & 1; const LAS float* sp = scr + (32 * half) * 33 + n;
    unsigned char* dst = WT8 + (size_t)(drow0 + n) * K + k0 + 32 * half;
#pragma unroll
    for (int c = 0; c < 2; ++c) { u32x4 o;
#pragma unroll
        for (int q = 0; q < 4; ++q) { int p = 0; const LAS float* s4 = sp + (16 * c + 4 * q) * 33;
            p = __builtin_amdgcn_cvt_pk_fp8_f32(s4[0] * sc, s4[33] * sc, p, false); p = __builtin_amdgcn_cvt_pk_fp8_f32(s4[66] * sc, s4[99] * sc, p, true); o[q] = (unsigned)p; }
        *(u32x4*)(dst + 16 * c) = o; }
    asm volatile("s_waitcnt lgkmcnt(0)" ::: "memory");
}
__device__ __forceinline__ void transpose_item_i8(const float* W, int ldw, int K, unsigned char* WT8, int drow0, int k0, int n0, LAS float* scr, int lane, float inv) {
#pragma unroll
    for (int i = 0; i < 32; ++i) { const int kk = 2 * i + (lane >> 5); scr[kk * 33 + (lane & 31)] = W[(size_t)(k0 + kk) * ldw + n0 + (lane & 31)]; }
    asm volatile("s_waitcnt lgkmcnt(0)" ::: "memory");
    const int n = lane >> 1, half = lane & 1; const LAS float* sp = scr + (32 * half) * 33 + n;
    unsigned char* dst = WT8 + (size_t)(drow0 + n) * K + k0 + 32 * half;
#pragma unroll
    for (int c = 0; c < 2; ++c) { u32x4 o;
#pragma unroll
        for (int q = 0; q < 4; ++q) { const LAS float* s4 = sp + (16 * c + 4 * q) * 33; o[q] = pack_i8((f32x4){s4[0] * inv, s4[33] * inv, s4[66] * inv, s4[99] * inv}); }
        *(u32x4*)(dst + 16 * c) = o; }
    asm volatile("s_waitcnt lgkmcnt(0)" ::: "memory");
}
__device__ __forceinline__ int pair_row(int n, int which) { return (n >> 7) * 256 + (n & 127) + which * 128; }
constexpr float HMR = 6.0f;
__device__ __forceinline__ void phase_cvt_mixer(const Args& A, const Ctx& C) {
    const int gw = C.bid * NW + C.wave, NGW = C.G * NW;
    unsigned* wmax = (unsigned*)(A.ws + WS_CTL) + CW_WMAX;
    for (int m8 = 0; m8 < 8; ++m8) {
        const float* W = m8 < 2 ? A.in[8] + (size_t)m8 * D * PROJ : m8 < 4 ? A.in[12] + (size_t)(m8 - 2) * D * PW : m8 < 6 ? A.in[11] + (size_t)(m8 - 4) * D * D : A.in[14] + (size_t)(m8 - 6) * D * D;
        const size_t n4 = (size_t)D * (m8 < 2 ? PROJ : m8 < 4 ? PW : D) / 4;
        float mx = 0.f;
        for (size_t i = (size_t)gw * 64 + C.lane; i < n4; i += (size_t)NGW * 64) { const f32x4 v = *(const f32x4*)(W + 4 * i); mx = fmaxf(mx, fmaxf(fmaxf(fabsf(v.x), fabsf(v.y)), fmaxf(fabsf(v.z), fabsf(v.w)))); }
        mx = wave_max_nn(mx);
        if (C.lane == 0 && mx > 0.f) atomicMax(wmax + m8 * CNT_STRIDE, __float_as_uint(mx));
    }
}
__device__ __forceinline__ void cvt_win_i8(const Args& A, const Ctx& C) {
    LAS float* scr = (LAS float*)(C.lds + 16384 + C.wave * 16384);
    const int gw = C.bid * NW + C.wave, NGW = C.G * NW;
    constexpr int I_IN = (D / 64) * (PW / 32);
    const unsigned* wmax = (const unsigned*)(A.ws + WS_CTL) + CW_WMAX;
    constexpr int I_OUT = (D / 64) * (D / 32);
    for (int it = gw; it < 4 * I_OUT; it += NGW) {
        const int m4 = it / I_OUT, kind = m4 >> 1, j = m4 & 1, r = it % I_OUT; const int kb = r / (D / 32), nb = r % (D / 32), n0 = nb * 32;
        const float inv = 127.0f / fmaxf(__uint_as_float(wmax[(4 + m4) * CNT_STRIDE]), 1.0e-30f);
        transpose_item_i8((kind == 0 ? A.in[11] : A.in[14]) + (size_t)j * D * D, D, D, A.ws + (kind == 0 ? WS_WAOUT : WS_WBOUT) + (size_t)j * D * D, n0, kb * 64, n0, scr, C.lane, inv); }
    for (int it = gw; it < 4 * I_IN; it += NGW) {
        const int m4 = it / I_IN, kind = m4 >> 1, j = m4 & 1, r = it % I_IN; const int kb = r / (PW / 32), nb = r % (PW / 32), n0 = nb * 32;
        const float inv = 127.0f / fmaxf(__uint_as_float(wmax[m4 * CNT_STRIDE]), 1.0e-30f);
        unsigned char* WT = A.ws + (kind == 0 ? WS_WAIN : WS_WBIN) + (size_t)j * PW * D;
        if (kind == 0) transpose_item_i8(A.in[8] + (size_t)j * D * PROJ, PROJ, D, WT, n0, kb * 64, n0, scr, C.lane, inv);
        else { const int drow = n0 < D ? n0 : (n0 < 2 * D ? D + pair_row(n0 - D, 0) : D + pair_row(n0 - 2 * D, 1));
            transpose_item_i8(A.in[12] + (size_t)j * D * PW, PW, D, WT, drow, kb * 64, n0, scr, C.lane, inv); }
    }
}
__device__ __forceinline__ void cvt_moe_items(const Args& A, const Ctx& C, int l, int it0, int end, int stride) {
    LAS float* scr = (LAS float*)(C.lds + 16384 + C.wave * 16384);
    unsigned char* WGU = A.ws + WS_WGU; unsigned char* WDN = A.ws + WS_WDN;
    for (int it = it0; it < end; it += stride) {
        const int e = it / CVT_PER; int r = it % CVT_PER;
        if (r < 2 * CVT_IG) { const int which = r / CVT_IG; r %= CVT_IG; const int kb = r / (DE / 32), nb = r % (DE / 32), n0 = nb * 32;
            transpose_item_fp8((which == 0 ? A.in[19] : A.in[20]) + ((size_t)l * NE + e) * D * DE, DE, D, WGU + (size_t)e * 2 * DE * D, pair_row(n0, which), kb * 64, n0, scr, C.lane, WSCALE); }
        else { r -= 2 * CVT_IG; const int kb = r / (D / 32), nb = r % (D / 32), n0 = nb * 32;
            transpose_item_fp8(A.in[21] + ((size_t)l * NE + e) * DE * D, D, DE, WDN + (size_t)e * D * DE, n0, kb * 64, n0, scr, C.lane, WSCALE); }
    }
}
__device__ __forceinline__ int cvt_idle(int nunits, int G) { const int rem = nunits % G; return rem ? G - rem : 0; }
__device__ __forceinline__ int cvt_t1(int l, int G) { const int n = cvt_idle((((l <= 2) ? NR : NL) / BM) * (PW / BM), G) * CVT_Q; return n < CVT_ITEMS ? n : CVT_ITEMS; }
__device__ __forceinline__ int cvt_t2(int l, int G) { const int n = cvt_t1(l, G) + cvt_idle((((l <= 1) ? NR : NL) / BM) * (D / BM), G) * CVT_Q; return n < CVT_ITEMS ? n : CVT_ITEMS; }
__device__ __forceinline__ void cvt_moe_tail(const Args& A, const Ctx& C, int l, int nunits, int base, int end) {
    const int rem = nunits % C.G;
    if (rem == 0 || C.bid < rem) return;
    const int first = base + (C.bid - rem) * CVT_Q; const int last = min(first + CVT_Q, end);
    cvt_moe_items(A, C, l, first + C.wave, last, NW);
}

__device__ __forceinline__ void phase_g1(const Args& A, const Ctx& C, int l) {
    const bool mls = (l & 1) == 0; const int j = l >> 1; const int nrows = (l <= 2) ? NR : NL;
    DenseSched S; S.init(A.ws + WS_H8, A.ws + (mls ? WS_WAIN : WS_WBIN) + (size_t)j * PW * D, nrows, PW, D, C.G, C.bid, 1);
    const float wsc = __uint_as_float(((const unsigned*)(A.ws + WS_CTL))[CW_WMAX + ((mls ? 0 : 2) + j) * CNT_STRIDE]) * (1.0f / 127.0f);
    const float* rs = (const float*)(A.ws + WS_RSC);
    if (mls) { S.sw_lo = 4; S.sw_hi = 8; EpiStore E{(bf16*)(A.ws + WS_PB), PW, 0.08838834764831845f, 2 * NQ + NV, (bf16*)(A.ws + WS_VT), wsc, rs}; gemm_phase<EpiStore, DenseSched, false, 2>(C.lds, D, S, E); }
    else { EpiPair<0> E{(bf16*)(A.ws + WS_PB), PW, D, wsc, rs}; gemm_phase<EpiPair<0>, DenseSched, false, 2>(C.lds, D, S, E); }
    cvt_moe_tail(A, C, l, S.nwg, 0, cvt_t1(l, C.G));
}
__device__ __forceinline__ void phase_g2(const Args& A, const Ctx& C, int l) {
    const bool mls = (l & 1) == 0; const int j = l >> 1; const int nrows = (l <= 1) ? NR : NL;
    DenseSched S; S.init(A.ws + WS_HM, A.ws + (mls ? WS_WAOUT : WS_WBOUT) + (size_t)j * D * D, nrows, D, D, C.G, C.bid, 1);
    const float wsc = __uint_as_float(((const unsigned*)(A.ws + WS_CTL))[CW_WMAX + (4 + (mls ? 0 : 2) + j) * CNT_STRIDE]) * (1.0f / 127.0f);
    EpiResid E{(bf16*)(A.ws + WS_LAT), (const float*)(A.ws + WS_MOD) + (size_t)(l * 3) * 6 * D + 2 * D, mls ? wsc * (HMR / 127.0f) : wsc, mls ? nullptr : (const float*)(A.ws + WS_RSC)}; gemm_phase<EpiResid, DenseSched, false, 2>(C.lds, D, S, E);
    cvt_moe_tail(A, C, l, S.nwg, cvt_t1(l, C.G), cvt_t2(l, C.G));
}
__device__ __forceinline__ void phase_m1(const Args& A, const Ctx& C, int l) {
    LAS MoeTab* T = (LAS MoeTab*)(C.lds + LDS_TAB); LAS unsigned* ridx = (LAS unsigned*)(C.lds + LDS_TAB + 1024);
    moe_tables<true>(A, C, l, 4, T, ridx, D);
    MoeSched S; S.T = T; S.ridx = ridx; S.A = (const char*)(A.ws + WS_H8); S.W = (const char*)(A.ws + WS_WGU); S.wstride_e = (size_t)2 * DE * D; S.tstepB = (size_t)BM * D; S.K = D; S.arow_bytes = 0;
    EpiSwigluF8 E{A.ws + WS_DC, DE, 1.0f / WSCALE}; gemm_phase<EpiSwigluF8, MoeSched, true, 1>(C.lds, D, S, E);
}
__device__ __forceinline__ void phase_m2(const Args& A, const Ctx& C, int l) {
    LAS MoeTab* T = (LAS MoeTab*)(C.lds + LDS_TAB); LAS unsigned* ridx = (LAS unsigned*)(C.lds + LDS_TAB + 1024);
    moe_tables<false>(A, C, l, 4, T, ridx, DE);
    MoeSched S; S.T = T; S.ridx = ridx; S.A = (const char*)(A.ws + WS_DC); S.W = (const char*)(A.ws + WS_WDN); S.wstride_e = (size_t)D * DE; S.tstepB = (size_t)BM * DE; S.K = DE; S.arow_bytes = DE;
    EpiStoreTile E{A.ws + WS_PB, D, YSCALE / WSCALE}; gemm_phase<EpiStoreTile, MoeSched, false, 1>(C.lds, DE, S, E);
}

typedef float f32x16 __attribute__((ext_vector_type(16)));
#define MFMA32(a, b, c) __builtin_amdgcn_mfma_f32_32x32x16_bf16((a), (b), (c), 0, 0, 0)
__device__ __forceinline__ bf16x8 pack8(float a0, float a1, float a2, float a3, float a4, float a5, float a6, float a7) {
    u32x4 p; p.x = cvt2(a0, a1); p.y = cvt2(a2, a3); p.z = cvt2(a4, a5); p.w = cvt2(a6, a7); return __builtin_bit_cast(bf16x8, p); }
__device__ __forceinline__ float bflo(unsigned w) { return __uint_as_float(w << 16); }
__device__ __forceinline__ float bfhi(unsigned w) { return __uint_as_float(w & 0xffff0000u); }
__device__ __forceinline__ int vt_tile(int b, int h, int blk) { return (blk == 0 ? 128 + b : b * 64 + blk - 1) * NH + h; }

__device__ __forceinline__ float wave_incl_scan(float v, int lane) {
#pragma unroll
    for (int o = 1; o < 64; o <<= 1) { const float t = __shfl_up(v, o); v += (lane >= o) ? t : 0.f; }
    return v;
}
__device__ __forceinline__ void block_gates(const Args& A, int row0, int h, LAS float* bf, LAS float* bb, LAS float* lif, LAS float* lib, int tid) {
    const float* GATE = (const float*)(A.ws + WS_GATE);
    if (tid < 256) { const float* g = GATE + (size_t)(row0 + tid) * 16; lif[tid] = g[0 + h]; bf[tid] = g[4 + h]; lib[tid] = g[8 + h]; bb[tid] = g[12 + h]; }
    __syncthreads();
    const int lane = tid & 63, wv = tid >> 6;
    if (wv == 0) { f32x4 x = *(LAS f32x4*)(bf + 4 * lane); x.y += x.x; x.z += x.y; x.w += x.z; const float tot = wave_incl_scan(x.w, lane); const float ex = tot - x.w;
        x.x += ex; x.y += ex; x.z += ex; x.w += ex; *(LAS f32x4*)(bf + 4 * lane) = x; }
    if (wv == 1) { f32x4 y = *(LAS f32x4*)(bb + 4 * (63 - lane)); y.z += y.w; y.y += y.z; y.x += y.y; const float tot = wave_incl_scan(y.x, lane); const float ex = tot - y.x;
        y.x += ex; y.y += ex; y.z += ex; y.w += ex; *(LAS f32x4*)(bb + 4 * (63 - lane)) = y; }
    __syncthreads();
}
__device__ __forceinline__ void phase_s1(const Args& A, const Ctx& C, int l) {
    LAS float* bf = (LAS float*)C.lds; LAS float* bb = bf + 256; LAS float* lif = bb + 256; LAS float* lib = lif + 256; LAS float* af = lib + 256; LAS float* ab = af + 256;
    constexpr int KP = 528;
    LAS unsigned char* KTf = C.lds + 8192; LAS unsigned char* KTb = KTf + 128 * KP;
    const bf16* P = (const bf16*)(A.ws + WS_PB); const bf16* VT = (const bf16*)(A.ws + WS_VT);
    bf16* DC = (bf16*)(A.ws + WS_DC); float* DN = (float*)(A.ws + WS_DN); float* BT = (float*)(A.ws + WS_BTOT);
    const int r = C.lane & 31, hh = C.lane >> 5, w = C.wave;
    for (int it = C.bid; it < BATCH * NH * (NBLK - 1) + 2 * BATCH * NH; it += C.G) {
        const bool isctx = it >= BATCH * NH * (NBLK - 1); const int ci_ = it - BATCH * NH * (NBLK - 1);
        const int bh = isctx ? (ci_ >> 1) : it / (NBLK - 1), blk = isctx ? 0 : 1 + it % (NBLK - 1), h = bh % NH, b = bh / NH; const int u = bh * NBLK + blk; const int row0 = blk_row0(b, blk);
        const int dlo = isctx ? (ci_ & 1) : 0, dhi = isctx ? (ci_ & 1) + 1 : 2;
        block_gates(A, row0, h, bf, bb, lif, lib, C.tid);
        if (C.tid < 256) { af[C.tid] = __expf(bf[255] - bf[C.tid] + lif[C.tid]); ab[C.tid] = __expf(bb[0] - bb[C.tid] + lib[C.tid]); }
        if (C.tid == 0) { BT[u * 2 + 0] = bf[255]; BT[u * 2 + 1] = bb[0]; }
        __syncthreads();
        { const int sp = C.tid >> 2, dq = C.tid & 3, s0 = 2 * sp;
          const bf16* k0 = P + (size_t)(row0 + s0) * PW + NQ + h * DQK + 32 * dq;
          const float f0 = af[s0], f1 = af[s0 + 1], g0 = ab[s0], g1 = ab[s0 + 1];
#pragma unroll
          for (int c = 0; c < 4; ++c) { const u32x4 x0 = *(const u32x4*)(k0 + 8 * c), x1 = *(const u32x4*)(k0 + PW + 8 * c);
#pragma unroll
              for (int q = 0; q < 4; ++q) { const int d = 32 * dq + 8 * c + 2 * q;
                  const float a0 = bflo(x0[q]), a1 = bfhi(x0[q]), c0 = bflo(x1[q]), c1 = bfhi(x1[q]);
                  *(LAS unsigned*)(KTf + d * KP + s0 * 2) = cvt2(a0 * f0, c0 * f1); *(LAS unsigned*)(KTf + (d + 1) * KP + s0 * 2) = cvt2(a1 * f0, c1 * f1);
                  *(LAS unsigned*)(KTb + d * KP + s0 * 2) = cvt2(a0 * g0, c0 * g1); *(LAS unsigned*)(KTb + (d + 1) * KP + s0 * 2) = cvt2(a1 * g0, c1 * g1); } } }
        __syncthreads();
        if (C.tid < 256) { const int dir = C.tid >> 7, d = C.tid & 127; LAS const unsigned* kr = (LAS const unsigned*)((dir ? KTb : KTf) + d * KP); float s = 0.f;
            for (int i = 0; i < 128; ++i) { const unsigned x = kr[i]; s += bflo(x) + bfhi(x); }
            DN[(size_t)(u * 2 + dir) * DQK + d] = s; }
        const bf16* vt = VT + (size_t)vt_tile(b, h, blk) * 65536 + (size_t)(32 * w + r) * 32 + 8 * hh;
        bf16x8 av[16];
#pragma unroll
        for (int ks = 0; ks < 16; ++ks) av[ks] = *(const bf16x8*)(vt + (ks >> 1) * 8192 + 16 * (ks & 1));
#pragma unroll 1
        for (int dir = dlo; dir < dhi; ++dir) {
            LAS const unsigned char* KT = dir ? KTb : KTf;
            f32x16 acc[4];
#pragma unroll
            for (int dt = 0; dt < 4; ++dt)
#pragma unroll
                for (int i = 0; i < 16; ++i) acc[dt][i] = 0.f;
#pragma unroll
            for (int ks = 0; ks < 16; ++ks) {
#pragma unroll
                for (int dt = 0; dt < 4; ++dt) { const bf16x8 b0 = *(const LAS bf16x8*)(KT + (dt * 32 + r) * KP + (16 * ks + 8 * hh) * 2); acc[dt] = MFMA32(av[ks], b0, acc[dt]); }
                if ((ks & 3) == 3) asm volatile("" ::: "memory"); }
            bf16* dc = DC + (size_t)(u * 2 + dir) * DQK * DV + (size_t)(32 * w + 4 * hh) * 32 + r;
#pragma unroll
            for (int g = 0; g < 4; ++g) { bf16* pf = dc + g * 8 * 32; asm volatile("" : "+v"(pf));
#pragma unroll
                for (int q = 0; q < 4; ++q)
#pragma unroll
                    for (int dt = 0; dt < 4; ++dt) pf[q * 32 + dt * 8192] = (bf16)f2bf(acc[dt][4 * g + q]); }
        }
        __syncthreads();
    }
}
__device__ __forceinline__ void phase_s2(const Args& A, const Ctx& C) {
    const bf16* __restrict__ DC = (const bf16*)(A.ws + WS_DC); const float* __restrict__ DN = (const float*)(A.ws + WS_DN); const float* __restrict__ BT = (const float*)(A.ws + WS_BTOT);
    bf16* __restrict__ CST = (bf16*)(A.ws + WS_CST); float* __restrict__ NST = (float*)(A.ws + WS_NST);
    constexpr int EL4 = DQK * DV / 4;
    for (int g = C.bid * NT + C.tid; g < BATCH * NH * 2 * EL4; g += C.G * NT) {
        const int e4 = (g % EL4) * 4, ch = g / EL4, dir = ch & 1, bh = ch >> 1;
        f32x4 st = (f32x4){0.f, 0.f, 0.f, 0.f};
#pragma unroll 13
        for (int idx = 0; idx < NBLK; ++idx) {
            const int blk = dir == 0 ? idx : (idx == 0 ? 0 : NBLK - idx); const int u = bh * NBLK + blk;
            const float dec = __expf(BT[u * 2 + dir]);
            const f32x4 dc = bf4(*(const u32x2*)(DC + (size_t)(u * 2 + dir) * DQK * DV + e4));
            u32x2 o; o.x = cvt2(st.x, st.y); o.y = cvt2(st.z, st.w);
            *(u32x2*)(CST + (size_t)(u * 2 + dir) * DQK * DV + e4) = o;
            st = st * dec + dc;
        }
    }
    for (int g = C.bid * NT + C.tid; g < BATCH * NH * 2 * DQK; g += C.G * NT) {
        const int d = g % DQK, ch = g / DQK, dir = ch & 1, bh = ch >> 1; float st = 0.f;
        for (int idx = 0; idx < NBLK; ++idx) {
            const int blk = dir == 0 ? idx : (idx == 0 ? 0 : NBLK - idx); const int u = bh * NBLK + blk;
            NST[(size_t)(u * 2 + dir) * DQK + d] = st; st = __expf(BT[u * 2 + dir]) * st + DN[(size_t)(u * 2 + dir) * DQK + d];
        }
    }
}
__device__ __forceinline__ void lds_barrier() { asm volatile("s_waitcnt lgkmcnt(0)" ::: "memory"); __builtin_amdgcn_s_barrier(); asm volatile("" ::: "memory"); }
__device__ __forceinline__ void phase_s3(const Args& A, const Ctx& C, int l) {
    const int jl = l >> 1; const bool ctx_out = (l == 0);
    LAS float* bf = (LAS float*)C.lds; LAS float* bb = bf + 256; LAS float* gf = bb + 256; LAS float* gb = gf + 256;
    LAS float* nf = gb + 256; LAS float* nb = nf + 128; LAS float* ssx = nb + 128;
    LAS float* cf = ssx + 256; LAS float* cb = cf + 256;
    constexpr int KP = 272, OP = 528, CHB = 16384, NCHB = 4;
    LAS unsigned char* Kimg = C.lds + 8192;
    LAS unsigned char* CH = Kimg + 256 * KP;
    LAS unsigned char* OUT = Kimg;
    static_assert(8192 + 256 * KP + NCHB * CHB <= LDS_TAB_END && 8192 + 256 * OP <= LDS_TAB_END, "S3 LDS map");
    const bf16* P = (const bf16*)(A.ws + WS_PB); const bf16* VT = (const bf16*)(A.ws + WS_VT); unsigned char* HM = A.ws + WS_HM;
    const bf16* CST = (const bf16*)(A.ws + WS_CST); const float* NST = (const float*)(A.ws + WS_NST);
    const float* hg = A.in[10] + (size_t)jl * NV;
    const int w = C.wave;
    bf16x8 qf[8]; u32x4 kr8[8]; f32x4 gl;
#define S3_UNIT(it_) ((it_) < BATCH * NH * (NBLK - 1) ? ((it_) / (NBLK - 1)) * NBLK + 1 + (it_) % (NBLK - 1) : ((it_) - BATCH * NH * (NBLK - 1)) * NBLK)
#define S3_LOAD_IN(u_) do { const int u2_ = (u_); const int blk_ = u2_ % NBLK, bh_ = u2_ / NBLK, h_ = bh_ % NH, b_ = bh_ / NH; const int row0_ = blk_row0(b_, blk_); \
        int tq_ = threadIdx.x; asm volatile("" : "+v"(tq_)); const int lq_ = tq_ & 63; \
        { const bf16* qr_ = P + (size_t)(row0_ + 32 * w + (lq_ & 31)) * PW + h_ * DQK + 8 * (lq_ >> 5); \
          _Pragma("unroll") for (int kk = 0; kk < 8; ++kk) qf[kk] = *(const bf16x8*)(qr_ + 16 * kk); } \
        { const bf16* kr_ = P + (size_t)(row0_ + (tq_ >> 4)) * PW + NQ + h_ * DQK + 8 * (tq_ & 15); \
          _Pragma("unroll") for (int i = 0; i < 8; ++i) kr8[i] = *(const u32x4*)(kr_ + (size_t)(32 * i) * PW); } \
        if (tq_ < 256) { const float* g_ = (const float*)(A.ws + WS_GATE) + (size_t)(row0_ + tq_) * 16 + h_; gl = (f32x4){g_[0], g_[4], g_[8], g_[12]}; } \
        else { const int t2_ = tq_ - 256; gl = (f32x4){NST[(size_t)(u2_ * 2 + (t2_ >> 7)) * DQK + (t2_ & 127)], 0.f, 0.f, 0.f}; } } while (0)
    const int nitems = BATCH * NH * (NBLK - 1) + (ctx_out ? BATCH * NH : 0);
    int it = C.bid;
    if (it < nitems) S3_LOAD_IN(S3_UNIT(it));
    while (it < nitems) {
        const int u = S3_UNIT(it);
        const int blk = u % NBLK, bh = u / NBLK, h = bh % NH, b = bh / NH; const int row0 = blk_row0(b, blk);
        const int itn = it + C.G; const int un = itn < nitems ? S3_UNIT(itn) : u;
        const bf16* vtile = VT + (size_t)vt_tile(b, h, blk) * 65536;
        const bf16* ctile = CST + (size_t)(u * 2) * DQK * DV;
#define S3_DMA(c_) do { const int cc_ = (c_); const bool isv_ = cc_ < 8; int ld_ = threadIdx.x & 63; asm volatile("" : "+v"(ld_)); \
                const unsigned dlp_ = (unsigned)(((ld_ & 3) ^ ((ld_ >> 4) & 3)) * 16), drow_ = (unsigned)(32 * w + (ld_ >> 2)); \
                const unsigned long long gp_ = (unsigned long long)(isv_ ? (const char*)vtile + 16384 * cc_ : (const char*)ctile + (cc_ >= 12 ? 2 * DQK * DV : 0) + 16384 * ((cc_ - 8) & 3)); \
                const char* gb_ = (const char*)(((unsigned long long)(unsigned)__builtin_amdgcn_readfirstlane((int)(unsigned)(gp_ >> 32)) << 32) | (unsigned)__builtin_amdgcn_readfirstlane((int)(unsigned)gp_)); \
                _Pragma("unroll") for (int jj = 0; jj < 2; ++jj) \
                    asm volatile("s_mov_b32 m0, %2\n\ts_nop 0\n\tglobal_load_lds_dwordx4 %0, %1" :: "v"(((drow_ + 16u * jj) << 6) + dlp_), "s"(gb_), "s"((unsigned)(size_t)CH + (unsigned)w * 2048u + (unsigned)((cc_ & 3) * CHB + jj * 1024)) : "memory"); } while (0)
        S3_DMA(0); S3_DMA(1); S3_DMA(2);
        { int tu = threadIdx.x; asm volatile("" : "+v"(tu));
          if (tu < 256) { gf[tu] = gl.x; bf[tu] = gl.y; gb[tu] = gl.z; bb[tu] = gl.w; } else nf[tu - 256] = gl.x;
          { const int pc = tu & 15, s0 = tu >> 4, ps0 = (s0 & ~12) | ((s0 & 4) << 1) | ((s0 & 8) >> 1);
#pragma unroll
            for (int i = 0; i < 8; ++i) *(LAS u32x4*)(Kimg + (ps0 + 32 * i) * KP + pc * 16) = kr8[i]; }
          lds_barrier();
          const int lane = tu & 63, wv = tu >> 6;
          if (wv == 0) { f32x4 x = *(LAS f32x4*)(bf + 4 * lane); x.y += x.x; x.z += x.y; x.w += x.z; const float tot = wave_incl_scan(x.w, lane); const float ex = tot - x.w;
              x.x += ex; x.y += ex; x.z += ex; x.w += ex; *(LAS f32x4*)(bf + 4 * lane) = x; }
          if (wv == 1) { f32x4 y = *(LAS f32x4*)(bb + 4 * (63 - lane)); y.z += y.w; y.y += y.z; y.x += y.y; const float tot = wave_incl_scan(y.x, lane); const float ex = tot - y.x;
              y.x += ex; y.y += ex; y.z += ex; y.w += ex; *(LAS f32x4*)(bb + 4 * (63 - lane)) = y; }
          lds_barrier();
          if (tu < 256) { const float a0 = gf[tu] - bf[tu], a1 = gb[tu] - bb[tu]; gf[tu] = a0; gb[tu] = a1; cf[tu] = __expf(bf[tu | 31] + a0); cb[tu] = __expf(bb[tu & ~31] + a1); }
          lds_barrier(); }
        {
            int lz = threadIdx.x & 63; asm volatile("" : "+v"(lz));
            const int r = lz & 31, hh = lz >> 5;
            const int jt = w;
            const float bfj = bf[32 * jt + r], bbj = bb[32 * jt + r];
            float qnf = 0.f, qnb = 0.f;
#pragma unroll
            for (int kk = 0; kk < 8; ++kk) { u32x4 qq = __builtin_bit_cast(u32x4, qf[kk]); asm volatile("" : "+v"(qq));
                const int d = 16 * kk + 8 * hh;
                const f32x4 n0 = *(const LAS f32x4*)(nf + d), n1 = *(const LAS f32x4*)(nf + d + 4), m0 = *(const LAS f32x4*)(nb + d), m1 = *(const LAS f32x4*)(nb + d + 4);
                qnf += (bflo(qq.x) * n0.x + bfhi(qq.x) * n0.y) + (bflo(qq.y) * n0.z + bfhi(qq.y) * n0.w) + (bflo(qq.z) * n1.x + bfhi(qq.z) * n1.y) + (bflo(qq.w) * n1.z + bfhi(qq.w) * n1.w);
                qnb += (bflo(qq.x) * m0.x + bfhi(qq.x) * m0.y) + (bflo(qq.y) * m0.z + bfhi(qq.y) * m0.w) + (bflo(qq.z) * m1.x + bfhi(qq.z) * m1.y) + (bflo(qq.w) * m1.z + bfhi(qq.w) * m1.w);
                if (kk & 1) asm volatile("" ::: "memory"); }
            qnf += __shfl_xor(qnf, 32); qnb += __shfl_xor(qnb, 32);
            float denf = 0.f, denb = 0.f;
#pragma unroll 1
            for (int kt = 0; kt < 8; ++kt) {
                f32x16 c;
#pragma unroll
                for (int i = 0; i < 16; ++i) c[i] = 0.f;
#pragma unroll
                for (int kk = 0; kk < 8; ++kk) { const bf16x8 a = *(const LAS bf16x8*)(Kimg + (kt * 32 + r) * KP + (16 * kk + 8 * hh) * 2); c = MFMA32(a, qf[kk], c); }
                if (kt == jt) {
#pragma unroll
                    for (int g = 0; g < 4; ++g) { const int sl0 = 16 * (g >> 1) + 8 * hh + 4 * (g & 1);
                        const f32x4 g4f = *(const LAS f32x4*)(gf + kt * 32 + sl0), g4b = *(const LAS f32x4*)(gb + kt * 32 + sl0);
#pragma unroll
                        for (int q = 0; q < 4; ++q) { const int sl = sl0 + q; const float cv = c[4 * g + q];
                            denf += cv * __expf((sl <= r) ? bfj + g4f[q] : -1.0e30f); denb += cv * __expf((sl >= r) ? bbj + g4b[q] : -1.0e30f); } }
                } else {
                    LAS const float* cx = (kt < jt ? cf : cb) + kt * 32 + 8 * hh; float sm = 0.f;
#pragma unroll
                    for (int g = 0; g < 4; ++g) { const f32x4 c4 = *(const LAS f32x4*)(cx + 16 * (g >> 1) + 4 * (g & 1)); sm += (c[4 * g] * c4.x + c[4 * g + 1] * c4.y) + (c[4 * g + 2] * c4.z + c[4 * g + 3] * c4.w); }
                    if (kt < jt) denf += sm * __expf(bfj - bf[kt * 32 + 31]); else denb += sm * __expf(bbj - bb[kt * 32]);
                }
            }
            denf += __shfl_xor(denf, 32); denb += __shfl_xor(denb, 32);
            const float ebf = __expf(bfj), ebb = __expf(bbj);
            denf += ebf * qnf; denb += ebb * qnb;
            const float rf = 1.0f / fmaxf(fabsf(denf), 1.0f), rb = 1.0f / fmaxf(fabsf(denb), 1.0f);
            const float scf = ebf * rf, scb = ebb * rb;
            unsigned wdg[8];
#pragma unroll
            for (int g = 0; g < 4; ++g) { const int sl0 = 16 * (g >> 1) + 8 * hh + 4 * (g & 1);
                const f32x4 g4f = *(const LAS f32x4*)(gf + jt * 32 + sl0), g4b = *(const LAS f32x4*)(gb + jt * 32 + sl0);
                float wv[4];
#pragma unroll
                for (int q = 0; q < 4; ++q) { const int sl = sl0 + q; wv[q] = rf * __expf((sl <= r) ? bfj + g4f[q] : -1.0e30f) + rb * __expf((sl >= r) ? bbj + g4b[q] : -1.0e30f); }
                wdg[2 * g] = cvt2(wv[0], wv[1]); wdg[2 * g + 1] = cvt2(wv[2], wv[3]); }
            f32x16 acc[8];
#pragma unroll
            for (int et = 0; et < 8; ++et)
#pragma unroll
                for (int i = 0; i < 16; ++i) acc[et][i] = 0.f;
            asm volatile("s_waitcnt vmcnt(0)" ::: "memory");
            const int swz = (r >> 2) & 3;
#pragma unroll 1
            for (int ci = 0; ci < 8; ++ci) {
                if (ci) { if (blk == 0 && ci >= 6) { if (ci == 6) asm volatile("s_waitcnt vmcnt(2)" ::: "memory"); else asm volatile("s_waitcnt vmcnt(0)" ::: "memory"); } else asm volatile("s_waitcnt vmcnt(4)" ::: "memory"); }
                lds_barrier();
                if (blk != 0 || ci + 3 < 8) S3_DMA(ci + 3);
                LAS const unsigned char* CHc = CH + (ci & 3) * CHB;
                { const int kt = ci;
                        f32x16 c;
#pragma unroll
                        for (int i = 0; i < 16; ++i) c[i] = 0.f;
#pragma unroll
                        for (int kk = 0; kk < 8; ++kk) { const bf16x8 a = *(const LAS bf16x8*)(Kimg + (kt * 32 + r) * KP + (16 * kk + 8 * hh) * 2); c = MFMA32(a, qf[kk], c); }
                        float p[16];
                        if (kt == jt) {
#pragma unroll
                            for (int i = 0; i < 8; ++i) { p[2 * i] = c[2 * i] * bflo(wdg[i]); p[2 * i + 1] = c[2 * i + 1] * bfhi(wdg[i]); }
                        } else {
                            LAS const float* cx = (kt < jt ? cf : cb) + kt * 32 + 8 * hh;
                            const float rw = (kt < jt) ? rf * __expf(bfj - bf[kt * 32 + 31]) : rb * __expf(bbj - bb[kt * 32]);
#pragma unroll
                            for (int g = 0; g < 4; ++g) { const f32x4 c4 = *(const LAS f32x4*)(cx + 16 * (g >> 1) + 4 * (g & 1));
                                p[4 * g] = c[4 * g] * (c4.x * rw); p[4 * g + 1] = c[4 * g + 1] * (c4.y * rw); p[4 * g + 2] = c[4 * g + 2] * (c4.z * rw); p[4 * g + 3] = c[4 * g + 3] * (c4.w * rw); }
                        }
                        const bf16x8 pa0 = pack8(p[0], p[1], p[2], p[3], p[4], p[5], p[6], p[7]), pa1 = pack8(p[8], p[9], p[10], p[11], p[12], p[13], p[14], p[15]);
#pragma unroll
                        for (int et = 0; et < 8; ++et) { LAS const unsigned char* vb = CHc + (et * 32 + r) * 64;
                            const bf16x8 a0 = *(const LAS bf16x8*)(vb + ((hh ^ swz) << 4)), a1 = *(const LAS bf16x8*)(vb + (((2 + hh) ^ swz) << 4));
                            acc[et] = MFMA32(a0, pa0, acc[et]); acc[et] = MFMA32(a1, pa1, acc[et]);
                            if (et & 1) asm volatile("" ::: "memory"); }
                }
            }
            if (blk != 0) {
#pragma unroll
            for (int ci = 8; ci < 16; ++ci) {
                if (ci <= 13) asm volatile("s_waitcnt vmcnt(4)" ::: "memory"); else if (ci == 14) asm volatile("s_waitcnt vmcnt(2)" ::: "memory"); else asm volatile("s_waitcnt vmcnt(0)" ::: "memory");
                lds_barrier();
                if (ci + 3 < 16) S3_DMA(ci + 3);
                LAS const unsigned char* CHc = CH + (ci & 3) * CHB;
                {
                    const int dir = (ci - 8) >> 2, dq = (ci - 8) & 3;
                    const float sc = dir ? scb : scf;
#pragma unroll
                    for (int k2 = 0; k2 < 2; ++k2) { const u32x4 qq = __builtin_bit_cast(u32x4, qf[2 * dq + k2]);
                        const bf16x8 qs = pack8(bflo(qq.x) * sc, bfhi(qq.x) * sc, bflo(qq.y) * sc, bfhi(qq.y) * sc, bflo(qq.z) * sc, bfhi(qq.z) * sc, bflo(qq.w) * sc, bfhi(qq.w) * sc);
#pragma unroll
                        for (int et = 0; et < 8; ++et) { const bf16x8 a = *(const LAS bf16x8*)(CHc + (et * 32 + r) * 64 + (((2 * k2 + hh) ^ swz) << 4)); acc[et] = MFMA32(a, qs, acc[et]);
                            if ((et & 3) == 3) asm volatile("" ::: "memory"); } }
                }
            }
            }
            u32x4 ov[16]; f32x4 g0, g1;
            { int tz = threadIdx.x & 63; asm volatile("" : "+v"(tz)); const int pc = tz & 31, lr0 = tz >> 5;
              g0 = *(const f32x4*)(hg + h * DV + 8 * pc); g1 = *(const f32x4*)(hg + h * DV + 8 * pc + 4);
#pragma unroll
              for (int i = 0; i < 16; ++i) ov[i] = *(const u32x4*)(P + (size_t)(row0 + 32 * w + lr0 + 2 * i) * PW + 2 * NQ + NV + h * DV + 8 * pc); }
            float ss = 0.f;
#pragma unroll
            for (int et = 0; et < 8; ++et)
#pragma unroll
                for (int i = 0; i < 16; ++i) ss += acc[et][i] * acc[et][i];
            ss += __shfl_xor(ss, 32);
            const float rs = 1.0f / sqrtf(ss * (1.0f / DV) + EPS);
            lds_barrier();
            { LAS unsigned char* ob = OUT + (w * 32 + r) * OP + (4 * hh) * 2;
#pragma unroll
              for (int et = 0; et < 8; ++et)
#pragma unroll
                  for (int g = 0; g < 4; ++g) { u32x2 o; o.x = cvt2(acc[et][4 * g + 0] * rs, acc[et][4 * g + 1] * rs); o.y = cvt2(acc[et][4 * g + 2] * rs, acc[et][4 * g + 3] * rs);
                      *(LAS u32x2*)(ob + (et * 32 + 8 * g) * 2) = o; } }
            asm volatile("s_waitcnt lgkmcnt(0)" ::: "memory");
            S3_LOAD_IN(un);
            { int tz = threadIdx.x & 63; asm volatile("" : "+v"(tz)); const int pc = tz & 31, lr0 = tz >> 5;
#pragma unroll
              for (int i = 0; i < 16; ++i) { const int lr = 32 * w + lr0 + 2 * i; const int grow = row0 + lr;
                  const u32x4 hv = *(const LAS u32x4*)(OUT + lr * OP + pc * 16);
                  const f32x4 o0 = (f32x4){bflo(hv.x) * g0.x * bflo(ov[i].x), bfhi(hv.x) * g0.y * bfhi(ov[i].x), bflo(hv.y) * g0.z * bflo(ov[i].y), bfhi(hv.y) * g0.w * bfhi(ov[i].y)};
                  const f32x4 o1 = (f32x4){bflo(hv.z) * g1.x * bflo(ov[i].z), bfhi(hv.z) * g1.y * bfhi(ov[i].z), bflo(hv.w) * g1.z * bflo(ov[i].w), bfhi(hv.w) * g1.w * bfhi(ov[i].w)};
                  *(u32x2*)(HM + (size_t)grow * D + h * DV + 8 * pc) = (u32x2){pack_i8(o0 * (127.0f / HMR)), pack_i8(o1 * (127.0f / HMR))};
                  if ((i & 3) == 3) asm volatile("" ::: "memory"); } }
        }
#undef S3_DMA
        lds_barrier();
        it = itn;
    }
#undef S3_LOAD_IN
#undef S3_UNIT
}

#define XB_TMO      128
#define XB_XCNT(j)  (256  + 64 * (j))
#define XB_XSUB(j)  (1280 + 64 * (j))
#define XB_XGEN(j)  (2304 + 64 * (j))
#define XB_TOP      3328
#define XB_TOPGEN   3392
#define XCD_BAR_WORDS 3456
#define XB_SPIN_CAP (1u << 18)

__device__ __forceinline__ unsigned xb_ld(unsigned* p)              { return __hip_atomic_load(p, __ATOMIC_RELAXED, __HIP_MEMORY_SCOPE_AGENT); }
__device__ __forceinline__ unsigned xb_add(unsigned* p, unsigned v) { return __hip_atomic_fetch_add(p, v, __ATOMIC_RELAXED, __HIP_MEMORY_SCOPE_AGENT); }
__device__ __forceinline__ unsigned xb_xcc_id() { return (unsigned)__builtin_amdgcn_s_getreg((3 << 11) | 20) & 0xFu; }
#define XB_SPIN(cond, bar) do { unsigned _sp = 0; while (cond) { __builtin_amdgcn_s_sleep(1); \
    if ((++_sp & 255u) == 0u) { if (xb_ld(&(bar)[XB_TMO])) break; if (_sp > XB_SPIN_CAP) { atomicAdd(&(bar)[XB_TMO], 1u); break; } } } } while (0)

struct XcdBarrier {
    unsigned* bar; unsigned x;
    volatile LAS unsigned* st;
};

__device__ __forceinline__ XcdBarrier xcd_barrier_post(unsigned* bar, volatile LAS unsigned* st) {
    XcdBarrier b; b.bar = bar; b.x = xb_xcc_id(); b.st = st;
    if (threadIdx.x == 0) (void)xb_add(&bar[XB_XCNT(b.x)], 1u);
    return b;
}
__device__ __forceinline__ void xcd_barrier_complete(unsigned* bar, unsigned x, unsigned& nloc, unsigned& nx) {
    const unsigned G = gridDim.x * gridDim.y * gridDim.z;
    unsigned sum, cnt, mine, sp = 0u;
    for (;;) {
        sum = 0u; cnt = 0u; mine = 0u;
#pragma unroll
        for (unsigned j = 0; j < 16; ++j) { const unsigned c = xb_ld(&bar[XB_XCNT(j)]); sum += c; cnt += (c > 0u) ? 1u : 0u; mine = (j == x) ? c : mine; }
        if (sum == G) break;
        __builtin_amdgcn_s_sleep(1);
        if ((++sp & 255u) == 0u) { if (xb_ld(&bar[XB_TMO])) break; if (sp > XB_SPIN_CAP) { atomicAdd(&bar[XB_TMO], 1u); break; } }
    }
    nloc = mine > 0u ? mine : 1u; nx = cnt > 0u ? cnt : 1u;
}

__device__ __forceinline__ void xcd_barrier(const XcdBarrier& b) {
    asm volatile("s_waitcnt vmcnt(0)" ::: "memory");
    __syncthreads();
    if (threadIdx.x == 0) {
        unsigned* bar = b.bar;
        __builtin_amdgcn_s_waitcnt(0);
        unsigned nloc = b.st[0], nx = b.st[1];
        if (nloc == 0u) { xcd_barrier_complete(bar, b.x, nloc, nx); b.st[0] = nloc; b.st[1] = nx; }
        const unsigned old = xb_add(&bar[XB_XSUB(b.x)], 1u);
        const unsigned gen = old / nloc;
        if (old + 1u == (gen + 1u) * nloc) {
            __builtin_amdgcn_fence(__ATOMIC_RELEASE, "agent");
            asm volatile("s_waitcnt vmcnt(0)" ::: "memory");
            const unsigned og = xb_add(&bar[XB_TOP], 1u);
            const unsigned tg = og / nx;
            if (og + 1u == (tg + 1u) * nx) xb_add(&bar[XB_TOPGEN], 1u);
            else XB_SPIN(xb_ld(&bar[XB_TOPGEN]) == tg, bar);
            __builtin_amdgcn_fence(__ATOMIC_ACQUIRE, "agent");
            xb_add(&bar[XB_XGEN(b.x)], 1u);
            asm volatile("s_waitcnt vmcnt(0)" ::: "memory");
        } else {
            XB_SPIN(xb_ld(&bar[XB_XGEN(b.x)]) == gen, bar);
            __builtin_amdgcn_fence(__ATOMIC_ACQUIRE, "agent");
            asm volatile("s_waitcnt vmcnt(0)" ::: "memory");
        }
    }
    __syncthreads();
}


constexpr int LDS_BYTES = 152 * 1024;
constexpr int CW_BAR = 16384;
static_assert((CW_BAR + XCD_BAR_WORDS) * 4 <= (int)CTL_BYTES, "ctl");
#ifndef MK_MULTI
#define MK_MULTI 0
#endif
#define IN(p) (lo <= (p) && (p) < hi)
#define SEAM(p) do { if ((p) + 1 < hi) { XcdBarrier b_; b_.bar = (unsigned*)(load_args().ws + WS_CTL) + CW_BAR; b_.x = xb_xcc_id(); b_.st = (volatile LAS unsigned*)(C.lds + LDS_BYTES - 16); xcd_barrier(b_); } } while (0)
#define CAS __attribute__((address_space(4)))
__device__ __forceinline__ Args load_args() {
#if defined(__HIP_DEVICE_COMPILE__)
    const CAS Args* p = (const CAS Args*)__builtin_amdgcn_kernarg_segment_ptr(); asm volatile("" : "+s"(p));
    Args a; for (int i = 0; i < 22; ++i) a.in[i] = p->in[i]; a.out = p->out; a.ws = p->ws; a.lo = p->lo; a.hi = p->hi; return a;
#else
    return Args{};
#endif
}
__device__ __forceinline__ Ctx fresh(const Ctx& C) { Ctx R = C; int tz = threadIdx.x; asm volatile("" : "+v"(tz)); R.tid = tz; R.lane = tz & 63; return R; }
template <int L> __device__ __forceinline__ void layer_phases(const Args& args, const Ctx& C, int bar, int lo, int hi) {
    constexpr int pb = 16 * L;
    if (IN(pb + 1)) { phase_r1(load_args(), fresh(C), L); SEAM(pb + 1); }
    if (IN(pb + 2)) { phase_g1(load_args(), fresh(C), L); SEAM(pb + 2); }
    if constexpr ((L & 1) == 0) {
        if (IN(pb + 3)) { phase_s1(load_args(), fresh(C), L); SEAM(pb + 3); }
        if (IN(pb + 4)) { phase_s2(load_args(), fresh(C)); SEAM(pb + 4); }
        if (IN(pb + 5)) { phase_s3(load_args(), fresh(C), L); SEAM(pb + 5); }
    } else {
        if (IN(pb + 3)) { phase_conv(load_args(), fresh(C), L); SEAM(pb + 3); }
    }
    if (IN(pb + 6)) { phase_g2(load_args(), fresh(C), L); SEAM(pb + 6); }
    if (IN(pb + 7)) { phase_r2(load_args(), fresh(C), L); SEAM(pb + 7); }
    if (IN(pb + 8)) { phase_m1(load_args(), fresh(C), L); SEAM(pb + 8); }
    if (IN(pb + 9)) { phase_m2(load_args(), fresh(C), L); SEAM(pb + 9); }
}
__global__ void __launch_bounds__(NT, 2) fwd_kernel(Args args) {
    extern __shared__ __attribute__((aligned(16))) unsigned char lds_raw[];
    Ctx C; C.lds = (LAS unsigned char*)lds_raw; C.tid = threadIdx.x; C.lane = C.tid & 63; C.wave = __builtin_amdgcn_readfirstlane(C.tid >> 6); C.G = gridDim.x; C.bid = blockIdx.x; C.a = &args;
    const int lo = args.lo, hi = args.hi;
    volatile LAS unsigned* xbw = (volatile LAS unsigned*)(C.lds + LDS_BYTES - 16);
    if (C.tid < 4) xbw[C.tid] = 0u;
    __syncthreads();
    if (hi - lo > 1) (void)xcd_barrier_post((unsigned*)(args.ws + WS_CTL) + CW_BAR, xbw);
    const int bar = 0; (void)bar;
    if (IN(0)) { phase_mod(load_args(), fresh(C)); __syncthreads(); phase_cvt_mixer(load_args(), fresh(C)); SEAM(0); }
    layer_phases<0>(args, C, bar, lo, hi);
    layer_phases<1>(args, C, bar, lo, hi);
    layer_phases<2>(args, C, bar, lo, hi);
    layer_phases<3>(args, C, bar, lo, hi);
    if (IN(64)) phase_final(load_args(), fresh(C));
}
#undef IN
#undef SEAM

extern "C" void kernel_launch(void* const* d_in, const int* in_sizes, int n_in, void* d_out, int out_size, void* d_ws, size_t ws_size, hipStream_t stream) {
    static int grid = 0;
    if (grid == 0) {
        if (n_in != 22 || out_size != NL * D || ws_size < WS_END) { fprintf(stderr, "kernel_launch: unexpected shapes (n_in %d out %d ws %zu)\n", n_in, out_size, ws_size); grid = -1; return; }
        int dev = 0, cus = 0, per_cu = 0;
        if (hipGetDevice(&dev) != hipSuccess || hipDeviceGetAttribute(&cus, hipDeviceAttributeMultiprocessorCount, dev) != hipSuccess) { grid = -1; return; }
        if (hipFuncSetAttribute((const void*)fwd_kernel, hipFuncAttributeMaxDynamicSharedMemorySize, LDS_BYTES) != hipSuccess) { grid = -1; return; }
        if (hipOccupancyMaxActiveBlocksPerMultiprocessor(&per_cu, (const void*)fwd_kernel, NT, LDS_BYTES) != hipSuccess || per_cu < 1) { fprintf(stderr, "kernel_launch: occupancy query says %d\n", per_cu); }
        (void)hipGetLastError();
        grid = cus;
    }
    if (grid < 0) return;
    (void)hipMemsetAsync((char*)d_ws + WS_CTL, 0, CTL_BYTES, stream);
    Args a{};
    for (int i = 0; i < 22; ++i) a.in[i] = (const float*)d_in[i];
    a.out = (float*)d_out; a.ws = (unsigned char*)d_ws;
#if MK_MULTI
    int phases[64]; int np = 0;
    phases[np++] = 0;
    for (int l = 0; l < DEPTH; ++l) { const int pb = 16 * l; phases[np++] = pb + 1; phases[np++] = pb + 2; phases[np++] = pb + 3;
        if ((l & 1) == 0) { phases[np++] = pb + 4; phases[np++] = pb + 5; }
        phases[np++] = pb + 6; phases[np++] = pb + 7; phases[np++] = pb + 8; phases[np++] = pb + 9; }
    phases[np++] = 64;
    for (int i = 0; i < np; ++i) { a.lo = phases[i]; a.hi = phases[i] + 1; hipLaunchKernelGGL(fwd_kernel, dim3(grid), dim3(NT), LDS_BYTES, stream, a); }
#else
    a.lo = 0; a.hi = 65;
    hipLaunchKernelGGL(fwd_kernel, dim3(grid), dim3(NT), LDS_BYTES, stream, a);
#ifdef PROBE_PHASES
    { const int pp[] = {PROBE_PHASES};
      for (int rep = 0; rep < PROBE_REPS; ++rep) for (unsigned i = 0; i < sizeof(pp) / sizeof(pp[0]); ++i) { a.lo = pp[i]; a.hi = pp[i] + 1; hipLaunchKernelGGL(fwd_kernel, dim3(grid), dim3(NT), LDS_BYTES, stream, a); } }
#endif
#endif
}
```

```cpp
#include <hip/hip_runtime.h>
#include <cstdio>
#include <cstdint>

#define LAS __attribute__((address_space(3)))
typedef unsigned short bf16;
typedef float f32x4 __attribute__((ext_vector_type(4)));
typedef unsigned u32x4 __attribute__((ext_vector_type(4)));
typedef unsigned u32x2 __attribute__((ext_vector_type(2)));
typedef int i32x4r __attribute__((ext_vector_type(4)));

constexpr int D = 1024, BATCH = 2, SEQ = 16384, DEPTH = 4, CTXL = 256;
constexpr int NL = BATCH * SEQ, NCX = BATCH * CTXL, NR = NL + NCX;
constexpr int NH = 4, DQK = 128, DV = 256, NQ = 512, NV = 1024, PROJ = 3088, PW = 3072;
constexpr int NGRP = 4, EPG = 8, NE = 32, DE = 512;
constexpr int NBLK = 65;
constexpr int NUNIT = BATCH * NH * NBLK;
constexpr int CAP = NR;
constexpr int YROWS = 74752;
constexpr float EPS = 1e-6f;
constexpr float WSCALE = 32.0f;
constexpr float YSCALE = 4.0f;
constexpr int NT = 512, NW = 8;
constexpr int LDS_TAB_END = 152 * 1024 - 16;

constexpr size_t MiB = 1u << 20;
constexpr size_t WS_CTL = 0, CTL_BYTES = 1 * MiB;
constexpr size_t WS_MOD = 1 * MiB;
constexpr size_t WS_GATE = 2 * MiB;
constexpr size_t WS_TOKSLOT = 5 * MiB;
constexpr size_t WS_TOKW = 6 * MiB;
constexpr size_t WS_SLOTTOK = 7 * MiB;
constexpr size_t WS_DN = 12 * MiB;
constexpr size_t WS_NST = 13 * MiB;
constexpr size_t WS_BTOT = 14 * MiB;
constexpr size_t WS_RSC = 15 * MiB;
constexpr size_t WS_LAT = 16 * MiB;
constexpr size_t WS_HB = 146 * MiB;
constexpr size_t WS_PB = 211 * MiB;
constexpr size_t WS_HM = 406 * MiB;
constexpr size_t WS_DC = 471 * MiB;
constexpr size_t WS_CST = 601 * MiB;
constexpr size_t WS_VT = 666 * MiB;
constexpr size_t WS_WAIN = 731 * MiB;
constexpr size_t WS_WBIN = 743 * MiB;
constexpr size_t WS_WAOUT = 755 * MiB;
constexpr size_t WS_WBOUT = 759 * MiB;
constexpr size_t WS_WGU = 763 * MiB;
constexpr size_t WS_WDN = 827 * MiB;
constexpr size_t WS_H8 = 843 * MiB;
constexpr size_t WS_END = 880 * MiB;
constexpr int CW_WMAX = 256;
constexpr int CW_CNT = 1024, CNT_STRIDE = 64;

struct Args { const float* in[22]; float* out; unsigned char* ws; int lo, hi; };

typedef short bf16x8 __attribute__((ext_vector_type(8)));
typedef float f32x2 __attribute__((ext_vector_type(2)));
typedef __bf16 bf16x2_t __attribute__((ext_vector_type(2)));
__device__ __forceinline__ unsigned cvt2(float lo, float hi) { const f32x2 v = {lo, hi}; return __builtin_bit_cast(unsigned, __builtin_convertvector(v, bf16x2_t)); }
__device__ __forceinline__ float bf2f(bf16 v) { return __uint_as_float(((unsigned)v) << 16); }
__device__ __forceinline__ unsigned f2bf(float f) { unsigned u = __float_as_uint(f); return (u + 0x7fffu + ((u >> 16) & 1u)) >> 16; }
__device__ __forceinline__ unsigned pk2(float lo, float hi) { return f2bf(lo) | (f2bf(hi) << 16); }
template <int CTRL, int ROWMASK> __device__ __forceinline__ float dpp_mov(float x) { return __int_as_float(__builtin_amdgcn_update_dpp(0, __float_as_int(x), CTRL, ROWMASK, 0xf, false)); }
__device__ __forceinline__ float wave_sum(float v) {
    v += dpp_mov<0xB1, 0xf>(v); v += dpp_mov<0x4E, 0xf>(v); v += dpp_mov<0x141, 0xf>(v); v += dpp_mov<0x140, 0xf>(v);
    v += dpp_mov<0x142, 0xA>(v); v += dpp_mov<0x143, 0xC>(v);
    return __int_as_float(__builtin_amdgcn_readlane(__float_as_int(v), 63));
}
__device__ __forceinline__ float wave_max_nn(float v) {
    v = fmaxf(v, dpp_mov<0xB1, 0xf>(v)); v = fmaxf(v, dpp_mov<0x4E, 0xf>(v)); v = fmaxf(v, dpp_mov<0x141, 0xf>(v)); v = fmaxf(v, dpp_mov<0x140, 0xf>(v));
    v = fmaxf(v, dpp_mov<0x142, 0xA>(v)); v = fmaxf(v, dpp_mov<0x143, 0xC>(v));
    return __int_as_float(__builtin_amdgcn_readlane(__float_as_int(v), 63));
}
__device__ __forceinline__ unsigned pack_i8(f32x4 v) {
    const int a = (int)__builtin_rintf(fminf(fmaxf(v.x, -127.f), 127.f)), b = (int)__builtin_rintf(fminf(fmaxf(v.y, -127.f), 127.f)), c = (int)__builtin_rintf(fminf(fmaxf(v.z, -127.f), 127.f)), d = (int)__builtin_rintf(fminf(fmaxf(v.w, -127.f), 127.f));
    return (unsigned)(a & 255) | ((unsigned)(b & 255) << 8) | ((unsigned)(c & 255) << 16) | ((unsigned)d << 24);
}
__device__ __forceinline__ float sigmoidf_(float x) { return 1.f / (1.f + __expf(-x)); }
__device__ __forceinline__ float siluf_(float x) { return x / (1.f + __expf(-x)); }
__device__ __forceinline__ float logsigmoidf_(float x) { return fminf(x, 0.f) - log1pf(__expf(-fabsf(x))); }
__device__ __forceinline__ int blk_row0(int b, int blk) { return blk == 0 ? NL + b * CTXL : b * SEQ + (blk - 1) * 256; }
__device__ __forceinline__ int mod_vec_of_row(int row) { return row < NL ? row / SEQ : 2; }

struct Ctx {
    LAS unsigned char* lds; int tid, lane, wave, G, bid;
    const Args* a;
};

__device__ __forceinline__ int expert_block_prefix(const unsigned* cnt, int lane, int& nb) {
    nb = lane < NE ? ((int)cnt[lane * CNT_STRIDE] + 255) / 256 : 0; int v = nb;
#pragma unroll
    for (int o = 1; o < 64; o <<= 1) { const int t = __shfl_up(v, o); v += (lane >= o) ? t : 0; }
    return v - nb;
}
__device__ __forceinline__ void slot_bases(const Args& A, int l, LAS int* sb, int tid) {
    if (tid < 64) { int nb; const int ex = expert_block_prefix((const unsigned*)(A.ws + WS_CTL) + CW_CNT + l * 32 * CNT_STRIDE, tid, nb); if (tid <= NE) sb[tid] = ex * 256; }
    __syncthreads();
}

__device__ __forceinline__ void phase_mod(const Args& A, const Ctx& C) {
    LAS float* sc = (LAS float*)C.lds;
    LAS float* red = sc + 3072;
    const float* c = A.in[1]; const float* cc = A.in[3];
    for (int i = C.tid; i < 3072; i += NT) { const float v = i < 2048 ? c[i] : cc[i - 2048]; sc[i] = siluf_(v); }
    __syncthreads();
    float* MOD = (float*)(A.ws + WS_MOD);
    for (int u = C.bid; u < DEPTH * 96; u += C.G) {
        const int l = u / 96, cg = u % 96, col = cg * 64 + C.lane;
        const float* w = A.in[4] + (size_t)l * D * 6 * D + col;
        float a0 = 0.f, a1 = 0.f, a2 = 0.f;
#pragma unroll 32
        for (int k = C.wave * 128; k < C.wave * 128 + 128; ++k) { const float wv = w[(size_t)k * 6 * D]; a0 += sc[k] * wv; a1 += sc[1024 + k] * wv; a2 += sc[2048 + k] * wv; }
        red[(C.wave * 3 + 0) * 64 + C.lane] = a0; red[(C.wave * 3 + 1) * 64 + C.lane] = a1; red[(C.wave * 3 + 2) * 64 + C.lane] = a2;
        __syncthreads();
        if (C.tid < 192) { const int v = C.tid / 64, ln = C.tid % 64; float s = 0.f;
            for (int w8 = 0; w8 < 8; ++w8) s += red[(w8 * 3 + v) * 64 + ln];
            MOD[(size_t)(l * 3 + v) * 6 * D + cg * 64 + ln] = s + A.in[5][(size_t)l * 6 * D + cg * 64 + ln]; }
        __syncthreads();
    }
}

__device__ __forceinline__ void load_row_f32(const float* p, int lane, f32x4 (&v)[4]) {
#pragma unroll
    for (int j = 0; j < 4; ++j) v[j] = *(const f32x4*)(p + 4 * lane + 256 * j);
}
__device__ __forceinline__ void load_row_bf16(const bf16* p, int lane, f32x4 (&v)[4]) {
#pragma unroll
    for (int j = 0; j < 4; ++j) { const u32x2 w = *(const u32x2*)(p + 4 * lane + 256 * j);
        v[j] = (f32x4){__uint_as_float(w.x << 16), __uint_as_float(w.x & 0xffff0000u), __uint_as_float(w.y << 16), __uint_as_float(w.y & 0xffff0000u)}; }
}
__device__ __forceinline__ void store_row_bf16(bf16* p, int lane, const f32x4 (&v)[4]) {
#pragma unroll
    for (int j = 0; j < 4; ++j) { u32x2 w; w.x = pk2(v[j].x, v[j].y); w.y = pk2(v[j].z, v[j].w); *(u32x2*)(p + 4 * lane + 256 * j) = w; }
}
constexpr int CVT_IG = (D / 64) * (DE / 32), CVT_ID = (DE / 64) * (D / 32), CVT_PER = 2 * CVT_IG + CVT_ID, CVT_ITEMS = NE * CVT_PER;
constexpr int CVT_Q = 24;
__device__ __forceinline__ void cvt_moe_items(const Args& A, const Ctx& C, int l, int it0, int end, int stride);
__device__ __forceinline__ void cvt_win_i8(const Args& A, const Ctx& C);
__device__ __forceinline__ int cvt_t2(int l, int G);
struct RowVec { f32x4 a[4], s[4], g[4]; };
__device__ __forceinline__ void load_rowvec(RowVec& R, const float* ng, const float* sh, const float* sc, const float* gt, int lane) {
    f32x4 n[4], c[4]; load_row_f32(ng, lane, n); load_row_f32(sc, lane, c); load_row_f32(sh, lane, R.s); if (gt) load_row_f32(gt, lane, R.g);
#pragma unroll
    for (int q = 0; q < 4; ++q) R.a[q] = n[q] * (1.f + c[q]);
}
__device__ __forceinline__ void load_row_bf16raw(const bf16* p, int lane, u32x2 (&v)[4]) {
#pragma unroll
    for (int j = 0; j < 4; ++j) v[j] = *(const u32x2*)(p + 4 * lane + 256 * j);
}
__device__ __forceinline__ void store_row_fp8(unsigned char* p, int lane, const f32x4 (&v)[4]) {
#pragma unroll
    for (int j = 0; j < 4; ++j) { int w = 0; w = __builtin_amdgcn_cvt_pk_fp8_f32(v[j].x, v[j].y, w, false); w = __builtin_amdgcn_cvt_pk_fp8_f32(v[j].z, v[j].w, w, true); *(unsigned*)(p + 4 * lane + 256 * j) = (unsigned)w; }
}
__device__ __forceinline__ void load_row_fp8raw(const unsigned char* p, int lane, unsigned (&v)[4]) {
#pragma unroll
    for (int j = 0; j < 4; ++j) v[j] = *(const unsigned*)(p + 4 * lane + 256 * j);
}
__device__ __forceinline__ f32x4 fp8x4(unsigned w) { const f32x2 lo = __builtin_amdgcn_cvt_pk_f32_fp8((int)w, false), hi = __builtin_amdgcn_cvt_pk_f32_fp8((int)w, true); return (f32x4){lo.x, lo.y, hi.x, hi.y}; }
__device__ __forceinline__ f32x4 bf4(u32x2 w) { return (f32x4){__uint_as_float(w.x << 16), __uint_as_float(w.x & 0xffff0000u), __uint_as_float(w.y << 16), __uint_as_float(w.y & 0xffff0000u)}; }
__device__ __forceinline__ float row_rstd(const f32x4 (&v)[4]) {
    float s = 0.f;
#pragma unroll
    for (int j = 0; j < 4; ++j) s += (v[j].x * v[j].x + v[j].y * v[j].y) + (v[j].z * v[j].z + v[j].w * v[j].w);
    return 1.0f / sqrtf(wave_sum(s) * (1.f / D) + EPS);
}

__device__ __forceinline__ void phase_r1(const Args& A, const Ctx& C, int l) {
    LAS int* sb = (LAS int*)C.lds;
    constexpr int GWP = 2064;
    LAS unsigned char* GW = C.lds + 256;
    LAS unsigned char* HS = C.lds + 256 + 16 * GWP + C.wave * 2 * GWP;
    const bool mls = (l & 1) == 0; const int j = l >> 1;
    if (l == 0) { cvt_win_i8(A, C); __syncthreads(); }
    if (l > 0) slot_bases(A, l - 1, sb, C.tid);
    if (mls) { const float* w = A.in[8] + (size_t)j * D * PROJ + PW;
        f32x4 t[2][4];
#pragma unroll
        for (int jj = 0; jj < 2; ++jj)
#pragma unroll
            for (int q = 0; q < 4; ++q) t[jj][q] = *(const f32x4*)(w + (size_t)(C.tid + NT * jj) * PROJ + 4 * q);
#pragma unroll
        for (int jj = 0; jj < 2; ++jj)
#pragma unroll
            for (int q = 0; q < 4; ++q) { const int k = C.tid + NT * jj;
#pragma unroll
                for (int c = 0; c < 4; ++c) *(LAS unsigned short*)(GW + (4 * q + c) * GWP + k * 2) = (unsigned short)f2bf(t[jj][q][c]); }
        __syncthreads(); }
    const int nrows = (l <= 2) ? NR : NL;
    bf16* LAT = (bf16*)(A.ws + WS_LAT); unsigned char* HI8 = A.ws + WS_H8; float* RSC = (float*)(A.ws + WS_RSC); float* GATE = (float*)(A.ws + WS_GATE);
    const float* MOD = (const float*)(A.ws + WS_MOD); const unsigned char* Y8 = A.ws + WS_PB;
    const int* TS = (const int*)(A.ws + WS_TOKSLOT); const float* TW = (const float*)(A.ws + WS_TOKW);
    const int rpw = (((nrows + C.G - 1) / C.G) + 1) & ~1; const int wrow0 = C.bid * rpw; const int wend = min(wrow0 + rpw, nrows);
    for (int sa = wrow0; sa < wend;) {
        const int mvi = mod_vec_of_row(sa); const int bnd = mvi == 0 ? SEQ : (mvi == 1 ? NL : NR); const int sbnd = min(wend, bnd);
        RowVec RV; { const float* mv = MOD + (size_t)(l * 3 + mvi) * 6 * D;
            load_rowvec(RV, A.in[6] + (size_t)(l * 2 + 0) * D, mv + 0 * D, mv + 1 * D, l > 0 ? MOD + (size_t)((l - 1) * 3 + mvi) * 6 * D + 5 * D : nullptr, C.lane); }
        const int rlast = sbnd - 2; const int rfirst = sa + 2 * C.wave;
        i32x4r ts1 = (i32x4r){0, 0, 0, 0}, ts2 = ts1; f32x4 tw1 = (f32x4){0.f, 0.f, 0.f, 0.f}, tw2 = tw1;
        u32x2 nla[4], nlb[4]; unsigned nya0[4], nya1[4], nyb0[4], nyb1[4]; f32x4 nxa[4], nxb[4];
#define R1_FETCH(r_, ts_) do { const int fa_ = (r_), fb_ = fa_ + 1; \
            if (l == 0) { load_row_f32(fa_ < NL ? A.in[0] + (size_t)fa_ * D : A.in[2] + (size_t)(fa_ - NL) * D, C.lane, nxa); load_row_f32(fb_ < NL ? A.in[0] + (size_t)fb_ * D : A.in[2] + (size_t)(fb_ - NL) * D, C.lane, nxb); } \
            else { load_row_bf16raw(LAT + (size_t)fa_ * D, C.lane, nla); load_row_bf16raw(LAT + (size_t)fb_ * D, C.lane, nlb); \
                load_row_fp8raw(Y8 + (size_t)(sb[(ts_).x >> 20] + ((ts_).x & 0xfffff)) * D, C.lane, nya0); load_row_fp8raw(Y8 + (size_t)(sb[(ts_).y >> 20] + ((ts_).y & 0xfffff)) * D, C.lane, nya1); \
                load_row_fp8raw(Y8 + (size_t)(sb[(ts_).z >> 20] + ((ts_).z & 0xfffff)) * D, C.lane, nyb0); load_row_fp8raw(Y8 + (size_t)(sb[(ts_).w >> 20] + ((ts_).w & 0xfffff)) * D, C.lane, nyb1); } } while (0)
        if (l > 0) { const int r0 = min(rfirst, rlast), r1 = min(rfirst + 2 * NW, rlast);
            ts1 = *(const i32x4r*)(TS + r0 * 2); tw1 = *(const f32x4*)(TW + r0 * 2); ts2 = *(const i32x4r*)(TS + r1 * 2); tw2 = *(const f32x4*)(TW + r1 * 2); }
        R1_FETCH(min(rfirst, rlast), ts1);
        for (int ra = rfirst; ra < sbnd; ra += 2 * NW) {
            const bool hasb = true; const int rb = ra + 1;
            f32x4 va[4], vb[4];
            if (l == 0) {
#pragma unroll
                for (int q = 0; q < 4; ++q) { va[q] = nxa[q]; vb[q] = nxb[q]; }
                R1_FETCH(min(ra + 2 * NW, rlast), ts1);
            } else {
                u32x2 la[4], lb[4]; unsigned ya0[4], ya1[4], yb0[4], yb1[4];
#pragma unroll
                for (int q = 0; q < 4; ++q) { la[q] = nla[q]; lb[q] = nlb[q]; ya0[q] = nya0[q]; ya1[q] = nya1[q]; yb0[q] = nyb0[q]; yb1[q] = nyb1[q]; }
                const f32x4 twc = tw1;
                ts1 = ts2; tw1 = tw2;
                { const int r2 = min(ra + 4 * NW, rlast); ts2 = *(const i32x4r*)(TS + r2 * 2); tw2 = *(const f32x4*)(TW + r2 * 2); }
                R1_FETCH(min(ra + 2 * NW, rlast), ts1);
                const float wa0 = twc.x * (1.0f / YSCALE), wa1 = twc.y * (1.0f / YSCALE), wb0 = twc.z * (1.0f / YSCALE), wb1 = twc.w * (1.0f / YSCALE);
#pragma unroll
                for (int q = 0; q < 4; ++q) { va[q] = bf4(la[q]) + RV.g[q] * (fp8x4(ya0[q]) * wa0 + fp8x4(ya1[q]) * wa1); vb[q] = bf4(lb[q]) + RV.g[q] * (fp8x4(yb0[q]) * wb0 + fp8x4(yb1[q]) * wb1); }
            }
            store_row_bf16(LAT + (size_t)ra * D, C.lane, va); if (hasb) store_row_bf16(LAT + (size_t)rb * D, C.lane, vb);
            const float rra = row_rstd(va), rrb = row_rstd(vb);
            f32x4 ha[4], hb[4];
#pragma unroll
            for (int q = 0; q < 4; ++q) { ha[q] = (va[q] * rra) * RV.a[q] + RV.s[q]; hb[q] = (vb[q] * rrb) * RV.a[q] + RV.s[q]; }
            { float ma = 0.f, mb = 0.f;
#pragma unroll
              for (int q = 0; q < 4; ++q) { ma = fmaxf(ma, fmaxf(fmaxf(fabsf(ha[q].x), fabsf(ha[q].y)), fmaxf(fabsf(ha[q].z), fabsf(ha[q].w)))); mb = fmaxf(mb, fmaxf(fmaxf(fabsf(hb[q].x), fabsf(hb[q].y)), fmaxf(fabsf(hb[q].z), fabsf(hb[q].w)))); }
              ma = fmaxf(wave_max_nn(ma), 1.0e-20f); mb = fmaxf(wave_max_nn(mb), 1.0e-20f);
              const float ia = 127.0f / ma, ib = 127.0f / mb;
#pragma unroll
              for (int q = 0; q < 4; ++q) { *(unsigned*)(HI8 + (size_t)ra * D + 4 * C.lane + 256 * q) = pack_i8(ha[q] * ia); *(unsigned*)(HI8 + (size_t)rb * D + 4 * C.lane + 256 * q) = pack_i8(hb[q] * ib); }
              if (C.lane == 0) { RSC[ra] = ma * (1.0f / 127.0f); RSC[rb] = mb * (1.0f / 127.0f); } }
            if (mls) {
#pragma unroll
                for (int q = 0; q < 4; ++q) { *(LAS u32x2*)(HS + (4 * C.lane + 256 * q) * 2) = (u32x2){cvt2(ha[q].x, ha[q].y), cvt2(ha[q].z, ha[q].w)}; *(LAS u32x2*)(HS + GWP + (4 * C.lane + 256 * q) * 2) = (u32x2){cvt2(hb[q].x, hb[q].y), cvt2(hb[q].z, hb[q].w)}; }
                asm volatile("s_waitcnt lgkmcnt(0)" ::: "memory");
                f32x4 gacc = (f32x4){0.f, 0.f, 0.f, 0.f};
                { const int gi = C.lane & 15, kg = C.lane >> 4; LAS const unsigned char* ap = HS + (gi & 1) * GWP + kg * 16; LAS const unsigned char* bp = GW + gi * GWP + kg * 16;
#pragma unroll 8
                  for (int s2 = 0; s2 < 32; ++s2) { bf16x8 av = *(const LAS bf16x8*)(ap + s2 * 64); const bf16x8 bv = *(const LAS bf16x8*)(bp + s2 * 64);
                      if (gi >= 2) av = (bf16x8){0, 0, 0, 0, 0, 0, 0, 0};
                      gacc = __builtin_amdgcn_mfma_f32_16x16x32_bf16(av, bv, gacc, 0, 0, 0); } }
                float ga = gacc[0], gb = gacc[1];
                if (C.lane < 16) {
                    const float bgt = A.in[9][j * 16 + C.lane]; const int gtype = C.lane >> 2;
                    ga += bgt; gb += bgt;
                    GATE[(size_t)ra * 16 + C.lane] = (gtype & 1) ? logsigmoidf_(ga) : 15.0f * tanhf(ga * (1.0f / 15.0f));
                    if (hasb) GATE[(size_t)rb * 16 + C.lane] = (gtype & 1) ? logsigmoidf_(gb) : 15.0f * tanhf(gb * (1.0f / 15.0f)); }
            }
        }
#undef R1_FETCH
        sa = sbnd;
    }
}

__device__ __forceinline__ void phase_r2(const Args& A, const Ctx& C, int l) {
    constexpr int WP = 2064;
    LAS unsigned char* RWB = C.lds;
    LAS float* WL = (LAS float*)(C.lds + 48 * WP);
    LAS unsigned* hist = (LAS unsigned*)(WL + 8 * 16 * 48);
    LAS unsigned* gbase = hist + 32;
    constexpr int RCAP = 144;
    LAS int* rec = (LAS int*)(gbase + 32);
    static_assert(48 * WP + 8 * 16 * 48 * 4 + 256 + RCAP * 16 <= LDS_TAB_END, "R2 LDS map");
    cvt_moe_items(A, C, l, cvt_t2(l, C.G) + C.bid * NW + C.wave, CVT_ITEMS, C.G * NW);
    __syncthreads();
    { const float* wg = A.in[15] + (size_t)l * D * NGRP; const float* wr = A.in[17] + (size_t)l * D * NE;
      { const int kp = C.tid; const f32x4 x0 = *(const f32x4*)(wg + (size_t)(2 * kp) * 4), x1 = *(const f32x4*)(wg + (size_t)(2 * kp + 1) * 4);
        *(LAS unsigned*)(RWB + 0 * WP + kp * 4) = cvt2(x0.x, x1.x); *(LAS unsigned*)(RWB + 1 * WP + kp * 4) = cvt2(x0.y, x1.y);
        *(LAS unsigned*)(RWB + 2 * WP + kp * 4) = cvt2(x0.z, x1.z); *(LAS unsigned*)(RWB + 3 * WP + kp * 4) = cvt2(x0.w, x1.w); }
      f32x4 t0[8], t1[8];
#pragma unroll
      for (int jj = 0; jj < 8; ++jj) { const int it = C.tid + NT * jj, kp = it >> 3, cg = it & 7; t0[jj] = *(const f32x4*)(wr + (size_t)(2 * kp) * NE + 4 * cg); t1[jj] = *(const f32x4*)(wr + (size_t)(2 * kp + 1) * NE + 4 * cg); }
#pragma unroll
      for (int jj = 0; jj < 8; ++jj) { const int it = C.tid + NT * jj, kp = it >> 3, c0 = 4 + 4 * (it & 7);
          *(LAS unsigned*)(RWB + (c0 + 0) * WP + kp * 4) = cvt2(t0[jj].x, t1[jj].x); *(LAS unsigned*)(RWB + (c0 + 1) * WP + kp * 4) = cvt2(t0[jj].y, t1[jj].y);
          *(LAS unsigned*)(RWB + (c0 + 2) * WP + kp * 4) = cvt2(t0[jj].z, t1[jj].z); *(LAS unsigned*)(RWB + (c0 + 3) * WP + kp * 4) = cvt2(t0[jj].w, t1[jj].w); }
      for (int i = C.tid; i < 12 * 512; i += NT) *(LAS unsigned*)(RWB + (36 + i / 512) * WP + (i % 512) * 4) = 0u; }
    const int nrows = (l <= 1) ? NR : NL;
    bf16* LAT = (bf16*)(A.ws + WS_LAT); bf16* H = (bf16*)(A.ws + WS_HB); unsigned char* H8 = A.ws + WS_H8;
    const float* MOD = (const float*)(A.ws + WS_MOD);
    unsigned* cnt = (unsigned*)(A.ws + WS_CTL) + CW_CNT + l * 32 * CNT_STRIDE;
    int* TS = (int*)(A.ws + WS_TOKSLOT); float* TW = (float*)(A.ws + WS_TOKW); int* ST = (int*)(A.ws + WS_SLOTTOK);
    const int rpw = (((nrows + C.G - 1) / C.G) + 1) & ~1; const int wrow0 = C.bid * rpw; const int wend0 = min(wrow0 + rpw, nrows);
    const float* bg = A.in[16] + l * NGRP; const float* br = A.in[18] + l * NE;
    for (int cb = wrow0; cb < wend0; cb += RCAP) {
        const int wend = min(cb + RCAP, wend0);
        if (C.tid < 32) hist[C.tid] = 0u;
        for (int sa = cb; sa < wend;) {
            const int mvi = mod_vec_of_row(sa); const int bnd = mvi == 0 ? SEQ : (mvi == 1 ? NL : NR); const int sbnd = min(wend, bnd);
            RowVec RV; { const float* mv = MOD + (size_t)(l * 3 + mvi) * 6 * D; load_rowvec(RV, A.in[6] + (size_t)(l * 2 + 1) * D, mv + 3 * D, mv + 4 * D, mv + 2 * D, C.lane); }
            const int rlast = sbnd - 2;
            u32x2 la[4], lb[4];
            { const int r0 = min(sa + 2 * C.wave, rlast); load_row_bf16raw(LAT + (size_t)r0 * D, C.lane, la); load_row_bf16raw(LAT + (size_t)(r0 + 1) * D, C.lane, lb); }
            for (int ra = sa + 2 * C.wave; ra < sbnd; ra += 2 * NW) {
                const int rb = ra + 1;
                u32x2 lan[4], lbn[4];
                { const int r1 = min(ra + 2 * NW, rlast); load_row_bf16raw(LAT + (size_t)r1 * D, C.lane, lan); load_row_bf16raw(LAT + (size_t)(r1 + 1) * D, C.lane, lbn); }
                f32x4 va[4], vb[4];
#pragma unroll
                for (int q = 0; q < 4; ++q) { va[q] = bf4(la[q]); vb[q] = bf4(lb[q]); }
                const float rra = row_rstd(va), rrb = row_rstd(vb);
                f32x4 ha[4], hb[4];
#pragma unroll
                for (int q = 0; q < 4; ++q) { ha[q] = (va[q] * rra) * RV.a[q] + RV.s[q]; hb[q] = (vb[q] * rrb) * RV.a[q] + RV.s[q]; }
                store_row_bf16(H + (size_t)ra * D, C.lane, ha); store_row_bf16(H + (size_t)rb * D, C.lane, hb);
                store_row_fp8(H8 + (size_t)ra * D, C.lane, ha); store_row_fp8(H8 + (size_t)rb * D, C.lane, hb);
#pragma unroll
                for (int q = 0; q < 4; ++q) { la[q] = lan[q]; lb[q] = lbn[q]; }
            }
            sa = sbnd;
        }
        __syncthreads();
        const int fr = C.lane & 15, fq = C.lane >> 4;
        for (int t = C.wave; t * 16 < wend - cb; t += NW) {
            const int trow = min(cb + 16 * t + fr, wend - 1);
            const bf16* hp = H + (size_t)trow * D + 8 * fq;
            f32x4 acc[3];
#pragma unroll
            for (int ct = 0; ct < 3; ++ct) acc[ct] = (f32x4){0.f, 0.f, 0.f, 0.f};
#pragma unroll 1
            for (int kb = 0; kb < 4; ++kb) {
                bf16x8 av[8];
#pragma unroll
                for (int k8 = 0; k8 < 8; ++k8) av[k8] = *(const bf16x8*)(hp + 32 * (8 * kb + k8));
#pragma unroll
                for (int k8 = 0; k8 < 8; ++k8)
#pragma unroll
                    for (int ct = 0; ct < 3; ++ct) { const bf16x8 bv = *(const LAS bf16x8*)(RWB + (ct * 16 + fr) * WP + (32 * (8 * kb + k8) + 8 * fq) * 2);
                        acc[ct] = __builtin_amdgcn_mfma_f32_16x16x32_bf16(av[k8], bv, acc[ct], 0, 0, 0); }
            }
            LAS float* wl = WL + C.wave * 16 * 48;
#pragma unroll
            for (int ct = 0; ct < 3; ++ct)
#pragma unroll
                for (int jq = 0; jq < 4; ++jq) wl[(4 * fq + jq) * 48 + ct * 16 + fr] = acc[ct][jq];
            asm volatile("s_waitcnt lgkmcnt(0)" ::: "memory");
            const int row = cb + 16 * t + C.lane;
            if (C.lane < 16 && row < wend) {
                LAS const float* wm = wl + C.lane * 48;
                float lg[36];
#pragma unroll
                for (int c = 0; c < 36; ++c) lg[c] = wm[c];
                float gl[4]; int grp = 0; float gm = -3.0e38f;
#pragma unroll
                for (int c = 0; c < 4; ++c) { gl[c] = lg[c] + bg[c]; if (gl[c] > gm) { gm = gl[c]; grp = c; } }
                float gs = 0.f;
#pragma unroll
                for (int c = 0; c < 4; ++c) gs += __expf(gl[c] - gm);
                const float pgrp = 1.0f / gs;
                float rl[8];
#pragma unroll
                for (int i = 0; i < 8; ++i) { float tt = 0.f;
#pragma unroll
                    for (int g = 0; g < 4; ++g) tt = (g == grp) ? lg[4 + g * 8 + i] : tt;
                    rl[i] = tt + br[grp * 8 + i]; }
                int i0 = 0; float m0 = rl[0];
#pragma unroll
                for (int i = 1; i < 8; ++i) if (rl[i] > m0) { m0 = rl[i]; i0 = i; }
                int i1 = -1; float m1 = -3.0e38f;
#pragma unroll
                for (int i = 0; i < 8; ++i) if (i != i0 && rl[i] > m1) { m1 = rl[i]; i1 = i; }
                const float p0 = 1.0f, p1 = __expf(m1 - m0);
                const float w0 = pgrp * p0 / (p0 + p1), w1 = pgrp * p1 / (p0 + p1);
                const int e0 = grp * 8 + i0, e1 = grp * 8 + i1;
                const unsigned q0 = __hip_atomic_fetch_add(hist + e0, 1u, __ATOMIC_RELAXED, __HIP_MEMORY_SCOPE_WORKGROUP), q1 = __hip_atomic_fetch_add(hist + e1, 1u, __ATOMIC_RELAXED, __HIP_MEMORY_SCOPE_WORKGROUP);
                const int li = row - cb;
                rec[li * 4 + 0] = e0 | (e1 << 8); rec[li * 4 + 1] = (int)q0; rec[li * 4 + 2] = (int)q1;
                TW[row * 2 + 0] = w0; TW[row * 2 + 1] = w1;
            }
        }
        __syncthreads();
        if (C.tid < 32) gbase[C.tid] = hist[C.tid] ? atomicAdd(cnt + C.tid * CNT_STRIDE, hist[C.tid]) : 0u;
        __syncthreads();
        for (int i = C.tid; i < wend - cb; i += NT) { const int row = cb + i; const int ee = rec[i * 4], e0 = ee & 255, e1 = ee >> 8;
            const unsigned q0 = gbase[e0] + (unsigned)rec[i * 4 + 1], q1 = gbase[e1] + (unsigned)rec[i * 4 + 2];
            ST[(size_t)e0 * CAP + q0] = row; ST[(size_t)e1 * CAP + q1] = row;
            TS[row * 2 + 0] = (e0 << 20) | (int)q0; TS[row * 2 + 1] = (e1 << 20) | (int)q1; }
        __syncthreads();
    }
}

__device__ __forceinline__ void phase_final(const Args& A, const Ctx& C) {
    LAS int* sb = (LAS int*)C.lds;
    slot_bases(A, 3, sb, C.tid);
    const bf16* LAT = (const bf16*)(A.ws + WS_LAT); const unsigned char* Y8 = A.ws + WS_PB;
    const int* TS = (const int*)(A.ws + WS_TOKSLOT); const float* TW = (const float*)(A.ws + WS_TOKW);
    const float* MOD = (const float*)(A.ws + WS_MOD);
    f32x4 fg[4]; load_row_f32(A.in[7], C.lane, fg);
    const int rpw = (((NL + C.G - 1) / C.G) + 1) & ~1; const int wrow0 = C.bid * rpw; const int wend = min(wrow0 + rpw, NL);
    for (int sa = wrow0; sa < wend;) {
        const int mvi = mod_vec_of_row(sa); const int sbnd = min(wend, mvi == 0 ? SEQ : NL);
        f32x4 g2[4]; load_row_f32(MOD + (size_t)(3 * 3 + mvi) * 6 * D + 5 * D, C.lane, g2);
        const int rlast = sbnd - 2; const int rfirst = sa + 2 * C.wave;
        i32x4r ts1, ts2; f32x4 tw1, tw2;
        u32x2 nla[4], nlb[4]; unsigned nya0[4], nya1[4], nyb0[4], nyb1[4];
#define FIN_FETCH(r_, ts_) do { const int fa_ = (r_); \
            load_row_bf16raw(LAT + (size_t)fa_ * D, C.lane, nla); load_row_bf16raw(LAT + (size_t)(fa_ + 1) * D, C.lane, nlb); \
            load_row_fp8raw(Y8 + (size_t)(sb[(ts_).x >> 20] + ((ts_).x & 0xfffff)) * D, C.lane, nya0); load_row_fp8raw(Y8 + (size_t)(sb[(ts_).y >> 20] + ((ts_).y & 0xfffff)) * D, C.lane, nya1); \
            load_row_fp8raw(Y8 + (size_t)(sb[(ts_).z >> 20] + ((ts_).z & 0xfffff)) * D, C.lane, nyb0); load_row_fp8raw(Y8 + (size_t)(sb[(ts_).w >> 20] + ((ts_).w & 0xfffff)) * D, C.lane, nyb1); } while (0)
        { const int r0 = min(rfirst, rlast), r1 = min(rfirst + 2 * NW, rlast);
          ts1 = *(const i32x4r*)(TS + r0 * 2); tw1 = *(const f32x4*)(TW + r0 * 2); ts2 = *(const i32x4r*)(TS + r1 * 2); tw2 = *(const f32x4*)(TW + r1 * 2); }
        FIN_FETCH(min(rfirst, rlast), ts1);
        for (int ra = rfirst; ra < sbnd; ra += 2 * NW) {
            const int rb = ra + 1;
            u32x2 la[4], lb[4]; unsigned ya0[4], ya1[4], yb0[4], yb1[4];
#pragma unroll
            for (int q = 0; q < 4; ++q) { la[q] = nla[q]; lb[q] = nlb[q]; ya0[q] = nya0[q]; ya1[q] = nya1[q]; yb0[q] = nyb0[q]; yb1[q] = nyb1[q]; }
            const f32x4 twc = tw1;
            ts1 = ts2; tw1 = tw2;
            { const int r2 = min(ra + 4 * NW, rlast); ts2 = *(const i32x4r*)(TS + r2 * 2); tw2 = *(const f32x4*)(TW + r2 * 2); }
            FIN_FETCH(min(ra + 2 * NW, rlast), ts1);
            const float wa0 = twc.x * (1.0f / YSCALE), wa1 = twc.y * (1.0f / YSCALE), wb0 = twc.z * (1.0f / YSCALE), wb1 = twc.w * (1.0f / YSCALE);
            f32x4 va[4], vb[4];
#pragma unroll
            for (int q = 0; q < 4; ++q) { va[q] = bf4(la[q]) + g2[q] * (fp8x4(ya0[q]) * wa0 + fp8x4(ya1[q]) * wa1); vb[q] = bf4(lb[q]) + g2[q] * (fp8x4(yb0[q]) * wb0 + fp8x4(yb1[q]) * wb1); }
            const float rra = row_rstd(va), rrb = row_rstd(vb);
#pragma unroll
            for (int q = 0; q < 4; ++q) { *(f32x4*)(A.out + (size_t)ra * D + 4 * C.lane + 256 * q) = (va[q] * rra) * fg[q]; *(f32x4*)(A.out + (size_t)rb * D + 4 * C.lane + 256 * q) = (vb[q] * rrb) * fg[q]; }
        }
#undef FIN_FETCH
        sa = sbnd;
    }
}

__device__ __forceinline__ void phase_conv(const Args& A, const Ctx& C, int l) {
    const int j = l >> 1; const int nrows = (l <= 1) ? NR : NL;
    const bf16* P = (const bf16*)(A.ws + WS_PB); unsigned char* HM = A.ws + WS_HM; float* RSC = (float*)(A.ws + WS_RSC);
    const float* cw = A.in[13] + (size_t)j * 3 * D;
    f32x4 w0[4], w1[4], w2[4];
    load_row_f32(cw, C.lane, w0); load_row_f32(cw + D, C.lane, w1); load_row_f32(cw + 2 * D, C.lane, w2);
    const int rpw = (((nrows + C.G - 1) / C.G) + 1) & ~1; const int wrow0 = C.bid * rpw; const int wend = min(wrow0 + rpw, nrows);
    for (int ra = wrow0 + 2 * C.wave; ra < wend; ra += 2 * NW) {
        const int rb = ra + 1;
        const int ta = ra < NL ? (ra & 63) : ((ra - NL) & 255), tb1 = rb < NL ? (rb & 63) : ((rb - NL) & 255), tlast = ra < NL ? 63 : 255;
        const bool hasl = ta != 0, hasr = tb1 != tlast;
        const bf16* pa = P + (size_t)ra * PW;
        u32x2 bga[4], bgb[4], zm[4], z0[4], z1[4], z2[4];
        load_row_bf16raw(pa, C.lane, bga); load_row_bf16raw(pa + PW, C.lane, bgb);
        load_row_bf16raw(pa + D, C.lane, z0); load_row_bf16raw(pa + PW + D, C.lane, z1);
        load_row_bf16raw(hasl ? pa - PW + D : pa + D, C.lane, zm); load_row_bf16raw(hasr ? pa + 2 * PW + D : pa + D, C.lane, z2);
        const float fl = hasl ? 1.f : 0.f, fr = hasr ? 1.f : 0.f;
        f32x4 oa[4], ob[4];
#pragma unroll
        for (int q = 0; q < 4; ++q) { const f32x4 a0 = bf4(z0[q]), a1 = bf4(z1[q]);
            oa[q] = bf4(bga[q]) * (w0[q] * (bf4(zm[q]) * fl) + w1[q] * a0 + w2[q] * a1);
            ob[q] = bf4(bgb[q]) * (w0[q] * a0 + w1[q] * a1 + w2[q] * (bf4(z2[q]) * fr)); }
        float ma = 0.f, mb = 0.f;
#pragma unroll
        for (int q = 0; q < 4; ++q) { ma = fmaxf(ma, fmaxf(fmaxf(fabsf(oa[q].x), fabsf(oa[q].y)), fmaxf(fabsf(oa[q].z), fabsf(oa[q].w)))); mb = fmaxf(mb, fmaxf(fmaxf(fabsf(ob[q].x), fabsf(ob[q].y)), fmaxf(fabsf(ob[q].z), fabsf(ob[q].w)))); }
        ma = fmaxf(wave_max_nn(ma), 1.0e-20f); mb = fmaxf(wave_max_nn(mb), 1.0e-20f);
        const float ia = 127.0f / ma, ib = 127.0f / mb;
#pragma unroll
        for (int q = 0; q < 4; ++q) { *(unsigned*)(HM + (size_t)ra * D + 4 * C.lane + 256 * q) = pack_i8(oa[q] * ia); *(unsigned*)(HM + (size_t)rb * D + 4 * C.lane + 256 * q) = pack_i8(ob[q] * ib); }
        if (C.lane == 0) { RSC[ra] = ma * (1.0f / 127.0f); RSC[rb] = mb * (1.0f / 127.0f); }
    }
}

constexpr int BM = 256, BK = 64, HALF = 128, HTB = HALF * BK * 2, STAGE_BYTES = 8 * HTB, NXCD = 8, WGM = 8;
constexpr int LDS_TAB = STAGE_BYTES;
__device__ __forceinline__ int lds_byte(int r, int c) { const int st = (r >> 4) * 2 + (c >> 5), rr = r & 15, cc = c & 31, ob = rr * 64 + cc * 2; return st * 1024 + (ob ^ (((ob >> 9) & 1) << 5)); }
__device__ __forceinline__ void stage_rc(int b, int& R, int& C) { const int st = b / 1024, sb = b % 1024, swz = sb ^ (((sb >> 9) & 1) << 5); R = (st >> 1) * 16 + swz / 64; C = (st & 1) * 32 + (swz % 64) / 2; }
__device__ __forceinline__ int perm32(int rho) { const int n = rho >> 4, i = rho & 15; return 8 * (i >> 2) + 4 * n + (i & 3); }
__device__ __forceinline__ unsigned cvt_pk_bf16(float lo, float hi) { unsigned r; asm volatile("v_cvt_pk_bf16_f32 %0, %1, %2" : "=v"(r) : "v"(lo), "v"(hi)); return r; }

struct GUnit { const char* a; const char* b; int orow, ocol, aux; };

typedef int i32x8 __attribute__((ext_vector_type(8)));
typedef int i32x4 __attribute__((ext_vector_type(4)));
template <class Epi, class Sched, bool GATHER, int OPM = 0>
__device__ __forceinline__ void gemm_phase(LAS unsigned char* lds, const int K, const Sched& S, const Epi& E) {
    const int tid = threadIdx.x, wid = __builtin_amdgcn_readfirstlane(tid >> 6), lane = tid & 63, wr = wid >> 2, wc = wid & 3, fr = lane & 15, fq = lane >> 4;
    constexpr bool FP8 = (OPM == 1), I8 = (OPM == 2);
    const int RB = (OPM != 0) ? K : 2 * K;
    const int nt = RB / (BK * 2);
    unsigned voffB[2], voA[2][2]; int Rr[2], Cc[2];
#pragma unroll
    for (int i = 0; i < 2; ++i) { int R, C; stage_rc(tid * 16 + i * 8192, R, C); const int Rb = (R & ~31) + perm32(R & 31); Rr[i] = R; Cc[i] = C;
        voffB[i] = (unsigned)(Rb * RB + C * 2);
        voA[0][i] = (unsigned)(R * RB + C * 2); voA[1][i] = (unsigned)((R + HALF) * RB + C * 2); }
    const size_t kstep = (size_t)(BK * 2);
    const size_t hstep = (size_t)HALF * RB;
    const unsigned ldsw = (unsigned)wid * 1024u;
    const unsigned ldsbase = (unsigned)(size_t)lds;
    const int aoff = lds_byte(wr * 64 + fr, fq * 8), boff = lds_byte(wc * 32 + fr, fq * 8);
#define PG8_SA(b, h) (((b) * 2 + (h)) * HTB)
#define PG8_SB(b, h) ((4 + (b) * 2 + (h)) * HTB)
#define PG8_STAGE(bufoff, gbase, voff) do { _Pragma("unroll") for (int _i = 0; _i < 2; ++_i) \
        asm volatile("s_mov_b32 m0, %2\n\ts_nop 0\n\tglobal_load_lds_dwordx4 %0, %1" :: "v"((voff)[_i]), "s"((const char*)(gbase)), "s"(ldsbase + (unsigned)(bufoff) + ldsw + (unsigned)(_i * 8192)) : "memory"); } while (0)
#define PG8_STAGE_A1(bufoff, gbase) do { if constexpr (GATHER) PG8_STAGE(bufoff, gbase, voA[1]); else PG8_STAGE(bufoff, (const char*)(gbase) + hstep, voA[0]); } while (0)
#define PG8_LDA(dst, b, h) do { if constexpr (FP8) { _Pragma("unroll") for (int m = 0; m < 4; ++m) { \
        const i32x4 _lo = *(const LAS i32x4*)(lds + PG8_SA(b, h) + aoff + m * 2048), _hi = *(const LAS i32x4*)(lds + PG8_SA(b, h) + aoff + m * 2048 + 1024); \
        dst##8[m] = __builtin_shufflevector(_lo, _hi, 0, 1, 2, 3, 4, 5, 6, 7); } } \
      else { _Pragma("unroll") for (int m = 0; m < 4; ++m) _Pragma("unroll") for (int k = 0; k < 2; ++k) dst[m][k] = *(const LAS bf16x8*)(lds + PG8_SA(b, h) + aoff + m * 2048 + k * 1024); } } while (0)
#define PG8_LDB(dst, b, h) do { if constexpr (FP8) { _Pragma("unroll") for (int n = 0; n < 2; ++n) { \
        const i32x4 _lo = *(const LAS i32x4*)(lds + PG8_SB(b, h) + boff + n * 2048), _hi = *(const LAS i32x4*)(lds + PG8_SB(b, h) + boff + n * 2048 + 1024); \
        dst##8[n] = __builtin_shufflevector(_lo, _hi, 0, 1, 2, 3, 4, 5, 6, 7); } } \
      else { _Pragma("unroll") for (int n = 0; n < 2; ++n) _Pragma("unroll") for (int k = 0; k < 2; ++k) dst[n][k] = *(const LAS bf16x8*)(lds + PG8_SB(b, h) + boff + n * 2048 + k * 1024); } } while (0)
#define PG8_MMA(ai, bj, At, Bt) do { __builtin_amdgcn_s_setprio(1); \
        if constexpr (FP8) { _Pragma("unroll") for (int m = 0; m < 4; ++m) _Pragma("unroll") for (int n = 0; n < 2; ++n) \
            acc[ai][bj][m][n] = __builtin_amdgcn_mfma_scale_f32_16x16x128_f8f6f4(Bt##8[n], At##8[m], acc[ai][bj][m][n], 0, 0, 0, 0x7f7f7f7f, 0, 0x7f7f7f7f); } \
        else if constexpr (I8) { _Pragma("unroll") for (int m = 0; m < 4; ++m) _Pragma("unroll") for (int n = 0; n < 2; ++n) _Pragma("unroll") for (int k = 0; k < 2; ++k) \
            acc[ai][bj][m][n] = __builtin_bit_cast(f32x4, __builtin_amdgcn_mfma_i32_16x16x64_i8(__builtin_bit_cast(i32x4, Bt[n][k]), __builtin_bit_cast(i32x4, At[m][k]), __builtin_bit_cast(i32x4, acc[ai][bj][m][n]), 0, 0, 0)); } \
        else { _Pragma("unroll") for (int m = 0; m < 4; ++m) _Pragma("unroll") for (int n = 0; n < 2; ++n) _Pragma("unroll") for (int k = 0; k < 2; ++k) \
            acc[ai][bj][m][n] = __builtin_amdgcn_mfma_f32_16x16x32_bf16(Bt[n][k], At[m][k], acc[ai][bj][m][n], 0, 0, 0); } \
        __builtin_amdgcn_s_setprio(0); } while (0)
#define PG8_WAIT_V(n) asm volatile("s_waitcnt vmcnt(" #n ")" ::: "memory")
#define PG8_WAIT_L(n) asm volatile("s_waitcnt lgkmcnt(" #n ")" ::: "memory")
#define PG8_BAR __builtin_amdgcn_s_barrier()
#define PG8_SCHED __builtin_amdgcn_sched_barrier(0)
    GUnit cur, nxt; int ui = 0;
    if (!S.next(0, cur)) return;
    if constexpr (GATHER) {
#pragma unroll
        for (int h = 0; h < 2; ++h)
#pragma unroll
            for (int i = 0; i < 2; ++i) voA[h][i] = S.arow_off(0, h * HALF + Rr[i]) + (unsigned)Cc[i] * 2u;
    }
    f32x4 acc[2][2][4][2];
#pragma unroll
    for (int a = 0; a < 2; ++a)
#pragma unroll
        for (int b = 0; b < 2; ++b)
#pragma unroll
            for (int m = 0; m < 4; ++m)
#pragma unroll
                for (int n = 0; n < 2; ++n) acc[a][b][m][n] = (f32x4){0.f, 0.f, 0.f, 0.f};
    bf16x8 At[4][2], B0[2][2], B1[2][2]; i32x8 At8[4], B08[2], B18[2];
    const char* cA = cur.a; const char* cB = cur.b;
    PG8_STAGE(PG8_SB(0, 0), cB, voffB); PG8_STAGE(PG8_SB(0, 1), cB + hstep, voffB); PG8_STAGE(PG8_SA(0, 0), cA, voA[0]); PG8_STAGE_A1(PG8_SA(0, 1), cA);
    if (wr == 1) PG8_BAR;
    PG8_WAIT_V(2); PG8_BAR;
    PG8_STAGE(PG8_SB(1, 0), cB + kstep, voffB); PG8_STAGE(PG8_SA(1, 0), cA + kstep, voA[0]); PG8_STAGE(PG8_SB(1, 1), cB + hstep + kstep, voffB);
    PG8_WAIT_V(6); PG8_BAR;
    for (;;) {
        const bool has_next = S.next(ui + 1, nxt);
        const char* nA = has_next ? nxt.a : cA; const char* nB = has_next ? nxt.b : cB;
#pragma unroll 1
        for (int t = 0; t < nt; t += 2) {
            const bool last = (t == nt - 2);
            const char* a1 = cA + (size_t)(t + 1) * kstep;
            const char* a2 = last ? nA : cA + (size_t)(t + 2) * kstep; const char* b2 = last ? nB : cB + (size_t)(t + 2) * kstep;
            const char* a3 = a2 + kstep; const char* b3 = b2 + kstep;
            PG8_LDB(B0, 0, 0); PG8_LDB(B1, 0, 1); PG8_SCHED; PG8_LDA(At, 0, 0); PG8_STAGE_A1(PG8_SA(1, 1), a1);
            if constexpr (GATHER) { if (last && has_next) {
#pragma unroll
                for (int h = 0; h < 2; ++h)
#pragma unroll
                    for (int i = 0; i < 2; ++i) { int R2, C2; stage_rc(tid * 16 + i * 8192, R2, C2); voA[h][i] = S.arow_off(ui + 1, h * HALF + R2) + (unsigned)C2 * 2u; } } }
            PG8_WAIT_V(8); PG8_WAIT_L(0); PG8_BAR; PG8_MMA(0, 0, At, B0); PG8_MMA(0, 1, At, B1); PG8_BAR; PG8_SCHED;
            PG8_LDA(At, 0, 1); PG8_STAGE(PG8_SB(0, 0), b2, voffB); PG8_STAGE(PG8_SB(0, 1), b2 + hstep, voffB); PG8_STAGE(PG8_SA(0, 0), a2, voA[0]);
            PG8_WAIT_V(8); PG8_WAIT_L(0); PG8_BAR; PG8_MMA(1, 0, At, B0); PG8_MMA(1, 1, At, B1); PG8_BAR; PG8_SCHED;
            PG8_LDB(B0, 1, 0); PG8_LDB(B1, 1, 1); PG8_SCHED; PG8_LDA(At, 1, 0); PG8_STAGE_A1(PG8_SA(0, 1), a2);
            PG8_WAIT_V(8); PG8_WAIT_L(0); PG8_BAR; PG8_MMA(0, 0, At, B0); PG8_MMA(0, 1, At, B1); PG8_BAR; PG8_SCHED;
            PG8_LDA(At, 1, 1); PG8_STAGE(PG8_SB(1, 0), b3, voffB); PG8_STAGE(PG8_SB(1, 1), b3 + hstep, voffB); PG8_STAGE(PG8_SA(1, 0), a3, voA[0]);
            PG8_WAIT_V(8); PG8_WAIT_L(0); PG8_BAR; PG8_MMA(1, 0, At, B0); PG8_MMA(1, 1, At, B1); PG8_BAR; PG8_SCHED;
        }
        if (wr == 0) PG8_BAR;
        { int tz = threadIdx.x; asm volatile("" : "+v"(tz));
          if constexpr (I8) {
#pragma unroll
              for (int a_ = 0; a_ < 2; ++a_)
#pragma unroll
                  for (int b_ = 0; b_ < 2; ++b_)
#pragma unroll
                      for (int m = 0; m < 4; ++m)
#pragma unroll
                          for (int n = 0; n < 2; ++n) acc[a_][b_][m][n] = __builtin_convertvector(__builtin_bit_cast(i32x4, acc[a_][b_][m][n]), f32x4); }
          const int wz = tz >> 6, lz = tz & 63; E(acc, cur, wz >> 2, wz & 3, lz & 15, lz >> 4); }
        if (!has_next) break;
#pragma unroll
        for (int a = 0; a < 2; ++a)
#pragma unroll
            for (int b = 0; b < 2; ++b)
#pragma unroll
                for (int m = 0; m < 4; ++m)
#pragma unroll
                    for (int n = 0; n < 2; ++n) acc[a][b][m][n] = (f32x4){0.f, 0.f, 0.f, 0.f};
        cur = nxt; cA = nA; cB = nB; ++ui;
        if (wr == 1) PG8_BAR;
    }
    PG8_WAIT_V(0);
    PG8_BAR;
#undef PG8_SA
#undef PG8_SB
#undef PG8_STAGE
#undef PG8_STAGE_A1
#undef PG8_LDA
#undef PG8_LDB
#undef PG8_MMA
#undef PG8_WAIT_V
#undef PG8_WAIT_L
#undef PG8_BAR
#undef PG8_SCHED
}

__device__ __forceinline__ int xcd_remap(int L, int nwg) { const int q = nwg / NXCD, r = nwg % NXCD, xcd = L % NXCD, off = L / NXCD; return (xcd < r ? xcd * (q + 1) : r * (q + 1) + (xcd - r) * q) + off; }

struct DenseSched {
    const char* A; const char* Bt; int nM, nN, nwg, G, c; size_t tstep; int sw_lo, sw_hi;
    __device__ __forceinline__ void init(const void* A_, const void* Bt_, int M, int N, int K, int G_, int c_, int ebytes = 2) { A = (const char*)A_; Bt = (const char*)Bt_; nM = M / BM; nN = N / BM; nwg = nM * nN; G = G_; c = c_; tstep = (size_t)BM * K * ebytes; sw_lo = 0; sw_hi = 0; }
    __device__ __forceinline__ bool next(int i, GUnit& u) const {
        const long L = (long)i * G + c; if (L >= nwg) return false;
        const int wgid = xcd_remap((int)L, nwg);
        const int nig = WGM * nN, gid = wgid / nig, fm = gid * WGM, gsz = (nM - fm) < WGM ? (nM - fm) : WGM;
        const int pm = fm + ((wgid % nig) % gsz), pn = (wgid % nig) / gsz;
        if (pn >= sw_lo && pn < sw_hi) { u.a = Bt + (size_t)pn * tstep; u.b = A + (size_t)pm * tstep; u.orow = pm; u.ocol = pn - sw_lo; u.aux = 1; }
        else { u.a = A + (size_t)pm * tstep; u.b = Bt + (size_t)pn * tstep; u.orow = pm * BM; u.ocol = pn * BM; u.aux = 0; }
        return true;
    }
    __device__ __forceinline__ unsigned arow_off(int, int) const { return 0u; }
};

constexpr int MAXU = 12;
struct MoeTab { int n; int e[MAXU], mb[MAXU], nt[MAXU]; int sb[NE + 1]; };
struct MoeSched {
    LAS const MoeTab* T; LAS const unsigned* ridx;
    const char* A; const char* W; size_t wstride_e, tstepB; int K; int arow_bytes;
    __device__ __forceinline__ bool next(int i, GUnit& u) const {
        const int n = __builtin_amdgcn_readfirstlane(T->n); if (i >= n) return false;
        const int e = __builtin_amdgcn_readfirstlane(T->e[i]), mb = __builtin_amdgcn_readfirstlane(T->mb[i]), nt = __builtin_amdgcn_readfirstlane(T->nt[i]);
        const int base = __builtin_amdgcn_readfirstlane(T->sb[e]);
        u.orow = base + mb * BM; u.ocol = nt; u.aux = e;
        u.a = A + (size_t)u.orow * arow_bytes;
        u.b = W + (size_t)e * wstride_e + (size_t)nt * tstepB; return true;
    }
    __device__ __forceinline__ unsigned arow_off(int i, int r) const { return ridx[i * 256 + r]; }
};
template <bool GATHER>
__device__ __forceinline__ void moe_tables(const Args& A, const Ctx& C, int l, int ntile_n, LAS MoeTab* T, LAS unsigned* ridx, int arow_bytes) {
    const unsigned* cnt = (const unsigned*)(A.ws + WS_CTL) + CW_CNT + l * 32 * CNT_STRIDE;
    LAS int* ust = (LAS int*)(T + 1);
    if (C.tid < 64) { int nb; const int ex = expert_block_prefix(cnt, C.tid, nb); if (C.tid <= NE) { T->sb[C.tid] = ex * 256; ust[C.tid] = ex * ntile_n; } }
    __syncthreads();
    if (C.tid < MAXU) { const int nwg = ust[NE]; const long L = (long)C.tid * C.G + C.bid;
        if (L < nwg) { const int w = xcd_remap((int)L, nwg); int e = 0; while (w >= ust[e + 1]) ++e;
            const int lu = w - ust[e]; T->e[C.tid] = e; T->mb[C.tid] = lu / ntile_n; T->nt[C.tid] = lu % ntile_n; } }
    if (C.tid == 0) { const int nwg = ust[NE]; int n = 0; while (n < MAXU && (long)n * C.G + C.bid < nwg) ++n; T->n = n; }
    __syncthreads();
    if constexpr (GATHER) {
        const int* ST = (const int*)(A.ws + WS_SLOTTOK); const int n = T->n;
        for (int i = C.tid; i < n * 256; i += NT) { const int ui = i >> 8, r = i & 255, e = T->e[ui], m0 = T->mb[ui] * 256, ce = (int)cnt[e * CNT_STRIDE];
            const int rr = (m0 + r < ce) ? m0 + r : ce - 1;
            ridx[i] = (unsigned)ST[(size_t)e * CAP + rr] * (unsigned)arow_bytes; }
        __syncthreads();
    }
}

struct EpiStore { bf16* O; int ldc; float scale_lo; int sig_from; bf16* VT; float sall = 1.0f; const float* rs = nullptr;
    __device__ __forceinline__ void operator()(const f32x4 (&acc)[2][2][4][2], const GUnit& u, int wr, int wc, int fr, int fq) const {
        const bool tr = u.aux != 0;
        const float sc = ((!tr && u.ocol < NQ) ? scale_lo : 1.0f) * sall; const bool sg = !tr && u.ocol >= sig_from;
        bf16* Ob = tr ? VT + (size_t)(u.orow * NH + u.ocol) * 65536 : O + (size_t)u.orow * ldc + u.ocol; const int ld = tr ? 256 : ldc;
        f32x4 cs[2][2];
#pragma unroll
        for (int bj = 0; bj < 2; ++bj) { const f32x4 one = (f32x4){1.f, 1.f, 1.f, 1.f};
            cs[bj][0] = (rs && tr) ? *(const f32x4*)(rs + u.orow * BM + bj * HALF + wc * 32 + 8 * fq) : one; cs[bj][1] = (rs && tr) ? *(const f32x4*)(rs + u.orow * BM + bj * HALF + wc * 32 + 8 * fq + 4) : one; }
#pragma unroll
        for (int ai = 0; ai < 2; ++ai)
#pragma unroll
            for (int m = 0; m < 4; ++m) { const int rl = ai * HALF + wr * 64 + m * 16 + fr; bf16* rowp = tr ? Ob + wc * 8192 + rl * 32 + 8 * fq : Ob + (size_t)rl * ld + wc * 32 + 8 * fq;

                const float scr = (rs && !tr) ? sc * rs[u.orow + rl] : sc;
#pragma unroll
                for (int bj = 0; bj < 2; ++bj) { f32x4 v0 = acc[ai][bj][m][0] * scr * cs[bj][0], v1 = acc[ai][bj][m][1] * scr * cs[bj][1];
                    if (sg) {
#pragma unroll
                        for (int q = 0; q < 4; ++q) { v0[q] = __builtin_amdgcn_rcpf(1.0f + __expf(-v0[q])); v1[q] = __builtin_amdgcn_rcpf(1.0f + __expf(-v1[q])); } }
                    u32x4 w; w.x = cvt_pk_bf16(v0[0], v0[1]); w.y = cvt_pk_bf16(v0[2], v0[3]); w.z = cvt_pk_bf16(v1[0], v1[1]); w.w = cvt_pk_bf16(v1[2], v1[3]);
                    *(u32x4*)(rowp + (tr ? bj * 4 * 8192 : bj * HALF)) = w; } }
    }
};
__device__ __forceinline__ u32x2 cvt8_fp8(f32x4 a, f32x4 b) { int lo = 0, hi = 0;
    lo = __builtin_amdgcn_cvt_pk_fp8_f32(a[0], a[1], lo, false); lo = __builtin_amdgcn_cvt_pk_fp8_f32(a[2], a[3], lo, true);
    hi = __builtin_amdgcn_cvt_pk_fp8_f32(b[0], b[1], hi, false); hi = __builtin_amdgcn_cvt_pk_fp8_f32(b[2], b[3], hi, true); return (u32x2){(unsigned)lo, (unsigned)hi}; }
struct EpiSwigluF8 { unsigned char* O; int ldc; float s;
    __device__ __forceinline__ void operator()(const f32x4 (&acc)[2][2][4][2], const GUnit& u, int wr, int wc, int fr, int fq) const {
        const int ocol = u.ocol * HALF;
#pragma unroll
        for (int ai = 0; ai < 2; ++ai)
#pragma unroll
            for (int m = 0; m < 4; ++m) { unsigned char* rowp = O + (size_t)(u.orow + ai * HALF + wr * 64 + m * 16 + fr) * ldc + ocol + wc * 32 + 8 * fq;
                f32x4 v0, v1;
#pragma unroll
                for (int q = 0; q < 4; ++q) { const float x0 = acc[ai][0][m][0][q] * s, x1 = acc[ai][0][m][1][q] * s;
                    v0[q] = x0 * __builtin_amdgcn_rcpf(1.0f + __expf(-x0)) * (acc[ai][1][m][0][q] * s); v1[q] = x1 * __builtin_amdgcn_rcpf(1.0f + __expf(-x1)) * (acc[ai][1][m][1][q] * s); }
                *(u32x2*)rowp = cvt8_fp8(v0, v1); }
    }
};
template <int MODE> struct EpiPair { bf16* O; int ldc; int plain_below; float sall = 1.0f; const float* rs = nullptr;
    __device__ __forceinline__ void operator()(const f32x4 (&acc)[2][2][4][2], const GUnit& u, int wr, int wc, int fr, int fq) const {
        if (MODE == 0 && u.ocol < plain_below) {
#pragma unroll
            for (int ai = 0; ai < 2; ++ai)
#pragma unroll
                for (int m = 0; m < 4; ++m) { const int rg = u.orow + ai * HALF + wr * 64 + m * 16 + fr; bf16* rowp = O + (size_t)rg * ldc + u.ocol + wc * 32 + 8 * fq;
                    const float scr = rs ? sall * rs[rg] : sall;
#pragma unroll
                    for (int bj = 0; bj < 2; ++bj) { const f32x4 v0 = acc[ai][bj][m][0] * scr, v1 = acc[ai][bj][m][1] * scr;
                        u32x4 w; w.x = cvt_pk_bf16(v0[0], v0[1]); w.y = cvt_pk_bf16(v0[2], v0[3]); w.z = cvt_pk_bf16(v1[0], v1[1]); w.w = cvt_pk_bf16(v1[2], v1[3]);
                        *(u32x4*)(rowp + bj * HALF) = w; } }
            return;
        }
        const int ocol = (MODE == 0) ? plain_below + (u.ocol - plain_below) / 2 : u.ocol * HALF;
#pragma unroll
        for (int ai = 0; ai < 2; ++ai)
#pragma unroll
            for (int m = 0; m < 4; ++m) { const int rg = u.orow + ai * HALF + wr * 64 + m * 16 + fr; bf16* rowp = O + (size_t)rg * ldc + ocol + wc * 32 + 8 * fq;
                const float scr = rs ? sall * rs[rg] : sall; const float sc2 = scr * scr;
                f32x4 v0, v1;
#pragma unroll
                for (int q = 0; q < 4; ++q) {
                    const float x0 = acc[ai][0][m][0][q], x1 = acc[ai][0][m][1][q];
                    const float g0 = (MODE == 1) ? x0 * __builtin_amdgcn_rcpf(1.0f + __expf(-x0)) : x0, g1 = (MODE == 1) ? x1 * __builtin_amdgcn_rcpf(1.0f + __expf(-x1)) : x1;
                    v0[q] = g0 * acc[ai][1][m][0][q] * sc2; v1[q] = g1 * acc[ai][1][m][1][q] * sc2; }
                u32x4 w; w.x = cvt_pk_bf16(v0[0], v0[1]); w.y = cvt_pk_bf16(v0[2], v0[3]); w.z = cvt_pk_bf16(v1[0], v1[1]); w.w = cvt_pk_bf16(v1[2], v1[3]);
                *(u32x4*)rowp = w; }
    }
};
struct EpiResid { bf16* LAT; const float* g1; float sall; const float* rs;
    __device__ __forceinline__ void operator()(const f32x4 (&acc)[2][2][4][2], const GUnit& u, int wr, int wc, int fr, int fq) const {
        bf16* Ob = LAT + (size_t)u.orow * D + u.ocol + wc * 32 + 8 * fq;
        u32x4 old[2][4][2];
#pragma unroll
        for (int ai = 0; ai < 2; ++ai)
#pragma unroll
            for (int m = 0; m < 4; ++m)
#pragma unroll
                for (int bj = 0; bj < 2; ++bj) old[ai][m][bj] = *(const u32x4*)(Ob + (size_t)(ai * HALF + wr * 64 + m * 16 + fr) * D + bj * HALF);
        const float* gv = g1 + (size_t)mod_vec_of_row(u.orow) * 6 * D + u.ocol + wc * 32 + 8 * fq;
        f32x4 g[2][2];
#pragma unroll
        for (int bj = 0; bj < 2; ++bj) { g[bj][0] = *(const f32x4*)(gv + bj * HALF); g[bj][1] = *(const f32x4*)(gv + bj * HALF + 4); }
#pragma unroll
        for (int ai = 0; ai < 2; ++ai)
#pragma unroll
            for (int m = 0; m < 4; ++m) { const int rl = ai * HALF + wr * 64 + m * 16 + fr; bf16* rowp = Ob + (size_t)rl * D;
                const float scr = rs ? sall * rs[u.orow + rl] : sall;
#pragma unroll
                for (int bj = 0; bj < 2; ++bj) { const u32x4 o = old[ai][m][bj];
                    const f32x4 v0 = bf4((u32x2){o.x, o.y}) + g[bj][0] * (acc[ai][bj][m][0] * scr), v1 = bf4((u32x2){o.z, o.w}) + g[bj][1] * (acc[ai][bj][m][1] * scr);
                    u32x4 w; w.x = cvt_pk_bf16(v0[0], v0[1]); w.y = cvt_pk_bf16(v0[2], v0[3]); w.z = cvt_pk_bf16(v1[0], v1[1]); w.w = cvt_pk_bf16(v1[2], v1[3]);
                    *(u32x4*)(rowp + bj * HALF) = w; } }
    }
};
struct EpiStoreTile { unsigned char* O; int ldc; float s;
    __device__ __forceinline__ void operator()(const f32x4 (&acc)[2][2][4][2], const GUnit& u, int wr, int wc, int fr, int fq) const {
#pragma unroll
        for (int ai = 0; ai < 2; ++ai)
#pragma unroll
            for (int m = 0; m < 4; ++m) { unsigned char* rowp = O + (size_t)(u.orow + ai * HALF + wr * 64 + m * 16 + fr) * ldc + u.ocol * BM + wc * 32 + 8 * fq;
#pragma unroll
                for (int bj = 0; bj < 2; ++bj) *(u32x2*)(rowp + bj * HALF) = cvt8_fp8(acc[ai][bj][m][0] * s, acc[ai][bj][m][1] * s); }
    }
};

__device__ __forceinline__ void transpose_item(const float* W, int ldw, int K, bf16* WT, int drow0, int k0, int n0, LAS float* scr, int lane) {
#pragma unroll
    for (int i = 0; i < 32; ++i) { const int kk = 2 * i + (lane >> 5); scr[kk * 33 + (lane & 31)] = W[(size_t)(k0 + kk) * ldw + n0 + (lane & 31)]; }
    asm volatile("s_waitcnt lgkmcnt(0)" ::: "memory");
    const int c = lane & 7;
#pragma unroll
    for (int j = 0; j < 4; ++j) { const int n = (lane >> 3) + 8 * j; const LAS float* s = scr + (8 * c) * 33 + n;
        u32x4 o; o.x = pk2(s[0 * 33], s[1 * 33]); o.y = pk2(s[2 * 33], s[3 * 33]); o.z = pk2(s[4 * 33], s[5 * 33]); o.w = pk2(s[6 * 33], s[7 * 33]);
        *(u32x4*)(WT + (size_t)(drow0 + n) * K + k0 + 8 * c) = o; }
    asm volatile("s_waitcnt lgkmcnt(0)" ::: "memory");
}
__device__ __forceinline__ void transpose_item_fp8(const float* W, int ldw, int K, unsigned char* WT8, int drow0, int k0, int n0, LAS float* scr, int lane, float sc) {
#pragma unroll
    for (int i = 0; i < 32; ++i) { const int kk = 2 * i + (lane >> 5); scr[kk * 33 + (lane & 31)] = W[(size_t)(k0 + kk) * ldw + n0 + (lane & 31)]; }
    asm volatile("s_waitcnt lgkmcnt(0)" ::: "memory");
    const int n = lane >> 1, half = lane & 1; const LAS float* sp = scr + (32 * half) * 33 + n;
    unsigned char* dst = WT8 + (size_t)(drow0 + n) * K + k0 + 32 * half;
#pragma unroll
    for (int c = 0; c < 2; ++c) { u32x4 o;
#pragma unroll
        for (int q = 0; q < 4; ++q) { int p = 0; const LAS float* s4 = sp + (16 * c + 4 * q) * 33;
            p = __builtin_amdgcn_cvt_pk_fp8_f32(s4[0] * sc, s4[33] * sc, p, false); p = __builtin_amdgcn_cvt_pk_fp8_f32(s4[66] * sc, s4[99] * sc, p, true); o[q] = (unsigned)p; }
        *(u32x4*)(dst + 16 * c) = o; }
    asm volatile("s_waitcnt lgkmcnt(0)" ::: "memory");
}
__device__ __forceinline__ void transpose_item_i8(const float* W, int ldw, int K, unsigned char* WT8, int drow0, int k0, int n0, LAS float* scr, int lane, float inv) {
#pragma unroll
    for (int i = 0; i < 32; ++i) { const int kk = 2 * i + (lane >> 5); scr[kk * 33 + (lane & 31)] = W[(size_t)(k0 + kk) * ldw + n0 + (lane & 31)]; }
    asm volatile("s_waitcnt lgkmcnt(0)" ::: "memory");
    const int n = lane >> 1, half = lane & 1; const LAS float* sp = scr + (32 * half) * 33 + n;
    unsigned char* dst = WT8 + (size_t)(drow0 + n) * K + k0 + 32 * half;
#pragma unroll
    for (int c = 0; c < 2; ++c) { u32x4 o;
#pragma unroll
        for (int q = 0; q < 4; ++q) { const LAS float* s4 = sp + (16 * c + 4 * q) * 33; o[q] = pack_i8((f32x4){s4[0] * inv, s4[33] * inv, s4[66] * inv, s4[99] * inv}); }
        *(u32x4*)(dst + 16 * c) = o; }
    asm volatile("s_waitcnt lgkmcnt(0)" ::: "memory");
}
__device__ __forceinline__ int pair_row(int n, int which) { return (n >> 7) * 256 + (n & 127) + which * 128; }
constexpr float HMR = 6.0f;
__device__ __forceinline__ void phase_cvt_mixer(const Args& A, const Ctx& C) {
    const int gw = C.bid * NW + C.wave, NGW = C.G * NW;
    unsigned* wmax = (unsigned*)(A.ws + WS_CTL) + CW_WMAX;
    for (int m8 = 0; m8 < 8; ++m8) {
        const float* W = m8 < 2 ? A.in[8] + (size_t)m8 * D * PROJ : m8 < 4 ? A.in[12] + (size_t)(m8 - 2) * D * PW : m8 < 6 ? A.in[11] + (size_t)(m8 - 4) * D * D : A.in[14] + (size_t)(m8 - 6) * D * D;
        const size_t n4 = (size_t)D * (m8 < 2 ? PROJ : m8 < 4 ? PW : D) / 4;
        float mx = 0.f;
        for (size_t i = (size_t)gw * 64 + C.lane; i < n4; i += (size_t)NGW * 64) { const f32x4 v = *(const f32x4*)(W + 4 * i); mx = fmaxf(mx, fmaxf(fmaxf(fabsf(v.x), fabsf(v.y)), fmaxf(fabsf(v.z), fabsf(v.w)))); }
        mx = wave_max_nn(mx);
        if (C.lane == 0 && mx > 0.f) atomicMax(wmax + m8 * CNT_STRIDE, __float_as_uint(mx));
    }
}
__device__ __forceinline__ void cvt_win_i8(const Args& A, const Ctx& C) {
    LAS float* scr = (LAS float*)(C.lds + 16384 + C.wave * 16384);
    const int gw = C.bid * NW + C.wave, NGW = C.G * NW;
    constexpr int I_IN = (D / 64) * (PW / 32);
    const unsigned* wmax = (const unsigned*)(A.ws + WS_CTL) + CW_WMAX;
    constexpr int I_OUT = (D / 64) * (D / 32);
    for (int it = gw; it < 4 * I_OUT; it += NGW) {
        const int m4 = it / I_OUT, kind = m4 >> 1, j = m4 & 1, r = it % I_OUT; const int kb = r / (D / 32), nb = r % (D / 32), n0 = nb * 32;
        const float inv = 127.0f / fmaxf(__uint_as_float(wmax[(4 + m4) * CNT_STRIDE]), 1.0e-30f);
        transpose_item_i8((kind == 0 ? A.in[11] : A.in[14]) + (size_t)j * D * D, D, D, A.ws + (kind == 0 ? WS_WAOUT : WS_WBOUT) + (size_t)j * D * D, n0, kb * 64, n0, scr, C.lane, inv); }
    for (int it = gw; it < 4 * I_IN; it += NGW) {
        const int m4 = it / I_IN, kind = m4 >> 1, j = m4 & 1, r = it % I_IN; const int kb = r / (PW / 32), nb = r % (PW / 32), n0 = nb * 32;
        const float inv = 127.0f / fmaxf(__uint_as_float(wmax[m4 * CNT_STRIDE]), 1.0e-30f);
        unsigned char* WT = A.ws + (kind == 0 ? WS_WAIN : WS_WBIN) + (size_t)j * PW * D;
        if (kind == 0) transpose_item_i8(A.in[8] + (size_t)j * D * PROJ, PROJ, D, WT, n0, kb * 64, n0, scr, C.lane, inv);
        else { const int drow = n0 < D ? n0 : (n0 < 2 * D ? D + pair_row(n0 - D, 0) : D + pair_row(n0 - 2 * D, 1));
            transpose_item_i8(A.in[12] + (size_t)j * D * PW, PW, D, WT, drow, kb * 64, n0, scr, C.lane, inv); }
    }
}
__device__ __forceinline__ void cvt_moe_items(const Args& A, const Ctx& C, int l, int it0, int end, int stride) {
    LAS float* scr = (LAS float*)(C.lds + 16384 + C.wave * 16384);
    unsigned char* WGU = A.ws + WS_WGU; unsigned char* WDN = A.ws + WS_WDN;
    for (int it = it0; it < end; it += stride) {
        const int e = it / CVT_PER; int r = it % CVT_PER;
        if (r < 2 * CVT_IG) { const int which = r / CVT_IG; r %= CVT_IG; const int kb = r / (DE / 32), nb = r % (DE / 32), n0 = nb * 32;
            transpose_item_fp8((which == 0 ? A.in[19] : A.in[20]) + ((size_t)l * NE + e) * D * DE, DE, D, WGU + (size_t)e * 2 * DE * D, pair_row(n0, which), kb * 64, n0, scr, C.lane, WSCALE); }
        else { r -= 2 * CVT_IG; const int kb = r / (D / 32), nb = r % (D / 32), n0 = nb * 32;
            transpose_item_fp8(A.in[21] + ((size_t)l * NE + e) * DE * D, D, DE, WDN + (size_t)e * D * DE, n0, kb * 64, n0, scr, C.lane, WSCALE); }
    }
}
__device__ __forceinline__ int cvt_idle(int nunits, int G) { const int rem = nunits % G; return rem ? G - rem : 0; }
__device__ __forceinline__ int cvt_t1(int l, int G) { const int n = cvt_idle((((l <= 2) ? NR : NL) / BM) * (PW / BM), G) * CVT_Q; return n < CVT_ITEMS ? n : CVT_ITEMS; }
__device__ __forceinline__ int cvt_t2(int l, int G) { const int n = cvt_t1(l, G) + cvt_idle((((l <= 1) ? NR : NL) / BM) * (D / BM), G) * CVT_Q; return n < CVT_ITEMS ? n : CVT_ITEMS; }
__device__ __forceinline__ void cvt_moe_tail(const Args& A, const Ctx& C, int l, int nunits, int base, int end) {
    const int rem = nunits % C.G;
    if (rem == 0 || C.bid < rem) return;
    const int first = base + (C.bid - rem) * CVT_Q; const int last = min(first + CVT_Q, end);
    cvt_moe_items(A, C, l, first + C.wave, last, NW);
}

__device__ __forceinline__ void phase_g1(const Args& A, const Ctx& C, int l) {
    const bool mls = (l & 1) == 0; const int j = l >> 1; const int nrows = (l <= 2) ? NR : NL;
    DenseSched S; S.init(A.ws + WS_H8, A.ws + (mls ? WS_WAIN : WS_WBIN) + (size_t)j * PW * D, nrows, PW, D, C.G, C.bid, 1);
    const float wsc = __uint_as_float(((const unsigned*)(A.ws + WS_CTL))[CW_WMAX + ((mls ? 0 : 2) + j) * CNT_STRIDE]) * (1.0f / 127.0f);
    const float* rs = (const float*)(A.ws + WS_RSC);
    if (mls) { S.sw_lo = 4; S.sw_hi = 8; EpiStore E{(bf16*)(A.ws + WS_PB), PW, 0.08838834764831845f, 2 * NQ + NV, (bf16*)(A.ws + WS_VT), wsc, rs}; gemm_phase<EpiStore, DenseSched, false, 2>(C.lds, D, S, E); }
    else { EpiPair<0> E{(bf16*)(A.ws + WS_PB), PW, D, wsc, rs}; gemm_phase<EpiPair<0>, DenseSched, false, 2>(C.lds, D, S, E); }
    cvt_moe_tail(A, C, l, S.nwg, 0, cvt_t1(l, C.G));
}
__device__ __forceinline__ void phase_g2(const Args& A, const Ctx& C, int l) {
    const bool mls = (l & 1) == 0; const int j = l >> 1; const int nrows = (l <= 1) ? NR : NL;
    DenseSched S; S.init(A.ws + WS_HM, A.ws + (mls ? WS_WAOUT : WS_WBOUT) + (size_t)j * D * D, nrows, D, D, C.G, C.bid, 1);
    const float wsc = __uint_as_float(((const unsigned*)(A.ws + WS_CTL))[CW_WMAX + (4 + (mls ? 0 : 2) + j) * CNT_STRIDE]) * (1.0f / 127.0f);
    EpiResid E{(bf16*)(A.ws + WS_LAT), (const float*)(A.ws + WS_MOD) + (size_t)(l * 3) * 6 * D + 2 * D, mls ? wsc * (HMR / 127.0f) : wsc, mls ? nullptr : (const float*)(A.ws + WS_RSC)}; gemm_phase<EpiResid, DenseSched, false, 2>(C.lds, D, S, E);
    cvt_moe_tail(A, C, l, S.nwg, cvt_t1(l, C.G), cvt_t2(l, C.G));
}
__device__ __forceinline__ void phase_m1(const Args& A, const Ctx& C, int l) {
    LAS MoeTab* T = (LAS MoeTab*)(C.lds + LDS_TAB); LAS unsigned* ridx = (LAS unsigned*)(C.lds + LDS_TAB + 1024);
    moe_tables<true>(A, C, l, 4, T, ridx, D);
    MoeSched S; S.T = T; S.ridx = ridx; S.A = (const char*)(A.ws + WS_H8); S.W = (const char*)(A.ws + WS_WGU); S.wstride_e = (size_t)2 * DE * D; S.tstepB = (size_t)BM * D; S.K = D; S.arow_bytes = 0;
    EpiSwigluF8 E{A.ws + WS_DC, DE, 1.0f / WSCALE}; gemm_phase<EpiSwigluF8, MoeSched, true, 1>(C.lds, D, S, E);
}
__device__ __forceinline__ void phase_m2(const Args& A, const Ctx& C, int l) {
    LAS MoeTab* T = (LAS MoeTab*)(C.lds + LDS_TAB); LAS unsigned* ridx = (LAS unsigned*)(C.lds + LDS_TAB + 1024);
    moe_tables<false>(A, C, l, 4, T, ridx, DE);
    MoeSched S; S.T = T; S.ridx = ridx; S.A = (const char*)(A.ws + WS_DC); S.W = (const char*)(A.ws + WS_WDN); S.wstride_e = (size_t)D * DE; S.tstepB = (size_t)BM * DE; S.K = DE; S.arow_bytes = DE;
    EpiStoreTile E{A.ws + WS_PB, D, YSCALE / WSCALE}; gemm_phase<EpiStoreTile, MoeSched, false, 1>(C.lds, DE, S, E);
}

typedef float f32x16 __attribute__((ext_vector_type(16)));
#define MFMA32(a, b, c) __builtin_amdgcn_mfma_f32_32x32x16_bf16((a), (b), (c), 0, 0, 0)
__device__ __forceinline__ bf16x8 pack8(float a0, float a1, float a2, float a3, float a4, float a5, float a6, float a7) {
    u32x4 p; p.x = cvt2(a0, a1); p.y = cvt2(a2, a3); p.z = cvt2(a4, a5); p.w = cvt2(a6, a7); return __builtin_bit_cast(bf16x8, p); }
__device__ __forceinline__ float bflo(unsigned w) { return __uint_as_float(w << 16); }
__device__ __forceinline__ float bfhi(unsigned w) { return __uint_as_float(w & 0xffff0000u); }
__device__ __forceinline__ int vt_tile(int b, int h, int blk) { return (blk == 0 ? 128 + b : b * 64 + blk - 1) * NH + h; }

__device__ __forceinline__ float wave_incl_scan(float v, int lane) {
#pragma unroll
    for (int o = 1; o < 64; o <<= 1) { const float t = __shfl_up(v, o); v += (lane >= o) ? t : 0.f; }
    return v;
}
__device__ __forceinline__ void block_gates(const Args& A, int row0, int h, LAS float* bf, LAS float* bb, LAS float* lif, LAS float* lib, int tid) {
    const float* GATE = (const float*)(A.ws + WS_GATE);
    if (tid < 256) { const float* g = GATE + (size_t)(row0 + tid) * 16; lif[tid] = g[0 + h]; bf[tid] = g[4 + h]; lib[tid] = g[8 + h]; bb[tid] = g[12 + h]; }
    __syncthreads();
    const int lane = tid & 63, wv = tid >> 6;
    if (wv == 0) { f32x4 x = *(LAS f32x4*)(bf + 4 * lane); x.y += x.x; x.z += x.y; x.w += x.z; const float tot = wave_incl_scan(x.w, lane); const float ex = tot - x.w;
        x.x += ex; x.y += ex; x.z += ex; x.w += ex; *(LAS f32x4*)(bf + 4 * lane) = x; }
    if (wv == 1) { f32x4 y = *(LAS f32x4*)(bb + 4 * (63 - lane)); y.z += y.w; y.y += y.z; y.x += y.y; const float tot = wave_incl_scan(y.x, lane); const float ex = tot - y.x;
        y.x += ex; y.y += ex; y.z += ex; y.w += ex; *(LAS f32x4*)(bb + 4 * (63 - lane)) = y; }
    __syncthreads();
}
__device__ __forceinline__ void phase_s1(const Args& A, const Ctx& C, int l) {
    LAS float* bf = (LAS float*)C.lds; LAS float* bb = bf + 256; LAS float* lif = bb + 256; LAS float* lib = lif + 256; LAS float* af = lib + 256; LAS float* ab = af + 256;
    constexpr int KP = 528;
    LAS unsigned char* KTf = C.lds + 8192; LAS unsigned char* KTb = KTf + 128 * KP;
    const bf16* P = (const bf16*)(A.ws + WS_PB); const bf16* VT = (const bf16*)(A.ws + WS_VT);
    bf16* DC = (bf16*)(A.ws + WS_DC); float* DN = (float*)(A.ws + WS_DN); float* BT = (float*)(A.ws + WS_BTOT);
    const int r = C.lane & 31, hh = C.lane >> 5, w = C.wave;
    for (int it = C.bid; it < BATCH * NH * (NBLK - 1) + 2 * BATCH * NH; it += C.G) {
        const bool isctx = it >= BATCH * NH * (NBLK - 1); const int ci_ = it - BATCH * NH * (NBLK - 1);
        const int bh = isctx ? (ci_ >> 1) : it / (NBLK - 1), blk = isctx ? 0 : 1 + it % (NBLK - 1), h = bh % NH, b = bh / NH; const int u = bh * NBLK + blk; const int row0 = blk_row0(b, blk);
        const int dlo = isctx ? (ci_ & 1) : 0, dhi = isctx ? (ci_ & 1) + 1 : 2;
        block_gates(A, row0, h, bf, bb, lif, lib, C.tid);
        if (C.tid < 256) { af[C.tid] = __expf(bf[255] - bf[C.tid] + lif[C.tid]); ab[C.tid] = __expf(bb[0] - bb[C.tid] + lib[C.tid]); }
        if (C.tid == 0) { BT[u * 2 + 0] = bf[255]; BT[u * 2 + 1] = bb[0]; }
        __syncthreads();
        { const int sp = C.tid >> 2, dq = C.tid & 3, s0 = 2 * sp;
          const bf16* k0 = P + (size_t)(row0 + s0) * PW + NQ + h * DQK + 32 * dq;
          const float f0 = af[s0], f1 = af[s0 + 1], g0 = ab[s0], g1 = ab[s0 + 1];
#pragma unroll
          for (int c = 0; c < 4; ++c) { const u32x4 x0 = *(const u32x4*)(k0 + 8 * c), x1 = *(const u32x4*)(k0 + PW + 8 * c);
#pragma unroll
              for (int q = 0; q < 4; ++q) { const int d = 32 * dq + 8 * c + 2 * q;
                  const float a0 = bflo(x0[q]), a1 = bfhi(x0[q]), c0 = bflo(x1[q]), c1 = bfhi(x1[q]);
                  *(LAS unsigned*)(KTf + d * KP + s0 * 2) = cvt2(a0 * f0, c0 * f1); *(LAS unsigned*)(KTf + (d + 1) * KP + s0 * 2) = cvt2(a1 * f0, c1 * f1);
                  *(LAS unsigned*)(KTb + d * KP + s0 * 2) = cvt2(a0 * g0, c0 * g1); *(LAS unsigned*)(KTb + (d + 1) * KP + s0 * 2) = cvt2(a1 * g0, c1 * g1); } } }
        __syncthreads();
        if (C.tid < 256) { const int dir = C.tid >> 7, d = C.tid & 127; LAS const unsigned* kr = (LAS const unsigned*)((dir ? KTb : KTf) + d * KP); float s = 0.f;
            for (int i = 0; i < 128; ++i) { const unsigned x = kr[i]; s += bflo(x) + bfhi(x); }
            DN[(size_t)(u * 2 + dir) * DQK + d] = s; }
        const bf16* vt = VT + (size_t)vt_tile(b, h, blk) * 65536 + (size_t)(32 * w + r) * 32 + 8 * hh;
        bf16x8 av[16];
#pragma unroll
        for (int ks = 0; ks < 16; ++ks) av[ks] = *(const bf16x8*)(vt + (ks >> 1) * 8192 + 16 * (ks & 1));
#pragma unroll 1
        for (int dir = dlo; dir < dhi; ++dir) {
            LAS const unsigned char* KT = dir ? KTb : KTf;
            f32x16 acc[4];
#pragma unroll
            for (int dt = 0; dt < 4; ++dt)
#pragma unroll
                for (int i = 0; i < 16; ++i) acc[dt][i] = 0.f;
#pragma unroll
            for (int ks = 0; ks < 16; ++ks) {
#pragma unroll
                for (int dt = 0; dt < 4; ++dt) { const bf16x8 b0 = *(const LAS bf16x8*)(KT + (dt * 32 + r) * KP + (16 * ks + 8 * hh) * 2); acc[dt] = MFMA32(av[ks], b0, acc[dt]); }
                if ((ks & 3) == 3) asm volatile("" ::: "memory"); }
            bf16* dc = DC + (size_t)(u * 2 + dir) * DQK * DV + (size_t)(32 * w + 4 * hh) * 32 + r;
#pragma unroll
            for (int g = 0; g < 4; ++g) { bf16* pf = dc + g * 8 * 32; asm volatile("" : "+v"(pf));
#pragma unroll
                for (int q = 0; q < 4; ++q)
#pragma unroll
                    for (int dt = 0; dt < 4; ++dt) pf[q * 32 + dt * 8192] = (bf16)f2bf(acc[dt][4 * g + q]); }
        }
        __syncthreads();
    }
}
__device__ __forceinline__ void phase_s2(const Args& A, const Ctx& C) {
    const bf16* __restrict__ DC = (const bf16*)(A.ws + WS_DC); const float* __restrict__ DN = (const float*)(A.ws + WS_DN); const float* __restrict__ BT = (const float*)(A.ws + WS_BTOT);
    bf16* __restrict__ CST = (bf16*)(A.ws + WS_CST); float* __restrict__ NST = (float*)(A.ws + WS_NST);
    constexpr int EL4 = DQK * DV / 4;
    for (int g = C.bid * NT + C.tid; g < BATCH * NH * 2 * EL4; g += C.G * NT) {
        const int e4 = (g % EL4) * 4, ch = g / EL4, dir = ch & 1, bh = ch >> 1;
        f32x4 st = (f32x4){0.f, 0.f, 0.f, 0.f};
#pragma unroll 13
        for (int idx = 0; idx < NBLK; ++idx) {
            const int blk = dir == 0 ? idx : (idx == 0 ? 0 : NBLK - idx); const int u = bh * NBLK + blk;
            const float dec = __expf(BT[u * 2 + dir]);
            const f32x4 dc = bf4(*(const u32x2*)(DC + (size_t)(u * 2 + dir) * DQK * DV + e4));
            u32x2 o; o.x = cvt2(st.x, st.y); o.y = cvt2(st.z, st.w);
            *(u32x2*)(CST + (size_t)(u * 2 + dir) * DQK * DV + e4) = o;
            st = st * dec + dc;
        }
    }
    for (int g = C.bid * NT + C.tid; g < BATCH * NH * 2 * DQK; g += C.G * NT) {
        const int d = g % DQK, ch = g / DQK, dir = ch & 1, bh = ch >> 1; float st = 0.f;
        for (int idx = 0; idx < NBLK; ++idx) {
            const int blk = dir == 0 ? idx : (idx == 0 ? 0 : NBLK - idx); const int u = bh * NBLK + blk;
            NST[(size_t)(u * 2 + dir) * DQK + d] = st; st = __expf(BT[u * 2 + dir]) * st + DN[(size_t)(u * 2 + dir) * DQK + d];
        }
    }
}
__device__ __forceinline__ void lds_barrier() { asm volatile("s_waitcnt lgkmcnt(0)" ::: "memory"); __builtin_amdgcn_s_barrier(); asm volatile("" ::: "memory"); }
__device__ __forceinline__ void phase_s3(const Args& A, const Ctx& C, int l) {
    const int jl = l >> 1; const bool ctx_out = (l == 0);
    LAS float* bf = (LAS float*)C.lds; LAS float* bb = bf + 256; LAS float* gf = bb + 256; LAS float* gb = gf + 256;
    LAS float* nf = gb + 256; LAS float* nb = nf + 128; LAS float* ssx = nb + 128;
    LAS float* cf = ssx + 256; LAS float* cb = cf + 256;
    constexpr int KP = 272, OP = 528, CHB = 16384, NCHB = 4;
    LAS unsigned char* Kimg = C.lds + 8192;
    LAS unsigned char* CH = Kimg + 256 * KP;
    LAS unsigned char* OUT = Kimg;
    static_assert(8192 + 256 * KP + NCHB * CHB <= LDS_TAB_END && 8192 + 256 * OP <= LDS_TAB_END, "S3 LDS map");
    const bf16* P = (const bf16*)(A.ws + WS_PB); const bf16* VT = (const bf16*)(A.ws + WS_VT); unsigned char* HM = A.ws + WS_HM;
    const bf16* CST = (const bf16*)(A.ws + WS_CST); const float* NST = (const float*)(A.ws + WS_NST);
    const float* hg = A.in[10] + (size_t)jl * NV;
    const int w = C.wave;
    bf16x8 qf[8]; u32x4 kr8[8]; f32x4 gl;
#define S3_UNIT(it_) ((it_) < BATCH * NH * (NBLK - 1) ? ((it_) / (NBLK - 1)) * NBLK + 1 + (it_) % (NBLK - 1) : ((it_) - BATCH * NH * (NBLK - 1)) * NBLK)
#define S3_LOAD_IN(u_) do { const int u2_ = (u_); const int blk_ = u2_ % NBLK, bh_ = u2_ / NBLK, h_ = bh_ % NH, b_ = bh_ / NH; const int row0_ = blk_row0(b_, blk_); \
        int tq_ = threadIdx.x; asm volatile("" : "+v"(tq_)); const int lq_ = tq_ & 63; \
        { const bf16* qr_ = P + (size_t)(row0_ + 32 * w + (lq_ & 31)) * PW + h_ * DQK + 8 * (lq_ >> 5); \
          _Pragma("unroll") for (int kk = 0; kk < 8; ++kk) qf[kk] = *(const bf16x8*)(qr_ + 16 * kk); } \
        { const bf16* kr_ = P + (size_t)(row0_ + (tq_ >> 4)) * PW + NQ + h_ * DQK + 8 * (tq_ & 15); \
          _Pragma("unroll") for (int i = 0; i < 8; ++i) kr8[i] = *(const u32x4*)(kr_ + (size_t)(32 * i) * PW); } \
        if (tq_ < 256) { const float* g_ = (const float*)(A.ws + WS_GATE) + (size_t)(row0_ + tq_) * 16 + h_; gl = (f32x4){g_[0], g_[4], g_[8], g_[12]}; } \
        else { const int t2_ = tq_ - 256; gl = (f32x4){NST[(size_t)(u2_ * 2 + (t2_ >> 7)) * DQK + (t2_ & 127)], 0.f, 0.f, 0.f}; } } while (0)
    const int nitems = BATCH * NH * (NBLK - 1) + (ctx_out ? BATCH * NH : 0);
    int it = C.bid;
    if (it < nitems) S3_LOAD_IN(S3_UNIT(it));
    while (it < nitems) {
        const int u = S3_UNIT(it);
        const int blk = u % NBLK, bh = u / NBLK, h = bh % NH, b = bh / NH; const int row0 = blk_row0(b, blk);
        const int itn = it + C.G; const int un = itn < nitems ? S3_UNIT(itn) : u;
        const bf16* vtile = VT + (size_t)vt_tile(b, h, blk) * 65536;
        const bf16* ctile = CST + (size_t)(u * 2) * DQK * DV;
#define S3_DMA(c_) do { const int cc_ = (c_); const bool isv_ = cc_ < 8; int ld_ = threadIdx.x & 63; asm volatile("" : "+v"(ld_)); \
                const unsigned dlp_ = (unsigned)(((ld_ & 3) ^ ((ld_ >> 4) & 3)) * 16), drow_ = (unsigned)(32 * w + (ld_ >> 2)); \
                const unsigned long long gp_ = (unsigned long long)(isv_ ? (const char*)vtile + 16384 * cc_ : (const char*)ctile + (cc_ >= 12 ? 2 * DQK * DV : 0) + 16384 * ((cc_ - 8) & 3)); \
                const char* gb_ = (const char*)(((unsigned long long)(unsigned)__builtin_amdgcn_readfirstlane((int)(unsigned)(gp_ >> 32)) << 32) | (unsigned)__builtin_amdgcn_readfirstlane((int)(unsigned)gp_)); \
                _Pragma("unroll") for (int jj = 0; jj < 2; ++jj) \
                    asm volatile("s_mov_b32 m0, %2\n\ts_nop 0\n\tglobal_load_lds_dwordx4 %0, %1" :: "v"(((drow_ + 16u * jj) << 6) + dlp_), "s"(gb_), "s"((unsigned)(size_t)CH + (unsigned)w * 2048u + (unsigned)((cc_ & 3) * CHB + jj * 1024)) : "memory"); } while (0)
        S3_DMA(0); S3_DMA(1); S3_DMA(2);
        { int tu = threadIdx.x; asm volatile("" : "+v"(tu));
          if (tu < 256) { gf[tu] = gl.x; bf[tu] = gl.y; gb[tu] = gl.z; bb[tu] = gl.w; } else nf[tu - 256] = gl.x;
          { const int pc = tu & 15, s0 = tu >> 4, ps0 = (s0 & ~12) | ((s0 & 4) << 1) | ((s0 & 8) >> 1);
#pragma unroll
            for (int i = 0; i < 8; ++i) *(LAS u32x4*)(Kimg + (ps0 + 32 * i) * KP + pc * 16) = kr8[i]; }
          lds_barrier();
          const int lane = tu & 63, wv = tu >> 6;
          if (wv == 0) { f32x4 x = *(LAS f32x4*)(bf + 4 * lane); x.y += x.x; x.z += x.y; x.w += x.z; const float tot = wave_incl_scan(x.w, lane); const float ex = tot - x.w;
              x.x += ex; x.y += ex; x.z += ex; x.w += ex; *(LAS f32x4*)(bf + 4 * lane) = x; }
          if (wv == 1) { f32x4 y = *(LAS f32x4*)(bb + 4 * (63 - lane)); y.z += y.w; y.y += y.z; y.x += y.y; const float tot = wave_incl_scan(y.x, lane); const float ex = tot - y.x;
              y.x += ex; y.y += ex; y.z += ex; y.w += ex; *(LAS f32x4*)(bb + 4 * (63 - lane)) = y; }
          lds_barrier();
          if (tu < 256) { const float a0 = gf[tu] - bf[tu], a1 = gb[tu] - bb[tu]; gf[tu] = a0; gb[tu] = a1; cf[tu] = __expf(bf[tu | 31] + a0); cb[tu] = __expf(bb[tu & ~31] + a1); }
          lds_barrier(); }
        {
            int lz = threadIdx.x & 63; asm volatile("" : "+v"(lz));
            const int r = lz & 31, hh = lz >> 5;
            const int jt = w;
            const float bfj = bf[32 * jt + r], bbj = bb[32 * jt + r];
            float qnf = 0.f, qnb = 0.f;
#pragma unroll
            for (int kk = 0; kk < 8; ++kk) { u32x4 qq = __builtin_bit_cast(u32x4, qf[kk]); asm volatile("" : "+v"(qq));
                const int d = 16 * kk + 8 * hh;
                const f32x4 n0 = *(const LAS f32x4*)(nf + d), n1 = *(const LAS f32x4*)(nf + d + 4), m0 = *(const LAS f32x4*)(nb + d), m1 = *(const LAS f32x4*)(nb + d + 4);
                qnf += (bflo(qq.x) * n0.x + bfhi(qq.x) * n0.y) + (bflo(qq.y) * n0.z + bfhi(qq.y) * n0.w) + (bflo(qq.z) * n1.x + bfhi(qq.z) * n1.y) + (bflo(qq.w) * n1.z + bfhi(qq.w) * n1.w);
                qnb += (bflo(qq.x) * m0.x + bfhi(qq.x) * m0.y) + (bflo(qq.y) * m0.z + bfhi(qq.y) * m0.w) + (bflo(qq.z) * m1.x + bfhi(qq.z) * m1.y) + (bflo(qq.w) * m1.z + bfhi(qq.w) * m1.w);
                if (kk & 1) asm volatile("" ::: "memory"); }
            qnf += __shfl_xor(qnf, 32); qnb += __shfl_xor(qnb, 32);
            float denf = 0.f, denb = 0.f;
#pragma unroll 1
            for (int kt = 0; kt < 8; ++kt) {
                f32x16 c;
#pragma unroll
                for (int i = 0; i < 16; ++i) c[i] = 0.f;
#pragma unroll
                for (int kk = 0; kk < 8; ++kk) { const bf16x8 a = *(const LAS bf16x8*)(Kimg + (kt * 32 + r) * KP + (16 * kk + 8 * hh) * 2); c = MFMA32(a, qf[kk], c); }
                if (kt == jt) {
#pragma unroll
                    for (int g = 0; g < 4; ++g) { const int sl0 = 16 * (g >> 1) + 8 * hh + 4 * (g & 1);
                        const f32x4 g4f = *(const LAS f32x4*)(gf + kt * 32 + sl0), g4b = *(const LAS f32x4*)(gb + kt * 32 + sl0);
#pragma unroll
                        for (int q = 0; q < 4; ++q) { const int sl = sl0 + q; const float cv = c[4 * g + q];
                            denf += cv * __expf((sl <= r) ? bfj + g4f[q] : -1.0e30f); denb += cv * __expf((sl >= r) ? bbj + g4b[q] : -1.0e30f); } }
                } else {
                    LAS const float* cx = (kt < jt ? cf : cb) + kt * 32 + 8 * hh; float sm = 0.f;
#pragma unroll
                    for (int g = 0; g < 4; ++g) { const f32x4 c4 = *(const LAS f32x4*)(cx + 16 * (g >> 1) + 4 * (g & 1)); sm += (c[4 * g] * c4.x + c[4 * g + 1] * c4.y) + (c[4 * g + 2] * c4.z + c[4 * g + 3] * c4.w); }
                    if (kt < jt) denf += sm * __expf(bfj - bf[kt * 32 + 31]); else denb += sm * __expf(bbj - bb[kt * 32]);
                }
            }
            denf += __shfl_xor(denf, 32); denb += __shfl_xor(denb, 32);
            const float ebf = __expf(bfj), ebb = __expf(bbj);
            denf += ebf * qnf; denb += ebb * qnb;
            const float rf = 1.0f / fmaxf(fabsf(denf), 1.0f), rb = 1.0f / fmaxf(fabsf(denb), 1.0f);
            const float scf = ebf * rf, scb = ebb * rb;
            unsigned wdg[8];
#pragma unroll
            for (int g = 0; g < 4; ++g) { const int sl0 = 16 * (g >> 1) + 8 * hh + 4 * (g & 1);
                const f32x4 g4f = *(const LAS f32x4*)(gf + jt * 32 + sl0), g4b = *(const LAS f32x4*)(gb + jt * 32 + sl0);
                float wv[4];
#pragma unroll
                for (int q = 0; q < 4; ++q) { const int sl = sl0 + q; wv[q] = rf * __expf((sl <= r) ? bfj + g4f[q] : -1.0e30f) + rb * __expf((sl >= r) ? bbj + g4b[q] : -1.0e30f); }
                wdg[2 * g] = cvt2(wv[0], wv[1]); wdg[2 * g + 1] = cvt2(wv[2], wv[3]); }
            f32x16 acc[8];
#pragma unroll
            for (int et = 0; et < 8; ++et)
#pragma unroll
                for (int i = 0; i < 16; ++i) acc[et][i] = 0.f;
            asm volatile("s_waitcnt vmcnt(0)" ::: "memory");
            const int swz = (r >> 2) & 3;
#pragma unroll 1
            for (int ci = 0; ci < 8; ++ci) {
                if (ci) { if (blk == 0 && ci >= 6) { if (ci == 6) asm volatile("s_waitcnt vmcnt(2)" ::: "memory"); else asm volatile("s_waitcnt vmcnt(0)" ::: "memory"); } else asm volatile("s_waitcnt vmcnt(4)" ::: "memory"); }
                lds_barrier();
                if (blk != 0 || ci + 3 < 8) S3_DMA(ci + 3);
                LAS const unsigned char* CHc = CH + (ci & 3) * CHB;
                { const int kt = ci;
                        f32x16 c;
#pragma unroll
                        for (int i = 0; i < 16; ++i) c[i] = 0.f;
#pragma unroll
                        for (int kk = 0; kk < 8; ++kk) { const bf16x8 a = *(const LAS bf16x8*)(Kimg + (kt * 32 + r) * KP + (16 * kk + 8 * hh) * 2); c = MFMA32(a, qf[kk], c); }
                        float p[16];
                        if (kt == jt) {
#pragma unroll
                            for (int i = 0; i < 8; ++i) { p[2 * i] = c[2 * i] * bflo(wdg[i]); p[2 * i + 1] = c[2 * i + 1] * bfhi(wdg[i]); }
                        } else {
                            LAS const float* cx = (kt < jt ? cf : cb) + kt * 32 + 8 * hh;
                            const float rw = (kt < jt) ? rf * __expf(bfj - bf[kt * 32 + 31]) : rb * __expf(bbj - bb[kt * 32]);
#pragma unroll
                            for (int g = 0; g < 4; ++g) { const f32x4 c4 = *(const LAS f32x4*)(cx + 16 * (g >> 1) + 4 * (g & 1));
                                p[4 * g] = c[4 * g] * (c4.x * rw); p[4 * g + 1] = c[4 * g + 1] * (c4.y * rw); p[4 * g + 2] = c[4 * g + 2] * (c4.z * rw); p[4 * g + 3] = c[4 * g + 3] * (c4.w * rw); }
                        }
                        const bf16x8 pa0 = pack8(p[0], p[1], p[2], p[3], p[4], p[5], p[6], p[7]), pa1 = pack8(p[8], p[9], p[10], p[11], p[12], p[13], p[14], p[15]);
#pragma unroll
                        for (int et = 0; et < 8; ++et) { LAS const unsigned char* vb = CHc + (et * 32 + r) * 64;
                            const bf16x8 a0 = *(const LAS bf16x8*)(vb + ((hh ^ swz) << 4)), a1 = *(const LAS bf16x8*)(vb + (((2 + hh) ^ swz) << 4));
                            acc[et] = MFMA32(a0, pa0, acc[et]); acc[et] = MFMA32(a1, pa1, acc[et]);
                            if (et & 1) asm volatile("" ::: "memory"); }
                }
            }
            if (blk != 0) {
#pragma unroll
            for (int ci = 8; ci < 16; ++ci) {
                if (ci <= 13) asm volatile("s_waitcnt vmcnt(4)" ::: "memory"); else if (ci == 14) asm volatile("s_waitcnt vmcnt(2)" ::: "memory"); else asm volatile("s_waitcnt vmcnt(0)" ::: "memory");
                lds_barrier();
                if (ci + 3 < 16) S3_DMA(ci + 3);
                LAS const unsigned char* CHc = CH + (ci & 3) * CHB;
                {
                    const int dir = (ci - 8) >> 2, dq = (ci - 8) & 3;
                    const float sc = dir ? scb : scf;
#pragma unroll
                    for (int k2 = 0; k2 < 2; ++k2) { const u32x4 qq = __builtin_bit_cast(u32x4, qf[2 * dq + k2]);
                        const bf16x8 qs = pack8(bflo(qq.x) * sc, bfhi(qq.x) * sc, bflo(qq.y) * sc, bfhi(qq.y) * sc, bflo(qq.z) * sc, bfhi(qq.z) * sc, bflo(qq.w) * sc, bfhi(qq.w) * sc);
#pragma unroll
                        for (int et = 0; et < 8; ++et) { const bf16x8 a = *(const LAS bf16x8*)(CHc + (et * 32 + r) * 64 + (((2 * k2 + hh) ^ swz) << 4)); acc[et] = MFMA32(a, qs, acc[et]);
                            if ((et & 3) == 3) asm volatile("" ::: "memory"); } }
                }
            }
            }
            u32x4 ov[16]; f32x4 g0, g1;
            { int tz = threadIdx.x & 63; asm volatile("" : "+v"(tz)); const int pc = tz & 31, lr0 = tz >> 5;
              g0 = *(const f32x4*)(hg + h * DV + 8 * pc); g1 = *(const f32x4*)(hg + h * DV + 8 * pc + 4);
#pragma unroll
              for (int i = 0; i < 16; ++i) ov[i] = *(const u32x4*)(P + (size_t)(row0 + 32 * w + lr0 + 2 * i) * PW + 2 * NQ + NV + h * DV + 8 * pc); }
            float ss = 0.f;
#pragma unroll
            for (int et = 0; et < 8; ++et)
#pragma unroll
                for (int i = 0; i < 16; ++i) ss += acc[et][i] * acc[et][i];
            ss += __shfl_xor(ss, 32);
            const float rs = 1.0f / sqrtf(ss * (1.0f / DV) + EPS);
            lds_barrier();
            { LAS unsigned char* ob = OUT + (w * 32 + r) * OP + (4 * hh) * 2;
#pragma unroll
              for (int et = 0; et < 8; ++et)
#pragma unroll
                  for (int g = 0; g < 4; ++g) { u32x2 o; o.x = cvt2(acc[et][4 * g + 0] * rs, acc[et][4 * g + 1] * rs); o.y = cvt2(acc[et][4 * g + 2] * rs, acc[et][4 * g + 3] * rs);
                      *(LAS u32x2*)(ob + (et * 32 + 8 * g) * 2) = o; } }
            asm volatile("s_waitcnt lgkmcnt(0)" ::: "memory");
            S3_LOAD_IN(un);
            { int tz = threadIdx.x & 63; asm volatile("" : "+v"(tz)); const int pc = tz & 31, lr0 = tz >> 5;
#pragma unroll
              for (int i = 0; i < 16; ++i) { const int lr = 32 * w + lr0 + 2 * i; const int grow = row0 + lr;
                  const u32x4 hv = *(const LAS u32x4*)(OUT + lr * OP + pc * 16);
                  const f32x4 o0 = (f32x4){bflo(hv.x) * g0.x * bflo(ov[i].x), bfhi(hv.x) * g0.y * bfhi(ov[i].x), bflo(hv.y) * g0.z * bflo(ov[i].y), bfhi(hv.y) * g0.w * bfhi(ov[i].y)};
                  const f32x4 o1 = (f32x4){bflo(hv.z) * g1.x * bflo(ov[i].z), bfhi(hv.z) * g1.y * bfhi(ov[i].z), bflo(hv.w) * g1.z * bflo(ov[i].w), bfhi(hv.w) * g1.w * bfhi(ov[i].w)};
                  *(u32x2*)(HM + (size_t)grow * D + h * DV + 8 * pc) = (u32x2){pack_i8(o0 * (127.0f / HMR)), pack_i8(o1 * (127.0f / HMR))};
                  if ((i & 3) == 3) asm volatile("" ::: "memory"); } }
        }
#undef S3_DMA
        lds_barrier();
        it = itn;
    }
#undef S3_LOAD_IN
#undef S3_UNIT
}

#define XB_TMO      128
#define XB_XCNT(j)  (256  + 64 * (j))
#define XB_XSUB(j)  (1280 + 64 * (j))
#define XB_XGEN(j)  (2304 + 64 * (j))
#define XB_TOP      3328
#define XB_TOPGEN   3392
#define XCD_BAR_WORDS 3456
#define XB_SPIN_CAP (1u << 18)

__device__ __forceinline__ unsigned xb_ld(unsigned* p)              { return __hip_atomic_load(p, __ATOMIC_RELAXED, __HIP_MEMORY_SCOPE_AGENT); }
__device__ __forceinline__ unsigned xb_add(unsigned* p, unsigned v) { return __hip_atomic_fetch_add(p, v, __ATOMIC_RELAXED, __HIP_MEMORY_SCOPE_AGENT); }
__device__ __forceinline__ unsigned xb_xcc_id() { return (unsigned)__builtin_amdgcn_s_getreg((3 << 11) | 20) & 0xFu; }
#define XB_SPIN(cond, bar) do { unsigned _sp = 0; while (cond) { __builtin_amdgcn_s_sleep(1); \
    if ((++_sp & 255u) == 0u) { if (xb_ld(&(bar)[XB_TMO])) break; if (_sp > XB_SPIN_CAP) { atomicAdd(&(bar)[XB_TMO], 1u); break; } } } } while (0)

struct XcdBarrier {
    unsigned* bar; unsigned x;
    volatile LAS unsigned* st;
};

__device__ __forceinline__ XcdBarrier xcd_barrier_post(unsigned* bar, volatile LAS unsigned* st) {
    XcdBarrier b; b.bar = bar; b.x = xb_xcc_id(); b.st = st;
    if (threadIdx.x == 0) (void)xb_add(&bar[XB_XCNT(b.x)], 1u);
    return b;
}
__device__ __forceinline__ void xcd_barrier_complete(unsigned* bar, unsigned x, unsigned& nloc, unsigned& nx) {
    const unsigned G = gridDim.x * gridDim.y * gridDim.z;
    unsigned sum, cnt, mine, sp = 0u;
    for (;;) {
        sum = 0u; cnt = 0u; mine = 0u;
#pragma unroll
        for (unsigned j = 0; j < 16; ++j) { const unsigned c = xb_ld(&bar[XB_XCNT(j)]); sum += c; cnt += (c > 0u) ? 1u : 0u; mine = (j == x) ? c : mine; }
        if (sum == G) break;
        __builtin_amdgcn_s_sleep(1);
        if ((++sp & 255u) == 0u) { if (xb_ld(&bar[XB_TMO])) break; if (sp > XB_SPIN_CAP) { atomicAdd(&bar[XB_TMO], 1u); break; } }
    }
    nloc = mine > 0u ? mine : 1u; nx = cnt > 0u ? cnt : 1u;
}

__device__ __forceinline__ void xcd_barrier(const XcdBarrier& b) {
    asm volatile("s_waitcnt vmcnt(0)" ::: "memory");
    __syncthreads();
    if (threadIdx.x == 0) {
        unsigned* bar = b.bar;
        __builtin_amdgcn_s_waitcnt(0);
        unsigned nloc = b.st[0], nx = b.st[1];
        if (nloc == 0u) { xcd_barrier_complete(bar, b.x, nloc, nx); b.st[0] = nloc; b.st[1] = nx; }
        const unsigned old = xb_add(&bar[XB_XSUB(b.x)], 1u);
        const unsigned gen = old / nloc;
        if (old + 1u == (gen + 1u) * nloc) {
            __builtin_amdgcn_fence(__ATOMIC_RELEASE, "agent");
            asm volatile("s_waitcnt vmcnt(0)" ::: "memory");
            const unsigned og = xb_add(&bar[XB_TOP], 1u);
            const unsigned tg = og / nx;
            if (og + 1u == (tg + 1u) * nx) xb_add(&bar[XB_TOPGEN], 1u);
            else XB_SPIN(xb_ld(&bar[XB_TOPGEN]) == tg, bar);
            __builtin_amdgcn_fence(__ATOMIC_ACQUIRE, "agent");
            xb_add(&bar[XB_XGEN(b.x)], 1u);
            asm volatile("s_waitcnt vmcnt(0)" ::: "memory");
        } else {
            XB_SPIN(xb_ld(&bar[XB_XGEN(b.x)]) == gen, bar);
            __builtin_amdgcn_fence(__ATOMIC_ACQUIRE, "agent");
            asm volatile("s_waitcnt vmcnt(0)" ::: "memory");
        }
    }
    __syncthreads();
}


constexpr int LDS_BYTES = 152 * 1024;
constexpr int CW_BAR = 16384;
static_assert((CW_BAR + XCD_BAR_WORDS) * 4 <= (int)CTL_BYTES, "ctl");
#ifndef MK_MULTI
#define MK_MULTI 0
#endif
#define IN(p) (lo <= (p) && (p) < hi)
#define SEAM(p) do { if ((p) + 1 < hi) { XcdBarrier b_; b_.bar = (unsigned*)(load_args().ws + WS_CTL) + CW_BAR; b_.x = xb_xcc_id(); b_.st = (volatile LAS unsigned*)(C.lds + LDS_BYTES - 16); xcd_barrier(b_); } } while (0)
#define CAS __attribute__((address_space(4)))
__device__ __forceinline__ Args load_args() {
#if defined(__HIP_DEVICE_COMPILE__)
    const CAS Args* p = (const CAS Args*)__builtin_amdgcn_kernarg_segment_ptr(); asm volatile("" : "+s"(p));
    Args a; for (int i = 0; i < 22; ++i) a.in[i] = p->in[i]; a.out = p->out; a.ws = p->ws; a.lo = p->lo; a.hi = p->hi; return a;
#else
    return Args{};
#endif
}
__device__ __forceinline__ Ctx fresh(const Ctx& C) { Ctx R = C; int tz = threadIdx.x; asm volatile("" : "+v"(tz)); R.tid = tz; R.lane = tz & 63; return R; }
template <int L> __device__ __forceinline__ void layer_phases(const Args& args, const Ctx& C, int bar, int lo, int hi) {
    constexpr int pb = 16 * L;
    if (IN(pb + 1)) { phase_r1(load_args(), fresh(C), L); SEAM(pb + 1); }
    if (IN(pb + 2)) { phase_g1(load_args(), fresh(C), L); SEAM(pb + 2); }
    if constexpr ((L & 1) == 0) {
        if (IN(pb + 3)) { phase_s1(load_args(), fresh(C), L); SEAM(pb + 3); }
        if (IN(pb + 4)) { phase_s2(load_args(), fresh(C)); SEAM(pb + 4); }
        if (IN(pb + 5)) { phase_s3(load_args(), fresh(C), L); SEAM(pb + 5); }
    } else {
        if (IN(pb + 3)) { phase_conv(load_args(), fresh(C), L); SEAM(pb + 3); }
    }
    if (IN(pb + 6)) { phase_g2(load_args(), fresh(C), L); SEAM(pb + 6); }
    if (IN(pb + 7)) { phase_r2(load_args(), fresh(C), L); SEAM(pb + 7); }
    if (IN(pb + 8)) { phase_m1(load_args(), fresh(C), L); SEAM(pb + 8); }
    if (IN(pb + 9)) { phase_m2(load_args(), fresh(C), L); SEAM(pb + 9); }
}
__global__ void __launch_bounds__(NT, 2) fwd_kernel(Args args) {
    extern __shared__ __attribute__((aligned(16))) unsigned char lds_raw[];
    Ctx C; C.lds = (LAS unsigned char*)lds_raw; C.tid = threadIdx.x; C.lane = C.tid & 63; C.wave = __builtin_amdgcn_readfirstlane(C.tid >> 6); C.G = gridDim.x; C.bid = blockIdx.x; C.a = &args;
    const int lo = args.lo, hi = args.hi;
    volatile LAS unsigned* xbw = (volatile LAS unsigned*)(C.lds + LDS_BYTES - 16);
    if (C.tid < 4) xbw[C.tid] = 0u;
    __syncthreads();
    if (hi - lo > 1) (void)xcd_barrier_post((unsigned*)(args.ws + WS_CTL) + CW_BAR, xbw);
    const int bar = 0; (void)bar;
    if (IN(0)) { phase_mod(load_args(), fresh(C)); __syncthreads(); phase_cvt_mixer(load_args(), fresh(C)); SEAM(0); }
    layer_phases<0>(args, C, bar, lo, hi);
    layer_phases<1>(args, C, bar, lo, hi);
    layer_phases<2>(args, C, bar, lo, hi);
    layer_phases<3>(args, C, bar, lo, hi);
    if (IN(64)) phase_final(load_args(), fresh(C));
}
#undef IN
#undef SEAM

extern "C" void kernel_launch(void* const* d_in, const int* in_sizes, int n_in, void* d_out, int out_size, void* d_ws, size_t ws_size, hipStream_t stream) {
    static int grid = 0;
    if (grid == 0) {
        if (n_in != 22 || out_size != NL * D || ws_size < WS_END) { fprintf(stderr, "kernel_launch: unexpected shapes (n_in %d out %d ws %zu)\n", n_in, out_size, ws_size); grid = -1; return; }
        int dev = 0, cus = 0, per_cu = 0;
        if (hipGetDevice(&dev) != hipSuccess || hipDeviceGetAttribute(&cus, hipDeviceAttributeMultiprocessorCount, dev) != hipSuccess) { grid = -1; return; }
        if (hipFuncSetAttribute((const void*)fwd_kernel, hipFuncAttributeMaxDynamicSharedMemorySize, LDS_BYTES) != hipSuccess) { grid = -1; return; }
        if (hipOccupancyMaxActiveBlocksPerMultiprocessor(&per_cu, (const void*)fwd_kernel, NT, LDS_BYTES) != hipSuccess || per_cu < 1) { fprintf(stderr, "kernel_launch: occupancy query says %d\n", per_cu); }
        (void)hipGetLastError();
        grid = cus;
    }
    if (grid < 0) return;
    (void)hipMemsetAsync((char*)d_ws + WS_CTL, 0, CTL_BYTES, stream);
    Args a{};
    for (int i = 0; i < 22; ++i) a.in[i] = (const float*)d_in[i];
    a.out = (float*)d_out; a.ws = (unsigned char*)d_ws;
#if MK_MULTI
    int phases[64]; int np = 0;
    phases[np++] = 0;
    for (int l = 0; l < DEPTH; ++l) { const int pb = 16 * l; phases[np++] = pb + 1; phases[np++] = pb + 2; phases[np++] = pb + 3;
        if ((l & 1) == 0) { phases[np++] = pb + 4; phases[np++] = pb + 5; }
        phases[np++] = pb + 6; phases[np++] = pb + 7; phases[np++] = pb + 8; phases[np++] = pb + 9; }
    phases[np++] = 64;
    for (int i = 0; i < np; ++i) { a.lo = phases[i]; a.hi = phases[i] + 1; hipLaunchKernelGGL(fwd_kernel, dim3(grid), dim3(NT), LDS_BYTES, stream, a); }
#else
    a.lo = 0; a.hi = 65;
    hipLaunchKernelGGL(fwd_kernel, dim3(grid), dim3(NT), LDS_BYTES, stream, a);
#ifdef PROBE_PHASES
    { const int pp[] = {PROBE_PHASES};
      for (int rep = 0; rep < PROBE_REPS; ++rep) for (unsigned i = 0; i < sizeof(pp) / sizeof(pp[0]); ++i) { a.lo = pp[i]; a.hi = pp[i] + 1; hipLaunchKernelGGL(fwd_kernel, dim3(grid), dim3(NT), LDS_BYTES, stream, a); } }
#endif
#endif
}
```

```cpp
#include <hip/hip_runtime.h>
#include <cstdio>
#include <cstdint>

#define LAS __attribute__((address_space(3)))
typedef unsigned short bf16;
typedef float f32x4 __attribute__((ext_vector_type(4)));
typedef unsigned u32x4 __attribute__((ext_vector_type(4)));
typedef unsigned u32x2 __attribute__((ext_vector_type(2)));
typedef int i32x4r __attribute__((ext_vector_type(4)));

constexpr int D = 1024, BATCH = 2, SEQ = 16384, DEPTH = 4, CTXL = 256;
constexpr int NL = BATCH * SEQ, NCX = BATCH * CTXL, NR = NL + NCX;
constexpr int NH = 4, DQK = 128, DV = 256, NQ = 512, NV = 1024, PROJ = 3088, PW = 3072;
constexpr int NGRP = 4, EPG = 8, NE = 32, DE = 512;
constexpr int NBLK = 65;
constexpr int NUNIT = BATCH * NH * NBLK;
constexpr int CAP = NR;
constexpr int YROWS = 74752;
constexpr float EPS = 1e-6f;
constexpr float WSCALE = 32.0f;
constexpr float YSCALE = 4.0f;
constexpr int NT = 512, NW = 8;
constexpr int LDS_TAB_END = 152 * 1024 - 16;

constexpr size_t MiB = 1u << 20;
constexpr size_t WS_CTL = 0, CTL_BYTES = 1 * MiB;
constexpr size_t WS_MOD = 1 * MiB;
constexpr size_t WS_GATE = 2 * MiB;
constexpr size_t WS_TOKSLOT = 5 * MiB;
constexpr size_t WS_TOKW = 6 * MiB;
constexpr size_t WS_SLOTTOK = 7 * MiB;
constexpr size_t WS_DN = 12 * MiB;
constexpr size_t WS_NST = 13 * MiB;
constexpr size_t WS_BTOT = 14 * MiB;
constexpr size_t WS_RSC = 15 * MiB;
constexpr size_t WS_LAT = 16 * MiB;
constexpr size_t WS_HB = 146 * MiB;
constexpr size_t WS_PB = 211 * MiB;
constexpr size_t WS_HM = 406 * MiB;
constexpr size_t WS_DC = 471 * MiB;
constexpr size_t WS_CST = 601 * MiB;
constexpr size_t WS_VT = 666 * MiB;
constexpr size_t WS_WAIN = 731 * MiB;
constexpr size_t WS_WBIN = 743 * MiB;
constexpr size_t WS_WAOUT = 755 * MiB;
constexpr size_t WS_WBOUT = 759 * MiB;
constexpr size_t WS_WGU = 763 * MiB;
constexpr size_t WS_WDN = 827 * MiB;
constexpr size_t WS_H8 = 843 * MiB;
constexpr size_t WS_END = 880 * MiB;
constexpr int CW_WMAX = 256;
constexpr int CW_CNT = 1024, CNT_STRIDE = 64;

struct Args { const float* in[22]; float* out; unsigned char* ws; int lo, hi; };

typedef short bf16x8 __attribute__((ext_vector_type(8)));
typedef float f32x2 __attribute__((ext_vector_type(2)));
typedef __bf16 bf16x2_t __attribute__((ext_vector_type(2)));
__device__ __forceinline__ unsigned cvt2(float lo, float hi) { const f32x2 v = {lo, hi}; return __builtin_bit_cast(unsigned, __builtin_convertvector(v, bf16x2_t)); }
__device__ __forceinline__ float bf2f(bf16 v) { return __uint_as_float(((unsigned)v) << 16); }
__device__ __forceinline__ unsigned f2bf(float f) { return cvt2(f, 0.f) & 0xffffu; }
__device__ __forceinline__ unsigned pk2(float lo, float hi) { return cvt2(lo, hi); }
template <int CTRL, int ROWMASK> __device__ __forceinline__ float dpp_mov(float x) { return __int_as_float(__builtin_amdgcn_update_dpp(0, __float_as_int(x), CTRL, ROWMASK, 0xf, false)); }
__device__ __forceinline__ float wave_sum(float v) {
    v += dpp_mov<0xB1, 0xf>(v); v += dpp_mov<0x4E, 0xf>(v); v += dpp_mov<0x141, 0xf>(v); v += dpp_mov<0x140, 0xf>(v);
    v += dpp_mov<0x142, 0xA>(v); v += dpp_mov<0x143, 0xC>(v);
    return __int_as_float(__builtin_amdgcn_readlane(__float_as_int(v), 63));
}
__device__ __forceinline__ float wave_max_nn(float v) {
    v = fmaxf(v, dpp_mov<0xB1, 0xf>(v)); v = fmaxf(v, dpp_mov<0x4E, 0xf>(v)); v = fmaxf(v, dpp_mov<0x141, 0xf>(v)); v = fmaxf(v, dpp_mov<0x140, 0xf>(v));
    v = fmaxf(v, dpp_mov<0x142, 0xA>(v)); v = fmaxf(v, dpp_mov<0x143, 0xC>(v));
    return __int_as_float(__builtin_amdgcn_readlane(__float_as_int(v), 63));
}
__device__ __forceinline__ unsigned pack_i8_nc(f32x4 v) {
    const unsigned a = __float_as_uint(v.x + 12582912.0f), b = __float_as_uint(v.y + 12582912.0f), c = __float_as_uint(v.z + 12582912.0f), d = __float_as_uint(v.w + 12582912.0f);
    return __builtin_amdgcn_perm(__builtin_amdgcn_perm(d, c, 0x0c0c0400u) , __builtin_amdgcn_perm(b, a, 0x0c0c0400u), 0x05040100u);
}
__device__ __forceinline__ unsigned pack_i8(f32x4 v) {
    return pack_i8_nc((f32x4){__builtin_amdgcn_fmed3f(v.x, -127.f, 127.f), __builtin_amdgcn_fmed3f(v.y, -127.f, 127.f), __builtin_amdgcn_fmed3f(v.z, -127.f, 127.f), __builtin_amdgcn_fmed3f(v.w, -127.f, 127.f)});
}
__device__ __forceinline__ float sigmoidf_(float x) { return 1.f / (1.f + __expf(-x)); }
__device__ __forceinline__ float siluf_(float x) { return x / (1.f + __expf(-x)); }
__device__ __forceinline__ float logsigmoidf_(float x) { return fminf(x, 0.f) - log1pf(__expf(-fabsf(x))); }
__device__ __forceinline__ int blk_row0(int b, int blk) { return blk == 0 ? NL + b * CTXL : b * SEQ + (blk - 1) * 256; }
__device__ __forceinline__ int mod_vec_of_row(int row) { return row < NL ? row / SEQ : 2; }

struct Ctx {
    LAS unsigned char* lds; int tid, lane, wave, G, bid;
    const Args* a;
};

__device__ __forceinline__ int expert_block_prefix(const unsigned* cnt, int lane, int& nb) {
    nb = lane < NE ? ((int)cnt[lane * CNT_STRIDE] + 255) / 256 : 0; int v = nb;
#pragma unroll
    for (int o = 1; o < 64; o <<= 1) { const int t = __shfl_up(v, o); v += (lane >= o) ? t : 0; }
    return v - nb;
}
__device__ __forceinline__ void slot_bases(const Args& A, int l, LAS int* sb, int tid) {
    if (tid < 64) { int nb; const int ex = expert_block_prefix((const unsigned*)(A.ws + WS_CTL) + CW_CNT + l * 32 * CNT_STRIDE, tid, nb); if (tid <= NE) sb[tid] = ex * 256; }
    __syncthreads();
}

__device__ __forceinline__ void phase_mod(const Args& A, const Ctx& C) {
    LAS float* sc = (LAS float*)C.lds;
    LAS float* red = sc + 3072;
    const float* c = A.in[1]; const float* cc = A.in[3];
    for (int i = C.tid; i < 3072; i += NT) { const float v = i < 2048 ? c[i] : cc[i - 2048]; sc[i] = siluf_(v); }
    __syncthreads();
    float* MOD = (float*)(A.ws + WS_MOD);
    for (int u = C.bid; u < DEPTH * 192; u += C.G) {
        const int l = u / 192, cg = u % 192, col = cg * 32 + (C.lane & 31), kh = C.lane >> 5;
        const float* w = A.in[4] + (size_t)l * D * 6 * D + col + (size_t)(C.wave * 128 + kh * 64) * 6 * D;
        float wv[64];
#pragma unroll
        for (int k = 0; k < 64; ++k) wv[k] = w[(size_t)k * 6 * D];
        LAS const float* s0 = sc + C.wave * 128 + kh * 64;
        float a0 = 0.f, a1 = 0.f, a2 = 0.f;
#pragma unroll
        for (int k = 0; k < 64; ++k) { a0 += s0[k] * wv[k]; a1 += s0[1024 + k] * wv[k]; a2 += s0[2048 + k] * wv[k]; }
        a0 += __shfl_xor(a0, 32); a1 += __shfl_xor(a1, 32); a2 += __shfl_xor(a2, 32);
        if (kh == 0) { red[(C.wave * 3 + 0) * 64 + C.lane] = a0; red[(C.wave * 3 + 1) * 64 + C.lane] = a1; red[(C.wave * 3 + 2) * 64 + C.lane] = a2; }
        __syncthreads();
        if (C.tid < 96) { const int v = C.tid / 32, ln = C.tid % 32; float s = 0.f;
            for (int w8 = 0; w8 < 8; ++w8) s += red[(w8 * 3 + v) * 64 + ln];
            MOD[(size_t)(l * 3 + v) * 6 * D + cg * 32 + ln] = s + A.in[5][(size_t)l * 6 * D + cg * 32 + ln]; }
        __syncthreads();
    }
}
__device__ __forceinline__ void load_row_f32(const float* p, int lane, f32x4 (&v)[4]) {
#pragma unroll
    for (int j = 0; j < 4; ++j) v[j] = *(const f32x4*)(p + 4 * lane + 256 * j);
}
__device__ __forceinline__ void load_row_bf16(const bf16* p, int lane, f32x4 (&v)[4]) {
#pragma unroll
    for (int j = 0; j < 4; ++j) { const u32x2 w = *(const u32x2*)(p + 4 * lane + 256 * j);
        v[j] = (f32x4){__uint_as_float(w.x << 16), __uint_as_float(w.x & 0xffff0000u), __uint_as_float(w.y << 16), __uint_as_float(w.y & 0xffff0000u)}; }
}
__device__ __forceinline__ void store_row_bf16(bf16* p, int lane, const f32x4 (&v)[4]) {
#pragma unroll
    for (int j = 0; j < 4; ++j) { u32x2 w; w.x = pk2(v[j].x, v[j].y); w.y = pk2(v[j].z, v[j].w); *(u32x2*)(p + 4 * lane + 256 * j) = w; }
}
constexpr int CVT_IG = (D / 64) * (DE / 32), CVT_ID = (DE / 64) * (D / 32), CVT_PER = 2 * CVT_IG + CVT_ID, CVT_ITEMS = NE * CVT_PER;
constexpr int CVT_Q = 24;
__device__ __forceinline__ void cvt_moe_items(const Args& A, const Ctx& C, int l, int it0, int end, int stride);
__device__ __forceinline__ void cvt_win_i8(const Args& A, const Ctx& C);
__device__ __forceinline__ int cvt_t2(int l, int G);
struct RowVec { f32x4 a[4], s[4], g[4]; };
__device__ __forceinline__ void load_rowvec(RowVec& R, const float* ng, const float* sh, const float* sc, const float* gt, int lane) {
    f32x4 n[4], c[4]; load_row_f32(ng, lane, n); load_row_f32(sc, lane, c); load_row_f32(sh, lane, R.s); if (gt) load_row_f32(gt, lane, R.g);
#pragma unroll
    for (int q = 0; q < 4; ++q) R.a[q] = n[q] * (1.f + c[q]);
}
__device__ __forceinline__ void load_row_bf16raw(const bf16* p, int lane, u32x2 (&v)[4]) {
#pragma unroll
    for (int j = 0; j < 4; ++j) v[j] = *(const u32x2*)(p + 4 * lane + 256 * j);
}
__device__ __forceinline__ void store_row_fp8(unsigned char* p, int lane, const f32x4 (&v)[4]) {
#pragma unroll
    for (int j = 0; j < 4; ++j) { int w = 0; w = __builtin_amdgcn_cvt_pk_fp8_f32(v[j].x, v[j].y, w, false); w = __builtin_amdgcn_cvt_pk_fp8_f32(v[j].z, v[j].w, w, true); *(unsigned*)(p + 4 * lane + 256 * j) = (unsigned)w; }
}
__device__ __forceinline__ void load_row_fp8raw(const unsigned char* p, int lane, unsigned (&v)[4]) {
#pragma unroll
    for (int j = 0; j < 4; ++j) v[j] = *(const unsigned*)(p + 4 * lane + 256 * j);
}
__device__ __forceinline__ f32x4 fp8x4(unsigned w) { const f32x2 lo = __builtin_amdgcn_cvt_pk_f32_fp8((int)w, false), hi = __builtin_amdgcn_cvt_pk_f32_fp8((int)w, true); return (f32x4){lo.x, lo.y, hi.x, hi.y}; }
__device__ __forceinline__ f32x4 bf4(u32x2 w) { return (f32x4){__uint_as_float(w.x << 16), __uint_as_float(w.x & 0xffff0000u), __uint_as_float(w.y << 16), __uint_as_float(w.y & 0xffff0000u)}; }
__device__ __forceinline__ float row_rstd(const f32x4 (&v)[4]) {
    float s = 0.f;
#pragma unroll
    for (int j = 0; j < 4; ++j) s += (v[j].x * v[j].x + v[j].y * v[j].y) + (v[j].z * v[j].z + v[j].w * v[j].w);
    return 1.0f / sqrtf(wave_sum(s) * (1.f / D) + EPS);
}

__device__ __forceinline__ void phase_r1(const Args& A, const Ctx& C, int l) {
    LAS int* sb = (LAS int*)C.lds;
    constexpr int GWP = 2064;
    LAS unsigned char* GW = C.lds + 256;
    LAS unsigned char* HS = C.lds + 256 + 16 * GWP + C.wave * 2 * GWP;
    const bool mls = (l & 1) == 0; const int j = l >> 1;
    if (l == 0) { cvt_win_i8(A, C); __syncthreads(); }
    if (l > 0) slot_bases(A, l - 1, sb, C.tid);
    if (mls) { const float* w = A.in[8] + (size_t)j * D * PROJ + PW;
        f32x4 t[2][4];
#pragma unroll
        for (int jj = 0; jj < 2; ++jj)
#pragma unroll
            for (int q = 0; q < 4; ++q) t[jj][q] = *(const f32x4*)(w + (size_t)(C.tid + NT * jj) * PROJ + 4 * q);
#pragma unroll
        for (int jj = 0; jj < 2; ++jj)
#pragma unroll
            for (int q = 0; q < 4; ++q) { const int k = C.tid + NT * jj;
#pragma unroll
                for (int c = 0; c < 4; ++c) *(LAS unsigned short*)(GW + (4 * q + c) * GWP + k * 2) = (unsigned short)f2bf(t[jj][q][c]); }
        __syncthreads(); }
    const int nrows = (l <= 2) ? NR : NL;
    bf16* LAT = (bf16*)(A.ws + WS_LAT); unsigned char* HI8 = A.ws + WS_H8; float* RSC = (float*)(A.ws + WS_RSC); float* GATE = (float*)(A.ws + WS_GATE);
    const float* MOD = (const float*)(A.ws + WS_MOD); const unsigned char* Y8 = A.ws + WS_PB;
    const int* TS = (const int*)(A.ws + WS_TOKSLOT); const float* TW = (const float*)(A.ws + WS_TOKW);
    const int rpw = (((nrows + C.G - 1) / C.G) + 1) & ~1; const int wrow0 = C.bid * rpw; const int wend = min(wrow0 + rpw, nrows);
    for (int sa = wrow0; sa < wend;) {
        const int mvi = mod_vec_of_row(sa); const int bnd = mvi == 0 ? SEQ : (mvi == 1 ? NL : NR); const int sbnd = min(wend, bnd);
        RowVec RV; { const float* mv = MOD + (size_t)(l * 3 + mvi) * 6 * D;
            load_rowvec(RV, A.in[6] + (size_t)(l * 2 + 0) * D, mv + 0 * D, mv + 1 * D, l > 0 ? MOD + (size_t)((l - 1) * 3 + mvi) * 6 * D + 5 * D : nullptr, C.lane); }
        const int rlast = sbnd - 2; const int rfirst = sa + 2 * C.wave;
        i32x4r ts1 = (i32x4r){0, 0, 0, 0}, ts2 = ts1; f32x4 tw1 = (f32x4){0.f, 0.f, 0.f, 0.f}, tw2 = tw1;
        u32x2 nla[4], nlb[4]; unsigned nya0[4], nya1[4], nyb0[4], nyb1[4]; f32x4 nxa[4], nxb[4];
#define R1_FETCH(r_, ts_) do { const int fa_ = (r_), fb_ = fa_ + 1; \
            if (l == 0) { load_row_f32(fa_ < NL ? A.in[0] + (size_t)fa_ * D : A.in[2] + (size_t)(fa_ - NL) * D, C.lane, nxa); load_row_f32(fb_ < NL ? A.in[0] + (size_t)fb_ * D : A.in[2] + (size_t)(fb_ - NL) * D, C.lane, nxb); } \
            else { load_row_bf16raw(LAT + (size_t)fa_ * D, C.lane, nla); load_row_bf16raw(LAT + (size_t)fb_ * D, C.lane, nlb); \
                load_row_fp8raw(Y8 + (size_t)(sb[(ts_).x >> 20] + ((ts_).x & 0xfffff)) * D, C.lane, nya0); load_row_fp8raw(Y8 + (size_t)(sb[(ts_).y >> 20] + ((ts_).y & 0xfffff)) * D, C.lane, nya1); \
                load_row_fp8raw(Y8 + (size_t)(sb[(ts_).z >> 20] + ((ts_).z & 0xfffff)) * D, C.lane, nyb0); load_row_fp8raw(Y8 + (size_t)(sb[(ts_).w >> 20] + ((ts_).w & 0xfffff)) * D, C.lane, nyb1); } } while (0)
        if (l > 0) { const int r0 = min(rfirst, rlast), r1 = min(rfirst + 2 * NW, rlast);
            ts1 = *(const i32x4r*)(TS + r0 * 2); tw1 = *(const f32x4*)(TW + r0 * 2); ts2 = *(const i32x4r*)(TS + r1 * 2); tw2 = *(const f32x4*)(TW + r1 * 2); }
        R1_FETCH(min(rfirst, rlast), ts1);
        for (int ra = rfirst; ra < sbnd; ra += 2 * NW) {
            const bool hasb = true; const int rb = ra + 1;
            f32x4 va[4], vb[4];
            if (l == 0) {
#pragma unroll
                for (int q = 0; q < 4; ++q) { va[q] = nxa[q]; vb[q] = nxb[q]; }
                R1_FETCH(min(ra + 2 * NW, rlast), ts1);
            } else {
                u32x2 la[4], lb[4]; unsigned ya0[4], ya1[4], yb0[4], yb1[4];
#pragma unroll
                for (int q = 0; q < 4; ++q) { la[q] = nla[q]; lb[q] = nlb[q]; ya0[q] = nya0[q]; ya1[q] = nya1[q]; yb0[q] = nyb0[q]; yb1[q] = nyb1[q]; }
                const f32x4 twc = tw1;
                ts1 = ts2; tw1 = tw2;
                { const int r2 = min(ra + 4 * NW, rlast); ts2 = *(const i32x4r*)(TS + r2 * 2); tw2 = *(const f32x4*)(TW + r2 * 2); }
                R1_FETCH(min(ra + 2 * NW, rlast), ts1);
                const float wa0 = twc.x * (1.0f / YSCALE), wa1 = twc.y * (1.0f / YSCALE), wb0 = twc.z * (1.0f / YSCALE), wb1 = twc.w * (1.0f / YSCALE);
#pragma unroll
                for (int q = 0; q < 4; ++q) { va[q] = bf4(la[q]) + RV.g[q] * (fp8x4(ya0[q]) * wa0 + fp8x4(ya1[q]) * wa1); vb[q] = bf4(lb[q]) + RV.g[q] * (fp8x4(yb0[q]) * wb0 + fp8x4(yb1[q]) * wb1); }
            }
            store_row_bf16(LAT + (size_t)ra * D, C.lane, va); if (hasb) store_row_bf16(LAT + (size_t)rb * D, C.lane, vb);
            const float rra = row_rstd(va), rrb = row_rstd(vb);
            f32x4 ha[4], hb[4];
#pragma unroll
            for (int q = 0; q < 4; ++q) { ha[q] = (va[q] * rra) * RV.a[q] + RV.s[q]; hb[q] = (vb[q] * rrb) * RV.a[q] + RV.s[q]; }
            { float ma = 0.f, mb = 0.f;
#pragma unroll
              for (int q = 0; q < 4; ++q) { ma = fmaxf(ma, fmaxf(fmaxf(fabsf(ha[q].x), fabsf(ha[q].y)), fmaxf(fabsf(ha[q].z), fabsf(ha[q].w)))); mb = fmaxf(mb, fmaxf(fmaxf(fabsf(hb[q].x), fabsf(hb[q].y)), fmaxf(fabsf(hb[q].z), fabsf(hb[q].w)))); }
              ma = fmaxf(wave_max_nn(ma), 1.0e-20f); mb = fmaxf(wave_max_nn(mb), 1.0e-20f);
              const float ia = 127.0f / ma, ib = 127.0f / mb;
#pragma unroll
              for (int q = 0; q < 4; ++q) { *(unsigned*)(HI8 + (size_t)ra * D + 4 * C.lane + 256 * q) = pack_i8_nc(ha[q] * ia); *(unsigned*)(HI8 + (size_t)rb * D + 4 * C.lane + 256 * q) = pack_i8_nc(hb[q] * ib); }
              if (C.lane == 0) { RSC[ra] = ma * (1.0f / 127.0f); RSC[rb] = mb * (1.0f / 127.0f); } }
            if (mls) {
#pragma unroll
                for (int q = 0; q < 4; ++q) { *(LAS u32x2*)(HS + (4 * C.lane + 256 * q) * 2) = (u32x2){cvt2(ha[q].x, ha[q].y), cvt2(ha[q].z, ha[q].w)}; *(LAS u32x2*)(HS + GWP + (4 * C.lane + 256 * q) * 2) = (u32x2){cvt2(hb[q].x, hb[q].y), cvt2(hb[q].z, hb[q].w)}; }
                asm volatile("s_waitcnt lgkmcnt(0)" ::: "memory");
                f32x4 gacc = (f32x4){0.f, 0.f, 0.f, 0.f};
                { const int gi = C.lane & 15, kg = C.lane >> 4; LAS const unsigned char* ap = HS + (gi & 1) * GWP + kg * 16; LAS const unsigned char* bp = GW + gi * GWP + kg * 16;
#pragma unroll 8
                  for (int s2 = 0; s2 < 32; ++s2) { bf16x8 av = *(const LAS bf16x8*)(ap + s2 * 64); const bf16x8 bv = *(const LAS bf16x8*)(bp + s2 * 64);
                      if (gi >= 2) av = (bf16x8){0, 0, 0, 0, 0, 0, 0, 0};
                      gacc = __builtin_amdgcn_mfma_f32_16x16x32_bf16(av, bv, gacc, 0, 0, 0); } }
                float ga = gacc[0], gb = gacc[1];
                if (C.lane < 16) {
                    const float bgt = A.in[9][j * 16 + C.lane]; const int gtype = C.lane >> 2;
                    ga += bgt; gb += bgt;
                    GATE[(size_t)ra * 16 + C.lane] = (gtype & 1) ? logsigmoidf_(ga) : 15.0f * tanhf(ga * (1.0f / 15.0f));
                    if (hasb) GATE[(size_t)rb * 16 + C.lane] = (gtype & 1) ? logsigmoidf_(gb) : 15.0f * tanhf(gb * (1.0f / 15.0f)); }
            }
        }
#undef R1_FETCH
        sa = sbnd;
    }
}

__device__ __forceinline__ void phase_r2(const Args& A, const Ctx& C, int l) {
    constexpr int WP = 2064;
    LAS unsigned char* RWB = C.lds;
    LAS float* WL = (LAS float*)(C.lds + 48 * WP);
    LAS unsigned* hist = (LAS unsigned*)(WL + 8 * 16 * 48);
    LAS unsigned* gbase = hist + 32;
    constexpr int RCAP = 144;
    LAS int* rec = (LAS int*)(gbase + 32);
    static_assert(48 * WP + 8 * 16 * 48 * 4 + 256 + RCAP * 16 <= LDS_TAB_END, "R2 LDS map");
    cvt_moe_items(A, C, l, cvt_t2(l, C.G) + C.bid * NW + C.wave, CVT_ITEMS, C.G * NW);
    __syncthreads();
    { const float* wg = A.in[15] + (size_t)l * D * NGRP; const float* wr = A.in[17] + (size_t)l * D * NE;
      { const int kp = C.tid; const f32x4 x0 = *(const f32x4*)(wg + (size_t)(2 * kp) * 4), x1 = *(const f32x4*)(wg + (size_t)(2 * kp + 1) * 4);
        *(LAS unsigned*)(RWB + 0 * WP + kp * 4) = cvt2(x0.x, x1.x); *(LAS unsigned*)(RWB + 1 * WP + kp * 4) = cvt2(x0.y, x1.y);
        *(LAS unsigned*)(RWB + 2 * WP + kp * 4) = cvt2(x0.z, x1.z); *(LAS unsigned*)(RWB + 3 * WP + kp * 4) = cvt2(x0.w, x1.w); }
      f32x4 t0[8], t1[8];
#pragma unroll
      for (int jj = 0; jj < 8; ++jj) { const int it = C.tid + NT * jj, kp = it >> 3, cg = it & 7; t0[jj] = *(const f32x4*)(wr + (size_t)(2 * kp) * NE + 4 * cg); t1[jj] = *(const f32x4*)(wr + (size_t)(2 * kp + 1) * NE + 4 * cg); }
#pragma unroll
      for (int jj = 0; jj < 8; ++jj) { const int it = C.tid + NT * jj, kp = it >> 3, c0 = 4 + 4 * (it & 7);
          *(LAS unsigned*)(RWB + (c0 + 0) * WP + kp * 4) = cvt2(t0[jj].x, t1[jj].x); *(LAS unsigned*)(RWB + (c0 + 1) * WP + kp * 4) = cvt2(t0[jj].y, t1[jj].y);
          *(LAS unsigned*)(RWB + (c0 + 2) * WP + kp * 4) = cvt2(t0[jj].z, t1[jj].z); *(LAS unsigned*)(RWB + (c0 + 3) * WP + kp * 4) = cvt2(t0[jj].w, t1[jj].w); }
      for (int i = C.tid; i < 12 * 512; i += NT) *(LAS unsigned*)(RWB + (36 + i / 512) * WP + (i % 512) * 4) = 0u; }
    const int nrows = (l <= 1) ? NR : NL;
    bf16* LAT = (bf16*)(A.ws + WS_LAT); bf16* H = (bf16*)(A.ws + WS_HB); unsigned char* H8 = A.ws + WS_H8;
    const float* MOD = (const float*)(A.ws + WS_MOD);
    unsigned* cnt = (unsigned*)(A.ws + WS_CTL) + CW_CNT + l * 32 * CNT_STRIDE;
    int* TS = (int*)(A.ws + WS_TOKSLOT); float* TW = (float*)(A.ws + WS_TOKW); int* ST = (int*)(A.ws + WS_SLOTTOK);
    const int rpw = (((nrows + C.G - 1) / C.G) + 1) & ~1; const int wrow0 = C.bid * rpw; const int wend0 = min(wrow0 + rpw, nrows);
    const float* bg = A.in[16] + l * NGRP; const float* br = A.in[18] + l * NE;
    for (int cb = wrow0; cb < wend0; cb += RCAP) {
        const int wend = min(cb + RCAP, wend0);
        if (C.tid < 32) hist[C.tid] = 0u;
        for (int sa = cb; sa < wend;) {
            const int mvi = mod_vec_of_row(sa); const int bnd = mvi == 0 ? SEQ : (mvi == 1 ? NL : NR); const int sbnd = min(wend, bnd);
            RowVec RV; { const float* mv = MOD + (size_t)(l * 3 + mvi) * 6 * D; load_rowvec(RV, A.in[6] + (size_t)(l * 2 + 1) * D, mv + 3 * D, mv + 4 * D, mv + 2 * D, C.lane); }
            const int rlast = sbnd - 2;
            u32x2 la[4], lb[4];
            { const int r0 = min(sa + 2 * C.wave, rlast); load_row_bf16raw(LAT + (size_t)r0 * D, C.lane, la); load_row_bf16raw(LAT + (size_t)(r0 + 1) * D, C.lane, lb); }
            for (int ra = sa + 2 * C.wave; ra < sbnd; ra += 2 * NW) {
                const int rb = ra + 1;
                u32x2 lan[4], lbn[4];
                { const int r1 = min(ra + 2 * NW, rlast); load_row_bf16raw(LAT + (size_t)r1 * D, C.lane, lan); load_row_bf16raw(LAT + (size_t)(r1 + 1) * D, C.lane, lbn); }
                f32x4 va[4], vb[4];
#pragma unroll
                for (int q = 0; q < 4; ++q) { va[q] = bf4(la[q]); vb[q] = bf4(lb[q]); }
                const float rra = row_rstd(va), rrb = row_rstd(vb);
                f32x4 ha[4], hb[4];
#pragma unroll
                for (int q = 0; q < 4; ++q) { ha[q] = (va[q] * rra) * RV.a[q] + RV.s[q]; hb[q] = (vb[q] * rrb) * RV.a[q] + RV.s[q]; }
                store_row_bf16(H + (size_t)ra * D, C.lane, ha); store_row_bf16(H + (size_t)rb * D, C.lane, hb);
                store_row_fp8(H8 + (size_t)ra * D, C.lane, ha); store_row_fp8(H8 + (size_t)rb * D, C.lane, hb);
#pragma unroll
                for (int q = 0; q < 4; ++q) { la[q] = lan[q]; lb[q] = lbn[q]; }
            }
            sa = sbnd;
        }
        __syncthreads();
        const int fr = C.lane & 15, fq = C.lane >> 4;
        for (int t = C.wave; t * 16 < wend - cb; t += NW) {
            const int trow = min(cb + 16 * t + fr, wend - 1);
            const bf16* hp = H + (size_t)trow * D + 8 * fq;
            f32x4 acc[3];
#pragma unroll
            for (int ct = 0; ct < 3; ++ct) acc[ct] = (f32x4){0.f, 0.f, 0.f, 0.f};
            { bf16x8 av[32];
#pragma unroll
              for (int k8 = 0; k8 < 32; ++k8) av[k8] = *(const bf16x8*)(hp + 32 * k8);
#pragma unroll
              for (int k8 = 0; k8 < 32; ++k8) {
#pragma unroll
                  for (int ct = 0; ct < 3; ++ct) { const bf16x8 bv = *(const LAS bf16x8*)(RWB + (ct * 16 + fr) * WP + (32 * k8 + 8 * fq) * 2);
                      acc[ct] = __builtin_amdgcn_mfma_f32_16x16x32_bf16(av[k8], bv, acc[ct], 0, 0, 0); }
                  if ((k8 & 3) == 3) asm volatile("" ::: "memory"); } }
            LAS float* wl = WL + C.wave * 16 * 48;
#pragma unroll
            for (int ct = 0; ct < 3; ++ct)
#pragma unroll
                for (int jq = 0; jq < 4; ++jq) wl[(4 * fq + jq) * 48 + ct * 16 + fr] = acc[ct][jq];
            asm volatile("s_waitcnt lgkmcnt(0)" ::: "memory");
            const int row = cb + 16 * t + C.lane;
            if (C.lane < 16 && row < wend) {
                LAS const float* wm = wl + C.lane * 48;
                float lg[36];
#pragma unroll
                for (int c = 0; c < 36; ++c) lg[c] = wm[c];
                float gl[4]; int grp = 0; float gm = -3.0e38f;
#pragma unroll
                for (int c = 0; c < 4; ++c) { gl[c] = lg[c] + bg[c]; if (gl[c] > gm) { gm = gl[c]; grp = c; } }
                float gs = 0.f;
#pragma unroll
                for (int c = 0; c < 4; ++c) gs += __expf(gl[c] - gm);
                const float pgrp = 1.0f / gs;
                float rl[8];
#pragma unroll
                for (int i = 0; i < 8; ++i) { float tt = 0.f;
#pragma unroll
                    for (int g = 0; g < 4; ++g) tt = (g == grp) ? lg[4 + g * 8 + i] : tt;
                    rl[i] = tt + br[grp * 8 + i]; }
                int i0 = 0; float m0 = rl[0];
#pragma unroll
                for (int i = 1; i < 8; ++i) if (rl[i] > m0) { m0 = rl[i]; i0 = i; }
                int i1 = -1; float m1 = -3.0e38f;
#pragma unroll
                for (int i = 0; i < 8; ++i) if (i != i0 && rl[i] > m1) { m1 = rl[i]; i1 = i; }
                const float p0 = 1.0f, p1 = __expf(m1 - m0);
                const float w0 = pgrp * p0 / (p0 + p1), w1 = pgrp * p1 / (p0 + p1);
                const int e0 = grp * 8 + i0, e1 = grp * 8 + i1;
                const unsigned q0 = __hip_atomic_fetch_add(hist + e0, 1u, __ATOMIC_RELAXED, __HIP_MEMORY_SCOPE_WORKGROUP), q1 = __hip_atomic_fetch_add(hist + e1, 1u, __ATOMIC_RELAXED, __HIP_MEMORY_SCOPE_WORKGROUP);
                const int li = row - cb;
                rec[li * 4 + 0] = e0 | (e1 << 8); rec[li * 4 + 1] = (int)q0; rec[li * 4 + 2] = (int)q1;
                TW[row * 2 + 0] = w0; TW[row * 2 + 1] = w1;
            }
        }
        __syncthreads();
        if (C.tid < 32) gbase[C.tid] = hist[C.tid] ? atomicAdd(cnt + C.tid * CNT_STRIDE, hist[C.tid]) : 0u;
        __syncthreads();
        for (int i = C.tid; i < wend - cb; i += NT) { const int row = cb + i; const int ee = rec[i * 4], e0 = ee & 255, e1 = ee >> 8;
            const unsigned q0 = gbase[e0] + (unsigned)rec[i * 4 + 1], q1 = gbase[e1] + (unsigned)rec[i * 4 + 2];
            ST[(size_t)e0 * CAP + q0] = row; ST[(size_t)e1 * CAP + q1] = row;
            TS[row * 2 + 0] = (e0 << 20) | (int)q0; TS[row * 2 + 1] = (e1 << 20) | (int)q1; }
        __syncthreads();
    }
}

__device__ __forceinline__ void phase_final(const Args& A, const Ctx& C) {
    LAS int* sb = (LAS int*)C.lds;
    slot_bases(A, 3, sb, C.tid);
    const bf16* LAT = (const bf16*)(A.ws + WS_LAT); const unsigned char* Y8 = A.ws + WS_PB;
    const int* TS = (const int*)(A.ws + WS_TOKSLOT); const float* TW = (const float*)(A.ws + WS_TOKW);
    const float* MOD = (const float*)(A.ws + WS_MOD);
    f32x4 fg[4]; load_row_f32(A.in[7], C.lane, fg);
    const int rpw = (((NL + C.G - 1) / C.G) + 1) & ~1; const int wrow0 = C.bid * rpw; const int wend = min(wrow0 + rpw, NL);
    for (int sa = wrow0; sa < wend;) {
        const int mvi = mod_vec_of_row(sa); const int sbnd = min(wend, mvi == 0 ? SEQ : NL);
        f32x4 g2[4]; load_row_f32(MOD + (size_t)(3 * 3 + mvi) * 6 * D + 5 * D, C.lane, g2);
        const int rlast = sbnd - 2; const int rfirst = sa + 2 * C.wave;
        i32x4r ts1, ts2; f32x4 tw1, tw2;
        u32x2 nla[4], nlb[4]; unsigned nya0[4], nya1[4], nyb0[4], nyb1[4];
#define FIN_FETCH(r_, ts_) do { const int fa_ = (r_); \
            load_row_bf16raw(LAT + (size_t)fa_ * D, C.lane, nla); load_row_bf16raw(LAT + (size_t)(fa_ + 1) * D, C.lane, nlb); \
            load_row_fp8raw(Y8 + (size_t)(sb[(ts_).x >> 20] + ((ts_).x & 0xfffff)) * D, C.lane, nya0); load_row_fp8raw(Y8 + (size_t)(sb[(ts_).y >> 20] + ((ts_).y & 0xfffff)) * D, C.lane, nya1); \
            load_row_fp8raw(Y8 + (size_t)(sb[(ts_).z >> 20] + ((ts_).z & 0xfffff)) * D, C.lane, nyb0); load_row_fp8raw(Y8 + (size_t)(sb[(ts_).w >> 20] + ((ts_).w & 0xfffff)) * D, C.lane, nyb1); } while (0)
        { const int r0 = min(rfirst, rlast), r1 = min(rfirst + 2 * NW, rlast);
          ts1 = *(const i32x4r*)(TS + r0 * 2); tw1 = *(const f32x4*)(TW + r0 * 2); ts2 = *(const i32x4r*)(TS + r1 * 2); tw2 = *(const f32x4*)(TW + r1 * 2); }
        FIN_FETCH(min(rfirst, rlast), ts1);
        for (int ra = rfirst; ra < sbnd; ra += 2 * NW) {
            const int rb = ra + 1;
            u32x2 la[4], lb[4]; unsigned ya0[4], ya1[4], yb0[4], yb1[4];
#pragma unroll
            for (int q = 0; q < 4; ++q) { la[q] = nla[q]; lb[q] = nlb[q]; ya0[q] = nya0[q]; ya1[q] = nya1[q]; yb0[q] = nyb0[q]; yb1[q] = nyb1[q]; }
            const f32x4 twc = tw1;
            ts1 = ts2; tw1 = tw2;
            { const int r2 = min(ra + 4 * NW, rlast); ts2 = *(const i32x4r*)(TS + r2 * 2); tw2 = *(const f32x4*)(TW + r2 * 2); }
            FIN_FETCH(min(ra + 2 * NW, rlast), ts1);
            const float wa0 = twc.x * (1.0f / YSCALE), wa1 = twc.y * (1.0f / YSCALE), wb0 = twc.z * (1.0f / YSCALE), wb1 = twc.w * (1.0f / YSCALE);
            f32x4 va[4], vb[4];
#pragma unroll
            for (int q = 0; q < 4; ++q) { va[q] = bf4(la[q]) + g2[q] * (fp8x4(ya0[q]) * wa0 + fp8x4(ya1[q]) * wa1); vb[q] = bf4(lb[q]) + g2[q] * (fp8x4(yb0[q]) * wb0 + fp8x4(yb1[q]) * wb1); }
            const float rra = row_rstd(va), rrb = row_rstd(vb);
#pragma unroll
            for (int q = 0; q < 4; ++q) { *(f32x4*)(A.out + (size_t)ra * D + 4 * C.lane + 256 * q) = (va[q] * rra) * fg[q]; *(f32x4*)(A.out + (size_t)rb * D + 4 * C.lane + 256 * q) = (vb[q] * rrb) * fg[q]; }
        }
#undef FIN_FETCH
        sa = sbnd;
    }
}

__device__ __forceinline__ void phase_conv(const Args& A, const Ctx& C, int l) {
    const int j = l >> 1; const int nrows = (l <= 1) ? NR : NL;
    const bf16* P = (const bf16*)(A.ws + WS_PB); unsigned char* HM = A.ws + WS_HM; float* RSC = (float*)(A.ws + WS_RSC);
    const float* cw = A.in[13] + (size_t)j * 3 * D;
    f32x4 w0[4], w1[4], w2[4];
    load_row_f32(cw, C.lane, w0); load_row_f32(cw + D, C.lane, w1); load_row_f32(cw + 2 * D, C.lane, w2);
    const int rpw = (((nrows + C.G - 1) / C.G) + 1) & ~1; const int wrow0 = C.bid * rpw; const int wend = min(wrow0 + rpw, nrows);
    for (int ra = wrow0 + 2 * C.wave; ra < wend; ra += 2 * NW) {
        const int rb = ra + 1;
        const int ta = ra < NL ? (ra & 63) : ((ra - NL) & 255), tb1 = rb < NL ? (rb & 63) : ((rb - NL) & 255), tlast = ra < NL ? 63 : 255;
        const bool hasl = ta != 0, hasr = tb1 != tlast;
        const bf16* pa = P + (size_t)ra * PW;
        u32x2 bga[4], bgb[4], zm[4], z0[4], z1[4], z2[4];
        load_row_bf16raw(pa, C.lane, bga); load_row_bf16raw(pa + PW, C.lane, bgb);
        load_row_bf16raw(pa + D, C.lane, z0); load_row_bf16raw(pa + PW + D, C.lane, z1);
        load_row_bf16raw(hasl ? pa - PW + D : pa + D, C.lane, zm); load_row_bf16raw(hasr ? pa + 2 * PW + D : pa + D, C.lane, z2);
        const float fl = hasl ? 1.f : 0.f, fr = hasr ? 1.f : 0.f;
        f32x4 oa[4], ob[4];
#pragma unroll
        for (int q = 0; q < 4; ++q) { const f32x4 a0 = bf4(z0[q]), a1 = bf4(z1[q]);
            oa[q] = bf4(bga[q]) * (w0[q] * (bf4(zm[q]) * fl) + w1[q] * a0 + w2[q] * a1);
            ob[q] = bf4(bgb[q]) * (w0[q] * a0 + w1[q] * a1 + w2[q] * (bf4(z2[q]) * fr)); }
        float ma = 0.f, mb = 0.f;
#pragma unroll
        for (int q = 0; q < 4; ++q) { ma = fmaxf(ma, fmaxf(fmaxf(fabsf(oa[q].x), fabsf(oa[q].y)), fmaxf(fabsf(oa[q].z), fabsf(oa[q].w)))); mb = fmaxf(mb, fmaxf(fmaxf(fabsf(ob[q].x), fabsf(ob[q].y)), fmaxf(fabsf(ob[q].z), fabsf(ob[q].w)))); }
        ma = fmaxf(wave_max_nn(ma), 1.0e-20f); mb = fmaxf(wave_max_nn(mb), 1.0e-20f);
        const float ia = 127.0f / ma, ib = 127.0f / mb;
#pragma unroll
        for (int q = 0; q < 4; ++q) { *(unsigned*)(HM + (size_t)ra * D + 4 * C.lane + 256 * q) = pack_i8_nc(oa[q] * ia); *(unsigned*)(HM + (size_t)rb * D + 4 * C.lane + 256 * q) = pack_i8_nc(ob[q] * ib); }
        if (C.lane == 0) { RSC[ra] = ma * (1.0f / 127.0f); RSC[rb] = mb * (1.0f / 127.0f); }
    }
}

constexpr int BM = 256, BK = 64, HALF = 128, HTB = HALF * BK * 2, STAGE_BYTES = 8 * HTB, NXCD = 8, WGM = 8;
constexpr int LDS_TAB = STAGE_BYTES;
__device__ __forceinline__ int lds_byte(int r, int c) { const int st = (r >> 4) * 2 + (c >> 5), rr = r & 15, cc = c & 31, ob = rr * 64 + cc * 2; return st * 1024 + (ob ^ (((ob >> 9) & 1) << 5)); }
__device__ __forceinline__ void stage_rc(int b, int& R, int& C) { const int st = b / 1024, sb = b % 1024, swz = sb ^ (((sb >> 9) & 1) << 5); R = (st >> 1) * 16 + swz / 64; C = (st & 1) * 32 + (swz % 64) / 2; }
__device__ __forceinline__ int perm32(int rho) { const int n = rho >> 4, i = rho & 15; return 8 * (i >> 2) + 4 * n + (i & 3); }
__device__ __forceinline__ unsigned cvt_pk_bf16(float lo, float hi) { unsigned r; asm volatile("v_cvt_pk_bf16_f32 %0, %1, %2" : "=v"(r) : "v"(lo), "v"(hi)); return r; }

struct GUnit { const char* a; const char* b; int orow, ocol, aux; };

typedef int i32x8 __attribute__((ext_vector_type(8)));
typedef int i32x4 __attribute__((ext_vector_type(4)));
template <class Epi, class Sched, bool GATHER, int OPM = 0>
__device__ __forceinline__ void gemm_phase(LAS unsigned char* lds, const int K, const Sched& S, const Epi& E) {
    const int tid = threadIdx.x, wid = __builtin_amdgcn_readfirstlane(tid >> 6), lane = tid & 63, wr = wid >> 2, wc = wid & 3, fr = lane & 15, fq = lane >> 4;
    constexpr bool FP8 = (OPM == 1), I8 = (OPM == 2);
    const int RB = (OPM != 0) ? K : 2 * K;
    const int nt = RB / (BK * 2);
    unsigned voffB[2], voA[2][2]; int Rr[2], Cc[2];
#pragma unroll
    for (int i = 0; i < 2; ++i) { int R, C; stage_rc(tid * 16 + i * 8192, R, C); const int Rb = (R & ~31) + perm32(R & 31); Rr[i] = R; Cc[i] = C;
        voffB[i] = (unsigned)(Rb * RB + C * 2);
        voA[0][i] = (unsigned)(R * RB + C * 2); voA[1][i] = (unsigned)((R + HALF) * RB + C * 2); }
    const size_t kstep = (size_t)(BK * 2);
    const size_t hstep = (size_t)HALF * RB;
    const unsigned ldsw = (unsigned)wid * 1024u;
    const unsigned ldsbase = (unsigned)(size_t)lds;
    const int aoff = lds_byte(wr * 64 + fr, fq * 8), boff = lds_byte(wc * 32 + fr, fq * 8);
#define PG8_SA(b, h) (((b) * 2 + (h)) * HTB)
#define PG8_SB(b, h) ((4 + (b) * 2 + (h)) * HTB)
#define PG8_STAGE(bufoff, gbase, voff) do { _Pragma("unroll") for (int _i = 0; _i < 2; ++_i) \
        asm volatile("s_mov_b32 m0, %2\n\ts_nop 0\n\tglobal_load_lds_dwordx4 %0, %1" :: "v"((voff)[_i]), "s"((const char*)(gbase)), "s"(ldsbase + (unsigned)(bufoff) + ldsw + (unsigned)(_i * 8192)) : "memory"); } while (0)
#define PG8_STAGE_A1(bufoff, gbase) do { if constexpr (GATHER) PG8_STAGE(bufoff, gbase, voA[1]); else PG8_STAGE(bufoff, (const char*)(gbase) + hstep, voA[0]); } while (0)
#define PG8_LDA(dst, b, h) do { if constexpr (FP8) { _Pragma("unroll") for (int m = 0; m < 4; ++m) { \
        const i32x4 _lo = *(const LAS i32x4*)(lds + PG8_SA(b, h) + aoff + m * 2048), _hi = *(const LAS i32x4*)(lds + PG8_SA(b, h) + aoff + m * 2048 + 1024); \
        dst##8[m] = __builtin_shufflevector(_lo, _hi, 0, 1, 2, 3, 4, 5, 6, 7); } } \
      else { _Pragma("unroll") for (int m = 0; m < 4; ++m) _Pragma("unroll") for (int k = 0; k < 2; ++k) dst[m][k] = *(const LAS bf16x8*)(lds + PG8_SA(b, h) + aoff + m * 2048 + k * 1024); } } while (0)
#define PG8_LDB(dst, b, h) do { if constexpr (FP8) { _Pragma("unroll") for (int n = 0; n < 2; ++n) { \
        const i32x4 _lo = *(const LAS i32x4*)(lds + PG8_SB(b, h) + boff + n * 2048), _hi = *(const LAS i32x4*)(lds + PG8_SB(b, h) + boff + n * 2048 + 1024); \
        dst##8[n] = __builtin_shufflevector(_lo, _hi, 0, 1, 2, 3, 4, 5, 6, 7); } } \
      else { _Pragma("unroll") for (int n = 0; n < 2; ++n) _Pragma("unroll") for (int k = 0; k < 2; ++k) dst[n][k] = *(const LAS bf16x8*)(lds + PG8_SB(b, h) + boff + n * 2048 + k * 1024); } } while (0)
#define PG8_MMA(ai, bj, At, Bt) do { __builtin_amdgcn_s_setprio(1); \
        if constexpr (FP8) { _Pragma("unroll") for (int m = 0; m < 4; ++m) _Pragma("unroll") for (int n = 0; n < 2; ++n) \
            acc[ai][bj][m][n] = __builtin_amdgcn_mfma_scale_f32_16x16x128_f8f6f4(Bt##8[n], At##8[m], acc[ai][bj][m][n], 0, 0, 0, 0x7f7f7f7f, 0, 0x7f7f7f7f); } \
        else if constexpr (I8) { _Pragma("unroll") for (int m = 0; m < 4; ++m) _Pragma("unroll") for (int n = 0; n < 2; ++n) _Pragma("unroll") for (int k = 0; k < 2; ++k) \
            acc[ai][bj][m][n] = __builtin_bit_cast(f32x4, __builtin_amdgcn_mfma_i32_16x16x64_i8(__builtin_bit_cast(i32x4, Bt[n][k]), __builtin_bit_cast(i32x4, At[m][k]), __builtin_bit_cast(i32x4, acc[ai][bj][m][n]), 0, 0, 0)); } \
        else { _Pragma("unroll") for (int m = 0; m < 4; ++m) _Pragma("unroll") for (int n = 0; n < 2; ++n) _Pragma("unroll") for (int k = 0; k < 2; ++k) \
            acc[ai][bj][m][n] = __builtin_amdgcn_mfma_f32_16x16x32_bf16(Bt[n][k], At[m][k], acc[ai][bj][m][n], 0, 0, 0); } \
        __builtin_amdgcn_s_setprio(0); } while (0)
#define PG8_WAIT_V(n) asm volatile("s_waitcnt vmcnt(" #n ")" ::: "memory")
#define PG8_WAIT_L(n) asm volatile("s_waitcnt lgkmcnt(" #n ")" ::: "memory")
#define PG8_BAR __builtin_amdgcn_s_barrier()
#define PG8_SCHED __builtin_amdgcn_sched_barrier(0)
    GUnit cur, nxt; int ui = 0;
    if (!S.next(0, cur)) return;
    if constexpr (GATHER) {
#pragma unroll
        for (int h = 0; h < 2; ++h)
#pragma unroll
            for (int i = 0; i < 2; ++i) voA[h][i] = S.arow_off(0, h * HALF + Rr[i]) + (unsigned)Cc[i] * 2u;
    }
    f32x4 acc[2][2][4][2];
#pragma unroll
    for (int a = 0; a < 2; ++a)
#pragma unroll
        for (int b = 0; b < 2; ++b)
#pragma unroll
            for (int m = 0; m < 4; ++m)
#pragma unroll
                for (int n = 0; n < 2; ++n) acc[a][b][m][n] = (f32x4){0.f, 0.f, 0.f, 0.f};
    bf16x8 At[4][2], B0[2][2], B1[2][2]; i32x8 At8[4], B08[2], B18[2];
    const char* cA = cur.a; const char* cB = cur.b;
    PG8_STAGE(PG8_SB(0, 0), cB, voffB); PG8_STAGE(PG8_SB(0, 1), cB + hstep, voffB); PG8_STAGE(PG8_SA(0, 0), cA, voA[0]); PG8_STAGE_A1(PG8_SA(0, 1), cA);
    if (wr == 1) PG8_BAR;
    PG8_WAIT_V(2); PG8_BAR;
    PG8_STAGE(PG8_SB(1, 0), cB + kstep, voffB); PG8_STAGE(PG8_SA(1, 0), cA + kstep, voA[0]); PG8_STAGE(PG8_SB(1, 1), cB + hstep + kstep, voffB);
    PG8_WAIT_V(6); PG8_BAR;
    for (;;) {
        const bool has_next = S.next(ui + 1, nxt);
        const char* nA = has_next ? nxt.a : cA; const char* nB = has_next ? nxt.b : cB;
#pragma unroll 1
        for (int t = 0; t < nt; t += 2) {
            const bool last = (t == nt - 2);
            const char* a1 = cA + (size_t)(t + 1) * kstep;
            const char* a2 = last ? nA : cA + (size_t)(t + 2) * kstep; const char* b2 = last ? nB : cB + (size_t)(t + 2) * kstep;
            const char* a3 = a2 + kstep; const char* b3 = b2 + kstep;
            PG8_LDB(B0, 0, 0); PG8_LDB(B1, 0, 1); PG8_SCHED; PG8_LDA(At, 0, 0); PG8_STAGE_A1(PG8_SA(1, 1), a1);
            if constexpr (GATHER) { if (last && has_next) {
#pragma unroll
                for (int h = 0; h < 2; ++h)
#pragma unroll
                    for (int i = 0; i < 2; ++i) { int R2, C2; stage_rc(tid * 16 + i * 8192, R2, C2); voA[h][i] = S.arow_off(ui + 1, h * HALF + R2) + (unsigned)C2 * 2u; } } }
            PG8_WAIT_V(8); PG8_WAIT_L(0); PG8_BAR; PG8_MMA(0, 0, At, B0); PG8_MMA(0, 1, At, B1); PG8_BAR; PG8_SCHED;
            PG8_LDA(At, 0, 1); PG8_STAGE(PG8_SB(0, 0), b2, voffB); PG8_STAGE(PG8_SB(0, 1), b2 + hstep, voffB); PG8_STAGE(PG8_SA(0, 0), a2, voA[0]);
            PG8_WAIT_V(8); PG8_WAIT_L(0); PG8_BAR; PG8_MMA(1, 0, At, B0); PG8_MMA(1, 1, At, B1); PG8_BAR; PG8_SCHED;
            PG8_LDB(B0, 1, 0); PG8_LDB(B1, 1, 1); PG8_SCHED; PG8_LDA(At, 1, 0); PG8_STAGE_A1(PG8_SA(0, 1), a2);
            PG8_WAIT_V(8); PG8_WAIT_L(0); PG8_BAR; PG8_MMA(0, 0, At, B0); PG8_MMA(0, 1, At, B1); PG8_BAR; PG8_SCHED;
            PG8_LDA(At, 1, 1); PG8_STAGE(PG8_SB(1, 0), b3, voffB); PG8_STAGE(PG8_SB(1, 1), b3 + hstep, voffB); PG8_STAGE(PG8_SA(1, 0), a3, voA[0]);
            PG8_WAIT_V(8); PG8_WAIT_L(0); PG8_BAR; PG8_MMA(1, 0, At, B0); PG8_MMA(1, 1, At, B1); PG8_BAR; PG8_SCHED;
        }
        if (wr == 0) PG8_BAR;
        { int tz = threadIdx.x; asm volatile("" : "+v"(tz));
          if constexpr (I8) {
#pragma unroll
              for (int a_ = 0; a_ < 2; ++a_)
#pragma unroll
                  for (int b_ = 0; b_ < 2; ++b_)
#pragma unroll
                      for (int m = 0; m < 4; ++m)
#pragma unroll
                          for (int n = 0; n < 2; ++n) acc[a_][b_][m][n] = __builtin_convertvector(__builtin_bit_cast(i32x4, acc[a_][b_][m][n]), f32x4); }
          const int wz = tz >> 6, lz = tz & 63; E(acc, cur, wz >> 2, wz & 3, lz & 15, lz >> 4); }
        if (!has_next) break;
#pragma unroll
        for (int a = 0; a < 2; ++a)
#pragma unroll
            for (int b = 0; b < 2; ++b)
#pragma unroll
                for (int m = 0; m < 4; ++m)
#pragma unroll
                    for (int n = 0; n < 2; ++n) acc[a][b][m][n] = (f32x4){0.f, 0.f, 0.f, 0.f};
        cur = nxt; cA = nA; cB = nB; ++ui;
        if (wr == 1) PG8_BAR;
    }
    PG8_WAIT_V(0);
    PG8_BAR;
#undef PG8_SA
#undef PG8_SB
#undef PG8_STAGE
#undef PG8_STAGE_A1
#undef PG8_LDA
#undef PG8_LDB
#undef PG8_MMA
#undef PG8_WAIT_V
#undef PG8_WAIT_L
#undef PG8_BAR
#undef PG8_SCHED
}

__device__ __forceinline__ int xcd_remap(int L, int nwg) { const int q = nwg / NXCD, r = nwg % NXCD, xcd = L % NXCD, off = L / NXCD; return (xcd < r ? xcd * (q + 1) : r * (q + 1) + (xcd - r) * q) + off; }

struct DenseSched {
    const char* A; const char* Bt; int nM, nN, nwg, G, c; size_t tstep; int sw_lo, sw_hi;
    __device__ __forceinline__ void init(const void* A_, const void* Bt_, int M, int N, int K, int G_, int c_, int ebytes = 2) { A = (const char*)A_; Bt = (const char*)Bt_; nM = M / BM; nN = N / BM; nwg = nM * nN; G = G_; c = c_; tstep = (size_t)BM * K * ebytes; sw_lo = 0; sw_hi = 0; }
    __device__ __forceinline__ bool next(int i, GUnit& u) const {
        const long L = (long)i * G + c; if (L >= nwg) return false;
        const int wgid = xcd_remap((int)L, nwg);
        const int nig = WGM * nN, gid = wgid / nig, fm = gid * WGM, gsz = (nM - fm) < WGM ? (nM - fm) : WGM;
        const int pm = fm + ((wgid % nig) % gsz), pn = (wgid % nig) / gsz;
        if (pn >= sw_lo && pn < sw_hi) { u.a = Bt + (size_t)pn * tstep; u.b = A + (size_t)pm * tstep; u.orow = pm; u.ocol = pn - sw_lo; u.aux = 1; }
        else { u.a = A + (size_t)pm * tstep; u.b = Bt + (size_t)pn * tstep; u.orow = pm * BM; u.ocol = pn * BM; u.aux = 0; }
        return true;
    }
    __device__ __forceinline__ unsigned arow_off(int, int) const { return 0u; }
};

constexpr int MAXU = 12;
struct MoeTab { int n; int e[MAXU], mb[MAXU], nt[MAXU]; int sb[NE + 1]; };
struct MoeSched {
    LAS const MoeTab* T; LAS const unsigned* ridx;
    const char* A; const char* W; size_t wstride_e, tstepB; int K; int arow_bytes;
    __device__ __forceinline__ bool next(int i, GUnit& u) const {
        const int n = __builtin_amdgcn_readfirstlane(T->n); if (i >= n) return false;
        const int e = __builtin_amdgcn_readfirstlane(T->e[i]), mb = __builtin_amdgcn_readfirstlane(T->mb[i]), nt = __builtin_amdgcn_readfirstlane(T->nt[i]);
        const int base = __builtin_amdgcn_readfirstlane(T->sb[e]);
        u.orow = base + mb * BM; u.ocol = nt; u.aux = e;
        u.a = A + (size_t)u.orow * arow_bytes;
        u.b = W + (size_t)e * wstride_e + (size_t)nt * tstepB; return true;
    }
    __device__ __forceinline__ unsigned arow_off(int i, int r) const { return ridx[i * 256 + r]; }
};
template <bool GATHER>
__device__ __forceinline__ void moe_tables(const Args& A, const Ctx& C, int l, int ntile_n, LAS MoeTab* T, LAS unsigned* ridx, int arow_bytes) {
    const unsigned* cnt = (const unsigned*)(A.ws + WS_CTL) + CW_CNT + l * 32 * CNT_STRIDE;
    LAS int* ust = (LAS int*)(T + 1);
    LAS int* cntv = ust + 33;
    if (C.tid < 64) { int nb; const int ex = expert_block_prefix(cnt, C.tid, nb); if (C.tid <= NE) { T->sb[C.tid] = ex * 256; ust[C.tid] = ex * ntile_n; } if (C.tid < NE) cntv[C.tid] = (int)cnt[C.tid * CNT_STRIDE]; }
    __syncthreads();
    if (C.tid < MAXU) { const int nwg = ust[NE]; const long L = (long)C.tid * C.G + C.bid;
        if (L < nwg) { const int w = xcd_remap((int)L, nwg); int e = 0; while (w >= ust[e + 1]) ++e;
            const int lu = w - ust[e]; T->e[C.tid] = e; T->mb[C.tid] = lu / ntile_n; T->nt[C.tid] = lu % ntile_n; } }
    if (C.tid == 0) { const int nwg = ust[NE]; int n = 0; while (n < MAXU && (long)n * C.G + C.bid < nwg) ++n; T->n = n; }
    __syncthreads();
    if constexpr (GATHER) {
        const int* ST = (const int*)(A.ws + WS_SLOTTOK); const int n = T->n;
        for (int i = C.tid; i < n * 256; i += NT) { const int ui = i >> 8, r = i & 255, e = T->e[ui], m0 = T->mb[ui] * 256, ce = cntv[e];
            const int rr = (m0 + r < ce) ? m0 + r : ce - 1;
            ridx[i] = (unsigned)ST[(size_t)e * CAP + rr] * (unsigned)arow_bytes; }
        __syncthreads();
    }
}

struct EpiStore { bf16* O; int ldc; float scale_lo; int sig_from; bf16* VT; float sall = 1.0f; const float* rs = nullptr;
    __device__ __forceinline__ void operator()(const f32x4 (&acc)[2][2][4][2], const GUnit& u, int wr, int wc, int fr, int fq) const {
        const bool tr = u.aux != 0;
        const float sc = ((!tr && u.ocol < NQ) ? scale_lo : 1.0f) * sall; const bool sg = !tr && u.ocol >= sig_from;
        bf16* Ob = tr ? VT + (size_t)(u.orow * NH + u.ocol) * 65536 : O + (size_t)u.orow * ldc + u.ocol; const int ld = tr ? 256 : ldc;
        f32x4 cs[2][2];
#pragma unroll
        for (int bj = 0; bj < 2; ++bj) { const f32x4 one = (f32x4){1.f, 1.f, 1.f, 1.f};
            cs[bj][0] = (rs && tr) ? *(const f32x4*)(rs + u.orow * BM + bj * HALF + wc * 32 + 8 * fq) : one; cs[bj][1] = (rs && tr) ? *(const f32x4*)(rs + u.orow * BM + bj * HALF + wc * 32 + 8 * fq + 4) : one; }
#pragma unroll
        for (int ai = 0; ai < 2; ++ai)
#pragma unroll
            for (int m = 0; m < 4; ++m) { const int rl = ai * HALF + wr * 64 + m * 16 + fr; bf16* rowp = tr ? Ob + wc * 8192 + rl * 32 + 8 * fq : Ob + (size_t)rl * ld + wc * 32 + 8 * fq;

                const float scr = (rs && !tr) ? sc * rs[u.orow + rl] : sc;
#pragma unroll
                for (int bj = 0; bj < 2; ++bj) { f32x4 v0 = acc[ai][bj][m][0] * scr * cs[bj][0], v1 = acc[ai][bj][m][1] * scr * cs[bj][1];
                    if (sg) {
#pragma unroll
                        for (int q = 0; q < 4; ++q) { v0[q] = __builtin_amdgcn_rcpf(1.0f + __expf(-v0[q])); v1[q] = __builtin_amdgcn_rcpf(1.0f + __expf(-v1[q])); } }
                    u32x4 w; w.x = cvt_pk_bf16(v0[0], v0[1]); w.y = cvt_pk_bf16(v0[2], v0[3]); w.z = cvt_pk_bf16(v1[0], v1[1]); w.w = cvt_pk_bf16(v1[2], v1[3]);
                    *(u32x4*)(rowp + (tr ? bj * 4 * 8192 : bj * HALF)) = w; } }
    }
};
__device__ __forceinline__ u32x2 cvt8_fp8(f32x4 a, f32x4 b) { int lo = 0, hi = 0;
    lo = __builtin_amdgcn_cvt_pk_fp8_f32(a[0], a[1], lo, false); lo = __builtin_amdgcn_cvt_pk_fp8_f32(a[2], a[3], lo, true);
    hi = __builtin_amdgcn_cvt_pk_fp8_f32(b[0], b[1], hi, false); hi = __builtin_amdgcn_cvt_pk_fp8_f32(b[2], b[3], hi, true); return (u32x2){(unsigned)lo, (unsigned)hi}; }
struct EpiSwigluF8 { unsigned char* O; int ldc; float s;
    __device__ __forceinline__ void operator()(const f32x4 (&acc)[2][2][4][2], const GUnit& u, int wr, int wc, int fr, int fq) const {
        const int ocol = u.ocol * HALF;
#pragma unroll
        for (int ai = 0; ai < 2; ++ai)
#pragma unroll
            for (int m = 0; m < 4; ++m) { unsigned char* rowp = O + (size_t)(u.orow + ai * HALF + wr * 64 + m * 16 + fr) * ldc + ocol + wc * 32 + 8 * fq;
                f32x4 v0, v1;
#pragma unroll
                for (int q = 0; q < 4; ++q) { const float x0 = acc[ai][0][m][0][q] * s, x1 = acc[ai][0][m][1][q] * s;
                    v0[q] = x0 * __builtin_amdgcn_rcpf(1.0f + __expf(-x0)) * (acc[ai][1][m][0][q] * s); v1[q] = x1 * __builtin_amdgcn_rcpf(1.0f + __expf(-x1)) * (acc[ai][1][m][1][q] * s); }
                *(u32x2*)rowp = cvt8_fp8(v0, v1); }
    }
};
template <int MODE> struct EpiPair { bf16* O; int ldc; int plain_below; float sall = 1.0f; const float* rs = nullptr;
    __device__ __forceinline__ void operator()(const f32x4 (&acc)[2][2][4][2], const GUnit& u, int wr, int wc, int fr, int fq) const {
        if (MODE == 0 && u.ocol < plain_below) {
#pragma unroll
            for (int ai = 0; ai < 2; ++ai)
#pragma unroll
                for (int m = 0; m < 4; ++m) { const int rg = u.orow + ai * HALF + wr * 64 + m * 16 + fr; bf16* rowp = O + (size_t)rg * ldc + u.ocol + wc * 32 + 8 * fq;
                    const float scr = rs ? sall * rs[rg] : sall;
#pragma unroll
                    for (int bj = 0; bj < 2; ++bj) { const f32x4 v0 = acc[ai][bj][m][0] * scr, v1 = acc[ai][bj][m][1] * scr;
                        u32x4 w; w.x = cvt_pk_bf16(v0[0], v0[1]); w.y = cvt_pk_bf16(v0[2], v0[3]); w.z = cvt_pk_bf16(v1[0], v1[1]); w.w = cvt_pk_bf16(v1[2], v1[3]);
                        *(u32x4*)(rowp + bj * HALF) = w; } }
            return;
        }
        const int ocol = (MODE == 0) ? plain_below + (u.ocol - plain_below) / 2 : u.ocol * HALF;
#pragma unroll
        for (int ai = 0; ai < 2; ++ai)
#pragma unroll
            for (int m = 0; m < 4; ++m) { const int rg = u.orow + ai * HALF + wr * 64 + m * 16 + fr; bf16* rowp = O + (size_t)rg * ldc + ocol + wc * 32 + 8 * fq;
                const float scr = rs ? sall * rs[rg] : sall; const float sc2 = scr * scr;
                f32x4 v0, v1;
#pragma unroll
                for (int q = 0; q < 4; ++q) {
                    const float x0 = acc[ai][0][m][0][q], x1 = acc[ai][0][m][1][q];
                    const float g0 = (MODE == 1) ? x0 * __builtin_amdgcn_rcpf(1.0f + __expf(-x0)) : x0, g1 = (MODE == 1) ? x1 * __builtin_amdgcn_rcpf(1.0f + __expf(-x1)) : x1;
                    v0[q] = g0 * acc[ai][1][m][0][q] * sc2; v1[q] = g1 * acc[ai][1][m][1][q] * sc2; }
                u32x4 w; w.x = cvt_pk_bf16(v0[0], v0[1]); w.y = cvt_pk_bf16(v0[2], v0[3]); w.z = cvt_pk_bf16(v1[0], v1[1]); w.w = cvt_pk_bf16(v1[2], v1[3]);
                *(u32x4*)rowp = w; }
    }
};
struct EpiResid { bf16* LAT; const float* g1; float sall; const float* rs;
    __device__ __forceinline__ void operator()(const f32x4 (&acc)[2][2][4][2], const GUnit& u, int wr, int wc, int fr, int fq) const {
        bf16* Ob = LAT + (size_t)u.orow * D + u.ocol + wc * 32 + 8 * fq;
        u32x4 old[2][4][2];
#pragma unroll
        for (int ai = 0; ai < 2; ++ai)
#pragma unroll
            for (int m = 0; m < 4; ++m)
#pragma unroll
                for (int bj = 0; bj < 2; ++bj) old[ai][m][bj] = *(const u32x4*)(Ob + (size_t)(ai * HALF + wr * 64 + m * 16 + fr) * D + bj * HALF);
        const float* gv = g1 + (size_t)mod_vec_of_row(u.orow) * 6 * D + u.ocol + wc * 32 + 8 * fq;
        f32x4 g[2][2];
#pragma unroll
        for (int bj = 0; bj < 2; ++bj) { g[bj][0] = *(const f32x4*)(gv + bj * HALF); g[bj][1] = *(const f32x4*)(gv + bj * HALF + 4); }
#pragma unroll
        for (int ai = 0; ai < 2; ++ai)
#pragma unroll
            for (int m = 0; m < 4; ++m) { const int rl = ai * HALF + wr * 64 + m * 16 + fr; bf16* rowp = Ob + (size_t)rl * D;
                const float scr = rs ? sall * rs[u.orow + rl] : sall;
#pragma unroll
                for (int bj = 0; bj < 2; ++bj) { const u32x4 o = old[ai][m][bj];
                    const f32x4 v0 = bf4((u32x2){o.x, o.y}) + g[bj][0] * (acc[ai][bj][m][0] * scr), v1 = bf4((u32x2){o.z, o.w}) + g[bj][1] * (acc[ai][bj][m][1] * scr);
                    u32x4 w; w.x = cvt_pk_bf16(v0[0], v0[1]); w.y = cvt_pk_bf16(v0[2], v0[3]); w.z = cvt_pk_bf16(v1[0], v1[1]); w.w = cvt_pk_bf16(v1[2], v1[3]);
                    *(u32x4*)(rowp + bj * HALF) = w; } }
    }
};
struct EpiStoreTile { unsigned char* O; int ldc; float s;
    __device__ __forceinline__ void operator()(const f32x4 (&acc)[2][2][4][2], const GUnit& u, int wr, int wc, int fr, int fq) const {
#pragma unroll
        for (int ai = 0; ai < 2; ++ai)
#pragma unroll
            for (int m = 0; m < 4; ++m) { unsigned char* rowp = O + (size_t)(u.orow + ai * HALF + wr * 64 + m * 16 + fr) * ldc + u.ocol * BM + wc * 32 + 8 * fq;
#pragma unroll
                for (int bj = 0; bj < 2; ++bj) *(u32x2*)(rowp + bj * HALF) = cvt8_fp8(acc[ai][bj][m][0] * s, acc[ai][bj][m][1] * s); }
    }
};

__device__ __forceinline__ void transpose_item(const float* W, int ldw, int K, bf16* WT, int drow0, int k0, int n0, LAS float* scr, int lane) {
#pragma unroll
    for (int i = 0; i < 32; ++i) { const int kk = 2 * i + (lane >> 5); scr[kk * 33 + (lane & 31)] = W[(size_t)(k0 + kk) * ldw + n0 + (lane & 31)]; }
    asm volatile("s_waitcnt lgkmcnt(0)" ::: "memory");
    const int c = lane & 7;
#pragma unroll
    for (int j = 0; j < 4; ++j) { const int n = (lane >> 3) + 8 * j; const LAS float* s = scr + (8 * c) * 33 + n;
        u32x4 o; o.x = pk2(s[0 * 33], s[1 * 33]); o.y = pk2(s[2 * 33], s[3 * 33]); o.z = pk2(s[4 * 33], s[5 * 33]); o.w = pk2(s[6 * 33], s[7 * 33]);
        *(u32x4*)(WT + (size_t)(drow0 + n) * K + k0 + 8 * c) = o; }
    asm volatile("s_waitcnt lgkmcnt(0)" ::: "memory");
}
__device__ __forceinline__ void transpose_item_fp8(const float* W, int ldw, int K, unsigned char* WT8, int drow0, int k0, int n0, LAS float* scr, int lane, float sc) {
#pragma unroll
    for (int i = 0; i < 32; ++i) { const int kk = 2 * i + (lane >> 5); scr[kk * 33 + (lane & 31)] = W[(size_t)(k0 + kk) * ldw + n0 + (lane & 31)]; }
    asm volatile("s_waitcnt lgkmcnt(0)" ::: "memory");
    const int n = lane >> 1, half = lane & 1; const LAS float* sp = scr + (32 * half) * 33 + n;
    unsigned char* dst = WT8 + (size_t)(drow0 + n) * K + k0 + 32 * half;
#pragma unroll
    for (int c = 0; c < 2; ++c) { u32x4 o;
#pragma unroll
        for (int q = 0; q < 4; ++q) { int p = 0; const LAS float* s4 = sp + (16 * c + 4 * q) * 33;
            p = __builtin_amdgcn_cvt_pk_fp8_f32(s4[0] * sc, s4[33] * sc, p, false); p = __builtin_amdgcn_cvt_pk_fp8_f32(s4[66] * sc, s4[99] * sc, p, true); o[q] = (unsigned)p; }
        *(u32x4*)(dst + 16 * c) = o; }
    asm volatile("s_waitcnt lgkmcnt(0)" ::: "memory");
}
__device__ __forceinline__ void transpose_item_i8(const float* W, int ldw, int K, unsigned char* WT8, int drow0, int k0, int n0, LAS float* scr, int lane, float inv) {
#pragma unroll
    for (int i = 0; i < 32; ++i) { const int kk = 2 * i + (lane >> 5); scr[kk * 33 + (lane & 31)] = W[(size_t)(k0 + kk) * ldw + n0 + (lane & 31)]; }
    asm volatile("s_waitcnt lgkmcnt(0)" ::: "memory");
    const int n = lane >> 1, half = lane & 1; const LAS float* sp = scr + (32 * half) * 33 + n;
    unsigned char* dst = WT8 + (size_t)(drow0 + n) * K + k0 + 32 * half;
#pragma unroll
    for (int c = 0; c < 2; ++c) { u32x4 o;
#pragma unroll
        for (int q = 0; q < 4; ++q) { const LAS float* s4 = sp + (16 * c + 4 * q) * 33; o[q] = pack_i8((f32x4){s4[0] * inv, s4[33] * inv, s4[66] * inv, s4[99] * inv}); }
        *(u32x4*)(dst + 16 * c) = o; }
    asm volatile("s_waitcnt lgkmcnt(0)" ::: "memory");
}
__device__ __forceinline__ int pair_row(int n, int which) { return (n >> 7) * 256 + (n & 127) + which * 128; }
constexpr float HMR = 6.0f;
__device__ __forceinline__ void phase_cvt_mixer(const Args& A, const Ctx& C) {
    const int gw = C.bid * NW + C.wave, NGW = C.G * NW;
    unsigned* wmax = (unsigned*)(A.ws + WS_CTL) + CW_WMAX;
    for (int m8 = 0; m8 < 8; ++m8) {
        const float* W = m8 < 2 ? A.in[8] + (size_t)m8 * D * PROJ : m8 < 4 ? A.in[12] + (size_t)(m8 - 2) * D * PW : m8 < 6 ? A.in[11] + (size_t)(m8 - 4) * D * D : A.in[14] + (size_t)(m8 - 6) * D * D;
        const size_t n4 = (size_t)D * (m8 < 2 ? PROJ : m8 < 4 ? PW : D) / 4;
        float mx = 0.f;
        for (size_t i0 = (size_t)gw * 64 + C.lane; i0 < n4; i0 += (size_t)NGW * 64 * 8) {
            f32x4 v[8];
#pragma unroll
            for (int j = 0; j < 8; ++j) { const size_t i = i0 + (size_t)j * NGW * 64; v[j] = *(const f32x4*)(W + 4 * (i < n4 ? i : i0)); }
#pragma unroll
            for (int j = 0; j < 8; ++j) mx = fmaxf(mx, fmaxf(fmaxf(fabsf(v[j].x), fabsf(v[j].y)), fmaxf(fabsf(v[j].z), fabsf(v[j].w)))); }
        mx = wave_max_nn(mx);
        if (C.lane == 0 && mx > 0.f) atomicMax(wmax + m8 * CNT_STRIDE, __float_as_uint(mx));
    }
}
__device__ __forceinline__ void cvt_win_i8(const Args& A, const Ctx& C) {
    LAS float* scr = (LAS float*)(C.lds + 16384 + C.wave * 16384);
    const int gw = C.bid * NW + C.wave, NGW = C.G * NW;
    constexpr int I_IN = (D / 64) * (PW / 32);
    const unsigned* wmax = (const unsigned*)(A.ws + WS_CTL) + CW_WMAX;
    constexpr int I_OUT = (D / 64) * (D / 32);
    for (int it = gw; it < 4 * I_OUT; it += NGW) {
        const int m4 = it / I_OUT, kind = m4 >> 1, j = m4 & 1, r = it % I_OUT; const int kb = r / (D / 32), nb = r % (D / 32), n0 = nb * 32;
        const float inv = 127.0f / fmaxf(__uint_as_float(wmax[(4 + m4) * CNT_STRIDE]), 1.0e-30f);
        transpose_item_i8((kind == 0 ? A.in[11] : A.in[14]) + (size_t)j * D * D, D, D, A.ws + (kind == 0 ? WS_WAOUT : WS_WBOUT) + (size_t)j * D * D, n0, kb * 64, n0, scr, C.lane, inv); }
    for (int it = gw; it < 4 * I_IN; it += NGW) {
        const int m4 = it / I_IN, kind = m4 >> 1, j = m4 & 1, r = it % I_IN; const int kb = r / (PW / 32), nb = r % (PW / 32), n0 = nb * 32;
        const float inv = 127.0f / fmaxf(__uint_as_float(wmax[m4 * CNT_STRIDE]), 1.0e-30f);
        unsigned char* WT = A.ws + (kind == 0 ? WS_WAIN : WS_WBIN) + (size_t)j * PW * D;
        if (kind == 0) transpose_item_i8(A.in[8] + (size_t)j * D * PROJ, PROJ, D, WT, n0, kb * 64, n0, scr, C.lane, inv);
        else { const int drow = n0 < D ? n0 : (n0 < 2 * D ? D + pair_row(n0 - D, 0) : D + pair_row(n0 - 2 * D, 1));
            transpose_item_i8(A.in[12] + (size_t)j * D * PW, PW, D, WT, drow, kb * 64, n0, scr, C.lane, inv); }
    }
}
__device__ __forceinline__ void cvt_moe_items(const Args& A, const Ctx& C, int l, int it0, int end, int stride) {
    LAS float* scr = (LAS float*)(C.lds + 16384 + C.wave * 16384);
    unsigned char* WGU = A.ws + WS_WGU; unsigned char* WDN = A.ws + WS_WDN;
    for (int it = it0; it < end; it += stride) {
        const int e = it / CVT_PER; int r = it % CVT_PER;
        if (r < 2 * CVT_IG) { const int which = r / CVT_IG; r %= CVT_IG; const int kb = r / (DE / 32), nb = r % (DE / 32), n0 = nb * 32;
            transpose_item_fp8((which == 0 ? A.in[19] : A.in[20]) + ((size_t)l * NE + e) * D * DE, DE, D, WGU + (size_t)e * 2 * DE * D, pair_row(n0, which), kb * 64, n0, scr, C.lane, WSCALE); }
        else { r -= 2 * CVT_IG; const int kb = r / (D / 32), nb = r % (D / 32), n0 = nb * 32;
            transpose_item_fp8(A.in[21] + ((size_t)l * NE + e) * DE * D, D, DE, WDN + (size_t)e * D * DE, n0, kb * 64, n0, scr, C.lane, WSCALE); }
    }
}
__device__ __forceinline__ int cvt_idle(int nunits, int G) { const int rem = nunits % G; return rem ? G - rem : 0; }
__device__ __forceinline__ int cvt_t1(int l, int G) { const int n = cvt_idle((((l <= 2) ? NR : NL) / BM) * (PW / BM), G) * CVT_Q; return n < CVT_ITEMS ? n : CVT_ITEMS; }
__device__ __forceinline__ int cvt_t2(int l, int G) { const int n = cvt_t1(l, G) + cvt_idle((((l <= 1) ? NR : NL) / BM) * (D / BM), G) * CVT_Q; return n < CVT_ITEMS ? n : CVT_ITEMS; }
__device__ __forceinline__ void cvt_moe_tail(const Args& A, const Ctx& C, int l, int nunits, int base, int end) {
    const int rem = nunits % C.G;
    if (rem == 0 || C.bid < rem) return;
    const int first = base + (C.bid - rem) * CVT_Q; const int last = min(first + CVT_Q, end);
    cvt_moe_items(A, C, l, first + C.wave, last, NW);
}

__device__ __forceinline__ void phase_g1(const Args& A, const Ctx& C, int l) {
    const bool mls = (l & 1) == 0; const int j = l >> 1; const int nrows = (l <= 2) ? NR : NL;
    DenseSched S; S.init(A.ws + WS_H8, A.ws + (mls ? WS_WAIN : WS_WBIN) + (size_t)j * PW * D, nrows, PW, D, C.G, C.bid, 1);
    const float wsc = __uint_as_float(((const unsigned*)(A.ws + WS_CTL))[CW_WMAX + ((mls ? 0 : 2) + j) * CNT_STRIDE]) * (1.0f / 127.0f);
    const float* rs = (const float*)(A.ws + WS_RSC);
    if (mls) { S.sw_lo = 4; S.sw_hi = 8; EpiStore E{(bf16*)(A.ws + WS_PB), PW, 0.08838834764831845f, 2 * NQ + NV, (bf16*)(A.ws + WS_VT), wsc, rs}; gemm_phase<EpiStore, DenseSched, false, 2>(C.lds, D, S, E); }
    else { EpiPair<0> E{(bf16*)(A.ws + WS_PB), PW, D, wsc, rs}; gemm_phase<EpiPair<0>, DenseSched, false, 2>(C.lds, D, S, E); }
    cvt_moe_tail(A, C, l, S.nwg, 0, cvt_t1(l, C.G));
}
__device__ __forceinline__ void phase_g2(const Args& A, const Ctx& C, int l) {
    const bool mls = (l & 1) == 0; const int j = l >> 1; const int nrows = (l <= 1) ? NR : NL;
    DenseSched S; S.init(A.ws + WS_HM, A.ws + (mls ? WS_WAOUT : WS_WBOUT) + (size_t)j * D * D, nrows, D, D, C.G, C.bid, 1);
    const float wsc = __uint_as_float(((const unsigned*)(A.ws + WS_CTL))[CW_WMAX + (4 + (mls ? 0 : 2) + j) * CNT_STRIDE]) * (1.0f / 127.0f);
    EpiResid E{(bf16*)(A.ws + WS_LAT), (const float*)(A.ws + WS_MOD) + (size_t)(l * 3) * 6 * D + 2 * D, mls ? wsc * (HMR / 127.0f) : wsc, mls ? nullptr : (const float*)(A.ws + WS_RSC)}; gemm_phase<EpiResid, DenseSched, false, 2>(C.lds, D, S, E);
    cvt_moe_tail(A, C, l, S.nwg, cvt_t1(l, C.G), cvt_t2(l, C.G));
}
__device__ __forceinline__ void phase_m1(const Args& A, const Ctx& C, int l) {
    LAS MoeTab* T = (LAS MoeTab*)(C.lds + LDS_TAB); LAS unsigned* ridx = (LAS unsigned*)(C.lds + LDS_TAB + 1024);
    moe_tables<true>(A, C, l, 4, T, ridx, D);
    MoeSched S; S.T = T; S.ridx = ridx; S.A = (const char*)(A.ws + WS_H8); S.W = (const char*)(A.ws + WS_WGU); S.wstride_e = (size_t)2 * DE * D; S.tstepB = (size_t)BM * D; S.K = D; S.arow_bytes = 0;
    EpiSwigluF8 E{A.ws + WS_DC, DE, 1.0f / WSCALE}; gemm_phase<EpiSwigluF8, MoeSched, true, 1>(C.lds, D, S, E);
}
__device__ __forceinline__ void phase_m2(const Args& A, const Ctx& C, int l) {
    LAS MoeTab* T = (LAS MoeTab*)(C.lds + LDS_TAB); LAS unsigned* ridx = (LAS unsigned*)(C.lds + LDS_TAB + 1024);
    moe_tables<false>(A, C, l, 4, T, ridx, DE);
    MoeSched S; S.T = T; S.ridx = ridx; S.A = (const char*)(A.ws + WS_DC); S.W = (const char*)(A.ws + WS_WDN); S.wstride_e = (size_t)D * DE; S.tstepB = (size_t)BM * DE; S.K = DE; S.arow_bytes = DE;
    EpiStoreTile E{A.ws + WS_PB, D, YSCALE / WSCALE}; gemm_phase<EpiStoreTile, MoeSched, false, 1>(C.lds, DE, S, E);
}

typedef float f32x16 __attribute__((ext_vector_type(16)));
#define MFMA32(a, b, c) __builtin_amdgcn_mfma_f32_32x32x16_bf16((a), (b), (c), 0, 0, 0)
__device__ __forceinline__ bf16x8 pack8(float a0, float a1, float a2, float a3, float a4, float a5, float a6, float a7) {
    u32x4 p; p.x = cvt2(a0, a1); p.y = cvt2(a2, a3); p.z = cvt2(a4, a5); p.w = cvt2(a6, a7); return __builtin_bit_cast(bf16x8, p); }
__device__ __forceinline__ float bflo(unsigned w) { return __uint_as_float(w << 16); }
__device__ __forceinline__ float bfhi(unsigned w) { return __uint_as_float(w & 0xffff0000u); }
__device__ __forceinline__ int vt_tile(int b, int h, int blk) { return (blk == 0 ? 128 + b : b * 64 + blk - 1) * NH + h; }

__device__ __forceinline__ float wave_incl_scan(float v, int lane) {
#pragma unroll
    for (int o = 1; o < 64; o <<= 1) { const float t = __shfl_up(v, o); v += (lane >= o) ? t : 0.f; }
    return v;
}
__device__ __forceinline__ void block_gates(const Args& A, int row0, int h, LAS float* bf, LAS float* bb, LAS float* lif, LAS float* lib, int tid) {
    const float* GATE = (const float*)(A.ws + WS_GATE);
    if (tid < 256) { const float* g = GATE + (size_t)(row0 + tid) * 16; lif[tid] = g[0 + h]; bf[tid] = g[4 + h]; lib[tid] = g[8 + h]; bb[tid] = g[12 + h]; }
    __syncthreads();
    const int lane = tid & 63, wv = tid >> 6;
    if (wv == 0) { f32x4 x = *(LAS f32x4*)(bf + 4 * lane); x.y += x.x; x.z += x.y; x.w += x.z; const float tot = wave_incl_scan(x.w, lane); const float ex = tot - x.w;
        x.x += ex; x.y += ex; x.z += ex; x.w += ex; *(LAS f32x4*)(bf + 4 * lane) = x; }
    if (wv == 1) { f32x4 y = *(LAS f32x4*)(bb + 4 * (63 - lane)); y.z += y.w; y.y += y.z; y.x += y.y; const float tot = wave_incl_scan(y.x, lane); const float ex = tot - y.x;
        y.x += ex; y.y += ex; y.z += ex; y.w += ex; *(LAS f32x4*)(bb + 4 * (63 - lane)) = y; }
    __syncthreads();
}
__device__ __forceinline__ void phase_s1(const Args& A, const Ctx& C, int l) {
    LAS float* bf = (LAS float*)C.lds; LAS float* bb = bf + 256; LAS float* lif = bb + 256; LAS float* lib = lif + 256; LAS float* af = lib + 256; LAS float* ab = af + 256;
    constexpr int KP = 528;
    LAS unsigned char* KTf = C.lds + 8192; LAS unsigned char* KTb = KTf + 128 * KP;
    const bf16* P = (const bf16*)(A.ws + WS_PB); const bf16* VT = (const bf16*)(A.ws + WS_VT);
    bf16* DC = (bf16*)(A.ws + WS_DC); float* DN = (float*)(A.ws + WS_DN); float* BT = (float*)(A.ws + WS_BTOT);
    const int r = C.lane & 31, hh = C.lane >> 5, w = C.wave;
    for (int it = C.bid; it < BATCH * NH * (NBLK - 1) + 2 * BATCH * NH; it += C.G) {
        const bool isctx = it >= BATCH * NH * (NBLK - 1); const int ci_ = it - BATCH * NH * (NBLK - 1);
        const int bh = isctx ? (ci_ >> 1) : it / (NBLK - 1), blk = isctx ? 0 : 1 + it % (NBLK - 1), h = bh % NH, b = bh / NH; const int u = bh * NBLK + blk; const int row0 = blk_row0(b, blk);
        const int dlo = isctx ? (ci_ & 1) : 0, dhi = isctx ? (ci_ & 1) + 1 : 2;
        const bf16* vt = VT + (size_t)vt_tile(b, h, blk) * 65536 + (size_t)(32 * w + r) * 32 + 8 * hh;
        bf16x8 av[16];
#pragma unroll
        for (int ks = 0; ks < 16; ++ks) av[ks] = *(const bf16x8*)(vt + (ks >> 1) * 8192 + 16 * (ks & 1));
        u32x4 kx[8];
        { const bf16* k0 = P + (size_t)(row0 + 2 * (C.tid >> 2)) * PW + NQ + h * DQK + 32 * (C.tid & 3);
#pragma unroll
          for (int c = 0; c < 4; ++c) { kx[2 * c] = *(const u32x4*)(k0 + 8 * c); kx[2 * c + 1] = *(const u32x4*)(k0 + PW + 8 * c); } }
        block_gates(A, row0, h, bf, bb, lif, lib, C.tid);
        if (C.tid < 256) { af[C.tid] = __expf(bf[255] - bf[C.tid] + lif[C.tid]); ab[C.tid] = __expf(bb[0] - bb[C.tid] + lib[C.tid]); }
        if (C.tid == 0) { BT[u * 2 + 0] = bf[255]; BT[u * 2 + 1] = bb[0]; }
        __syncthreads();
        { const int sp = C.tid >> 2, dq = C.tid & 3, s0 = 2 * sp;
          const float f0 = af[s0], f1 = af[s0 + 1], g0 = ab[s0], g1 = ab[s0 + 1];
#pragma unroll
          for (int c = 0; c < 4; ++c) { const u32x4 x0 = kx[2 * c], x1 = kx[2 * c + 1];
#pragma unroll
              for (int q = 0; q < 4; ++q) { const int d = 32 * dq + 8 * c + 2 * q;
                  const float a0 = bflo(x0[q]), a1 = bfhi(x0[q]), c0 = bflo(x1[q]), c1 = bfhi(x1[q]);
                  *(LAS unsigned*)(KTf + d * KP + s0 * 2) = cvt2(a0 * f0, c0 * f1); *(LAS unsigned*)(KTf + (d + 1) * KP + s0 * 2) = cvt2(a1 * f0, c1 * f1);
                  *(LAS unsigned*)(KTb + d * KP + s0 * 2) = cvt2(a0 * g0, c0 * g1); *(LAS unsigned*)(KTb + (d + 1) * KP + s0 * 2) = cvt2(a1 * g0, c1 * g1); } } }
        __syncthreads();
        if (C.tid < 256) { const int dir = C.tid >> 7, d = C.tid & 127; LAS const unsigned* kr = (LAS const unsigned*)((dir ? KTb : KTf) + d * KP); float s = 0.f;
#pragma unroll 8
            for (int i = 0; i < 32; ++i) { const u32x4 x = *(LAS const u32x4*)(kr + 4 * i); s += ((bflo(x.x) + bfhi(x.x)) + (bflo(x.y) + bfhi(x.y))) + ((bflo(x.z) + bfhi(x.z)) + (bflo(x.w) + bfhi(x.w))); }
            DN[(size_t)(u * 2 + dir) * DQK + d] = s; }
#pragma unroll 1
        for (int dir = dlo; dir < dhi; ++dir) {
            LAS const unsigned char* KT = dir ? KTb : KTf;
            f32x16 acc[4];
#pragma unroll
            for (int dt = 0; dt < 4; ++dt)
#pragma unroll
                for (int i = 0; i < 16; ++i) acc[dt][i] = 0.f;
#pragma unroll
            for (int ks = 0; ks < 16; ++ks) {
#pragma unroll
                for (int dt = 0; dt < 4; ++dt) { const bf16x8 b0 = *(const LAS bf16x8*)(KT + (dt * 32 + r) * KP + (16 * ks + 8 * hh) * 2); acc[dt] = MFMA32(av[ks], b0, acc[dt]); }
                if ((ks & 3) == 3) asm volatile("" ::: "memory"); }
            bf16* dc = DC + (size_t)(u * 2 + dir) * DQK * DV + (size_t)(32 * w + 4 * hh) * 32 + r;
#pragma unroll
            for (int g = 0; g < 4; ++g) { bf16* pf = dc + g * 8 * 32; asm volatile("" : "+v"(pf));
#pragma unroll
                for (int q = 0; q < 4; ++q)
#pragma unroll
                    for (int dt = 0; dt < 4; ++dt) pf[q * 32 + dt * 8192] = (bf16)f2bf(acc[dt][4 * g + q]); }
        }
        __syncthreads();
    }
}
__device__ __forceinline__ void phase_s2(const Args& A, const Ctx& C) {
    const bf16* __restrict__ DC = (const bf16*)(A.ws + WS_DC); const float* __restrict__ DN = (const float*)(A.ws + WS_DN); const float* __restrict__ BT = (const float*)(A.ws + WS_BTOT);
    bf16* __restrict__ CST = (bf16*)(A.ws + WS_CST); float* __restrict__ NST = (float*)(A.ws + WS_NST);
    constexpr int EL4 = DQK * DV / 4;
    for (int g = C.bid * NT + C.tid; g < BATCH * NH * 2 * EL4; g += C.G * NT) {
        const int e4 = (g % EL4) * 4, ch = g / EL4, dir = ch & 1, bh = ch >> 1;
        f32x4 st = (f32x4){0.f, 0.f, 0.f, 0.f};
        constexpr int PF = 16;
        u32x2 ring[PF]; float decr[PF];
#define S2_BLK(idx_) (dir == 0 ? (idx_) : ((idx_) == 0 ? 0 : NBLK - (idx_)))
#pragma unroll
        for (int i = 0; i < PF; ++i) { const int u = bh * NBLK + S2_BLK(i); ring[i] = *(const u32x2*)(DC + (size_t)(u * 2 + dir) * DQK * DV + e4); decr[i] = BT[u * 2 + dir]; }
#pragma unroll
        for (int idx = 0; idx < NBLK; ++idx) {
            const int u = bh * NBLK + S2_BLK(idx);
            const f32x4 dc = bf4(ring[idx % PF]); const float dec = __expf(decr[idx % PF]);
            if (idx + PF < NBLK) { const int u2 = bh * NBLK + S2_BLK(idx + PF); ring[idx % PF] = *(const u32x2*)(DC + (size_t)(u2 * 2 + dir) * DQK * DV + e4); decr[idx % PF] = BT[u2 * 2 + dir]; }
            u32x2 o; o.x = cvt2(st.x, st.y); o.y = cvt2(st.z, st.w);
            *(u32x2*)(CST + (size_t)(u * 2 + dir) * DQK * DV + e4) = o;
            st = st * dec + dc;
        }
#undef S2_BLK
    }
    if (C.wave == 0 && C.bid * 64 < BATCH * NH * 2 * DQK) {
        const int g = C.bid * 64 + C.lane; const int d = g % DQK, ch = g / DQK, dir = ch & 1, bh = ch >> 1; float st = 0.f;
        constexpr int PF = 16; float dnr[PF], btr[PF];
#define S2_BLK(idx_) (dir == 0 ? (idx_) : ((idx_) == 0 ? 0 : NBLK - (idx_)))
#pragma unroll
        for (int i = 0; i < PF; ++i) { const int u = bh * NBLK + S2_BLK(i); dnr[i] = DN[(size_t)(u * 2 + dir) * DQK + d]; btr[i] = BT[u * 2 + dir]; }
#pragma unroll
        for (int idx = 0; idx < NBLK; ++idx) {
            const int u = bh * NBLK + S2_BLK(idx);
            const float dn = dnr[idx % PF], dec = __expf(btr[idx % PF]);
            if (idx + PF < NBLK) { const int u2 = bh * NBLK + S2_BLK(idx + PF); dnr[idx % PF] = DN[(size_t)(u2 * 2 + dir) * DQK + d]; btr[idx % PF] = BT[u2 * 2 + dir]; }
            NST[(size_t)(u * 2 + dir) * DQK + d] = st; st = dec * st + dn;
        }
#undef S2_BLK
    }
}
__device__ __forceinline__ void lds_barrier() { asm volatile("s_waitcnt lgkmcnt(0)" ::: "memory"); __builtin_amdgcn_s_barrier(); asm volatile("" ::: "memory"); }
__device__ __forceinline__ void phase_s3(const Args& A, const Ctx& C, int l) {
    const int jl = l >> 1; const bool ctx_out = (l == 0);
    LAS float* bf = (LAS float*)C.lds; LAS float* bb = bf + 256; LAS float* gf = bb + 256; LAS float* gb = gf + 256;
    LAS float* nf = gb + 256; LAS float* nb = nf + 128; LAS float* ssx = nb + 128;
    LAS float* cf = ssx + 256; LAS float* cb = cf + 256;
    constexpr int KP = 272, OP = 528, CHB = 16384, NCHB = 4;
    LAS unsigned char* Kimg = C.lds + 8192;
    LAS unsigned char* CH = Kimg + 256 * KP;
    LAS unsigned char* OUT = Kimg;
    static_assert(8192 + 256 * KP + NCHB * CHB <= LDS_TAB_END && 8192 + 256 * OP <= LDS_TAB_END, "S3 LDS map");
    const bf16* P = (const bf16*)(A.ws + WS_PB); const bf16* VT = (const bf16*)(A.ws + WS_VT); unsigned char* HM = A.ws + WS_HM;
    const bf16* CST = (const bf16*)(A.ws + WS_CST); const float* NST = (const float*)(A.ws + WS_NST);
    const float* hg = A.in[10] + (size_t)jl * NV;
    const int w = C.wave;
    bf16x8 qf[8]; u32x4 kr8[8]; f32x4 gl;
#define S3_UNIT(it_) ((it_) < BATCH * NH * (NBLK - 1) ? ((it_) / (NBLK - 1)) * NBLK + 1 + (it_) % (NBLK - 1) : ((it_) - BATCH * NH * (NBLK - 1)) * NBLK)
#define S3_LOAD_IN(u_) do { const int u2_ = (u_); const int blk_ = u2_ % NBLK, bh_ = u2_ / NBLK, h_ = bh_ % NH, b_ = bh_ / NH; const int row0_ = blk_row0(b_, blk_); \
        int tq_ = threadIdx.x; asm volatile("" : "+v"(tq_)); const int lq_ = tq_ & 63; \
        { const bf16* qr_ = P + (size_t)(row0_ + 32 * w + (lq_ & 31)) * PW + h_ * DQK + 8 * (lq_ >> 5); \
          _Pragma("unroll") for (int kk = 0; kk < 8; ++kk) qf[kk] = *(const bf16x8*)(qr_ + 16 * kk); } \
        { const bf16* kr_ = P + (size_t)(row0_ + (tq_ >> 4)) * PW + NQ + h_ * DQK + 8 * (tq_ & 15); \
          _Pragma("unroll") for (int i = 0; i < 8; ++i) kr8[i] = *(const u32x4*)(kr_ + (size_t)(32 * i) * PW); } \
        if (tq_ < 256) { const float* g_ = (const float*)(A.ws + WS_GATE) + (size_t)(row0_ + tq_) * 16 + h_; gl = (f32x4){g_[0], g_[4], g_[8], g_[12]}; } \
        else { const int t2_ = tq_ - 256; gl = (f32x4){NST[(size_t)(u2_ * 2 + (t2_ >> 7)) * DQK + (t2_ & 127)], 0.f, 0.f, 0.f}; } } while (0)
    const int nitems = BATCH * NH * (NBLK - 1) + (ctx_out ? BATCH * NH : 0);
    int it = C.bid;
    if (it < nitems) S3_LOAD_IN(S3_UNIT(it));
    while (it < nitems) {
        const int u = S3_UNIT(it);
        const int blk = u % NBLK, bh = u / NBLK, h = bh % NH, b = bh / NH; const int row0 = blk_row0(b, blk);
        const int itn = it + C.G; const int un = itn < nitems ? S3_UNIT(itn) : u;
        const bf16* vtile = VT + (size_t)vt_tile(b, h, blk) * 65536;
        const bf16* ctile = CST + (size_t)(u * 2) * DQK * DV;
#define S3_DMA(c_) do { const int cc_ = (c_); const bool isv_ = cc_ < 8; int ld_ = threadIdx.x & 63; asm volatile("" : "+v"(ld_)); \
                const unsigned dlp_ = (unsigned)(((ld_ & 3) ^ ((ld_ >> 4) & 3)) * 16), drow_ = (unsigned)(32 * w + (ld_ >> 2)); \
                const unsigned long long gp_ = (unsigned long long)(isv_ ? (const char*)vtile + 16384 * cc_ : (const char*)ctile + (cc_ >= 12 ? 2 * DQK * DV : 0) + 16384 * ((cc_ - 8) & 3)); \
                const char* gb_ = (const char*)(((unsigned long long)(unsigned)__builtin_amdgcn_readfirstlane((int)(unsigned)(gp_ >> 32)) << 32) | (unsigned)__builtin_amdgcn_readfirstlane((int)(unsigned)gp_)); \
                _Pragma("unroll") for (int jj = 0; jj < 2; ++jj) \
                    asm volatile("s_mov_b32 m0, %2\n\ts_nop 0\n\tglobal_load_lds_dwordx4 %0, %1" :: "v"(((drow_ + 16u * jj) << 6) + dlp_), "s"(gb_), "s"((unsigned)(size_t)CH + (unsigned)w * 2048u + (unsigned)((cc_ & 3) * CHB + jj * 1024)) : "memory"); } while (0)
        S3_DMA(0); S3_DMA(1); S3_DMA(2);
        { int tu = threadIdx.x; asm volatile("" : "+v"(tu));
          if (tu < 256) { gf[tu] = gl.x; bf[tu] = gl.y; gb[tu] = gl.z; bb[tu] = gl.w; } else nf[tu - 256] = gl.x;
          { const int pc = tu & 15, s0 = tu >> 4, ps0 = (s0 & ~12) | ((s0 & 4) << 1) | ((s0 & 8) >> 1);
#pragma unroll
            for (int i = 0; i < 8; ++i) *(LAS u32x4*)(Kimg + (ps0 + 32 * i) * KP + pc * 16) = kr8[i]; }
          lds_barrier();
          const int lane = tu & 63, wv = tu >> 6;
          if (wv == 0) { f32x4 x = *(LAS f32x4*)(bf + 4 * lane); x.y += x.x; x.z += x.y; x.w += x.z; const float tot = wave_incl_scan(x.w, lane); const float ex = tot - x.w;
              x.x += ex; x.y += ex; x.z += ex; x.w += ex; *(LAS f32x4*)(bf + 4 * lane) = x; }
          if (wv == 1) { f32x4 y = *(LAS f32x4*)(bb + 4 * (63 - lane)); y.z += y.w; y.y += y.z; y.x += y.y; const float tot = wave_incl_scan(y.x, lane); const float ex = tot - y.x;
              y.x += ex; y.y += ex; y.z += ex; y.w += ex; *(LAS f32x4*)(bb + 4 * (63 - lane)) = y; }
          lds_barrier();
          if (tu < 256) { const float a0 = gf[tu] - bf[tu], a1 = gb[tu] - bb[tu]; gf[tu] = a0; gb[tu] = a1; cf[tu] = __expf(bf[tu | 31] + a0); cb[tu] = __expf(bb[tu & ~31] + a1); }
          lds_barrier(); }
        {
            int lz = threadIdx.x & 63; asm volatile("" : "+v"(lz));
            const int r = lz & 31, hh = lz >> 5;
            const int jt = w;
            const float bfj = bf[32 * jt + r], bbj = bb[32 * jt + r];
            float qnf = 0.f, qnb = 0.f;
#pragma unroll
            for (int kk = 0; kk < 8; ++kk) { u32x4 qq = __builtin_bit_cast(u32x4, qf[kk]); asm volatile("" : "+v"(qq));
                const int d = 16 * kk + 8 * hh;
                const f32x4 n0 = *(const LAS f32x4*)(nf + d), n1 = *(const LAS f32x4*)(nf + d + 4), m0 = *(const LAS f32x4*)(nb + d), m1 = *(const LAS f32x4*)(nb + d + 4);
                qnf += (bflo(qq.x) * n0.x + bfhi(qq.x) * n0.y) + (bflo(qq.y) * n0.z + bfhi(qq.y) * n0.w) + (bflo(qq.z) * n1.x + bfhi(qq.z) * n1.y) + (bflo(qq.w) * n1.z + bfhi(qq.w) * n1.w);
                qnb += (bflo(qq.x) * m0.x + bfhi(qq.x) * m0.y) + (bflo(qq.y) * m0.z + bfhi(qq.y) * m0.w) + (bflo(qq.z) * m1.x + bfhi(qq.z) * m1.y) + (bflo(qq.w) * m1.z + bfhi(qq.w) * m1.w);
                if (kk & 1) asm volatile("" ::: "memory"); }
            qnf += __shfl_xor(qnf, 32); qnb += __shfl_xor(qnb, 32);
            float denf = 0.f, denb = 0.f;
#pragma unroll 1
            for (int kt = 0; kt < 8; ++kt) {
                f32x16 c;
#pragma unroll
                for (int i = 0; i < 16; ++i) c[i] = 0.f;
#pragma unroll
                for (int kk = 0; kk < 8; ++kk) { const bf16x8 a = *(const LAS bf16x8*)(Kimg + (kt * 32 + r) * KP + (16 * kk + 8 * hh) * 2); c = MFMA32(a, qf[kk], c); }
                if (kt == jt) {
#pragma unroll
                    for (int g = 0; g < 4; ++g) { const int sl0 = 16 * (g >> 1) + 8 * hh + 4 * (g & 1);
                        const f32x4 g4f = *(const LAS f32x4*)(gf + kt * 32 + sl0), g4b = *(const LAS f32x4*)(gb + kt * 32 + sl0);
#pragma unroll
                        for (int q = 0; q < 4; ++q) { const int sl = sl0 + q; const float cv = c[4 * g + q];
                            denf += cv * __expf((sl <= r) ? bfj + g4f[q] : -1.0e30f); denb += cv * __expf((sl >= r) ? bbj + g4b[q] : -1.0e30f); } }
                } else {
                    LAS const float* cx = (kt < jt ? cf : cb) + kt * 32 + 8 * hh; float sm = 0.f;
#pragma unroll
                    for (int g = 0; g < 4; ++g) { const f32x4 c4 = *(const LAS f32x4*)(cx + 16 * (g >> 1) + 4 * (g & 1)); sm += (c[4 * g] * c4.x + c[4 * g + 1] * c4.y) + (c[4 * g + 2] * c4.z + c[4 * g + 3] * c4.w); }
                    if (kt < jt) denf += sm * __expf(bfj - bf[kt * 32 + 31]); else denb += sm * __expf(bbj - bb[kt * 32]);
                }
            }
            denf += __shfl_xor(denf, 32); denb += __shfl_xor(denb, 32);
            const float ebf = __expf(bfj), ebb = __expf(bbj);
            denf += ebf * qnf; denb += ebb * qnb;
            const float rf = 1.0f / fmaxf(fabsf(denf), 1.0f), rb = 1.0f / fmaxf(fabsf(denb), 1.0f);
            const float scf = ebf * rf, scb = ebb * rb;
            unsigned wdg[8];
#pragma unroll
            for (int g = 0; g < 4; ++g) { const int sl0 = 16 * (g >> 1) + 8 * hh + 4 * (g & 1);
                const f32x4 g4f = *(const LAS f32x4*)(gf + jt * 32 + sl0), g4b = *(const LAS f32x4*)(gb + jt * 32 + sl0);
                float wv[4];
#pragma unroll
                for (int q = 0; q < 4; ++q) { const int sl = sl0 + q; wv[q] = rf * __expf((sl <= r) ? bfj + g4f[q] : -1.0e30f) + rb * __expf((sl >= r) ? bbj + g4b[q] : -1.0e30f); }
                wdg[2 * g] = cvt2(wv[0], wv[1]); wdg[2 * g + 1] = cvt2(wv[2], wv[3]); }
            f32x16 acc[8];
#pragma unroll
            for (int et = 0; et < 8; ++et)
#pragma unroll
                for (int i = 0; i < 16; ++i) acc[et][i] = 0.f;
            asm volatile("s_waitcnt vmcnt(0)" ::: "memory");
            const int swz = (r >> 2) & 3;
#pragma unroll 1
            for (int ci = 0; ci < 8; ++ci) {
                if (ci) { if (blk == 0 && ci >= 6) { if (ci == 6) asm volatile("s_waitcnt vmcnt(2)" ::: "memory"); else asm volatile("s_waitcnt vmcnt(0)" ::: "memory"); } else asm volatile("s_waitcnt vmcnt(4)" ::: "memory"); }
                lds_barrier();
                if (blk != 0 || ci + 3 < 8) S3_DMA(ci + 3);
                LAS const unsigned char* CHc = CH + (ci & 3) * CHB;
                { const int kt = ci;
                        f32x16 c;
#pragma unroll
                        for (int i = 0; i < 16; ++i) c[i] = 0.f;
#pragma unroll
                        for (int kk = 0; kk < 8; ++kk) { const bf16x8 a = *(const LAS bf16x8*)(Kimg + (kt * 32 + r) * KP + (16 * kk + 8 * hh) * 2); c = MFMA32(a, qf[kk], c); }
                        float p[16];
                        if (kt == jt) {
#pragma unroll
                            for (int i = 0; i < 8; ++i) { p[2 * i] = c[2 * i] * bflo(wdg[i]); p[2 * i + 1] = c[2 * i + 1] * bfhi(wdg[i]); }
                        } else {
                            LAS const float* cx = (kt < jt ? cf : cb) + kt * 32 + 8 * hh;
                            const float rw = (kt < jt) ? rf * __expf(bfj - bf[kt * 32 + 31]) : rb * __expf(bbj - bb[kt * 32]);
#pragma unroll
                            for (int g = 0; g < 4; ++g) { const f32x4 c4 = *(const LAS f32x4*)(cx + 16 * (g >> 1) + 4 * (g & 1));
                                p[4 * g] = c[4 * g] * (c4.x * rw); p[4 * g + 1] = c[4 * g + 1] * (c4.y * rw); p[4 * g + 2] = c[4 * g + 2] * (c4.z * rw); p[4 * g + 3] = c[4 * g + 3] * (c4.w * rw); }
                        }
                        const bf16x8 pa0 = pack8(p[0], p[1], p[2], p[3], p[4], p[5], p[6], p[7]), pa1 = pack8(p[8], p[9], p[10], p[11], p[12], p[13], p[14], p[15]);
#pragma unroll
                        for (int et = 0; et < 8; ++et) { LAS const unsigned char* vb = CHc + (et * 32 + r) * 64;
                            const bf16x8 a0 = *(const LAS bf16x8*)(vb + ((hh ^ swz) << 4)), a1 = *(const LAS bf16x8*)(vb + (((2 + hh) ^ swz) << 4));
                            acc[et] = MFMA32(a0, pa0, acc[et]); acc[et] = MFMA32(a1, pa1, acc[et]);
                            if (et & 1) asm volatile("" ::: "memory"); }
                }
            }
            if (blk != 0) {
#pragma unroll
            for (int ci = 8; ci < 16; ++ci) {
                if (ci <= 13) asm volatile("s_waitcnt vmcnt(4)" ::: "memory"); else if (ci == 14) asm volatile("s_waitcnt vmcnt(2)" ::: "memory"); else asm volatile("s_waitcnt vmcnt(0)" ::: "memory");
                lds_barrier();
                if (ci + 3 < 16) S3_DMA(ci + 3);
                LAS const unsigned char* CHc = CH + (ci & 3) * CHB;
                {
                    const int dir = (ci - 8) >> 2, dq = (ci - 8) & 3;
                    const float sc = dir ? scb : scf;
#pragma unroll
                    for (int k2 = 0; k2 < 2; ++k2) { const u32x4 qq = __builtin_bit_cast(u32x4, qf[2 * dq + k2]);
                        const bf16x8 qs = pack8(bflo(qq.x) * sc, bfhi(qq.x) * sc, bflo(qq.y) * sc, bfhi(qq.y) * sc, bflo(qq.z) * sc, bfhi(qq.z) * sc, bflo(qq.w) * sc, bfhi(qq.w) * sc);
#pragma unroll
                        for (int et = 0; et < 8; ++et) { const bf16x8 a = *(const LAS bf16x8*)(CHc + (et * 32 + r) * 64 + (((2 * k2 + hh) ^ swz) << 4)); acc[et] = MFMA32(a, qs, acc[et]);
                            if ((et & 3) == 3) asm volatile("" ::: "memory"); } }
                }
            }
            }
            u32x4 ov[16]; f32x4 g0, g1;
            { int tz = threadIdx.x & 63; asm volatile("" : "+v"(tz)); const int pc = tz & 31, lr0 = tz >> 5;
              g0 = *(const f32x4*)(hg + h * DV + 8 * pc); g1 = *(const f32x4*)(hg + h * DV + 8 * pc + 4);
#pragma unroll
              for (int i = 0; i < 16; ++i) ov[i] = *(const u32x4*)(P + (size_t)(row0 + 32 * w + lr0 + 2 * i) * PW + 2 * NQ + NV + h * DV + 8 * pc); }
            float ss = 0.f;
#pragma unroll
            for (int et = 0; et < 8; ++et)
#pragma unroll
                for (int i = 0; i < 16; ++i) ss += acc[et][i] * acc[et][i];
            ss += __shfl_xor(ss, 32);
            const float rs = 1.0f / sqrtf(ss * (1.0f / DV) + EPS);
            lds_barrier();
            { LAS unsigned char* ob = OUT + (w * 32 + r) * OP + (4 * hh) * 2;
#pragma unroll
              for (int et = 0; et < 8; ++et)
#pragma unroll
                  for (int g = 0; g < 4; ++g) { u32x2 o; o.x = cvt2(acc[et][4 * g + 0] * rs, acc[et][4 * g + 1] * rs); o.y = cvt2(acc[et][4 * g + 2] * rs, acc[et][4 * g + 3] * rs);
                      *(LAS u32x2*)(ob + (et * 32 + 8 * g) * 2) = o; } }
            asm volatile("s_waitcnt lgkmcnt(0)" ::: "memory");
            S3_LOAD_IN(un);
            { int tz = threadIdx.x & 63; asm volatile("" : "+v"(tz)); const int pc = tz & 31, lr0 = tz >> 5;
#pragma unroll
              for (int i = 0; i < 16; ++i) { const int lr = 32 * w + lr0 + 2 * i; const int grow = row0 + lr;
                  const u32x4 hv = *(const LAS u32x4*)(OUT + lr * OP + pc * 16);
                  const f32x4 o0 = (f32x4){bflo(hv.x) * g0.x * bflo(ov[i].x), bfhi(hv.x) * g0.y * bfhi(ov[i].x), bflo(hv.y) * g0.z * bflo(ov[i].y), bfhi(hv.y) * g0.w * bfhi(ov[i].y)};
                  const f32x4 o1 = (f32x4){bflo(hv.z) * g1.x * bflo(ov[i].z), bfhi(hv.z) * g1.y * bfhi(ov[i].z), bflo(hv.w) * g1.z * bflo(ov[i].w), bfhi(hv.w) * g1.w * bfhi(ov[i].w)};
                  *(u32x2*)(HM + (size_t)grow * D + h * DV + 8 * pc) = (u32x2){pack_i8(o0 * (127.0f / HMR)), pack_i8(o1 * (127.0f / HMR))};
                  if ((i & 3) == 3) asm volatile("" ::: "memory"); } }
        }
#undef S3_DMA
        lds_barrier();
        it = itn;
    }
#undef S3_LOAD_IN
#undef S3_UNIT
}

#define XB_TMO      128
#define XB_XCNT(j)  (256  + 64 * (j))
#define XB_XSUB(j)  (1280 + 64 * (j))
#define XB_XGEN(j)  (2304 + 64 * (j))
#define XB_TOP      3328
#define XB_TOPGEN   3392
#define XCD_BAR_WORDS 3456
#define XB_SPIN_CAP (1u << 18)

__device__ __forceinline__ unsigned xb_ld(unsigned* p)              { return __hip_atomic_load(p, __ATOMIC_RELAXED, __HIP_MEMORY_SCOPE_AGENT); }
__device__ __forceinline__ unsigned xb_add(unsigned* p, unsigned v) { return __hip_atomic_fetch_add(p, v, __ATOMIC_RELAXED, __HIP_MEMORY_SCOPE_AGENT); }
__device__ __forceinline__ unsigned xb_xcc_id() { return (unsigned)__builtin_amdgcn_s_getreg((3 << 11) | 20) & 0xFu; }
#define XB_SPIN(cond, bar) do { unsigned _sp = 0; while (cond) { __builtin_amdgcn_s_sleep(1); \
    if ((++_sp & 255u) == 0u) { if (xb_ld(&(bar)[XB_TMO])) break; if (_sp > XB_SPIN_CAP) { atomicAdd(&(bar)[XB_TMO], 1u); break; } } } } while (0)

struct XcdBarrier {
    unsigned* bar; unsigned x;
    volatile LAS unsigned* st;
};

__device__ __forceinline__ XcdBarrier xcd_barrier_post(unsigned* bar, volatile LAS unsigned* st) {
    XcdBarrier b; b.bar = bar; b.x = xb_xcc_id(); b.st = st;
    if (threadIdx.x == 0) (void)xb_add(&bar[XB_XCNT(b.x)], 1u);
    return b;
}
__device__ __forceinline__ void xcd_barrier_complete(unsigned* bar, unsigned x, unsigned& nloc, unsigned& nx) {
    const unsigned G = gridDim.x * gridDim.y * gridDim.z;
    unsigned sum, cnt, mine, sp = 0u;
    for (;;) {
        sum = 0u; cnt = 0u; mine = 0u;
#pragma unroll
        for (unsigned j = 0; j < 16; ++j) { const unsigned c = xb_ld(&bar[XB_XCNT(j)]); sum += c; cnt += (c > 0u) ? 1u : 0u; mine = (j == x) ? c : mine; }
        if (sum == G) break;
        __builtin_amdgcn_s_sleep(1);
        if ((++sp & 255u) == 0u) { if (xb_ld(&bar[XB_TMO])) break; if (sp > XB_SPIN_CAP) { atomicAdd(&bar[XB_TMO], 1u); break; } }
    }
    nloc = mine > 0u ? mine : 1u; nx = cnt > 0u ? cnt : 1u;
}

__device__ __forceinline__ void xcd_barrier(const XcdBarrier& b) {
    asm volatile("s_waitcnt vmcnt(0)" ::: "memory");
    __syncthreads();
    if (threadIdx.x == 0) {
        unsigned* bar = b.bar;
        __builtin_amdgcn_s_waitcnt(0);
        unsigned nloc = b.st[0], nx = b.st[1];
        if (nloc == 0u) { xcd_barrier_complete(bar, b.x, nloc, nx); b.st[0] = nloc; b.st[1] = nx; }
        const unsigned old = xb_add(&bar[XB_XSUB(b.x)], 1u);
        const unsigned gen = old / nloc;
        if (old + 1u == (gen + 1u) * nloc) {
            __builtin_amdgcn_fence(__ATOMIC_RELEASE, "agent");
            asm volatile("s_waitcnt vmcnt(0)" ::: "memory");
            const unsigned og = xb_add(&bar[XB_TOP], 1u);
            const unsigned tg = og / nx;
            if (og + 1u == (tg + 1u) * nx) xb_add(&bar[XB_TOPGEN], 1u);
            else XB_SPIN(xb_ld(&bar[XB_TOPGEN]) == tg, bar);
            __builtin_amdgcn_fence(__ATOMIC_ACQUIRE, "agent");
            xb_add(&bar[XB_XGEN(b.x)], 1u);
            asm volatile("s_waitcnt vmcnt(0)" ::: "memory");
        } else {
            XB_SPIN(xb_ld(&bar[XB_XGEN(b.x)]) == gen, bar);
            __builtin_amdgcn_fence(__ATOMIC_ACQUIRE, "agent");
            asm volatile("s_waitcnt vmcnt(0)" ::: "memory");
        }
    }
    __syncthreads();
}


constexpr int LDS_BYTES = 152 * 1024;
constexpr int CW_BAR = 16384;
static_assert((CW_BAR + XCD_BAR_WORDS) * 4 <= (int)CTL_BYTES, "ctl");
#ifndef MK_MULTI
#define MK_MULTI 0
#endif
#define IN(p) (lo <= (p) && (p) < hi)
#define SEAM(p) do { if ((p) + 1 < hi) { XcdBarrier b_; b_.bar = (unsigned*)(load_args().ws + WS_CTL) + CW_BAR; b_.x = xb_xcc_id(); b_.st = (volatile LAS unsigned*)(C.lds + LDS_BYTES - 16); xcd_barrier(b_); } } while (0)
#define CAS __attribute__((address_space(4)))
__device__ __forceinline__ Args load_args() {
#if defined(__HIP_DEVICE_COMPILE__)
    const CAS Args* p = (const CAS Args*)__builtin_amdgcn_kernarg_segment_ptr(); asm volatile("" : "+s"(p));
    Args a; for (int i = 0; i < 22; ++i) a.in[i] = p->in[i]; a.out = p->out; a.ws = p->ws; a.lo = p->lo; a.hi = p->hi; return a;
#else
    return Args{};
#endif
}
__device__ __forceinline__ Ctx fresh(const Ctx& C) { Ctx R = C; int tz = threadIdx.x; asm volatile("" : "+v"(tz)); R.tid = tz; R.lane = tz & 63; return R; }
template <int L> __device__ __forceinline__ void layer_phases(const Args& args, const Ctx& C, int bar, int lo, int hi) {
    constexpr int pb = 16 * L;
    if (IN(pb + 1)) { phase_r1(load_args(), fresh(C), L); SEAM(pb + 1); }
    if (IN(pb + 2)) { phase_g1(load_args(), fresh(C), L); SEAM(pb + 2); }
    if constexpr ((L & 1) == 0) {
        if (IN(pb + 3)) { phase_s1(load_args(), fresh(C), L); SEAM(pb + 3); }
        if (IN(pb + 4)) { phase_s2(load_args(), fresh(C)); SEAM(pb + 4); }
        if (IN(pb + 5)) { phase_s3(load_args(), fresh(C), L); SEAM(pb + 5); }
    } else {
        if (IN(pb + 3)) { phase_conv(load_args(), fresh(C), L); SEAM(pb + 3); }
    }
    if (IN(pb + 6)) { phase_g2(load_args(), fresh(C), L); SEAM(pb + 6); }
    if (IN(pb + 7)) { phase_r2(load_args(), fresh(C), L); SEAM(pb + 7); }
    if (IN(pb + 8)) { phase_m1(load_args(), fresh(C), L); SEAM(pb + 8); }
    if (IN(pb + 9)) { phase_m2(load_args(), fresh(C), L); SEAM(pb + 9); }
}
__global__ void __launch_bounds__(NT, 2) fwd_kernel(Args args) {
    extern __shared__ __attribute__((aligned(16))) unsigned char lds_raw[];
    Ctx C; C.lds = (LAS unsigned char*)lds_raw; C.tid = threadIdx.x; C.lane = C.tid & 63; C.wave = __builtin_amdgcn_readfirstlane(C.tid >> 6); C.G = gridDim.x; C.bid = blockIdx.x; C.a = &args;
    const int lo = args.lo, hi = args.hi;
    volatile LAS unsigned* xbw = (volatile LAS unsigned*)(C.lds + LDS_BYTES - 16);
    if (C.tid < 4) xbw[C.tid] = 0u;
    __syncthreads();
    if (hi - lo > 1) (void)xcd_barrier_post((unsigned*)(args.ws + WS_CTL) + CW_BAR, xbw);
    const int bar = 0; (void)bar;
    if (IN(0)) { phase_mod(load_args(), fresh(C)); __syncthreads(); phase_cvt_mixer(load_args(), fresh(C)); SEAM(0); }
    layer_phases<0>(args, C, bar, lo, hi);
    layer_phases<1>(args, C, bar, lo, hi);
    layer_phases<2>(args, C, bar, lo, hi);
    layer_phases<3>(args, C, bar, lo, hi);
    if (IN(64)) phase_final(load_args(), fresh(C));
}
#undef IN
#undef SEAM

extern "C" void kernel_launch(void* const* d_in, const int* in_sizes, int n_in, void* d_out, int out_size, void* d_ws, size_t ws_size, hipStream_t stream) {
    static int grid = 0;
    if (grid == 0) {
        if (n_in != 22 || out_size != NL * D || ws_size < WS_END) { fprintf(stderr, "kernel_launch: unexpected shapes (n_in %d out %d ws %zu)\n", n_in, out_size, ws_size); grid = -1; return; }
        int dev = 0, cus = 0, per_cu = 0;
        if (hipGetDevice(&dev) != hipSuccess || hipDeviceGetAttribute(&cus, hipDeviceAttributeMultiprocessorCount, dev) != hipSuccess) { grid = -1; return; }
        if (hipFuncSetAttribute((const void*)fwd_kernel, hipFuncAttributeMaxDynamicSharedMemorySize, LDS_BYTES) != hipSuccess) { grid = -1; return; }
        if (hipOccupancyMaxActiveBlocksPerMultiprocessor(&per_cu, (const void*)fwd_kernel, NT, LDS_BYTES) != hipSuccess || per_cu < 1) { fprintf(stderr, "kernel_launch: occupancy query says %d\n", per_cu); }
        (void)hipGetLastError();
        grid = cus;
    }
    if (grid < 0) return;
    (void)hipMemsetAsync((char*)d_ws + WS_CTL, 0, CTL_BYTES, stream);
    Args a{};
    for (int i = 0; i < 22; ++i) a.in[i] = (const float*)d_in[i];
    a.out = (float*)d_out; a.ws = (unsigned char*)d_ws;
#if MK_MULTI
    int phases[64]; int np = 0;
    phases[np++] = 0;
    for (int l = 0; l < DEPTH; ++l) { const int pb = 16 * l; phases[np++] = pb + 1; phases[np++] = pb + 2; phases[np++] = pb + 3;
        if ((l & 1) == 0) { phases[np++] = pb + 4; phases[np++] = pb + 5; }
        phases[np++] = pb + 6; phases[np++] = pb + 7; phases[np++] = pb + 8; phases[np++] = pb + 9; }
    phases[np++] = 64;
    for (int i = 0; i < np; ++i) { a.lo = phases[i]; a.hi = phases[i] + 1; hipLaunchKernelGGL(fwd_kernel, dim3(grid), dim3(NT), LDS_BYTES, stream, a); }
#else
    a.lo = 0; a.hi = 65;
    hipLaunchKernelGGL(fwd_kernel, dim3(grid), dim3(NT), LDS_BYTES, stream, a);
#ifdef PROBE_PHASES
    { const int pp[] = {PROBE_PHASES};
      for (int rep = 0; rep < PROBE_REPS; ++rep) for (unsigned i = 0; i < sizeof(pp) / sizeof(pp[0]); ++i) { a.lo = pp[i]; a.hi = pp[i] + 1; hipLaunchKernelGGL(fwd_kernel, dim3(grid), dim3(NT), LDS_BYTES, stream, a); } }
#endif
#endif
}
```

```cpp
#include <hip/hip_runtime.h>
#include <cstdio>
#include <cstdint>

#define LAS __attribute__((address_space(3)))
typedef unsigned short bf16;
typedef float f32x4 __attribute__((ext_vector_type(4)));
typedef unsigned u32x4 __attribute__((ext_vector_type(4)));
typedef unsigned u32x2 __attribute__((ext_vector_type(2)));
typedef int i32x4r __attribute__((ext_vector_type(4)));

constexpr int D = 1024, BATCH = 2, SEQ = 16384, DEPTH = 4, CTXL = 256;
constexpr int NL = BATCH * SEQ, NCX = BATCH * CTXL, NR = NL + NCX;
constexpr int NH = 4, DQK = 128, DV = 256, NQ = 512, NV = 1024, PROJ = 3088, PW = 3072;
constexpr int NGRP = 4, EPG = 8, NE = 32, DE = 512;
constexpr int NBLK = 65;
constexpr int NUNIT = BATCH * NH * NBLK;
constexpr int CAP = NR;
constexpr int YROWS = 74752;
constexpr float EPS = 1e-6f;
constexpr float WSCALE = 32.0f;
constexpr float YSCALE = 4.0f;
constexpr int NT = 512, NW = 8;
constexpr int LDS_TAB_END = 152 * 1024 - 16;

constexpr size_t MiB = 1u << 20;
constexpr size_t WS_CTL = 0, CTL_BYTES = 1 * MiB;
constexpr size_t WS_MOD = 1 * MiB;
constexpr size_t WS_GATE = 2 * MiB;
constexpr size_t WS_TOKSLOT = 5 * MiB;
constexpr size_t WS_TOKW = 6 * MiB;
constexpr size_t WS_SLOTTOK = 7 * MiB;
constexpr size_t WS_DN = 12 * MiB;
constexpr size_t WS_NST = 13 * MiB;
constexpr size_t WS_BTOT = 14 * MiB;
constexpr size_t WS_RSC = 15 * MiB;
constexpr size_t WS_LAT = 16 * MiB;
constexpr size_t WS_HB = 146 * MiB;
constexpr size_t WS_PB = 211 * MiB;
constexpr size_t WS_HM = 406 * MiB;
constexpr size_t WS_DC = 471 * MiB;
constexpr size_t WS_CST = 601 * MiB;
constexpr size_t WS_VT = 666 * MiB;
constexpr size_t WS_WAIN = 731 * MiB;
constexpr size_t WS_WBIN = 743 * MiB;
constexpr size_t WS_WAOUT = 755 * MiB;
constexpr size_t WS_WBOUT = 759 * MiB;
constexpr size_t WS_WGU = 763 * MiB;
constexpr size_t WS_WDN = 827 * MiB;
constexpr size_t WS_H8 = 843 * MiB;
constexpr size_t WS_END = 880 * MiB;
constexpr int CW_WMAX = 256;
constexpr int CW_CNT = 1024, CNT_STRIDE = 64;

struct Args { const float* in[22]; float* out; unsigned char* ws; int lo, hi; };

typedef short bf16x8 __attribute__((ext_vector_type(8)));
typedef float f32x2 __attribute__((ext_vector_type(2)));
typedef __bf16 bf16x2_t __attribute__((ext_vector_type(2)));
__device__ __forceinline__ unsigned cvt2(float lo, float hi) { const f32x2 v = {lo, hi}; return __builtin_bit_cast(unsigned, __builtin_convertvector(v, bf16x2_t)); }
__device__ __forceinline__ float bf2f(bf16 v) { return __uint_as_float(((unsigned)v) << 16); }
__device__ __forceinline__ unsigned f2bf(float f) { return cvt2(f, 0.f) & 0xffffu; }
__device__ __forceinline__ unsigned pk2(float lo, float hi) { return cvt2(lo, hi); }
template <int CTRL, int ROWMASK> __device__ __forceinline__ float dpp_mov(float x) { return __int_as_float(__builtin_amdgcn_update_dpp(0, __float_as_int(x), CTRL, ROWMASK, 0xf, false)); }
__device__ __forceinline__ float wave_sum(float v) {
    v += dpp_mov<0xB1, 0xf>(v); v += dpp_mov<0x4E, 0xf>(v); v += dpp_mov<0x141, 0xf>(v); v += dpp_mov<0x140, 0xf>(v);
    v += dpp_mov<0x142, 0xA>(v); v += dpp_mov<0x143, 0xC>(v);
    return __int_as_float(__builtin_amdgcn_readlane(__float_as_int(v), 63));
}
__device__ __forceinline__ float wave_max_nn(float v) {
    v = fmaxf(v, dpp_mov<0xB1, 0xf>(v)); v = fmaxf(v, dpp_mov<0x4E, 0xf>(v)); v = fmaxf(v, dpp_mov<0x141, 0xf>(v)); v = fmaxf(v, dpp_mov<0x140, 0xf>(v));
    v = fmaxf(v, dpp_mov<0x142, 0xA>(v)); v = fmaxf(v, dpp_mov<0x143, 0xC>(v));
    return __int_as_float(__builtin_amdgcn_readlane(__float_as_int(v), 63));
}
__device__ __forceinline__ unsigned pack_i8_nc(f32x4 v) {
    const unsigned a = __float_as_uint(v.x + 12582912.0f), b = __float_as_uint(v.y + 12582912.0f), c = __float_as_uint(v.z + 12582912.0f), d = __float_as_uint(v.w + 12582912.0f);
    return __builtin_amdgcn_perm(__builtin_amdgcn_perm(d, c, 0x0c0c0400u) , __builtin_amdgcn_perm(b, a, 0x0c0c0400u), 0x05040100u);
}
__device__ __forceinline__ unsigned pack_i8(f32x4 v) {
    return pack_i8_nc((f32x4){__builtin_amdgcn_fmed3f(v.x, -127.f, 127.f), __builtin_amdgcn_fmed3f(v.y, -127.f, 127.f), __builtin_amdgcn_fmed3f(v.z, -127.f, 127.f), __builtin_amdgcn_fmed3f(v.w, -127.f, 127.f)});
}
__device__ __forceinline__ float sigmoidf_(float x) { return 1.f / (1.f + __expf(-x)); }
__device__ __forceinline__ float siluf_(float x) { return x / (1.f + __expf(-x)); }
__device__ __forceinline__ float logsigmoidf_(float x) { return fminf(x, 0.f) - log1pf(__expf(-fabsf(x))); }
__device__ __forceinline__ int blk_row0(int b, int blk) { return blk == 0 ? NL + b * CTXL : b * SEQ + (blk - 1) * 256; }
__device__ __forceinline__ int mod_vec_of_row(int row) { return row < NL ? row / SEQ : 2; }

struct Ctx {
    LAS unsigned char* lds; int tid, lane, wave, G, bid;
    const Args* a;
};

__device__ __forceinline__ int expert_block_prefix(const unsigned* cnt, int lane, int& nb) {
    nb = lane < NE ? ((int)cnt[lane * CNT_STRIDE] + 255) / 256 : 0; int v = nb;
#pragma unroll
    for (int o = 1; o < 64; o <<= 1) { const int t = __shfl_up(v, o); v += (lane >= o) ? t : 0; }
    return v - nb;
}
__device__ __forceinline__ void slot_bases(const Args& A, int l, LAS int* sb, int tid) {
    if (tid < 64) { int nb; const int ex = expert_block_prefix((const unsigned*)(A.ws + WS_CTL) + CW_CNT + l * 32 * CNT_STRIDE, tid, nb); if (tid <= NE) sb[tid] = ex * 256; }
    __syncthreads();
}

__device__ __forceinline__ void phase_mod(const Args& A, const Ctx& C) {
    LAS float* sc = (LAS float*)C.lds;
    LAS float* red = sc + 3072;
    const float* c = A.in[1]; const float* cc = A.in[3];
    for (int i = C.tid; i < 3072; i += NT) { const float v = i < 2048 ? c[i] : cc[i - 2048]; sc[i] = siluf_(v); }
    __syncthreads();
    float* MOD = (float*)(A.ws + WS_MOD);
    for (int u = C.bid; u < DEPTH * 192; u += C.G) {
        const int l = u / 192, cg = u % 192, col = cg * 32 + (C.lane & 31), kh = C.lane >> 5;
        const float* w = A.in[4] + (size_t)l * D * 6 * D + col + (size_t)(C.wave * 128 + kh * 64) * 6 * D;
        float wv[64];
#pragma unroll
        for (int k = 0; k < 64; ++k) wv[k] = w[(size_t)k * 6 * D];
        LAS const float* s0 = sc + C.wave * 128 + kh * 64;
        float a0 = 0.f, a1 = 0.f, a2 = 0.f;
#pragma unroll
        for (int k = 0; k < 64; ++k) { a0 += s0[k] * wv[k]; a1 += s0[1024 + k] * wv[k]; a2 += s0[2048 + k] * wv[k]; }
        a0 += __shfl_xor(a0, 32); a1 += __shfl_xor(a1, 32); a2 += __shfl_xor(a2, 32);
        if (kh == 0) { red[(C.wave * 3 + 0) * 64 + C.lane] = a0; red[(C.wave * 3 + 1) * 64 + C.lane] = a1; red[(C.wave * 3 + 2) * 64 + C.lane] = a2; }
        __syncthreads();
        if (C.tid < 96) { const int v = C.tid / 32, ln = C.tid % 32; float s = 0.f;
            for (int w8 = 0; w8 < 8; ++w8) s += red[(w8 * 3 + v) * 64 + ln];
            MOD[(size_t)(l * 3 + v) * 6 * D + cg * 32 + ln] = s + A.in[5][(size_t)l * 6 * D + cg * 32 + ln]; }
        __syncthreads();
    }
}
__device__ __forceinline__ void load_row_f32(const float* p, int lane, f32x4 (&v)[4]) {
#pragma unroll
    for (int j = 0; j < 4; ++j) v[j] = *(const f32x4*)(p + 4 * lane + 256 * j);
}
__device__ __forceinline__ void load_row_bf16(const bf16* p, int lane, f32x4 (&v)[4]) {
#pragma unroll
    for (int j = 0; j < 4; ++j) { const u32x2 w = *(const u32x2*)(p + 4 * lane + 256 * j);
        v[j] = (f32x4){__uint_as_float(w.x << 16), __uint_as_float(w.x & 0xffff0000u), __uint_as_float(w.y << 16), __uint_as_float(w.y & 0xffff0000u)}; }
}
__device__ __forceinline__ void store_row_bf16(bf16* p, int lane, const f32x4 (&v)[4]) {
#pragma unroll
    for (int j = 0; j < 4; ++j) { u32x2 w; w.x = pk2(v[j].x, v[j].y); w.y = pk2(v[j].z, v[j].w); *(u32x2*)(p + 4 * lane + 256 * j) = w; }
}
constexpr int CVT_IG = (D / 64) * (DE / 32), CVT_ID = (DE / 64) * (D / 32), CVT_PER = 2 * CVT_IG + CVT_ID, CVT_ITEMS = NE * CVT_PER;
constexpr int CVT_Q = 24;
__device__ __forceinline__ void cvt_moe_items(const Args& A, const Ctx& C, int l, int it0, int end, int stride);
__device__ __forceinline__ void cvt_win_i8(const Args& A, const Ctx& C);
__device__ __forceinline__ int cvt_t2(int l, int G);
struct RowVec { f32x4 a[4], s[4], g[4]; };
__device__ __forceinline__ void load_rowvec(RowVec& R, const float* ng, const float* sh, const float* sc, const float* gt, int lane) {
    f32x4 n[4], c[4]; load_row_f32(ng, lane, n); load_row_f32(sc, lane, c); load_row_f32(sh, lane, R.s); if (gt) load_row_f32(gt, lane, R.g);
#pragma unroll
    for (int q = 0; q < 4; ++q) R.a[q] = n[q] * (1.f + c[q]);
}
__device__ __forceinline__ void load_row_bf16raw(const bf16* p, int lane, u32x2 (&v)[4]) {
#pragma unroll
    for (int j = 0; j < 4; ++j) v[j] = *(const u32x2*)(p + 4 * lane + 256 * j);
}
__device__ __forceinline__ void store_row_fp8(unsigned char* p, int lane, const f32x4 (&v)[4]) {
#pragma unroll
    for (int j = 0; j < 4; ++j) { int w = 0; w = __builtin_amdgcn_cvt_pk_fp8_f32(v[j].x, v[j].y, w, false); w = __builtin_amdgcn_cvt_pk_fp8_f32(v[j].z, v[j].w, w, true); *(unsigned*)(p + 4 * lane + 256 * j) = (unsigned)w; }
}
__device__ __forceinline__ void load_row_fp8raw(const unsigned char* p, int lane, unsigned (&v)[4]) {
#pragma unroll
    for (int j = 0; j < 4; ++j) v[j] = *(const unsigned*)(p + 4 * lane + 256 * j);
}
__device__ __forceinline__ f32x4 fp8x4(unsigned w) { const f32x2 lo = __builtin_amdgcn_cvt_pk_f32_fp8((int)w, false), hi = __builtin_amdgcn_cvt_pk_f32_fp8((int)w, true); return (f32x4){lo.x, lo.y, hi.x, hi.y}; }
__device__ __forceinline__ f32x4 bf4(u32x2 w) { return (f32x4){__uint_as_float(w.x << 16), __uint_as_float(w.x & 0xffff0000u), __uint_as_float(w.y << 16), __uint_as_float(w.y & 0xffff0000u)}; }
__device__ __forceinline__ float row_rstd(const f32x4 (&v)[4]) {
    float s = 0.f;
#pragma unroll
    for (int j = 0; j < 4; ++j) s += (v[j].x * v[j].x + v[j].y * v[j].y) + (v[j].z * v[j].z + v[j].w * v[j].w);
    return 1.0f / sqrtf(wave_sum(s) * (1.f / D) + EPS);
}

__device__ __forceinline__ void phase_r1(const Args& A, const Ctx& C, int l) {
    LAS int* sb = (LAS int*)C.lds;
    constexpr int GWP = 2064;
    LAS unsigned char* GW = C.lds + 256;
    LAS unsigned char* HS = C.lds + 256 + 16 * GWP + C.wave * 2 * GWP;
    const bool mls = (l & 1) == 0; const int j = l >> 1;
    if (l == 0) { cvt_win_i8(A, C); __syncthreads(); }
    if (l > 0) slot_bases(A, l - 1, sb, C.tid);
    if (mls) { const float* w = A.in[8] + (size_t)j * D * PROJ + PW;
        f32x4 t[2][4];
#pragma unroll
        for (int jj = 0; jj < 2; ++jj)
#pragma unroll
            for (int q = 0; q < 4; ++q) t[jj][q] = *(const f32x4*)(w + (size_t)(C.tid + NT * jj) * PROJ + 4 * q);
#pragma unroll
        for (int jj = 0; jj < 2; ++jj)
#pragma unroll
            for (int q = 0; q < 4; ++q) { const int k = C.tid + NT * jj;
#pragma unroll
                for (int c = 0; c < 4; ++c) *(LAS unsigned short*)(GW + (4 * q + c) * GWP + k * 2) = (unsigned short)f2bf(t[jj][q][c]); }
        __syncthreads(); }
    const int nrows = (l <= 2) ? NR : NL;
    bf16* LAT = (bf16*)(A.ws + WS_LAT); unsigned char* HI8 = A.ws + WS_H8; float* RSC = (float*)(A.ws + WS_RSC); float* GATE = (float*)(A.ws + WS_GATE);
    const float* MOD = (const float*)(A.ws + WS_MOD); const unsigned char* Y8 = A.ws + WS_PB;
    const int* TS = (const int*)(A.ws + WS_TOKSLOT); const float* TW = (const float*)(A.ws + WS_TOKW);
    const int rpw = (((nrows + C.G - 1) / C.G) + 1) & ~1; const int wrow0 = C.bid * rpw; const int wend = min(wrow0 + rpw, nrows);
    for (int sa = wrow0; sa < wend;) {
        const int mvi = mod_vec_of_row(sa); const int bnd = mvi == 0 ? SEQ : (mvi == 1 ? NL : NR); const int sbnd = min(wend, bnd);
        RowVec RV; { const float* mv = MOD + (size_t)(l * 3 + mvi) * 6 * D;
            load_rowvec(RV, A.in[6] + (size_t)(l * 2 + 0) * D, mv + 0 * D, mv + 1 * D, l > 0 ? MOD + (size_t)((l - 1) * 3 + mvi) * 6 * D + 5 * D : nullptr, C.lane); }
        const int rlast = sbnd - 2; const int rfirst = sa + 2 * C.wave;
        i32x4r ts1 = (i32x4r){0, 0, 0, 0}, ts2 = ts1; f32x4 tw1 = (f32x4){0.f, 0.f, 0.f, 0.f}, tw2 = tw1;
        u32x2 nla[4], nlb[4]; unsigned nya0[4], nya1[4], nyb0[4], nyb1[4]; f32x4 nxa[4], nxb[4];
#define R1_FETCH(r_, ts_) do { const int fa_ = (r_), fb_ = fa_ + 1; \
            if (l == 0) { load_row_f32(fa_ < NL ? A.in[0] + (size_t)fa_ * D : A.in[2] + (size_t)(fa_ - NL) * D, C.lane, nxa); load_row_f32(fb_ < NL ? A.in[0] + (size_t)fb_ * D : A.in[2] + (size_t)(fb_ - NL) * D, C.lane, nxb); } \
            else { load_row_bf16raw(LAT + (size_t)fa_ * D, C.lane, nla); load_row_bf16raw(LAT + (size_t)fb_ * D, C.lane, nlb); \
                load_row_fp8raw(Y8 + (size_t)(sb[(ts_).x >> 20] + ((ts_).x & 0xfffff)) * D, C.lane, nya0); load_row_fp8raw(Y8 + (size_t)(sb[(ts_).y >> 20] + ((ts_).y & 0xfffff)) * D, C.lane, nya1); \
                load_row_fp8raw(Y8 + (size_t)(sb[(ts_).z >> 20] + ((ts_).z & 0xfffff)) * D, C.lane, nyb0); load_row_fp8raw(Y8 + (size_t)(sb[(ts_).w >> 20] + ((ts_).w & 0xfffff)) * D, C.lane, nyb1); } } while (0)
        if (l > 0) { const int r0 = min(rfirst, rlast), r1 = min(rfirst + 2 * NW, rlast);
            ts1 = *(const i32x4r*)(TS + r0 * 2); tw1 = *(const f32x4*)(TW + r0 * 2); ts2 = *(const i32x4r*)(TS + r1 * 2); tw2 = *(const f32x4*)(TW + r1 * 2); }
        R1_FETCH(min(rfirst, rlast), ts1);
        for (int ra = rfirst; ra < sbnd; ra += 2 * NW) {
            const bool hasb = true; const int rb = ra + 1;
            f32x4 va[4], vb[4];
            if (l == 0) {
#pragma unroll
                for (int q = 0; q < 4; ++q) { va[q] = nxa[q]; vb[q] = nxb[q]; }
                R1_FETCH(min(ra + 2 * NW, rlast), ts1);
            } else {
                u32x2 la[4], lb[4]; unsigned ya0[4], ya1[4], yb0[4], yb1[4];
#pragma unroll
                for (int q = 0; q < 4; ++q) { la[q] = nla[q]; lb[q] = nlb[q]; ya0[q] = nya0[q]; ya1[q] = nya1[q]; yb0[q] = nyb0[q]; yb1[q] = nyb1[q]; }
                const f32x4 twc = tw1;
                ts1 = ts2; tw1 = tw2;
                { const int r2 = min(ra + 4 * NW, rlast); ts2 = *(const i32x4r*)(TS + r2 * 2); tw2 = *(const f32x4*)(TW + r2 * 2); }
                R1_FETCH(min(ra + 2 * NW, rlast), ts1);
                const float wa0 = twc.x * (1.0f / YSCALE), wa1 = twc.y * (1.0f / YSCALE), wb0 = twc.z * (1.0f / YSCALE), wb1 = twc.w * (1.0f / YSCALE);
#pragma unroll
                for (int q = 0; q < 4; ++q) { va[q] = bf4(la[q]) + RV.g[q] * (fp8x4(ya0[q]) * wa0 + fp8x4(ya1[q]) * wa1); vb[q] = bf4(lb[q]) + RV.g[q] * (fp8x4(yb0[q]) * wb0 + fp8x4(yb1[q]) * wb1); }
            }
            store_row_bf16(LAT + (size_t)ra * D, C.lane, va); if (hasb) store_row_bf16(LAT + (size_t)rb * D, C.lane, vb);
            const float rra = row_rstd(va), rrb = row_rstd(vb);
            f32x4 ha[4], hb[4];
#pragma unroll
            for (int q = 0; q < 4; ++q) { ha[q] = (va[q] * rra) * RV.a[q] + RV.s[q]; hb[q] = (vb[q] * rrb) * RV.a[q] + RV.s[q]; }
            { float ma = 0.f, mb = 0.f;
#pragma unroll
              for (int q = 0; q < 4; ++q) { ma = fmaxf(ma, fmaxf(fmaxf(fabsf(ha[q].x), fabsf(ha[q].y)), fmaxf(fabsf(ha[q].z), fabsf(ha[q].w)))); mb = fmaxf(mb, fmaxf(fmaxf(fabsf(hb[q].x), fabsf(hb[q].y)), fmaxf(fabsf(hb[q].z), fabsf(hb[q].w)))); }
              ma = fmaxf(wave_max_nn(ma), 1.0e-20f); mb = fmaxf(wave_max_nn(mb), 1.0e-20f);
              const float ia = 127.0f / ma, ib = 127.0f / mb;
#pragma unroll
              for (int q = 0; q < 4; ++q) { *(unsigned*)(HI8 + (size_t)ra * D + 4 * C.lane + 256 * q) = pack_i8_nc(ha[q] * ia); *(unsigned*)(HI8 + (size_t)rb * D + 4 * C.lane + 256 * q) = pack_i8_nc(hb[q] * ib); }
              if (C.lane == 0) { RSC[ra] = ma * (1.0f / 127.0f); RSC[rb] = mb * (1.0f / 127.0f); } }
            if (mls) {
#pragma unroll
                for (int q = 0; q < 4; ++q) { *(LAS u32x2*)(HS + (4 * C.lane + 256 * q) * 2) = (u32x2){cvt2(ha[q].x, ha[q].y), cvt2(ha[q].z, ha[q].w)}; *(LAS u32x2*)(HS + GWP + (4 * C.lane + 256 * q) * 2) = (u32x2){cvt2(hb[q].x, hb[q].y), cvt2(hb[q].z, hb[q].w)}; }
                asm volatile("s_waitcnt lgkmcnt(0)" ::: "memory");
                f32x4 gacc = (f32x4){0.f, 0.f, 0.f, 0.f};
                { const int gi = C.lane & 15, kg = C.lane >> 4; LAS const unsigned char* ap = HS + (gi & 1) * GWP + kg * 16; LAS const unsigned char* bp = GW + gi * GWP + kg * 16;
#pragma unroll 8
                  for (int s2 = 0; s2 < 32; ++s2) { bf16x8 av = *(const LAS bf16x8*)(ap + s2 * 64); const bf16x8 bv = *(const LAS bf16x8*)(bp + s2 * 64);
                      if (gi >= 2) av = (bf16x8){0, 0, 0, 0, 0, 0, 0, 0};
                      gacc = __builtin_amdgcn_mfma_f32_16x16x32_bf16(av, bv, gacc, 0, 0, 0); } }
                float ga = gacc[0], gb = gacc[1];
                if (C.lane < 16) {
                    const float bgt = A.in[9][j * 16 + C.lane]; const int gtype = C.lane >> 2;
                    ga += bgt; gb += bgt;
                    GATE[(size_t)ra * 16 + C.lane] = (gtype & 1) ? logsigmoidf_(ga) : 15.0f * tanhf(ga * (1.0f / 15.0f));
                    if (hasb) GATE[(size_t)rb * 16 + C.lane] = (gtype & 1) ? logsigmoidf_(gb) : 15.0f * tanhf(gb * (1.0f / 15.0f)); }
            }
        }
#undef R1_FETCH
        sa = sbnd;
    }
}

__device__ __forceinline__ void phase_r2(const Args& A, const Ctx& C, int l) {
    constexpr int WP = 2064;
    LAS unsigned char* RWB = C.lds;
    LAS float* WL = (LAS float*)(C.lds + 48 * WP);
    LAS unsigned* hist = (LAS unsigned*)(WL + 8 * 16 * 48);
    LAS unsigned* gbase = hist + 32;
    constexpr int RCAP = 144;
    LAS int* rec = (LAS int*)(gbase + 32);
    static_assert(48 * WP + 8 * 16 * 48 * 4 + 256 + RCAP * 16 <= LDS_TAB_END, "R2 LDS map");
    cvt_moe_items(A, C, l, cvt_t2(l, C.G) + C.bid * NW + C.wave, CVT_ITEMS, C.G * NW);
    __syncthreads();
    { const float* wg = A.in[15] + (size_t)l * D * NGRP; const float* wr = A.in[17] + (size_t)l * D * NE;
      { const int kp = C.tid; const f32x4 x0 = *(const f32x4*)(wg + (size_t)(2 * kp) * 4), x1 = *(const f32x4*)(wg + (size_t)(2 * kp + 1) * 4);
        *(LAS unsigned*)(RWB + 0 * WP + kp * 4) = cvt2(x0.x, x1.x); *(LAS unsigned*)(RWB + 1 * WP + kp * 4) = cvt2(x0.y, x1.y);
        *(LAS unsigned*)(RWB + 2 * WP + kp * 4) = cvt2(x0.z, x1.z); *(LAS unsigned*)(RWB + 3 * WP + kp * 4) = cvt2(x0.w, x1.w); }
      f32x4 t0[8], t1[8];
#pragma unroll
      for (int jj = 0; jj < 8; ++jj) { const int it = C.tid + NT * jj, kp = it >> 3, cg = it & 7; t0[jj] = *(const f32x4*)(wr + (size_t)(2 * kp) * NE + 4 * cg); t1[jj] = *(const f32x4*)(wr + (size_t)(2 * kp + 1) * NE + 4 * cg); }
#pragma unroll
      for (int jj = 0; jj < 8; ++jj) { const int it = C.tid + NT * jj, kp = it >> 3, c0 = 4 + 4 * (it & 7);
          *(LAS unsigned*)(RWB + (c0 + 0) * WP + kp * 4) = cvt2(t0[jj].x, t1[jj].x); *(LAS unsigned*)(RWB + (c0 + 1) * WP + kp * 4) = cvt2(t0[jj].y, t1[jj].y);
          *(LAS unsigned*)(RWB + (c0 + 2) * WP + kp * 4) = cvt2(t0[jj].z, t1[jj].z); *(LAS unsigned*)(RWB + (c0 + 3) * WP + kp * 4) = cvt2(t0[jj].w, t1[jj].w); }
      for (int i = C.tid; i < 12 * 512; i += NT) *(LAS unsigned*)(RWB + (36 + i / 512) * WP + (i % 512) * 4) = 0u; }
    const int nrows = (l <= 1) ? NR : NL;
    bf16* LAT = (bf16*)(A.ws + WS_LAT); bf16* H = (bf16*)(A.ws + WS_HB); unsigned char* H8 = A.ws + WS_H8;
    const float* MOD = (const float*)(A.ws + WS_MOD);
    unsigned* cnt = (unsigned*)(A.ws + WS_CTL) + CW_CNT + l * 32 * CNT_STRIDE;
    int* TS = (int*)(A.ws + WS_TOKSLOT); float* TW = (float*)(A.ws + WS_TOKW); int* ST = (int*)(A.ws + WS_SLOTTOK);
    const int rpw = (((nrows + C.G - 1) / C.G) + 1) & ~1; const int wrow0 = C.bid * rpw; const int wend0 = min(wrow0 + rpw, nrows);
    const float* bg = A.in[16] + l * NGRP; const float* br = A.in[18] + l * NE;
    for (int cb = wrow0; cb < wend0; cb += RCAP) {
        const int wend = min(cb + RCAP, wend0);
        if (C.tid < 32) hist[C.tid] = 0u;
        for (int sa = cb; sa < wend;) {
            const int mvi = mod_vec_of_row(sa); const int bnd = mvi == 0 ? SEQ : (mvi == 1 ? NL : NR); const int sbnd = min(wend, bnd);
            RowVec RV; { const float* mv = MOD + (size_t)(l * 3 + mvi) * 6 * D; load_rowvec(RV, A.in[6] + (size_t)(l * 2 + 1) * D, mv + 3 * D, mv + 4 * D, mv + 2 * D, C.lane); }
            const int rlast = sbnd - 2;
            u32x2 la[4], lb[4];
            { const int r0 = min(sa + 2 * C.wave, rlast); load_row_bf16raw(LAT + (size_t)r0 * D, C.lane, la); load_row_bf16raw(LAT + (size_t)(r0 + 1) * D, C.lane, lb); }
            for (int ra = sa + 2 * C.wave; ra < sbnd; ra += 2 * NW) {
                const int rb = ra + 1;
                u32x2 lan[4], lbn[4];
                { const int r1 = min(ra + 2 * NW, rlast); load_row_bf16raw(LAT + (size_t)r1 * D, C.lane, lan); load_row_bf16raw(LAT + (size_t)(r1 + 1) * D, C.lane, lbn); }
                f32x4 va[4], vb[4];
#pragma unroll
                for (int q = 0; q < 4; ++q) { va[q] = bf4(la[q]); vb[q] = bf4(lb[q]); }
                const float rra = row_rstd(va), rrb = row_rstd(vb);
                f32x4 ha[4], hb[4];
#pragma unroll
                for (int q = 0; q < 4; ++q) { ha[q] = (va[q] * rra) * RV.a[q] + RV.s[q]; hb[q] = (vb[q] * rrb) * RV.a[q] + RV.s[q]; }
                store_row_bf16(H + (size_t)ra * D, C.lane, ha); store_row_bf16(H + (size_t)rb * D, C.lane, hb);
                store_row_fp8(H8 + (size_t)ra * D, C.lane, ha); store_row_fp8(H8 + (size_t)rb * D, C.lane, hb);
#pragma unroll
                for (int q = 0; q < 4; ++q) { la[q] = lan[q]; lb[q] = lbn[q]; }
            }
            sa = sbnd;
        }
        __syncthreads();
        const int fr = C.lane & 15, fq = C.lane >> 4;
        for (int t = C.wave; t * 16 < wend - cb; t += NW) {
            const int trow = min(cb + 16 * t + fr, wend - 1);
            const bf16* hp = H + (size_t)trow * D + 8 * fq;
            f32x4 acc[3];
#pragma unroll
            for (int ct = 0; ct < 3; ++ct) acc[ct] = (f32x4){0.f, 0.f, 0.f, 0.f};
            { bf16x8 av[32];
#pragma unroll
              for (int k8 = 0; k8 < 32; ++k8) av[k8] = *(const bf16x8*)(hp + 32 * k8);
#pragma unroll
              for (int k8 = 0; k8 < 32; ++k8) {
#pragma unroll
                  for (int ct = 0; ct < 3; ++ct) { const bf16x8 bv = *(const LAS bf16x8*)(RWB + (ct * 16 + fr) * WP + (32 * k8 + 8 * fq) * 2);
                      acc[ct] = __builtin_amdgcn_mfma_f32_16x16x32_bf16(av[k8], bv, acc[ct], 0, 0, 0); }
                  if ((k8 & 3) == 3) asm volatile("" ::: "memory"); } }
            LAS float* wl = WL + C.wave * 16 * 48;
#pragma unroll
            for (int ct = 0; ct < 3; ++ct)
#pragma unroll
                for (int jq = 0; jq < 4; ++jq) wl[(4 * fq + jq) * 48 + ct * 16 + fr] = acc[ct][jq];
            asm volatile("s_waitcnt lgkmcnt(0)" ::: "memory");
            const int row = cb + 16 * t + C.lane;
            if (C.lane < 16 && row < wend) {
                LAS const float* wm = wl + C.lane * 48;
                float lg[36];
#pragma unroll
                for (int c = 0; c < 36; ++c) lg[c] = wm[c];
                float gl[4]; int grp = 0; float gm = -3.0e38f;
#pragma unroll
                for (int c = 0; c < 4; ++c) { gl[c] = lg[c] + bg[c]; if (gl[c] > gm) { gm = gl[c]; grp = c; } }
                float gs = 0.f;
#pragma unroll
                for (int c = 0; c < 4; ++c) gs += __expf(gl[c] - gm);
                const float pgrp = 1.0f / gs;
                float rl[8];
#pragma unroll
                for (int i = 0; i < 8; ++i) { float tt = 0.f;
#pragma unroll
                    for (int g = 0; g < 4; ++g) tt = (g == grp) ? lg[4 + g * 8 + i] : tt;
                    rl[i] = tt + br[grp * 8 + i]; }
                int i0 = 0; float m0 = rl[0];
#pragma unroll
                for (int i = 1; i < 8; ++i) if (rl[i] > m0) { m0 = rl[i]; i0 = i; }
                int i1 = -1; float m1 = -3.0e38f;
#pragma unroll
                for (int i = 0; i < 8; ++i) if (i != i0 && rl[i] > m1) { m1 = rl[i]; i1 = i; }
                const float p0 = 1.0f, p1 = __expf(m1 - m0);
                const float w0 = pgrp * p0 / (p0 + p1), w1 = pgrp * p1 / (p0 + p1);
                const int e0 = grp * 8 + i0, e1 = grp * 8 + i1;
                const unsigned q0 = __hip_atomic_fetch_add(hist + e0, 1u, __ATOMIC_RELAXED, __HIP_MEMORY_SCOPE_WORKGROUP), q1 = __hip_atomic_fetch_add(hist + e1, 1u, __ATOMIC_RELAXED, __HIP_MEMORY_SCOPE_WORKGROUP);
                const int li = row - cb;
                rec[li * 4 + 0] = e0 | (e1 << 8); rec[li * 4 + 1] = (int)q0; rec[li * 4 + 2] = (int)q1;
                TW[row * 2 + 0] = w0; TW[row * 2 + 1] = w1;
            }
        }
        __syncthreads();
        if (C.tid < 32) gbase[C.tid] = hist[C.tid] ? atomicAdd(cnt + C.tid * CNT_STRIDE, hist[C.tid]) : 0u;
        __syncthreads();
        for (int i = C.tid; i < wend - cb; i += NT) { const int row = cb + i; const int ee = rec[i * 4], e0 = ee & 255, e1 = ee >> 8;
            const unsigned q0 = gbase[e0] + (unsigned)rec[i * 4 + 1], q1 = gbase[e1] + (unsigned)rec[i * 4 + 2];
            ST[(size_t)e0 * CAP + q0] = row; ST[(size_t)e1 * CAP + q1] = row;
            TS[row * 2 + 0] = (e0 << 20) | (int)q0; TS[row * 2 + 1] = (e1 << 20) | (int)q1; }
        __syncthreads();
    }
}

__device__ __forceinline__ void phase_final(const Args& A, const Ctx& C) {
    LAS int* sb = (LAS int*)C.lds;
    slot_bases(A, 3, sb, C.tid);
    const bf16* LAT = (const bf16*)(A.ws + WS_LAT); const unsigned char* Y8 = A.ws + WS_PB;
    const int* TS = (const int*)(A.ws + WS_TOKSLOT); const float* TW = (const float*)(A.ws + WS_TOKW);
    const float* MOD = (const float*)(A.ws + WS_MOD);
    f32x4 fg[4]; load_row_f32(A.in[7], C.lane, fg);
    const int rpw = (((NL + C.G - 1) / C.G) + 1) & ~1; const int wrow0 = C.bid * rpw; const int wend = min(wrow0 + rpw, NL);
    for (int sa = wrow0; sa < wend;) {
        const int mvi = mod_vec_of_row(sa); const int sbnd = min(wend, mvi == 0 ? SEQ : NL);
        f32x4 g2[4]; load_row_f32(MOD + (size_t)(3 * 3 + mvi) * 6 * D + 5 * D, C.lane, g2);
        const int rlast = sbnd - 2; const int rfirst = sa + 2 * C.wave;
        i32x4r ts1, ts2; f32x4 tw1, tw2;
        u32x2 nla[4], nlb[4]; unsigned nya0[4], nya1[4], nyb0[4], nyb1[4];
#define FIN_FETCH(r_, ts_) do { const int fa_ = (r_); \
            load_row_bf16raw(LAT + (size_t)fa_ * D, C.lane, nla); load_row_bf16raw(LAT + (size_t)(fa_ + 1) * D, C.lane, nlb); \
            load_row_fp8raw(Y8 + (size_t)(sb[(ts_).x >> 20] + ((ts_).x & 0xfffff)) * D, C.lane, nya0); load_row_fp8raw(Y8 + (size_t)(sb[(ts_).y >> 20] + ((ts_).y & 0xfffff)) * D, C.lane, nya1); \
            load_row_fp8raw(Y8 + (size_t)(sb[(ts_).z >> 20] + ((ts_).z & 0xfffff)) * D, C.lane, nyb0); load_row_fp8raw(Y8 + (size_t)(sb[(ts_).w >> 20] + ((ts_).w & 0xfffff)) * D, C.lane, nyb1); } while (0)
        { const int r0 = min(rfirst, rlast), r1 = min(rfirst + 2 * NW, rlast);
          ts1 = *(const i32x4r*)(TS + r0 * 2); tw1 = *(const f32x4*)(TW + r0 * 2); ts2 = *(const i32x4r*)(TS + r1 * 2); tw2 = *(const f32x4*)(TW + r1 * 2); }
        FIN_FETCH(min(rfirst, rlast), ts1);
        for (int ra = rfirst; ra < sbnd; ra += 2 * NW) {
            const int rb = ra + 1;
            u32x2 la[4], lb[4]; unsigned ya0[4], ya1[4], yb0[4], yb1[4];
#pragma unroll
            for (int q = 0; q < 4; ++q) { la[q] = nla[q]; lb[q] = nlb[q]; ya0[q] = nya0[q]; ya1[q] = nya1[q]; yb0[q] = nyb0[q]; yb1[q] = nyb1[q]; }
            const f32x4 twc = tw1;
            ts1 = ts2; tw1 = tw2;
            { const int r2 = min(ra + 4 * NW, rlast); ts2 = *(const i32x4r*)(TS + r2 * 2); tw2 = *(const f32x4*)(TW + r2 * 2); }
            FIN_FETCH(min(ra + 2 * NW, rlast), ts1);
            const float wa0 = twc.x * (1.0f / YSCALE), wa1 = twc.y * (1.0f / YSCALE), wb0 = twc.z * (1.0f / YSCALE), wb1 = twc.w * (1.0f / YSCALE);
            f32x4 va[4], vb[4];
#pragma unroll
            for (int q = 0; q < 4; ++q) { va[q] = bf4(la[q]) + g2[q] * (fp8x4(ya0[q]) * wa0 + fp8x4(ya1[q]) * wa1); vb[q] = bf4(lb[q]) + g2[q] * (fp8x4(yb0[q]) * wb0 + fp8x4(yb1[q]) * wb1); }
            const float rra = row_rstd(va), rrb = row_rstd(vb);
#pragma unroll
            for (int q = 0; q < 4; ++q) { *(f32x4*)(A.out + (size_t)ra * D + 4 * C.lane + 256 * q) = (va[q] * rra) * fg[q]; *(f32x4*)(A.out + (size_t)rb * D + 4 * C.lane + 256 * q) = (vb[q] * rrb) * fg[q]; }
        }
#undef FIN_FETCH
        sa = sbnd;
    }
}

__device__ __forceinline__ void phase_conv(const Args& A, const Ctx& C, int l) {
    const int j = l >> 1; const int nrows = (l <= 1) ? NR : NL;
    const bf16* P = (const bf16*)(A.ws + WS_PB); unsigned char* HM = A.ws + WS_HM; float* RSC = (float*)(A.ws + WS_RSC);
    const float* cw = A.in[13] + (size_t)j * 3 * D;
    f32x4 w0[4], w1[4], w2[4];
    load_row_f32(cw, C.lane, w0); load_row_f32(cw + D, C.lane, w1); load_row_f32(cw + 2 * D, C.lane, w2);
    const int rpw = (((nrows + C.G - 1) / C.G) + 1) & ~1; const int wrow0 = C.bid * rpw; const int wend = min(wrow0 + rpw, nrows);
    for (int ra = wrow0 + 2 * C.wave; ra < wend; ra += 2 * NW) {
        const int rb = ra + 1;
        const int ta = ra < NL ? (ra & 63) : ((ra - NL) & 255), tb1 = rb < NL ? (rb & 63) : ((rb - NL) & 255), tlast = ra < NL ? 63 : 255;
        const bool hasl = ta != 0, hasr = tb1 != tlast;
        const bf16* pa = P + (size_t)ra * PW;
        u32x2 bga[4], bgb[4], zm[4], z0[4], z1[4], z2[4];
        load_row_bf16raw(pa, C.lane, bga); load_row_bf16raw(pa + PW, C.lane, bgb);
        load_row_bf16raw(pa + D, C.lane, z0); load_row_bf16raw(pa + PW + D, C.lane, z1);
        load_row_bf16raw(hasl ? pa - PW + D : pa + D, C.lane, zm); load_row_bf16raw(hasr ? pa + 2 * PW + D : pa + D, C.lane, z2);
        const float fl = hasl ? 1.f : 0.f, fr = hasr ? 1.f : 0.f;
        f32x4 oa[4], ob[4];
#pragma unroll
        for (int q = 0; q < 4; ++q) { const f32x4 a0 = bf4(z0[q]), a1 = bf4(z1[q]);
            oa[q] = bf4(bga[q]) * (w0[q] * (bf4(zm[q]) * fl) + w1[q] * a0 + w2[q] * a1);
            ob[q] = bf4(bgb[q]) * (w0[q] * a0 + w1[q] * a1 + w2[q] * (bf4(z2[q]) * fr)); }
        float ma = 0.f, mb = 0.f;
#pragma unroll
        for (int q = 0; q < 4; ++q) { ma = fmaxf(ma, fmaxf(fmaxf(fabsf(oa[q].x), fabsf(oa[q].y)), fmaxf(fabsf(oa[q].z), fabsf(oa[q].w)))); mb = fmaxf(mb, fmaxf(fmaxf(fabsf(ob[q].x), fabsf(ob[q].y)), fmaxf(fabsf(ob[q].z), fabsf(ob[q].w)))); }
        ma = fmaxf(wave_max_nn(ma), 1.0e-20f); mb = fmaxf(wave_max_nn(mb), 1.0e-20f);
        const float ia = 127.0f / ma, ib = 127.0f / mb;
#pragma unroll
        for (int q = 0; q < 4; ++q) { *(unsigned*)(HM + (size_t)ra * D + 4 * C.lane + 256 * q) = pack_i8_nc(oa[q] * ia); *(unsigned*)(HM + (size_t)rb * D + 4 * C.lane + 256 * q) = pack_i8_nc(ob[q] * ib); }
        if (C.lane == 0) { RSC[ra] = ma * (1.0f / 127.0f); RSC[rb] = mb * (1.0f / 127.0f); }
    }
}

constexpr int BM = 256, BK = 64, HALF = 128, HTB = HALF * BK * 2, STAGE_BYTES = 8 * HTB, NXCD = 8, WGM = 8;
constexpr int LDS_TAB = STAGE_BYTES;
__device__ __forceinline__ int lds_byte(int r, int c) { const int st = (r >> 4) * 2 + (c >> 5), rr = r & 15, cc = c & 31, ob = rr * 64 + cc * 2; return st * 1024 + (ob ^ (((ob >> 9) & 1) << 5)); }
__device__ __forceinline__ void stage_rc(int b, int& R, int& C) { const int st = b / 1024, sb = b % 1024, swz = sb ^ (((sb >> 9) & 1) << 5); R = (st >> 1) * 16 + swz / 64; C = (st & 1) * 32 + (swz % 64) / 2; }
__device__ __forceinline__ int perm32(int rho) { const int n = rho >> 4, i = rho & 15; return 8 * (i >> 2) + 4 * n + (i & 3); }
__device__ __forceinline__ unsigned cvt_pk_bf16(float lo, float hi) { unsigned r; asm volatile("v_cvt_pk_bf16_f32 %0, %1, %2" : "=v"(r) : "v"(lo), "v"(hi)); return r; }

struct GUnit { const char* a; const char* b; int orow, ocol, aux; };

typedef int i32x8 __attribute__((ext_vector_type(8)));
typedef int i32x4 __attribute__((ext_vector_type(4)));
template <class Epi, class Sched, bool GATHER, int OPM = 0>
__device__ __forceinline__ void gemm_phase(LAS unsigned char* lds, const int K, const Sched& S, const Epi& E) {
    const int tid = threadIdx.x, wid = __builtin_amdgcn_readfirstlane(tid >> 6), lane = tid & 63, wr = wid >> 2, wc = wid & 3, fr = lane & 15, fq = lane >> 4;
    constexpr bool FP8 = (OPM == 1), I8 = (OPM == 2);
    const int RB = (OPM != 0) ? K : 2 * K;
    const int nt = RB / (BK * 2);
    unsigned voffB[2], voA[2][2]; int Rr[2], Cc[2];
#pragma unroll
    for (int i = 0; i < 2; ++i) { int R, C; stage_rc(tid * 16 + i * 8192, R, C); const int Rb = (R & ~31) + perm32(R & 31); Rr[i] = R; Cc[i] = C;
        voffB[i] = (unsigned)(Rb * RB + C * 2);
        voA[0][i] = (unsigned)(R * RB + C * 2); voA[1][i] = (unsigned)((R + HALF) * RB + C * 2); }
    const size_t kstep = (size_t)(BK * 2);
    const size_t hstep = (size_t)HALF * RB;
    const unsigned ldsw = (unsigned)wid * 1024u;
    const unsigned ldsbase = (unsigned)(size_t)lds;
    const int aoff = lds_byte(wr * 64 + fr, fq * 8), boff = lds_byte(wc * 32 + fr, fq * 8);
#define PG8_SA(b, h) (((b) * 2 + (h)) * HTB)
#define PG8_SB(b, h) ((4 + (b) * 2 + (h)) * HTB)
#define PG8_STAGE(bufoff, gbase, voff) do { _Pragma("unroll") for (int _i = 0; _i < 2; ++_i) \
        asm volatile("s_mov_b32 m0, %2\n\ts_nop 0\n\tglobal_load_lds_dwordx4 %0, %1" :: "v"((voff)[_i]), "s"((const char*)(gbase)), "s"(ldsbase + (unsigned)(bufoff) + ldsw + (unsigned)(_i * 8192)) : "memory"); } while (0)
#define PG8_STAGE_A1(bufoff, gbase) do { if constexpr (GATHER) PG8_STAGE(bufoff, gbase, voA[1]); else PG8_STAGE(bufoff, (const char*)(gbase) + hstep, voA[0]); } while (0)
#define PG8_LDA(dst, b, h) do { if constexpr (FP8) { _Pragma("unroll") for (int m = 0; m < 4; ++m) { \
        const i32x4 _lo = *(const LAS i32x4*)(lds + PG8_SA(b, h) + aoff + m * 2048), _hi = *(const LAS i32x4*)(lds + PG8_SA(b, h) + aoff + m * 2048 + 1024); \
        dst##8[m] = __builtin_shufflevector(_lo, _hi, 0, 1, 2, 3, 4, 5, 6, 7); } } \
      else { _Pragma("unroll") for (int m = 0; m < 4; ++m) _Pragma("unroll") for (int k = 0; k < 2; ++k) dst[m][k] = *(const LAS bf16x8*)(lds + PG8_SA(b, h) + aoff + m * 2048 + k * 1024); } } while (0)
#define PG8_LDB(dst, b, h) do { if constexpr (FP8) { _Pragma("unroll") for (int n = 0; n < 2; ++n) { \
        const i32x4 _lo = *(const LAS i32x4*)(lds + PG8_SB(b, h) + boff + n * 2048), _hi = *(const LAS i32x4*)(lds + PG8_SB(b, h) + boff + n * 2048 + 1024); \
        dst##8[n] = __builtin_shufflevector(_lo, _hi, 0, 1, 2, 3, 4, 5, 6, 7); } } \
      else { _Pragma("unroll") for (int n = 0; n < 2; ++n) _Pragma("unroll") for (int k = 0; k < 2; ++k) dst[n][k] = *(const LAS bf16x8*)(lds + PG8_SB(b, h) + boff + n * 2048 + k * 1024); } } while (0)
#define PG8_MMA(ai, bj, At, Bt) do { __builtin_amdgcn_s_setprio(1); \
        if constexpr (FP8) { _Pragma("unroll") for (int m = 0; m < 4; ++m) _Pragma("unroll") for (int n = 0; n < 2; ++n) \
            acc[ai][bj][m][n] = __builtin_amdgcn_mfma_scale_f32_16x16x128_f8f6f4(Bt##8[n], At##8[m], acc[ai][bj][m][n], 0, 0, 0, 0x7f7f7f7f, 0, 0x7f7f7f7f); } \
        else if constexpr (I8) { _Pragma("unroll") for (int m = 0; m < 4; ++m) _Pragma("unroll") for (int n = 0; n < 2; ++n) _Pragma("unroll") for (int k = 0; k < 2; ++k) \
            acc[ai][bj][m][n] = __builtin_bit_cast(f32x4, __builtin_amdgcn_mfma_i32_16x16x64_i8(__builtin_bit_cast(i32x4, Bt[n][k]), __builtin_bit_cast(i32x4, At[m][k]), __builtin_bit_cast(i32x4, acc[ai][bj][m][n]), 0, 0, 0)); } \
        else { _Pragma("unroll") for (int m = 0; m < 4; ++m) _Pragma("unroll") for (int n = 0; n < 2; ++n) _Pragma("unroll") for (int k = 0; k < 2; ++k) \
            acc[ai][bj][m][n] = __builtin_amdgcn_mfma_f32_16x16x32_bf16(Bt[n][k], At[m][k], acc[ai][bj][m][n], 0, 0, 0); } \
        __builtin_amdgcn_s_setprio(0); } while (0)
#define PG8_WAIT_V(n) asm volatile("s_waitcnt vmcnt(" #n ")" ::: "memory")
#define PG8_WAIT_L(n) asm volatile("s_waitcnt lgkmcnt(" #n ")" ::: "memory")
#define PG8_BAR __builtin_amdgcn_s_barrier()
#define PG8_SCHED __builtin_amdgcn_sched_barrier(0)
    GUnit cur, nxt; int ui = 0;
    if (!S.next(0, cur)) return;
    if constexpr (GATHER) {
#pragma unroll
        for (int h = 0; h < 2; ++h)
#pragma unroll
            for (int i = 0; i < 2; ++i) voA[h][i] = S.arow_off(0, h * HALF + Rr[i]) + (unsigned)Cc[i] * 2u;
    }
    f32x4 acc[2][2][4][2];
#pragma unroll
    for (int a = 0; a < 2; ++a)
#pragma unroll
        for (int b = 0; b < 2; ++b)
#pragma unroll
            for (int m = 0; m < 4; ++m)
#pragma unroll
                for (int n = 0; n < 2; ++n) acc[a][b][m][n] = (f32x4){0.f, 0.f, 0.f, 0.f};
    bf16x8 At[4][2], B0[2][2], B1[2][2]; i32x8 At8[4], B08[2], B18[2];
    const char* cA = cur.a; const char* cB = cur.b;
    PG8_STAGE(PG8_SB(0, 0), cB, voffB); PG8_STAGE(PG8_SB(0, 1), cB + hstep, voffB); PG8_STAGE(PG8_SA(0, 0), cA, voA[0]); PG8_STAGE_A1(PG8_SA(0, 1), cA);
    if (wr == 1) PG8_BAR;
    PG8_WAIT_V(2); PG8_BAR;
    PG8_STAGE(PG8_SB(1, 0), cB + kstep, voffB); PG8_STAGE(PG8_SA(1, 0), cA + kstep, voA[0]); PG8_STAGE(PG8_SB(1, 1), cB + hstep + kstep, voffB);
    PG8_WAIT_V(6); PG8_BAR;
    for (;;) {
        const bool has_next = S.next(ui + 1, nxt);
        const char* nA = has_next ? nxt.a : cA; const char* nB = has_next ? nxt.b : cB;
#pragma unroll 1
        for (int t = 0; t < nt; t += 2) {
            const bool last = (t == nt - 2);
            const char* a1 = cA + (size_t)(t + 1) * kstep;
            const char* a2 = last ? nA : cA + (size_t)(t + 2) * kstep; const char* b2 = last ? nB : cB + (size_t)(t + 2) * kstep;
            const char* a3 = a2 + kstep; const char* b3 = b2 + kstep;
            PG8_LDB(B0, 0, 0); PG8_LDB(B1, 0, 1); PG8_SCHED; PG8_LDA(At, 0, 0); PG8_STAGE_A1(PG8_SA(1, 1), a1);
            if constexpr (GATHER) { if (last && has_next) {
#pragma unroll
                for (int h = 0; h < 2; ++h)
#pragma unroll
                    for (int i = 0; i < 2; ++i) { int R2, C2; stage_rc(tid * 16 + i * 8192, R2, C2); voA[h][i] = S.arow_off(ui + 1, h * HALF + R2) + (unsigned)C2 * 2u; } } }
            PG8_WAIT_V(8); PG8_WAIT_L(0); PG8_BAR; PG8_MMA(0, 0, At, B0); PG8_MMA(0, 1, At, B1); PG8_BAR; PG8_SCHED;
            PG8_LDA(At, 0, 1); PG8_STAGE(PG8_SB(0, 0), b2, voffB); PG8_STAGE(PG8_SB(0, 1), b2 + hstep, voffB); PG8_STAGE(PG8_SA(0, 0), a2, voA[0]);
            PG8_WAIT_V(8); PG8_WAIT_L(0); PG8_BAR; PG8_MMA(1, 0, At, B0); PG8_MMA(1, 1, At, B1); PG8_BAR; PG8_SCHED;
            PG8_LDB(B0, 1, 0); PG8_LDB(B1, 1, 1); PG8_SCHED; PG8_LDA(At, 1, 0); PG8_STAGE_A1(PG8_SA(0, 1), a2);
            PG8_WAIT_V(8); PG8_WAIT_L(0); PG8_BAR; PG8_MMA(0, 0, At, B0); PG8_MMA(0, 1, At, B1); PG8_BAR; PG8_SCHED;
            PG8_LDA(At, 1, 1); PG8_STAGE(PG8_SB(1, 0), b3, voffB); PG8_STAGE(PG8_SB(1, 1), b3 + hstep, voffB); PG8_STAGE(PG8_SA(1, 0), a3, voA[0]);
            PG8_WAIT_V(8); PG8_WAIT_L(0); PG8_BAR; PG8_MMA(1, 0, At, B0); PG8_MMA(1, 1, At, B1); PG8_BAR; PG8_SCHED;
        }
        if (wr == 0) PG8_BAR;
        { int tz = threadIdx.x; asm volatile("" : "+v"(tz));
          if constexpr (I8) {
#pragma unroll
              for (int a_ = 0; a_ < 2; ++a_)
#pragma unroll
                  for (int b_ = 0; b_ < 2; ++b_)
#pragma unroll
                      for (int m = 0; m < 4; ++m)
#pragma unroll
                          for (int n = 0; n < 2; ++n) acc[a_][b_][m][n] = __builtin_convertvector(__builtin_bit_cast(i32x4, acc[a_][b_][m][n]), f32x4); }
          const int wz = tz >> 6, lz = tz & 63; E(acc, cur, wz >> 2, wz & 3, lz & 15, lz >> 4); }
        if (!has_next) break;
#pragma unroll
        for (int a = 0; a < 2; ++a)
#pragma unroll
            for (int b = 0; b < 2; ++b)
#pragma unroll
                for (int m = 0; m < 4; ++m)
#pragma unroll
                    for (int n = 0; n < 2; ++n) acc[a][b][m][n] = (f32x4){0.f, 0.f, 0.f, 0.f};
        cur = nxt; cA = nA; cB = nB; ++ui;
        if (wr == 1) PG8_BAR;
    }
    PG8_WAIT_V(0);
    PG8_BAR;
#undef PG8_SA
#undef PG8_SB
#undef PG8_STAGE
#undef PG8_STAGE_A1
#undef PG8_LDA
#undef PG8_LDB
#undef PG8_MMA
#undef PG8_WAIT_V
#undef PG8_WAIT_L
#undef PG8_BAR
#undef PG8_SCHED
}

__device__ __forceinline__ int xcd_remap(int L, int nwg) { const int q = nwg / NXCD, r = nwg % NXCD, xcd = L % NXCD, off = L / NXCD; return (xcd < r ? xcd * (q + 1) : r * (q + 1) + (xcd - r) * q) + off; }

struct DenseSched {
    const char* A; const char* Bt; int nM, nN, nwg, G, c; size_t tstep; int sw_lo, sw_hi;
    __device__ __forceinline__ void init(const void* A_, const void* Bt_, int M, int N, int K, int G_, int c_, int ebytes = 2) { A = (const char*)A_; Bt = (const char*)Bt_; nM = M / BM; nN = N / BM; nwg = nM * nN; G = G_; c = c_; tstep = (size_t)BM * K * ebytes; sw_lo = 0; sw_hi = 0; }
    __device__ __forceinline__ bool next(int i, GUnit& u) const {
        const long L = (long)i * G + c; if (L >= nwg) return false;
        const int wgid = xcd_remap((int)L, nwg);
        const int nig = WGM * nN, gid = wgid / nig, fm = gid * WGM, gsz = (nM - fm) < WGM ? (nM - fm) : WGM;
        const int pm = fm + ((wgid % nig) % gsz), pn = (wgid % nig) / gsz;
        if (pn >= sw_lo && pn < sw_hi) { u.a = Bt + (size_t)pn * tstep; u.b = A + (size_t)pm * tstep; u.orow = pm; u.ocol = pn - sw_lo; u.aux = 1; }
        else { u.a = A + (size_t)pm * tstep; u.b = Bt + (size_t)pn * tstep; u.orow = pm * BM; u.ocol = pn * BM; u.aux = 0; }
        return true;
    }
    __device__ __forceinline__ unsigned arow_off(int, int) const { return 0u; }
};

constexpr int MAXU = 12;
struct MoeTab { int n; int e[MAXU], mb[MAXU], nt[MAXU]; int sb[NE + 1]; };
struct MoeSched {
    LAS const MoeTab* T; LAS const unsigned* ridx;
    const char* A; const char* W; size_t wstride_e, tstepB; int K; int arow_bytes;
    __device__ __forceinline__ bool next(int i, GUnit& u) const {
        const int n = __builtin_amdgcn_readfirstlane(T->n); if (i >= n) return false;
        const int e = __builtin_amdgcn_readfirstlane(T->e[i]), mb = __builtin_amdgcn_readfirstlane(T->mb[i]), nt = __builtin_amdgcn_readfirstlane(T->nt[i]);
        const int base = __builtin_amdgcn_readfirstlane(T->sb[e]);
        u.orow = base + mb * BM; u.ocol = nt; u.aux = e;
        u.a = A + (size_t)u.orow * arow_bytes;
        u.b = W + (size_t)e * wstride_e + (size_t)nt * tstepB; return true;
    }
    __device__ __forceinline__ unsigned arow_off(int i, int r) const { return ridx[i * 256 + r]; }
};
template <bool GATHER>
__device__ __forceinline__ void moe_tables(const Args& A, const Ctx& C, int l, int ntile_n, LAS MoeTab* T, LAS unsigned* ridx, int arow_bytes) {
    const unsigned* cnt = (const unsigned*)(A.ws + WS_CTL) + CW_CNT + l * 32 * CNT_STRIDE;
    LAS int* ust = (LAS int*)(T + 1);
    LAS int* cntv = ust + 33;
    if (C.tid < 64) { int nb; const int ex = expert_block_prefix(cnt, C.tid, nb); if (C.tid <= NE) { T->sb[C.tid] = ex * 256; ust[C.tid] = ex * ntile_n; } if (C.tid < NE) cntv[C.tid] = (int)cnt[C.tid * CNT_STRIDE]; }
    __syncthreads();
    if (C.tid < MAXU) { const int nwg = ust[NE]; const long L = (long)C.tid * C.G + C.bid;
        if (L < nwg) { const int w = xcd_remap((int)L, nwg); int e = 0; while (w >= ust[e + 1]) ++e;
            const int lu = w - ust[e]; T->e[C.tid] = e; T->mb[C.tid] = lu / ntile_n; T->nt[C.tid] = lu % ntile_n; } }
    if (C.tid == 0) { const int nwg = ust[NE]; int n = 0; while (n < MAXU && (long)n * C.G + C.bid < nwg) ++n; T->n = n; }
    __syncthreads();
    if constexpr (GATHER) {
        const int* ST = (const int*)(A.ws + WS_SLOTTOK); const int n = T->n;
        for (int i = C.tid; i < n * 256; i += NT) { const int ui = i >> 8, r = i & 255, e = T->e[ui], m0 = T->mb[ui] * 256, ce = cntv[e];
            const int rr = (m0 + r < ce) ? m0 + r : ce - 1;
            ridx[i] = (unsigned)ST[(size_t)e * CAP + rr] * (unsigned)arow_bytes; }
        __syncthreads();
    }
}

struct EpiStore { bf16* O; int ldc; float scale_lo; int sig_from; bf16* VT; float sall = 1.0f; const float* rs = nullptr;
    __device__ __forceinline__ void operator()(const f32x4 (&acc)[2][2][4][2], const GUnit& u, int wr, int wc, int fr, int fq) const {
        const bool tr = u.aux != 0;
        const float sc = ((!tr && u.ocol < NQ) ? scale_lo : 1.0f) * sall; const bool sg = !tr && u.ocol >= sig_from;
        bf16* Ob = tr ? VT + (size_t)(u.orow * NH + u.ocol) * 65536 : O + (size_t)u.orow * ldc + u.ocol; const int ld = tr ? 256 : ldc;
        f32x4 cs[2][2];
#pragma unroll
        for (int bj = 0; bj < 2; ++bj) { const f32x4 one = (f32x4){1.f, 1.f, 1.f, 1.f};
            cs[bj][0] = (rs && tr) ? *(const f32x4*)(rs + u.orow * BM + bj * HALF + wc * 32 + 8 * fq) : one; cs[bj][1] = (rs && tr) ? *(const f32x4*)(rs + u.orow * BM + bj * HALF + wc * 32 + 8 * fq + 4) : one; }
#pragma unroll
        for (int ai = 0; ai < 2; ++ai)
#pragma unroll
            for (int m = 0; m < 4; ++m) { const int rl = ai * HALF + wr * 64 + m * 16 + fr; bf16* rowp = tr ? Ob + wc * 8192 + rl * 32 + 8 * fq : Ob + (size_t)rl * ld + wc * 32 + 8 * fq;

                const float scr = (rs && !tr) ? sc * rs[u.orow + rl] : sc;
#pragma unroll
                for (int bj = 0; bj < 2; ++bj) { f32x4 v0 = acc[ai][bj][m][0] * scr * cs[bj][0], v1 = acc[ai][bj][m][1] * scr * cs[bj][1];
                    if (sg) {
#pragma unroll
                        for (int q = 0; q < 4; ++q) { v0[q] = __builtin_amdgcn_rcpf(1.0f + __expf(-v0[q])); v1[q] = __builtin_amdgcn_rcpf(1.0f + __expf(-v1[q])); } }
                    u32x4 w; w.x = cvt_pk_bf16(v0[0], v0[1]); w.y = cvt_pk_bf16(v0[2], v0[3]); w.z = cvt_pk_bf16(v1[0], v1[1]); w.w = cvt_pk_bf16(v1[2], v1[3]);
                    *(u32x4*)(rowp + (tr ? bj * 4 * 8192 : bj * HALF)) = w; } }
    }
};
__device__ __forceinline__ u32x2 cvt8_fp8(f32x4 a, f32x4 b) { int lo = 0, hi = 0;
    lo = __builtin_amdgcn_cvt_pk_fp8_f32(a[0], a[1], lo, false); lo = __builtin_amdgcn_cvt_pk_fp8_f32(a[2], a[3], lo, true);
    hi = __builtin_amdgcn_cvt_pk_fp8_f32(b[0], b[1], hi, false); hi = __builtin_amdgcn_cvt_pk_fp8_f32(b[2], b[3], hi, true); return (u32x2){(unsigned)lo, (unsigned)hi}; }
struct EpiSwigluF8 { unsigned char* O; int ldc; float s;
    __device__ __forceinline__ void operator()(const f32x4 (&acc)[2][2][4][2], const GUnit& u, int wr, int wc, int fr, int fq) const {
        const int ocol = u.ocol * HALF;
#pragma unroll
        for (int ai = 0; ai < 2; ++ai)
#pragma unroll
            for (int m = 0; m < 4; ++m) { unsigned char* rowp = O + (size_t)(u.orow + ai * HALF + wr * 64 + m * 16 + fr) * ldc + ocol + wc * 32 + 8 * fq;
                f32x4 v0, v1;
#pragma unroll
                for (int q = 0; q < 4; ++q) { const float x0 = acc[ai][0][m][0][q] * s, x1 = acc[ai][0][m][1][q] * s;
                    v0[q] = x0 * __builtin_amdgcn_rcpf(1.0f + __expf(-x0)) * (acc[ai][1][m][0][q] * s); v1[q] = x1 * __builtin_amdgcn_rcpf(1.0f + __expf(-x1)) * (acc[ai][1][m][1][q] * s); }
                *(u32x2*)rowp = cvt8_fp8(v0, v1); }
    }
};
template <int MODE> struct EpiPair { bf16* O; int ldc; int plain_below; float sall = 1.0f; const float* rs = nullptr;
    __device__ __forceinline__ void operator()(const f32x4 (&acc)[2][2][4][2], const GUnit& u, int wr, int wc, int fr, int fq) const {
        if (MODE == 0 && u.ocol < plain_below) {
#pragma unroll
            for (int ai = 0; ai < 2; ++ai)
#pragma unroll
                for (int m = 0; m < 4; ++m) { const int rg = u.orow + ai * HALF + wr * 64 + m * 16 + fr; bf16* rowp = O + (size_t)rg * ldc + u.ocol + wc * 32 + 8 * fq;
                    const float scr = rs ? sall * rs[rg] : sall;
#pragma unroll
                    for (int bj = 0; bj < 2; ++bj) { const f32x4 v0 = acc[ai][bj][m][0] * scr, v1 = acc[ai][bj][m][1] * scr;
                        u32x4 w; w.x = cvt_pk_bf16(v0[0], v0[1]); w.y = cvt_pk_bf16(v0[2], v0[3]); w.z = cvt_pk_bf16(v1[0], v1[1]); w.w = cvt_pk_bf16(v1[2], v1[3]);
                        *(u32x4*)(rowp + bj * HALF) = w; } }
            return;
        }
        const int ocol = (MODE == 0) ? plain_below + (u.ocol - plain_below) / 2 : u.ocol * HALF;
#pragma unroll
        for (int ai = 0; ai < 2; ++ai)
#pragma unroll
            for (int m = 0; m < 4; ++m) { const int rg = u.orow + ai * HALF + wr * 64 + m * 16 + fr; bf16* rowp = O + (size_t)rg * ldc + ocol + wc * 32 + 8 * fq;
                const float scr = rs ? sall * rs[rg] : sall; const float sc2 = scr * scr;
                f32x4 v0, v1;
#pragma unroll
                for (int q = 0; q < 4; ++q) {
                    const float x0 = acc[ai][0][m][0][q], x1 = acc[ai][0][m][1][q];
                    const float g0 = (MODE == 1) ? x0 * __builtin_amdgcn_rcpf(1.0f + __expf(-x0)) : x0, g1 = (MODE == 1) ? x1 * __builtin_amdgcn_rcpf(1.0f + __expf(-x1)) : x1;
                    v0[q] = g0 * acc[ai][1][m][0][q] * sc2; v1[q] = g1 * acc[ai][1][m][1][q] * sc2; }
                u32x4 w; w.x = cvt_pk_bf16(v0[0], v0[1]); w.y = cvt_pk_bf16(v0[2], v0[3]); w.z = cvt_pk_bf16(v1[0], v1[1]); w.w = cvt_pk_bf16(v1[2], v1[3]);
                *(u32x4*)rowp = w; }
    }
};
struct EpiResid { bf16* LAT; const float* g1; float sall; const float* rs;
    __device__ __forceinline__ void operator()(const f32x4 (&acc)[2][2][4][2], const GUnit& u, int wr, int wc, int fr, int fq) const {
        bf16* Ob = LAT + (size_t)u.orow * D + u.ocol + wc * 32 + 8 * fq;
        u32x4 old[2][4][2];
#pragma unroll
        for (int ai = 0; ai < 2; ++ai)
#pragma unroll
            for (int m = 0; m < 4; ++m)
#pragma unroll
                for (int bj = 0; bj < 2; ++bj) old[ai][m][bj] = *(const u32x4*)(Ob + (size_t)(ai * HALF + wr * 64 + m * 16 + fr) * D + bj * HALF);
        const float* gv = g1 + (size_t)mod_vec_of_row(u.orow) * 6 * D + u.ocol + wc * 32 + 8 * fq;
        f32x4 g[2][2];
#pragma unroll
        for (int bj = 0; bj < 2; ++bj) { g[bj][0] = *(const f32x4*)(gv + bj * HALF); g[bj][1] = *(const f32x4*)(gv + bj * HALF + 4); }
#pragma unroll
        for (int ai = 0; ai < 2; ++ai)
#pragma unroll
            for (int m = 0; m < 4; ++m) { const int rl = ai * HALF + wr * 64 + m * 16 + fr; bf16* rowp = Ob + (size_t)rl * D;
                const float scr = rs ? sall * rs[u.orow + rl] : sall;
#pragma unroll
                for (int bj = 0; bj < 2; ++bj) { const u32x4 o = old[ai][m][bj];
                    const f32x4 v0 = bf4((u32x2){o.x, o.y}) + g[bj][0] * (acc[ai][bj][m][0] * scr), v1 = bf4((u32x2){o.z, o.w}) + g[bj][1] * (acc[ai][bj][m][1] * scr);
                    u32x4 w; w.x = cvt_pk_bf16(v0[0], v0[1]); w.y = cvt_pk_bf16(v0[2], v0[3]); w.z = cvt_pk_bf16(v1[0], v1[1]); w.w = cvt_pk_bf16(v1[2], v1[3]);
                    *(u32x4*)(rowp + bj * HALF) = w; } }
    }
};
struct EpiStoreTile { unsigned char* O; int ldc; float s;
    __device__ __forceinline__ void operator()(const f32x4 (&acc)[2][2][4][2], const GUnit& u, int wr, int wc, int fr, int fq) const {
#pragma unroll
        for (int ai = 0; ai < 2; ++ai)
#pragma unroll
            for (int m = 0; m < 4; ++m) { unsigned char* rowp = O + (size_t)(u.orow + ai * HALF + wr * 64 + m * 16 + fr) * ldc + u.ocol * BM + wc * 32 + 8 * fq;
#pragma unroll
                for (int bj = 0; bj < 2; ++bj) *(u32x2*)(rowp + bj * HALF) = cvt8_fp8(acc[ai][bj][m][0] * s, acc[ai][bj][m][1] * s); }
    }
};

__device__ __forceinline__ void transpose_item(const float* W, int ldw, int K, bf16* WT, int drow0, int k0, int n0, LAS float* scr, int lane) {
#pragma unroll
    for (int i = 0; i < 32; ++i) { const int kk = 2 * i + (lane >> 5); scr[kk * 33 + (lane & 31)] = W[(size_t)(k0 + kk) * ldw + n0 + (lane & 31)]; }
    asm volatile("s_waitcnt lgkmcnt(0)" ::: "memory");
    const int c = lane & 7;
#pragma unroll
    for (int j = 0; j < 4; ++j) { const int n = (lane >> 3) + 8 * j; const LAS float* s = scr + (8 * c) * 33 + n;
        u32x4 o; o.x = pk2(s[0 * 33], s[1 * 33]); o.y = pk2(s[2 * 33], s[3 * 33]); o.z = pk2(s[4 * 33], s[5 * 33]); o.w = pk2(s[6 * 33], s[7 * 33]);
        *(u32x4*)(WT + (size_t)(drow0 + n) * K + k0 + 8 * c) = o; }
    asm volatile("s_waitcnt lgkmcnt(0)" ::: "memory");
}
__device__ __forceinline__ void transpose_item_fp8(const float* W, int ldw, int K, unsigned char* WT8, int drow0, int k0, int n0, LAS float* scr, int lane, float sc) {
#pragma unroll
    for (int i = 0; i < 32; ++i) { const int kk = 2 * i + (lane >> 5); scr[kk * 33 + (lane & 31)] = W[(size_t)(k0 + kk) * ldw + n0 + (lane & 31)]; }
    asm volatile("s_waitcnt lgkmcnt(0)" ::: "memory");
    const int n = lane >> 1, half = lane & 1; const LAS float* sp = scr + (32 * half) * 33 + n;
    unsigned char* dst = WT8 + (size_t)(drow0 + n) * K + k0 + 32 * half;
#pragma unroll
    for (int c = 0; c < 2; ++c) { u32x4 o;
#pragma unroll
        for (int q = 0; q < 4; ++q) { int p = 0; const LAS float* s4 = sp + (16 * c + 4 * q) * 33;
            p = __builtin_amdgcn_cvt_pk_fp8_f32(s4[0] * sc, s4[33] * sc, p, false); p = __builtin_amdgcn_cvt_pk_fp8_f32(s4[66] * sc, s4[99] * sc, p, true); o[q] = (unsigned)p; }
        *(u32x4*)(dst + 16 * c) = o; }
    asm volatile("s_waitcnt lgkmcnt(0)" ::: "memory");
}
__device__ __forceinline__ void transpose_item_i8(const float* W, int ldw, int K, unsigned char* WT8, int drow0, int k0, int n0, LAS float* scr, int lane, float inv) {
#pragma unroll
    for (int i = 0; i < 32; ++i) { const int kk = 2 * i + (lane >> 5); scr[kk * 33 + (lane & 31)] = W[(size_t)(k0 + kk) * ldw + n0 + (lane & 31)]; }
    asm volatile("s_waitcnt lgkmcnt(0)" ::: "memory");
    const int n = lane >> 1, half = lane & 1; const LAS float* sp = scr + (32 * half) * 33 + n;
    unsigned char* dst = WT8 + (size_t)(drow0 + n) * K + k0 + 32 * half;
#pragma unroll
    for (int c = 0; c < 2; ++c) { u32x4 o;
#pragma unroll
        for (int q = 0; q < 4; ++q) { const LAS float* s4 = sp + (16 * c + 4 * q) * 33; o[q] = pack_i8((f32x4){s4[0] * inv, s4[33] * inv, s4[66] * inv, s4[99] * inv}); }
        *(u32x4*)(dst + 16 * c) = o; }
    asm volatile("s_waitcnt lgkmcnt(0)" ::: "memory");
}
__device__ __forceinline__ int pair_row(int n, int which) { return (n >> 7) * 256 + (n & 127) + which * 128; }
constexpr float HMR = 6.0f;
__device__ __forceinline__ void phase_cvt_mixer(const Args& A, const Ctx& C) {
    const int gw = C.bid * NW + C.wave, NGW = C.G * NW;
    unsigned* wmax = (unsigned*)(A.ws + WS_CTL) + CW_WMAX;
    for (int m8 = 0; m8 < 8; ++m8) {
        const float* W = m8 < 2 ? A.in[8] + (size_t)m8 * D * PROJ : m8 < 4 ? A.in[12] + (size_t)(m8 - 2) * D * PW : m8 < 6 ? A.in[11] + (size_t)(m8 - 4) * D * D : A.in[14] + (size_t)(m8 - 6) * D * D;
        const size_t n4 = (size_t)D * (m8 < 2 ? PROJ : m8 < 4 ? PW : D) / 4;
        float mx = 0.f;
        for (size_t i0 = (size_t)gw * 64 + C.lane; i0 < n4; i0 += (size_t)NGW * 64 * 8) {
            f32x4 v[8];
#pragma unroll
            for (int j = 0; j < 8; ++j) { const size_t i = i0 + (size_t)j * NGW * 64; v[j] = *(const f32x4*)(W + 4 * (i < n4 ? i : i0)); }
#pragma unroll
            for (int j = 0; j < 8; ++j) mx = fmaxf(mx, fmaxf(fmaxf(fabsf(v[j].x), fabsf(v[j].y)), fmaxf(fabsf(v[j].z), fabsf(v[j].w)))); }
        mx = wave_max_nn(mx);
        if (C.lane == 0 && mx > 0.f) atomicMax(wmax + m8 * CNT_STRIDE, __float_as_uint(mx));
    }
}
__device__ __forceinline__ void cvt_win_i8(const Args& A, const Ctx& C) {
    LAS float* scr = (LAS float*)(C.lds + 16384 + C.wave * 16384);
    const int gw = C.bid * NW + C.wave, NGW = C.G * NW;
    constexpr int I_IN = (D / 64) * (PW / 32);
    const unsigned* wmax = (const unsigned*)(A.ws + WS_CTL) + CW_WMAX;
    constexpr int I_OUT = (D / 64) * (D / 32);
    for (int it = gw; it < 4 * I_OUT; it += NGW) {
        const int m4 = it / I_OUT, kind = m4 >> 1, j = m4 & 1, r = it % I_OUT; const int kb = r / (D / 32), nb = r % (D / 32), n0 = nb * 32;
        const float inv = 127.0f / fmaxf(__uint_as_float(wmax[(4 + m4) * CNT_STRIDE]), 1.0e-30f);
        transpose_item_i8((kind == 0 ? A.in[11] : A.in[14]) + (size_t)j * D * D, D, D, A.ws + (kind == 0 ? WS_WAOUT : WS_WBOUT) + (size_t)j * D * D, n0, kb * 64, n0, scr, C.lane, inv); }
    for (int it = gw; it < 4 * I_IN; it += NGW) {
        const int m4 = it / I_IN, kind = m4 >> 1, j = m4 & 1, r = it % I_IN; const int kb = r / (PW / 32), nb = r % (PW / 32), n0 = nb * 32;
        const float inv = 127.0f / fmaxf(__uint_as_float(wmax[m4 * CNT_STRIDE]), 1.0e-30f);
        unsigned char* WT = A.ws + (kind == 0 ? WS_WAIN : WS_WBIN) + (size_t)j * PW * D;
        if (kind == 0) transpose_item_i8(A.in[8] + (size_t)j * D * PROJ, PROJ, D, WT, n0, kb * 64, n0, scr, C.lane, inv);
        else { const int drow = n0 < D ? n0 : (n0 < 2 * D ? D + pair_row(n0 - D, 0) : D + pair_row(n0 - 2 * D, 1));
            transpose_item_i8(A.in[12] + (size_t)j * D * PW, PW, D, WT, drow, kb * 64, n0, scr, C.lane, inv); }
    }
}
__device__ __forceinline__ void cvt_moe_items(const Args& A, const Ctx& C, int l, int it0, int end, int stride) {
    LAS float* scr = (LAS float*)(C.lds + 16384 + C.wave * 16384);
    unsigned char* WGU = A.ws + WS_WGU; unsigned char* WDN = A.ws + WS_WDN;
    for (int it = it0; it < end; it += stride) {
        const int e = it / CVT_PER; int r = it % CVT_PER;
        if (r < 2 * CVT_IG) { const int which = r / CVT_IG; r %= CVT_IG; const int kb = r / (DE / 32), nb = r % (DE / 32), n0 = nb * 32;
            transpose_item_fp8((which == 0 ? A.in[19] : A.in[20]) + ((size_t)l * NE + e) * D * DE, DE, D, WGU + (size_t)e * 2 * DE * D, pair_row(n0, which), kb * 64, n0, scr, C.lane, WSCALE); }
        else { r -= 2 * CVT_IG; const int kb = r / (D / 32), nb = r % (D / 32), n0 = nb * 32;
            transpose_item_fp8(A.in[21] + ((size_t)l * NE + e) * DE * D, D, DE, WDN + (size_t)e * D * DE, n0, kb * 64, n0, scr, C.lane, WSCALE); }
    }
}
__device__ __forceinline__ int cvt_idle(int nunits, int G) { const int rem = nunits % G; return rem ? G - rem : 0; }
__device__ __forceinline__ int cvt_t1(int l, int G) { const int n = cvt_idle((((l <= 2) ? NR : NL) / BM) * (PW / BM), G) * CVT_Q; return n < CVT_ITEMS ? n : CVT_ITEMS; }
__device__ __forceinline__ int cvt_t2(int l, int G) { const int n = cvt_t1(l, G) + cvt_idle((((l <= 1) ? NR : NL) / BM) * (D / BM), G) * CVT_Q; return n < CVT_ITEMS ? n : CVT_ITEMS; }
__device__ __forceinline__ void cvt_moe_tail(const Args& A, const Ctx& C, int l, int nunits, int base, int end) {
    const int rem = nunits % C.G;
    if (rem == 0 || C.bid < rem) return;
    const int first = base + (C.bid - rem) * CVT_Q; const int last = min(first + CVT_Q, end);
    cvt_moe_items(A, C, l, first + C.wave, last, NW);
}

__device__ __forceinline__ void phase_g1(const Args& A, const Ctx& C, int l) {
    const bool mls = (l & 1) == 0; const int j = l >> 1; const int nrows = (l <= 2) ? NR : NL;
    DenseSched S; S.init(A.ws + WS_H8, A.ws + (mls ? WS_WAIN : WS_WBIN) + (size_t)j * PW * D, nrows, PW, D, C.G, C.bid, 1);
    const float wsc = __uint_as_float(((const unsigned*)(A.ws + WS_CTL))[CW_WMAX + ((mls ? 0 : 2) + j) * CNT_STRIDE]) * (1.0f / 127.0f);
    const float* rs = (const float*)(A.ws + WS_RSC);
    if (mls) { S.sw_lo = 4; S.sw_hi = 8; EpiStore E{(bf16*)(A.ws + WS_PB), PW, 0.08838834764831845f, 2 * NQ + NV, (bf16*)(A.ws + WS_VT), wsc, rs}; gemm_phase<EpiStore, DenseSched, false, 2>(C.lds, D, S, E); }
    else { EpiPair<0> E{(bf16*)(A.ws + WS_PB), PW, D, wsc, rs}; gemm_phase<EpiPair<0>, DenseSched, false, 2>(C.lds, D, S, E); }
    cvt_moe_tail(A, C, l, S.nwg, 0, cvt_t1(l, C.G));
}
__device__ __forceinline__ void phase_g2(const Args& A, const Ctx& C, int l) {
    const bool mls = (l & 1) == 0; const int j = l >> 1; const int nrows = (l <= 1) ? NR : NL;
    DenseSched S; S.init(A.ws + WS_HM, A.ws + (mls ? WS_WAOUT : WS_WBOUT) + (size_t)j * D * D, nrows, D, D, C.G, C.bid, 1);
    const float wsc = __uint_as_float(((const unsigned*)(A.ws + WS_CTL))[CW_WMAX + (4 + (mls ? 0 : 2) + j) * CNT_STRIDE]) * (1.0f / 127.0f);
    EpiResid E{(bf16*)(A.ws + WS_LAT), (const float*)(A.ws + WS_MOD) + (size_t)(l * 3) * 6 * D + 2 * D, mls ? wsc * (HMR / 127.0f) : wsc, mls ? nullptr : (const float*)(A.ws + WS_RSC)}; gemm_phase<EpiResid, DenseSched, false, 2>(C.lds, D, S, E);
    cvt_moe_tail(A, C, l, S.nwg, cvt_t1(l, C.G), cvt_t2(l, C.G));
}
__device__ __forceinline__ void phase_m1(const Args& A, const Ctx& C, int l) {
    LAS MoeTab* T = (LAS MoeTab*)(C.lds + LDS_TAB); LAS unsigned* ridx = (LAS unsigned*)(C.lds + LDS_TAB + 1024);
    moe_tables<true>(A, C, l, 4, T, ridx, D);
    MoeSched S; S.T = T; S.ridx = ridx; S.A = (const char*)(A.ws + WS_H8); S.W = (const char*)(A.ws + WS_WGU); S.wstride_e = (size_t)2 * DE * D; S.tstepB = (size_t)BM * D; S.K = D; S.arow_bytes = 0;
    EpiSwigluF8 E{A.ws + WS_DC, DE, 1.0f / WSCALE}; gemm_phase<EpiSwigluF8, MoeSched, true, 1>(C.lds, D, S, E);
}
__device__ __forceinline__ void phase_m2(const Args& A, const Ctx& C, int l) {
    LAS MoeTab* T = (LAS MoeTab*)(C.lds + LDS_TAB); LAS unsigned* ridx = (LAS unsigned*)(C.lds + LDS_TAB + 1024);
    moe_tables<false>(A, C, l, 4, T, ridx, DE);
    MoeSched S; S.T = T; S.ridx = ridx; S.A = (const char*)(A.ws + WS_DC); S.W = (const char*)(A.ws + WS_WDN); S.wstride_e = (size_t)D * DE; S.tstepB = (size_t)BM * DE; S.K = DE; S.arow_bytes = DE;
    EpiStoreTile E{A.ws + WS_PB, D, YSCALE / WSCALE}; gemm_phase<EpiStoreTile, MoeSched, false, 1>(C.lds, DE, S, E);
}

typedef float f32x16 __attribute__((ext_vector_type(16)));
#define MFMA32(a, b, c) __builtin_amdgcn_mfma_f32_32x32x16_bf16((a), (b), (c), 0, 0, 0)
__device__ __forceinline__ bf16x8 pack8(float a0, float a1, float a2, float a3, float a4, float a5, float a6, float a7) {
    u32x4 p; p.x = cvt2(a0, a1); p.y = cvt2(a2, a3); p.z = cvt2(a4, a5); p.w = cvt2(a6, a7); return __builtin_bit_cast(bf16x8, p); }
__device__ __forceinline__ float bflo(unsigned w) { return __uint_as_float(w << 16); }
__device__ __forceinline__ float bfhi(unsigned w) { return __uint_as_float(w & 0xffff0000u); }
__device__ __forceinline__ int vt_tile(int b, int h, int blk) { return (blk == 0 ? 128 + b : b * 64 + blk - 1) * NH + h; }

__device__ __forceinline__ void lds_barrier() { asm volatile("s_waitcnt lgkmcnt(0)" ::: "memory"); __builtin_amdgcn_s_barrier(); asm volatile("" ::: "memory"); }
__device__ __forceinline__ float wave_incl_scan(float v, int lane) {
#pragma unroll
    for (int o = 1; o < 64; o <<= 1) { const float t = __shfl_up(v, o); v += (lane >= o) ? t : 0.f; }
    return v;
}
__device__ __forceinline__ void block_gates(const Args& A, int row0, int h, LAS float* bf, LAS float* bb, LAS float* lif, LAS float* lib, int tid) {
    const float* GATE = (const float*)(A.ws + WS_GATE);
    if (tid < 256) { const float* g = GATE + (size_t)(row0 + tid) * 16; lif[tid] = g[0 + h]; bf[tid] = g[4 + h]; lib[tid] = g[8 + h]; bb[tid] = g[12 + h]; }
    __syncthreads();
    const int lane = tid & 63, wv = tid >> 6;
    if (wv == 0) { f32x4 x = *(LAS f32x4*)(bf + 4 * lane); x.y += x.x; x.z += x.y; x.w += x.z; const float tot = wave_incl_scan(x.w, lane); const float ex = tot - x.w;
        x.x += ex; x.y += ex; x.z += ex; x.w += ex; *(LAS f32x4*)(bf + 4 * lane) = x; }
    if (wv == 1) { f32x4 y = *(LAS f32x4*)(bb + 4 * (63 - lane)); y.z += y.w; y.y += y.z; y.x += y.y; const float tot = wave_incl_scan(y.x, lane); const float ex = tot - y.x;
        y.x += ex; y.y += ex; y.z += ex; y.w += ex; *(LAS f32x4*)(bb + 4 * (63 - lane)) = y; }
    __syncthreads();
}
__device__ __forceinline__ void phase_s1(const Args& A, const Ctx& C, int l) {
    LAS float* bf = (LAS float*)C.lds; LAS float* bb = bf + 256; LAS float* lif = bb + 256; LAS float* lib = lif + 256; LAS float* af = lib + 256; LAS float* ab = af + 256;
    constexpr int KP = 528;
    LAS unsigned char* KTf = C.lds + 8192; LAS unsigned char* KTb = KTf + 128 * KP;
    const bf16* P = (const bf16*)(A.ws + WS_PB); const bf16* VT = (const bf16*)(A.ws + WS_VT);
    bf16* DC = (bf16*)(A.ws + WS_DC); float* DN = (float*)(A.ws + WS_DN); float* BT = (float*)(A.ws + WS_BTOT);
    const int r = C.lane & 31, hh = C.lane >> 5, w = C.wave;
    for (int it = C.bid; it < BATCH * NH * (NBLK - 1) + 2 * BATCH * NH; it += C.G) {
        const bool isctx = it >= BATCH * NH * (NBLK - 1); const int ci_ = it - BATCH * NH * (NBLK - 1);
        const int bh = isctx ? (ci_ >> 1) : it / (NBLK - 1), blk = isctx ? 0 : 1 + it % (NBLK - 1), h = bh % NH, b = bh / NH; const int u = bh * NBLK + blk; const int row0 = blk_row0(b, blk);
        const int dlo = isctx ? (ci_ & 1) : 0, dhi = isctx ? (ci_ & 1) + 1 : 2;
        block_gates(A, row0, h, bf, bb, lif, lib, C.tid);
        if (C.tid < 256) { af[C.tid] = __expf(bf[255] - bf[C.tid] + lif[C.tid]); ab[C.tid] = __expf(bb[0] - bb[C.tid] + lib[C.tid]); }
        if (C.tid == 0) { BT[u * 2 + 0] = bf[255]; BT[u * 2 + 1] = bb[0]; }
        __syncthreads();
        { const int sp = C.tid >> 2, dq = C.tid & 3, s0 = 2 * sp;
          const bf16* k0 = P + (size_t)(row0 + s0) * PW + NQ + h * DQK + 32 * dq;
          const float f0 = af[s0], f1 = af[s0 + 1], g0 = ab[s0], g1 = ab[s0 + 1];
#pragma unroll
          for (int c = 0; c < 4; ++c) { const u32x4 x0 = *(const u32x4*)(k0 + 8 * c), x1 = *(const u32x4*)(k0 + PW + 8 * c);
#pragma unroll
              for (int q = 0; q < 4; ++q) { const int d = 32 * dq + 8 * c + 2 * q;
                  const float a0 = bflo(x0[q]), a1 = bfhi(x0[q]), c0 = bflo(x1[q]), c1 = bfhi(x1[q]);
                  *(LAS unsigned*)(KTf + d * KP + s0 * 2) = cvt2(a0 * f0, c0 * f1); *(LAS unsigned*)(KTf + (d + 1) * KP + s0 * 2) = cvt2(a1 * f0, c1 * f1);
                  *(LAS unsigned*)(KTb + d * KP + s0 * 2) = cvt2(a0 * g0, c0 * g1); *(LAS unsigned*)(KTb + (d + 1) * KP + s0 * 2) = cvt2(a1 * g0, c1 * g1); } } }
        __syncthreads();
        if (C.tid < 256) { const int dir = C.tid >> 7, d = C.tid & 127; LAS const unsigned* kr = (LAS const unsigned*)((dir ? KTb : KTf) + d * KP); float s = 0.f;
#pragma unroll 8
            for (int i = 0; i < 32; ++i) { const u32x4 x = *(LAS const u32x4*)(kr + 4 * i); s += ((bflo(x.x) + bfhi(x.x)) + (bflo(x.y) + bfhi(x.y))) + ((bflo(x.z) + bfhi(x.z)) + (bflo(x.w) + bfhi(x.w))); }
            DN[(size_t)(u * 2 + dir) * DQK + d] = s; }
        const bf16* vt = VT + (size_t)vt_tile(b, h, blk) * 65536 + (size_t)(32 * w + r) * 32 + 8 * hh;
        bf16x8 av[16];
#pragma unroll
        for (int ks = 0; ks < 16; ++ks) av[ks] = *(const bf16x8*)(vt + (ks >> 1) * 8192 + 16 * (ks & 1));
#pragma unroll 1
        for (int dir = dlo; dir < dhi; ++dir) {
            LAS const unsigned char* KT = dir ? KTb : KTf;
            f32x16 acc[4];
#pragma unroll
            for (int dt = 0; dt < 4; ++dt)
#pragma unroll
                for (int i = 0; i < 16; ++i) acc[dt][i] = 0.f;
#pragma unroll
            for (int ks = 0; ks < 16; ++ks) {
#pragma unroll
                for (int dt = 0; dt < 4; ++dt) { const bf16x8 b0 = *(const LAS bf16x8*)(KT + (dt * 32 + r) * KP + (16 * ks + 8 * hh) * 2); acc[dt] = MFMA32(av[ks], b0, acc[dt]); }
                if ((ks & 3) == 3) asm volatile("" ::: "memory"); }
            lds_barrier();
            { LAS unsigned char* st = KTf + w * 8192;
#pragma unroll
              for (int g = 0; g < 4; ++g)
#pragma unroll
                  for (int q = 0; q < 4; ++q)
#pragma unroll
                      for (int dt = 0; dt < 4; ++dt) *(LAS unsigned short*)(st + dt * 2048 + (8 * g + 4 * hh + q) * 64 + r * 2) = (unsigned short)f2bf(acc[dt][4 * g + q]);
              asm volatile("s_waitcnt lgkmcnt(0)" ::: "memory");
              int lz = threadIdx.x & 63; asm volatile("" : "+v"(lz));
              bf16* dc = DC + (size_t)(u * 2 + dir) * DQK * DV + (size_t)(32 * w) * 32;
#pragma unroll
              for (int i = 0; i < 8; ++i) { const int dt = i >> 1, off = (i & 1) * 1024 + lz * 16;
                  *(u32x4*)((char*)(dc + dt * 8192) + off) = *(const LAS u32x4*)(st + dt * 2048 + off); } }
        }
        __syncthreads();
    }
}
__device__ __forceinline__ void phase_s2(const Args& A, const Ctx& C) {
    const bf16* __restrict__ DC = (const bf16*)(A.ws + WS_DC); const float* __restrict__ DN = (const float*)(A.ws + WS_DN); const float* __restrict__ BT = (const float*)(A.ws + WS_BTOT);
    bf16* __restrict__ CST = (bf16*)(A.ws + WS_CST); float* __restrict__ NST = (float*)(A.ws + WS_NST);
    constexpr int EL4 = DQK * DV / 4;
    for (int g = C.bid * NT + C.tid; g < BATCH * NH * 2 * EL4; g += C.G * NT) {
        const int e4 = (g % EL4) * 4, ch = g / EL4, dir = ch & 1, bh = ch >> 1;
        f32x4 st = (f32x4){0.f, 0.f, 0.f, 0.f};
        constexpr int PF = 16;
        u32x2 ring[PF]; float decr[PF];
#define S2_BLK(idx_) (dir == 0 ? (idx_) : ((idx_) == 0 ? 0 : NBLK - (idx_)))
#pragma unroll
        for (int i = 0; i < PF; ++i) { const int u = bh * NBLK + S2_BLK(i); ring[i] = *(const u32x2*)(DC + (size_t)(u * 2 + dir) * DQK * DV + e4); decr[i] = BT[u * 2 + dir]; }
#pragma unroll
        for (int idx = 0; idx < NBLK; ++idx) {
            const int u = bh * NBLK + S2_BLK(idx);
            const f32x4 dc = bf4(ring[idx % PF]); const float dec = __expf(decr[idx % PF]);
            if (idx + PF < NBLK) { const int u2 = bh * NBLK + S2_BLK(idx + PF); ring[idx % PF] = *(const u32x2*)(DC + (size_t)(u2 * 2 + dir) * DQK * DV + e4); decr[idx % PF] = BT[u2 * 2 + dir]; }
            u32x2 o; o.x = cvt2(st.x, st.y); o.y = cvt2(st.z, st.w);
            *(u32x2*)(CST + (size_t)(u * 2 + dir) * DQK * DV + e4) = o;
            st = st * dec + dc;
        }
#undef S2_BLK
    }
    if (C.wave == 0 && C.bid * 64 < BATCH * NH * 2 * DQK) {
        const int g = C.bid * 64 + C.lane; const int d = g % DQK, ch = g / DQK, dir = ch & 1, bh = ch >> 1; float st = 0.f;
        constexpr int PF = 16; float dnr[PF], btr[PF];
#define S2_BLK(idx_) (dir == 0 ? (idx_) : ((idx_) == 0 ? 0 : NBLK - (idx_)))
#pragma unroll
        for (int i = 0; i < PF; ++i) { const int u = bh * NBLK + S2_BLK(i); dnr[i] = DN[(size_t)(u * 2 + dir) * DQK + d]; btr[i] = BT[u * 2 + dir]; }
#pragma unroll
        for (int idx = 0; idx < NBLK; ++idx) {
            const int u = bh * NBLK + S2_BLK(idx);
            const float dn = dnr[idx % PF], dec = __expf(btr[idx % PF]);
            if (idx + PF < NBLK) { const int u2 = bh * NBLK + S2_BLK(idx + PF); dnr[idx % PF] = DN[(size_t)(u2 * 2 + dir) * DQK + d]; btr[idx % PF] = BT[u2 * 2 + dir]; }
            NST[(size_t)(u * 2 + dir) * DQK + d] = st; st = dec * st + dn;
        }
#undef S2_BLK
    }
}
__device__ __forceinline__ void phase_s3(const Args& A, const Ctx& C, int l) {
    const int jl = l >> 1; const bool ctx_out = (l == 0);
    LAS float* bf = (LAS float*)C.lds; LAS float* bb = bf + 256; LAS float* gf = bb + 256; LAS float* gb = gf + 256;
    LAS float* nf = gb + 256; LAS float* nb = nf + 128; LAS float* ssx = nb + 128;
    LAS float* cf = ssx + 256; LAS float* cb = cf + 256;
    constexpr int KP = 272, OP = 528, CHB = 16384, NCHB = 4;
    LAS unsigned char* Kimg = C.lds + 8192;
    LAS unsigned char* CH = Kimg + 256 * KP;
    LAS unsigned char* OUT = Kimg;
    static_assert(8192 + 256 * KP + NCHB * CHB <= LDS_TAB_END && 8192 + 256 * OP <= LDS_TAB_END, "S3 LDS map");
    const bf16* P = (const bf16*)(A.ws + WS_PB); const bf16* VT = (const bf16*)(A.ws + WS_VT); unsigned char* HM = A.ws + WS_HM;
    const bf16* CST = (const bf16*)(A.ws + WS_CST); const float* NST = (const float*)(A.ws + WS_NST);
    const float* hg = A.in[10] + (size_t)jl * NV;
    const int w = C.wave;
    bf16x8 qf[8]; u32x4 kr8[8]; f32x4 gl;
#define S3_UNIT(it_) ((it_) < BATCH * NH * (NBLK - 1) ? ((it_) / (NBLK - 1)) * NBLK + 1 + (it_) % (NBLK - 1) : ((it_) - BATCH * NH * (NBLK - 1)) * NBLK)
#define S3_LOAD_IN(u_) do { const int u2_ = (u_); const int blk_ = u2_ % NBLK, bh_ = u2_ / NBLK, h_ = bh_ % NH, b_ = bh_ / NH; const int row0_ = blk_row0(b_, blk_); \
        int tq_ = threadIdx.x; asm volatile("" : "+v"(tq_)); const int lq_ = tq_ & 63; \
        { const bf16* qr_ = P + (size_t)(row0_ + 32 * w + (lq_ & 31)) * PW + h_ * DQK + 8 * (lq_ >> 5); \
          _Pragma("unroll") for (int kk = 0; kk < 8; ++kk) qf[kk] = *(const bf16x8*)(qr_ + 16 * kk); } \
        { const bf16* kr_ = P + (size_t)(row0_ + (tq_ >> 4)) * PW + NQ + h_ * DQK + 8 * (tq_ & 15); \
          _Pragma("unroll") for (int i = 0; i < 8; ++i) kr8[i] = *(const u32x4*)(kr_ + (size_t)(32 * i) * PW); } \
        if (tq_ < 256) { const float* g_ = (const float*)(A.ws + WS_GATE) + (size_t)(row0_ + tq_) * 16 + h_; gl = (f32x4){g_[0], g_[4], g_[8], g_[12]}; } \
        else { const int t2_ = tq_ - 256; gl = (f32x4){NST[(size_t)(u2_ * 2 + (t2_ >> 7)) * DQK + (t2_ & 127)], 0.f, 0.f, 0.f}; } } while (0)
    const int nitems = BATCH * NH * (NBLK - 1) + (ctx_out ? BATCH * NH : 0);
    int it = C.bid;
    if (it < nitems) S3_LOAD_IN(S3_UNIT(it));
    while (it < nitems) {
        const int u = S3_UNIT(it);
        const int blk = u % NBLK, bh = u / NBLK, h = bh % NH, b = bh / NH; const int row0 = blk_row0(b, blk);
        const int itn = it + C.G; const int un = itn < nitems ? S3_UNIT(itn) : u;
        const bf16* vtile = VT + (size_t)vt_tile(b, h, blk) * 65536;
        const bf16* ctile = CST + (size_t)(u * 2) * DQK * DV;
#define S3_DMA(c_) do { const int cc_ = (c_); const bool isv_ = cc_ < 8; int ld_ = threadIdx.x & 63; asm volatile("" : "+v"(ld_)); \
                const unsigned dlp_ = (unsigned)(((ld_ & 3) ^ ((ld_ >> 4) & 3)) * 16), drow_ = (unsigned)(32 * w + (ld_ >> 2)); \
                const unsigned long long gp_ = (unsigned long long)(isv_ ? (const char*)vtile + 16384 * cc_ : (const char*)ctile + (cc_ >= 12 ? 2 * DQK * DV : 0) + 16384 * ((cc_ - 8) & 3)); \
                const char* gb_ = (const char*)(((unsigned long long)(unsigned)__builtin_amdgcn_readfirstlane((int)(unsigned)(gp_ >> 32)) << 32) | (unsigned)__builtin_amdgcn_readfirstlane((int)(unsigned)gp_)); \
                _Pragma("unroll") for (int jj = 0; jj < 2; ++jj) \
                    asm volatile("s_mov_b32 m0, %2\n\ts_nop 0\n\tglobal_load_lds_dwordx4 %0, %1" :: "v"(((drow_ + 16u * jj) << 6) + dlp_), "s"(gb_), "s"((unsigned)(size_t)CH + (unsigned)w * 2048u + (unsigned)((cc_ & 3) * CHB + jj * 1024)) : "memory"); } while (0)
        S3_DMA(0); S3_DMA(1); S3_DMA(2);
        { int tu = threadIdx.x; asm volatile("" : "+v"(tu));
          if (tu < 256) { gf[tu] = gl.x; bf[tu] = gl.y; gb[tu] = gl.z; bb[tu] = gl.w; } else nf[tu - 256] = gl.x;
          { const int pc = tu & 15, s0 = tu >> 4, ps0 = (s0 & ~12) | ((s0 & 4) << 1) | ((s0 & 8) >> 1);
#pragma unroll
            for (int i = 0; i < 8; ++i) *(LAS u32x4*)(Kimg + (ps0 + 32 * i) * KP + pc * 16) = kr8[i]; }
          lds_barrier();
          const int lane = tu & 63, wv = tu >> 6;
          if (wv == 0) { f32x4 x = *(LAS f32x4*)(bf + 4 * lane); x.y += x.x; x.z += x.y; x.w += x.z; const float tot = wave_incl_scan(x.w, lane); const float ex = tot - x.w;
              x.x += ex; x.y += ex; x.z += ex; x.w += ex; *(LAS f32x4*)(bf + 4 * lane) = x; }
          if (wv == 1) { f32x4 y = *(LAS f32x4*)(bb + 4 * (63 - lane)); y.z += y.w; y.y += y.z; y.x += y.y; const float tot = wave_incl_scan(y.x, lane); const float ex = tot - y.x;
              y.x += ex; y.y += ex; y.z += ex; y.w += ex; *(LAS f32x4*)(bb + 4 * (63 - lane)) = y; }
          lds_barrier();
          if (tu < 256) { const float a0 = gf[tu] - bf[tu], a1 = gb[tu] - bb[tu]; gf[tu] = a0; gb[tu] = a1; cf[tu] = __expf(bf[tu | 31] + a0); cb[tu] = __expf(bb[tu & ~31] + a1); }
          lds_barrier(); }
        {
            int lz = threadIdx.x & 63; asm volatile("" : "+v"(lz));
            const int r = lz & 31, hh = lz >> 5;
            const int jt = w;
            const float bfj = bf[32 * jt + r], bbj = bb[32 * jt + r];
            float qnf = 0.f, qnb = 0.f;
#pragma unroll
            for (int kk = 0; kk < 8; ++kk) { u32x4 qq = __builtin_bit_cast(u32x4, qf[kk]); asm volatile("" : "+v"(qq));
                const int d = 16 * kk + 8 * hh;
                const f32x4 n0 = *(const LAS f32x4*)(nf + d), n1 = *(const LAS f32x4*)(nf + d + 4), m0 = *(const LAS f32x4*)(nb + d), m1 = *(const LAS f32x4*)(nb + d + 4);
                qnf += (bflo(qq.x) * n0.x + bfhi(qq.x) * n0.y) + (bflo(qq.y) * n0.z + bfhi(qq.y) * n0.w) + (bflo(qq.z) * n1.x + bfhi(qq.z) * n1.y) + (bflo(qq.w) * n1.z + bfhi(qq.w) * n1.w);
                qnb += (bflo(qq.x) * m0.x + bfhi(qq.x) * m0.y) + (bflo(qq.y) * m0.z + bfhi(qq.y) * m0.w) + (bflo(qq.z) * m1.x + bfhi(qq.z) * m1.y) + (bflo(qq.w) * m1.z + bfhi(qq.w) * m1.w);
                if (kk & 1) asm volatile("" ::: "memory"); }
            qnf += __shfl_xor(qnf, 32); qnb += __shfl_xor(qnb, 32);
            float denf = 0.f, denb = 0.f;
#pragma unroll 1
            for (int kt = 0; kt < 8; ++kt) {
                f32x16 c;
#pragma unroll
                for (int i = 0; i < 16; ++i) c[i] = 0.f;
#pragma unroll
                for (int kk = 0; kk < 8; ++kk) { const bf16x8 a = *(const LAS bf16x8*)(Kimg + (kt * 32 + r) * KP + (16 * kk + 8 * hh) * 2); c = MFMA32(a, qf[kk], c); }
                if (kt == jt) {
#pragma unroll
                    for (int g = 0; g < 4; ++g) { const int sl0 = 16 * (g >> 1) + 8 * hh + 4 * (g & 1);
                        const f32x4 g4f = *(const LAS f32x4*)(gf + kt * 32 + sl0), g4b = *(const LAS f32x4*)(gb + kt * 32 + sl0);
#pragma unroll
                        for (int q = 0; q < 4; ++q) { const int sl = sl0 + q; const float cv = c[4 * g + q];
                            denf += cv * __expf((sl <= r) ? bfj + g4f[q] : -1.0e30f); denb += cv * __expf((sl >= r) ? bbj + g4b[q] : -1.0e30f); } }
                } else {
                    LAS const float* cx = (kt < jt ? cf : cb) + kt * 32 + 8 * hh; float sm = 0.f;
#pragma unroll
                    for (int g = 0; g < 4; ++g) { const f32x4 c4 = *(const LAS f32x4*)(cx + 16 * (g >> 1) + 4 * (g & 1)); sm += (c[4 * g] * c4.x + c[4 * g + 1] * c4.y) + (c[4 * g + 2] * c4.z + c[4 * g + 3] * c4.w); }
                    if (kt < jt) denf += sm * __expf(bfj - bf[kt * 32 + 31]); else denb += sm * __expf(bbj - bb[kt * 32]);
                }
            }
            denf += __shfl_xor(denf, 32); denb += __shfl_xor(denb, 32);
            const float ebf = __expf(bfj), ebb = __expf(bbj);
            denf += ebf * qnf; denb += ebb * qnb;
            const float rf = 1.0f / fmaxf(fabsf(denf), 1.0f), rb = 1.0f / fmaxf(fabsf(denb), 1.0f);
            const float scf = ebf * rf, scb = ebb * rb;
            unsigned wdg[8];
#pragma unroll
            for (int g = 0; g < 4; ++g) { const int sl0 = 16 * (g >> 1) + 8 * hh + 4 * (g & 1);
                const f32x4 g4f = *(const LAS f32x4*)(gf + jt * 32 + sl0), g4b = *(const LAS f32x4*)(gb + jt * 32 + sl0);
                float wv[4];
#pragma unroll
                for (int q = 0; q < 4; ++q) { const int sl = sl0 + q; wv[q] = rf * __expf((sl <= r) ? bfj + g4f[q] : -1.0e30f) + rb * __expf((sl >= r) ? bbj + g4b[q] : -1.0e30f); }
                wdg[2 * g] = cvt2(wv[0], wv[1]); wdg[2 * g + 1] = cvt2(wv[2], wv[3]); }
            f32x16 acc[8];
#pragma unroll
            for (int et = 0; et < 8; ++et)
#pragma unroll
                for (int i = 0; i < 16; ++i) acc[et][i] = 0.f;
            asm volatile("s_waitcnt vmcnt(0)" ::: "memory");
            const int swz = (r >> 2) & 3;
#pragma unroll 1
            for (int ci = 0; ci < 8; ++ci) {
                if (ci) { if (blk == 0 && ci >= 6) { if (ci == 6) asm volatile("s_waitcnt vmcnt(2)" ::: "memory"); else asm volatile("s_waitcnt vmcnt(0)" ::: "memory"); } else asm volatile("s_waitcnt vmcnt(4)" ::: "memory"); }
                lds_barrier();
                if (blk != 0 || ci + 3 < 8) S3_DMA(ci + 3);
                LAS const unsigned char* CHc = CH + (ci & 3) * CHB;
                { const int kt = ci;
                        f32x16 c;
#pragma unroll
                        for (int i = 0; i < 16; ++i) c[i] = 0.f;
#pragma unroll
                        for (int kk = 0; kk < 8; ++kk) { const bf16x8 a = *(const LAS bf16x8*)(Kimg + (kt * 32 + r) * KP + (16 * kk + 8 * hh) * 2); c = MFMA32(a, qf[kk], c); }
                        float p[16];
                        if (kt == jt) {
#pragma unroll
                            for (int i = 0; i < 8; ++i) { p[2 * i] = c[2 * i] * bflo(wdg[i]); p[2 * i + 1] = c[2 * i + 1] * bfhi(wdg[i]); }
                        } else {
                            LAS const float* cx = (kt < jt ? cf : cb) + kt * 32 + 8 * hh;
                            const float rw = (kt < jt) ? rf * __expf(bfj - bf[kt * 32 + 31]) : rb * __expf(bbj - bb[kt * 32]);
#pragma unroll
                            for (int g = 0; g < 4; ++g) { const f32x4 c4 = *(const LAS f32x4*)(cx + 16 * (g >> 1) + 4 * (g & 1));
                                p[4 * g] = c[4 * g] * (c4.x * rw); p[4 * g + 1] = c[4 * g + 1] * (c4.y * rw); p[4 * g + 2] = c[4 * g + 2] * (c4.z * rw); p[4 * g + 3] = c[4 * g + 3] * (c4.w * rw); }
                        }
                        const bf16x8 pa0 = pack8(p[0], p[1], p[2], p[3], p[4], p[5], p[6], p[7]), pa1 = pack8(p[8], p[9], p[10], p[11], p[12], p[13], p[14], p[15]);
#pragma unroll
                        for (int et = 0; et < 8; ++et) { LAS const unsigned char* vb = CHc + (et * 32 + r) * 64;
                            const bf16x8 a0 = *(const LAS bf16x8*)(vb + ((hh ^ swz) << 4)), a1 = *(const LAS bf16x8*)(vb + (((2 + hh) ^ swz) << 4));
                            acc[et] = MFMA32(a0, pa0, acc[et]); acc[et] = MFMA32(a1, pa1, acc[et]);
                            if (et & 1) asm volatile("" ::: "memory"); }
                }
            }
            if (blk != 0) {
#pragma unroll
            for (int ci = 8; ci < 16; ++ci) {
                if (ci <= 13) asm volatile("s_waitcnt vmcnt(4)" ::: "memory"); else if (ci == 14) asm volatile("s_waitcnt vmcnt(2)" ::: "memory"); else asm volatile("s_waitcnt vmcnt(0)" ::: "memory");
                lds_barrier();
                if (ci + 3 < 16) S3_DMA(ci + 3);
                LAS const unsigned char* CHc = CH + (ci & 3) * CHB;
                {
                    const int dir = (ci - 8) >> 2, dq = (ci - 8) & 3;
                    const float sc = dir ? scb : scf;
#pragma unroll
                    for (int k2 = 0; k2 < 2; ++k2) { const u32x4 qq = __builtin_bit_cast(u32x4, qf[2 * dq + k2]);
                        const bf16x8 qs = pack8(bflo(qq.x) * sc, bfhi(qq.x) * sc, bflo(qq.y) * sc, bfhi(qq.y) * sc, bflo(qq.z) * sc, bfhi(qq.z) * sc, bflo(qq.w) * sc, bfhi(qq.w) * sc);
#pragma unroll
                        for (int et = 0; et < 8; ++et) { const bf16x8 a = *(const LAS bf16x8*)(CHc + (et * 32 + r) * 64 + (((2 * k2 + hh) ^ swz) << 4)); acc[et] = MFMA32(a, qs, acc[et]);
                            if ((et & 3) == 3) asm volatile("" ::: "memory"); } }
                }
            }
            }
            u32x4 ov[16]; f32x4 g0, g1;
            { int tz = threadIdx.x & 63; asm volatile("" : "+v"(tz)); const int pc = tz & 31, lr0 = tz >> 5;
              g0 = *(const f32x4*)(hg + h * DV + 8 * pc); g1 = *(const f32x4*)(hg + h * DV + 8 * pc + 4);
#pragma unroll
              for (int i = 0; i < 16; ++i) ov[i] = *(const u32x4*)(P + (size_t)(row0 + 32 * w + lr0 + 2 * i) * PW + 2 * NQ + NV + h * DV + 8 * pc); }
            float ss = 0.f;
#pragma unroll
            for (int et = 0; et < 8; ++et)
#pragma unroll
                for (int i = 0; i < 16; ++i) ss += acc[et][i] * acc[et][i];
            ss += __shfl_xor(ss, 32);
            const float rs = 1.0f / sqrtf(ss * (1.0f / DV) + EPS);
            lds_barrier();
            { LAS unsigned char* ob = OUT + (w * 32 + r) * OP + (4 * hh) * 2;
#pragma unroll
              for (int et = 0; et < 8; ++et)
#pragma unroll
                  for (int g = 0; g < 4; ++g) { u32x2 o; o.x = cvt2(acc[et][4 * g + 0] * rs, acc[et][4 * g + 1] * rs); o.y = cvt2(acc[et][4 * g + 2] * rs, acc[et][4 * g + 3] * rs);
                      *(LAS u32x2*)(ob + (et * 32 + 8 * g) * 2) = o; } }
            asm volatile("s_waitcnt lgkmcnt(0)" ::: "memory");
            S3_LOAD_IN(un);
            { int tz = threadIdx.x & 63; asm volatile("" : "+v"(tz)); const int pc = tz & 31, lr0 = tz >> 5;
#pragma unroll
              for (int i = 0; i < 16; ++i) { const int lr = 32 * w + lr0 + 2 * i; const int grow = row0 + lr;
                  const u32x4 hv = *(const LAS u32x4*)(OUT + lr * OP + pc * 16);
                  const f32x4 o0 = (f32x4){bflo(hv.x) * g0.x * bflo(ov[i].x), bfhi(hv.x) * g0.y * bfhi(ov[i].x), bflo(hv.y) * g0.z * bflo(ov[i].y), bfhi(hv.y) * g0.w * bfhi(ov[i].y)};
                  const f32x4 o1 = (f32x4){bflo(hv.z) * g1.x * bflo(ov[i].z), bfhi(hv.z) * g1.y * bfhi(ov[i].z), bflo(hv.w) * g1.z * bflo(ov[i].w), bfhi(hv.w) * g1.w * bfhi(ov[i].w)};
                  *(u32x2*)(HM + (size_t)grow * D + h * DV + 8 * pc) = (u32x2){pack_i8(o0 * (127.0f / HMR)), pack_i8(o1 * (127.0f / HMR))};
                  if ((i & 3) == 3) asm volatile("" ::: "memory"); } }
        }
#undef S3_DMA
        lds_barrier();
        it = itn;
    }
#undef S3_LOAD_IN
#undef S3_UNIT
}

#define XB_TMO      128
#define XB_XCNT(j)  (256  + 64 * (j))
#define XB_XSUB(j)  (1280 + 64 * (j))
#define XB_XGEN(j)  (2304 + 64 * (j))
#define XB_TOP      3328
#define XB_TOPGEN   3392
#define XCD_BAR_WORDS 3456
#define XB_SPIN_CAP (1u << 18)

__device__ __forceinline__ unsigned xb_ld(unsigned* p)              { return __hip_atomic_load(p, __ATOMIC_RELAXED, __HIP_MEMORY_SCOPE_AGENT); }
__device__ __forceinline__ unsigned xb_add(unsigned* p, unsigned v) { return __hip_atomic_fetch_add(p, v, __ATOMIC_RELAXED, __HIP_MEMORY_SCOPE_AGENT); }
__device__ __forceinline__ unsigned xb_xcc_id() { return (unsigned)__builtin_amdgcn_s_getreg((3 << 11) | 20) & 0xFu; }
#define XB_SPIN(cond, bar) do { unsigned _sp = 0; while (cond) { __builtin_amdgcn_s_sleep(1); \
    if ((++_sp & 255u) == 0u) { if (xb_ld(&(bar)[XB_TMO])) break; if (_sp > XB_SPIN_CAP) { atomicAdd(&(bar)[XB_TMO], 1u); break; } } } } while (0)

struct XcdBarrier {
    unsigned* bar; unsigned x;
    volatile LAS unsigned* st;
};

__device__ __forceinline__ XcdBarrier xcd_barrier_post(unsigned* bar, volatile LAS unsigned* st) {
    XcdBarrier b; b.bar = bar; b.x = xb_xcc_id(); b.st = st;
    if (threadIdx.x == 0) (void)xb_add(&bar[XB_XCNT(b.x)], 1u);
    return b;
}
__device__ __forceinline__ void xcd_barrier_complete(unsigned* bar, unsigned x, unsigned& nloc, unsigned& nx) {
    const unsigned G = gridDim.x * gridDim.y * gridDim.z;
    unsigned sum, cnt, mine, sp = 0u;
    for (;;) {
        sum = 0u; cnt = 0u; mine = 0u;
#pragma unroll
        for (unsigned j = 0; j < 16; ++j) { const unsigned c = xb_ld(&bar[XB_XCNT(j)]); sum += c; cnt += (c > 0u) ? 1u : 0u; mine = (j == x) ? c : mine; }
        if (sum == G) break;
        __builtin_amdgcn_s_sleep(1);
        if ((++sp & 255u) == 0u) { if (xb_ld(&bar[XB_TMO])) break; if (sp > XB_SPIN_CAP) { atomicAdd(&bar[XB_TMO], 1u); break; } }
    }
    nloc = mine > 0u ? mine : 1u; nx = cnt > 0u ? cnt : 1u;
}

__device__ __forceinline__ void xcd_barrier(const XcdBarrier& b) {
    asm volatile("s_waitcnt vmcnt(0)" ::: "memory");
    __syncthreads();
    if (threadIdx.x == 0) {
        unsigned* bar = b.bar;
        __builtin_amdgcn_s_waitcnt(0);
        unsigned nloc = b.st[0], nx = b.st[1];
        if (nloc == 0u) { xcd_barrier_complete(bar, b.x, nloc, nx); b.st[0] = nloc; b.st[1] = nx; }
        const unsigned old = xb_add(&bar[XB_XSUB(b.x)], 1u);
        const unsigned gen = old / nloc;
        if (old + 1u == (gen + 1u) * nloc) {
            __builtin_amdgcn_fence(__ATOMIC_RELEASE, "agent");
            asm volatile("s_waitcnt vmcnt(0)" ::: "memory");
            const unsigned og = xb_add(&bar[XB_TOP], 1u);
            const unsigned tg = og / nx;
            if (og + 1u == (tg + 1u) * nx) xb_add(&bar[XB_TOPGEN], 1u);
            else XB_SPIN(xb_ld(&bar[XB_TOPGEN]) == tg, bar);
            __builtin_amdgcn_fence(__ATOMIC_ACQUIRE, "agent");
            xb_add(&bar[XB_XGEN(b.x)], 1u);
            asm volatile("s_waitcnt vmcnt(0)" ::: "memory");
        } else {
            XB_SPIN(xb_ld(&bar[XB_XGEN(b.x)]) == gen, bar);
            __builtin_amdgcn_fence(__ATOMIC_ACQUIRE, "agent");
            asm volatile("s_waitcnt vmcnt(0)" ::: "memory");
        }
    }
    __syncthreads();
}


constexpr int LDS_BYTES = 152 * 1024;
constexpr int CW_BAR = 16384;
static_assert((CW_BAR + XCD_BAR_WORDS) * 4 <= (int)CTL_BYTES, "ctl");
#ifndef MK_MULTI
#define MK_MULTI 0
#endif
#define IN(p) (lo <= (p) && (p) < hi)
#define SEAM(p) do { if ((p) + 1 < hi) { XcdBarrier b_; b_.bar = (unsigned*)(load_args().ws + WS_CTL) + CW_BAR; b_.x = xb_xcc_id(); b_.st = (volatile LAS unsigned*)(C.lds + LDS_BYTES - 16); xcd_barrier(b_); } } while (0)
#define CAS __attribute__((address_space(4)))
__device__ __forceinline__ Args load_args() {
#if defined(__HIP_DEVICE_COMPILE__)
    const CAS Args* p = (const CAS Args*)__builtin_amdgcn_kernarg_segment_ptr(); asm volatile("" : "+s"(p));
    Args a; for (int i = 0; i < 22; ++i) a.in[i] = p->in[i]; a.out = p->out; a.ws = p->ws; a.lo = p->lo; a.hi = p->hi; return a;
#else
    return Args{};
#endif
}
__device__ __forceinline__ Ctx fresh(const Ctx& C) { Ctx R = C; int tz = threadIdx.x; asm volatile("" : "+v"(tz)); R.tid = tz; R.lane = tz & 63; return R; }
template <int L> __device__ __forceinline__ void layer_phases(const Args& args, const Ctx& C, int bar, int lo, int hi) {
    constexpr int pb = 16 * L;
    if (IN(pb + 1)) { phase_r1(load_args(), fresh(C), L); SEAM(pb + 1); }
    if (IN(pb + 2)) { phase_g1(load_args(), fresh(C), L); SEAM(pb + 2); }
    if constexpr ((L & 1) == 0) {
        if (IN(pb + 3)) { phase_s1(load_args(), fresh(C), L); SEAM(pb + 3); }
        if (IN(pb + 4)) { phase_s2(load_args(), fresh(C)); SEAM(pb + 4); }
        if (IN(pb + 5)) { phase_s3(load_args(), fresh(C), L); SEAM(pb + 5); }
    } else {
        if (IN(pb + 3)) { phase_conv(load_args(), fresh(C), L); SEAM(pb + 3); }
    }
    if (IN(pb + 6)) { phase_g2(load_args(), fresh(C), L); SEAM(pb + 6); }
    if (IN(pb + 7)) { phase_r2(load_args(), fresh(C), L); SEAM(pb + 7); }
    if (IN(pb + 8)) { phase_m1(load_args(), fresh(C), L); SEAM(pb + 8); }
    if (IN(pb + 9)) { phase_m2(load_args(), fresh(C), L); SEAM(pb + 9); }
}
__global__ void __launch_bounds__(NT, 2) fwd_kernel(Args args) {
    extern __shared__ __attribute__((aligned(16))) unsigned char lds_raw[];
    Ctx C; C.lds = (LAS unsigned char*)lds_raw; C.tid = threadIdx.x; C.lane = C.tid & 63; C.wave = __builtin_amdgcn_readfirstlane(C.tid >> 6); C.G = gridDim.x; C.bid = blockIdx.x; C.a = &args;
    const int lo = args.lo, hi = args.hi;
    volatile LAS unsigned* xbw = (volatile LAS unsigned*)(C.lds + LDS_BYTES - 16);
    if (C.tid < 4) xbw[C.tid] = 0u;
    __syncthreads();
    if (hi - lo > 1) (void)xcd_barrier_post((unsigned*)(args.ws + WS_CTL) + CW_BAR, xbw);
    const int bar = 0; (void)bar;
    if (IN(0)) { phase_mod(load_args(), fresh(C)); __syncthreads(); phase_cvt_mixer(load_args(), fresh(C)); SEAM(0); }
    layer_phases<0>(args, C, bar, lo, hi);
    layer_phases<1>(args, C, bar, lo, hi);
    layer_phases<2>(args, C, bar, lo, hi);
    layer_phases<3>(args, C, bar, lo, hi);
    if (IN(64)) phase_final(load_args(), fresh(C));
}
#undef IN
#undef SEAM

extern "C" void kernel_launch(void* const* d_in, const int* in_sizes, int n_in, void* d_out, int out_size, void* d_ws, size_t ws_size, hipStream_t stream) {
    static int grid = 0;
    if (grid == 0) {
        if (n_in != 22 || out_size != NL * D || ws_size < WS_END) { fprintf(stderr, "kernel_launch: unexpected shapes (n_in %d out %d ws %zu)\n", n_in, out_size, ws_size); grid = -1; return; }
        int dev = 0, cus = 0, per_cu = 0;
        if (hipGetDevice(&dev) != hipSuccess || hipDeviceGetAttribute(&cus, hipDeviceAttributeMultiprocessorCount, dev) != hipSuccess) { grid = -1; return; }
        if (hipFuncSetAttribute((const void*)fwd_kernel, hipFuncAttributeMaxDynamicSharedMemorySize, LDS_BYTES) != hipSuccess) { grid = -1; return; }
        if (hipOccupancyMaxActiveBlocksPerMultiprocessor(&per_cu, (const void*)fwd_kernel, NT, LDS_BYTES) != hipSuccess || per_cu < 1) { fprintf(stderr, "kernel_launch: occupancy query says %d\n", per_cu); }
        (void)hipGetLastError();
        grid = cus;
    }
    if (grid < 0) return;
    (void)hipMemsetAsync((char*)d_ws + WS_CTL, 0, CTL_BYTES, stream);
    Args a{};
    for (int i = 0; i < 22; ++i) a.in[i] = (const float*)d_in[i];
    a.out = (float*)d_out; a.ws = (unsigned char*)d_ws;
#if MK_MULTI
    int phases[64]; int np = 0;
    phases[np++] = 0;
    for (int l = 0; l < DEPTH; ++l) { const int pb = 16 * l; phases[np++] = pb + 1; phases[np++] = pb + 2; phases[np++] = pb + 3;
        if ((l & 1) == 0) { phases[np++] = pb + 4; phases[np++] = pb + 5; }
        phases[np++] = pb + 6; phases[np++] = pb + 7; phases[np++] = pb + 8; phases[np++] = pb + 9; }
    phases[np++] = 64;
    for (int i = 0; i < np; ++i) { a.lo = phases[i]; a.hi = phases[i] + 1; hipLaunchKernelGGL(fwd_kernel, dim3(grid), dim3(NT), LDS_BYTES, stream, a); }
#else
    a.lo = 0; a.hi = 65;
    hipLaunchKernelGGL(fwd_kernel, dim3(grid), dim3(NT), LDS_BYTES, stream, a);
#ifdef PROBE_PHASES
    { const int pp[] = {PROBE_PHASES};
      for (int rep = 0; rep < PROBE_REPS; ++rep) for (unsigned i = 0; i < sizeof(pp) / sizeof(pp[0]); ++i) { a.lo = pp[i]; a.hi = pp[i] + 1; hipLaunchKernelGGL(fwd_kernel, dim3(grid), dim3(NT), LDS_BYTES, stream, a); } }
#endif
#endif
}
```

```cpp
#include <hip/hip_runtime.h>
#include <cstdio>
#include <cstdint>

#define LAS __attribute__((address_space(3)))
typedef unsigned short bf16;
typedef float f32x4 __attribute__((ext_vector_type(4)));
typedef unsigned u32x4 __attribute__((ext_vector_type(4)));
typedef unsigned u32x2 __attribute__((ext_vector_type(2)));
typedef int i32x4r __attribute__((ext_vector_type(4)));

constexpr int D = 1024, BATCH = 2, SEQ = 16384, DEPTH = 4, CTXL = 256;
constexpr int NL = BATCH * SEQ, NCX = BATCH * CTXL, NR = NL + NCX;
constexpr int NH = 4, DQK = 128, DV = 256, NQ = 512, NV = 1024, PROJ = 3088, PW = 3072;
constexpr int NGRP = 4, EPG = 8, NE = 32, DE = 512;
constexpr int NBLK = 65;
constexpr int NUNIT = BATCH * NH * NBLK;
constexpr int CAP = NR;
constexpr int YROWS = 74752;
constexpr float EPS = 1e-6f;
constexpr float WSCALE = 32.0f;
constexpr float YSCALE = 4.0f;
constexpr int NT = 512, NW = 8;
constexpr int LDS_TAB_END = 152 * 1024 - 16;

constexpr size_t MiB = 1u << 20;
constexpr size_t WS_CTL = 0, CTL_BYTES = 1 * MiB;
constexpr size_t WS_MOD = 1 * MiB;
constexpr size_t WS_GATE = 2 * MiB;
constexpr size_t WS_TOKSLOT = 5 * MiB;
constexpr size_t WS_TOKW = 6 * MiB;
constexpr size_t WS_SLOTTOK = 7 * MiB;
constexpr size_t WS_DN = 12 * MiB;
constexpr size_t WS_NST = 13 * MiB;
constexpr size_t WS_BTOT = 14 * MiB;
constexpr size_t WS_RSC = 15 * MiB;
constexpr size_t WS_LAT = 16 * MiB;
constexpr size_t WS_HB = 146 * MiB;
constexpr size_t WS_PB = 211 * MiB;
constexpr size_t WS_HM = 406 * MiB;
constexpr size_t WS_DC = 471 * MiB;
constexpr size_t WS_CST = 601 * MiB;
constexpr size_t WS_VT = 666 * MiB;
constexpr size_t WS_WAIN = 731 * MiB;
constexpr size_t WS_WBIN = 743 * MiB;
constexpr size_t WS_WAOUT = 755 * MiB;
constexpr size_t WS_WBOUT = 759 * MiB;
constexpr size_t WS_WGU = 763 * MiB;
constexpr size_t WS_WDN = 827 * MiB;
constexpr size_t WS_H8 = 843 * MiB;
constexpr size_t WS_END = 880 * MiB;
constexpr int CW_WMAX = 256;
constexpr int CW_CNT = 1024, CNT_STRIDE = 64;

struct Args { const float* in[22]; float* out; unsigned char* ws; int lo, hi; };

typedef short bf16x8 __attribute__((ext_vector_type(8)));
typedef float f32x2 __attribute__((ext_vector_type(2)));
typedef __bf16 bf16x2_t __attribute__((ext_vector_type(2)));
__device__ __forceinline__ unsigned cvt2(float lo, float hi) { const f32x2 v = {lo, hi}; return __builtin_bit_cast(unsigned, __builtin_convertvector(v, bf16x2_t)); }
__device__ __forceinline__ float bf2f(bf16 v) { return __uint_as_float(((unsigned)v) << 16); }
__device__ __forceinline__ unsigned f2bf(float f) { return cvt2(f, 0.f) & 0xffffu; }
__device__ __forceinline__ unsigned pk2(float lo, float hi) { return cvt2(lo, hi); }
template <int CTRL, int ROWMASK> __device__ __forceinline__ float dpp_mov(float x) { return __int_as_float(__builtin_amdgcn_update_dpp(0, __float_as_int(x), CTRL, ROWMASK, 0xf, false)); }
__device__ __forceinline__ float wave_sum(float v) {
    v += dpp_mov<0xB1, 0xf>(v); v += dpp_mov<0x4E, 0xf>(v); v += dpp_mov<0x141, 0xf>(v); v += dpp_mov<0x140, 0xf>(v);
    v += dpp_mov<0x142, 0xA>(v); v += dpp_mov<0x143, 0xC>(v);
    return __int_as_float(__builtin_amdgcn_readlane(__float_as_int(v), 63));
}
__device__ __forceinline__ float wave_max_nn(float v) {
    v = fmaxf(v, dpp_mov<0xB1, 0xf>(v)); v = fmaxf(v, dpp_mov<0x4E, 0xf>(v)); v = fmaxf(v, dpp_mov<0x141, 0xf>(v)); v = fmaxf(v, dpp_mov<0x140, 0xf>(v));
    v = fmaxf(v, dpp_mov<0x142, 0xA>(v)); v = fmaxf(v, dpp_mov<0x143, 0xC>(v));
    return __int_as_float(__builtin_amdgcn_readlane(__float_as_int(v), 63));
}
__device__ __forceinline__ unsigned pack_i8_nc(f32x4 v) {
    const unsigned a = __float_as_uint(v.x + 12582912.0f), b = __float_as_uint(v.y + 12582912.0f), c = __float_as_uint(v.z + 12582912.0f), d = __float_as_uint(v.w + 12582912.0f);
    return __builtin_amdgcn_perm(__builtin_amdgcn_perm(d, c, 0x0c0c0400u) , __builtin_amdgcn_perm(b, a, 0x0c0c0400u), 0x05040100u);
}
__device__ __forceinline__ unsigned pack_i8(f32x4 v) {
    return pack_i8_nc((f32x4){__builtin_amdgcn_fmed3f(v.x, -127.f, 127.f), __builtin_amdgcn_fmed3f(v.y, -127.f, 127.f), __builtin_amdgcn_fmed3f(v.z, -127.f, 127.f), __builtin_amdgcn_fmed3f(v.w, -127.f, 127.f)});
}
__device__ __forceinline__ float sigmoidf_(float x) { return 1.f / (1.f + __expf(-x)); }
__device__ __forceinline__ float siluf_(float x) { return x / (1.f + __expf(-x)); }
__device__ __forceinline__ float logsigmoidf_(float x) { return fminf(x, 0.f) - log1pf(__expf(-fabsf(x))); }
__device__ __forceinline__ int blk_row0(int b, int blk) { return blk == 0 ? NL + b * CTXL : b * SEQ + (blk - 1) * 256; }
__device__ __forceinline__ int mod_vec_of_row(int row) { return row < NL ? row / SEQ : 2; }

struct Ctx {
    LAS unsigned char* lds; int tid, lane, wave, G, bid;
    const Args* a;
};

__device__ __forceinline__ int expert_block_prefix(const unsigned* cnt, int lane, int& nb) {
    nb = lane < NE ? ((int)cnt[lane * CNT_STRIDE] + 255) / 256 : 0; int v = nb;
#pragma unroll
    for (int o = 1; o < 64; o <<= 1) { const int t = __shfl_up(v, o); v += (lane >= o) ? t : 0; }
    return v - nb;
}
__device__ __forceinline__ void slot_bases(const Args& A, int l, LAS int* sb, int tid) {
    if (tid < 64) { int nb; const int ex = expert_block_prefix((const unsigned*)(A.ws + WS_CTL) + CW_CNT + l * 32 * CNT_STRIDE, tid, nb); if (tid <= NE) sb[tid] = ex * 256; }
    __syncthreads();
}

__device__ __forceinline__ void phase_mod(const Args& A, const Ctx& C) {
    LAS float* sc = (LAS float*)C.lds;
    LAS float* red = sc + 3072;
    const float* c = A.in[1]; const float* cc = A.in[3];
    for (int i = C.tid; i < 3072; i += NT) { const float v = i < 2048 ? c[i] : cc[i - 2048]; sc[i] = siluf_(v); }
    __syncthreads();
    float* MOD = (float*)(A.ws + WS_MOD);
    for (int u = C.bid; u < DEPTH * 192; u += C.G) {
        const int l = u / 192, cg = u % 192, col = cg * 32 + (C.lane & 31), kh = C.lane >> 5;
        const float* w = A.in[4] + (size_t)l * D * 6 * D + col + (size_t)(C.wave * 128 + kh * 64) * 6 * D;
        float wv[64];
#pragma unroll
        for (int k = 0; k < 64; ++k) wv[k] = w[(size_t)k * 6 * D];
        LAS const float* s0 = sc + C.wave * 128 + kh * 64;
        float a0 = 0.f, a1 = 0.f, a2 = 0.f;
#pragma unroll
        for (int k = 0; k < 64; ++k) { a0 += s0[k] * wv[k]; a1 += s0[1024 + k] * wv[k]; a2 += s0[2048 + k] * wv[k]; }
        a0 += __shfl_xor(a0, 32); a1 += __shfl_xor(a1, 32); a2 += __shfl_xor(a2, 32);
        if (kh == 0) { red[(C.wave * 3 + 0) * 64 + C.lane] = a0; red[(C.wave * 3 + 1) * 64 + C.lane] = a1; red[(C.wave * 3 + 2) * 64 + C.lane] = a2; }
        __syncthreads();
        if (C.tid < 96) { const int v = C.tid / 32, ln = C.tid % 32; float s = 0.f;
            for (int w8 = 0; w8 < 8; ++w8) s += red[(w8 * 3 + v) * 64 + ln];
            MOD[(size_t)(l * 3 + v) * 6 * D + cg * 32 + ln] = s + A.in[5][(size_t)l * 6 * D + cg * 32 + ln]; }
        __syncthreads();
    }
}
__device__ __forceinline__ void load_row_f32(const float* p, int lane, f32x4 (&v)[4]) {
#pragma unroll
    for (int j = 0; j < 4; ++j) v[j] = *(const f32x4*)(p + 4 * lane + 256 * j);
}
__device__ __forceinline__ void load_row_bf16(const bf16* p, int lane, f32x4 (&v)[4]) {
#pragma unroll
    for (int j = 0; j < 4; ++j) { const u32x2 w = *(const u32x2*)(p + 4 * lane + 256 * j);
        v[j] = (f32x4){__uint_as_float(w.x << 16), __uint_as_float(w.x & 0xffff0000u), __uint_as_float(w.y << 16), __uint_as_float(w.y & 0xffff0000u)}; }
}
__device__ __forceinline__ void store_row_bf16(bf16* p, int lane, const f32x4 (&v)[4]) {
#pragma unroll
    for (int j = 0; j < 4; ++j) { u32x2 w; w.x = pk2(v[j].x, v[j].y); w.y = pk2(v[j].z, v[j].w); *(u32x2*)(p + 4 * lane + 256 * j) = w; }
}
constexpr int CVT_IG = (D / 64) * (DE / 32), CVT_ID = (DE / 64) * (D / 32), CVT_PER = 2 * CVT_IG + CVT_ID, CVT_ITEMS = NE * CVT_PER;
constexpr int CVT_Q = 24;
__device__ __forceinline__ void cvt_moe_items(const Args& A, const Ctx& C, int l, int it0, int end, int stride);
__device__ __forceinline__ void cvt_win_i8(const Args& A, const Ctx& C);
__device__ __forceinline__ int cvt_t2(int l, int G);
struct RowVec { f32x4 a[4], s[4], g[4]; };
__device__ __forceinline__ void load_rowvec(RowVec& R, const float* ng, const float* sh, const float* sc, const float* gt, int lane) {
    f32x4 n[4], c[4]; load_row_f32(ng, lane, n); load_row_f32(sc, lane, c); load_row_f32(sh, lane, R.s); if (gt) load_row_f32(gt, lane, R.g);
#pragma unroll
    for (int q = 0; q < 4; ++q) R.a[q] = n[q] * (1.f + c[q]);
}
__device__ __forceinline__ void load_row_bf16raw(const bf16* p, int lane, u32x2 (&v)[4]) {
#pragma unroll
    for (int j = 0; j < 4; ++j) v[j] = *(const u32x2*)(p + 4 * lane + 256 * j);
}
__device__ __forceinline__ void store_row_fp8(unsigned char* p, int lane, const f32x4 (&v)[4]) {
#pragma unroll
    for (int j = 0; j < 4; ++j) { int w = 0; w = __builtin_amdgcn_cvt_pk_fp8_f32(v[j].x, v[j].y, w, false); w = __builtin_amdgcn_cvt_pk_fp8_f32(v[j].z, v[j].w, w, true); *(unsigned*)(p + 4 * lane + 256 * j) = (unsigned)w; }
}
__device__ __forceinline__ void load_row_fp8raw(const unsigned char* p, int lane, unsigned (&v)[4]) {
#pragma unroll
    for (int j = 0; j < 4; ++j) v[j] = *(const unsigned*)(p + 4 * lane + 256 * j);
}
__device__ __forceinline__ f32x4 fp8x4(unsigned w) { const f32x2 lo = __builtin_amdgcn_cvt_pk_f32_fp8((int)w, false), hi = __builtin_amdgcn_cvt_pk_f32_fp8((int)w, true); return (f32x4){lo.x, lo.y, hi.x, hi.y}; }
__device__ __forceinline__ f32x4 bf4(u32x2 w) { return (f32x4){__uint_as_float(w.x << 16), __uint_as_float(w.x & 0xffff0000u), __uint_as_float(w.y << 16), __uint_as_float(w.y & 0xffff0000u)}; }
__device__ __forceinline__ float row_rstd(const f32x4 (&v)[4]) {
    float s = 0.f;
#pragma unroll
    for (int j = 0; j < 4; ++j) s += (v[j].x * v[j].x + v[j].y * v[j].y) + (v[j].z * v[j].z + v[j].w * v[j].w);
    return 1.0f / sqrtf(wave_sum(s) * (1.f / D) + EPS);
}

__device__ __forceinline__ void phase_r1(const Args& A, const Ctx& C, int l) {
    LAS int* sb = (LAS int*)C.lds;
    constexpr int GWP = 2064;
    LAS unsigned char* GW = C.lds + 256;
    LAS unsigned char* HS = C.lds + 256 + 16 * GWP + C.wave * 2 * GWP;
    const bool mls = (l & 1) == 0; const int j = l >> 1;
    if (l == 0) { cvt_win_i8(A, C); __syncthreads(); }
    if (l > 0) slot_bases(A, l - 1, sb, C.tid);
    if (mls) { const float* w = A.in[8] + (size_t)j * D * PROJ + PW;
        f32x4 t[2][4];
#pragma unroll
        for (int jj = 0; jj < 2; ++jj)
#pragma unroll
            for (int q = 0; q < 4; ++q) t[jj][q] = *(const f32x4*)(w + (size_t)(C.tid + NT * jj) * PROJ + 4 * q);
#pragma unroll
        for (int jj = 0; jj < 2; ++jj)
#pragma unroll
            for (int q = 0; q < 4; ++q) { const int k = C.tid + NT * jj;
#pragma unroll
                for (int c = 0; c < 4; ++c) *(LAS unsigned short*)(GW + (4 * q + c) * GWP + k * 2) = (unsigned short)f2bf(t[jj][q][c]); }
        __syncthreads(); }
    const int nrows = (l <= 2) ? NR : NL;
    bf16* LAT = (bf16*)(A.ws + WS_LAT); unsigned char* HI8 = A.ws + WS_H8; float* RSC = (float*)(A.ws + WS_RSC); float* GATE = (float*)(A.ws + WS_GATE);
    const float* MOD = (const float*)(A.ws + WS_MOD); const unsigned char* Y8 = A.ws + WS_PB;
    const int* TS = (const int*)(A.ws + WS_TOKSLOT); const float* TW = (const float*)(A.ws + WS_TOKW);
    const int rpw = (((nrows + C.G - 1) / C.G) + 1) & ~1; const int wrow0 = C.bid * rpw; const int wend = min(wrow0 + rpw, nrows);
    for (int sa = wrow0; sa < wend;) {
        const int mvi = mod_vec_of_row(sa); const int bnd = mvi == 0 ? SEQ : (mvi == 1 ? NL : NR); const int sbnd = min(wend, bnd);
        RowVec RV; { const float* mv = MOD + (size_t)(l * 3 + mvi) * 6 * D;
            load_rowvec(RV, A.in[6] + (size_t)(l * 2 + 0) * D, mv + 0 * D, mv + 1 * D, l > 0 ? MOD + (size_t)((l - 1) * 3 + mvi) * 6 * D + 5 * D : nullptr, C.lane); }
        const int rlast = sbnd - 2; const int rfirst = sa + 2 * C.wave;
        i32x4r ts1 = (i32x4r){0, 0, 0, 0}, ts2 = ts1; f32x4 tw1 = (f32x4){0.f, 0.f, 0.f, 0.f}, tw2 = tw1;
        u32x2 nla[4], nlb[4]; unsigned nya0[4], nya1[4], nyb0[4], nyb1[4]; f32x4 nxa[4], nxb[4];
#define R1_FETCH(r_, ts_) do { const int fa_ = (r_), fb_ = fa_ + 1; \
            if (l == 0) { load_row_f32(fa_ < NL ? A.in[0] + (size_t)fa_ * D : A.in[2] + (size_t)(fa_ - NL) * D, C.lane, nxa); load_row_f32(fb_ < NL ? A.in[0] + (size_t)fb_ * D : A.in[2] + (size_t)(fb_ - NL) * D, C.lane, nxb); } \
            else { load_row_bf16raw(LAT + (size_t)fa_ * D, C.lane, nla); load_row_bf16raw(LAT + (size_t)fb_ * D, C.lane, nlb); \
                load_row_fp8raw(Y8 + (size_t)(sb[(ts_).x >> 20] + ((ts_).x & 0xfffff)) * D, C.lane, nya0); load_row_fp8raw(Y8 + (size_t)(sb[(ts_).y >> 20] + ((ts_).y & 0xfffff)) * D, C.lane, nya1); \
                load_row_fp8raw(Y8 + (size_t)(sb[(ts_).z >> 20] + ((ts_).z & 0xfffff)) * D, C.lane, nyb0); load_row_fp8raw(Y8 + (size_t)(sb[(ts_).w >> 20] + ((ts_).w & 0xfffff)) * D, C.lane, nyb1); } } while (0)
        if (l > 0) { const int r0 = min(rfirst, rlast), r1 = min(rfirst + 2 * NW, rlast);
            ts1 = *(const i32x4r*)(TS + r0 * 2); tw1 = *(const f32x4*)(TW + r0 * 2); ts2 = *(const i32x4r*)(TS + r1 * 2); tw2 = *(const f32x4*)(TW + r1 * 2); }
        R1_FETCH(min(rfirst, rlast), ts1);
        for (int ra = rfirst; ra < sbnd; ra += 2 * NW) {
            const bool hasb = true; const int rb = ra + 1;
            f32x4 va[4], vb[4];
            if (l == 0) {
#pragma unroll
                for (int q = 0; q < 4; ++q) { va[q] = nxa[q]; vb[q] = nxb[q]; }
                R1_FETCH(min(ra + 2 * NW, rlast), ts1);
            } else {
                u32x2 la[4], lb[4]; unsigned ya0[4], ya1[4], yb0[4], yb1[4];
#pragma unroll
                for (int q = 0; q < 4; ++q) { la[q] = nla[q]; lb[q] = nlb[q]; ya0[q] = nya0[q]; ya1[q] = nya1[q]; yb0[q] = nyb0[q]; yb1[q] = nyb1[q]; }
                const f32x4 twc = tw1;
                ts1 = ts2; tw1 = tw2;
                { const int r2 = min(ra + 4 * NW, rlast); ts2 = *(const i32x4r*)(TS + r2 * 2); tw2 = *(const f32x4*)(TW + r2 * 2); }
                R1_FETCH(min(ra + 2 * NW, rlast), ts1);
                const float wa0 = twc.x * (1.0f / YSCALE), wa1 = twc.y * (1.0f / YSCALE), wb0 = twc.z * (1.0f / YSCALE), wb1 = twc.w * (1.0f / YSCALE);
#pragma unroll
                for (int q = 0; q < 4; ++q) { va[q] = bf4(la[q]) + RV.g[q] * (fp8x4(ya0[q]) * wa0 + fp8x4(ya1[q]) * wa1); vb[q] = bf4(lb[q]) + RV.g[q] * (fp8x4(yb0[q]) * wb0 + fp8x4(yb1[q]) * wb1); }
            }
            store_row_bf16(LAT + (size_t)ra * D, C.lane, va); if (hasb) store_row_bf16(LAT + (size_t)rb * D, C.lane, vb);
            const float rra = row_rstd(va), rrb = row_rstd(vb);
            f32x4 ha[4], hb[4];
#pragma unroll
            for (int q = 0; q < 4; ++q) { ha[q] = (va[q] * rra) * RV.a[q] + RV.s[q]; hb[q] = (vb[q] * rrb) * RV.a[q] + RV.s[q]; }
            { float ma = 0.f, mb = 0.f;
#pragma unroll
              for (int q = 0; q < 4; ++q) { ma = fmaxf(ma, fmaxf(fmaxf(fabsf(ha[q].x), fabsf(ha[q].y)), fmaxf(fabsf(ha[q].z), fabsf(ha[q].w)))); mb = fmaxf(mb, fmaxf(fmaxf(fabsf(hb[q].x), fabsf(hb[q].y)), fmaxf(fabsf(hb[q].z), fabsf(hb[q].w)))); }
              ma = fmaxf(wave_max_nn(ma), 1.0e-20f); mb = fmaxf(wave_max_nn(mb), 1.0e-20f);
              const float ia = 127.0f / ma, ib = 127.0f / mb;
#pragma unroll
              for (int q = 0; q < 4; ++q) { *(unsigned*)(HI8 + (size_t)ra * D + 4 * C.lane + 256 * q) = pack_i8_nc(ha[q] * ia); *(unsigned*)(HI8 + (size_t)rb * D + 4 * C.lane + 256 * q) = pack_i8_nc(hb[q] * ib); }
              if (C.lane == 0) { RSC[ra] = ma * (1.0f / 127.0f); RSC[rb] = mb * (1.0f / 127.0f); } }
            if (mls) {
#pragma unroll
                for (int q = 0; q < 4; ++q) { *(LAS u32x2*)(HS + (4 * C.lane + 256 * q) * 2) = (u32x2){cvt2(ha[q].x, ha[q].y), cvt2(ha[q].z, ha[q].w)}; *(LAS u32x2*)(HS + GWP + (4 * C.lane + 256 * q) * 2) = (u32x2){cvt2(hb[q].x, hb[q].y), cvt2(hb[q].z, hb[q].w)}; }
                asm volatile("s_waitcnt lgkmcnt(0)" ::: "memory");
                f32x4 gacc = (f32x4){0.f, 0.f, 0.f, 0.f};
                { const int gi = C.lane & 15, kg = C.lane >> 4; LAS const unsigned char* ap = HS + (gi & 1) * GWP + kg * 16; LAS const unsigned char* bp = GW + gi * GWP + kg * 16;
#pragma unroll 8
                  for (int s2 = 0; s2 < 32; ++s2) { bf16x8 av = *(const LAS bf16x8*)(ap + s2 * 64); const bf16x8 bv = *(const LAS bf16x8*)(bp + s2 * 64);
                      if (gi >= 2) av = (bf16x8){0, 0, 0, 0, 0, 0, 0, 0};
                      gacc = __builtin_amdgcn_mfma_f32_16x16x32_bf16(av, bv, gacc, 0, 0, 0); } }
                float ga = gacc[0], gb = gacc[1];
                if (C.lane < 16) {
                    const float bgt = A.in[9][j * 16 + C.lane]; const int gtype = C.lane >> 2;
                    ga += bgt; gb += bgt;
                    GATE[(size_t)ra * 16 + C.lane] = (gtype & 1) ? logsigmoidf_(ga) : 15.0f * tanhf(ga * (1.0f / 15.0f));
                    if (hasb) GATE[(size_t)rb * 16 + C.lane] = (gtype & 1) ? logsigmoidf_(gb) : 15.0f * tanhf(gb * (1.0f / 15.0f)); }
            }
        }
#undef R1_FETCH
        sa = sbnd;
    }
}

__device__ __forceinline__ void phase_r2(const Args& A, const Ctx& C, int l) {
    constexpr int WP = 2064;
    LAS unsigned char* RWB = C.lds;
    LAS float* WL = (LAS float*)(C.lds + 48 * WP);
    LAS unsigned* hist = (LAS unsigned*)(WL + 8 * 16 * 48);
    LAS unsigned* gbase = hist + 32;
    constexpr int RCAP = 144;
    LAS int* rec = (LAS int*)(gbase + 32);
    static_assert(48 * WP + 8 * 16 * 48 * 4 + 256 + RCAP * 16 <= LDS_TAB_END, "R2 LDS map");
    cvt_moe_items(A, C, l, cvt_t2(l, C.G) + C.bid * NW + C.wave, CVT_ITEMS, C.G * NW);
    __syncthreads();
    { const float* wg = A.in[15] + (size_t)l * D * NGRP; const float* wr = A.in[17] + (size_t)l * D * NE;
      { const int kp = C.tid; const f32x4 x0 = *(const f32x4*)(wg + (size_t)(2 * kp) * 4), x1 = *(const f32x4*)(wg + (size_t)(2 * kp + 1) * 4);
        *(LAS unsigned*)(RWB + 0 * WP + kp * 4) = cvt2(x0.x, x1.x); *(LAS unsigned*)(RWB + 1 * WP + kp * 4) = cvt2(x0.y, x1.y);
        *(LAS unsigned*)(RWB + 2 * WP + kp * 4) = cvt2(x0.z, x1.z); *(LAS unsigned*)(RWB + 3 * WP + kp * 4) = cvt2(x0.w, x1.w); }
      f32x4 t0[8], t1[8];
#pragma unroll
      for (int jj = 0; jj < 8; ++jj) { const int it = C.tid + NT * jj, kp = it >> 3, cg = it & 7; t0[jj] = *(const f32x4*)(wr + (size_t)(2 * kp) * NE + 4 * cg); t1[jj] = *(const f32x4*)(wr + (size_t)(2 * kp + 1) * NE + 4 * cg); }
#pragma unroll
      for (int jj = 0; jj < 8; ++jj) { const int it = C.tid + NT * jj, kp = it >> 3, c0 = 4 + 4 * (it & 7);
          *(LAS unsigned*)(RWB + (c0 + 0) * WP + kp * 4) = cvt2(t0[jj].x, t1[jj].x); *(LAS unsigned*)(RWB + (c0 + 1) * WP + kp * 4) = cvt2(t0[jj].y, t1[jj].y);
          *(LAS unsigned*)(RWB + (c0 + 2) * WP + kp * 4) = cvt2(t0[jj].z, t1[jj].z); *(LAS unsigned*)(RWB + (c0 + 3) * WP + kp * 4) = cvt2(t0[jj].w, t1[jj].w); }
      for (int i = C.tid; i < 12 * 512; i += NT) *(LAS unsigned*)(RWB + (36 + i / 512) * WP + (i % 512) * 4) = 0u; }
    const int nrows = (l <= 1) ? NR : NL;
    bf16* LAT = (bf16*)(A.ws + WS_LAT); bf16* H = (bf16*)(A.ws + WS_HB); unsigned char* H8 = A.ws + WS_H8;
    const float* MOD = (const float*)(A.ws + WS_MOD);
    unsigned* cnt = (unsigned*)(A.ws + WS_CTL) + CW_CNT + l * 32 * CNT_STRIDE;
    int* TS = (int*)(A.ws + WS_TOKSLOT); float* TW = (float*)(A.ws + WS_TOKW); int* ST = (int*)(A.ws + WS_SLOTTOK);
    const int rpw = (((nrows + C.G - 1) / C.G) + 1) & ~1; const int wrow0 = C.bid * rpw; const int wend0 = min(wrow0 + rpw, nrows);
    const float* bg = A.in[16] + l * NGRP; const float* br = A.in[18] + l * NE;
    for (int cb = wrow0; cb < wend0; cb += RCAP) {
        const int wend = min(cb + RCAP, wend0);
        if (C.tid < 32) hist[C.tid] = 0u;
        for (int sa = cb; sa < wend;) {
            const int mvi = mod_vec_of_row(sa); const int bnd = mvi == 0 ? SEQ : (mvi == 1 ? NL : NR); const int sbnd = min(wend, bnd);
            RowVec RV; { const float* mv = MOD + (size_t)(l * 3 + mvi) * 6 * D; load_rowvec(RV, A.in[6] + (size_t)(l * 2 + 1) * D, mv + 3 * D, mv + 4 * D, mv + 2 * D, C.lane); }
            const int rlast = sbnd - 2;
            u32x2 la[4], lb[4];
            { const int r0 = min(sa + 2 * C.wave, rlast); load_row_bf16raw(LAT + (size_t)r0 * D, C.lane, la); load_row_bf16raw(LAT + (size_t)(r0 + 1) * D, C.lane, lb); }
            for (int ra = sa + 2 * C.wave; ra < sbnd; ra += 2 * NW) {
                const int rb = ra + 1;
                u32x2 lan[4], lbn[4];
                { const int r1 = min(ra + 2 * NW, rlast); load_row_bf16raw(LAT + (size_t)r1 * D, C.lane, lan); load_row_bf16raw(LAT + (size_t)(r1 + 1) * D, C.lane, lbn); }
                f32x4 va[4], vb[4];
#pragma unroll
                for (int q = 0; q < 4; ++q) { va[q] = bf4(la[q]); vb[q] = bf4(lb[q]); }
                const float rra = row_rstd(va), rrb = row_rstd(vb);
                f32x4 ha[4], hb[4];
#pragma unroll
                for (int q = 0; q < 4; ++q) { ha[q] = (va[q] * rra) * RV.a[q] + RV.s[q]; hb[q] = (vb[q] * rrb) * RV.a[q] + RV.s[q]; }
                store_row_bf16(H + (size_t)ra * D, C.lane, ha); store_row_bf16(H + (size_t)rb * D, C.lane, hb);
                store_row_fp8(H8 + (size_t)ra * D, C.lane, ha); store_row_fp8(H8 + (size_t)rb * D, C.lane, hb);
#pragma unroll
                for (int q = 0; q < 4; ++q) { la[q] = lan[q]; lb[q] = lbn[q]; }
            }
            sa = sbnd;
        }
        __syncthreads();
        const int fr = C.lane & 15, fq = C.lane >> 4;
        for (int t = C.wave; t * 16 < wend - cb; t += NW) {
            const int trow = min(cb + 16 * t + fr, wend - 1);
            const bf16* hp = H + (size_t)trow * D + 8 * fq;
            f32x4 acc[3];
#pragma unroll
            for (int ct = 0; ct < 3; ++ct) acc[ct] = (f32x4){0.f, 0.f, 0.f, 0.f};
            { bf16x8 av[32];
#pragma unroll
              for (int k8 = 0; k8 < 32; ++k8) av[k8] = *(const bf16x8*)(hp + 32 * k8);
#pragma unroll
              for (int k8 = 0; k8 < 32; ++k8) {
#pragma unroll
                  for (int ct = 0; ct < 3; ++ct) { const bf16x8 bv = *(const LAS bf16x8*)(RWB + (ct * 16 + fr) * WP + (32 * k8 + 8 * fq) * 2);
                      acc[ct] = __builtin_amdgcn_mfma_f32_16x16x32_bf16(av[k8], bv, acc[ct], 0, 0, 0); }
                  if ((k8 & 3) == 3) asm volatile("" ::: "memory"); } }
            LAS float* wl = WL + C.wave * 16 * 48;
#pragma unroll
            for (int ct = 0; ct < 3; ++ct)
#pragma unroll
                for (int jq = 0; jq < 4; ++jq) wl[(4 * fq + jq) * 48 + ct * 16 + fr] = acc[ct][jq];
            asm volatile("s_waitcnt lgkmcnt(0)" ::: "memory");
            const int row = cb + 16 * t + C.lane;
            if (C.lane < 16 && row < wend) {
                LAS const float* wm = wl + C.lane * 48;
                float lg[36];
#pragma unroll
                for (int c = 0; c < 36; ++c) lg[c] = wm[c];
                float gl[4]; int grp = 0; float gm = -3.0e38f;
#pragma unroll
                for (int c = 0; c < 4; ++c) { gl[c] = lg[c] + bg[c]; if (gl[c] > gm) { gm = gl[c]; grp = c; } }
                float gs = 0.f;
#pragma unroll
                for (int c = 0; c < 4; ++c) gs += __expf(gl[c] - gm);
                const float pgrp = 1.0f / gs;
                float rl[8];
#pragma unroll
                for (int i = 0; i < 8; ++i) { float tt = 0.f;
#pragma unroll
                    for (int g = 0; g < 4; ++g) tt = (g == grp) ? lg[4 + g * 8 + i] : tt;
                    rl[i] = tt + br[grp * 8 + i]; }
                int i0 = 0; float m0 = rl[0];
#pragma unroll
                for (int i = 1; i < 8; ++i) if (rl[i] > m0) { m0 = rl[i]; i0 = i; }
                int i1 = -1; float m1 = -3.0e38f;
#pragma unroll
                for (int i = 0; i < 8; ++i) if (i != i0 && rl[i] > m1) { m1 = rl[i]; i1 = i; }
                const float p0 = 1.0f, p1 = __expf(m1 - m0);
                const float w0 = pgrp * p0 / (p0 + p1), w1 = pgrp * p1 / (p0 + p1);
                const int e0 = grp * 8 + i0, e1 = grp * 8 + i1;
                const unsigned q0 = __hip_atomic_fetch_add(hist + e0, 1u, __ATOMIC_RELAXED, __HIP_MEMORY_SCOPE_WORKGROUP), q1 = __hip_atomic_fetch_add(hist + e1, 1u, __ATOMIC_RELAXED, __HIP_MEMORY_SCOPE_WORKGROUP);
                const int li = row - cb;
                rec[li * 4 + 0] = e0 | (e1 << 8); rec[li * 4 + 1] = (int)q0; rec[li * 4 + 2] = (int)q1;
                TW[row * 2 + 0] = w0; TW[row * 2 + 1] = w1;
            }
        }
        __syncthreads();
        if (C.tid < 32) gbase[C.tid] = hist[C.tid] ? atomicAdd(cnt + C.tid * CNT_STRIDE, hist[C.tid]) : 0u;
        __syncthreads();
        for (int i = C.tid; i < wend - cb; i += NT) { const int row = cb + i; const int ee = rec[i * 4], e0 = ee & 255, e1 = ee >> 8;
            const unsigned q0 = gbase[e0] + (unsigned)rec[i * 4 + 1], q1 = gbase[e1] + (unsigned)rec[i * 4 + 2];
            ST[(size_t)e0 * CAP + q0] = row; ST[(size_t)e1 * CAP + q1] = row;
            TS[row * 2 + 0] = (e0 << 20) | (int)q0; TS[row * 2 + 1] = (e1 << 20) | (int)q1; }
        __syncthreads();
    }
}

__device__ __forceinline__ void phase_final(const Args& A, const Ctx& C) {
    LAS int* sb = (LAS int*)C.lds;
    slot_bases(A, 3, sb, C.tid);
    const bf16* LAT = (const bf16*)(A.ws + WS_LAT); const unsigned char* Y8 = A.ws + WS_PB;
    const int* TS = (const int*)(A.ws + WS_TOKSLOT); const float* TW = (const float*)(A.ws + WS_TOKW);
    const float* MOD = (const float*)(A.ws + WS_MOD);
    f32x4 fg[4]; load_row_f32(A.in[7], C.lane, fg);
    const int rpw = (((NL + C.G - 1) / C.G) + 1) & ~1; const int wrow0 = C.bid * rpw; const int wend = min(wrow0 + rpw, NL);
    for (int sa = wrow0; sa < wend;) {
        const int mvi = mod_vec_of_row(sa); const int sbnd = min(wend, mvi == 0 ? SEQ : NL);
        f32x4 g2[4]; load_row_f32(MOD + (size_t)(3 * 3 + mvi) * 6 * D + 5 * D, C.lane, g2);
        const int rlast = sbnd - 2; const int rfirst = sa + 2 * C.wave;
        i32x4r ts1, ts2; f32x4 tw1, tw2;
        u32x2 nla[4], nlb[4]; unsigned nya0[4], nya1[4], nyb0[4], nyb1[4];
#define FIN_FETCH(r_, ts_) do { const int fa_ = (r_); \
            load_row_bf16raw(LAT + (size_t)fa_ * D, C.lane, nla); load_row_bf16raw(LAT + (size_t)(fa_ + 1) * D, C.lane, nlb); \
            load_row_fp8raw(Y8 + (size_t)(sb[(ts_).x >> 20] + ((ts_).x & 0xfffff)) * D, C.lane, nya0); load_row_fp8raw(Y8 + (size_t)(sb[(ts_).y >> 20] + ((ts_).y & 0xfffff)) * D, C.lane, nya1); \
            load_row_fp8raw(Y8 + (size_t)(sb[(ts_).z >> 20] + ((ts_).z & 0xfffff)) * D, C.lane, nyb0); load_row_fp8raw(Y8 + (size_t)(sb[(ts_).w >> 20] + ((ts_).w & 0xfffff)) * D, C.lane, nyb1); } while (0)
        { const int r0 = min(rfirst, rlast), r1 = min(rfirst + 2 * NW, rlast);
          ts1 = *(const i32x4r*)(TS + r0 * 2); tw1 = *(const f32x4*)(TW + r0 * 2); ts2 = *(const i32x4r*)(TS + r1 * 2); tw2 = *(const f32x4*)(TW + r1 * 2); }
        FIN_FETCH(min(rfirst, rlast), ts1);
        for (int ra = rfirst; ra < sbnd; ra += 2 * NW) {
            const int rb = ra + 1;
            u32x2 la[4], lb[4]; unsigned ya0[4], ya1[4], yb0[4], yb1[4];
#pragma unroll
            for (int q = 0; q < 4; ++q) { la[q] = nla[q]; lb[q] = nlb[q]; ya0[q] = nya0[q]; ya1[q] = nya1[q]; yb0[q] = nyb0[q]; yb1[q] = nyb1[q]; }
            const f32x4 twc = tw1;
            ts1 = ts2; tw1 = tw2;
            { const int r2 = min(ra + 4 * NW, rlast); ts2 = *(const i32x4r*)(TS + r2 * 2); tw2 = *(const f32x4*)(TW + r2 * 2); }
            FIN_FETCH(min(ra + 2 * NW, rlast), ts1);
            const float wa0 = twc.x * (1.0f / YSCALE), wa1 = twc.y * (1.0f / YSCALE), wb0 = twc.z * (1.0f / YSCALE), wb1 = twc.w * (1.0f / YSCALE);
            f32x4 va[4], vb[4];
#pragma unroll
            for (int q = 0; q < 4; ++q) { va[q] = bf4(la[q]) + g2[q] * (fp8x4(ya0[q]) * wa0 + fp8x4(ya1[q]) * wa1); vb[q] = bf4(lb[q]) + g2[q] * (fp8x4(yb0[q]) * wb0 + fp8x4(yb1[q]) * wb1); }
            const float rra = row_rstd(va), rrb = row_rstd(vb);
#pragma unroll
            for (int q = 0; q < 4; ++q) { __builtin_nontemporal_store((va[q] * rra) * fg[q], (f32x4*)(A.out + (size_t)ra * D + 4 * C.lane + 256 * q)); __builtin_nontemporal_store((vb[q] * rrb) * fg[q], (f32x4*)(A.out + (size_t)rb * D + 4 * C.lane + 256 * q)); }
        }
#undef FIN_FETCH
        sa = sbnd;
    }
}

__device__ __forceinline__ void phase_conv(const Args& A, const Ctx& C, int l) {
    const int j = l >> 1; const int nrows = (l <= 1) ? NR : NL;
    const bf16* P = (const bf16*)(A.ws + WS_PB); unsigned char* HM = A.ws + WS_HM; float* RSC = (float*)(A.ws + WS_RSC);
    const float* cw = A.in[13] + (size_t)j * 3 * D;
    f32x4 w0[4], w1[4], w2[4];
    load_row_f32(cw, C.lane, w0); load_row_f32(cw + D, C.lane, w1); load_row_f32(cw + 2 * D, C.lane, w2);
    const int rpw = (((nrows + C.G - 1) / C.G) + 1) & ~1; const int wrow0 = C.bid * rpw; const int wend = min(wrow0 + rpw, nrows);
    for (int ra = wrow0 + 2 * C.wave; ra < wend; ra += 2 * NW) {
        const int rb = ra + 1;
        const int ta = ra < NL ? (ra & 63) : ((ra - NL) & 255), tb1 = rb < NL ? (rb & 63) : ((rb - NL) & 255), tlast = ra < NL ? 63 : 255;
        const bool hasl = ta != 0, hasr = tb1 != tlast;
        const bf16* pa = P + (size_t)ra * PW;
        u32x2 bga[4], bgb[4], zm[4], z0[4], z1[4], z2[4];
        load_row_bf16raw(pa, C.lane, bga); load_row_bf16raw(pa + PW, C.lane, bgb);
        load_row_bf16raw(pa + D, C.lane, z0); load_row_bf16raw(pa + PW + D, C.lane, z1);
        load_row_bf16raw(hasl ? pa - PW + D : pa + D, C.lane, zm); load_row_bf16raw(hasr ? pa + 2 * PW + D : pa + D, C.lane, z2);
        const float fl = hasl ? 1.f : 0.f, fr = hasr ? 1.f : 0.f;
        f32x4 oa[4], ob[4];
#pragma unroll
        for (int q = 0; q < 4; ++q) { const f32x4 a0 = bf4(z0[q]), a1 = bf4(z1[q]);
            oa[q] = bf4(bga[q]) * (w0[q] * (bf4(zm[q]) * fl) + w1[q] * a0 + w2[q] * a1);
            ob[q] = bf4(bgb[q]) * (w0[q] * a0 + w1[q] * a1 + w2[q] * (bf4(z2[q]) * fr)); }
        float ma = 0.f, mb = 0.f;
#pragma unroll
        for (int q = 0; q < 4; ++q) { ma = fmaxf(ma, fmaxf(fmaxf(fabsf(oa[q].x), fabsf(oa[q].y)), fmaxf(fabsf(oa[q].z), fabsf(oa[q].w)))); mb = fmaxf(mb, fmaxf(fmaxf(fabsf(ob[q].x), fabsf(ob[q].y)), fmaxf(fabsf(ob[q].z), fabsf(ob[q].w)))); }
        ma = fmaxf(wave_max_nn(ma), 1.0e-20f); mb = fmaxf(wave_max_nn(mb), 1.0e-20f);
        const float ia = 127.0f / ma, ib = 127.0f / mb;
#pragma unroll
        for (int q = 0; q < 4; ++q) { *(unsigned*)(HM + (size_t)ra * D + 4 * C.lane + 256 * q) = pack_i8_nc(oa[q] * ia); *(unsigned*)(HM + (size_t)rb * D + 4 * C.lane + 256 * q) = pack_i8_nc(ob[q] * ib); }
        if (C.lane == 0) { RSC[ra] = ma * (1.0f / 127.0f); RSC[rb] = mb * (1.0f / 127.0f); }
    }
}

constexpr int BM = 256, BK = 64, HALF = 128, HTB = HALF * BK * 2, STAGE_BYTES = 8 * HTB, NXCD = 8, WGM = 8;
constexpr int LDS_TAB = STAGE_BYTES;
__device__ __forceinline__ int lds_byte(int r, int c) { const int st = (r >> 4) * 2 + (c >> 5), rr = r & 15, cc = c & 31, ob = rr * 64 + cc * 2; return st * 1024 + (ob ^ (((ob >> 9) & 1) << 5)); }
__device__ __forceinline__ void stage_rc(int b, int& R, int& C) { const int st = b / 1024, sb = b % 1024, swz = sb ^ (((sb >> 9) & 1) << 5); R = (st >> 1) * 16 + swz / 64; C = (st & 1) * 32 + (swz % 64) / 2; }
__device__ __forceinline__ int perm32(int rho) { const int n = rho >> 4, i = rho & 15; return 8 * (i >> 2) + 4 * n + (i & 3); }
__device__ __forceinline__ unsigned cvt_pk_bf16(float lo, float hi) { unsigned r; asm volatile("v_cvt_pk_bf16_f32 %0, %1, %2" : "=v"(r) : "v"(lo), "v"(hi)); return r; }

struct GUnit { const char* a; const char* b; int orow, ocol, aux; };

typedef int i32x8 __attribute__((ext_vector_type(8)));
typedef int i32x4 __attribute__((ext_vector_type(4)));
template <class Epi, class Sched, bool GATHER, int OPM = 0>
__device__ __forceinline__ void gemm_phase(LAS unsigned char* lds, const int K, const Sched& S, const Epi& E) {
    const int tid = threadIdx.x, wid = __builtin_amdgcn_readfirstlane(tid >> 6), lane = tid & 63, wr = wid >> 2, wc = wid & 3, fr = lane & 15, fq = lane >> 4;
    constexpr bool FP8 = (OPM == 1), I8 = (OPM == 2);
    const int RB = (OPM != 0) ? K : 2 * K;
    const int nt = RB / (BK * 2);
    unsigned voffB[2], voA[2][2]; int Rr[2], Cc[2];
#pragma unroll
    for (int i = 0; i < 2; ++i) { int R, C; stage_rc(tid * 16 + i * 8192, R, C); const int Rb = (R & ~31) + perm32(R & 31); Rr[i] = R; Cc[i] = C;
        voffB[i] = (unsigned)(Rb * RB + C * 2);
        voA[0][i] = (unsigned)(R * RB + C * 2); voA[1][i] = (unsigned)((R + HALF) * RB + C * 2); }
    const size_t kstep = (size_t)(BK * 2);
    const size_t hstep = (size_t)HALF * RB;
    const unsigned ldsw = (unsigned)wid * 1024u;
    const unsigned ldsbase = (unsigned)(size_t)lds;
    const int aoff = lds_byte(wr * 64 + fr, fq * 8), boff = lds_byte(wc * 32 + fr, fq * 8);
#define PG8_SA(b, h) (((b) * 2 + (h)) * HTB)
#define PG8_SB(b, h) ((4 + (b) * 2 + (h)) * HTB)
#define PG8_STAGE(bufoff, gbase, voff) do { _Pragma("unroll") for (int _i = 0; _i < 2; ++_i) \
        asm volatile("s_mov_b32 m0, %2\n\ts_nop 0\n\tglobal_load_lds_dwordx4 %0, %1" :: "v"((voff)[_i]), "s"((const char*)(gbase)), "s"(ldsbase + (unsigned)(bufoff) + ldsw + (unsigned)(_i * 8192)) : "memory"); } while (0)
#define PG8_STAGE_A1(bufoff, gbase) do { if constexpr (GATHER) PG8_STAGE(bufoff, gbase, voA[1]); else PG8_STAGE(bufoff, (const char*)(gbase) + hstep, voA[0]); } while (0)
#define PG8_LDA(dst, b, h) do { if constexpr (FP8) { _Pragma("unroll") for (int m = 0; m < 4; ++m) { \
        const i32x4 _lo = *(const LAS i32x4*)(lds + PG8_SA(b, h) + aoff + m * 2048), _hi = *(const LAS i32x4*)(lds + PG8_SA(b, h) + aoff + m * 2048 + 1024); \
        dst##8[m] = __builtin_shufflevector(_lo, _hi, 0, 1, 2, 3, 4, 5, 6, 7); } } \
      else { _Pragma("unroll") for (int m = 0; m < 4; ++m) _Pragma("unroll") for (int k = 0; k < 2; ++k) dst[m][k] = *(const LAS bf16x8*)(lds + PG8_SA(b, h) + aoff + m * 2048 + k * 1024); } } while (0)
#define PG8_LDB(dst, b, h) do { if constexpr (FP8) { _Pragma("unroll") for (int n = 0; n < 2; ++n) { \
        const i32x4 _lo = *(const LAS i32x4*)(lds + PG8_SB(b, h) + boff + n * 2048), _hi = *(const LAS i32x4*)(lds + PG8_SB(b, h) + boff + n * 2048 + 1024); \
        dst##8[n] = __builtin_shufflevector(_lo, _hi, 0, 1, 2, 3, 4, 5, 6, 7); } } \
      else { _Pragma("unroll") for (int n = 0; n < 2; ++n) _Pragma("unroll") for (int k = 0; k < 2; ++k) dst[n][k] = *(const LAS bf16x8*)(lds + PG8_SB(b, h) + boff + n * 2048 + k * 1024); } } while (0)
#define PG8_MMA(ai, bj, At, Bt) do { __builtin_amdgcn_s_setprio(1); \
        if constexpr (FP8) { _Pragma("unroll") for (int m = 0; m < 4; ++m) _Pragma("unroll") for (int n = 0; n < 2; ++n) \
            acc[ai][bj][m][n] = __builtin_amdgcn_mfma_scale_f32_16x16x128_f8f6f4(Bt##8[n], At##8[m], acc[ai][bj][m][n], 0, 0, 0, 0x7f7f7f7f, 0, 0x7f7f7f7f); } \
        else if constexpr (I8) { _Pragma("unroll") for (int m = 0; m < 4; ++m) _Pragma("unroll") for (int n = 0; n < 2; ++n) _Pragma("unroll") for (int k = 0; k < 2; ++k) \
            acc[ai][bj][m][n] = __builtin_bit_cast(f32x4, __builtin_amdgcn_mfma_i32_16x16x64_i8(__builtin_bit_cast(i32x4, Bt[n][k]), __builtin_bit_cast(i32x4, At[m][k]), __builtin_bit_cast(i32x4, acc[ai][bj][m][n]), 0, 0, 0)); } \
        else { _Pragma("unroll") for (int m = 0; m < 4; ++m) _Pragma("unroll") for (int n = 0; n < 2; ++n) _Pragma("unroll") for (int k = 0; k < 2; ++k) \
            acc[ai][bj][m][n] = __builtin_amdgcn_mfma_f32_16x16x32_bf16(Bt[n][k], At[m][k], acc[ai][bj][m][n], 0, 0, 0); } \
        __builtin_amdgcn_s_setprio(0); } while (0)
#define PG8_WAIT_V(n) asm volatile("s_waitcnt vmcnt(" #n ")" ::: "memory")
#define PG8_WAIT_L(n) asm volatile("s_waitcnt lgkmcnt(" #n ")" ::: "memory")
#define PG8_BAR __builtin_amdgcn_s_barrier()
#define PG8_SCHED __builtin_amdgcn_sched_barrier(0)
    GUnit cur, nxt; int ui = 0;
    if (!S.next(0, cur)) return;
    if constexpr (GATHER) {
#pragma unroll
        for (int h = 0; h < 2; ++h)
#pragma unroll
            for (int i = 0; i < 2; ++i) voA[h][i] = S.arow_off(0, h * HALF + Rr[i]) + (unsigned)Cc[i] * 2u;
    }
    f32x4 acc[2][2][4][2];
#pragma unroll
    for (int a = 0; a < 2; ++a)
#pragma unroll
        for (int b = 0; b < 2; ++b)
#pragma unroll
            for (int m = 0; m < 4; ++m)
#pragma unroll
                for (int n = 0; n < 2; ++n) acc[a][b][m][n] = (f32x4){0.f, 0.f, 0.f, 0.f};
    bf16x8 At[4][2], B0[2][2], B1[2][2]; i32x8 At8[4], B08[2], B18[2];
    const char* cA = cur.a; const char* cB = cur.b;
    PG8_STAGE(PG8_SB(0, 0), cB, voffB); PG8_STAGE(PG8_SB(0, 1), cB + hstep, voffB); PG8_STAGE(PG8_SA(0, 0), cA, voA[0]); PG8_STAGE_A1(PG8_SA(0, 1), cA);
    if (wr == 1) PG8_BAR;
    PG8_WAIT_V(2); PG8_BAR;
    PG8_STAGE(PG8_SB(1, 0), cB + kstep, voffB); PG8_STAGE(PG8_SA(1, 0), cA + kstep, voA[0]); PG8_STAGE(PG8_SB(1, 1), cB + hstep + kstep, voffB);
    PG8_WAIT_V(6); PG8_BAR;
    for (;;) {
        const bool has_next = S.next(ui + 1, nxt);
        const char* nA = has_next ? nxt.a : cA; const char* nB = has_next ? nxt.b : cB;
#pragma unroll 1
        for (int t = 0; t < nt; t += 2) {
            const bool last = (t == nt - 2);
            const char* a1 = cA + (size_t)(t + 1) * kstep;
            const char* a2 = last ? nA : cA + (size_t)(t + 2) * kstep; const char* b2 = last ? nB : cB + (size_t)(t + 2) * kstep;
            const char* a3 = a2 + kstep; const char* b3 = b2 + kstep;
            PG8_LDB(B0, 0, 0); PG8_LDB(B1, 0, 1); PG8_SCHED; PG8_LDA(At, 0, 0); PG8_STAGE_A1(PG8_SA(1, 1), a1);
            if constexpr (GATHER) { if (last && has_next) {
#pragma unroll
                for (int h = 0; h < 2; ++h)
#pragma unroll
                    for (int i = 0; i < 2; ++i) { int R2, C2; stage_rc(tid * 16 + i * 8192, R2, C2); voA[h][i] = S.arow_off(ui + 1, h * HALF + R2) + (unsigned)C2 * 2u; } } }
            PG8_WAIT_V(8); PG8_WAIT_L(0); PG8_BAR; PG8_MMA(0, 0, At, B0); PG8_MMA(0, 1, At, B1); PG8_BAR; PG8_SCHED;
            PG8_LDA(At, 0, 1); PG8_STAGE(PG8_SB(0, 0), b2, voffB); PG8_STAGE(PG8_SB(0, 1), b2 + hstep, voffB); PG8_STAGE(PG8_SA(0, 0), a2, voA[0]);
            PG8_WAIT_V(8); PG8_WAIT_L(0); PG8_BAR; PG8_MMA(1, 0, At, B0); PG8_MMA(1, 1, At, B1); PG8_BAR; PG8_SCHED;
            PG8_LDB(B0, 1, 0); PG8_LDB(B1, 1, 1); PG8_SCHED; PG8_LDA(At, 1, 0); PG8_STAGE_A1(PG8_SA(0, 1), a2);
            PG8_WAIT_V(8); PG8_WAIT_L(0); PG8_BAR; PG8_MMA(0, 0, At, B0); PG8_MMA(0, 1, At, B1); PG8_BAR; PG8_SCHED;
            PG8_LDA(At, 1, 1); PG8_STAGE(PG8_SB(1, 0), b3, voffB); PG8_STAGE(PG8_SB(1, 1), b3 + hstep, voffB); PG8_STAGE(PG8_SA(1, 0), a3, voA[0]);
            PG8_WAIT_V(8); PG8_WAIT_L(0); PG8_BAR; PG8_MMA(1, 0, At, B0); PG8_MMA(1, 1, At, B1); PG8_BAR; PG8_SCHED;
        }
        if (wr == 0) PG8_BAR;
        { int tz = threadIdx.x; asm volatile("" : "+v"(tz));
          if constexpr (I8) {
#pragma unroll
              for (int a_ = 0; a_ < 2; ++a_)
#pragma unroll
                  for (int b_ = 0; b_ < 2; ++b_)
#pragma unroll
                      for (int m = 0; m < 4; ++m)
#pragma unroll
                          for (int n = 0; n < 2; ++n) acc[a_][b_][m][n] = __builtin_convertvector(__builtin_bit_cast(i32x4, acc[a_][b_][m][n]), f32x4); }
          const int wz = tz >> 6, lz = tz & 63; E(acc, cur, wz >> 2, wz & 3, lz & 15, lz >> 4); }
        if (!has_next) break;
#pragma unroll
        for (int a = 0; a < 2; ++a)
#pragma unroll
            for (int b = 0; b < 2; ++b)
#pragma unroll
                for (int m = 0; m < 4; ++m)
#pragma unroll
                    for (int n = 0; n < 2; ++n) acc[a][b][m][n] = (f32x4){0.f, 0.f, 0.f, 0.f};
        cur = nxt; cA = nA; cB = nB; ++ui;
        if (wr == 1) PG8_BAR;
    }
    PG8_WAIT_V(0);
    PG8_BAR;
#undef PG8_SA
#undef PG8_SB
#undef PG8_STAGE
#undef PG8_STAGE_A1
#undef PG8_LDA
#undef PG8_LDB
#undef PG8_MMA
#undef PG8_WAIT_V
#undef PG8_WAIT_L
#undef PG8_BAR
#undef PG8_SCHED
}

__device__ __forceinline__ int xcd_remap(int L, int nwg) { const int q = nwg / NXCD, r = nwg % NXCD, xcd = L % NXCD, off = L / NXCD; return (xcd < r ? xcd * (q + 1) : r * (q + 1) + (xcd - r) * q) + off; }

struct DenseSched {
    const char* A; const char* Bt; int nM, nN, nwg, G, c; size_t tstep; int sw_lo, sw_hi;
    __device__ __forceinline__ void init(const void* A_, const void* Bt_, int M, int N, int K, int G_, int c_, int ebytes = 2) { A = (const char*)A_; Bt = (const char*)Bt_; nM = M / BM; nN = N / BM; nwg = nM * nN; G = G_; c = c_; tstep = (size_t)BM * K * ebytes; sw_lo = 0; sw_hi = 0; }
    __device__ __forceinline__ bool next(int i, GUnit& u) const {
        const long L = (long)i * G + c; if (L >= nwg) return false;
        const int wgid = xcd_remap((int)L, nwg);
        const int nig = WGM * nN, gid = wgid / nig, fm = gid * WGM, gsz = (nM - fm) < WGM ? (nM - fm) : WGM;
        const int pm = fm + ((wgid % nig) % gsz), pn = (wgid % nig) / gsz;
        if (pn >= sw_lo && pn < sw_hi) { u.a = Bt + (size_t)pn * tstep; u.b = A + (size_t)pm * tstep; u.orow = pm; u.ocol = pn - sw_lo; u.aux = 1; }
        else { u.a = A + (size_t)pm * tstep; u.b = Bt + (size_t)pn * tstep; u.orow = pm * BM; u.ocol = pn * BM; u.aux = 0; }
        return true;
    }
    __device__ __forceinline__ unsigned arow_off(int, int) const { return 0u; }
};

constexpr int MAXU = 12;
struct MoeTab { int n; int e[MAXU], mb[MAXU], nt[MAXU]; int sb[NE + 1]; };
struct MoeSched {
    LAS const MoeTab* T; LAS const unsigned* ridx;
    const char* A; const char* W; size_t wstride_e, tstepB; int K; int arow_bytes;
    __device__ __forceinline__ bool next(int i, GUnit& u) const {
        const int n = __builtin_amdgcn_readfirstlane(T->n); if (i >= n) return false;
        const int e = __builtin_amdgcn_readfirstlane(T->e[i]), mb = __builtin_amdgcn_readfirstlane(T->mb[i]), nt = __builtin_amdgcn_readfirstlane(T->nt[i]);
        const int base = __builtin_amdgcn_readfirstlane(T->sb[e]);
        u.orow = base + mb * BM; u.ocol = nt; u.aux = e;
        u.a = A + (size_t)u.orow * arow_bytes;
        u.b = W + (size_t)e * wstride_e + (size_t)nt * tstepB; return true;
    }
    __device__ __forceinline__ unsigned arow_off(int i, int r) const { return ridx[i * 256 + r]; }
};
template <bool GATHER>
__device__ __forceinline__ void moe_tables(const Args& A, const Ctx& C, int l, int ntile_n, LAS MoeTab* T, LAS unsigned* ridx, int arow_bytes) {
    const unsigned* cnt = (const unsigned*)(A.ws + WS_CTL) + CW_CNT + l * 32 * CNT_STRIDE;
    LAS int* ust = (LAS int*)(T + 1);
    LAS int* cntv = ust + 33;
    if (C.tid < 64) { int nb; const int ex = expert_block_prefix(cnt, C.tid, nb); if (C.tid <= NE) { T->sb[C.tid] = ex * 256; ust[C.tid] = ex * ntile_n; } if (C.tid < NE) cntv[C.tid] = (int)cnt[C.tid * CNT_STRIDE]; }
    __syncthreads();
    if (C.tid < MAXU) { const int nwg = ust[NE]; const long L = (long)C.tid * C.G + C.bid;
        if (L < nwg) { const int w = xcd_remap((int)L, nwg); int e = 0; while (w >= ust[e + 1]) ++e;
            const int lu = w - ust[e]; T->e[C.tid] = e; T->mb[C.tid] = lu / ntile_n; T->nt[C.tid] = lu % ntile_n; } }
    if (C.tid == 0) { const int nwg = ust[NE]; int n = 0; while (n < MAXU && (long)n * C.G + C.bid < nwg) ++n; T->n = n; }
    __syncthreads();
    if constexpr (GATHER) {
        const int* ST = (const int*)(A.ws + WS_SLOTTOK); const int n = T->n;
        for (int i = C.tid; i < n * 256; i += NT) { const int ui = i >> 8, r = i & 255, e = T->e[ui], m0 = T->mb[ui] * 256, ce = cntv[e];
            const int rr = (m0 + r < ce) ? m0 + r : ce - 1;
            ridx[i] = (unsigned)ST[(size_t)e * CAP + rr] * (unsigned)arow_bytes; }
        __syncthreads();
    }
}

struct EpiStore { bf16* O; int ldc; float scale_lo; int sig_from; bf16* VT; float sall = 1.0f; const float* rs = nullptr;
    __device__ __forceinline__ void operator()(const f32x4 (&acc)[2][2][4][2], const GUnit& u, int wr, int wc, int fr, int fq) const {
        const bool tr = u.aux != 0;
        const float sc = ((!tr && u.ocol < NQ) ? scale_lo : 1.0f) * sall; const bool sg = !tr && u.ocol >= sig_from;
        bf16* Ob = tr ? VT + (size_t)(u.orow * NH + u.ocol) * 65536 : O + (size_t)u.orow * ldc + u.ocol; const int ld = tr ? 256 : ldc;
        f32x4 cs[2][2];
#pragma unroll
        for (int bj = 0; bj < 2; ++bj) { const f32x4 one = (f32x4){1.f, 1.f, 1.f, 1.f};
            cs[bj][0] = (rs && tr) ? *(const f32x4*)(rs + u.orow * BM + bj * HALF + wc * 32 + 8 * fq) : one; cs[bj][1] = (rs && tr) ? *(const f32x4*)(rs + u.orow * BM + bj * HALF + wc * 32 + 8 * fq + 4) : one; }
#pragma unroll
        for (int ai = 0; ai < 2; ++ai)
#pragma unroll
            for (int m = 0; m < 4; ++m) { const int rl = ai * HALF + wr * 64 + m * 16 + fr; bf16* rowp = tr ? Ob + wc * 8192 + rl * 32 + 8 * fq : Ob + (size_t)rl * ld + wc * 32 + 8 * fq;

                const float scr = (rs && !tr) ? sc * rs[u.orow + rl] : sc;
#pragma unroll
                for (int bj = 0; bj < 2; ++bj) { f32x4 v0 = acc[ai][bj][m][0] * scr * cs[bj][0], v1 = acc[ai][bj][m][1] * scr * cs[bj][1];
                    if (sg) {
#pragma unroll
                        for (int q = 0; q < 4; ++q) { v0[q] = __builtin_amdgcn_rcpf(1.0f + __expf(-v0[q])); v1[q] = __builtin_amdgcn_rcpf(1.0f + __expf(-v1[q])); } }
                    u32x4 w; w.x = cvt_pk_bf16(v0[0], v0[1]); w.y = cvt_pk_bf16(v0[2], v0[3]); w.z = cvt_pk_bf16(v1[0], v1[1]); w.w = cvt_pk_bf16(v1[2], v1[3]);
                    *(u32x4*)(rowp + (tr ? bj * 4 * 8192 : bj * HALF)) = w; } }
    }
};
__device__ __forceinline__ u32x2 cvt8_fp8(f32x4 a, f32x4 b) { int lo = 0, hi = 0;
    lo = __builtin_amdgcn_cvt_pk_fp8_f32(a[0], a[1], lo, false); lo = __builtin_amdgcn_cvt_pk_fp8_f32(a[2], a[3], lo, true);
    hi = __builtin_amdgcn_cvt_pk_fp8_f32(b[0], b[1], hi, false); hi = __builtin_amdgcn_cvt_pk_fp8_f32(b[2], b[3], hi, true); return (u32x2){(unsigned)lo, (unsigned)hi}; }
struct EpiSwigluF8 { unsigned char* O; int ldc; float s;
    __device__ __forceinline__ void operator()(const f32x4 (&acc)[2][2][4][2], const GUnit& u, int wr, int wc, int fr, int fq) const {
        const int ocol = u.ocol * HALF;
#pragma unroll
        for (int ai = 0; ai < 2; ++ai)
#pragma unroll
            for (int m = 0; m < 4; ++m) { unsigned char* rowp = O + (size_t)(u.orow + ai * HALF + wr * 64 + m * 16 + fr) * ldc + ocol + wc * 32 + 8 * fq;
                f32x4 v0, v1;
#pragma unroll
                for (int q = 0; q < 4; ++q) { const float x0 = acc[ai][0][m][0][q] * s, x1 = acc[ai][0][m][1][q] * s;
                    v0[q] = x0 * __builtin_amdgcn_rcpf(1.0f + __expf(-x0)) * (acc[ai][1][m][0][q] * s); v1[q] = x1 * __builtin_amdgcn_rcpf(1.0f + __expf(-x1)) * (acc[ai][1][m][1][q] * s); }
                *(u32x2*)rowp = cvt8_fp8(v0, v1); }
    }
};
template <int MODE> struct EpiPair { bf16* O; int ldc; int plain_below; float sall = 1.0f; const float* rs = nullptr;
    __device__ __forceinline__ void operator()(const f32x4 (&acc)[2][2][4][2], const GUnit& u, int wr, int wc, int fr, int fq) const {
        if (MODE == 0 && u.ocol < plain_below) {
#pragma unroll
            for (int ai = 0; ai < 2; ++ai)
#pragma unroll
                for (int m = 0; m < 4; ++m) { const int rg = u.orow + ai * HALF + wr * 64 + m * 16 + fr; bf16* rowp = O + (size_t)rg * ldc + u.ocol + wc * 32 + 8 * fq;
                    const float scr = rs ? sall * rs[rg] : sall;
#pragma unroll
                    for (int bj = 0; bj < 2; ++bj) { const f32x4 v0 = acc[ai][bj][m][0] * scr, v1 = acc[ai][bj][m][1] * scr;
                        u32x4 w; w.x = cvt_pk_bf16(v0[0], v0[1]); w.y = cvt_pk_bf16(v0[2], v0[3]); w.z = cvt_pk_bf16(v1[0], v1[1]); w.w = cvt_pk_bf16(v1[2], v1[3]);
                        *(u32x4*)(rowp + bj * HALF) = w; } }
            return;
        }
        const int ocol = (MODE == 0) ? plain_below + (u.ocol - plain_below) / 2 : u.ocol * HALF;
#pragma unroll
        for (int ai = 0; ai < 2; ++ai)
#pragma unroll
            for (int m = 0; m < 4; ++m) { const int rg = u.orow + ai * HALF + wr * 64 + m * 16 + fr; bf16* rowp = O + (size_t)rg * ldc + ocol + wc * 32 + 8 * fq;
                const float scr = rs ? sall * rs[rg] : sall; const float sc2 = scr * scr;
                f32x4 v0, v1;
#pragma unroll
                for (int q = 0; q < 4; ++q) {
                    const float x0 = acc[ai][0][m][0][q], x1 = acc[ai][0][m][1][q];
                    const float g0 = (MODE == 1) ? x0 * __builtin_amdgcn_rcpf(1.0f + __expf(-x0)) : x0, g1 = (MODE == 1) ? x1 * __builtin_amdgcn_rcpf(1.0f + __expf(-x1)) : x1;
                    v0[q] = g0 * acc[ai][1][m][0][q] * sc2; v1[q] = g1 * acc[ai][1][m][1][q] * sc2; }
                u32x4 w; w.x = cvt_pk_bf16(v0[0], v0[1]); w.y = cvt_pk_bf16(v0[2], v0[3]); w.z = cvt_pk_bf16(v1[0], v1[1]); w.w = cvt_pk_bf16(v1[2], v1[3]);
                *(u32x4*)rowp = w; }
    }
};
struct EpiResid { bf16* LAT; const float* g1; float sall; const float* rs;
    __device__ __forceinline__ void operator()(const f32x4 (&acc)[2][2][4][2], const GUnit& u, int wr, int wc, int fr, int fq) const {
        bf16* Ob = LAT + (size_t)u.orow * D + u.ocol + wc * 32 + 8 * fq;
        u32x4 old[2][4][2];
#pragma unroll
        for (int ai = 0; ai < 2; ++ai)
#pragma unroll
            for (int m = 0; m < 4; ++m)
#pragma unroll
                for (int bj = 0; bj < 2; ++bj) old[ai][m][bj] = *(const u32x4*)(Ob + (size_t)(ai * HALF + wr * 64 + m * 16 + fr) * D + bj * HALF);
        const float* gv = g1 + (size_t)mod_vec_of_row(u.orow) * 6 * D + u.ocol + wc * 32 + 8 * fq;
        f32x4 g[2][2];
#pragma unroll
        for (int bj = 0; bj < 2; ++bj) { g[bj][0] = *(const f32x4*)(gv + bj * HALF); g[bj][1] = *(const f32x4*)(gv + bj * HALF + 4); }
#pragma unroll
        for (int ai = 0; ai < 2; ++ai)
#pragma unroll
            for (int m = 0; m < 4; ++m) { const int rl = ai * HALF + wr * 64 + m * 16 + fr; bf16* rowp = Ob + (size_t)rl * D;
                const float scr = rs ? sall * rs[u.orow + rl] : sall;
#pragma unroll
                for (int bj = 0; bj < 2; ++bj) { const u32x4 o = old[ai][m][bj];
                    const f32x4 v0 = bf4((u32x2){o.x, o.y}) + g[bj][0] * (acc[ai][bj][m][0] * scr), v1 = bf4((u32x2){o.z, o.w}) + g[bj][1] * (acc[ai][bj][m][1] * scr);
                    u32x4 w; w.x = cvt_pk_bf16(v0[0], v0[1]); w.y = cvt_pk_bf16(v0[2], v0[3]); w.z = cvt_pk_bf16(v1[0], v1[1]); w.w = cvt_pk_bf16(v1[2], v1[3]);
                    *(u32x4*)(rowp + bj * HALF) = w; } }
    }
};
struct EpiStoreTile { unsigned char* O; int ldc; float s;
    __device__ __forceinline__ void operator()(const f32x4 (&acc)[2][2][4][2], const GUnit& u, int wr, int wc, int fr, int fq) const {
#pragma unroll
        for (int ai = 0; ai < 2; ++ai)
#pragma unroll
            for (int m = 0; m < 4; ++m) { unsigned char* rowp = O + (size_t)(u.orow + ai * HALF + wr * 64 + m * 16 + fr) * ldc + u.ocol * BM + wc * 32 + 8 * fq;
#pragma unroll
                for (int bj = 0; bj < 2; ++bj) *(u32x2*)(rowp + bj * HALF) = cvt8_fp8(acc[ai][bj][m][0] * s, acc[ai][bj][m][1] * s); }
    }
};

__device__ __forceinline__ void transpose_item(const float* W, int ldw, int K, bf16* WT, int drow0, int k0, int n0, LAS float* scr, int lane) {
#pragma unroll
    for (int i = 0; i < 32; ++i) { const int kk = 2 * i + (lane >> 5); scr[kk * 33 + (lane & 31)] = W[(size_t)(k0 + kk) * ldw + n0 + (lane & 31)]; }
    asm volatile("s_waitcnt lgkmcnt(0)" ::: "memory");
    const int c = lane & 7;
#pragma unroll
    for (int j = 0; j < 4; ++j) { const int n = (lane >> 3) + 8 * j; const LAS float* s = scr + (8 * c) * 33 + n;
        u32x4 o; o.x = pk2(s[0 * 33], s[1 * 33]); o.y = pk2(s[2 * 33], s[3 * 33]); o.z = pk2(s[4 * 33], s[5 * 33]); o.w = pk2(s[6 * 33], s[7 * 33]);
        *(u32x4*)(WT + (size_t)(drow0 + n) * K + k0 + 8 * c) = o; }
    asm volatile("s_waitcnt lgkmcnt(0)" ::: "memory");
}
__device__ __forceinline__ void transpose_item_fp8(const float* W, int ldw, int K, unsigned char* WT8, int drow0, int k0, int n0, LAS float* scr, int lane, float sc) {
#pragma unroll
    for (int i = 0; i < 32; ++i) { const int kk = 2 * i + (lane >> 5); scr[kk * 33 + (lane & 31)] = __builtin_nontemporal_load(W + (size_t)(k0 + kk) * ldw + n0 + (lane & 31)); }
    asm volatile("s_waitcnt lgkmcnt(0)" ::: "memory");
    const int n = lane >> 1, half = lane & 1; const LAS float* sp = scr + (32 * half) * 33 + n;
    unsigned char* dst = WT8 + (size_t)(drow0 + n) * K + k0 + 32 * half;
#pragma unroll
    for (int c = 0; c < 2; ++c) { u32x4 o;
#pragma unroll
        for (int q = 0; q < 4; ++q) { int p = 0; const LAS float* s4 = sp + (16 * c + 4 * q) * 33;
            p = __builtin_amdgcn_cvt_pk_fp8_f32(s4[0] * sc, s4[33] * sc, p, false); p = __builtin_amdgcn_cvt_pk_fp8_f32(s4[66] * sc, s4[99] * sc, p, true); o[q] = (unsigned)p; }
        *(u32x4*)(dst + 16 * c) = o; }
    asm volatile("s_waitcnt lgkmcnt(0)" ::: "memory");
}
__device__ __forceinline__ void transpose_item_i8(const float* W, int ldw, int K, unsigned char* WT8, int drow0, int k0, int n0, LAS float* scr, int lane, float inv) {
#pragma unroll
    for (int i = 0; i < 32; ++i) { const int kk = 2 * i + (lane >> 5); scr[kk * 33 + (lane & 31)] = W[(size_t)(k0 + kk) * ldw + n0 + (lane & 31)]; }
    asm volatile("s_waitcnt lgkmcnt(0)" ::: "memory");
    const int n = lane >> 1, half = lane & 1; const LAS float* sp = scr + (32 * half) * 33 + n;
    unsigned char* dst = WT8 + (size_t)(drow0 + n) * K + k0 + 32 * half;
#pragma unroll
    for (int c = 0; c < 2; ++c) { u32x4 o;
#pragma unroll
        for (int q = 0; q < 4; ++q) { const LAS float* s4 = sp + (16 * c + 4 * q) * 33; o[q] = pack_i8((f32x4){s4[0] * inv, s4[33] * inv, s4[66] * inv, s4[99] * inv}); }
        *(u32x4*)(dst + 16 * c) = o; }
    asm volatile("s_waitcnt lgkmcnt(0)" ::: "memory");
}
__device__ __forceinline__ int pair_row(int n, int which) { return (n >> 7) * 256 + (n & 127) + which * 128; }
constexpr float HMR = 6.0f;
__device__ __forceinline__ void phase_cvt_mixer(const Args& A, const Ctx& C) {
    const int gw = C.bid * NW + C.wave, NGW = C.G * NW;
    unsigned* wmax = (unsigned*)(A.ws + WS_CTL) + CW_WMAX;
    for (int m8 = 0; m8 < 8; ++m8) {
        const float* W = m8 < 2 ? A.in[8] + (size_t)m8 * D * PROJ : m8 < 4 ? A.in[12] + (size_t)(m8 - 2) * D * PW : m8 < 6 ? A.in[11] + (size_t)(m8 - 4) * D * D : A.in[14] + (size_t)(m8 - 6) * D * D;
        const size_t n4 = (size_t)D * (m8 < 2 ? PROJ : m8 < 4 ? PW : D) / 4;
        float mx = 0.f;
        for (size_t i0 = (size_t)gw * 64 + C.lane; i0 < n4; i0 += (size_t)NGW * 64 * 8) {
            f32x4 v[8];
#pragma unroll
            for (int j = 0; j < 8; ++j) { const size_t i = i0 + (size_t)j * NGW * 64; v[j] = *(const f32x4*)(W + 4 * (i < n4 ? i : i0)); }
#pragma unroll
            for (int j = 0; j < 8; ++j) mx = fmaxf(mx, fmaxf(fmaxf(fabsf(v[j].x), fabsf(v[j].y)), fmaxf(fabsf(v[j].z), fabsf(v[j].w)))); }
        mx = wave_max_nn(mx);
        if (C.lane == 0 && mx > 0.f) atomicMax(wmax + m8 * CNT_STRIDE, __float_as_uint(mx));
    }
}
__device__ __forceinline__ void cvt_win_i8(const Args& A, const Ctx& C) {
    LAS float* scr = (LAS float*)(C.lds + 16384 + C.wave * 16384);
    const int gw = C.bid * NW + C.wave, NGW = C.G * NW;
    constexpr int I_IN = (D / 64) * (PW / 32);
    const unsigned* wmax = (const unsigned*)(A.ws + WS_CTL) + CW_WMAX;
    constexpr int I_OUT = (D / 64) * (D / 32);
    for (int it = gw; it < 4 * I_OUT; it += NGW) {
        const int m4 = it / I_OUT, kind = m4 >> 1, j = m4 & 1, r = it % I_OUT; const int kb = r / (D / 32), nb = r % (D / 32), n0 = nb * 32;
        const float inv = 127.0f / fmaxf(__uint_as_float(wmax[(4 + m4) * CNT_STRIDE]), 1.0e-30f);
        transpose_item_i8((kind == 0 ? A.in[11] : A.in[14]) + (size_t)j * D * D, D, D, A.ws + (kind == 0 ? WS_WAOUT : WS_WBOUT) + (size_t)j * D * D, n0, kb * 64, n0, scr, C.lane, inv); }
    for (int it = gw; it < 4 * I_IN; it += NGW) {
        const int m4 = it / I_IN, kind = m4 >> 1, j = m4 & 1, r = it % I_IN; const int kb = r / (PW / 32), nb = r % (PW / 32), n0 = nb * 32;
        const float inv = 127.0f / fmaxf(__uint_as_float(wmax[m4 * CNT_STRIDE]), 1.0e-30f);
        unsigned char* WT = A.ws + (kind == 0 ? WS_WAIN : WS_WBIN) + (size_t)j * PW * D;
        if (kind == 0) transpose_item_i8(A.in[8] + (size_t)j * D * PROJ, PROJ, D, WT, n0, kb * 64, n0, scr, C.lane, inv);
        else { const int drow = n0 < D ? n0 : (n0 < 2 * D ? D + pair_row(n0 - D, 0) : D + pair_row(n0 - 2 * D, 1));
            transpose_item_i8(A.in[12] + (size_t)j * D * PW, PW, D, WT, drow, kb * 64, n0, scr, C.lane, inv); }
    }
}
__device__ __forceinline__ void cvt_moe_items(const Args& A, const Ctx& C, int l, int it0, int end, int stride) {
    LAS float* scr = (LAS float*)(C.lds + 16384 + C.wave * 16384);
    unsigned char* WGU = A.ws + WS_WGU; unsigned char* WDN = A.ws + WS_WDN;
    for (int it = it0; it < end; it += stride) {
        const int e = it / CVT_PER; int r = it % CVT_PER;
        if (r < 2 * CVT_IG) { const int which = r / CVT_IG; r %= CVT_IG; const int kb = r / (DE / 32), nb = r % (DE / 32), n0 = nb * 32;
            transpose_item_fp8((which == 0 ? A.in[19] : A.in[20]) + ((size_t)l * NE + e) * D * DE, DE, D, WGU + (size_t)e * 2 * DE * D, pair_row(n0, which), kb * 64, n0, scr, C.lane, WSCALE); }
        else { r -= 2 * CVT_IG; const int kb = r / (D / 32), nb = r % (D / 32), n0 = nb * 32;
            transpose_item_fp8(A.in[21] + ((size_t)l * NE + e) * DE * D, D, DE, WDN + (size_t)e * D * DE, n0, kb * 64, n0, scr, C.lane, WSCALE); }
    }
}
__device__ __forceinline__ int cvt_idle(int nunits, int G) { const int rem = nunits % G; return rem ? G - rem : 0; }
__device__ __forceinline__ int cvt_t1(int l, int G) { const int n = cvt_idle((((l <= 2) ? NR : NL) / BM) * (PW / BM), G) * CVT_Q; return n < CVT_ITEMS ? n : CVT_ITEMS; }
__device__ __forceinline__ int cvt_t2(int l, int G) { const int n = cvt_t1(l, G) + cvt_idle((((l <= 1) ? NR : NL) / BM) * (D / BM), G) * CVT_Q; return n < CVT_ITEMS ? n : CVT_ITEMS; }
__device__ __forceinline__ void cvt_moe_tail(const Args& A, const Ctx& C, int l, int nunits, int base, int end) {
    const int rem = nunits % C.G;
    if (rem == 0 || C.bid < rem) return;
    const int first = base + (C.bid - rem) * CVT_Q; const int last = min(first + CVT_Q, end);
    cvt_moe_items(A, C, l, first + C.wave, last, NW);
}

__device__ __forceinline__ void phase_g1(const Args& A, const Ctx& C, int l) {
    const bool mls = (l & 1) == 0; const int j = l >> 1; const int nrows = (l <= 2) ? NR : NL;
    DenseSched S; S.init(A.ws + WS_H8, A.ws + (mls ? WS_WAIN : WS_WBIN) + (size_t)j * PW * D, nrows, PW, D, C.G, C.bid, 1);
    const float wsc = __uint_as_float(((const unsigned*)(A.ws + WS_CTL))[CW_WMAX + ((mls ? 0 : 2) + j) * CNT_STRIDE]) * (1.0f / 127.0f);
    const float* rs = (const float*)(A.ws + WS_RSC);
    if (mls) { S.sw_lo = 4; S.sw_hi = 8; EpiStore E{(bf16*)(A.ws + WS_PB), PW, 0.08838834764831845f, 2 * NQ + NV, (bf16*)(A.ws + WS_VT), wsc, rs}; gemm_phase<EpiStore, DenseSched, false, 2>(C.lds, D, S, E); }
    else { EpiPair<0> E{(bf16*)(A.ws + WS_PB), PW, D, wsc, rs}; gemm_phase<EpiPair<0>, DenseSched, false, 2>(C.lds, D, S, E); }
    cvt_moe_tail(A, C, l, S.nwg, 0, cvt_t1(l, C.G));
}
__device__ __forceinline__ void phase_g2(const Args& A, const Ctx& C, int l) {
    const bool mls = (l & 1) == 0; const int j = l >> 1; const int nrows = (l <= 1) ? NR : NL;
    DenseSched S; S.init(A.ws + WS_HM, A.ws + (mls ? WS_WAOUT : WS_WBOUT) + (size_t)j * D * D, nrows, D, D, C.G, C.bid, 1);
    const float wsc = __uint_as_float(((const unsigned*)(A.ws + WS_CTL))[CW_WMAX + (4 + (mls ? 0 : 2) + j) * CNT_STRIDE]) * (1.0f / 127.0f);
    EpiResid E{(bf16*)(A.ws + WS_LAT), (const float*)(A.ws + WS_MOD) + (size_t)(l * 3) * 6 * D + 2 * D, mls ? wsc * (HMR / 127.0f) : wsc, mls ? nullptr : (const float*)(A.ws + WS_RSC)}; gemm_phase<EpiResid, DenseSched, false, 2>(C.lds, D, S, E);
    cvt_moe_tail(A, C, l, S.nwg, cvt_t1(l, C.G), cvt_t2(l, C.G));
}
__device__ __forceinline__ void phase_m1(const Args& A, const Ctx& C, int l) {
    LAS MoeTab* T = (LAS MoeTab*)(C.lds + LDS_TAB); LAS unsigned* ridx = (LAS unsigned*)(C.lds + LDS_TAB + 1024);
    moe_tables<true>(A, C, l, 4, T, ridx, D);
    MoeSched S; S.T = T; S.ridx = ridx; S.A = (const char*)(A.ws + WS_H8); S.W = (const char*)(A.ws + WS_WGU); S.wstride_e = (size_t)2 * DE * D; S.tstepB = (size_t)BM * D; S.K = D; S.arow_bytes = 0;
    EpiSwigluF8 E{A.ws + WS_DC, DE, 1.0f / WSCALE}; gemm_phase<EpiSwigluF8, MoeSched, true, 1>(C.lds, D, S, E);
}
__device__ __forceinline__ void phase_m2(const Args& A, const Ctx& C, int l) {
    LAS MoeTab* T = (LAS MoeTab*)(C.lds + LDS_TAB); LAS unsigned* ridx = (LAS unsigned*)(C.lds + LDS_TAB + 1024);
    moe_tables<false>(A, C, l, 4, T, ridx, DE);
    MoeSched S; S.T = T; S.ridx = ridx; S.A = (const char*)(A.ws + WS_DC); S.W = (const char*)(A.ws + WS_WDN); S.wstride_e = (size_t)D * DE; S.tstepB = (size_t)BM * DE; S.K = DE; S.arow_bytes = DE;
    EpiStoreTile E{A.ws + WS_PB, D, YSCALE / WSCALE}; gemm_phase<EpiStoreTile, MoeSched, false, 1>(C.lds, DE, S, E);
}

typedef float f32x16 __attribute__((ext_vector_type(16)));
#define MFMA32(a, b, c) __builtin_amdgcn_mfma_f32_32x32x16_bf16((a), (b), (c), 0, 0, 0)
__device__ __forceinline__ bf16x8 pack8(float a0, float a1, float a2, float a3, float a4, float a5, float a6, float a7) {
    u32x4 p; p.x = cvt2(a0, a1); p.y = cvt2(a2, a3); p.z = cvt2(a4, a5); p.w = cvt2(a6, a7); return __builtin_bit_cast(bf16x8, p); }
__device__ __forceinline__ float bflo(unsigned w) { return __uint_as_float(w << 16); }
__device__ __forceinline__ float bfhi(unsigned w) { return __uint_as_float(w & 0xffff0000u); }
__device__ __forceinline__ int vt_tile(int b, int h, int blk) { return (blk == 0 ? 128 + b : b * 64 + blk - 1) * NH + h; }

__device__ __forceinline__ float wave_incl_scan(float v, int lane) {
#pragma unroll
    for (int o = 1; o < 64; o <<= 1) { const float t = __shfl_up(v, o); v += (lane >= o) ? t : 0.f; }
    return v;
}
__device__ __forceinline__ void block_gates(const Args& A, int row0, int h, LAS float* bf, LAS float* bb, LAS float* lif, LAS float* lib, int tid) {
    const float* GATE = (const float*)(A.ws + WS_GATE);
    if (tid < 256) { const float* g = GATE + (size_t)(row0 + tid) * 16; lif[tid] = g[0 + h]; bf[tid] = g[4 + h]; lib[tid] = g[8 + h]; bb[tid] = g[12 + h]; }
    __syncthreads();
    const int lane = tid & 63, wv = tid >> 6;
    if (wv == 0) { f32x4 x = *(LAS f32x4*)(bf + 4 * lane); x.y += x.x; x.z += x.y; x.w += x.z; const float tot = wave_incl_scan(x.w, lane); const float ex = tot - x.w;
        x.x += ex; x.y += ex; x.z += ex; x.w += ex; *(LAS f32x4*)(bf + 4 * lane) = x; }
    if (wv == 1) { f32x4 y = *(LAS f32x4*)(bb + 4 * (63 - lane)); y.z += y.w; y.y += y.z; y.x += y.y; const float tot = wave_incl_scan(y.x, lane); const float ex = tot - y.x;
        y.x += ex; y.y += ex; y.z += ex; y.w += ex; *(LAS f32x4*)(bb + 4 * (63 - lane)) = y; }
    __syncthreads();
}
__device__ __forceinline__ void phase_s1(const Args& A, const Ctx& C, int l) {
    LAS float* bf = (LAS float*)C.lds; LAS float* bb = bf + 256; LAS float* lif = bb + 256; LAS float* lib = lif + 256; LAS float* af = lib + 256; LAS float* ab = af + 256;
    constexpr int KP = 528;
    LAS unsigned char* KTf = C.lds + 8192; LAS unsigned char* KTb = KTf + 128 * KP;
    const bf16* P = (const bf16*)(A.ws + WS_PB); const bf16* VT = (const bf16*)(A.ws + WS_VT);
    bf16* DC = (bf16*)(A.ws + WS_DC); float* DN = (float*)(A.ws + WS_DN); float* BT = (float*)(A.ws + WS_BTOT);
    const int r = C.lane & 31, hh = C.lane >> 5, w = C.wave;
    for (int it = C.bid; it < BATCH * NH * (NBLK - 1) + 2 * BATCH * NH; it += C.G) {
        const bool isctx = it >= BATCH * NH * (NBLK - 1); const int ci_ = it - BATCH * NH * (NBLK - 1);
        const int bh = isctx ? (ci_ >> 1) : it / (NBLK - 1), blk = isctx ? 0 : 1 + it % (NBLK - 1), h = bh % NH, b = bh / NH; const int u = bh * NBLK + blk; const int row0 = blk_row0(b, blk);
        const int dlo = isctx ? (ci_ & 1) : 0, dhi = isctx ? (ci_ & 1) + 1 : 2;
        block_gates(A, row0, h, bf, bb, lif, lib, C.tid);
        if (C.tid < 256) { af[C.tid] = __expf(bf[255] - bf[C.tid] + lif[C.tid]); ab[C.tid] = __expf(bb[0] - bb[C.tid] + lib[C.tid]); }
        if (C.tid == 0) { BT[u * 2 + 0] = bf[255]; BT[u * 2 + 1] = bb[0]; }
        __syncthreads();
        { const int sp = C.tid >> 2, dq = C.tid & 3, s0 = 2 * sp;
          const bf16* k0 = P + (size_t)(row0 + s0) * PW + NQ + h * DQK + 32 * dq;
          const float f0 = af[s0], f1 = af[s0 + 1], g0 = ab[s0], g1 = ab[s0 + 1];
#pragma unroll
          for (int c = 0; c < 4; ++c) { const u32x4 x0 = *(const u32x4*)(k0 + 8 * c), x1 = *(const u32x4*)(k0 + PW + 8 * c);
#pragma unroll
              for (int q = 0; q < 4; ++q) { const int d = 32 * dq + 8 * c + 2 * q;
                  const float a0 = bflo(x0[q]), a1 = bfhi(x0[q]), c0 = bflo(x1[q]), c1 = bfhi(x1[q]);
                  *(LAS unsigned*)(KTf + d * KP + s0 * 2) = cvt2(a0 * f0, c0 * f1); *(LAS unsigned*)(KTf + (d + 1) * KP + s0 * 2) = cvt2(a1 * f0, c1 * f1);
                  *(LAS unsigned*)(KTb + d * KP + s0 * 2) = cvt2(a0 * g0, c0 * g1); *(LAS unsigned*)(KTb + (d + 1) * KP + s0 * 2) = cvt2(a1 * g0, c1 * g1); } } }
        __syncthreads();
        if (C.tid < 256) { const int dir = C.tid >> 7, d = C.tid & 127; LAS const unsigned* kr = (LAS const unsigned*)((dir ? KTb : KTf) + d * KP); float s = 0.f;
#pragma unroll 8
            for (int i = 0; i < 32; ++i) { const u32x4 x = *(LAS const u32x4*)(kr + 4 * i); s += ((bflo(x.x) + bfhi(x.x)) + (bflo(x.y) + bfhi(x.y))) + ((bflo(x.z) + bfhi(x.z)) + (bflo(x.w) + bfhi(x.w))); }
            DN[(size_t)(u * 2 + dir) * DQK + d] = s; }
        const bf16* vt = VT + (size_t)vt_tile(b, h, blk) * 65536 + (size_t)(32 * w + r) * 32 + 8 * hh;
        bf16x8 av[16];
#pragma unroll
        for (int ks = 0; ks < 16; ++ks) av[ks] = *(const bf16x8*)(vt + (ks >> 1) * 8192 + 16 * (ks & 1));
#pragma unroll 1
        for (int dir = dlo; dir < dhi; ++dir) {
            LAS const unsigned char* KT = dir ? KTb : KTf;
            f32x16 acc[4];
#pragma unroll
            for (int dt = 0; dt < 4; ++dt)
#pragma unroll
                for (int i = 0; i < 16; ++i) acc[dt][i] = 0.f;
#pragma unroll
            for (int ks = 0; ks < 16; ++ks) {
#pragma unroll
                for (int dt = 0; dt < 4; ++dt) { const bf16x8 b0 = *(const LAS bf16x8*)(KT + (dt * 32 + r) * KP + (16 * ks + 8 * hh) * 2); acc[dt] = MFMA32(av[ks], b0, acc[dt]); }
                if ((ks & 3) == 3) asm volatile("" ::: "memory"); }
            bf16* dc = DC + (size_t)(u * 2 + dir) * DQK * DV + (size_t)(32 * w + 4 * hh) * 32 + r;
#pragma unroll
            for (int g = 0; g < 4; ++g) { bf16* pf = dc + g * 8 * 32; asm volatile("" : "+v"(pf));
#pragma unroll
                for (int q = 0; q < 4; ++q)
#pragma unroll
                    for (int dt = 0; dt < 4; ++dt) pf[q * 32 + dt * 8192] = (bf16)f2bf(acc[dt][4 * g + q]); }
        }
        __syncthreads();
    }
}
__device__ __forceinline__ void phase_s2(const Args& A, const Ctx& C) {
    const bf16* __restrict__ DC = (const bf16*)(A.ws + WS_DC); const float* __restrict__ DN = (const float*)(A.ws + WS_DN); const float* __restrict__ BT = (const float*)(A.ws + WS_BTOT);
    bf16* __restrict__ CST = (bf16*)(A.ws + WS_CST); float* __restrict__ NST = (float*)(A.ws + WS_NST);
    constexpr int EL4 = DQK * DV / 4;
    for (int g = C.bid * NT + C.tid; g < BATCH * NH * 2 * EL4; g += C.G * NT) {
        const int e4 = (g % EL4) * 4, ch = g / EL4, dir = ch & 1, bh = ch >> 1;
        f32x4 st = (f32x4){0.f, 0.f, 0.f, 0.f};
        constexpr int PF = 16;
        u32x2 ring[PF]; float decr[PF];
#define S2_BLK(idx_) (dir == 0 ? (idx_) : ((idx_) == 0 ? 0 : NBLK - (idx_)))
#pragma unroll
        for (int i = 0; i < PF; ++i) { const int u = bh * NBLK + S2_BLK(i); ring[i] = *(const u32x2*)(DC + (size_t)(u * 2 + dir) * DQK * DV + e4); decr[i] = BT[u * 2 + dir]; }
#pragma unroll
        for (int idx = 0; idx < NBLK; ++idx) {
            const int u = bh * NBLK + S2_BLK(idx);
            const f32x4 dc = bf4(ring[idx % PF]); const float dec = __expf(decr[idx % PF]);
            if (idx + PF < NBLK) { const int u2 = bh * NBLK + S2_BLK(idx + PF); ring[idx % PF] = *(const u32x2*)(DC + (size_t)(u2 * 2 + dir) * DQK * DV + e4); decr[idx % PF] = BT[u2 * 2 + dir]; }
            u32x2 o; o.x = cvt2(st.x, st.y); o.y = cvt2(st.z, st.w);
            *(u32x2*)(CST + (size_t)(u * 2 + dir) * DQK * DV + e4) = o;
            st = st * dec + dc;
        }
#undef S2_BLK
    }
    if (C.wave == 0 && C.bid * 64 < BATCH * NH * 2 * DQK) {
        const int g = C.bid * 64 + C.lane; const int d = g % DQK, ch = g / DQK, dir = ch & 1, bh = ch >> 1; float st = 0.f;
        constexpr int PF = 16; float dnr[PF], btr[PF];
#define S2_BLK(idx_) (dir == 0 ? (idx_) : ((idx_) == 0 ? 0 : NBLK - (idx_)))
#pragma unroll
        for (int i = 0; i < PF; ++i) { const int u = bh * NBLK + S2_BLK(i); dnr[i] = DN[(size_t)(u * 2 + dir) * DQK + d]; btr[i] = BT[u * 2 + dir]; }
#pragma unroll
        for (int idx = 0; idx < NBLK; ++idx) {
            const int u = bh * NBLK + S2_BLK(idx);
            const float dn = dnr[idx % PF], dec = __expf(btr[idx % PF]);
            if (idx + PF < NBLK) { const int u2 = bh * NBLK + S2_BLK(idx + PF); dnr[idx % PF] = DN[(size_t)(u2 * 2 + dir) * DQK + d]; btr[idx % PF] = BT[u2 * 2 + dir]; }
            NST[(size_t)(u * 2 + dir) * DQK + d] = st; st = dec * st + dn;
        }
#undef S2_BLK
    }
}
__device__ __forceinline__ void lds_barrier() { asm volatile("s_waitcnt lgkmcnt(0)" ::: "memory"); __builtin_amdgcn_s_barrier(); asm volatile("" ::: "memory"); }
__device__ __forceinline__ void phase_s3(const Args& A, const Ctx& C, int l) {
    const int jl = l >> 1; const bool ctx_out = (l == 0);
    LAS float* bf = (LAS float*)C.lds; LAS float* bb = bf + 256; LAS float* gf = bb + 256; LAS float* gb = gf + 256;
    LAS float* nf = gb + 256; LAS float* nb = nf + 128; LAS float* ssx = nb + 128;
    LAS float* cf = ssx + 256; LAS float* cb = cf + 256;
    constexpr int KP = 272, OP = 528, CHB = 16384, NCHB = 4;
    LAS unsigned char* Kimg = C.lds + 8192;
    LAS unsigned char* CH = Kimg + 256 * KP;
    LAS unsigned char* OUT = Kimg;
    static_assert(8192 + 256 * KP + NCHB * CHB <= LDS_TAB_END && 8192 + 256 * OP <= LDS_TAB_END, "S3 LDS map");
    const bf16* P = (const bf16*)(A.ws + WS_PB); const bf16* VT = (const bf16*)(A.ws + WS_VT); unsigned char* HM = A.ws + WS_HM;
    const bf16* CST = (const bf16*)(A.ws + WS_CST); const float* NST = (const float*)(A.ws + WS_NST);
    const float* hg = A.in[10] + (size_t)jl * NV;
    const int w = C.wave;
    bf16x8 qf[8]; u32x4 kr8[8]; f32x4 gl;
#define S3_UNIT(it_) ((it_) < BATCH * NH * (NBLK - 1) ? ((it_) / (NBLK - 1)) * NBLK + 1 + (it_) % (NBLK - 1) : ((it_) - BATCH * NH * (NBLK - 1)) * NBLK)
#define S3_LOAD_IN(u_) do { const int u2_ = (u_); const int blk_ = u2_ % NBLK, bh_ = u2_ / NBLK, h_ = bh_ % NH, b_ = bh_ / NH; const int row0_ = blk_row0(b_, blk_); \
        int tq_ = threadIdx.x; asm volatile("" : "+v"(tq_)); const int lq_ = tq_ & 63; \
        { const bf16* qr_ = P + (size_t)(row0_ + 32 * w + (lq_ & 31)) * PW + h_ * DQK + 8 * (lq_ >> 5); \
          _Pragma("unroll") for (int kk = 0; kk < 8; ++kk) qf[kk] = *(const bf16x8*)(qr_ + 16 * kk); } \
        { const bf16* kr_ = P + (size_t)(row0_ + (tq_ >> 4)) * PW + NQ + h_ * DQK + 8 * (tq_ & 15); \
          _Pragma("unroll") for (int i = 0; i < 8; ++i) kr8[i] = *(const u32x4*)(kr_ + (size_t)(32 * i) * PW); } \
        if (tq_ < 256) { const float* g_ = (const float*)(A.ws + WS_GATE) + (size_t)(row0_ + tq_) * 16 + h_; gl = (f32x4){g_[0], g_[4], g_[8], g_[12]}; } \
        else { const int t2_ = tq_ - 256; gl = (f32x4){NST[(size_t)(u2_ * 2 + (t2_ >> 7)) * DQK + (t2_ & 127)], 0.f, 0.f, 0.f}; } } while (0)
    const int nitems = BATCH * NH * (NBLK - 1) + (ctx_out ? BATCH * NH : 0);
    int it = C.bid;
    if (it < nitems) S3_LOAD_IN(S3_UNIT(it));
    while (it < nitems) {
        const int u = S3_UNIT(it);
        const int blk = u % NBLK, bh = u / NBLK, h = bh % NH, b = bh / NH; const int row0 = blk_row0(b, blk);
        const int itn = it + C.G; const int un = itn < nitems ? S3_UNIT(itn) : u;
        const bf16* vtile = VT + (size_t)vt_tile(b, h, blk) * 65536;
        const bf16* ctile = CST + (size_t)(u * 2) * DQK * DV;
#define S3_DMA(c_) do { const int cc_ = (c_); const bool isv_ = cc_ < 8; int ld_ = threadIdx.x & 63; asm volatile("" : "+v"(ld_)); \
                const unsigned dlp_ = (unsigned)(((ld_ & 3) ^ ((ld_ >> 4) & 3)) * 16), drow_ = (unsigned)(32 * w + (ld_ >> 2)); \
                const unsigned long long gp_ = (unsigned long long)(isv_ ? (const char*)vtile + 16384 * cc_ : (const char*)ctile + (cc_ >= 12 ? 2 * DQK * DV : 0) + 16384 * ((cc_ - 8) & 3)); \
                const char* gb_ = (const char*)(((unsigned long long)(unsigned)__builtin_amdgcn_readfirstlane((int)(unsigned)(gp_ >> 32)) << 32) | (unsigned)__builtin_amdgcn_readfirstlane((int)(unsigned)gp_)); \
                _Pragma("unroll") for (int jj = 0; jj < 2; ++jj) \
                    asm volatile("s_mov_b32 m0, %2\n\ts_nop 0\n\tglobal_load_lds_dwordx4 %0, %1" :: "v"(((drow_ + 16u * jj) << 6) + dlp_), "s"(gb_), "s"((unsigned)(size_t)CH + (unsigned)w * 2048u + (unsigned)((cc_ & 3) * CHB + jj * 1024)) : "memory"); } while (0)
        S3_DMA(0); S3_DMA(1); S3_DMA(2);
        { int tu = threadIdx.x; asm volatile("" : "+v"(tu));
          if (tu < 256) { gf[tu] = gl.x; bf[tu] = gl.y; gb[tu] = gl.z; bb[tu] = gl.w; } else nf[tu - 256] = gl.x;
          { const int pc = tu & 15, s0 = tu >> 4, ps0 = (s0 & ~12) | ((s0 & 4) << 1) | ((s0 & 8) >> 1);
#pragma unroll
            for (int i = 0; i < 8; ++i) *(LAS u32x4*)(Kimg + (ps0 + 32 * i) * KP + pc * 16) = kr8[i]; }
          lds_barrier();
          const int lane = tu & 63, wv = tu >> 6;
          if (wv == 0) { f32x4 x = *(LAS f32x4*)(bf + 4 * lane); x.y += x.x; x.z += x.y; x.w += x.z; const float tot = wave_incl_scan(x.w, lane); const float ex = tot - x.w;
              x.x += ex; x.y += ex; x.z += ex; x.w += ex; *(LAS f32x4*)(bf + 4 * lane) = x; }
          if (wv == 1) { f32x4 y = *(LAS f32x4*)(bb + 4 * (63 - lane)); y.z += y.w; y.y += y.z; y.x += y.y; const float tot = wave_incl_scan(y.x, lane); const float ex = tot - y.x;
              y.x += ex; y.y += ex; y.z += ex; y.w += ex; *(LAS f32x4*)(bb + 4 * (63 - lane)) = y; }
          lds_barrier();
          if (tu < 256) { const float a0 = gf[tu] - bf[tu], a1 = gb[tu] - bb[tu]; gf[tu] = a0; gb[tu] = a1; cf[tu] = __expf(bf[tu | 31] + a0); cb[tu] = __expf(bb[tu & ~31] + a1); }
          lds_barrier(); }
        {
            int lz = threadIdx.x & 63; asm volatile("" : "+v"(lz));
            const int r = lz & 31, hh = lz >> 5;
            const int jt = w;
            const float bfj = bf[32 * jt + r], bbj = bb[32 * jt + r];
            float qnf = 0.f, qnb = 0.f;
#pragma unroll
            for (int kk = 0; kk < 8; ++kk) { u32x4 qq = __builtin_bit_cast(u32x4, qf[kk]); asm volatile("" : "+v"(qq));
                const int d = 16 * kk + 8 * hh;
                const f32x4 n0 = *(const LAS f32x4*)(nf + d), n1 = *(const LAS f32x4*)(nf + d + 4), m0 = *(const LAS f32x4*)(nb + d), m1 = *(const LAS f32x4*)(nb + d + 4);
                qnf += (bflo(qq.x) * n0.x + bfhi(qq.x) * n0.y) + (bflo(qq.y) * n0.z + bfhi(qq.y) * n0.w) + (bflo(qq.z) * n1.x + bfhi(qq.z) * n1.y) + (bflo(qq.w) * n1.z + bfhi(qq.w) * n1.w);
                qnb += (bflo(qq.x) * m0.x + bfhi(qq.x) * m0.y) + (bflo(qq.y) * m0.z + bfhi(qq.y) * m0.w) + (bflo(qq.z) * m1.x + bfhi(qq.z) * m1.y) + (bflo(qq.w) * m1.z + bfhi(qq.w) * m1.w);
                if (kk & 1) asm volatile("" ::: "memory"); }
            qnf += __shfl_xor(qnf, 32); qnb += __shfl_xor(qnb, 32);
            float denf = 0.f, denb = 0.f;
#pragma unroll 1
            for (int kt = 0; kt < 8; ++kt) {
                f32x16 c;
#pragma unroll
                for (int i = 0; i < 16; ++i) c[i] = 0.f;
#pragma unroll
                for (int kk = 0; kk < 8; ++kk) { const bf16x8 a = *(const LAS bf16x8*)(Kimg + (kt * 32 + r) * KP + (16 * kk + 8 * hh) * 2); c = MFMA32(a, qf[kk], c); }
                if (kt == jt) {
#pragma unroll
                    for (int g = 0; g < 4; ++g) { const int sl0 = 16 * (g >> 1) + 8 * hh + 4 * (g & 1);
                        const f32x4 g4f = *(const LAS f32x4*)(gf + kt * 32 + sl0), g4b = *(const LAS f32x4*)(gb + kt * 32 + sl0);
#pragma unroll
                        for (int q = 0; q < 4; ++q) { const int sl = sl0 + q; const float cv = c[4 * g + q];
                            denf += cv * __expf((sl <= r) ? bfj + g4f[q] : -1.0e30f); denb += cv * __expf((sl >= r) ? bbj + g4b[q] : -1.0e30f); } }
                } else {
                    LAS const float* cx = (kt < jt ? cf : cb) + kt * 32 + 8 * hh; float sm = 0.f;
#pragma unroll
                    for (int g = 0; g < 4; ++g) { const f32x4 c4 = *(const LAS f32x4*)(cx + 16 * (g >> 1) + 4 * (g & 1)); sm += (c[4 * g] * c4.x + c[4 * g + 1] * c4.y) + (c[4 * g + 2] * c4.z + c[4 * g + 3] * c4.w); }
                    if (kt < jt) denf += sm * __expf(bfj - bf[kt * 32 + 31]); else denb += sm * __expf(bbj - bb[kt * 32]);
                }
            }
            denf += __shfl_xor(denf, 32); denb += __shfl_xor(denb, 32);
            const float ebf = __expf(bfj), ebb = __expf(bbj);
            denf += ebf * qnf; denb += ebb * qnb;
            const float rf = 1.0f / fmaxf(fabsf(denf), 1.0f), rb = 1.0f / fmaxf(fabsf(denb), 1.0f);
            const float scf = ebf * rf, scb = ebb * rb;
            unsigned wdg[8];
#pragma unroll
            for (int g = 0; g < 4; ++g) { const int sl0 = 16 * (g >> 1) + 8 * hh + 4 * (g & 1);
                const f32x4 g4f = *(const LAS f32x4*)(gf + jt * 32 + sl0), g4b = *(const LAS f32x4*)(gb + jt * 32 + sl0);
                float wv[4];
#pragma unroll
                for (int q = 0; q < 4; ++q) { const int sl = sl0 + q; wv[q] = rf * __expf((sl <= r) ? bfj + g4f[q] : -1.0e30f) + rb * __expf((sl >= r) ? bbj + g4b[q] : -1.0e30f); }
                wdg[2 * g] = cvt2(wv[0], wv[1]); wdg[2 * g + 1] = cvt2(wv[2], wv[3]); }
            f32x16 acc[8];
#pragma unroll
            for (int et = 0; et < 8; ++et)
#pragma unroll
                for (int i = 0; i < 16; ++i) acc[et][i] = 0.f;
            asm volatile("s_waitcnt vmcnt(0)" ::: "memory");
            const int swz = (r >> 2) & 3;
#pragma unroll 1
            for (int ci = 0; ci < 8; ++ci) {
                if (ci) { if (blk == 0 && ci >= 6) { if (ci == 6) asm volatile("s_waitcnt vmcnt(2)" ::: "memory"); else asm volatile("s_waitcnt vmcnt(0)" ::: "memory"); } else asm volatile("s_waitcnt vmcnt(4)" ::: "memory"); }
                lds_barrier();
                if (blk != 0 || ci + 3 < 8) S3_DMA(ci + 3);
                LAS const unsigned char* CHc = CH + (ci & 3) * CHB;
                { const int kt = ci;
                        f32x16 c;
#pragma unroll
                        for (int i = 0; i < 16; ++i) c[i] = 0.f;
#pragma unroll
                        for (int kk = 0; kk < 8; ++kk) { const bf16x8 a = *(const LAS bf16x8*)(Kimg + (kt * 32 + r) * KP + (16 * kk + 8 * hh) * 2); c = MFMA32(a, qf[kk], c); }
                        float p[16];
                        if (kt == jt) {
#pragma unroll
                            for (int i = 0; i < 8; ++i) { p[2 * i] = c[2 * i] * bflo(wdg[i]); p[2 * i + 1] = c[2 * i + 1] * bfhi(wdg[i]); }
                        } else {
                            LAS const float* cx = (kt < jt ? cf : cb) + kt * 32 + 8 * hh;
                            const float rw = (kt < jt) ? rf * __expf(bfj - bf[kt * 32 + 31]) : rb * __expf(bbj - bb[kt * 32]);
#pragma unroll
                            for (int g = 0; g < 4; ++g) { const f32x4 c4 = *(const LAS f32x4*)(cx + 16 * (g >> 1) + 4 * (g & 1));
                                p[4 * g] = c[4 * g] * (c4.x * rw); p[4 * g + 1] = c[4 * g + 1] * (c4.y * rw); p[4 * g + 2] = c[4 * g + 2] * (c4.z * rw); p[4 * g + 3] = c[4 * g + 3] * (c4.w * rw); }
                        }
                        const bf16x8 pa0 = pack8(p[0], p[1], p[2], p[3], p[4], p[5], p[6], p[7]), pa1 = pack8(p[8], p[9], p[10], p[11], p[12], p[13], p[14], p[15]);
#pragma unroll
                        for (int et = 0; et < 8; ++et) { LAS const unsigned char* vb = CHc + (et * 32 + r) * 64;
                            const bf16x8 a0 = *(const LAS bf16x8*)(vb + ((hh ^ swz) << 4)), a1 = *(const LAS bf16x8*)(vb + (((2 + hh) ^ swz) << 4));
                            acc[et] = MFMA32(a0, pa0, acc[et]); acc[et] = MFMA32(a1, pa1, acc[et]);
                            if (et & 1) asm volatile("" ::: "memory"); }
                }
            }
            if (blk != 0) {
#pragma unroll
            for (int ci = 8; ci < 16; ++ci) {
                if (ci <= 13) asm volatile("s_waitcnt vmcnt(4)" ::: "memory"); else if (ci == 14) asm volatile("s_waitcnt vmcnt(2)" ::: "memory"); else asm volatile("s_waitcnt vmcnt(0)" ::: "memory");
                lds_barrier();
                if (ci + 3 < 16) S3_DMA(ci + 3);
                LAS const unsigned char* CHc = CH + (ci & 3) * CHB;
                {
                    const int dir = (ci - 8) >> 2, dq = (ci - 8) & 3;
                    const float sc = dir ? scb : scf;
#pragma unroll
                    for (int k2 = 0; k2 < 2; ++k2) { const u32x4 qq = __builtin_bit_cast(u32x4, qf[2 * dq + k2]);
                        const bf16x8 qs = pack8(bflo(qq.x) * sc, bfhi(qq.x) * sc, bflo(qq.y) * sc, bfhi(qq.y) * sc, bflo(qq.z) * sc, bfhi(qq.z) * sc, bflo(qq.w) * sc, bfhi(qq.w) * sc);
#pragma unroll
                        for (int et = 0; et < 8; ++et) { const bf16x8 a = *(const LAS bf16x8*)(CHc + (et * 32 + r) * 64 + (((2 * k2 + hh) ^ swz) << 4)); acc[et] = MFMA32(a, qs, acc[et]);
                            if ((et & 3) == 3) asm volatile("" ::: "memory"); } }
                }
            }
            }
            u32x4 ov[16]; f32x4 g0, g1;
            { int tz = threadIdx.x & 63; asm volatile("" : "+v"(tz)); const int pc = tz & 31, lr0 = tz >> 5;
              g0 = *(const f32x4*)(hg + h * DV + 8 * pc); g1 = *(const f32x4*)(hg + h * DV + 8 * pc + 4);
#pragma unroll
              for (int i = 0; i < 16; ++i) ov[i] = *(const u32x4*)(P + (size_t)(row0 + 32 * w + lr0 + 2 * i) * PW + 2 * NQ + NV + h * DV + 8 * pc); }
            float ss = 0.f;
#pragma unroll
            for (int et = 0; et < 8; ++et)
#pragma unroll
                for (int i = 0; i < 16; ++i) ss += acc[et][i] * acc[et][i];
            ss += __shfl_xor(ss, 32);
            const float rs = 1.0f / sqrtf(ss * (1.0f / DV) + EPS);
            lds_barrier();
            { LAS unsigned char* ob = OUT + (w * 32 + r) * OP + (4 * hh) * 2;
#pragma unroll
              for (int et = 0; et < 8; ++et)
#pragma unroll
                  for (int g = 0; g < 4; ++g) { u32x2 o; o.x = cvt2(acc[et][4 * g + 0] * rs, acc[et][4 * g + 1] * rs); o.y = cvt2(acc[et][4 * g + 2] * rs, acc[et][4 * g + 3] * rs);
                      *(LAS u32x2*)(ob + (et * 32 + 8 * g) * 2) = o; } }
            asm volatile("s_waitcnt lgkmcnt(0)" ::: "memory");
            S3_LOAD_IN(un);
            { int tz = threadIdx.x & 63; asm volatile("" : "+v"(tz)); const int pc = tz & 31, lr0 = tz >> 5;
#pragma unroll
              for (int i = 0; i < 16; ++i) { const int lr = 32 * w + lr0 + 2 * i; const int grow = row0 + lr;
                  const u32x4 hv = *(const LAS u32x4*)(OUT + lr * OP + pc * 16);
                  const f32x4 o0 = (f32x4){bflo(hv.x) * g0.x * bflo(ov[i].x), bfhi(hv.x) * g0.y * bfhi(ov[i].x), bflo(hv.y) * g0.z * bflo(ov[i].y), bfhi(hv.y) * g0.w * bfhi(ov[i].y)};
                  const f32x4 o1 = (f32x4){bflo(hv.z) * g1.x * bflo(ov[i].z), bfhi(hv.z) * g1.y * bfhi(ov[i].z), bflo(hv.w) * g1.z * bflo(ov[i].w), bfhi(hv.w) * g1.w * bfhi(ov[i].w)};
                  *(u32x2*)(HM + (size_t)grow * D + h * DV + 8 * pc) = (u32x2){pack_i8(o0 * (127.0f / HMR)), pack_i8(o1 * (127.0f / HMR))};
                  if ((i & 3) == 3) asm volatile("" ::: "memory"); } }
        }
#undef S3_DMA
        lds_barrier();
        it = itn;
    }
#undef S3_LOAD_IN
#undef S3_UNIT
}

#define XB_TMO      128
#define XB_XCNT(j)  (256  + 64 * (j))
#define XB_XSUB(j)  (1280 + 64 * (j))
#define XB_XGEN(j)  (2304 + 64 * (j))
#define XB_TOP      3328
#define XB_TOPGEN   3392
#define XCD_BAR_WORDS 3456
#define XB_SPIN_CAP (1u << 18)

__device__ __forceinline__ unsigned xb_ld(unsigned* p)              { return __hip_atomic_load(p, __ATOMIC_RELAXED, __HIP_MEMORY_SCOPE_AGENT); }
__device__ __forceinline__ unsigned xb_add(unsigned* p, unsigned v) { return __hip_atomic_fetch_add(p, v, __ATOMIC_RELAXED, __HIP_MEMORY_SCOPE_AGENT); }
__device__ __forceinline__ unsigned xb_xcc_id() { return (unsigned)__builtin_amdgcn_s_getreg((3 << 11) | 20) & 0xFu; }
#define XB_SPIN(cond, bar) do { unsigned _sp = 0; while (cond) { __builtin_amdgcn_s_sleep(1); \
    if ((++_sp & 255u) == 0u) { if (xb_ld(&(bar)[XB_TMO])) break; if (_sp > XB_SPIN_CAP) { atomicAdd(&(bar)[XB_TMO], 1u); break; } } } } while (0)

struct XcdBarrier {
    unsigned* bar; unsigned x;
    volatile LAS unsigned* st;
};

__device__ __forceinline__ XcdBarrier xcd_barrier_post(unsigned* bar, volatile LAS unsigned* st) {
    XcdBarrier b; b.bar = bar; b.x = xb_xcc_id(); b.st = st;
    if (threadIdx.x == 0) (void)xb_add(&bar[XB_XCNT(b.x)], 1u);
    return b;
}
__device__ __forceinline__ void xcd_barrier_complete(unsigned* bar, unsigned x, unsigned& nloc, unsigned& nx) {
    const unsigned G = gridDim.x * gridDim.y * gridDim.z;
    unsigned sum, cnt, mine, sp = 0u;
    for (;;) {
        sum = 0u; cnt = 0u; mine = 0u;
#pragma unroll
        for (unsigned j = 0; j < 16; ++j) { const unsigned c = xb_ld(&bar[XB_XCNT(j)]); sum += c; cnt += (c > 0u) ? 1u : 0u; mine = (j == x) ? c : mine; }
        if (sum == G) break;
        __builtin_amdgcn_s_sleep(1);
        if ((++sp & 255u) == 0u) { if (xb_ld(&bar[XB_TMO])) break; if (sp > XB_SPIN_CAP) { atomicAdd(&bar[XB_TMO], 1u); break; } }
    }
    nloc = mine > 0u ? mine : 1u; nx = cnt > 0u ? cnt : 1u;
}

__device__ __forceinline__ void xcd_barrier(const XcdBarrier& b) {
    asm volatile("s_waitcnt vmcnt(0)" ::: "memory");
    __syncthreads();
    if (threadIdx.x == 0) {
        unsigned* bar = b.bar;
        __builtin_amdgcn_s_waitcnt(0);
        unsigned nloc = b.st[0], nx = b.st[1];
        if (nloc == 0u) { xcd_barrier_complete(bar, b.x, nloc, nx); b.st[0] = nloc; b.st[1] = nx; }
        const unsigned old = xb_add(&bar[XB_XSUB(b.x)], 1u);
        const unsigned gen = old / nloc;
        if (old + 1u == (gen + 1u) * nloc) {
            __builtin_amdgcn_fence(__ATOMIC_RELEASE, "agent");
            asm volatile("s_waitcnt vmcnt(0)" ::: "memory");
            const unsigned og = xb_add(&bar[XB_TOP], 1u);
            const unsigned tg = og / nx;
            if (og + 1u == (tg + 1u) * nx) xb_add(&bar[XB_TOPGEN], 1u);
            else XB_SPIN(xb_ld(&bar[XB_TOPGEN]) == tg, bar);
            __builtin_amdgcn_fence(__ATOMIC_ACQUIRE, "agent");
            xb_add(&bar[XB_XGEN(b.x)], 1u);
            asm volatile("s_waitcnt vmcnt(0)" ::: "memory");
        } else {
            XB_SPIN(xb_ld(&bar[XB_XGEN(b.x)]) == gen, bar);
            __builtin_amdgcn_fence(__ATOMIC_ACQUIRE, "agent");
            asm volatile("s_waitcnt vmcnt(0)" ::: "memory");
        }
    }
    __syncthreads();
}


constexpr int LDS_BYTES = 152 * 1024;
constexpr int CW_BAR = 16384;
static_assert((CW_BAR + XCD_BAR_WORDS) * 4 <= (int)CTL_BYTES, "ctl");
#ifndef MK_MULTI
#define MK_MULTI 0
#endif
#define IN(p) (lo <= (p) && (p) < hi)
#define SEAM(p) do { if ((p) + 1 < hi) { XcdBarrier b_; b_.bar = (unsigned*)(load_args().ws + WS_CTL) + CW_BAR; b_.x = xb_xcc_id(); b_.st = (volatile LAS unsigned*)(C.lds + LDS_BYTES - 16); xcd_barrier(b_); } } while (0)
#define CAS __attribute__((address_space(4)))
__device__ __forceinline__ Args load_args() {
#if defined(__HIP_DEVICE_COMPILE__)
    const CAS Args* p = (const CAS Args*)__builtin_amdgcn_kernarg_segment_ptr(); asm volatile("" : "+s"(p));
    Args a; for (int i = 0; i < 22; ++i) a.in[i] = p->in[i]; a.out = p->out; a.ws = p->ws; a.lo = p->lo; a.hi = p->hi; return a;
#else
    return Args{};
#endif
}
__device__ __forceinline__ Ctx fresh(const Ctx& C) { Ctx R = C; int tz = threadIdx.x; asm volatile("" : "+v"(tz)); R.tid = tz; R.lane = tz & 63; return R; }
template <int L> __device__ __forceinline__ void layer_phases(const Args& args, const Ctx& C, int bar, int lo, int hi) {
    constexpr int pb = 16 * L;
    if (IN(pb + 1)) { phase_r1(load_args(), fresh(C), L); SEAM(pb + 1); }
    if (IN(pb + 2)) { phase_g1(load_args(), fresh(C), L); SEAM(pb + 2); }
    if constexpr ((L & 1) == 0) {
        if (IN(pb + 3)) { phase_s1(load_args(), fresh(C), L); SEAM(pb + 3); }
        if (IN(pb + 4)) { phase_s2(load_args(), fresh(C)); SEAM(pb + 4); }
        if (IN(pb + 5)) { phase_s3(load_args(), fresh(C), L); SEAM(pb + 5); }
    } else {
        if (IN(pb + 3)) { phase_conv(load_args(), fresh(C), L); SEAM(pb + 3); }
    }
    if (IN(pb + 6)) { phase_g2(load_args(), fresh(C), L); SEAM(pb + 6); }
    if (IN(pb + 7)) { phase_r2(load_args(), fresh(C), L); SEAM(pb + 7); }
    if (IN(pb + 8)) { phase_m1(load_args(), fresh(C), L); SEAM(pb + 8); }
    if (IN(pb + 9)) { phase_m2(load_args(), fresh(C), L); SEAM(pb + 9); }
}
__global__ void __launch_bounds__(NT, 2) fwd_kernel(Args args) {
    extern __shared__ __attribute__((aligned(16))) unsigned char lds_raw[];
    Ctx C; C.lds = (LAS unsigned char*)lds_raw; C.tid = threadIdx.x; C.lane = C.tid & 63; C.wave = __builtin_amdgcn_readfirstlane(C.tid >> 6); C.G = gridDim.x; C.bid = blockIdx.x; C.a = &args;
    const int lo = args.lo, hi = args.hi;
    volatile LAS unsigned* xbw = (volatile LAS unsigned*)(C.lds + LDS_BYTES - 16);
    if (C.tid < 4) xbw[C.tid] = 0u;
    __syncthreads();
    if (hi - lo > 1) (void)xcd_barrier_post((unsigned*)(args.ws + WS_CTL) + CW_BAR, xbw);
    const int bar = 0; (void)bar;
    if (IN(0)) { phase_mod(load_args(), fresh(C)); __syncthreads(); phase_cvt_mixer(load_args(), fresh(C)); SEAM(0); }
    layer_phases<0>(args, C, bar, lo, hi);
    layer_phases<1>(args, C, bar, lo, hi);
    layer_phases<2>(args, C, bar, lo, hi);
    layer_phases<3>(args, C, bar, lo, hi);
    if (IN(64)) phase_final(load_args(), fresh(C));
}
#undef IN
#undef SEAM

extern "C" void kernel_launch(void* const* d_in, const int* in_sizes, int n_in, void* d_out, int out_size, void* d_ws, size_t ws_size, hipStream_t stream) {
    static int grid = 0;
    if (grid == 0) {
        if (n_in != 22 || out_size != NL * D || ws_size < WS_END) { fprintf(stderr, "kernel_launch: unexpected shapes (n_in %d out %d ws %zu)\n", n_in, out_size, ws_size); grid = -1; return; }
        int dev = 0, cus = 0, per_cu = 0;
        if (hipGetDevice(&dev) != hipSuccess || hipDeviceGetAttribute(&cus, hipDeviceAttributeMultiprocessorCount, dev) != hipSuccess) { grid = -1; return; }
        if (hipFuncSetAttribute((const void*)fwd_kernel, hipFuncAttributeMaxDynamicSharedMemorySize, LDS_BYTES) != hipSuccess) { grid = -1; return; }
        if (hipOccupancyMaxActiveBlocksPerMultiprocessor(&per_cu, (const void*)fwd_kernel, NT, LDS_BYTES) != hipSuccess || per_cu < 1) { fprintf(stderr, "kernel_launch: occupancy query says %d\n", per_cu); }
        (void)hipGetLastError();
        grid = cus;
    }
    if (grid < 0) return;
    (void)hipMemsetAsync((char*)d_ws + WS_CTL, 0, CTL_BYTES, stream);
    Args a{};
    for (int i = 0; i < 22; ++i) a.in[i] = (const float*)d_in[i];
    a.out = (float*)d_out; a.ws = (unsigned char*)d_ws;
#if MK_MULTI
    int phases[64]; int np = 0;
    phases[np++] = 0;
    for (int l = 0; l < DEPTH; ++l) { const int pb = 16 * l; phases[np++] = pb + 1; phases[np++] = pb + 2; phases[np++] = pb + 3;
        if ((l & 1) == 0) { phases[np++] = pb + 4; phases[np++] = pb + 5; }
        phases[np++] = pb + 6; phases[np++] = pb + 7; phases[np++] = pb + 8; phases[np++] = pb + 9; }
    phases[np++] = 64;
    for (int i = 0; i < np; ++i) { a.lo = phases[i]; a.hi = phases[i] + 1; hipLaunchKernelGGL(fwd_kernel, dim3(grid), dim3(NT), LDS_BYTES, stream, a); }
#else
    a.lo = 0; a.hi = 65;
    hipLaunchKernelGGL(fwd_kernel, dim3(grid), dim3(NT), LDS_BYTES, stream, a);
#ifdef PROBE_PHASES
    { const int pp[] = {PROBE_PHASES};
      for (int rep = 0; rep < PROBE_REPS; ++rep) for (unsigned i = 0; i < sizeof(pp) / sizeof(pp[0]); ++i) { a.lo = pp[i]; a.hi = pp[i] + 1; hipLaunchKernelGGL(fwd_kernel, dim3(grid), dim3(NT), LDS_BYTES, stream, a); } }
#endif
#endif
}
```

```cpp
#include <hip/hip_runtime.h>
#include <cstdio>
#include <cstdint>

#define LAS __attribute__((address_space(3)))
typedef unsigned short bf16;
typedef float f32x4 __attribute__((ext_vector_type(4)));
typedef unsigned u32x4 __attribute__((ext_vector_type(4)));
typedef unsigned u32x2 __attribute__((ext_vector_type(2)));
typedef int i32x4r __attribute__((ext_vector_type(4)));

constexpr int D = 1024, BATCH = 2, SEQ = 16384, DEPTH = 4, CTXL = 256;
constexpr int NL = BATCH * SEQ, NCX = BATCH * CTXL, NR = NL + NCX;
constexpr int NH = 4, DQK = 128, DV = 256, NQ = 512, NV = 1024, PROJ = 3088, PW = 3072;
constexpr int NGRP = 4, EPG = 8, NE = 32, DE = 512;
constexpr int NBLK = 65;
constexpr int NUNIT = BATCH * NH * NBLK;
constexpr int CAP = NR;
constexpr int YROWS = 74752;
constexpr float EPS = 1e-6f;
constexpr float WSCALE = 32.0f;
constexpr float YSCALE = 4.0f;
constexpr int NT = 512, NW = 8;
constexpr int LDS_TAB_END = 152 * 1024 - 16;

constexpr size_t MiB = 1u << 20;
constexpr size_t WS_CTL = 0, CTL_BYTES = 1 * MiB;
constexpr size_t WS_MOD = 1 * MiB;
constexpr size_t WS_GATE = 2 * MiB;
constexpr size_t WS_TOKSLOT = 5 * MiB;
constexpr size_t WS_TOKW = 6 * MiB;
constexpr size_t WS_SLOTTOK = 7 * MiB;
constexpr size_t WS_DN = 12 * MiB;
constexpr size_t WS_NST = 13 * MiB;
constexpr size_t WS_BTOT = 14 * MiB;
constexpr size_t WS_RSC = 15 * MiB;
constexpr size_t WS_LAT = 16 * MiB;
constexpr size_t WS_HB = 146 * MiB;
constexpr size_t WS_PB = 211 * MiB;
constexpr size_t WS_HM = 406 * MiB;
constexpr size_t WS_DC = 471 * MiB;
constexpr size_t WS_CST = 601 * MiB;
constexpr size_t WS_VT = 666 * MiB;
constexpr size_t WS_WAIN = 731 * MiB;
constexpr size_t WS_WBIN = 743 * MiB;
constexpr size_t WS_WAOUT = 755 * MiB;
constexpr size_t WS_WBOUT = 759 * MiB;
constexpr size_t WS_WGU = 763 * MiB;
constexpr size_t WS_WDN = 827 * MiB;
constexpr size_t WS_H8 = 843 * MiB;
constexpr size_t WS_END = 880 * MiB;
constexpr int CW_WMAX = 256;
constexpr int CW_CNT = 1024, CNT_STRIDE = 64;

struct Args { const float* in[22]; float* out; unsigned char* ws; int lo, hi; };

typedef short bf16x8 __attribute__((ext_vector_type(8)));
typedef float f32x2 __attribute__((ext_vector_type(2)));
typedef __bf16 bf16x2_t __attribute__((ext_vector_type(2)));
__device__ __forceinline__ unsigned cvt2(float lo, float hi) { const f32x2 v = {lo, hi}; return __builtin_bit_cast(unsigned, __builtin_convertvector(v, bf16x2_t)); }
__device__ __forceinline__ float bf2f(bf16 v) { return __uint_as_float(((unsigned)v) << 16); }
__device__ __forceinline__ unsigned f2bf(float f) { return cvt2(f, 0.f) & 0xffffu; }
__device__ __forceinline__ unsigned pk2(float lo, float hi) { return cvt2(lo, hi); }
template <int CTRL, int ROWMASK> __device__ __forceinline__ float dpp_mov(float x) { return __int_as_float(__builtin_amdgcn_update_dpp(0, __float_as_int(x), CTRL, ROWMASK, 0xf, false)); }
__device__ __forceinline__ float wave_sum(float v) {
    v += dpp_mov<0xB1, 0xf>(v); v += dpp_mov<0x4E, 0xf>(v); v += dpp_mov<0x141, 0xf>(v); v += dpp_mov<0x140, 0xf>(v);
    v += dpp_mov<0x142, 0xA>(v); v += dpp_mov<0x143, 0xC>(v);
    return __int_as_float(__builtin_amdgcn_readlane(__float_as_int(v), 63));
}
__device__ __forceinline__ float wave_max_nn(float v) {
    v = fmaxf(v, dpp_mov<0xB1, 0xf>(v)); v = fmaxf(v, dpp_mov<0x4E, 0xf>(v)); v = fmaxf(v, dpp_mov<0x141, 0xf>(v)); v = fmaxf(v, dpp_mov<0x140, 0xf>(v));
    v = fmaxf(v, dpp_mov<0x142, 0xA>(v)); v = fmaxf(v, dpp_mov<0x143, 0xC>(v));
    return __int_as_float(__builtin_amdgcn_readlane(__float_as_int(v), 63));
}
__device__ __forceinline__ unsigned pack_i8_nc(f32x4 v) {
    const unsigned a = __float_as_uint(v.x + 12582912.0f), b = __float_as_uint(v.y + 12582912.0f), c = __float_as_uint(v.z + 12582912.0f), d = __float_as_uint(v.w + 12582912.0f);
    return __builtin_amdgcn_perm(__builtin_amdgcn_perm(d, c, 0x0c0c0400u) , __builtin_amdgcn_perm(b, a, 0x0c0c0400u), 0x05040100u);
}
__device__ __forceinline__ unsigned pack_i8(f32x4 v) {
    return pack_i8_nc((f32x4){__builtin_amdgcn_fmed3f(v.x, -127.f, 127.f), __builtin_amdgcn_fmed3f(v.y, -127.f, 127.f), __builtin_amdgcn_fmed3f(v.z, -127.f, 127.f), __builtin_amdgcn_fmed3f(v.w, -127.f, 127.f)});
}
__device__ __forceinline__ float sigmoidf_(float x) { return 1.f / (1.f + __expf(-x)); }
__device__ __forceinline__ float siluf_(float x) { return x / (1.f + __expf(-x)); }
__device__ __forceinline__ float logsigmoidf_(float x) { return fminf(x, 0.f) - log1pf(__expf(-fabsf(x))); }
__device__ __forceinline__ int blk_row0(int b, int blk) { return blk == 0 ? NL + b * CTXL : b * SEQ + (blk - 1) * 256; }
__device__ __forceinline__ int mod_vec_of_row(int row) { return row < NL ? row / SEQ : 2; }

struct Ctx {
    LAS unsigned char* lds; int tid, lane, wave, G, bid;
    const Args* a;
};

__device__ __forceinline__ int expert_block_prefix(const unsigned* cnt, int lane, int& nb) {
    nb = lane < NE ? ((int)cnt[lane * CNT_STRIDE] + 255) / 256 : 0; int v = nb;
#pragma unroll
    for (int o = 1; o < 64; o <<= 1) { const int t = __shfl_up(v, o); v += (lane >= o) ? t : 0; }
    return v - nb;
}
__device__ __forceinline__ void slot_bases(const Args& A, int l, LAS int* sb, int tid) {
    if (tid < 64) { int nb; const int ex = expert_block_prefix((const unsigned*)(A.ws + WS_CTL) + CW_CNT + l * 32 * CNT_STRIDE, tid, nb); if (tid <= NE) sb[tid] = ex * 256; }
    __syncthreads();
}

__device__ __forceinline__ void phase_mod(const Args& A, const Ctx& C) {
    LAS float* sc = (LAS float*)C.lds;
    LAS float* red = sc + 3072;
    const float* c = A.in[1]; const float* cc = A.in[3];
    for (int i = C.tid; i < 3072; i += NT) { const float v = i < 2048 ? c[i] : cc[i - 2048]; sc[i] = siluf_(v); }
    __syncthreads();
    float* MOD = (float*)(A.ws + WS_MOD);
    for (int u = C.bid; u < DEPTH * 192; u += C.G) {
        const int l = u / 192, cg = u % 192, col = cg * 32 + (C.lane & 31), kh = C.lane >> 5;
        const float* w = A.in[4] + (size_t)l * D * 6 * D + col + (size_t)(C.wave * 128 + kh * 64) * 6 * D;
        float wv[64];
#pragma unroll
        for (int k = 0; k < 64; ++k) wv[k] = w[(size_t)k * 6 * D];
        LAS const float* s0 = sc + C.wave * 128 + kh * 64;
        float a0 = 0.f, a1 = 0.f, a2 = 0.f;
#pragma unroll
        for (int k = 0; k < 64; ++k) { a0 += s0[k] * wv[k]; a1 += s0[1024 + k] * wv[k]; a2 += s0[2048 + k] * wv[k]; }
        a0 += __shfl_xor(a0, 32); a1 += __shfl_xor(a1, 32); a2 += __shfl_xor(a2, 32);
        if (kh == 0) { red[(C.wave * 3 + 0) * 64 + C.lane] = a0; red[(C.wave * 3 + 1) * 64 + C.lane] = a1; red[(C.wave * 3 + 2) * 64 + C.lane] = a2; }
        __syncthreads();
        if (C.tid < 96) { const int v = C.tid / 32, ln = C.tid % 32; float s = 0.f;
            for (int w8 = 0; w8 < 8; ++w8) s += red[(w8 * 3 + v) * 64 + ln];
            MOD[(size_t)(l * 3 + v) * 6 * D + cg * 32 + ln] = s + A.in[5][(size_t)l * 6 * D + cg * 32 + ln]; }
        __syncthreads();
    }
}
__device__ __forceinline__ void load_row_f32(const float* p, int lane, f32x4 (&v)[4]) {
#pragma unroll
    for (int j = 0; j < 4; ++j) v[j] = *(const f32x4*)(p + 4 * lane + 256 * j);
}
__device__ __forceinline__ void load_row_bf16(const bf16* p, int lane, f32x4 (&v)[4]) {
#pragma unroll
    for (int j = 0; j < 4; ++j) { const u32x2 w = *(const u32x2*)(p + 4 * lane + 256 * j);
        v[j] = (f32x4){__uint_as_float(w.x << 16), __uint_as_float(w.x & 0xffff0000u), __uint_as_float(w.y << 16), __uint_as_float(w.y & 0xffff0000u)}; }
}
__device__ __forceinline__ void store_row_bf16(bf16* p, int lane, const f32x4 (&v)[4]) {
#pragma unroll
    for (int j = 0; j < 4; ++j) { u32x2 w; w.x = pk2(v[j].x, v[j].y); w.y = pk2(v[j].z, v[j].w); *(u32x2*)(p + 4 * lane + 256 * j) = w; }
}
constexpr int CVT_IG = (D / 64) * (DE / 32), CVT_ID = (DE / 64) * (D / 32), CVT_PER = 2 * CVT_IG + CVT_ID, CVT_ITEMS = NE * CVT_PER;
constexpr int CVT_Q = 24;
__device__ __forceinline__ void cvt_moe_items(const Args& A, const Ctx& C, int l, int it0, int end, int stride);
__device__ __forceinline__ void cvt_win_i8(const Args& A, const Ctx& C);
__device__ __forceinline__ int cvt_t2(int l, int G);
struct RowVec { f32x4 a[4], s[4], g[4]; };
__device__ __forceinline__ void load_rowvec(RowVec& R, const float* ng, const float* sh, const float* sc, const float* gt, int lane) {
    f32x4 n[4], c[4]; load_row_f32(ng, lane, n); load_row_f32(sc, lane, c); load_row_f32(sh, lane, R.s); if (gt) load_row_f32(gt, lane, R.g);
#pragma unroll
    for (int q = 0; q < 4; ++q) R.a[q] = n[q] * (1.f + c[q]);
}
__device__ __forceinline__ void load_row_bf16raw(const bf16* p, int lane, u32x2 (&v)[4]) {
#pragma unroll
    for (int j = 0; j < 4; ++j) v[j] = *(const u32x2*)(p + 4 * lane + 256 * j);
}
__device__ __forceinline__ void store_row_fp8(unsigned char* p, int lane, const f32x4 (&v)[4]) {
#pragma unroll
    for (int j = 0; j < 4; ++j) { int w = 0; w = __builtin_amdgcn_cvt_pk_fp8_f32(v[j].x, v[j].y, w, false); w = __builtin_amdgcn_cvt_pk_fp8_f32(v[j].z, v[j].w, w, true); *(unsigned*)(p + 4 * lane + 256 * j) = (unsigned)w; }
}
__device__ __forceinline__ void load_row_fp8raw(const unsigned char* p, int lane, unsigned (&v)[4]) {
#pragma unroll
    for (int j = 0; j < 4; ++j) v[j] = *(const unsigned*)(p + 4 * lane + 256 * j);
}
__device__ __forceinline__ f32x4 fp8x4(unsigned w) { const f32x2 lo = __builtin_amdgcn_cvt_pk_f32_fp8((int)w, false), hi = __builtin_amdgcn_cvt_pk_f32_fp8((int)w, true); return (f32x4){lo.x, lo.y, hi.x, hi.y}; }
__device__ __forceinline__ f32x4 bf4(u32x2 w) { return (f32x4){__uint_as_float(w.x << 16), __uint_as_float(w.x & 0xffff0000u), __uint_as_float(w.y << 16), __uint_as_float(w.y & 0xffff0000u)}; }
__device__ __forceinline__ float row_rstd(const f32x4 (&v)[4]) {
    float s = 0.f;
#pragma unroll
    for (int j = 0; j < 4; ++j) s += (v[j].x * v[j].x + v[j].y * v[j].y) + (v[j].z * v[j].z + v[j].w * v[j].w);
    return 1.0f / sqrtf(wave_sum(s) * (1.f / D) + EPS);
}

__device__ __forceinline__ void phase_r1(const Args& A, const Ctx& C, int l) {
    LAS int* sb = (LAS int*)C.lds;
    constexpr int GWP = 2064;
    LAS unsigned char* GW = C.lds + 256;
    LAS unsigned char* HS = C.lds + 256 + 16 * GWP + C.wave * 2 * GWP;
    const bool mls = (l & 1) == 0; const int j = l >> 1;
    if (l == 0) { cvt_win_i8(A, C); __syncthreads(); }
    if (l > 0) slot_bases(A, l - 1, sb, C.tid);
    if (mls) { const float* w = A.in[8] + (size_t)j * D * PROJ + PW;
        f32x4 t[2][4];
#pragma unroll
        for (int jj = 0; jj < 2; ++jj)
#pragma unroll
            for (int q = 0; q < 4; ++q) t[jj][q] = *(const f32x4*)(w + (size_t)(C.tid + NT * jj) * PROJ + 4 * q);
#pragma unroll
        for (int jj = 0; jj < 2; ++jj)
#pragma unroll
            for (int q = 0; q < 4; ++q) { const int k = C.tid + NT * jj;
#pragma unroll
                for (int c = 0; c < 4; ++c) *(LAS unsigned short*)(GW + (4 * q + c) * GWP + k * 2) = (unsigned short)f2bf(t[jj][q][c]); }
        __syncthreads(); }
    const int nrows = (l <= 2) ? NR : NL;
    bf16* LAT = (bf16*)(A.ws + WS_LAT); unsigned char* HI8 = A.ws + WS_H8; float* RSC = (float*)(A.ws + WS_RSC); float* GATE = (float*)(A.ws + WS_GATE);
    const float* MOD = (const float*)(A.ws + WS_MOD); const unsigned char* Y8 = A.ws + WS_PB;
    const int* TS = (const int*)(A.ws + WS_TOKSLOT); const float* TW = (const float*)(A.ws + WS_TOKW);
    const int rpw = (((nrows + C.G - 1) / C.G) + 1) & ~1; const int wrow0 = C.bid * rpw; const int wend = min(wrow0 + rpw, nrows);
    for (int sa = wrow0; sa < wend;) {
        const int mvi = mod_vec_of_row(sa); const int bnd = mvi == 0 ? SEQ : (mvi == 1 ? NL : NR); const int sbnd = min(wend, bnd);
        RowVec RV; { const float* mv = MOD + (size_t)(l * 3 + mvi) * 6 * D;
            load_rowvec(RV, A.in[6] + (size_t)(l * 2 + 0) * D, mv + 0 * D, mv + 1 * D, l > 0 ? MOD + (size_t)((l - 1) * 3 + mvi) * 6 * D + 5 * D : nullptr, C.lane); }
        const int rlast = sbnd - 2; const int rfirst = sa + 2 * C.wave;
        i32x4r ts1 = (i32x4r){0, 0, 0, 0}, ts2 = ts1; f32x4 tw1 = (f32x4){0.f, 0.f, 0.f, 0.f}, tw2 = tw1;
        u32x2 nla[4], nlb[4]; unsigned nya0[4], nya1[4], nyb0[4], nyb1[4]; f32x4 nxa[4], nxb[4];
#define R1_FETCH(r_, ts_) do { const int fa_ = (r_), fb_ = fa_ + 1; \
            if (l == 0) { load_row_f32(fa_ < NL ? A.in[0] + (size_t)fa_ * D : A.in[2] + (size_t)(fa_ - NL) * D, C.lane, nxa); load_row_f32(fb_ < NL ? A.in[0] + (size_t)fb_ * D : A.in[2] + (size_t)(fb_ - NL) * D, C.lane, nxb); } \
            else { load_row_bf16raw(LAT + (size_t)fa_ * D, C.lane, nla); load_row_bf16raw(LAT + (size_t)fb_ * D, C.lane, nlb); \
                load_row_fp8raw(Y8 + (size_t)(sb[(ts_).x >> 20] + ((ts_).x & 0xfffff)) * D, C.lane, nya0); load_row_fp8raw(Y8 + (size_t)(sb[(ts_).y >> 20] + ((ts_).y & 0xfffff)) * D, C.lane, nya1); \
                load_row_fp8raw(Y8 + (size_t)(sb[(ts_).z >> 20] + ((ts_).z & 0xfffff)) * D, C.lane, nyb0); load_row_fp8raw(Y8 + (size_t)(sb[(ts_).w >> 20] + ((ts_).w & 0xfffff)) * D, C.lane, nyb1); } } while (0)
        if (l > 0) { const int r0 = min(rfirst, rlast), r1 = min(rfirst + 2 * NW, rlast);
            ts1 = *(const i32x4r*)(TS + r0 * 2); tw1 = *(const f32x4*)(TW + r0 * 2); ts2 = *(const i32x4r*)(TS + r1 * 2); tw2 = *(const f32x4*)(TW + r1 * 2); }
        R1_FETCH(min(rfirst, rlast), ts1);
        for (int ra = rfirst; ra < sbnd; ra += 2 * NW) {
            const bool hasb = true; const int rb = ra + 1;
            f32x4 va[4], vb[4];
            if (l == 0) {
#pragma unroll
                for (int q = 0; q < 4; ++q) { va[q] = nxa[q]; vb[q] = nxb[q]; }
                R1_FETCH(min(ra + 2 * NW, rlast), ts1);
            } else {
                u32x2 la[4], lb[4]; unsigned ya0[4], ya1[4], yb0[4], yb1[4];
#pragma unroll
                for (int q = 0; q < 4; ++q) { la[q] = nla[q]; lb[q] = nlb[q]; ya0[q] = nya0[q]; ya1[q] = nya1[q]; yb0[q] = nyb0[q]; yb1[q] = nyb1[q]; }
                const f32x4 twc = tw1;
                ts1 = ts2; tw1 = tw2;
                { const int r2 = min(ra + 4 * NW, rlast); ts2 = *(const i32x4r*)(TS + r2 * 2); tw2 = *(const f32x4*)(TW + r2 * 2); }
                R1_FETCH(min(ra + 2 * NW, rlast), ts1);
                const float wa0 = twc.x * (1.0f / YSCALE), wa1 = twc.y * (1.0f / YSCALE), wb0 = twc.z * (1.0f / YSCALE), wb1 = twc.w * (1.0f / YSCALE);
#pragma unroll
                for (int q = 0; q < 4; ++q) { va[q] = bf4(la[q]) + RV.g[q] * (fp8x4(ya0[q]) * wa0 + fp8x4(ya1[q]) * wa1); vb[q] = bf4(lb[q]) + RV.g[q] * (fp8x4(yb0[q]) * wb0 + fp8x4(yb1[q]) * wb1); }
            }
            store_row_bf16(LAT + (size_t)ra * D, C.lane, va); if (hasb) store_row_bf16(LAT + (size_t)rb * D, C.lane, vb);
            const float rra = row_rstd(va), rrb = row_rstd(vb);
            f32x4 ha[4], hb[4];
#pragma unroll
            for (int q = 0; q < 4; ++q) { ha[q] = (va[q] * rra) * RV.a[q] + RV.s[q]; hb[q] = (vb[q] * rrb) * RV.a[q] + RV.s[q]; }
            { float ma = 0.f, mb = 0.f;
#pragma unroll
              for (int q = 0; q < 4; ++q) { ma = fmaxf(ma, fmaxf(fmaxf(fabsf(ha[q].x), fabsf(ha[q].y)), fmaxf(fabsf(ha[q].z), fabsf(ha[q].w)))); mb = fmaxf(mb, fmaxf(fmaxf(fabsf(hb[q].x), fabsf(hb[q].y)), fmaxf(fabsf(hb[q].z), fabsf(hb[q].w)))); }
              ma = fmaxf(wave_max_nn(ma), 1.0e-20f); mb = fmaxf(wave_max_nn(mb), 1.0e-20f);
              const float ia = 127.0f / ma, ib = 127.0f / mb;
#pragma unroll
              for (int q = 0; q < 4; ++q) { *(unsigned*)(HI8 + (size_t)ra * D + 4 * C.lane + 256 * q) = pack_i8_nc(ha[q] * ia); *(unsigned*)(HI8 + (size_t)rb * D + 4 * C.lane + 256 * q) = pack_i8_nc(hb[q] * ib); }
              if (C.lane == 0) { RSC[ra] = ma * (1.0f / 127.0f); RSC[rb] = mb * (1.0f / 127.0f); } }
            if (mls) {
#pragma unroll
                for (int q = 0; q < 4; ++q) { *(LAS u32x2*)(HS + (4 * C.lane + 256 * q) * 2) = (u32x2){cvt2(ha[q].x, ha[q].y), cvt2(ha[q].z, ha[q].w)}; *(LAS u32x2*)(HS + GWP + (4 * C.lane + 256 * q) * 2) = (u32x2){cvt2(hb[q].x, hb[q].y), cvt2(hb[q].z, hb[q].w)}; }
                asm volatile("s_waitcnt lgkmcnt(0)" ::: "memory");
                f32x4 gacc = (f32x4){0.f, 0.f, 0.f, 0.f};
                { const int gi = C.lane & 15, kg = C.lane >> 4; LAS const unsigned char* ap = HS + (gi & 1) * GWP + kg * 16; LAS const unsigned char* bp = GW + gi * GWP + kg * 16;
#pragma unroll 8
                  for (int s2 = 0; s2 < 32; ++s2) { bf16x8 av = *(const LAS bf16x8*)(ap + s2 * 64); const bf16x8 bv = *(const LAS bf16x8*)(bp + s2 * 64);
                      if (gi >= 2) av = (bf16x8){0, 0, 0, 0, 0, 0, 0, 0};
                      gacc = __builtin_amdgcn_mfma_f32_16x16x32_bf16(av, bv, gacc, 0, 0, 0); } }
                float ga = gacc[0], gb = gacc[1];
                if (C.lane < 16) {
                    const float bgt = A.in[9][j * 16 + C.lane]; const int gtype = C.lane >> 2;
                    ga += bgt; gb += bgt;
                    GATE[(size_t)ra * 16 + C.lane] = (gtype & 1) ? logsigmoidf_(ga) : 15.0f * tanhf(ga * (1.0f / 15.0f));
                    if (hasb) GATE[(size_t)rb * 16 + C.lane] = (gtype & 1) ? logsigmoidf_(gb) : 15.0f * tanhf(gb * (1.0f / 15.0f)); }
            }
        }
#undef R1_FETCH
        sa = sbnd;
    }
}

__device__ __forceinline__ void phase_r2(const Args& A, const Ctx& C, int l) {
    constexpr int WP = 2064;
    LAS unsigned char* RWB = C.lds;
    LAS float* WL = (LAS float*)(C.lds + 48 * WP);
    LAS unsigned* hist = (LAS unsigned*)(WL + 8 * 16 * 48);
    LAS unsigned* gbase = hist + 32;
    constexpr int RCAP = 144;
    LAS int* rec = (LAS int*)(gbase + 32);
    static_assert(48 * WP + 8 * 16 * 48 * 4 + 256 + RCAP * 16 <= LDS_TAB_END, "R2 LDS map");
    cvt_moe_items(A, C, l, cvt_t2(l, C.G) + C.bid * NW + C.wave, CVT_ITEMS, C.G * NW);
    __syncthreads();
    { const float* wg = A.in[15] + (size_t)l * D * NGRP; const float* wr = A.in[17] + (size_t)l * D * NE;
      { const int kp = C.tid; const f32x4 x0 = *(const f32x4*)(wg + (size_t)(2 * kp) * 4), x1 = *(const f32x4*)(wg + (size_t)(2 * kp + 1) * 4);
        *(LAS unsigned*)(RWB + 0 * WP + kp * 4) = cvt2(x0.x, x1.x); *(LAS unsigned*)(RWB + 1 * WP + kp * 4) = cvt2(x0.y, x1.y);
        *(LAS unsigned*)(RWB + 2 * WP + kp * 4) = cvt2(x0.z, x1.z); *(LAS unsigned*)(RWB + 3 * WP + kp * 4) = cvt2(x0.w, x1.w); }
      f32x4 t0[8], t1[8];
#pragma unroll
      for (int jj = 0; jj < 8; ++jj) { const int it = C.tid + NT * jj, kp = it >> 3, cg = it & 7; t0[jj] = *(const f32x4*)(wr + (size_t)(2 * kp) * NE + 4 * cg); t1[jj] = *(const f32x4*)(wr + (size_t)(2 * kp + 1) * NE + 4 * cg); }
#pragma unroll
      for (int jj = 0; jj < 8; ++jj) { const int it = C.tid + NT * jj, kp = it >> 3, c0 = 4 + 4 * (it & 7);
          *(LAS unsigned*)(RWB + (c0 + 0) * WP + kp * 4) = cvt2(t0[jj].x, t1[jj].x); *(LAS unsigned*)(RWB + (c0 + 1) * WP + kp * 4) = cvt2(t0[jj].y, t1[jj].y);
          *(LAS unsigned*)(RWB + (c0 + 2) * WP + kp * 4) = cvt2(t0[jj].z, t1[jj].z); *(LAS unsigned*)(RWB + (c0 + 3) * WP + kp * 4) = cvt2(t0[jj].w, t1[jj].w); }
      for (int i = C.tid; i < 12 * 512; i += NT) *(LAS unsigned*)(RWB + (36 + i / 512) * WP + (i % 512) * 4) = 0u; }
    const int nrows = (l <= 1) ? NR : NL;
    bf16* LAT = (bf16*)(A.ws + WS_LAT); bf16* H = (bf16*)(A.ws + WS_HB); unsigned char* H8 = A.ws + WS_H8;
    const float* MOD = (const float*)(A.ws + WS_MOD);
    unsigned* cnt = (unsigned*)(A.ws + WS_CTL) + CW_CNT + l * 32 * CNT_STRIDE;
    int* TS = (int*)(A.ws + WS_TOKSLOT); float* TW = (float*)(A.ws + WS_TOKW); int* ST = (int*)(A.ws + WS_SLOTTOK);
    const int rpw = (((nrows + C.G - 1) / C.G) + 1) & ~1; const int wrow0 = C.bid * rpw; const int wend0 = min(wrow0 + rpw, nrows);
    const float* bg = A.in[16] + l * NGRP; const float* br = A.in[18] + l * NE;
    for (int cb = wrow0; cb < wend0; cb += RCAP) {
        const int wend = min(cb + RCAP, wend0);
        if (C.tid < 32) hist[C.tid] = 0u;
        for (int sa = cb; sa < wend;) {
            const int mvi = mod_vec_of_row(sa); const int bnd = mvi == 0 ? SEQ : (mvi == 1 ? NL : NR); const int sbnd = min(wend, bnd);
            RowVec RV; { const float* mv = MOD + (size_t)(l * 3 + mvi) * 6 * D; load_rowvec(RV, A.in[6] + (size_t)(l * 2 + 1) * D, mv + 3 * D, mv + 4 * D, mv + 2 * D, C.lane); }
            const int rlast = sbnd - 2;
            u32x2 la[4], lb[4];
            { const int r0 = min(sa + 2 * C.wave, rlast); load_row_bf16raw(LAT + (size_t)r0 * D, C.lane, la); load_row_bf16raw(LAT + (size_t)(r0 + 1) * D, C.lane, lb); }
            for (int ra = sa + 2 * C.wave; ra < sbnd; ra += 2 * NW) {
                const int rb = ra + 1;
                u32x2 lan[4], lbn[4];
                { const int r1 = min(ra + 2 * NW, rlast); load_row_bf16raw(LAT + (size_t)r1 * D, C.lane, lan); load_row_bf16raw(LAT + (size_t)(r1 + 1) * D, C.lane, lbn); }
                f32x4 va[4], vb[4];
#pragma unroll
                for (int q = 0; q < 4; ++q) { va[q] = bf4(la[q]); vb[q] = bf4(lb[q]); }
                const float rra = row_rstd(va), rrb = row_rstd(vb);
                f32x4 ha[4], hb[4];
#pragma unroll
                for (int q = 0; q < 4; ++q) { ha[q] = (va[q] * rra) * RV.a[q] + RV.s[q]; hb[q] = (vb[q] * rrb) * RV.a[q] + RV.s[q]; }
                store_row_bf16(H + (size_t)ra * D, C.lane, ha); store_row_bf16(H + (size_t)rb * D, C.lane, hb);
                store_row_fp8(H8 + (size_t)ra * D, C.lane, ha); store_row_fp8(H8 + (size_t)rb * D, C.lane, hb);
#pragma unroll
                for (int q = 0; q < 4; ++q) { la[q] = lan[q]; lb[q] = lbn[q]; }
            }
            sa = sbnd;
        }
        __syncthreads();
        const int fr = C.lane & 15, fq = C.lane >> 4;
        for (int t = C.wave; t * 16 < wend - cb; t += NW) {
            const int trow = min(cb + 16 * t + fr, wend - 1);
            const bf16* hp = H + (size_t)trow * D + 8 * fq;
            f32x4 acc[3];
#pragma unroll
            for (int ct = 0; ct < 3; ++ct) acc[ct] = (f32x4){0.f, 0.f, 0.f, 0.f};
            { bf16x8 av[32];
#pragma unroll
              for (int k8 = 0; k8 < 32; ++k8) av[k8] = *(const bf16x8*)(hp + 32 * k8);
#pragma unroll
              for (int k8 = 0; k8 < 32; ++k8) {
#pragma unroll
                  for (int ct = 0; ct < 3; ++ct) { const bf16x8 bv = *(const LAS bf16x8*)(RWB + (ct * 16 + fr) * WP + (32 * k8 + 8 * fq) * 2);
                      acc[ct] = __builtin_amdgcn_mfma_f32_16x16x32_bf16(av[k8], bv, acc[ct], 0, 0, 0); }
                  if ((k8 & 3) == 3) asm volatile("" ::: "memory"); } }
            LAS float* wl = WL + C.wave * 16 * 48;
#pragma unroll
            for (int ct = 0; ct < 3; ++ct)
#pragma unroll
                for (int jq = 0; jq < 4; ++jq) wl[(4 * fq + jq) * 48 + ct * 16 + fr] = acc[ct][jq];
            asm volatile("s_waitcnt lgkmcnt(0)" ::: "memory");
            const int row = cb + 16 * t + C.lane;
            if (C.lane < 16 && row < wend) {
                LAS const float* wm = wl + C.lane * 48;
                float lg[36];
#pragma unroll
                for (int c = 0; c < 36; ++c) lg[c] = wm[c];
                float gl[4]; int grp = 0; float gm = -3.0e38f;
#pragma unroll
                for (int c = 0; c < 4; ++c) { gl[c] = lg[c] + bg[c]; if (gl[c] > gm) { gm = gl[c]; grp = c; } }
                float gs = 0.f;
#pragma unroll
                for (int c = 0; c < 4; ++c) gs += __expf(gl[c] - gm);
                const float pgrp = 1.0f / gs;
                float rl[8];
#pragma unroll
                for (int i = 0; i < 8; ++i) { float tt = 0.f;
#pragma unroll
                    for (int g = 0; g < 4; ++g) tt = (g == grp) ? lg[4 + g * 8 + i] : tt;
                    rl[i] = tt + br[grp * 8 + i]; }
                int i0 = 0; float m0 = rl[0];
#pragma unroll
                for (int i = 1; i < 8; ++i) if (rl[i] > m0) { m0 = rl[i]; i0 = i; }
                int i1 = -1; float m1 = -3.0e38f;
#pragma unroll
                for (int i = 0; i < 8; ++i) if (i != i0 && rl[i] > m1) { m1 = rl[i]; i1 = i; }
                const float p0 = 1.0f, p1 = __expf(m1 - m0);
                const float w0 = pgrp * p0 / (p0 + p1), w1 = pgrp * p1 / (p0 + p1);
                const int e0 = grp * 8 + i0, e1 = grp * 8 + i1;
                const unsigned q0 = __hip_atomic_fetch_add(hist + e0, 1u, __ATOMIC_RELAXED, __HIP_MEMORY_SCOPE_WORKGROUP), q1 = __hip_atomic_fetch_add(hist + e1, 1u, __ATOMIC_RELAXED, __HIP_MEMORY_SCOPE_WORKGROUP);
                const int li = row - cb;
                rec[li * 4 + 0] = e0 | (e1 << 8); rec[li * 4 + 1] = (int)q0; rec[li * 4 + 2] = (int)q1;
                TW[row * 2 + 0] = w0; TW[row * 2 + 1] = w1;
            }
        }
        __syncthreads();
        if (C.tid < 32) gbase[C.tid] = hist[C.tid] ? atomicAdd(cnt + C.tid * CNT_STRIDE, hist[C.tid]) : 0u;
        __syncthreads();
        for (int i = C.tid; i < wend - cb; i += NT) { const int row = cb + i; const int ee = rec[i * 4], e0 = ee & 255, e1 = ee >> 8;
            const unsigned q0 = gbase[e0] + (unsigned)rec[i * 4 + 1], q1 = gbase[e1] + (unsigned)rec[i * 4 + 2];
            ST[(size_t)e0 * CAP + q0] = row; ST[(size_t)e1 * CAP + q1] = row;
            TS[row * 2 + 0] = (e0 << 20) | (int)q0; TS[row * 2 + 1] = (e1 << 20) | (int)q1; }
        __syncthreads();
    }
}

__device__ __forceinline__ void phase_final(const Args& A, const Ctx& C) {
    LAS int* sb = (LAS int*)C.lds;
    slot_bases(A, 3, sb, C.tid);
    const bf16* LAT = (const bf16*)(A.ws + WS_LAT); const unsigned char* Y8 = A.ws + WS_PB;
    const int* TS = (const int*)(A.ws + WS_TOKSLOT); const float* TW = (const float*)(A.ws + WS_TOKW);
    const float* MOD = (const float*)(A.ws + WS_MOD);
    f32x4 fg[4]; load_row_f32(A.in[7], C.lane, fg);
    const int rpw = (((NL + C.G - 1) / C.G) + 1) & ~1; const int wrow0 = C.bid * rpw; const int wend = min(wrow0 + rpw, NL);
    for (int sa = wrow0; sa < wend;) {
        const int mvi = mod_vec_of_row(sa); const int sbnd = min(wend, mvi == 0 ? SEQ : NL);
        f32x4 g2[4]; load_row_f32(MOD + (size_t)(3 * 3 + mvi) * 6 * D + 5 * D, C.lane, g2);
        const int rlast = sbnd - 2; const int rfirst = sa + 2 * C.wave;
        i32x4r ts1, ts2; f32x4 tw1, tw2;
        u32x2 nla[4], nlb[4]; unsigned nya0[4], nya1[4], nyb0[4], nyb1[4];
#define FIN_FETCH(r_, ts_) do { const int fa_ = (r_); \
            load_row_bf16raw(LAT + (size_t)fa_ * D, C.lane, nla); load_row_bf16raw(LAT + (size_t)(fa_ + 1) * D, C.lane, nlb); \
            load_row_fp8raw(Y8 + (size_t)(sb[(ts_).x >> 20] + ((ts_).x & 0xfffff)) * D, C.lane, nya0); load_row_fp8raw(Y8 + (size_t)(sb[(ts_).y >> 20] + ((ts_).y & 0xfffff)) * D, C.lane, nya1); \
            load_row_fp8raw(Y8 + (size_t)(sb[(ts_).z >> 20] + ((ts_).z & 0xfffff)) * D, C.lane, nyb0); load_row_fp8raw(Y8 + (size_t)(sb[(ts_).w >> 20] + ((ts_).w & 0xfffff)) * D, C.lane, nyb1); } while (0)
        { const int r0 = min(rfirst, rlast), r1 = min(rfirst + 2 * NW, rlast);
          ts1 = *(const i32x4r*)(TS + r0 * 2); tw1 = *(const f32x4*)(TW + r0 * 2); ts2 = *(const i32x4r*)(TS + r1 * 2); tw2 = *(const f32x4*)(TW + r1 * 2); }
        FIN_FETCH(min(rfirst, rlast), ts1);
        for (int ra = rfirst; ra < sbnd; ra += 2 * NW) {
            const int rb = ra + 1;
            u32x2 la[4], lb[4]; unsigned ya0[4], ya1[4], yb0[4], yb1[4];
#pragma unroll
            for (int q = 0; q < 4; ++q) { la[q] = nla[q]; lb[q] = nlb[q]; ya0[q] = nya0[q]; ya1[q] = nya1[q]; yb0[q] = nyb0[q]; yb1[q] = nyb1[q]; }
            const f32x4 twc = tw1;
            ts1 = ts2; tw1 = tw2;
            { const int r2 = min(ra + 4 * NW, rlast); ts2 = *(const i32x4r*)(TS + r2 * 2); tw2 = *(const f32x4*)(TW + r2 * 2); }
            FIN_FETCH(min(ra + 2 * NW, rlast), ts1);
            const float wa0 = twc.x * (1.0f / YSCALE), wa1 = twc.y * (1.0f / YSCALE), wb0 = twc.z * (1.0f / YSCALE), wb1 = twc.w * (1.0f / YSCALE);
            f32x4 va[4], vb[4];
#pragma unroll
            for (int q = 0; q < 4; ++q) { va[q] = bf4(la[q]) + g2[q] * (fp8x4(ya0[q]) * wa0 + fp8x4(ya1[q]) * wa1); vb[q] = bf4(lb[q]) + g2[q] * (fp8x4(yb0[q]) * wb0 + fp8x4(yb1[q]) * wb1); }
            const float rra = row_rstd(va), rrb = row_rstd(vb);
#pragma unroll
            for (int q = 0; q < 4; ++q) { *(f32x4*)(A.out + (size_t)ra * D + 4 * C.lane + 256 * q) = (va[q] * rra) * fg[q]; *(f32x4*)(A.out + (size_t)rb * D + 4 * C.lane + 256 * q) = (vb[q] * rrb) * fg[q]; }
        }
#undef FIN_FETCH
        sa = sbnd;
    }
}

__device__ __forceinline__ void phase_conv(const Args& A, const Ctx& C, int l) {
    const int j = l >> 1; const int nrows = (l <= 1) ? NR : NL;
    const bf16* P = (const bf16*)(A.ws + WS_PB); unsigned char* HM = A.ws + WS_HM; float* RSC = (float*)(A.ws + WS_RSC);
    const float* cw = A.in[13] + (size_t)j * 3 * D;
    f32x4 w0[4], w1[4], w2[4];
    load_row_f32(cw, C.lane, w0); load_row_f32(cw + D, C.lane, w1); load_row_f32(cw + 2 * D, C.lane, w2);
    const int rpw = (((nrows + C.G - 1) / C.G) + 1) & ~1; const int wrow0 = C.bid * rpw; const int wend = min(wrow0 + rpw, nrows);
    for (int ra = wrow0 + 2 * C.wave; ra < wend; ra += 2 * NW) {
        const int rb = ra + 1;
        const int ta = ra < NL ? (ra & 63) : ((ra - NL) & 255), tb1 = rb < NL ? (rb & 63) : ((rb - NL) & 255), tlast = ra < NL ? 63 : 255;
        const bool hasl = ta != 0, hasr = tb1 != tlast;
        const bf16* pa = P + (size_t)ra * PW;
        u32x2 bga[4], bgb[4], zm[4], z0[4], z1[4], z2[4];
        load_row_bf16raw(pa, C.lane, bga); load_row_bf16raw(pa + PW, C.lane, bgb);
        load_row_bf16raw(pa + D, C.lane, z0); load_row_bf16raw(pa + PW + D, C.lane, z1);
        load_row_bf16raw(hasl ? pa - PW + D : pa + D, C.lane, zm); load_row_bf16raw(hasr ? pa + 2 * PW + D : pa + D, C.lane, z2);
        const float fl = hasl ? 1.f : 0.f, fr = hasr ? 1.f : 0.f;
        f32x4 oa[4], ob[4];
#pragma unroll
        for (int q = 0; q < 4; ++q) { const f32x4 a0 = bf4(z0[q]), a1 = bf4(z1[q]);
            oa[q] = bf4(bga[q]) * (w0[q] * (bf4(zm[q]) * fl) + w1[q] * a0 + w2[q] * a1);
            ob[q] = bf4(bgb[q]) * (w0[q] * a0 + w1[q] * a1 + w2[q] * (bf4(z2[q]) * fr)); }
        float ma = 0.f, mb = 0.f;
#pragma unroll
        for (int q = 0; q < 4; ++q) { ma = fmaxf(ma, fmaxf(fmaxf(fabsf(oa[q].x), fabsf(oa[q].y)), fmaxf(fabsf(oa[q].z), fabsf(oa[q].w)))); mb = fmaxf(mb, fmaxf(fmaxf(fabsf(ob[q].x), fabsf(ob[q].y)), fmaxf(fabsf(ob[q].z), fabsf(ob[q].w)))); }
        ma = fmaxf(wave_max_nn(ma), 1.0e-20f); mb = fmaxf(wave_max_nn(mb), 1.0e-20f);
        const float ia = 127.0f / ma, ib = 127.0f / mb;
#pragma unroll
        for (int q = 0; q < 4; ++q) { *(unsigned*)(HM + (size_t)ra * D + 4 * C.lane + 256 * q) = pack_i8_nc(oa[q] * ia); *(unsigned*)(HM + (size_t)rb * D + 4 * C.lane + 256 * q) = pack_i8_nc(ob[q] * ib); }
        if (C.lane == 0) { RSC[ra] = ma * (1.0f / 127.0f); RSC[rb] = mb * (1.0f / 127.0f); }
    }
}

constexpr int BM = 256, BK = 64, HALF = 128, HTB = HALF * BK * 2, STAGE_BYTES = 8 * HTB, NXCD = 8, WGM = 8;
constexpr int LDS_TAB = STAGE_BYTES;
__device__ __forceinline__ int lds_byte(int r, int c) { const int st = (r >> 4) * 2 + (c >> 5), rr = r & 15, cc = c & 31, ob = rr * 64 + cc * 2; return st * 1024 + (ob ^ (((ob >> 9) & 1) << 5)); }
__device__ __forceinline__ void stage_rc(int b, int& R, int& C) { const int st = b / 1024, sb = b % 1024, swz = sb ^ (((sb >> 9) & 1) << 5); R = (st >> 1) * 16 + swz / 64; C = (st & 1) * 32 + (swz % 64) / 2; }
__device__ __forceinline__ int perm32(int rho) { const int n = rho >> 4, i = rho & 15; return 8 * (i >> 2) + 4 * n + (i & 3); }
__device__ __forceinline__ unsigned cvt_pk_bf16(float lo, float hi) { unsigned r; asm volatile("v_cvt_pk_bf16_f32 %0, %1, %2" : "=v"(r) : "v"(lo), "v"(hi)); return r; }

struct GUnit { const char* a; const char* b; int orow, ocol, aux; };

typedef int i32x8 __attribute__((ext_vector_type(8)));
typedef int i32x4 __attribute__((ext_vector_type(4)));
template <class Epi, class Sched, bool GATHER, int OPM = 0>
__device__ __forceinline__ void gemm_phase(LAS unsigned char* lds, const int K, const Sched& S, const Epi& E) {
    const int tid = threadIdx.x, wid = __builtin_amdgcn_readfirstlane(tid >> 6), lane = tid & 63, wr = wid >> 2, wc = wid & 3, fr = lane & 15, fq = lane >> 4;
    constexpr bool FP8 = (OPM == 1), I8 = (OPM == 2);
    const int RB = (OPM != 0) ? K : 2 * K;
    const int nt = RB / (BK * 2);
    unsigned voffB[2], voA[2][2]; int Rr[2], Cc[2];
#pragma unroll
    for (int i = 0; i < 2; ++i) { int R, C; stage_rc(tid * 16 + i * 8192, R, C); const int Rb = (R & ~31) + perm32(R & 31); Rr[i] = R; Cc[i] = C;
        voffB[i] = (unsigned)(Rb * RB + C * 2);
        voA[0][i] = (unsigned)(R * RB + C * 2); voA[1][i] = (unsigned)((R + HALF) * RB + C * 2); }
    const size_t kstep = (size_t)(BK * 2);
    const size_t hstep = (size_t)HALF * RB;
    const unsigned ldsw = (unsigned)wid * 1024u;
    const unsigned ldsbase = (unsigned)(size_t)lds;
    const int aoff = lds_byte(wr * 64 + fr, fq * 8), boff = lds_byte(wc * 32 + fr, fq * 8);
#define PG8_SA(b, h) (((b) * 2 + (h)) * HTB)
#define PG8_SB(b, h) ((4 + (b) * 2 + (h)) * HTB)
#define PG8_STAGE(bufoff, gbase, voff) do { _Pragma("unroll") for (int _i = 0; _i < 2; ++_i) \
        asm volatile("s_mov_b32 m0, %2\n\ts_nop 0\n\tglobal_load_lds_dwordx4 %0, %1" :: "v"((voff)[_i]), "s"((const char*)(gbase)), "s"(ldsbase + (unsigned)(bufoff) + ldsw + (unsigned)(_i * 8192)) : "memory"); } while (0)
#define PG8_STAGE_A1(bufoff, gbase) do { if constexpr (GATHER) PG8_STAGE(bufoff, gbase, voA[1]); else PG8_STAGE(bufoff, (const char*)(gbase) + hstep, voA[0]); } while (0)
#define PG8_LDA(dst, b, h) do { if constexpr (FP8) { _Pragma("unroll") for (int m = 0; m < 4; ++m) { \
        const i32x4 _lo = *(const LAS i32x4*)(lds + PG8_SA(b, h) + aoff + m * 2048), _hi = *(const LAS i32x4*)(lds + PG8_SA(b, h) + aoff + m * 2048 + 1024); \
        dst##8[m] = __builtin_shufflevector(_lo, _hi, 0, 1, 2, 3, 4, 5, 6, 7); } } \
      else { _Pragma("unroll") for (int m = 0; m < 4; ++m) _Pragma("unroll") for (int k = 0; k < 2; ++k) dst[m][k] = *(const LAS bf16x8*)(lds + PG8_SA(b, h) + aoff + m * 2048 + k * 1024); } } while (0)
#define PG8_LDB(dst, b, h) do { if constexpr (FP8) { _Pragma("unroll") for (int n = 0; n < 2; ++n) { \
        const i32x4 _lo = *(const LAS i32x4*)(lds + PG8_SB(b, h) + boff + n * 2048), _hi = *(const LAS i32x4*)(lds + PG8_SB(b, h) + boff + n * 2048 + 1024); \
        dst##8[n] = __builtin_shufflevector(_lo, _hi, 0, 1, 2, 3, 4, 5, 6, 7); } } \
      else { _Pragma("unroll") for (int n = 0; n < 2; ++n) _Pragma("unroll") for (int k = 0; k < 2; ++k) dst[n][k] = *(const LAS bf16x8*)(lds + PG8_SB(b, h) + boff + n * 2048 + k * 1024); } } while (0)
#define PG8_MMA(ai, bj, At, Bt) do { __builtin_amdgcn_s_setprio(1); \
        if constexpr (FP8) { _Pragma("unroll") for (int m = 0; m < 4; ++m) _Pragma("unroll") for (int n = 0; n < 2; ++n) \
            acc[ai][bj][m][n] = __builtin_amdgcn_mfma_scale_f32_16x16x128_f8f6f4(Bt##8[n], At##8[m], acc[ai][bj][m][n], 0, 0, 0, 0x7f7f7f7f, 0, 0x7f7f7f7f); } \
        else if constexpr (I8) { _Pragma("unroll") for (int m = 0; m < 4; ++m) _Pragma("unroll") for (int n = 0; n < 2; ++n) _Pragma("unroll") for (int k = 0; k < 2; ++k) \
            acc[ai][bj][m][n] = __builtin_bit_cast(f32x4, __builtin_amdgcn_mfma_i32_16x16x64_i8(__builtin_bit_cast(i32x4, Bt[n][k]), __builtin_bit_cast(i32x4, At[m][k]), __builtin_bit_cast(i32x4, acc[ai][bj][m][n]), 0, 0, 0)); } \
        else { _Pragma("unroll") for (int m = 0; m < 4; ++m) _Pragma("unroll") for (int n = 0; n < 2; ++n) _Pragma("unroll") for (int k = 0; k < 2; ++k) \
            acc[ai][bj][m][n] = __builtin_amdgcn_mfma_f32_16x16x32_bf16(Bt[n][k], At[m][k], acc[ai][bj][m][n], 0, 0, 0); } \
        __builtin_amdgcn_s_setprio(0); } while (0)
#define PG8_WAIT_V(n) asm volatile("s_waitcnt vmcnt(" #n ")" ::: "memory")
#define PG8_WAIT_L(n) asm volatile("s_waitcnt lgkmcnt(" #n ")" ::: "memory")
#define PG8_BAR __builtin_amdgcn_s_barrier()
#define PG8_SCHED __builtin_amdgcn_sched_barrier(0)
    GUnit cur, nxt; int ui = 0;
    if (!S.next(0, cur)) return;
    if constexpr (GATHER) {
#pragma unroll
        for (int h = 0; h < 2; ++h)
#pragma unroll
            for (int i = 0; i < 2; ++i) voA[h][i] = S.arow_off(0, h * HALF + Rr[i]) + (unsigned)Cc[i] * 2u;
    }
    f32x4 acc[2][2][4][2];
#pragma unroll
    for (int a = 0; a < 2; ++a)
#pragma unroll
        for (int b = 0; b < 2; ++b)
#pragma unroll
            for (int m = 0; m < 4; ++m)
#pragma unroll
                for (int n = 0; n < 2; ++n) acc[a][b][m][n] = (f32x4){0.f, 0.f, 0.f, 0.f};
    bf16x8 At[4][2], B0[2][2], B1[2][2]; i32x8 At8[4], B08[2], B18[2];
    const char* cA = cur.a; const char* cB = cur.b;
    PG8_STAGE(PG8_SB(0, 0), cB, voffB); PG8_STAGE(PG8_SB(0, 1), cB + hstep, voffB); PG8_STAGE(PG8_SA(0, 0), cA, voA[0]); PG8_STAGE_A1(PG8_SA(0, 1), cA);
    if (wr == 1) PG8_BAR;
    PG8_WAIT_V(2); PG8_BAR;
    PG8_STAGE(PG8_SB(1, 0), cB + kstep, voffB); PG8_STAGE(PG8_SA(1, 0), cA + kstep, voA[0]); PG8_STAGE(PG8_SB(1, 1), cB + hstep + kstep, voffB);
    PG8_WAIT_V(6); PG8_BAR;
    for (;;) {
        const bool has_next = S.next(ui + 1, nxt);
        const char* nA = has_next ? nxt.a : cA; const char* nB = has_next ? nxt.b : cB;
#pragma unroll 1
        for (int t = 0; t < nt; t += 2) {
            const bool last = (t == nt - 2);
            const char* a1 = cA + (size_t)(t + 1) * kstep;
            const char* a2 = last ? nA : cA + (size_t)(t + 2) * kstep; const char* b2 = last ? nB : cB + (size_t)(t + 2) * kstep;
            const char* a3 = a2 + kstep; const char* b3 = b2 + kstep;
            PG8_LDB(B0, 0, 0); PG8_LDB(B1, 0, 1); PG8_SCHED; PG8_LDA(At, 0, 0); PG8_STAGE_A1(PG8_SA(1, 1), a1);
            if constexpr (GATHER) { if (last && has_next) {
#pragma unroll
                for (int h = 0; h < 2; ++h)
#pragma unroll
                    for (int i = 0; i < 2; ++i) { int R2, C2; stage_rc(tid * 16 + i * 8192, R2, C2); voA[h][i] = S.arow_off(ui + 1, h * HALF + R2) + (unsigned)C2 * 2u; } } }
            PG8_WAIT_V(8); PG8_WAIT_L(0); PG8_BAR; PG8_MMA(0, 0, At, B0); PG8_MMA(0, 1, At, B1); PG8_BAR; PG8_SCHED;
            PG8_LDA(At, 0, 1); PG8_STAGE(PG8_SB(0, 0), b2, voffB); PG8_STAGE(PG8_SB(0, 1), b2 + hstep, voffB); PG8_STAGE(PG8_SA(0, 0), a2, voA[0]);
            PG8_WAIT_V(8); PG8_WAIT_L(0); PG8_BAR; PG8_MMA(1, 0, At, B0); PG8_MMA(1, 1, At, B1); PG8_BAR; PG8_SCHED;
            PG8_LDB(B0, 1, 0); PG8_LDB(B1, 1, 1); PG8_SCHED; PG8_LDA(At, 1, 0); PG8_STAGE_A1(PG8_SA(0, 1), a2);
            PG8_WAIT_V(8); PG8_WAIT_L(0); PG8_BAR; PG8_MMA(0, 0, At, B0); PG8_MMA(0, 1, At, B1); PG8_BAR; PG8_SCHED;
            PG8_LDA(At, 1, 1); PG8_STAGE(PG8_SB(1, 0), b3, voffB); PG8_STAGE(PG8_SB(1, 1), b3 + hstep, voffB); PG8_STAGE(PG8_SA(1, 0), a3, voA[0]);
            PG8_WAIT_V(8); PG8_WAIT_L(0); PG8_BAR; PG8_MMA(1, 0, At, B0); PG8_MMA(1, 1, At, B1); PG8_BAR; PG8_SCHED;
        }
        if (wr == 0) PG8_BAR;
        { int tz = threadIdx.x; asm volatile("" : "+v"(tz));
          if constexpr (I8) {
#pragma unroll
              for (int a_ = 0; a_ < 2; ++a_)
#pragma unroll
                  for (int b_ = 0; b_ < 2; ++b_)
#pragma unroll
                      for (int m = 0; m < 4; ++m)
#pragma unroll
                          for (int n = 0; n < 2; ++n) acc[a_][b_][m][n] = __builtin_convertvector(__builtin_bit_cast(i32x4, acc[a_][b_][m][n]), f32x4); }
          const int wz = tz >> 6, lz = tz & 63; E(acc, cur, wz >> 2, wz & 3, lz & 15, lz >> 4); }
        if (!has_next) break;
#pragma unroll
        for (int a = 0; a < 2; ++a)
#pragma unroll
            for (int b = 0; b < 2; ++b)
#pragma unroll
                for (int m = 0; m < 4; ++m)
#pragma unroll
                    for (int n = 0; n < 2; ++n) acc[a][b][m][n] = (f32x4){0.f, 0.f, 0.f, 0.f};
        cur = nxt; cA = nA; cB = nB; ++ui;
        if (wr == 1) PG8_BAR;
    }
    PG8_WAIT_V(0);
    PG8_BAR;
#undef PG8_SA
#undef PG8_SB
#undef PG8_STAGE
#undef PG8_STAGE_A1
#undef PG8_LDA
#undef PG8_LDB
#undef PG8_MMA
#undef PG8_WAIT_V
#undef PG8_WAIT_L
#undef PG8_BAR
#undef PG8_SCHED
}

__device__ __forceinline__ int xcd_remap(int L, int nwg) { const int q = nwg / NXCD, r = nwg % NXCD, xcd = L % NXCD, off = L / NXCD; return (xcd < r ? xcd * (q + 1) : r * (q + 1) + (xcd - r) * q) + off; }

struct DenseSched {
    const char* A; const char* Bt; int nM, nN, nwg, G, c; size_t tstep; int sw_lo, sw_hi;
    __device__ __forceinline__ void init(const void* A_, const void* Bt_, int M, int N, int K, int G_, int c_, int ebytes = 2) { A = (const char*)A_; Bt = (const char*)Bt_; nM = M / BM; nN = N / BM; nwg = nM * nN; G = G_; c = c_; tstep = (size_t)BM * K * ebytes; sw_lo = 0; sw_hi = 0; }
    __device__ __forceinline__ bool next(int i, GUnit& u) const {
        const long L = (long)i * G + c; if (L >= nwg) return false;
        const int wgid = xcd_remap((int)L, nwg);
        const int nig = WGM * nN, gid = wgid / nig, fm = gid * WGM, gsz = (nM - fm) < WGM ? (nM - fm) : WGM;
        const int pm = fm + ((wgid % nig) % gsz), pn = (wgid % nig) / gsz;
        if (pn >= sw_lo && pn < sw_hi) { u.a = Bt + (size_t)pn * tstep; u.b = A + (size_t)pm * tstep; u.orow = pm; u.ocol = pn - sw_lo; u.aux = 1; }
        else { u.a = A + (size_t)pm * tstep; u.b = Bt + (size_t)pn * tstep; u.orow = pm * BM; u.ocol = pn * BM; u.aux = 0; }
        return true;
    }
    __device__ __forceinline__ unsigned arow_off(int, int) const { return 0u; }
};

constexpr int MAXU = 12;
struct MoeTab { int n; int e[MAXU], mb[MAXU], nt[MAXU]; int sb[NE + 1]; };
struct MoeSched {
    LAS const MoeTab* T; LAS const unsigned* ridx;
    const char* A; const char* W; size_t wstride_e, tstepB; int K; int arow_bytes;
    __device__ __forceinline__ bool next(int i, GUnit& u) const {
        const int n = __builtin_amdgcn_readfirstlane(T->n); if (i >= n) return false;
        const int e = __builtin_amdgcn_readfirstlane(T->e[i]), mb = __builtin_amdgcn_readfirstlane(T->mb[i]), nt = __builtin_amdgcn_readfirstlane(T->nt[i]);
        const int base = __builtin_amdgcn_readfirstlane(T->sb[e]);
        u.orow = base + mb * BM; u.ocol = nt; u.aux = e;
        u.a = A + (size_t)u.orow * arow_bytes;
        u.b = W + (size_t)e * wstride_e + (size_t)nt * tstepB; return true;
    }
    __device__ __forceinline__ unsigned arow_off(int i, int r) const { return ridx[i * 256 + r]; }
};
template <bool GATHER>
__device__ __forceinline__ void moe_tables(const Args& A, const Ctx& C, int l, int ntile_n, LAS MoeTab* T, LAS unsigned* ridx, int arow_bytes) {
    const unsigned* cnt = (const unsigned*)(A.ws + WS_CTL) + CW_CNT + l * 32 * CNT_STRIDE;
    LAS int* ust = (LAS int*)(T + 1);
    LAS int* cntv = ust + 33;
    if (C.tid < 64) { int nb; const int ex = expert_block_prefix(cnt, C.tid, nb); if (C.tid <= NE) { T->sb[C.tid] = ex * 256; ust[C.tid] = ex * ntile_n; } if (C.tid < NE) cntv[C.tid] = (int)cnt[C.tid * CNT_STRIDE]; }
    __syncthreads();
    if (C.tid < MAXU) { const int nwg = ust[NE]; const long L = (long)C.tid * C.G + C.bid;
        if (L < nwg) { const int w = xcd_remap((int)L, nwg); int e = 0; while (w >= ust[e + 1]) ++e;
            const int lu = w - ust[e]; T->e[C.tid] = e; T->mb[C.tid] = lu / ntile_n; T->nt[C.tid] = lu % ntile_n; } }
    if (C.tid == 0) { const int nwg = ust[NE]; int n = 0; while (n < MAXU && (long)n * C.G + C.bid < nwg) ++n; T->n = n; }
    __syncthreads();
    if constexpr (GATHER) {
        const int* ST = (const int*)(A.ws + WS_SLOTTOK); const int n = T->n;
        for (int i = C.tid; i < n * 256; i += NT) { const int ui = i >> 8, r = i & 255, e = T->e[ui], m0 = T->mb[ui] * 256, ce = cntv[e];
            const int rr = (m0 + r < ce) ? m0 + r : ce - 1;
            ridx[i] = (unsigned)ST[(size_t)e * CAP + rr] * (unsigned)arow_bytes; }
        __syncthreads();
    }
}

struct EpiStore { bf16* O; int ldc; float scale_lo; int sig_from; bf16* VT; float sall = 1.0f; const float* rs = nullptr;
    __device__ __forceinline__ void operator()(const f32x4 (&acc)[2][2][4][2], const GUnit& u, int wr, int wc, int fr, int fq) const {
        const bool tr = u.aux != 0;
        const float sc = ((!tr && u.ocol < NQ) ? scale_lo : 1.0f) * sall; const bool sg = !tr && u.ocol >= sig_from;
        bf16* Ob = tr ? VT + (size_t)(u.orow * NH + u.ocol) * 65536 : O + (size_t)u.orow * ldc + u.ocol; const int ld = tr ? 256 : ldc;
        f32x4 cs[2][2];
#pragma unroll
        for (int bj = 0; bj < 2; ++bj) { const f32x4 one = (f32x4){1.f, 1.f, 1.f, 1.f};
            cs[bj][0] = (rs && tr) ? *(const f32x4*)(rs + u.orow * BM + bj * HALF + wc * 32 + 8 * fq) : one; cs[bj][1] = (rs && tr) ? *(const f32x4*)(rs + u.orow * BM + bj * HALF + wc * 32 + 8 * fq + 4) : one; }
#pragma unroll
        for (int ai = 0; ai < 2; ++ai)
#pragma unroll
            for (int m = 0; m < 4; ++m) { const int rl = ai * HALF + wr * 64 + m * 16 + fr; bf16* rowp = tr ? Ob + wc * 8192 + rl * 32 + 8 * fq : Ob + (size_t)rl * ld + wc * 32 + 8 * fq;

                const float scr = (rs && !tr) ? sc * rs[u.orow + rl] : sc;
#pragma unroll
                for (int bj = 0; bj < 2; ++bj) { f32x4 v0 = acc[ai][bj][m][0] * scr * cs[bj][0], v1 = acc[ai][bj][m][1] * scr * cs[bj][1];
                    if (sg) {
#pragma unroll
                        for (int q = 0; q < 4; ++q) { v0[q] = __builtin_amdgcn_rcpf(1.0f + __expf(-v0[q])); v1[q] = __builtin_amdgcn_rcpf(1.0f + __expf(-v1[q])); } }
                    u32x4 w; w.x = cvt_pk_bf16(v0[0], v0[1]); w.y = cvt_pk_bf16(v0[2], v0[3]); w.z = cvt_pk_bf16(v1[0], v1[1]); w.w = cvt_pk_bf16(v1[2], v1[3]);
                    *(u32x4*)(rowp + (tr ? bj * 4 * 8192 : bj * HALF)) = w; } }
    }
};
__device__ __forceinline__ u32x2 cvt8_fp8(f32x4 a, f32x4 b) { int lo = 0, hi = 0;
    lo = __builtin_amdgcn_cvt_pk_fp8_f32(a[0], a[1], lo, false); lo = __builtin_amdgcn_cvt_pk_fp8_f32(a[2], a[3], lo, true);
    hi = __builtin_amdgcn_cvt_pk_fp8_f32(b[0], b[1], hi, false); hi = __builtin_amdgcn_cvt_pk_fp8_f32(b[2], b[3], hi, true); return (u32x2){(unsigned)lo, (unsigned)hi}; }
struct EpiSwigluF8 { unsigned char* O; int ldc; float s;
    __device__ __forceinline__ void operator()(const f32x4 (&acc)[2][2][4][2], const GUnit& u, int wr, int wc, int fr, int fq) const {
        const int ocol = u.ocol * HALF;
#pragma unroll
        for (int ai = 0; ai < 2; ++ai)
#pragma unroll
            for (int m = 0; m < 4; ++m) { unsigned char* rowp = O + (size_t)(u.orow + ai * HALF + wr * 64 + m * 16 + fr) * ldc + ocol + wc * 32 + 8 * fq;
                f32x4 v0, v1;
#pragma unroll
                for (int q = 0; q < 4; ++q) { const float x0 = acc[ai][0][m][0][q] * s, x1 = acc[ai][0][m][1][q] * s;
                    v0[q] = x0 * __builtin_amdgcn_rcpf(1.0f + __expf(-x0)) * (acc[ai][1][m][0][q] * s); v1[q] = x1 * __builtin_amdgcn_rcpf(1.0f + __expf(-x1)) * (acc[ai][1][m][1][q] * s); }
                *(u32x2*)rowp = cvt8_fp8(v0, v1); }
    }
};
template <int MODE> struct EpiPair { bf16* O; int ldc; int plain_below; float sall = 1.0f; const float* rs = nullptr;
    __device__ __forceinline__ void operator()(const f32x4 (&acc)[2][2][4][2], const GUnit& u, int wr, int wc, int fr, int fq) const {
        if (MODE == 0 && u.ocol < plain_below) {
#pragma unroll
            for (int ai = 0; ai < 2; ++ai)
#pragma unroll
                for (int m = 0; m < 4; ++m) { const int rg = u.orow + ai * HALF + wr * 64 + m * 16 + fr; bf16* rowp = O + (size_t)rg * ldc + u.ocol + wc * 32 + 8 * fq;
                    const float scr = rs ? sall * rs[rg] : sall;
#pragma unroll
                    for (int bj = 0; bj < 2; ++bj) { const f32x4 v0 = acc[ai][bj][m][0] * scr, v1 = acc[ai][bj][m][1] * scr;
                        u32x4 w; w.x = cvt_pk_bf16(v0[0], v0[1]); w.y = cvt_pk_bf16(v0[2], v0[3]); w.z = cvt_pk_bf16(v1[0], v1[1]); w.w = cvt_pk_bf16(v1[2], v1[3]);
                        *(u32x4*)(rowp + bj * HALF) = w; } }
            return;
        }
        const int ocol = (MODE == 0) ? plain_below + (u.ocol - plain_below) / 2 : u.ocol * HALF;
#pragma unroll
        for (int ai = 0; ai < 2; ++ai)
#pragma unroll
            for (int m = 0; m < 4; ++m) { const int rg = u.orow + ai * HALF + wr * 64 + m * 16 + fr; bf16* rowp = O + (size_t)rg * ldc + ocol + wc * 32 + 8 * fq;
                const float scr = rs ? sall * rs[rg] : sall; const float sc2 = scr * scr;
                f32x4 v0, v1;
#pragma unroll
                for (int q = 0; q < 4; ++q) {
                    const float x0 = acc[ai][0][m][0][q], x1 = acc[ai][0][m][1][q];
                    const float g0 = (MODE == 1) ? x0 * __builtin_amdgcn_rcpf(1.0f + __expf(-x0)) : x0, g1 = (MODE == 1) ? x1 * __builtin_amdgcn_rcpf(1.0f + __expf(-x1)) : x1;
                    v0[q] = g0 * acc[ai][1][m][0][q] * sc2; v1[q] = g1 * acc[ai][1][m][1][q] * sc2; }
                u32x4 w; w.x = cvt_pk_bf16(v0[0], v0[1]); w.y = cvt_pk_bf16(v0[2], v0[3]); w.z = cvt_pk_bf16(v1[0], v1[1]); w.w = cvt_pk_bf16(v1[2], v1[3]);
                *(u32x4*)rowp = w; }
    }
};
struct EpiResid { bf16* LAT; const float* g1; float sall; const float* rs;
    __device__ __forceinline__ void operator()(const f32x4 (&acc)[2][2][4][2], const GUnit& u, int wr, int wc, int fr, int fq) const {
        bf16* Ob = LAT + (size_t)u.orow * D + u.ocol + wc * 32 + 8 * fq;
        u32x4 old[2][4][2];
#pragma unroll
        for (int ai = 0; ai < 2; ++ai)
#pragma unroll
            for (int m = 0; m < 4; ++m)
#pragma unroll
                for (int bj = 0; bj < 2; ++bj) old[ai][m][bj] = *(const u32x4*)(Ob + (size_t)(ai * HALF + wr * 64 + m * 16 + fr) * D + bj * HALF);
        const float* gv = g1 + (size_t)mod_vec_of_row(u.orow) * 6 * D + u.ocol + wc * 32 + 8 * fq;
        f32x4 g[2][2];
#pragma unroll
        for (int bj = 0; bj < 2; ++bj) { g[bj][0] = *(const f32x4*)(gv + bj * HALF); g[bj][1] = *(const f32x4*)(gv + bj * HALF + 4); }
#pragma unroll
        for (int ai = 0; ai < 2; ++ai)
#pragma unroll
            for (int m = 0; m < 4; ++m) { const int rl = ai * HALF + wr * 64 + m * 16 + fr; bf16* rowp = Ob + (size_t)rl * D;
                const float scr = rs ? sall * rs[u.orow + rl] : sall;
#pragma unroll
                for (int bj = 0; bj < 2; ++bj) { const u32x4 o = old[ai][m][bj];
                    const f32x4 v0 = bf4((u32x2){o.x, o.y}) + g[bj][0] * (acc[ai][bj][m][0] * scr), v1 = bf4((u32x2){o.z, o.w}) + g[bj][1] * (acc[ai][bj][m][1] * scr);
                    u32x4 w; w.x = cvt_pk_bf16(v0[0], v0[1]); w.y = cvt_pk_bf16(v0[2], v0[3]); w.z = cvt_pk_bf16(v1[0], v1[1]); w.w = cvt_pk_bf16(v1[2], v1[3]);
                    *(u32x4*)(rowp + bj * HALF) = w; } }
    }
};
struct EpiStoreTile { unsigned char* O; int ldc; float s;
    __device__ __forceinline__ void operator()(const f32x4 (&acc)[2][2][4][2], const GUnit& u, int wr, int wc, int fr, int fq) const {
#pragma unroll
        for (int ai = 0; ai < 2; ++ai)
#pragma unroll
            for (int m = 0; m < 4; ++m) { unsigned char* rowp = O + (size_t)(u.orow + ai * HALF + wr * 64 + m * 16 + fr) * ldc + u.ocol * BM + wc * 32 + 8 * fq;
#pragma unroll
                for (int bj = 0; bj < 2; ++bj) *(u32x2*)(rowp + bj * HALF) = cvt8_fp8(acc[ai][bj][m][0] * s, acc[ai][bj][m][1] * s); }
    }
};

__device__ __forceinline__ void transpose_item(const float* W, int ldw, int K, bf16* WT, int drow0, int k0, int n0, LAS float* scr, int lane) {
#pragma unroll
    for (int i = 0; i < 32; ++i) { const int kk = 2 * i + (lane >> 5); scr[kk * 33 + (lane & 31)] = W[(size_t)(k0 + kk) * ldw + n0 + (lane & 31)]; }
    asm volatile("s_waitcnt lgkmcnt(0)" ::: "memory");
    const int c = lane & 7;
#pragma unroll
    for (int j = 0; j < 4; ++j) { const int n = (lane >> 3) + 8 * j; const LAS float* s = scr + (8 * c) * 33 + n;
        u32x4 o; o.x = pk2(s[0 * 33], s[1 * 33]); o.y = pk2(s[2 * 33], s[3 * 33]); o.z = pk2(s[4 * 33], s[5 * 33]); o.w = pk2(s[6 * 33], s[7 * 33]);
        *(u32x4*)(WT + (size_t)(drow0 + n) * K + k0 + 8 * c) = o; }
    asm volatile("s_waitcnt lgkmcnt(0)" ::: "memory");
}
__device__ __forceinline__ void transpose_item_fp8(const float* W, int ldw, int K, unsigned char* WT8, int drow0, int k0, int n0, LAS float* scr, int lane, float sc) {
#pragma unroll
    for (int i = 0; i < 32; ++i) { const int kk = 2 * i + (lane >> 5); scr[kk * 33 + (lane & 31)] = W[(size_t)(k0 + kk) * ldw + n0 + (lane & 31)]; }
    asm volatile("s_waitcnt lgkmcnt(0)" ::: "memory");
    const int n = lane >> 1, half = lane & 1; const LAS float* sp = scr + (32 * half) * 33 + n;
    unsigned char* dst = WT8 + (size_t)(drow0 + n) * K + k0 + 32 * half;
#pragma unroll
    for (int c = 0; c < 2; ++c) { u32x4 o;
#pragma unroll
        for (int q = 0; q < 4; ++q) { int p = 0; const LAS float* s4 = sp + (16 * c + 4 * q) * 33;
            p = __builtin_amdgcn_cvt_pk_fp8_f32(s4[0] * sc, s4[33] * sc, p, false); p = __builtin_amdgcn_cvt_pk_fp8_f32(s4[66] * sc, s4[99] * sc, p, true); o[q] = (unsigned)p; }
        *(u32x4*)(dst + 16 * c) = o; }
    asm volatile("s_waitcnt lgkmcnt(0)" ::: "memory");
}
__device__ __forceinline__ void transpose_item_i8(const float* W, int ldw, int K, unsigned char* WT8, int drow0, int k0, int n0, LAS float* scr, int lane, float inv) {
#pragma unroll
    for (int i = 0; i < 32; ++i) { const int kk = 2 * i + (lane >> 5); scr[kk * 33 + (lane & 31)] = W[(size_t)(k0 + kk) * ldw + n0 + (lane & 31)]; }
    asm volatile("s_waitcnt lgkmcnt(0)" ::: "memory");
    const int n = lane >> 1, half = lane & 1; const LAS float* sp = scr + (32 * half) * 33 + n;
    unsigned char* dst = WT8 + (size_t)(drow0 + n) * K + k0 + 32 * half;
#pragma unroll
    for (int c = 0; c < 2; ++c) { u32x4 o;
#pragma unroll
        for (int q = 0; q < 4; ++q) { const LAS float* s4 = sp + (16 * c + 4 * q) * 33; o[q] = pack_i8((f32x4){s4[0] * inv, s4[33] * inv, s4[66] * inv, s4[99] * inv}); }
        *(u32x4*)(dst + 16 * c) = o; }
    asm volatile("s_waitcnt lgkmcnt(0)" ::: "memory");
}
__device__ __forceinline__ int pair_row(int n, int which) { return (n >> 7) * 256 + (n & 127) + which * 128; }
constexpr float HMR = 6.0f;
__device__ __forceinline__ void phase_cvt_mixer(const Args& A, const Ctx& C) {
    const int gw = C.bid * NW + C.wave, NGW = C.G * NW;
    unsigned* wmax = (unsigned*)(A.ws + WS_CTL) + CW_WMAX;
    for (int m8 = 0; m8 < 8; ++m8) {
        const float* W = m8 < 2 ? A.in[8] + (size_t)m8 * D * PROJ : m8 < 4 ? A.in[12] + (size_t)(m8 - 2) * D * PW : m8 < 6 ? A.in[11] + (size_t)(m8 - 4) * D * D : A.in[14] + (size_t)(m8 - 6) * D * D;
        const size_t n4 = (size_t)D * (m8 < 2 ? PROJ : m8 < 4 ? PW : D) / 4;
        float mx = 0.f;
        for (size_t i0 = (size_t)gw * 64 + C.lane; i0 < n4; i0 += (size_t)NGW * 64 * 8) {
            f32x4 v[8];
#pragma unroll
            for (int j = 0; j < 8; ++j) { const size_t i = i0 + (size_t)j * NGW * 64; v[j] = *(const f32x4*)(W + 4 * (i < n4 ? i : i0)); }
#pragma unroll
            for (int j = 0; j < 8; ++j) mx = fmaxf(mx, fmaxf(fmaxf(fabsf(v[j].x), fabsf(v[j].y)), fmaxf(fabsf(v[j].z), fabsf(v[j].w)))); }
        mx = wave_max_nn(mx);
        if (C.lane == 0 && mx > 0.f) atomicMax(wmax + m8 * CNT_STRIDE, __float_as_uint(mx));
    }
}
__device__ __forceinline__ void cvt_win_i8(const Args& A, const Ctx& C) {
    LAS float* scr = (LAS float*)(C.lds + 16384 + C.wave * 16384);
    const int gw = C.bid * NW + C.wave, NGW = C.G * NW;
    constexpr int I_IN = (D / 64) * (PW / 32);
    const unsigned* wmax = (const unsigned*)(A.ws + WS_CTL) + CW_WMAX;
    constexpr int I_OUT = (D / 64) * (D / 32);
    for (int it = gw; it < 4 * I_OUT; it += NGW) {
        const int m4 = it / I_OUT, kind = m4 >> 1, j = m4 & 1, r = it % I_OUT; const int kb = r / (D / 32), nb = r % (D / 32), n0 = nb * 32;
        const float inv = 127.0f / fmaxf(__uint_as_float(wmax[(4 + m4) * CNT_STRIDE]), 1.0e-30f);
        transpose_item_i8((kind == 0 ? A.in[11] : A.in[14]) + (size_t)j * D * D, D, D, A.ws + (kind == 0 ? WS_WAOUT : WS_WBOUT) + (size_t)j * D * D, n0, kb * 64, n0, scr, C.lane, inv); }
    for (int it = gw; it < 4 * I_IN; it += NGW) {
        const int m4 = it / I_IN, kind = m4 >> 1, j = m4 & 1, r = it % I_IN; const int kb = r / (PW / 32), nb = r % (PW / 32), n0 = nb * 32;
        const float inv = 127.0f / fmaxf(__uint_as_float(wmax[m4 * CNT_STRIDE]), 1.0e-30f);
        unsigned char* WT = A.ws + (kind == 0 ? WS_WAIN : WS_WBIN) + (size_t)j * PW * D;
        if (kind == 0) transpose_item_i8(A.in[8] + (size_t)j * D * PROJ, PROJ, D, WT, n0, kb * 64, n0, scr, C.lane, inv);
        else { const int drow = n0 < D ? n0 : (n0 < 2 * D ? D + pair_row(n0 - D, 0) : D + pair_row(n0 - 2 * D, 1));
            transpose_item_i8(A.in[12] + (size_t)j * D * PW, PW, D, WT, drow, kb * 64, n0, scr, C.lane, inv); }
    }
}
__device__ __forceinline__ void cvt_moe_items(const Args& A, const Ctx& C, int l, int it0, int end, int stride) {
    LAS float* scr = (LAS float*)(C.lds + 16384 + C.wave * 16384);
    unsigned char* WGU = A.ws + WS_WGU; unsigned char* WDN = A.ws + WS_WDN;
    for (int it = it0; it < end; it += stride) {
        const int e = it / CVT_PER; int r = it % CVT_PER;
        if (r < 2 * CVT_IG) { const int which = r / CVT_IG; r %= CVT_IG; const int kb = r / (DE / 32), nb = r % (DE / 32), n0 = nb * 32;
            transpose_item_fp8((which == 0 ? A.in[19] : A.in[20]) + ((size_t)l * NE + e) * D * DE, DE, D, WGU + (size_t)e * 2 * DE * D, pair_row(n0, which), kb * 64, n0, scr, C.lane, WSCALE); }
        else { r -= 2 * CVT_IG; const int kb = r / (D / 32), nb = r % (D / 32), n0 = nb * 32;
            transpose_item_fp8(A.in[21] + ((size_t)l * NE + e) * DE * D, D, DE, WDN + (size_t)e * D * DE, n0, kb * 64, n0, scr, C.lane, WSCALE); }
    }
}
__device__ __forceinline__ int cvt_idle(int nunits, int G) { const int rem = nunits % G; return rem ? G - rem : 0; }
__device__ __forceinline__ int cvt_t1(int l, int G) { const int n = cvt_idle((((l <= 2) ? NR : NL) / BM) * (PW / BM), G) * CVT_Q; return n < CVT_ITEMS ? n : CVT_ITEMS; }
__device__ __forceinline__ int cvt_t2(int l, int G) { const int n = cvt_t1(l, G) + cvt_idle((((l <= 1) ? NR : NL) / BM) * (D / BM), G) * CVT_Q; return n < CVT_ITEMS ? n : CVT_ITEMS; }
__device__ __forceinline__ void cvt_moe_tail(const Args& A, const Ctx& C, int l, int nunits, int base, int end) {
    const int rem = nunits % C.G;
    if (rem == 0 || C.bid < rem) return;
    const int first = base + (C.bid - rem) * CVT_Q; const int last = min(first + CVT_Q, end);
    cvt_moe_items(A, C, l, first + C.wave, last, NW);
}

__device__ __forceinline__ void phase_g1(const Args& A, const Ctx& C, int l) {
    const bool mls = (l & 1) == 0; const int j = l >> 1; const int nrows = (l <= 2) ? NR : NL;
    DenseSched S; S.init(A.ws + WS_H8, A.ws + (mls ? WS_WAIN : WS_WBIN) + (size_t)j * PW * D, nrows, PW, D, C.G, C.bid, 1);
    const float wsc = __uint_as_float(((const unsigned*)(A.ws + WS_CTL))[CW_WMAX + ((mls ? 0 : 2) + j) * CNT_STRIDE]) * (1.0f / 127.0f);
    const float* rs = (const float*)(A.ws + WS_RSC);
    if (mls) { S.sw_lo = 4; S.sw_hi = 8; EpiStore E{(bf16*)(A.ws + WS_PB), PW, 0.08838834764831845f, 2 * NQ + NV, (bf16*)(A.ws + WS_VT), wsc, rs}; gemm_phase<EpiStore, DenseSched, false, 2>(C.lds, D, S, E); }
    else { EpiPair<0> E{(bf16*)(A.ws + WS_PB), PW, D, wsc, rs}; gemm_phase<EpiPair<0>, DenseSched, false, 2>(C.lds, D, S, E); }
    cvt_moe_tail(A, C, l, S.nwg, 0, cvt_t1(l, C.G));
}
__device__ __forceinline__ void phase_g2(const Args& A, const Ctx& C, int l) {
    const bool mls = (l & 1) == 0; const int j = l >> 1; const int nrows = (l <= 1) ? NR : NL;
    DenseSched S; S.init(A.ws + WS_HM, A.ws + (mls ? WS_WAOUT : WS_WBOUT) + (size_t)j * D * D, nrows, D, D, C.G, C.bid, 1);
    const float wsc = __uint_as_float(((const unsigned*)(A.ws + WS_CTL))[CW_WMAX + (4 + (mls ? 0 : 2) + j) * CNT_STRIDE]) * (1.0f / 127.0f);
    EpiResid E{(bf16*)(A.ws + WS_LAT), (const float*)(A.ws + WS_MOD) + (size_t)(l * 3) * 6 * D + 2 * D, mls ? wsc * (HMR / 127.0f) : wsc, mls ? nullptr : (const float*)(A.ws + WS_RSC)}; gemm_phase<EpiResid, DenseSched, false, 2>(C.lds, D, S, E);
    cvt_moe_tail(A, C, l, S.nwg, cvt_t1(l, C.G), cvt_t2(l, C.G));
}
__device__ __forceinline__ void phase_m1(const Args& A, const Ctx& C, int l) {
    LAS MoeTab* T = (LAS MoeTab*)(C.lds + LDS_TAB); LAS unsigned* ridx = (LAS unsigned*)(C.lds + LDS_TAB + 1024);
    moe_tables<true>(A, C, l, 4, T, ridx, D);
    MoeSched S; S.T = T; S.ridx = ridx; S.A = (const char*)(A.ws + WS_H8); S.W = (const char*)(A.ws + WS_WGU); S.wstride_e = (size_t)2 * DE * D; S.tstepB = (size_t)BM * D; S.K = D; S.arow_bytes = 0;
    EpiSwigluF8 E{A.ws + WS_DC, DE, 1.0f / WSCALE}; gemm_phase<EpiSwigluF8, MoeSched, true, 1>(C.lds, D, S, E);
}
__device__ __forceinline__ void phase_m2(const Args& A, const Ctx& C, int l) {
    LAS MoeTab* T = (LAS MoeTab*)(C.lds + LDS_TAB); LAS unsigned* ridx = (LAS unsigned*)(C.lds + LDS_TAB + 1024);
    moe_tables<false>(A, C, l, 4, T, ridx, DE);
    MoeSched S; S.T = T; S.ridx = ridx; S.A = (const char*)(A.ws + WS_DC); S.W = (const char*)(A.ws + WS_WDN); S.wstride_e = (size_t)D * DE; S.tstepB = (size_t)BM * DE; S.K = DE; S.arow_bytes = DE;
    EpiStoreTile E{A.ws + WS_PB, D, YSCALE / WSCALE}; gemm_phase<EpiStoreTile, MoeSched, false, 1>(C.lds, DE, S, E);
}

typedef float f32x16 __attribute__((ext_vector_type(16)));
#define MFMA32(a, b, c) __builtin_amdgcn_mfma_f32_32x32x16_bf16((a), (b), (c), 0, 0, 0)
__device__ __forceinline__ bf16x8 pack8(float a0, float a1, float a2, float a3, float a4, float a5, float a6, float a7) {
    u32x4 p; p.x = cvt2(a0, a1); p.y = cvt2(a2, a3); p.z = cvt2(a4, a5); p.w = cvt2(a6, a7); return __builtin_bit_cast(bf16x8, p); }
__device__ __forceinline__ float bflo(unsigned w) { return __uint_as_float(w << 16); }
__device__ __forceinline__ float bfhi(unsigned w) { return __uint_as_float(w & 0xffff0000u); }
__device__ __forceinline__ int vt_tile(int b, int h, int blk) { return (blk == 0 ? 128 + b : b * 64 + blk - 1) * NH + h; }

__device__ __forceinline__ float wave_incl_scan(float v, int lane) {
#pragma unroll
    for (int o = 1; o < 64; o <<= 1) { const float t = __shfl_up(v, o); v += (lane >= o) ? t : 0.f; }
    return v;
}
__device__ __forceinline__ void block_gates(const Args& A, int row0, int h, LAS float* bf, LAS float* bb, LAS float* lif, LAS float* lib, int tid) {
    const float* GATE = (const float*)(A.ws + WS_GATE);
    if (tid < 256) { const float* g = GATE + (size_t)(row0 + tid) * 16; lif[tid] = g[0 + h]; bf[tid] = g[4 + h]; lib[tid] = g[8 + h]; bb[tid] = g[12 + h]; }
    __syncthreads();
    const int lane = tid & 63, wv = tid >> 6;
    if (wv == 0) { f32x4 x = *(LAS f32x4*)(bf + 4 * lane); x.y += x.x; x.z += x.y; x.w += x.z; const float tot = wave_incl_scan(x.w, lane); const float ex = tot - x.w;
        x.x += ex; x.y += ex; x.z += ex; x.w += ex; *(LAS f32x4*)(bf + 4 * lane) = x; }
    if (wv == 1) { f32x4 y = *(LAS f32x4*)(bb + 4 * (63 - lane)); y.z += y.w; y.y += y.z; y.x += y.y; const float tot = wave_incl_scan(y.x, lane); const float ex = tot - y.x;
        y.x += ex; y.y += ex; y.z += ex; y.w += ex; *(LAS f32x4*)(bb + 4 * (63 - lane)) = y; }
    __syncthreads();
}
__device__ __forceinline__ void phase_s1(const Args& A, const Ctx& C, int l) {
    LAS float* bf = (LAS float*)C.lds; LAS float* bb = bf + 256; LAS float* lif = bb + 256; LAS float* lib = lif + 256; LAS float* af = lib + 256; LAS float* ab = af + 256;
    constexpr int KP = 528;
    LAS unsigned char* KTf = C.lds + 8192; LAS unsigned char* KTb = KTf + 128 * KP;
    const bf16* P = (const bf16*)(A.ws + WS_PB); const bf16* VT = (const bf16*)(A.ws + WS_VT);
    bf16* DC = (bf16*)(A.ws + WS_DC); float* DN = (float*)(A.ws + WS_DN); float* BT = (float*)(A.ws + WS_BTOT);
    const int r = C.lane & 31, hh = C.lane >> 5, w = C.wave;
    for (int it = C.bid; it < BATCH * NH * (NBLK - 1) + 2 * BATCH * NH; it += C.G) {
        const bool isctx = it >= BATCH * NH * (NBLK - 1); const int ci_ = it - BATCH * NH * (NBLK - 1);
        const int bh = isctx ? (ci_ >> 1) : it / (NBLK - 1), blk = isctx ? 0 : 1 + it % (NBLK - 1), h = bh % NH, b = bh / NH; const int u = bh * NBLK + blk; const int row0 = blk_row0(b, blk);
        const int dlo = isctx ? (ci_ & 1) : 0, dhi = isctx ? (ci_ & 1) + 1 : 2;
        block_gates(A, row0, h, bf, bb, lif, lib, C.tid);
        if (C.tid < 256) { af[C.tid] = __expf(bf[255] - bf[C.tid] + lif[C.tid]); ab[C.tid] = __expf(bb[0] - bb[C.tid] + lib[C.tid]); }
        if (C.tid == 0) { BT[u * 2 + 0] = bf[255]; BT[u * 2 + 1] = bb[0]; }
        __syncthreads();
        { const int sp = C.tid >> 2, dq = C.tid & 3, s0 = 2 * sp;
          const bf16* k0 = P + (size_t)(row0 + s0) * PW + NQ + h * DQK + 32 * dq;
          const float f0 = af[s0], f1 = af[s0 + 1], g0 = ab[s0], g1 = ab[s0 + 1];
#pragma unroll
          for (int c = 0; c < 4; ++c) { const u32x4 x0 = *(const u32x4*)(k0 + 8 * c), x1 = *(const u32x4*)(k0 + PW + 8 * c);
#pragma unroll
              for (int q = 0; q < 4; ++q) { const int d = 32 * dq + 8 * c + 2 * q;
                  const float a0 = bflo(x0[q]), a1 = bfhi(x0[q]), c0 = bflo(x1[q]), c1 = bfhi(x1[q]);
                  *(LAS unsigned*)(KTf + d * KP + s0 * 2) = cvt2(a0 * f0, c0 * f1); *(LAS unsigned*)(KTf + (d + 1) * KP + s0 * 2) = cvt2(a1 * f0, c1 * f1);
                  *(LAS unsigned*)(KTb + d * KP + s0 * 2) = cvt2(a0 * g0, c0 * g1); *(LAS unsigned*)(KTb + (d + 1) * KP + s0 * 2) = cvt2(a1 * g0, c1 * g1); } } }
        __syncthreads();
        if (C.tid < 256) { const int dir = C.tid >> 7, d = C.tid & 127; LAS const unsigned* kr = (LAS const unsigned*)((dir ? KTb : KTf) + d * KP); float s = 0.f;
#pragma unroll 8
            for (int i = 0; i < 32; ++i) { const u32x4 x = *(LAS const u32x4*)(kr + 4 * i); s += ((bflo(x.x) + bfhi(x.x)) + (bflo(x.y) + bfhi(x.y))) + ((bflo(x.z) + bfhi(x.z)) + (bflo(x.w) + bfhi(x.w))); }
            DN[(size_t)(u * 2 + dir) * DQK + d] = s; }
        const bf16* vt = VT + (size_t)vt_tile(b, h, blk) * 65536 + (size_t)(32 * w + r) * 32 + 8 * hh;
        bf16x8 av[16];
#pragma unroll
        for (int ks = 0; ks < 16; ++ks) av[ks] = *(const bf16x8*)(vt + (ks >> 1) * 8192 + 16 * (ks & 1));
#pragma unroll 1
        for (int dir = dlo; dir < dhi; ++dir) {
            LAS const unsigned char* KT = dir ? KTb : KTf;
            f32x16 acc[4];
#pragma unroll
            for (int dt = 0; dt < 4; ++dt)
#pragma unroll
                for (int i = 0; i < 16; ++i) acc[dt][i] = 0.f;
#pragma unroll
            for (int ks = 0; ks < 16; ++ks) {
#pragma unroll
                for (int dt = 0; dt < 4; ++dt) { const bf16x8 b0 = *(const LAS bf16x8*)(KT + (dt * 32 + r) * KP + (16 * ks + 8 * hh) * 2); acc[dt] = MFMA32(av[ks], b0, acc[dt]); }
                if ((ks & 3) == 3) asm volatile("" ::: "memory"); }
            bf16* dc = DC + (size_t)(u * 2 + dir) * DQK * DV + (size_t)(32 * w + 4 * hh) * 32 + r;
#pragma unroll
            for (int g = 0; g < 4; ++g) { bf16* pf = dc + g * 8 * 32; asm volatile("" : "+v"(pf));
#pragma unroll
                for (int q = 0; q < 4; ++q)
#pragma unroll
                    for (int dt = 0; dt < 4; ++dt) pf[q * 32 + dt * 8192] = (bf16)f2bf(acc[dt][4 * g + q]); }
        }
        __syncthreads();
    }
}
__device__ __forceinline__ void phase_s2(const Args& A, const Ctx& C) {
    const bf16* __restrict__ DC = (const bf16*)(A.ws + WS_DC); const float* __restrict__ DN = (const float*)(A.ws + WS_DN); const float* __restrict__ BT = (const float*)(A.ws + WS_BTOT);
    bf16* __restrict__ CST = (bf16*)(A.ws + WS_CST); float* __restrict__ NST = (float*)(A.ws + WS_NST);
    constexpr int EL4 = DQK * DV / 4;
    for (int g = C.bid * NT + C.tid; g < BATCH * NH * 2 * EL4; g += C.G * NT) {
        const int e4 = (g % EL4) * 4, ch = g / EL4, dir = ch & 1, bh = ch >> 1;
        f32x4 st = (f32x4){0.f, 0.f, 0.f, 0.f};
        constexpr int PF = 16;
        u32x2 ring[PF]; float decr[PF];
#define S2_BLK(idx_) (dir == 0 ? (idx_) : ((idx_) == 0 ? 0 : NBLK - (idx_)))
#pragma unroll
        for (int i = 0; i < PF; ++i) { const int u = bh * NBLK + S2_BLK(i); ring[i] = *(const u32x2*)(DC + (size_t)(u * 2 + dir) * DQK * DV + e4); decr[i] = BT[u * 2 + dir]; }
#pragma unroll
        for (int idx = 0; idx < NBLK; ++idx) {
            const int u = bh * NBLK + S2_BLK(idx);
            const f32x4 dc = bf4(ring[idx % PF]); const float dec = __expf(decr[idx % PF]);
            if (idx + PF < NBLK) { const int u2 = bh * NBLK + S2_BLK(idx + PF); ring[idx % PF] = *(const u32x2*)(DC + (size_t)(u2 * 2 + dir) * DQK * DV + e4); decr[idx % PF] = BT[u2 * 2 + dir]; }
            u32x2 o; o.x = cvt2(st.x, st.y); o.y = cvt2(st.z, st.w);
            *(u32x2*)(CST + (size_t)(u * 2 + dir) * DQK * DV + e4) = o;
            st = st * dec + dc;
        }
#undef S2_BLK
    }
    if (C.wave == 0 && C.bid * 64 < BATCH * NH * 2 * DQK) {
        const int g = C.bid * 64 + C.lane; const int d = g % DQK, ch = g / DQK, dir = ch & 1, bh = ch >> 1; float st = 0.f;
        constexpr int PF = 16; float dnr[PF], btr[PF];
#define S2_BLK(idx_) (dir == 0 ? (idx_) : ((idx_) == 0 ? 0 : NBLK - (idx_)))
#pragma unroll
        for (int i = 0; i < PF; ++i) { const int u = bh * NBLK + S2_BLK(i); dnr[i] = DN[(size_t)(u * 2 + dir) * DQK + d]; btr[i] = BT[u * 2 + dir]; }
#pragma unroll
        for (int idx = 0; idx < NBLK; ++idx) {
            const int u = bh * NBLK + S2_BLK(idx);
            const float dn = dnr[idx % PF], dec = __expf(btr[idx % PF]);
            if (idx + PF < NBLK) { const int u2 = bh * NBLK + S2_BLK(idx + PF); dnr[idx % PF] = DN[(size_t)(u2 * 2 + dir) * DQK + d]; btr[idx % PF] = BT[u2 * 2 + dir]; }
            NST[(size_t)(u * 2 + dir) * DQK + d] = st; st = dec * st + dn;
        }
#undef S2_BLK
    }
}
__device__ __forceinline__ void lds_barrier() { asm volatile("s_waitcnt lgkmcnt(0)" ::: "memory"); __builtin_amdgcn_s_barrier(); asm volatile("" ::: "memory"); }
__device__ __forceinline__ void phase_s3(const Args& A, const Ctx& C, int l) {
    const int jl = l >> 1; const bool ctx_out = (l == 0);
    LAS float* bf = (LAS float*)C.lds; LAS float* bb = bf + 256; LAS float* gf = bb + 256; LAS float* gb = gf + 256;
    LAS float* nf = gb + 256; LAS float* nb = nf + 128; LAS float* ssx = nb + 128;
    LAS float* cf = ssx + 256; LAS float* cb = cf + 256;
    constexpr int KP = 272, OP = 528, CHB = 16384, NCHB = 4;
    LAS unsigned char* Kimg = C.lds + 8192;
    LAS unsigned char* CH = Kimg + 256 * KP;
    LAS unsigned char* OUT = Kimg;
    static_assert(8192 + 256 * KP + NCHB * CHB <= LDS_TAB_END && 8192 + 256 * OP <= LDS_TAB_END, "S3 LDS map");
    const bf16* P = (const bf16*)(A.ws + WS_PB); const bf16* VT = (const bf16*)(A.ws + WS_VT); unsigned char* HM = A.ws + WS_HM;
    const bf16* CST = (const bf16*)(A.ws + WS_CST); const float* NST = (const float*)(A.ws + WS_NST);
    const float* hg = A.in[10] + (size_t)jl * NV;
    const int w = C.wave;
    bf16x8 qf[8]; u32x4 kr8[8]; f32x4 gl;
#define S3_UNIT(it_) ((it_) < BATCH * NH * (NBLK - 1) ? ((it_) / (NBLK - 1)) * NBLK + 1 + (it_) % (NBLK - 1) : ((it_) - BATCH * NH * (NBLK - 1)) * NBLK)
#define S3_LOAD_IN(u_) do { const int u2_ = (u_); const int blk_ = u2_ % NBLK, bh_ = u2_ / NBLK, h_ = bh_ % NH, b_ = bh_ / NH; const int row0_ = blk_row0(b_, blk_); \
        int tq_ = threadIdx.x; asm volatile("" : "+v"(tq_)); const int lq_ = tq_ & 63; \
        { const bf16* qr_ = P + (size_t)(row0_ + 32 * w + (lq_ & 31)) * PW + h_ * DQK + 8 * (lq_ >> 5); \
          _Pragma("unroll") for (int kk = 0; kk < 8; ++kk) qf[kk] = *(const bf16x8*)(qr_ + 16 * kk); } \
        { const bf16* kr_ = P + (size_t)(row0_ + (tq_ >> 4)) * PW + NQ + h_ * DQK + 8 * (tq_ & 15); \
          _Pragma("unroll") for (int i = 0; i < 8; ++i) kr8[i] = *(const u32x4*)(kr_ + (size_t)(32 * i) * PW); } \
        if (tq_ < 256) { const float* g_ = (const float*)(A.ws + WS_GATE) + (size_t)(row0_ + tq_) * 16 + h_; gl = (f32x4){g_[0], g_[4], g_[8], g_[12]}; } \
        else { const int t2_ = tq_ - 256; gl = (f32x4){NST[(size_t)(u2_ * 2 + (t2_ >> 7)) * DQK + (t2_ & 127)], 0.f, 0.f, 0.f}; } } while (0)
    const int nitems = BATCH * NH * (NBLK - 1) + (ctx_out ? BATCH * NH : 0);
    int it = C.bid;
    if (it < nitems) S3_LOAD_IN(S3_UNIT(it));
    while (it < nitems) {
        const int u = S3_UNIT(it);
        const int blk = u % NBLK, bh = u / NBLK, h = bh % NH, b = bh / NH; const int row0 = blk_row0(b, blk);
        const int itn = it + C.G; const int un = itn < nitems ? S3_UNIT(itn) : u;
        const bf16* vtile = VT + (size_t)vt_tile(b, h, blk) * 65536;
        const bf16* ctile = CST + (size_t)(u * 2) * DQK * DV;
#define S3_DMA(c_) do { const int cc_ = (c_); const bool isv_ = cc_ < 8; int ld_ = threadIdx.x & 63; asm volatile("" : "+v"(ld_)); \
                const unsigned dlp_ = (unsigned)(((ld_ & 3) ^ ((ld_ >> 4) & 3)) * 16), drow_ = (unsigned)(32 * w + (ld_ >> 2)); \
                const unsigned long long gp_ = (unsigned long long)(isv_ ? (const char*)vtile + 16384 * cc_ : (const char*)ctile + (cc_ >= 12 ? 2 * DQK * DV : 0) + 16384 * ((cc_ - 8) & 3)); \
                const char* gb_ = (const char*)(((unsigned long long)(unsigned)__builtin_amdgcn_readfirstlane((int)(unsigned)(gp_ >> 32)) << 32) | (unsigned)__builtin_amdgcn_readfirstlane((int)(unsigned)gp_)); \
                _Pragma("unroll") for (int jj = 0; jj < 2; ++jj) \
                    asm volatile("s_mov_b32 m0, %2\n\ts_nop 0\n\tglobal_load_lds_dwordx4 %0, %1" :: "v"(((drow_ + 16u * jj) << 6) + dlp_), "s"(gb_), "s"((unsigned)(size_t)CH + (unsigned)w * 2048u + (unsigned)((cc_ & 3) * CHB + jj * 1024)) : "memory"); } while (0)
        S3_DMA(0); S3_DMA(1); S3_DMA(2);
        { int tu = threadIdx.x; asm volatile("" : "+v"(tu));
          if (tu < 256) { gf[tu] = gl.x; bf[tu] = gl.y; gb[tu] = gl.z; bb[tu] = gl.w; } else nf[tu - 256] = gl.x;
          { const int pc = tu & 15, s0 = tu >> 4, ps0 = (s0 & ~12) | ((s0 & 4) << 1) | ((s0 & 8) >> 1);
#pragma unroll
            for (int i = 0; i < 8; ++i) *(LAS u32x4*)(Kimg + (ps0 + 32 * i) * KP + pc * 16) = kr8[i]; }
          lds_barrier();
          const int lane = tu & 63, wv = tu >> 6;
          if (wv == 0) { f32x4 x = *(LAS f32x4*)(bf + 4 * lane); x.y += x.x; x.z += x.y; x.w += x.z; const float tot = wave_incl_scan(x.w, lane); const float ex = tot - x.w;
              x.x += ex; x.y += ex; x.z += ex; x.w += ex; *(LAS f32x4*)(bf + 4 * lane) = x; }
          if (wv == 1) { f32x4 y = *(LAS f32x4*)(bb + 4 * (63 - lane)); y.z += y.w; y.y += y.z; y.x += y.y; const float tot = wave_incl_scan(y.x, lane); const float ex = tot - y.x;
              y.x += ex; y.y += ex; y.z += ex; y.w += ex; *(LAS f32x4*)(bb + 4 * (63 - lane)) = y; }
          lds_barrier();
          if (tu < 256) { const float a0 = gf[tu] - bf[tu], a1 = gb[tu] - bb[tu]; gf[tu] = a0; gb[tu] = a1; cf[tu] = __expf(bf[tu | 31] + a0); cb[tu] = __expf(bb[tu & ~31] + a1); }
          lds_barrier(); }
        {
            int lz = threadIdx.x & 63; asm volatile("" : "+v"(lz));
            const int r = lz & 31, hh = lz >> 5;
            const int jt = w;
            const float bfj = bf[32 * jt + r], bbj = bb[32 * jt + r];
            float qnf = 0.f, qnb = 0.f;
#pragma unroll
            for (int kk = 0; kk < 8; ++kk) { u32x4 qq = __builtin_bit_cast(u32x4, qf[kk]); asm volatile("" : "+v"(qq));
                const int d = 16 * kk + 8 * hh;
                const f32x4 n0 = *(const LAS f32x4*)(nf + d), n1 = *(const LAS f32x4*)(nf + d + 4), m0 = *(const LAS f32x4*)(nb + d), m1 = *(const LAS f32x4*)(nb + d + 4);
                qnf += (bflo(qq.x) * n0.x + bfhi(qq.x) * n0.y) + (bflo(qq.y) * n0.z + bfhi(qq.y) * n0.w) + (bflo(qq.z) * n1.x + bfhi(qq.z) * n1.y) + (bflo(qq.w) * n1.z + bfhi(qq.w) * n1.w);
                qnb += (bflo(qq.x) * m0.x + bfhi(qq.x) * m0.y) + (bflo(qq.y) * m0.z + bfhi(qq.y) * m0.w) + (bflo(qq.z) * m1.x + bfhi(qq.z) * m1.y) + (bflo(qq.w) * m1.z + bfhi(qq.w) * m1.w);
                if (kk & 1) asm volatile("" ::: "memory"); }
            qnf += __shfl_xor(qnf, 32); qnb += __shfl_xor(qnb, 32);
            float denf = 0.f, denb = 0.f;
#pragma unroll 1
            for (int kt = 0; kt < 8; ++kt) {
                f32x16 c;
#pragma unroll
                for (int i = 0; i < 16; ++i) c[i] = 0.f;
#pragma unroll
                for (int kk = 0; kk < 8; ++kk) { const bf16x8 a = *(const LAS bf16x8*)(Kimg + (kt * 32 + r) * KP + (16 * kk + 8 * hh) * 2); c = MFMA32(a, qf[kk], c); }
                if (kt == jt) {
#pragma unroll
                    for (int g = 0; g < 4; ++g) { const int sl0 = 16 * (g >> 1) + 8 * hh + 4 * (g & 1);
                        const f32x4 g4f = *(const LAS f32x4*)(gf + kt * 32 + sl0), g4b = *(const LAS f32x4*)(gb + kt * 32 + sl0);
#pragma unroll
                        for (int q = 0; q < 4; ++q) { const int sl = sl0 + q; const float cv = c[4 * g + q];
                            denf += cv * __expf((sl <= r) ? bfj + g4f[q] : -1.0e30f); denb += cv * __expf((sl >= r) ? bbj + g4b[q] : -1.0e30f); } }
                } else {
                    LAS const float* cx = (kt < jt ? cf : cb) + kt * 32 + 8 * hh; float sm = 0.f;
#pragma unroll
                    for (int g = 0; g < 4; ++g) { const f32x4 c4 = *(const LAS f32x4*)(cx + 16 * (g >> 1) + 4 * (g & 1)); sm += (c[4 * g] * c4.x + c[4 * g + 1] * c4.y) + (c[4 * g + 2] * c4.z + c[4 * g + 3] * c4.w); }
                    if (kt < jt) denf += sm * __expf(bfj - bf[kt * 32 + 31]); else denb += sm * __expf(bbj - bb[kt * 32]);
                }
            }
            denf += __shfl_xor(denf, 32); denb += __shfl_xor(denb, 32);
            const float ebf = __expf(bfj), ebb = __expf(bbj);
            denf += ebf * qnf; denb += ebb * qnb;
            const float rf = 1.0f / fmaxf(fabsf(denf), 1.0f), rb = 1.0f / fmaxf(fabsf(denb), 1.0f);
            const float scf = ebf * rf, scb = ebb * rb;
            unsigned wdg[8];
#pragma unroll
            for (int g = 0; g < 4; ++g) { const int sl0 = 16 * (g >> 1) + 8 * hh + 4 * (g & 1);
                const f32x4 g4f = *(const LAS f32x4*)(gf + jt * 32 + sl0), g4b = *(const LAS f32x4*)(gb + jt * 32 + sl0);
                float wv[4];
#pragma unroll
                for (int q = 0; q < 4; ++q) { const int sl = sl0 + q; wv[q] = rf * __expf((sl <= r) ? bfj + g4f[q] : -1.0e30f) + rb * __expf((sl >= r) ? bbj + g4b[q] : -1.0e30f); }
                wdg[2 * g] = cvt2(wv[0], wv[1]); wdg[2 * g + 1] = cvt2(wv[2], wv[3]); }
            f32x16 acc[8];
#pragma unroll
            for (int et = 0; et < 8; ++et)
#pragma unroll
                for (int i = 0; i < 16; ++i) acc[et][i] = 0.f;
            asm volatile("s_waitcnt vmcnt(0)" ::: "memory");
            const int swz = (r >> 2) & 3;
#pragma unroll 1
            for (int ci = 0; ci < 8; ++ci) {
                if (ci) { if (blk == 0 && ci >= 6) { if (ci == 6) asm volatile("s_waitcnt vmcnt(2)" ::: "memory"); else asm volatile("s_waitcnt vmcnt(0)" ::: "memory"); } else asm volatile("s_waitcnt vmcnt(4)" ::: "memory"); }
                lds_barrier();
                if (blk != 0 || ci + 3 < 8) S3_DMA(ci + 3);
                LAS const unsigned char* CHc = CH + (ci & 3) * CHB;
                { const int kt = ci;
                        f32x16 c;
#pragma unroll
                        for (int i = 0; i < 16; ++i) c[i] = 0.f;
#pragma unroll
                        for (int kk = 0; kk < 8; ++kk) { const bf16x8 a = *(const LAS bf16x8*)(Kimg + (kt * 32 + r) * KP + (16 * kk + 8 * hh) * 2); c = MFMA32(a, qf[kk], c); }
                        float p[16];
                        if (kt == jt) {
#pragma unroll
                            for (int i = 0; i < 8; ++i) { p[2 * i] = c[2 * i] * bflo(wdg[i]); p[2 * i + 1] = c[2 * i + 1] * bfhi(wdg[i]); }
                        } else {
                            LAS const float* cx = (kt < jt ? cf : cb) + kt * 32 + 8 * hh;
                            const float rw = (kt < jt) ? rf * __expf(bfj - bf[kt * 32 + 31]) : rb * __expf(bbj - bb[kt * 32]);
#pragma unroll
                            for (int g = 0; g < 4; ++g) { const f32x4 c4 = *(const LAS f32x4*)(cx + 16 * (g >> 1) + 4 * (g & 1));
                                p[4 * g] = c[4 * g] * (c4.x * rw); p[4 * g + 1] = c[4 * g + 1] * (c4.y * rw); p[4 * g + 2] = c[4 * g + 2] * (c4.z * rw); p[4 * g + 3] = c[4 * g + 3] * (c4.w * rw); }
                        }
                        const bf16x8 pa0 = pack8(p[0], p[1], p[2], p[3], p[4], p[5], p[6], p[7]), pa1 = pack8(p[8], p[9], p[10], p[11], p[12], p[13], p[14], p[15]);
#pragma unroll
                        for (int et = 0; et < 8; ++et) { LAS const unsigned char* vb = CHc + (et * 32 + r) * 64;
                            const bf16x8 a0 = *(const LAS bf16x8*)(vb + ((hh ^ swz) << 4)), a1 = *(const LAS bf16x8*)(vb + (((2 + hh) ^ swz) << 4));
                            acc[et] = MFMA32(a0, pa0, acc[et]); acc[et] = MFMA32(a1, pa1, acc[et]);
                            if (et & 1) asm volatile("" ::: "memory"); }
                }
            }
            if (blk != 0) {
#pragma unroll
            for (int ci = 8; ci < 16; ++ci) {
                if (ci <= 13) asm volatile("s_waitcnt vmcnt(4)" ::: "memory"); else if (ci == 14) asm volatile("s_waitcnt vmcnt(2)" ::: "memory"); else asm volatile("s_waitcnt vmcnt(0)" ::: "memory");
                lds_barrier();
                if (ci + 3 < 16) S3_DMA(ci + 3);
                LAS const unsigned char* CHc = CH + (ci & 3) * CHB;
                {
                    const int dir = (ci - 8) >> 2, dq = (ci - 8) & 3;
                    const float sc = dir ? scb : scf;
#pragma unroll
                    for (int k2 = 0; k2 < 2; ++k2) { const u32x4 qq = __builtin_bit_cast(u32x4, qf[2 * dq + k2]);
                        const bf16x8 qs = pack8(bflo(qq.x) * sc, bfhi(qq.x) * sc, bflo(qq.y) * sc, bfhi(qq.y) * sc, bflo(qq.z) * sc, bfhi(qq.z) * sc, bflo(qq.w) * sc, bfhi(qq.w) * sc);
#pragma unroll
                        for (int et = 0; et < 8; ++et) { const bf16x8 a = *(const LAS bf16x8*)(CHc + (et * 32 + r) * 64 + (((2 * k2 + hh) ^ swz) << 4)); acc[et] = MFMA32(a, qs, acc[et]);
                            if ((et & 3) == 3) asm volatile("" ::: "memory"); } }
                }
            }
            }
            u32x4 ov[16]; f32x4 g0, g1;
            { int tz = threadIdx.x & 63; asm volatile("" : "+v"(tz)); const int pc = tz & 31, lr0 = tz >> 5;
              g0 = *(const f32x4*)(hg + h * DV + 8 * pc); g1 = *(const f32x4*)(hg + h * DV + 8 * pc + 4);
#pragma unroll
              for (int i = 0; i < 16; ++i) ov[i] = *(const u32x4*)(P + (size_t)(row0 + 32 * w + lr0 + 2 * i) * PW + 2 * NQ + NV + h * DV + 8 * pc); }
            float ss = 0.f;
#pragma unroll
            for (int et = 0; et < 8; ++et)
#pragma unroll
                for (int i = 0; i < 16; ++i) ss += acc[et][i] * acc[et][i];
            ss += __shfl_xor(ss, 32);
            const float rs = 1.0f / sqrtf(ss * (1.0f / DV) + EPS);
            lds_barrier();
            { LAS unsigned char* ob = OUT + (w * 32 + r) * OP + (4 * hh) * 2;
#pragma unroll
              for (int et = 0; et < 8; ++et)
#pragma unroll
                  for (int g = 0; g < 4; ++g) { u32x2 o; o.x = cvt2(acc[et][4 * g + 0] * rs, acc[et][4 * g + 1] * rs); o.y = cvt2(acc[et][4 * g + 2] * rs, acc[et][4 * g + 3] * rs);
                      *(LAS u32x2*)(ob + (et * 32 + 8 * g) * 2) = o; } }
            asm volatile("s_waitcnt lgkmcnt(0)" ::: "memory");
            S3_LOAD_IN(un);
            { int tz = threadIdx.x & 63; asm volatile("" : "+v"(tz)); const int pc = tz & 31, lr0 = tz >> 5;
#pragma unroll
              for (int i = 0; i < 16; ++i) { const int lr = 32 * w + lr0 + 2 * i; const int grow = row0 + lr;
                  const u32x4 hv = *(const LAS u32x4*)(OUT + lr * OP + pc * 16);
                  const f32x4 o0 = (f32x4){bflo(hv.x) * g0.x * bflo(ov[i].x), bfhi(hv.x) * g0.y * bfhi(ov[i].x), bflo(hv.y) * g0.z * bflo(ov[i].y), bfhi(hv.y) * g0.w * bfhi(ov[i].y)};
                  const f32x4 o1 = (f32x4){bflo(hv.z) * g1.x * bflo(ov[i].z), bfhi(hv.z) * g1.y * bfhi(ov[i].z), bflo(hv.w) * g1.z * bflo(ov[i].w), bfhi(hv.w) * g1.w * bfhi(ov[i].w)};
                  *(u32x2*)(HM + (size_t)grow * D + h * DV + 8 * pc) = (u32x2){pack_i8(o0 * (127.0f / HMR)), pack_i8(o1 * (127.0f / HMR))};
                  if ((i & 3) == 3) asm volatile("" ::: "memory"); } }
        }
#undef S3_DMA
        lds_barrier();
        it = itn;
    }
#undef S3_LOAD_IN
#undef S3_UNIT
}

#define XB_TMO      128
#define XB_XCNT(j)  (256  + 64 * (j))
#define XB_XSUB(j)  (1280 + 64 * (j))
#define XB_XGEN(j)  (2304 + 64 * (j))
#define XB_TOP      3328
#define XB_TOPGEN   3392
#define XCD_BAR_WORDS 3456
#define XB_SPIN_CAP (1u << 18)

__device__ __forceinline__ unsigned xb_ld(unsigned* p)              { return __hip_atomic_load(p, __ATOMIC_RELAXED, __HIP_MEMORY_SCOPE_AGENT); }
__device__ __forceinline__ unsigned xb_add(unsigned* p, unsigned v) { return __hip_atomic_fetch_add(p, v, __ATOMIC_RELAXED, __HIP_MEMORY_SCOPE_AGENT); }
__device__ __forceinline__ unsigned xb_xcc_id() { return (unsigned)__builtin_amdgcn_s_getreg((3 << 11) | 20) & 0xFu; }
#define XB_SPIN(cond, bar) do { unsigned _sp = 0; while (cond) { __builtin_amdgcn_s_sleep(1); \
    if ((++_sp & 255u) == 0u) { if (xb_ld(&(bar)[XB_TMO])) break; if (_sp > XB_SPIN_CAP) { atomicAdd(&(bar)[XB_TMO], 1u); break; } } } } while (0)

struct XcdBarrier {
    unsigned* bar; unsigned x;
    volatile LAS unsigned* st;
};

__device__ __forceinline__ XcdBarrier xcd_barrier_post(unsigned* bar, volatile LAS unsigned* st) {
    XcdBarrier b; b.bar = bar; b.x = xb_xcc_id(); b.st = st;
    if (threadIdx.x == 0) (void)xb_add(&bar[XB_XCNT(b.x)], 1u);
    return b;
}
__device__ __forceinline__ void xcd_barrier_complete(unsigned* bar, unsigned x, unsigned& nloc, unsigned& nx) {
    const unsigned G = gridDim.x * gridDim.y * gridDim.z;
    unsigned sum, cnt, mine, sp = 0u;
    for (;;) {
        sum = 0u; cnt = 0u; mine = 0u;
#pragma unroll
        for (unsigned j = 0; j < 16; ++j) { const unsigned c = xb_ld(&bar[XB_XCNT(j)]); sum += c; cnt += (c > 0u) ? 1u : 0u; mine = (j == x) ? c : mine; }
        if (sum == G) break;
        __builtin_amdgcn_s_sleep(1);
        if ((++sp & 255u) == 0u) { if (xb_ld(&bar[XB_TMO])) break; if (sp > XB_SPIN_CAP) { atomicAdd(&bar[XB_TMO], 1u); break; } }
    }
    nloc = mine > 0u ? mine : 1u; nx = cnt > 0u ? cnt : 1u;
}

__device__ __forceinline__ void xcd_barrier(const XcdBarrier& b) {
    asm volatile("s_waitcnt vmcnt(0)" ::: "memory");
    __syncthreads();
    if (threadIdx.x == 0) {
        unsigned* bar = b.bar;
        __builtin_amdgcn_s_waitcnt(0);
        unsigned nloc = b.st[0], nx = b.st[1];
        if (nloc == 0u) { xcd_barrier_complete(bar, b.x, nloc, nx); b.st[0] = nloc; b.st[1] = nx; }
        const unsigned old = xb_add(&bar[XB_XSUB(b.x)], 1u);
        const unsigned gen = old / nloc;
        if (old + 1u == (gen + 1u) * nloc) {
            __builtin_amdgcn_fence(__ATOMIC_RELEASE, "agent");
            asm volatile("s_waitcnt vmcnt(0)" ::: "memory");
            const unsigned og = xb_add(&bar[XB_TOP], 1u);
            const unsigned tg = og / nx;
            if (og + 1u == (tg + 1u) * nx) xb_add(&bar[XB_TOPGEN], 1u);
            else XB_SPIN(xb_ld(&bar[XB_TOPGEN]) == tg, bar);
            __builtin_amdgcn_fence(__ATOMIC_ACQUIRE, "agent");
            xb_add(&bar[XB_XGEN(b.x)], 1u);
            asm volatile("s_waitcnt vmcnt(0)" ::: "memory");
        } else {
            XB_SPIN(xb_ld(&bar[XB_XGEN(b.x)]) == gen, bar);
            __builtin_amdgcn_fence(__ATOMIC_ACQUIRE, "agent");
            asm volatile("s_waitcnt vmcnt(0)" ::: "memory");
        }
    }
    __syncthreads();
}


constexpr int LDS_BYTES = 152 * 1024;
constexpr int CW_BAR = 16384;
static_assert((CW_BAR + XCD_BAR_WORDS) * 4 <= (int)CTL_BYTES, "ctl");
#ifndef MK_MULTI
#define MK_MULTI 0
#endif
#define IN(p) (lo <= (p) && (p) < hi)
#define SEAM(p) do { if ((p) + 1 < hi) { XcdBarrier b_; b_.bar = (unsigned*)(load_args().ws + WS_CTL) + CW_BAR; b_.x = xb_xcc_id(); b_.st = (volatile LAS unsigned*)(C.lds + LDS_BYTES - 16); xcd_barrier(b_); } } while (0)
#define CAS __attribute__((address_space(4)))
__device__ __forceinline__ Args load_args() {
#if defined(__HIP_DEVICE_COMPILE__)
    const CAS Args* p = (const CAS Args*)__builtin_amdgcn_kernarg_segment_ptr(); asm volatile("" : "+s"(p));
    Args a; for (int i = 0; i < 22; ++i) a.in[i] = p->in[i]; a.out = p->out; a.ws = p->ws; a.lo = p->lo; a.hi = p->hi; return a;
#else
    return Args{};
#endif
}
__device__ __forceinline__ Ctx fresh(const Ctx& C) { Ctx R = C; int tz = threadIdx.x; asm volatile("" : "+v"(tz)); R.tid = tz; R.lane = tz & 63; return R; }
template <int L> __device__ __forceinline__ void layer_phases(const Args& args, const Ctx& C, int bar, int lo, int hi) {
    constexpr int pb = 16 * L;
    if (IN(pb + 1)) { phase_r1(load_args(), fresh(C), L); SEAM(pb + 1); }
    if (IN(pb + 2)) { phase_g1(load_args(), fresh(C), L); SEAM(pb + 2); }
    if constexpr ((L & 1) == 0) {
        if (IN(pb + 3)) { phase_s1(load_args(), fresh(C), L); SEAM(pb + 3); }
        if (IN(pb + 4)) { phase_s2(load_args(), fresh(C)); SEAM(pb + 4); }
        if (IN(pb + 5)) { phase_s3(load_args(), fresh(C), L); SEAM(pb + 5); }
    } else {
        if (IN(pb + 3)) { phase_conv(load_args(), fresh(C), L); SEAM(pb + 3); }
    }
    if (IN(pb + 6)) { phase_g2(load_args(), fresh(C), L); SEAM(pb + 6); }
    if (IN(pb + 7)) { phase_r2(load_args(), fresh(C), L); SEAM(pb + 7); }
    if (IN(pb + 8)) { phase_m1(load_args(), fresh(C), L); SEAM(pb + 8); }
    if (IN(pb + 9)) { phase_m2(load_args(), fresh(C), L); SEAM(pb + 9); }
}
__global__ void __launch_bounds__(NT, 2) fwd_kernel(Args args) {
    extern __shared__ __attribute__((aligned(16))) unsigned char lds_raw[];
    Ctx C; C.lds = (LAS unsigned char*)lds_raw; C.tid = threadIdx.x; C.lane = C.tid & 63; C.wave = __builtin_amdgcn_readfirstlane(C.tid >> 6); C.G = gridDim.x; C.bid = blockIdx.x; C.a = &args;
    const int lo = args.lo, hi = args.hi;
    volatile LAS unsigned* xbw = (volatile LAS unsigned*)(C.lds + LDS_BYTES - 16);
    if (C.tid < 4) xbw[C.tid] = 0u;
    __syncthreads();
    if (hi - lo > 1) (void)xcd_barrier_post((unsigned*)(args.ws + WS_CTL) + CW_BAR, xbw);
    const int bar = 0; (void)bar;
    if (IN(0)) { phase_mod(load_args(), fresh(C)); __syncthreads(); phase_cvt_mixer(load_args(), fresh(C)); SEAM(0); }
    layer_phases<0>(args, C, bar, lo, hi);
    layer_phases<1>(args, C, bar, lo, hi);
    layer_phases<2>(args, C, bar, lo, hi);
    layer_phases<3>(args, C, bar, lo, hi);
    if (IN(64)) phase_final(load_args(), fresh(C));
}
#undef IN
#undef SEAM

extern "C" void kernel_launch(void* const* d_in, const int* in_sizes, int n_in, void* d_out, int out_size, void* d_ws, size_t ws_size, hipStream_t stream) {
    static int grid = 0;
    if (grid == 0) {
        if (n_in != 22 || out_size != NL * D || ws_size < WS_END) { fprintf(stderr, "kernel_launch: unexpected shapes (n_in %d out %d ws %zu)\n", n_in, out_size, ws_size); grid = -1; return; }
        int dev = 0, cus = 0, per_cu = 0;
        if (hipGetDevice(&dev) != hipSuccess || hipDeviceGetAttribute(&cus, hipDeviceAttributeMultiprocessorCount, dev) != hipSuccess) { grid = -1; return; }
        if (hipFuncSetAttribute((const void*)fwd_kernel, hipFuncAttributeMaxDynamicSharedMemorySize, LDS_BYTES) != hipSuccess) { grid = -1; return; }
        if (hipOccupancyMaxActiveBlocksPerMultiprocessor(&per_cu, (const void*)fwd_kernel, NT, LDS_BYTES) != hipSuccess || per_cu < 1) { fprintf(stderr, "kernel_launch: occupancy query says %d\n", per_cu); }
        (void)hipGetLastError();
        grid = cus;
    }
    if (grid < 0) return;
    (void)hipMemsetAsync((char*)d_ws + WS_CTL, 0, CTL_BYTES, stream);
    Args a{};
    for (int i = 0; i < 22; ++i) a.in[i] = (const float*)d_in[i];
    a.out = (float*)d_out; a.ws = (unsigned char*)d_ws;
#if MK_MULTI
    int phases[64]; int np = 0;
    phases[np++] = 0;
    for (int l = 0; l < DEPTH; ++l) { const int pb = 16 * l; phases[np++] = pb + 1; phases[np++] = pb + 2; phases[np++] = pb + 3;
        if ((l & 1) == 0) { phases[np++] = pb + 4; phases[np++] = pb + 5; }
        phases[np++] = pb + 6; phases[np++] = pb + 7; phases[np++] = pb + 8; phases[np++] = pb + 9; }
    phases[np++] = 64;
    for (int i = 0; i < np; ++i) { a.lo = phases[i]; a.hi = phases[i] + 1; hipLaunchKernelGGL(fwd_kernel, dim3(grid), dim3(NT), LDS_BYTES, stream, a); }
#else
    a.lo = 0; a.hi = 65;
    hipLaunchKernelGGL(fwd_kernel, dim3(grid), dim3(NT), LDS_BYTES, stream, a);
#ifdef PROBE_PHASES
    { const int pp[] = {PROBE_PHASES};
      for (int rep = 0; rep < PROBE_REPS; ++rep) for (unsigned i = 0; i < sizeof(pp) / sizeof(pp[0]); ++i) { a.lo = pp[i]; a.hi = pp[i] + 1; hipLaunchKernelGGL(fwd_kernel, dim3(grid), dim3(NT), LDS_BYTES, stream, a); } }
#endif
#endif
}
```

```cpp
#include <hip/hip_runtime.h>
#include <cstdio>
#include <cstdint>

#define LAS __attribute__((address_space(3)))
typedef unsigned short bf16;
typedef float f32x4 __attribute__((ext_vector_type(4)));
typedef unsigned u32x4 __attribute__((ext_vector_type(4)));
typedef unsigned u32x2 __attribute__((ext_vector_type(2)));
typedef int i32x4r __attribute__((ext_vector_type(4)));

constexpr int D = 1024, BATCH = 2, SEQ = 16384, DEPTH = 4, CTXL = 256;
constexpr int NL = BATCH * SEQ, NCX = BATCH * CTXL, NR = NL + NCX;
constexpr int NH = 4, DQK = 128, DV = 256, NQ = 512, NV = 1024, PROJ = 3088, PW = 3072;
constexpr int NGRP = 4, EPG = 8, NE = 32, DE = 512;
constexpr int NBLK = 65;
constexpr int NUNIT = BATCH * NH * NBLK;
constexpr int CAP = NR;
constexpr int YROWS = 74752;
constexpr float EPS = 1e-6f;
constexpr float WSCALE = 32.0f;
constexpr float YSCALE = 4.0f;
constexpr int NT = 512, NW = 8;
constexpr int LDS_TAB_END = 152 * 1024 - 16;

constexpr size_t MiB = 1u << 20;
constexpr size_t WS_CTL = 0, CTL_BYTES = 1 * MiB;
constexpr size_t WS_MOD = 1 * MiB;
constexpr size_t WS_GATE = 2 * MiB;
constexpr size_t WS_TOKSLOT = 5 * MiB;
constexpr size_t WS_TOKW = 6 * MiB;
constexpr size_t WS_SLOTTOK = 7 * MiB;
constexpr size_t WS_DN = 12 * MiB;
constexpr size_t WS_NST = 13 * MiB;
constexpr size_t WS_BTOT = 14 * MiB;
constexpr size_t WS_RSC = 15 * MiB;
constexpr size_t WS_LAT = 16 * MiB;
constexpr size_t WS_HB = 146 * MiB;
constexpr size_t WS_PB = 211 * MiB;
constexpr size_t WS_HM = 406 * MiB;
constexpr size_t WS_DC = 471 * MiB;
constexpr size_t WS_CST = 601 * MiB;
constexpr size_t WS_VT = 666 * MiB;
constexpr size_t WS_WAIN = 731 * MiB;
constexpr size_t WS_WBIN = 743 * MiB;
constexpr size_t WS_WAOUT = 755 * MiB;
constexpr size_t WS_WBOUT = 759 * MiB;
constexpr size_t WS_WGU = 763 * MiB;
constexpr size_t WS_WDN = 827 * MiB;
constexpr size_t WS_H8 = 843 * MiB;
constexpr size_t WS_END = 880 * MiB;
constexpr int CW_WMAX = 256;
constexpr int CW_CNT = 1024, CNT_STRIDE = 64;

struct Args { const float* in[22]; float* out; unsigned char* ws; int lo, hi; };

typedef short bf16x8 __attribute__((ext_vector_type(8)));
typedef float f32x2 __attribute__((ext_vector_type(2)));
typedef __bf16 bf16x2_t __attribute__((ext_vector_type(2)));
__device__ __forceinline__ unsigned cvt2(float lo, float hi) { const f32x2 v = {lo, hi}; return __builtin_bit_cast(unsigned, __builtin_convertvector(v, bf16x2_t)); }
__device__ __forceinline__ float bf2f(bf16 v) { return __uint_as_float(((unsigned)v) << 16); }
__device__ __forceinline__ unsigned f2bf(float f) { return cvt2(f, 0.f) & 0xffffu; }
__device__ __forceinline__ unsigned pk2(float lo, float hi) { return cvt2(lo, hi); }
template <int CTRL, int ROWMASK> __device__ __forceinline__ float dpp_mov(float x) { return __int_as_float(__builtin_amdgcn_update_dpp(0, __float_as_int(x), CTRL, ROWMASK, 0xf, false)); }
__device__ __forceinline__ float wave_sum(float v) {
    v += dpp_mov<0xB1, 0xf>(v); v += dpp_mov<0x4E, 0xf>(v); v += dpp_mov<0x141, 0xf>(v); v += dpp_mov<0x140, 0xf>(v);
    v += dpp_mov<0x142, 0xA>(v); v += dpp_mov<0x143, 0xC>(v);
    return __int_as_float(__builtin_amdgcn_readlane(__float_as_int(v), 63));
}
__device__ __forceinline__ float wave_max_nn(float v) {
    v = fmaxf(v, dpp_mov<0xB1, 0xf>(v)); v = fmaxf(v, dpp_mov<0x4E, 0xf>(v)); v = fmaxf(v, dpp_mov<0x141, 0xf>(v)); v = fmaxf(v, dpp_mov<0x140, 0xf>(v));
    v = fmaxf(v, dpp_mov<0x142, 0xA>(v)); v = fmaxf(v, dpp_mov<0x143, 0xC>(v));
    return __int_as_float(__builtin_amdgcn_readlane(__float_as_int(v), 63));
}
__device__ __forceinline__ unsigned pack_i8_nc(f32x4 v) {
    const unsigned a = __float_as_uint(v.x + 12582912.0f), b = __float_as_uint(v.y + 12582912.0f), c = __float_as_uint(v.z + 12582912.0f), d = __float_as_uint(v.w + 12582912.0f);
    return __builtin_amdgcn_perm(__builtin_amdgcn_perm(d, c, 0x0c0c0400u) , __builtin_amdgcn_perm(b, a, 0x0c0c0400u), 0x05040100u);
}
__device__ __forceinline__ unsigned pack_i8(f32x4 v) {
    return pack_i8_nc((f32x4){__builtin_amdgcn_fmed3f(v.x, -127.f, 127.f), __builtin_amdgcn_fmed3f(v.y, -127.f, 127.f), __builtin_amdgcn_fmed3f(v.z, -127.f, 127.f), __builtin_amdgcn_fmed3f(v.w, -127.f, 127.f)});
}
__device__ __forceinline__ float sigmoidf_(float x) { return 1.f / (1.f + __expf(-x)); }
__device__ __forceinline__ float siluf_(float x) { return x / (1.f + __expf(-x)); }
__device__ __forceinline__ float logsigmoidf_(float x) { return fminf(x, 0.f) - log1pf(__expf(-fabsf(x))); }
__device__ __forceinline__ int blk_row0(int b, int blk) { return blk == 0 ? NL + b * CTXL : b * SEQ + (blk - 1) * 256; }
__device__ __forceinline__ int mod_vec_of_row(int row) { return row < NL ? row / SEQ : 2; }

struct Ctx {
    LAS unsigned char* lds; int tid, lane, wave, G, bid;
    const Args* a;
};
__device__ __forceinline__ Ctx fresh(const Ctx& C);

__device__ __forceinline__ int expert_block_prefix(const unsigned* cnt, int lane, int& nb) {
    nb = lane < NE ? ((int)cnt[lane * CNT_STRIDE] + 255) / 256 : 0; int v = nb;
#pragma unroll
    for (int o = 1; o < 64; o <<= 1) { const int t = __shfl_up(v, o); v += (lane >= o) ? t : 0; }
    return v - nb;
}
__device__ __forceinline__ void slot_bases(const Args& A, int l, LAS int* sb, int tid) {
    if (tid < 64) { int nb; const int ex = expert_block_prefix((const unsigned*)(A.ws + WS_CTL) + CW_CNT + l * 32 * CNT_STRIDE, tid, nb); if (tid <= NE) sb[tid] = ex * 256; }
    __syncthreads();
}

__device__ __forceinline__ void phase_mod(const Args& A, const Ctx& C) {
    LAS float* sc = (LAS float*)C.lds;
    LAS float* red = sc + 3072;
    const float* c = A.in[1]; const float* cc = A.in[3];
    for (int i = C.tid; i < 3072; i += NT) { const float v = i < 2048 ? c[i] : cc[i - 2048]; sc[i] = siluf_(v); }
    __syncthreads();
    float* MOD = (float*)(A.ws + WS_MOD);
    for (int u = C.bid; u < DEPTH * 192; u += C.G) {
        const int l = u / 192, cg = u % 192, col = cg * 32 + (C.lane & 31), kh = C.lane >> 5;
        const float* w = A.in[4] + (size_t)l * D * 6 * D + col + (size_t)(C.wave * 128 + kh * 64) * 6 * D;
        float wv[64];
#pragma unroll
        for (int k = 0; k < 64; ++k) wv[k] = w[(size_t)k * 6 * D];
        LAS const float* s0 = sc + C.wave * 128 + kh * 64;
        float a0 = 0.f, a1 = 0.f, a2 = 0.f;
#pragma unroll
        for (int k = 0; k < 64; ++k) { a0 += s0[k] * wv[k]; a1 += s0[1024 + k] * wv[k]; a2 += s0[2048 + k] * wv[k]; }
        a0 += __shfl_xor(a0, 32); a1 += __shfl_xor(a1, 32); a2 += __shfl_xor(a2, 32);
        if (kh == 0) { red[(C.wave * 3 + 0) * 64 + C.lane] = a0; red[(C.wave * 3 + 1) * 64 + C.lane] = a1; red[(C.wave * 3 + 2) * 64 + C.lane] = a2; }
        __syncthreads();
        if (C.tid < 96) { const int v = C.tid / 32, ln = C.tid % 32; float s = 0.f;
            for (int w8 = 0; w8 < 8; ++w8) s += red[(w8 * 3 + v) * 64 + ln];
            MOD[(size_t)(l * 3 + v) * 6 * D + cg * 32 + ln] = s + A.in[5][(size_t)l * 6 * D + cg * 32 + ln]; }
        __syncthreads();
    }
}
__device__ __forceinline__ void load_row_f32(const float* p, int lane, f32x4 (&v)[4]) {
#pragma unroll
    for (int j = 0; j < 4; ++j) v[j] = *(const f32x4*)(p + 4 * lane + 256 * j);
}
__device__ __forceinline__ void load_row_bf16(const bf16* p, int lane, f32x4 (&v)[4]) {
#pragma unroll
    for (int j = 0; j < 4; ++j) { const u32x2 w = *(const u32x2*)(p + 4 * lane + 256 * j);
        v[j] = (f32x4){__uint_as_float(w.x << 16), __uint_as_float(w.x & 0xffff0000u), __uint_as_float(w.y << 16), __uint_as_float(w.y & 0xffff0000u)}; }
}
__device__ __forceinline__ void store_row_bf16(bf16* p, int lane, const f32x4 (&v)[4]) {
#pragma unroll
    for (int j = 0; j < 4; ++j) { u32x2 w; w.x = pk2(v[j].x, v[j].y); w.y = pk2(v[j].z, v[j].w); *(u32x2*)(p + 4 * lane + 256 * j) = w; }
}
constexpr int CVT_IG = (D / 64) * (DE / 32), CVT_ID = (DE / 64) * (D / 32), CVT_PER = 2 * CVT_IG + CVT_ID, CVT_ITEMS = NE * CVT_PER;
constexpr int CVT_Q = 24;
__device__ __forceinline__ void cvt_moe_items(const Args& A, const Ctx& C, int l, int it0, int end, int stride);
__device__ __forceinline__ void cvt_win_i8(const Args& A, const Ctx& C);
__device__ __forceinline__ int cvt_t2(int l, int G);
__device__ __forceinline__ int cvt_t3(int l, int G);
struct RowVec { f32x4 a[4], s[4], g[4]; };
__device__ __forceinline__ void load_rowvec(RowVec& R, const float* ng, const float* sh, const float* sc, const float* gt, int lane) {
    f32x4 n[4], c[4]; load_row_f32(ng, lane, n); load_row_f32(sc, lane, c); load_row_f32(sh, lane, R.s); if (gt) load_row_f32(gt, lane, R.g);
#pragma unroll
    for (int q = 0; q < 4; ++q) R.a[q] = n[q] * (1.f + c[q]);
}
__device__ __forceinline__ void load_row_bf16raw(const bf16* p, int lane, u32x2 (&v)[4]) {
#pragma unroll
    for (int j = 0; j < 4; ++j) v[j] = *(const u32x2*)(p + 4 * lane + 256 * j);
}
__device__ __forceinline__ void store_row_fp8(unsigned char* p, int lane, const f32x4 (&v)[4]) {
#pragma unroll
    for (int j = 0; j < 4; ++j) { int w = 0; w = __builtin_amdgcn_cvt_pk_fp8_f32(v[j].x, v[j].y, w, false); w = __builtin_amdgcn_cvt_pk_fp8_f32(v[j].z, v[j].w, w, true); *(unsigned*)(p + 4 * lane + 256 * j) = (unsigned)w; }
}
__device__ __forceinline__ void load_row_fp8raw(const unsigned char* p, int lane, unsigned (&v)[4]) {
#pragma unroll
    for (int j = 0; j < 4; ++j) v[j] = *(const unsigned*)(p + 4 * lane + 256 * j);
}
__device__ __forceinline__ f32x4 fp8x4(unsigned w) { const f32x2 lo = __builtin_amdgcn_cvt_pk_f32_fp8((int)w, false), hi = __builtin_amdgcn_cvt_pk_f32_fp8((int)w, true); return (f32x4){lo.x, lo.y, hi.x, hi.y}; }
__device__ __forceinline__ f32x4 bf4(u32x2 w) { return (f32x4){__uint_as_float(w.x << 16), __uint_as_float(w.x & 0xffff0000u), __uint_as_float(w.y << 16), __uint_as_float(w.y & 0xffff0000u)}; }
__device__ __forceinline__ float row_rstd(const f32x4 (&v)[4]) {
    float s = 0.f;
#pragma unroll
    for (int j = 0; j < 4; ++j) s += (v[j].x * v[j].x + v[j].y * v[j].y) + (v[j].z * v[j].z + v[j].w * v[j].w);
    return 1.0f / sqrtf(wave_sum(s) * (1.f / D) + EPS);
}

__device__ __forceinline__ void phase_r1(const Args& A, const Ctx& C, int l) {
    LAS int* sb = (LAS int*)C.lds;
    constexpr int GWP = 2064;
    LAS unsigned char* GW = C.lds + 256;
    LAS unsigned char* HS = C.lds + 256 + 16 * GWP + C.wave * 2 * GWP;
    const bool mls = (l & 1) == 0; const int j = l >> 1;
    if (l == 0) { cvt_win_i8(A, C); __syncthreads(); }
    if (l > 0) slot_bases(A, l - 1, sb, C.tid);
    if (mls) { const float* w = A.in[8] + (size_t)j * D * PROJ + PW;
        f32x4 t[2][4];
#pragma unroll
        for (int jj = 0; jj < 2; ++jj)
#pragma unroll
            for (int q = 0; q < 4; ++q) t[jj][q] = *(const f32x4*)(w + (size_t)(C.tid + NT * jj) * PROJ + 4 * q);
#pragma unroll
        for (int jj = 0; jj < 2; ++jj)
#pragma unroll
            for (int q = 0; q < 4; ++q) { const int k = C.tid + NT * jj;
#pragma unroll
                for (int c = 0; c < 4; ++c) *(LAS unsigned short*)(GW + (4 * q + c) * GWP + k * 2) = (unsigned short)f2bf(t[jj][q][c]); }
        __syncthreads(); }
    const int nrows = (l <= 2) ? NR : NL;
    bf16* LAT = (bf16*)(A.ws + WS_LAT); unsigned char* HI8 = A.ws + WS_H8; float* RSC = (float*)(A.ws + WS_RSC); float* GATE = (float*)(A.ws + WS_GATE);
    const float* MOD = (const float*)(A.ws + WS_MOD); const unsigned char* Y8 = A.ws + WS_PB;
    const int* TS = (const int*)(A.ws + WS_TOKSLOT); const float* TW = (const float*)(A.ws + WS_TOKW);
    const int rpw = (((nrows + C.G - 1) / C.G) + 1) & ~1; const int wrow0 = C.bid * rpw; const int wend = min(wrow0 + rpw, nrows);
    for (int sa = wrow0; sa < wend;) {
        const int mvi = mod_vec_of_row(sa); const int bnd = mvi == 0 ? SEQ : (mvi == 1 ? NL : NR); const int sbnd = min(wend, bnd);
        RowVec RV; { const float* mv = MOD + (size_t)(l * 3 + mvi) * 6 * D;
            load_rowvec(RV, A.in[6] + (size_t)(l * 2 + 0) * D, mv + 0 * D, mv + 1 * D, l > 0 ? MOD + (size_t)((l - 1) * 3 + mvi) * 6 * D + 5 * D : nullptr, C.lane); }
        const int rlast = sbnd - 2; const int rfirst = sa + 2 * C.wave;
        i32x4r ts1 = (i32x4r){0, 0, 0, 0}, ts2 = ts1; f32x4 tw1 = (f32x4){0.f, 0.f, 0.f, 0.f}, tw2 = tw1;
        u32x2 nla[4], nlb[4]; unsigned nya0[4], nya1[4], nyb0[4], nyb1[4]; f32x4 nxa[4], nxb[4];
#define R1_FETCH(r_, ts_) do { const int fa_ = (r_), fb_ = fa_ + 1; \
            if (l == 0) { load_row_f32(fa_ < NL ? A.in[0] + (size_t)fa_ * D : A.in[2] + (size_t)(fa_ - NL) * D, C.lane, nxa); load_row_f32(fb_ < NL ? A.in[0] + (size_t)fb_ * D : A.in[2] + (size_t)(fb_ - NL) * D, C.lane, nxb); } \
            else { load_row_bf16raw(LAT + (size_t)fa_ * D, C.lane, nla); load_row_bf16raw(LAT + (size_t)fb_ * D, C.lane, nlb); \
                load_row_fp8raw(Y8 + (size_t)(sb[(ts_).x >> 20] + ((ts_).x & 0xfffff)) * D, C.lane, nya0); load_row_fp8raw(Y8 + (size_t)(sb[(ts_).y >> 20] + ((ts_).y & 0xfffff)) * D, C.lane, nya1); \
                load_row_fp8raw(Y8 + (size_t)(sb[(ts_).z >> 20] + ((ts_).z & 0xfffff)) * D, C.lane, nyb0); load_row_fp8raw(Y8 + (size_t)(sb[(ts_).w >> 20] + ((ts_).w & 0xfffff)) * D, C.lane, nyb1); } } while (0)
        if (l > 0) { const int r0 = min(rfirst, rlast), r1 = min(rfirst + 2 * NW, rlast);
            ts1 = *(const i32x4r*)(TS + r0 * 2); tw1 = *(const f32x4*)(TW + r0 * 2); ts2 = *(const i32x4r*)(TS + r1 * 2); tw2 = *(const f32x4*)(TW + r1 * 2); }
        R1_FETCH(min(rfirst, rlast), ts1);
        for (int ra = rfirst; ra < sbnd; ra += 2 * NW) {
            const bool hasb = true; const int rb = ra + 1;
            f32x4 va[4], vb[4];
            if (l == 0) {
#pragma unroll
                for (int q = 0; q < 4; ++q) { va[q] = nxa[q]; vb[q] = nxb[q]; }
                R1_FETCH(min(ra + 2 * NW, rlast), ts1);
            } else {
                u32x2 la[4], lb[4]; unsigned ya0[4], ya1[4], yb0[4], yb1[4];
#pragma unroll
                for (int q = 0; q < 4; ++q) { la[q] = nla[q]; lb[q] = nlb[q]; ya0[q] = nya0[q]; ya1[q] = nya1[q]; yb0[q] = nyb0[q]; yb1[q] = nyb1[q]; }
                const f32x4 twc = tw1;
                ts1 = ts2; tw1 = tw2;
                { const int r2 = min(ra + 4 * NW, rlast); ts2 = *(const i32x4r*)(TS + r2 * 2); tw2 = *(const f32x4*)(TW + r2 * 2); }
                R1_FETCH(min(ra + 2 * NW, rlast), ts1);
                const float wa0 = twc.x * (1.0f / YSCALE), wa1 = twc.y * (1.0f / YSCALE), wb0 = twc.z * (1.0f / YSCALE), wb1 = twc.w * (1.0f / YSCALE);
#pragma unroll
                for (int q = 0; q < 4; ++q) { va[q] = bf4(la[q]) + RV.g[q] * (fp8x4(ya0[q]) * wa0 + fp8x4(ya1[q]) * wa1); vb[q] = bf4(lb[q]) + RV.g[q] * (fp8x4(yb0[q]) * wb0 + fp8x4(yb1[q]) * wb1); }
            }
            store_row_bf16(LAT + (size_t)ra * D, C.lane, va); if (hasb) store_row_bf16(LAT + (size_t)rb * D, C.lane, vb);
            const float rra = row_rstd(va), rrb = row_rstd(vb);
            f32x4 ha[4], hb[4];
#pragma unroll
            for (int q = 0; q < 4; ++q) { ha[q] = (va[q] * rra) * RV.a[q] + RV.s[q]; hb[q] = (vb[q] * rrb) * RV.a[q] + RV.s[q]; }
            { float ma = 0.f, mb = 0.f;
#pragma unroll
              for (int q = 0; q < 4; ++q) { ma = fmaxf(ma, fmaxf(fmaxf(fabsf(ha[q].x), fabsf(ha[q].y)), fmaxf(fabsf(ha[q].z), fabsf(ha[q].w)))); mb = fmaxf(mb, fmaxf(fmaxf(fabsf(hb[q].x), fabsf(hb[q].y)), fmaxf(fabsf(hb[q].z), fabsf(hb[q].w)))); }
              ma = fmaxf(wave_max_nn(ma), 1.0e-20f); mb = fmaxf(wave_max_nn(mb), 1.0e-20f);
              const float ia = 127.0f / ma, ib = 127.0f / mb;
#pragma unroll
              for (int q = 0; q < 4; ++q) { *(unsigned*)(HI8 + (size_t)ra * D + 4 * C.lane + 256 * q) = pack_i8_nc(ha[q] * ia); *(unsigned*)(HI8 + (size_t)rb * D + 4 * C.lane + 256 * q) = pack_i8_nc(hb[q] * ib); }
              if (C.lane == 0) { RSC[ra] = ma * (1.0f / 127.0f); RSC[rb] = mb * (1.0f / 127.0f); } }
            if (mls) {
#pragma unroll
                for (int q = 0; q < 4; ++q) { *(LAS u32x2*)(HS + (4 * C.lane + 256 * q) * 2) = (u32x2){cvt2(ha[q].x, ha[q].y), cvt2(ha[q].z, ha[q].w)}; *(LAS u32x2*)(HS + GWP + (4 * C.lane + 256 * q) * 2) = (u32x2){cvt2(hb[q].x, hb[q].y), cvt2(hb[q].z, hb[q].w)}; }
                asm volatile("s_waitcnt lgkmcnt(0)" ::: "memory");
                f32x4 gacc = (f32x4){0.f, 0.f, 0.f, 0.f};
                { const int gi = C.lane & 15, kg = C.lane >> 4; LAS const unsigned char* ap = HS + (gi & 1) * GWP + kg * 16; LAS const unsigned char* bp = GW + gi * GWP + kg * 16;
#pragma unroll 8
                  for (int s2 = 0; s2 < 32; ++s2) { bf16x8 av = *(const LAS bf16x8*)(ap + s2 * 64); const bf16x8 bv = *(const LAS bf16x8*)(bp + s2 * 64);
                      if (gi >= 2) av = (bf16x8){0, 0, 0, 0, 0, 0, 0, 0};
                      gacc = __builtin_amdgcn_mfma_f32_16x16x32_bf16(av, bv, gacc, 0, 0, 0); } }
                float ga = gacc[0], gb = gacc[1];
                if (C.lane < 16) {
                    const float bgt = A.in[9][j * 16 + C.lane]; const int gtype = C.lane >> 2;
                    ga += bgt; gb += bgt;
                    GATE[(size_t)ra * 16 + C.lane] = (gtype & 1) ? logsigmoidf_(ga) : 15.0f * tanhf(ga * (1.0f / 15.0f));
                    if (hasb) GATE[(size_t)rb * 16 + C.lane] = (gtype & 1) ? logsigmoidf_(gb) : 15.0f * tanhf(gb * (1.0f / 15.0f)); }
            }
        }
#undef R1_FETCH
        sa = sbnd;
    }
}

__device__ __forceinline__ void phase_r2(const Args& A, const Ctx& C, int l) {
    constexpr int WP = 2064;
    LAS unsigned char* RWB = C.lds;
    LAS float* WL = (LAS float*)(C.lds + 48 * WP);
    LAS unsigned* hist = (LAS unsigned*)(WL + 8 * 16 * 48);
    LAS unsigned* gbase = hist + 32;
    constexpr int RCAP = 144;
    LAS int* rec = (LAS int*)(gbase + 32);
    static_assert(48 * WP + 8 * 16 * 48 * 4 + 256 + RCAP * 16 <= LDS_TAB_END, "R2 LDS map");
    cvt_moe_items(A, C, l, cvt_t3(l, C.G) + C.bid * NW + C.wave, CVT_ITEMS, C.G * NW);
    __syncthreads();
    { const float* wg = A.in[15] + (size_t)l * D * NGRP; const float* wr = A.in[17] + (size_t)l * D * NE;
      { const int kp = C.tid; const f32x4 x0 = *(const f32x4*)(wg + (size_t)(2 * kp) * 4), x1 = *(const f32x4*)(wg + (size_t)(2 * kp + 1) * 4);
        *(LAS unsigned*)(RWB + 0 * WP + kp * 4) = cvt2(x0.x, x1.x); *(LAS unsigned*)(RWB + 1 * WP + kp * 4) = cvt2(x0.y, x1.y);
        *(LAS unsigned*)(RWB + 2 * WP + kp * 4) = cvt2(x0.z, x1.z); *(LAS unsigned*)(RWB + 3 * WP + kp * 4) = cvt2(x0.w, x1.w); }
      f32x4 t0[8], t1[8];
#pragma unroll
      for (int jj = 0; jj < 8; ++jj) { const int it = C.tid + NT * jj, kp = it >> 3, cg = it & 7; t0[jj] = *(const f32x4*)(wr + (size_t)(2 * kp) * NE + 4 * cg); t1[jj] = *(const f32x4*)(wr + (size_t)(2 * kp + 1) * NE + 4 * cg); }
#pragma unroll
      for (int jj = 0; jj < 8; ++jj) { const int it = C.tid + NT * jj, kp = it >> 3, c0 = 4 + 4 * (it & 7);
          *(LAS unsigned*)(RWB + (c0 + 0) * WP + kp * 4) = cvt2(t0[jj].x, t1[jj].x); *(LAS unsigned*)(RWB + (c0 + 1) * WP + kp * 4) = cvt2(t0[jj].y, t1[jj].y);
          *(LAS unsigned*)(RWB + (c0 + 2) * WP + kp * 4) = cvt2(t0[jj].z, t1[jj].z); *(LAS unsigned*)(RWB + (c0 + 3) * WP + kp * 4) = cvt2(t0[jj].w, t1[jj].w); }
      for (int i = C.tid; i < 12 * 512; i += NT) *(LAS unsigned*)(RWB + (36 + i / 512) * WP + (i % 512) * 4) = 0u; }
    const int nrows = (l <= 1) ? NR : NL;
    bf16* LAT = (bf16*)(A.ws + WS_LAT); bf16* H = (bf16*)(A.ws + WS_HB); unsigned char* H8 = A.ws + WS_H8;
    const float* MOD = (const float*)(A.ws + WS_MOD);
    unsigned* cnt = (unsigned*)(A.ws + WS_CTL) + CW_CNT + l * 32 * CNT_STRIDE;
    int* TS = (int*)(A.ws + WS_TOKSLOT); float* TW = (float*)(A.ws + WS_TOKW); int* ST = (int*)(A.ws + WS_SLOTTOK);
    const int rpw = (((nrows + C.G - 1) / C.G) + 1) & ~1; const int wrow0 = C.bid * rpw; const int wend0 = min(wrow0 + rpw, nrows);
    const float* bg = A.in[16] + l * NGRP; const float* br = A.in[18] + l * NE;
    for (int cb = wrow0; cb < wend0; cb += RCAP) {
        const int wend = min(cb + RCAP, wend0);
        if (C.tid < 32) hist[C.tid] = 0u;
        for (int sa = cb; sa < wend;) {
            const int mvi = mod_vec_of_row(sa); const int bnd = mvi == 0 ? SEQ : (mvi == 1 ? NL : NR); const int sbnd = min(wend, bnd);
            RowVec RV; { const float* mv = MOD + (size_t)(l * 3 + mvi) * 6 * D; load_rowvec(RV, A.in[6] + (size_t)(l * 2 + 1) * D, mv + 3 * D, mv + 4 * D, mv + 2 * D, C.lane); }
            const int rlast = sbnd - 2;
            u32x2 la[4], lb[4];
            { const int r0 = min(sa + 2 * C.wave, rlast); load_row_bf16raw(LAT + (size_t)r0 * D, C.lane, la); load_row_bf16raw(LAT + (size_t)(r0 + 1) * D, C.lane, lb); }
            for (int ra = sa + 2 * C.wave; ra < sbnd; ra += 2 * NW) {
                const int rb = ra + 1;
                u32x2 lan[4], lbn[4];
                { const int r1 = min(ra + 2 * NW, rlast); load_row_bf16raw(LAT + (size_t)r1 * D, C.lane, lan); load_row_bf16raw(LAT + (size_t)(r1 + 1) * D, C.lane, lbn); }
                f32x4 va[4], vb[4];
#pragma unroll
                for (int q = 0; q < 4; ++q) { va[q] = bf4(la[q]); vb[q] = bf4(lb[q]); }
                const float rra = row_rstd(va), rrb = row_rstd(vb);
                f32x4 ha[4], hb[4];
#pragma unroll
                for (int q = 0; q < 4; ++q) { ha[q] = (va[q] * rra) * RV.a[q] + RV.s[q]; hb[q] = (vb[q] * rrb) * RV.a[q] + RV.s[q]; }
                store_row_bf16(H + (size_t)ra * D, C.lane, ha); store_row_bf16(H + (size_t)rb * D, C.lane, hb);
                store_row_fp8(H8 + (size_t)ra * D, C.lane, ha); store_row_fp8(H8 + (size_t)rb * D, C.lane, hb);
#pragma unroll
                for (int q = 0; q < 4; ++q) { la[q] = lan[q]; lb[q] = lbn[q]; }
            }
            sa = sbnd;
        }
        __syncthreads();
        const int fr = C.lane & 15, fq = C.lane >> 4;
        for (int t = C.wave; t * 16 < wend - cb; t += NW) {
            const int trow = min(cb + 16 * t + fr, wend - 1);
            const bf16* hp = H + (size_t)trow * D + 8 * fq;
            f32x4 acc[3];
#pragma unroll
            for (int ct = 0; ct < 3; ++ct) acc[ct] = (f32x4){0.f, 0.f, 0.f, 0.f};
            { bf16x8 av[32];
#pragma unroll
              for (int k8 = 0; k8 < 32; ++k8) av[k8] = *(const bf16x8*)(hp + 32 * k8);
#pragma unroll
              for (int k8 = 0; k8 < 32; ++k8) {
#pragma unroll
                  for (int ct = 0; ct < 3; ++ct) { const bf16x8 bv = *(const LAS bf16x8*)(RWB + (ct * 16 + fr) * WP + (32 * k8 + 8 * fq) * 2);
                      acc[ct] = __builtin_amdgcn_mfma_f32_16x16x32_bf16(av[k8], bv, acc[ct], 0, 0, 0); }
                  if ((k8 & 3) == 3) asm volatile("" ::: "memory"); } }
            LAS float* wl = WL + C.wave * 16 * 48;
#pragma unroll
            for (int ct = 0; ct < 3; ++ct)
#pragma unroll
                for (int jq = 0; jq < 4; ++jq) wl[(4 * fq + jq) * 48 + ct * 16 + fr] = acc[ct][jq];
            asm volatile("s_waitcnt lgkmcnt(0)" ::: "memory");
            const int row = cb + 16 * t + C.lane;
            if (C.lane < 16 && row < wend) {
                LAS const float* wm = wl + C.lane * 48;
                float lg[36];
#pragma unroll
                for (int c = 0; c < 36; ++c) lg[c] = wm[c];
                float gl[4]; int grp = 0; float gm = -3.0e38f;
#pragma unroll
                for (int c = 0; c < 4; ++c) { gl[c] = lg[c] + bg[c]; if (gl[c] > gm) { gm = gl[c]; grp = c; } }
                float gs = 0.f;
#pragma unroll
                for (int c = 0; c < 4; ++c) gs += __expf(gl[c] - gm);
                const float pgrp = 1.0f / gs;
                float rl[8];
#pragma unroll
                for (int i = 0; i < 8; ++i) { float tt = 0.f;
#pragma unroll
                    for (int g = 0; g < 4; ++g) tt = (g == grp) ? lg[4 + g * 8 + i] : tt;
                    rl[i] = tt + br[grp * 8 + i]; }
                int i0 = 0; float m0 = rl[0];
#pragma unroll
                for (int i = 1; i < 8; ++i) if (rl[i] > m0) { m0 = rl[i]; i0 = i; }
                int i1 = -1; float m1 = -3.0e38f;
#pragma unroll
                for (int i = 0; i < 8; ++i) if (i != i0 && rl[i] > m1) { m1 = rl[i]; i1 = i; }
                const float p0 = 1.0f, p1 = __expf(m1 - m0);
                const float w0 = pgrp * p0 / (p0 + p1), w1 = pgrp * p1 / (p0 + p1);
                const int e0 = grp * 8 + i0, e1 = grp * 8 + i1;
                const unsigned q0 = __hip_atomic_fetch_add(hist + e0, 1u, __ATOMIC_RELAXED, __HIP_MEMORY_SCOPE_WORKGROUP), q1 = __hip_atomic_fetch_add(hist + e1, 1u, __ATOMIC_RELAXED, __HIP_MEMORY_SCOPE_WORKGROUP);
                const int li = row - cb;
                rec[li * 4 + 0] = e0 | (e1 << 8); rec[li * 4 + 1] = (int)q0; rec[li * 4 + 2] = (int)q1;
                TW[row * 2 + 0] = w0; TW[row * 2 + 1] = w1;
            }
        }
        __syncthreads();
        if (C.tid < 32) gbase[C.tid] = hist[C.tid] ? atomicAdd(cnt + C.tid * CNT_STRIDE, hist[C.tid]) : 0u;
        __syncthreads();
        for (int i = C.tid; i < wend - cb; i += NT) { const int row = cb + i; const int ee = rec[i * 4], e0 = ee & 255, e1 = ee >> 8;
            const unsigned q0 = gbase[e0] + (unsigned)rec[i * 4 + 1], q1 = gbase[e1] + (unsigned)rec[i * 4 + 2];
            ST[(size_t)e0 * CAP + q0] = row; ST[(size_t)e1 * CAP + q1] = row;
            TS[row * 2 + 0] = (e0 << 20) | (int)q0; TS[row * 2 + 1] = (e1 << 20) | (int)q1; }
        __syncthreads();
    }
}

__device__ __forceinline__ void phase_final(const Args& A, const Ctx& C) {
    LAS int* sb = (LAS int*)C.lds;
    slot_bases(A, 3, sb, C.tid);
    const bf16* LAT = (const bf16*)(A.ws + WS_LAT); const unsigned char* Y8 = A.ws + WS_PB;
    const int* TS = (const int*)(A.ws + WS_TOKSLOT); const float* TW = (const float*)(A.ws + WS_TOKW);
    const float* MOD = (const float*)(A.ws + WS_MOD);
    f32x4 fg[4]; load_row_f32(A.in[7], C.lane, fg);
    const int rpw = (((NL + C.G - 1) / C.G) + 1) & ~1; const int wrow0 = C.bid * rpw; const int wend = min(wrow0 + rpw, NL);
    for (int sa = wrow0; sa < wend;) {
        const int mvi = mod_vec_of_row(sa); const int sbnd = min(wend, mvi == 0 ? SEQ : NL);
        f32x4 g2[4]; load_row_f32(MOD + (size_t)(3 * 3 + mvi) * 6 * D + 5 * D, C.lane, g2);
        const int rlast = sbnd - 2; const int rfirst = sa + 2 * C.wave;
        i32x4r ts1, ts2; f32x4 tw1, tw2;
        u32x2 nla[4], nlb[4]; unsigned nya0[4], nya1[4], nyb0[4], nyb1[4];
#define FIN_FETCH(r_, ts_) do { const int fa_ = (r_); \
            load_row_bf16raw(LAT + (size_t)fa_ * D, C.lane, nla); load_row_bf16raw(LAT + (size_t)(fa_ + 1) * D, C.lane, nlb); \
            load_row_fp8raw(Y8 + (size_t)(sb[(ts_).x >> 20] + ((ts_).x & 0xfffff)) * D, C.lane, nya0); load_row_fp8raw(Y8 + (size_t)(sb[(ts_).y >> 20] + ((ts_).y & 0xfffff)) * D, C.lane, nya1); \
            load_row_fp8raw(Y8 + (size_t)(sb[(ts_).z >> 20] + ((ts_).z & 0xfffff)) * D, C.lane, nyb0); load_row_fp8raw(Y8 + (size_t)(sb[(ts_).w >> 20] + ((ts_).w & 0xfffff)) * D, C.lane, nyb1); } while (0)
        { const int r0 = min(rfirst, rlast), r1 = min(rfirst + 2 * NW, rlast);
          ts1 = *(const i32x4r*)(TS + r0 * 2); tw1 = *(const f32x4*)(TW + r0 * 2); ts2 = *(const i32x4r*)(TS + r1 * 2); tw2 = *(const f32x4*)(TW + r1 * 2); }
        FIN_FETCH(min(rfirst, rlast), ts1);
        for (int ra = rfirst; ra < sbnd; ra += 2 * NW) {
            const int rb = ra + 1;
            u32x2 la[4], lb[4]; unsigned ya0[4], ya1[4], yb0[4], yb1[4];
#pragma unroll
            for (int q = 0; q < 4; ++q) { la[q] = nla[q]; lb[q] = nlb[q]; ya0[q] = nya0[q]; ya1[q] = nya1[q]; yb0[q] = nyb0[q]; yb1[q] = nyb1[q]; }
            const f32x4 twc = tw1;
            ts1 = ts2; tw1 = tw2;
            { const int r2 = min(ra + 4 * NW, rlast); ts2 = *(const i32x4r*)(TS + r2 * 2); tw2 = *(const f32x4*)(TW + r2 * 2); }
            FIN_FETCH(min(ra + 2 * NW, rlast), ts1);
            const float wa0 = twc.x * (1.0f / YSCALE), wa1 = twc.y * (1.0f / YSCALE), wb0 = twc.z * (1.0f / YSCALE), wb1 = twc.w * (1.0f / YSCALE);
            f32x4 va[4], vb[4];
#pragma unroll
            for (int q = 0; q < 4; ++q) { va[q] = bf4(la[q]) + g2[q] * (fp8x4(ya0[q]) * wa0 + fp8x4(ya1[q]) * wa1); vb[q] = bf4(lb[q]) + g2[q] * (fp8x4(yb0[q]) * wb0 + fp8x4(yb1[q]) * wb1); }
            const float rra = row_rstd(va), rrb = row_rstd(vb);
#pragma unroll
            for (int q = 0; q < 4; ++q) { *(f32x4*)(A.out + (size_t)ra * D + 4 * C.lane + 256 * q) = (va[q] * rra) * fg[q]; *(f32x4*)(A.out + (size_t)rb * D + 4 * C.lane + 256 * q) = (vb[q] * rrb) * fg[q]; }
        }
#undef FIN_FETCH
        sa = sbnd;
    }
}

__device__ __forceinline__ void phase_conv(const Args& A, const Ctx& C, int l) {
    const int j = l >> 1; const int nrows = (l <= 1) ? NR : NL;
    const bf16* P = (const bf16*)(A.ws + WS_PB); unsigned char* HM = A.ws + WS_HM; float* RSC = (float*)(A.ws + WS_RSC);
    const float* cw = A.in[13] + (size_t)j * 3 * D;
    f32x4 w0[4], w1[4], w2[4];
    load_row_f32(cw, C.lane, w0); load_row_f32(cw + D, C.lane, w1); load_row_f32(cw + 2 * D, C.lane, w2);
    const int rpw = (((nrows + C.G - 1) / C.G) + 1) & ~1; const int wrow0 = C.bid * rpw; const int wend = min(wrow0 + rpw, nrows);
    for (int ra = wrow0 + 2 * C.wave; ra < wend; ra += 2 * NW) {
        const int rb = ra + 1;
        const int ta = ra < NL ? (ra & 63) : ((ra - NL) & 255), tb1 = rb < NL ? (rb & 63) : ((rb - NL) & 255), tlast = ra < NL ? 63 : 255;
        const bool hasl = ta != 0, hasr = tb1 != tlast;
        const bf16* pa = P + (size_t)ra * PW;
        u32x2 bga[4], bgb[4], zm[4], z0[4], z1[4], z2[4];
        load_row_bf16raw(pa, C.lane, bga); load_row_bf16raw(pa + PW, C.lane, bgb);
        load_row_bf16raw(pa + D, C.lane, z0); load_row_bf16raw(pa + PW + D, C.lane, z1);
        load_row_bf16raw(hasl ? pa - PW + D : pa + D, C.lane, zm); load_row_bf16raw(hasr ? pa + 2 * PW + D : pa + D, C.lane, z2);
        const float fl = hasl ? 1.f : 0.f, fr = hasr ? 1.f : 0.f;
        f32x4 oa[4], ob[4];
#pragma unroll
        for (int q = 0; q < 4; ++q) { const f32x4 a0 = bf4(z0[q]), a1 = bf4(z1[q]);
            oa[q] = bf4(bga[q]) * (w0[q] * (bf4(zm[q]) * fl) + w1[q] * a0 + w2[q] * a1);
            ob[q] = bf4(bgb[q]) * (w0[q] * a0 + w1[q] * a1 + w2[q] * (bf4(z2[q]) * fr)); }
        float ma = 0.f, mb = 0.f;
#pragma unroll
        for (int q = 0; q < 4; ++q) { ma = fmaxf(ma, fmaxf(fmaxf(fabsf(oa[q].x), fabsf(oa[q].y)), fmaxf(fabsf(oa[q].z), fabsf(oa[q].w)))); mb = fmaxf(mb, fmaxf(fmaxf(fabsf(ob[q].x), fabsf(ob[q].y)), fmaxf(fabsf(ob[q].z), fabsf(ob[q].w)))); }
        ma = fmaxf(wave_max_nn(ma), 1.0e-20f); mb = fmaxf(wave_max_nn(mb), 1.0e-20f);
        const float ia = 127.0f / ma, ib = 127.0f / mb;
#pragma unroll
        for (int q = 0; q < 4; ++q) { *(unsigned*)(HM + (size_t)ra * D + 4 * C.lane + 256 * q) = pack_i8_nc(oa[q] * ia); *(unsigned*)(HM + (size_t)rb * D + 4 * C.lane + 256 * q) = pack_i8_nc(ob[q] * ib); }
        if (C.lane == 0) { RSC[ra] = ma * (1.0f / 127.0f); RSC[rb] = mb * (1.0f / 127.0f); }
    }
}

constexpr int BM = 256, BK = 64, HALF = 128, HTB = HALF * BK * 2, STAGE_BYTES = 8 * HTB, NXCD = 8, WGM = 8;
constexpr int LDS_TAB = STAGE_BYTES;
__device__ __forceinline__ int lds_byte(int r, int c) { const int st = (r >> 4) * 2 + (c >> 5), rr = r & 15, cc = c & 31, ob = rr * 64 + cc * 2; return st * 1024 + (ob ^ (((ob >> 9) & 1) << 5)); }
__device__ __forceinline__ void stage_rc(int b, int& R, int& C) { const int st = b / 1024, sb = b % 1024, swz = sb ^ (((sb >> 9) & 1) << 5); R = (st >> 1) * 16 + swz / 64; C = (st & 1) * 32 + (swz % 64) / 2; }
__device__ __forceinline__ int perm32(int rho) { const int n = rho >> 4, i = rho & 15; return 8 * (i >> 2) + 4 * n + (i & 3); }
__device__ __forceinline__ unsigned cvt_pk_bf16(float lo, float hi) { unsigned r; asm volatile("v_cvt_pk_bf16_f32 %0, %1, %2" : "=v"(r) : "v"(lo), "v"(hi)); return r; }

struct GUnit { const char* a; const char* b; int orow, ocol, aux; };

typedef int i32x8 __attribute__((ext_vector_type(8)));
typedef int i32x4 __attribute__((ext_vector_type(4)));
template <class Epi, class Sched, bool GATHER, int OPM = 0>
__device__ __forceinline__ void gemm_phase(LAS unsigned char* lds, const int K, const Sched& S, const Epi& E) {
    const int tid = threadIdx.x, wid = __builtin_amdgcn_readfirstlane(tid >> 6), lane = tid & 63, wr = wid >> 2, wc = wid & 3, fr = lane & 15, fq = lane >> 4;
    constexpr bool FP8 = (OPM == 1), I8 = (OPM == 2);
    const int RB = (OPM != 0) ? K : 2 * K;
    const int nt = RB / (BK * 2);
    unsigned voffB[2], voA[2][2]; int Rr[2], Cc[2];
#pragma unroll
    for (int i = 0; i < 2; ++i) { int R, C; stage_rc(tid * 16 + i * 8192, R, C); const int Rb = (R & ~31) + perm32(R & 31); Rr[i] = R; Cc[i] = C;
        voffB[i] = (unsigned)(Rb * RB + C * 2);
        voA[0][i] = (unsigned)(R * RB + C * 2); voA[1][i] = (unsigned)((R + HALF) * RB + C * 2); }
    const size_t kstep = (size_t)(BK * 2);
    const size_t hstep = (size_t)HALF * RB;
    const unsigned ldsw = (unsigned)wid * 1024u;
    const unsigned ldsbase = (unsigned)(size_t)lds;
    const int aoff = lds_byte(wr * 64 + fr, fq * 8), boff = lds_byte(wc * 32 + fr, fq * 8);
#define PG8_SA(b, h) (((b) * 2 + (h)) * HTB)
#define PG8_SB(b, h) ((4 + (b) * 2 + (h)) * HTB)
#define PG8_STAGE(bufoff, gbase, voff) do { _Pragma("unroll") for (int _i = 0; _i < 2; ++_i) \
        asm volatile("s_mov_b32 m0, %2\n\ts_nop 0\n\tglobal_load_lds_dwordx4 %0, %1" :: "v"((voff)[_i]), "s"((const char*)(gbase)), "s"(ldsbase + (unsigned)(bufoff) + ldsw + (unsigned)(_i * 8192)) : "memory"); } while (0)
#define PG8_STAGE_A1(bufoff, gbase) do { if constexpr (GATHER) PG8_STAGE(bufoff, gbase, voA[1]); else PG8_STAGE(bufoff, (const char*)(gbase) + hstep, voA[0]); } while (0)
#define PG8_LDA(dst, b, h) do { if constexpr (FP8) { _Pragma("unroll") for (int m = 0; m < 4; ++m) { \
        const i32x4 _lo = *(const LAS i32x4*)(lds + PG8_SA(b, h) + aoff + m * 2048), _hi = *(const LAS i32x4*)(lds + PG8_SA(b, h) + aoff + m * 2048 + 1024); \
        dst##8[m] = __builtin_shufflevector(_lo, _hi, 0, 1, 2, 3, 4, 5, 6, 7); } } \
      else { _Pragma("unroll") for (int m = 0; m < 4; ++m) _Pragma("unroll") for (int k = 0; k < 2; ++k) dst[m][k] = *(const LAS bf16x8*)(lds + PG8_SA(b, h) + aoff + m * 2048 + k * 1024); } } while (0)
#define PG8_LDB(dst, b, h) do { if constexpr (FP8) { _Pragma("unroll") for (int n = 0; n < 2; ++n) { \
        const i32x4 _lo = *(const LAS i32x4*)(lds + PG8_SB(b, h) + boff + n * 2048), _hi = *(const LAS i32x4*)(lds + PG8_SB(b, h) + boff + n * 2048 + 1024); \
        dst##8[n] = __builtin_shufflevector(_lo, _hi, 0, 1, 2, 3, 4, 5, 6, 7); } } \
      else { _Pragma("unroll") for (int n = 0; n < 2; ++n) _Pragma("unroll") for (int k = 0; k < 2; ++k) dst[n][k] = *(const LAS bf16x8*)(lds + PG8_SB(b, h) + boff + n * 2048 + k * 1024); } } while (0)
#define PG8_MMA(ai, bj, At, Bt) do { __builtin_amdgcn_s_setprio(1); \
        if constexpr (FP8) { _Pragma("unroll") for (int m = 0; m < 4; ++m) _Pragma("unroll") for (int n = 0; n < 2; ++n) \
            acc[ai][bj][m][n] = __builtin_amdgcn_mfma_scale_f32_16x16x128_f8f6f4(Bt##8[n], At##8[m], acc[ai][bj][m][n], 0, 0, 0, 0x7f7f7f7f, 0, 0x7f7f7f7f); } \
        else if constexpr (I8) { _Pragma("unroll") for (int m = 0; m < 4; ++m) _Pragma("unroll") for (int n = 0; n < 2; ++n) _Pragma("unroll") for (int k = 0; k < 2; ++k) \
            acc[ai][bj][m][n] = __builtin_bit_cast(f32x4, __builtin_amdgcn_mfma_i32_16x16x64_i8(__builtin_bit_cast(i32x4, Bt[n][k]), __builtin_bit_cast(i32x4, At[m][k]), __builtin_bit_cast(i32x4, acc[ai][bj][m][n]), 0, 0, 0)); } \
        else { _Pragma("unroll") for (int m = 0; m < 4; ++m) _Pragma("unroll") for (int n = 0; n < 2; ++n) _Pragma("unroll") for (int k = 0; k < 2; ++k) \
            acc[ai][bj][m][n] = __builtin_amdgcn_mfma_f32_16x16x32_bf16(Bt[n][k], At[m][k], acc[ai][bj][m][n], 0, 0, 0); } \
        __builtin_amdgcn_s_setprio(0); } while (0)
#define PG8_WAIT_V(n) asm volatile("s_waitcnt vmcnt(" #n ")" ::: "memory")
#define PG8_WAIT_L(n) asm volatile("s_waitcnt lgkmcnt(" #n ")" ::: "memory")
#define PG8_BAR __builtin_amdgcn_s_barrier()
#define PG8_SCHED __builtin_amdgcn_sched_barrier(0)
    GUnit cur, nxt; int ui = 0;
    if (!S.next(0, cur)) return;
    if constexpr (GATHER) {
#pragma unroll
        for (int h = 0; h < 2; ++h)
#pragma unroll
            for (int i = 0; i < 2; ++i) voA[h][i] = S.arow_off(0, h * HALF + Rr[i]) + (unsigned)Cc[i] * 2u;
    }
    f32x4 acc[2][2][4][2];
#pragma unroll
    for (int a = 0; a < 2; ++a)
#pragma unroll
        for (int b = 0; b < 2; ++b)
#pragma unroll
            for (int m = 0; m < 4; ++m)
#pragma unroll
                for (int n = 0; n < 2; ++n) acc[a][b][m][n] = (f32x4){0.f, 0.f, 0.f, 0.f};
    bf16x8 At[4][2], B0[2][2], B1[2][2]; i32x8 At8[4], B08[2], B18[2];
    const char* cA = cur.a; const char* cB = cur.b;
    PG8_STAGE(PG8_SB(0, 0), cB, voffB); PG8_STAGE(PG8_SB(0, 1), cB + hstep, voffB); PG8_STAGE(PG8_SA(0, 0), cA, voA[0]); PG8_STAGE_A1(PG8_SA(0, 1), cA);
    if (wr == 1) PG8_BAR;
    PG8_WAIT_V(2); PG8_BAR;
    PG8_STAGE(PG8_SB(1, 0), cB + kstep, voffB); PG8_STAGE(PG8_SA(1, 0), cA + kstep, voA[0]); PG8_STAGE(PG8_SB(1, 1), cB + hstep + kstep, voffB);
    PG8_WAIT_V(6); PG8_BAR;
    for (;;) {
        const bool has_next = S.next(ui + 1, nxt);
        const char* nA = has_next ? nxt.a : cA; const char* nB = has_next ? nxt.b : cB;
#pragma unroll 1
        for (int t = 0; t < nt; t += 2) {
            const bool last = (t == nt - 2);
            const char* a1 = cA + (size_t)(t + 1) * kstep;
            const char* a2 = last ? nA : cA + (size_t)(t + 2) * kstep; const char* b2 = last ? nB : cB + (size_t)(t + 2) * kstep;
            const char* a3 = a2 + kstep; const char* b3 = b2 + kstep;
            PG8_LDB(B0, 0, 0); PG8_LDB(B1, 0, 1); PG8_SCHED; PG8_LDA(At, 0, 0); PG8_STAGE_A1(PG8_SA(1, 1), a1);
            if constexpr (GATHER) { if (last && has_next) {
#pragma unroll
                for (int h = 0; h < 2; ++h)
#pragma unroll
                    for (int i = 0; i < 2; ++i) { int R2, C2; stage_rc(tid * 16 + i * 8192, R2, C2); voA[h][i] = S.arow_off(ui + 1, h * HALF + R2) + (unsigned)C2 * 2u; } } }
            PG8_WAIT_V(8); PG8_WAIT_L(0); PG8_BAR; PG8_MMA(0, 0, At, B0); PG8_MMA(0, 1, At, B1); PG8_BAR; PG8_SCHED;
            PG8_LDA(At, 0, 1); PG8_STAGE(PG8_SB(0, 0), b2, voffB); PG8_STAGE(PG8_SB(0, 1), b2 + hstep, voffB); PG8_STAGE(PG8_SA(0, 0), a2, voA[0]);
            PG8_WAIT_V(8); PG8_WAIT_L(0); PG8_BAR; PG8_MMA(1, 0, At, B0); PG8_MMA(1, 1, At, B1); PG8_BAR; PG8_SCHED;
            PG8_LDB(B0, 1, 0); PG8_LDB(B1, 1, 1); PG8_SCHED; PG8_LDA(At, 1, 0); PG8_STAGE_A1(PG8_SA(0, 1), a2);
            PG8_WAIT_V(8); PG8_WAIT_L(0); PG8_BAR; PG8_MMA(0, 0, At, B0); PG8_MMA(0, 1, At, B1); PG8_BAR; PG8_SCHED;
            PG8_LDA(At, 1, 1); PG8_STAGE(PG8_SB(1, 0), b3, voffB); PG8_STAGE(PG8_SB(1, 1), b3 + hstep, voffB); PG8_STAGE(PG8_SA(1, 0), a3, voA[0]);
            PG8_WAIT_V(8); PG8_WAIT_L(0); PG8_BAR; PG8_MMA(1, 0, At, B0); PG8_MMA(1, 1, At, B1); PG8_BAR; PG8_SCHED;
        }
        if (wr == 0) PG8_BAR;
        { int tz = threadIdx.x; asm volatile("" : "+v"(tz));
          if constexpr (I8) {
#pragma unroll
              for (int a_ = 0; a_ < 2; ++a_)
#pragma unroll
                  for (int b_ = 0; b_ < 2; ++b_)
#pragma unroll
                      for (int m = 0; m < 4; ++m)
#pragma unroll
                          for (int n = 0; n < 2; ++n) acc[a_][b_][m][n] = __builtin_convertvector(__builtin_bit_cast(i32x4, acc[a_][b_][m][n]), f32x4); }
          const int wz = tz >> 6, lz = tz & 63; E(acc, cur, wz >> 2, wz & 3, lz & 15, lz >> 4); }
        if (!has_next) break;
#pragma unroll
        for (int a = 0; a < 2; ++a)
#pragma unroll
            for (int b = 0; b < 2; ++b)
#pragma unroll
                for (int m = 0; m < 4; ++m)
#pragma unroll
                    for (int n = 0; n < 2; ++n) acc[a][b][m][n] = (f32x4){0.f, 0.f, 0.f, 0.f};
        cur = nxt; cA = nA; cB = nB; ++ui;
        if (wr == 1) PG8_BAR;
    }
    PG8_WAIT_V(0);
    PG8_BAR;
#undef PG8_SA
#undef PG8_SB
#undef PG8_STAGE
#undef PG8_STAGE_A1
#undef PG8_LDA
#undef PG8_LDB
#undef PG8_MMA
#undef PG8_WAIT_V
#undef PG8_WAIT_L
#undef PG8_BAR
#undef PG8_SCHED
}

__device__ __forceinline__ int xcd_remap(int L, int nwg) { const int q = nwg / NXCD, r = nwg % NXCD, xcd = L % NXCD, off = L / NXCD; return (xcd < r ? xcd * (q + 1) : r * (q + 1) + (xcd - r) * q) + off; }

struct DenseSched {
    const char* A; const char* Bt; int nM, nN, nwg, G, c; size_t tstep; int sw_lo, sw_hi;
    __device__ __forceinline__ void init(const void* A_, const void* Bt_, int M, int N, int K, int G_, int c_, int ebytes = 2) { A = (const char*)A_; Bt = (const char*)Bt_; nM = M / BM; nN = N / BM; nwg = nM * nN; G = G_; c = c_; tstep = (size_t)BM * K * ebytes; sw_lo = 0; sw_hi = 0; }
    __device__ __forceinline__ bool next(int i, GUnit& u) const {
        const long L = (long)i * G + c; if (L >= nwg) return false;
        const int wgid = xcd_remap((int)L, nwg);
        const int nig = WGM * nN, gid = wgid / nig, fm = gid * WGM, gsz = (nM - fm) < WGM ? (nM - fm) : WGM;
        const int pm = fm + ((wgid % nig) % gsz), pn = (wgid % nig) / gsz;
        if (pn >= sw_lo && pn < sw_hi) { u.a = Bt + (size_t)pn * tstep; u.b = A + (size_t)pm * tstep; u.orow = pm; u.ocol = pn - sw_lo; u.aux = 1; }
        else { u.a = A + (size_t)pm * tstep; u.b = Bt + (size_t)pn * tstep; u.orow = pm * BM; u.ocol = pn * BM; u.aux = 0; }
        return true;
    }
    __device__ __forceinline__ unsigned arow_off(int, int) const { return 0u; }
};

constexpr int MAXU = 12;
struct MoeTab { int n; int e[MAXU], mb[MAXU], nt[MAXU]; int sb[NE + 1]; };
struct MoeSched {
    LAS const MoeTab* T; LAS const unsigned* ridx;
    const char* A; const char* W; size_t wstride_e, tstepB; int K; int arow_bytes;
    __device__ __forceinline__ bool next(int i, GUnit& u) const {
        const int n = __builtin_amdgcn_readfirstlane(T->n); if (i >= n) return false;
        const int e = __builtin_amdgcn_readfirstlane(T->e[i]), mb = __builtin_amdgcn_readfirstlane(T->mb[i]), nt = __builtin_amdgcn_readfirstlane(T->nt[i]);
        const int base = __builtin_amdgcn_readfirstlane(T->sb[e]);
        u.orow = base + mb * BM; u.ocol = nt; u.aux = e;
        u.a = A + (size_t)u.orow * arow_bytes;
        u.b = W + (size_t)e * wstride_e + (size_t)nt * tstepB; return true;
    }
    __device__ __forceinline__ unsigned arow_off(int i, int r) const { return ridx[i * 256 + r]; }
};
template <bool GATHER>
__device__ __forceinline__ void moe_tables(const Args& A, const Ctx& C, int l, int ntile_n, LAS MoeTab* T, LAS unsigned* ridx, int arow_bytes) {
    const unsigned* cnt = (const unsigned*)(A.ws + WS_CTL) + CW_CNT + l * 32 * CNT_STRIDE;
    LAS int* ust = (LAS int*)(T + 1);
    LAS int* cntv = ust + 33;
    if (C.tid < 64) { int nb; const int ex = expert_block_prefix(cnt, C.tid, nb); if (C.tid <= NE) { T->sb[C.tid] = ex * 256; ust[C.tid] = ex * ntile_n; } if (C.tid < NE) cntv[C.tid] = (int)cnt[C.tid * CNT_STRIDE]; }
    __syncthreads();
    if (C.tid < MAXU) { const int nwg = ust[NE]; const long L = (long)C.tid * C.G + C.bid;
        if (L < nwg) { const int w = xcd_remap((int)L, nwg); int e = 0; while (w >= ust[e + 1]) ++e;
            const int lu = w - ust[e]; T->e[C.tid] = e; T->mb[C.tid] = lu / ntile_n; T->nt[C.tid] = lu % ntile_n; } }
    if (C.tid == 0) { const int nwg = ust[NE]; int n = 0; while (n < MAXU && (long)n * C.G + C.bid < nwg) ++n; T->n = n; }
    __syncthreads();
    if constexpr (GATHER) {
        const int* ST = (const int*)(A.ws + WS_SLOTTOK); const int n = T->n;
        for (int i = C.tid; i < n * 256; i += NT) { const int ui = i >> 8, r = i & 255, e = T->e[ui], m0 = T->mb[ui] * 256, ce = cntv[e];
            const int rr = (m0 + r < ce) ? m0 + r : ce - 1;
            ridx[i] = (unsigned)ST[(size_t)e * CAP + rr] * (unsigned)arow_bytes; }
        __syncthreads();
    }
}

struct EpiStore { bf16* O; int ldc; float scale_lo; int sig_from; bf16* VT; float sall = 1.0f; const float* rs = nullptr;
    __device__ __forceinline__ void operator()(const f32x4 (&acc)[2][2][4][2], const GUnit& u, int wr, int wc, int fr, int fq) const {
        const bool tr = u.aux != 0;
        const float sc = ((!tr && u.ocol < NQ) ? scale_lo : 1.0f) * sall; const bool sg = !tr && u.ocol >= sig_from;
        bf16* Ob = tr ? VT + (size_t)(u.orow * NH + u.ocol) * 65536 : O + (size_t)u.orow * ldc + u.ocol; const int ld = tr ? 256 : ldc;
        f32x4 cs[2][2];
#pragma unroll
        for (int bj = 0; bj < 2; ++bj) { const f32x4 one = (f32x4){1.f, 1.f, 1.f, 1.f};
            cs[bj][0] = (rs && tr) ? *(const f32x4*)(rs + u.orow * BM + bj * HALF + wc * 32 + 8 * fq) : one; cs[bj][1] = (rs && tr) ? *(const f32x4*)(rs + u.orow * BM + bj * HALF + wc * 32 + 8 * fq + 4) : one; }
#pragma unroll
        for (int ai = 0; ai < 2; ++ai)
#pragma unroll
            for (int m = 0; m < 4; ++m) { const int rl = ai * HALF + wr * 64 + m * 16 + fr; bf16* rowp = tr ? Ob + wc * 8192 + rl * 32 + 8 * fq : Ob + (size_t)rl * ld + wc * 32 + 8 * fq;

                const float scr = (rs && !tr) ? sc * rs[u.orow + rl] : sc;
#pragma unroll
                for (int bj = 0; bj < 2; ++bj) { f32x4 v0 = acc[ai][bj][m][0] * scr * cs[bj][0], v1 = acc[ai][bj][m][1] * scr * cs[bj][1];
                    if (sg) {
#pragma unroll
                        for (int q = 0; q < 4; ++q) { v0[q] = __builtin_amdgcn_rcpf(1.0f + __expf(-v0[q])); v1[q] = __builtin_amdgcn_rcpf(1.0f + __expf(-v1[q])); } }
                    u32x4 w; w.x = cvt_pk_bf16(v0[0], v0[1]); w.y = cvt_pk_bf16(v0[2], v0[3]); w.z = cvt_pk_bf16(v1[0], v1[1]); w.w = cvt_pk_bf16(v1[2], v1[3]);
                    *(u32x4*)(rowp + (tr ? bj * 4 * 8192 : bj * HALF)) = w; } }
    }
};
__device__ __forceinline__ u32x2 cvt8_fp8(f32x4 a, f32x4 b) { int lo = 0, hi = 0;
    lo = __builtin_amdgcn_cvt_pk_fp8_f32(a[0], a[1], lo, false); lo = __builtin_amdgcn_cvt_pk_fp8_f32(a[2], a[3], lo, true);
    hi = __builtin_amdgcn_cvt_pk_fp8_f32(b[0], b[1], hi, false); hi = __builtin_amdgcn_cvt_pk_fp8_f32(b[2], b[3], hi, true); return (u32x2){(unsigned)lo, (unsigned)hi}; }
struct EpiSwigluF8 { unsigned char* O; int ldc; float s;
    __device__ __forceinline__ void operator()(const f32x4 (&acc)[2][2][4][2], const GUnit& u, int wr, int wc, int fr, int fq) const {
        const int ocol = u.ocol * HALF;
#pragma unroll
        for (int ai = 0; ai < 2; ++ai)
#pragma unroll
            for (int m = 0; m < 4; ++m) { unsigned char* rowp = O + (size_t)(u.orow + ai * HALF + wr * 64 + m * 16 + fr) * ldc + ocol + wc * 32 + 8 * fq;
                f32x4 v0, v1;
#pragma unroll
                for (int q = 0; q < 4; ++q) { const float x0 = acc[ai][0][m][0][q] * s, x1 = acc[ai][0][m][1][q] * s;
                    v0[q] = x0 * __builtin_amdgcn_rcpf(1.0f + __expf(-x0)) * (acc[ai][1][m][0][q] * s); v1[q] = x1 * __builtin_amdgcn_rcpf(1.0f + __expf(-x1)) * (acc[ai][1][m][1][q] * s); }
                *(u32x2*)rowp = cvt8_fp8(v0, v1); }
    }
};
template <int MODE> struct EpiPair { bf16* O; int ldc; int plain_below; float sall = 1.0f; const float* rs = nullptr;
    __device__ __forceinline__ void operator()(const f32x4 (&acc)[2][2][4][2], const GUnit& u, int wr, int wc, int fr, int fq) const {
        if (MODE == 0 && u.ocol < plain_below) {
#pragma unroll
            for (int ai = 0; ai < 2; ++ai)
#pragma unroll
                for (int m = 0; m < 4; ++m) { const int rg = u.orow + ai * HALF + wr * 64 + m * 16 + fr; bf16* rowp = O + (size_t)rg * ldc + u.ocol + wc * 32 + 8 * fq;
                    const float scr = rs ? sall * rs[rg] : sall;
#pragma unroll
                    for (int bj = 0; bj < 2; ++bj) { const f32x4 v0 = acc[ai][bj][m][0] * scr, v1 = acc[ai][bj][m][1] * scr;
                        u32x4 w; w.x = cvt_pk_bf16(v0[0], v0[1]); w.y = cvt_pk_bf16(v0[2], v0[3]); w.z = cvt_pk_bf16(v1[0], v1[1]); w.w = cvt_pk_bf16(v1[2], v1[3]);
                        *(u32x4*)(rowp + bj * HALF) = w; } }
            return;
        }
        const int ocol = (MODE == 0) ? plain_below + (u.ocol - plain_below) / 2 : u.ocol * HALF;
#pragma unroll
        for (int ai = 0; ai < 2; ++ai)
#pragma unroll
            for (int m = 0; m < 4; ++m) { const int rg = u.orow + ai * HALF + wr * 64 + m * 16 + fr; bf16* rowp = O + (size_t)rg * ldc + ocol + wc * 32 + 8 * fq;
                const float scr = rs ? sall * rs[rg] : sall; const float sc2 = scr * scr;
                f32x4 v0, v1;
#pragma unroll
                for (int q = 0; q < 4; ++q) {
                    const float x0 = acc[ai][0][m][0][q], x1 = acc[ai][0][m][1][q];
                    const float g0 = (MODE == 1) ? x0 * __builtin_amdgcn_rcpf(1.0f + __expf(-x0)) : x0, g1 = (MODE == 1) ? x1 * __builtin_amdgcn_rcpf(1.0f + __expf(-x1)) : x1;
                    v0[q] = g0 * acc[ai][1][m][0][q] * sc2; v1[q] = g1 * acc[ai][1][m][1][q] * sc2; }
                u32x4 w; w.x = cvt_pk_bf16(v0[0], v0[1]); w.y = cvt_pk_bf16(v0[2], v0[3]); w.z = cvt_pk_bf16(v1[0], v1[1]); w.w = cvt_pk_bf16(v1[2], v1[3]);
                *(u32x4*)rowp = w; }
    }
};
struct EpiResid { bf16* LAT; const float* g1; float sall; const float* rs;
    __device__ __forceinline__ void operator()(const f32x4 (&acc)[2][2][4][2], const GUnit& u, int wr, int wc, int fr, int fq) const {
        bf16* Ob = LAT + (size_t)u.orow * D + u.ocol + wc * 32 + 8 * fq;
        u32x4 old[2][4][2];
#pragma unroll
        for (int ai = 0; ai < 2; ++ai)
#pragma unroll
            for (int m = 0; m < 4; ++m)
#pragma unroll
                for (int bj = 0; bj < 2; ++bj) old[ai][m][bj] = *(const u32x4*)(Ob + (size_t)(ai * HALF + wr * 64 + m * 16 + fr) * D + bj * HALF);
        const float* gv = g1 + (size_t)mod_vec_of_row(u.orow) * 6 * D + u.ocol + wc * 32 + 8 * fq;
        f32x4 g[2][2];
#pragma unroll
        for (int bj = 0; bj < 2; ++bj) { g[bj][0] = *(const f32x4*)(gv + bj * HALF); g[bj][1] = *(const f32x4*)(gv + bj * HALF + 4); }
#pragma unroll
        for (int ai = 0; ai < 2; ++ai)
#pragma unroll
            for (int m = 0; m < 4; ++m) { const int rl = ai * HALF + wr * 64 + m * 16 + fr; bf16* rowp = Ob + (size_t)rl * D;
                const float scr = rs ? sall * rs[u.orow + rl] : sall;
#pragma unroll
                for (int bj = 0; bj < 2; ++bj) { const u32x4 o = old[ai][m][bj];
                    const f32x4 v0 = bf4((u32x2){o.x, o.y}) + g[bj][0] * (acc[ai][bj][m][0] * scr), v1 = bf4((u32x2){o.z, o.w}) + g[bj][1] * (acc[ai][bj][m][1] * scr);
                    u32x4 w; w.x = cvt_pk_bf16(v0[0], v0[1]); w.y = cvt_pk_bf16(v0[2], v0[3]); w.z = cvt_pk_bf16(v1[0], v1[1]); w.w = cvt_pk_bf16(v1[2], v1[3]);
                    *(u32x4*)(rowp + bj * HALF) = w; } }
    }
};
struct EpiStoreTile { unsigned char* O; int ldc; float s;
    __device__ __forceinline__ void operator()(const f32x4 (&acc)[2][2][4][2], const GUnit& u, int wr, int wc, int fr, int fq) const {
#pragma unroll
        for (int ai = 0; ai < 2; ++ai)
#pragma unroll
            for (int m = 0; m < 4; ++m) { unsigned char* rowp = O + (size_t)(u.orow + ai * HALF + wr * 64 + m * 16 + fr) * ldc + u.ocol * BM + wc * 32 + 8 * fq;
#pragma unroll
                for (int bj = 0; bj < 2; ++bj) *(u32x2*)(rowp + bj * HALF) = cvt8_fp8(acc[ai][bj][m][0] * s, acc[ai][bj][m][1] * s); }
    }
};

__device__ __forceinline__ void transpose_item(const float* W, int ldw, int K, bf16* WT, int drow0, int k0, int n0, LAS float* scr, int lane) {
#pragma unroll
    for (int i = 0; i < 32; ++i) { const int kk = 2 * i + (lane >> 5); scr[kk * 33 + (lane & 31)] = W[(size_t)(k0 + kk) * ldw + n0 + (lane & 31)]; }
    asm volatile("s_waitcnt lgkmcnt(0)" ::: "memory");
    const int c = lane & 7;
#pragma unroll
    for (int j = 0; j < 4; ++j) { const int n = (lane >> 3) + 8 * j; const LAS float* s = scr + (8 * c) * 33 + n;
        u32x4 o; o.x = pk2(s[0 * 33], s[1 * 33]); o.y = pk2(s[2 * 33], s[3 * 33]); o.z = pk2(s[4 * 33], s[5 * 33]); o.w = pk2(s[6 * 33], s[7 * 33]);
        *(u32x4*)(WT + (size_t)(drow0 + n) * K + k0 + 8 * c) = o; }
    asm volatile("s_waitcnt lgkmcnt(0)" ::: "memory");
}
__device__ __forceinline__ void transpose_item_fp8(const float* W, int ldw, int K, unsigned char* WT8, int drow0, int k0, int n0, LAS float* scr, int lane, float sc) {
#pragma unroll
    for (int i = 0; i < 32; ++i) { const int kk = 2 * i + (lane >> 5); scr[kk * 33 + (lane & 31)] = W[(size_t)(k0 + kk) * ldw + n0 + (lane & 31)]; }
    asm volatile("s_waitcnt lgkmcnt(0)" ::: "memory");
    const int n = lane >> 1, half = lane & 1; const LAS float* sp = scr + (32 * half) * 33 + n;
    unsigned char* dst = WT8 + (size_t)(drow0 + n) * K + k0 + 32 * half;
#pragma unroll
    for (int c = 0; c < 2; ++c) { u32x4 o;
#pragma unroll
        for (int q = 0; q < 4; ++q) { int p = 0; const LAS float* s4 = sp + (16 * c + 4 * q) * 33;
            p = __builtin_amdgcn_cvt_pk_fp8_f32(s4[0] * sc, s4[33] * sc, p, false); p = __builtin_amdgcn_cvt_pk_fp8_f32(s4[66] * sc, s4[99] * sc, p, true); o[q] = (unsigned)p; }
        *(u32x4*)(dst + 16 * c) = o; }
    asm volatile("s_waitcnt lgkmcnt(0)" ::: "memory");
}
__device__ __forceinline__ void transpose_item_i8(const float* W, int ldw, int K, unsigned char* WT8, int drow0, int k0, int n0, LAS float* scr, int lane, float inv) {
#pragma unroll
    for (int i = 0; i < 32; ++i) { const int kk = 2 * i + (lane >> 5); scr[kk * 33 + (lane & 31)] = W[(size_t)(k0 + kk) * ldw + n0 + (lane & 31)]; }
    asm volatile("s_waitcnt lgkmcnt(0)" ::: "memory");
    const int n = lane >> 1, half = lane & 1; const LAS float* sp = scr + (32 * half) * 33 + n;
    unsigned char* dst = WT8 + (size_t)(drow0 + n) * K + k0 + 32 * half;
#pragma unroll
    for (int c = 0; c < 2; ++c) { u32x4 o;
#pragma unroll
        for (int q = 0; q < 4; ++q) { const LAS float* s4 = sp + (16 * c + 4 * q) * 33; o[q] = pack_i8((f32x4){s4[0] * inv, s4[33] * inv, s4[66] * inv, s4[99] * inv}); }
        *(u32x4*)(dst + 16 * c) = o; }
    asm volatile("s_waitcnt lgkmcnt(0)" ::: "memory");
}
__device__ __forceinline__ int pair_row(int n, int which) { return (n >> 7) * 256 + (n & 127) + which * 128; }
constexpr float HMR = 6.0f;
__device__ __forceinline__ void phase_cvt_mixer(const Args& A, const Ctx& C) {
    const int gw = C.bid * NW + C.wave, NGW = C.G * NW;
    unsigned* wmax = (unsigned*)(A.ws + WS_CTL) + CW_WMAX;
    for (int m8 = 0; m8 < 8; ++m8) {
        const float* W = m8 < 2 ? A.in[8] + (size_t)m8 * D * PROJ : m8 < 4 ? A.in[12] + (size_t)(m8 - 2) * D * PW : m8 < 6 ? A.in[11] + (size_t)(m8 - 4) * D * D : A.in[14] + (size_t)(m8 - 6) * D * D;
        const size_t n4 = (size_t)D * (m8 < 2 ? PROJ : m8 < 4 ? PW : D) / 4;
        float mx = 0.f;
        for (size_t i0 = (size_t)gw * 64 + C.lane; i0 < n4; i0 += (size_t)NGW * 64 * 8) {
            f32x4 v[8];
#pragma unroll
            for (int j = 0; j < 8; ++j) { const size_t i = i0 + (size_t)j * NGW * 64; v[j] = *(const f32x4*)(W + 4 * (i < n4 ? i : i0)); }
#pragma unroll
            for (int j = 0; j < 8; ++j) mx = fmaxf(mx, fmaxf(fmaxf(fabsf(v[j].x), fabsf(v[j].y)), fmaxf(fabsf(v[j].z), fabsf(v[j].w)))); }
        mx = wave_max_nn(mx);
        if (C.lane == 0 && mx > 0.f) atomicMax(wmax + m8 * CNT_STRIDE, __float_as_uint(mx));
    }
}
__device__ __forceinline__ void cvt_win_i8(const Args& A, const Ctx& C) {
    LAS float* scr = (LAS float*)(C.lds + 16384 + C.wave * 16384);
    const int gw = C.bid * NW + C.wave, NGW = C.G * NW;
    constexpr int I_IN = (D / 64) * (PW / 32);
    const unsigned* wmax = (const unsigned*)(A.ws + WS_CTL) + CW_WMAX;
    constexpr int I_OUT = (D / 64) * (D / 32);
    for (int it = gw; it < 4 * I_OUT; it += NGW) {
        const int m4 = it / I_OUT, kind = m4 >> 1, j = m4 & 1, r = it % I_OUT; const int kb = r / (D / 32), nb = r % (D / 32), n0 = nb * 32;
        const float inv = 127.0f / fmaxf(__uint_as_float(wmax[(4 + m4) * CNT_STRIDE]), 1.0e-30f);
        transpose_item_i8((kind == 0 ? A.in[11] : A.in[14]) + (size_t)j * D * D, D, D, A.ws + (kind == 0 ? WS_WAOUT : WS_WBOUT) + (size_t)j * D * D, n0, kb * 64, n0, scr, C.lane, inv); }
    for (int it = gw; it < 4 * I_IN; it += NGW) {
        const int m4 = it / I_IN, kind = m4 >> 1, j = m4 & 1, r = it % I_IN; const int kb = r / (PW / 32), nb = r % (PW / 32), n0 = nb * 32;
        const float inv = 127.0f / fmaxf(__uint_as_float(wmax[m4 * CNT_STRIDE]), 1.0e-30f);
        unsigned char* WT = A.ws + (kind == 0 ? WS_WAIN : WS_WBIN) + (size_t)j * PW * D;
        if (kind == 0) transpose_item_i8(A.in[8] + (size_t)j * D * PROJ, PROJ, D, WT, n0, kb * 64, n0, scr, C.lane, inv);
        else { const int drow = n0 < D ? n0 : (n0 < 2 * D ? D + pair_row(n0 - D, 0) : D + pair_row(n0 - 2 * D, 1));
            transpose_item_i8(A.in[12] + (size_t)j * D * PW, PW, D, WT, drow, kb * 64, n0, scr, C.lane, inv); }
    }
}
__device__ __forceinline__ void cvt_moe_items(const Args& A, const Ctx& C, int l, int it0, int end, int stride) {
    LAS float* scr = (LAS float*)(C.lds + 16384 + C.wave * 16384);
    unsigned char* WGU = A.ws + WS_WGU; unsigned char* WDN = A.ws + WS_WDN;
    for (int it = it0; it < end; it += stride) {
        const int e = it / CVT_PER; int r = it % CVT_PER;
        if (r < 2 * CVT_IG) { const int which = r / CVT_IG; r %= CVT_IG; const int kb = r / (DE / 32), nb = r % (DE / 32), n0 = nb * 32;
            transpose_item_fp8((which == 0 ? A.in[19] : A.in[20]) + ((size_t)l * NE + e) * D * DE, DE, D, WGU + (size_t)e * 2 * DE * D, pair_row(n0, which), kb * 64, n0, scr, C.lane, WSCALE); }
        else { r -= 2 * CVT_IG; const int kb = r / (D / 32), nb = r % (D / 32), n0 = nb * 32;
            transpose_item_fp8(A.in[21] + ((size_t)l * NE + e) * DE * D, D, DE, WDN + (size_t)e * D * DE, n0, kb * 64, n0, scr, C.lane, WSCALE); }
    }
}
__device__ __forceinline__ int cvt_idle(int nunits, int G) { const int rem = nunits % G; return rem ? G - rem : 0; }
__device__ __forceinline__ int cvt_t1(int l, int G) { const int n = cvt_idle((((l <= 2) ? NR : NL) / BM) * (PW / BM), G) * CVT_Q; return n < CVT_ITEMS ? n : CVT_ITEMS; }
__device__ __forceinline__ int cvt_t2(int l, int G) { const int n = cvt_t1(l, G) + cvt_idle((((l <= 1) ? NR : NL) / BM) * (D / BM), G) * CVT_Q; return n < CVT_ITEMS ? n : CVT_ITEMS; }
constexpr int CVT_Q3 = 40;
__device__ __forceinline__ int cvt_t3(int l, int G) { const int n = cvt_t2(l, G) + (l == 0 ? cvt_idle(BATCH * NH * (NBLK - 1) + BATCH * NH, G) * CVT_Q3 : 0); return n < CVT_ITEMS ? n : CVT_ITEMS; }
__device__ __forceinline__ void cvt_moe_tail(const Args& A, const Ctx& C, int l, int nunits, int base, int end) {
    const int rem = nunits % C.G;
    if (rem == 0 || C.bid < rem) return;
    const int first = base + (C.bid - rem) * CVT_Q; const int last = min(first + CVT_Q, end);
    cvt_moe_items(A, C, l, first + C.wave, last, NW);
}

__device__ __forceinline__ void phase_g1(const Args& A, const Ctx& C, int l) {
    const bool mls = (l & 1) == 0; const int j = l >> 1; const int nrows = (l <= 2) ? NR : NL;
    DenseSched S; S.init(A.ws + WS_H8, A.ws + (mls ? WS_WAIN : WS_WBIN) + (size_t)j * PW * D, nrows, PW, D, C.G, C.bid, 1);
    const float wsc = __uint_as_float(((const unsigned*)(A.ws + WS_CTL))[CW_WMAX + ((mls ? 0 : 2) + j) * CNT_STRIDE]) * (1.0f / 127.0f);
    const float* rs = (const float*)(A.ws + WS_RSC);
    if (mls) { S.sw_lo = 4; S.sw_hi = 8; EpiStore E{(bf16*)(A.ws + WS_PB), PW, 0.08838834764831845f, 2 * NQ + NV, (bf16*)(A.ws + WS_VT), wsc, rs}; gemm_phase<EpiStore, DenseSched, false, 2>(C.lds, D, S, E); }
    else { EpiPair<0> E{(bf16*)(A.ws + WS_PB), PW, D, wsc, rs}; gemm_phase<EpiPair<0>, DenseSched, false, 2>(C.lds, D, S, E); }
    cvt_moe_tail(A, fresh(C), l, S.nwg, 0, cvt_t1(l, C.G));
}
__device__ __forceinline__ void phase_g2(const Args& A, const Ctx& C, int l) {
    const bool mls = (l & 1) == 0; const int j = l >> 1; const int nrows = (l <= 1) ? NR : NL;
    DenseSched S; S.init(A.ws + WS_HM, A.ws + (mls ? WS_WAOUT : WS_WBOUT) + (size_t)j * D * D, nrows, D, D, C.G, C.bid, 1);
    const float wsc = __uint_as_float(((const unsigned*)(A.ws + WS_CTL))[CW_WMAX + (4 + (mls ? 0 : 2) + j) * CNT_STRIDE]) * (1.0f / 127.0f);
    EpiResid E{(bf16*)(A.ws + WS_LAT), (const float*)(A.ws + WS_MOD) + (size_t)(l * 3) * 6 * D + 2 * D, mls ? wsc * (HMR / 127.0f) : wsc, mls ? nullptr : (const float*)(A.ws + WS_RSC)}; gemm_phase<EpiResid, DenseSched, false, 2>(C.lds, D, S, E);
    cvt_moe_tail(A, fresh(C), l, S.nwg, cvt_t1(l, C.G), cvt_t2(l, C.G));
}
__device__ __forceinline__ void phase_m1(const Args& A, const Ctx& C, int l) {
    LAS MoeTab* T = (LAS MoeTab*)(C.lds + LDS_TAB); LAS unsigned* ridx = (LAS unsigned*)(C.lds + LDS_TAB + 1024);
    moe_tables<true>(A, C, l, 4, T, ridx, D);
    MoeSched S; S.T = T; S.ridx = ridx; S.A = (const char*)(A.ws + WS_H8); S.W = (const char*)(A.ws + WS_WGU); S.wstride_e = (size_t)2 * DE * D; S.tstepB = (size_t)BM * D; S.K = D; S.arow_bytes = 0;
    EpiSwigluF8 E{A.ws + WS_DC, DE, 1.0f / WSCALE}; gemm_phase<EpiSwigluF8, MoeSched, true, 1>(C.lds, D, S, E);
}
__device__ __forceinline__ void phase_m2(const Args& A, const Ctx& C, int l) {
    LAS MoeTab* T = (LAS MoeTab*)(C.lds + LDS_TAB); LAS unsigned* ridx = (LAS unsigned*)(C.lds + LDS_TAB + 1024);
    moe_tables<false>(A, C, l, 4, T, ridx, DE);
    MoeSched S; S.T = T; S.ridx = ridx; S.A = (const char*)(A.ws + WS_DC); S.W = (const char*)(A.ws + WS_WDN); S.wstride_e = (size_t)D * DE; S.tstepB = (size_t)BM * DE; S.K = DE; S.arow_bytes = DE;
    EpiStoreTile E{A.ws + WS_PB, D, YSCALE / WSCALE}; gemm_phase<EpiStoreTile, MoeSched, false, 1>(C.lds, DE, S, E);
}

typedef float f32x16 __attribute__((ext_vector_type(16)));
#define MFMA32(a, b, c) __builtin_amdgcn_mfma_f32_32x32x16_bf16((a), (b), (c), 0, 0, 0)
__device__ __forceinline__ bf16x8 pack8(float a0, float a1, float a2, float a3, float a4, float a5, float a6, float a7) {
    u32x4 p; p.x = cvt2(a0, a1); p.y = cvt2(a2, a3); p.z = cvt2(a4, a5); p.w = cvt2(a6, a7); return __builtin_bit_cast(bf16x8, p); }
__device__ __forceinline__ float bflo(unsigned w) { return __uint_as_float(w << 16); }
__device__ __forceinline__ float bfhi(unsigned w) { return __uint_as_float(w & 0xffff0000u); }
__device__ __forceinline__ int vt_tile(int b, int h, int blk) { return (blk == 0 ? 128 + b : b * 64 + blk - 1) * NH + h; }

__device__ __forceinline__ float wave_incl_scan(float v, int lane) {
#pragma unroll
    for (int o = 1; o < 64; o <<= 1) { const float t = __shfl_up(v, o); v += (lane >= o) ? t : 0.f; }
    return v;
}
__device__ __forceinline__ void block_gates(const Args& A, int row0, int h, LAS float* bf, LAS float* bb, LAS float* lif, LAS float* lib, int tid) {
    const float* GATE = (const float*)(A.ws + WS_GATE);
    if (tid < 256) { const float* g = GATE + (size_t)(row0 + tid) * 16; lif[tid] = g[0 + h]; bf[tid] = g[4 + h]; lib[tid] = g[8 + h]; bb[tid] = g[12 + h]; }
    __syncthreads();
    const int lane = tid & 63, wv = tid >> 6;
    if (wv == 0) { f32x4 x = *(LAS f32x4*)(bf + 4 * lane); x.y += x.x; x.z += x.y; x.w += x.z; const float tot = wave_incl_scan(x.w, lane); const float ex = tot - x.w;
        x.x += ex; x.y += ex; x.z += ex; x.w += ex; *(LAS f32x4*)(bf + 4 * lane) = x; }
    if (wv == 1) { f32x4 y = *(LAS f32x4*)(bb + 4 * (63 - lane)); y.z += y.w; y.y += y.z; y.x += y.y; const float tot = wave_incl_scan(y.x, lane); const float ex = tot - y.x;
        y.x += ex; y.y += ex; y.z += ex; y.w += ex; *(LAS f32x4*)(bb + 4 * (63 - lane)) = y; }
    __syncthreads();
}
__device__ __forceinline__ void phase_s1(const Args& A, const Ctx& C, int l) {
    LAS float* bf = (LAS float*)C.lds; LAS float* bb = bf + 256; LAS float* lif = bb + 256; LAS float* lib = lif + 256; LAS float* af = lib + 256; LAS float* ab = af + 256;
    constexpr int KP = 528;
    LAS unsigned char* KTf = C.lds + 8192; LAS unsigned char* KTb = KTf + 128 * KP;
    const bf16* P = (const bf16*)(A.ws + WS_PB); const bf16* VT = (const bf16*)(A.ws + WS_VT);
    bf16* DC = (bf16*)(A.ws + WS_DC); float* DN = (float*)(A.ws + WS_DN); float* BT = (float*)(A.ws + WS_BTOT);
    const int r = C.lane & 31, hh = C.lane >> 5, w = C.wave;
    for (int it = C.bid; it < BATCH * NH * (NBLK - 1) + 2 * BATCH * NH; it += C.G) {
        const bool isctx = it >= BATCH * NH * (NBLK - 1); const int ci_ = it - BATCH * NH * (NBLK - 1);
        const int bh = isctx ? (ci_ >> 1) : it / (NBLK - 1), blk = isctx ? 0 : 1 + it % (NBLK - 1), h = bh % NH, b = bh / NH; const int u = bh * NBLK + blk; const int row0 = blk_row0(b, blk);
        const int dlo = isctx ? (ci_ & 1) : 0, dhi = isctx ? (ci_ & 1) + 1 : 2;
        block_gates(A, row0, h, bf, bb, lif, lib, C.tid);
        if (C.tid < 256) { af[C.tid] = __expf(bf[255] - bf[C.tid] + lif[C.tid]); ab[C.tid] = __expf(bb[0] - bb[C.tid] + lib[C.tid]); }
        if (C.tid == 0) { BT[u * 2 + 0] = bf[255]; BT[u * 2 + 1] = bb[0]; }
        __syncthreads();
        { const int sp = C.tid >> 2, dq = C.tid & 3, s0 = 2 * sp;
          const bf16* k0 = P + (size_t)(row0 + s0) * PW + NQ + h * DQK + 32 * dq;
          const float f0 = af[s0], f1 = af[s0 + 1], g0 = ab[s0], g1 = ab[s0 + 1];
#pragma unroll
          for (int c = 0; c < 4; ++c) { const u32x4 x0 = *(const u32x4*)(k0 + 8 * c), x1 = *(const u32x4*)(k0 + PW + 8 * c);
#pragma unroll
              for (int q = 0; q < 4; ++q) { const int d = 32 * dq + 8 * c + 2 * q;
                  const int cs = (s0 * 2 + 64 * dq) & 511;
                  const float a0 = bflo(x0[q]), a1 = bfhi(x0[q]), c0 = bflo(x1[q]), c1 = bfhi(x1[q]);
                  *(LAS unsigned*)(KTf + d * KP + cs) = cvt2(a0 * f0, c0 * f1); *(LAS unsigned*)(KTf + (d + 1) * KP + cs) = cvt2(a1 * f0, c1 * f1);
                  *(LAS unsigned*)(KTb + d * KP + cs) = cvt2(a0 * g0, c0 * g1); *(LAS unsigned*)(KTb + (d + 1) * KP + cs) = cvt2(a1 * g0, c1 * g1); } } }
        __syncthreads();
        if (C.tid < 256) { const int dir = C.tid >> 7, d = C.tid & 127; LAS const unsigned* kr = (LAS const unsigned*)((dir ? KTb : KTf) + d * KP); float s = 0.f;
#pragma unroll 8
            for (int i = 0; i < 32; ++i) { const u32x4 x = *(LAS const u32x4*)(kr + 4 * i); s += ((bflo(x.x) + bfhi(x.x)) + (bflo(x.y) + bfhi(x.y))) + ((bflo(x.z) + bfhi(x.z)) + (bflo(x.w) + bfhi(x.w))); }
            DN[(size_t)(u * 2 + dir) * DQK + d] = s; }
        const bf16* vt = VT + (size_t)vt_tile(b, h, blk) * 65536 + (size_t)(32 * w + r) * 32 + 8 * hh;
        bf16x8 av[16];
#pragma unroll
        for (int ks = 0; ks < 16; ++ks) av[ks] = *(const bf16x8*)(vt + (ks >> 1) * 8192 + 16 * (ks & 1));
#pragma unroll 1
        for (int dir = dlo; dir < dhi; ++dir) {
            LAS const unsigned char* KT = dir ? KTb : KTf;
            f32x16 acc[4];
#pragma unroll
            for (int dt = 0; dt < 4; ++dt)
#pragma unroll
                for (int i = 0; i < 16; ++i) acc[dt][i] = 0.f;
#pragma unroll
            for (int ks = 0; ks < 16; ++ks) {
#pragma unroll
                for (int dt = 0; dt < 4; ++dt) { const bf16x8 b0 = *(const LAS bf16x8*)(KT + (dt * 32 + r) * KP + ((32 * ks + 64 * dt) & 511)   + 16 * hh); acc[dt] = MFMA32(av[ks], b0, acc[dt]); }
                if ((ks & 3) == 3) asm volatile("" ::: "memory"); }
            bf16* dc = DC + (size_t)(u * 2 + dir) * DQK * DV + (size_t)(32 * w + 4 * hh) * 32 + r;
#pragma unroll
            for (int g = 0; g < 4; ++g) { bf16* pf = dc + g * 8 * 32; asm volatile("" : "+v"(pf));
#pragma unroll
                for (int q = 0; q < 4; ++q)
#pragma unroll
                    for (int dt = 0; dt < 4; ++dt) pf[q * 32 + dt * 8192] = (bf16)f2bf(acc[dt][4 * g + q]); }
        }
        __syncthreads();
    }
}
__device__ __forceinline__ void phase_s2(const Args& A, const Ctx& C) {
    const bf16* __restrict__ DC = (const bf16*)(A.ws + WS_DC); const float* __restrict__ DN = (const float*)(A.ws + WS_DN); const float* __restrict__ BT = (const float*)(A.ws + WS_BTOT);
    bf16* __restrict__ CST = (bf16*)(A.ws + WS_CST); float* __restrict__ NST = (float*)(A.ws + WS_NST);
    constexpr int EL4 = DQK * DV / 4;
    for (int g = C.bid * NT + C.tid; g < BATCH * NH * 2 * EL4; g += C.G * NT) {
        const int e4 = (g % EL4) * 4, ch = g / EL4, dir = ch & 1, bh = ch >> 1;
        f32x4 st = (f32x4){0.f, 0.f, 0.f, 0.f};
        constexpr int PF = 16;
        u32x2 ring[PF]; float decr[PF];
#define S2_BLK(idx_) (dir == 0 ? (idx_) : ((idx_) == 0 ? 0 : NBLK - (idx_)))
#pragma unroll
        for (int i = 0; i < PF; ++i) { const int u = bh * NBLK + S2_BLK(i); ring[i] = *(const u32x2*)(DC + (size_t)(u * 2 + dir) * DQK * DV + e4); decr[i] = BT[u * 2 + dir]; }
#pragma unroll
        for (int idx = 0; idx < NBLK; ++idx) {
            const int u = bh * NBLK + S2_BLK(idx);
            const f32x4 dc = bf4(ring[idx % PF]); const float dec = __expf(decr[idx % PF]);
            if (idx + PF < NBLK) { const int u2 = bh * NBLK + S2_BLK(idx + PF); ring[idx % PF] = *(const u32x2*)(DC + (size_t)(u2 * 2 + dir) * DQK * DV + e4); decr[idx % PF] = BT[u2 * 2 + dir]; }
            u32x2 o; o.x = cvt2(st.x, st.y); o.y = cvt2(st.z, st.w);
            *(u32x2*)(CST + (size_t)(u * 2 + dir) * DQK * DV + e4) = o;
            st = st * dec + dc;
        }
#undef S2_BLK
    }
    if (C.wave == 0 && C.bid * 64 < BATCH * NH * 2 * DQK) {
        const int g = C.bid * 64 + C.lane; const int d = g % DQK, ch = g / DQK, dir = ch & 1, bh = ch >> 1; float st = 0.f;
        constexpr int PF = 16; float dnr[PF], btr[PF];
#define S2_BLK(idx_) (dir == 0 ? (idx_) : ((idx_) == 0 ? 0 : NBLK - (idx_)))
#pragma unroll
        for (int i = 0; i < PF; ++i) { const int u = bh * NBLK + S2_BLK(i); dnr[i] = DN[(size_t)(u * 2 + dir) * DQK + d]; btr[i] = BT[u * 2 + dir]; }
#pragma unroll
        for (int idx = 0; idx < NBLK; ++idx) {
            const int u = bh * NBLK + S2_BLK(idx);
            const float dn = dnr[idx % PF], dec = __expf(btr[idx % PF]);
            if (idx + PF < NBLK) { const int u2 = bh * NBLK + S2_BLK(idx + PF); dnr[idx % PF] = DN[(size_t)(u2 * 2 + dir) * DQK + d]; btr[idx % PF] = BT[u2 * 2 + dir]; }
            NST[(size_t)(u * 2 + dir) * DQK + d] = st; st = dec * st + dn;
        }
#undef S2_BLK
    }
}
__device__ __forceinline__ void lds_barrier() { asm volatile("s_waitcnt lgkmcnt(0)" ::: "memory"); __builtin_amdgcn_s_barrier(); asm volatile("" ::: "memory"); }
__device__ __forceinline__ void phase_s3(const Args& A, const Ctx& C, int l) {
    const int jl = l >> 1; const bool ctx_out = (l == 0);
    LAS float* bf = (LAS float*)C.lds; LAS float* bb = bf + 256; LAS float* gf = bb + 256; LAS float* gb = gf + 256;
    LAS float* nf = gb + 256; LAS float* nb = nf + 128; LAS float* ssx = nb + 128;
    LAS float* cf = ssx + 256; LAS float* cb = cf + 256;
    constexpr int KP = 272, OP = 528, CHB = 16384, NCHB = 4;
    LAS unsigned char* Kimg = C.lds + 8192;
    LAS unsigned char* CH = Kimg + 256 * KP;
    LAS unsigned char* OUT = Kimg;
    static_assert(8192 + 256 * KP + NCHB * CHB <= LDS_TAB_END && 8192 + 256 * OP <= LDS_TAB_END, "S3 LDS map");
    const bf16* P = (const bf16*)(A.ws + WS_PB); const bf16* VT = (const bf16*)(A.ws + WS_VT); unsigned char* HM = A.ws + WS_HM;
    const bf16* CST = (const bf16*)(A.ws + WS_CST); const float* NST = (const float*)(A.ws + WS_NST);
    const float* hg = A.in[10] + (size_t)jl * NV;
    const int w = C.wave;
    bf16x8 qf[8]; u32x4 kr8[8]; f32x4 gl;
#define S3_UNIT(it_) ((it_) < BATCH * NH * (NBLK - 1) ? ((it_) / (NBLK - 1)) * NBLK + 1 + (it_) % (NBLK - 1) : ((it_) - BATCH * NH * (NBLK - 1)) * NBLK)
#define S3_LOAD_IN(u_) do { const int u2_ = (u_); const int blk_ = u2_ % NBLK, bh_ = u2_ / NBLK, h_ = bh_ % NH, b_ = bh_ / NH; const int row0_ = blk_row0(b_, blk_); \
        int tq_ = threadIdx.x; asm volatile("" : "+v"(tq_)); const int lq_ = tq_ & 63; \
        { const bf16* qr_ = P + (size_t)(row0_ + 32 * w + (lq_ & 31)) * PW + h_ * DQK + 8 * (lq_ >> 5); \
          _Pragma("unroll") for (int kk = 0; kk < 8; ++kk) qf[kk] = *(const bf16x8*)(qr_ + 16 * kk); } \
        { const bf16* kr_ = P + (size_t)(row0_ + (tq_ >> 4)) * PW + NQ + h_ * DQK + 8 * (tq_ & 15); \
          _Pragma("unroll") for (int i = 0; i < 8; ++i) kr8[i] = *(const u32x4*)(kr_ + (size_t)(32 * i) * PW); } \
        if (tq_ < 256) { const float* g_ = (const float*)(A.ws + WS_GATE) + (size_t)(row0_ + tq_) * 16 + h_; gl = (f32x4){g_[0], g_[4], g_[8], g_[12]}; } \
        else { const int t2_ = tq_ - 256; gl = (f32x4){NST[(size_t)(u2_ * 2 + (t2_ >> 7)) * DQK + (t2_ & 127)], 0.f, 0.f, 0.f}; } } while (0)
    const int nitems = BATCH * NH * (NBLK - 1) + (ctx_out ? BATCH * NH : 0);
    int it = C.bid;
    if (it < nitems) S3_LOAD_IN(S3_UNIT(it));
    while (it < nitems) {
        const int u = S3_UNIT(it);
        const int blk = u % NBLK, bh = u / NBLK, h = bh % NH, b = bh / NH; const int row0 = blk_row0(b, blk);
        const int itn = it + C.G; const int un = itn < nitems ? S3_UNIT(itn) : u;
        const bf16* vtile = VT + (size_t)vt_tile(b, h, blk) * 65536;
        const bf16* ctile = CST + (size_t)(u * 2) * DQK * DV;
#define S3_DMA(c_) do { const int cc_ = (c_); const bool isv_ = cc_ < 8; int ld_ = threadIdx.x & 63; asm volatile("" : "+v"(ld_)); \
                const unsigned dlp_ = (unsigned)(((ld_ & 3) ^ ((ld_ >> 4) & 3)) * 16), drow_ = (unsigned)(32 * w + (ld_ >> 2)); \
                const unsigned long long gp_ = (unsigned long long)(isv_ ? (const char*)vtile + 16384 * cc_ : (const char*)ctile + (cc_ >= 12 ? 2 * DQK * DV : 0) + 16384 * ((cc_ - 8) & 3)); \
                const char* gb_ = (const char*)(((unsigned long long)(unsigned)__builtin_amdgcn_readfirstlane((int)(unsigned)(gp_ >> 32)) << 32) | (unsigned)__builtin_amdgcn_readfirstlane((int)(unsigned)gp_)); \
                _Pragma("unroll") for (int jj = 0; jj < 2; ++jj) \
                    asm volatile("s_mov_b32 m0, %2\n\ts_nop 0\n\tglobal_load_lds_dwordx4 %0, %1" :: "v"(((drow_ + 16u * jj) << 6) + dlp_), "s"(gb_), "s"((unsigned)(size_t)CH + (unsigned)w * 2048u + (unsigned)((cc_ & 3) * CHB + jj * 1024)) : "memory"); } while (0)
        S3_DMA(0); S3_DMA(1); S3_DMA(2);
        { int tu = threadIdx.x; asm volatile("" : "+v"(tu));
          if (tu < 256) { gf[tu] = gl.x; bf[tu] = gl.y; gb[tu] = gl.z; bb[tu] = gl.w; } else nf[tu - 256] = gl.x;
          { const int pc = tu & 15, s0 = tu >> 4, ps0 = (s0 & ~12) | ((s0 & 4) << 1) | ((s0 & 8) >> 1);
#pragma unroll
            for (int i = 0; i < 8; ++i) *(LAS u32x4*)(Kimg + (ps0 + 32 * i) * KP + pc * 16) = kr8[i]; }
          lds_barrier();
          const int lane = tu & 63, wv = tu >> 6;
          if (wv == 0) { f32x4 x = *(LAS f32x4*)(bf + 4 * lane); x.y += x.x; x.z += x.y; x.w += x.z; const float tot = wave_incl_scan(x.w, lane); const float ex = tot - x.w;
              x.x += ex; x.y += ex; x.z += ex; x.w += ex; *(LAS f32x4*)(bf + 4 * lane) = x; }
          if (wv == 1) { f32x4 y = *(LAS f32x4*)(bb + 4 * (63 - lane)); y.z += y.w; y.y += y.z; y.x += y.y; const float tot = wave_incl_scan(y.x, lane); const float ex = tot - y.x;
              y.x += ex; y.y += ex; y.z += ex; y.w += ex; *(LAS f32x4*)(bb + 4 * (63 - lane)) = y; }
          lds_barrier();
          if (tu < 256) { const float a0 = gf[tu] - bf[tu], a1 = gb[tu] - bb[tu]; gf[tu] = a0; gb[tu] = a1; cf[tu] = __expf(bf[tu | 31] + a0); cb[tu] = __expf(bb[tu & ~31] + a1); }
          lds_barrier(); }
        {
            int lz = threadIdx.x & 63; asm volatile("" : "+v"(lz));
            const int r = lz & 31, hh = lz >> 5;
            const int jt = w;
            const float bfj = bf[32 * jt + r], bbj = bb[32 * jt + r];
            float qnf = 0.f, qnb = 0.f;
#pragma unroll
            for (int kk = 0; kk < 8; ++kk) { u32x4 qq = __builtin_bit_cast(u32x4, qf[kk]); asm volatile("" : "+v"(qq));
                const int d = 16 * kk + 8 * hh;
                const f32x4 n0 = *(const LAS f32x4*)(nf + d), n1 = *(const LAS f32x4*)(nf + d + 4), m0 = *(const LAS f32x4*)(nb + d), m1 = *(const LAS f32x4*)(nb + d + 4);
                qnf += (bflo(qq.x) * n0.x + bfhi(qq.x) * n0.y) + (bflo(qq.y) * n0.z + bfhi(qq.y) * n0.w) + (bflo(qq.z) * n1.x + bfhi(qq.z) * n1.y) + (bflo(qq.w) * n1.z + bfhi(qq.w) * n1.w);
                qnb += (bflo(qq.x) * m0.x + bfhi(qq.x) * m0.y) + (bflo(qq.y) * m0.z + bfhi(qq.y) * m0.w) + (bflo(qq.z) * m1.x + bfhi(qq.z) * m1.y) + (bflo(qq.w) * m1.z + bfhi(qq.w) * m1.w);
                if (kk & 1) asm volatile("" ::: "memory"); }
            qnf += __shfl_xor(qnf, 32); qnb += __shfl_xor(qnb, 32);
            float denf = 0.f, denb = 0.f;
#pragma unroll 1
            for (int kt = 0; kt < 8; ++kt) {
                f32x16 c;
#pragma unroll
                for (int i = 0; i < 16; ++i) c[i] = 0.f;
#pragma unroll
                for (int kk = 0; kk < 8; ++kk) { const bf16x8 a = *(const LAS bf16x8*)(Kimg + (kt * 32 + r) * KP + (16 * kk + 8 * hh) * 2); c = MFMA32(a, qf[kk], c); }
                if (kt == jt) {
#pragma unroll
                    for (int g = 0; g < 4; ++g) { const int sl0 = 16 * (g >> 1) + 8 * hh + 4 * (g & 1);
                        const f32x4 g4f = *(const LAS f32x4*)(gf + kt * 32 + sl0), g4b = *(const LAS f32x4*)(gb + kt * 32 + sl0);
#pragma unroll
                        for (int q = 0; q < 4; ++q) { const int sl = sl0 + q; const float cv = c[4 * g + q];
                            denf += cv * __expf((sl <= r) ? bfj + g4f[q] : -1.0e30f); denb += cv * __expf((sl >= r) ? bbj + g4b[q] : -1.0e30f); } }
                } else {
                    LAS const float* cx = (kt < jt ? cf : cb) + kt * 32 + 8 * hh; float sm = 0.f;
#pragma unroll
                    for (int g = 0; g < 4; ++g) { const f32x4 c4 = *(const LAS f32x4*)(cx + 16 * (g >> 1) + 4 * (g & 1)); sm += (c[4 * g] * c4.x + c[4 * g + 1] * c4.y) + (c[4 * g + 2] * c4.z + c[4 * g + 3] * c4.w); }
                    if (kt < jt) denf += sm * __expf(bfj - bf[kt * 32 + 31]); else denb += sm * __expf(bbj - bb[kt * 32]);
                }
            }
            denf += __shfl_xor(denf, 32); denb += __shfl_xor(denb, 32);
            const float ebf = __expf(bfj), ebb = __expf(bbj);
            denf += ebf * qnf; denb += ebb * qnb;
            const float rf = 1.0f / fmaxf(fabsf(denf), 1.0f), rb = 1.0f / fmaxf(fabsf(denb), 1.0f);
            const float scf = ebf * rf, scb = ebb * rb;
            unsigned wdg[8];
#pragma unroll
            for (int g = 0; g < 4; ++g) { const int sl0 = 16 * (g >> 1) + 8 * hh + 4 * (g & 1);
                const f32x4 g4f = *(const LAS f32x4*)(gf + jt * 32 + sl0), g4b = *(const LAS f32x4*)(gb + jt * 32 + sl0);
                float wv[4];
#pragma unroll
                for (int q = 0; q < 4; ++q) { const int sl = sl0 + q; wv[q] = rf * __expf((sl <= r) ? bfj + g4f[q] : -1.0e30f) + rb * __expf((sl >= r) ? bbj + g4b[q] : -1.0e30f); }
                wdg[2 * g] = cvt2(wv[0], wv[1]); wdg[2 * g + 1] = cvt2(wv[2], wv[3]); }
            f32x16 acc[8];
#pragma unroll
            for (int et = 0; et < 8; ++et)
#pragma unroll
                for (int i = 0; i < 16; ++i) acc[et][i] = 0.f;
            asm volatile("s_waitcnt vmcnt(0)" ::: "memory");
            const int swz = (r >> 2) & 3;
#pragma unroll 1
            for (int ci = 0; ci < 8; ++ci) {
                if (ci) { if (blk == 0 && ci >= 6) { if (ci == 6) asm volatile("s_waitcnt vmcnt(2)" ::: "memory"); else asm volatile("s_waitcnt vmcnt(0)" ::: "memory"); } else asm volatile("s_waitcnt vmcnt(4)" ::: "memory"); }
                lds_barrier();
                if (blk != 0 || ci + 3 < 8) S3_DMA(ci + 3);
                LAS const unsigned char* CHc = CH + (ci & 3) * CHB;
                { const int kt = ci;
                        f32x16 c;
#pragma unroll
                        for (int i = 0; i < 16; ++i) c[i] = 0.f;
#pragma unroll
                        for (int kk = 0; kk < 8; ++kk) { const bf16x8 a = *(const LAS bf16x8*)(Kimg + (kt * 32 + r) * KP + (16 * kk + 8 * hh) * 2); c = MFMA32(a, qf[kk], c); }
                        float p[16];
                        if (kt == jt) {
#pragma unroll
                            for (int i = 0; i < 8; ++i) { p[2 * i] = c[2 * i] * bflo(wdg[i]); p[2 * i + 1] = c[2 * i + 1] * bfhi(wdg[i]); }
                        } else {
                            LAS const float* cx = (kt < jt ? cf : cb) + kt * 32 + 8 * hh;
                            const float rw = (kt < jt) ? rf * __expf(bfj - bf[kt * 32 + 31]) : rb * __expf(bbj - bb[kt * 32]);
#pragma unroll
                            for (int g = 0; g < 4; ++g) { const f32x4 c4 = *(const LAS f32x4*)(cx + 16 * (g >> 1) + 4 * (g & 1));
                                p[4 * g] = c[4 * g] * (c4.x * rw); p[4 * g + 1] = c[4 * g + 1] * (c4.y * rw); p[4 * g + 2] = c[4 * g + 2] * (c4.z * rw); p[4 * g + 3] = c[4 * g + 3] * (c4.w * rw); }
                        }
                        const bf16x8 pa0 = pack8(p[0], p[1], p[2], p[3], p[4], p[5], p[6], p[7]), pa1 = pack8(p[8], p[9], p[10], p[11], p[12], p[13], p[14], p[15]);
#pragma unroll
                        for (int et = 0; et < 8; ++et) { LAS const unsigned char* vb = CHc + (et * 32 + r) * 64;
                            const bf16x8 a0 = *(const LAS bf16x8*)(vb + ((hh ^ swz) << 4)), a1 = *(const LAS bf16x8*)(vb + (((2 + hh) ^ swz) << 4));
                            acc[et] = MFMA32(a0, pa0, acc[et]); acc[et] = MFMA32(a1, pa1, acc[et]);
                            if (et & 1) asm volatile("" ::: "memory"); }
                }
            }
            if (blk != 0) {
#pragma unroll
            for (int ci = 8; ci < 16; ++ci) {
                if (ci <= 13) asm volatile("s_waitcnt vmcnt(4)" ::: "memory"); else if (ci == 14) asm volatile("s_waitcnt vmcnt(2)" ::: "memory"); else asm volatile("s_waitcnt vmcnt(0)" ::: "memory");
                lds_barrier();
                if (ci + 3 < 16) S3_DMA(ci + 3);
                LAS const unsigned char* CHc = CH + (ci & 3) * CHB;
                {
                    const int dir = (ci - 8) >> 2, dq = (ci - 8) & 3;
                    const float sc = dir ? scb : scf;
#pragma unroll
                    for (int k2 = 0; k2 < 2; ++k2) { const u32x4 qq = __builtin_bit_cast(u32x4, qf[2 * dq + k2]);
                        const bf16x8 qs = pack8(bflo(qq.x) * sc, bfhi(qq.x) * sc, bflo(qq.y) * sc, bfhi(qq.y) * sc, bflo(qq.z) * sc, bfhi(qq.z) * sc, bflo(qq.w) * sc, bfhi(qq.w) * sc);
#pragma unroll
                        for (int et = 0; et < 8; ++et) { const bf16x8 a = *(const LAS bf16x8*)(CHc + (et * 32 + r) * 64 + (((2 * k2 + hh) ^ swz) << 4)); acc[et] = MFMA32(a, qs, acc[et]);
                            if ((et & 3) == 3) asm volatile("" ::: "memory"); } }
                }
            }
            }
            u32x4 ov[16]; f32x4 g0, g1;
            { int tz = threadIdx.x & 63; asm volatile("" : "+v"(tz)); const int pc = tz & 31, lr0 = tz >> 5;
              g0 = *(const f32x4*)(hg + h * DV + 8 * pc); g1 = *(const f32x4*)(hg + h * DV + 8 * pc + 4);
#pragma unroll
              for (int i = 0; i < 16; ++i) ov[i] = *(const u32x4*)(P + (size_t)(row0 + 32 * w + lr0 + 2 * i) * PW + 2 * NQ + NV + h * DV + 8 * pc); }
            float ss = 0.f;
#pragma unroll
            for (int et = 0; et < 8; ++et)
#pragma unroll
                for (int i = 0; i < 16; ++i) ss += acc[et][i] * acc[et][i];
            ss += __shfl_xor(ss, 32);
            const float rs = 1.0f / sqrtf(ss * (1.0f / DV) + EPS);
            lds_barrier();
            { LAS unsigned char* ob = OUT + (w * 32 + r) * OP + (4 * hh) * 2;
#pragma unroll
              for (int et = 0; et < 8; ++et)
#pragma unroll
                  for (int g = 0; g < 4; ++g) { u32x2 o; o.x = cvt2(acc[et][4 * g + 0] * rs, acc[et][4 * g + 1] * rs); o.y = cvt2(acc[et][4 * g + 2] * rs, acc[et][4 * g + 3] * rs);
                      *(LAS u32x2*)(ob + (et * 32 + 8 * g) * 2) = o; } }
            asm volatile("s_waitcnt lgkmcnt(0)" ::: "memory");
            S3_LOAD_IN(un);
            { int tz = threadIdx.x & 63; asm volatile("" : "+v"(tz)); const int pc = tz & 31, lr0 = tz >> 5;
#pragma unroll
              for (int i = 0; i < 16; ++i) { const int lr = 32 * w + lr0 + 2 * i; const int grow = row0 + lr;
                  const u32x4 hv = *(const LAS u32x4*)(OUT + lr * OP + pc * 16);
                  const f32x4 o0 = (f32x4){bflo(hv.x) * g0.x * bflo(ov[i].x), bfhi(hv.x) * g0.y * bfhi(ov[i].x), bflo(hv.y) * g0.z * bflo(ov[i].y), bfhi(hv.y) * g0.w * bfhi(ov[i].y)};
                  const f32x4 o1 = (f32x4){bflo(hv.z) * g1.x * bflo(ov[i].z), bfhi(hv.z) * g1.y * bfhi(ov[i].z), bflo(hv.w) * g1.z * bflo(ov[i].w), bfhi(hv.w) * g1.w * bfhi(ov[i].w)};
                  *(u32x2*)(HM + (size_t)grow * D + h * DV + 8 * pc) = (u32x2){pack_i8(o0 * (127.0f / HMR)), pack_i8(o1 * (127.0f / HMR))};
                  if ((i & 3) == 3) asm volatile("" ::: "memory"); } }
        }
#undef S3_DMA
        lds_barrier();
        it = itn;
    }
    if (l == 0) {
        const int rem = nitems % C.G;
        if (rem != 0 && C.bid >= rem) { const int first = cvt_t2(0, C.G) + (C.bid - rem) * CVT_Q3; const int last = min(first + CVT_Q3, cvt_t3(0, C.G));
            cvt_moe_items(A, fresh(C), 0, first + C.wave, last, NW); } }
#undef S3_LOAD_IN
#undef S3_UNIT
}

#define XB_TMO      128
#define XB_XCNT(j)  (256  + 64 * (j))
#define XB_XSUB(j)  (1280 + 64 * (j))
#define XB_XGEN(j)  (2304 + 64 * (j))
#define XB_TOP      3328
#define XB_TOPGEN   3392
#define XCD_BAR_WORDS 3456
#define XB_SPIN_CAP (1u << 18)

__device__ __forceinline__ unsigned xb_ld(unsigned* p)              { return __hip_atomic_load(p, __ATOMIC_RELAXED, __HIP_MEMORY_SCOPE_AGENT); }
__device__ __forceinline__ unsigned xb_add(unsigned* p, unsigned v) { return __hip_atomic_fetch_add(p, v, __ATOMIC_RELAXED, __HIP_MEMORY_SCOPE_AGENT); }
__device__ __forceinline__ unsigned xb_xcc_id() { return (unsigned)__builtin_amdgcn_s_getreg((3 << 11) | 20) & 0xFu; }
#define XB_SPIN(cond, bar) do { unsigned _sp = 0; while (cond) { __builtin_amdgcn_s_sleep(1); \
    if ((++_sp & 255u) == 0u) { if (xb_ld(&(bar)[XB_TMO])) break; if (_sp > XB_SPIN_CAP) { atomicAdd(&(bar)[XB_TMO], 1u); break; } } } } while (0)

struct XcdBarrier {
    unsigned* bar; unsigned x;
    volatile LAS unsigned* st;
};

__device__ __forceinline__ XcdBarrier xcd_barrier_post(unsigned* bar, volatile LAS unsigned* st) {
    XcdBarrier b; b.bar = bar; b.x = xb_xcc_id(); b.st = st;
    if (threadIdx.x == 0) (void)xb_add(&bar[XB_XCNT(b.x)], 1u);
    return b;
}
__device__ __forceinline__ void xcd_barrier_complete(unsigned* bar, unsigned x, unsigned& nloc, unsigned& nx) {
    const unsigned G = gridDim.x * gridDim.y * gridDim.z;
    unsigned sum, cnt, mine, sp = 0u;
    for (;;) {
        sum = 0u; cnt = 0u; mine = 0u;
#pragma unroll
        for (unsigned j = 0; j < 16; ++j) { const unsigned c = xb_ld(&bar[XB_XCNT(j)]); sum += c; cnt += (c > 0u) ? 1u : 0u; mine = (j == x) ? c : mine; }
        if (sum == G) break;
        __builtin_amdgcn_s_sleep(1);
        if ((++sp & 255u) == 0u) { if (xb_ld(&bar[XB_TMO])) break; if (sp > XB_SPIN_CAP) { atomicAdd(&bar[XB_TMO], 1u); break; } }
    }
    nloc = mine > 0u ? mine : 1u; nx = cnt > 0u ? cnt : 1u;
}

__device__ __forceinline__ void xcd_barrier(const XcdBarrier& b) {
    asm volatile("s_waitcnt vmcnt(0)" ::: "memory");
    __syncthreads();
    if (threadIdx.x == 0) {
        unsigned* bar = b.bar;
        __builtin_amdgcn_s_waitcnt(0);
        unsigned nloc = b.st[0], nx = b.st[1];
        if (nloc == 0u) { xcd_barrier_complete(bar, b.x, nloc, nx); b.st[0] = nloc; b.st[1] = nx; }
        const unsigned old = xb_add(&bar[XB_XSUB(b.x)], 1u);
        const unsigned gen = old / nloc;
        if (old + 1u == (gen + 1u) * nloc) {
            __builtin_amdgcn_fence(__ATOMIC_RELEASE, "agent");
            asm volatile("s_waitcnt vmcnt(0)" ::: "memory");
            const unsigned og = xb_add(&bar[XB_TOP], 1u);
            const unsigned tg = og / nx;
            if (og + 1u == (tg + 1u) * nx) xb_add(&bar[XB_TOPGEN], 1u);
            else XB_SPIN(xb_ld(&bar[XB_TOPGEN]) == tg, bar);
            __builtin_amdgcn_fence(__ATOMIC_ACQUIRE, "agent");
            xb_add(&bar[XB_XGEN(b.x)], 1u);
            asm volatile("s_waitcnt vmcnt(0)" ::: "memory");
        } else {
            XB_SPIN(xb_ld(&bar[XB_XGEN(b.x)]) == gen, bar);
            __builtin_amdgcn_fence(__ATOMIC_ACQUIRE, "agent");
            asm volatile("s_waitcnt vmcnt(0)" ::: "memory");
        }
    }
    __syncthreads();
}


constexpr int LDS_BYTES = 152 * 1024;
constexpr int CW_BAR = 16384;
static_assert((CW_BAR + XCD_BAR_WORDS) * 4 <= (int)CTL_BYTES, "ctl");
#ifndef MK_MULTI
#define MK_MULTI 0
#endif
#define IN(p) (lo <= (p) && (p) < hi)
#define SEAM(p) do { if ((p) + 1 < hi) { XcdBarrier b_; b_.bar = (unsigned*)(load_args().ws + WS_CTL) + CW_BAR; b_.x = xb_xcc_id(); b_.st = (volatile LAS unsigned*)(C.lds + LDS_BYTES - 16); xcd_barrier(b_); } } while (0)
#define CAS __attribute__((address_space(4)))
__device__ __forceinline__ Args load_args() {
#if defined(__HIP_DEVICE_COMPILE__)
    const CAS Args* p = (const CAS Args*)__builtin_amdgcn_kernarg_segment_ptr(); asm volatile("" : "+s"(p));
    Args a; for (int i = 0; i < 22; ++i) a.in[i] = p->in[i]; a.out = p->out; a.ws = p->ws; a.lo = p->lo; a.hi = p->hi; return a;
#else
    return Args{};
#endif
}
__device__ __forceinline__ Ctx fresh(const Ctx& C) { Ctx R = C; int tz = threadIdx.x; asm volatile("" : "+v"(tz)); R.tid = tz; R.lane = tz & 63; return R; }
template <int L> __device__ __forceinline__ void layer_phases(const Args& args, const Ctx& C, int bar, int lo, int hi) {
    constexpr int pb = 16 * L;
    if (IN(pb + 1)) { phase_r1(load_args(), fresh(C), L); SEAM(pb + 1); }
    if (IN(pb + 2)) { phase_g1(load_args(), fresh(C), L); SEAM(pb + 2); }
    if constexpr ((L & 1) == 0) {
        if (IN(pb + 3)) { phase_s1(load_args(), fresh(C), L); SEAM(pb + 3); }
        if (IN(pb + 4)) { phase_s2(load_args(), fresh(C)); SEAM(pb + 4); }
        if (IN(pb + 5)) { phase_s3(load_args(), fresh(C), L); SEAM(pb + 5); }
    } else {
        if (IN(pb + 3)) { phase_conv(load_args(), fresh(C), L); SEAM(pb + 3); }
    }
    if (IN(pb + 6)) { phase_g2(load_args(), fresh(C), L); SEAM(pb + 6); }
    if (IN(pb + 7)) { phase_r2(load_args(), fresh(C), L); SEAM(pb + 7); }
    if (IN(pb + 8)) { phase_m1(load_args(), fresh(C), L); SEAM(pb + 8); }
    if (IN(pb + 9)) { phase_m2(load_args(), fresh(C), L); SEAM(pb + 9); }
}
__global__ void __launch_bounds__(NT, 2) fwd_kernel(Args args) {
    extern __shared__ __attribute__((aligned(16))) unsigned char lds_raw[];
    Ctx C; C.lds = (LAS unsigned char*)lds_raw; C.tid = threadIdx.x; C.lane = C.tid & 63; C.wave = __builtin_amdgcn_readfirstlane(C.tid >> 6); C.G = gridDim.x; C.bid = blockIdx.x; C.a = &args;
    const int lo = args.lo, hi = args.hi;
    volatile LAS unsigned* xbw = (volatile LAS unsigned*)(C.lds + LDS_BYTES - 16);
    if (C.tid < 4) xbw[C.tid] = 0u;
    __syncthreads();
    if (hi - lo > 1) (void)xcd_barrier_post((unsigned*)(args.ws + WS_CTL) + CW_BAR, xbw);
    const int bar = 0; (void)bar;
    if (IN(0)) { phase_mod(load_args(), fresh(C)); __syncthreads(); phase_cvt_mixer(load_args(), fresh(C)); SEAM(0); }
    layer_phases<0>(args, C, bar, lo, hi);
    layer_phases<1>(args, C, bar, lo, hi);
    layer_phases<2>(args, C, bar, lo, hi);
    layer_phases<3>(args, C, bar, lo, hi);
    if (IN(64)) phase_final(load_args(), fresh(C));
}
#undef IN
#undef SEAM

extern "C" void kernel_launch(void* const* d_in, const int* in_sizes, int n_in, void* d_out, int out_size, void* d_ws, size_t ws_size, hipStream_t stream) {
    static int grid = 0;
    if (grid == 0) {
        if (n_in != 22 || out_size != NL * D || ws_size < WS_END) { fprintf(stderr, "kernel_launch: unexpected shapes (n_in %d out %d ws %zu)\n", n_in, out_size, ws_size); grid = -1; return; }
        int dev = 0, cus = 0, per_cu = 0;
        if (hipGetDevice(&dev) != hipSuccess || hipDeviceGetAttribute(&cus, hipDeviceAttributeMultiprocessorCount, dev) != hipSuccess) { grid = -1; return; }
        if (hipFuncSetAttribute((const void*)fwd_kernel, hipFuncAttributeMaxDynamicSharedMemorySize, LDS_BYTES) != hipSuccess) { grid = -1; return; }
        if (hipOccupancyMaxActiveBlocksPerMultiprocessor(&per_cu, (const void*)fwd_kernel, NT, LDS_BYTES) != hipSuccess || per_cu < 1) { fprintf(stderr, "kernel_launch: occupancy query says %d\n", per_cu); }
        (void)hipGetLastError();
        grid = cus;
    }
    if (grid < 0) return;
    (void)hipMemsetAsync((char*)d_ws + WS_CTL, 0, CTL_BYTES, stream);
    Args a{};
    for (int i = 0; i < 22; ++i) a.in[i] = (const float*)d_in[i];
    a.out = (float*)d_out; a.ws = (unsigned char*)d_ws;
#if MK_MULTI
    int phases[64]; int np = 0;
    phases[np++] = 0;
    for (int l = 0; l < DEPTH; ++l) { const int pb = 16 * l; phases[np++] = pb + 1; phases[np++] = pb + 2; phases[np++] = pb + 3;
        if ((l & 1) == 0) { phases[np++] = pb + 4; phases[np++] = pb + 5; }
        phases[np++] = pb + 6; phases[np++] = pb + 7; phases[np++] = pb + 8; phases[np++] = pb + 9; }
    phases[np++] = 64;
    for (int i = 0; i < np; ++i) { a.lo = phases[i]; a.hi = phases[i] + 1; hipLaunchKernelGGL(fwd_kernel, dim3(grid), dim3(NT), LDS_BYTES, stream, a); }
#else
    a.lo = 0; a.hi = 65;
    hipLaunchKernelGGL(fwd_kernel, dim3(grid), dim3(NT), LDS_BYTES, stream, a);
#ifdef PROBE_PHASES
    { const int pp[] = {PROBE_PHASES};
      for (int rep = 0; rep < PROBE_REPS; ++rep) for (unsigned i = 0; i < sizeof(pp) / sizeof(pp[0]); ++i) { a.lo = pp[i]; a.hi = pp[i] + 1; hipLaunchKernelGGL(fwd_kernel, dim3(grid), dim3(NT), LDS_BYTES, stream, a); } }
#endif
#endif
}
```
